# Optimizing an MI355X kernel written in HIP

```python
import math
import jax, jax.numpy as jnp
from jax import lax
import numpy as np

D_MODEL = 1024
BATCH = 8
SEQ = 4096
DEPTH = 2

CHUNK = 64
QBLOCK = 128
A_HEADS = 8
A_QK_DIM = 64
A_V_DIM = 64
A_KV_RANK = 256
IDX_HEADS = 4
IDX_DIM = 64
TOPK_MAX = 256
REL_BUCKETS = 32
REL_MAX_DIST = 1024
B_WIDTH = 512
B_GROUPS = 8
SHORT_CONV = 3
SSM_HEADS = 16
SSM_HEAD_DIM = 64
SSM_INNER = SSM_HEADS * SSM_HEAD_DIM
SSM_GROUPS = 2
SSM_HEADS_PER_GROUP = SSM_HEADS // SSM_GROUPS
SSM_STATE = 128
SSM_CONV = 4
SSM_XBC = SSM_INNER + 2 * SSM_GROUPS * SSM_STATE
MIX_WIDTH = A_HEADS * A_V_DIM + B_WIDTH + SSM_INNER
D_FF = -(-8 * D_MODEL // (3 * 256)) * 256
PLE_DIM = 256
NORM_EPS = 1e-6
IN_SPLITS = (A_HEADS * A_QK_DIM, A_KV_RANK, IDX_HEADS * IDX_DIM, IDX_DIM, IDX_HEADS,
             B_WIDTH, B_WIDTH, B_WIDTH,
             SSM_INNER, SSM_XBC, SSM_HEADS)
IN_WIDTH = sum(IN_SPLITS)

kernel_name = "hybrid_dsa_shortconv_ssd_trunk"


def rmsnorm(x, g):
    xf = x.astype(jnp.float32)
    y = xf * lax.rsqrt(jnp.mean(xf * xf, axis=-1, keepdims=True) + NORM_EPS)
    return (y * g.astype(jnp.float32)).astype(x.dtype)


def layernorm(x, g, b):
    xf = x.astype(jnp.float32)
    mu = jnp.mean(xf, axis=-1, keepdims=True)
    var = jnp.mean(jnp.square(xf - mu), axis=-1, keepdims=True)
    y = (xf - mu) * lax.rsqrt(var + NORM_EPS)
    return (y * g.astype(jnp.float32) + b.astype(jnp.float32)).astype(x.dtype)


def causal_depthwise_conv(u, w):
    k_w = w.shape[0]
    s = u.shape[1]
    up = jnp.pad(u, ((0, 0), (k_w - 1, 0), (0, 0)))
    y = up[:, 0:s] * w[0]
    for j in range(1, k_w):
        y = y + up[:, j:j + s] * w[j]
    return y


def t5_bucket(rel):
    half = REL_BUCKETS // 2
    max_exact = half // 2
    ret = jnp.where(rel > 0, half, 0)
    n = jnp.abs(rel)
    nf = jnp.maximum(n, 1).astype(jnp.float32)
    large = max_exact + (jnp.log(nf / max_exact) / math.log(REL_MAX_DIST / max_exact)
                         * (half - max_exact)).astype(jnp.int32)
    large = jnp.minimum(large, half - 1)
    return ret + jnp.where(n < max_exact, n, large)


def sparse_indexed_attention(q, c_kv, iq, ik, iw, w_uk, w_uv, rel_bias):
    bsz, s = q.shape[0], q.shape[1]
    k_top = min(TOPK_MAX, s // 4)
    n_blocks = s // QBLOCK
    q_lat = jnp.einsum("bshd,rhd->bshr", q, w_uk) * (A_QK_DIM ** -0.5)
    iq = iq * (IDX_DIM ** -0.5)
    iw = iw * (IDX_HEADS ** -0.5)
    key_chunk = jnp.arange(s, dtype=jnp.int32) // CHUNK

    def to_blocks(a):
        return jnp.moveaxis(a.reshape((bsz, n_blocks, QBLOCK) + a.shape[2:]), 1, 0)

    def block(args):
        ql, iqb, iwb, t0 = args
        qpos = t0 + jnp.arange(QBLOCK, dtype=jnp.int32)
        qchunk = qpos // CHUNK
        raw = jnp.einsum("bthd,bsd->bths", iqb, ik).astype(jnp.float32)
        idx_score = jnp.einsum("bths,bth->bts", jax.nn.relu(raw), iwb.astype(jnp.float32))
        admissible = key_chunk[None, :] <= qchunk[:, None]
        idx_score = jnp.where(admissible[None], idx_score, -jnp.inf)
        _, sel = lax.top_k(idx_score, k_top)
        valid = (sel // CHUNK) <= qchunk[None, :, None]
        kv_sel = jax.vmap(lambda c, i: c[i])(c_kv, sel)
        logits = jnp.einsum("bthr,btkr->bthk", ql, kv_sel).astype(jnp.float32)
        bias = rel_bias[t5_bucket(sel - qpos[None, :, None])].astype(jnp.float32)
        logits = logits + jnp.transpose(bias, (0, 1, 3, 2))
        logits = jnp.where(valid[:, :, None, :], logits, -jnp.inf)
        probs = jax.nn.softmax(logits, axis=-1).astype(kv_sel.dtype)
        return jnp.einsum("bthk,btkr->bthr", probs, kv_sel)

    t0s = jnp.arange(n_blocks, dtype=jnp.int32) * QBLOCK
    out = lax.map(block, (to_blocks(q_lat), to_blocks(iq), to_blocks(iw), t0s))
    out = jnp.moveaxis(out, 0, 1).reshape(bsz, s, A_HEADS, A_KV_RANK)
    out = jnp.einsum("bshr,rhd->bshd", out, w_uv)
    return out.reshape(bsz, s, A_HEADS * A_V_DIM)


def gated_short_conv(h, b_gate, c_gate, w_conv):
    return b_gate * causal_depthwise_conv(c_gate * h, w_conv)


def segsum(x):
    t = x.shape[-1]
    xr = jnp.broadcast_to(x[..., :, None], x.shape + (t,))
    xr = jnp.where(jnp.tril(jnp.ones((t, t), dtype=bool), -1), xr, 0.0)
    cs = jnp.cumsum(xr, axis=-2)
    return jnp.where(jnp.tril(jnp.ones((t, t), dtype=bool)), cs, -jnp.inf)


def ssd_chunked(xh, a, bm, cm):
    b, s, g, r, p = xh.shape
    n = bm.shape[-1]
    nc = s // CHUNK
    xh = xh.reshape(b, nc, CHUNK, g, r, p)
    bm = bm.reshape(b, nc, CHUNK, g, n)
    cm = cm.reshape(b, nc, CHUNK, g, n)
    a = jnp.transpose(a.reshape(b, nc, CHUNK, g, r), (0, 3, 4, 1, 2))
    a_cs = jnp.cumsum(a, axis=-1)
    l_mat = jnp.exp(segsum(a))
    cb = jnp.einsum("bclgn,bcsgn->bcgls", cm, bm)
    y_diag = jnp.einsum("bcgls,bgrcls,bcsgrp->bclgrp", cb, l_mat, xh)
    decay_states = jnp.exp(a_cs[..., -1:] - a_cs)
    states = jnp.einsum("bclgn,bgrcl,bclgrp->bcgrpn", bm, decay_states, xh)
    chunk_decay = jnp.exp(a_cs[..., -1])

    def step(carry, inp):
        st, dec = inp
        return carry * dec[..., None, None] + st, carry

    init = jnp.zeros((b, g, r, p, n), dtype=states.dtype)
    _, prev = lax.scan(step, init, (jnp.moveaxis(states, 1, 0), jnp.moveaxis(chunk_decay, -1, 0)))
    prev = jnp.moveaxis(prev, 0, 1)
    y_off = jnp.einsum("bclgn,bcgrpn,bgrcl->bclgrp", cm, prev, jnp.exp(a_cs))
    return (y_diag + y_off).reshape(b, s, g, r, p)


def mamba2_mixer(z, xbc, dt_raw, conv_w, conv_b, dt_bias, a_log, d_skip, norm_w):
    bsz, s = z.shape[0], z.shape[1]
    xbc = jax.nn.silu(causal_depthwise_conv(xbc, conv_w) + conv_b)
    xs = xbc[..., :SSM_INNER].reshape(bsz, s, SSM_GROUPS, SSM_HEADS_PER_GROUP, SSM_HEAD_DIM)
    bm = xbc[..., SSM_INNER:SSM_INNER + SSM_GROUPS * SSM_STATE].reshape(bsz, s, SSM_GROUPS, SSM_STATE)
    cm = xbc[..., SSM_INNER + SSM_GROUPS * SSM_STATE:].reshape(bsz, s, SSM_GROUPS, SSM_STATE)
    dt = jax.nn.softplus(dt_raw.astype(jnp.float32) + dt_bias.astype(jnp.float32))
    dt = dt.reshape(bsz, s, SSM_GROUPS, SSM_HEADS_PER_GROUP)
    a = -jnp.exp(a_log.astype(jnp.float32)).reshape(SSM_GROUPS, SSM_HEADS_PER_GROUP)
    xf = xs.astype(jnp.float32)
    y = ssd_chunked(xf * dt[..., None], dt * a, bm.astype(jnp.float32), cm.astype(jnp.float32))
    y = y + d_skip.astype(jnp.float32).reshape(SSM_GROUPS, SSM_HEADS_PER_GROUP)[..., None] * xf
    gw = SSM_HEADS_PER_GROUP * SSM_HEAD_DIM
    y = y.reshape(bsz, s, SSM_GROUPS, gw) * jax.nn.silu(z.astype(jnp.float32)).reshape(bsz, s, SSM_GROUPS, gw)
    y = rmsnorm(y, norm_w.reshape(SSM_GROUPS, gw))
    return y.reshape(bsz, s, SSM_INNER).astype(z.dtype)


def split_offsets():
    return [int(v) for v in np.cumsum(np.array(IN_SPLITS))[:-1]]


def setup_inputs(seed: int = 0) -> dict:
    key = jax.random.key(seed)
    ks = jax.random.split(key, 26)
    f32 = jnp.float32

    def nrm(k, shape, scale):
        return jax.random.normal(k, shape, f32) * scale

    def gain(k, shape):
        return 1.0 + 0.05 * jax.random.normal(k, shape, f32)

    u_dt = jax.random.uniform(ks[13], (DEPTH, SSM_HEADS), f32)
    dt0 = jnp.exp(u_dt * (math.log(0.1) - math.log(0.001)) + math.log(0.001))
    return {
        "x": nrm(ks[0], (BATCH, SEQ, D_MODEL), 1.0),
        "p": nrm(ks[1], (DEPTH, BATCH, SEQ, PLE_DIM), 1.0),
        "pre_mix_norm": gain(ks[2], (DEPTH, D_MODEL)),
        "post_mix_norm": gain(ks[3], (DEPTH, D_MODEL)),
        "pre_ffn_norm": gain(ks[4], (DEPTH, D_MODEL)),
        "post_ffn_norm": gain(ks[5], (DEPTH, D_MODEL)),
        "w_in": nrm(ks[6], (DEPTH, D_MODEL, IN_WIDTH), D_MODEL ** -0.5),
        "kv_norm": gain(ks[7], (DEPTH, A_KV_RANK)),
        "idx_k_norm_g": gain(ks[8], (DEPTH, IDX_DIM)),
        "idx_k_norm_b": nrm(ks[9], (DEPTH, IDX_DIM), 0.02),
        "w_uk": nrm(ks[10], (DEPTH, A_KV_RANK, A_HEADS, A_QK_DIM), A_KV_RANK ** -0.5),
        "w_uv": nrm(ks[11], (DEPTH, A_KV_RANK, A_HEADS, A_V_DIM), A_KV_RANK ** -0.5),
        "rel_bias": nrm(ks[12], (REL_BUCKETS, A_HEADS), 0.5),
        "short_conv_w": nrm(ks[14], (DEPTH, SHORT_CONV, B_WIDTH), SHORT_CONV ** -0.5),
        "ssm_conv_w": nrm(ks[15], (DEPTH, SSM_CONV, SSM_XBC), SSM_CONV ** -0.5),
        "ssm_conv_b": nrm(ks[16], (DEPTH, SSM_XBC), 0.02),
        "ssm_dt_bias": dt0 + jnp.log(-jnp.expm1(-dt0)),
        "ssm_a_log": jnp.log(jax.random.uniform(ks[17], (DEPTH, SSM_HEADS), f32, 1.0, 16.0)),
        "ssm_d": 1.0 + 0.1 * jax.random.normal(ks[18], (DEPTH, SSM_HEADS), f32),
        "ssm_norm": gain(ks[19], (DEPTH, SSM_INNER)),
        "w_out": nrm(ks[20], (DEPTH, MIX_WIDTH, D_MODEL), MIX_WIDTH ** -0.5),
        "w_ffn_gate": nrm(ks[21], (DEPTH, D_MODEL, D_FF), D_MODEL ** -0.5),
        "w_ffn_up": nrm(ks[22], (DEPTH, D_MODEL, D_FF), D_MODEL ** -0.5),
        "w_ffn_down": nrm(ks[23], (DEPTH, D_FF, D_MODEL), D_FF ** -0.5),
        "w_ple_proj": nrm(ks[24], (DEPTH, PLE_DIM, D_MODEL), PLE_DIM ** -0.5),
        "w_ple_gate": nrm(ks[25], (DEPTH, D_MODEL, D_MODEL), D_MODEL ** -0.5),
    }


def reference(x, p, pre_mix_norm, post_mix_norm, pre_ffn_norm, post_ffn_norm, w_in,
              kv_norm, idx_k_norm_g, idx_k_norm_b, w_uk, w_uv, rel_bias, short_conv_w,
              ssm_conv_w, ssm_conv_b, ssm_dt_bias, ssm_a_log, ssm_d, ssm_norm, w_out,
              w_ffn_gate, w_ffn_up, w_ffn_down, w_ple_proj, w_ple_gate):
    bsz, s = x.shape[0], x.shape[1]
    offsets = split_offsets()
    for i in range(DEPTH):
        h = rmsnorm(x, pre_mix_norm[i])
        proj = h @ w_in[i]
        q, ckv, iq, ik, iw, b_gate, c_gate, hb, z, xbc, dt_raw = jnp.split(proj, offsets, axis=-1)
        a_out = sparse_indexed_attention(
            q.reshape(bsz, s, A_HEADS, A_QK_DIM),
            rmsnorm(ckv, kv_norm[i]),
            iq.reshape(bsz, s, IDX_HEADS, IDX_DIM),
            layernorm(ik, idx_k_norm_g[i], idx_k_norm_b[i]),
            iw, w_uk[i], w_uv[i], rel_bias)
        b_out = gated_short_conv(hb, b_gate, c_gate, short_conv_w[i])
        c_out = mamba2_mixer(z, xbc, dt_raw, ssm_conv_w[i], ssm_conv_b[i], ssm_dt_bias[i],
                             ssm_a_log[i], ssm_d[i], ssm_norm[i])
        mix = jnp.concatenate([a_out, b_out, c_out], axis=-1) @ w_out[i]
        x = x + rmsnorm(mix, post_mix_norm[i])
        h = rmsnorm(x, pre_ffn_norm[i])
        f = (jax.nn.silu(h @ w_ffn_gate[i]) * (h @ w_ffn_up[i])) @ w_ffn_down[i]
        x = x + rmsnorm(f, post_ffn_norm[i])
        x = x + jax.nn.sigmoid(x @ w_ple_gate[i]) * (p[i] @ w_ple_proj[i])
    return x
```

```cpp
#include <hip/hip_runtime.h>
#include <cstdio>
#include <cstdint>
namespace pg8 {
#define PG8_LAS __attribute__((address_space(3)))
typedef unsigned short bf16_t;
typedef short bf16x8 __attribute__((ext_vector_type(8)));
typedef float f32x4 __attribute__((ext_vector_type(4)));
typedef unsigned u32x4 __attribute__((ext_vector_type(4)));
constexpr int BM = 256, BK = 64, HALF = 128, HTB = HALF * BK * 2  , STAGE_BYTES = 8 * HTB, NXCD = 8, WGM = 8;

__host__ __device__ __forceinline__ int lds_byte(int r, int c) { const int st = (r >> 4) * 2 + (c >> 5), rr = r & 15, cc = c & 31, ob = rr * 64 + cc * 2; return st * 1024 + (ob ^ (((ob >> 9) & 1) << 5)); }
__host__ __device__ __forceinline__ void stage_rc(int b, int& R, int& C) { const int st = b / 1024, sb = b % 1024, swz = sb ^ (((sb >> 9) & 1) << 5); R = (st >> 1) * 16 + swz / 64; C = (st & 1) * 32 + (swz % 64) / 2; }
__host__ __device__ __forceinline__ int perm32(int rho) { const int n = rho >> 4, i = rho & 15; return 8 * (i >> 2) + 4 * n + (i & 3); }

struct Unit { int pm, pn; };
struct Gemm { const bf16_t* A; const bf16_t* Bt; int M, N, K; };

struct StaticOrder {
    int nM, nN, nwg, G, c;
    __host__ __device__ void init(int M, int N, int G_, int c_) { nM = M / BM; nN = N / BM; nwg = nM * nN; G = G_; c = c_; }
    __host__ __device__ bool next(int i, Unit& u) const {
        const long L = (long)i * G + c; if (L >= nwg) return false;
        int wgid = (int)L; { const int q = nwg / NXCD, r = nwg % NXCD, xcd = wgid % NXCD, off = wgid / NXCD; wgid = (xcd < r ? xcd * (q + 1) : r * (q + 1) + (xcd - r) * q) + off; }
        const int nig = WGM * nN, gid = wgid / nig, fm = gid * WGM, gsz = (nM - fm) < WGM ? (nM - fm) : WGM;
        u.pm = fm + ((wgid % nig) % gsz); u.pn = (wgid % nig) / gsz; return true;
    }
    __device__ __forceinline__ void a_ready(const Unit&) const {}
    __device__ __forceinline__ void done(const Unit&) const {}
};

__device__ __forceinline__ unsigned cvt_pk_bf16(float lo, float hi) { unsigned r; asm volatile("v_cvt_pk_bf16_f32 %0, %1, %2" : "=v"(r) : "v"(lo), "v"(hi)); return r; }
typedef float f32x2 __attribute__((ext_vector_type(2)));
__device__ __forceinline__ f32x2 gelu_pk(f32x2 v) {
    const f32x2 av = __builtin_elementwise_abs(v), d = av * 0.2316418882f + 1.0f;
    f32x2 t; t.x = __builtin_amdgcn_rcpf(d.x); t.y = __builtin_amdgcn_rcpf(d.y);
    f32x2 q = t * 0.5307027145f + (-0.7265760135f); q = q * t + 0.7107068705f; q = q * t + (-0.142248368f); q = q * t + 0.127414796f; q = q * t;
    const f32x2 s = (v * v) * (-0.72134752044f);
    f32x2 e; e.x = __builtin_amdgcn_exp2f(s.x); e.y = __builtin_amdgcn_exp2f(s.y);
    const f32x2 m = v * (q * e), r = v - m;
    f32x2 o; o.x = v.x < 0.f ? m.x : r.x; o.y = v.y < 0.f ? m.y : r.y; return o;
}

template <int ACT  > struct EpiBf16 {
    static constexpr bool PERM = true, AFTER_DRAIN = false; static_assert(ACT == 0 || ACT == 1, "EpiBf16: ACT is 0 (none) or 1 (gelu_pk)");
    bf16_t* O; int ldc; const float* bias; int split_cols; size_t split_stride; float scale0;
    __device__ __forceinline__ void operator()(const f32x4 (&acc)[2][2][4][2], const Unit& u, int wr, int wc, int fr, int fq) const {
        const int row0 = u.pm * BM + wr * 64 + fr; int colt = u.pn * BM; bf16_t* base = O;
        float sc = 1.f; if (split_cols) { const int t = colt / split_cols; base += (size_t)t * split_stride; colt -= t * split_cols; if (t == 0) sc = scale0; }
        const int col0 = colt + wc * 32 + 8 * fq, bcol0 = u.pn * BM + wc * 32 + 8 * fq;
        f32x4 bv[2][2];
#pragma unroll
        for (int bj = 0; bj < 2; ++bj)
#pragma unroll
            for (int n = 0; n < 2; ++n) bv[bj][n] = bias ? *(const f32x4*)(bias + bcol0 + bj * HALF + 4 * n) : (f32x4){0.f, 0.f, 0.f, 0.f};
#pragma unroll
        for (int ai = 0; ai < 2; ++ai)
#pragma unroll
            for (int m = 0; m < 4; ++m) { bf16_t* rowp = base + (size_t)(row0 + ai * HALF + m * 16) * ldc + col0;
#pragma unroll
                for (int bj = 0; bj < 2; ++bj) { f32x4 v0 = acc[ai][bj][m][0] + bv[bj][0], v1 = acc[ai][bj][m][1] + bv[bj][1];
                    if (ACT == 1) { f32x2 a = gelu_pk((f32x2){v0[0], v0[1]}), b = gelu_pk((f32x2){v0[2], v0[3]}), c = gelu_pk((f32x2){v1[0], v1[1]}), d = gelu_pk((f32x2){v1[2], v1[3]});
                        v0 = (f32x4){a.x, a.y, b.x, b.y}; v1 = (f32x4){c.x, c.y, d.x, d.y}; }
                    v0 = v0 * sc; v1 = v1 * sc; u32x4 w; w.x = cvt_pk_bf16(v0[0], v0[1]); w.y = cvt_pk_bf16(v0[2], v0[3]); w.z = cvt_pk_bf16(v1[0], v1[1]); w.w = cvt_pk_bf16(v1[2], v1[3]);
                    *(u32x4*)(rowp + bj * HALF) = w; } }
    }
};

struct PanelStats {
    unsigned* xbuf;
    unsigned* cnt;
    unsigned* tmo;
    int ntn; float eps;
    unsigned code;
    __device__ __forceinline__ bool run(const f32x4 (&v)[2][2][4][2], const Unit& u, int wr, int wc, int fr, int fq, PG8_LAS unsigned char* lds, int wid, int lane) const {
        typedef float f32x2v __attribute__((ext_vector_type(2)));
        PG8_LAS f32x2v* P = (PG8_LAS f32x2v*)lds;
        PG8_LAS f32x2v* S = (PG8_LAS f32x2v*)(lds + 8192);
        PG8_LAS unsigned* flag = (PG8_LAS unsigned*)(lds + 8192 + 2048);
#pragma unroll
        for (int ai = 0; ai < 2; ++ai)
#pragma unroll
            for (int m = 0; m < 4; ++m) {
                float s = 0.f;
#pragma unroll
                for (int bj = 0; bj < 2; ++bj)
#pragma unroll
                    for (int n = 0; n < 2; ++n) { const f32x4 x = v[ai][bj][m][n]; s += (x[0] + x[1]) + (x[2] + x[3]); }
                s += __shfl_xor(s, 16); s += __shfl_xor(s, 32);
                const float mw = s * (1.0f / 64.0f); float q = 0.f;
#pragma unroll
                for (int bj = 0; bj < 2; ++bj)
#pragma unroll
                    for (int n = 0; n < 2; ++n) { const f32x4 d = v[ai][bj][m][n] - mw; q += (d[0] * d[0] + d[1] * d[1]) + (d[2] * d[2] + d[3] * d[3]); }
                q += __shfl_xor(q, 16); q += __shfl_xor(q, 32);
                if (fq == 0) P[(ai * HALF + wr * 64 + m * 16 + fr) * 4 + wc] = (f32x2v){mw, q};
            }
        asm volatile("s_waitcnt lgkmcnt(0)" ::: "memory"); __builtin_amdgcn_s_barrier(); asm volatile("" ::: "memory");
#if defined(BROKEN_EXCHANGE_NO_WAIT)
#warning BROKEN CONTROL BUILD: the row-statistics exchange does not wait; results are wrong by design
        if (blockIdx.x >= 64) { const long long t0_ = clock64(); while (clock64() - t0_ < 60000) __builtin_amdgcn_s_sleep(8); }
#endif
        const int row = wid * 32 + (lane & 31);
        if (lane < 32) {
            const f32x2v a = P[row * 4 + 0], b = P[row * 4 + 1], c = P[row * 4 + 2], d = P[row * 4 + 3];
            const float mt = (a.x + b.x + c.x + d.x) * 0.25f;
            const float da = a.x - mt, db = b.x - mt, dc = c.x - mt, dd = d.x - mt;
            const float m2 = (a.y + b.y) + (c.y + d.y) + 64.0f * ((da * da + db * db) + (dc * dc + dd * dd));
            unsigned long long* slot = (unsigned long long*)xbuf + ((size_t)(u.pm * BM + row) * 4 + u.pn);
            __hip_atomic_store(slot, ((unsigned long long)__float_as_uint(m2) << 32) | __float_as_uint(mt), __ATOMIC_RELAXED, __HIP_MEMORY_SCOPE_AGENT);
        }
        asm volatile("s_waitcnt vmcnt(0)" ::: "memory");
        if (lane == 0) __hip_atomic_fetch_add(cnt + 64 * u.pm, 1u, __ATOMIC_RELAXED, __HIP_MEMORY_SCOPE_AGENT);
        if (wid == 0) {
            bool dead = false; const unsigned long long t0 = __builtin_amdgcn_s_memrealtime(); const unsigned want = 8u * (unsigned)ntn;
            for (;;) {
#if defined(BROKEN_EXCHANGE_NO_WAIT)
                break;
#endif
                if ((unsigned)__builtin_amdgcn_readfirstlane(__hip_atomic_load(cnt + 64 * u.pm, __ATOMIC_RELAXED, __HIP_MEMORY_SCOPE_AGENT)) >= want) break;
                if (__builtin_amdgcn_s_memrealtime() - t0 > 2000000ull) {
                    if (lane == 0) { unsigned expect = 0u; __hip_atomic_compare_exchange_strong(tmo + 1, &expect, code | (unsigned)(u.pm & 0xff), __ATOMIC_RELAXED, __ATOMIC_RELAXED, __HIP_MEMORY_SCOPE_AGENT);
                                     __hip_atomic_store(tmo, 1u, __ATOMIC_RELAXED, __HIP_MEMORY_SCOPE_AGENT); }
                    dead = true; break; }
                __builtin_amdgcn_s_sleep(2);
            }
            __builtin_amdgcn_fence(__ATOMIC_ACQUIRE, "agent");
            if (lane == 0) flag[0] = dead ? 1u : 0u;
        }
        asm volatile("s_waitcnt vmcnt(0) lgkmcnt(0)" ::: "memory"); __builtin_amdgcn_s_barrier(); asm volatile("" ::: "memory");
        const bool bad = flag[0] != 0u;
        if (lane < 32) {
            const unsigned long long* slot = (const unsigned long long*)xbuf + (size_t)(u.pm * BM + row) * 4; float mt[4], m2[4]; float ms = 0.f;
#pragma unroll
            for (int t = 0; t < 4; ++t) { if (t < ntn) { const unsigned long long w = __hip_atomic_load(slot + t, __ATOMIC_RELAXED, __HIP_MEMORY_SCOPE_AGENT); mt[t] = __uint_as_float((unsigned)w); m2[t] = __uint_as_float((unsigned)(w >> 32)); } else { mt[t] = 0.f; m2[t] = 0.f; } ms += mt[t]; }
            const float mean = ms / (float)ntn; float q = 0.f;
#pragma unroll
            for (int t = 0; t < 4; ++t) if (t < ntn) { const float dm = mt[t] - mean; q += m2[t] + 256.0f * dm * dm; }
            S[row] = (f32x2v){mean, 1.0f / sqrtf(q / (256.0f * (float)ntn) + eps)};
        }
        asm volatile("s_waitcnt lgkmcnt(0)" ::: "memory"); __builtin_amdgcn_s_barrier(); asm volatile("" ::: "memory");
        return bad;
    }
};
struct EpiLnRes {
    static constexpr bool PERM = false, AFTER_DRAIN = true;
    const float* base; float* out; int ldc; const float* bias; PanelStats st; unsigned poison;
    __device__ __forceinline__ void fused(f32x4 (&acc)[2][2][4][2], const Unit& u, int wr, int wc, int fr, int fq, PG8_LAS unsigned char* lds, int wid, int lane) const {
        typedef float f32x2v __attribute__((ext_vector_type(2)));
        const PG8_LAS f32x2v* S = (const PG8_LAS f32x2v*)(lds + 8192);
        const int col0 = u.pn * BM + wc * 32 + 4 * fq;
#pragma unroll
        for (int bj = 0; bj < 2; ++bj)
#pragma unroll
            for (int n = 0; n < 2; ++n) { const f32x4 bv = bias ? *(const f32x4*)(bias + col0 + bj * HALF + n * 16) : (f32x4){0.f, 0.f, 0.f, 0.f};
#pragma unroll
                for (int ai = 0; ai < 2; ++ai)
#pragma unroll
                    for (int m = 0; m < 4; ++m) acc[ai][bj][m][n] += bv; }
        f32x4 pre[4][2][2];
#pragma unroll
        for (int m = 0; m < 4; ++m) { const size_t off = (size_t)(u.pm * BM + wr * 64 + m * 16 + fr) * ldc + col0;
#pragma unroll
            for (int bj = 0; bj < 2; ++bj)
#pragma unroll
                for (int n = 0; n < 2; ++n) pre[m][bj][n] = *(const f32x4*)(base + off + bj * HALF + n * 16); }
        const bool bad = st.run(acc, u, wr, wc, fr, fq, lds, wid, lane) || poison != 0u;
        const float qnan = __builtin_nanf("");
#pragma unroll
        for (int ai = 0; ai < 2; ++ai)
#pragma unroll
            for (int m = 0; m < 4; ++m) { const int r = ai * HALF + wr * 64 + m * 16 + fr; const f32x2v sr = S[r]; const size_t off = (size_t)(u.pm * BM + r) * ldc + col0;
#pragma unroll
                for (int bj = 0; bj < 2; ++bj)
#pragma unroll
                    for (int n = 0; n < 2; ++n) { const f32x4 bs = ai == 0 ? pre[m][bj][n] : *(const f32x4*)(base + off + bj * HALF + n * 16); f32x4 o = bs + (acc[ai][bj][m][n] - sr.x) * sr.y;
                        if (bad) o = (f32x4){qnan, qnan, qnan, qnan}; *(f32x4*)(out + off + bj * HALF + n * 16) = o; }
                if (m & 1) asm volatile("" ::: "memory"); }
    }
};
struct EpiLnResLn {
    static constexpr bool PERM = false, AFTER_DRAIN = true;
    const float* base; float* out; bf16_t* xn; int ldc; const float* bias; PanelStats st1, st2; unsigned poison;
    __device__ __forceinline__ void fused(f32x4 (&acc)[2][2][4][2], const Unit& u, int wr, int wc, int fr, int fq, PG8_LAS unsigned char* lds, int wid, int lane) const {
        typedef float f32x2v __attribute__((ext_vector_type(2))); typedef unsigned u32x2v __attribute__((ext_vector_type(2)));
        const PG8_LAS f32x2v* S = (const PG8_LAS f32x2v*)(lds + 8192);
        const int col0 = u.pn * BM + wc * 32 + 4 * fq;
#pragma unroll
        for (int bj = 0; bj < 2; ++bj)
#pragma unroll
            for (int n = 0; n < 2; ++n) { const f32x4 bv = bias ? *(const f32x4*)(bias + col0 + bj * HALF + n * 16) : (f32x4){0.f, 0.f, 0.f, 0.f};
#pragma unroll
                for (int ai = 0; ai < 2; ++ai)
#pragma unroll
                    for (int m = 0; m < 4; ++m) acc[ai][bj][m][n] += bv; }
        bool bad = st1.run(acc, u, wr, wc, fr, fq, lds, wid, lane) || poison != 0u;
        const float qnan = __builtin_nanf("");
#pragma unroll
        for (int ai = 0; ai < 2; ++ai)
#pragma unroll
            for (int m = 0; m < 4; ++m) { const int r = ai * HALF + wr * 64 + m * 16 + fr; const f32x2v sr = S[r]; const size_t off = (size_t)(u.pm * BM + r) * ldc + col0;
#pragma unroll
                for (int bj = 0; bj < 2; ++bj)
#pragma unroll
                    for (int n = 0; n < 2; ++n) { const f32x4 bs = *(const f32x4*)(base + off + bj * HALF + n * 16); acc[ai][bj][m][n] = bs + (acc[ai][bj][m][n] - sr.x) * sr.y; }
                asm volatile("" : "+v"(acc[ai][0][m][0]), "+v"(acc[ai][0][m][1]), "+v"(acc[ai][1][m][0]), "+v"(acc[ai][1][m][1]));
                if (m & 1) asm volatile("" ::: "memory"); }
        const bool bad1 = bad;
        bad = st2.run(acc, u, wr, wc, fr, fq, lds, wid, lane) || bad;
#pragma unroll
        for (int ai = 0; ai < 2; ++ai)
#pragma unroll
            for (int m = 0; m < 4; ++m) { const int r = ai * HALF + wr * 64 + m * 16 + fr; const f32x2v sr = S[r]; const size_t off = (size_t)(u.pm * BM + r) * ldc + col0;
#pragma unroll
                for (int bj = 0; bj < 2; ++bj)
#pragma unroll
                    for (int n = 0; n < 2; ++n) { const f32x4 x1 = acc[ai][bj][m][n]; *(f32x4*)(out + off + bj * HALF + n * 16) = bad1 ? (f32x4){qnan, qnan, qnan, qnan} : x1;
                        const f32x4 o = (x1 - sr.x) * sr.y; u32x2v w; w.x = cvt_pk_bf16(o[0], o[1]); w.y = cvt_pk_bf16(o[2], o[3]);
                        if (bad) { w.x = 0x7fc07fc0u; w.y = 0x7fc07fc0u; } *(u32x2v*)(xn + off + bj * HALF + n * 16) = w; }
                asm volatile("" ::: "memory"); }
    }
};

template <class Epi, class Sched, bool ALIGN_EPI = false, bool SP2 = false>
__device__ __forceinline__ void gemm_phase(PG8_LAS unsigned char* lds, const Gemm g, const Sched& S, const Epi& E) {
    const int tid = threadIdx.x, wid = __builtin_amdgcn_readfirstlane(tid >> 6), lane = tid & 63, wr = wid >> 2, wc = wid & 3, fr = lane & 15, fq = lane >> 4;
    const int K = g.K, nt = K / BK;
    unsigned voffA[2], voffB[2];
#pragma unroll
    for (int i = 0; i < 2; ++i) { int R, C; stage_rc(tid * 16 + i * 8192, R, C); const int Rb = Epi::PERM ? ((R & ~31) + perm32(R & 31)) : R;
        voffA[i] = (unsigned)(R * K + C) * 2u; voffB[i] = (unsigned)(Rb * K + C) * 2u; }
    const size_t kstep = (size_t)(BK * 2);
    const size_t hstep = (size_t)HALF * K * 2;
    const size_t tstep = 2 * hstep;
    const unsigned ldsw = (unsigned)wid * 1024u;
    const int aoff = lds_byte(wr * 64 + fr, fq * 8), boff = lds_byte(wc * 32 + fr, fq * 8);
#define PG8_SA(b, h) (((b) * 2 + (h)) * HTB)
#define PG8_SB(b, h) ((4 + (b) * 2 + (h)) * HTB)
#define PG8_STAGE(bufoff, gbase, voff) do { _Pragma("unroll") for (int _i = 0; _i < 2; ++_i) \
        __builtin_amdgcn_global_load_lds((const unsigned*)((const char*)(gbase) + (voff)[_i]), (PG8_LAS unsigned*)(lds + (bufoff) + ldsw + _i * 8192), 16, 0, 0); } while (0)
#define PG8_LDA(dst, b, h) do { _Pragma("unroll") for (int m = 0; m < 4; ++m) _Pragma("unroll") for (int k = 0; k < 2; ++k) dst[m][k] = *(const PG8_LAS bf16x8*)(lds + PG8_SA(b, h) + aoff + m * 2048 + k * 1024); } while (0)
#define PG8_LDB(dst, b, h) do { _Pragma("unroll") for (int n = 0; n < 2; ++n) _Pragma("unroll") for (int k = 0; k < 2; ++k) dst[n][k] = *(const PG8_LAS bf16x8*)(lds + PG8_SB(b, h) + boff + n * 2048 + k * 1024); } while (0)
#define PG8_MMA(ai, bj, At, Bt) do { __builtin_amdgcn_s_setprio(1); _Pragma("unroll") for (int m = 0; m < 4; ++m) _Pragma("unroll") for (int n = 0; n < 2; ++n) _Pragma("unroll") for (int k = 0; k < 2; ++k) \
        acc[ai][bj][m][n] = __builtin_amdgcn_mfma_f32_16x16x32_bf16(Bt[n][k], At[m][k], acc[ai][bj][m][n], 0, 0, 0); __builtin_amdgcn_s_setprio(0); } while (0)
#define PG8_WAIT_V(n) asm volatile("s_waitcnt vmcnt(" #n ")" ::: "memory")
#define PG8_WAIT_L(n) asm volatile("s_waitcnt lgkmcnt(" #n ")" ::: "memory")
#define PG8_BAR __builtin_amdgcn_s_barrier()
#define PG8_SCHED __builtin_amdgcn_sched_barrier(0)
    Unit cur, nxt; int ui = 0;
    if (!S.next(0, cur)) return;
    f32x4 acc[2][2][4][2];
#pragma unroll
    for (int a = 0; a < 2; ++a)
#pragma unroll
        for (int b = 0; b < 2; ++b)
#pragma unroll
            for (int m = 0; m < 4; ++m)
#pragma unroll
                for (int n = 0; n < 2; ++n) acc[a][b][m][n] = (f32x4){0.f, 0.f, 0.f, 0.f};
    bf16x8 At[4][2], B0[2][2], B1[2][2];
    const char* cA = (const char*)g.A + (size_t)cur.pm * tstep; const char* cB = (const char*)g.Bt + (size_t)cur.pn * tstep;
    S.a_ready(cur);
    if constexpr (SP2) {
        PG8_STAGE(PG8_SB(0, 0), cB, voffB); PG8_STAGE(PG8_SB(0, 1), cB + hstep, voffB); PG8_STAGE(PG8_SA(0, 0), cA, voffA); PG8_STAGE(PG8_SA(0, 1), cA + hstep, voffA);
        if (wr == 1) PG8_BAR;
        PG8_WAIT_V(2); PG8_BAR;
        PG8_STAGE(PG8_SB(1, 0), cB + kstep, voffB); PG8_STAGE(PG8_SA(1, 0), cA + kstep, voffA); PG8_STAGE(PG8_SB(1, 1), cB + hstep + kstep, voffB);
        PG8_WAIT_V(6); PG8_BAR;
    } else {
        PG8_STAGE(PG8_SB(0, 0), cB, voffB); PG8_STAGE(PG8_SA(0, 0), cA, voffA); PG8_STAGE(PG8_SB(0, 1), cB + hstep, voffB); PG8_STAGE(PG8_SA(0, 1), cA + hstep, voffA);
        if (wr == 1) PG8_BAR;
        PG8_WAIT_V(4); PG8_BAR;
        PG8_STAGE(PG8_SB(1, 0), cB + kstep, voffB); PG8_STAGE(PG8_SA(1, 0), cA + kstep, voffA); PG8_STAGE(PG8_SB(1, 1), cB + hstep + kstep, voffB);
        PG8_WAIT_V(6); PG8_BAR;
    }
    for (;;) {
        const bool has_next = S.next(ui + 1, nxt);
        const char* nA = has_next ? (const char*)g.A + (size_t)nxt.pm * tstep : cA; const char* nB = has_next ? (const char*)g.Bt + (size_t)nxt.pn * tstep : cB;
        for (int t = 0; t < nt; t += 2) {
            const bool last = (t == nt - 2);
            const char* a1 = cA + (size_t)(t + 1) * kstep;
            const char* a2 = last ? nA : cA + (size_t)(t + 2) * kstep; const char* b2 = last ? nB : cB + (size_t)(t + 2) * kstep;
            const char* a3 = a2 + kstep; const char* b3 = b2 + kstep;
            if (last && has_next) S.a_ready(nxt);
            if constexpr (SP2) {
            PG8_LDB(B0, 0, 0); PG8_LDB(B1, 0, 1); PG8_SCHED; PG8_LDA(At, 0, 0); PG8_STAGE(PG8_SA(1, 1), a1 + hstep, voffA);
            PG8_WAIT_V(8); PG8_WAIT_L(0); PG8_BAR; PG8_MMA(0, 0, At, B0); PG8_MMA(0, 1, At, B1); PG8_BAR; PG8_SCHED;
            PG8_LDA(At, 0, 1); PG8_STAGE(PG8_SB(0, 0), b2, voffB); PG8_STAGE(PG8_SB(0, 1), b2 + hstep, voffB); PG8_STAGE(PG8_SA(0, 0), a2, voffA);
            PG8_WAIT_V(8); PG8_WAIT_L(0); PG8_BAR; PG8_MMA(1, 0, At, B0); PG8_MMA(1, 1, At, B1); PG8_BAR; PG8_SCHED;
            PG8_LDB(B0, 1, 0); PG8_LDB(B1, 1, 1); PG8_SCHED; PG8_LDA(At, 1, 0); PG8_STAGE(PG8_SA(0, 1), a2 + hstep, voffA);
            PG8_WAIT_V(8); PG8_WAIT_L(0); PG8_BAR; PG8_MMA(0, 0, At, B0); PG8_MMA(0, 1, At, B1); PG8_BAR; PG8_SCHED;
            PG8_LDA(At, 1, 1); PG8_STAGE(PG8_SB(1, 0), b3, voffB); PG8_STAGE(PG8_SB(1, 1), b3 + hstep, voffB); PG8_STAGE(PG8_SA(1, 0), a3, voffA);
            PG8_WAIT_V(8); PG8_WAIT_L(0); PG8_BAR; PG8_MMA(1, 0, At, B0); PG8_MMA(1, 1, At, B1); PG8_BAR; PG8_SCHED;
            } else {
            PG8_LDB(B0, 0, 0); PG8_SCHED; PG8_LDA(At, 0, 0); PG8_STAGE(PG8_SA(1, 1), a1 + hstep, voffA);
            PG8_WAIT_L(8); PG8_BAR; PG8_WAIT_L(0); PG8_MMA(0, 0, At, B0); PG8_BAR; PG8_SCHED;
            PG8_LDB(B1, 0, 1); PG8_STAGE(PG8_SB(0, 0), b2, voffB);
            PG8_BAR; PG8_WAIT_L(0); PG8_MMA(0, 1, At, B1); PG8_BAR;
            PG8_LDA(At, 0, 1); PG8_STAGE(PG8_SA(0, 0), a2, voffA);
            PG8_BAR; PG8_WAIT_L(0); PG8_MMA(1, 0, At, B0); PG8_BAR; PG8_SCHED;
            PG8_STAGE(PG8_SB(0, 1), b2 + hstep, voffB);
            PG8_WAIT_V(6); PG8_BAR; PG8_MMA(1, 1, At, B1); PG8_BAR;
            PG8_LDB(B0, 1, 0); PG8_SCHED; PG8_LDA(At, 1, 0); PG8_STAGE(PG8_SA(0, 1), a2 + hstep, voffA);
            PG8_WAIT_L(8); PG8_BAR; PG8_WAIT_L(0); PG8_MMA(0, 0, At, B0); PG8_BAR; PG8_SCHED;
            PG8_LDB(B1, 1, 1); PG8_STAGE(PG8_SB(1, 0), b3, voffB);
            PG8_BAR; PG8_WAIT_L(0); PG8_MMA(0, 1, At, B1); PG8_BAR;
            PG8_LDA(At, 1, 1); PG8_STAGE(PG8_SA(1, 0), a3, voffA);
            PG8_BAR; PG8_WAIT_L(0); PG8_MMA(1, 0, At, B0); PG8_BAR; PG8_SCHED;
            PG8_STAGE(PG8_SB(1, 1), b3 + hstep, voffB);
            PG8_WAIT_V(6); PG8_BAR; PG8_MMA(1, 1, At, B1); PG8_BAR;
            }
        }
        if constexpr (ALIGN_EPI) { if (wr == 0) PG8_BAR; }
        if constexpr (!Epi::AFTER_DRAIN) { E(acc, cur, wr, wc, fr, fq); S.done(cur); }
        if (!has_next) break;
#pragma unroll
        for (int a = 0; a < 2; ++a)
#pragma unroll
            for (int b = 0; b < 2; ++b)
#pragma unroll
                for (int m = 0; m < 4; ++m)
#pragma unroll
                    for (int n = 0; n < 2; ++n) acc[a][b][m][n] = (f32x4){0.f, 0.f, 0.f, 0.f};
        cur = nxt; cA = nA; cB = nB; ++ui;
        if constexpr (ALIGN_EPI) { if (wr == 1) PG8_BAR; }
    }
    PG8_WAIT_V(0);
    if constexpr (!ALIGN_EPI) { if (wr == 0) PG8_BAR; }
    PG8_BAR;
    if constexpr (Epi::AFTER_DRAIN) { E.fused(acc, cur, wr, wc, fr, fq, lds, wid, lane); S.done(cur); }
#undef PG8_SA
#undef PG8_SB
#undef PG8_STAGE
#undef PG8_LDA
#undef PG8_LDB
#undef PG8_MMA
#undef PG8_WAIT_V
#undef PG8_WAIT_L
#undef PG8_BAR
#undef PG8_SCHED
}
}

typedef unsigned short bf16;
typedef float f32x4 __attribute__((ext_vector_type(4)));
typedef unsigned u32x4 __attribute__((ext_vector_type(4)));
typedef unsigned u32x2 __attribute__((ext_vector_type(2)));

constexpr int BATCH = 8, SEQ = 4096, T = BATCH * SEQ, D = 1024, DEPTH = 2;
constexpr int NA = 2048, NB = 3328, NIN = NA + NB, INW = 5204;
constexpr int DFF = 2816, NGU = 2 * DFF, PLE = 256, MIXW = 2048;
constexpr int A_Q = 0, A_BG = 512, A_Z = 1024;
constexpr int B_CKV = 0, B_IQ = 256, B_CG = 512, B_HB = 1024, B_XBC = 1536, B_IK = 3072, B_DT = 3136, B_IW = 3152;
constexpr int XBC = 1536, KV_R = 256, TOPK = 256;
constexpr float EPS = 1e-6f;

constexpr size_t MiB = 1u << 20;
constexpr size_t WS_CTL = 0;
constexpr size_t WS_RSTD = 1 * MiB;
constexpr size_t WS_RSTD2 = 1 * MiB + 256 * 1024;
constexpr size_t WS_DT = 2 * MiB;
constexpr size_t WS_SSQ = 4 * MiB;
constexpr size_t WS_W = 8 * MiB;
constexpr size_t WS_W_IN = WS_W, WS_W_OUT = WS_W_IN + (size_t)NIN * D * 2, WS_W_GU = WS_W_OUT + (size_t)D * MIXW * 2, WS_W_DOWN = WS_W_GU + (size_t)NGU * D * 2,
                 WS_W_PG = WS_W_DOWN + (size_t)D * DFF * 2, WS_W_PP = WS_W_PG + (size_t)D * D * 2, WS_W_END = WS_W_PP + (size_t)D * PLE * 2;
static_assert(WS_W_END <= 44 * MiB, "weights");
constexpr size_t WS_X0 = 44 * MiB, WS_X1 = 108 * MiB, WS_RA = 172 * MiB, WS_RB = 300 * MiB, WS_END = 508 * MiB;
constexpr size_t WS_XA = WS_X0;
constexpr size_t WS_IDX = WS_X1 + 48 * MiB;

__host__ __device__ __forceinline__ float bf2f(bf16 b) { return __builtin_bit_cast(float, ((unsigned)b) << 16); }
__host__ __device__ __forceinline__ bf16 f2bf(float f) { unsigned u = __builtin_bit_cast(unsigned, f); return (bf16)((u + 0x7fffu + ((u >> 16) & 1u)) >> 16); }
__device__ __forceinline__ unsigned pk2(float lo, float hi) { return (unsigned)f2bf(lo) | ((unsigned)f2bf(hi) << 16); }
__device__ __forceinline__ float wave_sum(float v) {
#pragma unroll
    for (int o = 1; o < 64; o <<= 1) v += __shfl_xor(v, o);
    return v;
}
__device__ __forceinline__ float wave_max(float v) {
#pragma unroll
    for (int o = 1; o < 64; o <<= 1) v = fmaxf(v, __shfl_xor(v, o));
    return v;
}
__device__ __forceinline__ float sigmoidf_(float v) { return __builtin_amdgcn_rcpf(1.0f + __expf(-v)); }
__device__ __forceinline__ float siluf_(float v) { return v * sigmoidf_(v); }

__host__ __device__ __forceinline__ int src_col_in(int n) {
    if (n < 512) return n;
    if (n < 1024) return 1092 + (n - 512);
    if (n < 2048) return 2628 + (n - 1024);
    n -= 2048;
    if (n < 256) return 512 + n;
    if (n < 512) return 768 + (n - 256);
    if (n < 1024) return 1604 + (n - 512);
    if (n < 1536) return 2116 + (n - 1024);
    if (n < 3072) return 3652 + (n - 1536);
    if (n < 3136) return 1024 + (n - 3072);
    if (n < 3152) return 5188 + (n - 3136);
    if (n < 3156) return 1088 + (n - 3152);
    return -1;
}

__host__ __device__ __forceinline__ int t5_bucket(int rel) {
    const int ret = rel > 0 ? 16 : 0; const int n = rel < 0 ? -rel : rel;
    int b;
    if (n < 8) b = n; else if (n < 15) b = 8; else if (n < 27) b = 9; else if (n < 50) b = 10; else if (n < 91) b = 11; else if (n < 166) b = 12; else if (n < 305) b = 13; else if (n < 559) b = 14; else b = 15;
    return ret + b;
}

template <int MODE> __global__ void __launch_bounds__(256) k_prep_w(const float* __restrict__ W, const float* __restrict__ W2, int K, int Nsrc, const float* __restrict__ gain, bf16* __restrict__ Wt) {
    __shared__ float tile[32][33];
    const int n0 = blockIdx.x * 32, k0 = blockIdx.y * 32, tx = threadIdx.x & 31, ty = threadIdx.x >> 5;
    const int n = n0 + tx; int src; const float* Ws = W;
    if (MODE == 0) src = n; else if (MODE == 1) src = src_col_in(n); else { const int which = (n & 255) >> 7; src = (n >> 8) * 128 + (n & 127); Ws = which ? W2 : W; }
    for (int kk = ty; kk < 32; kk += 8) { float v = 0.f; if (src >= 0) { v = Ws[(size_t)(k0 + kk) * Nsrc + src]; if (gain) v *= gain[k0 + kk]; } tile[kk][tx] = v; }
    __syncthreads();
    for (int nn = ty; nn < 32; nn += 8) Wt[(size_t)(n0 + nn) * K + k0 + tx] = f2bf(tile[tx][nn]);
}

__global__ void __launch_bounds__(256) k_x_prep(const float* __restrict__ x, bf16* __restrict__ xb, float* __restrict__ rstd) {
    const int lane = threadIdx.x & 63, row = blockIdx.x * 4 + (threadIdx.x >> 6);
    const f32x4* xr = (const f32x4*)(x + (size_t)row * D) + lane; float ss = 0.f; f32x4 v[4];
#pragma unroll
    for (int j = 0; j < 4; ++j) { v[j] = xr[64 * j]; ss += (v[j].x * v[j].x + v[j].y * v[j].y) + (v[j].z * v[j].z + v[j].w * v[j].w); }
    ss = wave_sum(ss);
    u32x2* o = (u32x2*)(xb + (size_t)row * D) + lane;
#pragma unroll
    for (int j = 0; j < 4; ++j) { u32x2 w; w.x = pk2(v[j].x, v[j].y); w.y = pk2(v[j].z, v[j].w); o[64 * j] = w; }
    if (lane == 0) rstd[row] = 1.0f / sqrtf(ss * (1.0f / D) + EPS);
}
__global__ void __launch_bounds__(256) k_rstd(const float* __restrict__ x, float* __restrict__ rstd) {
    const int lane = threadIdx.x & 63, row = blockIdx.x * 4 + (threadIdx.x >> 6);
    const f32x4* xr = (const f32x4*)(x + (size_t)row * D) + lane; float ss = 0.f;
#pragma unroll
    for (int j = 0; j < 4; ++j) { const f32x4 v = xr[64 * j]; ss += (v.x * v.x + v.y * v.y) + (v.z * v.z + v.w * v.w); }
    ss = wave_sum(ss);
    if (lane == 0) rstd[row] = 1.0f / sqrtf(ss * (1.0f / D) + EPS);
}
__global__ void __launch_bounds__(256) k_resid_norm(const float* xin, const float* __restrict__ y, const float* __restrict__ g, float* xo, bf16* __restrict__ xb,
                                                    float* __restrict__ rstd_out, const float* __restrict__ p, bf16* __restrict__ pb) {
    const int lane = threadIdx.x & 63, row = blockIdx.x * 4 + (threadIdx.x >> 6);
    const f32x4* yr = (const f32x4*)(y + (size_t)row * D) + lane; const f32x4* xr = (const f32x4*)(xin + (size_t)row * D) + lane; const f32x4* gr = (const f32x4*)g + lane;
    f32x4 v[4]; float ss = 0.f;
#pragma unroll
    for (int j = 0; j < 4; ++j) { v[j] = yr[64 * j]; ss += (v[j].x * v[j].x + v[j].y * v[j].y) + (v[j].z * v[j].z + v[j].w * v[j].w); }
    const float r = 1.0f / sqrtf(wave_sum(ss) * (1.0f / D) + EPS);
    float s2 = 0.f;
    f32x4* xor_ = (f32x4*)(xo + (size_t)row * D) + lane; u32x2* o = (u32x2*)(xb + (size_t)row * D) + lane;
#pragma unroll
    for (int j = 0; j < 4; ++j) { const f32x4 xx = xr[64 * j], gg = gr[64 * j]; f32x4 w = xx + v[j] * r * gg; xor_[64 * j] = w; s2 += (w.x * w.x + w.y * w.y) + (w.z * w.z + w.w * w.w);
        u32x2 q; q.x = pk2(w.x, w.y); q.y = pk2(w.z, w.w); o[64 * j] = q; }
    if (rstd_out) { s2 = wave_sum(s2); if (lane == 0) rstd_out[row] = 1.0f / sqrtf(s2 * (1.0f / D) + EPS); }
    if (p) { const f32x4 pv = *((const f32x4*)(p + (size_t)row * PLE) + lane); u32x2 q; q.x = pk2(pv.x, pv.y); q.y = pk2(pv.z, pv.w); *((u32x2*)(pb + (size_t)row * PLE) + lane) = q; }
}

namespace pg8 {
struct EpiProj {
    static constexpr bool PERM = true, AFTER_DRAIN = false;
    bf16_t* RA; bf16_t* RB; const float* rstd;
    __device__ __forceinline__ void operator()(const f32x4 (&acc)[2][2][4][2], const Unit& u, int wr, int wc, int fr, int fq) const {
        const int row0 = u.pm * BM + wr * 64 + fr; bf16_t* base; int ld, colt;
        if (u.pn < NA / 256) { base = RA; ld = NA; colt = u.pn * BM; } else { base = RB; ld = NB; colt = (u.pn - NA / 256) * BM; }
        const int col0 = colt + wc * 32 + 8 * fq;
#pragma unroll
        for (int ai = 0; ai < 2; ++ai)
#pragma unroll
            for (int m = 0; m < 4; ++m) { const int r = row0 + ai * HALF + m * 16; const float s = rstd[r]; bf16_t* rowp = base + (size_t)r * ld + col0;
#pragma unroll
                for (int bj = 0; bj < 2; ++bj) { const f32x4 v0 = acc[ai][bj][m][0] * s, v1 = acc[ai][bj][m][1] * s;
                    u32x4 w; w.x = cvt_pk_bf16(v0[0], v0[1]); w.y = cvt_pk_bf16(v0[2], v0[3]); w.z = cvt_pk_bf16(v1[0], v1[1]); w.w = cvt_pk_bf16(v1[2], v1[3]);
                    *(u32x4*)(rowp + bj * HALF) = w; } }
    }
};
struct EpiF32 {
    static constexpr bool PERM = false, AFTER_DRAIN = false;
    float* C; long ldc;
    __device__ __forceinline__ void operator()(const f32x4 (&acc)[2][2][4][2], const Unit& u, int wr, int wc, int fr, int fq) const {
        const int row0 = u.pm * BM + wr * 64 + fr, col0 = u.pn * BM + wc * 32 + 4 * fq;
#pragma unroll
        for (int ai = 0; ai < 2; ++ai)
#pragma unroll
            for (int m = 0; m < 4; ++m) { float* rowp = C + (size_t)(row0 + ai * HALF + m * 16) * ldc + col0;
#pragma unroll
                for (int bj = 0; bj < 2; ++bj)
#pragma unroll
                    for (int n = 0; n < 2; ++n) *(f32x4*)(rowp + bj * HALF + n * 16) = acc[ai][bj][m][n]; }
    }
};
struct EpiBf16P {
    static constexpr bool PERM = true, AFTER_DRAIN = false;
    bf16_t* O; long ldc;
    __device__ __forceinline__ void operator()(const f32x4 (&acc)[2][2][4][2], const Unit& u, int wr, int wc, int fr, int fq) const {
        const int row0 = u.pm * BM + wr * 64 + fr, col0 = u.pn * BM + wc * 32 + 8 * fq;
#pragma unroll
        for (int ai = 0; ai < 2; ++ai)
#pragma unroll
            for (int m = 0; m < 4; ++m) { bf16_t* rowp = O + (size_t)(row0 + ai * HALF + m * 16) * ldc + col0;
#pragma unroll
                for (int bj = 0; bj < 2; ++bj) { const f32x4 v0 = acc[ai][bj][m][0], v1 = acc[ai][bj][m][1];
                    u32x4 w; w.x = cvt_pk_bf16(v0[0], v0[1]); w.y = cvt_pk_bf16(v0[2], v0[3]); w.z = cvt_pk_bf16(v1[0], v1[1]); w.w = cvt_pk_bf16(v1[2], v1[3]);
                    *(u32x4*)(rowp + bj * HALF) = w; } }
    }
};
struct EpiSwiGLU {
    static constexpr bool PERM = true, AFTER_DRAIN = false;
    bf16_t* G; const float* rstd;
    __device__ __forceinline__ void operator()(const f32x4 (&acc)[2][2][4][2], const Unit& u, int wr, int wc, int fr, int fq) const {
        const int row0 = u.pm * BM + wr * 64 + fr, col0 = u.pn * HALF + wc * 32 + 8 * fq;
#pragma unroll
        for (int ai = 0; ai < 2; ++ai)
#pragma unroll
            for (int m = 0; m < 4; ++m) { const int r = row0 + ai * HALF + m * 16; const float s = rstd[r]; float o[8];
#pragma unroll
                for (int n = 0; n < 2; ++n)
#pragma unroll
                    for (int j = 0; j < 4; ++j) { const float gt = acc[ai][0][m][n][j] * s, up = acc[ai][1][m][n][j] * s; o[n * 4 + j] = gt * __builtin_amdgcn_rcpf(1.0f + __expf(-gt)) * up; }
                u32x4 w; w.x = cvt_pk_bf16(o[0], o[1]); w.y = cvt_pk_bf16(o[2], o[3]); w.z = cvt_pk_bf16(o[4], o[5]); w.w = cvt_pk_bf16(o[6], o[7]);
                *(u32x4*)(G + (size_t)r * DFF + col0) = w; }
    }
};
struct EpiPle {
    static constexpr bool PERM = true, AFTER_DRAIN = false;
    float* X; const bf16_t* Tt; bf16_t* XB;
    __device__ __forceinline__ void operator()(const f32x4 (&acc)[2][2][4][2], const Unit& u, int wr, int wc, int fr, int fq) const {
        const int row0 = u.pm * BM + wr * 64 + fr, col0 = u.pn * BM + wc * 32 + 8 * fq;
#pragma unroll
        for (int ai = 0; ai < 2; ++ai)
#pragma unroll
            for (int m = 0; m < 4; ++m) { const size_t off = (size_t)(row0 + ai * HALF + m * 16) * D + col0;
#pragma unroll
                for (int bj = 0; bj < 2; ++bj) { const u32x4 tv = *(const u32x4*)(Tt + off + bj * HALF); f32x4 x0 = *(const f32x4*)(X + off + bj * HALF), x1 = *(const f32x4*)(X + off + bj * HALF + 4);
                    const unsigned tw[4] = {tv.x, tv.y, tv.z, tv.w};
#pragma unroll
                    for (int j = 0; j < 4; ++j) { const float t0 = __builtin_bit_cast(float, (j & 1) ? (tw[j >> 1] & 0xffff0000u) : (tw[j >> 1] << 16));
                        const float t1 = __builtin_bit_cast(float, (j & 1) ? (tw[2 + (j >> 1)] & 0xffff0000u) : (tw[2 + (j >> 1)] << 16));
                        x0[j] += __builtin_amdgcn_rcpf(1.0f + __expf(-acc[ai][bj][m][0][j])) * t0; x1[j] += __builtin_amdgcn_rcpf(1.0f + __expf(-acc[ai][bj][m][1][j])) * t1; }
                    *(f32x4*)(X + off + bj * HALF) = x0; *(f32x4*)(X + off + bj * HALF + 4) = x1;
                    u32x4 w; w.x = cvt_pk_bf16(x0[0], x0[1]); w.y = cvt_pk_bf16(x0[2], x0[3]); w.z = cvt_pk_bf16(x1[0], x1[1]); w.w = cvt_pk_bf16(x1[2], x1[3]);
                    *(u32x4*)(XB + off + bj * HALF) = w; } }
    }
};
}

constexpr int GEMM_LDS = 131072;
template <class Epi> __global__ void __launch_bounds__(512, 2) k_gemm(const bf16* A, const bf16* Bt, int M, int N, int K, Epi E) {
    extern __shared__ __attribute__((aligned(16))) unsigned char shm[];
    pg8::Gemm g{A, Bt, M, N, K};
    pg8::StaticOrder S; S.init(g.M, g.N, (int)gridDim.x, (int)blockIdx.x);
    pg8::gemm_phase<Epi, pg8::StaticOrder, true, true>((PG8_LAS unsigned char*)shm, g, S, E);
}

__global__ void __launch_bounds__(256) k_m1_prep(bf16* __restrict__ RA, bf16* __restrict__ RB, const float* __restrict__ kvn, const float* __restrict__ ikg, const float* __restrict__ ikb, const float* __restrict__ scw) {
    const int lane = threadIdx.x & 63, t = blockIdx.x * 4 + (threadIdx.x >> 6), s = t & (SEQ - 1);
    bf16* rb = RB + (size_t)t * NB;
    {
        const u32x2 w = *((const u32x2*)(rb + B_CKV) + lane); float v[4] = {bf2f((bf16)(w.x & 0xffff)), bf2f((bf16)(w.x >> 16)), bf2f((bf16)(w.y & 0xffff)), bf2f((bf16)(w.y >> 16))};
        float ss = (v[0] * v[0] + v[1] * v[1]) + (v[2] * v[2] + v[3] * v[3]); ss = wave_sum(ss); const float r = 1.0f / sqrtf(ss * (1.0f / KV_R) + EPS);
        const f32x4 g = *((const f32x4*)kvn + lane); u32x2 o; o.x = pk2(v[0] * r * g.x, v[1] * r * g.y); o.y = pk2(v[2] * r * g.z, v[3] * r * g.w); *((u32x2*)(rb + B_CKV) + lane) = o;
    }
    {
        const float x = bf2f(rb[B_IK + lane]); const float mu = wave_sum(x) * (1.0f / 64.0f); const float d = x - mu; const float var = wave_sum(d * d) * (1.0f / 64.0f);
        rb[B_IK + lane] = f2bf(d * (1.0f / sqrtf(var + EPS)) * ikg[lane] + ikb[lane]);
    }
    {
        const int c = lane * 8; float acc[8] = {0.f, 0.f, 0.f, 0.f, 0.f, 0.f, 0.f, 0.f};
        for (int j = 0; j < 3; ++j) { const int ss_ = s - 2 + j; if (ss_ < 0) continue; const bf16* rr = RB + (size_t)(t - 2 + j) * NB;
            const u32x4 cg = *(const u32x4*)(rr + B_CG + c), hb = *(const u32x4*)(rr + B_HB + c); const unsigned cw[4] = {cg.x, cg.y, cg.z, cg.w}, hw[4] = {hb.x, hb.y, hb.z, hb.w};
#pragma unroll
            for (int e = 0; e < 8; ++e) { const float a = bf2f((bf16)((cw[e >> 1] >> ((e & 1) * 16)) & 0xffff)), b = bf2f((bf16)((hw[e >> 1] >> ((e & 1) * 16)) & 0xffff)); acc[e] += scw[j * 512 + c + e] * (a * b); } }
        bf16* ra = RA + (size_t)t * NA + A_BG + c; const u32x4 bg = *(const u32x4*)ra; const unsigned bw[4] = {bg.x, bg.y, bg.z, bg.w}; float o[8];
#pragma unroll
        for (int e = 0; e < 8; ++e) o[e] = bf2f((bf16)((bw[e >> 1] >> ((e & 1) * 16)) & 0xffff)) * acc[e];
        u32x4 w; w.x = pk2(o[0], o[1]); w.y = pk2(o[2], o[3]); w.z = pk2(o[4], o[5]); w.w = pk2(o[6], o[7]); *(u32x4*)ra = w;
    }
}

__device__ __forceinline__ unsigned ord_key(float f) { const unsigned u = __builtin_bit_cast(unsigned, f); return (u & 0x80000000u) ? ~u : (u | 0x80000000u); }

__global__ void __launch_bounds__(256) k_m2_select(const bf16* __restrict__ RB, unsigned short* __restrict__ idx) {
    __shared__ float iq[256]; __shared__ float iwv[4]; __shared__ unsigned keys[SEQ]; __shared__ unsigned red[8];
    const int t = blockIdx.x, s = t & (SEQ - 1), b = t >> 12, tid = threadIdx.x, lane = tid & 63, wv = tid >> 6;
    const int nk = ((s >> 6) + 1) << 6;
    const bf16* rb = RB + (size_t)t * NB;
    iq[tid] = bf2f(rb[B_IQ + tid]); if (tid < 4) iwv[tid] = bf2f(rb[B_IW + tid]) * (0.125f * 0.5f);
    __syncthreads();
    for (int k = tid; k < nk; k += 256) {
        const bf16* kr = RB + (size_t)(b * SEQ + k) * NB + B_IK; float kv[64];
#pragma unroll
        for (int j = 0; j < 8; ++j) { const u32x4 w = *((const u32x4*)kr + j); const unsigned ww[4] = {w.x, w.y, w.z, w.w};
#pragma unroll
            for (int e = 0; e < 8; ++e) kv[j * 8 + e] = bf2f((bf16)((ww[e >> 1] >> ((e & 1) * 16)) & 0xffff)); }
        float sc = 0.f;
#pragma unroll
        for (int h = 0; h < 4; ++h) { float d = 0.f;
#pragma unroll
            for (int j = 0; j < 64; ++j) d += iq[h * 64 + j] * kv[j];
            sc += fmaxf(d, 0.f) * iwv[h]; }
        keys[k] = ord_key(sc);
    }
    __syncthreads();
    unsigned Tt = 0u;
    if (nk > TOPK) {
        for (int bit = 31; bit >= 0; --bit) { const unsigned cand = Tt | (1u << bit); unsigned c = 0;
            for (int k = tid; k < nk; k += 256) c += (keys[k] >= cand) ? 1u : 0u;
#pragma unroll
            for (int o = 1; o < 64; o <<= 1) c += __shfl_xor(c, o);
            if (lane == 0) red[wv] = c;
            __syncthreads();
            const unsigned tot = red[0] + red[1] + red[2] + red[3];
            if (tot >= (unsigned)TOPK) Tt = cand;
            __syncthreads(); }
    }
    { unsigned c = 0; for (int k = tid; k < nk; k += 256) c += (keys[k] > Tt) ? 1u : 0u;
#pragma unroll
      for (int o = 1; o < 64; o <<= 1) c += __shfl_xor(c, o);
      if (lane == 0) red[4 + wv] = c; }
    __syncthreads();
    if (wv == 0) {
        const int ngt = (int)(red[4] + red[5] + red[6] + red[7]); const int need = TOPK - ngt;
        int pos = 0, eq_taken = 0; const unsigned long long lt = (1ull << lane) - 1ull;
        for (int base = 0; base < nk; base += 64) { const unsigned k = keys[base + lane]; const bool gt = k > Tt, eq = (k == Tt);
            const unsigned long long meq = __ballot(eq); const int rank_eq = __popcll(meq & lt); const bool take = gt || (eq && (eq_taken + rank_eq < need));
            const unsigned long long msel = __ballot(take);
            if (take) { const int o = pos + __popcll(msel & lt); if (o < TOPK) idx[(size_t)t * TOPK + o] = (unsigned short)(base + lane); }
            pos += __popcll(msel); eq_taken += __popcll(__ballot(eq && take)); }
    }
}

__global__ void __launch_bounds__(512) k_m3_attn(bf16* __restrict__ RA, const bf16* __restrict__ RB, const unsigned short* __restrict__ idx, const float* __restrict__ w_uk, const float* __restrict__ w_uv, const float* __restrict__ rel_bias) {
    __shared__ float q[512]; __shared__ float qlat[8][256]; __shared__ float pr[8][256]; __shared__ float outl[8][256]; __shared__ unsigned short sel[256];
    const int t = blockIdx.x, s = t & (SEQ - 1), b = t >> 12, tid = threadIdx.x, lane = tid & 63, wv = tid >> 6;
    const int nk = ((s >> 6) + 1) << 6, nsel = nk < TOPK ? nk : TOPK;
    q[tid] = bf2f(RA[(size_t)t * NA + A_Q + tid]); if (tid < 256) sel[tid] = tid < nsel ? idx[(size_t)t * TOPK + tid] : (unsigned short)0;
    __syncthreads();
    {
        const int r = tid & 255, h0 = (tid >> 8) * 4;
        for (int h = h0; h < h0 + 4; ++h) { const float* w = w_uk + ((size_t)r * 8 + h) * 64; float a = 0.f;
#pragma unroll 16
            for (int d = 0; d < 64; ++d) a += q[h * 64 + d] * w[d];
            qlat[h][r] = a * 0.125f; }
    }
    __syncthreads();
    {
        const int k = tid & 255, h0 = (tid >> 8) * 4;
        if (k < nsel) { const int key = sel[k]; const bf16* kr = RB + (size_t)(b * SEQ + key) * NB + B_CKV; float a[4] = {0.f, 0.f, 0.f, 0.f};
            for (int j = 0; j < 32; ++j) { const u32x4 w = *((const u32x4*)kr + j); const unsigned ww[4] = {w.x, w.y, w.z, w.w};
#pragma unroll
                for (int e = 0; e < 8; ++e) { const float v = bf2f((bf16)((ww[e >> 1] >> ((e & 1) * 16)) & 0xffff));
#pragma unroll
                    for (int hh = 0; hh < 4; ++hh) a[hh] += qlat[h0 + hh][j * 8 + e] * v; } }
            const int bk = t5_bucket(key - s);
#pragma unroll
            for (int hh = 0; hh < 4; ++hh) pr[h0 + hh][k] = a[hh] + rel_bias[bk * 8 + h0 + hh];
        } else {
#pragma unroll
            for (int hh = 0; hh < 4; ++hh) pr[h0 + hh][k] = -INFINITY; }
    }
    __syncthreads();
    {
        float v[4]; float m = -INFINITY;
#pragma unroll
        for (int j = 0; j < 4; ++j) { v[j] = pr[wv][lane + 64 * j]; m = fmaxf(m, v[j]); }
        m = wave_max(m); float sum = 0.f;
#pragma unroll
        for (int j = 0; j < 4; ++j) { v[j] = __expf(v[j] - m); sum += v[j]; }
        sum = wave_sum(sum); const float inv = 1.0f / sum;
#pragma unroll
        for (int j = 0; j < 4; ++j) pr[wv][lane + 64 * j] = v[j] * inv;
    }
    __syncthreads();
    {
        const int r = tid & 255, h0 = (tid >> 8) * 4; float a[4] = {0.f, 0.f, 0.f, 0.f};
        for (int k = 0; k < nsel; ++k) { const float v = bf2f(RB[(size_t)(b * SEQ + sel[k]) * NB + B_CKV + r]);
#pragma unroll
            for (int hh = 0; hh < 4; ++hh) a[hh] += pr[h0 + hh][k] * v; }
#pragma unroll
        for (int hh = 0; hh < 4; ++hh) outl[h0 + hh][r] = a[hh];
    }
    __syncthreads();
    {
        const int h = tid >> 6, d = tid & 63; float a = 0.f;
        for (int r = 0; r < 256; ++r) a += outl[h][r] * w_uv[((size_t)r * 8 + h) * 64 + d];
        RA[(size_t)t * NA + A_Q + tid] = f2bf(a);
    }
}

__global__ void __launch_bounds__(256) k_m4a_conv(const bf16* __restrict__ RB, const float* __restrict__ cw, const float* __restrict__ cb, const float* __restrict__ dtb, bf16* __restrict__ XA, float* __restrict__ DT) {
    const int t = blockIdx.x, s = t & (SEQ - 1), tid = threadIdx.x;
    for (int c = tid; c < XBC; c += 256) { float a = cb[c];
#pragma unroll
        for (int j = 0; j < 4; ++j) { const int ss = s - 3 + j; if (ss >= 0) a += cw[j * XBC + c] * bf2f(RB[(size_t)(t - 3 + j) * NB + B_XBC + c]); }
        XA[(size_t)t * XBC + c] = f2bf(siluf_(a)); }
    if (tid < 16) { const float x = bf2f(RB[(size_t)t * NB + B_DT + tid]) + dtb[tid]; DT[(size_t)t * 16 + tid] = x > 15.f ? x : log1pf(__expf(x)); }
}
__global__ void __launch_bounds__(256) k_m4b_scan(bf16* __restrict__ RA, const bf16* __restrict__ XA, const float* __restrict__ DT, const float* __restrict__ a_log, const float* __restrict__ dsk) {
    const int b = blockIdx.x >> 4, h = blockIdx.x & 15, g = h >> 3, tid = threadIdx.x, p = tid >> 2, nq = tid & 3;
    const float A = -__expf(a_log[h]), Dh = dsk[h];
    float hs[32];
#pragma unroll
    for (int n = 0; n < 32; ++n) hs[n] = 0.f;
    for (int s = 0; s < SEQ; ++s) { const size_t t = (size_t)b * SEQ + s; const float dt = DT[t * 16 + h]; const float dA = __expf(dt * A);
        const bf16* xr = XA + t * XBC; const float x = bf2f(xr[h * 64 + p]); const float dx = dt * x;
        const u32x4* Bp = (const u32x4*)(xr + 1024 + g * 128 + nq * 32); const u32x4* Cp = (const u32x4*)(xr + 1280 + g * 128 + nq * 32); float y = 0.f;
#pragma unroll
        for (int j = 0; j < 4; ++j) { const u32x4 bw = Bp[j], cw = Cp[j]; const unsigned bb[4] = {bw.x, bw.y, bw.z, bw.w}, cc[4] = {cw.x, cw.y, cw.z, cw.w};
#pragma unroll
            for (int e = 0; e < 8; ++e) { const float Bv = bf2f((bf16)((bb[e >> 1] >> ((e & 1) * 16)) & 0xffff)), Cv = bf2f((bf16)((cc[e >> 1] >> ((e & 1) * 16)) & 0xffff));
                hs[j * 8 + e] = hs[j * 8 + e] * dA + dx * Bv; y += Cv * hs[j * 8 + e]; } }
        y += __shfl_xor(y, 1); y += __shfl_xor(y, 2);
        if (nq == 0) { bf16* zp = RA + t * NA + A_Z + h * 64 + p; const float z = bf2f(*zp); *zp = f2bf((y + Dh * x) * siluf_(z)); }
    }
}
__global__ void __launch_bounds__(256) k_m4c_gnorm(bf16* __restrict__ RA, const float* __restrict__ nw) {
    const int lane = threadIdx.x & 63, w = blockIdx.x * 4 + (threadIdx.x >> 6), t = w >> 1, g = w & 1;
    bf16* p = RA + (size_t)t * NA + A_Z + g * 512 + lane * 8; const u32x4 v = *(const u32x4*)p; const unsigned vw[4] = {v.x, v.y, v.z, v.w}; float f[8]; float ss = 0.f;
#pragma unroll
    for (int e = 0; e < 8; ++e) { f[e] = bf2f((bf16)((vw[e >> 1] >> ((e & 1) * 16)) & 0xffff)); ss += f[e] * f[e]; }
    const float r = 1.0f / sqrtf(wave_sum(ss) * (1.0f / 512.0f) + EPS); const float* gw = nw + g * 512 + lane * 8;
    u32x4 o; o.x = pk2(f[0] * r * gw[0], f[1] * r * gw[1]); o.y = pk2(f[2] * r * gw[2], f[3] * r * gw[3]); o.z = pk2(f[4] * r * gw[4], f[5] * r * gw[5]); o.w = pk2(f[6] * r * gw[6], f[7] * r * gw[7]);
    *(u32x4*)p = o;
}

template <class Epi> static void launch_gemm(const bf16* A, const bf16* Bt, int M, int N, int K, const Epi& E, int grid, hipStream_t st) {
    static bool attr = false;
    if (!attr) { (void)hipFuncSetAttribute((const void*)k_gemm<Epi>, hipFuncAttributeMaxDynamicSharedMemorySize, GEMM_LDS); attr = true; }
    hipLaunchKernelGGL(k_gemm<Epi>, dim3(grid), dim3(512), GEMM_LDS, st, A, Bt, M, N, K, E);
}

extern "C" void kernel_launch(void* const* d_in, const int* in_sizes, int n_in, void* d_out, int out_size, void* d_ws, size_t ws_size, hipStream_t stream) {
    if (n_in != 26 || ws_size < WS_END) { fprintf(stderr, "kernel_launch: unexpected n_in %d / ws_size %zu\n", n_in, ws_size); return; }
    static int cus = 0;
    if (!cus) { int dev = 0; (void)hipGetDevice(&dev); (void)hipDeviceGetAttribute(&cus, hipDeviceAttributeMultiprocessorCount, dev); if (cus <= 0) cus = 256; }
    const int grid = cus;
    const float* x = (const float*)d_in[0]; const float* p = (const float*)d_in[1];
    const float *pre_mix = (const float*)d_in[2], *post_mix = (const float*)d_in[3], *pre_ffn = (const float*)d_in[4], *post_ffn = (const float*)d_in[5], *w_in = (const float*)d_in[6],
                *kv_norm = (const float*)d_in[7], *ikg = (const float*)d_in[8], *ikb = (const float*)d_in[9], *w_uk = (const float*)d_in[10], *w_uv = (const float*)d_in[11], *rel_bias = (const float*)d_in[12],
                *scw = (const float*)d_in[13], *ssm_cw = (const float*)d_in[14], *ssm_cb = (const float*)d_in[15], *dt_bias = (const float*)d_in[16], *a_log = (const float*)d_in[17], *ssm_d = (const float*)d_in[18],
                *ssm_norm = (const float*)d_in[19], *w_out = (const float*)d_in[20], *w_gate = (const float*)d_in[21], *w_up = (const float*)d_in[22], *w_down = (const float*)d_in[23], *w_pp = (const float*)d_in[24],
                *w_pg = (const float*)d_in[25];
    unsigned char* ws = (unsigned char*)d_ws; float* out = (float*)d_out;
    float* rstd = (float*)(ws + WS_RSTD); float* rstd2 = (float*)(ws + WS_RSTD2); float* DTb = (float*)(ws + WS_DT);
    bf16 *Win = (bf16*)(ws + WS_W_IN), *Wout = (bf16*)(ws + WS_W_OUT), *Wgu = (bf16*)(ws + WS_W_GU), *Wdown = (bf16*)(ws + WS_W_DOWN), *Wpg = (bf16*)(ws + WS_W_PG), *Wpp = (bf16*)(ws + WS_W_PP);
    bf16 *X0 = (bf16*)(ws + WS_X0), *X1 = (bf16*)(ws + WS_X1), *RA = (bf16*)(ws + WS_RA), *RB = (bf16*)(ws + WS_RB), *XA = (bf16*)(ws + WS_XA);
    unsigned short* IDX = (unsigned short*)(ws + WS_IDX);

    for (int L = 0; L < DEPTH; ++L) {
        hipLaunchKernelGGL(k_prep_w<1>, dim3(NIN / 32, D / 32), dim3(256), 0, stream, w_in + (size_t)L * D * INW, (const float*)nullptr, D, INW, pre_mix + (size_t)L * D, Win);
        hipLaunchKernelGGL(k_prep_w<0>, dim3(D / 32, MIXW / 32), dim3(256), 0, stream, w_out + (size_t)L * MIXW * D, (const float*)nullptr, MIXW, D, (const float*)nullptr, Wout);
        hipLaunchKernelGGL(k_prep_w<2>, dim3(NGU / 32, D / 32), dim3(256), 0, stream, w_gate + (size_t)L * D * DFF, w_up + (size_t)L * D * DFF, D, DFF, pre_ffn + (size_t)L * D, Wgu);
        hipLaunchKernelGGL(k_prep_w<0>, dim3(D / 32, DFF / 32), dim3(256), 0, stream, w_down + (size_t)L * DFF * D, (const float*)nullptr, DFF, D, (const float*)nullptr, Wdown);
        hipLaunchKernelGGL(k_prep_w<0>, dim3(D / 32, D / 32), dim3(256), 0, stream, w_pg + (size_t)L * D * D, (const float*)nullptr, D, D, (const float*)nullptr, Wpg);
        hipLaunchKernelGGL(k_prep_w<0>, dim3(D / 32, PLE / 32), dim3(256), 0, stream, w_pp + (size_t)L * PLE * D, (const float*)nullptr, PLE, D, (const float*)nullptr, Wpp);
        bf16* Xcur = (L == 0) ? X0 : X1;
        if (L == 0) hipLaunchKernelGGL(k_x_prep, dim3(T / 4), dim3(256), 0, stream, x, X0, rstd);
        else hipLaunchKernelGGL(k_rstd, dim3(T / 4), dim3(256), 0, stream, (const float*)out, rstd);
        launch_gemm(Xcur, Win, T, NIN, D, pg8::EpiProj{RA, RB, rstd}, grid, stream);
        hipLaunchKernelGGL(k_m1_prep, dim3(T / 4), dim3(256), 0, stream, RA, RB, kv_norm + L * KV_R, ikg + L * 64, ikb + L * 64, scw + (size_t)L * 3 * 512);
        hipLaunchKernelGGL(k_m2_select, dim3(T), dim3(256), 0, stream, (const bf16*)RB, IDX);
        hipLaunchKernelGGL(k_m3_attn, dim3(T), dim3(512), 0, stream, RA, (const bf16*)RB, (const unsigned short*)IDX, w_uk + (size_t)L * 256 * 8 * 64, w_uv + (size_t)L * 256 * 8 * 64, rel_bias);
        hipLaunchKernelGGL(k_m4a_conv, dim3(T), dim3(256), 0, stream, (const bf16*)RB, ssm_cw + (size_t)L * 4 * XBC, ssm_cb + (size_t)L * XBC, dt_bias + L * 16, XA, DTb);
        hipLaunchKernelGGL(k_m4b_scan, dim3(BATCH * 16), dim3(256), 0, stream, RA, (const bf16*)XA, (const float*)DTb, a_log + L * 16, ssm_d + L * 16);
        hipLaunchKernelGGL(k_m4c_gnorm, dim3(T * 2 / 4), dim3(256), 0, stream, RA, ssm_norm + (size_t)L * 1024);
        float* MIXF = (float*)RB;
        launch_gemm(RA, Wout, T, D, MIXW, pg8::EpiF32{MIXF, (long)D}, grid, stream);
        hipLaunchKernelGGL(k_resid_norm, dim3(T / 4), dim3(256), 0, stream, L == 0 ? x : (const float*)out, (const float*)MIXF, post_mix + (size_t)L * D, out, X0, rstd2, (const float*)nullptr, (bf16*)nullptr);
        bf16* G = RB;
        launch_gemm(X0, Wgu, T, NGU, D, pg8::EpiSwiGLU{G, rstd2}, grid, stream);
        float* FF = (float*)RA;
        launch_gemm(G, Wdown, T, D, DFF, pg8::EpiF32{FF, (long)D}, grid, stream);
        hipLaunchKernelGGL(k_resid_norm, dim3(T / 4), dim3(256), 0, stream, (const float*)out, (const float*)FF, post_ffn + (size_t)L * D, out, X0, (float*)nullptr, p + (size_t)L * T * PLE, X1);
        bf16* TT = RB;
        launch_gemm(X1, Wpp, T, D, PLE, pg8::EpiBf16P{TT, (long)D}, grid, stream);
        launch_gemm(X0, Wpg, T, D, D, pg8::EpiPle{out, TT, X1}, grid, stream);
    }
}
```

```cpp
#include <hip/hip_runtime.h>
#include <cstdio>
#include <cstdint>
#include <cstring>
namespace pg8 {
#define PG8_LAS __attribute__((address_space(3)))
typedef unsigned short bf16_t;
typedef short bf16x8 __attribute__((ext_vector_type(8)));
typedef float f32x4 __attribute__((ext_vector_type(4)));
typedef unsigned u32x4 __attribute__((ext_vector_type(4)));
constexpr int BM = 256, BK = 64, HALF = 128, HTB = HALF * BK * 2  , STAGE_BYTES = 8 * HTB, NXCD = 8, WGM = 8;

__host__ __device__ __forceinline__ int lds_byte(int r, int c) { const int st = (r >> 4) * 2 + (c >> 5), rr = r & 15, cc = c & 31, ob = rr * 64 + cc * 2; return st * 1024 + (ob ^ (((ob >> 9) & 1) << 5)); }
__host__ __device__ __forceinline__ void stage_rc(int b, int& R, int& C) { const int st = b / 1024, sb = b % 1024, swz = sb ^ (((sb >> 9) & 1) << 5); R = (st >> 1) * 16 + swz / 64; C = (st & 1) * 32 + (swz % 64) / 2; }
__host__ __device__ __forceinline__ int perm32(int rho) { const int n = rho >> 4, i = rho & 15; return 8 * (i >> 2) + 4 * n + (i & 3); }

struct Unit { int pm, pn; };
struct Gemm { const bf16_t* A; const bf16_t* Bt; int M, N, K; };

struct StaticOrder {
    int nM, nN, nwg, G, c;
    __host__ __device__ void init(int M, int N, int G_, int c_) { nM = M / BM; nN = N / BM; nwg = nM * nN; G = G_; c = c_; }
    __host__ __device__ bool next(int i, Unit& u) const {
        const long L = (long)i * G + c; if (L >= nwg) return false;
        int wgid = (int)L; { const int q = nwg / NXCD, r = nwg % NXCD, xcd = wgid % NXCD, off = wgid / NXCD; wgid = (xcd < r ? xcd * (q + 1) : r * (q + 1) + (xcd - r) * q) + off; }
        const int nig = WGM * nN, gid = wgid / nig, fm = gid * WGM, gsz = (nM - fm) < WGM ? (nM - fm) : WGM;
        u.pm = fm + ((wgid % nig) % gsz); u.pn = (wgid % nig) / gsz; return true;
    }
    __device__ __forceinline__ void a_ready(const Unit&) const {}
    __device__ __forceinline__ void done(const Unit&) const {}
};

__device__ __forceinline__ unsigned cvt_pk_bf16(float lo, float hi) { unsigned r; asm volatile("v_cvt_pk_bf16_f32 %0, %1, %2" : "=v"(r) : "v"(lo), "v"(hi)); return r; }
typedef float f32x2 __attribute__((ext_vector_type(2)));
__device__ __forceinline__ f32x2 gelu_pk(f32x2 v) {
    const f32x2 av = __builtin_elementwise_abs(v), d = av * 0.2316418882f + 1.0f;
    f32x2 t; t.x = __builtin_amdgcn_rcpf(d.x); t.y = __builtin_amdgcn_rcpf(d.y);
    f32x2 q = t * 0.5307027145f + (-0.7265760135f); q = q * t + 0.7107068705f; q = q * t + (-0.142248368f); q = q * t + 0.127414796f; q = q * t;
    const f32x2 s = (v * v) * (-0.72134752044f);
    f32x2 e; e.x = __builtin_amdgcn_exp2f(s.x); e.y = __builtin_amdgcn_exp2f(s.y);
    const f32x2 m = v * (q * e), r = v - m;
    f32x2 o; o.x = v.x < 0.f ? m.x : r.x; o.y = v.y < 0.f ? m.y : r.y; return o;
}

template <int ACT  > struct EpiBf16 {
    static constexpr bool PERM = true, AFTER_DRAIN = false; static_assert(ACT == 0 || ACT == 1, "EpiBf16: ACT is 0 (none) or 1 (gelu_pk)");
    bf16_t* O; int ldc; const float* bias; int split_cols; size_t split_stride; float scale0;
    __device__ __forceinline__ void operator()(const f32x4 (&acc)[2][2][4][2], const Unit& u, int wr, int wc, int fr, int fq) const {
        const int row0 = u.pm * BM + wr * 64 + fr; int colt = u.pn * BM; bf16_t* base = O;
        float sc = 1.f; if (split_cols) { const int t = colt / split_cols; base += (size_t)t * split_stride; colt -= t * split_cols; if (t == 0) sc = scale0; }
        const int col0 = colt + wc * 32 + 8 * fq, bcol0 = u.pn * BM + wc * 32 + 8 * fq;
        f32x4 bv[2][2];
#pragma unroll
        for (int bj = 0; bj < 2; ++bj)
#pragma unroll
            for (int n = 0; n < 2; ++n) bv[bj][n] = bias ? *(const f32x4*)(bias + bcol0 + bj * HALF + 4 * n) : (f32x4){0.f, 0.f, 0.f, 0.f};
#pragma unroll
        for (int ai = 0; ai < 2; ++ai)
#pragma unroll
            for (int m = 0; m < 4; ++m) { bf16_t* rowp = base + (size_t)(row0 + ai * HALF + m * 16) * ldc + col0;
#pragma unroll
                for (int bj = 0; bj < 2; ++bj) { f32x4 v0 = acc[ai][bj][m][0] + bv[bj][0], v1 = acc[ai][bj][m][1] + bv[bj][1];
                    if (ACT == 1) { f32x2 a = gelu_pk((f32x2){v0[0], v0[1]}), b = gelu_pk((f32x2){v0[2], v0[3]}), c = gelu_pk((f32x2){v1[0], v1[1]}), d = gelu_pk((f32x2){v1[2], v1[3]});
                        v0 = (f32x4){a.x, a.y, b.x, b.y}; v1 = (f32x4){c.x, c.y, d.x, d.y}; }
                    v0 = v0 * sc; v1 = v1 * sc; u32x4 w; w.x = cvt_pk_bf16(v0[0], v0[1]); w.y = cvt_pk_bf16(v0[2], v0[3]); w.z = cvt_pk_bf16(v1[0], v1[1]); w.w = cvt_pk_bf16(v1[2], v1[3]);
                    *(u32x4*)(rowp + bj * HALF) = w; } }
    }
};

struct PanelStats {
    unsigned* xbuf;
    unsigned* cnt;
    unsigned* tmo;
    int ntn; float eps;
    unsigned code;
    __device__ __forceinline__ bool run(const f32x4 (&v)[2][2][4][2], const Unit& u, int wr, int wc, int fr, int fq, PG8_LAS unsigned char* lds, int wid, int lane) const {
        typedef float f32x2v __attribute__((ext_vector_type(2)));
        PG8_LAS f32x2v* P = (PG8_LAS f32x2v*)lds;
        PG8_LAS f32x2v* S = (PG8_LAS f32x2v*)(lds + 8192);
        PG8_LAS unsigned* flag = (PG8_LAS unsigned*)(lds + 8192 + 2048);
#pragma unroll
        for (int ai = 0; ai < 2; ++ai)
#pragma unroll
            for (int m = 0; m < 4; ++m) {
                float s = 0.f;
#pragma unroll
                for (int bj = 0; bj < 2; ++bj)
#pragma unroll
                    for (int n = 0; n < 2; ++n) { const f32x4 x = v[ai][bj][m][n]; s += (x[0] + x[1]) + (x[2] + x[3]); }
                s += __shfl_xor(s, 16); s += __shfl_xor(s, 32);
                const float mw = s * (1.0f / 64.0f); float q = 0.f;
#pragma unroll
                for (int bj = 0; bj < 2; ++bj)
#pragma unroll
                    for (int n = 0; n < 2; ++n) { const f32x4 d = v[ai][bj][m][n] - mw; q += (d[0] * d[0] + d[1] * d[1]) + (d[2] * d[2] + d[3] * d[3]); }
                q += __shfl_xor(q, 16); q += __shfl_xor(q, 32);
                if (fq == 0) P[(ai * HALF + wr * 64 + m * 16 + fr) * 4 + wc] = (f32x2v){mw, q};
            }
        asm volatile("s_waitcnt lgkmcnt(0)" ::: "memory"); __builtin_amdgcn_s_barrier(); asm volatile("" ::: "memory");
#if defined(BROKEN_EXCHANGE_NO_WAIT)
#warning BROKEN CONTROL BUILD: the row-statistics exchange does not wait; results are wrong by design
        if (blockIdx.x >= 64) { const long long t0_ = clock64(); while (clock64() - t0_ < 60000) __builtin_amdgcn_s_sleep(8); }
#endif
        const int row = wid * 32 + (lane & 31);
        if (lane < 32) {
            const f32x2v a = P[row * 4 + 0], b = P[row * 4 + 1], c = P[row * 4 + 2], d = P[row * 4 + 3];
            const float mt = (a.x + b.x + c.x + d.x) * 0.25f;
            const float da = a.x - mt, db = b.x - mt, dc = c.x - mt, dd = d.x - mt;
            const float m2 = (a.y + b.y) + (c.y + d.y) + 64.0f * ((da * da + db * db) + (dc * dc + dd * dd));
            unsigned long long* slot = (unsigned long long*)xbuf + ((size_t)(u.pm * BM + row) * 4 + u.pn);
            __hip_atomic_store(slot, ((unsigned long long)__float_as_uint(m2) << 32) | __float_as_uint(mt), __ATOMIC_RELAXED, __HIP_MEMORY_SCOPE_AGENT);
        }
        asm volatile("s_waitcnt vmcnt(0)" ::: "memory");
        if (lane == 0) __hip_atomic_fetch_add(cnt + 64 * u.pm, 1u, __ATOMIC_RELAXED, __HIP_MEMORY_SCOPE_AGENT);
        if (wid == 0) {
            bool dead = false; const unsigned long long t0 = __builtin_amdgcn_s_memrealtime(); const unsigned want = 8u * (unsigned)ntn;
            for (;;) {
#if defined(BROKEN_EXCHANGE_NO_WAIT)
                break;
#endif
                if ((unsigned)__builtin_amdgcn_readfirstlane(__hip_atomic_load(cnt + 64 * u.pm, __ATOMIC_RELAXED, __HIP_MEMORY_SCOPE_AGENT)) >= want) break;
                if (__builtin_amdgcn_s_memrealtime() - t0 > 2000000ull) {
                    if (lane == 0) { unsigned expect = 0u; __hip_atomic_compare_exchange_strong(tmo + 1, &expect, code | (unsigned)(u.pm & 0xff), __ATOMIC_RELAXED, __ATOMIC_RELAXED, __HIP_MEMORY_SCOPE_AGENT);
                                     __hip_atomic_store(tmo, 1u, __ATOMIC_RELAXED, __HIP_MEMORY_SCOPE_AGENT); }
                    dead = true; break; }
                __builtin_amdgcn_s_sleep(2);
            }
            __builtin_amdgcn_fence(__ATOMIC_ACQUIRE, "agent");
            if (lane == 0) flag[0] = dead ? 1u : 0u;
        }
        asm volatile("s_waitcnt vmcnt(0) lgkmcnt(0)" ::: "memory"); __builtin_amdgcn_s_barrier(); asm volatile("" ::: "memory");
        const bool bad = flag[0] != 0u;
        if (lane < 32) {
            const unsigned long long* slot = (const unsigned long long*)xbuf + (size_t)(u.pm * BM + row) * 4; float mt[4], m2[4]; float ms = 0.f;
#pragma unroll
            for (int t = 0; t < 4; ++t) { if (t < ntn) { const unsigned long long w = __hip_atomic_load(slot + t, __ATOMIC_RELAXED, __HIP_MEMORY_SCOPE_AGENT); mt[t] = __uint_as_float((unsigned)w); m2[t] = __uint_as_float((unsigned)(w >> 32)); } else { mt[t] = 0.f; m2[t] = 0.f; } ms += mt[t]; }
            const float mean = ms / (float)ntn; float q = 0.f;
#pragma unroll
            for (int t = 0; t < 4; ++t) if (t < ntn) { const float dm = mt[t] - mean; q += m2[t] + 256.0f * dm * dm; }
            S[row] = (f32x2v){mean, 1.0f / sqrtf(q / (256.0f * (float)ntn) + eps)};
        }
        asm volatile("s_waitcnt lgkmcnt(0)" ::: "memory"); __builtin_amdgcn_s_barrier(); asm volatile("" ::: "memory");
        return bad;
    }
};
struct EpiLnRes {
    static constexpr bool PERM = false, AFTER_DRAIN = true;
    const float* base; float* out; int ldc; const float* bias; PanelStats st; unsigned poison;
    __device__ __forceinline__ void fused(f32x4 (&acc)[2][2][4][2], const Unit& u, int wr, int wc, int fr, int fq, PG8_LAS unsigned char* lds, int wid, int lane) const {
        typedef float f32x2v __attribute__((ext_vector_type(2)));
        const PG8_LAS f32x2v* S = (const PG8_LAS f32x2v*)(lds + 8192);
        const int col0 = u.pn * BM + wc * 32 + 4 * fq;
#pragma unroll
        for (int bj = 0; bj < 2; ++bj)
#pragma unroll
            for (int n = 0; n < 2; ++n) { const f32x4 bv = bias ? *(const f32x4*)(bias + col0 + bj * HALF + n * 16) : (f32x4){0.f, 0.f, 0.f, 0.f};
#pragma unroll
                for (int ai = 0; ai < 2; ++ai)
#pragma unroll
                    for (int m = 0; m < 4; ++m) acc[ai][bj][m][n] += bv; }
        f32x4 pre[4][2][2];
#pragma unroll
        for (int m = 0; m < 4; ++m) { const size_t off = (size_t)(u.pm * BM + wr * 64 + m * 16 + fr) * ldc + col0;
#pragma unroll
            for (int bj = 0; bj < 2; ++bj)
#pragma unroll
                for (int n = 0; n < 2; ++n) pre[m][bj][n] = *(const f32x4*)(base + off + bj * HALF + n * 16); }
        const bool bad = st.run(acc, u, wr, wc, fr, fq, lds, wid, lane) || poison != 0u;
        const float qnan = __builtin_nanf("");
#pragma unroll
        for (int ai = 0; ai < 2; ++ai)
#pragma unroll
            for (int m = 0; m < 4; ++m) { const int r = ai * HALF + wr * 64 + m * 16 + fr; const f32x2v sr = S[r]; const size_t off = (size_t)(u.pm * BM + r) * ldc + col0;
#pragma unroll
                for (int bj = 0; bj < 2; ++bj)
#pragma unroll
                    for (int n = 0; n < 2; ++n) { const f32x4 bs = ai == 0 ? pre[m][bj][n] : *(const f32x4*)(base + off + bj * HALF + n * 16); f32x4 o = bs + (acc[ai][bj][m][n] - sr.x) * sr.y;
                        if (bad) o = (f32x4){qnan, qnan, qnan, qnan}; *(f32x4*)(out + off + bj * HALF + n * 16) = o; }
                if (m & 1) asm volatile("" ::: "memory"); }
    }
};
struct EpiLnResLn {
    static constexpr bool PERM = false, AFTER_DRAIN = true;
    const float* base; float* out; bf16_t* xn; int ldc; const float* bias; PanelStats st1, st2; unsigned poison;
    __device__ __forceinline__ void fused(f32x4 (&acc)[2][2][4][2], const Unit& u, int wr, int wc, int fr, int fq, PG8_LAS unsigned char* lds, int wid, int lane) const {
        typedef float f32x2v __attribute__((ext_vector_type(2))); typedef unsigned u32x2v __attribute__((ext_vector_type(2)));
        const PG8_LAS f32x2v* S = (const PG8_LAS f32x2v*)(lds + 8192);
        const int col0 = u.pn * BM + wc * 32 + 4 * fq;
#pragma unroll
        for (int bj = 0; bj < 2; ++bj)
#pragma unroll
            for (int n = 0; n < 2; ++n) { const f32x4 bv = bias ? *(const f32x4*)(bias + col0 + bj * HALF + n * 16) : (f32x4){0.f, 0.f, 0.f, 0.f};
#pragma unroll
                for (int ai = 0; ai < 2; ++ai)
#pragma unroll
                    for (int m = 0; m < 4; ++m) acc[ai][bj][m][n] += bv; }
        bool bad = st1.run(acc, u, wr, wc, fr, fq, lds, wid, lane) || poison != 0u;
        const float qnan = __builtin_nanf("");
#pragma unroll
        for (int ai = 0; ai < 2; ++ai)
#pragma unroll
            for (int m = 0; m < 4; ++m) { const int r = ai * HALF + wr * 64 + m * 16 + fr; const f32x2v sr = S[r]; const size_t off = (size_t)(u.pm * BM + r) * ldc + col0;
#pragma unroll
                for (int bj = 0; bj < 2; ++bj)
#pragma unroll
                    for (int n = 0; n < 2; ++n) { const f32x4 bs = *(const f32x4*)(base + off + bj * HALF + n * 16); acc[ai][bj][m][n] = bs + (acc[ai][bj][m][n] - sr.x) * sr.y; }
                asm volatile("" : "+v"(acc[ai][0][m][0]), "+v"(acc[ai][0][m][1]), "+v"(acc[ai][1][m][0]), "+v"(acc[ai][1][m][1]));
                if (m & 1) asm volatile("" ::: "memory"); }
        const bool bad1 = bad;
        bad = st2.run(acc, u, wr, wc, fr, fq, lds, wid, lane) || bad;
#pragma unroll
        for (int ai = 0; ai < 2; ++ai)
#pragma unroll
            for (int m = 0; m < 4; ++m) { const int r = ai * HALF + wr * 64 + m * 16 + fr; const f32x2v sr = S[r]; const size_t off = (size_t)(u.pm * BM + r) * ldc + col0;
#pragma unroll
                for (int bj = 0; bj < 2; ++bj)
#pragma unroll
                    for (int n = 0; n < 2; ++n) { const f32x4 x1 = acc[ai][bj][m][n]; *(f32x4*)(out + off + bj * HALF + n * 16) = bad1 ? (f32x4){qnan, qnan, qnan, qnan} : x1;
                        const f32x4 o = (x1 - sr.x) * sr.y; u32x2v w; w.x = cvt_pk_bf16(o[0], o[1]); w.y = cvt_pk_bf16(o[2], o[3]);
                        if (bad) { w.x = 0x7fc07fc0u; w.y = 0x7fc07fc0u; } *(u32x2v*)(xn + off + bj * HALF + n * 16) = w; }
                asm volatile("" ::: "memory"); }
    }
};

template <class Epi, class Sched, bool ALIGN_EPI = false, bool SP2 = false>
__device__ __forceinline__ void gemm_phase(PG8_LAS unsigned char* lds, const Gemm g, const Sched& S, const Epi& E, int tid_in) {
    int tid_l = tid_in; asm volatile("" : "+v"(tid_l));
    const int tid = tid_l, wid = __builtin_amdgcn_readfirstlane(tid >> 6), lane = tid & 63, wr = wid >> 2, wc = wid & 3, fr = lane & 15, fq = lane >> 4;
    int K_l = g.K; asm volatile("" : "+s"(K_l));
    const int K = K_l, nt = K / BK;
    unsigned voffA[2], voffB[2];
#pragma unroll
    for (int i = 0; i < 2; ++i) { int R, C; stage_rc(tid * 16 + i * 8192, R, C); const int Rb = Epi::PERM ? ((R & ~31) + perm32(R & 31)) : R;
        voffA[i] = (unsigned)(R * K + C) * 2u; voffB[i] = (unsigned)(Rb * K + C) * 2u; }
    const size_t kstep = (size_t)(BK * 2);
    const size_t hstep = (size_t)HALF * K * 2;
    const size_t tstep = 2 * hstep;
    const unsigned ldsw = (unsigned)wid * 1024u;
    const int aoff = lds_byte(wr * 64 + fr, fq * 8), boff = lds_byte(wc * 32 + fr, fq * 8);
#define PG8_SA(b, h) (((b) * 2 + (h)) * HTB)
#define PG8_SB(b, h) ((4 + (b) * 2 + (h)) * HTB)
#define PG8_STAGE(bufoff, gbase, voff) do { _Pragma("unroll") for (int _i = 0; _i < 2; ++_i) \
        __builtin_amdgcn_global_load_lds((const unsigned*)((const char*)(gbase) + (voff)[_i]), (PG8_LAS unsigned*)(lds + (bufoff) + ldsw + _i * 8192), 16, 0, 0); } while (0)
#define PG8_LDA(dst, b, h) do { _Pragma("unroll") for (int m = 0; m < 4; ++m) _Pragma("unroll") for (int k = 0; k < 2; ++k) dst[m][k] = *(const PG8_LAS bf16x8*)(lds + PG8_SA(b, h) + aoff + m * 2048 + k * 1024); } while (0)
#define PG8_LDB(dst, b, h) do { _Pragma("unroll") for (int n = 0; n < 2; ++n) _Pragma("unroll") for (int k = 0; k < 2; ++k) dst[n][k] = *(const PG8_LAS bf16x8*)(lds + PG8_SB(b, h) + boff + n * 2048 + k * 1024); } while (0)
#define PG8_MMA(ai, bj, At, Bt) do { __builtin_amdgcn_s_setprio(1); _Pragma("unroll") for (int m = 0; m < 4; ++m) _Pragma("unroll") for (int n = 0; n < 2; ++n) _Pragma("unroll") for (int k = 0; k < 2; ++k) \
        acc[ai][bj][m][n] = __builtin_amdgcn_mfma_f32_16x16x32_bf16(Bt[n][k], At[m][k], acc[ai][bj][m][n], 0, 0, 0); __builtin_amdgcn_s_setprio(0); } while (0)
#define PG8_WAIT_V(n) asm volatile("s_waitcnt vmcnt(" #n ")" ::: "memory")
#define PG8_WAIT_L(n) asm volatile("s_waitcnt lgkmcnt(" #n ")" ::: "memory")
#define PG8_BAR __builtin_amdgcn_s_barrier()
#define PG8_SCHED __builtin_amdgcn_sched_barrier(0)
    Unit cur, nxt; int ui = 0;
    if (!S.next(0, cur)) return;
    f32x4 acc[2][2][4][2];
#pragma unroll
    for (int a = 0; a < 2; ++a)
#pragma unroll
        for (int b = 0; b < 2; ++b)
#pragma unroll
            for (int m = 0; m < 4; ++m)
#pragma unroll
                for (int n = 0; n < 2; ++n) acc[a][b][m][n] = (f32x4){0.f, 0.f, 0.f, 0.f};
    bf16x8 At[4][2], B0[2][2], B1[2][2];
    const char* cA = (const char*)g.A + (size_t)cur.pm * tstep; const char* cB = (const char*)g.Bt + (size_t)cur.pn * tstep;
    S.a_ready(cur);
    if constexpr (SP2) {
        PG8_STAGE(PG8_SB(0, 0), cB, voffB); PG8_STAGE(PG8_SB(0, 1), cB + hstep, voffB); PG8_STAGE(PG8_SA(0, 0), cA, voffA); PG8_STAGE(PG8_SA(0, 1), cA + hstep, voffA);
        if (wr == 1) PG8_BAR;
        PG8_WAIT_V(2); PG8_BAR;
        PG8_STAGE(PG8_SB(1, 0), cB + kstep, voffB); PG8_STAGE(PG8_SA(1, 0), cA + kstep, voffA); PG8_STAGE(PG8_SB(1, 1), cB + hstep + kstep, voffB);
        PG8_WAIT_V(6); PG8_BAR;
    } else {
        PG8_STAGE(PG8_SB(0, 0), cB, voffB); PG8_STAGE(PG8_SA(0, 0), cA, voffA); PG8_STAGE(PG8_SB(0, 1), cB + hstep, voffB); PG8_STAGE(PG8_SA(0, 1), cA + hstep, voffA);
        if (wr == 1) PG8_BAR;
        PG8_WAIT_V(4); PG8_BAR;
        PG8_STAGE(PG8_SB(1, 0), cB + kstep, voffB); PG8_STAGE(PG8_SA(1, 0), cA + kstep, voffA); PG8_STAGE(PG8_SB(1, 1), cB + hstep + kstep, voffB);
        PG8_WAIT_V(6); PG8_BAR;
    }
    for (;;) {
        const bool has_next = S.next(ui + 1, nxt);
        const char* nA = has_next ? (const char*)g.A + (size_t)nxt.pm * tstep : cA; const char* nB = has_next ? (const char*)g.Bt + (size_t)nxt.pn * tstep : cB;
        for (int t = 0; t < nt; t += 2) {
            const bool last = (t == nt - 2);
            const char* a1 = cA + (size_t)(t + 1) * kstep;
            const char* a2 = last ? nA : cA + (size_t)(t + 2) * kstep; const char* b2 = last ? nB : cB + (size_t)(t + 2) * kstep;
            const char* a3 = a2 + kstep; const char* b3 = b2 + kstep;
            if (last && has_next) S.a_ready(nxt);
            if constexpr (SP2) {
            PG8_LDB(B0, 0, 0); PG8_LDB(B1, 0, 1); PG8_SCHED; PG8_LDA(At, 0, 0); PG8_STAGE(PG8_SA(1, 1), a1 + hstep, voffA);
            PG8_WAIT_V(8); PG8_WAIT_L(0); PG8_BAR; PG8_MMA(0, 0, At, B0); PG8_MMA(0, 1, At, B1); PG8_BAR; PG8_SCHED;
            PG8_LDA(At, 0, 1); PG8_STAGE(PG8_SB(0, 0), b2, voffB); PG8_STAGE(PG8_SB(0, 1), b2 + hstep, voffB); PG8_STAGE(PG8_SA(0, 0), a2, voffA);
            PG8_WAIT_V(8); PG8_WAIT_L(0); PG8_BAR; PG8_MMA(1, 0, At, B0); PG8_MMA(1, 1, At, B1); PG8_BAR; PG8_SCHED;
            PG8_LDB(B0, 1, 0); PG8_LDB(B1, 1, 1); PG8_SCHED; PG8_LDA(At, 1, 0); PG8_STAGE(PG8_SA(0, 1), a2 + hstep, voffA);
            PG8_WAIT_V(8); PG8_WAIT_L(0); PG8_BAR; PG8_MMA(0, 0, At, B0); PG8_MMA(0, 1, At, B1); PG8_BAR; PG8_SCHED;
            PG8_LDA(At, 1, 1); PG8_STAGE(PG8_SB(1, 0), b3, voffB); PG8_STAGE(PG8_SB(1, 1), b3 + hstep, voffB); PG8_STAGE(PG8_SA(1, 0), a3, voffA);
            PG8_WAIT_V(8); PG8_WAIT_L(0); PG8_BAR; PG8_MMA(1, 0, At, B0); PG8_MMA(1, 1, At, B1); PG8_BAR; PG8_SCHED;
            } else {
            PG8_LDB(B0, 0, 0); PG8_SCHED; PG8_LDA(At, 0, 0); PG8_STAGE(PG8_SA(1, 1), a1 + hstep, voffA);
            PG8_WAIT_L(8); PG8_BAR; PG8_WAIT_L(0); PG8_MMA(0, 0, At, B0); PG8_BAR; PG8_SCHED;
            PG8_LDB(B1, 0, 1); PG8_STAGE(PG8_SB(0, 0), b2, voffB);
            PG8_BAR; PG8_WAIT_L(0); PG8_MMA(0, 1, At, B1); PG8_BAR;
            PG8_LDA(At, 0, 1); PG8_STAGE(PG8_SA(0, 0), a2, voffA);
            PG8_BAR; PG8_WAIT_L(0); PG8_MMA(1, 0, At, B0); PG8_BAR; PG8_SCHED;
            PG8_STAGE(PG8_SB(0, 1), b2 + hstep, voffB);
            PG8_WAIT_V(6); PG8_BAR; PG8_MMA(1, 1, At, B1); PG8_BAR;
            PG8_LDB(B0, 1, 0); PG8_SCHED; PG8_LDA(At, 1, 0); PG8_STAGE(PG8_SA(0, 1), a2 + hstep, voffA);
            PG8_WAIT_L(8); PG8_BAR; PG8_WAIT_L(0); PG8_MMA(0, 0, At, B0); PG8_BAR; PG8_SCHED;
            PG8_LDB(B1, 1, 1); PG8_STAGE(PG8_SB(1, 0), b3, voffB);
            PG8_BAR; PG8_WAIT_L(0); PG8_MMA(0, 1, At, B1); PG8_BAR;
            PG8_LDA(At, 1, 1); PG8_STAGE(PG8_SA(1, 0), a3, voffA);
            PG8_BAR; PG8_WAIT_L(0); PG8_MMA(1, 0, At, B0); PG8_BAR; PG8_SCHED;
            PG8_STAGE(PG8_SB(1, 1), b3 + hstep, voffB);
            PG8_WAIT_V(6); PG8_BAR; PG8_MMA(1, 1, At, B1); PG8_BAR;
            }
        }
        if constexpr (ALIGN_EPI) { if (wr == 0) PG8_BAR; }
        if constexpr (!Epi::AFTER_DRAIN) { E(acc, cur, wr, wc, fr, fq); S.done(cur); }
        if (!has_next) break;
#pragma unroll
        for (int a = 0; a < 2; ++a)
#pragma unroll
            for (int b = 0; b < 2; ++b)
#pragma unroll
                for (int m = 0; m < 4; ++m)
#pragma unroll
                    for (int n = 0; n < 2; ++n) acc[a][b][m][n] = (f32x4){0.f, 0.f, 0.f, 0.f};
        cur = nxt; cA = nA; cB = nB; ++ui;
        if constexpr (ALIGN_EPI) { if (wr == 1) PG8_BAR; }
    }
    PG8_WAIT_V(0);
    if constexpr (!ALIGN_EPI) { if (wr == 0) PG8_BAR; }
    PG8_BAR;
    if constexpr (Epi::AFTER_DRAIN) { E.fused(acc, cur, wr, wc, fr, fq, lds, wid, lane); S.done(cur); }
#undef PG8_SA
#undef PG8_SB
#undef PG8_STAGE
#undef PG8_LDA
#undef PG8_LDB
#undef PG8_MMA
#undef PG8_WAIT_V
#undef PG8_WAIT_L
#undef PG8_BAR
#undef PG8_SCHED
}
}

typedef unsigned short bf16;
typedef float f32x4 __attribute__((ext_vector_type(4)));
typedef unsigned u32x4 __attribute__((ext_vector_type(4)));
typedef unsigned u32x2 __attribute__((ext_vector_type(2)));

constexpr int BATCH = 8, SEQ = 4096, T = BATCH * SEQ, D = 1024, DEPTH = 2;
constexpr int NA = 2048, NB = 3328, NIN = NA + NB, INW = 5204;
constexpr int DFF = 2816, NGU = 2 * DFF, PLE = 256, MIXW = 2048;
constexpr int A_Q = 0, A_BG = 512, A_Z = 1024;
constexpr int B_CKV = 0, B_IQ = 256, B_CG = 512, B_HB = 1024, B_XBC = 1536, B_IK = 3072, B_DT = 3136, B_IW = 3152;
constexpr int XBC = 1536, KV_R = 256, TOPK = 256;
constexpr float EPS = 1e-6f;

constexpr size_t MiB = 1u << 20;
constexpr size_t WS_CTL = 0;
constexpr size_t WS_RSTD = 1 * MiB;
constexpr size_t WS_RSTD2 = 1 * MiB + 256 * 1024;
constexpr size_t WS_DT = 2 * MiB;
constexpr size_t WS_W = 8 * MiB;
constexpr size_t WS_W_IN = WS_W, WS_W_OUT = WS_W_IN + (size_t)NIN * D * 2, WS_W_GU = WS_W_OUT + (size_t)D * MIXW * 2, WS_W_DOWN = WS_W_GU + (size_t)NGU * D * 2,
                 WS_W_PG = WS_W_DOWN + (size_t)D * DFF * 2, WS_W_PP = WS_W_PG + (size_t)D * D * 2, WS_W_END = WS_W_PP + (size_t)D * PLE * 2;
constexpr size_t WS_WUK = 42 * MiB, WS_WUV = 43 * MiB;
static_assert(WS_W_END <= 42 * MiB, "weights");
constexpr size_t WS_X0 = 44 * MiB, WS_X1 = 108 * MiB, WS_RA = 172 * MiB, WS_RB = 300 * MiB, WS_DT2 = 508 * MiB, WS_END = 512 * MiB;
constexpr size_t WS_XA = WS_X0;
constexpr size_t WS_IDX = WS_X1 + 48 * MiB;
constexpr size_t WS_CKVC = WS_X1 + 32 * MiB;
constexpr size_t WS_IKC = 4 * MiB;

__host__ __device__ __forceinline__ float bf2f(bf16 b) { return __builtin_bit_cast(float, ((unsigned)b) << 16); }
__host__ __device__ __forceinline__ bf16 f2bf(float f) { unsigned u = __builtin_bit_cast(unsigned, f); return (bf16)((u + 0x7fffu + ((u >> 16) & 1u)) >> 16); }
__device__ __forceinline__ unsigned pk2(float lo, float hi) { return (unsigned)f2bf(lo) | ((unsigned)f2bf(hi) << 16); }
__device__ __forceinline__ float wave_sum(float v) {
#pragma unroll
    for (int o = 1; o < 64; o <<= 1) v += __shfl_xor(v, o);
    return v;
}
__device__ __forceinline__ float wave_max(float v) {
#pragma unroll
    for (int o = 1; o < 64; o <<= 1) v = fmaxf(v, __shfl_xor(v, o));
    return v;
}
__device__ __forceinline__ float sigmoidf_(float v) { return __builtin_amdgcn_rcpf(1.0f + __expf(-v)); }
__device__ __forceinline__ float siluf_(float v) { return v * sigmoidf_(v); }

__host__ __device__ __forceinline__ int src_col_in(int n) {
    if (n < 512) return n;
    if (n < 1024) return 1092 + (n - 512);
    if (n < 2048) return 2628 + (n - 1024);
    n -= 2048;
    if (n < 256) return 512 + n;
    if (n < 512) return 768 + (n - 256);
    if (n < 1024) return 1604 + (n - 512);
    if (n < 1536) return 2116 + (n - 1024);
    if (n < 3072) return 3652 + (n - 1536);
    if (n < 3136) return 1024 + (n - 3072);
    if (n < 3152) return 5188 + (n - 3136);
    if (n < 3156) return 1088 + (n - 3152);
    return -1;
}

__host__ __device__ __forceinline__ int t5_bucket(int rel) {
    const int ret = rel > 0 ? 16 : 0; const int n = rel < 0 ? -rel : rel;
    int b;
    if (n < 8) b = n; else if (n < 15) b = 8; else if (n < 27) b = 9; else if (n < 50) b = 10; else if (n < 91) b = 11; else if (n < 166) b = 12; else if (n < 305) b = 13; else if (n < 559) b = 14; else b = 15;
    return ret + b;
}

template <int MODE> __global__ void __launch_bounds__(256) k_prep_w(const float* __restrict__ W, const float* __restrict__ W2, int K, int Nsrc, const float* __restrict__ gain, bf16* __restrict__ Wt) {
    __shared__ float tile[32][33];
    const int n0 = blockIdx.x * 32, k0 = blockIdx.y * 32, tx = threadIdx.x & 31, ty = threadIdx.x >> 5;
    const int n = n0 + tx; int src; const float* Ws = W;
    if (MODE == 0) src = n; else if (MODE == 1) src = src_col_in(n); else { const int which = (n & 255) >> 7; src = (n >> 8) * 128 + (n & 127); Ws = which ? W2 : W; }
    for (int kk = ty; kk < 32; kk += 8) { float v = 0.f; if (src >= 0) { v = Ws[(size_t)(k0 + kk) * Nsrc + src]; if (gain) v *= gain[k0 + kk]; } tile[kk][tx] = v; }
    __syncthreads();
    for (int nn = ty; nn < 32; nn += 8) Wt[(size_t)(n0 + nn) * K + k0 + tx] = f2bf(tile[tx][nn]);
}

__global__ void __launch_bounds__(256) k_x_prep(const float* __restrict__ x, bf16* __restrict__ xb, float* __restrict__ rstd) {
    const int lane = threadIdx.x & 63, row = blockIdx.x * 4 + (threadIdx.x >> 6);
    const f32x4* xr = (const f32x4*)(x + (size_t)row * D) + lane; float ss = 0.f; f32x4 v[4];
#pragma unroll
    for (int j = 0; j < 4; ++j) { v[j] = xr[64 * j]; ss += (v[j].x * v[j].x + v[j].y * v[j].y) + (v[j].z * v[j].z + v[j].w * v[j].w); }
    ss = wave_sum(ss);
    u32x2* o = (u32x2*)(xb + (size_t)row * D) + lane;
#pragma unroll
    for (int j = 0; j < 4; ++j) { u32x2 w; w.x = pk2(v[j].x, v[j].y); w.y = pk2(v[j].z, v[j].w); o[64 * j] = w; }
    if (lane == 0) rstd[row] = 1.0f / sqrtf(ss * (1.0f / D) + EPS);
}
__global__ void __launch_bounds__(256) k_rstd(const float* __restrict__ x, float* __restrict__ rstd) {
    const int lane = threadIdx.x & 63, row = blockIdx.x * 4 + (threadIdx.x >> 6);
    const f32x4* xr = (const f32x4*)(x + (size_t)row * D) + lane; float ss = 0.f;
#pragma unroll
    for (int j = 0; j < 4; ++j) { const f32x4 v = xr[64 * j]; ss += (v.x * v.x + v.y * v.y) + (v.z * v.z + v.w * v.w); }
    ss = wave_sum(ss);
    if (lane == 0) rstd[row] = 1.0f / sqrtf(ss * (1.0f / D) + EPS);
}
__global__ void __launch_bounds__(256) k_resid_norm(const float* xin, const float* __restrict__ y, const float* __restrict__ g, float* xo, bf16* __restrict__ xb,
                                                    float* __restrict__ rstd_out, const float* __restrict__ p, bf16* __restrict__ pb) {
    const int lane = threadIdx.x & 63, row = blockIdx.x * 4 + (threadIdx.x >> 6);
    const f32x4* yr = (const f32x4*)(y + (size_t)row * D) + lane; const f32x4* xr = (const f32x4*)(xin + (size_t)row * D) + lane; const f32x4* gr = (const f32x4*)g + lane;
    f32x4 v[4]; float ss = 0.f;
#pragma unroll
    for (int j = 0; j < 4; ++j) { v[j] = yr[64 * j]; ss += (v[j].x * v[j].x + v[j].y * v[j].y) + (v[j].z * v[j].z + v[j].w * v[j].w); }
    const float r = 1.0f / sqrtf(wave_sum(ss) * (1.0f / D) + EPS);
    float s2 = 0.f;
    f32x4* xor_ = (f32x4*)(xo + (size_t)row * D) + lane; u32x2* o = (u32x2*)(xb + (size_t)row * D) + lane;
#pragma unroll
    for (int j = 0; j < 4; ++j) { const f32x4 xx = xr[64 * j], gg = gr[64 * j]; f32x4 w = xx + v[j] * r * gg; xor_[64 * j] = w; s2 += (w.x * w.x + w.y * w.y) + (w.z * w.z + w.w * w.w);
        u32x2 q; q.x = pk2(w.x, w.y); q.y = pk2(w.z, w.w); o[64 * j] = q; }
    if (rstd_out) { s2 = wave_sum(s2); if (lane == 0) rstd_out[row] = 1.0f / sqrtf(s2 * (1.0f / D) + EPS); }
    if (p) { const f32x4 pv = *((const f32x4*)(p + (size_t)row * PLE) + lane); u32x2 q; q.x = pk2(pv.x, pv.y); q.y = pk2(pv.z, pv.w); *((u32x2*)(pb + (size_t)row * PLE) + lane) = q; }
}

namespace pg8 {
struct EpiProj {
    static constexpr bool PERM = true, AFTER_DRAIN = false;
    bf16_t* RA; bf16_t* RB; const float* rstd;
    __device__ __forceinline__ void operator()(const f32x4 (&acc)[2][2][4][2], const Unit& u, int wr, int wc, int fr, int fq) const {
        const int row0 = u.pm * BM + wr * 64 + fr; bf16_t* base; int ld, colt;
        if (u.pn < NA / 256) { base = RA; ld = NA; colt = u.pn * BM; } else { base = RB; ld = NB; colt = (u.pn - NA / 256) * BM; }
        const int col0 = colt + wc * 32 + 8 * fq;
        float sr[2][4];
#pragma unroll
        for (int ai = 0; ai < 2; ++ai)
#pragma unroll
            for (int m = 0; m < 4; ++m) sr[ai][m] = rstd[row0 + ai * HALF + m * 16];
#pragma unroll
        for (int ai = 0; ai < 2; ++ai)
#pragma unroll
            for (int m = 0; m < 4; ++m) { const int r = row0 + ai * HALF + m * 16; const float s = sr[ai][m]; bf16_t* rowp = base + (size_t)r * ld + col0;
#pragma unroll
                for (int bj = 0; bj < 2; ++bj) { const f32x4 v0 = acc[ai][bj][m][0] * s, v1 = acc[ai][bj][m][1] * s;
                    u32x4 w; w.x = cvt_pk_bf16(v0[0], v0[1]); w.y = cvt_pk_bf16(v0[2], v0[3]); w.z = cvt_pk_bf16(v1[0], v1[1]); w.w = cvt_pk_bf16(v1[2], v1[3]);
                    *(u32x4*)(rowp + bj * HALF) = w; } }
    }
};
struct EpiF32 {
    static constexpr bool PERM = false, AFTER_DRAIN = false;
    float* C; long ldc;
    __device__ __forceinline__ void operator()(const f32x4 (&acc)[2][2][4][2], const Unit& u, int wr, int wc, int fr, int fq) const {
        const int row0 = u.pm * BM + wr * 64 + fr, col0 = u.pn * BM + wc * 32 + 4 * fq;
#pragma unroll
        for (int ai = 0; ai < 2; ++ai)
#pragma unroll
            for (int m = 0; m < 4; ++m) { float* rowp = C + (size_t)(row0 + ai * HALF + m * 16) * ldc + col0;
#pragma unroll
                for (int bj = 0; bj < 2; ++bj)
#pragma unroll
                    for (int n = 0; n < 2; ++n) *(f32x4*)(rowp + bj * HALF + n * 16) = acc[ai][bj][m][n]; }
    }
};
struct EpiBf16P {
    static constexpr bool PERM = true, AFTER_DRAIN = false;
    bf16_t* O; long ldc;
    __device__ __forceinline__ void operator()(const f32x4 (&acc)[2][2][4][2], const Unit& u, int wr, int wc, int fr, int fq) const {
        const int row0 = u.pm * BM + wr * 64 + fr, col0 = u.pn * BM + wc * 32 + 8 * fq;
#pragma unroll
        for (int ai = 0; ai < 2; ++ai)
#pragma unroll
            for (int m = 0; m < 4; ++m) { bf16_t* rowp = O + (size_t)(row0 + ai * HALF + m * 16) * ldc + col0;
#pragma unroll
                for (int bj = 0; bj < 2; ++bj) { const f32x4 v0 = acc[ai][bj][m][0], v1 = acc[ai][bj][m][1];
                    u32x4 w; w.x = cvt_pk_bf16(v0[0], v0[1]); w.y = cvt_pk_bf16(v0[2], v0[3]); w.z = cvt_pk_bf16(v1[0], v1[1]); w.w = cvt_pk_bf16(v1[2], v1[3]);
                    *(u32x4*)(rowp + bj * HALF) = w; } }
    }
};
struct EpiSwiGLU {
    static constexpr bool PERM = true, AFTER_DRAIN = false;
    bf16_t* G; const float* rstd;
    __device__ __forceinline__ void operator()(const f32x4 (&acc)[2][2][4][2], const Unit& u, int wr, int wc, int fr, int fq) const {
        const int row0 = u.pm * BM + wr * 64 + fr, col0 = u.pn * HALF + wc * 32 + 8 * fq;
        float sr[2][4];
#pragma unroll
        for (int ai = 0; ai < 2; ++ai)
#pragma unroll
            for (int m = 0; m < 4; ++m) sr[ai][m] = rstd[row0 + ai * HALF + m * 16];
#pragma unroll
        for (int ai = 0; ai < 2; ++ai)
#pragma unroll
            for (int m = 0; m < 4; ++m) { const int r = row0 + ai * HALF + m * 16; const float s = sr[ai][m]; float o[8];
#pragma unroll
                for (int n = 0; n < 2; ++n)
#pragma unroll
                    for (int j = 0; j < 4; ++j) { const float gt = acc[ai][0][m][n][j] * s, up = acc[ai][1][m][n][j] * s; o[n * 4 + j] = gt * __builtin_amdgcn_rcpf(1.0f + __expf(-gt)) * up; }
                u32x4 w; w.x = cvt_pk_bf16(o[0], o[1]); w.y = cvt_pk_bf16(o[2], o[3]); w.z = cvt_pk_bf16(o[4], o[5]); w.w = cvt_pk_bf16(o[6], o[7]);
                *(u32x4*)(G + (size_t)r * DFF + col0) = w; }
    }
};
struct EpiPle {
    static constexpr bool PERM = true, AFTER_DRAIN = false;
    const bf16_t* X; const bf16_t* Tt; bf16_t* XB; float* OUT;
    __device__ __forceinline__ void operator()(const f32x4 (&acc)[2][2][4][2], const Unit& u, int wr, int wc, int fr, int fq) const {
        const int row0 = u.pm * BM + wr * 64 + fr, col0 = u.pn * BM + wc * 32 + 8 * fq;
        u32x4 tv[2][2], xv[2][2];
#define PLE_LOAD(slot, grp) do { const size_t off_ = (size_t)(row0 + ((grp) >> 2) * HALF + ((grp) & 3) * 16) * D + col0; _Pragma("unroll") for (int bj_ = 0; bj_ < 2; ++bj_) { \
            tv[slot][bj_] = *(const u32x4*)(Tt + off_ + bj_ * HALF); xv[slot][bj_] = *(const u32x4*)(X + off_ + bj_ * HALF); } } while (0)
        PLE_LOAD(0, 0);
#pragma unroll
        for (int grp = 0; grp < 8; ++grp) { const int ai = grp >> 2, m = grp & 3, sl = grp & 1; const size_t off = (size_t)(row0 + ai * HALF + m * 16) * D + col0;
            if (grp + 1 < 8) PLE_LOAD((grp + 1) & 1, grp + 1);
#pragma unroll
            for (int bj = 0; bj < 2; ++bj) { const unsigned tw[4] = {tv[sl][bj].x, tv[sl][bj].y, tv[sl][bj].z, tv[sl][bj].w}, xw[4] = {xv[sl][bj].x, xv[sl][bj].y, xv[sl][bj].z, xv[sl][bj].w}; f32x4 x0, x1;
#pragma unroll
                for (int j = 0; j < 4; ++j) { const float t0 = __builtin_bit_cast(float, (j & 1) ? (tw[j >> 1] & 0xffff0000u) : (tw[j >> 1] << 16));
                    const float t1 = __builtin_bit_cast(float, (j & 1) ? (tw[2 + (j >> 1)] & 0xffff0000u) : (tw[2 + (j >> 1)] << 16));
                    const float a0 = __builtin_bit_cast(float, (j & 1) ? (xw[j >> 1] & 0xffff0000u) : (xw[j >> 1] << 16));
                    const float a1 = __builtin_bit_cast(float, (j & 1) ? (xw[2 + (j >> 1)] & 0xffff0000u) : (xw[2 + (j >> 1)] << 16));
                    x0[j] = a0 + __builtin_amdgcn_rcpf(1.0f + __expf(-acc[ai][bj][m][0][j])) * t0; x1[j] = a1 + __builtin_amdgcn_rcpf(1.0f + __expf(-acc[ai][bj][m][1][j])) * t1; }
                if (OUT) { *(f32x4*)(OUT + off + bj * HALF) = x0; *(f32x4*)(OUT + off + bj * HALF + 4) = x1; }
                else { u32x4 w; w.x = cvt_pk_bf16(x0[0], x0[1]); w.y = cvt_pk_bf16(x0[2], x0[3]); w.z = cvt_pk_bf16(x1[0], x1[1]); w.w = cvt_pk_bf16(x1[2], x1[3]);
                    *(u32x4*)(XB + off + bj * HALF) = w; } } }
#undef PLE_LOAD
    }
};
}

__device__ __forceinline__ unsigned ord_key(float f) { const unsigned u = __builtin_bit_cast(unsigned, f); return (u & 0x80000000u) ? ~u : (u | 0x80000000u); }
#define LAS __attribute__((address_space(3)))
#define XB_TMO      128
#define XB_XCNT(j)  (256  + 64 * (j))
#define XB_XSUB(j)  (1280 + 64 * (j))
#define XB_XGEN(j)  (2304 + 64 * (j))
#define XB_TOP      3328
#define XB_TOPGEN   3392
#define XCD_BAR_WORDS 3456
#define XB_SPIN_CAP (1u << 18)

__device__ __forceinline__ unsigned xb_ld(unsigned* p)              { return __hip_atomic_load(p, __ATOMIC_RELAXED, __HIP_MEMORY_SCOPE_AGENT); }
__device__ __forceinline__ unsigned xb_add(unsigned* p, unsigned v) { return __hip_atomic_fetch_add(p, v, __ATOMIC_RELAXED, __HIP_MEMORY_SCOPE_AGENT); }
__device__ __forceinline__ unsigned xb_xcc_id() { return (unsigned)__builtin_amdgcn_s_getreg((3 << 11) | 20) & 0xFu; }
#define XB_SPIN(cond, bar) do { unsigned _sp = 0; while (cond) { __builtin_amdgcn_s_sleep(1); \
    if ((++_sp & 255u) == 0u) { if (xb_ld(&(bar)[XB_TMO])) break; if (_sp > XB_SPIN_CAP) { atomicAdd(&(bar)[XB_TMO], 1u); break; } } } } while (0)

struct XcdBarrier {
    unsigned* bar; unsigned x;
    volatile LAS unsigned* st;
};

__device__ __forceinline__ XcdBarrier xcd_barrier_post(unsigned* bar, volatile LAS unsigned* st) {
    XcdBarrier b; b.bar = bar; b.x = xb_xcc_id(); b.st = st;
    if (threadIdx.x == 0) (void)xb_add(&bar[XB_XCNT(b.x)], 1u);
    return b;
}
__device__ __forceinline__ void xcd_barrier_complete(unsigned* bar, unsigned x, unsigned& nloc, unsigned& nx) {
    const unsigned G = gridDim.x * gridDim.y * gridDim.z;
    unsigned sum, cnt, mine, sp = 0u;
    for (;;) {
        sum = 0u; cnt = 0u; mine = 0u;
#pragma unroll
        for (unsigned j = 0; j < 16; ++j) { const unsigned c = xb_ld(&bar[XB_XCNT(j)]); sum += c; cnt += (c > 0u) ? 1u : 0u; mine = (j == x) ? c : mine; }
        if (sum == G) break;
        __builtin_amdgcn_s_sleep(1);
        if ((++sp & 255u) == 0u) { if (xb_ld(&bar[XB_TMO])) break; if (sp > XB_SPIN_CAP) { atomicAdd(&bar[XB_TMO], 1u); break; } }
    }
    nloc = mine > 0u ? mine : 1u; nx = cnt > 0u ? cnt : 1u;
}

__device__ __forceinline__ void xcd_barrier(const XcdBarrier& b, int tid_in) {
    asm volatile("s_waitcnt vmcnt(0)" ::: "memory");
    __syncthreads();
    if (tid_in == 0) {
        unsigned* bar = b.bar;
        __builtin_amdgcn_s_waitcnt(0);
        unsigned nloc = b.st[0], nx = b.st[1];
        if (nloc == 0u) { xcd_barrier_complete(bar, b.x, nloc, nx); b.st[0] = nloc; b.st[1] = nx; }
        const unsigned old = xb_add(&bar[XB_XSUB(b.x)], 1u);
        const unsigned gen = old / nloc;
        if (old + 1u == (gen + 1u) * nloc) {
            __builtin_amdgcn_fence(__ATOMIC_RELEASE, "agent");
            asm volatile("s_waitcnt vmcnt(0)" ::: "memory");
            const unsigned og = xb_add(&bar[XB_TOP], 1u);
            const unsigned tg = og / nx;
            if (og + 1u == (tg + 1u) * nx) xb_add(&bar[XB_TOPGEN], 1u);
            else XB_SPIN(xb_ld(&bar[XB_TOPGEN]) == tg, bar);
            __builtin_amdgcn_fence(__ATOMIC_ACQUIRE, "agent");
            xb_add(&bar[XB_XGEN(b.x)], 1u);
            asm volatile("s_waitcnt vmcnt(0)" ::: "memory");
        } else {
            XB_SPIN(xb_ld(&bar[XB_XGEN(b.x)]) == gen, bar);
            __builtin_amdgcn_fence(__ATOMIC_ACQUIRE, "agent");
            asm volatile("s_waitcnt vmcnt(0)" ::: "memory");
        }
    }
    __syncthreads();
}


constexpr int NTHR = 512, NWAVES = 8;
constexpr int RING_BYTES = 131072, LDS_BYTES = 147456, MISC_OFF = LDS_BYTES - 512;
constexpr int CW_BAR = 4096, CW_RANK = 8192;
constexpr size_t CTL_ZERO_BYTES = 1 * MiB;
constexpr int NPH = 14;

__device__ __forceinline__ int mk_tid(int wave_s) { int l_; asm volatile("v_mbcnt_lo_u32_b32 %0, -1, 0\n\tv_mbcnt_hi_u32_b32 %0, -1, %0" : "=v"(l_)); return wave_s * 64 + l_; }
struct Params { const float* in[26]; float* out; unsigned char* ws; int ph_lo, ph_hi, dbl_mask, pad; };
static_assert(sizeof(Params) == 26 * 8 + 8 + 8 + 16, "no padding");

#define LDSP __attribute__((address_space(3)))
#define LDS_WAIT() asm volatile("s_waitcnt lgkmcnt(0)" ::: "memory")
#ifndef NAIVE_SELECT
#define NAIVE_SELECT 0
#endif
#ifndef NAIVE_ATTN
#define NAIVE_ATTN 0
#endif
#ifndef NAIVE_SSM
#define NAIVE_SSM 0
#endif
#ifndef DBG_SSM
#define DBG_SSM 0
#endif
#ifndef TIMING
#define TIMING 0
#endif
#ifndef DBL_MASK
#define DBL_MASK 0
#endif
#ifndef GEMM_DRYK
#define GEMM_DRYK 0
#endif
#ifndef CLK_PROBE
#define CLK_PROBE 0
#endif
#ifndef XTRA_BAR
#define XTRA_BAR 0
#endif
#ifndef ATT_SUB_V
#define ATT_SUB_V 0
#endif
#ifndef TIMING_SHIFT
#define TIMING_SHIFT 0.0f
#endif
#ifndef TIMING_A
#define TIMING_A 2
#endif
#ifndef TIMING_B
#define TIMING_B 3
#endif

template <int MODE> __device__ __forceinline__ void ph_prep_w(LDSP float* scr, const float* __restrict__ W, const float* __restrict__ W2, int K, int Nsrc, const float* __restrict__ gain, bf16* __restrict__ Wt, int Ndst, int gw, int NGW, int lane) {
    const int ntn = Ndst / 32, nt = ntn * (K / 64), tx = lane & 31, ty = lane >> 5;
    for (int it = gw; it < nt; it += NGW) {
        const int n0 = (it % ntn) * 32, k0 = (it / ntn) * 64, n = n0 + tx; int src; const float* Ws = W;
        if (MODE == 0) src = n; else if (MODE == 1) src = src_col_in(n); else { const int which = (n & 255) >> 7; src = (n >> 8) * 128 + (n & 127); Ws = which ? W2 : W; }
#pragma unroll 8
        for (int i = 0; i < 32; ++i) { const int kk = 2 * i + ty; float v = 0.f; if (src >= 0) { v = Ws[(size_t)(k0 + kk) * Nsrc + src]; if (gain) v *= gain[k0 + kk]; } scr[kk * 33 + tx] = v; }
        LDS_WAIT(); asm volatile("" ::: "memory");
        const int cc = lane & 7;
#pragma unroll
        for (int j = 0; j < 4; ++j) { const int nn = (lane >> 3) + 8 * j; const LDSP float* s = scr + (8 * cc) * 33 + nn;
            u32x4 o; o.x = pk2(s[0 * 33], s[1 * 33]); o.y = pk2(s[2 * 33], s[3 * 33]); o.z = pk2(s[4 * 33], s[5 * 33]); o.w = pk2(s[6 * 33], s[7 * 33]);
            *(u32x4*)(Wt + (size_t)(n0 + nn) * K + k0 + 8 * cc) = o; }
        LDS_WAIT(); asm volatile("" ::: "memory");
    }
}
__device__ __forceinline__ void row_x_prep(const float* __restrict__ x, bf16* __restrict__ xb, float* __restrict__ rstd, int row, int lane) {
    const f32x4* xr = (const f32x4*)(x + (size_t)row * D) + lane; float ss = 0.f; f32x4 v[4];
#pragma unroll
    for (int j = 0; j < 4; ++j) { v[j] = xr[64 * j]; ss += (v[j].x * v[j].x + v[j].y * v[j].y) + (v[j].z * v[j].z + v[j].w * v[j].w); }
    ss = wave_sum(ss);
    if (xb) { u32x2* o = (u32x2*)(xb + (size_t)row * D) + lane;
#pragma unroll
        for (int j = 0; j < 4; ++j) { u32x2 w; w.x = pk2(v[j].x, v[j].y); w.y = pk2(v[j].z, v[j].w); o[64 * j] = w; } }
    if (lane == 0) rstd[row] = 1.0f / sqrtf(ss * (1.0f / D) + EPS);
}
__device__ __forceinline__ void row_resid_norm(const float* xin, const float* __restrict__ y, const float* __restrict__ g, float* xo, bf16* __restrict__ xb, float* __restrict__ rstd_out, const float* __restrict__ p, bf16* __restrict__ pb, int row, int lane, bool dry = false) {
    const f32x4* yr = (const f32x4*)(y + (size_t)row * D) + lane; const f32x4* xr = (const f32x4*)(xin + (size_t)row * D) + lane; const f32x4* gr = (const f32x4*)g + lane;
    f32x4 v[4]; float ss = 0.f;
#pragma unroll
    for (int j = 0; j < 4; ++j) { v[j] = yr[64 * j]; ss += (v[j].x * v[j].x + v[j].y * v[j].y) + (v[j].z * v[j].z + v[j].w * v[j].w); }
    const float r = 1.0f / sqrtf(wave_sum(ss) * (1.0f / D) + EPS);
    float s2 = 0.f;
    f32x4* xor_ = (f32x4*)(xo + (size_t)row * D) + lane; u32x2* o = (u32x2*)(xb + (size_t)row * D) + lane;
#pragma unroll
    for (int j = 0; j < 4; ++j) { const f32x4 xx = xr[64 * j], gg = gr[64 * j]; f32x4 w = xx + v[j] * r * gg; if (!dry) xor_[64 * j] = w; s2 += (w.x * w.x + w.y * w.y) + (w.z * w.z + w.w * w.w);
        u32x2 q; q.x = pk2(w.x, w.y); q.y = pk2(w.z, w.w); o[64 * j] = q; }
    if (rstd_out) { s2 = wave_sum(s2); if (lane == 0) rstd_out[row] = 1.0f / sqrtf(s2 * (1.0f / D) + EPS); }
    if (p) { const f32x4 pv = *((const f32x4*)(p + (size_t)row * PLE) + lane); u32x2 q; q.x = pk2(pv.x, pv.y); q.y = pk2(pv.z, pv.w); *((u32x2*)(pb + (size_t)row * PLE) + lane) = q; }
}

__device__ __forceinline__ void row_resid_norm2(const bf16* xin, const bf16* __restrict__ y, const float* __restrict__ g, bf16* xo, float* __restrict__ rstd_out, const float* __restrict__ p, bf16* __restrict__ pb, int row0, int lane, bool dry = false) {
    f32x4 v[2][4], xx[2][4], pv[2]; const f32x4* gr = (const f32x4*)g + lane;
#pragma unroll
    for (int r = 0; r < 2; ++r) { const u32x2* yr = (const u32x2*)(y + (size_t)(row0 + r) * D) + lane; const u32x2* xr = (const u32x2*)(xin + (size_t)(row0 + r) * D) + lane;
#pragma unroll
        for (int j = 0; j < 4; ++j) { const u32x2 yw = yr[64 * j], xw = xr[64 * j];
            v[r][j] = (f32x4){__builtin_bit_cast(float, yw.x << 16), __builtin_bit_cast(float, yw.x & 0xffff0000u), __builtin_bit_cast(float, yw.y << 16), __builtin_bit_cast(float, yw.y & 0xffff0000u)};
            xx[r][j] = (f32x4){__builtin_bit_cast(float, xw.x << 16), __builtin_bit_cast(float, xw.x & 0xffff0000u), __builtin_bit_cast(float, xw.y << 16), __builtin_bit_cast(float, xw.y & 0xffff0000u)}; }
        if (p) pv[r] = *((const f32x4*)(p + (size_t)(row0 + r) * PLE) + lane); }
    f32x4 gg[4];
#pragma unroll
    for (int j = 0; j < 4; ++j) gg[j] = gr[64 * j];
#pragma unroll
    for (int r = 0; r < 2; ++r) { float ss = 0.f;
#pragma unroll
        for (int j = 0; j < 4; ++j) ss += (v[r][j].x * v[r][j].x + v[r][j].y * v[r][j].y) + (v[r][j].z * v[r][j].z + v[r][j].w * v[r][j].w);
        const float rr = 1.0f / sqrtf(wave_sum(ss) * (1.0f / D) + EPS); float s2 = 0.f;
        u32x2* o = (u32x2*)(xo + (size_t)(row0 + r) * D) + lane;
#pragma unroll
        for (int j = 0; j < 4; ++j) { const f32x4 w = xx[r][j] + v[r][j] * rr * gg[j]; u32x2 q; q.x = pk2(w.x, w.y); q.y = pk2(w.z, w.w); if (!dry) o[64 * j] = q;
            const float r0 = __builtin_bit_cast(float, q.x << 16), r1 = __builtin_bit_cast(float, q.x & 0xffff0000u), r2 = __builtin_bit_cast(float, q.y << 16), r3 = __builtin_bit_cast(float, q.y & 0xffff0000u);
            s2 += (r0 * r0 + r1 * r1) + (r2 * r2 + r3 * r3); }
        if (rstd_out) { s2 = wave_sum(s2); if (lane == 0) rstd_out[row0 + r] = 1.0f / sqrtf(s2 * (1.0f / D) + EPS); }
        if (p) { u32x2 q; q.x = pk2(pv[r].x, pv[r].y); q.y = pk2(pv[r].z, pv[r].w); *((u32x2*)(pb + (size_t)(row0 + r) * PLE) + lane) = q; } }
}
__device__ __forceinline__ void row_rstd_bf16(const bf16* __restrict__ xb, float* __restrict__ rstd, int row, int lane) {
    const u32x2* xr = (const u32x2*)(xb + (size_t)row * D) + lane; float ss = 0.f;
#pragma unroll
    for (int j = 0; j < 4; ++j) { const u32x2 w = xr[64 * j]; const float a = __builtin_bit_cast(float, w.x << 16), b = __builtin_bit_cast(float, w.x & 0xffff0000u), c2 = __builtin_bit_cast(float, w.y << 16), d = __builtin_bit_cast(float, w.y & 0xffff0000u); ss += (a * a + b * b) + (c2 * c2 + d * d); }
    ss = wave_sum(ss); if (lane == 0) rstd[row] = 1.0f / sqrtf(ss * (1.0f / D) + EPS);
}
__device__ __forceinline__ void wave_gnorm4(bf16* RA, const float* __restrict__ nw, int w0, int lane, bool dry = false) {
    u32x4 v[4]; float ss[4];
#pragma unroll
    for (int i = 0; i < 4; ++i) { const int w = w0 + i, t = w >> 1, g = w & 1; v[i] = *(const u32x4*)(RA + (size_t)t * NA + A_Z + g * 512 + lane * 8); }
    float f[4][8];
#pragma unroll
    for (int i = 0; i < 4; ++i) { const unsigned vw[4] = {v[i].x, v[i].y, v[i].z, v[i].w}; ss[i] = 0.f;
#pragma unroll
        for (int e = 0; e < 8; ++e) { f[i][e] = bf2f((bf16)((vw[e >> 1] >> ((e & 1) * 16)) & 0xffff)); ss[i] += f[i][e] * f[i][e]; } }
#pragma unroll
    for (int o = 1; o < 64; o <<= 1) {
#pragma unroll
        for (int i = 0; i < 4; ++i) ss[i] += __shfl_xor(ss[i], o); }
#pragma unroll
    for (int i = 0; i < 4; ++i) { const int w = w0 + i, t = w >> 1, g = w & 1; const float r = 1.0f / sqrtf(ss[i] * (1.0f / 512.0f) + EPS); const float* gw = nw + g * 512 + lane * 8;
        u32x4 o; o.x = pk2(f[i][0] * r * gw[0], f[i][1] * r * gw[1]); o.y = pk2(f[i][2] * r * gw[2], f[i][3] * r * gw[3]); o.z = pk2(f[i][4] * r * gw[4], f[i][5] * r * gw[5]); o.w = pk2(f[i][6] * r * gw[6], f[i][7] * r * gw[7]);
        if (!dry) *(u32x4*)(RA + (size_t)t * NA + A_Z + g * 512 + lane * 8) = o; }
}
__device__ __forceinline__ void tok_m1(bf16* __restrict__ RA, bf16* __restrict__ RB, bf16* __restrict__ CKVC, bf16* __restrict__ IKC, const float* __restrict__ kvn, const float* __restrict__ ikg, const float* __restrict__ ikb, const float* __restrict__ scw, int t, int lane) {
    const int s = t & (SEQ - 1); bf16* rb = RB + (size_t)t * NB;
    {   const u32x2 w = *((const u32x2*)(rb + B_CKV) + lane); float v[4] = {bf2f((bf16)(w.x & 0xffff)), bf2f((bf16)(w.x >> 16)), bf2f((bf16)(w.y & 0xffff)), bf2f((bf16)(w.y >> 16))};
        float ss = (v[0] * v[0] + v[1] * v[1]) + (v[2] * v[2] + v[3] * v[3]); ss = wave_sum(ss); const float r = 1.0f / sqrtf(ss * (1.0f / KV_R) + EPS);
        const f32x4 g = *((const f32x4*)kvn + lane); u32x2 o; o.x = pk2(v[0] * r * g.x, v[1] * r * g.y); o.y = pk2(v[2] * r * g.z, v[3] * r * g.w); *((u32x2*)(rb + B_CKV) + lane) = o; *((u32x2*)(CKVC + (size_t)t * KV_R) + lane) = o; }
    {   const float x = bf2f(rb[B_IK + lane]); const float mu = wave_sum(x) * (1.0f / 64.0f); const float d = x - mu; const float var = wave_sum(d * d) * (1.0f / 64.0f);
        const bf16 o = f2bf(d * (1.0f / sqrtf(var + EPS)) * ikg[lane] + ikb[lane]); rb[B_IK + lane] = o; IKC[(size_t)t * 64 + lane] = o; }
    {   const int c = lane * 8; float acc[8] = {0.f, 0.f, 0.f, 0.f, 0.f, 0.f, 0.f, 0.f};
        for (int j = 0; j < 3; ++j) { const int ss_ = s - 2 + j; if (ss_ < 0) continue; const bf16* rr = RB + (size_t)(t - 2 + j) * NB;
            const u32x4 cg = *(const u32x4*)(rr + B_CG + c), hb = *(const u32x4*)(rr + B_HB + c); const unsigned cw[4] = {cg.x, cg.y, cg.z, cg.w}, hw[4] = {hb.x, hb.y, hb.z, hb.w};
#pragma unroll
            for (int e = 0; e < 8; ++e) { const float a = bf2f((bf16)((cw[e >> 1] >> ((e & 1) * 16)) & 0xffff)), b = bf2f((bf16)((hw[e >> 1] >> ((e & 1) * 16)) & 0xffff)); acc[e] += scw[j * 512 + c + e] * (a * b); } }
        bf16* ra = RA + (size_t)t * NA + A_BG + c; const u32x4 bg = *(const u32x4*)ra; const unsigned bw[4] = {bg.x, bg.y, bg.z, bg.w}; float o[8];
#pragma unroll
        for (int e = 0; e < 8; ++e) o[e] = bf2f((bf16)((bw[e >> 1] >> ((e & 1) * 16)) & 0xffff)) * acc[e];
        u32x4 w; w.x = pk2(o[0], o[1]); w.y = pk2(o[2], o[3]); w.z = pk2(o[4], o[5]); w.w = pk2(o[6], o[7]); *(u32x4*)ra = w; }
}
__device__ __forceinline__ void tok_m4a(const bf16* __restrict__ RB, const float* __restrict__ cw, const float* __restrict__ cb, const float* __restrict__ dtb, bf16* __restrict__ XA, float* __restrict__ DT, int t, int lane) {
    const int s = t & (SEQ - 1);
    for (int c = lane; c < XBC; c += 64) { float a = cb[c];
#pragma unroll
        for (int j = 0; j < 4; ++j) { const int ss = s - 3 + j; if (ss >= 0) a += cw[j * XBC + c] * bf2f(RB[(size_t)(t - 3 + j) * NB + B_XBC + c]); }
        XA[(size_t)t * XBC + c] = f2bf(siluf_(a)); }
    if (lane < 16) { const float x = bf2f(RB[(size_t)t * NB + B_DT + lane]) + dtb[lane]; DT[(size_t)t * 16 + lane] = x > 15.f ? x : log1pf(__expf(x)); }
}
__device__ __forceinline__ void wg_m2_select(LDSP unsigned char* lds, const bf16* __restrict__ RB, unsigned short* __restrict__ idx, int t, int tid) {
    LDSP float* iq = (LDSP float*)lds; LDSP float* iwv = iq + 256; LDSP unsigned* red = (LDSP unsigned*)(iq + 272); LDSP unsigned* keys = (LDSP unsigned*)(iq + 288);
    const int s = t & (SEQ - 1), b = t >> 12, lane = tid & 63, wv = tid >> 6;
    const int nk = ((s >> 6) + 1) << 6;
    const bf16* rb = RB + (size_t)t * NB;
    if (tid < 256) iq[tid] = bf2f(rb[B_IQ + tid]); if (tid < 4) iwv[tid] = bf2f(rb[B_IW + tid]) * (0.125f * 0.5f);
    __syncthreads();
    for (int k = tid; k < nk; k += NTHR) {
        const bf16* kr = RB + (size_t)(b * SEQ + k) * NB + B_IK; float sc = 0.f;
        float d0 = 0.f, d1 = 0.f, d2 = 0.f, d3 = 0.f;
#pragma unroll 1
        for (int j = 0; j < 8; ++j) { const u32x4 w = *((const u32x4*)kr + j); const unsigned ww[4] = {w.x, w.y, w.z, w.w};
#pragma unroll
            for (int e = 0; e < 8; ++e) { const float kv = bf2f((bf16)((ww[e >> 1] >> ((e & 1) * 16)) & 0xffff)); const int c = j * 8 + e;
                d0 += iq[c] * kv; d1 += iq[64 + c] * kv; d2 += iq[128 + c] * kv; d3 += iq[192 + c] * kv; } }
        sc += fmaxf(d0, 0.f) * iwv[0]; sc += fmaxf(d1, 0.f) * iwv[1]; sc += fmaxf(d2, 0.f) * iwv[2]; sc += fmaxf(d3, 0.f) * iwv[3];
        keys[k] = ord_key(sc);
    }
    __syncthreads();
    unsigned Tt = 0u;
    if (nk > TOPK) {
        for (int bit = 31; bit >= 0; --bit) { const unsigned cand = Tt | (1u << bit); unsigned c = 0;
            for (int k = tid; k < nk; k += NTHR) c += (keys[k] >= cand) ? 1u : 0u;
#pragma unroll
            for (int o = 1; o < 64; o <<= 1) c += __shfl_xor(c, o);
            if (lane == 0) red[wv] = c;
            __syncthreads();
            unsigned tot = 0;
#pragma unroll
            for (int w = 0; w < 8; ++w) tot += red[w];
            if (tot >= (unsigned)TOPK) Tt = cand;
            __syncthreads(); }
    }
    { unsigned c = 0; for (int k = tid; k < nk; k += NTHR) c += (keys[k] > Tt) ? 1u : 0u;
#pragma unroll
      for (int o = 1; o < 64; o <<= 1) c += __shfl_xor(c, o);
      if (lane == 0) red[8 + wv] = c; }
    __syncthreads();
    if (wv == 0) {
        int ngt = 0;
#pragma unroll
        for (int w = 0; w < 8; ++w) ngt += (int)red[8 + w];
        const int need = TOPK - ngt; int pos = 0, eq_taken = 0; const unsigned long long lt = (1ull << lane) - 1ull;
        for (int base = 0; base < nk; base += 64) { const unsigned k = keys[base + lane]; const bool gt = k > Tt, eq = (k == Tt);
            const unsigned long long meq = __ballot(eq); const int rank_eq = __popcll(meq & lt); const bool take = gt || (eq && (eq_taken + rank_eq < need));
            const unsigned long long msel = __ballot(take);
            if (take) { const int o = pos + __popcll(msel & lt); if (o < TOPK) idx[(size_t)t * TOPK + o] = (unsigned short)(base + lane); }
            pos += __popcll(msel); eq_taken += __popcll(__ballot(eq && take)); }
    }
    __syncthreads();
}
__device__ __forceinline__ void wg_m3_attn(LDSP unsigned char* lds, bf16* RA, const bf16* __restrict__ RB, const unsigned short* __restrict__ idx, const float* __restrict__ w_uk, const float* __restrict__ w_uv, const float* __restrict__ rel_bias, int t, int tid) {
    LDSP float* q = (LDSP float*)lds; LDSP float* qlat = q + 512; LDSP float* pr = qlat + 2048; LDSP float* outl = pr + 2048; LDSP unsigned short* sel = (LDSP unsigned short*)(outl + 2048);
    const int s = t & (SEQ - 1), b = t >> 12, lane = tid & 63, wv = tid >> 6;
    const int nk = ((s >> 6) + 1) << 6, nsel = nk < TOPK ? nk : TOPK;
    q[tid] = bf2f(RA[(size_t)t * NA + A_Q + tid]); if (tid < 256) sel[tid] = tid < nsel ? idx[(size_t)t * TOPK + tid] : (unsigned short)0;
    __syncthreads();
    {   const int r = tid & 255, h0 = (tid >> 8) * 4;
        for (int h = h0; h < h0 + 4; ++h) { const float* w = w_uk + ((size_t)r * 8 + h) * 64; float a = 0.f;
#pragma unroll 16
            for (int d = 0; d < 64; ++d) a += q[h * 64 + d] * w[d];
            qlat[h * 256 + r] = a * 0.125f; } }
    __syncthreads();
    {   const int k = tid & 255, h0 = (tid >> 8) * 4;
        if (k < nsel) { const int key = sel[k]; const bf16* kr = RB + (size_t)(b * SEQ + key) * NB + B_CKV; float a[4] = {0.f, 0.f, 0.f, 0.f};
            for (int j = 0; j < 32; ++j) { const u32x4 w = *((const u32x4*)kr + j); const unsigned ww[4] = {w.x, w.y, w.z, w.w};
#pragma unroll
                for (int e = 0; e < 8; ++e) { const float v = bf2f((bf16)((ww[e >> 1] >> ((e & 1) * 16)) & 0xffff));
#pragma unroll
                    for (int hh = 0; hh < 4; ++hh) a[hh] += qlat[(h0 + hh) * 256 + j * 8 + e] * v; } }
            const int bk = t5_bucket(key - s);
#pragma unroll
            for (int hh = 0; hh < 4; ++hh) pr[(h0 + hh) * 256 + k] = a[hh] + rel_bias[bk * 8 + h0 + hh];
        } else {
#pragma unroll
            for (int hh = 0; hh < 4; ++hh) pr[(h0 + hh) * 256 + k] = -INFINITY; } }
    __syncthreads();
    {   float v[4]; float m = -INFINITY;
#pragma unroll
        for (int j = 0; j < 4; ++j) { v[j] = pr[wv * 256 + lane + 64 * j]; m = fmaxf(m, v[j]); }
        m = wave_max(m); float sum = 0.f;
#pragma unroll
        for (int j = 0; j < 4; ++j) { v[j] = __expf(v[j] - m); sum += v[j]; }
        sum = wave_sum(sum); const float inv = 1.0f / sum;
#pragma unroll
        for (int j = 0; j < 4; ++j) pr[wv * 256 + lane + 64 * j] = v[j] * inv; }
    __syncthreads();
    {   const int r = tid & 255, h0 = (tid >> 8) * 4; float a[4] = {0.f, 0.f, 0.f, 0.f};
        for (int k = 0; k < nsel; ++k) { const float v = bf2f(RB[(size_t)(b * SEQ + sel[k]) * NB + B_CKV + r]);
#pragma unroll
            for (int hh = 0; hh < 4; ++hh) a[hh] += pr[(h0 + hh) * 256 + k] * v; }
#pragma unroll
        for (int hh = 0; hh < 4; ++hh) outl[(h0 + hh) * 256 + r] = a[hh]; }
    __syncthreads();
    {   const int h = tid >> 6, d = tid & 63; float a = 0.f;
        for (int r = 0; r < 256; ++r) a += outl[h * 256 + r] * w_uv[((size_t)r * 8 + h) * 64 + d];
        RA[(size_t)t * NA + A_Q + tid] = f2bf(a); }
    __syncthreads();
}
__device__ __forceinline__ void half_m4b_scan(bf16* RA, const bf16* __restrict__ XA, const float* __restrict__ DT, const float* __restrict__ a_log, const float* __restrict__ dsk, int b, int h, int tid) {
    const int g = h >> 3, p = tid >> 2, nq = tid & 3;
    const float A = -__expf(a_log[h]), Dh = dsk[h];
    float hs[32];
#pragma unroll
    for (int n = 0; n < 32; ++n) hs[n] = 0.f;
    for (int s = 0; s < SEQ; ++s) { const size_t t = (size_t)b * SEQ + s; const float dt = DT[t * 16 + h]; const float dA = __expf(dt * A);
        const bf16* xr = XA + t * XBC; const float x = bf2f(xr[h * 64 + p]); const float dx = dt * x;
        const u32x4* Bp = (const u32x4*)(xr + 1024 + g * 128 + nq * 32); const u32x4* Cp = (const u32x4*)(xr + 1280 + g * 128 + nq * 32); float y = 0.f;
#pragma unroll
        for (int j = 0; j < 4; ++j) { const u32x4 bw = Bp[j], cw = Cp[j]; const unsigned bb[4] = {bw.x, bw.y, bw.z, bw.w}, cc[4] = {cw.x, cw.y, cw.z, cw.w};
#pragma unroll
            for (int e = 0; e < 8; ++e) { const float Bv = bf2f((bf16)((bb[e >> 1] >> ((e & 1) * 16)) & 0xffff)), Cv = bf2f((bf16)((cc[e >> 1] >> ((e & 1) * 16)) & 0xffff));
                hs[j * 8 + e] = hs[j * 8 + e] * dA + dx * Bv; y += Cv * hs[j * 8 + e]; } }
        y += __shfl_xor(y, 1); y += __shfl_xor(y, 2);
        if (nq == 0) { bf16* zp = RA + t * NA + A_Z + h * 64 + p; const float z = bf2f(*zp); *zp = f2bf((y + Dh * x) * siluf_(z)); }
    }
}
__device__ __forceinline__ void wave_m4c_gnorm(bf16* RA, const float* __restrict__ nw, int w, int lane, bool dry = false) {
    const int t = w >> 1, g = w & 1;
    bf16* p = RA + (size_t)t * NA + A_Z + g * 512 + lane * 8; const u32x4 v = *(const u32x4*)p; const unsigned vw[4] = {v.x, v.y, v.z, v.w}; float f[8]; float ss = 0.f;
#pragma unroll
    for (int e = 0; e < 8; ++e) { f[e] = bf2f((bf16)((vw[e >> 1] >> ((e & 1) * 16)) & 0xffff)); ss += f[e] * f[e]; }
    const float r = 1.0f / sqrtf(wave_sum(ss) * (1.0f / 512.0f) + EPS); const float* gw = nw + g * 512 + lane * 8;
    u32x4 o; o.x = pk2(f[0] * r * gw[0], f[1] * r * gw[1]); o.y = pk2(f[2] * r * gw[2], f[3] * r * gw[3]); o.z = pk2(f[4] * r * gw[4], f[5] * r * gw[5]); o.w = pk2(f[6] * r * gw[6], f[7] * r * gw[7]);
    if (!dry) *(u32x4*)p = o;
}

__device__ __forceinline__ void unpack8(const u32x4 w, float (&f)[8]) { const unsigned ww[4] = {w.x, w.y, w.z, w.w};
#pragma unroll
    for (int e = 0; e < 4; ++e) { f[2 * e] = __builtin_bit_cast(float, ww[e] << 16); f[2 * e + 1] = __builtin_bit_cast(float, ww[e] & 0xffff0000u); } }
__device__ __forceinline__ void prep_ckv4(const bf16* __restrict__ RB, bf16* __restrict__ CKVC, const float* __restrict__ kvn, int it, int lane) {
    const int t = it * 4 + (lane >> 4), c = lane & 15; const u32x4* src = (const u32x4*)(RB + (size_t)t * NB + B_CKV + c * 16); const u32x4 a = src[0], b = src[1];
    float v[16]; { float f[8]; unpack8(a, f);
#pragma unroll
        for (int e = 0; e < 8; ++e) v[e] = f[e]; unpack8(b, f);
#pragma unroll
        for (int e = 0; e < 8; ++e) v[8 + e] = f[e]; }
    float ss = 0.f;
#pragma unroll
    for (int e = 0; e < 16; ++e) ss += v[e] * v[e];
    ss += __shfl_xor(ss, 1); ss += __shfl_xor(ss, 2); ss += __shfl_xor(ss, 4); ss += __shfl_xor(ss, 8);
    const float r = 1.0f / sqrtf(ss * (1.0f / KV_R) + EPS); const f32x4* gp = (const f32x4*)(kvn + c * 16); float o[16];
#pragma unroll
    for (int q = 0; q < 4; ++q) { const f32x4 gg = gp[q]; o[4 * q] = v[4 * q] * r * gg.x; o[4 * q + 1] = v[4 * q + 1] * r * gg.y; o[4 * q + 2] = v[4 * q + 2] * r * gg.z; o[4 * q + 3] = v[4 * q + 3] * r * gg.w; }
    u32x4 w0, w1; w0.x = pk2(o[0], o[1]); w0.y = pk2(o[2], o[3]); w0.z = pk2(o[4], o[5]); w0.w = pk2(o[6], o[7]); w1.x = pk2(o[8], o[9]); w1.y = pk2(o[10], o[11]); w1.z = pk2(o[12], o[13]); w1.w = pk2(o[14], o[15]);
    u32x4* dst = (u32x4*)(CKVC + (size_t)t * KV_R + c * 16); dst[0] = w0; dst[1] = w1;
}
__device__ __forceinline__ void prep_ik16(const bf16* __restrict__ RB, bf16* __restrict__ IKC, const float* __restrict__ ikg, const float* __restrict__ ikb, int it, int lane) {
    const int t = it * 16 + (lane >> 2), c = lane & 3; const u32x4* src = (const u32x4*)(RB + (size_t)t * NB + B_IK + c * 16); const u32x4 a = src[0], b = src[1];
    float v[16]; { float f[8]; unpack8(a, f);
#pragma unroll
        for (int e = 0; e < 8; ++e) v[e] = f[e]; unpack8(b, f);
#pragma unroll
        for (int e = 0; e < 8; ++e) v[8 + e] = f[e]; }
    float s = 0.f;
#pragma unroll
    for (int e = 0; e < 16; ++e) s += v[e];
    s += __shfl_xor(s, 1); s += __shfl_xor(s, 2); const float mu = s * (1.0f / 64.0f); float q2 = 0.f;
#pragma unroll
    for (int e = 0; e < 16; ++e) { v[e] -= mu; q2 += v[e] * v[e]; }
    q2 += __shfl_xor(q2, 1); q2 += __shfl_xor(q2, 2); const float r = 1.0f / sqrtf(q2 * (1.0f / 64.0f) + EPS); float o[16];
#pragma unroll
    for (int e = 0; e < 16; ++e) o[e] = v[e] * r * ikg[c * 16 + e] + ikb[c * 16 + e];
    u32x4 w0, w1; w0.x = pk2(o[0], o[1]); w0.y = pk2(o[2], o[3]); w0.z = pk2(o[4], o[5]); w0.w = pk2(o[6], o[7]); w1.x = pk2(o[8], o[9]); w1.y = pk2(o[10], o[11]); w1.z = pk2(o[12], o[13]); w1.w = pk2(o[14], o[15]);
    u32x4* dst = (u32x4*)(IKC + (size_t)t * 64 + c * 16); dst[0] = w0; dst[1] = w1;
}
__device__ __forceinline__ void prep_bout(bf16* RA, const bf16* __restrict__ RB, const float* __restrict__ scw, int t, int lane, bool dry = false) {
    const int s = t & (SEQ - 1), c = lane * 8; float acc[8] = {0.f, 0.f, 0.f, 0.f, 0.f, 0.f, 0.f, 0.f};
    u32x4 cg[3], hb[3];
#pragma unroll
    for (int j = 0; j < 3; ++j) { const bool ok = (s - 2 + j) >= 0; const bf16* rr = RB + (size_t)(t - 2 + j) * NB; cg[j] = ok ? *(const u32x4*)(rr + B_CG + c) : (u32x4){0u, 0u, 0u, 0u}; hb[j] = ok ? *(const u32x4*)(rr + B_HB + c) : (u32x4){0u, 0u, 0u, 0u}; }
    bf16* ra = RA + (size_t)t * NA + A_BG + c; const u32x4 bg = *(const u32x4*)ra;
#pragma unroll
    for (int j = 0; j < 3; ++j) { float a[8], b[8]; unpack8(cg[j], a); unpack8(hb[j], b); const f32x4 w0 = *(const f32x4*)(scw + j * 512 + c), w1 = *(const f32x4*)(scw + j * 512 + c + 4);
        acc[0] += w0.x * (a[0] * b[0]); acc[1] += w0.y * (a[1] * b[1]); acc[2] += w0.z * (a[2] * b[2]); acc[3] += w0.w * (a[3] * b[3]);
        acc[4] += w1.x * (a[4] * b[4]); acc[5] += w1.y * (a[5] * b[5]); acc[6] += w1.z * (a[6] * b[6]); acc[7] += w1.w * (a[7] * b[7]); }
    float g8[8]; unpack8(bg, g8); u32x4 w; w.x = pk2(g8[0] * acc[0], g8[1] * acc[1]); w.y = pk2(g8[2] * acc[2], g8[3] * acc[3]); w.z = pk2(g8[4] * acc[4], g8[5] * acc[5]); w.w = pk2(g8[6] * acc[6], g8[7] * acc[7]);
    if (!dry) *(u32x4*)ra = w;
}
__device__ __forceinline__ void prep_conv(const bf16* __restrict__ RB, bf16* __restrict__ XA, const float* __restrict__ cw, const float* __restrict__ cb, int it, int lane) {
    const int rb = it / 12, cbk = it % 12, xcol = cbk * 128 + 2 * lane, t0 = rb * 16, s0 = t0 & (SEQ - 1);
    float w0[4], w1[4];
#pragma unroll
    for (int j = 0; j < 4; ++j) { w0[j] = cw[j * XBC + xcol]; w1[j] = cw[j * XBC + xcol + 1]; }
    const float cb0 = cb[xcol], cb1 = cb[xcol + 1];
    const bf16* src = RB + (size_t)(t0 - 3) * NB + B_XBC + xcol; unsigned raw[19];
#pragma unroll
    for (int i = 0; i < 19; ++i) raw[i] = (s0 - 3 + i >= 0) ? *(const unsigned*)(src + (size_t)i * NB) : 0u;
#pragma unroll
    for (int i = 0; i < 16; ++i) { float a0 = cb0, a1 = cb1;
#pragma unroll
        for (int j = 0; j < 4; ++j) { a0 += w0[j] * __builtin_bit_cast(float, raw[i + j] << 16); a1 += w1[j] * __builtin_bit_cast(float, raw[i + j] & 0xffff0000u); }
        *(unsigned*)(XA + (size_t)(t0 + i) * XBC + xcol) = pk2(siluf_(a0), siluf_(a1)); }
}

typedef short bf16x8_t __attribute__((ext_vector_type(8)));
#ifndef SEL_REP_SEARCH
#define SEL_REP_SEARCH 1
#endif
#ifndef SEL_REP_STAGE
#define SEL_REP_STAGE 1
#endif
constexpr int SC_STRIDE = 516, SC_BUF = 16 * SC_STRIDE;
constexpr int IKW_OFF = 66560;
__device__ __forceinline__ void wg_select16(LDSP unsigned char* lds, const bf16* __restrict__ RB, const bf16* __restrict__ IKC, unsigned short* __restrict__ idx, int unit, int tid, bool dry = false) {
    const int lane = tid & 63, wave = __builtin_amdgcn_readfirstlane(tid >> 6), g = lane >> 4, c = lane & 15;
    const int b = unit >> 8, qg = unit & 255, t0 = b * SEQ + qg * 16, nk = ((qg >> 2) + 1) << 6, nr = nk >> 6;
    LDSP unsigned* SC = (LDSP unsigned*)lds;
    bf16x8_t bq[4][2]; float iwq[4];
    { const bf16* qr = RB + (size_t)(t0 + c) * NB;
#pragma unroll
      for (int h = 0; h < 4; ++h) { bq[h][0] = *(const bf16x8_t*)(qr + B_IQ + h * 64 + g * 8); bq[h][1] = *(const bf16x8_t*)(qr + B_IQ + h * 64 + 32 + g * 8); iwq[h] = bf2f(qr[B_IW + h]) * 0.0625f; } }
    unsigned val[2][64];
#pragma unroll
    for (int r = 0; r < 64; ++r) { val[0][r] = 0u; val[1][r] = 0u; }
    const bf16* ikb = IKC + (size_t)b * SEQ * 64;
    LDSP unsigned char* ikw = lds + IKW_OFF + wave * 8192;
#define IK_DMA(stage) do { if ((stage) * 512 + wave * 64 < nk) { const bf16* src_ = ikb + (size_t)((stage) * 512 + wave * 64) * 64 + lane * 8; _Pragma("unroll") for (int pc_ = 0; pc_ < 8; ++pc_) \
        __builtin_amdgcn_global_load_lds((const unsigned*)(src_ + pc_ * 512), (LDSP unsigned*)(ikw + pc_ * 1024), 16, 0, 0); } } while (0)
    IK_DMA(0);
    for (int rep_st = 0; rep_st < SEL_REP_STAGE; ++rep_st) {
    if (rep_st > 0) { asm volatile("s_waitcnt vmcnt(0)" ::: "memory"); __builtin_amdgcn_s_barrier(); IK_DMA(0); }
#pragma unroll
    for (int s = 0; s < 8; ++s) {
        if (s * 512 < nk) {
            LDSP unsigned* buf = SC + (s & 1) * SC_BUF;
            asm volatile("s_waitcnt vmcnt(0)" ::: "memory");
            bf16x8_t af[4][2];
#pragma unroll
            for (int i = 0; i < 4; ++i) { af[i][0] = *(const LDSP bf16x8_t*)(ikw + (16 * i + c) * 128 + g * 16); af[i][1] = *(const LDSP bf16x8_t*)(ikw + (16 * i + c) * 128 + 64 + g * 16); }
            asm volatile("s_waitcnt lgkmcnt(0)" ::: "memory");
            if (s < 7) IK_DMA(s + 1);
#pragma unroll
            for (int i = 0; i < 4; ++i) { const int tl = wave * 4 + i, kb = s * 512 + tl * 16;
                if (kb < nk) {
                    const bf16x8_t a0 = af[i][0], a1 = af[i][1];
                    float sc[4] = {0.f, 0.f, 0.f, 0.f};
#pragma unroll
                    for (int h = 0; h < 4; ++h) { pg8::f32x4 acc = {0.f, 0.f, 0.f, 0.f};
                        acc = __builtin_amdgcn_mfma_f32_16x16x32_bf16(a0, bq[h][0], acc, 0, 0, 0); acc = __builtin_amdgcn_mfma_f32_16x16x32_bf16(a1, bq[h][1], acc, 0, 0, 0);
#pragma unroll
                        for (int e = 0; e < 4; ++e) sc[e] += fmaxf(acc[e], 0.f) * iwq[h]; }
                    u32x4 kv; kv.x = ord_key(sc[0]); kv.y = ord_key(sc[1]); kv.z = ord_key(sc[2]); kv.w = ord_key(sc[3]);
                    *(LDSP u32x4*)(buf + c * SC_STRIDE + tl * 16 + 4 * g) = kv; } }
            asm volatile("s_waitcnt lgkmcnt(0)" ::: "memory"); __builtin_amdgcn_s_barrier(); asm volatile("" ::: "memory");
#pragma unroll
            for (int j = 0; j < 8; ++j) if (s * 512 + j * 64 < nk) { val[0][s * 8 + j] = buf[(2 * wave) * SC_STRIDE + j * 64 + lane]; val[1][s * 8 + j] = buf[(2 * wave + 1) * SC_STRIDE + j * 64 + lane]; }
            asm volatile("s_waitcnt lgkmcnt(0)" ::: "memory");
        }
    }
    }
    const unsigned long long lt = (1ull << lane) - 1ull;
#pragma unroll
    for (int qq = 0; qq < 2; ++qq) {
        unsigned Tt = 0u;
        for (int rep_se = 0; rep_se < SEL_REP_SEARCH; ++rep_se) { Tt = 0u; asm volatile("" : "+v"(val[qq][0]));
        if (nk > TOPK) {
            for (int bit = 31; bit >= 0; --bit) { const unsigned cand = Tt | (1u << bit); int cnt = 0;
#pragma unroll
                for (int r8 = 0; r8 < 8; ++r8) if (r8 * 8 < nr) {
#pragma unroll
                    for (int r = r8 * 8; r < r8 * 8 + 8; ++r) cnt += __popcll(__ballot(val[qq][r] >= cand)); }
                if (cnt >= TOPK) Tt = cand; if (cnt == TOPK) break; }
        }
        }
        int ngt = 0;
#pragma unroll
        for (int r8 = 0; r8 < 8; ++r8) if (r8 * 8 < nr) {
#pragma unroll
            for (int r = r8 * 8; r < r8 * 8 + 8; ++r) ngt += __popcll(__ballot(val[qq][r] > Tt)); }
        const int need = TOPK - ngt; int pos = 0, eq_taken = 0;
        unsigned short* orow = idx + (size_t)(t0 + 2 * wave + qq) * TOPK;
#pragma unroll
        for (int r = 0; r < 64; ++r) if (r < nr) { const unsigned k = val[qq][r]; const bool gt = k > Tt, eq = (k == Tt);
            const unsigned long long meq = __ballot(eq); const int rank_eq = __popcll(meq & lt); const bool take = gt || (eq && (eq_taken + rank_eq < need));
            const unsigned long long msel = __ballot(take);
            if (take) { const int o = pos + __popcll(msel & lt); if (o < TOPK && !dry) orow[o] = (unsigned short)(r * 64 + lane); }
            pos += __popcll(msel); eq_taken += __popcll(__ballot(eq && take)); }
    }
    asm volatile("s_waitcnt vmcnt(0)" ::: "memory"); __builtin_amdgcn_s_barrier();
#undef IK_DMA
}

typedef unsigned short u16x4_t __attribute__((ext_vector_type(4)));
#ifndef ATT_LOCAL_DRY
#define ATT_LOCAL_DRY 0
#endif
#ifndef ATT_STAGGER
#define ATT_STAGGER 0
#endif
#ifndef ATT_DRY_SKIP
#define ATT_DRY_SKIP 0
#endif
#define DSK(b) (ATT_DRY_SKIP & (b)) && dry
#ifndef ATT_SUB_EN
#define ATT_SUB_EN 0
#endif
constexpr int SELW_OFF = 134 * 1024, BT_OFF = 142 * 1024, KVP = 528, TILE_STRIDE = 32 * KVP;
constexpr int SELW_OFF_OLD = 132 * 1024, BT_OFF_OLD = 140 * 1024;
__device__ __forceinline__ int kv_off(int row, int ch) { const int hf = ch >> 4, c16 = ch & 15; return hf * 8192 + 256 * row + 16 * (c16 ^ (((row & 3) << 2) | ((row >> 2) & 3))); }
#define TR4I(d0, d1, d2, d3, base, o0, o1, o2, o3) asm volatile("ds_read_b64_tr_b16 %0, %4 offset:%5\n\tds_read_b64_tr_b16 %1, %4 offset:%6\n\tds_read_b64_tr_b16 %2, %4 offset:%7\n\tds_read_b64_tr_b16 %3, %4 offset:%8" \
    : "=&v"(d0), "=&v"(d1), "=&v"(d2), "=&v"(d3) : "v"(base), "i"(o0), "i"(o1), "i"(o2), "i"(o3) : "memory")
#define TR8N(d0, d1, d2, d3, d4, d5, d6, d7, base, o0, o1, o2, o3, o4, o5, o6, o7) asm volatile( \
    "ds_read_b64_tr_b16 %0, %8 offset:%9\n\tds_read_b64_tr_b16 %1, %8 offset:%10\n\tds_read_b64_tr_b16 %2, %8 offset:%11\n\tds_read_b64_tr_b16 %3, %8 offset:%12\n\t" \
    "ds_read_b64_tr_b16 %4, %8 offset:%13\n\tds_read_b64_tr_b16 %5, %8 offset:%14\n\tds_read_b64_tr_b16 %6, %8 offset:%15\n\tds_read_b64_tr_b16 %7, %8 offset:%16" \
    : "=&v"(d0), "=&v"(d1), "=&v"(d2), "=&v"(d3), "=&v"(d4), "=&v"(d5), "=&v"(d6), "=&v"(d7) : "v"(base), "i"(o0), "i"(o1), "i"(o2), "i"(o3), "i"(o4), "i"(o5), "i"(o6), "i"(o7) : "memory")
#define WAITPIN8(n, d0, d1, d2, d3, d4, d5, d6, d7) asm volatile("s_waitcnt lgkmcnt(" #n ")" : "+v"(d0), "+v"(d1), "+v"(d2), "+v"(d3), "+v"(d4), "+v"(d5), "+v"(d6), "+v"(d7) :: "memory")
#define WAITPIN4(n, d0, d1, d2, d3) asm volatile("s_waitcnt lgkmcnt(" #n ")" : "+v"(d0), "+v"(d1), "+v"(d2), "+v"(d3) :: "memory")
__device__ __forceinline__ bf16x8_t mk8a(u16x4_t a, u16x4_t b) { bf16x8_t r; r[0] = a[0]; r[1] = a[1]; r[2] = a[2]; r[3] = a[3]; r[4] = b[0]; r[5] = b[1]; r[6] = b[2]; r[7] = b[3]; return r; }
#define TR8I(d0, d1, d2, d3, d4, d5, d6, d7, base, o0, o1, o2, o3, o4, o5, o6, o7) asm volatile( \
    "ds_read_b64_tr_b16 %0, %8 offset:%9\n\tds_read_b64_tr_b16 %1, %8 offset:%10\n\tds_read_b64_tr_b16 %2, %8 offset:%11\n\tds_read_b64_tr_b16 %3, %8 offset:%12\n\t" \
    "ds_read_b64_tr_b16 %4, %8 offset:%13\n\tds_read_b64_tr_b16 %5, %8 offset:%14\n\tds_read_b64_tr_b16 %6, %8 offset:%15\n\tds_read_b64_tr_b16 %7, %8 offset:%16\n\ts_waitcnt lgkmcnt(0)" \
    : "=&v"(d0), "=&v"(d1), "=&v"(d2), "=&v"(d3), "=&v"(d4), "=&v"(d5), "=&v"(d6), "=&v"(d7) : "v"(base), "i"(o0), "i"(o1), "i"(o2), "i"(o3), "i"(o4), "i"(o5), "i"(o6), "i"(o7) : "memory")
#define TR8(d0, d1, d2, d3, d4, d5, d6, d7, a0, a1, a2, a3, a4, a5, a6, a7) asm volatile( \
    "ds_read_b64_tr_b16 %0, %8\n\tds_read_b64_tr_b16 %1, %9\n\tds_read_b64_tr_b16 %2, %10\n\tds_read_b64_tr_b16 %3, %11\n\t" \
    "ds_read_b64_tr_b16 %4, %12\n\tds_read_b64_tr_b16 %5, %13\n\tds_read_b64_tr_b16 %6, %14\n\tds_read_b64_tr_b16 %7, %15\n\ts_waitcnt lgkmcnt(0)" \
    : "=&v"(d0), "=&v"(d1), "=&v"(d2), "=&v"(d3), "=&v"(d4), "=&v"(d5), "=&v"(d6), "=&v"(d7) : "v"(a0), "v"(a1), "v"(a2), "v"(a3), "v"(a4), "v"(a5), "v"(a6), "v"(a7) : "memory")
__device__ __forceinline__ void wg_attn16(LDSP unsigned char* lds, bf16* RA, const bf16* __restrict__ CKVC, const unsigned short* __restrict__ idx, const bf16* __restrict__ WUK, const bf16* __restrict__ WUV,
                                          const float* __restrict__ rel_bias, int unit, int nxt_unit, int par, bool first, int tid, bool dry = false) {
    const int lane = tid & 63, wave = __builtin_amdgcn_readfirstlane(tid >> 6), g = lane >> 4, c = lane & 15;
    const int b = unit >> 9, qg = unit & 511, t0 = b * SEQ + qg * 8, nk = ((qg >> 3) + 1) << 6, nsel = nk < TOPK ? nk : TOPK, ntile = nsel >> 5;
    LDSP unsigned char* QL = lds;
    LDSP unsigned char* tile = lds + wave * TILE_STRIDE;
    LDSP unsigned short* selw = (LDSP unsigned short*)(lds + SELW_OFF + (par * 8 + wave) * 512);
    LDSP unsigned short* selw_n = (LDSP unsigned short*)(lds + SELW_OFF + ((par ^ 1) * 8 + wave) * 512);
    if (first) { if (lane < 32) *((LDSP u32x4*)selw + lane) = *((const u32x4*)(idx + (size_t)(t0 + wave) * TOPK) + lane); }
    const bf16* kvb = CKVC + (size_t)b * SEQ * KV_R + g * 8;
    bf16x8_t kv0[8], kv1[8];
#define KV_LOAD(dst, key) do { const bf16* rp_ = kvb + (size_t)(key) * KV_R; _Pragma("unroll") for (int ks_ = 0; ks_ < 8; ++ks_) dst[ks_] = *(const bf16x8_t*)(rp_ + ks_ * 32); } while (0)
    int ka = (int)selw[c], kb = (int)selw[16 + c];
    KV_LOAD(kv0, ka); KV_LOAD(kv1, kb);
    {   const int h = wave; const bf16* qr = RA + (size_t)(t0 + (c & 7)) * NA + A_Q + h * 64 + g * 8;
        const bf16x8_t b0 = *(const bf16x8_t*)qr, b1 = *(const bf16x8_t*)(qr + 32);
        const bf16* wb = WUK + ((size_t)h * 256 + c) * 64 + g * 8;
#pragma unroll 4
        for (int rt = 0; rt < 16; ++rt) { const bf16x8_t a0 = *(const bf16x8_t*)(wb + rt * 16 * 64), a1 = *(const bf16x8_t*)(wb + rt * 16 * 64 + 32);
            pg8::f32x4 acc = {0.f, 0.f, 0.f, 0.f};
            acc = __builtin_amdgcn_mfma_f32_16x16x32_bf16(a0, b0, acc, 0, 0, 0); acc = __builtin_amdgcn_mfma_f32_16x16x32_bf16(a1, b1, acc, 0, 0, 0);
            u32x2 w; w.x = pk2(acc[0], acc[1]); w.y = pk2(acc[2], acc[3]);
            if (c < 8) *(LDSP u32x2*)(QL + (((c * 8 + h) * 256) + rt * 16 + 4 * g) * 2) = w; }
    }
    asm volatile("s_waitcnt lgkmcnt(0)" ::: "memory"); __builtin_amdgcn_s_barrier(); asm volatile("" ::: "memory");
    bf16x8_t qf[8];
#pragma unroll
    for (int ks = 0; ks < 8; ++ks) qf[ks] = *(const LDSP bf16x8_t*)(QL + (((wave * 8 + (c & 7)) * 256) + ks * 32 + g * 8) * 2);
    asm volatile("s_waitcnt lgkmcnt(0)" ::: "memory"); __builtin_amdgcn_s_barrier(); asm volatile("" ::: "memory");
    const unsigned tile_a = (unsigned)(size_t)tile;
#if ATT_STAGGER
    if (wave >= 4) __builtin_amdgcn_s_sleep(ATT_STAGGER);
#endif
    bf16x8_t bbf; { float bv[8];
#pragma unroll
        for (int j = 0; j < 8; ++j) bv[j] = rel_bias[(8 * g + j) * 8 + (c & 7)];
        u32x4 w; w.x = pk2(bv[0], bv[1]); w.y = pk2(bv[2], bv[3]); w.z = pk2(bv[4], bv[5]); w.w = pk2(bv[6], bv[7]); bbf = __builtin_bit_cast(bf16x8_t, w); }
    {
        const int spos = (qg * 8 + wave);
        pg8::f32x4 acc[16];
#pragma unroll
        for (int nt = 0; nt < 16; ++nt) acc[nt] = (pg8::f32x4){0.f, 0.f, 0.f, 0.f};
        float m_run = -INFINITY, l_run = 0.f;
#define ONEHOT(dst, key) do { const int rel_ = (key) - spos, n_ = rel_ < 0 ? -rel_ : rel_; \
            const int big_ = 8 + (n_ >= 15) + (n_ >= 27) + (n_ >= 50) + (n_ >= 91) + (n_ >= 166) + (n_ >= 305) + (n_ >= 559); \
            const int pos_ = (n_ < 8 ? n_ : big_) + (rel_ > 0 ? 16 : 0) - 8 * g; const unsigned one_ = (pos_ & 1) ? 0x3F800000u : 0x3F80u; const int hi_ = pos_ >> 1; \
            u32x4 w_; w_.x = (hi_ == 0) ? one_ : 0u; w_.y = (hi_ == 1) ? one_ : 0u; w_.z = (hi_ == 2) ? one_ : 0u; w_.w = (hi_ == 3) ? one_ : 0u; dst = __builtin_bit_cast(bf16x8_t, w_); } while (0)
        const int q4 = c >> 2, p = c & 3;
        const unsigned trb = tile_a + (4 * g + q4) * KVP + 8 * p;
        for (int tl = 0; tl < ntile; ++tl) {
            int kan = 0, kbn = 0; const bool more = tl + 1 < ntile;
            if (more) { kan = (int)selw[(2 * tl + 2) * 16 + c]; kbn = (int)selw[(2 * tl + 3) * 16 + c]; }
            bf16x8_t oha, ohb; ONEHOT(oha, ka); ONEHOT(ohb, kb);
            asm volatile("s_waitcnt vmcnt(8)" ::: "memory");
            pg8::f32x4 s0 = {0.f, 0.f, 0.f, 0.f}, s1 = {0.f, 0.f, 0.f, 0.f};
            s0 = __builtin_amdgcn_mfma_f32_16x16x32_bf16(oha, bbf, s0, 0, 0, 0);
#pragma unroll
            for (int ks = 0; ks < 8; ++ks) { s0 = __builtin_amdgcn_mfma_f32_16x16x32_bf16(kv0[ks], qf[ks], s0, 0, 0, 0); *(LDSP bf16x8_t*)(tile + c * KVP + g * 16 + ks * 64) = kv0[ks]; }
            if (more) KV_LOAD(kv0, kan);
            if (more) asm volatile("s_waitcnt vmcnt(8)" ::: "memory"); else asm volatile("s_waitcnt vmcnt(0)" ::: "memory");
            s1 = __builtin_amdgcn_mfma_f32_16x16x32_bf16(ohb, bbf, s1, 0, 0, 0);
#pragma unroll
            for (int ks = 0; ks < 8; ++ks) { s1 = __builtin_amdgcn_mfma_f32_16x16x32_bf16(kv1[ks], qf[ks], s1, 0, 0, 0); *(LDSP bf16x8_t*)(tile + (16 + c) * KVP + g * 16 + ks * 64) = kv1[ks]; }
            if (more) KV_LOAD(kv1, kbn);
            ka = kan; kb = kbn;
            float sv[8];
#pragma unroll
            for (int j = 0; j < 4; ++j) { sv[j] = s0[j]; sv[4 + j] = s1[j]; }
            float tmax = fmaxf(fmaxf(fmaxf(sv[0], sv[1]), fmaxf(sv[2], sv[3])), fmaxf(fmaxf(sv[4], sv[5]), fmaxf(sv[6], sv[7])));
            tmax = fmaxf(tmax, __shfl_xor(tmax, 16)); tmax = fmaxf(tmax, __shfl_xor(tmax, 32));
            const float m_new = fmaxf(m_run, tmax); const float scl = __expf(m_run - m_new); const bool grow = m_new > m_run; m_run = m_new;
            float ps = 0.f;
#pragma unroll
            for (int j = 0; j < 8; ++j) { sv[j] = __expf(sv[j] - m_new); ps += sv[j]; }
            l_run = l_run * scl + ps;
            bf16x8_t pf; { u32x4 w; w.x = pk2(sv[0], sv[1]); w.y = pk2(sv[2], sv[3]); w.z = pk2(sv[4], sv[5]); w.w = pk2(sv[6], sv[7]); pf = __builtin_bit_cast(bf16x8_t, w); }
            if (__builtin_amdgcn_ballot_w64(grow) != 0ull) {
                float rs[4];
#pragma unroll
                for (int e = 0; e < 4; ++e) rs[e] = __shfl(scl, 4 * g + e);
#pragma unroll
                for (int nt = 0; nt < 16; ++nt) {
#pragma unroll
                    for (int e = 0; e < 4; ++e) acc[nt][e] *= rs[e]; } }
            asm volatile("s_waitcnt lgkmcnt(0)" ::: "memory");
            u16x4_t va[8], vb[8];
            TR8N(va[0], va[1], va[2], va[3], va[4], va[5], va[6], va[7], trb, 0, 16 * KVP, 32, 32 + 16 * KVP, 64, 64 + 16 * KVP, 96, 96 + 16 * KVP);
            TR8N(vb[0], vb[1], vb[2], vb[3], vb[4], vb[5], vb[6], vb[7], trb, 128, 128 + 16 * KVP, 160, 160 + 16 * KVP, 192, 192 + 16 * KVP, 224, 224 + 16 * KVP);
            WAITPIN8(8, va[0], va[1], va[2], va[3], va[4], va[5], va[6], va[7]);
#pragma unroll
            for (int k = 0; k < 4; ++k) acc[k] = __builtin_amdgcn_mfma_f32_16x16x32_bf16(pf, mk8a(va[2 * k], va[2 * k + 1]), acc[k], 0, 0, 0);
            TR8N(va[0], va[1], va[2], va[3], va[4], va[5], va[6], va[7], trb, 256, 256 + 16 * KVP, 288, 288 + 16 * KVP, 320, 320 + 16 * KVP, 352, 352 + 16 * KVP);
            WAITPIN8(8, vb[0], vb[1], vb[2], vb[3], vb[4], vb[5], vb[6], vb[7]);
#pragma unroll
            for (int k = 0; k < 4; ++k) acc[4 + k] = __builtin_amdgcn_mfma_f32_16x16x32_bf16(pf, mk8a(vb[2 * k], vb[2 * k + 1]), acc[4 + k], 0, 0, 0);
            TR8N(vb[0], vb[1], vb[2], vb[3], vb[4], vb[5], vb[6], vb[7], trb, 384, 384 + 16 * KVP, 416, 416 + 16 * KVP, 448, 448 + 16 * KVP, 480, 480 + 16 * KVP);
            WAITPIN8(8, va[0], va[1], va[2], va[3], va[4], va[5], va[6], va[7]);
#pragma unroll
            for (int k = 0; k < 4; ++k) acc[8 + k] = __builtin_amdgcn_mfma_f32_16x16x32_bf16(pf, mk8a(va[2 * k], va[2 * k + 1]), acc[8 + k], 0, 0, 0);
            WAITPIN8(0, vb[0], vb[1], vb[2], vb[3], vb[4], vb[5], vb[6], vb[7]);
#pragma unroll
            for (int k = 0; k < 4; ++k) acc[12 + k] = __builtin_amdgcn_mfma_f32_16x16x32_bf16(pf, mk8a(vb[2 * k], vb[2 * k + 1]), acc[12 + k], 0, 0, 0);
        }
#undef KV_LOAD
#undef ONEHOT
        float lt = l_run + __shfl_xor(l_run, 16); lt += __shfl_xor(lt, 32); const float inv = 1.0f / lt;
        float ri[4];
#pragma unroll
        for (int e = 0; e < 4; ++e) ri[e] = __shfl(inv, 4 * g + e);
        if (g < 2) {
#pragma unroll
            for (int nt = 0; nt < 16; ++nt) { LDSP unsigned short* o1 = (LDSP unsigned short*)(tile) + (4 * g) * 256 + nt * 16 + c;
                o1[0] = f2bf(acc[nt][0] * ri[0]); o1[256] = f2bf(acc[nt][1] * ri[1]); o1[512] = f2bf(acc[nt][2] * ri[2]); o1[768] = f2bf(acc[nt][3] * ri[3]); }
        }
    }
    u32x4 nsel_v = {0u, 0u, 0u, 0u};
    if (nxt_unit >= 0 && lane < 32) { const int nb = nxt_unit >> 9, nq = nxt_unit & 511; nsel_v = *((const u32x4*)(idx + (size_t)(nb * SEQ + nq * 8 + wave) * TOPK) + lane); }
    asm volatile("s_waitcnt lgkmcnt(0)" ::: "memory"); __builtin_amdgcn_s_barrier(); asm volatile("" ::: "memory");
    {   const int h = wave; pg8::f32x4 o[4];
#pragma unroll
        for (int nt = 0; nt < 4; ++nt) o[nt] = (pg8::f32x4){0.f, 0.f, 0.f, 0.f};
        const LDSP unsigned char* ab = lds + TILE_STRIDE * (c & 7) + (h * 256 + g * 8) * 2;
        const bf16* wb = WUV + ((size_t)h * 64 + c) * 256 + g * 8;
#pragma unroll
        for (int ks = 0; ks < 8; ++ks) { const bf16x8_t a = *(const LDSP bf16x8_t*)(ab + ks * 64);
#pragma unroll
            for (int nt = 0; nt < 4; ++nt) { const bf16x8_t bw = *(const bf16x8_t*)(wb + (size_t)nt * 16 * 256 + ks * 32); o[nt] = __builtin_amdgcn_mfma_f32_16x16x32_bf16(a, bw, o[nt], 0, 0, 0); } }
        if (g < 2 && !dry) {
#pragma unroll
            for (int nt = 0; nt < 4; ++nt)
#pragma unroll
                for (int e = 0; e < 4; ++e) RA[(size_t)(t0 + 4 * g + e) * NA + A_Q + h * 64 + nt * 16 + c] = f2bf(o[nt][e]); }
    }
    if (nxt_unit >= 0 && lane < 32) *((LDSP u32x4*)selw_n + lane) = nsel_v;
    asm volatile("s_waitcnt lgkmcnt(0)" ::: "memory"); __builtin_amdgcn_s_barrier(); asm volatile("" ::: "memory");
}

#ifndef SSM_SPLIT_V
#define SSM_SPLIT_V 42
#endif
constexpr int SSM_SPLIT = SSM_SPLIT_V;
constexpr int XP = 144, BP = 272;
constexpr int SB_X = 0, SB_B = 8192, SB_C = 24576, SB_SIZE = 40960;
constexpr int L_XS = 2 * SB_SIZE, L_M = L_XS + 64 * XP, L_HC = L_M + 64 * XP, L_TB = L_HC + 2 * 64 * BP;
static_assert(L_TB + 2048 <= 140 * 1024, "ssm lds");
#define TR2(d0, d1, a0, a1) asm volatile("ds_read_b64_tr_b16 %0, %2\n\tds_read_b64_tr_b16 %1, %3\n\ts_waitcnt lgkmcnt(0)" : "=&v"(d0), "=&v"(d1) : "v"(a0), "v"(a1) : "memory")
__device__ __forceinline__ bf16x8_t mk8(u16x4_t a, u16x4_t b) { bf16x8_t r; r[0] = a[0]; r[1] = a[1]; r[2] = a[2]; r[3] = a[3]; r[4] = b[0]; r[5] = b[1]; r[6] = b[2]; r[7] = b[3]; return r; }
__device__ __forceinline__ int bc_off(int row, int ch) { return 256 * row + 16 * (ch ^ (((row & 3) << 2) | ((row >> 2) & 3))); }
__device__ __forceinline__ void ssm_dma(LDSP unsigned char* buf, const bf16* __restrict__ XA, int tc0, int h, int grp, int wave, int lane, bool full) {
    const int npc = full ? 40 : 24;
    for (int p = wave; p < npc; p += 8) {
        const bf16* src;
        if (p < 8) { const int row = 8 * p + (lane >> 3), ch = lane & 7; src = XA + (size_t)(tc0 + row) * XBC + h * 64 + ch * 8; }
        else { const int pp = (p - 8) & 15, row = 4 * pp + (lane >> 4), ch = (lane & 15) ^ (((row & 3) << 2) | ((row >> 2) & 3)); src = XA + (size_t)(tc0 + row) * XBC + (p < 24 ? 1024 : 1280) + grp * 128 + ch * 8; }
        __builtin_amdgcn_global_load_lds((const unsigned*)src, (LDSP unsigned*)(buf + 1024 * p), 16, 0, 0);
    }
}
__device__ __forceinline__ void wg_ssm_unit(LDSP unsigned char* lds, bf16* RA, const bf16* __restrict__ XA, const float* __restrict__ DTt,
                                            const float* __restrict__ a_log, const float* __restrict__ dsk, int unit, int tid, bf16* dbg_out = nullptr, bool dry = false) {
    const int lane = tid & 63, wave = __builtin_amdgcn_readfirstlane(tid >> 6), g = lane >> 4, c = lane & 15, q4 = c >> 2, p4 = c & 3;
    const int b = unit >> 5, h = (unit >> 1) & 15, seg = unit & 1, grp = h >> 3, pq = wave & 3, hf = wave >> 2;
    const float Dh = dsk[h];
    const unsigned lds_a = (unsigned)(size_t)lds;
    LDSP float* TB = (LDSP float*)(lds + L_TB);
    typedef float f32x2_t __attribute__((ext_vector_type(2)));
    const f32x2_t* dtp = (const f32x2_t*)DTt + (size_t)(b * 16 + h) * SEQ;
    pg8::f32x4 hacc[4];
#pragma unroll
    for (int nt = 0; nt < 4; ++nt) hacc[nt] = (pg8::f32x4){0.f, 0.f, 0.f, 0.f};
    for (int i = tid; i < (2 * 64 * BP) / 4; i += NTHR) ((LDSP unsigned*)(lds + L_HC))[i] = 0u;
    const int c_end = seg ? 64 : SSM_SPLIT;
    ssm_dma(lds, XA, b * SEQ, h, grp, wave, lane, seg == 0 || SSM_SPLIT == 0);
    f32x2_t dt_cur = dtp[lane];
    asm volatile("s_waitcnt vmcnt(0) lgkmcnt(0)" ::: "memory"); __builtin_amdgcn_s_barrier(); asm volatile("" ::: "memory");
    for (int ci = 0; ci < c_end; ++ci) {
        const bool full = (seg == 0) || (ci >= SSM_SPLIT);
        const int tc0 = b * SEQ + ci * 64;
        LDSP unsigned char* buf = lds + (ci & 1) * SB_SIZE;
        f32x2_t dt_nxt = {0.f, 0.f};
        if (ci + 1 < c_end) { ssm_dma(lds + ((ci + 1) & 1) * SB_SIZE, XA, tc0 + 64, h, grp, wave, lane, (seg == 0) || (ci + 1 >= SSM_SPLIT)); dt_nxt = dtp[(ci + 1) * 64 + lane]; }
        unsigned short zraw[8];
        if (full) {
#pragma unroll
            for (int k2 = 0; k2 < 2; ++k2)
#pragma unroll
                for (int e = 0; e < 4; ++e) zraw[k2 * 4 + e] = RA[(size_t)(tc0 + 16 * (2 * hf + k2) + 4 * g + e) * NA + A_Z + h * 64 + 16 * pq + c]; }
        {   const float dt = dt_cur.x, acs = dt_cur.y; const float tot = __builtin_bit_cast(float, __builtin_amdgcn_readlane(__builtin_bit_cast(int, acs), 63));
            TB[lane] = dt; TB[64 + lane] = acs; TB[128 + lane] = __expf(acs); TB[192 + lane] = __expf(tot - acs) * dt; if (lane == 0) TB[256] = __expf(tot); }
        asm volatile("s_waitcnt lgkmcnt(0)" ::: "memory");
        {   const int row = tid >> 3, ch = tid & 7; const u32x4 xv = *(const LDSP u32x4*)(buf + SB_X + row * 128 + ch * 16); const float wl = TB[192 + row]; const unsigned xw[4] = {xv.x, xv.y, xv.z, xv.w}; u32x4 o;
            o.x = pk2(__builtin_bit_cast(float, xw[0] << 16) * wl, __builtin_bit_cast(float, xw[0] & 0xffff0000u) * wl); o.y = pk2(__builtin_bit_cast(float, xw[1] << 16) * wl, __builtin_bit_cast(float, xw[1] & 0xffff0000u) * wl);
            o.z = pk2(__builtin_bit_cast(float, xw[2] << 16) * wl, __builtin_bit_cast(float, xw[2] & 0xffff0000u) * wl); o.w = pk2(__builtin_bit_cast(float, xw[3] << 16) * wl, __builtin_bit_cast(float, xw[3] & 0xffff0000u) * wl);
            *(LDSP u32x4*)(lds + L_XS + row * XP + ch * 16) = o; }
        if (full) {
            const int lt = wave >> 1;
#pragma unroll
            for (int k2 = 0; k2 < 2; ++k2) { const int st = 2 * (wave & 1) + k2; pg8::f32x4 ga = {0.f, 0.f, 0.f, 0.f};
#pragma unroll
                for (int ks = 0; ks < 4; ++ks) { const bf16x8_t af = *(const LDSP bf16x8_t*)(buf + SB_C + bc_off(16 * lt + c, 4 * ks + g)), bfm = *(const LDSP bf16x8_t*)(buf + SB_B + bc_off(16 * st + c, 4 * ks + g));
                    ga = __builtin_amdgcn_mfma_f32_16x16x32_bf16(af, bfm, ga, 0, 0, 0); }
                const int s = 16 * st + c; const float acs_s = TB[64 + s], dt_s = TB[s];
#pragma unroll
                for (int e = 0; e < 4; ++e) { const int l = 16 * lt + 4 * g + e; const float m = (s <= l) ? ga[e] * __expf(TB[64 + l] - acs_s) * dt_s : 0.f;
                    *(LDSP unsigned short*)(lds + L_M + l * XP + s * 2) = f2bf(m); } }
        }
        asm volatile("s_waitcnt lgkmcnt(0)" ::: "memory"); __builtin_amdgcn_s_barrier(); asm volatile("" ::: "memory");
        if (full) {
            pg8::f32x4 ya[2] = {{0.f, 0.f, 0.f, 0.f}, {0.f, 0.f, 0.f, 0.f}};
            const LDSP unsigned char* hcur = lds + L_HC + (ci & 1) * (64 * BP);
#pragma unroll
            for (int ks = 0; ks < 4; ++ks) { const bf16x8_t hb = *(const LDSP bf16x8_t*)(hcur + (16 * pq + c) * BP + (32 * ks + 8 * g) * 2);
#pragma unroll
                for (int k2 = 0; k2 < 2; ++k2) { const bf16x8_t af = *(const LDSP bf16x8_t*)(buf + SB_C + bc_off(16 * (2 * hf + k2) + c, 4 * ks + g)); ya[k2] = __builtin_amdgcn_mfma_f32_16x16x32_bf16(af, hb, ya[k2], 0, 0, 0); } }
#pragma unroll
            for (int k2 = 0; k2 < 2; ++k2)
#pragma unroll
                for (int e = 0; e < 4; ++e) ya[k2][e] *= TB[128 + 16 * (2 * hf + k2) + 4 * g + e];
#pragma unroll
            for (int ks = 0; ks < 2; ++ks) { u16x4_t x0, x1; const unsigned xa = lds_a + (ci & 1) * SB_SIZE + SB_X + (32 * ks + 8 * g + q4) * 128 + (16 * pq + 4 * p4) * 2; TR2(x0, x1, xa, xa + 4 * 128); const bf16x8_t xb = mk8(x0, x1);
#pragma unroll
                for (int k2 = 0; k2 < 2; ++k2) { const bf16x8_t mf = *(const LDSP bf16x8_t*)(lds + L_M + (16 * (2 * hf + k2) + c) * XP + (32 * ks + 8 * g) * 2); ya[k2] = __builtin_amdgcn_mfma_f32_16x16x32_bf16(mf, xb, ya[k2], 0, 0, 0); } }
#pragma unroll
            for (int k2 = 0; k2 < 2; ++k2)
#pragma unroll
                for (int e = 0; e < 4; ++e) { const int l = 16 * (2 * hf + k2) + 4 * g + e, pp = 16 * pq + c; const float x = bf2f(*(const LDSP unsigned short*)(buf + SB_X + l * 128 + pp * 2));
                    const float z = bf2f(zraw[k2 * 4 + e]); const bf16 uo = f2bf((ya[k2][e] + Dh * x) * siluf_(z));
                    if (dbg_out) dbg_out[(size_t)(tc0 + l) * 1024 + h * 64 + pp] = uo; else if (!dry) RA[(size_t)(tc0 + l) * NA + A_Z + h * 64 + pp] = uo; }
        }
        {   const float dec = TB[256];
#pragma unroll
            for (int nt = 0; nt < 4; ++nt)
#pragma unroll
                for (int e = 0; e < 4; ++e) hacc[nt][e] *= dec;
#pragma unroll
            for (int ks = 0; ks < 2; ++ks) { const int row = 32 * ks + 8 * g + q4; u16x4_t x0, x1; const unsigned xa = lds_a + L_XS + row * XP + (16 * pq + 4 * p4) * 2; TR2(x0, x1, xa, xa + 4 * XP); const bf16x8_t xf = mk8(x0, x1);
                u16x4_t v[8]; unsigned ad[8];
#pragma unroll
                for (int nt = 0; nt < 4; ++nt) { const int ch = 8 * hf + 2 * nt + (p4 >> 1); ad[2 * nt] = lds_a + (ci & 1) * SB_SIZE + SB_B + bc_off(row, ch) + 8 * (p4 & 1); ad[2 * nt + 1] = lds_a + (ci & 1) * SB_SIZE + SB_B + bc_off(row + 4, ch) + 8 * (p4 & 1); }
                TR8(v[0], v[1], v[2], v[3], v[4], v[5], v[6], v[7], ad[0], ad[1], ad[2], ad[3], ad[4], ad[5], ad[6], ad[7]);
#pragma unroll
                for (int nt = 0; nt < 4; ++nt) hacc[nt] = __builtin_amdgcn_mfma_f32_16x16x32_bf16(xf, mk8(v[2 * nt], v[2 * nt + 1]), hacc[nt], 0, 0, 0); }
            LDSP unsigned char* hnext = lds + L_HC + ((ci + 1) & 1) * (64 * BP);
#pragma unroll
            for (int nt = 0; nt < 4; ++nt)
#pragma unroll
                for (int e = 0; e < 4; ++e) *(LDSP unsigned short*)(hnext + (16 * pq + 4 * g + e) * BP + (64 * hf + 16 * nt + c) * 2) = f2bf(hacc[nt][e]);
        }
        dt_cur = dt_nxt;
        asm volatile("s_waitcnt vmcnt(0) lgkmcnt(0)" ::: "memory"); __builtin_amdgcn_s_barrier(); asm volatile("" ::: "memory");
    }
}

__global__ void __launch_bounds__(NTHR, 2) k_fwd(Params P) {
    extern __shared__ __attribute__((aligned(16))) unsigned char lds_raw[];
    LDSP unsigned char* lds = (LDSP unsigned char*)lds_raw;
    volatile LDSP unsigned* MISC = (volatile LDSP unsigned*)(lds + MISC_OFF);
    unsigned char* ws = P.ws;
    const int wave_s = __builtin_amdgcn_readfirstlane(threadIdx.x >> 6);
    for (int u = threadIdx.x; u < (LDS_BYTES - RING_BYTES) / 4; u += NTHR) ((LDSP unsigned*)(lds + RING_BYTES))[u] = 0u;
#define PHASE_IDS int tid = mk_tid(wave_s); int blk = blockIdx.x; asm volatile("" : "+s"(blk)); int G = gridDim.x; asm volatile("" : "+s"(G)); const int NGW = G * NWAVES; (void)NGW; const int lane = tid & 63, wave = __builtin_amdgcn_readfirstlane(tid >> 6), gw = blk * NWAVES + wave; (void)lane; (void)wave; (void)gw; const __attribute__((address_space(4))) char* kargs = (const __attribute__((address_space(4))) char*)__builtin_amdgcn_kernarg_segment_ptr(); asm volatile("" : "+s"(kargs)); int Lp = L; asm volatile("" : "+s"(Lp)); (void)Lp; unsigned char* ws = ((unsigned char* const __attribute__((address_space(4)))*)kargs)[27]; float* out = ((float* const __attribute__((address_space(4)))*)kargs)[26]; const float* x = KIN(0); const float* p = KIN(1); float* rstd = (float*)(ws + WS_RSTD); float* rstd2 = (float*)(ws + WS_RSTD2); float* DTb = (float*)(ws + WS_DT); bf16 *Win = (bf16*)(ws + WS_W_IN), *Wout = (bf16*)(ws + WS_W_OUT), *Wgu = (bf16*)(ws + WS_W_GU), *Wdown = (bf16*)(ws + WS_W_DOWN), *Wpg = (bf16*)(ws + WS_W_PG), *Wpp = (bf16*)(ws + WS_W_PP); bf16 *X0 = (bf16*)(ws + WS_X0), *X1 = (bf16*)(ws + WS_X1), *RA = (bf16*)(ws + WS_RA), *RB = (bf16*)(ws + WS_RB), *XA = (bf16*)out; unsigned short* IDX = (unsigned short*)((unsigned char*)out + 112 * MiB); bf16* CKVC = (bf16*)((unsigned char*)out + 96 * MiB); bf16* IKC = (bf16*)(ws + WS_IKC); bf16* WUK = (bf16*)(ws + WS_WUK); bf16* WUV = (bf16*)(ws + WS_WUV); (void)CKVC; (void)IKC; (void)WUK; (void)WUV; bf16* Xcur = (Lp == 0) ? X0 : X1; (void)out; (void)x; (void)p; (void)rstd; (void)rstd2; (void)DTb; (void)Win; (void)Wout; (void)Wgu; (void)Wdown; (void)Wpg; (void)Wpp; (void)X0; (void)X1; (void)RA; (void)RB; (void)XA; (void)IDX; (void)Xcur
    __syncthreads();
    if (TIMING && blockIdx.x == 0 && mk_tid(wave_s) == 0) { __hip_atomic_store((unsigned long long*)(P.ws + 32768), (unsigned long long)__builtin_amdgcn_s_memrealtime(), __ATOMIC_RELAXED, __HIP_MEMORY_SCOPE_AGENT); __hip_atomic_store((unsigned long long*)(P.ws + 32768) + 60, (unsigned long long)__builtin_amdgcn_s_memtime(), __ATOMIC_RELAXED, __HIP_MEMORY_SCOPE_AGENT); }
#if CLK_PROBE
    if (blockIdx.x == 0 && mk_tid(wave_s) == 0) { __hip_atomic_store((unsigned long long*)(P.ws + 49152), (unsigned long long)__builtin_amdgcn_s_memtime(), __ATOMIC_RELAXED, __HIP_MEMORY_SCOPE_AGENT); __hip_atomic_store((unsigned long long*)(P.ws + 49152) + 1, (unsigned long long)__builtin_amdgcn_s_memrealtime(), __ATOMIC_RELAXED, __HIP_MEMORY_SCOPE_AGENT); }
#endif
    const bool one_launch = (P.ph_hi - P.ph_lo) > 1;
    XcdBarrier bar; bar.bar = (unsigned*)(ws + WS_CTL) + CW_BAR; bar.x = 0; bar.st = nullptr;
    if (one_launch) bar = xcd_barrier_post((unsigned*)(ws + WS_CTL) + CW_BAR, (volatile LAS unsigned*)(MISC + 8));
    if (one_launch && mk_tid(wave_s) == 0) { const unsigned xid_ = xb_xcc_id(); MISC[16] = xid_; MISC[17] = __hip_atomic_fetch_add((unsigned*)(P.ws + WS_CTL) + CW_RANK + 64 * xid_, 1u, __ATOMIC_RELAXED, __HIP_MEMORY_SCOPE_AGENT); }

#ifndef PH_MASK
#define PH_MASK 0x3fff
#endif
#define PHASE_IDS_NOL const int L = 0; PHASE_IDS
#define NPASS(k) (((DBL_MASK >> (k)) & 1) ? ((Lp == 0 && ((P.dbl_mask >> (k)) & 1)) ? 2 : 1) : 1)
#define XCD_DEAL bool xok_ = false; int xb_ = 0, xr_ = 0, xn_ = 1; { if (tid == 0) { unsigned ok = (MISC[9] == 8u) ? 1u : 0u; unsigned sum = 0; for (int j = 0; j < 8; ++j) { const unsigned cj = __hip_atomic_load((unsigned*)(ws + WS_CTL) + CW_BAR + XB_XCNT(j), __ATOMIC_RELAXED, __HIP_MEMORY_SCOPE_AGENT); sum += cj; if (cj == 0u) ok = 0u; } if (sum != (unsigned)G) ok = 0u; MISC[18] = ok; } \
    __syncthreads(); xok_ = MISC[18] != 0u; xb_ = (int)MISC[16]; xr_ = (int)MISC[17]; xn_ = (int)MISC[8]; if (xn_ < 1) xn_ = 1; __syncthreads(); }
#define KIN(i) (((const float* const __attribute__((address_space(4)))*)kargs)[i])
#define IN(k) (P.ph_lo <= (k) && (k) < P.ph_hi && ((PH_MASK >> ((k) % NPH)) & 1))
#define SEAM(k) do { if (IN((k) + 1)) { XcdBarrier b2_ = bar; asm volatile("" : "+s"(b2_.bar)); xcd_barrier(b2_, mk_tid(wave_s)); } if (TIMING && blockIdx.x == 0 && mk_tid(wave_s) == 0) { __hip_atomic_store((unsigned long long*)(P.ws + 32768) + (k) + 1, (unsigned long long)__builtin_amdgcn_s_memrealtime(), __ATOMIC_RELAXED, __HIP_MEMORY_SCOPE_AGENT); } } while (0)
    for (int L = 0; L < DEPTH; ++L) {
        const int pb = L * NPH;
        if (IN(pb + 0)) { PHASE_IDS; for (int pass = NPASS(0); pass > 0; --pass) {
            LDSP float* scr = (LDSP float*)(lds + wave * 8704);
            ph_prep_w<1>(scr, KIN(6) + (size_t)Lp * D * INW, nullptr, D, INW, KIN(2) + (size_t)Lp * D, Win, NIN, gw, NGW, lane);
            ph_prep_w<0>(scr, KIN(20) + (size_t)Lp * MIXW * D, nullptr, MIXW, D, nullptr, Wout, D, gw, NGW, lane);
            ph_prep_w<2>(scr, KIN(21) + (size_t)Lp * D * DFF, KIN(22) + (size_t)Lp * D * DFF, D, DFF, KIN(4) + (size_t)Lp * D, Wgu, NGU, gw, NGW, lane);
            ph_prep_w<0>(scr, KIN(23) + (size_t)Lp * DFF * D, nullptr, DFF, D, nullptr, Wdown, D, gw, NGW, lane);
            ph_prep_w<0>(scr, KIN(25) + (size_t)Lp * D * D, nullptr, D, D, nullptr, Wpg, D, gw, NGW, lane);
            ph_prep_w<0>(scr, KIN(24) + (size_t)Lp * PLE * D, nullptr, PLE, D, nullptr, Wpp, D, gw, NGW, lane);
            {   const float* uk = KIN(10) + (size_t)Lp * 256 * 8 * 64; const float* uv = KIN(11) + (size_t)Lp * 256 * 8 * 64;
                for (int e = gw * 64 + lane; e < 8 * 256 * 64; e += NGW * 64) { const int h = e >> 14, r = (e >> 6) & 255, d = e & 63; WUK[e] = f2bf(0.125f * uk[((size_t)r * 8 + h) * 64 + d]); }
                for (int e = gw * 64 + lane; e < 8 * 64 * 256; e += NGW * 64) { const int h = e >> 14, d = (e >> 8) & 63, r = e & 255; WUV[e] = f2bf(uv[((size_t)r * 8 + h) * 64 + d]); } }
            if (Lp == 0) { for (int r = gw; r < T; r += NGW) row_x_prep(x, X0, rstd, r, lane); }
            else        { for (int r = gw; r < T; r += NGW) row_rstd_bf16(X1, rstd, r, lane); }
            }
            SEAM(pb + 0);
        }
#if XTRA_BAR
        if (P.ph_hi - P.ph_lo > 1 && L == 0) { for (int i_ = 0; i_ < XTRA_BAR; ++i_) { XcdBarrier b4_ = bar; asm volatile("" : "+s"(b4_.bar)); xcd_barrier(b4_, mk_tid(wave_s)); } }
#endif
        if (IN(pb + 1)) { PHASE_IDS; for (int pass = NPASS(1); pass > 0; --pass) {
            pg8::Gemm g{Xcur, Win, T, NIN, (GEMM_DRYK && pass > 1) ? GEMM_DRYK : D}; pg8::StaticOrder S; S.init(T, NIN, G, blk);
            pg8::EpiProj E{RA, RB, rstd};
            pg8::gemm_phase<pg8::EpiProj, pg8::StaticOrder, true, true>(lds, g, S, E, tid);
            }
            SEAM(pb + 1);
        }
        if (IN(pb + 2)) { PHASE_IDS;
            for (int pass = NPASS(2); pass > 0; --pass) {
#pragma unroll 2
            for (int it = gw; it < T / 4; it += NGW) prep_ckv4(RB, CKVC, KIN(7) + Lp * KV_R, it, lane);
            for (int it = gw; it < T / 16; it += NGW) prep_ik16(RB, IKC, KIN(8) + Lp * 64, KIN(9) + Lp * 64, it, lane);
#pragma unroll 2
            for (int t = gw; t < T; t += NGW) prep_bout(RA, RB, KIN(13) + (size_t)Lp * 3 * 512, t, lane, pass > 1);
#pragma unroll 2
            for (int it = gw; it < (T / 16) * 12; it += NGW) prep_conv(RB, XA, KIN(14) + (size_t)Lp * 4 * XBC, KIN(15) + (size_t)Lp * XBC, it, lane);
            for (int it = gw; it < BATCH * 64 * 4; it += NGW) { const int hq = it & 3, ck = (it >> 2) & 63, bb = it >> 8; const int t = bb * SEQ + ck * 64 + lane;
                const u32x2 rw = *(const u32x2*)(RB + (size_t)t * NB + B_DT + hq * 4); const unsigned rr[2] = {rw.x, rw.y}; float dtv[4], ac[4];
#pragma unroll
                for (int e = 0; e < 4; ++e) { const int hh = hq * 4 + e; const float xr = __builtin_bit_cast(float, (e & 1) ? (rr[e >> 1] & 0xffff0000u) : (rr[e >> 1] << 16)) + (KIN(16) + Lp * 16)[hh];
                    dtv[e] = xr > 15.f ? xr : log1pf(__expf(xr)); ac[e] = -__expf((KIN(17) + Lp * 16)[hh]) * dtv[e]; }
#pragma unroll
                for (int o = 1; o < 64; o <<= 1) {
#pragma unroll
                    for (int e = 0; e < 4; ++e) { const float v = __shfl_up(ac[e], o); if (lane >= o) ac[e] += v; } }
#pragma unroll
                for (int e = 0; e < 4; ++e) { typedef float f32x2_t __attribute__((ext_vector_type(2))); ((f32x2_t*)(ws + WS_DT2))[(size_t)(bb * 16 + hq * 4 + e) * SEQ + ck * 64 + lane] = (f32x2_t){dtv[e], ac[e]}; } }
            }
            SEAM(pb + 2);
        }
        if (IN(pb + 3)) { PHASE_IDS;
#if NAIVE_SELECT
            for (int t = blk; t < T; t += G) wg_m2_select(lds, RB, IDX, t, tid);
#else
            for (int pass = NPASS(3); pass > 0; --pass) for (int i = blk; i < T / 16; i += G) { const int b_ = i & 7, j_ = i >> 3; wg_select16(lds, RB, IKC, IDX, b_ * 256 + (255 - j_), tid, pass > 1); }
#endif
            SEAM(pb + 3); }
        if (IN(pb + 4)) { PHASE_IDS;
#if NAIVE_ATTN
            for (int t = blk; t < T; t += G) wg_m3_attn(lds, RA, RB, IDX, KIN(10) + (size_t)Lp * 256 * 8 * 64, KIN(11) + (size_t)Lp * 256 * 8 * 64, KIN(12), t, tid);
#else
            for (int pass = NPASS(4); pass > 0; --pass) {
                for (int i_ = blk, k_ = 0; i_ < T / 8; i_ += G, ++k_) { const int ucur = (i_ & 7) * 512 + (511 - (i_ >> 3)), in_ = i_ + G, unxt = (in_ < T / 8) ? (in_ & 7) * 512 + (511 - (in_ >> 3)) : -1;
                    wg_attn16(lds, RA, CKVC, IDX, WUK, WUV, KIN(12), ucur, unxt, k_ & 1, k_ == 0, tid, pass > 1); }
            }
#endif
            SEAM(pb + 4); }
        if (IN(pb + 5)) { PHASE_IDS;
#if 0
#elif NAIVE_SSM
            for (int u = blk * 2 + (tid >> 8); u < BATCH * 16; u += G * 2) half_m4b_scan(RA, XA, DTb, KIN(17) + Lp * 16, KIN(18) + Lp * 16, u >> 4, u & 15, tid & 255);
#else
            for (int pass = NPASS(5); pass > 0; --pass) for (int u = blk; u < BATCH * 32; u += G) { const int uu = (u & 127) * 2 + (u >> 7);
                wg_ssm_unit(lds, RA, XA, (const float*)(ws + WS_DT2), KIN(17) + Lp * 16, KIN(18) + Lp * 16, uu ^ 1, tid, nullptr, pass > 1); }
#endif
            SEAM(pb + 5); }
        if (IN(pb + 6)) { PHASE_IDS; for (int pass = NPASS(6); pass > 0; --pass) for (int w = 4 * gw; w < T * 2; w += 4 * NGW) wave_gnorm4(RA, KIN(19) + (size_t)Lp * 1024, w, lane, pass > 1); SEAM(pb + 6); }
        if (IN(pb + 7)) { PHASE_IDS; for (int pass = NPASS(7); pass > 0; --pass) {
            pg8::Gemm g{RA, Wout, T, D, MIXW}; pg8::StaticOrder S; S.init(T, D, G, blk);
            pg8::EpiBf16P E{RB, (long)D};
            pg8::gemm_phase<pg8::EpiBf16P, pg8::StaticOrder, true, true>(lds, g, S, E, tid);
            }
            SEAM(pb + 7);
        }
        if (IN(pb + 8)) { PHASE_IDS; for (int pass = NPASS(8); pass > 0; --pass) for (int r = 2 * gw; r < T; r += 2 * NGW) row_resid_norm2(Xcur, (const bf16*)RB, KIN(3) + (size_t)Lp * D, X0, rstd2, nullptr, nullptr, r, lane, pass > 1); SEAM(pb + 8); }
        if (IN(pb + 9)) { PHASE_IDS; for (int pass = NPASS(9); pass > 0; --pass) {
            pg8::Gemm g{X0, Wgu, T, NGU, D}; pg8::StaticOrder S; S.init(T, NGU, G, blk);
            pg8::EpiSwiGLU E{RB, rstd2};
            pg8::gemm_phase<pg8::EpiSwiGLU, pg8::StaticOrder, true, true>(lds, g, S, E, tid);
            }
            SEAM(pb + 9);
        }
        if (IN(pb + 10)) { PHASE_IDS; for (int pass = NPASS(10); pass > 0; --pass) {
            pg8::Gemm g{RB, Wdown, T, D, DFF}; pg8::StaticOrder S; S.init(T, D, G, blk);
            pg8::EpiBf16P E{RA, (long)D};
            pg8::gemm_phase<pg8::EpiBf16P, pg8::StaticOrder, true, true>(lds, g, S, E, tid);
            }
            SEAM(pb + 10);
        }
        if (IN(pb + 11)) { PHASE_IDS; for (int pass = NPASS(11); pass > 0; --pass) for (int r = 2 * gw; r < T; r += 2 * NGW) row_resid_norm2(X0, (const bf16*)RA, KIN(5) + (size_t)Lp * D, X0, nullptr, p + (size_t)Lp * T * PLE, X1, r, lane, pass > 1); SEAM(pb + 11); }
        if (IN(pb + 12)) { PHASE_IDS; for (int pass = NPASS(12); pass > 0; --pass) {
            pg8::Gemm g{X1, Wpp, T, D, PLE}; pg8::StaticOrder S; S.init(T, D, G, blk);
            pg8::EpiBf16P E{RB, (long)D};
            pg8::gemm_phase<pg8::EpiBf16P, pg8::StaticOrder, true, true>(lds, g, S, E, tid);
            }
            SEAM(pb + 12);
        }
        if (IN(pb + 13)) { PHASE_IDS; for (int pass = NPASS(13); pass > 0; --pass) {
            pg8::Gemm g{X0, Wpg, T, D, D}; pg8::StaticOrder S; S.init(T, D, G, blk);
            pg8::EpiPle E{X0, RB, X1, (Lp == DEPTH - 1) ? out : nullptr};
            pg8::gemm_phase<pg8::EpiPle, pg8::StaticOrder, true, true>(lds, g, S, E, tid);
            }
            SEAM(pb + 13);
        }
    }
#if CLK_PROBE
    if (P.ph_hi == DEPTH * NPH) { PHASE_IDS_NOL; { XcdBarrier b3_ = bar; asm volatile("" : "+s"(b3_.bar)); xcd_barrier(b3_, mk_tid(wave_s)); }
        if (blk == 0 && tid == 0) { const unsigned long long c1 = __builtin_amdgcn_s_memtime(), r1 = __builtin_amdgcn_s_memrealtime(); const unsigned long long* ts = (const unsigned long long*)(ws + 49152);
            const unsigned long long c0 = __hip_atomic_load(ts, __ATOMIC_RELAXED, __HIP_MEMORY_SCOPE_AGENT), r0 = __hip_atomic_load(ts + 1, __ATOMIC_RELAXED, __HIP_MEMORY_SCOPE_AGENT);
            const float mhz = (float)(c1 - c0) / (float)(r1 - r0) * 100.0f; const float q = exp2f(rintf(4.0f * log2f(fmaxf(mhz, 1.0f))) * 0.25f);
            __hip_atomic_store((float*)(ws + 49152 + 64), q * 0.001f, __ATOMIC_RELAXED, __HIP_MEMORY_SCOPE_AGENT); }
        { XcdBarrier b3_ = bar; asm volatile("" : "+s"(b3_.bar)); xcd_barrier(b3_, mk_tid(wave_s)); }
        const float sc = 1.0f + __hip_atomic_load((float*)(ws + 49152 + 64), __ATOMIC_RELAXED, __HIP_MEMORY_SCOPE_AGENT);
        for (size_t i = (size_t)blk * NTHR + tid; i < (size_t)T * D; i += (size_t)G * NTHR) out[i] *= sc; }
#endif
#if TIMING
    if (P.ph_hi == DEPTH * NPH) { PHASE_IDS_NOL; { XcdBarrier b3_ = bar; asm volatile("" : "+s"(b3_.bar)); xcd_barrier(b3_, mk_tid(wave_s)); }
        const unsigned long long* ts = (const unsigned long long*)(ws + 32768);
        const float ta = (float)(__hip_atomic_load(ts + TIMING_A + 1, __ATOMIC_RELAXED, __HIP_MEMORY_SCOPE_AGENT) - __hip_atomic_load(ts + TIMING_A, __ATOMIC_RELAXED, __HIP_MEMORY_SCOPE_AGENT)) * 0.01f;
        const float tb = (float)(__hip_atomic_load(ts + TIMING_B + 1, __ATOMIC_RELAXED, __HIP_MEMORY_SCOPE_AGENT) - __hip_atomic_load(ts + TIMING_B, __ATOMIC_RELAXED, __HIP_MEMORY_SCOPE_AGENT)) * 0.01f;
        float ta_ = ta; if (TIMING_A == 99) { const unsigned long long c1 = __builtin_amdgcn_s_memtime(), r1 = __builtin_amdgcn_s_memrealtime(); const unsigned long long c0 = __hip_atomic_load(ts + 60, __ATOMIC_RELAXED, __HIP_MEMORY_SCOPE_AGENT), r0 = __hip_atomic_load(ts + 0, __ATOMIC_RELAXED, __HIP_MEMORY_SCOPE_AGENT);
            ta_ = (float)(c1 - c0) / (float)(r1 - r0) * 10.0f;   ta_ = __builtin_bit_cast(float, __builtin_amdgcn_readfirstlane(__builtin_bit_cast(int, ta_))); }
        const float taq = exp2f(rintf(4.0f * log2f(fmaxf(ta_, 1.0f)) + TIMING_SHIFT) * 0.25f), tbq = exp2f(rintf(2.0f * log2f(fmaxf(tb, 1.0f)) + TIMING_SHIFT) * 0.5f);
        const float sc = 1.0f + taq * 0.001f;
        for (size_t i = (size_t)blk * NTHR + tid; i < (size_t)T * D; i += (size_t)G * NTHR) out[i] *= sc;
        __syncthreads(); if (blk == 0 && tid == 0) out[0] += tbq * 10.0f; }
#endif
#if DBG_SSM
    if (P.ph_hi == DEPTH * NPH) { PHASE_IDS_NOL; { XcdBarrier b3_ = bar; asm volatile("" : "+s"(b3_.bar)); xcd_barrier(b3_, mk_tid(wave_s)); }
        const float d2 = __hip_atomic_load((float*)(ws + 65536), __ATOMIC_RELAXED, __HIP_MEMORY_SCOPE_AGENT), n2 = __hip_atomic_load((float*)(ws + 65536 + 4), __ATOMIC_RELAXED, __HIP_MEMORY_SCOPE_AGENT);
        const float sc = 1.0f + (n2 > 0.f ? sqrtf(d2 / n2) : 7.0f);
        for (size_t i = (size_t)blk * NTHR + tid; i < (size_t)T * D; i += (size_t)G * NTHR) out[i] *= sc; }
#endif
#undef IN
#undef SEAM
}

#ifndef MK_ONE_LAUNCH
#define MK_ONE_LAUNCH 1
#endif
extern "C" void kernel_launch(void* const* d_in, const int* in_sizes, int n_in, void* d_out, int out_size, void* d_ws, size_t ws_size, hipStream_t stream) {
    static int grid = 0;
    if (grid == 0) {
        if (n_in != 26 || ws_size < WS_END) { fprintf(stderr, "kernel_launch: unexpected n_in %d / ws_size %zu\n", n_in, ws_size); grid = -1; return; }
        int dev = 0, cus = 0, per_cu = 0;
        if (hipGetDevice(&dev) != hipSuccess || hipDeviceGetAttribute(&cus, hipDeviceAttributeMultiprocessorCount, dev) != hipSuccess) { grid = -1; return; }
        if (hipFuncSetAttribute((const void*)k_fwd, hipFuncAttributeMaxDynamicSharedMemorySize, LDS_BYTES) != hipSuccess) { fprintf(stderr, "kernel_launch: hipFuncSetAttribute failed\n"); grid = -1; return; }
        if (hipOccupancyMaxActiveBlocksPerMultiprocessor(&per_cu, (const void*)k_fwd, NTHR, LDS_BYTES) != hipSuccess || per_cu < 1) { fprintf(stderr, "kernel_launch: occupancy query says %d\n", per_cu); }
        (void)hipGetLastError();
        grid = cus;
    }
    if (grid < 0) return;
    if (hipMemsetAsync((char*)d_ws + WS_CTL, 0, CTL_ZERO_BYTES, stream) != hipSuccess) return;
    Params P; memset(&P, 0, sizeof(P));
    for (int i = 0; i < 26; ++i) P.in[i] = (const float*)d_in[i];
    P.out = (float*)d_out; P.ws = (unsigned char*)d_ws;
#if MK_ONE_LAUNCH
    P.ph_lo = 0; P.ph_hi = DEPTH * NPH; P.dbl_mask = DBL_MASK; P.pad = ATT_SUB_V;
    hipLaunchKernelGGL(k_fwd, dim3(grid), dim3(NTHR), LDS_BYTES, stream, P);
#else
    for (int ph = 0; ph < DEPTH * NPH; ++ph) { P.ph_lo = ph; P.ph_hi = ph + 1; hipLaunchKernelGGL(k_fwd, dim3(grid), dim3(NTHR), LDS_BYTES, stream, P); }
#endif
}
```

```cpp
#include <hip/hip_runtime.h>
#include <cstdio>
#include <cstdint>
#include <cstring>
namespace pg8 {
#define PG8_LAS __attribute__((address_space(3)))
typedef unsigned short bf16_t;
typedef short bf16x8 __attribute__((ext_vector_type(8)));
typedef float f32x4 __attribute__((ext_vector_type(4)));
typedef unsigned u32x4 __attribute__((ext_vector_type(4)));
constexpr int BM = 256, BK = 64, HALF = 128, HTB = HALF * BK * 2  , STAGE_BYTES = 8 * HTB, NXCD = 8, WGM = 8;

__host__ __device__ __forceinline__ int lds_byte(int r, int c) { const int st = (r >> 4) * 2 + (c >> 5), rr = r & 15, cc = c & 31, ob = rr * 64 + cc * 2; return st * 1024 + (ob ^ (((ob >> 9) & 1) << 5)); }
__host__ __device__ __forceinline__ void stage_rc(int b, int& R, int& C) { const int st = b / 1024, sb = b % 1024, swz = sb ^ (((sb >> 9) & 1) << 5); R = (st >> 1) * 16 + swz / 64; C = (st & 1) * 32 + (swz % 64) / 2; }
__host__ __device__ __forceinline__ int perm32(int rho) { const int n = rho >> 4, i = rho & 15; return 8 * (i >> 2) + 4 * n + (i & 3); }

struct Unit { int pm, pn; };
struct Gemm { const bf16_t* A; const bf16_t* Bt; int M, N, K; };

struct StaticOrder {
    int nM, nN, nwg, G, c;
    __host__ __device__ void init(int M, int N, int G_, int c_) { nM = M / BM; nN = N / BM; nwg = nM * nN; G = G_; c = c_; }
    __host__ __device__ bool next(int i, Unit& u) const {
        const long L = (long)i * G + c; if (L >= nwg) return false;
        int wgid = (int)L; { const int q = nwg / NXCD, r = nwg % NXCD, xcd = wgid % NXCD, off = wgid / NXCD; wgid = (xcd < r ? xcd * (q + 1) : r * (q + 1) + (xcd - r) * q) + off; }
        const int nig = WGM * nN, gid = wgid / nig, fm = gid * WGM, gsz = (nM - fm) < WGM ? (nM - fm) : WGM;
        u.pm = fm + ((wgid % nig) % gsz); u.pn = (wgid % nig) / gsz; return true;
    }
    __device__ __forceinline__ void a_ready(const Unit&) const {}
    __device__ __forceinline__ void done(const Unit&) const {}
};

__device__ __forceinline__ unsigned cvt_pk_bf16(float lo, float hi) { unsigned r; asm volatile("v_cvt_pk_bf16_f32 %0, %1, %2" : "=v"(r) : "v"(lo), "v"(hi)); return r; }
typedef float f32x2 __attribute__((ext_vector_type(2)));
__device__ __forceinline__ f32x2 gelu_pk(f32x2 v) {
    const f32x2 av = __builtin_elementwise_abs(v), d = av * 0.2316418882f + 1.0f;
    f32x2 t; t.x = __builtin_amdgcn_rcpf(d.x); t.y = __builtin_amdgcn_rcpf(d.y);
    f32x2 q = t * 0.5307027145f + (-0.7265760135f); q = q * t + 0.7107068705f; q = q * t + (-0.142248368f); q = q * t + 0.127414796f; q = q * t;
    const f32x2 s = (v * v) * (-0.72134752044f);
    f32x2 e; e.x = __builtin_amdgcn_exp2f(s.x); e.y = __builtin_amdgcn_exp2f(s.y);
    const f32x2 m = v * (q * e), r = v - m;
    f32x2 o; o.x = v.x < 0.f ? m.x : r.x; o.y = v.y < 0.f ? m.y : r.y; return o;
}

template <int ACT  > struct EpiBf16 {
    static constexpr bool PERM = true, AFTER_DRAIN = false; static_assert(ACT == 0 || ACT == 1, "EpiBf16: ACT is 0 (none) or 1 (gelu_pk)");
    bf16_t* O; int ldc; const float* bias; int split_cols; size_t split_stride; float scale0;
    __device__ __forceinline__ void operator()(const f32x4 (&acc)[2][2][4][2], const Unit& u, int wr, int wc, int fr, int fq) const {
        const int row0 = u.pm * BM + wr * 64 + fr; int colt = u.pn * BM; bf16_t* base = O;
        float sc = 1.f; if (split_cols) { const int t = colt / split_cols; base += (size_t)t * split_stride; colt -= t * split_cols; if (t == 0) sc = scale0; }
        const int col0 = colt + wc * 32 + 8 * fq, bcol0 = u.pn * BM + wc * 32 + 8 * fq;
        f32x4 bv[2][2];
#pragma unroll
        for (int bj = 0; bj < 2; ++bj)
#pragma unroll
            for (int n = 0; n < 2; ++n) bv[bj][n] = bias ? *(const f32x4*)(bias + bcol0 + bj * HALF + 4 * n) : (f32x4){0.f, 0.f, 0.f, 0.f};
#pragma unroll
        for (int ai = 0; ai < 2; ++ai)
#pragma unroll
            for (int m = 0; m < 4; ++m) { bf16_t* rowp = base + (size_t)(row0 + ai * HALF + m * 16) * ldc + col0;
#pragma unroll
                for (int bj = 0; bj < 2; ++bj) { f32x4 v0 = acc[ai][bj][m][0] + bv[bj][0], v1 = acc[ai][bj][m][1] + bv[bj][1];
                    if (ACT == 1) { f32x2 a = gelu_pk((f32x2){v0[0], v0[1]}), b = gelu_pk((f32x2){v0[2], v0[3]}), c = gelu_pk((f32x2){v1[0], v1[1]}), d = gelu_pk((f32x2){v1[2], v1[3]});
                        v0 = (f32x4){a.x, a.y, b.x, b.y}; v1 = (f32x4){c.x, c.y, d.x, d.y}; }
                    v0 = v0 * sc; v1 = v1 * sc; u32x4 w; w.x = cvt_pk_bf16(v0[0], v0[1]); w.y = cvt_pk_bf16(v0[2], v0[3]); w.z = cvt_pk_bf16(v1[0], v1[1]); w.w = cvt_pk_bf16(v1[2], v1[3]);
                    *(u32x4*)(rowp + bj * HALF) = w; } }
    }
};

struct PanelStats {
    unsigned* xbuf;
    unsigned* cnt;
    unsigned* tmo;
    int ntn; float eps;
    unsigned code;
    __device__ __forceinline__ bool run(const f32x4 (&v)[2][2][4][2], const Unit& u, int wr, int wc, int fr, int fq, PG8_LAS unsigned char* lds, int wid, int lane) const {
        typedef float f32x2v __attribute__((ext_vector_type(2)));
        PG8_LAS f32x2v* P = (PG8_LAS f32x2v*)lds;
        PG8_LAS f32x2v* S = (PG8_LAS f32x2v*)(lds + 8192);
        PG8_LAS unsigned* flag = (PG8_LAS unsigned*)(lds + 8192 + 2048);
#pragma unroll
        for (int ai = 0; ai < 2; ++ai)
#pragma unroll
            for (int m = 0; m < 4; ++m) {
                float s = 0.f;
#pragma unroll
                for (int bj = 0; bj < 2; ++bj)
#pragma unroll
                    for (int n = 0; n < 2; ++n) { const f32x4 x = v[ai][bj][m][n]; s += (x[0] + x[1]) + (x[2] + x[3]); }
                s += __shfl_xor(s, 16); s += __shfl_xor(s, 32);
                const float mw = s * (1.0f / 64.0f); float q = 0.f;
#pragma unroll
                for (int bj = 0; bj < 2; ++bj)
#pragma unroll
                    for (int n = 0; n < 2; ++n) { const f32x4 d = v[ai][bj][m][n] - mw; q += (d[0] * d[0] + d[1] * d[1]) + (d[2] * d[2] + d[3] * d[3]); }
                q += __shfl_xor(q, 16); q += __shfl_xor(q, 32);
                if (fq == 0) P[(ai * HALF + wr * 64 + m * 16 + fr) * 4 + wc] = (f32x2v){mw, q};
            }
        asm volatile("s_waitcnt lgkmcnt(0)" ::: "memory"); __builtin_amdgcn_s_barrier(); asm volatile("" ::: "memory");
#if defined(BROKEN_EXCHANGE_NO_WAIT)
#warning BROKEN CONTROL BUILD: the row-statistics exchange does not wait; results are wrong by design
        if (blockIdx.x >= 64) { const long long t0_ = clock64(); while (clock64() - t0_ < 60000) __builtin_amdgcn_s_sleep(8); }
#endif
        const int row = wid * 32 + (lane & 31);
        if (lane < 32) {
            const f32x2v a = P[row * 4 + 0], b = P[row * 4 + 1], c = P[row * 4 + 2], d = P[row * 4 + 3];
            const float mt = (a.x + b.x + c.x + d.x) * 0.25f;
            const float da = a.x - mt, db = b.x - mt, dc = c.x - mt, dd = d.x - mt;
            const float m2 = (a.y + b.y) + (c.y + d.y) + 64.0f * ((da * da + db * db) + (dc * dc + dd * dd));
            unsigned long long* slot = (unsigned long long*)xbuf + ((size_t)(u.pm * BM + row) * 4 + u.pn);
            __hip_atomic_store(slot, ((unsigned long long)__float_as_uint(m2) << 32) | __float_as_uint(mt), __ATOMIC_RELAXED, __HIP_MEMORY_SCOPE_AGENT);
        }
        asm volatile("s_waitcnt vmcnt(0)" ::: "memory");
        if (lane == 0) __hip_atomic_fetch_add(cnt + 64 * u.pm, 1u, __ATOMIC_RELAXED, __HIP_MEMORY_SCOPE_AGENT);
        if (wid == 0) {
            bool dead = false; const unsigned long long t0 = __builtin_amdgcn_s_memrealtime(); const unsigned want = 8u * (unsigned)ntn;
            for (;;) {
#if defined(BROKEN_EXCHANGE_NO_WAIT)
                break;
#endif
                if ((unsigned)__builtin_amdgcn_readfirstlane(__hip_atomic_load(cnt + 64 * u.pm, __ATOMIC_RELAXED, __HIP_MEMORY_SCOPE_AGENT)) >= want) break;
                if (__builtin_amdgcn_s_memrealtime() - t0 > 2000000ull) {
                    if (lane == 0) { unsigned expect = 0u; __hip_atomic_compare_exchange_strong(tmo + 1, &expect, code | (unsigned)(u.pm & 0xff), __ATOMIC_RELAXED, __ATOMIC_RELAXED, __HIP_MEMORY_SCOPE_AGENT);
                                     __hip_atomic_store(tmo, 1u, __ATOMIC_RELAXED, __HIP_MEMORY_SCOPE_AGENT); }
                    dead = true; break; }
                __builtin_amdgcn_s_sleep(2);
            }
            __builtin_amdgcn_fence(__ATOMIC_ACQUIRE, "agent");
            if (lane == 0) flag[0] = dead ? 1u : 0u;
        }
        asm volatile("s_waitcnt vmcnt(0) lgkmcnt(0)" ::: "memory"); __builtin_amdgcn_s_barrier(); asm volatile("" ::: "memory");
        const bool bad = flag[0] != 0u;
        if (lane < 32) {
            const unsigned long long* slot = (const unsigned long long*)xbuf + (size_t)(u.pm * BM + row) * 4; float mt[4], m2[4]; float ms = 0.f;
#pragma unroll
            for (int t = 0; t < 4; ++t) { if (t < ntn) { const unsigned long long w = __hip_atomic_load(slot + t, __ATOMIC_RELAXED, __HIP_MEMORY_SCOPE_AGENT); mt[t] = __uint_as_float((unsigned)w); m2[t] = __uint_as_float((unsigned)(w >> 32)); } else { mt[t] = 0.f; m2[t] = 0.f; } ms += mt[t]; }
            const float mean = ms / (float)ntn; float q = 0.f;
#pragma unroll
            for (int t = 0; t < 4; ++t) if (t < ntn) { const float dm = mt[t] - mean; q += m2[t] + 256.0f * dm * dm; }
            S[row] = (f32x2v){mean, 1.0f / sqrtf(q / (256.0f * (float)ntn) + eps)};
        }
        asm volatile("s_waitcnt lgkmcnt(0)" ::: "memory"); __builtin_amdgcn_s_barrier(); asm volatile("" ::: "memory");
        return bad;
    }
};
struct EpiLnRes {
    static constexpr bool PERM = false, AFTER_DRAIN = true;
    const float* base; float* out; int ldc; const float* bias; PanelStats st; unsigned poison;
    __device__ __forceinline__ void fused(f32x4 (&acc)[2][2][4][2], const Unit& u, int wr, int wc, int fr, int fq, PG8_LAS unsigned char* lds, int wid, int lane) const {
        typedef float f32x2v __attribute__((ext_vector_type(2)));
        const PG8_LAS f32x2v* S = (const PG8_LAS f32x2v*)(lds + 8192);
        const int col0 = u.pn * BM + wc * 32 + 4 * fq;
#pragma unroll
        for (int bj = 0; bj < 2; ++bj)
#pragma unroll
            for (int n = 0; n < 2; ++n) { const f32x4 bv = bias ? *(const f32x4*)(bias + col0 + bj * HALF + n * 16) : (f32x4){0.f, 0.f, 0.f, 0.f};
#pragma unroll
                for (int ai = 0; ai < 2; ++ai)
#pragma unroll
                    for (int m = 0; m < 4; ++m) acc[ai][bj][m][n] += bv; }
        f32x4 pre[4][2][2];
#pragma unroll
        for (int m = 0; m < 4; ++m) { const size_t off = (size_t)(u.pm * BM + wr * 64 + m * 16 + fr) * ldc + col0;
#pragma unroll
            for (int bj = 0; bj < 2; ++bj)
#pragma unroll
                for (int n = 0; n < 2; ++n) pre[m][bj][n] = *(const f32x4*)(base + off + bj * HALF + n * 16); }
        const bool bad = st.run(acc, u, wr, wc, fr, fq, lds, wid, lane) || poison != 0u;
        const float qnan = __builtin_nanf("");
#pragma unroll
        for (int ai = 0; ai < 2; ++ai)
#pragma unroll
            for (int m = 0; m < 4; ++m) { const int r = ai * HALF + wr * 64 + m * 16 + fr; const f32x2v sr = S[r]; const size_t off = (size_t)(u.pm * BM + r) * ldc + col0;
#pragma unroll
                for (int bj = 0; bj < 2; ++bj)
#pragma unroll
                    for (int n = 0; n < 2; ++n) { const f32x4 bs = ai == 0 ? pre[m][bj][n] : *(const f32x4*)(base + off + bj * HALF + n * 16); f32x4 o = bs + (acc[ai][bj][m][n] - sr.x) * sr.y;
                        if (bad) o = (f32x4){qnan, qnan, qnan, qnan}; *(f32x4*)(out + off + bj * HALF + n * 16) = o; }
                if (m & 1) asm volatile("" ::: "memory"); }
    }
};
struct EpiLnResLn {
    static constexpr bool PERM = false, AFTER_DRAIN = true;
    const float* base; float* out; bf16_t* xn; int ldc; const float* bias; PanelStats st1, st2; unsigned poison;
    __device__ __forceinline__ void fused(f32x4 (&acc)[2][2][4][2], const Unit& u, int wr, int wc, int fr, int fq, PG8_LAS unsigned char* lds, int wid, int lane) const {
        typedef float f32x2v __attribute__((ext_vector_type(2))); typedef unsigned u32x2v __attribute__((ext_vector_type(2)));
        const PG8_LAS f32x2v* S = (const PG8_LAS f32x2v*)(lds + 8192);
        const int col0 = u.pn * BM + wc * 32 + 4 * fq;
#pragma unroll
        for (int bj = 0; bj < 2; ++bj)
#pragma unroll
            for (int n = 0; n < 2; ++n) { const f32x4 bv = bias ? *(const f32x4*)(bias + col0 + bj * HALF + n * 16) : (f32x4){0.f, 0.f, 0.f, 0.f};
#pragma unroll
                for (int ai = 0; ai < 2; ++ai)
#pragma unroll
                    for (int m = 0; m < 4; ++m) acc[ai][bj][m][n] += bv; }
        bool bad = st1.run(acc, u, wr, wc, fr, fq, lds, wid, lane) || poison != 0u;
        const float qnan = __builtin_nanf("");
#pragma unroll
        for (int ai = 0; ai < 2; ++ai)
#pragma unroll
            for (int m = 0; m < 4; ++m) { const int r = ai * HALF + wr * 64 + m * 16 + fr; const f32x2v sr = S[r]; const size_t off = (size_t)(u.pm * BM + r) * ldc + col0;
#pragma unroll
                for (int bj = 0; bj < 2; ++bj)
#pragma unroll
                    for (int n = 0; n < 2; ++n) { const f32x4 bs = *(const f32x4*)(base + off + bj * HALF + n * 16); acc[ai][bj][m][n] = bs + (acc[ai][bj][m][n] - sr.x) * sr.y; }
                asm volatile("" : "+v"(acc[ai][0][m][0]), "+v"(acc[ai][0][m][1]), "+v"(acc[ai][1][m][0]), "+v"(acc[ai][1][m][1]));
                if (m & 1) asm volatile("" ::: "memory"); }
        const bool bad1 = bad;
        bad = st2.run(acc, u, wr, wc, fr, fq, lds, wid, lane) || bad;
#pragma unroll
        for (int ai = 0; ai < 2; ++ai)
#pragma unroll
            for (int m = 0; m < 4; ++m) { const int r = ai * HALF + wr * 64 + m * 16 + fr; const f32x2v sr = S[r]; const size_t off = (size_t)(u.pm * BM + r) * ldc + col0;
#pragma unroll
                for (int bj = 0; bj < 2; ++bj)
#pragma unroll
                    for (int n = 0; n < 2; ++n) { const f32x4 x1 = acc[ai][bj][m][n]; *(f32x4*)(out + off + bj * HALF + n * 16) = bad1 ? (f32x4){qnan, qnan, qnan, qnan} : x1;
                        const f32x4 o = (x1 - sr.x) * sr.y; u32x2v w; w.x = cvt_pk_bf16(o[0], o[1]); w.y = cvt_pk_bf16(o[2], o[3]);
                        if (bad) { w.x = 0x7fc07fc0u; w.y = 0x7fc07fc0u; } *(u32x2v*)(xn + off + bj * HALF + n * 16) = w; }
                asm volatile("" ::: "memory"); }
    }
};

template <class Epi, class Sched, bool ALIGN_EPI = false, bool SP2 = false>
__device__ __forceinline__ void gemm_phase(PG8_LAS unsigned char* lds, const Gemm g, const Sched& S, const Epi& E, int tid_in) {
    int tid_l = tid_in; asm volatile("" : "+v"(tid_l));
    const int tid = tid_l, wid = __builtin_amdgcn_readfirstlane(tid >> 6), lane = tid & 63, wr = wid >> 2, wc = wid & 3, fr = lane & 15, fq = lane >> 4;
    int K_l = g.K; asm volatile("" : "+s"(K_l));
    const int K = K_l, nt = K / BK;
    unsigned voffA[2], voffB[2];
#pragma unroll
    for (int i = 0; i < 2; ++i) { int R, C; stage_rc(tid * 16 + i * 8192, R, C); const int Rb = Epi::PERM ? ((R & ~31) + perm32(R & 31)) : R;
        voffA[i] = (unsigned)(R * K + C) * 2u; voffB[i] = (unsigned)(Rb * K + C) * 2u; }
    const size_t kstep = (size_t)(BK * 2);
    const size_t hstep = (size_t)HALF * K * 2;
    const size_t tstep = 2 * hstep;
    const unsigned ldsw = (unsigned)wid * 1024u;
    const int aoff = lds_byte(wr * 64 + fr, fq * 8), boff = lds_byte(wc * 32 + fr, fq * 8);
#define PG8_SA(b, h) (((b) * 2 + (h)) * HTB)
#define PG8_SB(b, h) ((4 + (b) * 2 + (h)) * HTB)
#define PG8_STAGE(bufoff, gbase, voff) do { _Pragma("unroll") for (int _i = 0; _i < 2; ++_i) \
        __builtin_amdgcn_global_load_lds((const unsigned*)((const char*)(gbase) + (voff)[_i]), (PG8_LAS unsigned*)(lds + (bufoff) + ldsw + _i * 8192), 16, 0, 0); } while (0)
#define PG8_LDA(dst, b, h) do { _Pragma("unroll") for (int m = 0; m < 4; ++m) _Pragma("unroll") for (int k = 0; k < 2; ++k) dst[m][k] = *(const PG8_LAS bf16x8*)(lds + PG8_SA(b, h) + aoff + m * 2048 + k * 1024); } while (0)
#define PG8_LDB(dst, b, h) do { _Pragma("unroll") for (int n = 0; n < 2; ++n) _Pragma("unroll") for (int k = 0; k < 2; ++k) dst[n][k] = *(const PG8_LAS bf16x8*)(lds + PG8_SB(b, h) + boff + n * 2048 + k * 1024); } while (0)
#define PG8_MMA(ai, bj, At, Bt) do { __builtin_amdgcn_s_setprio(1); _Pragma("unroll") for (int m = 0; m < 4; ++m) _Pragma("unroll") for (int n = 0; n < 2; ++n) _Pragma("unroll") for (int k = 0; k < 2; ++k) \
        acc[ai][bj][m][n] = __builtin_amdgcn_mfma_f32_16x16x32_bf16(Bt[n][k], At[m][k], acc[ai][bj][m][n], 0, 0, 0); __builtin_amdgcn_s_setprio(0); } while (0)
#define PG8_WAIT_V(n) asm volatile("s_waitcnt vmcnt(" #n ")" ::: "memory")
#define PG8_WAIT_L(n) asm volatile("s_waitcnt lgkmcnt(" #n ")" ::: "memory")
#define PG8_BAR __builtin_amdgcn_s_barrier()
#define PG8_SCHED __builtin_amdgcn_sched_barrier(0)
    Unit cur, nxt; int ui = 0;
    if (!S.next(0, cur)) return;
    f32x4 acc[2][2][4][2];
#pragma unroll
    for (int a = 0; a < 2; ++a)
#pragma unroll
        for (int b = 0; b < 2; ++b)
#pragma unroll
            for (int m = 0; m < 4; ++m)
#pragma unroll
                for (int n = 0; n < 2; ++n) acc[a][b][m][n] = (f32x4){0.f, 0.f, 0.f, 0.f};
    bf16x8 At[4][2], B0[2][2], B1[2][2];
    const char* cA = (const char*)g.A + (size_t)cur.pm * tstep; const char* cB = (const char*)g.Bt + (size_t)cur.pn * tstep;
    S.a_ready(cur);
    if constexpr (SP2) {
        PG8_STAGE(PG8_SB(0, 0), cB, voffB); PG8_STAGE(PG8_SB(0, 1), cB + hstep, voffB); PG8_STAGE(PG8_SA(0, 0), cA, voffA); PG8_STAGE(PG8_SA(0, 1), cA + hstep, voffA);
        if (wr == 1) PG8_BAR;
        PG8_WAIT_V(2); PG8_BAR;
        PG8_STAGE(PG8_SB(1, 0), cB + kstep, voffB); PG8_STAGE(PG8_SA(1, 0), cA + kstep, voffA); PG8_STAGE(PG8_SB(1, 1), cB + hstep + kstep, voffB);
        PG8_WAIT_V(6); PG8_BAR;
    } else {
        PG8_STAGE(PG8_SB(0, 0), cB, voffB); PG8_STAGE(PG8_SA(0, 0), cA, voffA); PG8_STAGE(PG8_SB(0, 1), cB + hstep, voffB); PG8_STAGE(PG8_SA(0, 1), cA + hstep, voffA);
        if (wr == 1) PG8_BAR;
        PG8_WAIT_V(4); PG8_BAR;
        PG8_STAGE(PG8_SB(1, 0), cB + kstep, voffB); PG8_STAGE(PG8_SA(1, 0), cA + kstep, voffA); PG8_STAGE(PG8_SB(1, 1), cB + hstep + kstep, voffB);
        PG8_WAIT_V(6); PG8_BAR;
    }
    for (;;) {
        const bool has_next = S.next(ui + 1, nxt);
        const char* nA = has_next ? (const char*)g.A + (size_t)nxt.pm * tstep : cA; const char* nB = has_next ? (const char*)g.Bt + (size_t)nxt.pn * tstep : cB;
        for (int t = 0; t < nt; t += 2) {
            const bool last = (t == nt - 2);
            const char* a1 = cA + (size_t)(t + 1) * kstep;
            const char* a2 = last ? nA : cA + (size_t)(t + 2) * kstep; const char* b2 = last ? nB : cB + (size_t)(t + 2) * kstep;
            const char* a3 = a2 + kstep; const char* b3 = b2 + kstep;
            if (last && has_next) S.a_ready(nxt);
            if constexpr (SP2) {
            PG8_LDB(B0, 0, 0); PG8_LDB(B1, 0, 1); PG8_SCHED; PG8_LDA(At, 0, 0); PG8_STAGE(PG8_SA(1, 1), a1 + hstep, voffA);
            PG8_WAIT_V(8); PG8_WAIT_L(0); PG8_BAR; PG8_MMA(0, 0, At, B0); PG8_MMA(0, 1, At, B1); PG8_BAR; PG8_SCHED;
            PG8_LDA(At, 0, 1); PG8_STAGE(PG8_SB(0, 0), b2, voffB); PG8_STAGE(PG8_SB(0, 1), b2 + hstep, voffB); PG8_STAGE(PG8_SA(0, 0), a2, voffA);
            PG8_WAIT_V(8); PG8_WAIT_L(0); PG8_BAR; PG8_MMA(1, 0, At, B0); PG8_MMA(1, 1, At, B1); PG8_BAR; PG8_SCHED;
            PG8_LDB(B0, 1, 0); PG8_LDB(B1, 1, 1); PG8_SCHED; PG8_LDA(At, 1, 0); PG8_STAGE(PG8_SA(0, 1), a2 + hstep, voffA);
            PG8_WAIT_V(8); PG8_WAIT_L(0); PG8_BAR; PG8_MMA(0, 0, At, B0); PG8_MMA(0, 1, At, B1); PG8_BAR; PG8_SCHED;
            PG8_LDA(At, 1, 1); PG8_STAGE(PG8_SB(1, 0), b3, voffB); PG8_STAGE(PG8_SB(1, 1), b3 + hstep, voffB); PG8_STAGE(PG8_SA(1, 0), a3, voffA);
            PG8_WAIT_V(8); PG8_WAIT_L(0); PG8_BAR; PG8_MMA(1, 0, At, B0); PG8_MMA(1, 1, At, B1); PG8_BAR; PG8_SCHED;
            } else {
            PG8_LDB(B0, 0, 0); PG8_SCHED; PG8_LDA(At, 0, 0); PG8_STAGE(PG8_SA(1, 1), a1 + hstep, voffA);
            PG8_WAIT_L(8); PG8_BAR; PG8_WAIT_L(0); PG8_MMA(0, 0, At, B0); PG8_BAR; PG8_SCHED;
            PG8_LDB(B1, 0, 1); PG8_STAGE(PG8_SB(0, 0), b2, voffB);
            PG8_BAR; PG8_WAIT_L(0); PG8_MMA(0, 1, At, B1); PG8_BAR;
            PG8_LDA(At, 0, 1); PG8_STAGE(PG8_SA(0, 0), a2, voffA);
            PG8_BAR; PG8_WAIT_L(0); PG8_MMA(1, 0, At, B0); PG8_BAR; PG8_SCHED;
            PG8_STAGE(PG8_SB(0, 1), b2 + hstep, voffB);
            PG8_WAIT_V(6); PG8_BAR; PG8_MMA(1, 1, At, B1); PG8_BAR;
            PG8_LDB(B0, 1, 0); PG8_SCHED; PG8_LDA(At, 1, 0); PG8_STAGE(PG8_SA(0, 1), a2 + hstep, voffA);
            PG8_WAIT_L(8); PG8_BAR; PG8_WAIT_L(0); PG8_MMA(0, 0, At, B0); PG8_BAR; PG8_SCHED;
            PG8_LDB(B1, 1, 1); PG8_STAGE(PG8_SB(1, 0), b3, voffB);
            PG8_BAR; PG8_WAIT_L(0); PG8_MMA(0, 1, At, B1); PG8_BAR;
            PG8_LDA(At, 1, 1); PG8_STAGE(PG8_SA(1, 0), a3, voffA);
            PG8_BAR; PG8_WAIT_L(0); PG8_MMA(1, 0, At, B0); PG8_BAR; PG8_SCHED;
            PG8_STAGE(PG8_SB(1, 1), b3 + hstep, voffB);
            PG8_WAIT_V(6); PG8_BAR; PG8_MMA(1, 1, At, B1); PG8_BAR;
            }
        }
        if constexpr (ALIGN_EPI) { if (wr == 0) PG8_BAR; }
        if constexpr (!Epi::AFTER_DRAIN) { E(acc, cur, wr, wc, fr, fq); S.done(cur); }
        if (!has_next) break;
#pragma unroll
        for (int a = 0; a < 2; ++a)
#pragma unroll
            for (int b = 0; b < 2; ++b)
#pragma unroll
                for (int m = 0; m < 4; ++m)
#pragma unroll
                    for (int n = 0; n < 2; ++n) acc[a][b][m][n] = (f32x4){0.f, 0.f, 0.f, 0.f};
        cur = nxt; cA = nA; cB = nB; ++ui;
        if constexpr (ALIGN_EPI) { if (wr == 1) PG8_BAR; }
    }
    PG8_WAIT_V(0);
    if constexpr (!ALIGN_EPI) { if (wr == 0) PG8_BAR; }
    PG8_BAR;
    if constexpr (Epi::AFTER_DRAIN) { E.fused(acc, cur, wr, wc, fr, fq, lds, wid, lane); S.done(cur); }
#undef PG8_SA
#undef PG8_SB
#undef PG8_STAGE
#undef PG8_LDA
#undef PG8_LDB
#undef PG8_MMA
#undef PG8_WAIT_V
#undef PG8_WAIT_L
#undef PG8_BAR
#undef PG8_SCHED
}
}

typedef unsigned short bf16;
typedef float f32x4 __attribute__((ext_vector_type(4)));
typedef unsigned u32x4 __attribute__((ext_vector_type(4)));
typedef unsigned u32x2 __attribute__((ext_vector_type(2)));

constexpr int BATCH = 8, SEQ = 4096, T = BATCH * SEQ, D = 1024, DEPTH = 2;
constexpr int NA = 2048, NB = 3328, NIN = NA + NB, INW = 5204;
constexpr int DFF = 2816, NGU = 2 * DFF, PLE = 256, MIXW = 2048;
constexpr int A_Q = 0, A_BG = 512, A_Z = 1024;
constexpr int B_CKV = 0, B_IQ = 256, B_CG = 512, B_HB = 1024, B_XBC = 1536, B_IK = 3072, B_DT = 3136, B_IW = 3152;
constexpr int XBC = 1536, KV_R = 256, TOPK = 256;
constexpr float EPS = 1e-6f;

constexpr size_t MiB = 1u << 20;
constexpr size_t WS_CTL = 0;
constexpr size_t WS_RSTD = 1 * MiB;
constexpr size_t WS_RSTD2 = 1 * MiB + 256 * 1024;
constexpr size_t WS_DT = 2 * MiB;
constexpr size_t WS_W = 8 * MiB;
constexpr size_t WS_W_IN = WS_W, WS_W_OUT = WS_W_IN + (size_t)NIN * D * 2, WS_W_GU = WS_W_OUT + (size_t)D * MIXW * 2, WS_W_DOWN = WS_W_GU + (size_t)NGU * D * 2,
                 WS_W_PG = WS_W_DOWN + (size_t)D * DFF * 2, WS_W_PP = WS_W_PG + (size_t)D * D * 2, WS_W_END = WS_W_PP + (size_t)D * PLE * 2;
constexpr size_t WS_WUK = 42 * MiB, WS_WUV = 43 * MiB;
static_assert(WS_W_END <= 42 * MiB, "weights");
constexpr size_t WS_X0 = 44 * MiB, WS_X1 = 108 * MiB, WS_RA = 172 * MiB, WS_RB = 300 * MiB, WS_DT2 = 508 * MiB, WS_END = 512 * MiB;
constexpr size_t WS_XA = WS_X0;
constexpr size_t WS_IDX = WS_X1 + 48 * MiB;
constexpr size_t WS_CKVC = WS_X1 + 32 * MiB;
constexpr size_t WS_IKC = 4 * MiB;

__host__ __device__ __forceinline__ float bf2f(bf16 b) { return __builtin_bit_cast(float, ((unsigned)b) << 16); }
__host__ __device__ __forceinline__ bf16 f2bf(float f) { unsigned u = __builtin_bit_cast(unsigned, f); return (bf16)((u + 0x7fffu + ((u >> 16) & 1u)) >> 16); }
__device__ __forceinline__ unsigned pk2(float lo, float hi) { return (unsigned)f2bf(lo) | ((unsigned)f2bf(hi) << 16); }
__device__ __forceinline__ float wave_sum(float v) {
#pragma unroll
    for (int o = 1; o < 64; o <<= 1) v += __shfl_xor(v, o);
    return v;
}
__device__ __forceinline__ float wave_max(float v) {
#pragma unroll
    for (int o = 1; o < 64; o <<= 1) v = fmaxf(v, __shfl_xor(v, o));
    return v;
}
__device__ __forceinline__ float sigmoidf_(float v) { return __builtin_amdgcn_rcpf(1.0f + __expf(-v)); }
__device__ __forceinline__ float siluf_(float v) { return v * sigmoidf_(v); }

__host__ __device__ __forceinline__ int src_col_in(int n) {
    if (n < 512) return n;
    if (n < 1024) return 1092 + (n - 512);
    if (n < 2048) return 2628 + (n - 1024);
    n -= 2048;
    if (n < 256) return 512 + n;
    if (n < 512) return 768 + (n - 256);
    if (n < 1024) return 1604 + (n - 512);
    if (n < 1536) return 2116 + (n - 1024);
    if (n < 3072) return 3652 + (n - 1536);
    if (n < 3136) return 1024 + (n - 3072);
    if (n < 3152) return 5188 + (n - 3136);
    if (n < 3156) return 1088 + (n - 3152);
    return -1;
}

__host__ __device__ __forceinline__ int t5_bucket(int rel) {
    const int ret = rel > 0 ? 16 : 0; const int n = rel < 0 ? -rel : rel;
    int b;
    if (n < 8) b = n; else if (n < 15) b = 8; else if (n < 27) b = 9; else if (n < 50) b = 10; else if (n < 91) b = 11; else if (n < 166) b = 12; else if (n < 305) b = 13; else if (n < 559) b = 14; else b = 15;
    return ret + b;
}

template <int MODE> __global__ void __launch_bounds__(256) k_prep_w(const float* __restrict__ W, const float* __restrict__ W2, int K, int Nsrc, const float* __restrict__ gain, bf16* __restrict__ Wt) {
    __shared__ float tile[32][33];
    const int n0 = blockIdx.x * 32, k0 = blockIdx.y * 32, tx = threadIdx.x & 31, ty = threadIdx.x >> 5;
    const int n = n0 + tx; int src; const float* Ws = W;
    if (MODE == 0) src = n; else if (MODE == 1) src = src_col_in(n); else { const int which = (n & 255) >> 7; src = (n >> 8) * 128 + (n & 127); Ws = which ? W2 : W; }
    for (int kk = ty; kk < 32; kk += 8) { float v = 0.f; if (src >= 0) { v = Ws[(size_t)(k0 + kk) * Nsrc + src]; if (gain) v *= gain[k0 + kk]; } tile[kk][tx] = v; }
    __syncthreads();
    for (int nn = ty; nn < 32; nn += 8) Wt[(size_t)(n0 + nn) * K + k0 + tx] = f2bf(tile[tx][nn]);
}

__global__ void __launch_bounds__(256) k_x_prep(const float* __restrict__ x, bf16* __restrict__ xb, float* __restrict__ rstd) {
    const int lane = threadIdx.x & 63, row = blockIdx.x * 4 + (threadIdx.x >> 6);
    const f32x4* xr = (const f32x4*)(x + (size_t)row * D) + lane; float ss = 0.f; f32x4 v[4];
#pragma unroll
    for (int j = 0; j < 4; ++j) { v[j] = xr[64 * j]; ss += (v[j].x * v[j].x + v[j].y * v[j].y) + (v[j].z * v[j].z + v[j].w * v[j].w); }
    ss = wave_sum(ss);
    u32x2* o = (u32x2*)(xb + (size_t)row * D) + lane;
#pragma unroll
    for (int j = 0; j < 4; ++j) { u32x2 w; w.x = pk2(v[j].x, v[j].y); w.y = pk2(v[j].z, v[j].w); o[64 * j] = w; }
    if (lane == 0) rstd[row] = 1.0f / sqrtf(ss * (1.0f / D) + EPS);
}
__global__ void __launch_bounds__(256) k_rstd(const float* __restrict__ x, float* __restrict__ rstd) {
    const int lane = threadIdx.x & 63, row = blockIdx.x * 4 + (threadIdx.x >> 6);
    const f32x4* xr = (const f32x4*)(x + (size_t)row * D) + lane; float ss = 0.f;
#pragma unroll
    for (int j = 0; j < 4; ++j) { const f32x4 v = xr[64 * j]; ss += (v.x * v.x + v.y * v.y) + (v.z * v.z + v.w * v.w); }
    ss = wave_sum(ss);
    if (lane == 0) rstd[row] = 1.0f / sqrtf(ss * (1.0f / D) + EPS);
}
__global__ void __launch_bounds__(256) k_resid_norm(const float* xin, const float* __restrict__ y, const float* __restrict__ g, float* xo, bf16* __restrict__ xb,
                                                    float* __restrict__ rstd_out, const float* __restrict__ p, bf16* __restrict__ pb) {
    const int lane = threadIdx.x & 63, row = blockIdx.x * 4 + (threadIdx.x >> 6);
    const f32x4* yr = (const f32x4*)(y + (size_t)row * D) + lane; const f32x4* xr = (const f32x4*)(xin + (size_t)row * D) + lane; const f32x4* gr = (const f32x4*)g + lane;
    f32x4 v[4]; float ss = 0.f;
#pragma unroll
    for (int j = 0; j < 4; ++j) { v[j] = yr[64 * j]; ss += (v[j].x * v[j].x + v[j].y * v[j].y) + (v[j].z * v[j].z + v[j].w * v[j].w); }
    const float r = 1.0f / sqrtf(wave_sum(ss) * (1.0f / D) + EPS);
    float s2 = 0.f;
    f32x4* xor_ = (f32x4*)(xo + (size_t)row * D) + lane; u32x2* o = (u32x2*)(xb + (size_t)row * D) + lane;
#pragma unroll
    for (int j = 0; j < 4; ++j) { const f32x4 xx = xr[64 * j], gg = gr[64 * j]; f32x4 w = xx + v[j] * r * gg; xor_[64 * j] = w; s2 += (w.x * w.x + w.y * w.y) + (w.z * w.z + w.w * w.w);
        u32x2 q; q.x = pk2(w.x, w.y); q.y = pk2(w.z, w.w); o[64 * j] = q; }
    if (rstd_out) { s2 = wave_sum(s2); if (lane == 0) rstd_out[row] = 1.0f / sqrtf(s2 * (1.0f / D) + EPS); }
    if (p) { const f32x4 pv = *((const f32x4*)(p + (size_t)row * PLE) + lane); u32x2 q; q.x = pk2(pv.x, pv.y); q.y = pk2(pv.z, pv.w); *((u32x2*)(pb + (size_t)row * PLE) + lane) = q; }
}

namespace pg8 {
struct EpiProj {
    static constexpr bool PERM = true, AFTER_DRAIN = false;
    bf16_t* RA; bf16_t* RB; const float* rstd;
    __device__ __forceinline__ void operator()(const f32x4 (&acc)[2][2][4][2], const Unit& u, int wr, int wc, int fr, int fq) const {
        const int row0 = u.pm * BM + wr * 64 + fr; bf16_t* base; int ld, colt;
        if (u.pn < NA / 256) { base = RA; ld = NA; colt = u.pn * BM; } else { base = RB; ld = NB; colt = (u.pn - NA / 256) * BM; }
        const int col0 = colt + wc * 32 + 8 * fq;
        float sr[2][4];
#pragma unroll
        for (int ai = 0; ai < 2; ++ai)
#pragma unroll
            for (int m = 0; m < 4; ++m) sr[ai][m] = rstd[row0 + ai * HALF + m * 16];
#pragma unroll
        for (int ai = 0; ai < 2; ++ai)
#pragma unroll
            for (int m = 0; m < 4; ++m) { const int r = row0 + ai * HALF + m * 16; const float s = sr[ai][m]; bf16_t* rowp = base + (size_t)r * ld + col0;
#pragma unroll
                for (int bj = 0; bj < 2; ++bj) { const f32x4 v0 = acc[ai][bj][m][0] * s, v1 = acc[ai][bj][m][1] * s;
                    u32x4 w; w.x = cvt_pk_bf16(v0[0], v0[1]); w.y = cvt_pk_bf16(v0[2], v0[3]); w.z = cvt_pk_bf16(v1[0], v1[1]); w.w = cvt_pk_bf16(v1[2], v1[3]);
                    *(u32x4*)(rowp + bj * HALF) = w; } }
    }
};
struct EpiF32 {
    static constexpr bool PERM = false, AFTER_DRAIN = false;
    float* C; long ldc;
    __device__ __forceinline__ void operator()(const f32x4 (&acc)[2][2][4][2], const Unit& u, int wr, int wc, int fr, int fq) const {
        const int row0 = u.pm * BM + wr * 64 + fr, col0 = u.pn * BM + wc * 32 + 4 * fq;
#pragma unroll
        for (int ai = 0; ai < 2; ++ai)
#pragma unroll
            for (int m = 0; m < 4; ++m) { float* rowp = C + (size_t)(row0 + ai * HALF + m * 16) * ldc + col0;
#pragma unroll
                for (int bj = 0; bj < 2; ++bj)
#pragma unroll
                    for (int n = 0; n < 2; ++n) *(f32x4*)(rowp + bj * HALF + n * 16) = acc[ai][bj][m][n]; }
    }
};
struct EpiBf16P {
    static constexpr bool PERM = true, AFTER_DRAIN = false;
    bf16_t* O; long ldc;
    __device__ __forceinline__ void operator()(const f32x4 (&acc)[2][2][4][2], const Unit& u, int wr, int wc, int fr, int fq) const {
        const int row0 = u.pm * BM + wr * 64 + fr, col0 = u.pn * BM + wc * 32 + 8 * fq;
#pragma unroll
        for (int ai = 0; ai < 2; ++ai)
#pragma unroll
            for (int m = 0; m < 4; ++m) { bf16_t* rowp = O + (size_t)(row0 + ai * HALF + m * 16) * ldc + col0;
#pragma unroll
                for (int bj = 0; bj < 2; ++bj) { const f32x4 v0 = acc[ai][bj][m][0], v1 = acc[ai][bj][m][1];
                    u32x4 w; w.x = cvt_pk_bf16(v0[0], v0[1]); w.y = cvt_pk_bf16(v0[2], v0[3]); w.z = cvt_pk_bf16(v1[0], v1[1]); w.w = cvt_pk_bf16(v1[2], v1[3]);
                    *(u32x4*)(rowp + bj * HALF) = w; } }
    }
};
struct EpiSwiGLU {
    static constexpr bool PERM = true, AFTER_DRAIN = false;
    bf16_t* G; const float* rstd;
    __device__ __forceinline__ void operator()(const f32x4 (&acc)[2][2][4][2], const Unit& u, int wr, int wc, int fr, int fq) const {
        const int row0 = u.pm * BM + wr * 64 + fr, col0 = u.pn * HALF + wc * 32 + 8 * fq;
        float sr[2][4];
#pragma unroll
        for (int ai = 0; ai < 2; ++ai)
#pragma unroll
            for (int m = 0; m < 4; ++m) sr[ai][m] = rstd[row0 + ai * HALF + m * 16];
#pragma unroll
        for (int ai = 0; ai < 2; ++ai)
#pragma unroll
            for (int m = 0; m < 4; ++m) { const int r = row0 + ai * HALF + m * 16; const float s = sr[ai][m]; float o[8];
#pragma unroll
                for (int n = 0; n < 2; ++n)
#pragma unroll
                    for (int j = 0; j < 4; ++j) { const float gt = acc[ai][0][m][n][j] * s, up = acc[ai][1][m][n][j] * s; o[n * 4 + j] = gt * __builtin_amdgcn_rcpf(1.0f + __expf(-gt)) * up; }
                u32x4 w; w.x = cvt_pk_bf16(o[0], o[1]); w.y = cvt_pk_bf16(o[2], o[3]); w.z = cvt_pk_bf16(o[4], o[5]); w.w = cvt_pk_bf16(o[6], o[7]);
                *(u32x4*)(G + (size_t)r * DFF + col0) = w; }
    }
};
struct EpiPle {
    static constexpr bool PERM = true, AFTER_DRAIN = false;
    const bf16_t* X; const bf16_t* Tt; bf16_t* XB; float* OUT;
    __device__ __forceinline__ void operator()(const f32x4 (&acc)[2][2][4][2], const Unit& u, int wr, int wc, int fr, int fq) const {
        const int row0 = u.pm * BM + wr * 64 + fr, col0 = u.pn * BM + wc * 32 + 8 * fq;
        u32x4 tv[2][2], xv[2][2];
#define PLE_LOAD(slot, grp) do { const size_t off_ = (size_t)(row0 + ((grp) >> 2) * HALF + ((grp) & 3) * 16) * D + col0; _Pragma("unroll") for (int bj_ = 0; bj_ < 2; ++bj_) { \
            tv[slot][bj_] = *(const u32x4*)(Tt + off_ + bj_ * HALF); xv[slot][bj_] = *(const u32x4*)(X + off_ + bj_ * HALF); } } while (0)
        PLE_LOAD(0, 0);
#pragma unroll
        for (int grp = 0; grp < 8; ++grp) { const int ai = grp >> 2, m = grp & 3, sl = grp & 1; const size_t off = (size_t)(row0 + ai * HALF + m * 16) * D + col0;
            if (grp + 1 < 8) PLE_LOAD((grp + 1) & 1, grp + 1);
#pragma unroll
            for (int bj = 0; bj < 2; ++bj) { const unsigned tw[4] = {tv[sl][bj].x, tv[sl][bj].y, tv[sl][bj].z, tv[sl][bj].w}, xw[4] = {xv[sl][bj].x, xv[sl][bj].y, xv[sl][bj].z, xv[sl][bj].w}; f32x4 x0, x1;
#pragma unroll
                for (int j = 0; j < 4; ++j) { const float t0 = __builtin_bit_cast(float, (j & 1) ? (tw[j >> 1] & 0xffff0000u) : (tw[j >> 1] << 16));
                    const float t1 = __builtin_bit_cast(float, (j & 1) ? (tw[2 + (j >> 1)] & 0xffff0000u) : (tw[2 + (j >> 1)] << 16));
                    const float a0 = __builtin_bit_cast(float, (j & 1) ? (xw[j >> 1] & 0xffff0000u) : (xw[j >> 1] << 16));
                    const float a1 = __builtin_bit_cast(float, (j & 1) ? (xw[2 + (j >> 1)] & 0xffff0000u) : (xw[2 + (j >> 1)] << 16));
                    x0[j] = a0 + __builtin_amdgcn_rcpf(1.0f + __expf(-acc[ai][bj][m][0][j])) * t0; x1[j] = a1 + __builtin_amdgcn_rcpf(1.0f + __expf(-acc[ai][bj][m][1][j])) * t1; }
                if (OUT) { *(f32x4*)(OUT + off + bj * HALF) = x0; *(f32x4*)(OUT + off + bj * HALF + 4) = x1; }
                else { u32x4 w; w.x = cvt_pk_bf16(x0[0], x0[1]); w.y = cvt_pk_bf16(x0[2], x0[3]); w.z = cvt_pk_bf16(x1[0], x1[1]); w.w = cvt_pk_bf16(x1[2], x1[3]);
                    *(u32x4*)(XB + off + bj * HALF) = w; } } }
#undef PLE_LOAD
    }
};
}

__device__ __forceinline__ unsigned ord_key(float f) { const unsigned u = __builtin_bit_cast(unsigned, f); return (u & 0x80000000u) ? ~u : (u | 0x80000000u); }
#define LAS __attribute__((address_space(3)))
#define XB_TMO      128
#define XB_XCNT(j)  (256  + 64 * (j))
#define XB_XSUB(j)  (1280 + 64 * (j))
#define XB_XGEN(j)  (2304 + 64 * (j))
#define XB_TOP      3328
#define XB_TOPGEN   3392
#define XCD_BAR_WORDS 3456
#define XB_SPIN_CAP (1u << 18)

__device__ __forceinline__ unsigned xb_ld(unsigned* p)              { return __hip_atomic_load(p, __ATOMIC_RELAXED, __HIP_MEMORY_SCOPE_AGENT); }
__device__ __forceinline__ unsigned xb_add(unsigned* p, unsigned v) { return __hip_atomic_fetch_add(p, v, __ATOMIC_RELAXED, __HIP_MEMORY_SCOPE_AGENT); }
__device__ __forceinline__ unsigned xb_xcc_id() { return (unsigned)__builtin_amdgcn_s_getreg((3 << 11) | 20) & 0xFu; }
#define XB_SPIN(cond, bar) do { unsigned _sp = 0; while (cond) { __builtin_amdgcn_s_sleep(1); \
    if ((++_sp & 255u) == 0u) { if (xb_ld(&(bar)[XB_TMO])) break; if (_sp > XB_SPIN_CAP) { atomicAdd(&(bar)[XB_TMO], 1u); break; } } } } while (0)

struct XcdBarrier {
    unsigned* bar; unsigned x;
    volatile LAS unsigned* st;
};

__device__ __forceinline__ XcdBarrier xcd_barrier_post(unsigned* bar, volatile LAS unsigned* st) {
    XcdBarrier b; b.bar = bar; b.x = xb_xcc_id(); b.st = st;
    if (threadIdx.x == 0) (void)xb_add(&bar[XB_XCNT(b.x)], 1u);
    return b;
}
__device__ __forceinline__ void xcd_barrier_complete(unsigned* bar, unsigned x, unsigned& nloc, unsigned& nx) {
    const unsigned G = gridDim.x * gridDim.y * gridDim.z;
    unsigned sum, cnt, mine, sp = 0u;
    for (;;) {
        sum = 0u; cnt = 0u; mine = 0u;
#pragma unroll
        for (unsigned j = 0; j < 16; ++j) { const unsigned c = xb_ld(&bar[XB_XCNT(j)]); sum += c; cnt += (c > 0u) ? 1u : 0u; mine = (j == x) ? c : mine; }
        if (sum == G) break;
        __builtin_amdgcn_s_sleep(1);
        if ((++sp & 255u) == 0u) { if (xb_ld(&bar[XB_TMO])) break; if (sp > XB_SPIN_CAP) { atomicAdd(&bar[XB_TMO], 1u); break; } }
    }
    nloc = mine > 0u ? mine : 1u; nx = cnt > 0u ? cnt : 1u;
}

__device__ __forceinline__ void xcd_barrier(const XcdBarrier& b, int tid_in) {
    asm volatile("s_waitcnt vmcnt(0)" ::: "memory");
    __syncthreads();
    if (tid_in == 0) {
        unsigned* bar = b.bar;
        __builtin_amdgcn_s_waitcnt(0);
        unsigned nloc = b.st[0], nx = b.st[1];
        if (nloc == 0u) { xcd_barrier_complete(bar, b.x, nloc, nx); b.st[0] = nloc; b.st[1] = nx; }
        const unsigned old = xb_add(&bar[XB_XSUB(b.x)], 1u);
        const unsigned gen = old / nloc;
        if (old + 1u == (gen + 1u) * nloc) {
            __builtin_amdgcn_fence(__ATOMIC_RELEASE, "agent");
            asm volatile("s_waitcnt vmcnt(0)" ::: "memory");
            const unsigned og = xb_add(&bar[XB_TOP], 1u);
            const unsigned tg = og / nx;
            if (og + 1u == (tg + 1u) * nx) xb_add(&bar[XB_TOPGEN], 1u);
            else XB_SPIN(xb_ld(&bar[XB_TOPGEN]) == tg, bar);
            __builtin_amdgcn_fence(__ATOMIC_ACQUIRE, "agent");
            xb_add(&bar[XB_XGEN(b.x)], 1u);
            asm volatile("s_waitcnt vmcnt(0)" ::: "memory");
        } else {
            XB_SPIN(xb_ld(&bar[XB_XGEN(b.x)]) == gen, bar);
            __builtin_amdgcn_fence(__ATOMIC_ACQUIRE, "agent");
            asm volatile("s_waitcnt vmcnt(0)" ::: "memory");
        }
    }
    __syncthreads();
}


constexpr int NTHR = 512, NWAVES = 8;
constexpr int RING_BYTES = 131072, LDS_BYTES = 147456, MISC_OFF = LDS_BYTES - 512;
constexpr int CW_BAR = 4096, CW_RANK = 8192;
constexpr size_t CTL_ZERO_BYTES = 1 * MiB;
constexpr int NPH = 14;

__device__ __forceinline__ int mk_tid(int wave_s) { int l_; asm volatile("v_mbcnt_lo_u32_b32 %0, -1, 0\n\tv_mbcnt_hi_u32_b32 %0, -1, %0" : "=v"(l_)); return wave_s * 64 + l_; }
struct Params { const float* in[26]; float* out; unsigned char* ws; int ph_lo, ph_hi, dbl_mask, pad; };
static_assert(sizeof(Params) == 26 * 8 + 8 + 8 + 16, "no padding");

#define LDSP __attribute__((address_space(3)))
#define LDS_WAIT() asm volatile("s_waitcnt lgkmcnt(0)" ::: "memory")
#ifndef NAIVE_SELECT
#define NAIVE_SELECT 0
#endif
#ifndef NAIVE_ATTN
#define NAIVE_ATTN 0
#endif
#ifndef NAIVE_SSM
#define NAIVE_SSM 0
#endif
#ifndef DBG_SSM
#define DBG_SSM 0
#endif
#ifndef TIMING
#define TIMING 0
#endif
#ifndef DBL_MASK
#define DBL_MASK 0
#endif
#ifndef GEMM_DRYK
#define GEMM_DRYK 0
#endif
#ifndef CLK_PROBE
#define CLK_PROBE 0
#endif
#ifndef XTRA_BAR
#define XTRA_BAR 0
#endif
#ifndef ATT_SUB_V
#define ATT_SUB_V 0
#endif
#ifndef TIMING_SHIFT
#define TIMING_SHIFT 0.0f
#endif
#ifndef TIMING_A
#define TIMING_A 2
#endif
#ifndef TIMING_B
#define TIMING_B 3
#endif

template <int MODE> __device__ __forceinline__ void ph_prep_w(LDSP float* scr, const float* __restrict__ W, const float* __restrict__ W2, int K, int Nsrc, const float* __restrict__ gain, bf16* __restrict__ Wt, int Ndst, int gw, int NGW, int lane) {
    const int ntn = Ndst / 32, nt = ntn * (K / 64), tx = lane & 31, ty = lane >> 5;
    for (int it = gw; it < nt; it += NGW) {
        const int n0 = (it % ntn) * 32, k0 = (it / ntn) * 64, n = n0 + tx; int src; const float* Ws = W;
        if (MODE == 0) src = n; else if (MODE == 1) src = src_col_in(n); else { const int which = (n & 255) >> 7; src = (n >> 8) * 128 + (n & 127); Ws = which ? W2 : W; }
#pragma unroll 8
        for (int i = 0; i < 32; ++i) { const int kk = 2 * i + ty; float v = 0.f; if (src >= 0) { v = Ws[(size_t)(k0 + kk) * Nsrc + src]; if (gain) v *= gain[k0 + kk]; } scr[kk * 33 + tx] = v; }
        LDS_WAIT(); asm volatile("" ::: "memory");
        const int cc = lane & 7;
#pragma unroll
        for (int j = 0; j < 4; ++j) { const int nn = (lane >> 3) + 8 * j; const LDSP float* s = scr + (8 * cc) * 33 + nn;
            u32x4 o; o.x = pk2(s[0 * 33], s[1 * 33]); o.y = pk2(s[2 * 33], s[3 * 33]); o.z = pk2(s[4 * 33], s[5 * 33]); o.w = pk2(s[6 * 33], s[7 * 33]);
            *(u32x4*)(Wt + (size_t)(n0 + nn) * K + k0 + 8 * cc) = o; }
        LDS_WAIT(); asm volatile("" ::: "memory");
    }
}
__device__ __forceinline__ void row_x_prep(const float* __restrict__ x, bf16* __restrict__ xb, float* __restrict__ rstd, int row, int lane) {
    const f32x4* xr = (const f32x4*)(x + (size_t)row * D) + lane; float ss = 0.f; f32x4 v[4];
#pragma unroll
    for (int j = 0; j < 4; ++j) { v[j] = xr[64 * j]; ss += (v[j].x * v[j].x + v[j].y * v[j].y) + (v[j].z * v[j].z + v[j].w * v[j].w); }
    ss = wave_sum(ss);
    if (xb) { u32x2* o = (u32x2*)(xb + (size_t)row * D) + lane;
#pragma unroll
        for (int j = 0; j < 4; ++j) { u32x2 w; w.x = pk2(v[j].x, v[j].y); w.y = pk2(v[j].z, v[j].w); o[64 * j] = w; } }
    if (lane == 0) rstd[row] = 1.0f / sqrtf(ss * (1.0f / D) + EPS);
}
__device__ __forceinline__ void row_resid_norm(const float* xin, const float* __restrict__ y, const float* __restrict__ g, float* xo, bf16* __restrict__ xb, float* __restrict__ rstd_out, const float* __restrict__ p, bf16* __restrict__ pb, int row, int lane, bool dry = false) {
    const f32x4* yr = (const f32x4*)(y + (size_t)row * D) + lane; const f32x4* xr = (const f32x4*)(xin + (size_t)row * D) + lane; const f32x4* gr = (const f32x4*)g + lane;
    f32x4 v[4]; float ss = 0.f;
#pragma unroll
    for (int j = 0; j < 4; ++j) { v[j] = yr[64 * j]; ss += (v[j].x * v[j].x + v[j].y * v[j].y) + (v[j].z * v[j].z + v[j].w * v[j].w); }
    const float r = 1.0f / sqrtf(wave_sum(ss) * (1.0f / D) + EPS);
    float s2 = 0.f;
    f32x4* xor_ = (f32x4*)(xo + (size_t)row * D) + lane; u32x2* o = (u32x2*)(xb + (size_t)row * D) + lane;
#pragma unroll
    for (int j = 0; j < 4; ++j) { const f32x4 xx = xr[64 * j], gg = gr[64 * j]; f32x4 w = xx + v[j] * r * gg; if (!dry) xor_[64 * j] = w; s2 += (w.x * w.x + w.y * w.y) + (w.z * w.z + w.w * w.w);
        u32x2 q; q.x = pk2(w.x, w.y); q.y = pk2(w.z, w.w); o[64 * j] = q; }
    if (rstd_out) { s2 = wave_sum(s2); if (lane == 0) rstd_out[row] = 1.0f / sqrtf(s2 * (1.0f / D) + EPS); }
    if (p) { const f32x4 pv = *((const f32x4*)(p + (size_t)row * PLE) + lane); u32x2 q; q.x = pk2(pv.x, pv.y); q.y = pk2(pv.z, pv.w); *((u32x2*)(pb + (size_t)row * PLE) + lane) = q; }
}

__device__ __forceinline__ void row_resid_norm2(const bf16* xin, const bf16* __restrict__ y, const float* __restrict__ g, bf16* xo, float* __restrict__ rstd_out, const float* __restrict__ p, bf16* __restrict__ pb, int row0, int lane, bool dry = false) {
    f32x4 v[2][4], xx[2][4], pv[2]; const f32x4* gr = (const f32x4*)g + lane;
#pragma unroll
    for (int r = 0; r < 2; ++r) { const u32x2* yr = (const u32x2*)(y + (size_t)(row0 + r) * D) + lane; const u32x2* xr = (const u32x2*)(xin + (size_t)(row0 + r) * D) + lane;
#pragma unroll
        for (int j = 0; j < 4; ++j) { const u32x2 yw = yr[64 * j], xw = xr[64 * j];
            v[r][j] = (f32x4){__builtin_bit_cast(float, yw.x << 16), __builtin_bit_cast(float, yw.x & 0xffff0000u), __builtin_bit_cast(float, yw.y << 16), __builtin_bit_cast(float, yw.y & 0xffff0000u)};
            xx[r][j] = (f32x4){__builtin_bit_cast(float, xw.x << 16), __builtin_bit_cast(float, xw.x & 0xffff0000u), __builtin_bit_cast(float, xw.y << 16), __builtin_bit_cast(float, xw.y & 0xffff0000u)}; }
        if (p) pv[r] = *((const f32x4*)(p + (size_t)(row0 + r) * PLE) + lane); }
    f32x4 gg[4];
#pragma unroll
    for (int j = 0; j < 4; ++j) gg[j] = gr[64 * j];
#pragma unroll
    for (int r = 0; r < 2; ++r) { float ss = 0.f;
#pragma unroll
        for (int j = 0; j < 4; ++j) ss += (v[r][j].x * v[r][j].x + v[r][j].y * v[r][j].y) + (v[r][j].z * v[r][j].z + v[r][j].w * v[r][j].w);
        const float rr = 1.0f / sqrtf(wave_sum(ss) * (1.0f / D) + EPS); float s2 = 0.f;
        u32x2* o = (u32x2*)(xo + (size_t)(row0 + r) * D) + lane;
#pragma unroll
        for (int j = 0; j < 4; ++j) { const f32x4 w = xx[r][j] + v[r][j] * rr * gg[j]; u32x2 q; q.x = pk2(w.x, w.y); q.y = pk2(w.z, w.w); if (!dry) o[64 * j] = q;
            const float r0 = __builtin_bit_cast(float, q.x << 16), r1 = __builtin_bit_cast(float, q.x & 0xffff0000u), r2 = __builtin_bit_cast(float, q.y << 16), r3 = __builtin_bit_cast(float, q.y & 0xffff0000u);
            s2 += (r0 * r0 + r1 * r1) + (r2 * r2 + r3 * r3); }
        if (rstd_out) { s2 = wave_sum(s2); if (lane == 0) rstd_out[row0 + r] = 1.0f / sqrtf(s2 * (1.0f / D) + EPS); }
        if (p) { u32x2 q; q.x = pk2(pv[r].x, pv[r].y); q.y = pk2(pv[r].z, pv[r].w); *((u32x2*)(pb + (size_t)(row0 + r) * PLE) + lane) = q; } }
}
__device__ __forceinline__ void row_rstd_bf16(const bf16* __restrict__ xb, float* __restrict__ rstd, int row, int lane) {
    const u32x2* xr = (const u32x2*)(xb + (size_t)row * D) + lane; float ss = 0.f;
#pragma unroll
    for (int j = 0; j < 4; ++j) { const u32x2 w = xr[64 * j]; const float a = __builtin_bit_cast(float, w.x << 16), b = __builtin_bit_cast(float, w.x & 0xffff0000u), c2 = __builtin_bit_cast(float, w.y << 16), d = __builtin_bit_cast(float, w.y & 0xffff0000u); ss += (a * a + b * b) + (c2 * c2 + d * d); }
    ss = wave_sum(ss); if (lane == 0) rstd[row] = 1.0f / sqrtf(ss * (1.0f / D) + EPS);
}
__device__ __forceinline__ void wave_gnorm4(bf16* RA, const float* __restrict__ nw, int w0, int lane, bool dry = false) {
    u32x4 v[4]; float ss[4];
#pragma unroll
    for (int i = 0; i < 4; ++i) { const int w = w0 + i, t = w >> 1, g = w & 1; v[i] = *(const u32x4*)(RA + (size_t)t * NA + A_Z + g * 512 + lane * 8); }
    float f[4][8];
#pragma unroll
    for (int i = 0; i < 4; ++i) { const unsigned vw[4] = {v[i].x, v[i].y, v[i].z, v[i].w}; ss[i] = 0.f;
#pragma unroll
        for (int e = 0; e < 8; ++e) { f[i][e] = bf2f((bf16)((vw[e >> 1] >> ((e & 1) * 16)) & 0xffff)); ss[i] += f[i][e] * f[i][e]; } }
#pragma unroll
    for (int o = 1; o < 64; o <<= 1) {
#pragma unroll
        for (int i = 0; i < 4; ++i) ss[i] += __shfl_xor(ss[i], o); }
#pragma unroll
    for (int i = 0; i < 4; ++i) { const int w = w0 + i, t = w >> 1, g = w & 1; const float r = 1.0f / sqrtf(ss[i] * (1.0f / 512.0f) + EPS); const float* gw = nw + g * 512 + lane * 8;
        u32x4 o; o.x = pk2(f[i][0] * r * gw[0], f[i][1] * r * gw[1]); o.y = pk2(f[i][2] * r * gw[2], f[i][3] * r * gw[3]); o.z = pk2(f[i][4] * r * gw[4], f[i][5] * r * gw[5]); o.w = pk2(f[i][6] * r * gw[6], f[i][7] * r * gw[7]);
        if (!dry) *(u32x4*)(RA + (size_t)t * NA + A_Z + g * 512 + lane * 8) = o; }
}
__device__ __forceinline__ void tok_m1(bf16* __restrict__ RA, bf16* __restrict__ RB, bf16* __restrict__ CKVC, bf16* __restrict__ IKC, const float* __restrict__ kvn, const float* __restrict__ ikg, const float* __restrict__ ikb, const float* __restrict__ scw, int t, int lane) {
    const int s = t & (SEQ - 1); bf16* rb = RB + (size_t)t * NB;
    {   const u32x2 w = *((const u32x2*)(rb + B_CKV) + lane); float v[4] = {bf2f((bf16)(w.x & 0xffff)), bf2f((bf16)(w.x >> 16)), bf2f((bf16)(w.y & 0xffff)), bf2f((bf16)(w.y >> 16))};
        float ss = (v[0] * v[0] + v[1] * v[1]) + (v[2] * v[2] + v[3] * v[3]); ss = wave_sum(ss); const float r = 1.0f / sqrtf(ss * (1.0f / KV_R) + EPS);
        const f32x4 g = *((const f32x4*)kvn + lane); u32x2 o; o.x = pk2(v[0] * r * g.x, v[1] * r * g.y); o.y = pk2(v[2] * r * g.z, v[3] * r * g.w); *((u32x2*)(rb + B_CKV) + lane) = o; *((u32x2*)(CKVC + (size_t)t * KV_R) + lane) = o; }
    {   const float x = bf2f(rb[B_IK + lane]); const float mu = wave_sum(x) * (1.0f / 64.0f); const float d = x - mu; const float var = wave_sum(d * d) * (1.0f / 64.0f);
        const bf16 o = f2bf(d * (1.0f / sqrtf(var + EPS)) * ikg[lane] + ikb[lane]); rb[B_IK + lane] = o; IKC[(size_t)t * 64 + lane] = o; }
    {   const int c = lane * 8; float acc[8] = {0.f, 0.f, 0.f, 0.f, 0.f, 0.f, 0.f, 0.f};
        for (int j = 0; j < 3; ++j) { const int ss_ = s - 2 + j; if (ss_ < 0) continue; const bf16* rr = RB + (size_t)(t - 2 + j) * NB;
            const u32x4 cg = *(const u32x4*)(rr + B_CG + c), hb = *(const u32x4*)(rr + B_HB + c); const unsigned cw[4] = {cg.x, cg.y, cg.z, cg.w}, hw[4] = {hb.x, hb.y, hb.z, hb.w};
#pragma unroll
            for (int e = 0; e < 8; ++e) { const float a = bf2f((bf16)((cw[e >> 1] >> ((e & 1) * 16)) & 0xffff)), b = bf2f((bf16)((hw[e >> 1] >> ((e & 1) * 16)) & 0xffff)); acc[e] += scw[j * 512 + c + e] * (a * b); } }
        bf16* ra = RA + (size_t)t * NA + A_BG + c; const u32x4 bg = *(const u32x4*)ra; const unsigned bw[4] = {bg.x, bg.y, bg.z, bg.w}; float o[8];
#pragma unroll
        for (int e = 0; e < 8; ++e) o[e] = bf2f((bf16)((bw[e >> 1] >> ((e & 1) * 16)) & 0xffff)) * acc[e];
        u32x4 w; w.x = pk2(o[0], o[1]); w.y = pk2(o[2], o[3]); w.z = pk2(o[4], o[5]); w.w = pk2(o[6], o[7]); *(u32x4*)ra = w; }
}
__device__ __forceinline__ void tok_m4a(const bf16* __restrict__ RB, const float* __restrict__ cw, const float* __restrict__ cb, const float* __restrict__ dtb, bf16* __restrict__ XA, float* __restrict__ DT, int t, int lane) {
    const int s = t & (SEQ - 1);
    for (int c = lane; c < XBC; c += 64) { float a = cb[c];
#pragma unroll
        for (int j = 0; j < 4; ++j) { const int ss = s - 3 + j; if (ss >= 0) a += cw[j * XBC + c] * bf2f(RB[(size_t)(t - 3 + j) * NB + B_XBC + c]); }
        XA[(size_t)t * XBC + c] = f2bf(siluf_(a)); }
    if (lane < 16) { const float x = bf2f(RB[(size_t)t * NB + B_DT + lane]) + dtb[lane]; DT[(size_t)t * 16 + lane] = x > 15.f ? x : log1pf(__expf(x)); }
}
__device__ __forceinline__ void wg_m2_select(LDSP unsigned char* lds, const bf16* __restrict__ RB, unsigned short* __restrict__ idx, int t, int tid) {
    LDSP float* iq = (LDSP float*)lds; LDSP float* iwv = iq + 256; LDSP unsigned* red = (LDSP unsigned*)(iq + 272); LDSP unsigned* keys = (LDSP unsigned*)(iq + 288);
    const int s = t & (SEQ - 1), b = t >> 12, lane = tid & 63, wv = tid >> 6;
    const int nk = ((s >> 6) + 1) << 6;
    const bf16* rb = RB + (size_t)t * NB;
    if (tid < 256) iq[tid] = bf2f(rb[B_IQ + tid]); if (tid < 4) iwv[tid] = bf2f(rb[B_IW + tid]) * (0.125f * 0.5f);
    __syncthreads();
    for (int k = tid; k < nk; k += NTHR) {
        const bf16* kr = RB + (size_t)(b * SEQ + k) * NB + B_IK; float sc = 0.f;
        float d0 = 0.f, d1 = 0.f, d2 = 0.f, d3 = 0.f;
#pragma unroll 1
        for (int j = 0; j < 8; ++j) { const u32x4 w = *((const u32x4*)kr + j); const unsigned ww[4] = {w.x, w.y, w.z, w.w};
#pragma unroll
            for (int e = 0; e < 8; ++e) { const float kv = bf2f((bf16)((ww[e >> 1] >> ((e & 1) * 16)) & 0xffff)); const int c = j * 8 + e;
                d0 += iq[c] * kv; d1 += iq[64 + c] * kv; d2 += iq[128 + c] * kv; d3 += iq[192 + c] * kv; } }
        sc += fmaxf(d0, 0.f) * iwv[0]; sc += fmaxf(d1, 0.f) * iwv[1]; sc += fmaxf(d2, 0.f) * iwv[2]; sc += fmaxf(d3, 0.f) * iwv[3];
        keys[k] = ord_key(sc);
    }
    __syncthreads();
    unsigned Tt = 0u;
    if (nk > TOPK) {
        for (int bit = 31; bit >= 0; --bit) { const unsigned cand = Tt | (1u << bit); unsigned c = 0;
            for (int k = tid; k < nk; k += NTHR) c += (keys[k] >= cand) ? 1u : 0u;
#pragma unroll
            for (int o = 1; o < 64; o <<= 1) c += __shfl_xor(c, o);
            if (lane == 0) red[wv] = c;
            __syncthreads();
            unsigned tot = 0;
#pragma unroll
            for (int w = 0; w < 8; ++w) tot += red[w];
            if (tot >= (unsigned)TOPK) Tt = cand;
            __syncthreads(); }
    }
    { unsigned c = 0; for (int k = tid; k < nk; k += NTHR) c += (keys[k] > Tt) ? 1u : 0u;
#pragma unroll
      for (int o = 1; o < 64; o <<= 1) c += __shfl_xor(c, o);
      if (lane == 0) red[8 + wv] = c; }
    __syncthreads();
    if (wv == 0) {
        int ngt = 0;
#pragma unroll
        for (int w = 0; w < 8; ++w) ngt += (int)red[8 + w];
        const int need = TOPK - ngt; int pos = 0, eq_taken = 0; const unsigned long long lt = (1ull << lane) - 1ull;
        for (int base = 0; base < nk; base += 64) { const unsigned k = keys[base + lane]; const bool gt = k > Tt, eq = (k == Tt);
            const unsigned long long meq = __ballot(eq); const int rank_eq = __popcll(meq & lt); const bool take = gt || (eq && (eq_taken + rank_eq < need));
            const unsigned long long msel = __ballot(take);
            if (take) { const int o = pos + __popcll(msel & lt); if (o < TOPK) idx[(size_t)t * TOPK + o] = (unsigned short)(base + lane); }
            pos += __popcll(msel); eq_taken += __popcll(__ballot(eq && take)); }
    }
    __syncthreads();
}
__device__ __forceinline__ void wg_m3_attn(LDSP unsigned char* lds, bf16* RA, const bf16* __restrict__ RB, const unsigned short* __restrict__ idx, const float* __restrict__ w_uk, const float* __restrict__ w_uv, const float* __restrict__ rel_bias, int t, int tid) {
    LDSP float* q = (LDSP float*)lds; LDSP float* qlat = q + 512; LDSP float* pr = qlat + 2048; LDSP float* outl = pr + 2048; LDSP unsigned short* sel = (LDSP unsigned short*)(outl + 2048);
    const int s = t & (SEQ - 1), b = t >> 12, lane = tid & 63, wv = tid >> 6;
    const int nk = ((s >> 6) + 1) << 6, nsel = nk < TOPK ? nk : TOPK;
    q[tid] = bf2f(RA[(size_t)t * NA + A_Q + tid]); if (tid < 256) sel[tid] = tid < nsel ? idx[(size_t)t * TOPK + tid] : (unsigned short)0;
    __syncthreads();
    {   const int r = tid & 255, h0 = (tid >> 8) * 4;
        for (int h = h0; h < h0 + 4; ++h) { const float* w = w_uk + ((size_t)r * 8 + h) * 64; float a = 0.f;
#pragma unroll 16
            for (int d = 0; d < 64; ++d) a += q[h * 64 + d] * w[d];
            qlat[h * 256 + r] = a * 0.125f; } }
    __syncthreads();
    {   const int k = tid & 255, h0 = (tid >> 8) * 4;
        if (k < nsel) { const int key = sel[k]; const bf16* kr = RB + (size_t)(b * SEQ + key) * NB + B_CKV; float a[4] = {0.f, 0.f, 0.f, 0.f};
            for (int j = 0; j < 32; ++j) { const u32x4 w = *((const u32x4*)kr + j); const unsigned ww[4] = {w.x, w.y, w.z, w.w};
#pragma unroll
                for (int e = 0; e < 8; ++e) { const float v = bf2f((bf16)((ww[e >> 1] >> ((e & 1) * 16)) & 0xffff));
#pragma unroll
                    for (int hh = 0; hh < 4; ++hh) a[hh] += qlat[(h0 + hh) * 256 + j * 8 + e] * v; } }
            const int bk = t5_bucket(key - s);
#pragma unroll
            for (int hh = 0; hh < 4; ++hh) pr[(h0 + hh) * 256 + k] = a[hh] + rel_bias[bk * 8 + h0 + hh];
        } else {
#pragma unroll
            for (int hh = 0; hh < 4; ++hh) pr[(h0 + hh) * 256 + k] = -INFINITY; } }
    __syncthreads();
    {   float v[4]; float m = -INFINITY;
#pragma unroll
        for (int j = 0; j < 4; ++j) { v[j] = pr[wv * 256 + lane + 64 * j]; m = fmaxf(m, v[j]); }
        m = wave_max(m); float sum = 0.f;
#pragma unroll
        for (int j = 0; j < 4; ++j) { v[j] = __expf(v[j] - m); sum += v[j]; }
        sum = wave_sum(sum); const float inv = 1.0f / sum;
#pragma unroll
        for (int j = 0; j < 4; ++j) pr[wv * 256 + lane + 64 * j] = v[j] * inv; }
    __syncthreads();
    {   const int r = tid & 255, h0 = (tid >> 8) * 4; float a[4] = {0.f, 0.f, 0.f, 0.f};
        for (int k = 0; k < nsel; ++k) { const float v = bf2f(RB[(size_t)(b * SEQ + sel[k]) * NB + B_CKV + r]);
#pragma unroll
            for (int hh = 0; hh < 4; ++hh) a[hh] += pr[(h0 + hh) * 256 + k] * v; }
#pragma unroll
        for (int hh = 0; hh < 4; ++hh) outl[(h0 + hh) * 256 + r] = a[hh]; }
    __syncthreads();
    {   const int h = tid >> 6, d = tid & 63; float a = 0.f;
        for (int r = 0; r < 256; ++r) a += outl[h * 256 + r] * w_uv[((size_t)r * 8 + h) * 64 + d];
        RA[(size_t)t * NA + A_Q + tid] = f2bf(a); }
    __syncthreads();
}
__device__ __forceinline__ void half_m4b_scan(bf16* RA, const bf16* __restrict__ XA, const float* __restrict__ DT, const float* __restrict__ a_log, const float* __restrict__ dsk, int b, int h, int tid) {
    const int g = h >> 3, p = tid >> 2, nq = tid & 3;
    const float A = -__expf(a_log[h]), Dh = dsk[h];
    float hs[32];
#pragma unroll
    for (int n = 0; n < 32; ++n) hs[n] = 0.f;
    for (int s = 0; s < SEQ; ++s) { const size_t t = (size_t)b * SEQ + s; const float dt = DT[t * 16 + h]; const float dA = __expf(dt * A);
        const bf16* xr = XA + t * XBC; const float x = bf2f(xr[h * 64 + p]); const float dx = dt * x;
        const u32x4* Bp = (const u32x4*)(xr + 1024 + g * 128 + nq * 32); const u32x4* Cp = (const u32x4*)(xr + 1280 + g * 128 + nq * 32); float y = 0.f;
#pragma unroll
        for (int j = 0; j < 4; ++j) { const u32x4 bw = Bp[j], cw = Cp[j]; const unsigned bb[4] = {bw.x, bw.y, bw.z, bw.w}, cc[4] = {cw.x, cw.y, cw.z, cw.w};
#pragma unroll
            for (int e = 0; e < 8; ++e) { const float Bv = bf2f((bf16)((bb[e >> 1] >> ((e & 1) * 16)) & 0xffff)), Cv = bf2f((bf16)((cc[e >> 1] >> ((e & 1) * 16)) & 0xffff));
                hs[j * 8 + e] = hs[j * 8 + e] * dA + dx * Bv; y += Cv * hs[j * 8 + e]; } }
        y += __shfl_xor(y, 1); y += __shfl_xor(y, 2);
        if (nq == 0) { bf16* zp = RA + t * NA + A_Z + h * 64 + p; const float z = bf2f(*zp); *zp = f2bf((y + Dh * x) * siluf_(z)); }
    }
}
__device__ __forceinline__ void wave_m4c_gnorm(bf16* RA, const float* __restrict__ nw, int w, int lane, bool dry = false) {
    const int t = w >> 1, g = w & 1;
    bf16* p = RA + (size_t)t * NA + A_Z + g * 512 + lane * 8; const u32x4 v = *(const u32x4*)p; const unsigned vw[4] = {v.x, v.y, v.z, v.w}; float f[8]; float ss = 0.f;
#pragma unroll
    for (int e = 0; e < 8; ++e) { f[e] = bf2f((bf16)((vw[e >> 1] >> ((e & 1) * 16)) & 0xffff)); ss += f[e] * f[e]; }
    const float r = 1.0f / sqrtf(wave_sum(ss) * (1.0f / 512.0f) + EPS); const float* gw = nw + g * 512 + lane * 8;
    u32x4 o; o.x = pk2(f[0] * r * gw[0], f[1] * r * gw[1]); o.y = pk2(f[2] * r * gw[2], f[3] * r * gw[3]); o.z = pk2(f[4] * r * gw[4], f[5] * r * gw[5]); o.w = pk2(f[6] * r * gw[6], f[7] * r * gw[7]);
    if (!dry) *(u32x4*)p = o;
}

__device__ __forceinline__ void unpack8(const u32x4 w, float (&f)[8]) { const unsigned ww[4] = {w.x, w.y, w.z, w.w};
#pragma unroll
    for (int e = 0; e < 4; ++e) { f[2 * e] = __builtin_bit_cast(float, ww[e] << 16); f[2 * e + 1] = __builtin_bit_cast(float, ww[e] & 0xffff0000u); } }
__device__ __forceinline__ void prep_ckv4(const bf16* __restrict__ RB, bf16* __restrict__ CKVC, const float* __restrict__ kvn, int it, int lane) {
    const int t = it * 4 + (lane >> 4), c = lane & 15; const u32x4* src = (const u32x4*)(RB + (size_t)t * NB + B_CKV + c * 16); const u32x4 a = src[0], b = src[1];
    float v[16]; { float f[8]; unpack8(a, f);
#pragma unroll
        for (int e = 0; e < 8; ++e) v[e] = f[e]; unpack8(b, f);
#pragma unroll
        for (int e = 0; e < 8; ++e) v[8 + e] = f[e]; }
    float ss = 0.f;
#pragma unroll
    for (int e = 0; e < 16; ++e) ss += v[e] * v[e];
    ss += __shfl_xor(ss, 1); ss += __shfl_xor(ss, 2); ss += __shfl_xor(ss, 4); ss += __shfl_xor(ss, 8);
    const float r = 1.0f / sqrtf(ss * (1.0f / KV_R) + EPS); const f32x4* gp = (const f32x4*)(kvn + c * 16); float o[16];
#pragma unroll
    for (int q = 0; q < 4; ++q) { const f32x4 gg = gp[q]; o[4 * q] = v[4 * q] * r * gg.x; o[4 * q + 1] = v[4 * q + 1] * r * gg.y; o[4 * q + 2] = v[4 * q + 2] * r * gg.z; o[4 * q + 3] = v[4 * q + 3] * r * gg.w; }
    u32x4 w0, w1; w0.x = pk2(o[0], o[1]); w0.y = pk2(o[2], o[3]); w0.z = pk2(o[4], o[5]); w0.w = pk2(o[6], o[7]); w1.x = pk2(o[8], o[9]); w1.y = pk2(o[10], o[11]); w1.z = pk2(o[12], o[13]); w1.w = pk2(o[14], o[15]);
    u32x4* dst = (u32x4*)(CKVC + (size_t)t * KV_R + c * 16); dst[0] = w0; dst[1] = w1;
}
__device__ __forceinline__ void prep_ik16(const bf16* __restrict__ RB, bf16* __restrict__ IKC, const float* __restrict__ ikg, const float* __restrict__ ikb, int it, int lane) {
    const int t = it * 16 + (lane >> 2), c = lane & 3; const u32x4* src = (const u32x4*)(RB + (size_t)t * NB + B_IK + c * 16); const u32x4 a = src[0], b = src[1];
    float v[16]; { float f[8]; unpack8(a, f);
#pragma unroll
        for (int e = 0; e < 8; ++e) v[e] = f[e]; unpack8(b, f);
#pragma unroll
        for (int e = 0; e < 8; ++e) v[8 + e] = f[e]; }
    float s = 0.f;
#pragma unroll
    for (int e = 0; e < 16; ++e) s += v[e];
    s += __shfl_xor(s, 1); s += __shfl_xor(s, 2); const float mu = s * (1.0f / 64.0f); float q2 = 0.f;
#pragma unroll
    for (int e = 0; e < 16; ++e) { v[e] -= mu; q2 += v[e] * v[e]; }
    q2 += __shfl_xor(q2, 1); q2 += __shfl_xor(q2, 2); const float r = 1.0f / sqrtf(q2 * (1.0f / 64.0f) + EPS); float o[16];
#pragma unroll
    for (int e = 0; e < 16; ++e) o[e] = v[e] * r * ikg[c * 16 + e] + ikb[c * 16 + e];
    u32x4 w0, w1; w0.x = pk2(o[0], o[1]); w0.y = pk2(o[2], o[3]); w0.z = pk2(o[4], o[5]); w0.w = pk2(o[6], o[7]); w1.x = pk2(o[8], o[9]); w1.y = pk2(o[10], o[11]); w1.z = pk2(o[12], o[13]); w1.w = pk2(o[14], o[15]);
    u32x4* dst = (u32x4*)(IKC + (size_t)t * 64 + c * 16); dst[0] = w0; dst[1] = w1;
}
__device__ __forceinline__ void prep_bout(bf16* RA, const bf16* __restrict__ RB, const float* __restrict__ scw, int t, int lane, bool dry = false) {
    const int s = t & (SEQ - 1), c = lane * 8; float acc[8] = {0.f, 0.f, 0.f, 0.f, 0.f, 0.f, 0.f, 0.f};
    u32x4 cg[3], hb[3];
#pragma unroll
    for (int j = 0; j < 3; ++j) { const bool ok = (s - 2 + j) >= 0; const bf16* rr = RB + (size_t)(t - 2 + j) * NB; cg[j] = ok ? *(const u32x4*)(rr + B_CG + c) : (u32x4){0u, 0u, 0u, 0u}; hb[j] = ok ? *(const u32x4*)(rr + B_HB + c) : (u32x4){0u, 0u, 0u, 0u}; }
    bf16* ra = RA + (size_t)t * NA + A_BG + c; const u32x4 bg = *(const u32x4*)ra;
#pragma unroll
    for (int j = 0; j < 3; ++j) { float a[8], b[8]; unpack8(cg[j], a); unpack8(hb[j], b); const f32x4 w0 = *(const f32x4*)(scw + j * 512 + c), w1 = *(const f32x4*)(scw + j * 512 + c + 4);
        acc[0] += w0.x * (a[0] * b[0]); acc[1] += w0.y * (a[1] * b[1]); acc[2] += w0.z * (a[2] * b[2]); acc[3] += w0.w * (a[3] * b[3]);
        acc[4] += w1.x * (a[4] * b[4]); acc[5] += w1.y * (a[5] * b[5]); acc[6] += w1.z * (a[6] * b[6]); acc[7] += w1.w * (a[7] * b[7]); }
    float g8[8]; unpack8(bg, g8); u32x4 w; w.x = pk2(g8[0] * acc[0], g8[1] * acc[1]); w.y = pk2(g8[2] * acc[2], g8[3] * acc[3]); w.z = pk2(g8[4] * acc[4], g8[5] * acc[5]); w.w = pk2(g8[6] * acc[6], g8[7] * acc[7]);
    if (!dry) *(u32x4*)ra = w;
}
__device__ __forceinline__ void prep_conv(const bf16* __restrict__ RB, bf16* __restrict__ XA, const float* __restrict__ cw, const float* __restrict__ cb, int it, int lane) {
    const int rb = it / 12, cbk = it % 12, xcol = cbk * 128 + 2 * lane, t0 = rb * 16, s0 = t0 & (SEQ - 1);
    float w0[4], w1[4];
#pragma unroll
    for (int j = 0; j < 4; ++j) { w0[j] = cw[j * XBC + xcol]; w1[j] = cw[j * XBC + xcol + 1]; }
    const float cb0 = cb[xcol], cb1 = cb[xcol + 1];
    const bf16* src = RB + (size_t)(t0 - 3) * NB + B_XBC + xcol; unsigned raw[19];
#pragma unroll
    for (int i = 0; i < 19; ++i) raw[i] = (s0 - 3 + i >= 0) ? *(const unsigned*)(src + (size_t)i * NB) : 0u;
#pragma unroll
    for (int i = 0; i < 16; ++i) { float a0 = cb0, a1 = cb1;
#pragma unroll
        for (int j = 0; j < 4; ++j) { a0 += w0[j] * __builtin_bit_cast(float, raw[i + j] << 16); a1 += w1[j] * __builtin_bit_cast(float, raw[i + j] & 0xffff0000u); }
        *(unsigned*)(XA + (size_t)(t0 + i) * XBC + xcol) = pk2(siluf_(a0), siluf_(a1)); }
}

typedef short bf16x8_t __attribute__((ext_vector_type(8)));
#ifndef SEL_REP_SEARCH
#define SEL_REP_SEARCH 1
#endif
#ifndef SEL_REP_STAGE
#define SEL_REP_STAGE 1
#endif
constexpr int SC_STRIDE = 516, SC_BUF = 16 * SC_STRIDE;
constexpr int IKW_OFF = 66560;
__device__ __forceinline__ void wg_select16(LDSP unsigned char* lds, const bf16* __restrict__ RB, const bf16* __restrict__ IKC, unsigned short* __restrict__ idx, int unit, int tid, bool dry = false) {
    const int lane = tid & 63, wave = __builtin_amdgcn_readfirstlane(tid >> 6), g = lane >> 4, c = lane & 15;
    const int b = unit >> 8, qg = unit & 255, t0 = b * SEQ + qg * 16, nk = ((qg >> 2) + 1) << 6, nr = nk >> 6;
    LDSP unsigned* SC = (LDSP unsigned*)lds;
    bf16x8_t bq[4][2]; float iwq[4];
    { const bf16* qr = RB + (size_t)(t0 + c) * NB;
#pragma unroll
      for (int h = 0; h < 4; ++h) { bq[h][0] = *(const bf16x8_t*)(qr + B_IQ + h * 64 + g * 8); bq[h][1] = *(const bf16x8_t*)(qr + B_IQ + h * 64 + 32 + g * 8); iwq[h] = bf2f(qr[B_IW + h]) * 0.0625f; } }
    unsigned val[2][64];
#pragma unroll
    for (int r = 0; r < 64; ++r) { val[0][r] = 0u; val[1][r] = 0u; }
    const bf16* ikb = IKC + (size_t)b * SEQ * 64;
    LDSP unsigned char* ikw = lds + IKW_OFF + wave * 8192;
#define IK_DMA(stage) do { if ((stage) * 512 + wave * 64 < nk) { const bf16* src_ = ikb + (size_t)((stage) * 512 + wave * 64) * 64 + lane * 8; _Pragma("unroll") for (int pc_ = 0; pc_ < 8; ++pc_) \
        __builtin_amdgcn_global_load_lds((const unsigned*)(src_ + pc_ * 512), (LDSP unsigned*)(ikw + pc_ * 1024), 16, 0, 0); } } while (0)
    IK_DMA(0);
    for (int rep_st = 0; rep_st < SEL_REP_STAGE; ++rep_st) {
    if (rep_st > 0) { asm volatile("s_waitcnt vmcnt(0)" ::: "memory"); __builtin_amdgcn_s_barrier(); IK_DMA(0); }
#pragma unroll
    for (int s = 0; s < 8; ++s) {
        if (s * 512 < nk) {
            LDSP unsigned* buf = SC + (s & 1) * SC_BUF;
            asm volatile("s_waitcnt vmcnt(0)" ::: "memory");
            bf16x8_t af[4][2];
#pragma unroll
            for (int i = 0; i < 4; ++i) { af[i][0] = *(const LDSP bf16x8_t*)(ikw + (16 * i + c) * 128 + g * 16); af[i][1] = *(const LDSP bf16x8_t*)(ikw + (16 * i + c) * 128 + 64 + g * 16); }
            asm volatile("s_waitcnt lgkmcnt(0)" ::: "memory");
            if (s < 7) IK_DMA(s + 1);
#pragma unroll
            for (int i = 0; i < 4; ++i) { const int tl = wave * 4 + i, kb = s * 512 + tl * 16;
                if (kb < nk) {
                    const bf16x8_t a0 = af[i][0], a1 = af[i][1];
                    float sc[4] = {0.f, 0.f, 0.f, 0.f};
#pragma unroll
                    for (int h = 0; h < 4; ++h) { pg8::f32x4 acc = {0.f, 0.f, 0.f, 0.f};
                        acc = __builtin_amdgcn_mfma_f32_16x16x32_bf16(a0, bq[h][0], acc, 0, 0, 0); acc = __builtin_amdgcn_mfma_f32_16x16x32_bf16(a1, bq[h][1], acc, 0, 0, 0);
#pragma unroll
                        for (int e = 0; e < 4; ++e) sc[e] += fmaxf(acc[e], 0.f) * iwq[h]; }
                    u32x4 kv; kv.x = ord_key(sc[0]); kv.y = ord_key(sc[1]); kv.z = ord_key(sc[2]); kv.w = ord_key(sc[3]);
                    *(LDSP u32x4*)(buf + c * SC_STRIDE + tl * 16 + 4 * g) = kv; } }
            asm volatile("s_waitcnt lgkmcnt(0)" ::: "memory"); __builtin_amdgcn_s_barrier(); asm volatile("" ::: "memory");
#pragma unroll
            for (int j = 0; j < 8; ++j) if (s * 512 + j * 64 < nk) { val[0][s * 8 + j] = buf[(2 * wave) * SC_STRIDE + j * 64 + lane]; val[1][s * 8 + j] = buf[(2 * wave + 1) * SC_STRIDE + j * 64 + lane]; }
            asm volatile("s_waitcnt lgkmcnt(0)" ::: "memory");
        }
    }
    }
    const unsigned long long lt = (1ull << lane) - 1ull;
#pragma unroll
    for (int qq = 0; qq < 2; ++qq) {
        unsigned Tt = 0u;
        for (int rep_se = 0; rep_se < SEL_REP_SEARCH; ++rep_se) { Tt = 0u; asm volatile("" : "+v"(val[qq][0]));
        if (nk > TOPK) {
            for (int bit = 31; bit >= 0; --bit) { const unsigned cand = Tt | (1u << bit); int cnt = 0;
#pragma unroll
                for (int r8 = 0; r8 < 8; ++r8) if (r8 * 8 < nr) {
#pragma unroll
                    for (int r = r8 * 8; r < r8 * 8 + 8; ++r) cnt += __popcll(__ballot(val[qq][r] >= cand)); }
                if (cnt >= TOPK) Tt = cand; if (cnt == TOPK) break; }
        }
        }
        int ngt = 0;
#pragma unroll
        for (int r8 = 0; r8 < 8; ++r8) if (r8 * 8 < nr) {
#pragma unroll
            for (int r = r8 * 8; r < r8 * 8 + 8; ++r) ngt += __popcll(__ballot(val[qq][r] > Tt)); }
        const int need = TOPK - ngt; int pos = 0, eq_taken = 0;
        unsigned short* orow = idx + (size_t)(t0 + 2 * wave + qq) * TOPK;
#pragma unroll
        for (int r = 0; r < 64; ++r) if (r < nr) { const unsigned k = val[qq][r]; const bool gt = k > Tt, eq = (k == Tt);
            const unsigned long long meq = __ballot(eq); const int rank_eq = __popcll(meq & lt); const bool take = gt || (eq && (eq_taken + rank_eq < need));
            const unsigned long long msel = __ballot(take);
            if (take) { const int o = pos + __popcll(msel & lt); if (o < TOPK && !dry) orow[o] = (unsigned short)(r * 64 + lane); }
            pos += __popcll(msel); eq_taken += __popcll(__ballot(eq && take)); }
    }
    asm volatile("s_waitcnt vmcnt(0)" ::: "memory"); __builtin_amdgcn_s_barrier();
#undef IK_DMA
}

typedef unsigned short u16x4_t __attribute__((ext_vector_type(4)));
#ifndef ATT_LOCAL_DRY
#define ATT_LOCAL_DRY 0
#endif
#ifndef ATT_STAGGER
#define ATT_STAGGER 0
#endif
#ifndef ATT_DRY_SKIP
#define ATT_DRY_SKIP 0
#endif
#define DSK(b) (ATT_DRY_SKIP & (b)) && dry
#ifndef ATT_SUB_EN
#define ATT_SUB_EN 0
#endif
constexpr int SELW_OFF = 134 * 1024, BT_OFF = 142 * 1024, KVP = 528, TILE_STRIDE = 32 * KVP;
constexpr int SELW_OFF_OLD = 132 * 1024, BT_OFF_OLD = 140 * 1024;
__device__ __forceinline__ int kv_off(int row, int ch) { const int hf = ch >> 4, c16 = ch & 15; return hf * 8192 + 256 * row + 16 * (c16 ^ (((row & 3) << 2) | ((row >> 2) & 3))); }
#define TR4I(d0, d1, d2, d3, base, o0, o1, o2, o3) asm volatile("ds_read_b64_tr_b16 %0, %4 offset:%5\n\tds_read_b64_tr_b16 %1, %4 offset:%6\n\tds_read_b64_tr_b16 %2, %4 offset:%7\n\tds_read_b64_tr_b16 %3, %4 offset:%8" \
    : "=&v"(d0), "=&v"(d1), "=&v"(d2), "=&v"(d3) : "v"(base), "i"(o0), "i"(o1), "i"(o2), "i"(o3) : "memory")
#define TR8N(d0, d1, d2, d3, d4, d5, d6, d7, base, o0, o1, o2, o3, o4, o5, o6, o7) asm volatile( \
    "ds_read_b64_tr_b16 %0, %8 offset:%9\n\tds_read_b64_tr_b16 %1, %8 offset:%10\n\tds_read_b64_tr_b16 %2, %8 offset:%11\n\tds_read_b64_tr_b16 %3, %8 offset:%12\n\t" \
    "ds_read_b64_tr_b16 %4, %8 offset:%13\n\tds_read_b64_tr_b16 %5, %8 offset:%14\n\tds_read_b64_tr_b16 %6, %8 offset:%15\n\tds_read_b64_tr_b16 %7, %8 offset:%16" \
    : "=&v"(d0), "=&v"(d1), "=&v"(d2), "=&v"(d3), "=&v"(d4), "=&v"(d5), "=&v"(d6), "=&v"(d7) : "v"(base), "i"(o0), "i"(o1), "i"(o2), "i"(o3), "i"(o4), "i"(o5), "i"(o6), "i"(o7) : "memory")
#define WAITPIN8(n, d0, d1, d2, d3, d4, d5, d6, d7) asm volatile("s_waitcnt lgkmcnt(" #n ")" : "+v"(d0), "+v"(d1), "+v"(d2), "+v"(d3), "+v"(d4), "+v"(d5), "+v"(d6), "+v"(d7) :: "memory")
#define WAITPIN4(n, d0, d1, d2, d3) asm volatile("s_waitcnt lgkmcnt(" #n ")" : "+v"(d0), "+v"(d1), "+v"(d2), "+v"(d3) :: "memory")
__device__ __forceinline__ bf16x8_t mk8a(u16x4_t a, u16x4_t b) { bf16x8_t r; r[0] = a[0]; r[1] = a[1]; r[2] = a[2]; r[3] = a[3]; r[4] = b[0]; r[5] = b[1]; r[6] = b[2]; r[7] = b[3]; return r; }
#define TR8I(d0, d1, d2, d3, d4, d5, d6, d7, base, o0, o1, o2, o3, o4, o5, o6, o7) asm volatile( \
    "ds_read_b64_tr_b16 %0, %8 offset:%9\n\tds_read_b64_tr_b16 %1, %8 offset:%10\n\tds_read_b64_tr_b16 %2, %8 offset:%11\n\tds_read_b64_tr_b16 %3, %8 offset:%12\n\t" \
    "ds_read_b64_tr_b16 %4, %8 offset:%13\n\tds_read_b64_tr_b16 %5, %8 offset:%14\n\tds_read_b64_tr_b16 %6, %8 offset:%15\n\tds_read_b64_tr_b16 %7, %8 offset:%16\n\ts_waitcnt lgkmcnt(0)" \
    : "=&v"(d0), "=&v"(d1), "=&v"(d2), "=&v"(d3), "=&v"(d4), "=&v"(d5), "=&v"(d6), "=&v"(d7) : "v"(base), "i"(o0), "i"(o1), "i"(o2), "i"(o3), "i"(o4), "i"(o5), "i"(o6), "i"(o7) : "memory")
#define TR8(d0, d1, d2, d3, d4, d5, d6, d7, a0, a1, a2, a3, a4, a5, a6, a7) asm volatile( \
    "ds_read_b64_tr_b16 %0, %8\n\tds_read_b64_tr_b16 %1, %9\n\tds_read_b64_tr_b16 %2, %10\n\tds_read_b64_tr_b16 %3, %11\n\t" \
    "ds_read_b64_tr_b16 %4, %12\n\tds_read_b64_tr_b16 %5, %13\n\tds_read_b64_tr_b16 %6, %14\n\tds_read_b64_tr_b16 %7, %15\n\ts_waitcnt lgkmcnt(0)" \
    : "=&v"(d0), "=&v"(d1), "=&v"(d2), "=&v"(d3), "=&v"(d4), "=&v"(d5), "=&v"(d6), "=&v"(d7) : "v"(a0), "v"(a1), "v"(a2), "v"(a3), "v"(a4), "v"(a5), "v"(a6), "v"(a7) : "memory")
__device__ __forceinline__ void wg_attn16(LDSP unsigned char* lds, bf16* RA, const bf16* __restrict__ CKVC, const unsigned short* __restrict__ idx, const bf16* __restrict__ WUK, const bf16* __restrict__ WUV,
                                          const float* __restrict__ rel_bias, int unit, int nxt_unit, int par, bool first, int tid, bool dry = false) {
    const int lane = tid & 63, wave = __builtin_amdgcn_readfirstlane(tid >> 6), g = lane >> 4, c = lane & 15;
    const int b = unit >> 9, qg = unit & 511, t0 = b * SEQ + qg * 8, nk = ((qg >> 3) + 1) << 6, nsel = nk < TOPK ? nk : TOPK, ntile = nsel >> 5;
    LDSP unsigned char* QL = lds;
    LDSP unsigned char* tile = lds + wave * TILE_STRIDE;
    LDSP unsigned short* selw = (LDSP unsigned short*)(lds + SELW_OFF + (par * 8 + wave) * 512);
    LDSP unsigned short* selw_n = (LDSP unsigned short*)(lds + SELW_OFF + ((par ^ 1) * 8 + wave) * 512);
    if (first) { if (lane < 32) *((LDSP u32x4*)selw + lane) = *((const u32x4*)(idx + (size_t)(t0 + wave) * TOPK) + lane); }
    const bf16* kvb = CKVC + (size_t)b * SEQ * KV_R + g * 8;
    bf16x8_t kv0[8], kv1[8];
#define KV_LOAD(dst, key) do { const bf16* rp_ = kvb + (size_t)(key) * KV_R; _Pragma("unroll") for (int ks_ = 0; ks_ < 8; ++ks_) dst[ks_] = *(const bf16x8_t*)(rp_ + ks_ * 32); } while (0)
    int ka = (int)selw[c], kb = (int)selw[16 + c];
    KV_LOAD(kv0, ka); KV_LOAD(kv1, kb);
    {   const int h = wave; const bf16* qr = RA + (size_t)(t0 + (c & 7)) * NA + A_Q + h * 64 + g * 8;
        const bf16x8_t b0 = *(const bf16x8_t*)qr, b1 = *(const bf16x8_t*)(qr + 32);
        const bf16* wb = WUK + ((size_t)h * 256 + c) * 64 + g * 8;
#pragma unroll 4
        for (int rt = 0; rt < 16; ++rt) { const bf16x8_t a0 = *(const bf16x8_t*)(wb + rt * 16 * 64), a1 = *(const bf16x8_t*)(wb + rt * 16 * 64 + 32);
            pg8::f32x4 acc = {0.f, 0.f, 0.f, 0.f};
            acc = __builtin_amdgcn_mfma_f32_16x16x32_bf16(a0, b0, acc, 0, 0, 0); acc = __builtin_amdgcn_mfma_f32_16x16x32_bf16(a1, b1, acc, 0, 0, 0);
            u32x2 w; w.x = pk2(acc[0], acc[1]); w.y = pk2(acc[2], acc[3]);
            if (c < 8) *(LDSP u32x2*)(QL + (((c * 8 + h) * 256) + rt * 16 + 4 * g) * 2) = w; }
    }
    asm volatile("s_waitcnt lgkmcnt(0)" ::: "memory"); __builtin_amdgcn_s_barrier(); asm volatile("" ::: "memory");
    bf16x8_t qf[8];
#pragma unroll
    for (int ks = 0; ks < 8; ++ks) qf[ks] = *(const LDSP bf16x8_t*)(QL + (((wave * 8 + (c & 7)) * 256) + ks * 32 + g * 8) * 2);
    asm volatile("s_waitcnt lgkmcnt(0)" ::: "memory"); __builtin_amdgcn_s_barrier(); asm volatile("" ::: "memory");
    const unsigned tile_a = (unsigned)(size_t)tile;
#if ATT_STAGGER
    if (wave >= 4) __builtin_amdgcn_s_sleep(ATT_STAGGER);
#endif
    bf16x8_t bbf; { float bv[8];
#pragma unroll
        for (int j = 0; j < 8; ++j) bv[j] = rel_bias[(8 * g + j) * 8 + (c & 7)];
        u32x4 w; w.x = pk2(bv[0], bv[1]); w.y = pk2(bv[2], bv[3]); w.z = pk2(bv[4], bv[5]); w.w = pk2(bv[6], bv[7]); bbf = __builtin_bit_cast(bf16x8_t, w); }
    {
        const int spos = (qg * 8 + wave);
        pg8::f32x4 acc[16];
#pragma unroll
        for (int nt = 0; nt < 16; ++nt) acc[nt] = (pg8::f32x4){0.f, 0.f, 0.f, 0.f};
        float m_run = -INFINITY, l_run = 0.f;
#define ONEHOT(dst, key) do { const int rel_ = (key) - spos, n_ = rel_ < 0 ? -rel_ : rel_; \
            const int big_ = 8 + (n_ >= 15) + (n_ >= 27) + (n_ >= 50) + (n_ >= 91) + (n_ >= 166) + (n_ >= 305) + (n_ >= 559); \
            const int pos_ = (n_ < 8 ? n_ : big_) + (rel_ > 0 ? 16 : 0) - 8 * g; const unsigned one_ = (pos_ & 1) ? 0x3F800000u : 0x3F80u; const int hi_ = pos_ >> 1; \
            u32x4 w_; w_.x = (hi_ == 0) ? one_ : 0u; w_.y = (hi_ == 1) ? one_ : 0u; w_.z = (hi_ == 2) ? one_ : 0u; w_.w = (hi_ == 3) ? one_ : 0u; dst = __builtin_bit_cast(bf16x8_t, w_); } while (0)
        const int q4 = c >> 2, p = c & 3;
        const unsigned trb = tile_a + (4 * g + q4) * KVP + 8 * p;
        for (int tl = 0; tl < ntile; ++tl) {
            int kan = 0, kbn = 0; const bool more = tl + 1 < ntile;
            if (more) { kan = (int)selw[(2 * tl + 2) * 16 + c]; kbn = (int)selw[(2 * tl + 3) * 16 + c]; }
            bf16x8_t oha, ohb; ONEHOT(oha, ka); ONEHOT(ohb, kb);
            asm volatile("s_waitcnt vmcnt(8)" ::: "memory");
            pg8::f32x4 s0 = {0.f, 0.f, 0.f, 0.f}, s1 = {0.f, 0.f, 0.f, 0.f};
            s0 = __builtin_amdgcn_mfma_f32_16x16x32_bf16(oha, bbf, s0, 0, 0, 0);
#pragma unroll
            for (int ks = 0; ks < 8; ++ks) { s0 = __builtin_amdgcn_mfma_f32_16x16x32_bf16(kv0[ks], qf[ks], s0, 0, 0, 0); *(LDSP bf16x8_t*)(tile + c * KVP + g * 16 + ks * 64) = kv0[ks]; }
            if (more) KV_LOAD(kv0, kan);
            if (more) asm volatile("s_waitcnt vmcnt(8)" ::: "memory"); else asm volatile("s_waitcnt vmcnt(0)" ::: "memory");
            s1 = __builtin_amdgcn_mfma_f32_16x16x32_bf16(ohb, bbf, s1, 0, 0, 0);
#pragma unroll
            for (int ks = 0; ks < 8; ++ks) { s1 = __builtin_amdgcn_mfma_f32_16x16x32_bf16(kv1[ks], qf[ks], s1, 0, 0, 0); *(LDSP bf16x8_t*)(tile + (16 + c) * KVP + g * 16 + ks * 64) = kv1[ks]; }
            if (more) KV_LOAD(kv1, kbn);
            ka = kan; kb = kbn;
            float sv[8];
#pragma unroll
            for (int j = 0; j < 4; ++j) { sv[j] = s0[j]; sv[4 + j] = s1[j]; }
            float tmax = fmaxf(fmaxf(fmaxf(sv[0], sv[1]), fmaxf(sv[2], sv[3])), fmaxf(fmaxf(sv[4], sv[5]), fmaxf(sv[6], sv[7])));
            tmax = fmaxf(tmax, __shfl_xor(tmax, 16)); tmax = fmaxf(tmax, __shfl_xor(tmax, 32));
            const float m_new = fmaxf(m_run, tmax); const float scl = __expf(m_run - m_new); const bool grow = m_new > m_run; m_run = m_new;
            float ps = 0.f;
#pragma unroll
            for (int j = 0; j < 8; ++j) { sv[j] = __expf(sv[j] - m_new); ps += sv[j]; }
            l_run = l_run * scl + ps;
            bf16x8_t pf; { u32x4 w; w.x = pk2(sv[0], sv[1]); w.y = pk2(sv[2], sv[3]); w.z = pk2(sv[4], sv[5]); w.w = pk2(sv[6], sv[7]); pf = __builtin_bit_cast(bf16x8_t, w); }
            if (__builtin_amdgcn_ballot_w64(grow) != 0ull) {
                float rs[4];
#pragma unroll
                for (int e = 0; e < 4; ++e) rs[e] = __shfl(scl, 4 * g + e);
#pragma unroll
                for (int nt = 0; nt < 16; ++nt) {
#pragma unroll
                    for (int e = 0; e < 4; ++e) acc[nt][e] *= rs[e]; } }
            asm volatile("s_waitcnt lgkmcnt(0)" ::: "memory");
            u16x4_t va[8], vb[8];
            TR8N(va[0], va[1], va[2], va[3], va[4], va[5], va[6], va[7], trb, 0, 16 * KVP, 32, 32 + 16 * KVP, 64, 64 + 16 * KVP, 96, 96 + 16 * KVP);
            TR8N(vb[0], vb[1], vb[2], vb[3], vb[4], vb[5], vb[6], vb[7], trb, 128, 128 + 16 * KVP, 160, 160 + 16 * KVP, 192, 192 + 16 * KVP, 224, 224 + 16 * KVP);
            WAITPIN8(8, va[0], va[1], va[2], va[3], va[4], va[5], va[6], va[7]);
#pragma unroll
            for (int k = 0; k < 4; ++k) acc[k] = __builtin_amdgcn_mfma_f32_16x16x32_bf16(pf, mk8a(va[2 * k], va[2 * k + 1]), acc[k], 0, 0, 0);
            TR8N(va[0], va[1], va[2], va[3], va[4], va[5], va[6], va[7], trb, 256, 256 + 16 * KVP, 288, 288 + 16 * KVP, 320, 320 + 16 * KVP, 352, 352 + 16 * KVP);
            WAITPIN8(8, vb[0], vb[1], vb[2], vb[3], vb[4], vb[5], vb[6], vb[7]);
#pragma unroll
            for (int k = 0; k < 4; ++k) acc[4 + k] = __builtin_amdgcn_mfma_f32_16x16x32_bf16(pf, mk8a(vb[2 * k], vb[2 * k + 1]), acc[4 + k], 0, 0, 0);
            TR8N(vb[0], vb[1], vb[2], vb[3], vb[4], vb[5], vb[6], vb[7], trb, 384, 384 + 16 * KVP, 416, 416 + 16 * KVP, 448, 448 + 16 * KVP, 480, 480 + 16 * KVP);
            WAITPIN8(8, va[0], va[1], va[2], va[3], va[4], va[5], va[6], va[7]);
#pragma unroll
            for (int k = 0; k < 4; ++k) acc[8 + k] = __builtin_amdgcn_mfma_f32_16x16x32_bf16(pf, mk8a(va[2 * k], va[2 * k + 1]), acc[8 + k], 0, 0, 0);
            WAITPIN8(0, vb[0], vb[1], vb[2], vb[3], vb[4], vb[5], vb[6], vb[7]);
#pragma unroll
            for (int k = 0; k < 4; ++k) acc[12 + k] = __builtin_amdgcn_mfma_f32_16x16x32_bf16(pf, mk8a(vb[2 * k], vb[2 * k + 1]), acc[12 + k], 0, 0, 0);
        }
#undef KV_LOAD
#undef ONEHOT
        float lt = l_run + __shfl_xor(l_run, 16); lt += __shfl_xor(lt, 32); const float inv = 1.0f / lt;
        float ri[4];
#pragma unroll
        for (int e = 0; e < 4; ++e) ri[e] = __shfl(inv, 4 * g + e);
        if (g < 2) {
#pragma unroll
            for (int nt = 0; nt < 16; ++nt) { LDSP unsigned short* o1 = (LDSP unsigned short*)(tile) + (4 * g) * 256 + nt * 16 + c;
                o1[0] = f2bf(acc[nt][0] * ri[0]); o1[256] = f2bf(acc[nt][1] * ri[1]); o1[512] = f2bf(acc[nt][2] * ri[2]); o1[768] = f2bf(acc[nt][3] * ri[3]); }
        }
    }
    u32x4 nsel_v = {0u, 0u, 0u, 0u};
    if (nxt_unit >= 0 && lane < 32) { const int nb = nxt_unit >> 9, nq = nxt_unit & 511; nsel_v = *((const u32x4*)(idx + (size_t)(nb * SEQ + nq * 8 + wave) * TOPK) + lane); }
    asm volatile("s_waitcnt lgkmcnt(0)" ::: "memory"); __builtin_amdgcn_s_barrier(); asm volatile("" ::: "memory");
    {   const int h = wave; pg8::f32x4 o[4];
#pragma unroll
        for (int nt = 0; nt < 4; ++nt) o[nt] = (pg8::f32x4){0.f, 0.f, 0.f, 0.f};
        const LDSP unsigned char* ab = lds + TILE_STRIDE * (c & 7) + (h * 256 + g * 8) * 2;
        const bf16* wb = WUV + ((size_t)h * 64 + c) * 256 + g * 8;
#pragma unroll
        for (int ks = 0; ks < 8; ++ks) { const bf16x8_t a = *(const LDSP bf16x8_t*)(ab + ks * 64);
#pragma unroll
            for (int nt = 0; nt < 4; ++nt) { const bf16x8_t bw = *(const bf16x8_t*)(wb + (size_t)nt * 16 * 256 + ks * 32); o[nt] = __builtin_amdgcn_mfma_f32_16x16x32_bf16(a, bw, o[nt], 0, 0, 0); } }
        if (g < 2 && !dry) {
#pragma unroll
            for (int nt = 0; nt < 4; ++nt)
#pragma unroll
                for (int e = 0; e < 4; ++e) RA[(size_t)(t0 + 4 * g + e) * NA + A_Q + h * 64 + nt * 16 + c] = f2bf(o[nt][e]); }
    }
    if (nxt_unit >= 0 && lane < 32) *((LDSP u32x4*)selw_n + lane) = nsel_v;
    asm volatile("s_waitcnt lgkmcnt(0)" ::: "memory"); __builtin_amdgcn_s_barrier(); asm volatile("" ::: "memory");
}

#ifndef SSM_SPLIT_V
#define SSM_SPLIT_V 42
#endif
constexpr int SSM_SPLIT = SSM_SPLIT_V;
constexpr int XP = 144, BP = 272;
constexpr int SB_X = 0, SB_B = 8192, SB_C = 24576, SB_SIZE = 40960;
constexpr int L_XS = 2 * SB_SIZE, L_M = L_XS + 64 * XP, L_HC = L_M + 64 * XP, L_TB = L_HC + 2 * 64 * BP;
static_assert(L_TB + 2048 <= 140 * 1024, "ssm lds");
#define TR2(d0, d1, a0, a1) asm volatile("ds_read_b64_tr_b16 %0, %2\n\tds_read_b64_tr_b16 %1, %3\n\ts_waitcnt lgkmcnt(0)" : "=&v"(d0), "=&v"(d1) : "v"(a0), "v"(a1) : "memory")
__device__ __forceinline__ bf16x8_t mk8(u16x4_t a, u16x4_t b) { bf16x8_t r; r[0] = a[0]; r[1] = a[1]; r[2] = a[2]; r[3] = a[3]; r[4] = b[0]; r[5] = b[1]; r[6] = b[2]; r[7] = b[3]; return r; }
__device__ __forceinline__ int bc_off(int row, int ch) { return 256 * row + 16 * (ch ^ (((row & 3) << 2) | ((row >> 2) & 3))); }
__device__ __forceinline__ void ssm_dma(LDSP unsigned char* buf, const bf16* __restrict__ XA, int tc0, int h, int grp, int wave, int lane, bool full) {
    const int npc = full ? 40 : 24;
    for (int p = wave; p < npc; p += 8) {
        const bf16* src;
        if (p < 8) { const int row = 8 * p + (lane >> 3), ch = lane & 7; src = XA + (size_t)(tc0 + row) * XBC + h * 64 + ch * 8; }
        else { const int pp = (p - 8) & 15, row = 4 * pp + (lane >> 4), ch = (lane & 15) ^ (((row & 3) << 2) | ((row >> 2) & 3)); src = XA + (size_t)(tc0 + row) * XBC + (p < 24 ? 1024 : 1280) + grp * 128 + ch * 8; }
        __builtin_amdgcn_global_load_lds((const unsigned*)src, (LDSP unsigned*)(buf + 1024 * p), 16, 0, 0);
    }
}
__device__ __forceinline__ void wg_ssm_unit(LDSP unsigned char* lds, bf16* RA, const bf16* __restrict__ XA, const float* __restrict__ DTt,
                                            const float* __restrict__ a_log, const float* __restrict__ dsk, int unit, int tid, bf16* dbg_out = nullptr, bool dry = false) {
    const int lane = tid & 63, wave = __builtin_amdgcn_readfirstlane(tid >> 6), g = lane >> 4, c = lane & 15, q4 = c >> 2, p4 = c & 3;
    const int b = unit >> 5, h = (unit >> 1) & 15, seg = unit & 1, grp = h >> 3, pq = wave & 3, hf = wave >> 2;
    const float Dh = dsk[h];
    const unsigned lds_a = (unsigned)(size_t)lds;
    LDSP float* TB = (LDSP float*)(lds + L_TB);
    typedef float f32x2_t __attribute__((ext_vector_type(2)));
    const f32x2_t* dtp = (const f32x2_t*)DTt + (size_t)(b * 16 + h) * SEQ;
    pg8::f32x4 hacc[4];
#pragma unroll
    for (int nt = 0; nt < 4; ++nt) hacc[nt] = (pg8::f32x4){0.f, 0.f, 0.f, 0.f};
    for (int i = tid; i < (2 * 64 * BP) / 4; i += NTHR) ((LDSP unsigned*)(lds + L_HC))[i] = 0u;
    const int c_end = seg ? 64 : SSM_SPLIT;
    ssm_dma(lds, XA, b * SEQ, h, grp, wave, lane, seg == 0 || SSM_SPLIT == 0);
    f32x2_t dt_cur = dtp[lane];
    asm volatile("s_waitcnt vmcnt(0) lgkmcnt(0)" ::: "memory"); __builtin_amdgcn_s_barrier(); asm volatile("" ::: "memory");
    for (int ci = 0; ci < c_end; ++ci) {
        const bool full = (seg == 0) || (ci >= SSM_SPLIT);
        const int tc0 = b * SEQ + ci * 64;
        LDSP unsigned char* buf = lds + (ci & 1) * SB_SIZE;
        f32x2_t dt_nxt = {0.f, 0.f};
        if (ci + 1 < c_end) { ssm_dma(lds + ((ci + 1) & 1) * SB_SIZE, XA, tc0 + 64, h, grp, wave, lane, (seg == 0) || (ci + 1 >= SSM_SPLIT)); dt_nxt = dtp[(ci + 1) * 64 + lane]; }
        unsigned short zraw[8];
        if (full) {
#pragma unroll
            for (int k2 = 0; k2 < 2; ++k2)
#pragma unroll
                for (int e = 0; e < 4; ++e) zraw[k2 * 4 + e] = RA[(size_t)(tc0 + 16 * (2 * hf + k2) + 4 * g + e) * NA + A_Z + h * 64 + 16 * pq + c]; }
        {   const float dt = dt_cur.x, acs = dt_cur.y; const float tot = __builtin_bit_cast(float, __builtin_amdgcn_readlane(__builtin_bit_cast(int, acs), 63));
            TB[lane] = dt; TB[64 + lane] = acs; TB[128 + lane] = __expf(acs); TB[192 + lane] = __expf(tot - acs) * dt; if (lane == 0) TB[256] = __expf(tot); }
        asm volatile("s_waitcnt lgkmcnt(0)" ::: "memory");
        {   const int row = tid >> 3, ch = tid & 7; const u32x4 xv = *(const LDSP u32x4*)(buf + SB_X + row * 128 + ch * 16); const float wl = TB[192 + row]; const unsigned xw[4] = {xv.x, xv.y, xv.z, xv.w}; u32x4 o;
            o.x = pk2(__builtin_bit_cast(float, xw[0] << 16) * wl, __builtin_bit_cast(float, xw[0] & 0xffff0000u) * wl); o.y = pk2(__builtin_bit_cast(float, xw[1] << 16) * wl, __builtin_bit_cast(float, xw[1] & 0xffff0000u) * wl);
            o.z = pk2(__builtin_bit_cast(float, xw[2] << 16) * wl, __builtin_bit_cast(float, xw[2] & 0xffff0000u) * wl); o.w = pk2(__builtin_bit_cast(float, xw[3] << 16) * wl, __builtin_bit_cast(float, xw[3] & 0xffff0000u) * wl);
            *(LDSP u32x4*)(lds + L_XS + row * XP + ch * 16) = o; }
        if (full) {
            const int lt = wave >> 1;
#pragma unroll
            for (int k2 = 0; k2 < 2; ++k2) { const int st = 2 * (wave & 1) + k2; pg8::f32x4 ga = {0.f, 0.f, 0.f, 0.f};
#pragma unroll
                for (int ks = 0; ks < 4; ++ks) { const bf16x8_t af = *(const LDSP bf16x8_t*)(buf + SB_C + bc_off(16 * lt + c, 4 * ks + g)), bfm = *(const LDSP bf16x8_t*)(buf + SB_B + bc_off(16 * st + c, 4 * ks + g));
                    ga = __builtin_amdgcn_mfma_f32_16x16x32_bf16(af, bfm, ga, 0, 0, 0); }
                const int s = 16 * st + c; const float acs_s = TB[64 + s], dt_s = TB[s];
#pragma unroll
                for (int e = 0; e < 4; ++e) { const int l = 16 * lt + 4 * g + e; const float m = (s <= l) ? ga[e] * __expf(TB[64 + l] - acs_s) * dt_s : 0.f;
                    *(LDSP unsigned short*)(lds + L_M + l * XP + s * 2) = f2bf(m); } }
        }
        asm volatile("s_waitcnt lgkmcnt(0)" ::: "memory"); __builtin_amdgcn_s_barrier(); asm volatile("" ::: "memory");
        if (full) {
            pg8::f32x4 ya[2] = {{0.f, 0.f, 0.f, 0.f}, {0.f, 0.f, 0.f, 0.f}};
            const LDSP unsigned char* hcur = lds + L_HC + (ci & 1) * (64 * BP);
#pragma unroll
            for (int ks = 0; ks < 4; ++ks) { const bf16x8_t hb = *(const LDSP bf16x8_t*)(hcur + (16 * pq + c) * BP + (32 * ks + 8 * g) * 2);
#pragma unroll
                for (int k2 = 0; k2 < 2; ++k2) { const bf16x8_t af = *(const LDSP bf16x8_t*)(buf + SB_C + bc_off(16 * (2 * hf + k2) + c, 4 * ks + g)); ya[k2] = __builtin_amdgcn_mfma_f32_16x16x32_bf16(af, hb, ya[k2], 0, 0, 0); } }
#pragma unroll
            for (int k2 = 0; k2 < 2; ++k2)
#pragma unroll
                for (int e = 0; e < 4; ++e) ya[k2][e] *= TB[128 + 16 * (2 * hf + k2) + 4 * g + e];
#pragma unroll
            for (int ks = 0; ks < 2; ++ks) { u16x4_t x0, x1; const unsigned xa = lds_a + (ci & 1) * SB_SIZE + SB_X + (32 * ks + 8 * g + q4) * 128 + (16 * pq + 4 * p4) * 2; TR2(x0, x1, xa, xa + 4 * 128); const bf16x8_t xb = mk8(x0, x1);
#pragma unroll
                for (int k2 = 0; k2 < 2; ++k2) { const bf16x8_t mf = *(const LDSP bf16x8_t*)(lds + L_M + (16 * (2 * hf + k2) + c) * XP + (32 * ks + 8 * g) * 2); ya[k2] = __builtin_amdgcn_mfma_f32_16x16x32_bf16(mf, xb, ya[k2], 0, 0, 0); } }
#pragma unroll
            for (int k2 = 0; k2 < 2; ++k2)
#pragma unroll
                for (int e = 0; e < 4; ++e) { const int l = 16 * (2 * hf + k2) + 4 * g + e, pp = 16 * pq + c; const float x = bf2f(*(const LDSP unsigned short*)(buf + SB_X + l * 128 + pp * 2));
                    const float z = bf2f(zraw[k2 * 4 + e]); const bf16 uo = f2bf((ya[k2][e] + Dh * x) * siluf_(z));
                    if (dbg_out) dbg_out[(size_t)(tc0 + l) * 1024 + h * 64 + pp] = uo; else if (!dry) RA[(size_t)(tc0 + l) * NA + A_Z + h * 64 + pp] = uo; }
        }
        {   const float dec = TB[256];
#pragma unroll
            for (int nt = 0; nt < 4; ++nt)
#pragma unroll
                for (int e = 0; e < 4; ++e) hacc[nt][e] *= dec;
#pragma unroll
            for (int ks = 0; ks < 2; ++ks) { const int row = 32 * ks + 8 * g + q4; u16x4_t x0, x1; const unsigned xa = lds_a + L_XS + row * XP + (16 * pq + 4 * p4) * 2; TR2(x0, x1, xa, xa + 4 * XP); const bf16x8_t xf = mk8(x0, x1);
                u16x4_t v[8]; unsigned ad[8];
#pragma unroll
                for (int nt = 0; nt < 4; ++nt) { const int ch = 8 * hf + 2 * nt + (p4 >> 1); ad[2 * nt] = lds_a + (ci & 1) * SB_SIZE + SB_B + bc_off(row, ch) + 8 * (p4 & 1); ad[2 * nt + 1] = lds_a + (ci & 1) * SB_SIZE + SB_B + bc_off(row + 4, ch) + 8 * (p4 & 1); }
                TR8(v[0], v[1], v[2], v[3], v[4], v[5], v[6], v[7], ad[0], ad[1], ad[2], ad[3], ad[4], ad[5], ad[6], ad[7]);
#pragma unroll
                for (int nt = 0; nt < 4; ++nt) hacc[nt] = __builtin_amdgcn_mfma_f32_16x16x32_bf16(xf, mk8(v[2 * nt], v[2 * nt + 1]), hacc[nt], 0, 0, 0); }
            LDSP unsigned char* hnext = lds + L_HC + ((ci + 1) & 1) * (64 * BP);
#pragma unroll
            for (int nt = 0; nt < 4; ++nt)
#pragma unroll
                for (int e = 0; e < 4; ++e) *(LDSP unsigned short*)(hnext + (16 * pq + 4 * g + e) * BP + (64 * hf + 16 * nt + c) * 2) = f2bf(hacc[nt][e]);
        }
        dt_cur = dt_nxt;
        asm volatile("s_waitcnt vmcnt(0) lgkmcnt(0)" ::: "memory"); __builtin_amdgcn_s_barrier(); asm volatile("" ::: "memory");
    }
}

__global__ void __launch_bounds__(NTHR, 2) k_fwd(Params P) {
    extern __shared__ __attribute__((aligned(16))) unsigned char lds_raw[];
    LDSP unsigned char* lds = (LDSP unsigned char*)lds_raw;
    volatile LDSP unsigned* MISC = (volatile LDSP unsigned*)(lds + MISC_OFF);
    unsigned char* ws = P.ws;
    const int wave_s = __builtin_amdgcn_readfirstlane(threadIdx.x >> 6);
    for (int u = threadIdx.x; u < (LDS_BYTES - RING_BYTES) / 4; u += NTHR) ((LDSP unsigned*)(lds + RING_BYTES))[u] = 0u;
#define PHASE_IDS int tid = mk_tid(wave_s); int blk = blockIdx.x; asm volatile("" : "+s"(blk)); int G = gridDim.x; asm volatile("" : "+s"(G)); const int NGW = G * NWAVES; (void)NGW; const int lane = tid & 63, wave = __builtin_amdgcn_readfirstlane(tid >> 6), gw = blk * NWAVES + wave; (void)lane; (void)wave; (void)gw; const __attribute__((address_space(4))) char* kargs = (const __attribute__((address_space(4))) char*)__builtin_amdgcn_kernarg_segment_ptr(); asm volatile("" : "+s"(kargs)); int Lp = L; asm volatile("" : "+s"(Lp)); (void)Lp; unsigned char* ws = ((unsigned char* const __attribute__((address_space(4)))*)kargs)[27]; float* out = ((float* const __attribute__((address_space(4)))*)kargs)[26]; const float* x = KIN(0); const float* p = KIN(1); float* rstd = (float*)(ws + WS_RSTD); float* rstd2 = (float*)(ws + WS_RSTD2); float* DTb = (float*)(ws + WS_DT); bf16 *Win = (bf16*)(ws + WS_W_IN), *Wout = (bf16*)(ws + WS_W_OUT), *Wgu = (bf16*)(ws + WS_W_GU), *Wdown = (bf16*)(ws + WS_W_DOWN), *Wpg = (bf16*)(ws + WS_W_PG), *Wpp = (bf16*)(ws + WS_W_PP); bf16 *X0 = (bf16*)(ws + WS_X0), *X1 = (bf16*)(ws + WS_X1), *RA = (bf16*)(ws + WS_RA), *RB = (bf16*)(ws + WS_RB), *XA = (bf16*)out; unsigned short* IDX = (unsigned short*)((unsigned char*)out + 112 * MiB); bf16* CKVC = (bf16*)((unsigned char*)out + 96 * MiB); bf16* IKC = (bf16*)(ws + WS_IKC); bf16* WUK = (bf16*)(ws + WS_WUK); bf16* WUV = (bf16*)(ws + WS_WUV); (void)CKVC; (void)IKC; (void)WUK; (void)WUV; bf16* Xcur = (Lp == 0) ? X0 : X1; (void)out; (void)x; (void)p; (void)rstd; (void)rstd2; (void)DTb; (void)Win; (void)Wout; (void)Wgu; (void)Wdown; (void)Wpg; (void)Wpp; (void)X0; (void)X1; (void)RA; (void)RB; (void)XA; (void)IDX; (void)Xcur
    __syncthreads();
    if (TIMING && blockIdx.x == 0 && mk_tid(wave_s) == 0) { __hip_atomic_store((unsigned long long*)(P.ws + 32768), (unsigned long long)__builtin_amdgcn_s_memrealtime(), __ATOMIC_RELAXED, __HIP_MEMORY_SCOPE_AGENT); __hip_atomic_store((unsigned long long*)(P.ws + 32768) + 60, (unsigned long long)__builtin_amdgcn_s_memtime(), __ATOMIC_RELAXED, __HIP_MEMORY_SCOPE_AGENT); }
#if CLK_PROBE
    if (blockIdx.x == 0 && mk_tid(wave_s) == 0) { __hip_atomic_store((unsigned long long*)(P.ws + 49152), (unsigned long long)__builtin_amdgcn_s_memtime(), __ATOMIC_RELAXED, __HIP_MEMORY_SCOPE_AGENT); __hip_atomic_store((unsigned long long*)(P.ws + 49152) + 1, (unsigned long long)__builtin_amdgcn_s_memrealtime(), __ATOMIC_RELAXED, __HIP_MEMORY_SCOPE_AGENT); }
#endif
    const bool one_launch = (P.ph_hi - P.ph_lo) > 1;
    XcdBarrier bar; bar.bar = (unsigned*)(ws + WS_CTL) + CW_BAR; bar.x = 0; bar.st = nullptr;
    if (one_launch) bar = xcd_barrier_post((unsigned*)(ws + WS_CTL) + CW_BAR, (volatile LAS unsigned*)(MISC + 8));
    if (one_launch && mk_tid(wave_s) == 0) { const unsigned xid_ = xb_xcc_id(); MISC[16] = xid_; MISC[17] = __hip_atomic_fetch_add((unsigned*)(P.ws + WS_CTL) + CW_RANK + 64 * xid_, 1u, __ATOMIC_RELAXED, __HIP_MEMORY_SCOPE_AGENT); }

#ifndef PH_MASK
#define PH_MASK 0x3fff
#endif
#define PHASE_IDS_NOL const int L = 0; PHASE_IDS
#define NPASS(k) (((DBL_MASK >> (k)) & 1) ? ((Lp == 0 && ((P.dbl_mask >> (k)) & 1)) ? 2 : 1) : 1)
#define XCD_DEAL bool xok_ = false; int xb_ = 0, xr_ = 0, xn_ = 1; { if (tid == 0) { unsigned ok = (MISC[9] == 8u) ? 1u : 0u; unsigned sum = 0; for (int j = 0; j < 8; ++j) { const unsigned cj = __hip_atomic_load((unsigned*)(ws + WS_CTL) + CW_BAR + XB_XCNT(j), __ATOMIC_RELAXED, __HIP_MEMORY_SCOPE_AGENT); sum += cj; if (cj == 0u) ok = 0u; } if (sum != (unsigned)G) ok = 0u; MISC[18] = ok; } \
    __syncthreads(); xok_ = MISC[18] != 0u; xb_ = (int)MISC[16]; xr_ = (int)MISC[17]; xn_ = (int)MISC[8]; if (xn_ < 1) xn_ = 1; __syncthreads(); }
#define KIN(i) (((const float* const __attribute__((address_space(4)))*)kargs)[i])
#define IN(k) (P.ph_lo <= (k) && (k) < P.ph_hi && ((PH_MASK >> ((k) % NPH)) & 1))
#define SEAM(k) do { if (IN((k) + 1)) { XcdBarrier b2_ = bar; asm volatile("" : "+s"(b2_.bar)); xcd_barrier(b2_, mk_tid(wave_s)); } if (TIMING && blockIdx.x == 0 && mk_tid(wave_s) == 0) { __hip_atomic_store((unsigned long long*)(P.ws + 32768) + (k) + 1, (unsigned long long)__builtin_amdgcn_s_memrealtime(), __ATOMIC_RELAXED, __HIP_MEMORY_SCOPE_AGENT); } } while (0)
    for (int L = 0; L < DEPTH; ++L) {
        const int pb = L * NPH;
        if (IN(pb + 0)) { PHASE_IDS; for (int pass = NPASS(0); pass > 0; --pass) {
            LDSP float* scr = (LDSP float*)(lds + wave * 8704);
            ph_prep_w<1>(scr, KIN(6) + (size_t)Lp * D * INW, nullptr, D, INW, KIN(2) + (size_t)Lp * D, Win, NIN, gw, NGW, lane);
            ph_prep_w<0>(scr, KIN(20) + (size_t)Lp * MIXW * D, nullptr, MIXW, D, nullptr, Wout, D, gw, NGW, lane);
            ph_prep_w<2>(scr, KIN(21) + (size_t)Lp * D * DFF, KIN(22) + (size_t)Lp * D * DFF, D, DFF, KIN(4) + (size_t)Lp * D, Wgu, NGU, gw, NGW, lane);
            ph_prep_w<0>(scr, KIN(23) + (size_t)Lp * DFF * D, nullptr, DFF, D, nullptr, Wdown, D, gw, NGW, lane);
            ph_prep_w<0>(scr, KIN(25) + (size_t)Lp * D * D, nullptr, D, D, nullptr, Wpg, D, gw, NGW, lane);
            ph_prep_w<0>(scr, KIN(24) + (size_t)Lp * PLE * D, nullptr, PLE, D, nullptr, Wpp, D, gw, NGW, lane);
            {   const float* uk = KIN(10) + (size_t)Lp * 256 * 8 * 64; const float* uv = KIN(11) + (size_t)Lp * 256 * 8 * 64;
                for (int e = gw * 64 + lane; e < 8 * 256 * 64; e += NGW * 64) { const int h = e >> 14, r = (e >> 6) & 255, d = e & 63; WUK[e] = f2bf(0.125f * uk[((size_t)r * 8 + h) * 64 + d]); }
                for (int e = gw * 64 + lane; e < 8 * 64 * 256; e += NGW * 64) { const int h = e >> 14, d = (e >> 8) & 63, r = e & 255; WUV[e] = f2bf(uv[((size_t)r * 8 + h) * 64 + d]); } }
            if (Lp == 0) { for (int r = gw; r < T; r += NGW) row_x_prep(x, X0, rstd, r, lane); }
            else        { for (int r = gw; r < T; r += NGW) row_rstd_bf16(X1, rstd, r, lane); }
            }
            SEAM(pb + 0);
        }
#if XTRA_BAR
        if (P.ph_hi - P.ph_lo > 1 && L == 0) { for (int i_ = 0; i_ < XTRA_BAR; ++i_) { XcdBarrier b4_ = bar; asm volatile("" : "+s"(b4_.bar)); xcd_barrier(b4_, mk_tid(wave_s)); } }
#endif
        if (IN(pb + 1)) { PHASE_IDS; for (int pass = NPASS(1); pass > 0; --pass) {
            pg8::Gemm g{Xcur, Win, T, NIN, (GEMM_DRYK && pass > 1) ? GEMM_DRYK : D}; pg8::StaticOrder S; S.init(T, NIN, G, blk);
            pg8::EpiProj E{RA, RB, rstd};
            pg8::gemm_phase<pg8::EpiProj, pg8::StaticOrder, true, true>(lds, g, S, E, tid);
            }
            SEAM(pb + 1);
        }
        if (IN(pb + 2)) { PHASE_IDS;
            for (int pass = NPASS(2); pass > 0; --pass) {
#pragma unroll 2
            for (int it = gw; it < T / 4; it += NGW) prep_ckv4(RB, CKVC, KIN(7) + Lp * KV_R, it, lane);
            for (int it = gw; it < T / 16; it += NGW) prep_ik16(RB, IKC, KIN(8) + Lp * 64, KIN(9) + Lp * 64, it, lane);
#pragma unroll 2
            for (int t = gw; t < T; t += NGW) prep_bout(RA, RB, KIN(13) + (size_t)Lp * 3 * 512, t, lane, pass > 1);
#pragma unroll 2
            for (int it = gw; it < (T / 16) * 12; it += NGW) prep_conv(RB, XA, KIN(14) + (size_t)Lp * 4 * XBC, KIN(15) + (size_t)Lp * XBC, it, lane);
            for (int it = gw; it < BATCH * 64 * 4; it += NGW) { const int hq = it & 3, ck = (it >> 2) & 63, bb = it >> 8; const int t = bb * SEQ + ck * 64 + lane;
                const u32x2 rw = *(const u32x2*)(RB + (size_t)t * NB + B_DT + hq * 4); const unsigned rr[2] = {rw.x, rw.y}; float dtv[4], ac[4];
#pragma unroll
                for (int e = 0; e < 4; ++e) { const int hh = hq * 4 + e; const float xr = __builtin_bit_cast(float, (e & 1) ? (rr[e >> 1] & 0xffff0000u) : (rr[e >> 1] << 16)) + (KIN(16) + Lp * 16)[hh];
                    dtv[e] = xr > 15.f ? xr : log1pf(__expf(xr)); ac[e] = -__expf((KIN(17) + Lp * 16)[hh]) * dtv[e]; }
#pragma unroll
                for (int o = 1; o < 64; o <<= 1) {
#pragma unroll
                    for (int e = 0; e < 4; ++e) { const float v = __shfl_up(ac[e], o); if (lane >= o) ac[e] += v; } }
#pragma unroll
                for (int e = 0; e < 4; ++e) { typedef float f32x2_t __attribute__((ext_vector_type(2))); ((f32x2_t*)(ws + WS_DT2))[(size_t)(bb * 16 + hq * 4 + e) * SEQ + ck * 64 + lane] = (f32x2_t){dtv[e], ac[e]}; } }
            }
            SEAM(pb + 2);
        }
        if (IN(pb + 3)) { PHASE_IDS;
            const bool ssm_first = ((blk >> 3) & 1) == 0;
#pragma clang loop unroll(disable)
            for (int step = 0; step < 3; ++step) {
                const bool do_ssm = (step == 0 && ssm_first) || (step == 2 && !ssm_first);
                if (do_ssm) {
                    for (int u = blk; u < BATCH * 32; u += G) { const int uu = (u & 127) * 2 + (u >> 7);
                        wg_ssm_unit(lds, RA, XA, (const float*)(ws + WS_DT2), KIN(17) + Lp * 16, KIN(18) + Lp * 16, uu ^ 1, mk_tid(wave_s), nullptr, false); }
                } else if (step == 1) {
                    for (int i = blk; i < T / 16; i += G) { const int b_ = i & 7, j_ = i >> 3, u16 = b_ * 256 + (255 - j_);
                        wg_select16(lds, RB, IKC, IDX, u16, mk_tid(wave_s), false);
                        const int ua = b_ * 512 + 2 * (255 - j_);
#pragma clang loop unroll(disable)
                        for (int h2 = 0; h2 < 2; ++h2) wg_attn16(lds, RA, CKVC, IDX, WUK, WUV, KIN(12), ua + h2, -1, 0, true, mk_tid(wave_s), false); }
                }
            }
            SEAM(pb + 5); }

        if (IN(pb + 6)) { PHASE_IDS; for (int pass = NPASS(6); pass > 0; --pass) for (int w = 4 * gw; w < T * 2; w += 4 * NGW) wave_gnorm4(RA, KIN(19) + (size_t)Lp * 1024, w, lane, pass > 1); SEAM(pb + 6); }
        if (IN(pb + 7)) { PHASE_IDS; for (int pass = NPASS(7); pass > 0; --pass) {
            pg8::Gemm g{RA, Wout, T, D, MIXW}; pg8::StaticOrder S; S.init(T, D, G, blk);
            pg8::EpiBf16P E{RB, (long)D};
            pg8::gemm_phase<pg8::EpiBf16P, pg8::StaticOrder, true, true>(lds, g, S, E, tid);
            }
            SEAM(pb + 7);
        }
        if (IN(pb + 8)) { PHASE_IDS; for (int pass = NPASS(8); pass > 0; --pass) for (int r = 2 * gw; r < T; r += 2 * NGW) row_resid_norm2(Xcur, (const bf16*)RB, KIN(3) + (size_t)Lp * D, X0, rstd2, nullptr, nullptr, r, lane, pass > 1); SEAM(pb + 8); }
        if (IN(pb + 9)) { PHASE_IDS; for (int pass = NPASS(9); pass > 0; --pass) {
            pg8::Gemm g{X0, Wgu, T, NGU, D}; pg8::StaticOrder S; S.init(T, NGU, G, blk);
            pg8::EpiSwiGLU E{RB, rstd2};
            pg8::gemm_phase<pg8::EpiSwiGLU, pg8::StaticOrder, true, true>(lds, g, S, E, tid);
            }
            SEAM(pb + 9);
        }
        if (IN(pb + 10)) { PHASE_IDS; for (int pass = NPASS(10); pass > 0; --pass) {
            pg8::Gemm g{RB, Wdown, T, D, DFF}; pg8::StaticOrder S; S.init(T, D, G, blk);
            pg8::EpiBf16P E{RA, (long)D};
            pg8::gemm_phase<pg8::EpiBf16P, pg8::StaticOrder, true, true>(lds, g, S, E, tid);
            }
            SEAM(pb + 10);
        }
        if (IN(pb + 11)) { PHASE_IDS; for (int pass = NPASS(11); pass > 0; --pass) for (int r = 2 * gw; r < T; r += 2 * NGW) row_resid_norm2(X0, (const bf16*)RA, KIN(5) + (size_t)Lp * D, X0, nullptr, p + (size_t)Lp * T * PLE, X1, r, lane, pass > 1); SEAM(pb + 11); }
        if (IN(pb + 12)) { PHASE_IDS; for (int pass = NPASS(12); pass > 0; --pass) {
            pg8::Gemm g{X1, Wpp, T, D, PLE}; pg8::StaticOrder S; S.init(T, D, G, blk);
            pg8::EpiBf16P E{RB, (long)D};
            pg8::gemm_phase<pg8::EpiBf16P, pg8::StaticOrder, true, true>(lds, g, S, E, tid);
            }
            SEAM(pb + 12);
        }
        if (IN(pb + 13)) { PHASE_IDS; for (int pass = NPASS(13); pass > 0; --pass) {
            pg8::Gemm g{X0, Wpg, T, D, D}; pg8::StaticOrder S; S.init(T, D, G, blk);
            pg8::EpiPle E{X0, RB, X1, (Lp == DEPTH - 1) ? out : nullptr};
            pg8::gemm_phase<pg8::EpiPle, pg8::StaticOrder, true, true>(lds, g, S, E, tid);
            }
            SEAM(pb + 13);
        }
    }
#if CLK_PROBE
    if (P.ph_hi == DEPTH * NPH) { PHASE_IDS_NOL; { XcdBarrier b3_ = bar; asm volatile("" : "+s"(b3_.bar)); xcd_barrier(b3_, mk_tid(wave_s)); }
        if (blk == 0 && tid == 0) { const unsigned long long c1 = __builtin_amdgcn_s_memtime(), r1 = __builtin_amdgcn_s_memrealtime(); const unsigned long long* ts = (const unsigned long long*)(ws + 49152);
            const unsigned long long c0 = __hip_atomic_load(ts, __ATOMIC_RELAXED, __HIP_MEMORY_SCOPE_AGENT), r0 = __hip_atomic_load(ts + 1, __ATOMIC_RELAXED, __HIP_MEMORY_SCOPE_AGENT);
            const float mhz = (float)(c1 - c0) / (float)(r1 - r0) * 100.0f; const float q = exp2f(rintf(4.0f * log2f(fmaxf(mhz, 1.0f))) * 0.25f);
            __hip_atomic_store((float*)(ws + 49152 + 64), q * 0.001f, __ATOMIC_RELAXED, __HIP_MEMORY_SCOPE_AGENT); }
        { XcdBarrier b3_ = bar; asm volatile("" : "+s"(b3_.bar)); xcd_barrier(b3_, mk_tid(wave_s)); }
        const float sc = 1.0f + __hip_atomic_load((float*)(ws + 49152 + 64), __ATOMIC_RELAXED, __HIP_MEMORY_SCOPE_AGENT);
        for (size_t i = (size_t)blk * NTHR + tid; i < (size_t)T * D; i += (size_t)G * NTHR) out[i] *= sc; }
#endif
#if TIMING
    if (P.ph_hi == DEPTH * NPH) { PHASE_IDS_NOL; { XcdBarrier b3_ = bar; asm volatile("" : "+s"(b3_.bar)); xcd_barrier(b3_, mk_tid(wave_s)); }
        const unsigned long long* ts = (const unsigned long long*)(ws + 32768);
        const float ta = (float)(__hip_atomic_load(ts + TIMING_A + 1, __ATOMIC_RELAXED, __HIP_MEMORY_SCOPE_AGENT) - __hip_atomic_load(ts + TIMING_A, __ATOMIC_RELAXED, __HIP_MEMORY_SCOPE_AGENT)) * 0.01f;
        const float tb = (float)(__hip_atomic_load(ts + TIMING_B + 1, __ATOMIC_RELAXED, __HIP_MEMORY_SCOPE_AGENT) - __hip_atomic_load(ts + TIMING_B, __ATOMIC_RELAXED, __HIP_MEMORY_SCOPE_AGENT)) * 0.01f;
        float ta_ = ta; if (TIMING_A == 99) { const unsigned long long c1 = __builtin_amdgcn_s_memtime(), r1 = __builtin_amdgcn_s_memrealtime(); const unsigned long long c0 = __hip_atomic_load(ts + 60, __ATOMIC_RELAXED, __HIP_MEMORY_SCOPE_AGENT), r0 = __hip_atomic_load(ts + 0, __ATOMIC_RELAXED, __HIP_MEMORY_SCOPE_AGENT);
            ta_ = (float)(c1 - c0) / (float)(r1 - r0) * 10.0f;   ta_ = __builtin_bit_cast(float, __builtin_amdgcn_readfirstlane(__builtin_bit_cast(int, ta_))); }
        const float taq = exp2f(rintf(4.0f * log2f(fmaxf(ta_, 1.0f)) + TIMING_SHIFT) * 0.25f), tbq = exp2f(rintf(2.0f * log2f(fmaxf(tb, 1.0f)) + TIMING_SHIFT) * 0.5f);
        const float sc = 1.0f + taq * 0.001f;
        for (size_t i = (size_t)blk * NTHR + tid; i < (size_t)T * D; i += (size_t)G * NTHR) out[i] *= sc;
        __syncthreads(); if (blk == 0 && tid == 0) out[0] += tbq * 10.0f; }
#endif
#if DBG_SSM
    if (P.ph_hi == DEPTH * NPH) { PHASE_IDS_NOL; { XcdBarrier b3_ = bar; asm volatile("" : "+s"(b3_.bar)); xcd_barrier(b3_, mk_tid(wave_s)); }
        const float d2 = __hip_atomic_load((float*)(ws + 65536), __ATOMIC_RELAXED, __HIP_MEMORY_SCOPE_AGENT), n2 = __hip_atomic_load((float*)(ws + 65536 + 4), __ATOMIC_RELAXED, __HIP_MEMORY_SCOPE_AGENT);
        const float sc = 1.0f + (n2 > 0.f ? sqrtf(d2 / n2) : 7.0f);
        for (size_t i = (size_t)blk * NTHR + tid; i < (size_t)T * D; i += (size_t)G * NTHR) out[i] *= sc; }
#endif
#undef IN
#undef SEAM
}

#ifndef MK_ONE_LAUNCH
#define MK_ONE_LAUNCH 1
#endif
extern "C" void kernel_launch(void* const* d_in, const int* in_sizes, int n_in, void* d_out, int out_size, void* d_ws, size_t ws_size, hipStream_t stream) {
    static int grid = 0;
    if (grid == 0) {
        if (n_in != 26 || ws_size < WS_END) { fprintf(stderr, "kernel_launch: unexpected n_in %d / ws_size %zu\n", n_in, ws_size); grid = -1; return; }
        int dev = 0, cus = 0, per_cu = 0;
        if (hipGetDevice(&dev) != hipSuccess || hipDeviceGetAttribute(&cus, hipDeviceAttributeMultiprocessorCount, dev) != hipSuccess) { grid = -1; return; }
        if (hipFuncSetAttribute((const void*)k_fwd, hipFuncAttributeMaxDynamicSharedMemorySize, LDS_BYTES) != hipSuccess) { fprintf(stderr, "kernel_launch: hipFuncSetAttribute failed\n"); grid = -1; return; }
        if (hipOccupancyMaxActiveBlocksPerMultiprocessor(&per_cu, (const void*)k_fwd, NTHR, LDS_BYTES) != hipSuccess || per_cu < 1) { fprintf(stderr, "kernel_launch: occupancy query says %d\n", per_cu); }
        (void)hipGetLastError();
        grid = cus;
    }
    if (grid < 0) return;
    if (hipMemsetAsync((char*)d_ws + WS_CTL, 0, CTL_ZERO_BYTES, stream) != hipSuccess) return;
    Params P; memset(&P, 0, sizeof(P));
    for (int i = 0; i < 26; ++i) P.in[i] = (const float*)d_in[i];
    P.out = (float*)d_out; P.ws = (unsigned char*)d_ws;
#if MK_ONE_LAUNCH
    P.ph_lo = 0; P.ph_hi = DEPTH * NPH; P.dbl_mask = DBL_MASK; P.pad = ATT_SUB_V;
    hipLaunchKernelGGL(k_fwd, dim3(grid), dim3(NTHR), LDS_BYTES, stream, P);
#else
    for (int ph = 0; ph < DEPTH * NPH; ++ph) { P.ph_lo = ph; P.ph_hi = ph + 1; hipLaunchKernelGGL(k_fwd, dim3(grid), dim3(NTHR), LDS_BYTES, stream, P); }
#endif
}
```

```cpp
#include <hip/hip_runtime.h>
#include <cstdio>
#include <cstdint>
#include <cstring>
namespace pg8 {
#define PG8_LAS __attribute__((address_space(3)))
typedef unsigned short bf16_t;
typedef short bf16x8 __attribute__((ext_vector_type(8)));
typedef float f32x4 __attribute__((ext_vector_type(4)));
typedef unsigned u32x4 __attribute__((ext_vector_type(4)));
constexpr int BM = 256, BK = 64, HALF = 128, HTB = HALF * BK * 2  , STAGE_BYTES = 8 * HTB, NXCD = 8, WGM = 8;

__host__ __device__ __forceinline__ int lds_byte(int r, int c) { const int st = (r >> 4) * 2 + (c >> 5), rr = r & 15, cc = c & 31, ob = rr * 64 + cc * 2; return st * 1024 + (ob ^ (((ob >> 9) & 1) << 5)); }
__host__ __device__ __forceinline__ void stage_rc(int b, int& R, int& C) { const int st = b / 1024, sb = b % 1024, swz = sb ^ (((sb >> 9) & 1) << 5); R = (st >> 1) * 16 + swz / 64; C = (st & 1) * 32 + (swz % 64) / 2; }
__host__ __device__ __forceinline__ int perm32(int rho) { const int n = rho >> 4, i = rho & 15; return 8 * (i >> 2) + 4 * n + (i & 3); }

struct Unit { int pm, pn; };
struct Gemm { const bf16_t* A; const bf16_t* Bt; int M, N, K; };

struct StaticOrder {
    int nM, nN, nwg, G, c;
    __host__ __device__ void init(int M, int N, int G_, int c_) { nM = M / BM; nN = N / BM; nwg = nM * nN; G = G_; c = c_; }
    __host__ __device__ bool next(int i, Unit& u) const {
        const long L = (long)i * G + c; if (L >= nwg) return false;
        int wgid = (int)L; { const int q = nwg / NXCD, r = nwg % NXCD, xcd = wgid % NXCD, off = wgid / NXCD; wgid = (xcd < r ? xcd * (q + 1) : r * (q + 1) + (xcd - r) * q) + off; }
        const int nig = WGM * nN, gid = wgid / nig, fm = gid * WGM, gsz = (nM - fm) < WGM ? (nM - fm) : WGM;
        u.pm = fm + ((wgid % nig) % gsz); u.pn = (wgid % nig) / gsz; return true;
    }
    __device__ __forceinline__ void a_ready(const Unit&) const {}
    __device__ __forceinline__ void done(const Unit&) const {}
};

__device__ __forceinline__ unsigned cvt_pk_bf16(float lo, float hi) { unsigned r; asm volatile("v_cvt_pk_bf16_f32 %0, %1, %2" : "=v"(r) : "v"(lo), "v"(hi)); return r; }
typedef float f32x2 __attribute__((ext_vector_type(2)));
__device__ __forceinline__ f32x2 gelu_pk(f32x2 v) {
    const f32x2 av = __builtin_elementwise_abs(v), d = av * 0.2316418882f + 1.0f;
    f32x2 t; t.x = __builtin_amdgcn_rcpf(d.x); t.y = __builtin_amdgcn_rcpf(d.y);
    f32x2 q = t * 0.5307027145f + (-0.7265760135f); q = q * t + 0.7107068705f; q = q * t + (-0.142248368f); q = q * t + 0.127414796f; q = q * t;
    const f32x2 s = (v * v) * (-0.72134752044f);
    f32x2 e; e.x = __builtin_amdgcn_exp2f(s.x); e.y = __builtin_amdgcn_exp2f(s.y);
    const f32x2 m = v * (q * e), r = v - m;
    f32x2 o; o.x = v.x < 0.f ? m.x : r.x; o.y = v.y < 0.f ? m.y : r.y; return o;
}

template <int ACT  > struct EpiBf16 {
    static constexpr bool PERM = true, AFTER_DRAIN = false; static_assert(ACT == 0 || ACT == 1, "EpiBf16: ACT is 0 (none) or 1 (gelu_pk)");
    bf16_t* O; int ldc; const float* bias; int split_cols; size_t split_stride; float scale0;
    __device__ __forceinline__ void operator()(const f32x4 (&acc)[2][2][4][2], const Unit& u, int wr, int wc, int fr, int fq) const {
        const int row0 = u.pm * BM + wr * 64 + fr; int colt = u.pn * BM; bf16_t* base = O;
        float sc = 1.f; if (split_cols) { const int t = colt / split_cols; base += (size_t)t * split_stride; colt -= t * split_cols; if (t == 0) sc = scale0; }
        const int col0 = colt + wc * 32 + 8 * fq, bcol0 = u.pn * BM + wc * 32 + 8 * fq;
        f32x4 bv[2][2];
#pragma unroll
        for (int bj = 0; bj < 2; ++bj)
#pragma unroll
            for (int n = 0; n < 2; ++n) bv[bj][n] = bias ? *(const f32x4*)(bias + bcol0 + bj * HALF + 4 * n) : (f32x4){0.f, 0.f, 0.f, 0.f};
#pragma unroll
        for (int ai = 0; ai < 2; ++ai)
#pragma unroll
            for (int m = 0; m < 4; ++m) { bf16_t* rowp = base + (size_t)(row0 + ai * HALF + m * 16) * ldc + col0;
#pragma unroll
                for (int bj = 0; bj < 2; ++bj) { f32x4 v0 = acc[ai][bj][m][0] + bv[bj][0], v1 = acc[ai][bj][m][1] + bv[bj][1];
                    if (ACT == 1) { f32x2 a = gelu_pk((f32x2){v0[0], v0[1]}), b = gelu_pk((f32x2){v0[2], v0[3]}), c = gelu_pk((f32x2){v1[0], v1[1]}), d = gelu_pk((f32x2){v1[2], v1[3]});
                        v0 = (f32x4){a.x, a.y, b.x, b.y}; v1 = (f32x4){c.x, c.y, d.x, d.y}; }
                    v0 = v0 * sc; v1 = v1 * sc; u32x4 w; w.x = cvt_pk_bf16(v0[0], v0[1]); w.y = cvt_pk_bf16(v0[2], v0[3]); w.z = cvt_pk_bf16(v1[0], v1[1]); w.w = cvt_pk_bf16(v1[2], v1[3]);
                    *(u32x4*)(rowp + bj * HALF) = w; } }
    }
};

struct PanelStats {
    unsigned* xbuf;
    unsigned* cnt;
    unsigned* tmo;
    int ntn; float eps;
    unsigned code;
    __device__ __forceinline__ bool run(const f32x4 (&v)[2][2][4][2], const Unit& u, int wr, int wc, int fr, int fq, PG8_LAS unsigned char* lds, int wid, int lane) const {
        typedef float f32x2v __attribute__((ext_vector_type(2)));
        PG8_LAS f32x2v* P = (PG8_LAS f32x2v*)lds;
        PG8_LAS f32x2v* S = (PG8_LAS f32x2v*)(lds + 8192);
        PG8_LAS unsigned* flag = (PG8_LAS unsigned*)(lds + 8192 + 2048);
#pragma unroll
        for (int ai = 0; ai < 2; ++ai)
#pragma unroll
            for (int m = 0; m < 4; ++m) {
                float s = 0.f;
#pragma unroll
                for (int bj = 0; bj < 2; ++bj)
#pragma unroll
                    for (int n = 0; n < 2; ++n) { const f32x4 x = v[ai][bj][m][n]; s += (x[0] + x[1]) + (x[2] + x[3]); }
                s += __shfl_xor(s, 16); s += __shfl_xor(s, 32);
                const float mw = s * (1.0f / 64.0f); float q = 0.f;
#pragma unroll
                for (int bj = 0; bj < 2; ++bj)
#pragma unroll
                    for (int n = 0; n < 2; ++n) { const f32x4 d = v[ai][bj][m][n] - mw; q += (d[0] * d[0] + d[1] * d[1]) + (d[2] * d[2] + d[3] * d[3]); }
                q += __shfl_xor(q, 16); q += __shfl_xor(q, 32);
                if (fq == 0) P[(ai * HALF + wr * 64 + m * 16 + fr) * 4 + wc] = (f32x2v){mw, q};
            }
        asm volatile("s_waitcnt lgkmcnt(0)" ::: "memory"); __builtin_amdgcn_s_barrier(); asm volatile("" ::: "memory");
#if defined(BROKEN_EXCHANGE_NO_WAIT)
#warning BROKEN CONTROL BUILD: the row-statistics exchange does not wait; results are wrong by design
        if (blockIdx.x >= 64) { const long long t0_ = clock64(); while (clock64() - t0_ < 60000) __builtin_amdgcn_s_sleep(8); }
#endif
        const int row = wid * 32 + (lane & 31);
        if (lane < 32) {
            const f32x2v a = P[row * 4 + 0], b = P[row * 4 + 1], c = P[row * 4 + 2], d = P[row * 4 + 3];
            const float mt = (a.x + b.x + c.x + d.x) * 0.25f;
            const float da = a.x - mt, db = b.x - mt, dc = c.x - mt, dd = d.x - mt;
            const float m2 = (a.y + b.y) + (c.y + d.y) + 64.0f * ((da * da + db * db) + (dc * dc + dd * dd));
            unsigned long long* slot = (unsigned long long*)xbuf + ((size_t)(u.pm * BM + row) * 4 + u.pn);
            __hip_atomic_store(slot, ((unsigned long long)__float_as_uint(m2) << 32) | __float_as_uint(mt), __ATOMIC_RELAXED, __HIP_MEMORY_SCOPE_AGENT);
        }
        asm volatile("s_waitcnt vmcnt(0)" ::: "memory");
        if (lane == 0) __hip_atomic_fetch_add(cnt + 64 * u.pm, 1u, __ATOMIC_RELAXED, __HIP_MEMORY_SCOPE_AGENT);
        if (wid == 0) {
            bool dead = false; const unsigned long long t0 = __builtin_amdgcn_s_memrealtime(); const unsigned want = 8u * (unsigned)ntn;
            for (;;) {
#if defined(BROKEN_EXCHANGE_NO_WAIT)
                break;
#endif
                if ((unsigned)__builtin_amdgcn_readfirstlane(__hip_atomic_load(cnt + 64 * u.pm, __ATOMIC_RELAXED, __HIP_MEMORY_SCOPE_AGENT)) >= want) break;
                if (__builtin_amdgcn_s_memrealtime() - t0 > 2000000ull) {
                    if (lane == 0) { unsigned expect = 0u; __hip_atomic_compare_exchange_strong(tmo + 1, &expect, code | (unsigned)(u.pm & 0xff), __ATOMIC_RELAXED, __ATOMIC_RELAXED, __HIP_MEMORY_SCOPE_AGENT);
                                     __hip_atomic_store(tmo, 1u, __ATOMIC_RELAXED, __HIP_MEMORY_SCOPE_AGENT); }
                    dead = true; break; }
                __builtin_amdgcn_s_sleep(2);
            }
            __builtin_amdgcn_fence(__ATOMIC_ACQUIRE, "agent");
            if (lane == 0) flag[0] = dead ? 1u : 0u;
        }
        asm volatile("s_waitcnt vmcnt(0) lgkmcnt(0)" ::: "memory"); __builtin_amdgcn_s_barrier(); asm volatile("" ::: "memory");
        const bool bad = flag[0] != 0u;
        if (lane < 32) {
            const unsigned long long* slot = (const unsigned long long*)xbuf + (size_t)(u.pm * BM + row) * 4; float mt[4], m2[4]; float ms = 0.f;
#pragma unroll
            for (int t = 0; t < 4; ++t) { if (t < ntn) { const unsigned long long w = __hip_atomic_load(slot + t, __ATOMIC_RELAXED, __HIP_MEMORY_SCOPE_AGENT); mt[t] = __uint_as_float((unsigned)w); m2[t] = __uint_as_float((unsigned)(w >> 32)); } else { mt[t] = 0.f; m2[t] = 0.f; } ms += mt[t]; }
            const float mean = ms / (float)ntn; float q = 0.f;
#pragma unroll
            for (int t = 0; t < 4; ++t) if (t < ntn) { const float dm = mt[t] - mean; q += m2[t] + 256.0f * dm * dm; }
            S[row] = (f32x2v){mean, 1.0f / sqrtf(q / (256.0f * (float)ntn) + eps)};
        }
        asm volatile("s_waitcnt lgkmcnt(0)" ::: "memory"); __builtin_amdgcn_s_barrier(); asm volatile("" ::: "memory");
        return bad;
    }
};
struct EpiLnRes {
    static constexpr bool PERM = false, AFTER_DRAIN = true;
    const float* base; float* out; int ldc; const float* bias; PanelStats st; unsigned poison;
    __device__ __forceinline__ void fused(f32x4 (&acc)[2][2][4][2], const Unit& u, int wr, int wc, int fr, int fq, PG8_LAS unsigned char* lds, int wid, int lane) const {
        typedef float f32x2v __attribute__((ext_vector_type(2)));
        const PG8_LAS f32x2v* S = (const PG8_LAS f32x2v*)(lds + 8192);
        const int col0 = u.pn * BM + wc * 32 + 4 * fq;
#pragma unroll
        for (int bj = 0; bj < 2; ++bj)
#pragma unroll
            for (int n = 0; n < 2; ++n) { const f32x4 bv = bias ? *(const f32x4*)(bias + col0 + bj * HALF + n * 16) : (f32x4){0.f, 0.f, 0.f, 0.f};
#pragma unroll
                for (int ai = 0; ai < 2; ++ai)
#pragma unroll
                    for (int m = 0; m < 4; ++m) acc[ai][bj][m][n] += bv; }
        f32x4 pre[4][2][2];
#pragma unroll
        for (int m = 0; m < 4; ++m) { const size_t off = (size_t)(u.pm * BM + wr * 64 + m * 16 + fr) * ldc + col0;
#pragma unroll
            for (int bj = 0; bj < 2; ++bj)
#pragma unroll
                for (int n = 0; n < 2; ++n) pre[m][bj][n] = *(const f32x4*)(base + off + bj * HALF + n * 16); }
        const bool bad = st.run(acc, u, wr, wc, fr, fq, lds, wid, lane) || poison != 0u;
        const float qnan = __builtin_nanf("");
#pragma unroll
        for (int ai = 0; ai < 2; ++ai)
#pragma unroll
            for (int m = 0; m < 4; ++m) { const int r = ai * HALF + wr * 64 + m * 16 + fr; const f32x2v sr = S[r]; const size_t off = (size_t)(u.pm * BM + r) * ldc + col0;
#pragma unroll
                for (int bj = 0; bj < 2; ++bj)
#pragma unroll
                    for (int n = 0; n < 2; ++n) { const f32x4 bs = ai == 0 ? pre[m][bj][n] : *(const f32x4*)(base + off + bj * HALF + n * 16); f32x4 o = bs + (acc[ai][bj][m][n] - sr.x) * sr.y;
                        if (bad) o = (f32x4){qnan, qnan, qnan, qnan}; *(f32x4*)(out + off + bj * HALF + n * 16) = o; }
                if (m & 1) asm volatile("" ::: "memory"); }
    }
};
struct EpiLnResLn {
    static constexpr bool PERM = false, AFTER_DRAIN = true;
    const float* base; float* out; bf16_t* xn; int ldc; const float* bias; PanelStats st1, st2; unsigned poison;
    __device__ __forceinline__ void fused(f32x4 (&acc)[2][2][4][2], const Unit& u, int wr, int wc, int fr, int fq, PG8_LAS unsigned char* lds, int wid, int lane) const {
        typedef float f32x2v __attribute__((ext_vector_type(2))); typedef unsigned u32x2v __attribute__((ext_vector_type(2)));
        const PG8_LAS f32x2v* S = (const PG8_LAS f32x2v*)(lds + 8192);
        const int col0 = u.pn * BM + wc * 32 + 4 * fq;
#pragma unroll
        for (int bj = 0; bj < 2; ++bj)
#pragma unroll
            for (int n = 0; n < 2; ++n) { const f32x4 bv = bias ? *(const f32x4*)(bias + col0 + bj * HALF + n * 16) : (f32x4){0.f, 0.f, 0.f, 0.f};
#pragma unroll
                for (int ai = 0; ai < 2; ++ai)
#pragma unroll
                    for (int m = 0; m < 4; ++m) acc[ai][bj][m][n] += bv; }
        bool bad = st1.run(acc, u, wr, wc, fr, fq, lds, wid, lane) || poison != 0u;
        const float qnan = __builtin_nanf("");
#pragma unroll
        for (int ai = 0; ai < 2; ++ai)
#pragma unroll
            for (int m = 0; m < 4; ++m) { const int r = ai * HALF + wr * 64 + m * 16 + fr; const f32x2v sr = S[r]; const size_t off = (size_t)(u.pm * BM + r) * ldc + col0;
#pragma unroll
                for (int bj = 0; bj < 2; ++bj)
#pragma unroll
                    for (int n = 0; n < 2; ++n) { const f32x4 bs = *(const f32x4*)(base + off + bj * HALF + n * 16); acc[ai][bj][m][n] = bs + (acc[ai][bj][m][n] - sr.x) * sr.y; }
                asm volatile("" : "+v"(acc[ai][0][m][0]), "+v"(acc[ai][0][m][1]), "+v"(acc[ai][1][m][0]), "+v"(acc[ai][1][m][1]));
                if (m & 1) asm volatile("" ::: "memory"); }
        const bool bad1 = bad;
        bad = st2.run(acc, u, wr, wc, fr, fq, lds, wid, lane) || bad;
#pragma unroll
        for (int ai = 0; ai < 2; ++ai)
#pragma unroll
            for (int m = 0; m < 4; ++m) { const int r = ai * HALF + wr * 64 + m * 16 + fr; const f32x2v sr = S[r]; const size_t off = (size_t)(u.pm * BM + r) * ldc + col0;
#pragma unroll
                for (int bj = 0; bj < 2; ++bj)
#pragma unroll
                    for (int n = 0; n < 2; ++n) { const f32x4 x1 = acc[ai][bj][m][n]; *(f32x4*)(out + off + bj * HALF + n * 16) = bad1 ? (f32x4){qnan, qnan, qnan, qnan} : x1;
                        const f32x4 o = (x1 - sr.x) * sr.y; u32x2v w; w.x = cvt_pk_bf16(o[0], o[1]); w.y = cvt_pk_bf16(o[2], o[3]);
                        if (bad) { w.x = 0x7fc07fc0u; w.y = 0x7fc07fc0u; } *(u32x2v*)(xn + off + bj * HALF + n * 16) = w; }
                asm volatile("" ::: "memory"); }
    }
};

template <class Epi, class Sched, bool ALIGN_EPI = false, bool SP2 = false>
__device__ __forceinline__ void gemm_phase(PG8_LAS unsigned char* lds, const Gemm g, const Sched& S, const Epi& E, int tid_in) {
    int tid_l = tid_in; asm volatile("" : "+v"(tid_l));
    const int tid = tid_l, wid = __builtin_amdgcn_readfirstlane(tid >> 6), lane = tid & 63, wr = wid >> 2, wc = wid & 3, fr = lane & 15, fq = lane >> 4;
    int K_l = g.K; asm volatile("" : "+s"(K_l));
    const int K = K_l, nt = K / BK;
    unsigned voffA[2], voffB[2];
#pragma unroll
    for (int i = 0; i < 2; ++i) { int R, C; stage_rc(tid * 16 + i * 8192, R, C); const int Rb = Epi::PERM ? ((R & ~31) + perm32(R & 31)) : R;
        voffA[i] = (unsigned)(R * K + C) * 2u; voffB[i] = (unsigned)(Rb * K + C) * 2u; }
    const size_t kstep = (size_t)(BK * 2);
    const size_t hstep = (size_t)HALF * K * 2;
    const size_t tstep = 2 * hstep;
    const unsigned ldsw = (unsigned)wid * 1024u;
    const int aoff = lds_byte(wr * 64 + fr, fq * 8), boff = lds_byte(wc * 32 + fr, fq * 8);
#define PG8_SA(b, h) (((b) * 2 + (h)) * HTB)
#define PG8_SB(b, h) ((4 + (b) * 2 + (h)) * HTB)
#define PG8_STAGE(bufoff, gbase, voff) do { _Pragma("unroll") for (int _i = 0; _i < 2; ++_i) \
        __builtin_amdgcn_global_load_lds((const unsigned*)((const char*)(gbase) + (voff)[_i]), (PG8_LAS unsigned*)(lds + (bufoff) + ldsw + _i * 8192), 16, 0, 0); } while (0)
#define PG8_LDA(dst, b, h) do { _Pragma("unroll") for (int m = 0; m < 4; ++m) _Pragma("unroll") for (int k = 0; k < 2; ++k) dst[m][k] = *(const PG8_LAS bf16x8*)(lds + PG8_SA(b, h) + aoff + m * 2048 + k * 1024); } while (0)
#define PG8_LDB(dst, b, h) do { _Pragma("unroll") for (int n = 0; n < 2; ++n) _Pragma("unroll") for (int k = 0; k < 2; ++k) dst[n][k] = *(const PG8_LAS bf16x8*)(lds + PG8_SB(b, h) + boff + n * 2048 + k * 1024); } while (0)
#define PG8_MMA(ai, bj, At, Bt) do { __builtin_amdgcn_s_setprio(1); _Pragma("unroll") for (int m = 0; m < 4; ++m) _Pragma("unroll") for (int n = 0; n < 2; ++n) _Pragma("unroll") for (int k = 0; k < 2; ++k) \
        acc[ai][bj][m][n] = __builtin_amdgcn_mfma_f32_16x16x32_bf16(Bt[n][k], At[m][k], acc[ai][bj][m][n], 0, 0, 0); __builtin_amdgcn_s_setprio(0); } while (0)
#define PG8_WAIT_V(n) asm volatile("s_waitcnt vmcnt(" #n ")" ::: "memory")
#define PG8_WAIT_L(n) asm volatile("s_waitcnt lgkmcnt(" #n ")" ::: "memory")
#define PG8_BAR __builtin_amdgcn_s_barrier()
#define PG8_SCHED __builtin_amdgcn_sched_barrier(0)
    Unit cur, nxt; int ui = 0;
    if (!S.next(0, cur)) return;
    f32x4 acc[2][2][4][2];
#pragma unroll
    for (int a = 0; a < 2; ++a)
#pragma unroll
        for (int b = 0; b < 2; ++b)
#pragma unroll
            for (int m = 0; m < 4; ++m)
#pragma unroll
                for (int n = 0; n < 2; ++n) acc[a][b][m][n] = (f32x4){0.f, 0.f, 0.f, 0.f};
    bf16x8 At[4][2], B0[2][2], B1[2][2];
    const char* cA = (const char*)g.A + (size_t)cur.pm * tstep; const char* cB = (const char*)g.Bt + (size_t)cur.pn * tstep;
    S.a_ready(cur);
    if constexpr (SP2) {
        PG8_STAGE(PG8_SB(0, 0), cB, voffB); PG8_STAGE(PG8_SB(0, 1), cB + hstep, voffB); PG8_STAGE(PG8_SA(0, 0), cA, voffA); PG8_STAGE(PG8_SA(0, 1), cA + hstep, voffA);
        if (wr == 1) PG8_BAR;
        PG8_WAIT_V(2); PG8_BAR;
        PG8_STAGE(PG8_SB(1, 0), cB + kstep, voffB); PG8_STAGE(PG8_SA(1, 0), cA + kstep, voffA); PG8_STAGE(PG8_SB(1, 1), cB + hstep + kstep, voffB);
        PG8_WAIT_V(6); PG8_BAR;
    } else {
        PG8_STAGE(PG8_SB(0, 0), cB, voffB); PG8_STAGE(PG8_SA(0, 0), cA, voffA); PG8_STAGE(PG8_SB(0, 1), cB + hstep, voffB); PG8_STAGE(PG8_SA(0, 1), cA + hstep, voffA);
        if (wr == 1) PG8_BAR;
        PG8_WAIT_V(4); PG8_BAR;
        PG8_STAGE(PG8_SB(1, 0), cB + kstep, voffB); PG8_STAGE(PG8_SA(1, 0), cA + kstep, voffA); PG8_STAGE(PG8_SB(1, 1), cB + hstep + kstep, voffB);
        PG8_WAIT_V(6); PG8_BAR;
    }
    for (;;) {
        const bool has_next = S.next(ui + 1, nxt);
        const char* nA = has_next ? (const char*)g.A + (size_t)nxt.pm * tstep : cA; const char* nB = has_next ? (const char*)g.Bt + (size_t)nxt.pn * tstep : cB;
        for (int t = 0; t < nt; t += 2) {
            const bool last = (t == nt - 2);
            const char* a1 = cA + (size_t)(t + 1) * kstep;
            const char* a2 = last ? nA : cA + (size_t)(t + 2) * kstep; const char* b2 = last ? nB : cB + (size_t)(t + 2) * kstep;
            const char* a3 = a2 + kstep; const char* b3 = b2 + kstep;
            if (last && has_next) S.a_ready(nxt);
            if constexpr (SP2) {
            PG8_LDB(B0, 0, 0); PG8_LDB(B1, 0, 1); PG8_SCHED; PG8_LDA(At, 0, 0); PG8_STAGE(PG8_SA(1, 1), a1 + hstep, voffA);
            PG8_WAIT_V(8); PG8_WAIT_L(0); PG8_BAR; PG8_MMA(0, 0, At, B0); PG8_MMA(0, 1, At, B1); PG8_BAR; PG8_SCHED;
            PG8_LDA(At, 0, 1); PG8_STAGE(PG8_SB(0, 0), b2, voffB); PG8_STAGE(PG8_SB(0, 1), b2 + hstep, voffB); PG8_STAGE(PG8_SA(0, 0), a2, voffA);
            PG8_WAIT_V(8); PG8_WAIT_L(0); PG8_BAR; PG8_MMA(1, 0, At, B0); PG8_MMA(1, 1, At, B1); PG8_BAR; PG8_SCHED;
            PG8_LDB(B0, 1, 0); PG8_LDB(B1, 1, 1); PG8_SCHED; PG8_LDA(At, 1, 0); PG8_STAGE(PG8_SA(0, 1), a2 + hstep, voffA);
            PG8_WAIT_V(8); PG8_WAIT_L(0); PG8_BAR; PG8_MMA(0, 0, At, B0); PG8_MMA(0, 1, At, B1); PG8_BAR; PG8_SCHED;
            PG8_LDA(At, 1, 1); PG8_STAGE(PG8_SB(1, 0), b3, voffB); PG8_STAGE(PG8_SB(1, 1), b3 + hstep, voffB); PG8_STAGE(PG8_SA(1, 0), a3, voffA);
            PG8_WAIT_V(8); PG8_WAIT_L(0); PG8_BAR; PG8_MMA(1, 0, At, B0); PG8_MMA(1, 1, At, B1); PG8_BAR; PG8_SCHED;
            } else {
            PG8_LDB(B0, 0, 0); PG8_SCHED; PG8_LDA(At, 0, 0); PG8_STAGE(PG8_SA(1, 1), a1 + hstep, voffA);
            PG8_WAIT_L(8); PG8_BAR; PG8_WAIT_L(0); PG8_MMA(0, 0, At, B0); PG8_BAR; PG8_SCHED;
            PG8_LDB(B1, 0, 1); PG8_STAGE(PG8_SB(0, 0), b2, voffB);
            PG8_BAR; PG8_WAIT_L(0); PG8_MMA(0, 1, At, B1); PG8_BAR;
            PG8_LDA(At, 0, 1); PG8_STAGE(PG8_SA(0, 0), a2, voffA);
            PG8_BAR; PG8_WAIT_L(0); PG8_MMA(1, 0, At, B0); PG8_BAR; PG8_SCHED;
            PG8_STAGE(PG8_SB(0, 1), b2 + hstep, voffB);
            PG8_WAIT_V(6); PG8_BAR; PG8_MMA(1, 1, At, B1); PG8_BAR;
            PG8_LDB(B0, 1, 0); PG8_SCHED; PG8_LDA(At, 1, 0); PG8_STAGE(PG8_SA(0, 1), a2 + hstep, voffA);
            PG8_WAIT_L(8); PG8_BAR; PG8_WAIT_L(0); PG8_MMA(0, 0, At, B0); PG8_BAR; PG8_SCHED;
            PG8_LDB(B1, 1, 1); PG8_STAGE(PG8_SB(1, 0), b3, voffB);
            PG8_BAR; PG8_WAIT_L(0); PG8_MMA(0, 1, At, B1); PG8_BAR;
            PG8_LDA(At, 1, 1); PG8_STAGE(PG8_SA(1, 0), a3, voffA);
            PG8_BAR; PG8_WAIT_L(0); PG8_MMA(1, 0, At, B0); PG8_BAR; PG8_SCHED;
            PG8_STAGE(PG8_SB(1, 1), b3 + hstep, voffB);
            PG8_WAIT_V(6); PG8_BAR; PG8_MMA(1, 1, At, B1); PG8_BAR;
            }
        }
        if constexpr (ALIGN_EPI) { if (wr == 0) PG8_BAR; }
        if constexpr (!Epi::AFTER_DRAIN) { E(acc, cur, wr, wc, fr, fq); S.done(cur); }
        if (!has_next) break;
#pragma unroll
        for (int a = 0; a < 2; ++a)
#pragma unroll
            for (int b = 0; b < 2; ++b)
#pragma unroll
                for (int m = 0; m < 4; ++m)
#pragma unroll
                    for (int n = 0; n < 2; ++n) acc[a][b][m][n] = (f32x4){0.f, 0.f, 0.f, 0.f};
        cur = nxt; cA = nA; cB = nB; ++ui;
        if constexpr (ALIGN_EPI) { if (wr == 1) PG8_BAR; }
    }
    PG8_WAIT_V(0);
    if constexpr (!ALIGN_EPI) { if (wr == 0) PG8_BAR; }
    PG8_BAR;
    if constexpr (Epi::AFTER_DRAIN) { E.fused(acc, cur, wr, wc, fr, fq, lds, wid, lane); S.done(cur); }
#undef PG8_SA
#undef PG8_SB
#undef PG8_STAGE
#undef PG8_LDA
#undef PG8_LDB
#undef PG8_MMA
#undef PG8_WAIT_V
#undef PG8_WAIT_L
#undef PG8_BAR
#undef PG8_SCHED
}
}

typedef unsigned short bf16;
typedef float f32x4 __attribute__((ext_vector_type(4)));
typedef unsigned u32x4 __attribute__((ext_vector_type(4)));
typedef unsigned u32x2 __attribute__((ext_vector_type(2)));

constexpr int BATCH = 8, SEQ = 4096, T = BATCH * SEQ, D = 1024, DEPTH = 2;
constexpr int NA = 2048, NB = 3328, NIN = NA + NB, INW = 5204;
constexpr int DFF = 2816, NGU = 2 * DFF, PLE = 256, MIXW = 2048;
constexpr int A_Q = 0, A_BG = 512, A_Z = 1024;
constexpr int B_CKV = 0, B_IQ = 256, B_CG = 512, B_HB = 1024, B_XBC = 1536, B_IK = 3072, B_DT = 3136, B_IW = 3152;
constexpr int XBC = 1536, KV_R = 256, TOPK = 256;
constexpr float EPS = 1e-6f;

constexpr size_t MiB = 1u << 20;
constexpr size_t WS_CTL = 0;
constexpr size_t WS_RSTD = 1 * MiB;
constexpr size_t WS_RSTD2 = 1 * MiB + 256 * 1024;
constexpr size_t WS_DT = 2 * MiB;
constexpr size_t WS_W = 8 * MiB;
constexpr size_t WS_W_IN = WS_W, WS_W_OUT = WS_W_IN + (size_t)NIN * D * 2, WS_W_GU = WS_W_OUT + (size_t)D * MIXW * 2, WS_W_DOWN = WS_W_GU + (size_t)NGU * D * 2,
                 WS_W_PG = WS_W_DOWN + (size_t)D * DFF * 2, WS_W_PP = WS_W_PG + (size_t)D * D * 2, WS_W_END = WS_W_PP + (size_t)D * PLE * 2;
constexpr size_t WS_WUK = 42 * MiB, WS_WUV = 43 * MiB;
static_assert(WS_W_END <= 42 * MiB, "weights");
constexpr size_t WS_X0 = 44 * MiB, WS_X1 = 108 * MiB, WS_RA = 172 * MiB, WS_RB = 300 * MiB, WS_DT2 = 508 * MiB, WS_END = 512 * MiB;
constexpr size_t WS_XA = WS_X0;
constexpr size_t WS_IDX = WS_X1 + 48 * MiB;
constexpr size_t WS_CKVC = WS_X1 + 32 * MiB;
constexpr size_t WS_IKC = 4 * MiB;

__host__ __device__ __forceinline__ float bf2f(bf16 b) { return __builtin_bit_cast(float, ((unsigned)b) << 16); }
__host__ __device__ __forceinline__ bf16 f2bf(float f) { unsigned u = __builtin_bit_cast(unsigned, f); return (bf16)((u + 0x7fffu + ((u >> 16) & 1u)) >> 16); }
__device__ __forceinline__ unsigned pk2(float lo, float hi) { return (unsigned)f2bf(lo) | ((unsigned)f2bf(hi) << 16); }
__device__ __forceinline__ float wave_sum(float v) {
#pragma unroll
    for (int o = 1; o < 64; o <<= 1) v += __shfl_xor(v, o);
    return v;
}
__device__ __forceinline__ float wave_max(float v) {
#pragma unroll
    for (int o = 1; o < 64; o <<= 1) v = fmaxf(v, __shfl_xor(v, o));
    return v;
}
__device__ __forceinline__ float sigmoidf_(float v) { return __builtin_amdgcn_rcpf(1.0f + __expf(-v)); }
__device__ __forceinline__ float siluf_(float v) { return v * sigmoidf_(v); }

__host__ __device__ __forceinline__ int src_col_in(int n) {
    if (n < 512) return n;
    if (n < 1024) return 1092 + (n - 512);
    if (n < 2048) return 2628 + (n - 1024);
    n -= 2048;
    if (n < 256) return 512 + n;
    if (n < 512) return 768 + (n - 256);
    if (n < 1024) return 1604 + (n - 512);
    if (n < 1536) return 2116 + (n - 1024);
    if (n < 3072) return 3652 + (n - 1536);
    if (n < 3136) return 1024 + (n - 3072);
    if (n < 3152) return 5188 + (n - 3136);
    if (n < 3156) return 1088 + (n - 3152);
    return -1;
}

__host__ __device__ __forceinline__ int t5_bucket(int rel) {
    const int ret = rel > 0 ? 16 : 0; const int n = rel < 0 ? -rel : rel;
    int b;
    if (n < 8) b = n; else if (n < 15) b = 8; else if (n < 27) b = 9; else if (n < 50) b = 10; else if (n < 91) b = 11; else if (n < 166) b = 12; else if (n < 305) b = 13; else if (n < 559) b = 14; else b = 15;
    return ret + b;
}

template <int MODE> __global__ void __launch_bounds__(256) k_prep_w(const float* __restrict__ W, const float* __restrict__ W2, int K, int Nsrc, const float* __restrict__ gain, bf16* __restrict__ Wt) {
    __shared__ float tile[32][33];
    const int n0 = blockIdx.x * 32, k0 = blockIdx.y * 32, tx = threadIdx.x & 31, ty = threadIdx.x >> 5;
    const int n = n0 + tx; int src; const float* Ws = W;
    if (MODE == 0) src = n; else if (MODE == 1) src = src_col_in(n); else { const int which = (n & 255) >> 7; src = (n >> 8) * 128 + (n & 127); Ws = which ? W2 : W; }
    for (int kk = ty; kk < 32; kk += 8) { float v = 0.f; if (src >= 0) { v = Ws[(size_t)(k0 + kk) * Nsrc + src]; if (gain) v *= gain[k0 + kk]; } tile[kk][tx] = v; }
    __syncthreads();
    for (int nn = ty; nn < 32; nn += 8) Wt[(size_t)(n0 + nn) * K + k0 + tx] = f2bf(tile[tx][nn]);
}

__global__ void __launch_bounds__(256) k_x_prep(const float* __restrict__ x, bf16* __restrict__ xb, float* __restrict__ rstd) {
    const int lane = threadIdx.x & 63, row = blockIdx.x * 4 + (threadIdx.x >> 6);
    const f32x4* xr = (const f32x4*)(x + (size_t)row * D) + lane; float ss = 0.f; f32x4 v[4];
#pragma unroll
    for (int j = 0; j < 4; ++j) { v[j] = xr[64 * j]; ss += (v[j].x * v[j].x + v[j].y * v[j].y) + (v[j].z * v[j].z + v[j].w * v[j].w); }
    ss = wave_sum(ss);
    u32x2* o = (u32x2*)(xb + (size_t)row * D) + lane;
#pragma unroll
    for (int j = 0; j < 4; ++j) { u32x2 w; w.x = pk2(v[j].x, v[j].y); w.y = pk2(v[j].z, v[j].w); o[64 * j] = w; }
    if (lane == 0) rstd[row] = 1.0f / sqrtf(ss * (1.0f / D) + EPS);
}
__global__ void __launch_bounds__(256) k_rstd(const float* __restrict__ x, float* __restrict__ rstd) {
    const int lane = threadIdx.x & 63, row = blockIdx.x * 4 + (threadIdx.x >> 6);
    const f32x4* xr = (const f32x4*)(x + (size_t)row * D) + lane; float ss = 0.f;
#pragma unroll
    for (int j = 0; j < 4; ++j) { const f32x4 v = xr[64 * j]; ss += (v.x * v.x + v.y * v.y) + (v.z * v.z + v.w * v.w); }
    ss = wave_sum(ss);
    if (lane == 0) rstd[row] = 1.0f / sqrtf(ss * (1.0f / D) + EPS);
}
__global__ void __launch_bounds__(256) k_resid_norm(const float* xin, const float* __restrict__ y, const float* __restrict__ g, float* xo, bf16* __restrict__ xb,
                                                    float* __restrict__ rstd_out, const float* __restrict__ p, bf16* __restrict__ pb) {
    const int lane = threadIdx.x & 63, row = blockIdx.x * 4 + (threadIdx.x >> 6);
    const f32x4* yr = (const f32x4*)(y + (size_t)row * D) + lane; const f32x4* xr = (const f32x4*)(xin + (size_t)row * D) + lane; const f32x4* gr = (const f32x4*)g + lane;
    f32x4 v[4]; float ss = 0.f;
#pragma unroll
    for (int j = 0; j < 4; ++j) { v[j] = yr[64 * j]; ss += (v[j].x * v[j].x + v[j].y * v[j].y) + (v[j].z * v[j].z + v[j].w * v[j].w); }
    const float r = 1.0f / sqrtf(wave_sum(ss) * (1.0f / D) + EPS);
    float s2 = 0.f;
    f32x4* xor_ = (f32x4*)(xo + (size_t)row * D) + lane; u32x2* o = (u32x2*)(xb + (size_t)row * D) + lane;
#pragma unroll
    for (int j = 0; j < 4; ++j) { const f32x4 xx = xr[64 * j], gg = gr[64 * j]; f32x4 w = xx + v[j] * r * gg; xor_[64 * j] = w; s2 += (w.x * w.x + w.y * w.y) + (w.z * w.z + w.w * w.w);
        u32x2 q; q.x = pk2(w.x, w.y); q.y = pk2(w.z, w.w); o[64 * j] = q; }
    if (rstd_out) { s2 = wave_sum(s2); if (lane == 0) rstd_out[row] = 1.0f / sqrtf(s2 * (1.0f / D) + EPS); }
    if (p) { const f32x4 pv = *((const f32x4*)(p + (size_t)row * PLE) + lane); u32x2 q; q.x = pk2(pv.x, pv.y); q.y = pk2(pv.z, pv.w); *((u32x2*)(pb + (size_t)row * PLE) + lane) = q; }
}

namespace pg8 {
struct EpiProj {
    static constexpr bool PERM = true, AFTER_DRAIN = false;
    bf16_t* RA; bf16_t* RB; const float* rstd;
    __device__ __forceinline__ void operator()(const f32x4 (&acc)[2][2][4][2], const Unit& u, int wr, int wc, int fr, int fq) const {
        const int row0 = u.pm * BM + wr * 64 + fr; bf16_t* base; int ld, colt;
        if (u.pn < NA / 256) { base = RA; ld = NA; colt = u.pn * BM; } else { base = RB; ld = NB; colt = (u.pn - NA / 256) * BM; }
        const int col0 = colt + wc * 32 + 8 * fq;
        float sr[2][4];
#pragma unroll
        for (int ai = 0; ai < 2; ++ai)
#pragma unroll
            for (int m = 0; m < 4; ++m) sr[ai][m] = rstd[row0 + ai * HALF + m * 16];
#pragma unroll
        for (int ai = 0; ai < 2; ++ai)
#pragma unroll
            for (int m = 0; m < 4; ++m) { const int r = row0 + ai * HALF + m * 16; const float s = sr[ai][m]; bf16_t* rowp = base + (size_t)r * ld + col0;
#pragma unroll
                for (int bj = 0; bj < 2; ++bj) { const f32x4 v0 = acc[ai][bj][m][0] * s, v1 = acc[ai][bj][m][1] * s;
                    u32x4 w; w.x = cvt_pk_bf16(v0[0], v0[1]); w.y = cvt_pk_bf16(v0[2], v0[3]); w.z = cvt_pk_bf16(v1[0], v1[1]); w.w = cvt_pk_bf16(v1[2], v1[3]);
                    *(u32x4*)(rowp + bj * HALF) = w; } }
    }
};
struct EpiF32 {
    static constexpr bool PERM = false, AFTER_DRAIN = false;
    float* C; long ldc;
    __device__ __forceinline__ void operator()(const f32x4 (&acc)[2][2][4][2], const Unit& u, int wr, int wc, int fr, int fq) const {
        const int row0 = u.pm * BM + wr * 64 + fr, col0 = u.pn * BM + wc * 32 + 4 * fq;
#pragma unroll
        for (int ai = 0; ai < 2; ++ai)
#pragma unroll
            for (int m = 0; m < 4; ++m) { float* rowp = C + (size_t)(row0 + ai * HALF + m * 16) * ldc + col0;
#pragma unroll
                for (int bj = 0; bj < 2; ++bj)
#pragma unroll
                    for (int n = 0; n < 2; ++n) *(f32x4*)(rowp + bj * HALF + n * 16) = acc[ai][bj][m][n]; }
    }
};
struct EpiBf16P {
    static constexpr bool PERM = true, AFTER_DRAIN = false;
    bf16_t* O; long ldc;
    __device__ __forceinline__ void operator()(const f32x4 (&acc)[2][2][4][2], const Unit& u, int wr, int wc, int fr, int fq) const {
        const int row0 = u.pm * BM + wr * 64 + fr, col0 = u.pn * BM + wc * 32 + 8 * fq;
#pragma unroll
        for (int ai = 0; ai < 2; ++ai)
#pragma unroll
            for (int m = 0; m < 4; ++m) { bf16_t* rowp = O + (size_t)(row0 + ai * HALF + m * 16) * ldc + col0;
#pragma unroll
                for (int bj = 0; bj < 2; ++bj) { const f32x4 v0 = acc[ai][bj][m][0], v1 = acc[ai][bj][m][1];
                    u32x4 w; w.x = cvt_pk_bf16(v0[0], v0[1]); w.y = cvt_pk_bf16(v0[2], v0[3]); w.z = cvt_pk_bf16(v1[0], v1[1]); w.w = cvt_pk_bf16(v1[2], v1[3]);
                    *(u32x4*)(rowp + bj * HALF) = w; } }
    }
};
struct EpiSwiGLU {
    static constexpr bool PERM = true, AFTER_DRAIN = false;
    bf16_t* G; const float* rstd;
    __device__ __forceinline__ void operator()(const f32x4 (&acc)[2][2][4][2], const Unit& u, int wr, int wc, int fr, int fq) const {
        const int row0 = u.pm * BM + wr * 64 + fr, col0 = u.pn * HALF + wc * 32 + 8 * fq;
        float sr[2][4];
#pragma unroll
        for (int ai = 0; ai < 2; ++ai)
#pragma unroll
            for (int m = 0; m < 4; ++m) sr[ai][m] = rstd[row0 + ai * HALF + m * 16];
#pragma unroll
        for (int ai = 0; ai < 2; ++ai)
#pragma unroll
            for (int m = 0; m < 4; ++m) { const int r = row0 + ai * HALF + m * 16; const float s = sr[ai][m]; float o[8];
#pragma unroll
                for (int n = 0; n < 2; ++n)
#pragma unroll
                    for (int j = 0; j < 4; ++j) { const float gt = acc[ai][0][m][n][j] * s, up = acc[ai][1][m][n][j] * s; o[n * 4 + j] = gt * __builtin_amdgcn_rcpf(1.0f + __expf(-gt)) * up; }
                u32x4 w; w.x = cvt_pk_bf16(o[0], o[1]); w.y = cvt_pk_bf16(o[2], o[3]); w.z = cvt_pk_bf16(o[4], o[5]); w.w = cvt_pk_bf16(o[6], o[7]);
                *(u32x4*)(G + (size_t)r * DFF + col0) = w; }
    }
};
struct EpiPle {
    static constexpr bool PERM = true, AFTER_DRAIN = false;
    const bf16_t* X; const bf16_t* Tt; bf16_t* XB; float* OUT;
    __device__ __forceinline__ void operator()(const f32x4 (&acc)[2][2][4][2], const Unit& u, int wr, int wc, int fr, int fq) const {
        const int row0 = u.pm * BM + wr * 64 + fr, col0 = u.pn * BM + wc * 32 + 8 * fq;
        u32x4 tv[2][2], xv[2][2];
#define PLE_LOAD(slot, grp) do { const size_t off_ = (size_t)(row0 + ((grp) >> 2) * HALF + ((grp) & 3) * 16) * D + col0; _Pragma("unroll") for (int bj_ = 0; bj_ < 2; ++bj_) { \
            tv[slot][bj_] = *(const u32x4*)(Tt + off_ + bj_ * HALF); xv[slot][bj_] = *(const u32x4*)(X + off_ + bj_ * HALF); } } while (0)
        PLE_LOAD(0, 0);
#pragma unroll
        for (int grp = 0; grp < 8; ++grp) { const int ai = grp >> 2, m = grp & 3, sl = grp & 1; const size_t off = (size_t)(row0 + ai * HALF + m * 16) * D + col0;
            if (grp + 1 < 8) PLE_LOAD((grp + 1) & 1, grp + 1);
#pragma unroll
            for (int bj = 0; bj < 2; ++bj) { const unsigned tw[4] = {tv[sl][bj].x, tv[sl][bj].y, tv[sl][bj].z, tv[sl][bj].w}, xw[4] = {xv[sl][bj].x, xv[sl][bj].y, xv[sl][bj].z, xv[sl][bj].w}; f32x4 x0, x1;
#pragma unroll
                for (int j = 0; j < 4; ++j) { const float t0 = __builtin_bit_cast(float, (j & 1) ? (tw[j >> 1] & 0xffff0000u) : (tw[j >> 1] << 16));
                    const float t1 = __builtin_bit_cast(float, (j & 1) ? (tw[2 + (j >> 1)] & 0xffff0000u) : (tw[2 + (j >> 1)] << 16));
                    const float a0 = __builtin_bit_cast(float, (j & 1) ? (xw[j >> 1] & 0xffff0000u) : (xw[j >> 1] << 16));
                    const float a1 = __builtin_bit_cast(float, (j & 1) ? (xw[2 + (j >> 1)] & 0xffff0000u) : (xw[2 + (j >> 1)] << 16));
                    x0[j] = a0 + __builtin_amdgcn_rcpf(1.0f + __expf(-acc[ai][bj][m][0][j])) * t0; x1[j] = a1 + __builtin_amdgcn_rcpf(1.0f + __expf(-acc[ai][bj][m][1][j])) * t1; }
                if (OUT) { *(f32x4*)(OUT + off + bj * HALF) = x0; *(f32x4*)(OUT + off + bj * HALF + 4) = x1; }
                else { u32x4 w; w.x = cvt_pk_bf16(x0[0], x0[1]); w.y = cvt_pk_bf16(x0[2], x0[3]); w.z = cvt_pk_bf16(x1[0], x1[1]); w.w = cvt_pk_bf16(x1[2], x1[3]);
                    *(u32x4*)(XB + off + bj * HALF) = w; } } }
#undef PLE_LOAD
    }
};
}

__device__ __forceinline__ unsigned ord_key(float f) { const unsigned u = __builtin_bit_cast(unsigned, f); return (u & 0x80000000u) ? ~u : (u | 0x80000000u); }
#define LAS __attribute__((address_space(3)))
#define XB_TMO      128
#define XB_XCNT(j)  (256  + 64 * (j))
#define XB_XSUB(j)  (1280 + 64 * (j))
#define XB_XGEN(j)  (2304 + 64 * (j))
#define XB_TOP      3328
#define XB_TOPGEN   3392
#define XCD_BAR_WORDS 3456
#define XB_SPIN_CAP (1u << 18)

__device__ __forceinline__ unsigned xb_ld(unsigned* p)              { return __hip_atomic_load(p, __ATOMIC_RELAXED, __HIP_MEMORY_SCOPE_AGENT); }
__device__ __forceinline__ unsigned xb_add(unsigned* p, unsigned v) { return __hip_atomic_fetch_add(p, v, __ATOMIC_RELAXED, __HIP_MEMORY_SCOPE_AGENT); }
__device__ __forceinline__ unsigned xb_xcc_id() { return (unsigned)__builtin_amdgcn_s_getreg((3 << 11) | 20) & 0xFu; }
#define XB_SPIN(cond, bar) do { unsigned _sp = 0; while (cond) { __builtin_amdgcn_s_sleep(1); \
    if ((++_sp & 255u) == 0u) { if (xb_ld(&(bar)[XB_TMO])) break; if (_sp > XB_SPIN_CAP) { atomicAdd(&(bar)[XB_TMO], 1u); break; } } } } while (0)

struct XcdBarrier {
    unsigned* bar; unsigned x;
    volatile LAS unsigned* st;
};

__device__ __forceinline__ XcdBarrier xcd_barrier_post(unsigned* bar, volatile LAS unsigned* st) {
    XcdBarrier b; b.bar = bar; b.x = xb_xcc_id(); b.st = st;
    if (threadIdx.x == 0) (void)xb_add(&bar[XB_XCNT(b.x)], 1u);
    return b;
}
__device__ __forceinline__ void xcd_barrier_complete(unsigned* bar, unsigned x, unsigned& nloc, unsigned& nx) {
    const unsigned G = gridDim.x * gridDim.y * gridDim.z;
    unsigned sum, cnt, mine, sp = 0u;
    for (;;) {
        sum = 0u; cnt = 0u; mine = 0u;
#pragma unroll
        for (unsigned j = 0; j < 16; ++j) { const unsigned c = xb_ld(&bar[XB_XCNT(j)]); sum += c; cnt += (c > 0u) ? 1u : 0u; mine = (j == x) ? c : mine; }
        if (sum == G) break;
        __builtin_amdgcn_s_sleep(1);
        if ((++sp & 255u) == 0u) { if (xb_ld(&bar[XB_TMO])) break; if (sp > XB_SPIN_CAP) { atomicAdd(&bar[XB_TMO], 1u); break; } }
    }
    nloc = mine > 0u ? mine : 1u; nx = cnt > 0u ? cnt : 1u;
}

__device__ __forceinline__ void xcd_barrier(const XcdBarrier& b, int tid_in) {
    asm volatile("s_waitcnt vmcnt(0)" ::: "memory");
    __syncthreads();
    if (tid_in == 0) {
        unsigned* bar = b.bar;
        __builtin_amdgcn_s_waitcnt(0);
        unsigned nloc = b.st[0], nx = b.st[1];
        if (nloc == 0u) { xcd_barrier_complete(bar, b.x, nloc, nx); b.st[0] = nloc; b.st[1] = nx; }
        const unsigned old = xb_add(&bar[XB_XSUB(b.x)], 1u);
        const unsigned gen = old / nloc;
        if (old + 1u == (gen + 1u) * nloc) {
            __builtin_amdgcn_fence(__ATOMIC_RELEASE, "agent");
            asm volatile("s_waitcnt vmcnt(0)" ::: "memory");
            const unsigned og = xb_add(&bar[XB_TOP], 1u);
            const unsigned tg = og / nx;
            if (og + 1u == (tg + 1u) * nx) xb_add(&bar[XB_TOPGEN], 1u);
            else XB_SPIN(xb_ld(&bar[XB_TOPGEN]) == tg, bar);
            __builtin_amdgcn_fence(__ATOMIC_ACQUIRE, "agent");
            xb_add(&bar[XB_XGEN(b.x)], 1u);
            asm volatile("s_waitcnt vmcnt(0)" ::: "memory");
        } else {
            XB_SPIN(xb_ld(&bar[XB_XGEN(b.x)]) == gen, bar);
            __builtin_amdgcn_fence(__ATOMIC_ACQUIRE, "agent");
            asm volatile("s_waitcnt vmcnt(0)" ::: "memory");
        }
    }
    __syncthreads();
}


constexpr int NTHR = 512, NWAVES = 8;
constexpr int RING_BYTES = 131072, LDS_BYTES = 147456, MISC_OFF = LDS_BYTES - 512;
constexpr int CW_BAR = 4096, CW_RANK = 8192;
constexpr size_t CTL_ZERO_BYTES = 1 * MiB;
constexpr int NPH = 14;

__device__ __forceinline__ int mk_tid(int wave_s) { int l_; asm volatile("v_mbcnt_lo_u32_b32 %0, -1, 0\n\tv_mbcnt_hi_u32_b32 %0, -1, %0" : "=v"(l_)); return wave_s * 64 + l_; }
struct Params { const float* in[26]; float* out; unsigned char* ws; int ph_lo, ph_hi, dbl_mask, pad; };
static_assert(sizeof(Params) == 26 * 8 + 8 + 8 + 16, "no padding");

#define LDSP __attribute__((address_space(3)))
#define LDS_WAIT() asm volatile("s_waitcnt lgkmcnt(0)" ::: "memory")
#ifndef NAIVE_SELECT
#define NAIVE_SELECT 0
#endif
#ifndef NAIVE_ATTN
#define NAIVE_ATTN 0
#endif
#ifndef NAIVE_SSM
#define NAIVE_SSM 0
#endif
#ifndef DBG_SSM
#define DBG_SSM 0
#endif
#ifndef TIMING
#define TIMING 0
#endif
#ifndef DBL_MASK
#define DBL_MASK 0
#endif
#ifndef GEMM_DRYK
#define GEMM_DRYK 0
#endif
#ifndef CLK_PROBE
#define CLK_PROBE 0
#endif
#ifndef XTRA_BAR
#define XTRA_BAR 0
#endif
#ifndef ATT_SUB_V
#define ATT_SUB_V 0
#endif
#ifndef TIMING_SHIFT
#define TIMING_SHIFT 0.0f
#endif
#ifndef TIMING_A
#define TIMING_A 2
#endif
#ifndef TIMING_B
#define TIMING_B 3
#endif

template <int MODE> __device__ __forceinline__ void ph_prep_w(LDSP float* scr, const float* __restrict__ W, const float* __restrict__ W2, int K, int Nsrc, const float* __restrict__ gain, bf16* __restrict__ Wt, int Ndst, int gw, int NGW, int lane) {
    const int ntn = Ndst / 32, nt = ntn * (K / 64), tx = lane & 31, ty = lane >> 5;
    for (int it = gw; it < nt; it += NGW) {
        const int n0 = (it % ntn) * 32, k0 = (it / ntn) * 64, n = n0 + tx; int src; const float* Ws = W;
        if (MODE == 0) src = n; else if (MODE == 1) src = src_col_in(n); else { const int which = (n & 255) >> 7; src = (n >> 8) * 128 + (n & 127); Ws = which ? W2 : W; }
#pragma unroll 8
        for (int i = 0; i < 32; ++i) { const int kk = 2 * i + ty; float v = 0.f; if (src >= 0) { v = Ws[(size_t)(k0 + kk) * Nsrc + src]; if (gain) v *= gain[k0 + kk]; } scr[kk * 33 + tx] = v; }
        LDS_WAIT(); asm volatile("" ::: "memory");
        const int cc = lane & 7;
#pragma unroll
        for (int j = 0; j < 4; ++j) { const int nn = (lane >> 3) + 8 * j; const LDSP float* s = scr + (8 * cc) * 33 + nn;
            u32x4 o; o.x = pk2(s[0 * 33], s[1 * 33]); o.y = pk2(s[2 * 33], s[3 * 33]); o.z = pk2(s[4 * 33], s[5 * 33]); o.w = pk2(s[6 * 33], s[7 * 33]);
            *(u32x4*)(Wt + (size_t)(n0 + nn) * K + k0 + 8 * cc) = o; }
        LDS_WAIT(); asm volatile("" ::: "memory");
    }
}
__device__ __forceinline__ void row_x_prep(const float* __restrict__ x, bf16* __restrict__ xb, float* __restrict__ rstd, int row, int lane) {
    const f32x4* xr = (const f32x4*)(x + (size_t)row * D) + lane; float ss = 0.f; f32x4 v[4];
#pragma unroll
    for (int j = 0; j < 4; ++j) { v[j] = xr[64 * j]; ss += (v[j].x * v[j].x + v[j].y * v[j].y) + (v[j].z * v[j].z + v[j].w * v[j].w); }
    ss = wave_sum(ss);
    if (xb) { u32x2* o = (u32x2*)(xb + (size_t)row * D) + lane;
#pragma unroll
        for (int j = 0; j < 4; ++j) { u32x2 w; w.x = pk2(v[j].x, v[j].y); w.y = pk2(v[j].z, v[j].w); o[64 * j] = w; } }
    if (lane == 0) rstd[row] = 1.0f / sqrtf(ss * (1.0f / D) + EPS);
}
__device__ __forceinline__ void row_resid_norm(const float* xin, const float* __restrict__ y, const float* __restrict__ g, float* xo, bf16* __restrict__ xb, float* __restrict__ rstd_out, const float* __restrict__ p, bf16* __restrict__ pb, int row, int lane, bool dry = false) {
    const f32x4* yr = (const f32x4*)(y + (size_t)row * D) + lane; const f32x4* xr = (const f32x4*)(xin + (size_t)row * D) + lane; const f32x4* gr = (const f32x4*)g + lane;
    f32x4 v[4]; float ss = 0.f;
#pragma unroll
    for (int j = 0; j < 4; ++j) { v[j] = yr[64 * j]; ss += (v[j].x * v[j].x + v[j].y * v[j].y) + (v[j].z * v[j].z + v[j].w * v[j].w); }
    const float r = 1.0f / sqrtf(wave_sum(ss) * (1.0f / D) + EPS);
    float s2 = 0.f;
    f32x4* xor_ = (f32x4*)(xo + (size_t)row * D) + lane; u32x2* o = (u32x2*)(xb + (size_t)row * D) + lane;
#pragma unroll
    for (int j = 0; j < 4; ++j) { const f32x4 xx = xr[64 * j], gg = gr[64 * j]; f32x4 w = xx + v[j] * r * gg; if (!dry) xor_[64 * j] = w; s2 += (w.x * w.x + w.y * w.y) + (w.z * w.z + w.w * w.w);
        u32x2 q; q.x = pk2(w.x, w.y); q.y = pk2(w.z, w.w); o[64 * j] = q; }
    if (rstd_out) { s2 = wave_sum(s2); if (lane == 0) rstd_out[row] = 1.0f / sqrtf(s2 * (1.0f / D) + EPS); }
    if (p) { const f32x4 pv = *((const f32x4*)(p + (size_t)row * PLE) + lane); u32x2 q; q.x = pk2(pv.x, pv.y); q.y = pk2(pv.z, pv.w); *((u32x2*)(pb + (size_t)row * PLE) + lane) = q; }
}

__device__ __forceinline__ void row_resid_norm2(const bf16* xin, const bf16* __restrict__ y, const float* __restrict__ g, bf16* xo, float* __restrict__ rstd_out, const float* __restrict__ p, bf16* __restrict__ pb, int row0, int lane, bool dry = false) {
    f32x4 v[2][4], xx[2][4], pv[2]; const f32x4* gr = (const f32x4*)g + lane;
#pragma unroll
    for (int r = 0; r < 2; ++r) { const u32x2* yr = (const u32x2*)(y + (size_t)(row0 + r) * D) + lane; const u32x2* xr = (const u32x2*)(xin + (size_t)(row0 + r) * D) + lane;
#pragma unroll
        for (int j = 0; j < 4; ++j) { const u32x2 yw = yr[64 * j], xw = xr[64 * j];
            v[r][j] = (f32x4){__builtin_bit_cast(float, yw.x << 16), __builtin_bit_cast(float, yw.x & 0xffff0000u), __builtin_bit_cast(float, yw.y << 16), __builtin_bit_cast(float, yw.y & 0xffff0000u)};
            xx[r][j] = (f32x4){__builtin_bit_cast(float, xw.x << 16), __builtin_bit_cast(float, xw.x & 0xffff0000u), __builtin_bit_cast(float, xw.y << 16), __builtin_bit_cast(float, xw.y & 0xffff0000u)}; }
        if (p) pv[r] = *((const f32x4*)(p + (size_t)(row0 + r) * PLE) + lane); }
    f32x4 gg[4];
#pragma unroll
    for (int j = 0; j < 4; ++j) gg[j] = gr[64 * j];
#pragma unroll
    for (int r = 0; r < 2; ++r) { float ss = 0.f;
#pragma unroll
        for (int j = 0; j < 4; ++j) ss += (v[r][j].x * v[r][j].x + v[r][j].y * v[r][j].y) + (v[r][j].z * v[r][j].z + v[r][j].w * v[r][j].w);
        const float rr = 1.0f / sqrtf(wave_sum(ss) * (1.0f / D) + EPS); float s2 = 0.f;
        u32x2* o = (u32x2*)(xo + (size_t)(row0 + r) * D) + lane;
#pragma unroll
        for (int j = 0; j < 4; ++j) { const f32x4 w = xx[r][j] + v[r][j] * rr * gg[j]; u32x2 q; q.x = pk2(w.x, w.y); q.y = pk2(w.z, w.w); if (!dry) o[64 * j] = q;
            const float r0 = __builtin_bit_cast(float, q.x << 16), r1 = __builtin_bit_cast(float, q.x & 0xffff0000u), r2 = __builtin_bit_cast(float, q.y << 16), r3 = __builtin_bit_cast(float, q.y & 0xffff0000u);
            s2 += (r0 * r0 + r1 * r1) + (r2 * r2 + r3 * r3); }
        if (rstd_out) { s2 = wave_sum(s2); if (lane == 0) rstd_out[row0 + r] = 1.0f / sqrtf(s2 * (1.0f / D) + EPS); }
        if (p) { u32x2 q; q.x = pk2(pv[r].x, pv[r].y); q.y = pk2(pv[r].z, pv[r].w); *((u32x2*)(pb + (size_t)(row0 + r) * PLE) + lane) = q; } }
}
__device__ __forceinline__ void row_rstd_bf16(const bf16* __restrict__ xb, float* __restrict__ rstd, int row, int lane) {
    const u32x2* xr = (const u32x2*)(xb + (size_t)row * D) + lane; float ss = 0.f;
#pragma unroll
    for (int j = 0; j < 4; ++j) { const u32x2 w = xr[64 * j]; const float a = __builtin_bit_cast(float, w.x << 16), b = __builtin_bit_cast(float, w.x & 0xffff0000u), c2 = __builtin_bit_cast(float, w.y << 16), d = __builtin_bit_cast(float, w.y & 0xffff0000u); ss += (a * a + b * b) + (c2 * c2 + d * d); }
    ss = wave_sum(ss); if (lane == 0) rstd[row] = 1.0f / sqrtf(ss * (1.0f / D) + EPS);
}
__device__ __forceinline__ void wave_gnorm4(bf16* RA, const float* __restrict__ nw, int w0, int lane, bool dry = false) {
    u32x4 v[4]; float ss[4];
#pragma unroll
    for (int i = 0; i < 4; ++i) { const int w = w0 + i, t = w >> 1, g = w & 1; v[i] = *(const u32x4*)(RA + (size_t)t * NA + A_Z + g * 512 + lane * 8); }
    float f[4][8];
#pragma unroll
    for (int i = 0; i < 4; ++i) { const unsigned vw[4] = {v[i].x, v[i].y, v[i].z, v[i].w}; ss[i] = 0.f;
#pragma unroll
        for (int e = 0; e < 8; ++e) { f[i][e] = bf2f((bf16)((vw[e >> 1] >> ((e & 1) * 16)) & 0xffff)); ss[i] += f[i][e] * f[i][e]; } }
#pragma unroll
    for (int o = 1; o < 64; o <<= 1) {
#pragma unroll
        for (int i = 0; i < 4; ++i) ss[i] += __shfl_xor(ss[i], o); }
#pragma unroll
    for (int i = 0; i < 4; ++i) { const int w = w0 + i, t = w >> 1, g = w & 1; const float r = 1.0f / sqrtf(ss[i] * (1.0f / 512.0f) + EPS); const float* gw = nw + g * 512 + lane * 8;
        u32x4 o; o.x = pk2(f[i][0] * r * gw[0], f[i][1] * r * gw[1]); o.y = pk2(f[i][2] * r * gw[2], f[i][3] * r * gw[3]); o.z = pk2(f[i][4] * r * gw[4], f[i][5] * r * gw[5]); o.w = pk2(f[i][6] * r * gw[6], f[i][7] * r * gw[7]);
        if (!dry) *(u32x4*)(RA + (size_t)t * NA + A_Z + g * 512 + lane * 8) = o; }
}
__device__ __forceinline__ void tok_m1(bf16* __restrict__ RA, bf16* __restrict__ RB, bf16* __restrict__ CKVC, bf16* __restrict__ IKC, const float* __restrict__ kvn, const float* __restrict__ ikg, const float* __restrict__ ikb, const float* __restrict__ scw, int t, int lane) {
    const int s = t & (SEQ - 1); bf16* rb = RB + (size_t)t * NB;
    {   const u32x2 w = *((const u32x2*)(rb + B_CKV) + lane); float v[4] = {bf2f((bf16)(w.x & 0xffff)), bf2f((bf16)(w.x >> 16)), bf2f((bf16)(w.y & 0xffff)), bf2f((bf16)(w.y >> 16))};
        float ss = (v[0] * v[0] + v[1] * v[1]) + (v[2] * v[2] + v[3] * v[3]); ss = wave_sum(ss); const float r = 1.0f / sqrtf(ss * (1.0f / KV_R) + EPS);
        const f32x4 g = *((const f32x4*)kvn + lane); u32x2 o; o.x = pk2(v[0] * r * g.x, v[1] * r * g.y); o.y = pk2(v[2] * r * g.z, v[3] * r * g.w); *((u32x2*)(rb + B_CKV) + lane) = o; *((u32x2*)(CKVC + (size_t)t * KV_R) + lane) = o; }
    {   const float x = bf2f(rb[B_IK + lane]); const float mu = wave_sum(x) * (1.0f / 64.0f); const float d = x - mu; const float var = wave_sum(d * d) * (1.0f / 64.0f);
        const bf16 o = f2bf(d * (1.0f / sqrtf(var + EPS)) * ikg[lane] + ikb[lane]); rb[B_IK + lane] = o; IKC[(size_t)t * 64 + lane] = o; }
    {   const int c = lane * 8; float acc[8] = {0.f, 0.f, 0.f, 0.f, 0.f, 0.f, 0.f, 0.f};
        for (int j = 0; j < 3; ++j) { const int ss_ = s - 2 + j; if (ss_ < 0) continue; const bf16* rr = RB + (size_t)(t - 2 + j) * NB;
            const u32x4 cg = *(const u32x4*)(rr + B_CG + c), hb = *(const u32x4*)(rr + B_HB + c); const unsigned cw[4] = {cg.x, cg.y, cg.z, cg.w}, hw[4] = {hb.x, hb.y, hb.z, hb.w};
#pragma unroll
            for (int e = 0; e < 8; ++e) { const float a = bf2f((bf16)((cw[e >> 1] >> ((e & 1) * 16)) & 0xffff)), b = bf2f((bf16)((hw[e >> 1] >> ((e & 1) * 16)) & 0xffff)); acc[e] += scw[j * 512 + c + e] * (a * b); } }
        bf16* ra = RA + (size_t)t * NA + A_BG + c; const u32x4 bg = *(const u32x4*)ra; const unsigned bw[4] = {bg.x, bg.y, bg.z, bg.w}; float o[8];
#pragma unroll
        for (int e = 0; e < 8; ++e) o[e] = bf2f((bf16)((bw[e >> 1] >> ((e & 1) * 16)) & 0xffff)) * acc[e];
        u32x4 w; w.x = pk2(o[0], o[1]); w.y = pk2(o[2], o[3]); w.z = pk2(o[4], o[5]); w.w = pk2(o[6], o[7]); *(u32x4*)ra = w; }
}
__device__ __forceinline__ void tok_m4a(const bf16* __restrict__ RB, const float* __restrict__ cw, const float* __restrict__ cb, const float* __restrict__ dtb, bf16* __restrict__ XA, float* __restrict__ DT, int t, int lane) {
    const int s = t & (SEQ - 1);
    for (int c = lane; c < XBC; c += 64) { float a = cb[c];
#pragma unroll
        for (int j = 0; j < 4; ++j) { const int ss = s - 3 + j; if (ss >= 0) a += cw[j * XBC + c] * bf2f(RB[(size_t)(t - 3 + j) * NB + B_XBC + c]); }
        XA[(size_t)t * XBC + c] = f2bf(siluf_(a)); }
    if (lane < 16) { const float x = bf2f(RB[(size_t)t * NB + B_DT + lane]) + dtb[lane]; DT[(size_t)t * 16 + lane] = x > 15.f ? x : log1pf(__expf(x)); }
}
__device__ __forceinline__ void wg_m2_select(LDSP unsigned char* lds, const bf16* __restrict__ RB, unsigned short* __restrict__ idx, int t, int tid) {
    LDSP float* iq = (LDSP float*)lds; LDSP float* iwv = iq + 256; LDSP unsigned* red = (LDSP unsigned*)(iq + 272); LDSP unsigned* keys = (LDSP unsigned*)(iq + 288);
    const int s = t & (SEQ - 1), b = t >> 12, lane = tid & 63, wv = tid >> 6;
    const int nk = ((s >> 6) + 1) << 6;
    const bf16* rb = RB + (size_t)t * NB;
    if (tid < 256) iq[tid] = bf2f(rb[B_IQ + tid]); if (tid < 4) iwv[tid] = bf2f(rb[B_IW + tid]) * (0.125f * 0.5f);
    __syncthreads();
    for (int k = tid; k < nk; k += NTHR) {
        const bf16* kr = RB + (size_t)(b * SEQ + k) * NB + B_IK; float sc = 0.f;
        float d0 = 0.f, d1 = 0.f, d2 = 0.f, d3 = 0.f;
#pragma unroll 1
        for (int j = 0; j < 8; ++j) { const u32x4 w = *((const u32x4*)kr + j); const unsigned ww[4] = {w.x, w.y, w.z, w.w};
#pragma unroll
            for (int e = 0; e < 8; ++e) { const float kv = bf2f((bf16)((ww[e >> 1] >> ((e & 1) * 16)) & 0xffff)); const int c = j * 8 + e;
                d0 += iq[c] * kv; d1 += iq[64 + c] * kv; d2 += iq[128 + c] * kv; d3 += iq[192 + c] * kv; } }
        sc += fmaxf(d0, 0.f) * iwv[0]; sc += fmaxf(d1, 0.f) * iwv[1]; sc += fmaxf(d2, 0.f) * iwv[2]; sc += fmaxf(d3, 0.f) * iwv[3];
        keys[k] = ord_key(sc);
    }
    __syncthreads();
    unsigned Tt = 0u;
    if (nk > TOPK) {
        for (int bit = 31; bit >= 0; --bit) { const unsigned cand = Tt | (1u << bit); unsigned c = 0;
            for (int k = tid; k < nk; k += NTHR) c += (keys[k] >= cand) ? 1u : 0u;
#pragma unroll
            for (int o = 1; o < 64; o <<= 1) c += __shfl_xor(c, o);
            if (lane == 0) red[wv] = c;
            __syncthreads();
            unsigned tot = 0;
#pragma unroll
            for (int w = 0; w < 8; ++w) tot += red[w];
            if (tot >= (unsigned)TOPK) Tt = cand;
            __syncthreads(); }
    }
    { unsigned c = 0; for (int k = tid; k < nk; k += NTHR) c += (keys[k] > Tt) ? 1u : 0u;
#pragma unroll
      for (int o = 1; o < 64; o <<= 1) c += __shfl_xor(c, o);
      if (lane == 0) red[8 + wv] = c; }
    __syncthreads();
    if (wv == 0) {
        int ngt = 0;
#pragma unroll
        for (int w = 0; w < 8; ++w) ngt += (int)red[8 + w];
        const int need = TOPK - ngt; int pos = 0, eq_taken = 0; const unsigned long long lt = (1ull << lane) - 1ull;
        for (int base = 0; base < nk; base += 64) { const unsigned k = keys[base + lane]; const bool gt = k > Tt, eq = (k == Tt);
            const unsigned long long meq = __ballot(eq); const int rank_eq = __popcll(meq & lt); const bool take = gt || (eq && (eq_taken + rank_eq < need));
            const unsigned long long msel = __ballot(take);
            if (take) { const int o = pos + __popcll(msel & lt); if (o < TOPK) idx[(size_t)t * TOPK + o] = (unsigned short)(base + lane); }
            pos += __popcll(msel); eq_taken += __popcll(__ballot(eq && take)); }
    }
    __syncthreads();
}
__device__ __forceinline__ void wg_m3_attn(LDSP unsigned char* lds, bf16* RA, const bf16* __restrict__ RB, const unsigned short* __restrict__ idx, const float* __restrict__ w_uk, const float* __restrict__ w_uv, const float* __restrict__ rel_bias, int t, int tid) {
    LDSP float* q = (LDSP float*)lds; LDSP float* qlat = q + 512; LDSP float* pr = qlat + 2048; LDSP float* outl = pr + 2048; LDSP unsigned short* sel = (LDSP unsigned short*)(outl + 2048);
    const int s = t & (SEQ - 1), b = t >> 12, lane = tid & 63, wv = tid >> 6;
    const int nk = ((s >> 6) + 1) << 6, nsel = nk < TOPK ? nk : TOPK;
    q[tid] = bf2f(RA[(size_t)t * NA + A_Q + tid]); if (tid < 256) sel[tid] = tid < nsel ? idx[(size_t)t * TOPK + tid] : (unsigned short)0;
    __syncthreads();
    {   const int r = tid & 255, h0 = (tid >> 8) * 4;
        for (int h = h0; h < h0 + 4; ++h) { const float* w = w_uk + ((size_t)r * 8 + h) * 64; float a = 0.f;
#pragma unroll 16
            for (int d = 0; d < 64; ++d) a += q[h * 64 + d] * w[d];
            qlat[h * 256 + r] = a * 0.125f; } }
    __syncthreads();
    {   const int k = tid & 255, h0 = (tid >> 8) * 4;
        if (k < nsel) { const int key = sel[k]; const bf16* kr = RB + (size_t)(b * SEQ + key) * NB + B_CKV; float a[4] = {0.f, 0.f, 0.f, 0.f};
            for (int j = 0; j < 32; ++j) { const u32x4 w = *((const u32x4*)kr + j); const unsigned ww[4] = {w.x, w.y, w.z, w.w};
#pragma unroll
                for (int e = 0; e < 8; ++e) { const float v = bf2f((bf16)((ww[e >> 1] >> ((e & 1) * 16)) & 0xffff));
#pragma unroll
                    for (int hh = 0; hh < 4; ++hh) a[hh] += qlat[(h0 + hh) * 256 + j * 8 + e] * v; } }
            const int bk = t5_bucket(key - s);
#pragma unroll
            for (int hh = 0; hh < 4; ++hh) pr[(h0 + hh) * 256 + k] = a[hh] + rel_bias[bk * 8 + h0 + hh];
        } else {
#pragma unroll
            for (int hh = 0; hh < 4; ++hh) pr[(h0 + hh) * 256 + k] = -INFINITY; } }
    __syncthreads();
    {   float v[4]; float m = -INFINITY;
#pragma unroll
        for (int j = 0; j < 4; ++j) { v[j] = pr[wv * 256 + lane + 64 * j]; m = fmaxf(m, v[j]); }
        m = wave_max(m); float sum = 0.f;
#pragma unroll
        for (int j = 0; j < 4; ++j) { v[j] = __expf(v[j] - m); sum += v[j]; }
        sum = wave_sum(sum); const float inv = 1.0f / sum;
#pragma unroll
        for (int j = 0; j < 4; ++j) pr[wv * 256 + lane + 64 * j] = v[j] * inv; }
    __syncthreads();
    {   const int r = tid & 255, h0 = (tid >> 8) * 4; float a[4] = {0.f, 0.f, 0.f, 0.f};
        for (int k = 0; k < nsel; ++k) { const float v = bf2f(RB[(size_t)(b * SEQ + sel[k]) * NB + B_CKV + r]);
#pragma unroll
            for (int hh = 0; hh < 4; ++hh) a[hh] += pr[(h0 + hh) * 256 + k] * v; }
#pragma unroll
        for (int hh = 0; hh < 4; ++hh) outl[(h0 + hh) * 256 + r] = a[hh]; }
    __syncthreads();
    {   const int h = tid >> 6, d = tid & 63; float a = 0.f;
        for (int r = 0; r < 256; ++r) a += outl[h * 256 + r] * w_uv[((size_t)r * 8 + h) * 64 + d];
        RA[(size_t)t * NA + A_Q + tid] = f2bf(a); }
    __syncthreads();
}
__device__ __forceinline__ void half_m4b_scan(bf16* RA, const bf16* __restrict__ XA, const float* __restrict__ DT, const float* __restrict__ a_log, const float* __restrict__ dsk, int b, int h, int tid) {
    const int g = h >> 3, p = tid >> 2, nq = tid & 3;
    const float A = -__expf(a_log[h]), Dh = dsk[h];
    float hs[32];
#pragma unroll
    for (int n = 0; n < 32; ++n) hs[n] = 0.f;
    for (int s = 0; s < SEQ; ++s) { const size_t t = (size_t)b * SEQ + s; const float dt = DT[t * 16 + h]; const float dA = __expf(dt * A);
        const bf16* xr = XA + t * XBC; const float x = bf2f(xr[h * 64 + p]); const float dx = dt * x;
        const u32x4* Bp = (const u32x4*)(xr + 1024 + g * 128 + nq * 32); const u32x4* Cp = (const u32x4*)(xr + 1280 + g * 128 + nq * 32); float y = 0.f;
#pragma unroll
        for (int j = 0; j < 4; ++j) { const u32x4 bw = Bp[j], cw = Cp[j]; const unsigned bb[4] = {bw.x, bw.y, bw.z, bw.w}, cc[4] = {cw.x, cw.y, cw.z, cw.w};
#pragma unroll
            for (int e = 0; e < 8; ++e) { const float Bv = bf2f((bf16)((bb[e >> 1] >> ((e & 1) * 16)) & 0xffff)), Cv = bf2f((bf16)((cc[e >> 1] >> ((e & 1) * 16)) & 0xffff));
                hs[j * 8 + e] = hs[j * 8 + e] * dA + dx * Bv; y += Cv * hs[j * 8 + e]; } }
        y += __shfl_xor(y, 1); y += __shfl_xor(y, 2);
        if (nq == 0) { bf16* zp = RA + t * NA + A_Z + h * 64 + p; const float z = bf2f(*zp); *zp = f2bf((y + Dh * x) * siluf_(z)); }
    }
}
__device__ __forceinline__ void wave_m4c_gnorm(bf16* RA, const float* __restrict__ nw, int w, int lane, bool dry = false) {
    const int t = w >> 1, g = w & 1;
    bf16* p = RA + (size_t)t * NA + A_Z + g * 512 + lane * 8; const u32x4 v = *(const u32x4*)p; const unsigned vw[4] = {v.x, v.y, v.z, v.w}; float f[8]; float ss = 0.f;
#pragma unroll
    for (int e = 0; e < 8; ++e) { f[e] = bf2f((bf16)((vw[e >> 1] >> ((e & 1) * 16)) & 0xffff)); ss += f[e] * f[e]; }
    const float r = 1.0f / sqrtf(wave_sum(ss) * (1.0f / 512.0f) + EPS); const float* gw = nw + g * 512 + lane * 8;
    u32x4 o; o.x = pk2(f[0] * r * gw[0], f[1] * r * gw[1]); o.y = pk2(f[2] * r * gw[2], f[3] * r * gw[3]); o.z = pk2(f[4] * r * gw[4], f[5] * r * gw[5]); o.w = pk2(f[6] * r * gw[6], f[7] * r * gw[7]);
    if (!dry) *(u32x4*)p = o;
}

__device__ __forceinline__ void unpack8(const u32x4 w, float (&f)[8]) { const unsigned ww[4] = {w.x, w.y, w.z, w.w};
#pragma unroll
    for (int e = 0; e < 4; ++e) { f[2 * e] = __builtin_bit_cast(float, ww[e] << 16); f[2 * e + 1] = __builtin_bit_cast(float, ww[e] & 0xffff0000u); } }
__device__ __forceinline__ void prep_ckv4(const bf16* __restrict__ RB, bf16* __restrict__ CKVC, const float* __restrict__ kvn, int it, int lane) {
    const int t = it * 4 + (lane >> 4), c = lane & 15; const u32x4* src = (const u32x4*)(RB + (size_t)t * NB + B_CKV + c * 16); const u32x4 a = src[0], b = src[1];
    float v[16]; { float f[8]; unpack8(a, f);
#pragma unroll
        for (int e = 0; e < 8; ++e) v[e] = f[e]; unpack8(b, f);
#pragma unroll
        for (int e = 0; e < 8; ++e) v[8 + e] = f[e]; }
    float ss = 0.f;
#pragma unroll
    for (int e = 0; e < 16; ++e) ss += v[e] * v[e];
    ss += __shfl_xor(ss, 1); ss += __shfl_xor(ss, 2); ss += __shfl_xor(ss, 4); ss += __shfl_xor(ss, 8);
    const float r = 1.0f / sqrtf(ss * (1.0f / KV_R) + EPS); const f32x4* gp = (const f32x4*)(kvn + c * 16); float o[16];
#pragma unroll
    for (int q = 0; q < 4; ++q) { const f32x4 gg = gp[q]; o[4 * q] = v[4 * q] * r * gg.x; o[4 * q + 1] = v[4 * q + 1] * r * gg.y; o[4 * q + 2] = v[4 * q + 2] * r * gg.z; o[4 * q + 3] = v[4 * q + 3] * r * gg.w; }
    u32x4 w0, w1; w0.x = pk2(o[0], o[1]); w0.y = pk2(o[2], o[3]); w0.z = pk2(o[4], o[5]); w0.w = pk2(o[6], o[7]); w1.x = pk2(o[8], o[9]); w1.y = pk2(o[10], o[11]); w1.z = pk2(o[12], o[13]); w1.w = pk2(o[14], o[15]);
    u32x4* dst = (u32x4*)(CKVC + (size_t)t * KV_R + c * 16); dst[0] = w0; dst[1] = w1;
}
__device__ __forceinline__ void prep_ik16(const bf16* __restrict__ RB, bf16* __restrict__ IKC, const float* __restrict__ ikg, const float* __restrict__ ikb, int it, int lane) {
    const int t = it * 16 + (lane >> 2), c = lane & 3; const u32x4* src = (const u32x4*)(RB + (size_t)t * NB + B_IK + c * 16); const u32x4 a = src[0], b = src[1];
    float v[16]; { float f[8]; unpack8(a, f);
#pragma unroll
        for (int e = 0; e < 8; ++e) v[e] = f[e]; unpack8(b, f);
#pragma unroll
        for (int e = 0; e < 8; ++e) v[8 + e] = f[e]; }
    float s = 0.f;
#pragma unroll
    for (int e = 0; e < 16; ++e) s += v[e];
    s += __shfl_xor(s, 1); s += __shfl_xor(s, 2); const float mu = s * (1.0f / 64.0f); float q2 = 0.f;
#pragma unroll
    for (int e = 0; e < 16; ++e) { v[e] -= mu; q2 += v[e] * v[e]; }
    q2 += __shfl_xor(q2, 1); q2 += __shfl_xor(q2, 2); const float r = 1.0f / sqrtf(q2 * (1.0f / 64.0f) + EPS); float o[16];
#pragma unroll
    for (int e = 0; e < 16; ++e) o[e] = v[e] * r * ikg[c * 16 + e] + ikb[c * 16 + e];
    u32x4 w0, w1; w0.x = pk2(o[0], o[1]); w0.y = pk2(o[2], o[3]); w0.z = pk2(o[4], o[5]); w0.w = pk2(o[6], o[7]); w1.x = pk2(o[8], o[9]); w1.y = pk2(o[10], o[11]); w1.z = pk2(o[12], o[13]); w1.w = pk2(o[14], o[15]);
    u32x4* dst = (u32x4*)(IKC + (size_t)t * 64 + c * 16); dst[0] = w0; dst[1] = w1;
}
__device__ __forceinline__ void prep_bout(bf16* RA, const bf16* __restrict__ RB, const float* __restrict__ scw, int t, int lane, bool dry = false) {
    const int s = t & (SEQ - 1), c = lane * 8; float acc[8] = {0.f, 0.f, 0.f, 0.f, 0.f, 0.f, 0.f, 0.f};
    u32x4 cg[3], hb[3];
#pragma unroll
    for (int j = 0; j < 3; ++j) { const bool ok = (s - 2 + j) >= 0; const bf16* rr = RB + (size_t)(t - 2 + j) * NB; cg[j] = ok ? *(const u32x4*)(rr + B_CG + c) : (u32x4){0u, 0u, 0u, 0u}; hb[j] = ok ? *(const u32x4*)(rr + B_HB + c) : (u32x4){0u, 0u, 0u, 0u}; }
    bf16* ra = RA + (size_t)t * NA + A_BG + c; const u32x4 bg = *(const u32x4*)ra;
#pragma unroll
    for (int j = 0; j < 3; ++j) { float a[8], b[8]; unpack8(cg[j], a); unpack8(hb[j], b); const f32x4 w0 = *(const f32x4*)(scw + j * 512 + c), w1 = *(const f32x4*)(scw + j * 512 + c + 4);
        acc[0] += w0.x * (a[0] * b[0]); acc[1] += w0.y * (a[1] * b[1]); acc[2] += w0.z * (a[2] * b[2]); acc[3] += w0.w * (a[3] * b[3]);
        acc[4] += w1.x * (a[4] * b[4]); acc[5] += w1.y * (a[5] * b[5]); acc[6] += w1.z * (a[6] * b[6]); acc[7] += w1.w * (a[7] * b[7]); }
    float g8[8]; unpack8(bg, g8); u32x4 w; w.x = pk2(g8[0] * acc[0], g8[1] * acc[1]); w.y = pk2(g8[2] * acc[2], g8[3] * acc[3]); w.z = pk2(g8[4] * acc[4], g8[5] * acc[5]); w.w = pk2(g8[6] * acc[6], g8[7] * acc[7]);
    if (!dry) *(u32x4*)ra = w;
}
__device__ __forceinline__ void prep_conv(const bf16* __restrict__ RB, bf16* __restrict__ XA, const float* __restrict__ cw, const float* __restrict__ cb, int it, int lane) {
    const int rb = it / 12, cbk = it % 12, xcol = cbk * 128 + 2 * lane, t0 = rb * 16, s0 = t0 & (SEQ - 1);
    float w0[4], w1[4];
#pragma unroll
    for (int j = 0; j < 4; ++j) { w0[j] = cw[j * XBC + xcol]; w1[j] = cw[j * XBC + xcol + 1]; }
    const float cb0 = cb[xcol], cb1 = cb[xcol + 1];
    const bf16* src = RB + (size_t)(t0 - 3) * NB + B_XBC + xcol; unsigned raw[19];
#pragma unroll
    for (int i = 0; i < 19; ++i) raw[i] = (s0 - 3 + i >= 0) ? *(const unsigned*)(src + (size_t)i * NB) : 0u;
#pragma unroll
    for (int i = 0; i < 16; ++i) { float a0 = cb0, a1 = cb1;
#pragma unroll
        for (int j = 0; j < 4; ++j) { a0 += w0[j] * __builtin_bit_cast(float, raw[i + j] << 16); a1 += w1[j] * __builtin_bit_cast(float, raw[i + j] & 0xffff0000u); }
        *(unsigned*)(XA + (size_t)(t0 + i) * XBC + xcol) = pk2(siluf_(a0), siluf_(a1)); }
}

typedef short bf16x8_t __attribute__((ext_vector_type(8)));
#ifndef SEL_REP_SEARCH
#define SEL_REP_SEARCH 1
#endif
#ifndef SEL_REP_STAGE
#define SEL_REP_STAGE 1
#endif
constexpr int SC_STRIDE = 516, SC_BUF = 16 * SC_STRIDE;
constexpr int IKW_OFF = 66560;
__device__ __forceinline__ void wg_select16(LDSP unsigned char* lds, const bf16* __restrict__ RB, const bf16* __restrict__ IKC, unsigned short* __restrict__ idx, int unit, int tid, bool dry = false, bool lds_out = false) {
    const int lane = tid & 63, wave = __builtin_amdgcn_readfirstlane(tid >> 6), g = lane >> 4, c = lane & 15;
    const int b = unit >> 8, qg = unit & 255, t0 = b * SEQ + qg * 16, nk = ((qg >> 2) + 1) << 6, nr = nk >> 6;
    LDSP unsigned* SC = (LDSP unsigned*)lds;
    bf16x8_t bq[4][2]; float iwq[4];
    { const bf16* qr = RB + (size_t)(t0 + c) * NB;
#pragma unroll
      for (int h = 0; h < 4; ++h) { bq[h][0] = *(const bf16x8_t*)(qr + B_IQ + h * 64 + g * 8); bq[h][1] = *(const bf16x8_t*)(qr + B_IQ + h * 64 + 32 + g * 8); iwq[h] = bf2f(qr[B_IW + h]) * 0.0625f; } }
    unsigned val[2][64];
#pragma unroll
    for (int r = 0; r < 64; ++r) { val[0][r] = 0u; val[1][r] = 0u; }
    const bf16* ikb = IKC + (size_t)b * SEQ * 64;
    LDSP unsigned char* ikw = lds + IKW_OFF + wave * 8192;
#define IK_DMA(stage) do { if ((stage) * 512 + wave * 64 < nk) { const bf16* src_ = ikb + (size_t)((stage) * 512 + wave * 64) * 64 + lane * 8; _Pragma("unroll") for (int pc_ = 0; pc_ < 8; ++pc_) \
        __builtin_amdgcn_global_load_lds((const unsigned*)(src_ + pc_ * 512), (LDSP unsigned*)(ikw + pc_ * 1024), 16, 0, 0); } } while (0)
    IK_DMA(0);
    for (int rep_st = 0; rep_st < SEL_REP_STAGE; ++rep_st) {
    if (rep_st > 0) { asm volatile("s_waitcnt vmcnt(0)" ::: "memory"); __builtin_amdgcn_s_barrier(); IK_DMA(0); }
#pragma unroll
    for (int s = 0; s < 8; ++s) {
        if (s * 512 < nk) {
            LDSP unsigned* buf = SC + (s & 1) * SC_BUF;
            asm volatile("s_waitcnt vmcnt(0)" ::: "memory");
            bf16x8_t af[4][2];
#pragma unroll
            for (int i = 0; i < 4; ++i) { af[i][0] = *(const LDSP bf16x8_t*)(ikw + (16 * i + c) * 128 + g * 16); af[i][1] = *(const LDSP bf16x8_t*)(ikw + (16 * i + c) * 128 + 64 + g * 16); }
            asm volatile("s_waitcnt lgkmcnt(0)" ::: "memory");
            if (s < 7) IK_DMA(s + 1);
#pragma unroll
            for (int i = 0; i < 4; ++i) { const int tl = wave * 4 + i, kb = s * 512 + tl * 16;
                if (kb < nk) {
                    const bf16x8_t a0 = af[i][0], a1 = af[i][1];
                    float sc[4] = {0.f, 0.f, 0.f, 0.f};
#pragma unroll
                    for (int h = 0; h < 4; ++h) { pg8::f32x4 acc = {0.f, 0.f, 0.f, 0.f};
                        acc = __builtin_amdgcn_mfma_f32_16x16x32_bf16(a0, bq[h][0], acc, 0, 0, 0); acc = __builtin_amdgcn_mfma_f32_16x16x32_bf16(a1, bq[h][1], acc, 0, 0, 0);
#pragma unroll
                        for (int e = 0; e < 4; ++e) sc[e] += fmaxf(acc[e], 0.f) * iwq[h]; }
                    u32x4 kv; kv.x = ord_key(sc[0]); kv.y = ord_key(sc[1]); kv.z = ord_key(sc[2]); kv.w = ord_key(sc[3]);
                    *(LDSP u32x4*)(buf + c * SC_STRIDE + tl * 16 + 4 * g) = kv; } }
            asm volatile("s_waitcnt lgkmcnt(0)" ::: "memory"); __builtin_amdgcn_s_barrier(); asm volatile("" ::: "memory");
#pragma unroll
            for (int j = 0; j < 8; ++j) if (s * 512 + j * 64 < nk) { val[0][s * 8 + j] = buf[(2 * wave) * SC_STRIDE + j * 64 + lane]; val[1][s * 8 + j] = buf[(2 * wave + 1) * SC_STRIDE + j * 64 + lane]; }
            asm volatile("s_waitcnt lgkmcnt(0)" ::: "memory");
        }
    }
    }
    const unsigned long long lt = (1ull << lane) - 1ull;
#pragma unroll
    for (int qq = 0; qq < 2; ++qq) {
        unsigned Tt = 0u;
        for (int rep_se = 0; rep_se < SEL_REP_SEARCH; ++rep_se) { Tt = 0u; asm volatile("" : "+v"(val[qq][0]));
        if (nk > TOPK) {
            for (int bit = 31; bit >= 0; --bit) { const unsigned cand = Tt | (1u << bit); int cnt = 0;
#pragma unroll
                for (int r8 = 0; r8 < 8; ++r8) if (r8 * 8 < nr) {
#pragma unroll
                    for (int r = r8 * 8; r < r8 * 8 + 8; ++r) cnt += __popcll(__ballot(val[qq][r] >= cand)); }
                if (cnt >= TOPK) Tt = cand; if (cnt == TOPK) break; }
        }
        }
        int ngt = 0;
#pragma unroll
        for (int r8 = 0; r8 < 8; ++r8) if (r8 * 8 < nr) {
#pragma unroll
            for (int r = r8 * 8; r < r8 * 8 + 8; ++r) ngt += __popcll(__ballot(val[qq][r] > Tt)); }
        const int need = TOPK - ngt; int pos = 0, eq_taken = 0;
        unsigned short* orow = idx + (size_t)(t0 + 2 * wave + qq) * TOPK;
        LDSP unsigned short* orow_l = (LDSP unsigned short*)(lds + 134 * 1024) + (2 * wave + qq) * TOPK;
#pragma unroll
        for (int r = 0; r < 64; ++r) if (r < nr) { const unsigned k = val[qq][r]; const bool gt = k > Tt, eq = (k == Tt);
            const unsigned long long meq = __ballot(eq); const int rank_eq = __popcll(meq & lt); const bool take = gt || (eq && (eq_taken + rank_eq < need));
            const unsigned long long msel = __ballot(take);
            if (take) { const int o = pos + __popcll(msel & lt); if (o < TOPK && !dry) { if (lds_out) orow_l[o] = (unsigned short)(r * 64 + lane); else orow[o] = (unsigned short)(r * 64 + lane); } }
            pos += __popcll(msel); eq_taken += __popcll(__ballot(eq && take)); }
    }
    asm volatile("s_waitcnt vmcnt(0)" ::: "memory"); __builtin_amdgcn_s_barrier();
#undef IK_DMA
}

typedef unsigned short u16x4_t __attribute__((ext_vector_type(4)));
#ifndef ATT_LOCAL_DRY
#define ATT_LOCAL_DRY 0
#endif
#ifndef ATT_STAGGER
#define ATT_STAGGER 0
#endif
#ifndef ATT_DRY_SKIP
#define ATT_DRY_SKIP 0
#endif
#define DSK(b) (ATT_DRY_SKIP & (b)) && dry
#ifndef ATT_SUB_EN
#define ATT_SUB_EN 0
#endif
constexpr int SELW_OFF = 134 * 1024, BT_OFF = 142 * 1024, KVP = 528, TILE_STRIDE = 32 * KVP;
constexpr int SELW_OFF_OLD = 132 * 1024, BT_OFF_OLD = 140 * 1024;
__device__ __forceinline__ int kv_off(int row, int ch) { const int hf = ch >> 4, c16 = ch & 15; return hf * 8192 + 256 * row + 16 * (c16 ^ (((row & 3) << 2) | ((row >> 2) & 3))); }
#define TR4I(d0, d1, d2, d3, base, o0, o1, o2, o3) asm volatile("ds_read_b64_tr_b16 %0, %4 offset:%5\n\tds_read_b64_tr_b16 %1, %4 offset:%6\n\tds_read_b64_tr_b16 %2, %4 offset:%7\n\tds_read_b64_tr_b16 %3, %4 offset:%8" \
    : "=&v"(d0), "=&v"(d1), "=&v"(d2), "=&v"(d3) : "v"(base), "i"(o0), "i"(o1), "i"(o2), "i"(o3) : "memory")
#define TR8N(d0, d1, d2, d3, d4, d5, d6, d7, base, o0, o1, o2, o3, o4, o5, o6, o7) asm volatile( \
    "ds_read_b64_tr_b16 %0, %8 offset:%9\n\tds_read_b64_tr_b16 %1, %8 offset:%10\n\tds_read_b64_tr_b16 %2, %8 offset:%11\n\tds_read_b64_tr_b16 %3, %8 offset:%12\n\t" \
    "ds_read_b64_tr_b16 %4, %8 offset:%13\n\tds_read_b64_tr_b16 %5, %8 offset:%14\n\tds_read_b64_tr_b16 %6, %8 offset:%15\n\tds_read_b64_tr_b16 %7, %8 offset:%16" \
    : "=&v"(d0), "=&v"(d1), "=&v"(d2), "=&v"(d3), "=&v"(d4), "=&v"(d5), "=&v"(d6), "=&v"(d7) : "v"(base), "i"(o0), "i"(o1), "i"(o2), "i"(o3), "i"(o4), "i"(o5), "i"(o6), "i"(o7) : "memory")
#define WAITPIN8(n, d0, d1, d2, d3, d4, d5, d6, d7) asm volatile("s_waitcnt lgkmcnt(" #n ")" : "+v"(d0), "+v"(d1), "+v"(d2), "+v"(d3), "+v"(d4), "+v"(d5), "+v"(d6), "+v"(d7) :: "memory")
#define WAITPIN4(n, d0, d1, d2, d3) asm volatile("s_waitcnt lgkmcnt(" #n ")" : "+v"(d0), "+v"(d1), "+v"(d2), "+v"(d3) :: "memory")
__device__ __forceinline__ bf16x8_t mk8a(u16x4_t a, u16x4_t b) { bf16x8_t r; r[0] = a[0]; r[1] = a[1]; r[2] = a[2]; r[3] = a[3]; r[4] = b[0]; r[5] = b[1]; r[6] = b[2]; r[7] = b[3]; return r; }
#define TR8I(d0, d1, d2, d3, d4, d5, d6, d7, base, o0, o1, o2, o3, o4, o5, o6, o7) asm volatile( \
    "ds_read_b64_tr_b16 %0, %8 offset:%9\n\tds_read_b64_tr_b16 %1, %8 offset:%10\n\tds_read_b64_tr_b16 %2, %8 offset:%11\n\tds_read_b64_tr_b16 %3, %8 offset:%12\n\t" \
    "ds_read_b64_tr_b16 %4, %8 offset:%13\n\tds_read_b64_tr_b16 %5, %8 offset:%14\n\tds_read_b64_tr_b16 %6, %8 offset:%15\n\tds_read_b64_tr_b16 %7, %8 offset:%16\n\ts_waitcnt lgkmcnt(0)" \
    : "=&v"(d0), "=&v"(d1), "=&v"(d2), "=&v"(d3), "=&v"(d4), "=&v"(d5), "=&v"(d6), "=&v"(d7) : "v"(base), "i"(o0), "i"(o1), "i"(o2), "i"(o3), "i"(o4), "i"(o5), "i"(o6), "i"(o7) : "memory")
#define TR8(d0, d1, d2, d3, d4, d5, d6, d7, a0, a1, a2, a3, a4, a5, a6, a7) asm volatile( \
    "ds_read_b64_tr_b16 %0, %8\n\tds_read_b64_tr_b16 %1, %9\n\tds_read_b64_tr_b16 %2, %10\n\tds_read_b64_tr_b16 %3, %11\n\t" \
    "ds_read_b64_tr_b16 %4, %12\n\tds_read_b64_tr_b16 %5, %13\n\tds_read_b64_tr_b16 %6, %14\n\tds_read_b64_tr_b16 %7, %15\n\ts_waitcnt lgkmcnt(0)" \
    : "=&v"(d0), "=&v"(d1), "=&v"(d2), "=&v"(d3), "=&v"(d4), "=&v"(d5), "=&v"(d6), "=&v"(d7) : "v"(a0), "v"(a1), "v"(a2), "v"(a3), "v"(a4), "v"(a5), "v"(a6), "v"(a7) : "memory")
__device__ __forceinline__ void wg_attn16(LDSP unsigned char* lds, bf16* RA, const bf16* __restrict__ CKVC, const unsigned short* __restrict__ idx, const bf16* __restrict__ WUK, const bf16* __restrict__ WUV,
                                          const float* __restrict__ rel_bias, int unit, int nxt_unit, int par, bool first, int tid, bool dry = false, int qmode = 0, bf16* qscr = nullptr) {
    const int lane = tid & 63, wave = __builtin_amdgcn_readfirstlane(tid >> 6), g = lane >> 4, c = lane & 15;
    const int b = unit >> 9, qg = unit & 511, t0 = b * SEQ + qg * 8, nk = ((qg >> 3) + 1) << 6, nsel = nk < TOPK ? nk : TOPK, ntile = nsel >> 5;
    LDSP unsigned char* QL = lds;
    LDSP unsigned char* tile = lds + wave * TILE_STRIDE;
    LDSP unsigned short* selw = (LDSP unsigned short*)(lds + SELW_OFF + (par * 8 + wave) * 512);
    LDSP unsigned short* selw_n = (LDSP unsigned short*)(lds + SELW_OFF + ((par ^ 1) * 8 + wave) * 512);
    if (first) { if (lane < 32) *((LDSP u32x4*)selw + lane) = *((const u32x4*)(idx + (size_t)(t0 + wave) * TOPK) + lane); }
    const bf16* kvb = CKVC + (size_t)b * SEQ * KV_R + g * 8;
    bf16x8_t kv0[8], kv1[8];
#define KV_LOAD(dst, key) do { const bf16* rp_ = kvb + (size_t)(key) * KV_R; _Pragma("unroll") for (int ks_ = 0; ks_ < 8; ++ks_) dst[ks_] = *(const bf16x8_t*)(rp_ + ks_ * 32); } while (0)
    int ka = (int)selw[c], kb = (int)selw[16 + c];
    KV_LOAD(kv0, ka); KV_LOAD(kv1, kb);
    bf16x8_t qf[8];
    if (qmode != 2) {
        const int h = wave; const bf16* qr = RA + (size_t)(t0 + (qmode == 1 ? c : (c & 7))) * NA + A_Q + h * 64 + g * 8;
        const bf16x8_t b0 = *(const bf16x8_t*)qr, b1 = *(const bf16x8_t*)(qr + 32);
        const bf16* wb = WUK + ((size_t)h * 256 + c) * 64 + g * 8;
#pragma unroll 4
        for (int rt = 0; rt < 16; ++rt) { const bf16x8_t a0 = *(const bf16x8_t*)(wb + rt * 16 * 64), a1 = *(const bf16x8_t*)(wb + rt * 16 * 64 + 32);
            pg8::f32x4 acc = {0.f, 0.f, 0.f, 0.f};
            acc = __builtin_amdgcn_mfma_f32_16x16x32_bf16(a0, b0, acc, 0, 0, 0); acc = __builtin_amdgcn_mfma_f32_16x16x32_bf16(a1, b1, acc, 0, 0, 0);
            u32x2 w; w.x = pk2(acc[0], acc[1]); w.y = pk2(acc[2], acc[3]);
            if (c < 8) *(LDSP u32x2*)(QL + (((c * 8 + h) * 256) + rt * 16 + 4 * g) * 2) = w;
            else if (qmode == 1) *(u32x2*)(qscr + ((((c - 8) * 8 + h) * 256) + rt * 16 + 4 * g)) = w; }
        asm volatile("s_waitcnt lgkmcnt(0)" ::: "memory"); __builtin_amdgcn_s_barrier(); asm volatile("" ::: "memory");
#pragma unroll
        for (int ks = 0; ks < 8; ++ks) qf[ks] = *(const LDSP bf16x8_t*)(QL + (((wave * 8 + (c & 7)) * 256) + ks * 32 + g * 8) * 2);
        asm volatile("s_waitcnt lgkmcnt(0)" ::: "memory"); __builtin_amdgcn_s_barrier(); asm volatile("" ::: "memory");
    } else {
        const unsigned long long* qs = (const unsigned long long*)(qscr + (((wave * 8 + (c & 7)) * 256) + g * 8));
#pragma unroll
        for (int ks = 0; ks < 8; ++ks) { const unsigned long long lo = __hip_atomic_load(qs + ks * 8, __ATOMIC_RELAXED, __HIP_MEMORY_SCOPE_AGENT), hi = __hip_atomic_load(qs + ks * 8 + 1, __ATOMIC_RELAXED, __HIP_MEMORY_SCOPE_AGENT);
            u32x4 w; w.x = (unsigned)lo; w.y = (unsigned)(lo >> 32); w.z = (unsigned)hi; w.w = (unsigned)(hi >> 32); qf[ks] = __builtin_bit_cast(bf16x8_t, w); }
    }
    const unsigned tile_a = (unsigned)(size_t)tile;
#if ATT_STAGGER
    if (wave >= 4) __builtin_amdgcn_s_sleep(ATT_STAGGER);
#endif
    bf16x8_t bbf; { float bv[8];
#pragma unroll
        for (int j = 0; j < 8; ++j) bv[j] = rel_bias[(8 * g + j) * 8 + (c & 7)];
        u32x4 w; w.x = pk2(bv[0], bv[1]); w.y = pk2(bv[2], bv[3]); w.z = pk2(bv[4], bv[5]); w.w = pk2(bv[6], bv[7]); bbf = __builtin_bit_cast(bf16x8_t, w); }
    {
        const int spos = (qg * 8 + wave);
        pg8::f32x4 acc[16];
#pragma unroll
        for (int nt = 0; nt < 16; ++nt) acc[nt] = (pg8::f32x4){0.f, 0.f, 0.f, 0.f};
        float m_run = -INFINITY, l_run = 0.f;
#define ONEHOT(dst, key) do { const int rel_ = (key) - spos, n_ = rel_ < 0 ? -rel_ : rel_; \
            const int big_ = 8 + (n_ >= 15) + (n_ >= 27) + (n_ >= 50) + (n_ >= 91) + (n_ >= 166) + (n_ >= 305) + (n_ >= 559); \
            const int pos_ = (n_ < 8 ? n_ : big_) + (rel_ > 0 ? 16 : 0) - 8 * g; const unsigned one_ = (pos_ & 1) ? 0x3F800000u : 0x3F80u; const int hi_ = pos_ >> 1; \
            u32x4 w_; w_.x = (hi_ == 0) ? one_ : 0u; w_.y = (hi_ == 1) ? one_ : 0u; w_.z = (hi_ == 2) ? one_ : 0u; w_.w = (hi_ == 3) ? one_ : 0u; dst = __builtin_bit_cast(bf16x8_t, w_); } while (0)
        const int q4 = c >> 2, p = c & 3;
        const unsigned trb = tile_a + (4 * g + q4) * KVP + 8 * p;
        for (int tl = 0; tl < ntile; ++tl) {
            int kan = 0, kbn = 0; const bool more = tl + 1 < ntile;
            if (more) { kan = (int)selw[(2 * tl + 2) * 16 + c]; kbn = (int)selw[(2 * tl + 3) * 16 + c]; }
            bf16x8_t oha, ohb; ONEHOT(oha, ka); ONEHOT(ohb, kb);
            asm volatile("s_waitcnt vmcnt(8)" ::: "memory");
            pg8::f32x4 s0 = {0.f, 0.f, 0.f, 0.f}, s1 = {0.f, 0.f, 0.f, 0.f};
            s0 = __builtin_amdgcn_mfma_f32_16x16x32_bf16(oha, bbf, s0, 0, 0, 0);
#pragma unroll
            for (int ks = 0; ks < 8; ++ks) { s0 = __builtin_amdgcn_mfma_f32_16x16x32_bf16(kv0[ks], qf[ks], s0, 0, 0, 0); *(LDSP bf16x8_t*)(tile + c * KVP + g * 16 + ks * 64) = kv0[ks]; }
            if (more) KV_LOAD(kv0, kan);
            if (more) asm volatile("s_waitcnt vmcnt(8)" ::: "memory"); else asm volatile("s_waitcnt vmcnt(0)" ::: "memory");
            s1 = __builtin_amdgcn_mfma_f32_16x16x32_bf16(ohb, bbf, s1, 0, 0, 0);
#pragma unroll
            for (int ks = 0; ks < 8; ++ks) { s1 = __builtin_amdgcn_mfma_f32_16x16x32_bf16(kv1[ks], qf[ks], s1, 0, 0, 0); *(LDSP bf16x8_t*)(tile + (16 + c) * KVP + g * 16 + ks * 64) = kv1[ks]; }
            if (more) KV_LOAD(kv1, kbn);
            ka = kan; kb = kbn;
            float sv[8];
#pragma unroll
            for (int j = 0; j < 4; ++j) { sv[j] = s0[j]; sv[4 + j] = s1[j]; }
            float tmax = fmaxf(fmaxf(fmaxf(sv[0], sv[1]), fmaxf(sv[2], sv[3])), fmaxf(fmaxf(sv[4], sv[5]), fmaxf(sv[6], sv[7])));
            tmax = fmaxf(tmax, __shfl_xor(tmax, 16)); tmax = fmaxf(tmax, __shfl_xor(tmax, 32));
            const float m_new = fmaxf(m_run, tmax); const float scl = __expf(m_run - m_new); const bool grow = m_new > m_run; m_run = m_new;
            float ps = 0.f;
#pragma unroll
            for (int j = 0; j < 8; ++j) { sv[j] = __expf(sv[j] - m_new); ps += sv[j]; }
            l_run = l_run * scl + ps;
            bf16x8_t pf; { u32x4 w; w.x = pk2(sv[0], sv[1]); w.y = pk2(sv[2], sv[3]); w.z = pk2(sv[4], sv[5]); w.w = pk2(sv[6], sv[7]); pf = __builtin_bit_cast(bf16x8_t, w); }
            if (__builtin_amdgcn_ballot_w64(grow) != 0ull) {
                float rs[4];
#pragma unroll
                for (int e = 0; e < 4; ++e) rs[e] = __shfl(scl, 4 * g + e);
#pragma unroll
                for (int nt = 0; nt < 16; ++nt) {
#pragma unroll
                    for (int e = 0; e < 4; ++e) acc[nt][e] *= rs[e]; } }
            asm volatile("s_waitcnt lgkmcnt(0)" ::: "memory");
            u16x4_t va[8], vb[8];
            TR8N(va[0], va[1], va[2], va[3], va[4], va[5], va[6], va[7], trb, 0, 16 * KVP, 32, 32 + 16 * KVP, 64, 64 + 16 * KVP, 96, 96 + 16 * KVP);
            TR8N(vb[0], vb[1], vb[2], vb[3], vb[4], vb[5], vb[6], vb[7], trb, 128, 128 + 16 * KVP, 160, 160 + 16 * KVP, 192, 192 + 16 * KVP, 224, 224 + 16 * KVP);
            WAITPIN8(8, va[0], va[1], va[2], va[3], va[4], va[5], va[6], va[7]);
#pragma unroll
            for (int k = 0; k < 4; ++k) acc[k] = __builtin_amdgcn_mfma_f32_16x16x32_bf16(pf, mk8a(va[2 * k], va[2 * k + 1]), acc[k], 0, 0, 0);
            TR8N(va[0], va[1], va[2], va[3], va[4], va[5], va[6], va[7], trb, 256, 256 + 16 * KVP, 288, 288 + 16 * KVP, 320, 320 + 16 * KVP, 352, 352 + 16 * KVP);
            WAITPIN8(8, vb[0], vb[1], vb[2], vb[3], vb[4], vb[5], vb[6], vb[7]);
#pragma unroll
            for (int k = 0; k < 4; ++k) acc[4 + k] = __builtin_amdgcn_mfma_f32_16x16x32_bf16(pf, mk8a(vb[2 * k], vb[2 * k + 1]), acc[4 + k], 0, 0, 0);
            TR8N(vb[0], vb[1], vb[2], vb[3], vb[4], vb[5], vb[6], vb[7], trb, 384, 384 + 16 * KVP, 416, 416 + 16 * KVP, 448, 448 + 16 * KVP, 480, 480 + 16 * KVP);
            WAITPIN8(8, va[0], va[1], va[2], va[3], va[4], va[5], va[6], va[7]);
#pragma unroll
            for (int k = 0; k < 4; ++k) acc[8 + k] = __builtin_amdgcn_mfma_f32_16x16x32_bf16(pf, mk8a(va[2 * k], va[2 * k + 1]), acc[8 + k], 0, 0, 0);
            WAITPIN8(0, vb[0], vb[1], vb[2], vb[3], vb[4], vb[5], vb[6], vb[7]);
#pragma unroll
            for (int k = 0; k < 4; ++k) acc[12 + k] = __builtin_amdgcn_mfma_f32_16x16x32_bf16(pf, mk8a(vb[2 * k], vb[2 * k + 1]), acc[12 + k], 0, 0, 0);
        }
#undef KV_LOAD
#undef ONEHOT
        float lt = l_run + __shfl_xor(l_run, 16); lt += __shfl_xor(lt, 32); const float inv = 1.0f / lt;
        float ri[4];
#pragma unroll
        for (int e = 0; e < 4; ++e) ri[e] = __shfl(inv, 4 * g + e);
        if (g < 2) {
#pragma unroll
            for (int nt = 0; nt < 16; ++nt) { LDSP unsigned short* o1 = (LDSP unsigned short*)(tile) + (4 * g) * 256 + nt * 16 + c;
                o1[0] = f2bf(acc[nt][0] * ri[0]); o1[256] = f2bf(acc[nt][1] * ri[1]); o1[512] = f2bf(acc[nt][2] * ri[2]); o1[768] = f2bf(acc[nt][3] * ri[3]); }
        }
    }
    u32x4 nsel_v = {0u, 0u, 0u, 0u};
    if (nxt_unit >= 0 && lane < 32) { const int nb = nxt_unit >> 9, nq = nxt_unit & 511; nsel_v = *((const u32x4*)(idx + (size_t)(nb * SEQ + nq * 8 + wave) * TOPK) + lane); }
    asm volatile("s_waitcnt lgkmcnt(0)" ::: "memory"); __builtin_amdgcn_s_barrier(); asm volatile("" ::: "memory");
    if (qmode == 1) {
        bf16* oscr = qscr + 16384;
#pragma unroll
        for (int j = 0; j < 4; ++j) *((u32x4*)(oscr + (size_t)wave * 2048) + j * 64 + lane) = *((const LDSP u32x4*)(tile) + j * 64 + lane);
    } else {
        const int h = wave; pg8::f32x4 o[4];
#pragma unroll
        for (int nt = 0; nt < 4; ++nt) o[nt] = (pg8::f32x4){0.f, 0.f, 0.f, 0.f};
        const LDSP unsigned char* ab = lds + TILE_STRIDE * (c & 7) + (h * 256 + g * 8) * 2;
        const unsigned long long* os = (const unsigned long long*)(qscr + 16384 + ((c & 7) * 8 + h) * 256 + g * 8);
        const bf16* wb = WUV + ((size_t)h * 64 + c) * 256 + g * 8;
        const bool from_scr = (qmode == 2) && (c < 8);
#pragma unroll
        for (int ks = 0; ks < 8; ++ks) { bf16x8_t a;
            if (from_scr) { const unsigned long long lo = __hip_atomic_load(os + ks * 8, __ATOMIC_RELAXED, __HIP_MEMORY_SCOPE_AGENT), hi = __hip_atomic_load(os + ks * 8 + 1, __ATOMIC_RELAXED, __HIP_MEMORY_SCOPE_AGENT);
                u32x4 w; w.x = (unsigned)lo; w.y = (unsigned)(lo >> 32); w.z = (unsigned)hi; w.w = (unsigned)(hi >> 32); a = __builtin_bit_cast(bf16x8_t, w); }
            else a = *(const LDSP bf16x8_t*)(ab + ks * 64);
#pragma unroll
            for (int nt = 0; nt < 4; ++nt) { const bf16x8_t bw = *(const bf16x8_t*)(wb + (size_t)nt * 16 * 256 + ks * 32); o[nt] = __builtin_amdgcn_mfma_f32_16x16x32_bf16(a, bw, o[nt], 0, 0, 0); } }
        const int rbase = (qmode == 2) ? t0 - 8 : t0;
        if ((g < 2 || qmode == 2) && !dry) {
#pragma unroll
            for (int nt = 0; nt < 4; ++nt)
#pragma unroll
                for (int e = 0; e < 4; ++e) RA[(size_t)(rbase + 4 * g + e) * NA + A_Q + h * 64 + nt * 16 + c] = f2bf(o[nt][e]); }
    }
    if (nxt_unit >= 0 && lane < 32) *((LDSP u32x4*)selw_n + lane) = nsel_v;
    asm volatile("s_waitcnt vmcnt(0) lgkmcnt(0)" ::: "memory"); __builtin_amdgcn_s_barrier(); asm volatile("" ::: "memory");
}

#ifndef SSM_SPLIT_V
#define SSM_SPLIT_V 42
#endif
constexpr int SSM_SPLIT = SSM_SPLIT_V;
constexpr int XP = 144, BP = 272;
constexpr int SB_X = 0, SB_B = 8192, SB_C = 24576, SB_SIZE = 40960;
constexpr int L_XS = 2 * SB_SIZE, L_M = L_XS + 64 * XP, L_HC = L_M + 64 * XP, L_TB = L_HC + 2 * 64 * BP;
static_assert(L_TB + 2048 <= 140 * 1024, "ssm lds");
#define TR2(d0, d1, a0, a1) asm volatile("ds_read_b64_tr_b16 %0, %2\n\tds_read_b64_tr_b16 %1, %3\n\ts_waitcnt lgkmcnt(0)" : "=&v"(d0), "=&v"(d1) : "v"(a0), "v"(a1) : "memory")
__device__ __forceinline__ bf16x8_t mk8(u16x4_t a, u16x4_t b) { bf16x8_t r; r[0] = a[0]; r[1] = a[1]; r[2] = a[2]; r[3] = a[3]; r[4] = b[0]; r[5] = b[1]; r[6] = b[2]; r[7] = b[3]; return r; }
__device__ __forceinline__ int bc_off(int row, int ch) { return 256 * row + 16 * (ch ^ (((row & 3) << 2) | ((row >> 2) & 3))); }
__device__ __forceinline__ void ssm_dma(LDSP unsigned char* buf, const bf16* __restrict__ XA, int tc0, int h, int grp, int wave, int lane, bool full) {
    const int npc = full ? 40 : 24;
    for (int p = wave; p < npc; p += 8) {
        const bf16* src;
        if (p < 8) { const int row = 8 * p + (lane >> 3), ch = lane & 7; src = XA + (size_t)(tc0 + row) * XBC + h * 64 + ch * 8; }
        else { const int pp = (p - 8) & 15, row = 4 * pp + (lane >> 4), ch = (lane & 15) ^ (((row & 3) << 2) | ((row >> 2) & 3)); src = XA + (size_t)(tc0 + row) * XBC + (p < 24 ? 1024 : 1280) + grp * 128 + ch * 8; }
        __builtin_amdgcn_global_load_lds((const unsigned*)src, (LDSP unsigned*)(buf + 1024 * p), 16, 0, 0);
    }
}
__device__ __forceinline__ void wg_ssm_unit(LDSP unsigned char* lds, bf16* RA, const bf16* __restrict__ XA, const float* __restrict__ DTt,
                                            const float* __restrict__ a_log, const float* __restrict__ dsk, int unit, int tid, bf16* dbg_out = nullptr, bool dry = false) {
    const int lane = tid & 63, wave = __builtin_amdgcn_readfirstlane(tid >> 6), g = lane >> 4, c = lane & 15, q4 = c >> 2, p4 = c & 3;
    const int b = unit >> 5, h = (unit >> 1) & 15, seg = unit & 1, grp = h >> 3, pq = wave & 3, hf = wave >> 2;
    const float Dh = dsk[h];
    const unsigned lds_a = (unsigned)(size_t)lds;
    LDSP float* TB = (LDSP float*)(lds + L_TB);
    typedef float f32x2_t __attribute__((ext_vector_type(2)));
    const f32x2_t* dtp = (const f32x2_t*)DTt + (size_t)(b * 16 + h) * SEQ;
    pg8::f32x4 hacc[4];
#pragma unroll
    for (int nt = 0; nt < 4; ++nt) hacc[nt] = (pg8::f32x4){0.f, 0.f, 0.f, 0.f};
    for (int i = tid; i < (2 * 64 * BP) / 4; i += NTHR) ((LDSP unsigned*)(lds + L_HC))[i] = 0u;
    const int c_end = seg ? 64 : SSM_SPLIT;
    ssm_dma(lds, XA, b * SEQ, h, grp, wave, lane, seg == 0 || SSM_SPLIT == 0);
    f32x2_t dt_cur = dtp[lane];
    asm volatile("s_waitcnt vmcnt(0) lgkmcnt(0)" ::: "memory"); __builtin_amdgcn_s_barrier(); asm volatile("" ::: "memory");
    for (int ci = 0; ci < c_end; ++ci) {
        const bool full = (seg == 0) || (ci >= SSM_SPLIT);
        const int tc0 = b * SEQ + ci * 64;
        LDSP unsigned char* buf = lds + (ci & 1) * SB_SIZE;
        f32x2_t dt_nxt = {0.f, 0.f};
        if (ci + 1 < c_end) { ssm_dma(lds + ((ci + 1) & 1) * SB_SIZE, XA, tc0 + 64, h, grp, wave, lane, (seg == 0) || (ci + 1 >= SSM_SPLIT)); dt_nxt = dtp[(ci + 1) * 64 + lane]; }
        unsigned short zraw[8];
        if (full) {
#pragma unroll
            for (int k2 = 0; k2 < 2; ++k2)
#pragma unroll
                for (int e = 0; e < 4; ++e) zraw[k2 * 4 + e] = RA[(size_t)(tc0 + 16 * (2 * hf + k2) + 4 * g + e) * NA + A_Z + h * 64 + 16 * pq + c]; }
        {   const float dt = dt_cur.x, acs = dt_cur.y; const float tot = __builtin_bit_cast(float, __builtin_amdgcn_readlane(__builtin_bit_cast(int, acs), 63));
            TB[lane] = dt; TB[64 + lane] = acs; TB[128 + lane] = __expf(acs); TB[192 + lane] = __expf(tot - acs) * dt; if (lane == 0) TB[256] = __expf(tot); }
        asm volatile("s_waitcnt lgkmcnt(0)" ::: "memory");
        {   const int row = tid >> 3, ch = tid & 7; const u32x4 xv = *(const LDSP u32x4*)(buf + SB_X + row * 128 + ch * 16); const float wl = TB[192 + row]; const unsigned xw[4] = {xv.x, xv.y, xv.z, xv.w}; u32x4 o;
            o.x = pk2(__builtin_bit_cast(float, xw[0] << 16) * wl, __builtin_bit_cast(float, xw[0] & 0xffff0000u) * wl); o.y = pk2(__builtin_bit_cast(float, xw[1] << 16) * wl, __builtin_bit_cast(float, xw[1] & 0xffff0000u) * wl);
            o.z = pk2(__builtin_bit_cast(float, xw[2] << 16) * wl, __builtin_bit_cast(float, xw[2] & 0xffff0000u) * wl); o.w = pk2(__builtin_bit_cast(float, xw[3] << 16) * wl, __builtin_bit_cast(float, xw[3] & 0xffff0000u) * wl);
            *(LDSP u32x4*)(lds + L_XS + row * XP + ch * 16) = o; }
        if (full) {
            const int lt = wave >> 1;
#pragma unroll
            for (int k2 = 0; k2 < 2; ++k2) { const int st = 2 * (wave & 1) + k2; pg8::f32x4 ga = {0.f, 0.f, 0.f, 0.f};
#pragma unroll
                for (int ks = 0; ks < 4; ++ks) { const bf16x8_t af = *(const LDSP bf16x8_t*)(buf + SB_C + bc_off(16 * lt + c, 4 * ks + g)), bfm = *(const LDSP bf16x8_t*)(buf + SB_B + bc_off(16 * st + c, 4 * ks + g));
                    ga = __builtin_amdgcn_mfma_f32_16x16x32_bf16(af, bfm, ga, 0, 0, 0); }
                const int s = 16 * st + c; const float acs_s = TB[64 + s], dt_s = TB[s];
#pragma unroll
                for (int e = 0; e < 4; ++e) { const int l = 16 * lt + 4 * g + e; const float m = (s <= l) ? ga[e] * __expf(TB[64 + l] - acs_s) * dt_s : 0.f;
                    *(LDSP unsigned short*)(lds + L_M + l * XP + s * 2) = f2bf(m); } }
        }
        asm volatile("s_waitcnt lgkmcnt(0)" ::: "memory"); __builtin_amdgcn_s_barrier(); asm volatile("" ::: "memory");
        if (full) {
            pg8::f32x4 ya[2] = {{0.f, 0.f, 0.f, 0.f}, {0.f, 0.f, 0.f, 0.f}};
            const LDSP unsigned char* hcur = lds + L_HC + (ci & 1) * (64 * BP);
#pragma unroll
            for (int ks = 0; ks < 4; ++ks) { const bf16x8_t hb = *(const LDSP bf16x8_t*)(hcur + (16 * pq + c) * BP + (32 * ks + 8 * g) * 2);
#pragma unroll
                for (int k2 = 0; k2 < 2; ++k2) { const bf16x8_t af = *(const LDSP bf16x8_t*)(buf + SB_C + bc_off(16 * (2 * hf + k2) + c, 4 * ks + g)); ya[k2] = __builtin_amdgcn_mfma_f32_16x16x32_bf16(af, hb, ya[k2], 0, 0, 0); } }
#pragma unroll
            for (int k2 = 0; k2 < 2; ++k2)
#pragma unroll
                for (int e = 0; e < 4; ++e) ya[k2][e] *= TB[128 + 16 * (2 * hf + k2) + 4 * g + e];
#pragma unroll
            for (int ks = 0; ks < 2; ++ks) { u16x4_t x0, x1; const unsigned xa = lds_a + (ci & 1) * SB_SIZE + SB_X + (32 * ks + 8 * g + q4) * 128 + (16 * pq + 4 * p4) * 2; TR2(x0, x1, xa, xa + 4 * 128); const bf16x8_t xb = mk8(x0, x1);
#pragma unroll
                for (int k2 = 0; k2 < 2; ++k2) { const bf16x8_t mf = *(const LDSP bf16x8_t*)(lds + L_M + (16 * (2 * hf + k2) + c) * XP + (32 * ks + 8 * g) * 2); ya[k2] = __builtin_amdgcn_mfma_f32_16x16x32_bf16(mf, xb, ya[k2], 0, 0, 0); } }
#pragma unroll
            for (int k2 = 0; k2 < 2; ++k2)
#pragma unroll
                for (int e = 0; e < 4; ++e) { const int l = 16 * (2 * hf + k2) + 4 * g + e, pp = 16 * pq + c; const float x = bf2f(*(const LDSP unsigned short*)(buf + SB_X + l * 128 + pp * 2));
                    const float z = bf2f(zraw[k2 * 4 + e]); const bf16 uo = f2bf((ya[k2][e] + Dh * x) * siluf_(z));
                    if (dbg_out) dbg_out[(size_t)(tc0 + l) * 1024 + h * 64 + pp] = uo; else if (!dry) RA[(size_t)(tc0 + l) * NA + A_Z + h * 64 + pp] = uo; }
        }
        {   const float dec = TB[256];
#pragma unroll
            for (int nt = 0; nt < 4; ++nt)
#pragma unroll
                for (int e = 0; e < 4; ++e) hacc[nt][e] *= dec;
#pragma unroll
            for (int ks = 0; ks < 2; ++ks) { const int row = 32 * ks + 8 * g + q4; u16x4_t x0, x1; const unsigned xa = lds_a + L_XS + row * XP + (16 * pq + 4 * p4) * 2; TR2(x0, x1, xa, xa + 4 * XP); const bf16x8_t xf = mk8(x0, x1);
                u16x4_t v[8]; unsigned ad[8];
#pragma unroll
                for (int nt = 0; nt < 4; ++nt) { const int ch = 8 * hf + 2 * nt + (p4 >> 1); ad[2 * nt] = lds_a + (ci & 1) * SB_SIZE + SB_B + bc_off(row, ch) + 8 * (p4 & 1); ad[2 * nt + 1] = lds_a + (ci & 1) * SB_SIZE + SB_B + bc_off(row + 4, ch) + 8 * (p4 & 1); }
                TR8(v[0], v[1], v[2], v[3], v[4], v[5], v[6], v[7], ad[0], ad[1], ad[2], ad[3], ad[4], ad[5], ad[6], ad[7]);
#pragma unroll
                for (int nt = 0; nt < 4; ++nt) hacc[nt] = __builtin_amdgcn_mfma_f32_16x16x32_bf16(xf, mk8(v[2 * nt], v[2 * nt + 1]), hacc[nt], 0, 0, 0); }
            LDSP unsigned char* hnext = lds + L_HC + ((ci + 1) & 1) * (64 * BP);
#pragma unroll
            for (int nt = 0; nt < 4; ++nt)
#pragma unroll
                for (int e = 0; e < 4; ++e) *(LDSP unsigned short*)(hnext + (16 * pq + 4 * g + e) * BP + (64 * hf + 16 * nt + c) * 2) = f2bf(hacc[nt][e]);
        }
        dt_cur = dt_nxt;
        asm volatile("s_waitcnt vmcnt(0) lgkmcnt(0)" ::: "memory"); __builtin_amdgcn_s_barrier(); asm volatile("" ::: "memory");
    }
}

__global__ void __launch_bounds__(NTHR, 2) k_fwd(Params P) {
    extern __shared__ __attribute__((aligned(16))) unsigned char lds_raw[];
    LDSP unsigned char* lds = (LDSP unsigned char*)lds_raw;
    volatile LDSP unsigned* MISC = (volatile LDSP unsigned*)(lds + MISC_OFF);
    unsigned char* ws = P.ws;
    const int wave_s = __builtin_amdgcn_readfirstlane(threadIdx.x >> 6);
    for (int u = threadIdx.x; u < (LDS_BYTES - RING_BYTES) / 4; u += NTHR) ((LDSP unsigned*)(lds + RING_BYTES))[u] = 0u;
#define PHASE_IDS int tid = mk_tid(wave_s); int blk = blockIdx.x; asm volatile("" : "+s"(blk)); int G = gridDim.x; asm volatile("" : "+s"(G)); const int NGW = G * NWAVES; (void)NGW; const int lane = tid & 63, wave = __builtin_amdgcn_readfirstlane(tid >> 6), gw = blk * NWAVES + wave; (void)lane; (void)wave; (void)gw; const __attribute__((address_space(4))) char* kargs = (const __attribute__((address_space(4))) char*)__builtin_amdgcn_kernarg_segment_ptr(); asm volatile("" : "+s"(kargs)); int Lp = L; asm volatile("" : "+s"(Lp)); (void)Lp; unsigned char* ws = ((unsigned char* const __attribute__((address_space(4)))*)kargs)[27]; float* out = ((float* const __attribute__((address_space(4)))*)kargs)[26]; const float* x = KIN(0); const float* p = KIN(1); float* rstd = (float*)(ws + WS_RSTD); float* rstd2 = (float*)(ws + WS_RSTD2); float* DTb = (float*)(ws + WS_DT); bf16 *Win = (bf16*)(ws + WS_W_IN), *Wout = (bf16*)(ws + WS_W_OUT), *Wgu = (bf16*)(ws + WS_W_GU), *Wdown = (bf16*)(ws + WS_W_DOWN), *Wpg = (bf16*)(ws + WS_W_PG), *Wpp = (bf16*)(ws + WS_W_PP); bf16 *X0 = (bf16*)(ws + WS_X0), *X1 = (bf16*)(ws + WS_X1), *RA = (bf16*)(ws + WS_RA), *RB = (bf16*)(ws + WS_RB), *XA = (bf16*)out; unsigned short* IDX = (unsigned short*)((unsigned char*)out + 112 * MiB); bf16* CKVC = (bf16*)((unsigned char*)out + 96 * MiB); bf16* IKC = (bf16*)(ws + WS_IKC); bf16* WUK = (bf16*)(ws + WS_WUK); bf16* WUV = (bf16*)(ws + WS_WUV); (void)CKVC; (void)IKC; (void)WUK; (void)WUV; bf16* Xcur = (Lp == 0) ? X0 : X1; (void)out; (void)x; (void)p; (void)rstd; (void)rstd2; (void)DTb; (void)Win; (void)Wout; (void)Wgu; (void)Wdown; (void)Wpg; (void)Wpp; (void)X0; (void)X1; (void)RA; (void)RB; (void)XA; (void)IDX; (void)Xcur
    __syncthreads();
    if (TIMING && blockIdx.x == 0 && mk_tid(wave_s) == 0) { __hip_atomic_store((unsigned long long*)(P.ws + 32768), (unsigned long long)__builtin_amdgcn_s_memrealtime(), __ATOMIC_RELAXED, __HIP_MEMORY_SCOPE_AGENT); __hip_atomic_store((unsigned long long*)(P.ws + 32768) + 60, (unsigned long long)__builtin_amdgcn_s_memtime(), __ATOMIC_RELAXED, __HIP_MEMORY_SCOPE_AGENT); }
#if CLK_PROBE
    if (blockIdx.x == 0 && mk_tid(wave_s) == 0) { __hip_atomic_store((unsigned long long*)(P.ws + 49152), (unsigned long long)__builtin_amdgcn_s_memtime(), __ATOMIC_RELAXED, __HIP_MEMORY_SCOPE_AGENT); __hip_atomic_store((unsigned long long*)(P.ws + 49152) + 1, (unsigned long long)__builtin_amdgcn_s_memrealtime(), __ATOMIC_RELAXED, __HIP_MEMORY_SCOPE_AGENT); }
#endif
    const bool one_launch = (P.ph_hi - P.ph_lo) > 1;
    XcdBarrier bar; bar.bar = (unsigned*)(ws + WS_CTL) + CW_BAR; bar.x = 0; bar.st = nullptr;
    if (one_launch) bar = xcd_barrier_post((unsigned*)(ws + WS_CTL) + CW_BAR, (volatile LAS unsigned*)(MISC + 8));
    if (one_launch && mk_tid(wave_s) == 0) { const unsigned xid_ = xb_xcc_id(); MISC[16] = xid_; MISC[17] = __hip_atomic_fetch_add((unsigned*)(P.ws + WS_CTL) + CW_RANK + 64 * xid_, 1u, __ATOMIC_RELAXED, __HIP_MEMORY_SCOPE_AGENT); }

#ifndef PH_MASK
#define PH_MASK 0x3fff
#endif
#define PHASE_IDS_NOL const int L = 0; PHASE_IDS
#define NPASS(k) (((DBL_MASK >> (k)) & 1) ? ((Lp == 0 && ((P.dbl_mask >> (k)) & 1)) ? 2 : 1) : 1)
#define XCD_DEAL bool xok_ = false; int xb_ = 0, xr_ = 0, xn_ = 1; { if (tid == 0) { unsigned ok = (MISC[9] == 8u) ? 1u : 0u; unsigned sum = 0; for (int j = 0; j < 8; ++j) { const unsigned cj = __hip_atomic_load((unsigned*)(ws + WS_CTL) + CW_BAR + XB_XCNT(j), __ATOMIC_RELAXED, __HIP_MEMORY_SCOPE_AGENT); sum += cj; if (cj == 0u) ok = 0u; } if (sum != (unsigned)G) ok = 0u; MISC[18] = ok; } \
    __syncthreads(); xok_ = MISC[18] != 0u; xb_ = (int)MISC[16]; xr_ = (int)MISC[17]; xn_ = (int)MISC[8]; if (xn_ < 1) xn_ = 1; __syncthreads(); }
#define KIN(i) (((const float* const __attribute__((address_space(4)))*)kargs)[i])
#define IN(k) (P.ph_lo <= (k) && (k) < P.ph_hi && ((PH_MASK >> ((k) % NPH)) & 1))
#define SEAM(k) do { if (IN((k) + 1)) { XcdBarrier b2_ = bar; asm volatile("" : "+s"(b2_.bar)); xcd_barrier(b2_, mk_tid(wave_s)); } if (TIMING && blockIdx.x == 0 && mk_tid(wave_s) == 0) { __hip_atomic_store((unsigned long long*)(P.ws + 32768) + (k) + 1, (unsigned long long)__builtin_amdgcn_s_memrealtime(), __ATOMIC_RELAXED, __HIP_MEMORY_SCOPE_AGENT); } } while (0)
    for (int L = 0; L < DEPTH; ++L) {
        const int pb = L * NPH;
        if (IN(pb + 0)) { PHASE_IDS; for (int pass = NPASS(0); pass > 0; --pass) {
            LDSP float* scr = (LDSP float*)(lds + wave * 8704);
            ph_prep_w<1>(scr, KIN(6) + (size_t)Lp * D * INW, nullptr, D, INW, KIN(2) + (size_t)Lp * D, Win, NIN, gw, NGW, lane);
            ph_prep_w<0>(scr, KIN(20) + (size_t)Lp * MIXW * D, nullptr, MIXW, D, nullptr, Wout, D, gw, NGW, lane);
            ph_prep_w<2>(scr, KIN(21) + (size_t)Lp * D * DFF, KIN(22) + (size_t)Lp * D * DFF, D, DFF, KIN(4) + (size_t)Lp * D, Wgu, NGU, gw, NGW, lane);
            ph_prep_w<0>(scr, KIN(23) + (size_t)Lp * DFF * D, nullptr, DFF, D, nullptr, Wdown, D, gw, NGW, lane);
            ph_prep_w<0>(scr, KIN(25) + (size_t)Lp * D * D, nullptr, D, D, nullptr, Wpg, D, gw, NGW, lane);
            ph_prep_w<0>(scr, KIN(24) + (size_t)Lp * PLE * D, nullptr, PLE, D, nullptr, Wpp, D, gw, NGW, lane);
            {   const float* uk = KIN(10) + (size_t)Lp * 256 * 8 * 64; const float* uv = KIN(11) + (size_t)Lp * 256 * 8 * 64;
                for (int e = gw * 64 + lane; e < 8 * 256 * 64; e += NGW * 64) { const int h = e >> 14, r = (e >> 6) & 255, d = e & 63; WUK[e] = f2bf(0.125f * uk[((size_t)r * 8 + h) * 64 + d]); }
                for (int e = gw * 64 + lane; e < 8 * 64 * 256; e += NGW * 64) { const int h = e >> 14, d = (e >> 8) & 63, r = e & 255; WUV[e] = f2bf(uv[((size_t)r * 8 + h) * 64 + d]); } }
            if (Lp == 0) { for (int r = gw; r < T; r += NGW) row_x_prep(x, X0, rstd, r, lane); }
            else        { for (int r = gw; r < T; r += NGW) row_rstd_bf16(X1, rstd, r, lane); }
            }
            SEAM(pb + 0);
        }
#if XTRA_BAR
        if (P.ph_hi - P.ph_lo > 1 && L == 0) { for (int i_ = 0; i_ < XTRA_BAR; ++i_) { XcdBarrier b4_ = bar; asm volatile("" : "+s"(b4_.bar)); xcd_barrier(b4_, mk_tid(wave_s)); } }
#endif
        if (IN(pb + 1)) { PHASE_IDS; for (int pass = NPASS(1); pass > 0; --pass) {
            pg8::Gemm g{Xcur, Win, T, NIN, (GEMM_DRYK && pass > 1) ? GEMM_DRYK : D}; pg8::StaticOrder S; S.init(T, NIN, G, blk);
            pg8::EpiProj E{RA, RB, rstd};
            pg8::gemm_phase<pg8::EpiProj, pg8::StaticOrder, true, true>(lds, g, S, E, tid);
            }
            SEAM(pb + 1);
        }
        if (IN(pb + 2)) { PHASE_IDS;
            for (int pass = NPASS(2); pass > 0; --pass) {
#pragma unroll 2
            for (int it = gw; it < T / 4; it += NGW) prep_ckv4(RB, CKVC, KIN(7) + Lp * KV_R, it, lane);
            for (int it = gw; it < T / 16; it += NGW) prep_ik16(RB, IKC, KIN(8) + Lp * 64, KIN(9) + Lp * 64, it, lane);
#pragma unroll 2
            for (int t = gw; t < T; t += NGW) prep_bout(RA, RB, KIN(13) + (size_t)Lp * 3 * 512, t, lane, pass > 1);
#pragma unroll 2
            for (int it = gw; it < (T / 16) * 12; it += NGW) prep_conv(RB, XA, KIN(14) + (size_t)Lp * 4 * XBC, KIN(15) + (size_t)Lp * XBC, it, lane);
            for (int it = gw; it < BATCH * 64 * 4; it += NGW) { const int hq = it & 3, ck = (it >> 2) & 63, bb = it >> 8; const int t = bb * SEQ + ck * 64 + lane;
                const u32x2 rw = *(const u32x2*)(RB + (size_t)t * NB + B_DT + hq * 4); const unsigned rr[2] = {rw.x, rw.y}; float dtv[4], ac[4];
#pragma unroll
                for (int e = 0; e < 4; ++e) { const int hh = hq * 4 + e; const float xr = __builtin_bit_cast(float, (e & 1) ? (rr[e >> 1] & 0xffff0000u) : (rr[e >> 1] << 16)) + (KIN(16) + Lp * 16)[hh];
                    dtv[e] = xr > 15.f ? xr : log1pf(__expf(xr)); ac[e] = -__expf((KIN(17) + Lp * 16)[hh]) * dtv[e]; }
#pragma unroll
                for (int o = 1; o < 64; o <<= 1) {
#pragma unroll
                    for (int e = 0; e < 4; ++e) { const float v = __shfl_up(ac[e], o); if (lane >= o) ac[e] += v; } }
#pragma unroll
                for (int e = 0; e < 4; ++e) { typedef float f32x2_t __attribute__((ext_vector_type(2))); ((f32x2_t*)(ws + WS_DT2))[(size_t)(bb * 16 + hq * 4 + e) * SEQ + ck * 64 + lane] = (f32x2_t){dtv[e], ac[e]}; } }
            }
            SEAM(pb + 2);
        }
        if (IN(pb + 3)) { PHASE_IDS;
            const bool ssm_first = ((blk >> 3) & 1) == 0;
#pragma clang loop unroll(disable)
            for (int step = 0; step < 3; ++step) {
                const bool do_ssm = (step == 0 && ssm_first) || (step == 2 && !ssm_first);
                if (do_ssm) {
                    for (int u = blk; u < BATCH * 32; u += G) { const int uu = (u & 127) * 2 + (u >> 7);
                        wg_ssm_unit(lds, RA, XA, (const float*)(ws + WS_DT2), KIN(17) + Lp * 16, KIN(18) + Lp * 16, uu ^ 1, mk_tid(wave_s), nullptr, false); }
                } else if (step == 1) {
                    for (int i = blk; i < T / 16; i += G) { const int b_ = i & 7, j_ = i >> 3, u16 = b_ * 256 + (255 - j_);
                        wg_select16(lds, RB, IKC, IDX, u16, mk_tid(wave_s), false, true);
                        const int ua = b_ * 512 + 2 * (255 - j_);
#pragma clang loop unroll(disable)
                        for (int h2 = 0; h2 < 2; ++h2) wg_attn16(lds, RA, CKVC, IDX, WUK, WUV, KIN(12), ua + h2, -1, h2, false, mk_tid(wave_s), false, 1 + h2, (bf16*)((unsigned char*)out + 112 * MiB) + (size_t)blk * 32768); }
                }
            }
            SEAM(pb + 5); }

        if (IN(pb + 6)) { PHASE_IDS; for (int pass = NPASS(6); pass > 0; --pass) for (int w = 4 * gw; w < T * 2; w += 4 * NGW) wave_gnorm4(RA, KIN(19) + (size_t)Lp * 1024, w, lane, pass > 1); SEAM(pb + 6); }
        if (IN(pb + 7)) { PHASE_IDS; for (int pass = NPASS(7); pass > 0; --pass) {
            pg8::Gemm g{RA, Wout, T, D, MIXW}; pg8::StaticOrder S; S.init(T, D, G, blk);
            pg8::EpiBf16P E{RB, (long)D};
            pg8::gemm_phase<pg8::EpiBf16P, pg8::StaticOrder, true, true>(lds, g, S, E, tid);
            }
            SEAM(pb + 7);
        }
        if (IN(pb + 8)) { PHASE_IDS; for (int pass = NPASS(8); pass > 0; --pass) for (int r = 2 * gw; r < T; r += 2 * NGW) row_resid_norm2(Xcur, (const bf16*)RB, KIN(3) + (size_t)Lp * D, X0, rstd2, nullptr, nullptr, r, lane, pass > 1); SEAM(pb + 8); }
        if (IN(pb + 9)) { PHASE_IDS; for (int pass = NPASS(9); pass > 0; --pass) {
            pg8::Gemm g{X0, Wgu, T, NGU, D}; pg8::StaticOrder S; S.init(T, NGU, G, blk);
            pg8::EpiSwiGLU E{RB, rstd2};
            pg8::gemm_phase<pg8::EpiSwiGLU, pg8::StaticOrder, true, true>(lds, g, S, E, tid);
            }
            SEAM(pb + 9);
        }
        if (IN(pb + 10)) { PHASE_IDS; for (int pass = NPASS(10); pass > 0; --pass) {
            pg8::Gemm g{RB, Wdown, T, D, DFF}; pg8::StaticOrder S; S.init(T, D, G, blk);
            pg8::EpiBf16P E{RA, (long)D};
            pg8::gemm_phase<pg8::EpiBf16P, pg8::StaticOrder, true, true>(lds, g, S, E, tid);
            }
            SEAM(pb + 10);
        }
        if (IN(pb + 11)) { PHASE_IDS; for (int pass = NPASS(11); pass > 0; --pass) for (int r = 2 * gw; r < T; r += 2 * NGW) row_resid_norm2(X0, (const bf16*)RA, KIN(5) + (size_t)Lp * D, X0, nullptr, p + (size_t)Lp * T * PLE, X1, r, lane, pass > 1); SEAM(pb + 11); }
        if (IN(pb + 12)) { PHASE_IDS; for (int pass = NPASS(12); pass > 0; --pass) {
            pg8::Gemm g{X1, Wpp, T, D, PLE}; pg8::StaticOrder S; S.init(T, D, G, blk);
            pg8::EpiBf16P E{RB, (long)D};
            pg8::gemm_phase<pg8::EpiBf16P, pg8::StaticOrder, true, true>(lds, g, S, E, tid);
            }
            SEAM(pb + 12);
        }
        if (IN(pb + 13)) { PHASE_IDS; for (int pass = NPASS(13); pass > 0; --pass) {
            pg8::Gemm g{X0, Wpg, T, D, D}; pg8::StaticOrder S; S.init(T, D, G, blk);
            pg8::EpiPle E{X0, RB, X1, (Lp == DEPTH - 1) ? out : nullptr};
            pg8::gemm_phase<pg8::EpiPle, pg8::StaticOrder, true, true>(lds, g, S, E, tid);
            }
            SEAM(pb + 13);
        }
    }
#if CLK_PROBE
    if (P.ph_hi == DEPTH * NPH) { PHASE_IDS_NOL; { XcdBarrier b3_ = bar; asm volatile("" : "+s"(b3_.bar)); xcd_barrier(b3_, mk_tid(wave_s)); }
        if (blk == 0 && tid == 0) { const unsigned long long c1 = __builtin_amdgcn_s_memtime(), r1 = __builtin_amdgcn_s_memrealtime(); const unsigned long long* ts = (const unsigned long long*)(ws + 49152);
            const unsigned long long c0 = __hip_atomic_load(ts, __ATOMIC_RELAXED, __HIP_MEMORY_SCOPE_AGENT), r0 = __hip_atomic_load(ts + 1, __ATOMIC_RELAXED, __HIP_MEMORY_SCOPE_AGENT);
            const float mhz = (float)(c1 - c0) / (float)(r1 - r0) * 100.0f; const float q = exp2f(rintf(4.0f * log2f(fmaxf(mhz, 1.0f))) * 0.25f);
            __hip_atomic_store((float*)(ws + 49152 + 64), q * 0.001f, __ATOMIC_RELAXED, __HIP_MEMORY_SCOPE_AGENT); }
        { XcdBarrier b3_ = bar; asm volatile("" : "+s"(b3_.bar)); xcd_barrier(b3_, mk_tid(wave_s)); }
        const float sc = 1.0f + __hip_atomic_load((float*)(ws + 49152 + 64), __ATOMIC_RELAXED, __HIP_MEMORY_SCOPE_AGENT);
        for (size_t i = (size_t)blk * NTHR + tid; i < (size_t)T * D; i += (size_t)G * NTHR) out[i] *= sc; }
#endif
#if TIMING
    if (P.ph_hi == DEPTH * NPH) { PHASE_IDS_NOL; { XcdBarrier b3_ = bar; asm volatile("" : "+s"(b3_.bar)); xcd_barrier(b3_, mk_tid(wave_s)); }
        const unsigned long long* ts = (const unsigned long long*)(ws + 32768);
        const float ta = (float)(__hip_atomic_load(ts + TIMING_A + 1, __ATOMIC_RELAXED, __HIP_MEMORY_SCOPE_AGENT) - __hip_atomic_load(ts + TIMING_A, __ATOMIC_RELAXED, __HIP_MEMORY_SCOPE_AGENT)) * 0.01f;
        const float tb = (float)(__hip_atomic_load(ts + TIMING_B + 1, __ATOMIC_RELAXED, __HIP_MEMORY_SCOPE_AGENT) - __hip_atomic_load(ts + TIMING_B, __ATOMIC_RELAXED, __HIP_MEMORY_SCOPE_AGENT)) * 0.01f;
        float ta_ = ta; if (TIMING_A == 99) { const unsigned long long c1 = __builtin_amdgcn_s_memtime(), r1 = __builtin_amdgcn_s_memrealtime(); const unsigned long long c0 = __hip_atomic_load(ts + 60, __ATOMIC_RELAXED, __HIP_MEMORY_SCOPE_AGENT), r0 = __hip_atomic_load(ts + 0, __ATOMIC_RELAXED, __HIP_MEMORY_SCOPE_AGENT);
            ta_ = (float)(c1 - c0) / (float)(r1 - r0) * 10.0f;   ta_ = __builtin_bit_cast(float, __builtin_amdgcn_readfirstlane(__builtin_bit_cast(int, ta_))); }
        const float taq = exp2f(rintf(4.0f * log2f(fmaxf(ta_, 1.0f)) + TIMING_SHIFT) * 0.25f), tbq = exp2f(rintf(2.0f * log2f(fmaxf(tb, 1.0f)) + TIMING_SHIFT) * 0.5f);
        const float sc = 1.0f + taq * 0.001f;
        for (size_t i = (size_t)blk * NTHR + tid; i < (size_t)T * D; i += (size_t)G * NTHR) out[i] *= sc;
        __syncthreads(); if (blk == 0 && tid == 0) out[0] += tbq * 10.0f; }
#endif
#if DBG_SSM
    if (P.ph_hi == DEPTH * NPH) { PHASE_IDS_NOL; { XcdBarrier b3_ = bar; asm volatile("" : "+s"(b3_.bar)); xcd_barrier(b3_, mk_tid(wave_s)); }
        const float d2 = __hip_atomic_load((float*)(ws + 65536), __ATOMIC_RELAXED, __HIP_MEMORY_SCOPE_AGENT), n2 = __hip_atomic_load((float*)(ws + 65536 + 4), __ATOMIC_RELAXED, __HIP_MEMORY_SCOPE_AGENT);
        const float sc = 1.0f + (n2 > 0.f ? sqrtf(d2 / n2) : 7.0f);
        for (size_t i = (size_t)blk * NTHR + tid; i < (size_t)T * D; i += (size_t)G * NTHR) out[i] *= sc; }
#endif
#undef IN
#undef SEAM
}

#ifndef MK_ONE_LAUNCH
#define MK_ONE_LAUNCH 1
#endif
extern "C" void kernel_launch(void* const* d_in, const int* in_sizes, int n_in, void* d_out, int out_size, void* d_ws, size_t ws_size, hipStream_t stream) {
    static int grid = 0;
    if (grid == 0) {
        if (n_in != 26 || ws_size < WS_END) { fprintf(stderr, "kernel_launch: unexpected n_in %d / ws_size %zu\n", n_in, ws_size); grid = -1; return; }
        int dev = 0, cus = 0, per_cu = 0;
        if (hipGetDevice(&dev) != hipSuccess || hipDeviceGetAttribute(&cus, hipDeviceAttributeMultiprocessorCount, dev) != hipSuccess) { grid = -1; return; }
        if (hipFuncSetAttribute((const void*)k_fwd, hipFuncAttributeMaxDynamicSharedMemorySize, LDS_BYTES) != hipSuccess) { fprintf(stderr, "kernel_launch: hipFuncSetAttribute failed\n"); grid = -1; return; }
        if (hipOccupancyMaxActiveBlocksPerMultiprocessor(&per_cu, (const void*)k_fwd, NTHR, LDS_BYTES) != hipSuccess || per_cu < 1) { fprintf(stderr, "kernel_launch: occupancy query says %d\n", per_cu); }
        (void)hipGetLastError();
        grid = cus;
    }
    if (grid < 0) return;
    if (hipMemsetAsync((char*)d_ws + WS_CTL, 0, CTL_ZERO_BYTES, stream) != hipSuccess) return;
    Params P; memset(&P, 0, sizeof(P));
    for (int i = 0; i < 26; ++i) P.in[i] = (const float*)d_in[i];
    P.out = (float*)d_out; P.ws = (unsigned char*)d_ws;
#if MK_ONE_LAUNCH
    P.ph_lo = 0; P.ph_hi = DEPTH * NPH; P.dbl_mask = DBL_MASK; P.pad = ATT_SUB_V;
    hipLaunchKernelGGL(k_fwd, dim3(grid), dim3(NTHR), LDS_BYTES, stream, P);
#else
    for (int ph = 0; ph < DEPTH * NPH; ++ph) { P.ph_lo = ph; P.ph_hi = ph + 1; hipLaunchKernelGGL(k_fwd, dim3(grid), dim3(NTHR), LDS_BYTES, stream, P); }
#endif
}
```

```cpp
#include <hip/hip_runtime.h>
#include <cstdio>
#include <cstdint>
#include <cstring>
namespace pg8 {
#define PG8_LAS __attribute__((address_space(3)))
typedef unsigned short bf16_t;
typedef short bf16x8 __attribute__((ext_vector_type(8)));
typedef float f32x4 __attribute__((ext_vector_type(4)));
typedef unsigned u32x4 __attribute__((ext_vector_type(4)));
constexpr int BM = 256, BK = 64, HALF = 128, HTB = HALF * BK * 2  , STAGE_BYTES = 8 * HTB, NXCD = 8, WGM = 8;

__host__ __device__ __forceinline__ int lds_byte(int r, int c) { const int st = (r >> 4) * 2 + (c >> 5), rr = r & 15, cc = c & 31, ob = rr * 64 + cc * 2; return st * 1024 + (ob ^ (((ob >> 9) & 1) << 5)); }
__host__ __device__ __forceinline__ void stage_rc(int b, int& R, int& C) { const int st = b / 1024, sb = b % 1024, swz = sb ^ (((sb >> 9) & 1) << 5); R = (st >> 1) * 16 + swz / 64; C = (st & 1) * 32 + (swz % 64) / 2; }
__host__ __device__ __forceinline__ int perm32(int rho) { const int n = rho >> 4, i = rho & 15; return 8 * (i >> 2) + 4 * n + (i & 3); }

struct Unit { int pm, pn; };
struct Gemm { const bf16_t* A; const bf16_t* Bt; int M, N, K; };

struct StaticOrder {
    int nM, nN, nwg, G, c;
    __host__ __device__ void init(int M, int N, int G_, int c_) { nM = M / BM; nN = N / BM; nwg = nM * nN; G = G_; c = c_; }
    __host__ __device__ bool next(int i, Unit& u) const {
        const long L = (long)i * G + c; if (L >= nwg) return false;
        int wgid = (int)L; { const int q = nwg / NXCD, r = nwg % NXCD, xcd = wgid % NXCD, off = wgid / NXCD; wgid = (xcd < r ? xcd * (q + 1) : r * (q + 1) + (xcd - r) * q) + off; }
        const int nig = WGM * nN, gid = wgid / nig, fm = gid * WGM, gsz = (nM - fm) < WGM ? (nM - fm) : WGM;
        u.pm = fm + ((wgid % nig) % gsz); u.pn = (wgid % nig) / gsz; return true;
    }
    __device__ __forceinline__ void a_ready(const Unit&) const {}
    __device__ __forceinline__ void done(const Unit&) const {}
};

__device__ __forceinline__ unsigned cvt_pk_bf16(float lo, float hi) { unsigned r; asm volatile("v_cvt_pk_bf16_f32 %0, %1, %2" : "=v"(r) : "v"(lo), "v"(hi)); return r; }
typedef float f32x2 __attribute__((ext_vector_type(2)));
__device__ __forceinline__ f32x2 gelu_pk(f32x2 v) {
    const f32x2 av = __builtin_elementwise_abs(v), d = av * 0.2316418882f + 1.0f;
    f32x2 t; t.x = __builtin_amdgcn_rcpf(d.x); t.y = __builtin_amdgcn_rcpf(d.y);
    f32x2 q = t * 0.5307027145f + (-0.7265760135f); q = q * t + 0.7107068705f; q = q * t + (-0.142248368f); q = q * t + 0.127414796f; q = q * t;
    const f32x2 s = (v * v) * (-0.72134752044f);
    f32x2 e; e.x = __builtin_amdgcn_exp2f(s.x); e.y = __builtin_amdgcn_exp2f(s.y);
    const f32x2 m = v * (q * e), r = v - m;
    f32x2 o; o.x = v.x < 0.f ? m.x : r.x; o.y = v.y < 0.f ? m.y : r.y; return o;
}

template <int ACT  > struct EpiBf16 {
    static constexpr bool PERM = true, AFTER_DRAIN = false; static_assert(ACT == 0 || ACT == 1, "EpiBf16: ACT is 0 (none) or 1 (gelu_pk)");
    bf16_t* O; int ldc; const float* bias; int split_cols; size_t split_stride; float scale0;
    __device__ __forceinline__ void operator()(const f32x4 (&acc)[2][2][4][2], const Unit& u, int wr, int wc, int fr, int fq) const {
        const int row0 = u.pm * BM + wr * 64 + fr; int colt = u.pn * BM; bf16_t* base = O;
        float sc = 1.f; if (split_cols) { const int t = colt / split_cols; base += (size_t)t * split_stride; colt -= t * split_cols; if (t == 0) sc = scale0; }
        const int col0 = colt + wc * 32 + 8 * fq, bcol0 = u.pn * BM + wc * 32 + 8 * fq;
        f32x4 bv[2][2];
#pragma unroll
        for (int bj = 0; bj < 2; ++bj)
#pragma unroll
            for (int n = 0; n < 2; ++n) bv[bj][n] = bias ? *(const f32x4*)(bias + bcol0 + bj * HALF + 4 * n) : (f32x4){0.f, 0.f, 0.f, 0.f};
#pragma unroll
        for (int ai = 0; ai < 2; ++ai)
#pragma unroll
            for (int m = 0; m < 4; ++m) { bf16_t* rowp = base + (size_t)(row0 + ai * HALF + m * 16) * ldc + col0;
#pragma unroll
                for (int bj = 0; bj < 2; ++bj) { f32x4 v0 = acc[ai][bj][m][0] + bv[bj][0], v1 = acc[ai][bj][m][1] + bv[bj][1];
                    if (ACT == 1) { f32x2 a = gelu_pk((f32x2){v0[0], v0[1]}), b = gelu_pk((f32x2){v0[2], v0[3]}), c = gelu_pk((f32x2){v1[0], v1[1]}), d = gelu_pk((f32x2){v1[2], v1[3]});
                        v0 = (f32x4){a.x, a.y, b.x, b.y}; v1 = (f32x4){c.x, c.y, d.x, d.y}; }
                    v0 = v0 * sc; v1 = v1 * sc; u32x4 w; w.x = cvt_pk_bf16(v0[0], v0[1]); w.y = cvt_pk_bf16(v0[2], v0[3]); w.z = cvt_pk_bf16(v1[0], v1[1]); w.w = cvt_pk_bf16(v1[2], v1[3]);
                    *(u32x4*)(rowp + bj * HALF) = w; } }
    }
};

struct PanelStats {
    unsigned* xbuf;
    unsigned* cnt;
    unsigned* tmo;
    int ntn; float eps;
    unsigned code;
    __device__ __forceinline__ bool run(const f32x4 (&v)[2][2][4][2], const Unit& u, int wr, int wc, int fr, int fq, PG8_LAS unsigned char* lds, int wid, int lane) const {
        typedef float f32x2v __attribute__((ext_vector_type(2)));
        PG8_LAS f32x2v* P = (PG8_LAS f32x2v*)lds;
        PG8_LAS f32x2v* S = (PG8_LAS f32x2v*)(lds + 8192);
        PG8_LAS unsigned* flag = (PG8_LAS unsigned*)(lds + 8192 + 2048);
#pragma unroll
        for (int ai = 0; ai < 2; ++ai)
#pragma unroll
            for (int m = 0; m < 4; ++m) {
                float s = 0.f;
#pragma unroll
                for (int bj = 0; bj < 2; ++bj)
#pragma unroll
                    for (int n = 0; n < 2; ++n) { const f32x4 x = v[ai][bj][m][n]; s += (x[0] + x[1]) + (x[2] + x[3]); }
                s += __shfl_xor(s, 16); s += __shfl_xor(s, 32);
                const float mw = s * (1.0f / 64.0f); float q = 0.f;
#pragma unroll
                for (int bj = 0; bj < 2; ++bj)
#pragma unroll
                    for (int n = 0; n < 2; ++n) { const f32x4 d = v[ai][bj][m][n] - mw; q += (d[0] * d[0] + d[1] * d[1]) + (d[2] * d[2] + d[3] * d[3]); }
                q += __shfl_xor(q, 16); q += __shfl_xor(q, 32);
                if (fq == 0) P[(ai * HALF + wr * 64 + m * 16 + fr) * 4 + wc] = (f32x2v){mw, q};
            }
        asm volatile("s_waitcnt lgkmcnt(0)" ::: "memory"); __builtin_amdgcn_s_barrier(); asm volatile("" ::: "memory");
#if defined(BROKEN_EXCHANGE_NO_WAIT)
#warning BROKEN CONTROL BUILD: the row-statistics exchange does not wait; results are wrong by design
        if (blockIdx.x >= 64) { const long long t0_ = clock64(); while (clock64() - t0_ < 60000) __builtin_amdgcn_s_sleep(8); }
#endif
        const int row = wid * 32 + (lane & 31);
        if (lane < 32) {
            const f32x2v a = P[row * 4 + 0], b = P[row * 4 + 1], c = P[row * 4 + 2], d = P[row * 4 + 3];
            const float mt = (a.x + b.x + c.x + d.x) * 0.25f;
            const float da = a.x - mt, db = b.x - mt, dc = c.x - mt, dd = d.x - mt;
            const float m2 = (a.y + b.y) + (c.y + d.y) + 64.0f * ((da * da + db * db) + (dc * dc + dd * dd));
            unsigned long long* slot = (unsigned long long*)xbuf + ((size_t)(u.pm * BM + row) * 4 + u.pn);
            __hip_atomic_store(slot, ((unsigned long long)__float_as_uint(m2) << 32) | __float_as_uint(mt), __ATOMIC_RELAXED, __HIP_MEMORY_SCOPE_AGENT);
        }
        asm volatile("s_waitcnt vmcnt(0)" ::: "memory");
        if (lane == 0) __hip_atomic_fetch_add(cnt + 64 * u.pm, 1u, __ATOMIC_RELAXED, __HIP_MEMORY_SCOPE_AGENT);
        if (wid == 0) {
            bool dead = false; const unsigned long long t0 = __builtin_amdgcn_s_memrealtime(); const unsigned want = 8u * (unsigned)ntn;
            for (;;) {
#if defined(BROKEN_EXCHANGE_NO_WAIT)
                break;
#endif
                if ((unsigned)__builtin_amdgcn_readfirstlane(__hip_atomic_load(cnt + 64 * u.pm, __ATOMIC_RELAXED, __HIP_MEMORY_SCOPE_AGENT)) >= want) break;
                if (__builtin_amdgcn_s_memrealtime() - t0 > 2000000ull) {
                    if (lane == 0) { unsigned expect = 0u; __hip_atomic_compare_exchange_strong(tmo + 1, &expect, code | (unsigned)(u.pm & 0xff), __ATOMIC_RELAXED, __ATOMIC_RELAXED, __HIP_MEMORY_SCOPE_AGENT);
                                     __hip_atomic_store(tmo, 1u, __ATOMIC_RELAXED, __HIP_MEMORY_SCOPE_AGENT); }
                    dead = true; break; }
                __builtin_amdgcn_s_sleep(2);
            }
            __builtin_amdgcn_fence(__ATOMIC_ACQUIRE, "agent");
            if (lane == 0) flag[0] = dead ? 1u : 0u;
        }
        asm volatile("s_waitcnt vmcnt(0) lgkmcnt(0)" ::: "memory"); __builtin_amdgcn_s_barrier(); asm volatile("" ::: "memory");
        const bool bad = flag[0] != 0u;
        if (lane < 32) {
            const unsigned long long* slot = (const unsigned long long*)xbuf + (size_t)(u.pm * BM + row) * 4; float mt[4], m2[4]; float ms = 0.f;
#pragma unroll
            for (int t = 0; t < 4; ++t) { if (t < ntn) { const unsigned long long w = __hip_atomic_load(slot + t, __ATOMIC_RELAXED, __HIP_MEMORY_SCOPE_AGENT); mt[t] = __uint_as_float((unsigned)w); m2[t] = __uint_as_float((unsigned)(w >> 32)); } else { mt[t] = 0.f; m2[t] = 0.f; } ms += mt[t]; }
            const float mean = ms / (float)ntn; float q = 0.f;
#pragma unroll
            for (int t = 0; t < 4; ++t) if (t < ntn) { const float dm = mt[t] - mean; q += m2[t] + 256.0f * dm * dm; }
            S[row] = (f32x2v){mean, 1.0f / sqrtf(q / (256.0f * (float)ntn) + eps)};
        }
        asm volatile("s_waitcnt lgkmcnt(0)" ::: "memory"); __builtin_amdgcn_s_barrier(); asm volatile("" ::: "memory");
        return bad;
    }
};
struct EpiLnRes {
    static constexpr bool PERM = false, AFTER_DRAIN = true;
    const float* base; float* out; int ldc; const float* bias; PanelStats st; unsigned poison;
    __device__ __forceinline__ void fused(f32x4 (&acc)[2][2][4][2], const Unit& u, int wr, int wc, int fr, int fq, PG8_LAS unsigned char* lds, int wid, int lane) const {
        typedef float f32x2v __attribute__((ext_vector_type(2)));
        const PG8_LAS f32x2v* S = (const PG8_LAS f32x2v*)(lds + 8192);
        const int col0 = u.pn * BM + wc * 32 + 4 * fq;
#pragma unroll
        for (int bj = 0; bj < 2; ++bj)
#pragma unroll
            for (int n = 0; n < 2; ++n) { const f32x4 bv = bias ? *(const f32x4*)(bias + col0 + bj * HALF + n * 16) : (f32x4){0.f, 0.f, 0.f, 0.f};
#pragma unroll
                for (int ai = 0; ai < 2; ++ai)
#pragma unroll
                    for (int m = 0; m < 4; ++m) acc[ai][bj][m][n] += bv; }
        f32x4 pre[4][2][2];
#pragma unroll
        for (int m = 0; m < 4; ++m) { const size_t off = (size_t)(u.pm * BM + wr * 64 + m * 16 + fr) * ldc + col0;
#pragma unroll
            for (int bj = 0; bj < 2; ++bj)
#pragma unroll
                for (int n = 0; n < 2; ++n) pre[m][bj][n] = *(const f32x4*)(base + off + bj * HALF + n * 16); }
        const bool bad = st.run(acc, u, wr, wc, fr, fq, lds, wid, lane) || poison != 0u;
        const float qnan = __builtin_nanf("");
#pragma unroll
        for (int ai = 0; ai < 2; ++ai)
#pragma unroll
            for (int m = 0; m < 4; ++m) { const int r = ai * HALF + wr * 64 + m * 16 + fr; const f32x2v sr = S[r]; const size_t off = (size_t)(u.pm * BM + r) * ldc + col0;
#pragma unroll
                for (int bj = 0; bj < 2; ++bj)
#pragma unroll
                    for (int n = 0; n < 2; ++n) { const f32x4 bs = ai == 0 ? pre[m][bj][n] : *(const f32x4*)(base + off + bj * HALF + n * 16); f32x4 o = bs + (acc[ai][bj][m][n] - sr.x) * sr.y;
                        if (bad) o = (f32x4){qnan, qnan, qnan, qnan}; *(f32x4*)(out + off + bj * HALF + n * 16) = o; }
                if (m & 1) asm volatile("" ::: "memory"); }
    }
};
struct EpiLnResLn {
    static constexpr bool PERM = false, AFTER_DRAIN = true;
    const float* base; float* out; bf16_t* xn; int ldc; const float* bias; PanelStats st1, st2; unsigned poison;
    __device__ __forceinline__ void fused(f32x4 (&acc)[2][2][4][2], const Unit& u, int wr, int wc, int fr, int fq, PG8_LAS unsigned char* lds, int wid, int lane) const {
        typedef float f32x2v __attribute__((ext_vector_type(2))); typedef unsigned u32x2v __attribute__((ext_vector_type(2)));
        const PG8_LAS f32x2v* S = (const PG8_LAS f32x2v*)(lds + 8192);
        const int col0 = u.pn * BM + wc * 32 + 4 * fq;
#pragma unroll
        for (int bj = 0; bj < 2; ++bj)
#pragma unroll
            for (int n = 0; n < 2; ++n) { const f32x4 bv = bias ? *(const f32x4*)(bias + col0 + bj * HALF + n * 16) : (f32x4){0.f, 0.f, 0.f, 0.f};
#pragma unroll
                for (int ai = 0; ai < 2; ++ai)
#pragma unroll
                    for (int m = 0; m < 4; ++m) acc[ai][bj][m][n] += bv; }
        bool bad = st1.run(acc, u, wr, wc, fr, fq, lds, wid, lane) || poison != 0u;
        const float qnan = __builtin_nanf("");
#pragma unroll
        for (int ai = 0; ai < 2; ++ai)
#pragma unroll
            for (int m = 0; m < 4; ++m) { const int r = ai * HALF + wr * 64 + m * 16 + fr; const f32x2v sr = S[r]; const size_t off = (size_t)(u.pm * BM + r) * ldc + col0;
#pragma unroll
                for (int bj = 0; bj < 2; ++bj)
#pragma unroll
                    for (int n = 0; n < 2; ++n) { const f32x4 bs = *(const f32x4*)(base + off + bj * HALF + n * 16); acc[ai][bj][m][n] = bs + (acc[ai][bj][m][n] - sr.x) * sr.y; }
                asm volatile("" : "+v"(acc[ai][0][m][0]), "+v"(acc[ai][0][m][1]), "+v"(acc[ai][1][m][0]), "+v"(acc[ai][1][m][1]));
                if (m & 1) asm volatile("" ::: "memory"); }
        const bool bad1 = bad;
        bad = st2.run(acc, u, wr, wc, fr, fq, lds, wid, lane) || bad;
#pragma unroll
        for (int ai = 0; ai < 2; ++ai)
#pragma unroll
            for (int m = 0; m < 4; ++m) { const int r = ai * HALF + wr * 64 + m * 16 + fr; const f32x2v sr = S[r]; const size_t off = (size_t)(u.pm * BM + r) * ldc + col0;
#pragma unroll
                for (int bj = 0; bj < 2; ++bj)
#pragma unroll
                    for (int n = 0; n < 2; ++n) { const f32x4 x1 = acc[ai][bj][m][n]; *(f32x4*)(out + off + bj * HALF + n * 16) = bad1 ? (f32x4){qnan, qnan, qnan, qnan} : x1;
                        const f32x4 o = (x1 - sr.x) * sr.y; u32x2v w; w.x = cvt_pk_bf16(o[0], o[1]); w.y = cvt_pk_bf16(o[2], o[3]);
                        if (bad) { w.x = 0x7fc07fc0u; w.y = 0x7fc07fc0u; } *(u32x2v*)(xn + off + bj * HALF + n * 16) = w; }
                asm volatile("" ::: "memory"); }
    }
};

template <class Epi, class Sched, bool ALIGN_EPI = false, bool SP2 = false>
__device__ __forceinline__ void gemm_phase(PG8_LAS unsigned char* lds, const Gemm g, const Sched& S, const Epi& E, int tid_in) {
    int tid_l = tid_in; asm volatile("" : "+v"(tid_l));
    const int tid = tid_l, wid = __builtin_amdgcn_readfirstlane(tid >> 6), lane = tid & 63, wr = wid >> 2, wc = wid & 3, fr = lane & 15, fq = lane >> 4;
    int K_l = g.K; asm volatile("" : "+s"(K_l));
    const int K = K_l, nt = K / BK;
    unsigned voffA[2], voffB[2];
#pragma unroll
    for (int i = 0; i < 2; ++i) { int R, C; stage_rc(tid * 16 + i * 8192, R, C); const int Rb = Epi::PERM ? ((R & ~31) + perm32(R & 31)) : R;
        voffA[i] = (unsigned)(R * K + C) * 2u; voffB[i] = (unsigned)(Rb * K + C) * 2u; }
    const size_t kstep = (size_t)(BK * 2);
    const size_t hstep = (size_t)HALF * K * 2;
    const size_t tstep = 2 * hstep;
    const unsigned ldsw = (unsigned)wid * 1024u;
    const int aoff = lds_byte(wr * 64 + fr, fq * 8), boff = lds_byte(wc * 32 + fr, fq * 8);
#define PG8_SA(b, h) (((b) * 2 + (h)) * HTB)
#define PG8_SB(b, h) ((4 + (b) * 2 + (h)) * HTB)
#define PG8_STAGE(bufoff, gbase, voff) do { _Pragma("unroll") for (int _i = 0; _i < 2; ++_i) \
        __builtin_amdgcn_global_load_lds((const unsigned*)((const char*)(gbase) + (voff)[_i]), (PG8_LAS unsigned*)(lds + (bufoff) + ldsw + _i * 8192), 16, 0, 0); } while (0)
#define PG8_LDA(dst, b, h) do { _Pragma("unroll") for (int m = 0; m < 4; ++m) _Pragma("unroll") for (int k = 0; k < 2; ++k) dst[m][k] = *(const PG8_LAS bf16x8*)(lds + PG8_SA(b, h) + aoff + m * 2048 + k * 1024); } while (0)
#define PG8_LDB(dst, b, h) do { _Pragma("unroll") for (int n = 0; n < 2; ++n) _Pragma("unroll") for (int k = 0; k < 2; ++k) dst[n][k] = *(const PG8_LAS bf16x8*)(lds + PG8_SB(b, h) + boff + n * 2048 + k * 1024); } while (0)
#define PG8_MMA(ai, bj, At, Bt) do { __builtin_amdgcn_s_setprio(1); _Pragma("unroll") for (int m = 0; m < 4; ++m) _Pragma("unroll") for (int n = 0; n < 2; ++n) _Pragma("unroll") for (int k = 0; k < 2; ++k) \
        acc[ai][bj][m][n] = __builtin_amdgcn_mfma_f32_16x16x32_bf16(Bt[n][k], At[m][k], acc[ai][bj][m][n], 0, 0, 0); __builtin_amdgcn_s_setprio(0); } while (0)
#define PG8_WAIT_V(n) asm volatile("s_waitcnt vmcnt(" #n ")" ::: "memory")
#define PG8_WAIT_L(n) asm volatile("s_waitcnt lgkmcnt(" #n ")" ::: "memory")
#define PG8_BAR __builtin_amdgcn_s_barrier()
#define PG8_SCHED __builtin_amdgcn_sched_barrier(0)
    Unit cur, nxt; int ui = 0;
    if (!S.next(0, cur)) return;
    f32x4 acc[2][2][4][2];
#pragma unroll
    for (int a = 0; a < 2; ++a)
#pragma unroll
        for (int b = 0; b < 2; ++b)
#pragma unroll
            for (int m = 0; m < 4; ++m)
#pragma unroll
                for (int n = 0; n < 2; ++n) acc[a][b][m][n] = (f32x4){0.f, 0.f, 0.f, 0.f};
    bf16x8 At[4][2], B0[2][2], B1[2][2];
    const char* cA = (const char*)g.A + (size_t)cur.pm * tstep; const char* cB = (const char*)g.Bt + (size_t)cur.pn * tstep;
    S.a_ready(cur);
    if constexpr (SP2) {
        PG8_STAGE(PG8_SB(0, 0), cB, voffB); PG8_STAGE(PG8_SB(0, 1), cB + hstep, voffB); PG8_STAGE(PG8_SA(0, 0), cA, voffA); PG8_STAGE(PG8_SA(0, 1), cA + hstep, voffA);
        if (wr == 1) PG8_BAR;
        PG8_WAIT_V(2); PG8_BAR;
        PG8_STAGE(PG8_SB(1, 0), cB + kstep, voffB); PG8_STAGE(PG8_SA(1, 0), cA + kstep, voffA); PG8_STAGE(PG8_SB(1, 1), cB + hstep + kstep, voffB);
        PG8_WAIT_V(6); PG8_BAR;
    } else {
        PG8_STAGE(PG8_SB(0, 0), cB, voffB); PG8_STAGE(PG8_SA(0, 0), cA, voffA); PG8_STAGE(PG8_SB(0, 1), cB + hstep, voffB); PG8_STAGE(PG8_SA(0, 1), cA + hstep, voffA);
        if (wr == 1) PG8_BAR;
        PG8_WAIT_V(4); PG8_BAR;
        PG8_STAGE(PG8_SB(1, 0), cB + kstep, voffB); PG8_STAGE(PG8_SA(1, 0), cA + kstep, voffA); PG8_STAGE(PG8_SB(1, 1), cB + hstep + kstep, voffB);
        PG8_WAIT_V(6); PG8_BAR;
    }
    for (;;) {
        const bool has_next = S.next(ui + 1, nxt);
        const char* nA = has_next ? (const char*)g.A + (size_t)nxt.pm * tstep : cA; const char* nB = has_next ? (const char*)g.Bt + (size_t)nxt.pn * tstep : cB;
        for (int t = 0; t < nt; t += 2) {
            const bool last = (t == nt - 2);
            const char* a1 = cA + (size_t)(t + 1) * kstep;
            const char* a2 = last ? nA : cA + (size_t)(t + 2) * kstep; const char* b2 = last ? nB : cB + (size_t)(t + 2) * kstep;
            const char* a3 = a2 + kstep; const char* b3 = b2 + kstep;
            if (last && has_next) S.a_ready(nxt);
            if constexpr (SP2) {
            PG8_LDB(B0, 0, 0); PG8_LDB(B1, 0, 1); PG8_SCHED; PG8_LDA(At, 0, 0); PG8_STAGE(PG8_SA(1, 1), a1 + hstep, voffA);
            PG8_WAIT_V(8); PG8_WAIT_L(0); PG8_BAR; PG8_MMA(0, 0, At, B0); PG8_MMA(0, 1, At, B1); PG8_BAR; PG8_SCHED;
            PG8_LDA(At, 0, 1); PG8_STAGE(PG8_SB(0, 0), b2, voffB); PG8_STAGE(PG8_SB(0, 1), b2 + hstep, voffB); PG8_STAGE(PG8_SA(0, 0), a2, voffA);
            PG8_WAIT_V(8); PG8_WAIT_L(0); PG8_BAR; PG8_MMA(1, 0, At, B0); PG8_MMA(1, 1, At, B1); PG8_BAR; PG8_SCHED;
            PG8_LDB(B0, 1, 0); PG8_LDB(B1, 1, 1); PG8_SCHED; PG8_LDA(At, 1, 0); PG8_STAGE(PG8_SA(0, 1), a2 + hstep, voffA);
            PG8_WAIT_V(8); PG8_WAIT_L(0); PG8_BAR; PG8_MMA(0, 0, At, B0); PG8_MMA(0, 1, At, B1); PG8_BAR; PG8_SCHED;
            PG8_LDA(At, 1, 1); PG8_STAGE(PG8_SB(1, 0), b3, voffB); PG8_STAGE(PG8_SB(1, 1), b3 + hstep, voffB); PG8_STAGE(PG8_SA(1, 0), a3, voffA);
            PG8_WAIT_V(8); PG8_WAIT_L(0); PG8_BAR; PG8_MMA(1, 0, At, B0); PG8_MMA(1, 1, At, B1); PG8_BAR; PG8_SCHED;
            } else {
            PG8_LDB(B0, 0, 0); PG8_SCHED; PG8_LDA(At, 0, 0); PG8_STAGE(PG8_SA(1, 1), a1 + hstep, voffA);
            PG8_WAIT_L(8); PG8_BAR; PG8_WAIT_L(0); PG8_MMA(0, 0, At, B0); PG8_BAR; PG8_SCHED;
            PG8_LDB(B1, 0, 1); PG8_STAGE(PG8_SB(0, 0), b2, voffB);
            PG8_BAR; PG8_WAIT_L(0); PG8_MMA(0, 1, At, B1); PG8_BAR;
            PG8_LDA(At, 0, 1); PG8_STAGE(PG8_SA(0, 0), a2, voffA);
            PG8_BAR; PG8_WAIT_L(0); PG8_MMA(1, 0, At, B0); PG8_BAR; PG8_SCHED;
            PG8_STAGE(PG8_SB(0, 1), b2 + hstep, voffB);
            PG8_WAIT_V(6); PG8_BAR; PG8_MMA(1, 1, At, B1); PG8_BAR;
            PG8_LDB(B0, 1, 0); PG8_SCHED; PG8_LDA(At, 1, 0); PG8_STAGE(PG8_SA(0, 1), a2 + hstep, voffA);
            PG8_WAIT_L(8); PG8_BAR; PG8_WAIT_L(0); PG8_MMA(0, 0, At, B0); PG8_BAR; PG8_SCHED;
            PG8_LDB(B1, 1, 1); PG8_STAGE(PG8_SB(1, 0), b3, voffB);
            PG8_BAR; PG8_WAIT_L(0); PG8_MMA(0, 1, At, B1); PG8_BAR;
            PG8_LDA(At, 1, 1); PG8_STAGE(PG8_SA(1, 0), a3, voffA);
            PG8_BAR; PG8_WAIT_L(0); PG8_MMA(1, 0, At, B0); PG8_BAR; PG8_SCHED;
            PG8_STAGE(PG8_SB(1, 1), b3 + hstep, voffB);
            PG8_WAIT_V(6); PG8_BAR; PG8_MMA(1, 1, At, B1); PG8_BAR;
            }
        }
        if constexpr (ALIGN_EPI) { if (wr == 0) PG8_BAR; }
        if constexpr (!Epi::AFTER_DRAIN) { E(acc, cur, wr, wc, fr, fq); S.done(cur); }
        if (!has_next) break;
#pragma unroll
        for (int a = 0; a < 2; ++a)
#pragma unroll
            for (int b = 0; b < 2; ++b)
#pragma unroll
                for (int m = 0; m < 4; ++m)
#pragma unroll
                    for (int n = 0; n < 2; ++n) acc[a][b][m][n] = (f32x4){0.f, 0.f, 0.f, 0.f};
        cur = nxt; cA = nA; cB = nB; ++ui;
        if constexpr (ALIGN_EPI) { if (wr == 1) PG8_BAR; }
    }
    PG8_WAIT_V(0);
    if constexpr (!ALIGN_EPI) { if (wr == 0) PG8_BAR; }
    PG8_BAR;
    if constexpr (Epi::AFTER_DRAIN) { E.fused(acc, cur, wr, wc, fr, fq, lds, wid, lane); S.done(cur); }
#undef PG8_SA
#undef PG8_SB
#undef PG8_STAGE
#undef PG8_LDA
#undef PG8_LDB
#undef PG8_MMA
#undef PG8_WAIT_V
#undef PG8_WAIT_L
#undef PG8_BAR
#undef PG8_SCHED
}
}

typedef unsigned short bf16;
typedef float f32x4 __attribute__((ext_vector_type(4)));
typedef unsigned u32x4 __attribute__((ext_vector_type(4)));
typedef unsigned u32x2 __attribute__((ext_vector_type(2)));

constexpr int BATCH = 8, SEQ = 4096, T = BATCH * SEQ, D = 1024, DEPTH = 2;
constexpr int NA = 2048, NB = 3328, NIN = NA + NB, INW = 5204;
constexpr int DFF = 2816, NGU = 2 * DFF, PLE = 256, MIXW = 2048;
constexpr int A_Q = 0, A_BG = 512, A_Z = 1024;
constexpr int B_CKV = 0, B_IQ = 256, B_CG = 512, B_HB = 1024, B_XBC = 1536, B_IK = 3072, B_DT = 3136, B_IW = 3152;
constexpr int XBC = 1536, KV_R = 256, TOPK = 256;
constexpr float EPS = 1e-6f;

constexpr size_t MiB = 1u << 20;
constexpr size_t WS_CTL = 0;
constexpr size_t WS_RSTD = 1 * MiB;
constexpr size_t WS_RSTD2 = 1 * MiB + 256 * 1024;
constexpr size_t WS_DT = 2 * MiB;
constexpr size_t WS_W = 8 * MiB;
constexpr size_t WS_W_IN = WS_W, WS_W_OUT = WS_W_IN + (size_t)NIN * D * 2, WS_W_GU = WS_W_OUT + (size_t)D * MIXW * 2, WS_W_DOWN = WS_W_GU + (size_t)NGU * D * 2,
                 WS_W_PG = WS_W_DOWN + (size_t)D * DFF * 2, WS_W_PP = WS_W_PG + (size_t)D * D * 2, WS_W_END = WS_W_PP + (size_t)D * PLE * 2;
constexpr size_t WS_WUK = 42 * MiB, WS_WUV = 43 * MiB;
static_assert(WS_W_END <= 42 * MiB, "weights");
constexpr size_t WS_X0 = 44 * MiB, WS_X1 = 108 * MiB, WS_RA = 172 * MiB, WS_RB = 300 * MiB, WS_DT2 = 508 * MiB, WS_END = 512 * MiB;
constexpr size_t WS_XA = WS_X0;
constexpr size_t WS_IDX = WS_X1 + 48 * MiB;
constexpr size_t WS_CKVC = WS_X1 + 32 * MiB;
constexpr size_t WS_IKC = 4 * MiB;

__host__ __device__ __forceinline__ float bf2f(bf16 b) { return __builtin_bit_cast(float, ((unsigned)b) << 16); }
__host__ __device__ __forceinline__ bf16 f2bf(float f) { unsigned u = __builtin_bit_cast(unsigned, f); return (bf16)((u + 0x7fffu + ((u >> 16) & 1u)) >> 16); }
__device__ __forceinline__ unsigned pk2(float lo, float hi) { return (unsigned)f2bf(lo) | ((unsigned)f2bf(hi) << 16); }
__device__ __forceinline__ float wave_sum(float v) {
#pragma unroll
    for (int o = 1; o < 64; o <<= 1) v += __shfl_xor(v, o);
    return v;
}
__device__ __forceinline__ float wave_max(float v) {
#pragma unroll
    for (int o = 1; o < 64; o <<= 1) v = fmaxf(v, __shfl_xor(v, o));
    return v;
}
__device__ __forceinline__ float sigmoidf_(float v) { return __builtin_amdgcn_rcpf(1.0f + __expf(-v)); }
__device__ __forceinline__ float siluf_(float v) { return v * sigmoidf_(v); }

__host__ __device__ __forceinline__ int src_col_in(int n) {
    if (n < 512) return n;
    if (n < 1024) return 1092 + (n - 512);
    if (n < 2048) return 2628 + (n - 1024);
    n -= 2048;
    if (n < 256) return 512 + n;
    if (n < 512) return 768 + (n - 256);
    if (n < 1024) return 1604 + (n - 512);
    if (n < 1536) return 2116 + (n - 1024);
    if (n < 3072) return 3652 + (n - 1536);
    if (n < 3136) return 1024 + (n - 3072);
    if (n < 3152) return 5188 + (n - 3136);
    if (n < 3156) return 1088 + (n - 3152);
    return -1;
}

__host__ __device__ __forceinline__ int t5_bucket(int rel) {
    const int ret = rel > 0 ? 16 : 0; const int n = rel < 0 ? -rel : rel;
    int b;
    if (n < 8) b = n; else if (n < 15) b = 8; else if (n < 27) b = 9; else if (n < 50) b = 10; else if (n < 91) b = 11; else if (n < 166) b = 12; else if (n < 305) b = 13; else if (n < 559) b = 14; else b = 15;
    return ret + b;
}

template <int MODE> __global__ void __launch_bounds__(256) k_prep_w(const float* __restrict__ W, const float* __restrict__ W2, int K, int Nsrc, const float* __restrict__ gain, bf16* __restrict__ Wt) {
    __shared__ float tile[32][33];
    const int n0 = blockIdx.x * 32, k0 = blockIdx.y * 32, tx = threadIdx.x & 31, ty = threadIdx.x >> 5;
    const int n = n0 + tx; int src; const float* Ws = W;
    if (MODE == 0) src = n; else if (MODE == 1) src = src_col_in(n); else { const int which = (n & 255) >> 7; src = (n >> 8) * 128 + (n & 127); Ws = which ? W2 : W; }
    for (int kk = ty; kk < 32; kk += 8) { float v = 0.f; if (src >= 0) { v = Ws[(size_t)(k0 + kk) * Nsrc + src]; if (gain) v *= gain[k0 + kk]; } tile[kk][tx] = v; }
    __syncthreads();
    for (int nn = ty; nn < 32; nn += 8) Wt[(size_t)(n0 + nn) * K + k0 + tx] = f2bf(tile[tx][nn]);
}

__global__ void __launch_bounds__(256) k_x_prep(const float* __restrict__ x, bf16* __restrict__ xb, float* __restrict__ rstd) {
    const int lane = threadIdx.x & 63, row = blockIdx.x * 4 + (threadIdx.x >> 6);
    const f32x4* xr = (const f32x4*)(x + (size_t)row * D) + lane; float ss = 0.f; f32x4 v[4];
#pragma unroll
    for (int j = 0; j < 4; ++j) { v[j] = xr[64 * j]; ss += (v[j].x * v[j].x + v[j].y * v[j].y) + (v[j].z * v[j].z + v[j].w * v[j].w); }
    ss = wave_sum(ss);
    u32x2* o = (u32x2*)(xb + (size_t)row * D) + lane;
#pragma unroll
    for (int j = 0; j < 4; ++j) { u32x2 w; w.x = pk2(v[j].x, v[j].y); w.y = pk2(v[j].z, v[j].w); o[64 * j] = w; }
    if (lane == 0) rstd[row] = 1.0f / sqrtf(ss * (1.0f / D) + EPS);
}
__global__ void __launch_bounds__(256) k_rstd(const float* __restrict__ x, float* __restrict__ rstd) {
    const int lane = threadIdx.x & 63, row = blockIdx.x * 4 + (threadIdx.x >> 6);
    const f32x4* xr = (const f32x4*)(x + (size_t)row * D) + lane; float ss = 0.f;
#pragma unroll
    for (int j = 0; j < 4; ++j) { const f32x4 v = xr[64 * j]; ss += (v.x * v.x + v.y * v.y) + (v.z * v.z + v.w * v.w); }
    ss = wave_sum(ss);
    if (lane == 0) rstd[row] = 1.0f / sqrtf(ss * (1.0f / D) + EPS);
}
__global__ void __launch_bounds__(256) k_resid_norm(const float* xin, const float* __restrict__ y, const float* __restrict__ g, float* xo, bf16* __restrict__ xb,
                                                    float* __restrict__ rstd_out, const float* __restrict__ p, bf16* __restrict__ pb) {
    const int lane = threadIdx.x & 63, row = blockIdx.x * 4 + (threadIdx.x >> 6);
    const f32x4* yr = (const f32x4*)(y + (size_t)row * D) + lane; const f32x4* xr = (const f32x4*)(xin + (size_t)row * D) + lane; const f32x4* gr = (const f32x4*)g + lane;
    f32x4 v[4]; float ss = 0.f;
#pragma unroll
    for (int j = 0; j < 4; ++j) { v[j] = yr[64 * j]; ss += (v[j].x * v[j].x + v[j].y * v[j].y) + (v[j].z * v[j].z + v[j].w * v[j].w); }
    const float r = 1.0f / sqrtf(wave_sum(ss) * (1.0f / D) + EPS);
    float s2 = 0.f;
    f32x4* xor_ = (f32x4*)(xo + (size_t)row * D) + lane; u32x2* o = (u32x2*)(xb + (size_t)row * D) + lane;
#pragma unroll
    for (int j = 0; j < 4; ++j) { const f32x4 xx = xr[64 * j], gg = gr[64 * j]; f32x4 w = xx + v[j] * r * gg; xor_[64 * j] = w; s2 += (w.x * w.x + w.y * w.y) + (w.z * w.z + w.w * w.w);
        u32x2 q; q.x = pk2(w.x, w.y); q.y = pk2(w.z, w.w); o[64 * j] = q; }
    if (rstd_out) { s2 = wave_sum(s2); if (lane == 0) rstd_out[row] = 1.0f / sqrtf(s2 * (1.0f / D) + EPS); }
    if (p) { const f32x4 pv = *((const f32x4*)(p + (size_t)row * PLE) + lane); u32x2 q; q.x = pk2(pv.x, pv.y); q.y = pk2(pv.z, pv.w); *((u32x2*)(pb + (size_t)row * PLE) + lane) = q; }
}

namespace pg8 {
struct EpiProj {
    static constexpr bool PERM = true, AFTER_DRAIN = false;
    bf16_t* RA; bf16_t* RB; const float* rstd;
    __device__ __forceinline__ void operator()(const f32x4 (&acc)[2][2][4][2], const Unit& u, int wr, int wc, int fr, int fq) const {
        const int row0 = u.pm * BM + wr * 64 + fr; bf16_t* base; int ld, colt;
        if (u.pn < NA / 256) { base = RA; ld = NA; colt = u.pn * BM; } else { base = RB; ld = NB; colt = (u.pn - NA / 256) * BM; }
        const int col0 = colt + wc * 32 + 8 * fq;
        float sr[2][4];
#pragma unroll
        for (int ai = 0; ai < 2; ++ai)
#pragma unroll
            for (int m = 0; m < 4; ++m) sr[ai][m] = rstd[row0 + ai * HALF + m * 16];
#pragma unroll
        for (int ai = 0; ai < 2; ++ai)
#pragma unroll
            for (int m = 0; m < 4; ++m) { const int r = row0 + ai * HALF + m * 16; const float s = sr[ai][m]; bf16_t* rowp = base + (size_t)r * ld + col0;
#pragma unroll
                for (int bj = 0; bj < 2; ++bj) { const f32x4 v0 = acc[ai][bj][m][0] * s, v1 = acc[ai][bj][m][1] * s;
                    u32x4 w; w.x = cvt_pk_bf16(v0[0], v0[1]); w.y = cvt_pk_bf16(v0[2], v0[3]); w.z = cvt_pk_bf16(v1[0], v1[1]); w.w = cvt_pk_bf16(v1[2], v1[3]);
                    *(u32x4*)(rowp + bj * HALF) = w; } }
    }
};
struct EpiF32 {
    static constexpr bool PERM = false, AFTER_DRAIN = false;
    float* C; long ldc;
    __device__ __forceinline__ void operator()(const f32x4 (&acc)[2][2][4][2], const Unit& u, int wr, int wc, int fr, int fq) const {
        const int row0 = u.pm * BM + wr * 64 + fr, col0 = u.pn * BM + wc * 32 + 4 * fq;
#pragma unroll
        for (int ai = 0; ai < 2; ++ai)
#pragma unroll
            for (int m = 0; m < 4; ++m) { float* rowp = C + (size_t)(row0 + ai * HALF + m * 16) * ldc + col0;
#pragma unroll
                for (int bj = 0; bj < 2; ++bj)
#pragma unroll
                    for (int n = 0; n < 2; ++n) *(f32x4*)(rowp + bj * HALF + n * 16) = acc[ai][bj][m][n]; }
    }
};
struct EpiBf16P {
    static constexpr bool PERM = true, AFTER_DRAIN = false;
    bf16_t* O; long ldc;
    __device__ __forceinline__ void operator()(const f32x4 (&acc)[2][2][4][2], const Unit& u, int wr, int wc, int fr, int fq) const {
        const int row0 = u.pm * BM + wr * 64 + fr, col0 = u.pn * BM + wc * 32 + 8 * fq;
#pragma unroll
        for (int ai = 0; ai < 2; ++ai)
#pragma unroll
            for (int m = 0; m < 4; ++m) { bf16_t* rowp = O + (size_t)(row0 + ai * HALF + m * 16) * ldc + col0;
#pragma unroll
                for (int bj = 0; bj < 2; ++bj) { const f32x4 v0 = acc[ai][bj][m][0], v1 = acc[ai][bj][m][1];
                    u32x4 w; w.x = cvt_pk_bf16(v0[0], v0[1]); w.y = cvt_pk_bf16(v0[2], v0[3]); w.z = cvt_pk_bf16(v1[0], v1[1]); w.w = cvt_pk_bf16(v1[2], v1[3]);
                    *(u32x4*)(rowp + bj * HALF) = w; } }
    }
};
struct EpiSwiGLU {
    static constexpr bool PERM = true, AFTER_DRAIN = false;
    bf16_t* G; const float* rstd;
    __device__ __forceinline__ void operator()(const f32x4 (&acc)[2][2][4][2], const Unit& u, int wr, int wc, int fr, int fq) const {
        const int row0 = u.pm * BM + wr * 64 + fr, col0 = u.pn * HALF + wc * 32 + 8 * fq;
        float sr[2][4];
#pragma unroll
        for (int ai = 0; ai < 2; ++ai)
#pragma unroll
            for (int m = 0; m < 4; ++m) sr[ai][m] = rstd[row0 + ai * HALF + m * 16];
#pragma unroll
        for (int ai = 0; ai < 2; ++ai)
#pragma unroll
            for (int m = 0; m < 4; ++m) { const int r = row0 + ai * HALF + m * 16; const float s = sr[ai][m]; float o[8];
#pragma unroll
                for (int n = 0; n < 2; ++n)
#pragma unroll
                    for (int j = 0; j < 4; ++j) { const float gt = acc[ai][0][m][n][j] * s, up = acc[ai][1][m][n][j] * s; o[n * 4 + j] = gt * __builtin_amdgcn_rcpf(1.0f + __expf(-gt)) * up; }
                u32x4 w; w.x = cvt_pk_bf16(o[0], o[1]); w.y = cvt_pk_bf16(o[2], o[3]); w.z = cvt_pk_bf16(o[4], o[5]); w.w = cvt_pk_bf16(o[6], o[7]);
                *(u32x4*)(G + (size_t)r * DFF + col0) = w; }
    }
};
struct EpiPle {
    static constexpr bool PERM = true, AFTER_DRAIN = false;
    const bf16_t* X; const bf16_t* Tt; bf16_t* XB; float* OUT;
    __device__ __forceinline__ void operator()(const f32x4 (&acc)[2][2][4][2], const Unit& u, int wr, int wc, int fr, int fq) const {
        const int row0 = u.pm * BM + wr * 64 + fr, col0 = u.pn * BM + wc * 32 + 8 * fq;
        u32x4 tv[2][2], xv[2][2];
#define PLE_LOAD(slot, grp) do { const size_t off_ = (size_t)(row0 + ((grp) >> 2) * HALF + ((grp) & 3) * 16) * D + col0; _Pragma("unroll") for (int bj_ = 0; bj_ < 2; ++bj_) { \
            tv[slot][bj_] = *(const u32x4*)(Tt + off_ + bj_ * HALF); xv[slot][bj_] = *(const u32x4*)(X + off_ + bj_ * HALF); } } while (0)
        PLE_LOAD(0, 0);
#pragma unroll
        for (int grp = 0; grp < 8; ++grp) { const int ai = grp >> 2, m = grp & 3, sl = grp & 1; const size_t off = (size_t)(row0 + ai * HALF + m * 16) * D + col0;
            if (grp + 1 < 8) PLE_LOAD((grp + 1) & 1, grp + 1);
#pragma unroll
            for (int bj = 0; bj < 2; ++bj) { const unsigned tw[4] = {tv[sl][bj].x, tv[sl][bj].y, tv[sl][bj].z, tv[sl][bj].w}, xw[4] = {xv[sl][bj].x, xv[sl][bj].y, xv[sl][bj].z, xv[sl][bj].w}; f32x4 x0, x1;
#pragma unroll
                for (int j = 0; j < 4; ++j) { const float t0 = __builtin_bit_cast(float, (j & 1) ? (tw[j >> 1] & 0xffff0000u) : (tw[j >> 1] << 16));
                    const float t1 = __builtin_bit_cast(float, (j & 1) ? (tw[2 + (j >> 1)] & 0xffff0000u) : (tw[2 + (j >> 1)] << 16));
                    const float a0 = __builtin_bit_cast(float, (j & 1) ? (xw[j >> 1] & 0xffff0000u) : (xw[j >> 1] << 16));
                    const float a1 = __builtin_bit_cast(float, (j & 1) ? (xw[2 + (j >> 1)] & 0xffff0000u) : (xw[2 + (j >> 1)] << 16));
                    x0[j] = a0 + __builtin_amdgcn_rcpf(1.0f + __expf(-acc[ai][bj][m][0][j])) * t0; x1[j] = a1 + __builtin_amdgcn_rcpf(1.0f + __expf(-acc[ai][bj][m][1][j])) * t1; }
                if (OUT) { *(f32x4*)(OUT + off + bj * HALF) = x0; *(f32x4*)(OUT + off + bj * HALF + 4) = x1; }
                else { u32x4 w; w.x = cvt_pk_bf16(x0[0], x0[1]); w.y = cvt_pk_bf16(x0[2], x0[3]); w.z = cvt_pk_bf16(x1[0], x1[1]); w.w = cvt_pk_bf16(x1[2], x1[3]);
                    *(u32x4*)(XB + off + bj * HALF) = w; } } }
#undef PLE_LOAD
    }
};
}

__device__ __forceinline__ unsigned ord_key(float f) { const unsigned u = __builtin_bit_cast(unsigned, f); return (u & 0x80000000u) ? ~u : (u | 0x80000000u); }
#define LAS __attribute__((address_space(3)))
#define XB_TMO      128
#define XB_XCNT(j)  (256  + 64 * (j))
#define XB_XSUB(j)  (1280 + 64 * (j))
#define XB_XGEN(j)  (2304 + 64 * (j))
#define XB_TOP      3328
#define XB_TOPGEN   3392
#define XCD_BAR_WORDS 3456
#define XB_SPIN_CAP (1u << 18)

__device__ __forceinline__ unsigned xb_ld(unsigned* p)              { return __hip_atomic_load(p, __ATOMIC_RELAXED, __HIP_MEMORY_SCOPE_AGENT); }
__device__ __forceinline__ unsigned xb_add(unsigned* p, unsigned v) { return __hip_atomic_fetch_add(p, v, __ATOMIC_RELAXED, __HIP_MEMORY_SCOPE_AGENT); }
__device__ __forceinline__ unsigned xb_xcc_id() { return (unsigned)__builtin_amdgcn_s_getreg((3 << 11) | 20) & 0xFu; }
#define XB_SPIN(cond, bar) do { unsigned _sp = 0; while (cond) { __builtin_amdgcn_s_sleep(1); \
    if ((++_sp & 255u) == 0u) { if (xb_ld(&(bar)[XB_TMO])) break; if (_sp > XB_SPIN_CAP) { atomicAdd(&(bar)[XB_TMO], 1u); break; } } } } while (0)

struct XcdBarrier {
    unsigned* bar; unsigned x;
    volatile LAS unsigned* st;
};

__device__ __forceinline__ XcdBarrier xcd_barrier_post(unsigned* bar, volatile LAS unsigned* st) {
    XcdBarrier b; b.bar = bar; b.x = xb_xcc_id(); b.st = st;
    if (threadIdx.x == 0) (void)xb_add(&bar[XB_XCNT(b.x)], 1u);
    return b;
}
__device__ __forceinline__ void xcd_barrier_complete(unsigned* bar, unsigned x, unsigned& nloc, unsigned& nx) {
    const unsigned G = gridDim.x * gridDim.y * gridDim.z;
    unsigned sum, cnt, mine, sp = 0u;
    for (;;) {
        sum = 0u; cnt = 0u; mine = 0u;
#pragma unroll
        for (unsigned j = 0; j < 16; ++j) { const unsigned c = xb_ld(&bar[XB_XCNT(j)]); sum += c; cnt += (c > 0u) ? 1u : 0u; mine = (j == x) ? c : mine; }
        if (sum == G) break;
        __builtin_amdgcn_s_sleep(1);
        if ((++sp & 255u) == 0u) { if (xb_ld(&bar[XB_TMO])) break; if (sp > XB_SPIN_CAP) { atomicAdd(&bar[XB_TMO], 1u); break; } }
    }
    nloc = mine > 0u ? mine : 1u; nx = cnt > 0u ? cnt : 1u;
}

__device__ __forceinline__ void xcd_barrier(const XcdBarrier& b, int tid_in) {
    asm volatile("s_waitcnt vmcnt(0)" ::: "memory");
    __syncthreads();
    if (tid_in == 0) {
        unsigned* bar = b.bar;
        __builtin_amdgcn_s_waitcnt(0);
        unsigned nloc = b.st[0], nx = b.st[1];
        if (nloc == 0u) { xcd_barrier_complete(bar, b.x, nloc, nx); b.st[0] = nloc; b.st[1] = nx; }
        const unsigned old = xb_add(&bar[XB_XSUB(b.x)], 1u);
        const unsigned gen = old / nloc;
        if (old + 1u == (gen + 1u) * nloc) {
            __builtin_amdgcn_fence(__ATOMIC_RELEASE, "agent");
            asm volatile("s_waitcnt vmcnt(0)" ::: "memory");
            const unsigned og = xb_add(&bar[XB_TOP], 1u);
            const unsigned tg = og / nx;
            if (og + 1u == (tg + 1u) * nx) xb_add(&bar[XB_TOPGEN], 1u);
            else XB_SPIN(xb_ld(&bar[XB_TOPGEN]) == tg, bar);
            __builtin_amdgcn_fence(__ATOMIC_ACQUIRE, "agent");
            xb_add(&bar[XB_XGEN(b.x)], 1u);
            asm volatile("s_waitcnt vmcnt(0)" ::: "memory");
        } else {
            XB_SPIN(xb_ld(&bar[XB_XGEN(b.x)]) == gen, bar);
            __builtin_amdgcn_fence(__ATOMIC_ACQUIRE, "agent");
            asm volatile("s_waitcnt vmcnt(0)" ::: "memory");
        }
    }
    __syncthreads();
}


constexpr int NTHR = 512, NWAVES = 8;
constexpr int RING_BYTES = 131072, LDS_BYTES = 147456, MISC_OFF = LDS_BYTES - 512;
constexpr int CW_BAR = 4096, CW_RANK = 8192;
constexpr size_t CTL_ZERO_BYTES = 1 * MiB;
constexpr int NPH = 14;

__device__ __forceinline__ int mk_tid(int wave_s) { int l_; asm volatile("v_mbcnt_lo_u32_b32 %0, -1, 0\n\tv_mbcnt_hi_u32_b32 %0, -1, %0" : "=v"(l_)); return wave_s * 64 + l_; }
struct Params { const float* in[26]; float* out; unsigned char* ws; int ph_lo, ph_hi, dbl_mask, pad; };
static_assert(sizeof(Params) == 26 * 8 + 8 + 8 + 16, "no padding");

#define LDSP __attribute__((address_space(3)))
#define LDS_WAIT() asm volatile("s_waitcnt lgkmcnt(0)" ::: "memory")
#ifndef NAIVE_SELECT
#define NAIVE_SELECT 0
#endif
#ifndef NAIVE_ATTN
#define NAIVE_ATTN 0
#endif
#ifndef NAIVE_SSM
#define NAIVE_SSM 0
#endif
#ifndef DBG_SSM
#define DBG_SSM 0
#endif
#ifndef TIMING
#define TIMING 0
#endif
#ifndef DBL_MASK
#define DBL_MASK 0
#endif
#ifndef GEMM_DRYK
#define GEMM_DRYK 0
#endif
#ifndef CLK_PROBE
#define CLK_PROBE 0
#endif
#ifndef ATT_FN
#define ATT_FN wg_attn16d
#endif
#ifndef XTRA_BAR
#define XTRA_BAR 0
#endif
#ifndef ATT_SUB_V
#define ATT_SUB_V 0
#endif
#ifndef TIMING_SHIFT
#define TIMING_SHIFT 0.0f
#endif
#ifndef TIMING_A
#define TIMING_A 2
#endif
#ifndef TIMING_B
#define TIMING_B 3
#endif

template <int MODE> __device__ __forceinline__ void ph_prep_w(LDSP float* scr, const float* __restrict__ W, const float* __restrict__ W2, int K, int Nsrc, const float* __restrict__ gain, bf16* __restrict__ Wt, int Ndst, int gw, int NGW, int lane) {
    const int ntn = Ndst / 32, nt = ntn * (K / 64), tx = lane & 31, ty = lane >> 5;
    for (int it = gw; it < nt; it += NGW) {
        const int n0 = (it % ntn) * 32, k0 = (it / ntn) * 64, n = n0 + tx; int src; const float* Ws = W;
        if (MODE == 0) src = n; else if (MODE == 1) src = src_col_in(n); else { const int which = (n & 255) >> 7; src = (n >> 8) * 128 + (n & 127); Ws = which ? W2 : W; }
#pragma unroll 8
        for (int i = 0; i < 32; ++i) { const int kk = 2 * i + ty; float v = 0.f; if (src >= 0) { v = Ws[(size_t)(k0 + kk) * Nsrc + src]; if (gain) v *= gain[k0 + kk]; } scr[kk * 33 + tx] = v; }
        LDS_WAIT(); asm volatile("" ::: "memory");
        const int cc = lane & 7;
#pragma unroll
        for (int j = 0; j < 4; ++j) { const int nn = (lane >> 3) + 8 * j; const LDSP float* s = scr + (8 * cc) * 33 + nn;
            u32x4 o; o.x = pk2(s[0 * 33], s[1 * 33]); o.y = pk2(s[2 * 33], s[3 * 33]); o.z = pk2(s[4 * 33], s[5 * 33]); o.w = pk2(s[6 * 33], s[7 * 33]);
            *(u32x4*)(Wt + (size_t)(n0 + nn) * K + k0 + 8 * cc) = o; }
        LDS_WAIT(); asm volatile("" ::: "memory");
    }
}
__device__ __forceinline__ void row_x_prep(const float* __restrict__ x, bf16* __restrict__ xb, float* __restrict__ rstd, int row, int lane) {
    const f32x4* xr = (const f32x4*)(x + (size_t)row * D) + lane; float ss = 0.f; f32x4 v[4];
#pragma unroll
    for (int j = 0; j < 4; ++j) { v[j] = xr[64 * j]; ss += (v[j].x * v[j].x + v[j].y * v[j].y) + (v[j].z * v[j].z + v[j].w * v[j].w); }
    ss = wave_sum(ss);
    if (xb) { u32x2* o = (u32x2*)(xb + (size_t)row * D) + lane;
#pragma unroll
        for (int j = 0; j < 4; ++j) { u32x2 w; w.x = pk2(v[j].x, v[j].y); w.y = pk2(v[j].z, v[j].w); o[64 * j] = w; } }
    if (lane == 0) rstd[row] = 1.0f / sqrtf(ss * (1.0f / D) + EPS);
}
__device__ __forceinline__ void row_resid_norm(const float* xin, const float* __restrict__ y, const float* __restrict__ g, float* xo, bf16* __restrict__ xb, float* __restrict__ rstd_out, const float* __restrict__ p, bf16* __restrict__ pb, int row, int lane, bool dry = false) {
    const f32x4* yr = (const f32x4*)(y + (size_t)row * D) + lane; const f32x4* xr = (const f32x4*)(xin + (size_t)row * D) + lane; const f32x4* gr = (const f32x4*)g + lane;
    f32x4 v[4]; float ss = 0.f;
#pragma unroll
    for (int j = 0; j < 4; ++j) { v[j] = yr[64 * j]; ss += (v[j].x * v[j].x + v[j].y * v[j].y) + (v[j].z * v[j].z + v[j].w * v[j].w); }
    const float r = 1.0f / sqrtf(wave_sum(ss) * (1.0f / D) + EPS);
    float s2 = 0.f;
    f32x4* xor_ = (f32x4*)(xo + (size_t)row * D) + lane; u32x2* o = (u32x2*)(xb + (size_t)row * D) + lane;
#pragma unroll
    for (int j = 0; j < 4; ++j) { const f32x4 xx = xr[64 * j], gg = gr[64 * j]; f32x4 w = xx + v[j] * r * gg; if (!dry) xor_[64 * j] = w; s2 += (w.x * w.x + w.y * w.y) + (w.z * w.z + w.w * w.w);
        u32x2 q; q.x = pk2(w.x, w.y); q.y = pk2(w.z, w.w); o[64 * j] = q; }
    if (rstd_out) { s2 = wave_sum(s2); if (lane == 0) rstd_out[row] = 1.0f / sqrtf(s2 * (1.0f / D) + EPS); }
    if (p) { const f32x4 pv = *((const f32x4*)(p + (size_t)row * PLE) + lane); u32x2 q; q.x = pk2(pv.x, pv.y); q.y = pk2(pv.z, pv.w); *((u32x2*)(pb + (size_t)row * PLE) + lane) = q; }
}

__device__ __forceinline__ void row_resid_norm2(const bf16* xin, const bf16* __restrict__ y, const float* __restrict__ g, bf16* xo, float* __restrict__ rstd_out, const float* __restrict__ p, bf16* __restrict__ pb, int row0, int lane, bool dry = false) {
    f32x4 v[2][4], xx[2][4], pv[2]; const f32x4* gr = (const f32x4*)g + lane;
#pragma unroll
    for (int r = 0; r < 2; ++r) { const u32x2* yr = (const u32x2*)(y + (size_t)(row0 + r) * D) + lane; const u32x2* xr = (const u32x2*)(xin + (size_t)(row0 + r) * D) + lane;
#pragma unroll
        for (int j = 0; j < 4; ++j) { const u32x2 yw = yr[64 * j], xw = xr[64 * j];
            v[r][j] = (f32x4){__builtin_bit_cast(float, yw.x << 16), __builtin_bit_cast(float, yw.x & 0xffff0000u), __builtin_bit_cast(float, yw.y << 16), __builtin_bit_cast(float, yw.y & 0xffff0000u)};
            xx[r][j] = (f32x4){__builtin_bit_cast(float, xw.x << 16), __builtin_bit_cast(float, xw.x & 0xffff0000u), __builtin_bit_cast(float, xw.y << 16), __builtin_bit_cast(float, xw.y & 0xffff0000u)}; }
        if (p) pv[r] = *((const f32x4*)(p + (size_t)(row0 + r) * PLE) + lane); }
    f32x4 gg[4];
#pragma unroll
    for (int j = 0; j < 4; ++j) gg[j] = gr[64 * j];
#pragma unroll
    for (int r = 0; r < 2; ++r) { float ss = 0.f;
#pragma unroll
        for (int j = 0; j < 4; ++j) ss += (v[r][j].x * v[r][j].x + v[r][j].y * v[r][j].y) + (v[r][j].z * v[r][j].z + v[r][j].w * v[r][j].w);
        const float rr = 1.0f / sqrtf(wave_sum(ss) * (1.0f / D) + EPS); float s2 = 0.f;
        u32x2* o = (u32x2*)(xo + (size_t)(row0 + r) * D) + lane;
#pragma unroll
        for (int j = 0; j < 4; ++j) { const f32x4 w = xx[r][j] + v[r][j] * rr * gg[j]; u32x2 q; q.x = pk2(w.x, w.y); q.y = pk2(w.z, w.w); if (!dry) o[64 * j] = q;
            const float r0 = __builtin_bit_cast(float, q.x << 16), r1 = __builtin_bit_cast(float, q.x & 0xffff0000u), r2 = __builtin_bit_cast(float, q.y << 16), r3 = __builtin_bit_cast(float, q.y & 0xffff0000u);
            s2 += (r0 * r0 + r1 * r1) + (r2 * r2 + r3 * r3); }
        if (rstd_out) { s2 = wave_sum(s2); if (lane == 0) rstd_out[row0 + r] = 1.0f / sqrtf(s2 * (1.0f / D) + EPS); }
        if (p) { u32x2 q; q.x = pk2(pv[r].x, pv[r].y); q.y = pk2(pv[r].z, pv[r].w); *((u32x2*)(pb + (size_t)(row0 + r) * PLE) + lane) = q; } }
}
__device__ __forceinline__ void row_rstd_bf16(const bf16* __restrict__ xb, float* __restrict__ rstd, int row, int lane) {
    const u32x2* xr = (const u32x2*)(xb + (size_t)row * D) + lane; float ss = 0.f;
#pragma unroll
    for (int j = 0; j < 4; ++j) { const u32x2 w = xr[64 * j]; const float a = __builtin_bit_cast(float, w.x << 16), b = __builtin_bit_cast(float, w.x & 0xffff0000u), c2 = __builtin_bit_cast(float, w.y << 16), d = __builtin_bit_cast(float, w.y & 0xffff0000u); ss += (a * a + b * b) + (c2 * c2 + d * d); }
    ss = wave_sum(ss); if (lane == 0) rstd[row] = 1.0f / sqrtf(ss * (1.0f / D) + EPS);
}
__device__ __forceinline__ void wave_gnorm4(bf16* RA, const float* __restrict__ nw, int w0, int lane, bool dry = false) {
    u32x4 v[4]; float ss[4];
#pragma unroll
    for (int i = 0; i < 4; ++i) { const int w = w0 + i, t = w >> 1, g = w & 1; v[i] = *(const u32x4*)(RA + (size_t)t * NA + A_Z + g * 512 + lane * 8); }
    float f[4][8];
#pragma unroll
    for (int i = 0; i < 4; ++i) { const unsigned vw[4] = {v[i].x, v[i].y, v[i].z, v[i].w}; ss[i] = 0.f;
#pragma unroll
        for (int e = 0; e < 8; ++e) { f[i][e] = bf2f((bf16)((vw[e >> 1] >> ((e & 1) * 16)) & 0xffff)); ss[i] += f[i][e] * f[i][e]; } }
#pragma unroll
    for (int o = 1; o < 64; o <<= 1) {
#pragma unroll
        for (int i = 0; i < 4; ++i) ss[i] += __shfl_xor(ss[i], o); }
#pragma unroll
    for (int i = 0; i < 4; ++i) { const int w = w0 + i, t = w >> 1, g = w & 1; const float r = 1.0f / sqrtf(ss[i] * (1.0f / 512.0f) + EPS); const float* gw = nw + g * 512 + lane * 8;
        u32x4 o; o.x = pk2(f[i][0] * r * gw[0], f[i][1] * r * gw[1]); o.y = pk2(f[i][2] * r * gw[2], f[i][3] * r * gw[3]); o.z = pk2(f[i][4] * r * gw[4], f[i][5] * r * gw[5]); o.w = pk2(f[i][6] * r * gw[6], f[i][7] * r * gw[7]);
        if (!dry) *(u32x4*)(RA + (size_t)t * NA + A_Z + g * 512 + lane * 8) = o; }
}
__device__ __forceinline__ void tok_m1(bf16* __restrict__ RA, bf16* __restrict__ RB, bf16* __restrict__ CKVC, bf16* __restrict__ IKC, const float* __restrict__ kvn, const float* __restrict__ ikg, const float* __restrict__ ikb, const float* __restrict__ scw, int t, int lane) {
    const int s = t & (SEQ - 1); bf16* rb = RB + (size_t)t * NB;
    {   const u32x2 w = *((const u32x2*)(rb + B_CKV) + lane); float v[4] = {bf2f((bf16)(w.x & 0xffff)), bf2f((bf16)(w.x >> 16)), bf2f((bf16)(w.y & 0xffff)), bf2f((bf16)(w.y >> 16))};
        float ss = (v[0] * v[0] + v[1] * v[1]) + (v[2] * v[2] + v[3] * v[3]); ss = wave_sum(ss); const float r = 1.0f / sqrtf(ss * (1.0f / KV_R) + EPS);
        const f32x4 g = *((const f32x4*)kvn + lane); u32x2 o; o.x = pk2(v[0] * r * g.x, v[1] * r * g.y); o.y = pk2(v[2] * r * g.z, v[3] * r * g.w); *((u32x2*)(rb + B_CKV) + lane) = o; *((u32x2*)(CKVC + (size_t)t * KV_R) + lane) = o; }
    {   const float x = bf2f(rb[B_IK + lane]); const float mu = wave_sum(x) * (1.0f / 64.0f); const float d = x - mu; const float var = wave_sum(d * d) * (1.0f / 64.0f);
        const bf16 o = f2bf(d * (1.0f / sqrtf(var + EPS)) * ikg[lane] + ikb[lane]); rb[B_IK + lane] = o; IKC[(size_t)t * 64 + lane] = o; }
    {   const int c = lane * 8; float acc[8] = {0.f, 0.f, 0.f, 0.f, 0.f, 0.f, 0.f, 0.f};
        for (int j = 0; j < 3; ++j) { const int ss_ = s - 2 + j; if (ss_ < 0) continue; const bf16* rr = RB + (size_t)(t - 2 + j) * NB;
            const u32x4 cg = *(const u32x4*)(rr + B_CG + c), hb = *(const u32x4*)(rr + B_HB + c); const unsigned cw[4] = {cg.x, cg.y, cg.z, cg.w}, hw[4] = {hb.x, hb.y, hb.z, hb.w};
#pragma unroll
            for (int e = 0; e < 8; ++e) { const float a = bf2f((bf16)((cw[e >> 1] >> ((e & 1) * 16)) & 0xffff)), b = bf2f((bf16)((hw[e >> 1] >> ((e & 1) * 16)) & 0xffff)); acc[e] += scw[j * 512 + c + e] * (a * b); } }
        bf16* ra = RA + (size_t)t * NA + A_BG + c; const u32x4 bg = *(const u32x4*)ra; const unsigned bw[4] = {bg.x, bg.y, bg.z, bg.w}; float o[8];
#pragma unroll
        for (int e = 0; e < 8; ++e) o[e] = bf2f((bf16)((bw[e >> 1] >> ((e & 1) * 16)) & 0xffff)) * acc[e];
        u32x4 w; w.x = pk2(o[0], o[1]); w.y = pk2(o[2], o[3]); w.z = pk2(o[4], o[5]); w.w = pk2(o[6], o[7]); *(u32x4*)ra = w; }
}
__device__ __forceinline__ void tok_m4a(const bf16* __restrict__ RB, const float* __restrict__ cw, const float* __restrict__ cb, const float* __restrict__ dtb, bf16* __restrict__ XA, float* __restrict__ DT, int t, int lane) {
    const int s = t & (SEQ - 1);
    for (int c = lane; c < XBC; c += 64) { float a = cb[c];
#pragma unroll
        for (int j = 0; j < 4; ++j) { const int ss = s - 3 + j; if (ss >= 0) a += cw[j * XBC + c] * bf2f(RB[(size_t)(t - 3 + j) * NB + B_XBC + c]); }
        XA[(size_t)t * XBC + c] = f2bf(siluf_(a)); }
    if (lane < 16) { const float x = bf2f(RB[(size_t)t * NB + B_DT + lane]) + dtb[lane]; DT[(size_t)t * 16 + lane] = x > 15.f ? x : log1pf(__expf(x)); }
}
__device__ __forceinline__ void wg_m2_select(LDSP unsigned char* lds, const bf16* __restrict__ RB, unsigned short* __restrict__ idx, int t, int tid) {
    LDSP float* iq = (LDSP float*)lds; LDSP float* iwv = iq + 256; LDSP unsigned* red = (LDSP unsigned*)(iq + 272); LDSP unsigned* keys = (LDSP unsigned*)(iq + 288);
    const int s = t & (SEQ - 1), b = t >> 12, lane = tid & 63, wv = tid >> 6;
    const int nk = ((s >> 6) + 1) << 6;
    const bf16* rb = RB + (size_t)t * NB;
    if (tid < 256) iq[tid] = bf2f(rb[B_IQ + tid]); if (tid < 4) iwv[tid] = bf2f(rb[B_IW + tid]) * (0.125f * 0.5f);
    __syncthreads();
    for (int k = tid; k < nk; k += NTHR) {
        const bf16* kr = RB + (size_t)(b * SEQ + k) * NB + B_IK; float sc = 0.f;
        float d0 = 0.f, d1 = 0.f, d2 = 0.f, d3 = 0.f;
#pragma unroll 1
        for (int j = 0; j < 8; ++j) { const u32x4 w = *((const u32x4*)kr + j); const unsigned ww[4] = {w.x, w.y, w.z, w.w};
#pragma unroll
            for (int e = 0; e < 8; ++e) { const float kv = bf2f((bf16)((ww[e >> 1] >> ((e & 1) * 16)) & 0xffff)); const int c = j * 8 + e;
                d0 += iq[c] * kv; d1 += iq[64 + c] * kv; d2 += iq[128 + c] * kv; d3 += iq[192 + c] * kv; } }
        sc += fmaxf(d0, 0.f) * iwv[0]; sc += fmaxf(d1, 0.f) * iwv[1]; sc += fmaxf(d2, 0.f) * iwv[2]; sc += fmaxf(d3, 0.f) * iwv[3];
        keys[k] = ord_key(sc);
    }
    __syncthreads();
    unsigned Tt = 0u;
    if (nk > TOPK) {
        for (int bit = 31; bit >= 0; --bit) { const unsigned cand = Tt | (1u << bit); unsigned c = 0;
            for (int k = tid; k < nk; k += NTHR) c += (keys[k] >= cand) ? 1u : 0u;
#pragma unroll
            for (int o = 1; o < 64; o <<= 1) c += __shfl_xor(c, o);
            if (lane == 0) red[wv] = c;
            __syncthreads();
            unsigned tot = 0;
#pragma unroll
            for (int w = 0; w < 8; ++w) tot += red[w];
            if (tot >= (unsigned)TOPK) Tt = cand;
            __syncthreads(); }
    }
    { unsigned c = 0; for (int k = tid; k < nk; k += NTHR) c += (keys[k] > Tt) ? 1u : 0u;
#pragma unroll
      for (int o = 1; o < 64; o <<= 1) c += __shfl_xor(c, o);
      if (lane == 0) red[8 + wv] = c; }
    __syncthreads();
    if (wv == 0) {
        int ngt = 0;
#pragma unroll
        for (int w = 0; w < 8; ++w) ngt += (int)red[8 + w];
        const int need = TOPK - ngt; int pos = 0, eq_taken = 0; const unsigned long long lt = (1ull << lane) - 1ull;
        for (int base = 0; base < nk; base += 64) { const unsigned k = keys[base + lane]; const bool gt = k > Tt, eq = (k == Tt);
            const unsigned long long meq = __ballot(eq); const int rank_eq = __popcll(meq & lt); const bool take = gt || (eq && (eq_taken + rank_eq < need));
            const unsigned long long msel = __ballot(take);
            if (take) { const int o = pos + __popcll(msel & lt); if (o < TOPK) idx[(size_t)t * TOPK + o] = (unsigned short)(base + lane); }
            pos += __popcll(msel); eq_taken += __popcll(__ballot(eq && take)); }
    }
    __syncthreads();
}
__device__ __forceinline__ void wg_m3_attn(LDSP unsigned char* lds, bf16* RA, const bf16* __restrict__ RB, const unsigned short* __restrict__ idx, const float* __restrict__ w_uk, const float* __restrict__ w_uv, const float* __restrict__ rel_bias, int t, int tid) {
    LDSP float* q = (LDSP float*)lds; LDSP float* qlat = q + 512; LDSP float* pr = qlat + 2048; LDSP float* outl = pr + 2048; LDSP unsigned short* sel = (LDSP unsigned short*)(outl + 2048);
    const int s = t & (SEQ - 1), b = t >> 12, lane = tid & 63, wv = tid >> 6;
    const int nk = ((s >> 6) + 1) << 6, nsel = nk < TOPK ? nk : TOPK;
    q[tid] = bf2f(RA[(size_t)t * NA + A_Q + tid]); if (tid < 256) sel[tid] = tid < nsel ? idx[(size_t)t * TOPK + tid] : (unsigned short)0;
    __syncthreads();
    {   const int r = tid & 255, h0 = (tid >> 8) * 4;
        for (int h = h0; h < h0 + 4; ++h) { const float* w = w_uk + ((size_t)r * 8 + h) * 64; float a = 0.f;
#pragma unroll 16
            for (int d = 0; d < 64; ++d) a += q[h * 64 + d] * w[d];
            qlat[h * 256 + r] = a * 0.125f; } }
    __syncthreads();
    {   const int k = tid & 255, h0 = (tid >> 8) * 4;
        if (k < nsel) { const int key = sel[k]; const bf16* kr = RB + (size_t)(b * SEQ + key) * NB + B_CKV; float a[4] = {0.f, 0.f, 0.f, 0.f};
            for (int j = 0; j < 32; ++j) { const u32x4 w = *((const u32x4*)kr + j); const unsigned ww[4] = {w.x, w.y, w.z, w.w};
#pragma unroll
                for (int e = 0; e < 8; ++e) { const float v = bf2f((bf16)((ww[e >> 1] >> ((e & 1) * 16)) & 0xffff));
#pragma unroll
                    for (int hh = 0; hh < 4; ++hh) a[hh] += qlat[(h0 + hh) * 256 + j * 8 + e] * v; } }
            const int bk = t5_bucket(key - s);
#pragma unroll
            for (int hh = 0; hh < 4; ++hh) pr[(h0 + hh) * 256 + k] = a[hh] + rel_bias[bk * 8 + h0 + hh];
        } else {
#pragma unroll
            for (int hh = 0; hh < 4; ++hh) pr[(h0 + hh) * 256 + k] = -INFINITY; } }
    __syncthreads();
    {   float v[4]; float m = -INFINITY;
#pragma unroll
        for (int j = 0; j < 4; ++j) { v[j] = pr[wv * 256 + lane + 64 * j]; m = fmaxf(m, v[j]); }
        m = wave_max(m); float sum = 0.f;
#pragma unroll
        for (int j = 0; j < 4; ++j) { v[j] = __expf(v[j] - m); sum += v[j]; }
        sum = wave_sum(sum); const float inv = 1.0f / sum;
#pragma unroll
        for (int j = 0; j < 4; ++j) pr[wv * 256 + lane + 64 * j] = v[j] * inv; }
    __syncthreads();
    {   const int r = tid & 255, h0 = (tid >> 8) * 4; float a[4] = {0.f, 0.f, 0.f, 0.f};
        for (int k = 0; k < nsel; ++k) { const float v = bf2f(RB[(size_t)(b * SEQ + sel[k]) * NB + B_CKV + r]);
#pragma unroll
            for (int hh = 0; hh < 4; ++hh) a[hh] += pr[(h0 + hh) * 256 + k] * v; }
#pragma unroll
        for (int hh = 0; hh < 4; ++hh) outl[(h0 + hh) * 256 + r] = a[hh]; }
    __syncthreads();
    {   const int h = tid >> 6, d = tid & 63; float a = 0.f;
        for (int r = 0; r < 256; ++r) a += outl[h * 256 + r] * w_uv[((size_t)r * 8 + h) * 64 + d];
        RA[(size_t)t * NA + A_Q + tid] = f2bf(a); }
    __syncthreads();
}
__device__ __forceinline__ void half_m4b_scan(bf16* RA, const bf16* __restrict__ XA, const float* __restrict__ DT, const float* __restrict__ a_log, const float* __restrict__ dsk, int b, int h, int tid) {
    const int g = h >> 3, p = tid >> 2, nq = tid & 3;
    const float A = -__expf(a_log[h]), Dh = dsk[h];
    float hs[32];
#pragma unroll
    for (int n = 0; n < 32; ++n) hs[n] = 0.f;
    for (int s = 0; s < SEQ; ++s) { const size_t t = (size_t)b * SEQ + s; const float dt = DT[t * 16 + h]; const float dA = __expf(dt * A);
        const bf16* xr = XA + t * XBC; const float x = bf2f(xr[h * 64 + p]); const float dx = dt * x;
        const u32x4* Bp = (const u32x4*)(xr + 1024 + g * 128 + nq * 32); const u32x4* Cp = (const u32x4*)(xr + 1280 + g * 128 + nq * 32); float y = 0.f;
#pragma unroll
        for (int j = 0; j < 4; ++j) { const u32x4 bw = Bp[j], cw = Cp[j]; const unsigned bb[4] = {bw.x, bw.y, bw.z, bw.w}, cc[4] = {cw.x, cw.y, cw.z, cw.w};
#pragma unroll
            for (int e = 0; e < 8; ++e) { const float Bv = bf2f((bf16)((bb[e >> 1] >> ((e & 1) * 16)) & 0xffff)), Cv = bf2f((bf16)((cc[e >> 1] >> ((e & 1) * 16)) & 0xffff));
                hs[j * 8 + e] = hs[j * 8 + e] * dA + dx * Bv; y += Cv * hs[j * 8 + e]; } }
        y += __shfl_xor(y, 1); y += __shfl_xor(y, 2);
        if (nq == 0) { bf16* zp = RA + t * NA + A_Z + h * 64 + p; const float z = bf2f(*zp); *zp = f2bf((y + Dh * x) * siluf_(z)); }
    }
}
__device__ __forceinline__ void wave_m4c_gnorm(bf16* RA, const float* __restrict__ nw, int w, int lane, bool dry = false) {
    const int t = w >> 1, g = w & 1;
    bf16* p = RA + (size_t)t * NA + A_Z + g * 512 + lane * 8; const u32x4 v = *(const u32x4*)p; const unsigned vw[4] = {v.x, v.y, v.z, v.w}; float f[8]; float ss = 0.f;
#pragma unroll
    for (int e = 0; e < 8; ++e) { f[e] = bf2f((bf16)((vw[e >> 1] >> ((e & 1) * 16)) & 0xffff)); ss += f[e] * f[e]; }
    const float r = 1.0f / sqrtf(wave_sum(ss) * (1.0f / 512.0f) + EPS); const float* gw = nw + g * 512 + lane * 8;
    u32x4 o; o.x = pk2(f[0] * r * gw[0], f[1] * r * gw[1]); o.y = pk2(f[2] * r * gw[2], f[3] * r * gw[3]); o.z = pk2(f[4] * r * gw[4], f[5] * r * gw[5]); o.w = pk2(f[6] * r * gw[6], f[7] * r * gw[7]);
    if (!dry) *(u32x4*)p = o;
}

__device__ __forceinline__ void unpack8(const u32x4 w, float (&f)[8]) { const unsigned ww[4] = {w.x, w.y, w.z, w.w};
#pragma unroll
    for (int e = 0; e < 4; ++e) { f[2 * e] = __builtin_bit_cast(float, ww[e] << 16); f[2 * e + 1] = __builtin_bit_cast(float, ww[e] & 0xffff0000u); } }
__device__ __forceinline__ void prep_ckv4(const bf16* __restrict__ RB, bf16* __restrict__ CKVC, const float* __restrict__ kvn, int it, int lane) {
    const int t = it * 4 + (lane >> 4), c = lane & 15; const u32x4* src = (const u32x4*)(RB + (size_t)t * NB + B_CKV + c * 16); const u32x4 a = src[0], b = src[1];
    float v[16]; { float f[8]; unpack8(a, f);
#pragma unroll
        for (int e = 0; e < 8; ++e) v[e] = f[e]; unpack8(b, f);
#pragma unroll
        for (int e = 0; e < 8; ++e) v[8 + e] = f[e]; }
    float ss = 0.f;
#pragma unroll
    for (int e = 0; e < 16; ++e) ss += v[e] * v[e];
    ss += __shfl_xor(ss, 1); ss += __shfl_xor(ss, 2); ss += __shfl_xor(ss, 4); ss += __shfl_xor(ss, 8);
    const float r = 1.0f / sqrtf(ss * (1.0f / KV_R) + EPS); const f32x4* gp = (const f32x4*)(kvn + c * 16); float o[16];
#pragma unroll
    for (int q = 0; q < 4; ++q) { const f32x4 gg = gp[q]; o[4 * q] = v[4 * q] * r * gg.x; o[4 * q + 1] = v[4 * q + 1] * r * gg.y; o[4 * q + 2] = v[4 * q + 2] * r * gg.z; o[4 * q + 3] = v[4 * q + 3] * r * gg.w; }
    u32x4 w0, w1; w0.x = pk2(o[0], o[1]); w0.y = pk2(o[2], o[3]); w0.z = pk2(o[4], o[5]); w0.w = pk2(o[6], o[7]); w1.x = pk2(o[8], o[9]); w1.y = pk2(o[10], o[11]); w1.z = pk2(o[12], o[13]); w1.w = pk2(o[14], o[15]);
    u32x4* dst = (u32x4*)(CKVC + (size_t)t * KV_R + c * 16); dst[0] = w0; dst[1] = w1;
}
__device__ __forceinline__ void prep_ik16(const bf16* __restrict__ RB, bf16* __restrict__ IKC, const float* __restrict__ ikg, const float* __restrict__ ikb, int it, int lane) {
    const int t = it * 16 + (lane >> 2), c = lane & 3; const u32x4* src = (const u32x4*)(RB + (size_t)t * NB + B_IK + c * 16); const u32x4 a = src[0], b = src[1];
    float v[16]; { float f[8]; unpack8(a, f);
#pragma unroll
        for (int e = 0; e < 8; ++e) v[e] = f[e]; unpack8(b, f);
#pragma unroll
        for (int e = 0; e < 8; ++e) v[8 + e] = f[e]; }
    float s = 0.f;
#pragma unroll
    for (int e = 0; e < 16; ++e) s += v[e];
    s += __shfl_xor(s, 1); s += __shfl_xor(s, 2); const float mu = s * (1.0f / 64.0f); float q2 = 0.f;
#pragma unroll
    for (int e = 0; e < 16; ++e) { v[e] -= mu; q2 += v[e] * v[e]; }
    q2 += __shfl_xor(q2, 1); q2 += __shfl_xor(q2, 2); const float r = 1.0f / sqrtf(q2 * (1.0f / 64.0f) + EPS); float o[16];
#pragma unroll
    for (int e = 0; e < 16; ++e) o[e] = v[e] * r * ikg[c * 16 + e] + ikb[c * 16 + e];
    u32x4 w0, w1; w0.x = pk2(o[0], o[1]); w0.y = pk2(o[2], o[3]); w0.z = pk2(o[4], o[5]); w0.w = pk2(o[6], o[7]); w1.x = pk2(o[8], o[9]); w1.y = pk2(o[10], o[11]); w1.z = pk2(o[12], o[13]); w1.w = pk2(o[14], o[15]);
    u32x4* dst = (u32x4*)(IKC + (size_t)t * 64 + c * 16); dst[0] = w0; dst[1] = w1;
}
__device__ __forceinline__ void prep_bout(bf16* RA, const bf16* __restrict__ RB, const float* __restrict__ scw, int t, int lane, bool dry = false) {
    const int s = t & (SEQ - 1), c = lane * 8; float acc[8] = {0.f, 0.f, 0.f, 0.f, 0.f, 0.f, 0.f, 0.f};
    u32x4 cg[3], hb[3];
#pragma unroll
    for (int j = 0; j < 3; ++j) { const bool ok = (s - 2 + j) >= 0; const bf16* rr = RB + (size_t)(t - 2 + j) * NB; cg[j] = ok ? *(const u32x4*)(rr + B_CG + c) : (u32x4){0u, 0u, 0u, 0u}; hb[j] = ok ? *(const u32x4*)(rr + B_HB + c) : (u32x4){0u, 0u, 0u, 0u}; }
    bf16* ra = RA + (size_t)t * NA + A_BG + c; const u32x4 bg = *(const u32x4*)ra;
#pragma unroll
    for (int j = 0; j < 3; ++j) { float a[8], b[8]; unpack8(cg[j], a); unpack8(hb[j], b); const f32x4 w0 = *(const f32x4*)(scw + j * 512 + c), w1 = *(const f32x4*)(scw + j * 512 + c + 4);
        acc[0] += w0.x * (a[0] * b[0]); acc[1] += w0.y * (a[1] * b[1]); acc[2] += w0.z * (a[2] * b[2]); acc[3] += w0.w * (a[3] * b[3]);
        acc[4] += w1.x * (a[4] * b[4]); acc[5] += w1.y * (a[5] * b[5]); acc[6] += w1.z * (a[6] * b[6]); acc[7] += w1.w * (a[7] * b[7]); }
    float g8[8]; unpack8(bg, g8); u32x4 w; w.x = pk2(g8[0] * acc[0], g8[1] * acc[1]); w.y = pk2(g8[2] * acc[2], g8[3] * acc[3]); w.z = pk2(g8[4] * acc[4], g8[5] * acc[5]); w.w = pk2(g8[6] * acc[6], g8[7] * acc[7]);
    if (!dry) *(u32x4*)ra = w;
}
__device__ __forceinline__ void prep_conv(const bf16* __restrict__ RB, bf16* __restrict__ XA, const float* __restrict__ cw, const float* __restrict__ cb, int it, int lane) {
    const int rb = it / 12, cbk = it % 12, xcol = cbk * 128 + 2 * lane, t0 = rb * 16, s0 = t0 & (SEQ - 1);
    float w0[4], w1[4];
#pragma unroll
    for (int j = 0; j < 4; ++j) { w0[j] = cw[j * XBC + xcol]; w1[j] = cw[j * XBC + xcol + 1]; }
    const float cb0 = cb[xcol], cb1 = cb[xcol + 1];
    const bf16* src = RB + (size_t)(t0 - 3) * NB + B_XBC + xcol; unsigned raw[19];
#pragma unroll
    for (int i = 0; i < 19; ++i) raw[i] = (s0 - 3 + i >= 0) ? *(const unsigned*)(src + (size_t)i * NB) : 0u;
#pragma unroll
    for (int i = 0; i < 16; ++i) { float a0 = cb0, a1 = cb1;
#pragma unroll
        for (int j = 0; j < 4; ++j) { a0 += w0[j] * __builtin_bit_cast(float, raw[i + j] << 16); a1 += w1[j] * __builtin_bit_cast(float, raw[i + j] & 0xffff0000u); }
        *(unsigned*)(XA + (size_t)(t0 + i) * XBC + xcol) = pk2(siluf_(a0), siluf_(a1)); }
}

typedef short bf16x8_t __attribute__((ext_vector_type(8)));
#ifndef SEL_REP_SEARCH
#define SEL_REP_SEARCH 1
#endif
#ifndef SEL_REP_STAGE
#define SEL_REP_STAGE 1
#endif
#define CNT8_GE(cnt, v0, v1, v2, v3, v4, v5, v6, v7, cand) do { unsigned long long m0_, m1_, m2_, m3_, m4_, m5_, m6_, m7_; \
    asm("v_cmp_ge_u32_e64 %0, %8, %16\n\tv_cmp_ge_u32_e64 %1, %9, %16\n\tv_cmp_ge_u32_e64 %2, %10, %16\n\tv_cmp_ge_u32_e64 %3, %11, %16\n\t" \
        "v_cmp_ge_u32_e64 %4, %12, %16\n\tv_cmp_ge_u32_e64 %5, %13, %16\n\tv_cmp_ge_u32_e64 %6, %14, %16\n\tv_cmp_ge_u32_e64 %7, %15, %16" \
        : "=&s"(m0_), "=&s"(m1_), "=&s"(m2_), "=&s"(m3_), "=&s"(m4_), "=&s"(m5_), "=&s"(m6_), "=&s"(m7_) \
        : "v"(v0), "v"(v1), "v"(v2), "v"(v3), "v"(v4), "v"(v5), "v"(v6), "v"(v7), "s"(cand)); \
    cnt += (__popcll(m0_) + __popcll(m1_)) + (__popcll(m2_) + __popcll(m3_)) + (__popcll(m4_) + __popcll(m5_)) + (__popcll(m6_) + __popcll(m7_)); } while (0)
constexpr int SC_STRIDE = 516, SC_BUF = 16 * SC_STRIDE;
constexpr int IKW_OFF = 66560;
__device__ __forceinline__ void wg_select16(LDSP unsigned char* lds, const bf16* __restrict__ RB, const bf16* __restrict__ IKC, unsigned short* __restrict__ idx, int unit, int tid, bool dry = false, bool lds_out = false) {
    const int lane = tid & 63, wave = __builtin_amdgcn_readfirstlane(tid >> 6), g = lane >> 4, c = lane & 15;
    const int b = unit >> 8, qg = unit & 255, t0 = b * SEQ + qg * 16, nk = ((qg >> 2) + 1) << 6, nr = nk >> 6;
    LDSP unsigned* SC = (LDSP unsigned*)lds;
    bf16x8_t bq[4][2]; float iwq[4];
    { const bf16* qr = RB + (size_t)(t0 + c) * NB;
#pragma unroll
      for (int h = 0; h < 4; ++h) { bq[h][0] = *(const bf16x8_t*)(qr + B_IQ + h * 64 + g * 8); bq[h][1] = *(const bf16x8_t*)(qr + B_IQ + h * 64 + 32 + g * 8); iwq[h] = bf2f(qr[B_IW + h]) * 0.0625f; } }
    unsigned val[2][64];
#pragma unroll
    for (int r = 0; r < 64; ++r) { val[0][r] = 0u; val[1][r] = 0u; }
    const bf16* ikb = IKC + (size_t)b * SEQ * 64;
    LDSP unsigned char* ikw = lds + IKW_OFF + wave * 8192;
#define IK_DMA(stage) do { if ((stage) * 512 + wave * 64 < nk) { const bf16* src_ = ikb + (size_t)((stage) * 512 + wave * 64) * 64 + lane * 8; _Pragma("unroll") for (int pc_ = 0; pc_ < 8; ++pc_) \
        __builtin_amdgcn_global_load_lds((const unsigned*)(src_ + pc_ * 512), (LDSP unsigned*)(ikw + pc_ * 1024), 16, 0, 0); } } while (0)
    IK_DMA(0);
    for (int rep_st = 0; rep_st < SEL_REP_STAGE; ++rep_st) {
    if (rep_st > 0) { asm volatile("s_waitcnt vmcnt(0)" ::: "memory"); __builtin_amdgcn_s_barrier(); IK_DMA(0); }
#pragma unroll
    for (int s = 0; s < 8; ++s) {
        if (s * 512 < nk) {
            LDSP unsigned* buf = SC + (s & 1) * SC_BUF;
            asm volatile("s_waitcnt vmcnt(0)" ::: "memory");
            bf16x8_t af[4][2];
#pragma unroll
            for (int i = 0; i < 4; ++i) { af[i][0] = *(const LDSP bf16x8_t*)(ikw + (16 * i + c) * 128 + g * 16); af[i][1] = *(const LDSP bf16x8_t*)(ikw + (16 * i + c) * 128 + 64 + g * 16); }
            asm volatile("s_waitcnt lgkmcnt(0)" ::: "memory");
            if (s < 7) IK_DMA(s + 1);
#pragma unroll
            for (int i = 0; i < 4; ++i) { const int tl = wave * 4 + i, kb = s * 512 + tl * 16;
                if (kb < nk) {
                    const bf16x8_t a0 = af[i][0], a1 = af[i][1];
                    float sc[4] = {0.f, 0.f, 0.f, 0.f};
#pragma unroll
                    for (int h = 0; h < 4; ++h) { pg8::f32x4 acc = {0.f, 0.f, 0.f, 0.f};
                        acc = __builtin_amdgcn_mfma_f32_16x16x32_bf16(a0, bq[h][0], acc, 0, 0, 0); acc = __builtin_amdgcn_mfma_f32_16x16x32_bf16(a1, bq[h][1], acc, 0, 0, 0);
#pragma unroll
                        for (int e = 0; e < 4; ++e) sc[e] += fmaxf(acc[e], 0.f) * iwq[h]; }
                    u32x4 kv; kv.x = ord_key(sc[0]); kv.y = ord_key(sc[1]); kv.z = ord_key(sc[2]); kv.w = ord_key(sc[3]);
                    *(LDSP u32x4*)(buf + c * SC_STRIDE + tl * 16 + 4 * g) = kv; } }
            asm volatile("s_waitcnt lgkmcnt(0)" ::: "memory"); __builtin_amdgcn_s_barrier(); asm volatile("" ::: "memory");
#pragma unroll
            for (int j = 0; j < 8; ++j) if (s * 512 + j * 64 < nk) { val[0][s * 8 + j] = buf[(2 * wave) * SC_STRIDE + j * 64 + lane]; val[1][s * 8 + j] = buf[(2 * wave + 1) * SC_STRIDE + j * 64 + lane]; }
            asm volatile("s_waitcnt lgkmcnt(0)" ::: "memory");
        }
    }
    }
    const unsigned long long lt = (1ull << lane) - 1ull;
#pragma unroll
    for (int qq = 0; qq < 2; ++qq) {
        unsigned Tt = 0u;
        for (int rep_se = 0; rep_se < SEL_REP_SEARCH; ++rep_se) { Tt = 0u; asm volatile("" : "+v"(val[qq][0]));
        if (nk > TOPK) {
            for (int bit = 31; bit >= 0; --bit) { const unsigned cand = Tt | (1u << bit); int cnt = 0;
#pragma unroll
                for (int r8 = 0; r8 < 8; ++r8) if (r8 * 8 < nr) CNT8_GE(cnt, val[qq][r8 * 8], val[qq][r8 * 8 + 1], val[qq][r8 * 8 + 2], val[qq][r8 * 8 + 3], val[qq][r8 * 8 + 4], val[qq][r8 * 8 + 5], val[qq][r8 * 8 + 6], val[qq][r8 * 8 + 7], cand);
                if (cnt >= TOPK) Tt = cand; if (cnt == TOPK) break; }
        }
        }
        unsigned short* orow = idx + (size_t)(t0 + 2 * wave + qq) * TOPK;
        LDSP unsigned short* orow_l = (LDSP unsigned short*)(lds + 134 * 1024) + (2 * wave + qq) * TOPK;
        int pos = 0;
#define PUT_KEY(o_, key_) do { if ((o_) < TOPK && !dry) { if (lds_out) orow_l[o_] = (unsigned short)(key_); else orow[o_] = (unsigned short)(key_); } } while (0)
#pragma unroll
        for (int r8 = 0; r8 < 8; ++r8) if (r8 * 8 < nr) { unsigned long long k0, k1, k2, k3, k4, k5, k6, k7;
            asm("v_cmp_gt_u32_e64 %0, %8, %16\n\tv_cmp_gt_u32_e64 %1, %9, %16\n\tv_cmp_gt_u32_e64 %2, %10, %16\n\tv_cmp_gt_u32_e64 %3, %11, %16\n\t"
                "v_cmp_gt_u32_e64 %4, %12, %16\n\tv_cmp_gt_u32_e64 %5, %13, %16\n\tv_cmp_gt_u32_e64 %6, %14, %16\n\tv_cmp_gt_u32_e64 %7, %15, %16"
                : "=&s"(k0), "=&s"(k1), "=&s"(k2), "=&s"(k3), "=&s"(k4), "=&s"(k5), "=&s"(k6), "=&s"(k7)
                : "v"(val[qq][r8 * 8]), "v"(val[qq][r8 * 8 + 1]), "v"(val[qq][r8 * 8 + 2]), "v"(val[qq][r8 * 8 + 3]), "v"(val[qq][r8 * 8 + 4]), "v"(val[qq][r8 * 8 + 5]), "v"(val[qq][r8 * 8 + 6]), "v"(val[qq][r8 * 8 + 7]), "s"(Tt));
#define PUT_MASK(m_, i_) do { if ((m_) != 0ull) { if (((m_) >> lane) & 1ull) { const int o = pos + __popcll((m_) & lt); PUT_KEY(o, (r8 * 8 + (i_)) * 64 + lane); } pos += __popcll(m_); } } while (0)
            PUT_MASK(k0, 0); PUT_MASK(k1, 1); PUT_MASK(k2, 2); PUT_MASK(k3, 3); PUT_MASK(k4, 4); PUT_MASK(k5, 5); PUT_MASK(k6, 6); PUT_MASK(k7, 7);
#undef PUT_MASK
        }
        int need = TOPK - pos;
        if (need > 0) {
#pragma unroll
            for (int r = 0; r < 64; ++r) if (r < nr && need > 0) { const unsigned long long meq = __ballot(val[qq][r] == Tt);
                if (meq != 0ull) { const int rank = __popcll(meq & lt); if (((meq >> lane) & 1ull) && rank < need) { PUT_KEY(pos + rank, r * 64 + lane); } const int tk = __popcll(meq); const int tkn = tk < need ? tk : need; pos += tkn; need -= tkn; } }
        }
#undef PUT_KEY
    }
    asm volatile("s_waitcnt vmcnt(0)" ::: "memory"); __builtin_amdgcn_s_barrier();
#undef IK_DMA
}

typedef unsigned short u16x4_t __attribute__((ext_vector_type(4)));
#ifndef ATT_LOCAL_DRY
#define ATT_LOCAL_DRY 0
#endif
#ifndef ATT_STAGGER
#define ATT_STAGGER 0
#endif
#ifndef ATT_DRY_SKIP
#define ATT_DRY_SKIP 0
#endif
#define DSK(b) (ATT_DRY_SKIP & (b)) && dry
#ifndef ATT_SUB_EN
#define ATT_SUB_EN 0
#endif
constexpr int SELW_OFF = 134 * 1024, BT_OFF = 142 * 1024, KVP = 528, TILE_STRIDE = 32 * KVP;
constexpr int SELW_OFF_OLD = 132 * 1024, BT_OFF_OLD = 140 * 1024;
__device__ __forceinline__ int kv_off(int row, int ch) { const int hf = ch >> 4, c16 = ch & 15; return hf * 8192 + 256 * row + 16 * (c16 ^ (((row & 3) << 2) | ((row >> 2) & 3))); }
#define TR4I(d0, d1, d2, d3, base, o0, o1, o2, o3) asm volatile("ds_read_b64_tr_b16 %0, %4 offset:%5\n\tds_read_b64_tr_b16 %1, %4 offset:%6\n\tds_read_b64_tr_b16 %2, %4 offset:%7\n\tds_read_b64_tr_b16 %3, %4 offset:%8" \
    : "=&v"(d0), "=&v"(d1), "=&v"(d2), "=&v"(d3) : "v"(base), "i"(o0), "i"(o1), "i"(o2), "i"(o3) : "memory")
#define TR8N(d0, d1, d2, d3, d4, d5, d6, d7, base, o0, o1, o2, o3, o4, o5, o6, o7) asm volatile( \
    "ds_read_b64_tr_b16 %0, %8 offset:%9\n\tds_read_b64_tr_b16 %1, %8 offset:%10\n\tds_read_b64_tr_b16 %2, %8 offset:%11\n\tds_read_b64_tr_b16 %3, %8 offset:%12\n\t" \
    "ds_read_b64_tr_b16 %4, %8 offset:%13\n\tds_read_b64_tr_b16 %5, %8 offset:%14\n\tds_read_b64_tr_b16 %6, %8 offset:%15\n\tds_read_b64_tr_b16 %7, %8 offset:%16" \
    : "=&v"(d0), "=&v"(d1), "=&v"(d2), "=&v"(d3), "=&v"(d4), "=&v"(d5), "=&v"(d6), "=&v"(d7) : "v"(base), "i"(o0), "i"(o1), "i"(o2), "i"(o3), "i"(o4), "i"(o5), "i"(o6), "i"(o7) : "memory")
#define WAITPIN8(n, d0, d1, d2, d3, d4, d5, d6, d7) asm volatile("s_waitcnt lgkmcnt(" #n ")" : "+v"(d0), "+v"(d1), "+v"(d2), "+v"(d3), "+v"(d4), "+v"(d5), "+v"(d6), "+v"(d7) :: "memory")
#define WAITPIN4(n, d0, d1, d2, d3) asm volatile("s_waitcnt lgkmcnt(" #n ")" : "+v"(d0), "+v"(d1), "+v"(d2), "+v"(d3) :: "memory")
__device__ __forceinline__ bf16x8_t mk8a(u16x4_t a, u16x4_t b) { bf16x8_t r; r[0] = a[0]; r[1] = a[1]; r[2] = a[2]; r[3] = a[3]; r[4] = b[0]; r[5] = b[1]; r[6] = b[2]; r[7] = b[3]; return r; }
#define TR8I(d0, d1, d2, d3, d4, d5, d6, d7, base, o0, o1, o2, o3, o4, o5, o6, o7) asm volatile( \
    "ds_read_b64_tr_b16 %0, %8 offset:%9\n\tds_read_b64_tr_b16 %1, %8 offset:%10\n\tds_read_b64_tr_b16 %2, %8 offset:%11\n\tds_read_b64_tr_b16 %3, %8 offset:%12\n\t" \
    "ds_read_b64_tr_b16 %4, %8 offset:%13\n\tds_read_b64_tr_b16 %5, %8 offset:%14\n\tds_read_b64_tr_b16 %6, %8 offset:%15\n\tds_read_b64_tr_b16 %7, %8 offset:%16\n\ts_waitcnt lgkmcnt(0)" \
    : "=&v"(d0), "=&v"(d1), "=&v"(d2), "=&v"(d3), "=&v"(d4), "=&v"(d5), "=&v"(d6), "=&v"(d7) : "v"(base), "i"(o0), "i"(o1), "i"(o2), "i"(o3), "i"(o4), "i"(o5), "i"(o6), "i"(o7) : "memory")
#define TR8(d0, d1, d2, d3, d4, d5, d6, d7, a0, a1, a2, a3, a4, a5, a6, a7) asm volatile( \
    "ds_read_b64_tr_b16 %0, %8\n\tds_read_b64_tr_b16 %1, %9\n\tds_read_b64_tr_b16 %2, %10\n\tds_read_b64_tr_b16 %3, %11\n\t" \
    "ds_read_b64_tr_b16 %4, %12\n\tds_read_b64_tr_b16 %5, %13\n\tds_read_b64_tr_b16 %6, %14\n\tds_read_b64_tr_b16 %7, %15\n\ts_waitcnt lgkmcnt(0)" \
    : "=&v"(d0), "=&v"(d1), "=&v"(d2), "=&v"(d3), "=&v"(d4), "=&v"(d5), "=&v"(d6), "=&v"(d7) : "v"(a0), "v"(a1), "v"(a2), "v"(a3), "v"(a4), "v"(a5), "v"(a6), "v"(a7) : "memory")
__device__ __forceinline__ void wg_attn16(LDSP unsigned char* lds, bf16* RA, const bf16* __restrict__ CKVC, const unsigned short* __restrict__ idx, const bf16* __restrict__ WUK, const bf16* __restrict__ WUV,
                                          const float* __restrict__ rel_bias, int unit, int nxt_unit, int par, bool first, int tid, bool dry = false, int qmode = 0, bf16* qscr = nullptr) {
    const int lane = tid & 63, wave = __builtin_amdgcn_readfirstlane(tid >> 6), g = lane >> 4, c = lane & 15;
    const int b = unit >> 9, qg = unit & 511, t0 = b * SEQ + qg * 8, nk = ((qg >> 3) + 1) << 6, nsel = nk < TOPK ? nk : TOPK, ntile = nsel >> 5;
    LDSP unsigned char* QL = lds;
    LDSP unsigned char* tile = lds + wave * TILE_STRIDE;
    LDSP unsigned short* selw = (LDSP unsigned short*)(lds + SELW_OFF + (par * 8 + wave) * 512);
    LDSP unsigned short* selw_n = (LDSP unsigned short*)(lds + SELW_OFF + ((par ^ 1) * 8 + wave) * 512);
    if (first) { if (lane < 32) *((LDSP u32x4*)selw + lane) = *((const u32x4*)(idx + (size_t)(t0 + wave) * TOPK) + lane); }
    const bf16* kvb = CKVC + (size_t)b * SEQ * KV_R + g * 8;
    bf16x8_t kv0[8], kv1[8];
#define KV_LOAD(dst, key) do { const bf16* rp_ = kvb + (size_t)(key) * KV_R; _Pragma("unroll") for (int ks_ = 0; ks_ < 8; ++ks_) dst[ks_] = *(const bf16x8_t*)(rp_ + ks_ * 32); } while (0)
    int ka = (int)selw[c], kb = (int)selw[16 + c];
    KV_LOAD(kv0, ka); KV_LOAD(kv1, kb);
    bf16x8_t qf[8];
    if (qmode != 2) {
        const int h = wave; const bf16* qr = RA + (size_t)(t0 + (qmode == 1 ? c : (c & 7))) * NA + A_Q + h * 64 + g * 8;
        const bf16x8_t b0 = *(const bf16x8_t*)qr, b1 = *(const bf16x8_t*)(qr + 32);
        const bf16* wb = WUK + ((size_t)h * 256 + c) * 64 + g * 8;
#pragma unroll 4
        for (int rt = 0; rt < 16; ++rt) { const bf16x8_t a0 = *(const bf16x8_t*)(wb + rt * 16 * 64), a1 = *(const bf16x8_t*)(wb + rt * 16 * 64 + 32);
            pg8::f32x4 acc = {0.f, 0.f, 0.f, 0.f};
            acc = __builtin_amdgcn_mfma_f32_16x16x32_bf16(a0, b0, acc, 0, 0, 0); acc = __builtin_amdgcn_mfma_f32_16x16x32_bf16(a1, b1, acc, 0, 0, 0);
            u32x2 w; w.x = pk2(acc[0], acc[1]); w.y = pk2(acc[2], acc[3]);
            if (c < 8) *(LDSP u32x2*)(QL + (((c * 8 + h) * 256) + rt * 16 + 4 * g) * 2) = w;
            else if (qmode == 1) *(u32x2*)(qscr + ((((c - 8) * 8 + h) * 256) + rt * 16 + 4 * g)) = w; }
        asm volatile("s_waitcnt lgkmcnt(0)" ::: "memory"); __builtin_amdgcn_s_barrier(); asm volatile("" ::: "memory");
#pragma unroll
        for (int ks = 0; ks < 8; ++ks) qf[ks] = *(const LDSP bf16x8_t*)(QL + (((wave * 8 + (c & 7)) * 256) + ks * 32 + g * 8) * 2);
        asm volatile("s_waitcnt lgkmcnt(0)" ::: "memory"); __builtin_amdgcn_s_barrier(); asm volatile("" ::: "memory");
    } else {
        const unsigned long long* qs = (const unsigned long long*)(qscr + (((wave * 8 + (c & 7)) * 256) + g * 8));
#pragma unroll
        for (int ks = 0; ks < 8; ++ks) { const unsigned long long lo = __hip_atomic_load(qs + ks * 8, __ATOMIC_RELAXED, __HIP_MEMORY_SCOPE_AGENT), hi = __hip_atomic_load(qs + ks * 8 + 1, __ATOMIC_RELAXED, __HIP_MEMORY_SCOPE_AGENT);
            u32x4 w; w.x = (unsigned)lo; w.y = (unsigned)(lo >> 32); w.z = (unsigned)hi; w.w = (unsigned)(hi >> 32); qf[ks] = __builtin_bit_cast(bf16x8_t, w); }
    }
    const unsigned tile_a = (unsigned)(size_t)tile;
#if ATT_STAGGER
    if (wave >= 4) __builtin_amdgcn_s_sleep(ATT_STAGGER);
#endif
    bf16x8_t bbf; { float bv[8];
#pragma unroll
        for (int j = 0; j < 8; ++j) bv[j] = rel_bias[(8 * g + j) * 8 + (c & 7)];
        u32x4 w; w.x = pk2(bv[0], bv[1]); w.y = pk2(bv[2], bv[3]); w.z = pk2(bv[4], bv[5]); w.w = pk2(bv[6], bv[7]); bbf = __builtin_bit_cast(bf16x8_t, w); }
    {
        const int spos = (qg * 8 + wave);
        pg8::f32x4 acc[16];
#pragma unroll
        for (int nt = 0; nt < 16; ++nt) acc[nt] = (pg8::f32x4){0.f, 0.f, 0.f, 0.f};
        float m_run = -INFINITY, l_run = 0.f;
#define ONEHOT(dst, key) do { const int rel_ = (key) - spos, n_ = rel_ < 0 ? -rel_ : rel_; \
            const int big_ = 8 + (n_ >= 15) + (n_ >= 27) + (n_ >= 50) + (n_ >= 91) + (n_ >= 166) + (n_ >= 305) + (n_ >= 559); \
            const int pos_ = (n_ < 8 ? n_ : big_) + (rel_ > 0 ? 16 : 0) - 8 * g; const unsigned one_ = (pos_ & 1) ? 0x3F800000u : 0x3F80u; const int hi_ = pos_ >> 1; \
            u32x4 w_; w_.x = (hi_ == 0) ? one_ : 0u; w_.y = (hi_ == 1) ? one_ : 0u; w_.z = (hi_ == 2) ? one_ : 0u; w_.w = (hi_ == 3) ? one_ : 0u; dst = __builtin_bit_cast(bf16x8_t, w_); } while (0)
        const int q4 = c >> 2, p = c & 3;
        const unsigned trb = tile_a + (4 * g + q4) * KVP + 8 * p;
        for (int tl = 0; tl < ntile; ++tl) {
            int kan = 0, kbn = 0; const bool more = tl + 1 < ntile;
            if (more) { kan = (int)selw[(2 * tl + 2) * 16 + c]; kbn = (int)selw[(2 * tl + 3) * 16 + c]; }
            bf16x8_t oha, ohb; ONEHOT(oha, ka); ONEHOT(ohb, kb);
            asm volatile("s_waitcnt vmcnt(8)" ::: "memory");
            pg8::f32x4 s0 = {0.f, 0.f, 0.f, 0.f}, s1 = {0.f, 0.f, 0.f, 0.f};
            s0 = __builtin_amdgcn_mfma_f32_16x16x32_bf16(oha, bbf, s0, 0, 0, 0);
#pragma unroll
            for (int ks = 0; ks < 8; ++ks) { s0 = __builtin_amdgcn_mfma_f32_16x16x32_bf16(kv0[ks], qf[ks], s0, 0, 0, 0); *(LDSP bf16x8_t*)(tile + c * KVP + g * 16 + ks * 64) = kv0[ks]; }
            if (more) KV_LOAD(kv0, kan);
            if (more) asm volatile("s_waitcnt vmcnt(8)" ::: "memory"); else asm volatile("s_waitcnt vmcnt(0)" ::: "memory");
            s1 = __builtin_amdgcn_mfma_f32_16x16x32_bf16(ohb, bbf, s1, 0, 0, 0);
#pragma unroll
            for (int ks = 0; ks < 8; ++ks) { s1 = __builtin_amdgcn_mfma_f32_16x16x32_bf16(kv1[ks], qf[ks], s1, 0, 0, 0); *(LDSP bf16x8_t*)(tile + (16 + c) * KVP + g * 16 + ks * 64) = kv1[ks]; }
            if (more) KV_LOAD(kv1, kbn);
            ka = kan; kb = kbn;
            float sv[8];
#pragma unroll
            for (int j = 0; j < 4; ++j) { sv[j] = s0[j]; sv[4 + j] = s1[j]; }
            float tmax = fmaxf(fmaxf(fmaxf(sv[0], sv[1]), fmaxf(sv[2], sv[3])), fmaxf(fmaxf(sv[4], sv[5]), fmaxf(sv[6], sv[7])));
            tmax = fmaxf(tmax, __shfl_xor(tmax, 16)); tmax = fmaxf(tmax, __shfl_xor(tmax, 32));
            const float m_new = fmaxf(m_run, tmax); const float scl = __expf(m_run - m_new); const bool grow = m_new > m_run; m_run = m_new;
            float ps = 0.f;
#pragma unroll
            for (int j = 0; j < 8; ++j) { sv[j] = __expf(sv[j] - m_new); ps += sv[j]; }
            l_run = l_run * scl + ps;
            bf16x8_t pf; { u32x4 w; w.x = pk2(sv[0], sv[1]); w.y = pk2(sv[2], sv[3]); w.z = pk2(sv[4], sv[5]); w.w = pk2(sv[6], sv[7]); pf = __builtin_bit_cast(bf16x8_t, w); }
            if (__builtin_amdgcn_ballot_w64(grow) != 0ull) {
                float rs[4];
#pragma unroll
                for (int e = 0; e < 4; ++e) rs[e] = __shfl(scl, 4 * g + e);
#pragma unroll
                for (int nt = 0; nt < 16; ++nt) {
#pragma unroll
                    for (int e = 0; e < 4; ++e) acc[nt][e] *= rs[e]; } }
            asm volatile("s_waitcnt lgkmcnt(0)" ::: "memory");
            u16x4_t va[8], vb[8];
            TR8N(va[0], va[1], va[2], va[3], va[4], va[5], va[6], va[7], trb, 0, 16 * KVP, 32, 32 + 16 * KVP, 64, 64 + 16 * KVP, 96, 96 + 16 * KVP);
            TR8N(vb[0], vb[1], vb[2], vb[3], vb[4], vb[5], vb[6], vb[7], trb, 128, 128 + 16 * KVP, 160, 160 + 16 * KVP, 192, 192 + 16 * KVP, 224, 224 + 16 * KVP);
            WAITPIN8(8, va[0], va[1], va[2], va[3], va[4], va[5], va[6], va[7]);
#pragma unroll
            for (int k = 0; k < 4; ++k) acc[k] = __builtin_amdgcn_mfma_f32_16x16x32_bf16(pf, mk8a(va[2 * k], va[2 * k + 1]), acc[k], 0, 0, 0);
            TR8N(va[0], va[1], va[2], va[3], va[4], va[5], va[6], va[7], trb, 256, 256 + 16 * KVP, 288, 288 + 16 * KVP, 320, 320 + 16 * KVP, 352, 352 + 16 * KVP);
            WAITPIN8(8, vb[0], vb[1], vb[2], vb[3], vb[4], vb[5], vb[6], vb[7]);
#pragma unroll
            for (int k = 0; k < 4; ++k) acc[4 + k] = __builtin_amdgcn_mfma_f32_16x16x32_bf16(pf, mk8a(vb[2 * k], vb[2 * k + 1]), acc[4 + k], 0, 0, 0);
            TR8N(vb[0], vb[1], vb[2], vb[3], vb[4], vb[5], vb[6], vb[7], trb, 384, 384 + 16 * KVP, 416, 416 + 16 * KVP, 448, 448 + 16 * KVP, 480, 480 + 16 * KVP);
            WAITPIN8(8, va[0], va[1], va[2], va[3], va[4], va[5], va[6], va[7]);
#pragma unroll
            for (int k = 0; k < 4; ++k) acc[8 + k] = __builtin_amdgcn_mfma_f32_16x16x32_bf16(pf, mk8a(va[2 * k], va[2 * k + 1]), acc[8 + k], 0, 0, 0);
            WAITPIN8(0, vb[0], vb[1], vb[2], vb[3], vb[4], vb[5], vb[6], vb[7]);
#pragma unroll
            for (int k = 0; k < 4; ++k) acc[12 + k] = __builtin_amdgcn_mfma_f32_16x16x32_bf16(pf, mk8a(vb[2 * k], vb[2 * k + 1]), acc[12 + k], 0, 0, 0);
        }
#undef KV_LOAD
#undef ONEHOT
        float lt = l_run + __shfl_xor(l_run, 16); lt += __shfl_xor(lt, 32); const float inv = 1.0f / lt;
        float ri[4];
#pragma unroll
        for (int e = 0; e < 4; ++e) ri[e] = __shfl(inv, 4 * g + e);
        if (g < 2) {
#pragma unroll
            for (int nt = 0; nt < 16; ++nt) { LDSP unsigned short* o1 = (LDSP unsigned short*)(tile) + (4 * g) * 256 + nt * 16 + c;
                o1[0] = f2bf(acc[nt][0] * ri[0]); o1[256] = f2bf(acc[nt][1] * ri[1]); o1[512] = f2bf(acc[nt][2] * ri[2]); o1[768] = f2bf(acc[nt][3] * ri[3]); }
        }
    }
    u32x4 nsel_v = {0u, 0u, 0u, 0u};
    if (nxt_unit >= 0 && lane < 32) { const int nb = nxt_unit >> 9, nq = nxt_unit & 511; nsel_v = *((const u32x4*)(idx + (size_t)(nb * SEQ + nq * 8 + wave) * TOPK) + lane); }
    asm volatile("s_waitcnt lgkmcnt(0)" ::: "memory"); __builtin_amdgcn_s_barrier(); asm volatile("" ::: "memory");
    if (qmode == 1) {
        bf16* oscr = qscr + 16384;
#pragma unroll
        for (int j = 0; j < 4; ++j) *((u32x4*)(oscr + (size_t)wave * 2048) + j * 64 + lane) = *((const LDSP u32x4*)(tile) + j * 64 + lane);
    } else {
        const int h = wave; pg8::f32x4 o[4];
#pragma unroll
        for (int nt = 0; nt < 4; ++nt) o[nt] = (pg8::f32x4){0.f, 0.f, 0.f, 0.f};
        const LDSP unsigned char* ab = lds + TILE_STRIDE * (c & 7) + (h * 256 + g * 8) * 2;
        const unsigned long long* os = (const unsigned long long*)(qscr + 16384 + ((c & 7) * 8 + h) * 256 + g * 8);
        const bf16* wb = WUV + ((size_t)h * 64 + c) * 256 + g * 8;
        const bool from_scr = (qmode == 2) && (c < 8);
#pragma unroll
        for (int ks = 0; ks < 8; ++ks) { bf16x8_t a;
            if (from_scr) { const unsigned long long lo = __hip_atomic_load(os + ks * 8, __ATOMIC_RELAXED, __HIP_MEMORY_SCOPE_AGENT), hi = __hip_atomic_load(os + ks * 8 + 1, __ATOMIC_RELAXED, __HIP_MEMORY_SCOPE_AGENT);
                u32x4 w; w.x = (unsigned)lo; w.y = (unsigned)(lo >> 32); w.z = (unsigned)hi; w.w = (unsigned)(hi >> 32); a = __builtin_bit_cast(bf16x8_t, w); }
            else a = *(const LDSP bf16x8_t*)(ab + ks * 64);
#pragma unroll
            for (int nt = 0; nt < 4; ++nt) { const bf16x8_t bw = *(const bf16x8_t*)(wb + (size_t)nt * 16 * 256 + ks * 32); o[nt] = __builtin_amdgcn_mfma_f32_16x16x32_bf16(a, bw, o[nt], 0, 0, 0); } }
        const int rbase = (qmode == 2) ? t0 - 8 : t0;
        if ((g < 2 || qmode == 2) && !dry) {
#pragma unroll
            for (int nt = 0; nt < 4; ++nt)
#pragma unroll
                for (int e = 0; e < 4; ++e) RA[(size_t)(rbase + 4 * g + e) * NA + A_Q + h * 64 + nt * 16 + c] = f2bf(o[nt][e]); }
    }
    if (nxt_unit >= 0 && lane < 32) *((LDSP u32x4*)selw_n + lane) = nsel_v;
    asm volatile("s_waitcnt vmcnt(0) lgkmcnt(0)" ::: "memory"); __builtin_amdgcn_s_barrier(); asm volatile("" ::: "memory");
}

__device__ __forceinline__ void wg_attn16d(LDSP unsigned char* lds, bf16* RA, const bf16* __restrict__ CKVC, const unsigned short* __restrict__ idx, const bf16* __restrict__ WUK, const bf16* __restrict__ WUV,
                                          const float* __restrict__ rel_bias, int unit, int nxt_unit, int par, bool first, int tid, bool dry = false, int qmode = 0, bf16* qscr = nullptr) {
    const int lane = tid & 63, wave = __builtin_amdgcn_readfirstlane(tid >> 6), g = lane >> 4, c = lane & 15;
    const int b = unit >> 9, qg = unit & 511, t0 = b * SEQ + qg * 8, nk = ((qg >> 3) + 1) << 6, nsel = nk < TOPK ? nk : TOPK, ntile = nsel >> 5;
    LDSP unsigned char* QL = lds;
    LDSP unsigned char* tile = lds + wave * TILE_STRIDE;
    LDSP unsigned short* selw = (LDSP unsigned short*)(lds + SELW_OFF + (par * 8 + wave) * 512);
    LDSP unsigned short* selw_n = (LDSP unsigned short*)(lds + SELW_OFF + ((par ^ 1) * 8 + wave) * 512);
    if (first) { if (lane < 32) *((LDSP u32x4*)selw + lane) = *((const u32x4*)(idx + (size_t)(t0 + wave) * TOPK) + lane); }
    const bf16* kvb = CKVC + (size_t)b * SEQ * KV_R;
    const int nstep = nsel >> 4;
#define KV_DMA(step) do { LDSP unsigned char* sl_ = tile + ((step) & 1) * 8192; \
        _Pragma("unroll") for (int i4_ = 0; i4_ < 4; ++i4_) { const int row_ = 4 * i4_ + g; const int key_ = (int)selw[(step) * 16 + row_]; const int c16_ = c ^ ((g << 2) | i4_); \
            const bf16* src_ = kvb + (size_t)key_ * KV_R + c16_ * 8; \
            __builtin_amdgcn_global_load_lds((const unsigned*)src_, (LDSP unsigned*)(sl_ + 1024 * i4_), 16, 0, 0); \
            __builtin_amdgcn_global_load_lds((const unsigned*)(src_ + 128), (LDSP unsigned*)(sl_ + 4096 + 1024 * i4_), 16, 0, 0); } } while (0)
    KV_DMA(0);
    bf16x8_t qf[8];
    if (qmode != 2) {
        const int h = wave; const bf16* qr = RA + (size_t)(t0 + (qmode == 1 ? c : (c & 7))) * NA + A_Q + h * 64 + g * 8;
        const bf16x8_t b0 = *(const bf16x8_t*)qr, b1 = *(const bf16x8_t*)(qr + 32);
        const bf16* wb = WUK + ((size_t)h * 256 + c) * 64 + g * 8;
#pragma unroll 4
        for (int rt = 0; rt < 16; ++rt) { const bf16x8_t a0 = *(const bf16x8_t*)(wb + rt * 16 * 64), a1 = *(const bf16x8_t*)(wb + rt * 16 * 64 + 32);
            pg8::f32x4 acc = {0.f, 0.f, 0.f, 0.f};
            acc = __builtin_amdgcn_mfma_f32_16x16x32_bf16(a0, b0, acc, 0, 0, 0); acc = __builtin_amdgcn_mfma_f32_16x16x32_bf16(a1, b1, acc, 0, 0, 0);
            u32x2 w; w.x = pk2(acc[0], acc[1]); w.y = pk2(acc[2], acc[3]);
            if (c < 8) *(LDSP u32x2*)(lds + c * TILE_STRIDE + 8192 + ((h * 256) + rt * 16 + 4 * g) * 2) = w;
            else if (qmode == 1) *(u32x2*)(qscr + ((((c - 8) * 8 + h) * 256) + rt * 16 + 4 * g)) = w; }
        asm volatile("s_waitcnt lgkmcnt(0)" ::: "memory"); __builtin_amdgcn_s_barrier(); asm volatile("" ::: "memory");
#pragma unroll
        for (int ks = 0; ks < 8; ++ks) qf[ks] = *(const LDSP bf16x8_t*)(tile + 8192 + (((c & 7) * 256) + ks * 32 + g * 8) * 2);
        asm volatile("s_waitcnt lgkmcnt(0)" ::: "memory"); __builtin_amdgcn_s_barrier(); asm volatile("" ::: "memory");
    } else {
        const unsigned long long* qs = (const unsigned long long*)(qscr + (((wave * 8 + (c & 7)) * 256) + g * 8));
#pragma unroll
        for (int ks = 0; ks < 8; ++ks) { const unsigned long long lo = __hip_atomic_load(qs + ks * 8, __ATOMIC_RELAXED, __HIP_MEMORY_SCOPE_AGENT), hi = __hip_atomic_load(qs + ks * 8 + 1, __ATOMIC_RELAXED, __HIP_MEMORY_SCOPE_AGENT);
            u32x4 w; w.x = (unsigned)lo; w.y = (unsigned)(lo >> 32); w.z = (unsigned)hi; w.w = (unsigned)(hi >> 32); qf[ks] = __builtin_bit_cast(bf16x8_t, w); }
    }
    const unsigned tile_a = (unsigned)(size_t)tile;
#if ATT_STAGGER
    if (wave >= 4) __builtin_amdgcn_s_sleep(ATT_STAGGER);
#endif
    bf16x8_t bbf; { float bv[8];
#pragma unroll
        for (int j = 0; j < 8; ++j) bv[j] = rel_bias[(8 * g + j) * 8 + (c & 7)];
        u32x4 w; w.x = pk2(bv[0], bv[1]); w.y = pk2(bv[2], bv[3]); w.z = pk2(bv[4], bv[5]); w.w = pk2(bv[6], bv[7]); bbf = __builtin_bit_cast(bf16x8_t, w); }
    {
        const int spos = (qg * 8 + wave);
        pg8::f32x4 acc[16];
#pragma unroll
        for (int nt = 0; nt < 16; ++nt) acc[nt] = (pg8::f32x4){0.f, 0.f, 0.f, 0.f};
        float m_run = -INFINITY, l_run = 0.f;
#define ONEHOT(dst, key) do { const int rel_ = (key) - spos, n_ = rel_ < 0 ? -rel_ : rel_; \
            const int big_ = 8 + (n_ >= 15) + (n_ >= 27) + (n_ >= 50) + (n_ >= 91) + (n_ >= 166) + (n_ >= 305) + (n_ >= 559); \
            const int pos_ = (n_ < 8 ? n_ : big_) + (rel_ > 0 ? 16 : 0) - 8 * g; const unsigned one_ = (pos_ & 1) ? 0x3F800000u : 0x3F80u; const int hi_ = pos_ >> 1; \
            u32x4 w_; w_.x = (hi_ == 0) ? one_ : 0u; w_.y = (hi_ == 1) ? one_ : 0u; w_.z = (hi_ == 2) ? one_ : 0u; w_.w = (hi_ == 3) ? one_ : 0u; dst = __builtin_bit_cast(bf16x8_t, w_); } while (0)
        const int q4 = c >> 2, p = c & 3;
        const unsigned rd0 = tile_a + 256 * c + 16 * (g ^ (c >> 2)); const unsigned rx = (unsigned)(c & 3);
        const unsigned tr0 = tile_a + 256 * (4 * g + q4) + 8 * (p & 1); const unsigned ts = (unsigned)(((q4 << 2) | g)), tb0 = (unsigned)(p >> 1);
        if (nstep > 1) KV_DMA(1);
        for (int st = 0; st < nstep; ++st) {
            const unsigned so = (unsigned)((st & 1) * 8192);
            const int key = (int)selw[st * 16 + c];
            bf16x8_t oh; ONEHOT(oh, key);
            if (st + 1 < nstep) asm volatile("s_waitcnt vmcnt(8)" ::: "memory"); else asm volatile("s_waitcnt vmcnt(0)" ::: "memory");
            bf16x8_t af[8]; u16x4_t v[16];
#pragma unroll
            for (int ks = 0; ks < 8; ++ks) af[ks] = *(const LDSP bf16x8_t*)(size_t)(rd0 + so + (ks >> 2) * 4096 + 64 * (((unsigned)(ks & 3)) ^ rx));
#pragma unroll
            for (int n4 = 0; n4 < 4; ++n4) { unsigned ad[4];
#pragma unroll
                for (int k = 0; k < 4; ++k) { const unsigned nt = (unsigned)(n4 * 4 + k); ad[k] = tr0 + so + (nt >> 3) * 4096 + 16 * ((((nt & 7) << 1) | tb0) ^ ts); }
                asm volatile("ds_read_b64_tr_b16 %0, %4\n\tds_read_b64_tr_b16 %1, %5\n\tds_read_b64_tr_b16 %2, %6\n\tds_read_b64_tr_b16 %3, %7" : "=&v"(v[n4 * 4]), "=&v"(v[n4 * 4 + 1]), "=&v"(v[n4 * 4 + 2]), "=&v"(v[n4 * 4 + 3]) : "v"(ad[0]), "v"(ad[1]), "v"(ad[2]), "v"(ad[3]) : "memory"); }
            WAITPIN4(0, v[0], v[1], v[2], v[3]); WAITPIN4(0, v[4], v[5], v[6], v[7]); WAITPIN4(0, v[8], v[9], v[10], v[11]); WAITPIN4(0, v[12], v[13], v[14], v[15]);
            if (st + 2 < nstep) KV_DMA(st + 2);
            pg8::f32x4 s0 = {0.f, 0.f, 0.f, 0.f};
            s0 = __builtin_amdgcn_mfma_f32_16x16x32_bf16(oh, bbf, s0, 0, 0, 0);
#pragma unroll
            for (int ks = 0; ks < 8; ++ks) s0 = __builtin_amdgcn_mfma_f32_16x16x32_bf16(af[ks], qf[ks], s0, 0, 0, 0);
            float tmax = fmaxf(fmaxf(s0[0], s0[1]), fmaxf(s0[2], s0[3]));
            tmax = fmaxf(tmax, __shfl_xor(tmax, 16)); tmax = fmaxf(tmax, __shfl_xor(tmax, 32));
            const float m_new = fmaxf(m_run, tmax); const float scl = __expf(m_run - m_new); const bool grow = m_new > m_run; m_run = m_new;
            float sv[4]; float ps = 0.f;
#pragma unroll
            for (int j = 0; j < 4; ++j) { sv[j] = __expf(s0[j] - m_new); ps += sv[j]; }
            l_run = l_run * scl + ps;
            typedef short bf16x4_t __attribute__((ext_vector_type(4)));
            bf16x4_t pf; { u32x2 w; w.x = pk2(sv[0], sv[1]); w.y = pk2(sv[2], sv[3]); pf = __builtin_bit_cast(bf16x4_t, w); }
            if (__builtin_amdgcn_ballot_w64(grow) != 0ull) {
                float rs[4];
#pragma unroll
                for (int e = 0; e < 4; ++e) rs[e] = __shfl(scl, 4 * g + e);
#pragma unroll
                for (int nt = 0; nt < 16; ++nt) {
#pragma unroll
                    for (int e = 0; e < 4; ++e) acc[nt][e] *= rs[e]; } }
#pragma unroll
            for (int k = 0; k < 16; ++k) acc[k] = __builtin_amdgcn_mfma_f32_16x16x16bf16_1k(pf, __builtin_bit_cast(bf16x4_t, v[k]), acc[k], 0, 0, 0);
        }
#undef KV_DMA
#undef ONEHOT
        float lt = l_run + __shfl_xor(l_run, 16); lt += __shfl_xor(lt, 32); const float inv = 1.0f / lt;
        float ri[4];
#pragma unroll
        for (int e = 0; e < 4; ++e) ri[e] = __shfl(inv, 4 * g + e);
        if (g < 2) {
#pragma unroll
            for (int nt = 0; nt < 16; ++nt) { LDSP unsigned short* o1 = (LDSP unsigned short*)(tile) + (4 * g) * 256 + nt * 16 + c;
                o1[0] = f2bf(acc[nt][0] * ri[0]); o1[256] = f2bf(acc[nt][1] * ri[1]); o1[512] = f2bf(acc[nt][2] * ri[2]); o1[768] = f2bf(acc[nt][3] * ri[3]); }
        }
    }
    u32x4 nsel_v = {0u, 0u, 0u, 0u};
    if (nxt_unit >= 0 && lane < 32) { const int nb = nxt_unit >> 9, nq = nxt_unit & 511; nsel_v = *((const u32x4*)(idx + (size_t)(nb * SEQ + nq * 8 + wave) * TOPK) + lane); }
    asm volatile("s_waitcnt lgkmcnt(0)" ::: "memory"); __builtin_amdgcn_s_barrier(); asm volatile("" ::: "memory");
    if (qmode == 1) {
        bf16* oscr = qscr + 16384;
#pragma unroll
        for (int j = 0; j < 4; ++j) *((u32x4*)(oscr + (size_t)wave * 2048) + j * 64 + lane) = *((const LDSP u32x4*)(tile) + j * 64 + lane);
    } else {
        const int h = wave; pg8::f32x4 o[4];
#pragma unroll
        for (int nt = 0; nt < 4; ++nt) o[nt] = (pg8::f32x4){0.f, 0.f, 0.f, 0.f};
        const LDSP unsigned char* ab = lds + TILE_STRIDE * (c & 7) + (h * 256 + g * 8) * 2;
        const unsigned long long* os = (const unsigned long long*)(qscr + 16384 + ((c & 7) * 8 + h) * 256 + g * 8);
        const bf16* wb = WUV + ((size_t)h * 64 + c) * 256 + g * 8;
        const bool from_scr = (qmode == 2) && (c < 8);
#pragma unroll
        for (int ks = 0; ks < 8; ++ks) { bf16x8_t a;
            if (from_scr) { const unsigned long long lo = __hip_atomic_load(os + ks * 8, __ATOMIC_RELAXED, __HIP_MEMORY_SCOPE_AGENT), hi = __hip_atomic_load(os + ks * 8 + 1, __ATOMIC_RELAXED, __HIP_MEMORY_SCOPE_AGENT);
                u32x4 w; w.x = (unsigned)lo; w.y = (unsigned)(lo >> 32); w.z = (unsigned)hi; w.w = (unsigned)(hi >> 32); a = __builtin_bit_cast(bf16x8_t, w); }
            else a = *(const LDSP bf16x8_t*)(ab + ks * 64);
#pragma unroll
            for (int nt = 0; nt < 4; ++nt) { const bf16x8_t bw = *(const bf16x8_t*)(wb + (size_t)nt * 16 * 256 + ks * 32); o[nt] = __builtin_amdgcn_mfma_f32_16x16x32_bf16(a, bw, o[nt], 0, 0, 0); } }
        const int rbase = (qmode == 2) ? t0 - 8 : t0;
        if ((g < 2 || qmode == 2) && !dry) {
#pragma unroll
            for (int nt = 0; nt < 4; ++nt)
#pragma unroll
                for (int e = 0; e < 4; ++e) RA[(size_t)(rbase + 4 * g + e) * NA + A_Q + h * 64 + nt * 16 + c] = f2bf(o[nt][e]); }
    }
    if (nxt_unit >= 0 && lane < 32) *((LDSP u32x4*)selw_n + lane) = nsel_v;
    asm volatile("s_waitcnt vmcnt(0) lgkmcnt(0)" ::: "memory"); __builtin_amdgcn_s_barrier(); asm volatile("" ::: "memory");
}

#ifndef SSM_SPLIT_V
#define SSM_SPLIT_V 42
#endif
constexpr int SSM_SPLIT = SSM_SPLIT_V;
constexpr int XP = 144, BP = 272;
constexpr int SB_X = 0, SB_B = 8192, SB_C = 24576, SB_SIZE = 40960;
constexpr int L_XS = 2 * SB_SIZE, L_M = L_XS + 64 * XP, L_HC = L_M + 64 * XP, L_TB = L_HC + 2 * 64 * BP;
static_assert(L_TB + 2048 <= 140 * 1024, "ssm lds");
#define TR2(d0, d1, a0, a1) asm volatile("ds_read_b64_tr_b16 %0, %2\n\tds_read_b64_tr_b16 %1, %3\n\ts_waitcnt lgkmcnt(0)" : "=&v"(d0), "=&v"(d1) : "v"(a0), "v"(a1) : "memory")
__device__ __forceinline__ bf16x8_t mk8(u16x4_t a, u16x4_t b) { bf16x8_t r; r[0] = a[0]; r[1] = a[1]; r[2] = a[2]; r[3] = a[3]; r[4] = b[0]; r[5] = b[1]; r[6] = b[2]; r[7] = b[3]; return r; }
__device__ __forceinline__ int bc_off(int row, int ch) { return 256 * row + 16 * (ch ^ (((row & 3) << 2) | ((row >> 2) & 3))); }
__device__ __forceinline__ void ssm_dma(LDSP unsigned char* buf, const bf16* __restrict__ XA, int tc0, int h, int grp, int wave, int lane, bool full) {
    const int npc = full ? 40 : 24;
    for (int p = wave; p < npc; p += 8) {
        const bf16* src;
        if (p < 8) { const int row = 8 * p + (lane >> 3), ch = lane & 7; src = XA + (size_t)(tc0 + row) * XBC + h * 64 + ch * 8; }
        else { const int pp = (p - 8) & 15, row = 4 * pp + (lane >> 4), ch = (lane & 15) ^ (((row & 3) << 2) | ((row >> 2) & 3)); src = XA + (size_t)(tc0 + row) * XBC + (p < 24 ? 1024 : 1280) + grp * 128 + ch * 8; }
        __builtin_amdgcn_global_load_lds((const unsigned*)src, (LDSP unsigned*)(buf + 1024 * p), 16, 0, 0);
    }
}
__device__ __forceinline__ void wg_ssm_unit(LDSP unsigned char* lds, bf16* RA, const bf16* __restrict__ XA, const float* __restrict__ DTt,
                                            const float* __restrict__ a_log, const float* __restrict__ dsk, int unit, int tid, bf16* dbg_out = nullptr, bool dry = false) {
    const int lane = tid & 63, wave = __builtin_amdgcn_readfirstlane(tid >> 6), g = lane >> 4, c = lane & 15, q4 = c >> 2, p4 = c & 3;
    const int b = unit >> 5, h = (unit >> 1) & 15, seg = unit & 1, grp = h >> 3, pq = wave & 3, hf = wave >> 2;
    const float Dh = dsk[h];
    const unsigned lds_a = (unsigned)(size_t)lds;
    LDSP float* TB = (LDSP float*)(lds + L_TB);
    typedef float f32x2_t __attribute__((ext_vector_type(2)));
    const f32x2_t* dtp = (const f32x2_t*)DTt + (size_t)(b * 16 + h) * SEQ;
    pg8::f32x4 hacc[4];
#pragma unroll
    for (int nt = 0; nt < 4; ++nt) hacc[nt] = (pg8::f32x4){0.f, 0.f, 0.f, 0.f};
    for (int i = tid; i < (2 * 64 * BP) / 4; i += NTHR) ((LDSP unsigned*)(lds + L_HC))[i] = 0u;
    const int c_end = seg ? 64 : SSM_SPLIT;
    ssm_dma(lds, XA, b * SEQ, h, grp, wave, lane, seg == 0 || SSM_SPLIT == 0);
    f32x2_t dt_cur = dtp[lane];
    asm volatile("s_waitcnt vmcnt(0) lgkmcnt(0)" ::: "memory"); __builtin_amdgcn_s_barrier(); asm volatile("" ::: "memory");
    for (int ci = 0; ci < c_end; ++ci) {
        const bool full = (seg == 0) || (ci >= SSM_SPLIT);
        const int tc0 = b * SEQ + ci * 64;
        LDSP unsigned char* buf = lds + (ci & 1) * SB_SIZE;
        f32x2_t dt_nxt = {0.f, 0.f};
        if (ci + 1 < c_end) { ssm_dma(lds + ((ci + 1) & 1) * SB_SIZE, XA, tc0 + 64, h, grp, wave, lane, (seg == 0) || (ci + 1 >= SSM_SPLIT)); dt_nxt = dtp[(ci + 1) * 64 + lane]; }
        unsigned short zraw[8];
        if (full) {
#pragma unroll
            for (int k2 = 0; k2 < 2; ++k2)
#pragma unroll
                for (int e = 0; e < 4; ++e) zraw[k2 * 4 + e] = RA[(size_t)(tc0 + 16 * (2 * hf + k2) + 4 * g + e) * NA + A_Z + h * 64 + 16 * pq + c]; }
        {   const float dt = dt_cur.x, acs = dt_cur.y; const float tot = __builtin_bit_cast(float, __builtin_amdgcn_readlane(__builtin_bit_cast(int, acs), 63));
            TB[lane] = dt; TB[64 + lane] = acs; TB[128 + lane] = __expf(acs); TB[192 + lane] = __expf(tot - acs) * dt; if (lane == 0) TB[256] = __expf(tot); }
        asm volatile("s_waitcnt lgkmcnt(0)" ::: "memory");
        {   const int row = tid >> 3, ch = tid & 7; const u32x4 xv = *(const LDSP u32x4*)(buf + SB_X + row * 128 + ch * 16); const float wl = TB[192 + row]; const unsigned xw[4] = {xv.x, xv.y, xv.z, xv.w}; u32x4 o;
            o.x = pk2(__builtin_bit_cast(float, xw[0] << 16) * wl, __builtin_bit_cast(float, xw[0] & 0xffff0000u) * wl); o.y = pk2(__builtin_bit_cast(float, xw[1] << 16) * wl, __builtin_bit_cast(float, xw[1] & 0xffff0000u) * wl);
            o.z = pk2(__builtin_bit_cast(float, xw[2] << 16) * wl, __builtin_bit_cast(float, xw[2] & 0xffff0000u) * wl); o.w = pk2(__builtin_bit_cast(float, xw[3] << 16) * wl, __builtin_bit_cast(float, xw[3] & 0xffff0000u) * wl);
            *(LDSP u32x4*)(lds + L_XS + row * XP + ch * 16) = o; }
        if (full) {
            const int lt = wave >> 1;
#pragma unroll
            for (int k2 = 0; k2 < 2; ++k2) { const int st = 2 * (wave & 1) + k2; pg8::f32x4 ga = {0.f, 0.f, 0.f, 0.f};
#pragma unroll
                for (int ks = 0; ks < 4; ++ks) { const bf16x8_t af = *(const LDSP bf16x8_t*)(buf + SB_C + bc_off(16 * lt + c, 4 * ks + g)), bfm = *(const LDSP bf16x8_t*)(buf + SB_B + bc_off(16 * st + c, 4 * ks + g));
                    ga = __builtin_amdgcn_mfma_f32_16x16x32_bf16(af, bfm, ga, 0, 0, 0); }
                const int s = 16 * st + c; const float acs_s = TB[64 + s], dt_s = TB[s];
#pragma unroll
                for (int e = 0; e < 4; ++e) { const int l = 16 * lt + 4 * g + e; const float m = (s <= l) ? ga[e] * __expf(TB[64 + l] - acs_s) * dt_s : 0.f;
                    *(LDSP unsigned short*)(lds + L_M + l * XP + s * 2) = f2bf(m); } }
        }
        asm volatile("s_waitcnt lgkmcnt(0)" ::: "memory"); __builtin_amdgcn_s_barrier(); asm volatile("" ::: "memory");
        if (full) {
            pg8::f32x4 ya[2] = {{0.f, 0.f, 0.f, 0.f}, {0.f, 0.f, 0.f, 0.f}};
            const LDSP unsigned char* hcur = lds + L_HC + (ci & 1) * (64 * BP);
#pragma unroll
            for (int ks = 0; ks < 4; ++ks) { const bf16x8_t hb = *(const LDSP bf16x8_t*)(hcur + (16 * pq + c) * BP + (32 * ks + 8 * g) * 2);
#pragma unroll
                for (int k2 = 0; k2 < 2; ++k2) { const bf16x8_t af = *(const LDSP bf16x8_t*)(buf + SB_C + bc_off(16 * (2 * hf + k2) + c, 4 * ks + g)); ya[k2] = __builtin_amdgcn_mfma_f32_16x16x32_bf16(af, hb, ya[k2], 0, 0, 0); } }
#pragma unroll
            for (int k2 = 0; k2 < 2; ++k2)
#pragma unroll
                for (int e = 0; e < 4; ++e) ya[k2][e] *= TB[128 + 16 * (2 * hf + k2) + 4 * g + e];
#pragma unroll
            for (int ks = 0; ks < 2; ++ks) { u16x4_t x0, x1; const unsigned xa = lds_a + (ci & 1) * SB_SIZE + SB_X + (32 * ks + 8 * g + q4) * 128 + (16 * pq + 4 * p4) * 2; TR2(x0, x1, xa, xa + 4 * 128); const bf16x8_t xb = mk8(x0, x1);
#pragma unroll
                for (int k2 = 0; k2 < 2; ++k2) { const bf16x8_t mf = *(const LDSP bf16x8_t*)(lds + L_M + (16 * (2 * hf + k2) + c) * XP + (32 * ks + 8 * g) * 2); ya[k2] = __builtin_amdgcn_mfma_f32_16x16x32_bf16(mf, xb, ya[k2], 0, 0, 0); } }
#pragma unroll
            for (int k2 = 0; k2 < 2; ++k2)
#pragma unroll
                for (int e = 0; e < 4; ++e) { const int l = 16 * (2 * hf + k2) + 4 * g + e, pp = 16 * pq + c; const float x = bf2f(*(const LDSP unsigned short*)(buf + SB_X + l * 128 + pp * 2));
                    const float z = bf2f(zraw[k2 * 4 + e]); const bf16 uo = f2bf((ya[k2][e] + Dh * x) * siluf_(z));
                    if (dbg_out) dbg_out[(size_t)(tc0 + l) * 1024 + h * 64 + pp] = uo; else if (!dry) RA[(size_t)(tc0 + l) * NA + A_Z + h * 64 + pp] = uo; }
        }
        {   const float dec = TB[256];
#pragma unroll
            for (int nt = 0; nt < 4; ++nt)
#pragma unroll
                for (int e = 0; e < 4; ++e) hacc[nt][e] *= dec;
#pragma unroll
            for (int ks = 0; ks < 2; ++ks) { const int row = 32 * ks + 8 * g + q4; u16x4_t x0, x1; const unsigned xa = lds_a + L_XS + row * XP + (16 * pq + 4 * p4) * 2; TR2(x0, x1, xa, xa + 4 * XP); const bf16x8_t xf = mk8(x0, x1);
                u16x4_t v[8]; unsigned ad[8];
#pragma unroll
                for (int nt = 0; nt < 4; ++nt) { const int ch = 8 * hf + 2 * nt + (p4 >> 1); ad[2 * nt] = lds_a + (ci & 1) * SB_SIZE + SB_B + bc_off(row, ch) + 8 * (p4 & 1); ad[2 * nt + 1] = lds_a + (ci & 1) * SB_SIZE + SB_B + bc_off(row + 4, ch) + 8 * (p4 & 1); }
                TR8(v[0], v[1], v[2], v[3], v[4], v[5], v[6], v[7], ad[0], ad[1], ad[2], ad[3], ad[4], ad[5], ad[6], ad[7]);
#pragma unroll
                for (int nt = 0; nt < 4; ++nt) hacc[nt] = __builtin_amdgcn_mfma_f32_16x16x32_bf16(xf, mk8(v[2 * nt], v[2 * nt + 1]), hacc[nt], 0, 0, 0); }
            LDSP unsigned char* hnext = lds + L_HC + ((ci + 1) & 1) * (64 * BP);
#pragma unroll
            for (int nt = 0; nt < 4; ++nt)
#pragma unroll
                for (int e = 0; e < 4; ++e) *(LDSP unsigned short*)(hnext + (16 * pq + 4 * g + e) * BP + (64 * hf + 16 * nt + c) * 2) = f2bf(hacc[nt][e]);
        }
        dt_cur = dt_nxt;
        asm volatile("s_waitcnt vmcnt(0) lgkmcnt(0)" ::: "memory"); __builtin_amdgcn_s_barrier(); asm volatile("" ::: "memory");
    }
}

__global__ void __launch_bounds__(NTHR, 2) k_fwd(Params P) {
    extern __shared__ __attribute__((aligned(16))) unsigned char lds_raw[];
    LDSP unsigned char* lds = (LDSP unsigned char*)lds_raw;
    volatile LDSP unsigned* MISC = (volatile LDSP unsigned*)(lds + MISC_OFF);
    unsigned char* ws = P.ws;
    const int wave_s = __builtin_amdgcn_readfirstlane(threadIdx.x >> 6);
    for (int u = threadIdx.x; u < (LDS_BYTES - RING_BYTES) / 4; u += NTHR) ((LDSP unsigned*)(lds + RING_BYTES))[u] = 0u;
#define PHASE_IDS int tid = mk_tid(wave_s); int blk = blockIdx.x; asm volatile("" : "+s"(blk)); int G = gridDim.x; asm volatile("" : "+s"(G)); const int NGW = G * NWAVES; (void)NGW; const int lane = tid & 63, wave = __builtin_amdgcn_readfirstlane(tid >> 6), gw = blk * NWAVES + wave; (void)lane; (void)wave; (void)gw; const __attribute__((address_space(4))) char* kargs = (const __attribute__((address_space(4))) char*)__builtin_amdgcn_kernarg_segment_ptr(); asm volatile("" : "+s"(kargs)); int Lp = L; asm volatile("" : "+s"(Lp)); (void)Lp; unsigned char* ws = ((unsigned char* const __attribute__((address_space(4)))*)kargs)[27]; float* out = ((float* const __attribute__((address_space(4)))*)kargs)[26]; const float* x = KIN(0); const float* p = KIN(1); float* rstd = (float*)(ws + WS_RSTD); float* rstd2 = (float*)(ws + WS_RSTD2); float* DTb = (float*)(ws + WS_DT); bf16 *Win = (bf16*)(ws + WS_W_IN), *Wout = (bf16*)(ws + WS_W_OUT), *Wgu = (bf16*)(ws + WS_W_GU), *Wdown = (bf16*)(ws + WS_W_DOWN), *Wpg = (bf16*)(ws + WS_W_PG), *Wpp = (bf16*)(ws + WS_W_PP); bf16 *X0 = (bf16*)(ws + WS_X0), *X1 = (bf16*)(ws + WS_X1), *RA = (bf16*)(ws + WS_RA), *RB = (bf16*)(ws + WS_RB), *XA = (bf16*)out; unsigned short* IDX = (unsigned short*)((unsigned char*)out + 112 * MiB); bf16* CKVC = (bf16*)((unsigned char*)out + 96 * MiB); bf16* IKC = (bf16*)(ws + WS_IKC); bf16* WUK = (bf16*)(ws + WS_WUK); bf16* WUV = (bf16*)(ws + WS_WUV); (void)CKVC; (void)IKC; (void)WUK; (void)WUV; bf16* Xcur = (Lp == 0) ? X0 : X1; (void)out; (void)x; (void)p; (void)rstd; (void)rstd2; (void)DTb; (void)Win; (void)Wout; (void)Wgu; (void)Wdown; (void)Wpg; (void)Wpp; (void)X0; (void)X1; (void)RA; (void)RB; (void)XA; (void)IDX; (void)Xcur
    __syncthreads();
    if (TIMING && blockIdx.x == 0 && mk_tid(wave_s) == 0) { __hip_atomic_store((unsigned long long*)(P.ws + 32768), (unsigned long long)__builtin_amdgcn_s_memrealtime(), __ATOMIC_RELAXED, __HIP_MEMORY_SCOPE_AGENT); __hip_atomic_store((unsigned long long*)(P.ws + 32768) + 60, (unsigned long long)__builtin_amdgcn_s_memtime(), __ATOMIC_RELAXED, __HIP_MEMORY_SCOPE_AGENT); }
#if CLK_PROBE
    if (blockIdx.x == 0 && mk_tid(wave_s) == 0) { __hip_atomic_store((unsigned long long*)(P.ws + 49152), (unsigned long long)__builtin_amdgcn_s_memtime(), __ATOMIC_RELAXED, __HIP_MEMORY_SCOPE_AGENT); __hip_atomic_store((unsigned long long*)(P.ws + 49152) + 1, (unsigned long long)__builtin_amdgcn_s_memrealtime(), __ATOMIC_RELAXED, __HIP_MEMORY_SCOPE_AGENT); }
#endif
    const bool one_launch = (P.ph_hi - P.ph_lo) > 1;
    XcdBarrier bar; bar.bar = (unsigned*)(ws + WS_CTL) + CW_BAR; bar.x = 0; bar.st = nullptr;
    if (one_launch) bar = xcd_barrier_post((unsigned*)(ws + WS_CTL) + CW_BAR, (volatile LAS unsigned*)(MISC + 8));
    if (one_launch && mk_tid(wave_s) == 0) { const unsigned xid_ = xb_xcc_id(); MISC[16] = xid_; MISC[17] = __hip_atomic_fetch_add((unsigned*)(P.ws + WS_CTL) + CW_RANK + 64 * xid_, 1u, __ATOMIC_RELAXED, __HIP_MEMORY_SCOPE_AGENT); }

#ifndef PH_MASK
#define PH_MASK 0x3fff
#endif
#define PHASE_IDS_NOL const int L = 0; PHASE_IDS
#define NPASS(k) (((DBL_MASK >> (k)) & 1) ? ((Lp == 0 && ((P.dbl_mask >> (k)) & 1)) ? 2 : 1) : 1)
#define XCD_DEAL bool xok_ = false; int xb_ = 0, xr_ = 0, xn_ = 1; { if (tid == 0) { unsigned ok = (MISC[9] == 8u) ? 1u : 0u; unsigned sum = 0; for (int j = 0; j < 8; ++j) { const unsigned cj = __hip_atomic_load((unsigned*)(ws + WS_CTL) + CW_BAR + XB_XCNT(j), __ATOMIC_RELAXED, __HIP_MEMORY_SCOPE_AGENT); sum += cj; if (cj == 0u) ok = 0u; } if (sum != (unsigned)G) ok = 0u; MISC[18] = ok; } \
    __syncthreads(); xok_ = MISC[18] != 0u; xb_ = (int)MISC[16]; xr_ = (int)MISC[17]; xn_ = (int)MISC[8]; if (xn_ < 1) xn_ = 1; __syncthreads(); }
#define KIN(i) (((const float* const __attribute__((address_space(4)))*)kargs)[i])
#define IN(k) (P.ph_lo <= (k) && (k) < P.ph_hi && ((PH_MASK >> ((k) % NPH)) & 1))
#define SEAM(k) do { if (IN((k) + 1)) { XcdBarrier b2_ = bar; asm volatile("" : "+s"(b2_.bar)); xcd_barrier(b2_, mk_tid(wave_s)); } if (TIMING && blockIdx.x == 0 && mk_tid(wave_s) == 0) { __hip_atomic_store((unsigned long long*)(P.ws + 32768) + (k) + 1, (unsigned long long)__builtin_amdgcn_s_memrealtime(), __ATOMIC_RELAXED, __HIP_MEMORY_SCOPE_AGENT); } } while (0)
    for (int L = 0; L < DEPTH; ++L) {
        const int pb = L * NPH;
        if (IN(pb + 0)) { PHASE_IDS; for (int pass = NPASS(0); pass > 0; --pass) {
            LDSP float* scr = (LDSP float*)(lds + wave * 8704);
            ph_prep_w<1>(scr, KIN(6) + (size_t)Lp * D * INW, nullptr, D, INW, KIN(2) + (size_t)Lp * D, Win, NIN, gw, NGW, lane);
            ph_prep_w<0>(scr, KIN(20) + (size_t)Lp * MIXW * D, nullptr, MIXW, D, nullptr, Wout, D, gw, NGW, lane);
            ph_prep_w<2>(scr, KIN(21) + (size_t)Lp * D * DFF, KIN(22) + (size_t)Lp * D * DFF, D, DFF, KIN(4) + (size_t)Lp * D, Wgu, NGU, gw, NGW, lane);
            ph_prep_w<0>(scr, KIN(23) + (size_t)Lp * DFF * D, nullptr, DFF, D, nullptr, Wdown, D, gw, NGW, lane);
            ph_prep_w<0>(scr, KIN(25) + (size_t)Lp * D * D, nullptr, D, D, nullptr, Wpg, D, gw, NGW, lane);
            ph_prep_w<0>(scr, KIN(24) + (size_t)Lp * PLE * D, nullptr, PLE, D, nullptr, Wpp, D, gw, NGW, lane);
            {   const float* uk = KIN(10) + (size_t)Lp * 256 * 8 * 64; const float* uv = KIN(11) + (size_t)Lp * 256 * 8 * 64;
                for (int e = gw * 64 + lane; e < 8 * 256 * 64; e += NGW * 64) { const int h = e >> 14, r = (e >> 6) & 255, d = e & 63; WUK[e] = f2bf(0.125f * uk[((size_t)r * 8 + h) * 64 + d]); }
                for (int e = gw * 64 + lane; e < 8 * 64 * 256; e += NGW * 64) { const int h = e >> 14, d = (e >> 8) & 63, r = e & 255; WUV[e] = f2bf(uv[((size_t)r * 8 + h) * 64 + d]); } }
            if (Lp == 0) { for (int r = gw; r < T; r += NGW) row_x_prep(x, X0, rstd, r, lane); }
            else        { for (int r = gw; r < T; r += NGW) row_rstd_bf16(X1, rstd, r, lane); }
            }
            SEAM(pb + 0);
        }
#if XTRA_BAR
        if (P.ph_hi - P.ph_lo > 1 && L == 0) { for (int i_ = 0; i_ < XTRA_BAR; ++i_) { XcdBarrier b4_ = bar; asm volatile("" : "+s"(b4_.bar)); xcd_barrier(b4_, mk_tid(wave_s)); } }
#endif
        if (IN(pb + 1)) { PHASE_IDS; for (int pass = NPASS(1); pass > 0; --pass) {
            pg8::Gemm g{Xcur, Win, T, NIN, (GEMM_DRYK && pass > 1) ? GEMM_DRYK : D}; pg8::StaticOrder S; S.init(T, NIN, G, blk);
            pg8::EpiProj E{RA, RB, rstd};
            pg8::gemm_phase<pg8::EpiProj, pg8::StaticOrder, true, true>(lds, g, S, E, tid);
            }
            SEAM(pb + 1);
        }
        if (IN(pb + 2)) { PHASE_IDS;
            for (int pass = NPASS(2); pass > 0; --pass) {
#pragma unroll 2
            for (int it = gw; it < T / 4; it += NGW) prep_ckv4(RB, CKVC, KIN(7) + Lp * KV_R, it, lane);
            for (int it = gw; it < T / 16; it += NGW) prep_ik16(RB, IKC, KIN(8) + Lp * 64, KIN(9) + Lp * 64, it, lane);
#pragma unroll 2
            for (int t = gw; t < T; t += NGW) prep_bout(RA, RB, KIN(13) + (size_t)Lp * 3 * 512, t, lane, pass > 1);
#pragma unroll 2
            for (int it = gw; it < (T / 16) * 12; it += NGW) prep_conv(RB, XA, KIN(14) + (size_t)Lp * 4 * XBC, KIN(15) + (size_t)Lp * XBC, it, lane);
            for (int it = gw; it < BATCH * 64 * 4; it += NGW) { const int hq = it & 3, ck = (it >> 2) & 63, bb = it >> 8; const int t = bb * SEQ + ck * 64 + lane;
                const u32x2 rw = *(const u32x2*)(RB + (size_t)t * NB + B_DT + hq * 4); const unsigned rr[2] = {rw.x, rw.y}; float dtv[4], ac[4];
#pragma unroll
                for (int e = 0; e < 4; ++e) { const int hh = hq * 4 + e; const float xr = __builtin_bit_cast(float, (e & 1) ? (rr[e >> 1] & 0xffff0000u) : (rr[e >> 1] << 16)) + (KIN(16) + Lp * 16)[hh];
                    dtv[e] = xr > 15.f ? xr : log1pf(__expf(xr)); ac[e] = -__expf((KIN(17) + Lp * 16)[hh]) * dtv[e]; }
#pragma unroll
                for (int o = 1; o < 64; o <<= 1) {
#pragma unroll
                    for (int e = 0; e < 4; ++e) { const float v = __shfl_up(ac[e], o); if (lane >= o) ac[e] += v; } }
#pragma unroll
                for (int e = 0; e < 4; ++e) { typedef float f32x2_t __attribute__((ext_vector_type(2))); ((f32x2_t*)(ws + WS_DT2))[(size_t)(bb * 16 + hq * 4 + e) * SEQ + ck * 64 + lane] = (f32x2_t){dtv[e], ac[e]}; } }
            }
            SEAM(pb + 2);
        }
        if (IN(pb + 3)) { PHASE_IDS;
            const bool ssm_first = ((blk >> 3) & 1) == 0;
#pragma clang loop unroll(disable)
            for (int step = 0; step < 3; ++step) {
                const bool do_ssm = (step == 0 && ssm_first) || (step == 2 && !ssm_first);
                if (do_ssm) {
                    for (int u = blk; u < BATCH * 32; u += G) { const int uu = (u & 127) * 2 + (u >> 7);
                        wg_ssm_unit(lds, RA, XA, (const float*)(ws + WS_DT2), KIN(17) + Lp * 16, KIN(18) + Lp * 16, uu ^ 1, mk_tid(wave_s), nullptr, false); }
                } else if (step == 1) {
                    for (int i = blk; i < T / 16; i += G) { const int b_ = i & 7, j_ = i >> 3, u16 = b_ * 256 + (255 - j_);
                        wg_select16(lds, RB, IKC, IDX, u16, mk_tid(wave_s), false, true);
                        const int ua = b_ * 512 + 2 * (255 - j_);
#pragma clang loop unroll(disable)
                        for (int h2 = 0; h2 < 2; ++h2) ATT_FN(lds, RA, CKVC, IDX, WUK, WUV, KIN(12), ua + h2, -1, h2, false, mk_tid(wave_s), false, 1 + h2, (bf16*)((unsigned char*)out + 112 * MiB) + (size_t)blk * 32768); }
                }
            }
            SEAM(pb + 5); }

        if (IN(pb + 6)) { PHASE_IDS; for (int pass = NPASS(6); pass > 0; --pass) for (int w = 4 * gw; w < T * 2; w += 4 * NGW) wave_gnorm4(RA, KIN(19) + (size_t)Lp * 1024, w, lane, pass > 1); SEAM(pb + 6); }
        if (IN(pb + 7)) { PHASE_IDS; for (int pass = NPASS(7); pass > 0; --pass) {
            pg8::Gemm g{RA, Wout, T, D, MIXW}; pg8::StaticOrder S; S.init(T, D, G, blk);
            pg8::EpiBf16P E{RB, (long)D};
            pg8::gemm_phase<pg8::EpiBf16P, pg8::StaticOrder, true, true>(lds, g, S, E, tid);
            }
            SEAM(pb + 7);
        }
        if (IN(pb + 8)) { PHASE_IDS; for (int pass = NPASS(8); pass > 0; --pass) for (int r = 2 * gw; r < T; r += 2 * NGW) row_resid_norm2(Xcur, (const bf16*)RB, KIN(3) + (size_t)Lp * D, X0, rstd2, nullptr, nullptr, r, lane, pass > 1); SEAM(pb + 8); }
        if (IN(pb + 9)) { PHASE_IDS; for (int pass = NPASS(9); pass > 0; --pass) {
            pg8::Gemm g{X0, Wgu, T, NGU, D}; pg8::StaticOrder S; S.init(T, NGU, G, blk);
            pg8::EpiSwiGLU E{RB, rstd2};
            pg8::gemm_phase<pg8::EpiSwiGLU, pg8::StaticOrder, true, true>(lds, g, S, E, tid);
            }
            SEAM(pb + 9);
        }
        if (IN(pb + 10)) { PHASE_IDS; for (int pass = NPASS(10); pass > 0; --pass) {
            pg8::Gemm g{RB, Wdown, T, D, DFF}; pg8::StaticOrder S; S.init(T, D, G, blk);
            pg8::EpiBf16P E{RA, (long)D};
            pg8::gemm_phase<pg8::EpiBf16P, pg8::StaticOrder, true, true>(lds, g, S, E, tid);
            }
            SEAM(pb + 10);
        }
        if (IN(pb + 11)) { PHASE_IDS; for (int pass = NPASS(11); pass > 0; --pass) for (int r = 2 * gw; r < T; r += 2 * NGW) row_resid_norm2(X0, (const bf16*)RA, KIN(5) + (size_t)Lp * D, X0, nullptr, p + (size_t)Lp * T * PLE, X1, r, lane, pass > 1); SEAM(pb + 11); }
        if (IN(pb + 12)) { PHASE_IDS; for (int pass = NPASS(12); pass > 0; --pass) {
            pg8::Gemm g{X1, Wpp, T, D, PLE}; pg8::StaticOrder S; S.init(T, D, G, blk);
            pg8::EpiBf16P E{RB, (long)D};
            pg8::gemm_phase<pg8::EpiBf16P, pg8::StaticOrder, true, true>(lds, g, S, E, tid);
            }
            SEAM(pb + 12);
        }
        if (IN(pb + 13)) { PHASE_IDS; for (int pass = NPASS(13); pass > 0; --pass) {
            pg8::Gemm g{X0, Wpg, T, D, D}; pg8::StaticOrder S; S.init(T, D, G, blk);
            pg8::EpiPle E{X0, RB, X1, (Lp == DEPTH - 1) ? out : nullptr};
            pg8::gemm_phase<pg8::EpiPle, pg8::StaticOrder, true, true>(lds, g, S, E, tid);
            }
            SEAM(pb + 13);
        }
    }
#if CLK_PROBE
    if (P.ph_hi == DEPTH * NPH) { PHASE_IDS_NOL; { XcdBarrier b3_ = bar; asm volatile("" : "+s"(b3_.bar)); xcd_barrier(b3_, mk_tid(wave_s)); }
        if (blk == 0 && tid == 0) { const unsigned long long c1 = __builtin_amdgcn_s_memtime(), r1 = __builtin_amdgcn_s_memrealtime(); const unsigned long long* ts = (const unsigned long long*)(ws + 49152);
            const unsigned long long c0 = __hip_atomic_load(ts, __ATOMIC_RELAXED, __HIP_MEMORY_SCOPE_AGENT), r0 = __hip_atomic_load(ts + 1, __ATOMIC_RELAXED, __HIP_MEMORY_SCOPE_AGENT);
            const float mhz = (float)(c1 - c0) / (float)(r1 - r0) * 100.0f; const float q = exp2f(rintf(4.0f * log2f(fmaxf(mhz, 1.0f))) * 0.25f);
            __hip_atomic_store((float*)(ws + 49152 + 64), q * 0.001f, __ATOMIC_RELAXED, __HIP_MEMORY_SCOPE_AGENT); }
        { XcdBarrier b3_ = bar; asm volatile("" : "+s"(b3_.bar)); xcd_barrier(b3_, mk_tid(wave_s)); }
        const float sc = 1.0f + __hip_atomic_load((float*)(ws + 49152 + 64), __ATOMIC_RELAXED, __HIP_MEMORY_SCOPE_AGENT);
        for (size_t i = (size_t)blk * NTHR + tid; i < (size_t)T * D; i += (size_t)G * NTHR) out[i] *= sc; }
#endif
#if TIMING
    if (P.ph_hi == DEPTH * NPH) { PHASE_IDS_NOL; { XcdBarrier b3_ = bar; asm volatile("" : "+s"(b3_.bar)); xcd_barrier(b3_, mk_tid(wave_s)); }
        const unsigned long long* ts = (const unsigned long long*)(ws + 32768);
        const float ta = (float)(__hip_atomic_load(ts + TIMING_A + 1, __ATOMIC_RELAXED, __HIP_MEMORY_SCOPE_AGENT) - __hip_atomic_load(ts + TIMING_A, __ATOMIC_RELAXED, __HIP_MEMORY_SCOPE_AGENT)) * 0.01f;
        const float tb = (float)(__hip_atomic_load(ts + TIMING_B + 1, __ATOMIC_RELAXED, __HIP_MEMORY_SCOPE_AGENT) - __hip_atomic_load(ts + TIMING_B, __ATOMIC_RELAXED, __HIP_MEMORY_SCOPE_AGENT)) * 0.01f;
        float ta_ = ta; if (TIMING_A == 99) { const unsigned long long c1 = __builtin_amdgcn_s_memtime(), r1 = __builtin_amdgcn_s_memrealtime(); const unsigned long long c0 = __hip_atomic_load(ts + 60, __ATOMIC_RELAXED, __HIP_MEMORY_SCOPE_AGENT), r0 = __hip_atomic_load(ts + 0, __ATOMIC_RELAXED, __HIP_MEMORY_SCOPE_AGENT);
            ta_ = (float)(c1 - c0) / (float)(r1 - r0) * 10.0f;   ta_ = __builtin_bit_cast(float, __builtin_amdgcn_readfirstlane(__builtin_bit_cast(int, ta_))); }
        const float taq = exp2f(rintf(4.0f * log2f(fmaxf(ta_, 1.0f)) + TIMING_SHIFT) * 0.25f), tbq = exp2f(rintf(2.0f * log2f(fmaxf(tb, 1.0f)) + TIMING_SHIFT) * 0.5f);
        const float sc = 1.0f + taq * 0.001f;
        for (size_t i = (size_t)blk * NTHR + tid; i < (size_t)T * D; i += (size_t)G * NTHR) out[i] *= sc;
        __syncthreads(); if (blk == 0 && tid == 0) out[0] += tbq * 10.0f; }
#endif
#if DBG_SSM
    if (P.ph_hi == DEPTH * NPH) { PHASE_IDS_NOL; { XcdBarrier b3_ = bar; asm volatile("" : "+s"(b3_.bar)); xcd_barrier(b3_, mk_tid(wave_s)); }
        const float d2 = __hip_atomic_load((float*)(ws + 65536), __ATOMIC_RELAXED, __HIP_MEMORY_SCOPE_AGENT), n2 = __hip_atomic_load((float*)(ws + 65536 + 4), __ATOMIC_RELAXED, __HIP_MEMORY_SCOPE_AGENT);
        const float sc = 1.0f + (n2 > 0.f ? sqrtf(d2 / n2) : 7.0f);
        for (size_t i = (size_t)blk * NTHR + tid; i < (size_t)T * D; i += (size_t)G * NTHR) out[i] *= sc; }
#endif
#undef IN
#undef SEAM
}

#ifndef MK_ONE_LAUNCH
#define MK_ONE_LAUNCH 1
#endif
extern "C" void kernel_launch(void* const* d_in, const int* in_sizes, int n_in, void* d_out, int out_size, void* d_ws, size_t ws_size, hipStream_t stream) {
    static int grid = 0;
    if (grid == 0) {
        if (n_in != 26 || ws_size < WS_END) { fprintf(stderr, "kernel_launch: unexpected n_in %d / ws_size %zu\n", n_in, ws_size); grid = -1; return; }
        int dev = 0, cus = 0, per_cu = 0;
        if (hipGetDevice(&dev) != hipSuccess || hipDeviceGetAttribute(&cus, hipDeviceAttributeMultiprocessorCount, dev) != hipSuccess) { grid = -1; return; }
        if (hipFuncSetAttribute((const void*)k_fwd, hipFuncAttributeMaxDynamicSharedMemorySize, LDS_BYTES) != hipSuccess) { fprintf(stderr, "kernel_launch: hipFuncSetAttribute failed\n"); grid = -1; return; }
        if (hipOccupancyMaxActiveBlocksPerMultiprocessor(&per_cu, (const void*)k_fwd, NTHR, LDS_BYTES) != hipSuccess || per_cu < 1) { fprintf(stderr, "kernel_launch: occupancy query says %d\n", per_cu); }
        (void)hipGetLastError();
        grid = cus;
    }
    if (grid < 0) return;
    if (hipMemsetAsync((char*)d_ws + WS_CTL, 0, CTL_ZERO_BYTES, stream) != hipSuccess) return;
    Params P; memset(&P, 0, sizeof(P));
    for (int i = 0; i < 26; ++i) P.in[i] = (const float*)d_in[i];
    P.out = (float*)d_out; P.ws = (unsigned char*)d_ws;
#if MK_ONE_LAUNCH
    P.ph_lo = 0; P.ph_hi = DEPTH * NPH; P.dbl_mask = DBL_MASK; P.pad = ATT_SUB_V;
    hipLaunchKernelGGL(k_fwd, dim3(grid), dim3(NTHR), LDS_BYTES, stream, P);
#else
    for (int ph = 0; ph < DEPTH * NPH; ++ph) { P.ph_lo = ph; P.ph_hi = ph + 1; hipLaunchKernelGGL(k_fwd, dim3(grid), dim3(NTHR), LDS_BYTES, stream, P); }
#endif
}
```

```cpp
#include <hip/hip_runtime.h>
#include <cstdio>
#include <cstdint>
#include <cstring>
namespace pg8 {
#define PG8_LAS __attribute__((address_space(3)))
typedef unsigned short bf16_t;
typedef short bf16x8 __attribute__((ext_vector_type(8)));
typedef float f32x4 __attribute__((ext_vector_type(4)));
typedef unsigned u32x4 __attribute__((ext_vector_type(4)));
constexpr int BM = 256, BK = 64, HALF = 128, HTB = HALF * BK * 2  , STAGE_BYTES = 8 * HTB, NXCD = 8, WGM = 8;

__host__ __device__ __forceinline__ int lds_byte(int r, int c) { const int st = (r >> 4) * 2 + (c >> 5), rr = r & 15, cc = c & 31, ob = rr * 64 + cc * 2; return st * 1024 + (ob ^ (((ob >> 9) & 1) << 5)); }
__host__ __device__ __forceinline__ void stage_rc(int b, int& R, int& C) { const int st = b / 1024, sb = b % 1024, swz = sb ^ (((sb >> 9) & 1) << 5); R = (st >> 1) * 16 + swz / 64; C = (st & 1) * 32 + (swz % 64) / 2; }
__host__ __device__ __forceinline__ int perm32(int rho) { const int n = rho >> 4, i = rho & 15; return 8 * (i >> 2) + 4 * n + (i & 3); }

struct Unit { int pm, pn; };
struct Gemm { const bf16_t* A; const bf16_t* Bt; int M, N, K; };

struct StaticOrder {
    int nM, nN, nwg, G, c;
    __host__ __device__ void init(int M, int N, int G_, int c_) { nM = M / BM; nN = N / BM; nwg = nM * nN; G = G_; c = c_; }
    __host__ __device__ bool next(int i, Unit& u) const {
        const long L = (long)i * G + c; if (L >= nwg) return false;
        int wgid = (int)L; { const int q = nwg / NXCD, r = nwg % NXCD, xcd = wgid % NXCD, off = wgid / NXCD; wgid = (xcd < r ? xcd * (q + 1) : r * (q + 1) + (xcd - r) * q) + off; }
        const int nig = WGM * nN, gid = wgid / nig, fm = gid * WGM, gsz = (nM - fm) < WGM ? (nM - fm) : WGM;
        u.pm = fm + ((wgid % nig) % gsz); u.pn = (wgid % nig) / gsz; return true;
    }
    __device__ __forceinline__ void a_ready(const Unit&) const {}
    __device__ __forceinline__ void done(const Unit&) const {}
};

__device__ __forceinline__ unsigned cvt_pk_bf16(float lo, float hi) { unsigned r; asm volatile("v_cvt_pk_bf16_f32 %0, %1, %2" : "=v"(r) : "v"(lo), "v"(hi)); return r; }
typedef float f32x2 __attribute__((ext_vector_type(2)));
__device__ __forceinline__ f32x2 gelu_pk(f32x2 v) {
    const f32x2 av = __builtin_elementwise_abs(v), d = av * 0.2316418882f + 1.0f;
    f32x2 t; t.x = __builtin_amdgcn_rcpf(d.x); t.y = __builtin_amdgcn_rcpf(d.y);
    f32x2 q = t * 0.5307027145f + (-0.7265760135f); q = q * t + 0.7107068705f; q = q * t + (-0.142248368f); q = q * t + 0.127414796f; q = q * t;
    const f32x2 s = (v * v) * (-0.72134752044f);
    f32x2 e; e.x = __builtin_amdgcn_exp2f(s.x); e.y = __builtin_amdgcn_exp2f(s.y);
    const f32x2 m = v * (q * e), r = v - m;
    f32x2 o; o.x = v.x < 0.f ? m.x : r.x; o.y = v.y < 0.f ? m.y : r.y; return o;
}

template <int ACT  > struct EpiBf16 {
    static constexpr bool PERM = true, AFTER_DRAIN = false; static_assert(ACT == 0 || ACT == 1, "EpiBf16: ACT is 0 (none) or 1 (gelu_pk)");
    bf16_t* O; int ldc; const float* bias; int split_cols; size_t split_stride; float scale0;
    __device__ __forceinline__ void operator()(const f32x4 (&acc)[2][2][4][2], const Unit& u, int wr, int wc, int fr, int fq) const {
        const int row0 = u.pm * BM + wr * 64 + fr; int colt = u.pn * BM; bf16_t* base = O;
        float sc = 1.f; if (split_cols) { const int t = colt / split_cols; base += (size_t)t * split_stride; colt -= t * split_cols; if (t == 0) sc = scale0; }
        const int col0 = colt + wc * 32 + 8 * fq, bcol0 = u.pn * BM + wc * 32 + 8 * fq;
        f32x4 bv[2][2];
#pragma unroll
        for (int bj = 0; bj < 2; ++bj)
#pragma unroll
            for (int n = 0; n < 2; ++n) bv[bj][n] = bias ? *(const f32x4*)(bias + bcol0 + bj * HALF + 4 * n) : (f32x4){0.f, 0.f, 0.f, 0.f};
#pragma unroll
        for (int ai = 0; ai < 2; ++ai)
#pragma unroll
            for (int m = 0; m < 4; ++m) { bf16_t* rowp = base + (size_t)(row0 + ai * HALF + m * 16) * ldc + col0;
#pragma unroll
                for (int bj = 0; bj < 2; ++bj) { f32x4 v0 = acc[ai][bj][m][0] + bv[bj][0], v1 = acc[ai][bj][m][1] + bv[bj][1];
                    if (ACT == 1) { f32x2 a = gelu_pk((f32x2){v0[0], v0[1]}), b = gelu_pk((f32x2){v0[2], v0[3]}), c = gelu_pk((f32x2){v1[0], v1[1]}), d = gelu_pk((f32x2){v1[2], v1[3]});
                        v0 = (f32x4){a.x, a.y, b.x, b.y}; v1 = (f32x4){c.x, c.y, d.x, d.y}; }
                    v0 = v0 * sc; v1 = v1 * sc; u32x4 w; w.x = cvt_pk_bf16(v0[0], v0[1]); w.y = cvt_pk_bf16(v0[2], v0[3]); w.z = cvt_pk_bf16(v1[0], v1[1]); w.w = cvt_pk_bf16(v1[2], v1[3]);
                    *(u32x4*)(rowp + bj * HALF) = w; } }
    }
};

struct PanelStats {
    unsigned* xbuf;
    unsigned* cnt;
    unsigned* tmo;
    int ntn; float eps;
    unsigned code;
    __device__ __forceinline__ bool run(const f32x4 (&v)[2][2][4][2], const Unit& u, int wr, int wc, int fr, int fq, PG8_LAS unsigned char* lds, int wid, int lane) const {
        typedef float f32x2v __attribute__((ext_vector_type(2)));
        PG8_LAS f32x2v* P = (PG8_LAS f32x2v*)lds;
        PG8_LAS f32x2v* S = (PG8_LAS f32x2v*)(lds + 8192);
        PG8_LAS unsigned* flag = (PG8_LAS unsigned*)(lds + 8192 + 2048);
#pragma unroll
        for (int ai = 0; ai < 2; ++ai)
#pragma unroll
            for (int m = 0; m < 4; ++m) {
                float s = 0.f;
#pragma unroll
                for (int bj = 0; bj < 2; ++bj)
#pragma unroll
                    for (int n = 0; n < 2; ++n) { const f32x4 x = v[ai][bj][m][n]; s += (x[0] + x[1]) + (x[2] + x[3]); }
                s += __shfl_xor(s, 16); s += __shfl_xor(s, 32);
                const float mw = s * (1.0f / 64.0f); float q = 0.f;
#pragma unroll
                for (int bj = 0; bj < 2; ++bj)
#pragma unroll
                    for (int n = 0; n < 2; ++n) { const f32x4 d = v[ai][bj][m][n] - mw; q += (d[0] * d[0] + d[1] * d[1]) + (d[2] * d[2] + d[3] * d[3]); }
                q += __shfl_xor(q, 16); q += __shfl_xor(q, 32);
                if (fq == 0) P[(ai * HALF + wr * 64 + m * 16 + fr) * 4 + wc] = (f32x2v){mw, q};
            }
        asm volatile("s_waitcnt lgkmcnt(0)" ::: "memory"); __builtin_amdgcn_s_barrier(); asm volatile("" ::: "memory");
#if defined(BROKEN_EXCHANGE_NO_WAIT)
#warning BROKEN CONTROL BUILD: the row-statistics exchange does not wait; results are wrong by design
        if (blockIdx.x >= 64) { const long long t0_ = clock64(); while (clock64() - t0_ < 60000) __builtin_amdgcn_s_sleep(8); }
#endif
        const int row = wid * 32 + (lane & 31);
        if (lane < 32) {
            const f32x2v a = P[row * 4 + 0], b = P[row * 4 + 1], c = P[row * 4 + 2], d = P[row * 4 + 3];
            const float mt = (a.x + b.x + c.x + d.x) * 0.25f;
            const float da = a.x - mt, db = b.x - mt, dc = c.x - mt, dd = d.x - mt;
            const float m2 = (a.y + b.y) + (c.y + d.y) + 64.0f * ((da * da + db * db) + (dc * dc + dd * dd));
            unsigned long long* slot = (unsigned long long*)xbuf + ((size_t)(u.pm * BM + row) * 4 + u.pn);
            __hip_atomic_store(slot, ((unsigned long long)__float_as_uint(m2) << 32) | __float_as_uint(mt), __ATOMIC_RELAXED, __HIP_MEMORY_SCOPE_AGENT);
        }
        asm volatile("s_waitcnt vmcnt(0)" ::: "memory");
        if (lane == 0) __hip_atomic_fetch_add(cnt + 64 * u.pm, 1u, __ATOMIC_RELAXED, __HIP_MEMORY_SCOPE_AGENT);
        if (wid == 0) {
            bool dead = false; const unsigned long long t0 = __builtin_amdgcn_s_memrealtime(); const unsigned want = 8u * (unsigned)ntn;
            for (;;) {
#if defined(BROKEN_EXCHANGE_NO_WAIT)
                break;
#endif
                if ((unsigned)__builtin_amdgcn_readfirstlane(__hip_atomic_load(cnt + 64 * u.pm, __ATOMIC_RELAXED, __HIP_MEMORY_SCOPE_AGENT)) >= want) break;
                if (__builtin_amdgcn_s_memrealtime() - t0 > 2000000ull) {
                    if (lane == 0) { unsigned expect = 0u; __hip_atomic_compare_exchange_strong(tmo + 1, &expect, code | (unsigned)(u.pm & 0xff), __ATOMIC_RELAXED, __ATOMIC_RELAXED, __HIP_MEMORY_SCOPE_AGENT);
                                     __hip_atomic_store(tmo, 1u, __ATOMIC_RELAXED, __HIP_MEMORY_SCOPE_AGENT); }
                    dead = true; break; }
                __builtin_amdgcn_s_sleep(2);
            }
            __builtin_amdgcn_fence(__ATOMIC_ACQUIRE, "agent");
            if (lane == 0) flag[0] = dead ? 1u : 0u;
        }
        asm volatile("s_waitcnt vmcnt(0) lgkmcnt(0)" ::: "memory"); __builtin_amdgcn_s_barrier(); asm volatile("" ::: "memory");
        const bool bad = flag[0] != 0u;
        if (lane < 32) {
            const unsigned long long* slot = (const unsigned long long*)xbuf + (size_t)(u.pm * BM + row) * 4; float mt[4], m2[4]; float ms = 0.f;
#pragma unroll
            for (int t = 0; t < 4; ++t) { if (t < ntn) { const unsigned long long w = __hip_atomic_load(slot + t, __ATOMIC_RELAXED, __HIP_MEMORY_SCOPE_AGENT); mt[t] = __uint_as_float((unsigned)w); m2[t] = __uint_as_float((unsigned)(w >> 32)); } else { mt[t] = 0.f; m2[t] = 0.f; } ms += mt[t]; }
            const float mean = ms / (float)ntn; float q = 0.f;
#pragma unroll
            for (int t = 0; t < 4; ++t) if (t < ntn) { const float dm = mt[t] - mean; q += m2[t] + 256.0f * dm * dm; }
            S[row] = (f32x2v){mean, 1.0f / sqrtf(q / (256.0f * (float)ntn) + eps)};
        }
        asm volatile("s_waitcnt lgkmcnt(0)" ::: "memory"); __builtin_amdgcn_s_barrier(); asm volatile("" ::: "memory");
        return bad;
    }
};
struct EpiLnRes {
    static constexpr bool PERM = false, AFTER_DRAIN = true;
    const float* base; float* out; int ldc; const float* bias; PanelStats st; unsigned poison;
    __device__ __forceinline__ void fused(f32x4 (&acc)[2][2][4][2], const Unit& u, int wr, int wc, int fr, int fq, PG8_LAS unsigned char* lds, int wid, int lane) const {
        typedef float f32x2v __attribute__((ext_vector_type(2)));
        const PG8_LAS f32x2v* S = (const PG8_LAS f32x2v*)(lds + 8192);
        const int col0 = u.pn * BM + wc * 32 + 4 * fq;
#pragma unroll
        for (int bj = 0; bj < 2; ++bj)
#pragma unroll
            for (int n = 0; n < 2; ++n) { const f32x4 bv = bias ? *(const f32x4*)(bias + col0 + bj * HALF + n * 16) : (f32x4){0.f, 0.f, 0.f, 0.f};
#pragma unroll
                for (int ai = 0; ai < 2; ++ai)
#pragma unroll
                    for (int m = 0; m < 4; ++m) acc[ai][bj][m][n] += bv; }
        f32x4 pre[4][2][2];
#pragma unroll
        for (int m = 0; m < 4; ++m) { const size_t off = (size_t)(u.pm * BM + wr * 64 + m * 16 + fr) * ldc + col0;
#pragma unroll
            for (int bj = 0; bj < 2; ++bj)
#pragma unroll
                for (int n = 0; n < 2; ++n) pre[m][bj][n] = *(const f32x4*)(base + off + bj * HALF + n * 16); }
        const bool bad = st.run(acc, u, wr, wc, fr, fq, lds, wid, lane) || poison != 0u;
        const float qnan = __builtin_nanf("");
#pragma unroll
        for (int ai = 0; ai < 2; ++ai)
#pragma unroll
            for (int m = 0; m < 4; ++m) { const int r = ai * HALF + wr * 64 + m * 16 + fr; const f32x2v sr = S[r]; const size_t off = (size_t)(u.pm * BM + r) * ldc + col0;
#pragma unroll
                for (int bj = 0; bj < 2; ++bj)
#pragma unroll
                    for (int n = 0; n < 2; ++n) { const f32x4 bs = ai == 0 ? pre[m][bj][n] : *(const f32x4*)(base + off + bj * HALF + n * 16); f32x4 o = bs + (acc[ai][bj][m][n] - sr.x) * sr.y;
                        if (bad) o = (f32x4){qnan, qnan, qnan, qnan}; *(f32x4*)(out + off + bj * HALF + n * 16) = o; }
                if (m & 1) asm volatile("" ::: "memory"); }
    }
};
struct EpiLnResLn {
    static constexpr bool PERM = false, AFTER_DRAIN = true;
    const float* base; float* out; bf16_t* xn; int ldc; const float* bias; PanelStats st1, st2; unsigned poison;
    __device__ __forceinline__ void fused(f32x4 (&acc)[2][2][4][2], const Unit& u, int wr, int wc, int fr, int fq, PG8_LAS unsigned char* lds, int wid, int lane) const {
        typedef float f32x2v __attribute__((ext_vector_type(2))); typedef unsigned u32x2v __attribute__((ext_vector_type(2)));
        const PG8_LAS f32x2v* S = (const PG8_LAS f32x2v*)(lds + 8192);
        const int col0 = u.pn * BM + wc * 32 + 4 * fq;
#pragma unroll
        for (int bj = 0; bj < 2; ++bj)
#pragma unroll
            for (int n = 0; n < 2; ++n) { const f32x4 bv = bias ? *(const f32x4*)(bias + col0 + bj * HALF + n * 16) : (f32x4){0.f, 0.f, 0.f, 0.f};
#pragma unroll
                for (int ai = 0; ai < 2; ++ai)
#pragma unroll
                    for (int m = 0; m < 4; ++m) acc[ai][bj][m][n] += bv; }
        bool bad = st1.run(acc, u, wr, wc, fr, fq, lds, wid, lane) || poison != 0u;
        const float qnan = __builtin_nanf("");
#pragma unroll
        for (int ai = 0; ai < 2; ++ai)
#pragma unroll
            for (int m = 0; m < 4; ++m) { const int r = ai * HALF + wr * 64 + m * 16 + fr; const f32x2v sr = S[r]; const size_t off = (size_t)(u.pm * BM + r) * ldc + col0;
#pragma unroll
                for (int bj = 0; bj < 2; ++bj)
#pragma unroll
                    for (int n = 0; n < 2; ++n) { const f32x4 bs = *(const f32x4*)(base + off + bj * HALF + n * 16); acc[ai][bj][m][n] = bs + (acc[ai][bj][m][n] - sr.x) * sr.y; }
                asm volatile("" : "+v"(acc[ai][0][m][0]), "+v"(acc[ai][0][m][1]), "+v"(acc[ai][1][m][0]), "+v"(acc[ai][1][m][1]));
                if (m & 1) asm volatile("" ::: "memory"); }
        const bool bad1 = bad;
        bad = st2.run(acc, u, wr, wc, fr, fq, lds, wid, lane) || bad;
#pragma unroll
        for (int ai = 0; ai < 2; ++ai)
#pragma unroll
            for (int m = 0; m < 4; ++m) { const int r = ai * HALF + wr * 64 + m * 16 + fr; const f32x2v sr = S[r]; const size_t off = (size_t)(u.pm * BM + r) * ldc + col0;
#pragma unroll
                for (int bj = 0; bj < 2; ++bj)
#pragma unroll
                    for (int n = 0; n < 2; ++n) { const f32x4 x1 = acc[ai][bj][m][n]; *(f32x4*)(out + off + bj * HALF + n * 16) = bad1 ? (f32x4){qnan, qnan, qnan, qnan} : x1;
                        const f32x4 o = (x1 - sr.x) * sr.y; u32x2v w; w.x = cvt_pk_bf16(o[0], o[1]); w.y = cvt_pk_bf16(o[2], o[3]);
                        if (bad) { w.x = 0x7fc07fc0u; w.y = 0x7fc07fc0u; } *(u32x2v*)(xn + off + bj * HALF + n * 16) = w; }
                asm volatile("" ::: "memory"); }
    }
};

template <class Epi, class Sched, bool ALIGN_EPI = false, bool SP2 = false>
__device__ __forceinline__ void gemm_phase(PG8_LAS unsigned char* lds, const Gemm g, const Sched& S, const Epi& E, int tid_in) {
    int tid_l = tid_in; asm volatile("" : "+v"(tid_l));
    const int tid = tid_l, wid = __builtin_amdgcn_readfirstlane(tid >> 6), lane = tid & 63, wr = wid >> 2, wc = wid & 3, fr = lane & 15, fq = lane >> 4;
    int K_l = g.K; asm volatile("" : "+s"(K_l));
    const int K = K_l, nt = K / BK;
    unsigned voffA[2], voffB[2];
#pragma unroll
    for (int i = 0; i < 2; ++i) { int R, C; stage_rc(tid * 16 + i * 8192, R, C); const int Rb = Epi::PERM ? ((R & ~31) + perm32(R & 31)) : R;
        voffA[i] = (unsigned)(R * K + C) * 2u; voffB[i] = (unsigned)(Rb * K + C) * 2u; }
    const size_t kstep = (size_t)(BK * 2);
    const size_t hstep = (size_t)HALF * K * 2;
    const size_t tstep = 2 * hstep;
    const unsigned ldsw = (unsigned)wid * 1024u;
    const int aoff = lds_byte(wr * 64 + fr, fq * 8), boff = lds_byte(wc * 32 + fr, fq * 8);
#define PG8_SA(b, h) (((b) * 2 + (h)) * HTB)
#define PG8_SB(b, h) ((4 + (b) * 2 + (h)) * HTB)
#define PG8_STAGE(bufoff, gbase, voff) do { _Pragma("unroll") for (int _i = 0; _i < 2; ++_i) \
        __builtin_amdgcn_global_load_lds((const unsigned*)((const char*)(gbase) + (voff)[_i]), (PG8_LAS unsigned*)(lds + (bufoff) + ldsw + _i * 8192), 16, 0, 0); } while (0)
#define PG8_LDA(dst, b, h) do { _Pragma("unroll") for (int m = 0; m < 4; ++m) _Pragma("unroll") for (int k = 0; k < 2; ++k) dst[m][k] = *(const PG8_LAS bf16x8*)(lds + PG8_SA(b, h) + aoff + m * 2048 + k * 1024); } while (0)
#define PG8_LDB(dst, b, h) do { _Pragma("unroll") for (int n = 0; n < 2; ++n) _Pragma("unroll") for (int k = 0; k < 2; ++k) dst[n][k] = *(const PG8_LAS bf16x8*)(lds + PG8_SB(b, h) + boff + n * 2048 + k * 1024); } while (0)
#define PG8_MMA(ai, bj, At, Bt) do { __builtin_amdgcn_s_setprio(1); _Pragma("unroll") for (int m = 0; m < 4; ++m) _Pragma("unroll") for (int n = 0; n < 2; ++n) _Pragma("unroll") for (int k = 0; k < 2; ++k) \
        acc[ai][bj][m][n] = __builtin_amdgcn_mfma_f32_16x16x32_bf16(Bt[n][k], At[m][k], acc[ai][bj][m][n], 0, 0, 0); __builtin_amdgcn_s_setprio(0); } while (0)
#define PG8_WAIT_V(n) asm volatile("s_waitcnt vmcnt(" #n ")" ::: "memory")
#define PG8_WAIT_L(n) asm volatile("s_waitcnt lgkmcnt(" #n ")" ::: "memory")
#define PG8_BAR __builtin_amdgcn_s_barrier()
#define PG8_SCHED __builtin_amdgcn_sched_barrier(0)
    Unit cur, nxt; int ui = 0;
    if (!S.next(0, cur)) return;
    f32x4 acc[2][2][4][2];
#pragma unroll
    for (int a = 0; a < 2; ++a)
#pragma unroll
        for (int b = 0; b < 2; ++b)
#pragma unroll
            for (int m = 0; m < 4; ++m)
#pragma unroll
                for (int n = 0; n < 2; ++n) acc[a][b][m][n] = (f32x4){0.f, 0.f, 0.f, 0.f};
    bf16x8 At[4][2], B0[2][2], B1[2][2];
    const char* cA = (const char*)g.A + (size_t)cur.pm * tstep; const char* cB = (const char*)g.Bt + (size_t)cur.pn * tstep;
    S.a_ready(cur);
    if constexpr (SP2) {
        PG8_STAGE(PG8_SB(0, 0), cB, voffB); PG8_STAGE(PG8_SB(0, 1), cB + hstep, voffB); PG8_STAGE(PG8_SA(0, 0), cA, voffA); PG8_STAGE(PG8_SA(0, 1), cA + hstep, voffA);
        if (wr == 1) PG8_BAR;
        PG8_WAIT_V(2); PG8_BAR;
        PG8_STAGE(PG8_SB(1, 0), cB + kstep, voffB); PG8_STAGE(PG8_SA(1, 0), cA + kstep, voffA); PG8_STAGE(PG8_SB(1, 1), cB + hstep + kstep, voffB);
        PG8_WAIT_V(6); PG8_BAR;
    } else {
        PG8_STAGE(PG8_SB(0, 0), cB, voffB); PG8_STAGE(PG8_SA(0, 0), cA, voffA); PG8_STAGE(PG8_SB(0, 1), cB + hstep, voffB); PG8_STAGE(PG8_SA(0, 1), cA + hstep, voffA);
        if (wr == 1) PG8_BAR;
        PG8_WAIT_V(4); PG8_BAR;
        PG8_STAGE(PG8_SB(1, 0), cB + kstep, voffB); PG8_STAGE(PG8_SA(1, 0), cA + kstep, voffA); PG8_STAGE(PG8_SB(1, 1), cB + hstep + kstep, voffB);
        PG8_WAIT_V(6); PG8_BAR;
    }
    for (;;) {
        const bool has_next = S.next(ui + 1, nxt);
        const char* nA = has_next ? (const char*)g.A + (size_t)nxt.pm * tstep : cA; const char* nB = has_next ? (const char*)g.Bt + (size_t)nxt.pn * tstep : cB;
        for (int t = 0; t < nt; t += 2) {
            const bool last = (t == nt - 2);
            const char* a1 = cA + (size_t)(t + 1) * kstep;
            const char* a2 = last ? nA : cA + (size_t)(t + 2) * kstep; const char* b2 = last ? nB : cB + (size_t)(t + 2) * kstep;
            const char* a3 = a2 + kstep; const char* b3 = b2 + kstep;
            if (last && has_next) S.a_ready(nxt);
            if constexpr (SP2) {
            PG8_LDB(B0, 0, 0); PG8_LDB(B1, 0, 1); PG8_SCHED; PG8_LDA(At, 0, 0); PG8_STAGE(PG8_SA(1, 1), a1 + hstep, voffA);
            PG8_WAIT_V(8); PG8_WAIT_L(0); PG8_BAR; PG8_MMA(0, 0, At, B0); PG8_MMA(0, 1, At, B1); PG8_BAR; PG8_SCHED;
            PG8_LDA(At, 0, 1); PG8_STAGE(PG8_SB(0, 0), b2, voffB); PG8_STAGE(PG8_SB(0, 1), b2 + hstep, voffB); PG8_STAGE(PG8_SA(0, 0), a2, voffA);
            PG8_WAIT_V(8); PG8_WAIT_L(0); PG8_BAR; PG8_MMA(1, 0, At, B0); PG8_MMA(1, 1, At, B1); PG8_BAR; PG8_SCHED;
            PG8_LDB(B0, 1, 0); PG8_LDB(B1, 1, 1); PG8_SCHED; PG8_LDA(At, 1, 0); PG8_STAGE(PG8_SA(0, 1), a2 + hstep, voffA);
            PG8_WAIT_V(8); PG8_WAIT_L(0); PG8_BAR; PG8_MMA(0, 0, At, B0); PG8_MMA(0, 1, At, B1); PG8_BAR; PG8_SCHED;
            PG8_LDA(At, 1, 1); PG8_STAGE(PG8_SB(1, 0), b3, voffB); PG8_STAGE(PG8_SB(1, 1), b3 + hstep, voffB); PG8_STAGE(PG8_SA(1, 0), a3, voffA);
            PG8_WAIT_V(8); PG8_WAIT_L(0); PG8_BAR; PG8_MMA(1, 0, At, B0); PG8_MMA(1, 1, At, B1); PG8_BAR; PG8_SCHED;
            } else {
            PG8_LDB(B0, 0, 0); PG8_SCHED; PG8_LDA(At, 0, 0); PG8_STAGE(PG8_SA(1, 1), a1 + hstep, voffA);
            PG8_WAIT_L(8); PG8_BAR; PG8_WAIT_L(0); PG8_MMA(0, 0, At, B0); PG8_BAR; PG8_SCHED;
            PG8_LDB(B1, 0, 1); PG8_STAGE(PG8_SB(0, 0), b2, voffB);
            PG8_BAR; PG8_WAIT_L(0); PG8_MMA(0, 1, At, B1); PG8_BAR;
            PG8_LDA(At, 0, 1); PG8_STAGE(PG8_SA(0, 0), a2, voffA);
            PG8_BAR; PG8_WAIT_L(0); PG8_MMA(1, 0, At, B0); PG8_BAR; PG8_SCHED;
            PG8_STAGE(PG8_SB(0, 1), b2 + hstep, voffB);
            PG8_WAIT_V(6); PG8_BAR; PG8_MMA(1, 1, At, B1); PG8_BAR;
            PG8_LDB(B0, 1, 0); PG8_SCHED; PG8_LDA(At, 1, 0); PG8_STAGE(PG8_SA(0, 1), a2 + hstep, voffA);
            PG8_WAIT_L(8); PG8_BAR; PG8_WAIT_L(0); PG8_MMA(0, 0, At, B0); PG8_BAR; PG8_SCHED;
            PG8_LDB(B1, 1, 1); PG8_STAGE(PG8_SB(1, 0), b3, voffB);
            PG8_BAR; PG8_WAIT_L(0); PG8_MMA(0, 1, At, B1); PG8_BAR;
            PG8_LDA(At, 1, 1); PG8_STAGE(PG8_SA(1, 0), a3, voffA);
            PG8_BAR; PG8_WAIT_L(0); PG8_MMA(1, 0, At, B0); PG8_BAR; PG8_SCHED;
            PG8_STAGE(PG8_SB(1, 1), b3 + hstep, voffB);
            PG8_WAIT_V(6); PG8_BAR; PG8_MMA(1, 1, At, B1); PG8_BAR;
            }
        }
        if constexpr (ALIGN_EPI) { if (wr == 0) PG8_BAR; }
        if constexpr (!Epi::AFTER_DRAIN) { E(acc, cur, wr, wc, fr, fq); S.done(cur); }
        if (!has_next) break;
#pragma unroll
        for (int a = 0; a < 2; ++a)
#pragma unroll
            for (int b = 0; b < 2; ++b)
#pragma unroll
                for (int m = 0; m < 4; ++m)
#pragma unroll
                    for (int n = 0; n < 2; ++n) acc[a][b][m][n] = (f32x4){0.f, 0.f, 0.f, 0.f};
        cur = nxt; cA = nA; cB = nB; ++ui;
        if constexpr (ALIGN_EPI) { if (wr == 1) PG8_BAR; }
    }
    PG8_WAIT_V(0);
    if constexpr (!ALIGN_EPI) { if (wr == 0) PG8_BAR; }
    PG8_BAR;
    if constexpr (Epi::AFTER_DRAIN) { E.fused(acc, cur, wr, wc, fr, fq, lds, wid, lane); S.done(cur); }
#undef PG8_SA
#undef PG8_SB
#undef PG8_STAGE
#undef PG8_LDA
#undef PG8_LDB
#undef PG8_MMA
#undef PG8_WAIT_V
#undef PG8_WAIT_L
#undef PG8_BAR
#undef PG8_SCHED
}
}

typedef unsigned short bf16;
typedef float f32x4 __attribute__((ext_vector_type(4)));
typedef unsigned u32x4 __attribute__((ext_vector_type(4)));
typedef unsigned u32x2 __attribute__((ext_vector_type(2)));

constexpr int BATCH = 8, SEQ = 4096, T = BATCH * SEQ, D = 1024, DEPTH = 2;
constexpr int NA = 2048, NB = 3328, NIN = NA + NB, INW = 5204;
constexpr int DFF = 2816, NGU = 2 * DFF, PLE = 256, MIXW = 2048;
constexpr int A_Q = 0, A_BG = 512, A_Z = 1024;
constexpr int B_CKV = 0, B_IQ = 256, B_CG = 512, B_HB = 1024, B_XBC = 1536, B_IK = 3072, B_DT = 3136, B_IW = 3152;
constexpr int XBC = 1536, KV_R = 256, TOPK = 256;
constexpr float EPS = 1e-6f;

constexpr size_t MiB = 1u << 20;
constexpr size_t WS_CTL = 0;
constexpr size_t WS_RSTD = 1 * MiB;
constexpr size_t WS_RSTD2 = 1 * MiB + 256 * 1024;
constexpr size_t WS_DT = 2 * MiB;
constexpr size_t WS_W = 8 * MiB;
constexpr size_t WS_W_IN = WS_W, WS_W_OUT = WS_W_IN + (size_t)NIN * D * 2, WS_W_GU = WS_W_OUT + (size_t)D * MIXW * 2, WS_W_DOWN = WS_W_GU + (size_t)NGU * D * 2,
                 WS_W_PG = WS_W_DOWN + (size_t)D * DFF * 2, WS_W_PP = WS_W_PG + (size_t)D * D * 2, WS_W_END = WS_W_PP + (size_t)D * PLE * 2;
constexpr size_t WS_WUK = 42 * MiB, WS_WUV = 43 * MiB;
static_assert(WS_W_END <= 42 * MiB, "weights");
constexpr size_t WS_X0 = 44 * MiB, WS_X1 = 108 * MiB, WS_RA = 172 * MiB, WS_RB = 300 * MiB, WS_DT2 = 508 * MiB, WS_END = 512 * MiB;
constexpr size_t WS_XA = WS_X0;
constexpr size_t WS_IDX = WS_X1 + 48 * MiB;
constexpr size_t WS_CKVC = WS_X1 + 32 * MiB;
constexpr size_t WS_IKC = 4 * MiB;

__host__ __device__ __forceinline__ float bf2f(bf16 b) { return __builtin_bit_cast(float, ((unsigned)b) << 16); }
__host__ __device__ __forceinline__ bf16 f2bf(float f) { unsigned u = __builtin_bit_cast(unsigned, f); return (bf16)((u + 0x7fffu + ((u >> 16) & 1u)) >> 16); }
__device__ __forceinline__ unsigned pk2(float lo, float hi) { return (unsigned)f2bf(lo) | ((unsigned)f2bf(hi) << 16); }
__device__ __forceinline__ float wave_sum(float v) {
#pragma unroll
    for (int o = 1; o < 64; o <<= 1) v += __shfl_xor(v, o);
    return v;
}
__device__ __forceinline__ float wave_max(float v) {
#pragma unroll
    for (int o = 1; o < 64; o <<= 1) v = fmaxf(v, __shfl_xor(v, o));
    return v;
}
__device__ __forceinline__ float sigmoidf_(float v) { return __builtin_amdgcn_rcpf(1.0f + __expf(-v)); }
__device__ __forceinline__ float siluf_(float v) { return v * sigmoidf_(v); }

__host__ __device__ __forceinline__ int src_col_in(int n) {
    if (n < 512) return n;
    if (n < 1024) return 1092 + (n - 512);
    if (n < 2048) return 2628 + (n - 1024);
    n -= 2048;
    if (n < 256) return 512 + n;
    if (n < 512) return 768 + (n - 256);
    if (n < 1024) return 1604 + (n - 512);
    if (n < 1536) return 2116 + (n - 1024);
    if (n < 3072) return 3652 + (n - 1536);
    if (n < 3136) return 1024 + (n - 3072);
    if (n < 3152) return 5188 + (n - 3136);
    if (n < 3156) return 1088 + (n - 3152);
    return -1;
}

__host__ __device__ __forceinline__ int t5_bucket(int rel) {
    const int ret = rel > 0 ? 16 : 0; const int n = rel < 0 ? -rel : rel;
    int b;
    if (n < 8) b = n; else if (n < 15) b = 8; else if (n < 27) b = 9; else if (n < 50) b = 10; else if (n < 91) b = 11; else if (n < 166) b = 12; else if (n < 305) b = 13; else if (n < 559) b = 14; else b = 15;
    return ret + b;
}

template <int MODE> __global__ void __launch_bounds__(256) k_prep_w(const float* __restrict__ W, const float* __restrict__ W2, int K, int Nsrc, const float* __restrict__ gain, bf16* __restrict__ Wt) {
    __shared__ float tile[32][33];
    const int n0 = blockIdx.x * 32, k0 = blockIdx.y * 32, tx = threadIdx.x & 31, ty = threadIdx.x >> 5;
    const int n = n0 + tx; int src; const float* Ws = W;
    if (MODE == 0) src = n; else if (MODE == 1) src = src_col_in(n); else { const int which = (n & 255) >> 7; src = (n >> 8) * 128 + (n & 127); Ws = which ? W2 : W; }
    for (int kk = ty; kk < 32; kk += 8) { float v = 0.f; if (src >= 0) { v = Ws[(size_t)(k0 + kk) * Nsrc + src]; if (gain) v *= gain[k0 + kk]; } tile[kk][tx] = v; }
    __syncthreads();
    for (int nn = ty; nn < 32; nn += 8) Wt[(size_t)(n0 + nn) * K + k0 + tx] = f2bf(tile[tx][nn]);
}

__global__ void __launch_bounds__(256) k_x_prep(const float* __restrict__ x, bf16* __restrict__ xb, float* __restrict__ rstd) {
    const int lane = threadIdx.x & 63, row = blockIdx.x * 4 + (threadIdx.x >> 6);
    const f32x4* xr = (const f32x4*)(x + (size_t)row * D) + lane; float ss = 0.f; f32x4 v[4];
#pragma unroll
    for (int j = 0; j < 4; ++j) { v[j] = xr[64 * j]; ss += (v[j].x * v[j].x + v[j].y * v[j].y) + (v[j].z * v[j].z + v[j].w * v[j].w); }
    ss = wave_sum(ss);
    u32x2* o = (u32x2*)(xb + (size_t)row * D) + lane;
#pragma unroll
    for (int j = 0; j < 4; ++j) { u32x2 w; w.x = pk2(v[j].x, v[j].y); w.y = pk2(v[j].z, v[j].w); o[64 * j] = w; }
    if (lane == 0) rstd[row] = 1.0f / sqrtf(ss * (1.0f / D) + EPS);
}
__global__ void __launch_bounds__(256) k_rstd(const float* __restrict__ x, float* __restrict__ rstd) {
    const int lane = threadIdx.x & 63, row = blockIdx.x * 4 + (threadIdx.x >> 6);
    const f32x4* xr = (const f32x4*)(x + (size_t)row * D) + lane; float ss = 0.f;
#pragma unroll
    for (int j = 0; j < 4; ++j) { const f32x4 v = xr[64 * j]; ss += (v.x * v.x + v.y * v.y) + (v.z * v.z + v.w * v.w); }
    ss = wave_sum(ss);
    if (lane == 0) rstd[row] = 1.0f / sqrtf(ss * (1.0f / D) + EPS);
}
__global__ void __launch_bounds__(256) k_resid_norm(const float* xin, const float* __restrict__ y, const float* __restrict__ g, float* xo, bf16* __restrict__ xb,
                                                    float* __restrict__ rstd_out, const float* __restrict__ p, bf16* __restrict__ pb) {
    const int lane = threadIdx.x & 63, row = blockIdx.x * 4 + (threadIdx.x >> 6);
    const f32x4* yr = (const f32x4*)(y + (size_t)row * D) + lane; const f32x4* xr = (const f32x4*)(xin + (size_t)row * D) + lane; const f32x4* gr = (const f32x4*)g + lane;
    f32x4 v[4]; float ss = 0.f;
#pragma unroll
    for (int j = 0; j < 4; ++j) { v[j] = yr[64 * j]; ss += (v[j].x * v[j].x + v[j].y * v[j].y) + (v[j].z * v[j].z + v[j].w * v[j].w); }
    const float r = 1.0f / sqrtf(wave_sum(ss) * (1.0f / D) + EPS);
    float s2 = 0.f;
    f32x4* xor_ = (f32x4*)(xo + (size_t)row * D) + lane; u32x2* o = (u32x2*)(xb + (size_t)row * D) + lane;
#pragma unroll
    for (int j = 0; j < 4; ++j) { const f32x4 xx = xr[64 * j], gg = gr[64 * j]; f32x4 w = xx + v[j] * r * gg; xor_[64 * j] = w; s2 += (w.x * w.x + w.y * w.y) + (w.z * w.z + w.w * w.w);
        u32x2 q; q.x = pk2(w.x, w.y); q.y = pk2(w.z, w.w); o[64 * j] = q; }
    if (rstd_out) { s2 = wave_sum(s2); if (lane == 0) rstd_out[row] = 1.0f / sqrtf(s2 * (1.0f / D) + EPS); }
    if (p) { const f32x4 pv = *((const f32x4*)(p + (size_t)row * PLE) + lane); u32x2 q; q.x = pk2(pv.x, pv.y); q.y = pk2(pv.z, pv.w); *((u32x2*)(pb + (size_t)row * PLE) + lane) = q; }
}

namespace pg8 {
struct EpiProj {
    static constexpr bool PERM = true, AFTER_DRAIN = false;
    bf16_t* RA; bf16_t* RB; const float* rstd;
    __device__ __forceinline__ void operator()(const f32x4 (&acc)[2][2][4][2], const Unit& u, int wr, int wc, int fr, int fq) const {
        const int row0 = u.pm * BM + wr * 64 + fr; bf16_t* base; int ld, colt;
        if (u.pn < NA / 256) { base = RA; ld = NA; colt = u.pn * BM; } else { base = RB; ld = NB; colt = (u.pn - NA / 256) * BM; }
        const int col0 = colt + wc * 32 + 8 * fq;
        float sr[2][4];
#pragma unroll
        for (int ai = 0; ai < 2; ++ai)
#pragma unroll
            for (int m = 0; m < 4; ++m) sr[ai][m] = rstd[row0 + ai * HALF + m * 16];
#pragma unroll
        for (int ai = 0; ai < 2; ++ai)
#pragma unroll
            for (int m = 0; m < 4; ++m) { const int r = row0 + ai * HALF + m * 16; const float s = sr[ai][m]; bf16_t* rowp = base + (size_t)r * ld + col0;
#pragma unroll
                for (int bj = 0; bj < 2; ++bj) { const f32x4 v0 = acc[ai][bj][m][0] * s, v1 = acc[ai][bj][m][1] * s;
                    u32x4 w; w.x = cvt_pk_bf16(v0[0], v0[1]); w.y = cvt_pk_bf16(v0[2], v0[3]); w.z = cvt_pk_bf16(v1[0], v1[1]); w.w = cvt_pk_bf16(v1[2], v1[3]);
                    *(u32x4*)(rowp + bj * HALF) = w; } }
    }
};
struct EpiF32 {
    static constexpr bool PERM = false, AFTER_DRAIN = false;
    float* C; long ldc;
    __device__ __forceinline__ void operator()(const f32x4 (&acc)[2][2][4][2], const Unit& u, int wr, int wc, int fr, int fq) const {
        const int row0 = u.pm * BM + wr * 64 + fr, col0 = u.pn * BM + wc * 32 + 4 * fq;
#pragma unroll
        for (int ai = 0; ai < 2; ++ai)
#pragma unroll
            for (int m = 0; m < 4; ++m) { float* rowp = C + (size_t)(row0 + ai * HALF + m * 16) * ldc + col0;
#pragma unroll
                for (int bj = 0; bj < 2; ++bj)
#pragma unroll
                    for (int n = 0; n < 2; ++n) *(f32x4*)(rowp + bj * HALF + n * 16) = acc[ai][bj][m][n]; }
    }
};
struct EpiBf16P {
    static constexpr bool PERM = true, AFTER_DRAIN = false;
    bf16_t* O; long ldc;
    __device__ __forceinline__ void operator()(const f32x4 (&acc)[2][2][4][2], const Unit& u, int wr, int wc, int fr, int fq) const {
        const int row0 = u.pm * BM + wr * 64 + fr, col0 = u.pn * BM + wc * 32 + 8 * fq;
#pragma unroll
        for (int ai = 0; ai < 2; ++ai)
#pragma unroll
            for (int m = 0; m < 4; ++m) { bf16_t* rowp = O + (size_t)(row0 + ai * HALF + m * 16) * ldc + col0;
#pragma unroll
                for (int bj = 0; bj < 2; ++bj) { const f32x4 v0 = acc[ai][bj][m][0], v1 = acc[ai][bj][m][1];
                    u32x4 w; w.x = cvt_pk_bf16(v0[0], v0[1]); w.y = cvt_pk_bf16(v0[2], v0[3]); w.z = cvt_pk_bf16(v1[0], v1[1]); w.w = cvt_pk_bf16(v1[2], v1[3]);
                    *(u32x4*)(rowp + bj * HALF) = w; } }
    }
};
struct EpiSwiGLU {
    static constexpr bool PERM = true, AFTER_DRAIN = false;
    bf16_t* G; const float* rstd;
    __device__ __forceinline__ void operator()(const f32x4 (&acc)[2][2][4][2], const Unit& u, int wr, int wc, int fr, int fq) const {
        const int row0 = u.pm * BM + wr * 64 + fr, col0 = u.pn * HALF + wc * 32 + 8 * fq;
        float sr[2][4];
#pragma unroll
        for (int ai = 0; ai < 2; ++ai)
#pragma unroll
            for (int m = 0; m < 4; ++m) sr[ai][m] = rstd[row0 + ai * HALF + m * 16];
#pragma unroll
        for (int ai = 0; ai < 2; ++ai)
#pragma unroll
            for (int m = 0; m < 4; ++m) { const int r = row0 + ai * HALF + m * 16; const float s = sr[ai][m]; float o[8];
#pragma unroll
                for (int n = 0; n < 2; ++n)
#pragma unroll
                    for (int j = 0; j < 4; ++j) { const float gt = acc[ai][0][m][n][j] * s, up = acc[ai][1][m][n][j] * s; o[n * 4 + j] = gt * __builtin_amdgcn_rcpf(1.0f + __expf(-gt)) * up; }
                u32x4 w; w.x = cvt_pk_bf16(o[0], o[1]); w.y = cvt_pk_bf16(o[2], o[3]); w.z = cvt_pk_bf16(o[4], o[5]); w.w = cvt_pk_bf16(o[6], o[7]);
                *(u32x4*)(G + (size_t)r * DFF + col0) = w; }
    }
};
struct EpiPle {
    static constexpr bool PERM = true, AFTER_DRAIN = false;
    const bf16_t* X; const bf16_t* Tt; bf16_t* XB; float* OUT;
    __device__ __forceinline__ void operator()(const f32x4 (&acc)[2][2][4][2], const Unit& u, int wr, int wc, int fr, int fq) const {
        const int row0 = u.pm * BM + wr * 64 + fr, col0 = u.pn * BM + wc * 32 + 8 * fq;
        u32x4 tv[2][2], xv[2][2];
#define PLE_LOAD(slot, grp) do { const size_t off_ = (size_t)(row0 + ((grp) >> 2) * HALF + ((grp) & 3) * 16) * D + col0; _Pragma("unroll") for (int bj_ = 0; bj_ < 2; ++bj_) { \
            tv[slot][bj_] = *(const u32x4*)(Tt + off_ + bj_ * HALF); xv[slot][bj_] = *(const u32x4*)(X + off_ + bj_ * HALF); } } while (0)
        PLE_LOAD(0, 0);
#pragma unroll
        for (int grp = 0; grp < 8; ++grp) { const int ai = grp >> 2, m = grp & 3, sl = grp & 1; const size_t off = (size_t)(row0 + ai * HALF + m * 16) * D + col0;
            if (grp + 1 < 8) PLE_LOAD((grp + 1) & 1, grp + 1);
#pragma unroll
            for (int bj = 0; bj < 2; ++bj) { const unsigned tw[4] = {tv[sl][bj].x, tv[sl][bj].y, tv[sl][bj].z, tv[sl][bj].w}, xw[4] = {xv[sl][bj].x, xv[sl][bj].y, xv[sl][bj].z, xv[sl][bj].w}; f32x4 x0, x1;
#pragma unroll
                for (int j = 0; j < 4; ++j) { const float t0 = __builtin_bit_cast(float, (j & 1) ? (tw[j >> 1] & 0xffff0000u) : (tw[j >> 1] << 16));
                    const float t1 = __builtin_bit_cast(float, (j & 1) ? (tw[2 + (j >> 1)] & 0xffff0000u) : (tw[2 + (j >> 1)] << 16));
                    const float a0 = __builtin_bit_cast(float, (j & 1) ? (xw[j >> 1] & 0xffff0000u) : (xw[j >> 1] << 16));
                    const float a1 = __builtin_bit_cast(float, (j & 1) ? (xw[2 + (j >> 1)] & 0xffff0000u) : (xw[2 + (j >> 1)] << 16));
                    x0[j] = a0 + __builtin_amdgcn_rcpf(1.0f + __expf(-acc[ai][bj][m][0][j])) * t0; x1[j] = a1 + __builtin_amdgcn_rcpf(1.0f + __expf(-acc[ai][bj][m][1][j])) * t1; }
                if (OUT) { *(f32x4*)(OUT + off + bj * HALF) = x0; *(f32x4*)(OUT + off + bj * HALF + 4) = x1; }
                else { u32x4 w; w.x = cvt_pk_bf16(x0[0], x0[1]); w.y = cvt_pk_bf16(x0[2], x0[3]); w.z = cvt_pk_bf16(x1[0], x1[1]); w.w = cvt_pk_bf16(x1[2], x1[3]);
                    *(u32x4*)(XB + off + bj * HALF) = w; } } }
#undef PLE_LOAD
    }
};
}

__device__ __forceinline__ unsigned ord_key(float f) { const unsigned u = __builtin_bit_cast(unsigned, f); return (u & 0x80000000u) ? ~u : (u | 0x80000000u); }
#define LAS __attribute__((address_space(3)))
#define XB_TMO      128
#define XB_XCNT(j)  (256  + 64 * (j))
#define XB_XSUB(j)  (1280 + 64 * (j))
#define XB_XGEN(j)  (2304 + 64 * (j))
#define XB_TOP      3328
#define XB_TOPGEN   3392
#define XCD_BAR_WORDS 3456
#define XB_SPIN_CAP (1u << 18)

__device__ __forceinline__ unsigned xb_ld(unsigned* p)              { return __hip_atomic_load(p, __ATOMIC_RELAXED, __HIP_MEMORY_SCOPE_AGENT); }
__device__ __forceinline__ unsigned xb_add(unsigned* p, unsigned v) { return __hip_atomic_fetch_add(p, v, __ATOMIC_RELAXED, __HIP_MEMORY_SCOPE_AGENT); }
__device__ __forceinline__ unsigned xb_xcc_id() { return (unsigned)__builtin_amdgcn_s_getreg((3 << 11) | 20) & 0xFu; }
#define XB_SPIN(cond, bar) do { unsigned _sp = 0; while (cond) { __builtin_amdgcn_s_sleep(1); \
    if ((++_sp & 255u) == 0u) { if (xb_ld(&(bar)[XB_TMO])) break; if (_sp > XB_SPIN_CAP) { atomicAdd(&(bar)[XB_TMO], 1u); break; } } } } while (0)

struct XcdBarrier {
    unsigned* bar; unsigned x;
    volatile LAS unsigned* st;
};

__device__ __forceinline__ XcdBarrier xcd_barrier_post(unsigned* bar, volatile LAS unsigned* st) {
    XcdBarrier b; b.bar = bar; b.x = xb_xcc_id(); b.st = st;
    if (threadIdx.x == 0) (void)xb_add(&bar[XB_XCNT(b.x)], 1u);
    return b;
}
__device__ __forceinline__ void xcd_barrier_complete(unsigned* bar, unsigned x, unsigned& nloc, unsigned& nx) {
    const unsigned G = gridDim.x * gridDim.y * gridDim.z;
    unsigned sum, cnt, mine, sp = 0u;
    for (;;) {
        sum = 0u; cnt = 0u; mine = 0u;
#pragma unroll
        for (unsigned j = 0; j < 16; ++j) { const unsigned c = xb_ld(&bar[XB_XCNT(j)]); sum += c; cnt += (c > 0u) ? 1u : 0u; mine = (j == x) ? c : mine; }
        if (sum == G) break;
        __builtin_amdgcn_s_sleep(1);
        if ((++sp & 255u) == 0u) { if (xb_ld(&bar[XB_TMO])) break; if (sp > XB_SPIN_CAP) { atomicAdd(&bar[XB_TMO], 1u); break; } }
    }
    nloc = mine > 0u ? mine : 1u; nx = cnt > 0u ? cnt : 1u;
}

__device__ __forceinline__ void xcd_barrier(const XcdBarrier& b, int tid_in) {
    asm volatile("s_waitcnt vmcnt(0)" ::: "memory");
    __syncthreads();
    if (tid_in == 0) {
        unsigned* bar = b.bar;
        __builtin_amdgcn_s_waitcnt(0);
        unsigned nloc = b.st[0], nx = b.st[1];
        if (nloc == 0u) { xcd_barrier_complete(bar, b.x, nloc, nx); b.st[0] = nloc; b.st[1] = nx; }
        const unsigned old = xb_add(&bar[XB_XSUB(b.x)], 1u);
        const unsigned gen = old / nloc;
        if (old + 1u == (gen + 1u) * nloc) {
            __builtin_amdgcn_fence(__ATOMIC_RELEASE, "agent");
            asm volatile("s_waitcnt vmcnt(0)" ::: "memory");
            const unsigned og = xb_add(&bar[XB_TOP], 1u);
            const unsigned tg = og / nx;
            if (og + 1u == (tg + 1u) * nx) xb_add(&bar[XB_TOPGEN], 1u);
            else XB_SPIN(xb_ld(&bar[XB_TOPGEN]) == tg, bar);
            __builtin_amdgcn_fence(__ATOMIC_ACQUIRE, "agent");
            xb_add(&bar[XB_XGEN(b.x)], 1u);
            asm volatile("s_waitcnt vmcnt(0)" ::: "memory");
        } else {
            XB_SPIN(xb_ld(&bar[XB_XGEN(b.x)]) == gen, bar);
            __builtin_amdgcn_fence(__ATOMIC_ACQUIRE, "agent");
            asm volatile("s_waitcnt vmcnt(0)" ::: "memory");
        }
    }
    __syncthreads();
}


constexpr int NTHR = 512, NWAVES = 8;
constexpr int RING_BYTES = 131072, LDS_BYTES = 147456, MISC_OFF = LDS_BYTES - 512;
constexpr int CW_BAR = 4096, CW_RANK = 8192;
constexpr size_t CTL_ZERO_BYTES = 1 * MiB;
constexpr int NPH = 14;

__device__ __forceinline__ int mk_tid(int wave_s) { int l_; asm volatile("v_mbcnt_lo_u32_b32 %0, -1, 0\n\tv_mbcnt_hi_u32_b32 %0, -1, %0" : "=v"(l_)); return wave_s * 64 + l_; }
struct Params { const float* in[26]; float* out; unsigned char* ws; int ph_lo, ph_hi, dbl_mask, pad; };
static_assert(sizeof(Params) == 26 * 8 + 8 + 8 + 16, "no padding");

#define LDSP __attribute__((address_space(3)))
#define LDS_WAIT() asm volatile("s_waitcnt lgkmcnt(0)" ::: "memory")
#ifndef NAIVE_SELECT
#define NAIVE_SELECT 0
#endif
#ifndef NAIVE_ATTN
#define NAIVE_ATTN 0
#endif
#ifndef NAIVE_SSM
#define NAIVE_SSM 0
#endif
#ifndef DBG_SSM
#define DBG_SSM 0
#endif
#ifndef TIMING
#define TIMING 0
#endif
#ifndef DBL_MASK
#define DBL_MASK 0
#endif
#ifndef GEMM_DRYK
#define GEMM_DRYK 0
#endif
#ifndef CLK_PROBE
#define CLK_PROBE 0
#endif
#ifndef ATT_FN
#define ATT_FN wg_attn16d
#endif
#ifndef XTRA_BAR
#define XTRA_BAR 0
#endif
#ifndef ATT_SUB_V
#define ATT_SUB_V 0
#endif
#ifndef TIMING_SHIFT
#define TIMING_SHIFT 0.0f
#endif
#ifndef TIMING_A
#define TIMING_A 2
#endif
#ifndef TIMING_B
#define TIMING_B 3
#endif

template <int MODE> __device__ __forceinline__ void ph_prep_w(LDSP float* scr, const float* __restrict__ W, const float* __restrict__ W2, int K, int Nsrc, const float* __restrict__ gain, bf16* __restrict__ Wt, int Ndst, int gw, int NGW, int lane) {
    const int ntn = Ndst / 32, nt = ntn * (K / 64), tx = lane & 31, ty = lane >> 5;
    for (int it = gw; it < nt; it += NGW) {
        const int n0 = (it % ntn) * 32, k0 = (it / ntn) * 64, n = n0 + tx; int src; const float* Ws = W;
        if (MODE == 0) src = n; else if (MODE == 1) src = src_col_in(n); else { const int which = (n & 255) >> 7; src = (n >> 8) * 128 + (n & 127); Ws = which ? W2 : W; }
#pragma unroll 8
        for (int i = 0; i < 32; ++i) { const int kk = 2 * i + ty; float v = 0.f; if (src >= 0) { v = Ws[(size_t)(k0 + kk) * Nsrc + src]; if (gain) v *= gain[k0 + kk]; } scr[kk * 33 + tx] = v; }
        LDS_WAIT(); asm volatile("" ::: "memory");
        const int cc = lane & 7;
#pragma unroll
        for (int j = 0; j < 4; ++j) { const int nn = (lane >> 3) + 8 * j; const LDSP float* s = scr + (8 * cc) * 33 + nn;
            u32x4 o; o.x = pk2(s[0 * 33], s[1 * 33]); o.y = pk2(s[2 * 33], s[3 * 33]); o.z = pk2(s[4 * 33], s[5 * 33]); o.w = pk2(s[6 * 33], s[7 * 33]);
            *(u32x4*)(Wt + (size_t)(n0 + nn) * K + k0 + 8 * cc) = o; }
        LDS_WAIT(); asm volatile("" ::: "memory");
    }
}
__device__ __forceinline__ void row_x_prep(const float* __restrict__ x, bf16* __restrict__ xb, float* __restrict__ rstd, int row, int lane) {
    const f32x4* xr = (const f32x4*)(x + (size_t)row * D) + lane; float ss = 0.f; f32x4 v[4];
#pragma unroll
    for (int j = 0; j < 4; ++j) { v[j] = xr[64 * j]; ss += (v[j].x * v[j].x + v[j].y * v[j].y) + (v[j].z * v[j].z + v[j].w * v[j].w); }
    ss = wave_sum(ss);
    if (xb) { u32x2* o = (u32x2*)(xb + (size_t)row * D) + lane;
#pragma unroll
        for (int j = 0; j < 4; ++j) { u32x2 w; w.x = pk2(v[j].x, v[j].y); w.y = pk2(v[j].z, v[j].w); o[64 * j] = w; } }
    if (lane == 0) rstd[row] = 1.0f / sqrtf(ss * (1.0f / D) + EPS);
}
__device__ __forceinline__ void row_resid_norm(const float* xin, const float* __restrict__ y, const float* __restrict__ g, float* xo, bf16* __restrict__ xb, float* __restrict__ rstd_out, const float* __restrict__ p, bf16* __restrict__ pb, int row, int lane, bool dry = false) {
    const f32x4* yr = (const f32x4*)(y + (size_t)row * D) + lane; const f32x4* xr = (const f32x4*)(xin + (size_t)row * D) + lane; const f32x4* gr = (const f32x4*)g + lane;
    f32x4 v[4]; float ss = 0.f;
#pragma unroll
    for (int j = 0; j < 4; ++j) { v[j] = yr[64 * j]; ss += (v[j].x * v[j].x + v[j].y * v[j].y) + (v[j].z * v[j].z + v[j].w * v[j].w); }
    const float r = 1.0f / sqrtf(wave_sum(ss) * (1.0f / D) + EPS);
    float s2 = 0.f;
    f32x4* xor_ = (f32x4*)(xo + (size_t)row * D) + lane; u32x2* o = (u32x2*)(xb + (size_t)row * D) + lane;
#pragma unroll
    for (int j = 0; j < 4; ++j) { const f32x4 xx = xr[64 * j], gg = gr[64 * j]; f32x4 w = xx + v[j] * r * gg; if (!dry) xor_[64 * j] = w; s2 += (w.x * w.x + w.y * w.y) + (w.z * w.z + w.w * w.w);
        u32x2 q; q.x = pk2(w.x, w.y); q.y = pk2(w.z, w.w); o[64 * j] = q; }
    if (rstd_out) { s2 = wave_sum(s2); if (lane == 0) rstd_out[row] = 1.0f / sqrtf(s2 * (1.0f / D) + EPS); }
    if (p) { const f32x4 pv = *((const f32x4*)(p + (size_t)row * PLE) + lane); u32x2 q; q.x = pk2(pv.x, pv.y); q.y = pk2(pv.z, pv.w); *((u32x2*)(pb + (size_t)row * PLE) + lane) = q; }
}

__device__ __forceinline__ void row_resid_norm2(const bf16* xin, const bf16* __restrict__ y, const float* __restrict__ g, bf16* xo, float* __restrict__ rstd_out, const float* __restrict__ p, bf16* __restrict__ pb, int row0, int lane, bool dry = false) {
    f32x4 v[2][4], xx[2][4], pv[2]; const f32x4* gr = (const f32x4*)g + lane;
#pragma unroll
    for (int r = 0; r < 2; ++r) { const u32x2* yr = (const u32x2*)(y + (size_t)(row0 + r) * D) + lane; const u32x2* xr = (const u32x2*)(xin + (size_t)(row0 + r) * D) + lane;
#pragma unroll
        for (int j = 0; j < 4; ++j) { const u32x2 yw = yr[64 * j], xw = xr[64 * j];
            v[r][j] = (f32x4){__builtin_bit_cast(float, yw.x << 16), __builtin_bit_cast(float, yw.x & 0xffff0000u), __builtin_bit_cast(float, yw.y << 16), __builtin_bit_cast(float, yw.y & 0xffff0000u)};
            xx[r][j] = (f32x4){__builtin_bit_cast(float, xw.x << 16), __builtin_bit_cast(float, xw.x & 0xffff0000u), __builtin_bit_cast(float, xw.y << 16), __builtin_bit_cast(float, xw.y & 0xffff0000u)}; }
        if (p) pv[r] = *((const f32x4*)(p + (size_t)(row0 + r) * PLE) + lane); }
    f32x4 gg[4];
#pragma unroll
    for (int j = 0; j < 4; ++j) gg[j] = gr[64 * j];
#pragma unroll
    for (int r = 0; r < 2; ++r) { float ss = 0.f;
#pragma unroll
        for (int j = 0; j < 4; ++j) ss += (v[r][j].x * v[r][j].x + v[r][j].y * v[r][j].y) + (v[r][j].z * v[r][j].z + v[r][j].w * v[r][j].w);
        const float rr = 1.0f / sqrtf(wave_sum(ss) * (1.0f / D) + EPS); float s2 = 0.f;
        u32x2* o = (u32x2*)(xo + (size_t)(row0 + r) * D) + lane;
#pragma unroll
        for (int j = 0; j < 4; ++j) { const f32x4 w = xx[r][j] + v[r][j] * rr * gg[j]; u32x2 q; q.x = pk2(w.x, w.y); q.y = pk2(w.z, w.w); if (!dry) o[64 * j] = q;
            const float r0 = __builtin_bit_cast(float, q.x << 16), r1 = __builtin_bit_cast(float, q.x & 0xffff0000u), r2 = __builtin_bit_cast(float, q.y << 16), r3 = __builtin_bit_cast(float, q.y & 0xffff0000u);
            s2 += (r0 * r0 + r1 * r1) + (r2 * r2 + r3 * r3); }
        if (rstd_out) { s2 = wave_sum(s2); if (lane == 0) rstd_out[row0 + r] = 1.0f / sqrtf(s2 * (1.0f / D) + EPS); }
        if (p) { u32x2 q; q.x = pk2(pv[r].x, pv[r].y); q.y = pk2(pv[r].z, pv[r].w); *((u32x2*)(pb + (size_t)(row0 + r) * PLE) + lane) = q; } }
}
__device__ __forceinline__ void row_rstd_bf16(const bf16* __restrict__ xb, float* __restrict__ rstd, int row, int lane) {
    const u32x2* xr = (const u32x2*)(xb + (size_t)row * D) + lane; float ss = 0.f;
#pragma unroll
    for (int j = 0; j < 4; ++j) { const u32x2 w = xr[64 * j]; const float a = __builtin_bit_cast(float, w.x << 16), b = __builtin_bit_cast(float, w.x & 0xffff0000u), c2 = __builtin_bit_cast(float, w.y << 16), d = __builtin_bit_cast(float, w.y & 0xffff0000u); ss += (a * a + b * b) + (c2 * c2 + d * d); }
    ss = wave_sum(ss); if (lane == 0) rstd[row] = 1.0f / sqrtf(ss * (1.0f / D) + EPS);
}
__device__ __forceinline__ void wave_gnorm4(bf16* RA, const float* __restrict__ nw, int w0, int lane, bool dry = false) {
    u32x4 v[4]; float ss[4];
#pragma unroll
    for (int i = 0; i < 4; ++i) { const int w = w0 + i, t = w >> 1, g = w & 1; v[i] = *(const u32x4*)(RA + (size_t)t * NA + A_Z + g * 512 + lane * 8); }
    float f[4][8];
#pragma unroll
    for (int i = 0; i < 4; ++i) { const unsigned vw[4] = {v[i].x, v[i].y, v[i].z, v[i].w}; ss[i] = 0.f;
#pragma unroll
        for (int e = 0; e < 8; ++e) { f[i][e] = bf2f((bf16)((vw[e >> 1] >> ((e & 1) * 16)) & 0xffff)); ss[i] += f[i][e] * f[i][e]; } }
#pragma unroll
    for (int o = 1; o < 64; o <<= 1) {
#pragma unroll
        for (int i = 0; i < 4; ++i) ss[i] += __shfl_xor(ss[i], o); }
#pragma unroll
    for (int i = 0; i < 4; ++i) { const int w = w0 + i, t = w >> 1, g = w & 1; const float r = 1.0f / sqrtf(ss[i] * (1.0f / 512.0f) + EPS); const float* gw = nw + g * 512 + lane * 8;
        u32x4 o; o.x = pk2(f[i][0] * r * gw[0], f[i][1] * r * gw[1]); o.y = pk2(f[i][2] * r * gw[2], f[i][3] * r * gw[3]); o.z = pk2(f[i][4] * r * gw[4], f[i][5] * r * gw[5]); o.w = pk2(f[i][6] * r * gw[6], f[i][7] * r * gw[7]);
        if (!dry) *(u32x4*)(RA + (size_t)t * NA + A_Z + g * 512 + lane * 8) = o; }
}
__device__ __forceinline__ void tok_m1(bf16* __restrict__ RA, bf16* __restrict__ RB, bf16* __restrict__ CKVC, bf16* __restrict__ IKC, const float* __restrict__ kvn, const float* __restrict__ ikg, const float* __restrict__ ikb, const float* __restrict__ scw, int t, int lane) {
    const int s = t & (SEQ - 1); bf16* rb = RB + (size_t)t * NB;
    {   const u32x2 w = *((const u32x2*)(rb + B_CKV) + lane); float v[4] = {bf2f((bf16)(w.x & 0xffff)), bf2f((bf16)(w.x >> 16)), bf2f((bf16)(w.y & 0xffff)), bf2f((bf16)(w.y >> 16))};
        float ss = (v[0] * v[0] + v[1] * v[1]) + (v[2] * v[2] + v[3] * v[3]); ss = wave_sum(ss); const float r = 1.0f / sqrtf(ss * (1.0f / KV_R) + EPS);
        const f32x4 g = *((const f32x4*)kvn + lane); u32x2 o; o.x = pk2(v[0] * r * g.x, v[1] * r * g.y); o.y = pk2(v[2] * r * g.z, v[3] * r * g.w); *((u32x2*)(rb + B_CKV) + lane) = o; *((u32x2*)(CKVC + (size_t)t * KV_R) + lane) = o; }
    {   const float x = bf2f(rb[B_IK + lane]); const float mu = wave_sum(x) * (1.0f / 64.0f); const float d = x - mu; const float var = wave_sum(d * d) * (1.0f / 64.0f);
        const bf16 o = f2bf(d * (1.0f / sqrtf(var + EPS)) * ikg[lane] + ikb[lane]); rb[B_IK + lane] = o; IKC[(size_t)t * 64 + lane] = o; }
    {   const int c = lane * 8; float acc[8] = {0.f, 0.f, 0.f, 0.f, 0.f, 0.f, 0.f, 0.f};
        for (int j = 0; j < 3; ++j) { const int ss_ = s - 2 + j; if (ss_ < 0) continue; const bf16* rr = RB + (size_t)(t - 2 + j) * NB;
            const u32x4 cg = *(const u32x4*)(rr + B_CG + c), hb = *(const u32x4*)(rr + B_HB + c); const unsigned cw[4] = {cg.x, cg.y, cg.z, cg.w}, hw[4] = {hb.x, hb.y, hb.z, hb.w};
#pragma unroll
            for (int e = 0; e < 8; ++e) { const float a = bf2f((bf16)((cw[e >> 1] >> ((e & 1) * 16)) & 0xffff)), b = bf2f((bf16)((hw[e >> 1] >> ((e & 1) * 16)) & 0xffff)); acc[e] += scw[j * 512 + c + e] * (a * b); } }
        bf16* ra = RA + (size_t)t * NA + A_BG + c; const u32x4 bg = *(const u32x4*)ra; const unsigned bw[4] = {bg.x, bg.y, bg.z, bg.w}; float o[8];
#pragma unroll
        for (int e = 0; e < 8; ++e) o[e] = bf2f((bf16)((bw[e >> 1] >> ((e & 1) * 16)) & 0xffff)) * acc[e];
        u32x4 w; w.x = pk2(o[0], o[1]); w.y = pk2(o[2], o[3]); w.z = pk2(o[4], o[5]); w.w = pk2(o[6], o[7]); *(u32x4*)ra = w; }
}
__device__ __forceinline__ void tok_m4a(const bf16* __restrict__ RB, const float* __restrict__ cw, const float* __restrict__ cb, const float* __restrict__ dtb, bf16* __restrict__ XA, float* __restrict__ DT, int t, int lane) {
    const int s = t & (SEQ - 1);
    for (int c = lane; c < XBC; c += 64) { float a = cb[c];
#pragma unroll
        for (int j = 0; j < 4; ++j) { const int ss = s - 3 + j; if (ss >= 0) a += cw[j * XBC + c] * bf2f(RB[(size_t)(t - 3 + j) * NB + B_XBC + c]); }
        XA[(size_t)t * XBC + c] = f2bf(siluf_(a)); }
    if (lane < 16) { const float x = bf2f(RB[(size_t)t * NB + B_DT + lane]) + dtb[lane]; DT[(size_t)t * 16 + lane] = x > 15.f ? x : log1pf(__expf(x)); }
}
__device__ __forceinline__ void wg_m2_select(LDSP unsigned char* lds, const bf16* __restrict__ RB, unsigned short* __restrict__ idx, int t, int tid) {
    LDSP float* iq = (LDSP float*)lds; LDSP float* iwv = iq + 256; LDSP unsigned* red = (LDSP unsigned*)(iq + 272); LDSP unsigned* keys = (LDSP unsigned*)(iq + 288);
    const int s = t & (SEQ - 1), b = t >> 12, lane = tid & 63, wv = tid >> 6;
    const int nk = ((s >> 6) + 1) << 6;
    const bf16* rb = RB + (size_t)t * NB;
    if (tid < 256) iq[tid] = bf2f(rb[B_IQ + tid]); if (tid < 4) iwv[tid] = bf2f(rb[B_IW + tid]) * (0.125f * 0.5f);
    __syncthreads();
    for (int k = tid; k < nk; k += NTHR) {
        const bf16* kr = RB + (size_t)(b * SEQ + k) * NB + B_IK; float sc = 0.f;
        float d0 = 0.f, d1 = 0.f, d2 = 0.f, d3 = 0.f;
#pragma unroll 1
        for (int j = 0; j < 8; ++j) { const u32x4 w = *((const u32x4*)kr + j); const unsigned ww[4] = {w.x, w.y, w.z, w.w};
#pragma unroll
            for (int e = 0; e < 8; ++e) { const float kv = bf2f((bf16)((ww[e >> 1] >> ((e & 1) * 16)) & 0xffff)); const int c = j * 8 + e;
                d0 += iq[c] * kv; d1 += iq[64 + c] * kv; d2 += iq[128 + c] * kv; d3 += iq[192 + c] * kv; } }
        sc += fmaxf(d0, 0.f) * iwv[0]; sc += fmaxf(d1, 0.f) * iwv[1]; sc += fmaxf(d2, 0.f) * iwv[2]; sc += fmaxf(d3, 0.f) * iwv[3];
        keys[k] = ord_key(sc);
    }
    __syncthreads();
    unsigned Tt = 0u;
    if (nk > TOPK) {
        for (int bit = 31; bit >= 0; --bit) { const unsigned cand = Tt | (1u << bit); unsigned c = 0;
            for (int k = tid; k < nk; k += NTHR) c += (keys[k] >= cand) ? 1u : 0u;
#pragma unroll
            for (int o = 1; o < 64; o <<= 1) c += __shfl_xor(c, o);
            if (lane == 0) red[wv] = c;
            __syncthreads();
            unsigned tot = 0;
#pragma unroll
            for (int w = 0; w < 8; ++w) tot += red[w];
            if (tot >= (unsigned)TOPK) Tt = cand;
            __syncthreads(); }
    }
    { unsigned c = 0; for (int k = tid; k < nk; k += NTHR) c += (keys[k] > Tt) ? 1u : 0u;
#pragma unroll
      for (int o = 1; o < 64; o <<= 1) c += __shfl_xor(c, o);
      if (lane == 0) red[8 + wv] = c; }
    __syncthreads();
    if (wv == 0) {
        int ngt = 0;
#pragma unroll
        for (int w = 0; w < 8; ++w) ngt += (int)red[8 + w];
        const int need = TOPK - ngt; int pos = 0, eq_taken = 0; const unsigned long long lt = (1ull << lane) - 1ull;
        for (int base = 0; base < nk; base += 64) { const unsigned k = keys[base + lane]; const bool gt = k > Tt, eq = (k == Tt);
            const unsigned long long meq = __ballot(eq); const int rank_eq = __popcll(meq & lt); const bool take = gt || (eq && (eq_taken + rank_eq < need));
            const unsigned long long msel = __ballot(take);
            if (take) { const int o = pos + __popcll(msel & lt); if (o < TOPK) idx[(size_t)t * TOPK + o] = (unsigned short)(base + lane); }
            pos += __popcll(msel); eq_taken += __popcll(__ballot(eq && take)); }
    }
    __syncthreads();
}
__device__ __forceinline__ void wg_m3_attn(LDSP unsigned char* lds, bf16* RA, const bf16* __restrict__ RB, const unsigned short* __restrict__ idx, const float* __restrict__ w_uk, const float* __restrict__ w_uv, const float* __restrict__ rel_bias, int t, int tid) {
    LDSP float* q = (LDSP float*)lds; LDSP float* qlat = q + 512; LDSP float* pr = qlat + 2048; LDSP float* outl = pr + 2048; LDSP unsigned short* sel = (LDSP unsigned short*)(outl + 2048);
    const int s = t & (SEQ - 1), b = t >> 12, lane = tid & 63, wv = tid >> 6;
    const int nk = ((s >> 6) + 1) << 6, nsel = nk < TOPK ? nk : TOPK;
    q[tid] = bf2f(RA[(size_t)t * NA + A_Q + tid]); if (tid < 256) sel[tid] = tid < nsel ? idx[(size_t)t * TOPK + tid] : (unsigned short)0;
    __syncthreads();
    {   const int r = tid & 255, h0 = (tid >> 8) * 4;
        for (int h = h0; h < h0 + 4; ++h) { const float* w = w_uk + ((size_t)r * 8 + h) * 64; float a = 0.f;
#pragma unroll 16
            for (int d = 0; d < 64; ++d) a += q[h * 64 + d] * w[d];
            qlat[h * 256 + r] = a * 0.125f; } }
    __syncthreads();
    {   const int k = tid & 255, h0 = (tid >> 8) * 4;
        if (k < nsel) { const int key = sel[k]; const bf16* kr = RB + (size_t)(b * SEQ + key) * NB + B_CKV; float a[4] = {0.f, 0.f, 0.f, 0.f};
            for (int j = 0; j < 32; ++j) { const u32x4 w = *((const u32x4*)kr + j); const unsigned ww[4] = {w.x, w.y, w.z, w.w};
#pragma unroll
                for (int e = 0; e < 8; ++e) { const float v = bf2f((bf16)((ww[e >> 1] >> ((e & 1) * 16)) & 0xffff));
#pragma unroll
                    for (int hh = 0; hh < 4; ++hh) a[hh] += qlat[(h0 + hh) * 256 + j * 8 + e] * v; } }
            const int bk = t5_bucket(key - s);
#pragma unroll
            for (int hh = 0; hh < 4; ++hh) pr[(h0 + hh) * 256 + k] = a[hh] + rel_bias[bk * 8 + h0 + hh];
        } else {
#pragma unroll
            for (int hh = 0; hh < 4; ++hh) pr[(h0 + hh) * 256 + k] = -INFINITY; } }
    __syncthreads();
    {   float v[4]; float m = -INFINITY;
#pragma unroll
        for (int j = 0; j < 4; ++j) { v[j] = pr[wv * 256 + lane + 64 * j]; m = fmaxf(m, v[j]); }
        m = wave_max(m); float sum = 0.f;
#pragma unroll
        for (int j = 0; j < 4; ++j) { v[j] = __expf(v[j] - m); sum += v[j]; }
        sum = wave_sum(sum); const float inv = 1.0f / sum;
#pragma unroll
        for (int j = 0; j < 4; ++j) pr[wv * 256 + lane + 64 * j] = v[j] * inv; }
    __syncthreads();
    {   const int r = tid & 255, h0 = (tid >> 8) * 4; float a[4] = {0.f, 0.f, 0.f, 0.f};
        for (int k = 0; k < nsel; ++k) { const float v = bf2f(RB[(size_t)(b * SEQ + sel[k]) * NB + B_CKV + r]);
#pragma unroll
            for (int hh = 0; hh < 4; ++hh) a[hh] += pr[(h0 + hh) * 256 + k] * v; }
#pragma unroll
        for (int hh = 0; hh < 4; ++hh) outl[(h0 + hh) * 256 + r] = a[hh]; }
    __syncthreads();
    {   const int h = tid >> 6, d = tid & 63; float a = 0.f;
        for (int r = 0; r < 256; ++r) a += outl[h * 256 + r] * w_uv[((size_t)r * 8 + h) * 64 + d];
        RA[(size_t)t * NA + A_Q + tid] = f2bf(a); }
    __syncthreads();
}
__device__ __forceinline__ void half_m4b_scan(bf16* RA, const bf16* __restrict__ XA, const float* __restrict__ DT, const float* __restrict__ a_log, const float* __restrict__ dsk, int b, int h, int tid) {
    const int g = h >> 3, p = tid >> 2, nq = tid & 3;
    const float A = -__expf(a_log[h]), Dh = dsk[h];
    float hs[32];
#pragma unroll
    for (int n = 0; n < 32; ++n) hs[n] = 0.f;
    for (int s = 0; s < SEQ; ++s) { const size_t t = (size_t)b * SEQ + s; const float dt = DT[t * 16 + h]; const float dA = __expf(dt * A);
        const bf16* xr = XA + t * XBC; const float x = bf2f(xr[h * 64 + p]); const float dx = dt * x;
        const u32x4* Bp = (const u32x4*)(xr + 1024 + g * 128 + nq * 32); const u32x4* Cp = (const u32x4*)(xr + 1280 + g * 128 + nq * 32); float y = 0.f;
#pragma unroll
        for (int j = 0; j < 4; ++j) { const u32x4 bw = Bp[j], cw = Cp[j]; const unsigned bb[4] = {bw.x, bw.y, bw.z, bw.w}, cc[4] = {cw.x, cw.y, cw.z, cw.w};
#pragma unroll
            for (int e = 0; e < 8; ++e) { const float Bv = bf2f((bf16)((bb[e >> 1] >> ((e & 1) * 16)) & 0xffff)), Cv = bf2f((bf16)((cc[e >> 1] >> ((e & 1) * 16)) & 0xffff));
                hs[j * 8 + e] = hs[j * 8 + e] * dA + dx * Bv; y += Cv * hs[j * 8 + e]; } }
        y += __shfl_xor(y, 1); y += __shfl_xor(y, 2);
        if (nq == 0) { bf16* zp = RA + t * NA + A_Z + h * 64 + p; const float z = bf2f(*zp); *zp = f2bf((y + Dh * x) * siluf_(z)); }
    }
}
__device__ __forceinline__ void wave_m4c_gnorm(bf16* RA, const float* __restrict__ nw, int w, int lane, bool dry = false) {
    const int t = w >> 1, g = w & 1;
    bf16* p = RA + (size_t)t * NA + A_Z + g * 512 + lane * 8; const u32x4 v = *(const u32x4*)p; const unsigned vw[4] = {v.x, v.y, v.z, v.w}; float f[8]; float ss = 0.f;
#pragma unroll
    for (int e = 0; e < 8; ++e) { f[e] = bf2f((bf16)((vw[e >> 1] >> ((e & 1) * 16)) & 0xffff)); ss += f[e] * f[e]; }
    const float r = 1.0f / sqrtf(wave_sum(ss) * (1.0f / 512.0f) + EPS); const float* gw = nw + g * 512 + lane * 8;
    u32x4 o; o.x = pk2(f[0] * r * gw[0], f[1] * r * gw[1]); o.y = pk2(f[2] * r * gw[2], f[3] * r * gw[3]); o.z = pk2(f[4] * r * gw[4], f[5] * r * gw[5]); o.w = pk2(f[6] * r * gw[6], f[7] * r * gw[7]);
    if (!dry) *(u32x4*)p = o;
}

__device__ __forceinline__ void unpack8(const u32x4 w, float (&f)[8]) { const unsigned ww[4] = {w.x, w.y, w.z, w.w};
#pragma unroll
    for (int e = 0; e < 4; ++e) { f[2 * e] = __builtin_bit_cast(float, ww[e] << 16); f[2 * e + 1] = __builtin_bit_cast(float, ww[e] & 0xffff0000u); } }
__device__ __forceinline__ void prep_ckv4(const bf16* __restrict__ RB, bf16* __restrict__ CKVC, const float* __restrict__ kvn, int it, int lane) {
    const int t = it * 4 + (lane >> 4), c = lane & 15; const u32x4* src = (const u32x4*)(RB + (size_t)t * NB + B_CKV + c * 16); const u32x4 a = src[0], b = src[1];
    float v[16]; { float f[8]; unpack8(a, f);
#pragma unroll
        for (int e = 0; e < 8; ++e) v[e] = f[e]; unpack8(b, f);
#pragma unroll
        for (int e = 0; e < 8; ++e) v[8 + e] = f[e]; }
    float ss = 0.f;
#pragma unroll
    for (int e = 0; e < 16; ++e) ss += v[e] * v[e];
    ss += __shfl_xor(ss, 1); ss += __shfl_xor(ss, 2); ss += __shfl_xor(ss, 4); ss += __shfl_xor(ss, 8);
    const float r = 1.0f / sqrtf(ss * (1.0f / KV_R) + EPS); const f32x4* gp = (const f32x4*)(kvn + c * 16); float o[16];
#pragma unroll
    for (int q = 0; q < 4; ++q) { const f32x4 gg = gp[q]; o[4 * q] = v[4 * q] * r * gg.x; o[4 * q + 1] = v[4 * q + 1] * r * gg.y; o[4 * q + 2] = v[4 * q + 2] * r * gg.z; o[4 * q + 3] = v[4 * q + 3] * r * gg.w; }
    u32x4 w0, w1; w0.x = pk2(o[0], o[1]); w0.y = pk2(o[2], o[3]); w0.z = pk2(o[4], o[5]); w0.w = pk2(o[6], o[7]); w1.x = pk2(o[8], o[9]); w1.y = pk2(o[10], o[11]); w1.z = pk2(o[12], o[13]); w1.w = pk2(o[14], o[15]);
    u32x4* dst = (u32x4*)(CKVC + (size_t)t * KV_R + c * 16); dst[0] = w0; dst[1] = w1;
}
__device__ __forceinline__ void prep_ik16(const bf16* __restrict__ RB, bf16* __restrict__ IKC, const float* __restrict__ ikg, const float* __restrict__ ikb, int it, int lane) {
    const int t = it * 16 + (lane >> 2), c = lane & 3; const u32x4* src = (const u32x4*)(RB + (size_t)t * NB + B_IK + c * 16); const u32x4 a = src[0], b = src[1];
    float v[16]; { float f[8]; unpack8(a, f);
#pragma unroll
        for (int e = 0; e < 8; ++e) v[e] = f[e]; unpack8(b, f);
#pragma unroll
        for (int e = 0; e < 8; ++e) v[8 + e] = f[e]; }
    float s = 0.f;
#pragma unroll
    for (int e = 0; e < 16; ++e) s += v[e];
    s += __shfl_xor(s, 1); s += __shfl_xor(s, 2); const float mu = s * (1.0f / 64.0f); float q2 = 0.f;
#pragma unroll
    for (int e = 0; e < 16; ++e) { v[e] -= mu; q2 += v[e] * v[e]; }
    q2 += __shfl_xor(q2, 1); q2 += __shfl_xor(q2, 2); const float r = 1.0f / sqrtf(q2 * (1.0f / 64.0f) + EPS); float o[16];
#pragma unroll
    for (int e = 0; e < 16; ++e) o[e] = v[e] * r * ikg[c * 16 + e] + ikb[c * 16 + e];
    u32x4 w0, w1; w0.x = pk2(o[0], o[1]); w0.y = pk2(o[2], o[3]); w0.z = pk2(o[4], o[5]); w0.w = pk2(o[6], o[7]); w1.x = pk2(o[8], o[9]); w1.y = pk2(o[10], o[11]); w1.z = pk2(o[12], o[13]); w1.w = pk2(o[14], o[15]);
    u32x4* dst = (u32x4*)(IKC + (size_t)t * 64 + c * 16); dst[0] = w0; dst[1] = w1;
}
__device__ __forceinline__ void prep_bout(bf16* RA, const bf16* __restrict__ RB, const float* __restrict__ scw, int t, int lane, bool dry = false) {
    const int s = t & (SEQ - 1), c = lane * 8; float acc[8] = {0.f, 0.f, 0.f, 0.f, 0.f, 0.f, 0.f, 0.f};
    u32x4 cg[3], hb[3];
#pragma unroll
    for (int j = 0; j < 3; ++j) { const bool ok = (s - 2 + j) >= 0; const bf16* rr = RB + (size_t)(t - 2 + j) * NB; cg[j] = ok ? *(const u32x4*)(rr + B_CG + c) : (u32x4){0u, 0u, 0u, 0u}; hb[j] = ok ? *(const u32x4*)(rr + B_HB + c) : (u32x4){0u, 0u, 0u, 0u}; }
    bf16* ra = RA + (size_t)t * NA + A_BG + c; const u32x4 bg = *(const u32x4*)ra;
#pragma unroll
    for (int j = 0; j < 3; ++j) { float a[8], b[8]; unpack8(cg[j], a); unpack8(hb[j], b); const f32x4 w0 = *(const f32x4*)(scw + j * 512 + c), w1 = *(const f32x4*)(scw + j * 512 + c + 4);
        acc[0] += w0.x * (a[0] * b[0]); acc[1] += w0.y * (a[1] * b[1]); acc[2] += w0.z * (a[2] * b[2]); acc[3] += w0.w * (a[3] * b[3]);
        acc[4] += w1.x * (a[4] * b[4]); acc[5] += w1.y * (a[5] * b[5]); acc[6] += w1.z * (a[6] * b[6]); acc[7] += w1.w * (a[7] * b[7]); }
    float g8[8]; unpack8(bg, g8); u32x4 w; w.x = pk2(g8[0] * acc[0], g8[1] * acc[1]); w.y = pk2(g8[2] * acc[2], g8[3] * acc[3]); w.z = pk2(g8[4] * acc[4], g8[5] * acc[5]); w.w = pk2(g8[6] * acc[6], g8[7] * acc[7]);
    if (!dry) *(u32x4*)ra = w;
}
__device__ __forceinline__ void prep_conv(const bf16* __restrict__ RB, bf16* __restrict__ XA, const float* __restrict__ cw, const float* __restrict__ cb, int it, int lane) {
    const int rb = it / 12, cbk = it % 12, xcol = cbk * 128 + 2 * lane, t0 = rb * 16, s0 = t0 & (SEQ - 1);
    float w0[4], w1[4];
#pragma unroll
    for (int j = 0; j < 4; ++j) { w0[j] = cw[j * XBC + xcol]; w1[j] = cw[j * XBC + xcol + 1]; }
    const float cb0 = cb[xcol], cb1 = cb[xcol + 1];
    const bf16* src = RB + (size_t)(t0 - 3) * NB + B_XBC + xcol; unsigned raw[19];
#pragma unroll
    for (int i = 0; i < 19; ++i) raw[i] = (s0 - 3 + i >= 0) ? *(const unsigned*)(src + (size_t)i * NB) : 0u;
#pragma unroll
    for (int i = 0; i < 16; ++i) { float a0 = cb0, a1 = cb1;
#pragma unroll
        for (int j = 0; j < 4; ++j) { a0 += w0[j] * __builtin_bit_cast(float, raw[i + j] << 16); a1 += w1[j] * __builtin_bit_cast(float, raw[i + j] & 0xffff0000u); }
        *(unsigned*)(XA + (size_t)(t0 + i) * XBC + xcol) = pk2(siluf_(a0), siluf_(a1)); }
}

typedef short bf16x8_t __attribute__((ext_vector_type(8)));
#ifndef SEL_REP_SEARCH
#define SEL_REP_SEARCH 1
#endif
#ifndef SEL_REP_STAGE
#define SEL_REP_STAGE 1
#endif
#define CNT8_GE(cnt, v0, v1, v2, v3, v4, v5, v6, v7, cand) do { unsigned long long m0_, m1_, m2_, m3_, m4_, m5_, m6_, m7_; \
    asm("v_cmp_ge_u32_e64 %0, %8, %16\n\tv_cmp_ge_u32_e64 %1, %9, %16\n\tv_cmp_ge_u32_e64 %2, %10, %16\n\tv_cmp_ge_u32_e64 %3, %11, %16\n\t" \
        "v_cmp_ge_u32_e64 %4, %12, %16\n\tv_cmp_ge_u32_e64 %5, %13, %16\n\tv_cmp_ge_u32_e64 %6, %14, %16\n\tv_cmp_ge_u32_e64 %7, %15, %16" \
        : "=&s"(m0_), "=&s"(m1_), "=&s"(m2_), "=&s"(m3_), "=&s"(m4_), "=&s"(m5_), "=&s"(m6_), "=&s"(m7_) \
        : "v"(v0), "v"(v1), "v"(v2), "v"(v3), "v"(v4), "v"(v5), "v"(v6), "v"(v7), "s"(cand)); \
    cnt += (__popcll(m0_) + __popcll(m1_)) + (__popcll(m2_) + __popcll(m3_)) + (__popcll(m4_) + __popcll(m5_)) + (__popcll(m6_) + __popcll(m7_)); } while (0)
constexpr int SC_STRIDE = 516, SC_BUF = 16 * SC_STRIDE;
constexpr int IKW_OFF = 66560;
__device__ __forceinline__ void wg_select16(LDSP unsigned char* lds, const bf16* __restrict__ RB, const bf16* __restrict__ IKC, unsigned short* __restrict__ idx, int unit, int tid, bool dry = false, bool lds_out = false) {
    const int lane = tid & 63, wave = __builtin_amdgcn_readfirstlane(tid >> 6), g = lane >> 4, c = lane & 15;
    const int b = unit >> 8, qg = unit & 255, t0 = b * SEQ + qg * 16, nk = ((qg >> 2) + 1) << 6, nr = nk >> 6;
    LDSP unsigned* SC = (LDSP unsigned*)lds;
    bf16x8_t bq[4][2]; float iwq[4];
    { const bf16* qr = RB + (size_t)(t0 + c) * NB;
#pragma unroll
      for (int h = 0; h < 4; ++h) { bq[h][0] = *(const bf16x8_t*)(qr + B_IQ + h * 64 + g * 8); bq[h][1] = *(const bf16x8_t*)(qr + B_IQ + h * 64 + 32 + g * 8); iwq[h] = bf2f(qr[B_IW + h]) * 0.0625f; } }
    unsigned val[2][64];
#pragma unroll
    for (int r = 0; r < 64; ++r) { val[0][r] = 0u; val[1][r] = 0u; }
    const bf16* ikb = IKC + (size_t)b * SEQ * 64;
    LDSP unsigned char* ikw = lds + IKW_OFF + wave * 8192;
#define IK_DMA(stage) do { if ((stage) * 512 + wave * 64 < nk) { const bf16* src_ = ikb + (size_t)((stage) * 512 + wave * 64) * 64 + lane * 8; _Pragma("unroll") for (int pc_ = 0; pc_ < 8; ++pc_) \
        __builtin_amdgcn_global_load_lds((const unsigned*)(src_ + pc_ * 512), (LDSP unsigned*)(ikw + pc_ * 1024), 16, 0, 0); } } while (0)
    IK_DMA(0);
    for (int rep_st = 0; rep_st < SEL_REP_STAGE; ++rep_st) {
    if (rep_st > 0) { asm volatile("s_waitcnt vmcnt(0)" ::: "memory"); __builtin_amdgcn_s_barrier(); IK_DMA(0); }
#pragma unroll
    for (int s = 0; s < 8; ++s) {
        if (s * 512 < nk) {
            LDSP unsigned* buf = SC + (s & 1) * SC_BUF;
            asm volatile("s_waitcnt vmcnt(0)" ::: "memory");
            bf16x8_t af[4][2];
#pragma unroll
            for (int i = 0; i < 4; ++i) { af[i][0] = *(const LDSP bf16x8_t*)(ikw + (16 * i + c) * 128 + g * 16); af[i][1] = *(const LDSP bf16x8_t*)(ikw + (16 * i + c) * 128 + 64 + g * 16); }
            asm volatile("s_waitcnt lgkmcnt(0)" ::: "memory");
            if (s < 7) IK_DMA(s + 1);
#pragma unroll
            for (int i = 0; i < 4; ++i) { const int tl = wave * 4 + i, kb = s * 512 + tl * 16;
                if (kb < nk) {
                    const bf16x8_t a0 = af[i][0], a1 = af[i][1];
                    float sc[4] = {0.f, 0.f, 0.f, 0.f};
#pragma unroll
                    for (int h = 0; h < 4; ++h) { pg8::f32x4 acc = {0.f, 0.f, 0.f, 0.f};
                        acc = __builtin_amdgcn_mfma_f32_16x16x32_bf16(a0, bq[h][0], acc, 0, 0, 0); acc = __builtin_amdgcn_mfma_f32_16x16x32_bf16(a1, bq[h][1], acc, 0, 0, 0);
#pragma unroll
                        for (int e = 0; e < 4; ++e) sc[e] += fmaxf(acc[e], 0.f) * iwq[h]; }
                    u32x4 kv; kv.x = ord_key(sc[0]); kv.y = ord_key(sc[1]); kv.z = ord_key(sc[2]); kv.w = ord_key(sc[3]);
                    *(LDSP u32x4*)(buf + c * SC_STRIDE + tl * 16 + 4 * g) = kv; } }
            asm volatile("s_waitcnt lgkmcnt(0)" ::: "memory"); __builtin_amdgcn_s_barrier(); asm volatile("" ::: "memory");
#pragma unroll
            for (int j = 0; j < 8; ++j) if (s * 512 + j * 64 < nk) { val[0][s * 8 + j] = buf[(2 * wave) * SC_STRIDE + j * 64 + lane]; val[1][s * 8 + j] = buf[(2 * wave + 1) * SC_STRIDE + j * 64 + lane]; }
            asm volatile("s_waitcnt lgkmcnt(0)" ::: "memory");
        }
    }
    }
    const unsigned long long lt = (1ull << lane) - 1ull;
#pragma unroll
    for (int qq = 0; qq < 2; ++qq) {
        unsigned Tt = 0u;
        for (int rep_se = 0; rep_se < SEL_REP_SEARCH; ++rep_se) { Tt = 0u; asm volatile("" : "+v"(val[qq][0]));
        if (nk > TOPK) {
            for (int bit = 31; bit >= 0; --bit) { const unsigned cand = Tt | (1u << bit); int cnt = 0;
#pragma unroll
                for (int r8 = 0; r8 < 8; ++r8) if (r8 * 8 < nr) CNT8_GE(cnt, val[qq][r8 * 8], val[qq][r8 * 8 + 1], val[qq][r8 * 8 + 2], val[qq][r8 * 8 + 3], val[qq][r8 * 8 + 4], val[qq][r8 * 8 + 5], val[qq][r8 * 8 + 6], val[qq][r8 * 8 + 7], cand);
                if (cnt >= TOPK) Tt = cand; if (cnt == TOPK) break; }
        }
        }
        unsigned short* orow = idx + (size_t)(t0 + 2 * wave + qq) * TOPK;
        LDSP unsigned short* orow_l = (LDSP unsigned short*)(lds + 134 * 1024) + (2 * wave + qq) * TOPK;
        int pos = 0;
#define PUT_KEY(o_, key_) do { if ((o_) < TOPK && !dry) { if (lds_out) orow_l[o_] = (unsigned short)(key_); else orow[o_] = (unsigned short)(key_); } } while (0)
#pragma unroll
        for (int r8 = 0; r8 < 8; ++r8) if (r8 * 8 < nr) { unsigned long long k0, k1, k2, k3, k4, k5, k6, k7;
            asm("v_cmp_gt_u32_e64 %0, %8, %16\n\tv_cmp_gt_u32_e64 %1, %9, %16\n\tv_cmp_gt_u32_e64 %2, %10, %16\n\tv_cmp_gt_u32_e64 %3, %11, %16\n\t"
                "v_cmp_gt_u32_e64 %4, %12, %16\n\tv_cmp_gt_u32_e64 %5, %13, %16\n\tv_cmp_gt_u32_e64 %6, %14, %16\n\tv_cmp_gt_u32_e64 %7, %15, %16"
                : "=&s"(k0), "=&s"(k1), "=&s"(k2), "=&s"(k3), "=&s"(k4), "=&s"(k5), "=&s"(k6), "=&s"(k7)
                : "v"(val[qq][r8 * 8]), "v"(val[qq][r8 * 8 + 1]), "v"(val[qq][r8 * 8 + 2]), "v"(val[qq][r8 * 8 + 3]), "v"(val[qq][r8 * 8 + 4]), "v"(val[qq][r8 * 8 + 5]), "v"(val[qq][r8 * 8 + 6]), "v"(val[qq][r8 * 8 + 7]), "s"(Tt));
#define PUT_MASK(m_, i_) do { if ((m_) != 0ull) { if (((m_) >> lane) & 1ull) { const int o = pos + __popcll((m_) & lt); PUT_KEY(o, (r8 * 8 + (i_)) * 64 + lane); } pos += __popcll(m_); } } while (0)
            PUT_MASK(k0, 0); PUT_MASK(k1, 1); PUT_MASK(k2, 2); PUT_MASK(k3, 3); PUT_MASK(k4, 4); PUT_MASK(k5, 5); PUT_MASK(k6, 6); PUT_MASK(k7, 7);
#undef PUT_MASK
        }
        int need = TOPK - pos;
        if (need > 0) {
#pragma unroll
            for (int r = 0; r < 64; ++r) if (r < nr && need > 0) { const unsigned long long meq = __ballot(val[qq][r] == Tt);
                if (meq != 0ull) { const int rank = __popcll(meq & lt); if (((meq >> lane) & 1ull) && rank < need) { PUT_KEY(pos + rank, r * 64 + lane); } const int tk = __popcll(meq); const int tkn = tk < need ? tk : need; pos += tkn; need -= tkn; } }
        }
#undef PUT_KEY
    }
    asm volatile("s_waitcnt vmcnt(0)" ::: "memory"); __builtin_amdgcn_s_barrier();
#undef IK_DMA
}

typedef unsigned short u16x4_t __attribute__((ext_vector_type(4)));
#ifndef ATT_LOCAL_DRY
#define ATT_LOCAL_DRY 0
#endif
#ifndef ATT_STAGGER
#define ATT_STAGGER 0
#endif
#ifndef ATT_DRY_SKIP
#define ATT_DRY_SKIP 0
#endif
#define DSK(b) (ATT_DRY_SKIP & (b)) && dry
#ifndef ATT_SUB_EN
#define ATT_SUB_EN 0
#endif
constexpr int SELW_OFF = 134 * 1024, BT_OFF = 142 * 1024, KVP = 528, TILE_STRIDE = 32 * KVP;
constexpr int SELW_OFF_OLD = 132 * 1024, BT_OFF_OLD = 140 * 1024;
__device__ __forceinline__ int kv_off(int row, int ch) { const int hf = ch >> 4, c16 = ch & 15; return hf * 8192 + 256 * row + 16 * (c16 ^ (((row & 3) << 2) | ((row >> 2) & 3))); }
#define TR4I(d0, d1, d2, d3, base, o0, o1, o2, o3) asm volatile("ds_read_b64_tr_b16 %0, %4 offset:%5\n\tds_read_b64_tr_b16 %1, %4 offset:%6\n\tds_read_b64_tr_b16 %2, %4 offset:%7\n\tds_read_b64_tr_b16 %3, %4 offset:%8" \
    : "=&v"(d0), "=&v"(d1), "=&v"(d2), "=&v"(d3) : "v"(base), "i"(o0), "i"(o1), "i"(o2), "i"(o3) : "memory")
#define TR8N(d0, d1, d2, d3, d4, d5, d6, d7, base, o0, o1, o2, o3, o4, o5, o6, o7) asm volatile( \
    "ds_read_b64_tr_b16 %0, %8 offset:%9\n\tds_read_b64_tr_b16 %1, %8 offset:%10\n\tds_read_b64_tr_b16 %2, %8 offset:%11\n\tds_read_b64_tr_b16 %3, %8 offset:%12\n\t" \
    "ds_read_b64_tr_b16 %4, %8 offset:%13\n\tds_read_b64_tr_b16 %5, %8 offset:%14\n\tds_read_b64_tr_b16 %6, %8 offset:%15\n\tds_read_b64_tr_b16 %7, %8 offset:%16" \
    : "=&v"(d0), "=&v"(d1), "=&v"(d2), "=&v"(d3), "=&v"(d4), "=&v"(d5), "=&v"(d6), "=&v"(d7) : "v"(base), "i"(o0), "i"(o1), "i"(o2), "i"(o3), "i"(o4), "i"(o5), "i"(o6), "i"(o7) : "memory")
#define WAITPIN8(n, d0, d1, d2, d3, d4, d5, d6, d7) asm volatile("s_waitcnt lgkmcnt(" #n ")" : "+v"(d0), "+v"(d1), "+v"(d2), "+v"(d3), "+v"(d4), "+v"(d5), "+v"(d6), "+v"(d7) :: "memory")
#define WAITPIN4(n, d0, d1, d2, d3) asm volatile("s_waitcnt lgkmcnt(" #n ")" : "+v"(d0), "+v"(d1), "+v"(d2), "+v"(d3) :: "memory")
__device__ __forceinline__ bf16x8_t mk8a(u16x4_t a, u16x4_t b) { bf16x8_t r; r[0] = a[0]; r[1] = a[1]; r[2] = a[2]; r[3] = a[3]; r[4] = b[0]; r[5] = b[1]; r[6] = b[2]; r[7] = b[3]; return r; }
#define TR8I(d0, d1, d2, d3, d4, d5, d6, d7, base, o0, o1, o2, o3, o4, o5, o6, o7) asm volatile( \
    "ds_read_b64_tr_b16 %0, %8 offset:%9\n\tds_read_b64_tr_b16 %1, %8 offset:%10\n\tds_read_b64_tr_b16 %2, %8 offset:%11\n\tds_read_b64_tr_b16 %3, %8 offset:%12\n\t" \
    "ds_read_b64_tr_b16 %4, %8 offset:%13\n\tds_read_b64_tr_b16 %5, %8 offset:%14\n\tds_read_b64_tr_b16 %6, %8 offset:%15\n\tds_read_b64_tr_b16 %7, %8 offset:%16\n\ts_waitcnt lgkmcnt(0)" \
    : "=&v"(d0), "=&v"(d1), "=&v"(d2), "=&v"(d3), "=&v"(d4), "=&v"(d5), "=&v"(d6), "=&v"(d7) : "v"(base), "i"(o0), "i"(o1), "i"(o2), "i"(o3), "i"(o4), "i"(o5), "i"(o6), "i"(o7) : "memory")
#define TR8(d0, d1, d2, d3, d4, d5, d6, d7, a0, a1, a2, a3, a4, a5, a6, a7) asm volatile( \
    "ds_read_b64_tr_b16 %0, %8\n\tds_read_b64_tr_b16 %1, %9\n\tds_read_b64_tr_b16 %2, %10\n\tds_read_b64_tr_b16 %3, %11\n\t" \
    "ds_read_b64_tr_b16 %4, %12\n\tds_read_b64_tr_b16 %5, %13\n\tds_read_b64_tr_b16 %6, %14\n\tds_read_b64_tr_b16 %7, %15\n\ts_waitcnt lgkmcnt(0)" \
    : "=&v"(d0), "=&v"(d1), "=&v"(d2), "=&v"(d3), "=&v"(d4), "=&v"(d5), "=&v"(d6), "=&v"(d7) : "v"(a0), "v"(a1), "v"(a2), "v"(a3), "v"(a4), "v"(a5), "v"(a6), "v"(a7) : "memory")
__device__ __forceinline__ void wg_attn16(LDSP unsigned char* lds, bf16* RA, const bf16* __restrict__ CKVC, const unsigned short* __restrict__ idx, const bf16* __restrict__ WUK, const bf16* __restrict__ WUV,
                                          const float* __restrict__ rel_bias, int unit, int nxt_unit, int par, bool first, int tid, bool dry = false, int qmode = 0, bf16* qscr = nullptr) {
    const int lane = tid & 63, wave = __builtin_amdgcn_readfirstlane(tid >> 6), g = lane >> 4, c = lane & 15;
    const int b = unit >> 9, qg = unit & 511, t0 = b * SEQ + qg * 8, nk = ((qg >> 3) + 1) << 6, nsel = nk < TOPK ? nk : TOPK, ntile = nsel >> 5;
    LDSP unsigned char* QL = lds;
    LDSP unsigned char* tile = lds + wave * TILE_STRIDE;
    LDSP unsigned short* selw = (LDSP unsigned short*)(lds + SELW_OFF + (par * 8 + wave) * 512);
    LDSP unsigned short* selw_n = (LDSP unsigned short*)(lds + SELW_OFF + ((par ^ 1) * 8 + wave) * 512);
    if (first) { if (lane < 32) *((LDSP u32x4*)selw + lane) = *((const u32x4*)(idx + (size_t)(t0 + wave) * TOPK) + lane); }
    const bf16* kvb = CKVC + (size_t)b * SEQ * KV_R + g * 8;
    bf16x8_t kv0[8], kv1[8];
#define KV_LOAD(dst, key) do { const bf16* rp_ = kvb + (size_t)(key) * KV_R; _Pragma("unroll") for (int ks_ = 0; ks_ < 8; ++ks_) dst[ks_] = *(const bf16x8_t*)(rp_ + ks_ * 32); } while (0)
    int ka = (int)selw[c], kb = (int)selw[16 + c];
    KV_LOAD(kv0, ka); KV_LOAD(kv1, kb);
    bf16x8_t qf[8];
    if (qmode != 2) {
        const int h = wave; const bf16* qr = RA + (size_t)(t0 + (qmode == 1 ? c : (c & 7))) * NA + A_Q + h * 64 + g * 8;
        const bf16x8_t b0 = *(const bf16x8_t*)qr, b1 = *(const bf16x8_t*)(qr + 32);
        const bf16* wb = WUK + ((size_t)h * 256 + c) * 64 + g * 8;
#pragma unroll 4
        for (int rt = 0; rt < 16; ++rt) { const bf16x8_t a0 = *(const bf16x8_t*)(wb + rt * 16 * 64), a1 = *(const bf16x8_t*)(wb + rt * 16 * 64 + 32);
            pg8::f32x4 acc = {0.f, 0.f, 0.f, 0.f};
            acc = __builtin_amdgcn_mfma_f32_16x16x32_bf16(a0, b0, acc, 0, 0, 0); acc = __builtin_amdgcn_mfma_f32_16x16x32_bf16(a1, b1, acc, 0, 0, 0);
            u32x2 w; w.x = pk2(acc[0], acc[1]); w.y = pk2(acc[2], acc[3]);
            if (c < 8) *(LDSP u32x2*)(QL + (((c * 8 + h) * 256) + rt * 16 + 4 * g) * 2) = w;
            else if (qmode == 1) *(u32x2*)(qscr + ((((c - 8) * 8 + h) * 256) + rt * 16 + 4 * g)) = w; }
        asm volatile("s_waitcnt lgkmcnt(0)" ::: "memory"); __builtin_amdgcn_s_barrier(); asm volatile("" ::: "memory");
#pragma unroll
        for (int ks = 0; ks < 8; ++ks) qf[ks] = *(const LDSP bf16x8_t*)(QL + (((wave * 8 + (c & 7)) * 256) + ks * 32 + g * 8) * 2);
        asm volatile("s_waitcnt lgkmcnt(0)" ::: "memory"); __builtin_amdgcn_s_barrier(); asm volatile("" ::: "memory");
    } else {
        const unsigned long long* qs = (const unsigned long long*)(qscr + (((wave * 8 + (c & 7)) * 256) + g * 8));
#pragma unroll
        for (int ks = 0; ks < 8; ++ks) { const unsigned long long lo = __hip_atomic_load(qs + ks * 8, __ATOMIC_RELAXED, __HIP_MEMORY_SCOPE_AGENT), hi = __hip_atomic_load(qs + ks * 8 + 1, __ATOMIC_RELAXED, __HIP_MEMORY_SCOPE_AGENT);
            u32x4 w; w.x = (unsigned)lo; w.y = (unsigned)(lo >> 32); w.z = (unsigned)hi; w.w = (unsigned)(hi >> 32); qf[ks] = __builtin_bit_cast(bf16x8_t, w); }
    }
    const unsigned tile_a = (unsigned)(size_t)tile;
#if ATT_STAGGER
    if (wave >= 4) __builtin_amdgcn_s_sleep(ATT_STAGGER);
#endif
    bf16x8_t bbf; { float bv[8];
#pragma unroll
        for (int j = 0; j < 8; ++j) bv[j] = rel_bias[(8 * g + j) * 8 + (c & 7)];
        u32x4 w; w.x = pk2(bv[0], bv[1]); w.y = pk2(bv[2], bv[3]); w.z = pk2(bv[4], bv[5]); w.w = pk2(bv[6], bv[7]); bbf = __builtin_bit_cast(bf16x8_t, w); }
    {
        const int spos = (qg * 8 + wave);
        pg8::f32x4 acc[16];
#pragma unroll
        for (int nt = 0; nt < 16; ++nt) acc[nt] = (pg8::f32x4){0.f, 0.f, 0.f, 0.f};
        float m_run = -INFINITY, l_run = 0.f;
#define ONEHOT(dst, key) do { const int rel_ = (key) - spos, n_ = rel_ < 0 ? -rel_ : rel_; \
            const int big_ = 8 + (n_ >= 15) + (n_ >= 27) + (n_ >= 50) + (n_ >= 91) + (n_ >= 166) + (n_ >= 305) + (n_ >= 559); \
            const int pos_ = (n_ < 8 ? n_ : big_) + (rel_ > 0 ? 16 : 0) - 8 * g; const unsigned one_ = (pos_ & 1) ? 0x3F800000u : 0x3F80u; const int hi_ = pos_ >> 1; \
            u32x4 w_; w_.x = (hi_ == 0) ? one_ : 0u; w_.y = (hi_ == 1) ? one_ : 0u; w_.z = (hi_ == 2) ? one_ : 0u; w_.w = (hi_ == 3) ? one_ : 0u; dst = __builtin_bit_cast(bf16x8_t, w_); } while (0)
        const int q4 = c >> 2, p = c & 3;
        const unsigned trb = tile_a + (4 * g + q4) * KVP + 8 * p;
        for (int tl = 0; tl < ntile; ++tl) {
            int kan = 0, kbn = 0; const bool more = tl + 1 < ntile;
            if (more) { kan = (int)selw[(2 * tl + 2) * 16 + c]; kbn = (int)selw[(2 * tl + 3) * 16 + c]; }
            bf16x8_t oha, ohb; ONEHOT(oha, ka); ONEHOT(ohb, kb);
            asm volatile("s_waitcnt vmcnt(8)" ::: "memory");
            pg8::f32x4 s0 = {0.f, 0.f, 0.f, 0.f}, s1 = {0.f, 0.f, 0.f, 0.f};
            s0 = __builtin_amdgcn_mfma_f32_16x16x32_bf16(oha, bbf, s0, 0, 0, 0);
#pragma unroll
            for (int ks = 0; ks < 8; ++ks) { s0 = __builtin_amdgcn_mfma_f32_16x16x32_bf16(kv0[ks], qf[ks], s0, 0, 0, 0); *(LDSP bf16x8_t*)(tile + c * KVP + g * 16 + ks * 64) = kv0[ks]; }
            if (more) KV_LOAD(kv0, kan);
            if (more) asm volatile("s_waitcnt vmcnt(8)" ::: "memory"); else asm volatile("s_waitcnt vmcnt(0)" ::: "memory");
            s1 = __builtin_amdgcn_mfma_f32_16x16x32_bf16(ohb, bbf, s1, 0, 0, 0);
#pragma unroll
            for (int ks = 0; ks < 8; ++ks) { s1 = __builtin_amdgcn_mfma_f32_16x16x32_bf16(kv1[ks], qf[ks], s1, 0, 0, 0); *(LDSP bf16x8_t*)(tile + (16 + c) * KVP + g * 16 + ks * 64) = kv1[ks]; }
            if (more) KV_LOAD(kv1, kbn);
            ka = kan; kb = kbn;
            float sv[8];
#pragma unroll
            for (int j = 0; j < 4; ++j) { sv[j] = s0[j]; sv[4 + j] = s1[j]; }
            float tmax = fmaxf(fmaxf(fmaxf(sv[0], sv[1]), fmaxf(sv[2], sv[3])), fmaxf(fmaxf(sv[4], sv[5]), fmaxf(sv[6], sv[7])));
            tmax = fmaxf(tmax, __shfl_xor(tmax, 16)); tmax = fmaxf(tmax, __shfl_xor(tmax, 32));
            const float m_new = fmaxf(m_run, tmax); const float scl = __expf(m_run - m_new); const bool grow = m_new > m_run; m_run = m_new;
            float ps = 0.f;
#pragma unroll
            for (int j = 0; j < 8; ++j) { sv[j] = __expf(sv[j] - m_new); ps += sv[j]; }
            l_run = l_run * scl + ps;
            bf16x8_t pf; { u32x4 w; w.x = pk2(sv[0], sv[1]); w.y = pk2(sv[2], sv[3]); w.z = pk2(sv[4], sv[5]); w.w = pk2(sv[6], sv[7]); pf = __builtin_bit_cast(bf16x8_t, w); }
            if (__builtin_amdgcn_ballot_w64(grow) != 0ull) {
                float rs[4];
#pragma unroll
                for (int e = 0; e < 4; ++e) rs[e] = __shfl(scl, 4 * g + e);
#pragma unroll
                for (int nt = 0; nt < 16; ++nt) {
#pragma unroll
                    for (int e = 0; e < 4; ++e) acc[nt][e] *= rs[e]; } }
            asm volatile("s_waitcnt lgkmcnt(0)" ::: "memory");
            u16x4_t va[8], vb[8];
            TR8N(va[0], va[1], va[2], va[3], va[4], va[5], va[6], va[7], trb, 0, 16 * KVP, 32, 32 + 16 * KVP, 64, 64 + 16 * KVP, 96, 96 + 16 * KVP);
            TR8N(vb[0], vb[1], vb[2], vb[3], vb[4], vb[5], vb[6], vb[7], trb, 128, 128 + 16 * KVP, 160, 160 + 16 * KVP, 192, 192 + 16 * KVP, 224, 224 + 16 * KVP);
            WAITPIN8(8, va[0], va[1], va[2], va[3], va[4], va[5], va[6], va[7]);
#pragma unroll
            for (int k = 0; k < 4; ++k) acc[k] = __builtin_amdgcn_mfma_f32_16x16x32_bf16(pf, mk8a(va[2 * k], va[2 * k + 1]), acc[k], 0, 0, 0);
            TR8N(va[0], va[1], va[2], va[3], va[4], va[5], va[6], va[7], trb, 256, 256 + 16 * KVP, 288, 288 + 16 * KVP, 320, 320 + 16 * KVP, 352, 352 + 16 * KVP);
            WAITPIN8(8, vb[0], vb[1], vb[2], vb[3], vb[4], vb[5], vb[6], vb[7]);
#pragma unroll
            for (int k = 0; k < 4; ++k) acc[4 + k] = __builtin_amdgcn_mfma_f32_16x16x32_bf16(pf, mk8a(vb[2 * k], vb[2 * k + 1]), acc[4 + k], 0, 0, 0);
            TR8N(vb[0], vb[1], vb[2], vb[3], vb[4], vb[5], vb[6], vb[7], trb, 384, 384 + 16 * KVP, 416, 416 + 16 * KVP, 448, 448 + 16 * KVP, 480, 480 + 16 * KVP);
            WAITPIN8(8, va[0], va[1], va[2], va[3], va[4], va[5], va[6], va[7]);
#pragma unroll
            for (int k = 0; k < 4; ++k) acc[8 + k] = __builtin_amdgcn_mfma_f32_16x16x32_bf16(pf, mk8a(va[2 * k], va[2 * k + 1]), acc[8 + k], 0, 0, 0);
            WAITPIN8(0, vb[0], vb[1], vb[2], vb[3], vb[4], vb[5], vb[6], vb[7]);
#pragma unroll
            for (int k = 0; k < 4; ++k) acc[12 + k] = __builtin_amdgcn_mfma_f32_16x16x32_bf16(pf, mk8a(vb[2 * k], vb[2 * k + 1]), acc[12 + k], 0, 0, 0);
        }
#undef KV_LOAD
#undef ONEHOT
        float lt = l_run + __shfl_xor(l_run, 16); lt += __shfl_xor(lt, 32); const float inv = 1.0f / lt;
        float ri[4];
#pragma unroll
        for (int e = 0; e < 4; ++e) ri[e] = __shfl(inv, 4 * g + e);
        if (g < 2) {
#pragma unroll
            for (int nt = 0; nt < 16; ++nt) { LDSP unsigned short* o1 = (LDSP unsigned short*)(tile) + (4 * g) * 256 + nt * 16 + c;
                o1[0] = f2bf(acc[nt][0] * ri[0]); o1[256] = f2bf(acc[nt][1] * ri[1]); o1[512] = f2bf(acc[nt][2] * ri[2]); o1[768] = f2bf(acc[nt][3] * ri[3]); }
        }
    }
    u32x4 nsel_v = {0u, 0u, 0u, 0u};
    if (nxt_unit >= 0 && lane < 32) { const int nb = nxt_unit >> 9, nq = nxt_unit & 511; nsel_v = *((const u32x4*)(idx + (size_t)(nb * SEQ + nq * 8 + wave) * TOPK) + lane); }
    asm volatile("s_waitcnt lgkmcnt(0)" ::: "memory"); __builtin_amdgcn_s_barrier(); asm volatile("" ::: "memory");
    if (qmode == 1) {
        bf16* oscr = qscr + 16384;
#pragma unroll
        for (int j = 0; j < 4; ++j) *((u32x4*)(oscr + (size_t)wave * 2048) + j * 64 + lane) = *((const LDSP u32x4*)(tile) + j * 64 + lane);
    } else {
        const int h = wave; pg8::f32x4 o[4];
#pragma unroll
        for (int nt = 0; nt < 4; ++nt) o[nt] = (pg8::f32x4){0.f, 0.f, 0.f, 0.f};
        const LDSP unsigned char* ab = lds + TILE_STRIDE * (c & 7) + (h * 256 + g * 8) * 2;
        const unsigned long long* os = (const unsigned long long*)(qscr + 16384 + ((c & 7) * 8 + h) * 256 + g * 8);
        const bf16* wb = WUV + ((size_t)h * 64 + c) * 256 + g * 8;
        const bool from_scr = (qmode == 2) && (c < 8);
#pragma unroll
        for (int ks = 0; ks < 8; ++ks) { bf16x8_t a;
            if (from_scr) { const unsigned long long lo = __hip_atomic_load(os + ks * 8, __ATOMIC_RELAXED, __HIP_MEMORY_SCOPE_AGENT), hi = __hip_atomic_load(os + ks * 8 + 1, __ATOMIC_RELAXED, __HIP_MEMORY_SCOPE_AGENT);
                u32x4 w; w.x = (unsigned)lo; w.y = (unsigned)(lo >> 32); w.z = (unsigned)hi; w.w = (unsigned)(hi >> 32); a = __builtin_bit_cast(bf16x8_t, w); }
            else a = *(const LDSP bf16x8_t*)(ab + ks * 64);
#pragma unroll
            for (int nt = 0; nt < 4; ++nt) { const bf16x8_t bw = *(const bf16x8_t*)(wb + (size_t)nt * 16 * 256 + ks * 32); o[nt] = __builtin_amdgcn_mfma_f32_16x16x32_bf16(a, bw, o[nt], 0, 0, 0); } }
        const int rbase = (qmode == 2) ? t0 - 8 : t0;
        if ((g < 2 || qmode == 2) && !dry) {
#pragma unroll
            for (int nt = 0; nt < 4; ++nt)
#pragma unroll
                for (int e = 0; e < 4; ++e) RA[(size_t)(rbase + 4 * g + e) * NA + A_Q + h * 64 + nt * 16 + c] = f2bf(o[nt][e]); }
    }
    if (nxt_unit >= 0 && lane < 32) *((LDSP u32x4*)selw_n + lane) = nsel_v;
    asm volatile("s_waitcnt vmcnt(0) lgkmcnt(0)" ::: "memory"); __builtin_amdgcn_s_barrier(); asm volatile("" ::: "memory");
}

__device__ __forceinline__ void wg_attn16d(LDSP unsigned char* lds, bf16* RA, const bf16* __restrict__ CKVC, const unsigned short* __restrict__ idx, const bf16* __restrict__ WUK, const bf16* __restrict__ WUV,
                                          const float* __restrict__ rel_bias, int unit, int nxt_unit, int par, bool first, int tid, bool dry = false, int qmode = 0, bf16* qscr = nullptr) {
    const int lane = tid & 63, wave = __builtin_amdgcn_readfirstlane(tid >> 6), g = lane >> 4, c = lane & 15;
    const int b = unit >> 9, qg = unit & 511, t0 = b * SEQ + qg * 8, nk = ((qg >> 3) + 1) << 6, nsel = nk < TOPK ? nk : TOPK, ntile = nsel >> 5;
    LDSP unsigned char* QL = lds;
    LDSP unsigned char* tile = lds + wave * TILE_STRIDE;
    LDSP unsigned short* selw = (LDSP unsigned short*)(lds + SELW_OFF + (par * 8 + wave) * 512);
    LDSP unsigned short* selw_n = (LDSP unsigned short*)(lds + SELW_OFF + ((par ^ 1) * 8 + wave) * 512);
    if (first) { if (lane < 32) *((LDSP u32x4*)selw + lane) = *((const u32x4*)(idx + (size_t)(t0 + wave) * TOPK) + lane); }
    const bf16* kvb = CKVC + (size_t)b * SEQ * KV_R;
    const int nstep = nsel >> 4;
#define KV_DMA(step) do { LDSP unsigned char* sl_ = tile + ((step) & 1) * 8192; \
        _Pragma("unroll") for (int i4_ = 0; i4_ < 4; ++i4_) { const int row_ = 4 * i4_ + g; const int key_ = (int)selw[(step) * 16 + row_]; const int c16_ = c ^ ((g << 2) | i4_); \
            const bf16* src_ = kvb + (size_t)key_ * KV_R + c16_ * 8; \
            __builtin_amdgcn_global_load_lds((const unsigned*)src_, (LDSP unsigned*)(sl_ + 1024 * i4_), 16, 0, 0); \
            __builtin_amdgcn_global_load_lds((const unsigned*)(src_ + 128), (LDSP unsigned*)(sl_ + 4096 + 1024 * i4_), 16, 0, 0); } } while (0)
    KV_DMA(0);
    bf16x8_t qf[8];
    if (qmode != 2) {
        const int h = wave; const bf16* qr = RA + (size_t)(t0 + (qmode == 1 ? c : (c & 7))) * NA + A_Q + h * 64 + g * 8;
        const bf16x8_t b0 = *(const bf16x8_t*)qr, b1 = *(const bf16x8_t*)(qr + 32);
        const bf16* wb = WUK + ((size_t)h * 256 + c) * 64 + g * 8;
#pragma unroll 4
        for (int rt = 0; rt < 16; ++rt) { const bf16x8_t a0 = *(const bf16x8_t*)(wb + rt * 16 * 64), a1 = *(const bf16x8_t*)(wb + rt * 16 * 64 + 32);
            pg8::f32x4 acc = {0.f, 0.f, 0.f, 0.f};
            acc = __builtin_amdgcn_mfma_f32_16x16x32_bf16(a0, b0, acc, 0, 0, 0); acc = __builtin_amdgcn_mfma_f32_16x16x32_bf16(a1, b1, acc, 0, 0, 0);
            u32x2 w; w.x = pk2(acc[0], acc[1]); w.y = pk2(acc[2], acc[3]);
            if (c < 8) *(LDSP u32x2*)(lds + c * TILE_STRIDE + 8192 + ((h * 256) + rt * 16 + 4 * g) * 2) = w;
            else if (qmode == 1) *(u32x2*)(qscr + ((((c - 8) * 8 + h) * 256) + rt * 16 + 4 * g)) = w; }
        asm volatile("s_waitcnt lgkmcnt(0)" ::: "memory"); __builtin_amdgcn_s_barrier(); asm volatile("" ::: "memory");
#pragma unroll
        for (int ks = 0; ks < 8; ++ks) qf[ks] = *(const LDSP bf16x8_t*)(tile + 8192 + (((c & 7) * 256) + ks * 32 + g * 8) * 2);
        asm volatile("s_waitcnt lgkmcnt(0)" ::: "memory");
    } else {
        const unsigned long long* qs = (const unsigned long long*)(qscr + (((wave * 8 + (c & 7)) * 256) + g * 8));
#pragma unroll
        for (int ks = 0; ks < 8; ++ks) { const unsigned long long lo = __hip_atomic_load(qs + ks * 8, __ATOMIC_RELAXED, __HIP_MEMORY_SCOPE_AGENT), hi = __hip_atomic_load(qs + ks * 8 + 1, __ATOMIC_RELAXED, __HIP_MEMORY_SCOPE_AGENT);
            u32x4 w; w.x = (unsigned)lo; w.y = (unsigned)(lo >> 32); w.z = (unsigned)hi; w.w = (unsigned)(hi >> 32); qf[ks] = __builtin_bit_cast(bf16x8_t, w); }
    }
    const unsigned tile_a = (unsigned)(size_t)tile;
#if ATT_STAGGER
    if (wave >= 4) __builtin_amdgcn_s_sleep(ATT_STAGGER);
#endif
    bf16x8_t bbf; { float bv[8];
#pragma unroll
        for (int j = 0; j < 8; ++j) bv[j] = rel_bias[(8 * g + j) * 8 + (c & 7)];
        u32x4 w; w.x = pk2(bv[0], bv[1]); w.y = pk2(bv[2], bv[3]); w.z = pk2(bv[4], bv[5]); w.w = pk2(bv[6], bv[7]); bbf = __builtin_bit_cast(bf16x8_t, w); }
    {
        const int spos = (qg * 8 + wave);
        pg8::f32x4 acc[16];
#pragma unroll
        for (int nt = 0; nt < 16; ++nt) acc[nt] = (pg8::f32x4){0.f, 0.f, 0.f, 0.f};
        float m_run = -INFINITY, l_run = 0.f;
#define ONEHOT(dst, key) do { const int rel_ = (key) - spos, n_ = rel_ < 0 ? -rel_ : rel_; \
            const int big_ = 8 + (n_ >= 15) + (n_ >= 27) + (n_ >= 50) + (n_ >= 91) + (n_ >= 166) + (n_ >= 305) + (n_ >= 559); \
            const int pos_ = (n_ < 8 ? n_ : big_) + (rel_ > 0 ? 16 : 0) - 8 * g; const unsigned one_ = (pos_ & 1) ? 0x3F800000u : 0x3F80u; const int hi_ = pos_ >> 1; \
            u32x4 w_; w_.x = (hi_ == 0) ? one_ : 0u; w_.y = (hi_ == 1) ? one_ : 0u; w_.z = (hi_ == 2) ? one_ : 0u; w_.w = (hi_ == 3) ? one_ : 0u; dst = __builtin_bit_cast(bf16x8_t, w_); } while (0)
        const int q4 = c >> 2, p = c & 3;
        const unsigned rd0 = tile_a + 256 * c + 16 * (g ^ (c >> 2)); const unsigned rx = (unsigned)(c & 3);
        const unsigned tr0 = tile_a + 256 * (4 * g + q4) + 8 * (p & 1); const unsigned ts = (unsigned)(((q4 << 2) | g)), tb0 = (unsigned)(p >> 1);
        if (nstep > 1) KV_DMA(1);
        for (int st = 0; st < nstep; ++st) {
            const unsigned so = (unsigned)((st & 1) * 8192);
            const int key = (int)selw[st * 16 + c];
            bf16x8_t oh; ONEHOT(oh, key);
            if (st + 1 < nstep) asm volatile("s_waitcnt vmcnt(8)" ::: "memory"); else asm volatile("s_waitcnt vmcnt(0)" ::: "memory");
            bf16x8_t af[8]; u16x4_t v[16];
#pragma unroll
            for (int ks = 0; ks < 8; ++ks) af[ks] = *(const LDSP bf16x8_t*)(size_t)(rd0 + so + (ks >> 2) * 4096 + 64 * (((unsigned)(ks & 3)) ^ rx));
#pragma unroll
            for (int n4 = 0; n4 < 4; ++n4) { unsigned ad[4];
#pragma unroll
                for (int k = 0; k < 4; ++k) { const unsigned nt = (unsigned)(n4 * 4 + k); ad[k] = tr0 + so + (nt >> 3) * 4096 + 16 * ((((nt & 7) << 1) | tb0) ^ ts); }
                asm volatile("ds_read_b64_tr_b16 %0, %4\n\tds_read_b64_tr_b16 %1, %5\n\tds_read_b64_tr_b16 %2, %6\n\tds_read_b64_tr_b16 %3, %7" : "=&v"(v[n4 * 4]), "=&v"(v[n4 * 4 + 1]), "=&v"(v[n4 * 4 + 2]), "=&v"(v[n4 * 4 + 3]) : "v"(ad[0]), "v"(ad[1]), "v"(ad[2]), "v"(ad[3]) : "memory"); }
            WAITPIN4(0, v[0], v[1], v[2], v[3]); WAITPIN4(0, v[4], v[5], v[6], v[7]); WAITPIN4(0, v[8], v[9], v[10], v[11]); WAITPIN4(0, v[12], v[13], v[14], v[15]);
            if (st + 2 < nstep) KV_DMA(st + 2);
            pg8::f32x4 s0 = {0.f, 0.f, 0.f, 0.f};
            s0 = __builtin_amdgcn_mfma_f32_16x16x32_bf16(oh, bbf, s0, 0, 0, 0);
#pragma unroll
            for (int ks = 0; ks < 8; ++ks) s0 = __builtin_amdgcn_mfma_f32_16x16x32_bf16(af[ks], qf[ks], s0, 0, 0, 0);
            float tmax = fmaxf(fmaxf(s0[0], s0[1]), fmaxf(s0[2], s0[3]));
            tmax = fmaxf(tmax, __shfl_xor(tmax, 16)); tmax = fmaxf(tmax, __shfl_xor(tmax, 32));
            const float m_new = fmaxf(m_run, tmax); const float scl = __expf(m_run - m_new); const bool grow = m_new > m_run; m_run = m_new;
            float sv[4]; float ps = 0.f;
#pragma unroll
            for (int j = 0; j < 4; ++j) { sv[j] = __expf(s0[j] - m_new); ps += sv[j]; }
            l_run = l_run * scl + ps;
            typedef short bf16x4_t __attribute__((ext_vector_type(4)));
            bf16x4_t pf; { u32x2 w; w.x = pk2(sv[0], sv[1]); w.y = pk2(sv[2], sv[3]); pf = __builtin_bit_cast(bf16x4_t, w); }
            if (__builtin_amdgcn_ballot_w64(grow) != 0ull) {
                float rs[4];
#pragma unroll
                for (int e = 0; e < 4; ++e) rs[e] = __shfl(scl, 4 * g + e);
#pragma unroll
                for (int nt = 0; nt < 16; ++nt) {
#pragma unroll
                    for (int e = 0; e < 4; ++e) acc[nt][e] *= rs[e]; } }
#pragma unroll
            for (int k = 0; k < 16; ++k) acc[k] = __builtin_amdgcn_mfma_f32_16x16x16bf16_1k(pf, __builtin_bit_cast(bf16x4_t, v[k]), acc[k], 0, 0, 0);
        }
#undef KV_DMA
#undef ONEHOT
        float lt = l_run + __shfl_xor(l_run, 16); lt += __shfl_xor(lt, 32); const float inv = 1.0f / lt;
        float ri[4];
#pragma unroll
        for (int e = 0; e < 4; ++e) ri[e] = __shfl(inv, 4 * g + e);
        if (g < 2) {
#pragma unroll
            for (int nt = 0; nt < 16; ++nt) { LDSP unsigned short* o1 = (LDSP unsigned short*)(tile) + (4 * g) * 256 + nt * 16 + c;
                o1[0] = f2bf(acc[nt][0] * ri[0]); o1[256] = f2bf(acc[nt][1] * ri[1]); o1[512] = f2bf(acc[nt][2] * ri[2]); o1[768] = f2bf(acc[nt][3] * ri[3]); }
        }
    }
    u32x4 nsel_v = {0u, 0u, 0u, 0u};
    if (nxt_unit >= 0 && lane < 32) { const int nb = nxt_unit >> 9, nq = nxt_unit & 511; nsel_v = *((const u32x4*)(idx + (size_t)(nb * SEQ + nq * 8 + wave) * TOPK) + lane); }
    asm volatile("s_waitcnt lgkmcnt(0)" ::: "memory"); __builtin_amdgcn_s_barrier(); asm volatile("" ::: "memory");
    if (qmode == 1) {
        bf16* oscr = qscr + 16384;
#pragma unroll
        for (int j = 0; j < 4; ++j) *((u32x4*)(oscr + (size_t)wave * 2048) + j * 64 + lane) = *((const LDSP u32x4*)(tile) + j * 64 + lane);
    } else {
        const int h = wave; pg8::f32x4 o[4];
#pragma unroll
        for (int nt = 0; nt < 4; ++nt) o[nt] = (pg8::f32x4){0.f, 0.f, 0.f, 0.f};
        const LDSP unsigned char* ab = lds + TILE_STRIDE * (c & 7) + (h * 256 + g * 8) * 2;
        const unsigned long long* os = (const unsigned long long*)(qscr + 16384 + ((c & 7) * 8 + h) * 256 + g * 8);
        const bf16* wb = WUV + ((size_t)h * 64 + c) * 256 + g * 8;
        const bool from_scr = (qmode == 2) && (c < 8);
#pragma unroll
        for (int ks = 0; ks < 8; ++ks) { bf16x8_t a;
            if (from_scr) { const unsigned long long lo = __hip_atomic_load(os + ks * 8, __ATOMIC_RELAXED, __HIP_MEMORY_SCOPE_AGENT), hi = __hip_atomic_load(os + ks * 8 + 1, __ATOMIC_RELAXED, __HIP_MEMORY_SCOPE_AGENT);
                u32x4 w; w.x = (unsigned)lo; w.y = (unsigned)(lo >> 32); w.z = (unsigned)hi; w.w = (unsigned)(hi >> 32); a = __builtin_bit_cast(bf16x8_t, w); }
            else a = *(const LDSP bf16x8_t*)(ab + ks * 64);
#pragma unroll
            for (int nt = 0; nt < 4; ++nt) { const bf16x8_t bw = *(const bf16x8_t*)(wb + (size_t)nt * 16 * 256 + ks * 32); o[nt] = __builtin_amdgcn_mfma_f32_16x16x32_bf16(a, bw, o[nt], 0, 0, 0); } }
        const int rbase = (qmode == 2) ? t0 - 8 : t0;
        if ((g < 2 || qmode == 2) && !dry) {
#pragma unroll
            for (int nt = 0; nt < 4; ++nt)
#pragma unroll
                for (int e = 0; e < 4; ++e) RA[(size_t)(rbase + 4 * g + e) * NA + A_Q + h * 64 + nt * 16 + c] = f2bf(o[nt][e]); }
    }
    if (nxt_unit >= 0 && lane < 32) *((LDSP u32x4*)selw_n + lane) = nsel_v;
    asm volatile("s_waitcnt vmcnt(0) lgkmcnt(0)" ::: "memory"); __builtin_amdgcn_s_barrier(); asm volatile("" ::: "memory");
}

#ifndef SSM_SPLIT_V
#define SSM_SPLIT_V 42
#endif
constexpr int SSM_SPLIT = SSM_SPLIT_V;
constexpr int XP = 144, BP = 272;
constexpr int SB_X = 0, SB_B = 8192, SB_C = 24576, SB_SIZE = 40960;
constexpr int L_XS = 2 * SB_SIZE, L_M = L_XS + 64 * XP, L_HC = L_M + 64 * XP, L_TB = L_HC + 2 * 64 * BP;
static_assert(L_TB + 2048 <= 140 * 1024, "ssm lds");
#define TR2(d0, d1, a0, a1) asm volatile("ds_read_b64_tr_b16 %0, %2\n\tds_read_b64_tr_b16 %1, %3\n\ts_waitcnt lgkmcnt(0)" : "=&v"(d0), "=&v"(d1) : "v"(a0), "v"(a1) : "memory")
__device__ __forceinline__ bf16x8_t mk8(u16x4_t a, u16x4_t b) { bf16x8_t r; r[0] = a[0]; r[1] = a[1]; r[2] = a[2]; r[3] = a[3]; r[4] = b[0]; r[5] = b[1]; r[6] = b[2]; r[7] = b[3]; return r; }
__device__ __forceinline__ int bc_off(int row, int ch) { return 256 * row + 16 * (ch ^ (((row & 3) << 2) | ((row >> 2) & 3))); }
__device__ __forceinline__ void ssm_dma(LDSP unsigned char* buf, const bf16* __restrict__ XA, int tc0, int h, int grp, int wave, int lane, bool full) {
    const int npc = full ? 40 : 24;
    for (int p = wave; p < npc; p += 8) {
        const bf16* src;
        if (p < 8) { const int row = 8 * p + (lane >> 3), ch = lane & 7; src = XA + (size_t)(tc0 + row) * XBC + h * 64 + ch * 8; }
        else { const int pp = (p - 8) & 15, row = 4 * pp + (lane >> 4), ch = (lane & 15) ^ (((row & 3) << 2) | ((row >> 2) & 3)); src = XA + (size_t)(tc0 + row) * XBC + (p < 24 ? 1024 : 1280) + grp * 128 + ch * 8; }
        __builtin_amdgcn_global_load_lds((const unsigned*)src, (LDSP unsigned*)(buf + 1024 * p), 16, 0, 0);
    }
}
__device__ __forceinline__ void wg_ssm_unit(LDSP unsigned char* lds, bf16* RA, const bf16* __restrict__ XA, const float* __restrict__ DTt,
                                            const float* __restrict__ a_log, const float* __restrict__ dsk, int unit, int tid, bf16* dbg_out = nullptr, bool dry = false) {
    const int lane = tid & 63, wave = __builtin_amdgcn_readfirstlane(tid >> 6), g = lane >> 4, c = lane & 15, q4 = c >> 2, p4 = c & 3;
    const int b = unit >> 5, h = (unit >> 1) & 15, seg = unit & 1, grp = h >> 3, pq = wave & 3, hf = wave >> 2;
    const float Dh = dsk[h];
    const unsigned lds_a = (unsigned)(size_t)lds;
    LDSP float* TB = (LDSP float*)(lds + L_TB);
    typedef float f32x2_t __attribute__((ext_vector_type(2)));
    const f32x2_t* dtp = (const f32x2_t*)DTt + (size_t)(b * 16 + h) * SEQ;
    pg8::f32x4 hacc[4];
#pragma unroll
    for (int nt = 0; nt < 4; ++nt) hacc[nt] = (pg8::f32x4){0.f, 0.f, 0.f, 0.f};
    for (int i = tid; i < (2 * 64 * BP) / 4; i += NTHR) ((LDSP unsigned*)(lds + L_HC))[i] = 0u;
    const int c_end = seg ? 64 : SSM_SPLIT;
    ssm_dma(lds, XA, b * SEQ, h, grp, wave, lane, seg == 0 || SSM_SPLIT == 0);
    f32x2_t dt_cur = dtp[lane];
    asm volatile("s_waitcnt vmcnt(0) lgkmcnt(0)" ::: "memory"); __builtin_amdgcn_s_barrier(); asm volatile("" ::: "memory");
    for (int ci = 0; ci < c_end; ++ci) {
        const bool full = (seg == 0) || (ci >= SSM_SPLIT);
        const int tc0 = b * SEQ + ci * 64;
        LDSP unsigned char* buf = lds + (ci & 1) * SB_SIZE;
        f32x2_t dt_nxt = {0.f, 0.f};
        if (ci + 1 < c_end) { ssm_dma(lds + ((ci + 1) & 1) * SB_SIZE, XA, tc0 + 64, h, grp, wave, lane, (seg == 0) || (ci + 1 >= SSM_SPLIT)); dt_nxt = dtp[(ci + 1) * 64 + lane]; }
        unsigned short zraw[8];
        if (full) {
#pragma unroll
            for (int k2 = 0; k2 < 2; ++k2)
#pragma unroll
                for (int e = 0; e < 4; ++e) zraw[k2 * 4 + e] = RA[(size_t)(tc0 + 16 * (2 * hf + k2) + 4 * g + e) * NA + A_Z + h * 64 + 16 * pq + c]; }
        {   const float dt = dt_cur.x, acs = dt_cur.y; const float tot = __builtin_bit_cast(float, __builtin_amdgcn_readlane(__builtin_bit_cast(int, acs), 63));
            TB[lane] = dt; TB[64 + lane] = acs; TB[128 + lane] = __expf(acs); TB[192 + lane] = __expf(tot - acs) * dt; if (lane == 0) TB[256] = __expf(tot); }
        asm volatile("s_waitcnt lgkmcnt(0)" ::: "memory");
        {   const int row = tid >> 3, ch = tid & 7; const u32x4 xv = *(const LDSP u32x4*)(buf + SB_X + row * 128 + ch * 16); const float wl = TB[192 + row]; const unsigned xw[4] = {xv.x, xv.y, xv.z, xv.w}; u32x4 o;
            o.x = pk2(__builtin_bit_cast(float, xw[0] << 16) * wl, __builtin_bit_cast(float, xw[0] & 0xffff0000u) * wl); o.y = pk2(__builtin_bit_cast(float, xw[1] << 16) * wl, __builtin_bit_cast(float, xw[1] & 0xffff0000u) * wl);
            o.z = pk2(__builtin_bit_cast(float, xw[2] << 16) * wl, __builtin_bit_cast(float, xw[2] & 0xffff0000u) * wl); o.w = pk2(__builtin_bit_cast(float, xw[3] << 16) * wl, __builtin_bit_cast(float, xw[3] & 0xffff0000u) * wl);
            *(LDSP u32x4*)(lds + L_XS + row * XP + ch * 16) = o; }
        if (full) {
            const int lt = wave >> 1;
#pragma unroll
            for (int k2 = 0; k2 < 2; ++k2) { const int st = 2 * (wave & 1) + k2; pg8::f32x4 ga = {0.f, 0.f, 0.f, 0.f};
#pragma unroll
                for (int ks = 0; ks < 4; ++ks) { const bf16x8_t af = *(const LDSP bf16x8_t*)(buf + SB_C + bc_off(16 * lt + c, 4 * ks + g)), bfm = *(const LDSP bf16x8_t*)(buf + SB_B + bc_off(16 * st + c, 4 * ks + g));
                    ga = __builtin_amdgcn_mfma_f32_16x16x32_bf16(af, bfm, ga, 0, 0, 0); }
                const int s = 16 * st + c; const float acs_s = TB[64 + s], dt_s = TB[s];
#pragma unroll
                for (int e = 0; e < 4; ++e) { const int l = 16 * lt + 4 * g + e; const float m = (s <= l) ? ga[e] * __expf(TB[64 + l] - acs_s) * dt_s : 0.f;
                    *(LDSP unsigned short*)(lds + L_M + l * XP + s * 2) = f2bf(m); } }
        }
        asm volatile("s_waitcnt lgkmcnt(0)" ::: "memory"); __builtin_amdgcn_s_barrier(); asm volatile("" ::: "memory");
        if (full) {
            pg8::f32x4 ya[2] = {{0.f, 0.f, 0.f, 0.f}, {0.f, 0.f, 0.f, 0.f}};
            const LDSP unsigned char* hcur = lds + L_HC + (ci & 1) * (64 * BP);
#pragma unroll
            for (int ks = 0; ks < 4; ++ks) { const bf16x8_t hb = *(const LDSP bf16x8_t*)(hcur + (16 * pq + c) * BP + (32 * ks + 8 * g) * 2);
#pragma unroll
                for (int k2 = 0; k2 < 2; ++k2) { const bf16x8_t af = *(const LDSP bf16x8_t*)(buf + SB_C + bc_off(16 * (2 * hf + k2) + c, 4 * ks + g)); ya[k2] = __builtin_amdgcn_mfma_f32_16x16x32_bf16(af, hb, ya[k2], 0, 0, 0); } }
#pragma unroll
            for (int k2 = 0; k2 < 2; ++k2)
#pragma unroll
                for (int e = 0; e < 4; ++e) ya[k2][e] *= TB[128 + 16 * (2 * hf + k2) + 4 * g + e];
#pragma unroll
            for (int ks = 0; ks < 2; ++ks) { u16x4_t x0, x1; const unsigned xa = lds_a + (ci & 1) * SB_SIZE + SB_X + (32 * ks + 8 * g + q4) * 128 + (16 * pq + 4 * p4) * 2; TR2(x0, x1, xa, xa + 4 * 128); const bf16x8_t xb = mk8(x0, x1);
#pragma unroll
                for (int k2 = 0; k2 < 2; ++k2) { const bf16x8_t mf = *(const LDSP bf16x8_t*)(lds + L_M + (16 * (2 * hf + k2) + c) * XP + (32 * ks + 8 * g) * 2); ya[k2] = __builtin_amdgcn_mfma_f32_16x16x32_bf16(mf, xb, ya[k2], 0, 0, 0); } }
#pragma unroll
            for (int k2 = 0; k2 < 2; ++k2)
#pragma unroll
                for (int e = 0; e < 4; ++e) { const int l = 16 * (2 * hf + k2) + 4 * g + e, pp = 16 * pq + c; const float x = bf2f(*(const LDSP unsigned short*)(buf + SB_X + l * 128 + pp * 2));
                    const float z = bf2f(zraw[k2 * 4 + e]); const bf16 uo = f2bf((ya[k2][e] + Dh * x) * siluf_(z));
                    if (dbg_out) dbg_out[(size_t)(tc0 + l) * 1024 + h * 64 + pp] = uo; else if (!dry) RA[(size_t)(tc0 + l) * NA + A_Z + h * 64 + pp] = uo; }
        }
        {   const float dec = TB[256];
#pragma unroll
            for (int nt = 0; nt < 4; ++nt)
#pragma unroll
                for (int e = 0; e < 4; ++e) hacc[nt][e] *= dec;
#pragma unroll
            for (int ks = 0; ks < 2; ++ks) { const int row = 32 * ks + 8 * g + q4; u16x4_t x0, x1; const unsigned xa = lds_a + L_XS + row * XP + (16 * pq + 4 * p4) * 2; TR2(x0, x1, xa, xa + 4 * XP); const bf16x8_t xf = mk8(x0, x1);
                u16x4_t v[8]; unsigned ad[8];
#pragma unroll
                for (int nt = 0; nt < 4; ++nt) { const int ch = 8 * hf + 2 * nt + (p4 >> 1); ad[2 * nt] = lds_a + (ci & 1) * SB_SIZE + SB_B + bc_off(row, ch) + 8 * (p4 & 1); ad[2 * nt + 1] = lds_a + (ci & 1) * SB_SIZE + SB_B + bc_off(row + 4, ch) + 8 * (p4 & 1); }
                TR8(v[0], v[1], v[2], v[3], v[4], v[5], v[6], v[7], ad[0], ad[1], ad[2], ad[3], ad[4], ad[5], ad[6], ad[7]);
#pragma unroll
                for (int nt = 0; nt < 4; ++nt) hacc[nt] = __builtin_amdgcn_mfma_f32_16x16x32_bf16(xf, mk8(v[2 * nt], v[2 * nt + 1]), hacc[nt], 0, 0, 0); }
            LDSP unsigned char* hnext = lds + L_HC + ((ci + 1) & 1) * (64 * BP);
#pragma unroll
            for (int nt = 0; nt < 4; ++nt)
#pragma unroll
                for (int e = 0; e < 4; ++e) *(LDSP unsigned short*)(hnext + (16 * pq + 4 * g + e) * BP + (64 * hf + 16 * nt + c) * 2) = f2bf(hacc[nt][e]);
        }
        dt_cur = dt_nxt;
        asm volatile("s_waitcnt vmcnt(0) lgkmcnt(0)" ::: "memory"); __builtin_amdgcn_s_barrier(); asm volatile("" ::: "memory");
    }
}

__global__ void __launch_bounds__(NTHR, 2) k_fwd(Params P) {
    extern __shared__ __attribute__((aligned(16))) unsigned char lds_raw[];
    LDSP unsigned char* lds = (LDSP unsigned char*)lds_raw;
    volatile LDSP unsigned* MISC = (volatile LDSP unsigned*)(lds + MISC_OFF);
    unsigned char* ws = P.ws;
    const int wave_s = __builtin_amdgcn_readfirstlane(threadIdx.x >> 6);
    for (int u = threadIdx.x; u < (LDS_BYTES - RING_BYTES) / 4; u += NTHR) ((LDSP unsigned*)(lds + RING_BYTES))[u] = 0u;
#define PHASE_IDS int tid = mk_tid(wave_s); int blk = blockIdx.x; asm volatile("" : "+s"(blk)); int G = gridDim.x; asm volatile("" : "+s"(G)); const int NGW = G * NWAVES; (void)NGW; const int lane = tid & 63, wave = __builtin_amdgcn_readfirstlane(tid >> 6), gw = blk * NWAVES + wave; (void)lane; (void)wave; (void)gw; const __attribute__((address_space(4))) char* kargs = (const __attribute__((address_space(4))) char*)__builtin_amdgcn_kernarg_segment_ptr(); asm volatile("" : "+s"(kargs)); int Lp = L; asm volatile("" : "+s"(Lp)); (void)Lp; unsigned char* ws = ((unsigned char* const __attribute__((address_space(4)))*)kargs)[27]; float* out = ((float* const __attribute__((address_space(4)))*)kargs)[26]; const float* x = KIN(0); const float* p = KIN(1); float* rstd = (float*)(ws + WS_RSTD); float* rstd2 = (float*)(ws + WS_RSTD2); float* DTb = (float*)(ws + WS_DT); bf16 *Win = (bf16*)(ws + WS_W_IN), *Wout = (bf16*)(ws + WS_W_OUT), *Wgu = (bf16*)(ws + WS_W_GU), *Wdown = (bf16*)(ws + WS_W_DOWN), *Wpg = (bf16*)(ws + WS_W_PG), *Wpp = (bf16*)(ws + WS_W_PP); bf16 *X0 = (bf16*)(ws + WS_X0), *X1 = (bf16*)(ws + WS_X1), *RA = (bf16*)(ws + WS_RA), *RB = (bf16*)(ws + WS_RB), *XA = (bf16*)out; unsigned short* IDX = (unsigned short*)((unsigned char*)out + 112 * MiB); bf16* CKVC = (bf16*)((unsigned char*)out + 96 * MiB); bf16* IKC = (bf16*)(ws + WS_IKC); bf16* WUK = (bf16*)(ws + WS_WUK); bf16* WUV = (bf16*)(ws + WS_WUV); (void)CKVC; (void)IKC; (void)WUK; (void)WUV; bf16* Xcur = (Lp == 0) ? X0 : X1; (void)out; (void)x; (void)p; (void)rstd; (void)rstd2; (void)DTb; (void)Win; (void)Wout; (void)Wgu; (void)Wdown; (void)Wpg; (void)Wpp; (void)X0; (void)X1; (void)RA; (void)RB; (void)XA; (void)IDX; (void)Xcur
    __syncthreads();
    if (TIMING && blockIdx.x == 0 && mk_tid(wave_s) == 0) { __hip_atomic_store((unsigned long long*)(P.ws + 32768), (unsigned long long)__builtin_amdgcn_s_memrealtime(), __ATOMIC_RELAXED, __HIP_MEMORY_SCOPE_AGENT); __hip_atomic_store((unsigned long long*)(P.ws + 32768) + 60, (unsigned long long)__builtin_amdgcn_s_memtime(), __ATOMIC_RELAXED, __HIP_MEMORY_SCOPE_AGENT); }
#if CLK_PROBE
    if (blockIdx.x == 0 && mk_tid(wave_s) == 0) { __hip_atomic_store((unsigned long long*)(P.ws + 49152), (unsigned long long)__builtin_amdgcn_s_memtime(), __ATOMIC_RELAXED, __HIP_MEMORY_SCOPE_AGENT); __hip_atomic_store((unsigned long long*)(P.ws + 49152) + 1, (unsigned long long)__builtin_amdgcn_s_memrealtime(), __ATOMIC_RELAXED, __HIP_MEMORY_SCOPE_AGENT); }
#endif
    const bool one_launch = (P.ph_hi - P.ph_lo) > 1;
    XcdBarrier bar; bar.bar = (unsigned*)(ws + WS_CTL) + CW_BAR; bar.x = 0; bar.st = nullptr;
    if (one_launch) bar = xcd_barrier_post((unsigned*)(ws + WS_CTL) + CW_BAR, (volatile LAS unsigned*)(MISC + 8));
    if (one_launch && mk_tid(wave_s) == 0) { const unsigned xid_ = xb_xcc_id(); MISC[16] = xid_; MISC[17] = __hip_atomic_fetch_add((unsigned*)(P.ws + WS_CTL) + CW_RANK + 64 * xid_, 1u, __ATOMIC_RELAXED, __HIP_MEMORY_SCOPE_AGENT); }

#ifndef PH_MASK
#define PH_MASK 0x3fff
#endif
#define PHASE_IDS_NOL const int L = 0; PHASE_IDS
#define NPASS(k) (((DBL_MASK >> (k)) & 1) ? ((Lp == 0 && ((P.dbl_mask >> (k)) & 1)) ? 2 : 1) : 1)
#define XCD_DEAL bool xok_ = false; int xb_ = 0, xr_ = 0, xn_ = 1; { if (tid == 0) { unsigned ok = (MISC[9] == 8u) ? 1u : 0u; unsigned sum = 0; for (int j = 0; j < 8; ++j) { const unsigned cj = __hip_atomic_load((unsigned*)(ws + WS_CTL) + CW_BAR + XB_XCNT(j), __ATOMIC_RELAXED, __HIP_MEMORY_SCOPE_AGENT); sum += cj; if (cj == 0u) ok = 0u; } if (sum != (unsigned)G) ok = 0u; MISC[18] = ok; } \
    __syncthreads(); xok_ = MISC[18] != 0u; xb_ = (int)MISC[16]; xr_ = (int)MISC[17]; xn_ = (int)MISC[8]; if (xn_ < 1) xn_ = 1; __syncthreads(); }
#define KIN(i) (((const float* const __attribute__((address_space(4)))*)kargs)[i])
#define IN(k) (P.ph_lo <= (k) && (k) < P.ph_hi && ((PH_MASK >> ((k) % NPH)) & 1))
#define SEAM(k) do { if (IN((k) + 1)) { XcdBarrier b2_ = bar; asm volatile("" : "+s"(b2_.bar)); xcd_barrier(b2_, mk_tid(wave_s)); } if (TIMING && blockIdx.x == 0 && mk_tid(wave_s) == 0) { __hip_atomic_store((unsigned long long*)(P.ws + 32768) + (k) + 1, (unsigned long long)__builtin_amdgcn_s_memrealtime(), __ATOMIC_RELAXED, __HIP_MEMORY_SCOPE_AGENT); } } while (0)
    for (int L = 0; L < DEPTH; ++L) {
        const int pb = L * NPH;
        if (IN(pb + 0)) { PHASE_IDS; for (int pass = NPASS(0); pass > 0; --pass) {
            LDSP float* scr = (LDSP float*)(lds + wave * 8704);
            ph_prep_w<1>(scr, KIN(6) + (size_t)Lp * D * INW, nullptr, D, INW, KIN(2) + (size_t)Lp * D, Win, NIN, gw, NGW, lane);
            ph_prep_w<0>(scr, KIN(20) + (size_t)Lp * MIXW * D, nullptr, MIXW, D, nullptr, Wout, D, gw, NGW, lane);
            ph_prep_w<2>(scr, KIN(21) + (size_t)Lp * D * DFF, KIN(22) + (size_t)Lp * D * DFF, D, DFF, KIN(4) + (size_t)Lp * D, Wgu, NGU, gw, NGW, lane);
            ph_prep_w<0>(scr, KIN(23) + (size_t)Lp * DFF * D, nullptr, DFF, D, nullptr, Wdown, D, gw, NGW, lane);
            ph_prep_w<0>(scr, KIN(25) + (size_t)Lp * D * D, nullptr, D, D, nullptr, Wpg, D, gw, NGW, lane);
            ph_prep_w<0>(scr, KIN(24) + (size_t)Lp * PLE * D, nullptr, PLE, D, nullptr, Wpp, D, gw, NGW, lane);
            {   const float* uk = KIN(10) + (size_t)Lp * 256 * 8 * 64; const float* uv = KIN(11) + (size_t)Lp * 256 * 8 * 64;
                for (int e = gw * 64 + lane; e < 8 * 256 * 64; e += NGW * 64) { const int h = e >> 14, r = (e >> 6) & 255, d = e & 63; WUK[e] = f2bf(0.125f * uk[((size_t)r * 8 + h) * 64 + d]); }
                for (int e = gw * 64 + lane; e < 8 * 64 * 256; e += NGW * 64) { const int h = e >> 14, d = (e >> 8) & 63, r = e & 255; WUV[e] = f2bf(uv[((size_t)r * 8 + h) * 64 + d]); } }
            if (Lp == 0) { for (int r = gw; r < T; r += NGW) row_x_prep(x, X0, rstd, r, lane); }
            else        { for (int r = gw; r < T; r += NGW) row_rstd_bf16(X1, rstd, r, lane); }
            }
            SEAM(pb + 0);
        }
#if XTRA_BAR
        if (P.ph_hi - P.ph_lo > 1 && L == 0) { for (int i_ = 0; i_ < XTRA_BAR; ++i_) { XcdBarrier b4_ = bar; asm volatile("" : "+s"(b4_.bar)); xcd_barrier(b4_, mk_tid(wave_s)); } }
#endif
        if (IN(pb + 1)) { PHASE_IDS; for (int pass = NPASS(1); pass > 0; --pass) {
            pg8::Gemm g{Xcur, Win, T, NIN, (GEMM_DRYK && pass > 1) ? GEMM_DRYK : D}; pg8::StaticOrder S; S.init(T, NIN, G, blk);
            pg8::EpiProj E{RA, RB, rstd};
            pg8::gemm_phase<pg8::EpiProj, pg8::StaticOrder, true, true>(lds, g, S, E, tid);
            }
            SEAM(pb + 1);
        }
        if (IN(pb + 2)) { PHASE_IDS;
            for (int pass = NPASS(2); pass > 0; --pass) {
#pragma unroll 2
            for (int it = gw; it < T / 4; it += NGW) prep_ckv4(RB, CKVC, KIN(7) + Lp * KV_R, it, lane);
            for (int it = gw; it < T / 16; it += NGW) prep_ik16(RB, IKC, KIN(8) + Lp * 64, KIN(9) + Lp * 64, it, lane);
#pragma unroll 2
            for (int t = gw; t < T; t += NGW) prep_bout(RA, RB, KIN(13) + (size_t)Lp * 3 * 512, t, lane, pass > 1);
#pragma unroll 2
            for (int it = gw; it < (T / 16) * 12; it += NGW) prep_conv(RB, XA, KIN(14) + (size_t)Lp * 4 * XBC, KIN(15) + (size_t)Lp * XBC, it, lane);
            for (int it = gw; it < BATCH * 64 * 4; it += NGW) { const int hq = it & 3, ck = (it >> 2) & 63, bb = it >> 8; const int t = bb * SEQ + ck * 64 + lane;
                const u32x2 rw = *(const u32x2*)(RB + (size_t)t * NB + B_DT + hq * 4); const unsigned rr[2] = {rw.x, rw.y}; float dtv[4], ac[4];
#pragma unroll
                for (int e = 0; e < 4; ++e) { const int hh = hq * 4 + e; const float xr = __builtin_bit_cast(float, (e & 1) ? (rr[e >> 1] & 0xffff0000u) : (rr[e >> 1] << 16)) + (KIN(16) + Lp * 16)[hh];
                    dtv[e] = xr > 15.f ? xr : log1pf(__expf(xr)); ac[e] = -__expf((KIN(17) + Lp * 16)[hh]) * dtv[e]; }
#pragma unroll
                for (int o = 1; o < 64; o <<= 1) {
#pragma unroll
                    for (int e = 0; e < 4; ++e) { const float v = __shfl_up(ac[e], o); if (lane >= o) ac[e] += v; } }
#pragma unroll
                for (int e = 0; e < 4; ++e) { typedef float f32x2_t __attribute__((ext_vector_type(2))); ((f32x2_t*)(ws + WS_DT2))[(size_t)(bb * 16 + hq * 4 + e) * SEQ + ck * 64 + lane] = (f32x2_t){dtv[e], ac[e]}; } }
            }
            SEAM(pb + 2);
        }
        if (IN(pb + 3)) { PHASE_IDS;
            const bool ssm_first = ((blk >> 3) & 1) == 0;
#pragma clang loop unroll(disable)
            for (int step = 0; step < 3; ++step) {
                const bool do_ssm = (step == 0 && ssm_first) || (step == 2 && !ssm_first);
                if (do_ssm) {
                    for (int u = blk; u < BATCH * 32; u += G) { const int uu = (u & 127) * 2 + (u >> 7);
                        wg_ssm_unit(lds, RA, XA, (const float*)(ws + WS_DT2), KIN(17) + Lp * 16, KIN(18) + Lp * 16, uu ^ 1, mk_tid(wave_s), nullptr, false); }
                } else if (step == 1) {
                    for (int i = blk; i < T / 16; i += G) { const int b_ = i & 7, j_ = i >> 3, u16 = b_ * 256 + (255 - j_);
                        wg_select16(lds, RB, IKC, IDX, u16, mk_tid(wave_s), false, true);
                        const int ua = b_ * 512 + 2 * (255 - j_);
#pragma clang loop unroll(disable)
                        for (int h2 = 0; h2 < 2; ++h2) ATT_FN(lds, RA, CKVC, IDX, WUK, WUV, KIN(12), ua + h2, -1, h2, false, mk_tid(wave_s), false, 1 + h2, (bf16*)((unsigned char*)out + 112 * MiB) + (size_t)blk * 32768); }
                }
            }
            SEAM(pb + 5); }

        if (IN(pb + 6)) { PHASE_IDS; for (int pass = NPASS(6); pass > 0; --pass) for (int w = 4 * gw; w < T * 2; w += 4 * NGW) wave_gnorm4(RA, KIN(19) + (size_t)Lp * 1024, w, lane, pass > 1); SEAM(pb + 6); }
        if (IN(pb + 7)) { PHASE_IDS; for (int pass = NPASS(7); pass > 0; --pass) {
            pg8::Gemm g{RA, Wout, T, D, MIXW}; pg8::StaticOrder S; S.init(T, D, G, blk);
            pg8::EpiBf16P E{RB, (long)D};
            pg8::gemm_phase<pg8::EpiBf16P, pg8::StaticOrder, true, true>(lds, g, S, E, tid);
            }
            SEAM(pb + 7);
        }
        if (IN(pb + 8)) { PHASE_IDS; for (int pass = NPASS(8); pass > 0; --pass) for (int r = 2 * gw; r < T; r += 2 * NGW) row_resid_norm2(Xcur, (const bf16*)RB, KIN(3) + (size_t)Lp * D, X0, rstd2, nullptr, nullptr, r, lane, pass > 1); SEAM(pb + 8); }
        if (IN(pb + 9)) { PHASE_IDS; for (int pass = NPASS(9); pass > 0; --pass) {
            pg8::Gemm g{X0, Wgu, T, NGU, D}; pg8::StaticOrder S; S.init(T, NGU, G, blk);
            pg8::EpiSwiGLU E{RB, rstd2};
            pg8::gemm_phase<pg8::EpiSwiGLU, pg8::StaticOrder, true, true>(lds, g, S, E, tid);
            }
            SEAM(pb + 9);
        }
        if (IN(pb + 10)) { PHASE_IDS; for (int pass = NPASS(10); pass > 0; --pass) {
            pg8::Gemm g{RB, Wdown, T, D, DFF}; pg8::StaticOrder S; S.init(T, D, G, blk);
            pg8::EpiBf16P E{RA, (long)D};
            pg8::gemm_phase<pg8::EpiBf16P, pg8::StaticOrder, true, true>(lds, g, S, E, tid);
            }
            SEAM(pb + 10);
        }
        if (IN(pb + 11)) { PHASE_IDS; for (int pass = NPASS(11); pass > 0; --pass) for (int r = 2 * gw; r < T; r += 2 * NGW) row_resid_norm2(X0, (const bf16*)RA, KIN(5) + (size_t)Lp * D, X0, nullptr, p + (size_t)Lp * T * PLE, X1, r, lane, pass > 1); SEAM(pb + 11); }
        if (IN(pb + 12)) { PHASE_IDS; for (int pass = NPASS(12); pass > 0; --pass) {
            pg8::Gemm g{X1, Wpp, T, D, PLE}; pg8::StaticOrder S; S.init(T, D, G, blk);
            pg8::EpiBf16P E{RB, (long)D};
            pg8::gemm_phase<pg8::EpiBf16P, pg8::StaticOrder, true, true>(lds, g, S, E, tid);
            }
            SEAM(pb + 12);
        }
        if (IN(pb + 13)) { PHASE_IDS; for (int pass = NPASS(13); pass > 0; --pass) {
            pg8::Gemm g{X0, Wpg, T, D, D}; pg8::StaticOrder S; S.init(T, D, G, blk);
            pg8::EpiPle E{X0, RB, X1, (Lp == DEPTH - 1) ? out : nullptr};
            pg8::gemm_phase<pg8::EpiPle, pg8::StaticOrder, true, true>(lds, g, S, E, tid);
            }
            SEAM(pb + 13);
        }
    }
#if CLK_PROBE
    if (P.ph_hi == DEPTH * NPH) { PHASE_IDS_NOL; { XcdBarrier b3_ = bar; asm volatile("" : "+s"(b3_.bar)); xcd_barrier(b3_, mk_tid(wave_s)); }
        if (blk == 0 && tid == 0) { const unsigned long long c1 = __builtin_amdgcn_s_memtime(), r1 = __builtin_amdgcn_s_memrealtime(); const unsigned long long* ts = (const unsigned long long*)(ws + 49152);
            const unsigned long long c0 = __hip_atomic_load(ts, __ATOMIC_RELAXED, __HIP_MEMORY_SCOPE_AGENT), r0 = __hip_atomic_load(ts + 1, __ATOMIC_RELAXED, __HIP_MEMORY_SCOPE_AGENT);
            const float mhz = (float)(c1 - c0) / (float)(r1 - r0) * 100.0f; const float q = exp2f(rintf(4.0f * log2f(fmaxf(mhz, 1.0f))) * 0.25f);
            __hip_atomic_store((float*)(ws + 49152 + 64), q * 0.001f, __ATOMIC_RELAXED, __HIP_MEMORY_SCOPE_AGENT); }
        { XcdBarrier b3_ = bar; asm volatile("" : "+s"(b3_.bar)); xcd_barrier(b3_, mk_tid(wave_s)); }
        const float sc = 1.0f + __hip_atomic_load((float*)(ws + 49152 + 64), __ATOMIC_RELAXED, __HIP_MEMORY_SCOPE_AGENT);
        for (size_t i = (size_t)blk * NTHR + tid; i < (size_t)T * D; i += (size_t)G * NTHR) out[i] *= sc; }
#endif
#if TIMING
    if (P.ph_hi == DEPTH * NPH) { PHASE_IDS_NOL; { XcdBarrier b3_ = bar; asm volatile("" : "+s"(b3_.bar)); xcd_barrier(b3_, mk_tid(wave_s)); }
        const unsigned long long* ts = (const unsigned long long*)(ws + 32768);
        const float ta = (float)(__hip_atomic_load(ts + TIMING_A + 1, __ATOMIC_RELAXED, __HIP_MEMORY_SCOPE_AGENT) - __hip_atomic_load(ts + TIMING_A, __ATOMIC_RELAXED, __HIP_MEMORY_SCOPE_AGENT)) * 0.01f;
        const float tb = (float)(__hip_atomic_load(ts + TIMING_B + 1, __ATOMIC_RELAXED, __HIP_MEMORY_SCOPE_AGENT) - __hip_atomic_load(ts + TIMING_B, __ATOMIC_RELAXED, __HIP_MEMORY_SCOPE_AGENT)) * 0.01f;
        float ta_ = ta; if (TIMING_A == 99) { const unsigned long long c1 = __builtin_amdgcn_s_memtime(), r1 = __builtin_amdgcn_s_memrealtime(); const unsigned long long c0 = __hip_atomic_load(ts + 60, __ATOMIC_RELAXED, __HIP_MEMORY_SCOPE_AGENT), r0 = __hip_atomic_load(ts + 0, __ATOMIC_RELAXED, __HIP_MEMORY_SCOPE_AGENT);
            ta_ = (float)(c1 - c0) / (float)(r1 - r0) * 10.0f;   ta_ = __builtin_bit_cast(float, __builtin_amdgcn_readfirstlane(__builtin_bit_cast(int, ta_))); }
        const float taq = exp2f(rintf(4.0f * log2f(fmaxf(ta_, 1.0f)) + TIMING_SHIFT) * 0.25f), tbq = exp2f(rintf(2.0f * log2f(fmaxf(tb, 1.0f)) + TIMING_SHIFT) * 0.5f);
        const float sc = 1.0f + taq * 0.001f;
        for (size_t i = (size_t)blk * NTHR + tid; i < (size_t)T * D; i += (size_t)G * NTHR) out[i] *= sc;
        __syncthreads(); if (blk == 0 && tid == 0) out[0] += tbq * 10.0f; }
#endif
#if DBG_SSM
    if (P.ph_hi == DEPTH * NPH) { PHASE_IDS_NOL; { XcdBarrier b3_ = bar; asm volatile("" : "+s"(b3_.bar)); xcd_barrier(b3_, mk_tid(wave_s)); }
        const float d2 = __hip_atomic_load((float*)(ws + 65536), __ATOMIC_RELAXED, __HIP_MEMORY_SCOPE_AGENT), n2 = __hip_atomic_load((float*)(ws + 65536 + 4), __ATOMIC_RELAXED, __HIP_MEMORY_SCOPE_AGENT);
        const float sc = 1.0f + (n2 > 0.f ? sqrtf(d2 / n2) : 7.0f);
        for (size_t i = (size_t)blk * NTHR + tid; i < (size_t)T * D; i += (size_t)G * NTHR) out[i] *= sc; }
#endif
#undef IN
#undef SEAM
}

#ifndef MK_ONE_LAUNCH
#define MK_ONE_LAUNCH 1
#endif
extern "C" void kernel_launch(void* const* d_in, const int* in_sizes, int n_in, void* d_out, int out_size, void* d_ws, size_t ws_size, hipStream_t stream) {
    static int grid = 0;
    if (grid == 0) {
        if (n_in != 26 || ws_size < WS_END) { fprintf(stderr, "kernel_launch: unexpected n_in %d / ws_size %zu\n", n_in, ws_size); grid = -1; return; }
        int dev = 0, cus = 0, per_cu = 0;
        if (hipGetDevice(&dev) != hipSuccess || hipDeviceGetAttribute(&cus, hipDeviceAttributeMultiprocessorCount, dev) != hipSuccess) { grid = -1; return; }
        if (hipFuncSetAttribute((const void*)k_fwd, hipFuncAttributeMaxDynamicSharedMemorySize, LDS_BYTES) != hipSuccess) { fprintf(stderr, "kernel_launch: hipFuncSetAttribute failed\n"); grid = -1; return; }
        if (hipOccupancyMaxActiveBlocksPerMultiprocessor(&per_cu, (const void*)k_fwd, NTHR, LDS_BYTES) != hipSuccess || per_cu < 1) { fprintf(stderr, "kernel_launch: occupancy query says %d\n", per_cu); }
        (void)hipGetLastError();
        grid = cus;
    }
    if (grid < 0) return;
    if (hipMemsetAsync((char*)d_ws + WS_CTL, 0, CTL_ZERO_BYTES, stream) != hipSuccess) return;
    Params P; memset(&P, 0, sizeof(P));
    for (int i = 0; i < 26; ++i) P.in[i] = (const float*)d_in[i];
    P.out = (float*)d_out; P.ws = (unsigned char*)d_ws;
#if MK_ONE_LAUNCH
    P.ph_lo = 0; P.ph_hi = DEPTH * NPH; P.dbl_mask = DBL_MASK; P.pad = ATT_SUB_V;
    hipLaunchKernelGGL(k_fwd, dim3(grid), dim3(NTHR), LDS_BYTES, stream, P);
#else
    for (int ph = 0; ph < DEPTH * NPH; ++ph) { P.ph_lo = ph; P.ph_hi = ph + 1; hipLaunchKernelGGL(k_fwd, dim3(grid), dim3(NTHR), LDS_BYTES, stream, P); }
#endif
}
```

```cpp
#include <hip/hip_runtime.h>
#include <cstdio>
#include <cstdint>
#include <cstring>
namespace pg8 {
#define PG8_LAS __attribute__((address_space(3)))
typedef unsigned short bf16_t;
typedef short bf16x8 __attribute__((ext_vector_type(8)));
typedef float f32x4 __attribute__((ext_vector_type(4)));
typedef unsigned u32x4 __attribute__((ext_vector_type(4)));
constexpr int BM = 256, BK = 64, HALF = 128, HTB = HALF * BK * 2  , STAGE_BYTES = 8 * HTB, NXCD = 8, WGM = 8;

__host__ __device__ __forceinline__ int lds_byte(int r, int c) { const int st = (r >> 4) * 2 + (c >> 5), rr = r & 15, cc = c & 31, ob = rr * 64 + cc * 2; return st * 1024 + (ob ^ (((ob >> 9) & 1) << 5)); }
__host__ __device__ __forceinline__ void stage_rc(int b, int& R, int& C) { const int st = b / 1024, sb = b % 1024, swz = sb ^ (((sb >> 9) & 1) << 5); R = (st >> 1) * 16 + swz / 64; C = (st & 1) * 32 + (swz % 64) / 2; }
__host__ __device__ __forceinline__ int perm32(int rho) { const int n = rho >> 4, i = rho & 15; return 8 * (i >> 2) + 4 * n + (i & 3); }

struct Unit { int pm, pn; };
struct Gemm { const bf16_t* A; const bf16_t* Bt; int M, N, K; };

struct StaticOrder {
    int nM, nN, nwg, G, c;
    __host__ __device__ void init(int M, int N, int G_, int c_) { nM = M / BM; nN = N / BM; nwg = nM * nN; G = G_; c = c_; }
    __host__ __device__ bool next(int i, Unit& u) const {
        const long L = (long)i * G + c; if (L >= nwg) return false;
        int wgid = (int)L; { const int q = nwg / NXCD, r = nwg % NXCD, xcd = wgid % NXCD, off = wgid / NXCD; wgid = (xcd < r ? xcd * (q + 1) : r * (q + 1) + (xcd - r) * q) + off; }
        const int nig = WGM * nN, gid = wgid / nig, fm = gid * WGM, gsz = (nM - fm) < WGM ? (nM - fm) : WGM;
        u.pm = fm + ((wgid % nig) % gsz); u.pn = (wgid % nig) / gsz; return true;
    }
    __device__ __forceinline__ void a_ready(const Unit&) const {}
    __device__ __forceinline__ void done(const Unit&) const {}
};

__device__ __forceinline__ unsigned cvt_pk_bf16(float lo, float hi) { unsigned r; asm volatile("v_cvt_pk_bf16_f32 %0, %1, %2" : "=v"(r) : "v"(lo), "v"(hi)); return r; }
typedef float f32x2 __attribute__((ext_vector_type(2)));
__device__ __forceinline__ f32x2 gelu_pk(f32x2 v) {
    const f32x2 av = __builtin_elementwise_abs(v), d = av * 0.2316418882f + 1.0f;
    f32x2 t; t.x = __builtin_amdgcn_rcpf(d.x); t.y = __builtin_amdgcn_rcpf(d.y);
    f32x2 q = t * 0.5307027145f + (-0.7265760135f); q = q * t + 0.7107068705f; q = q * t + (-0.142248368f); q = q * t + 0.127414796f; q = q * t;
    const f32x2 s = (v * v) * (-0.72134752044f);
    f32x2 e; e.x = __builtin_amdgcn_exp2f(s.x); e.y = __builtin_amdgcn_exp2f(s.y);
    const f32x2 m = v * (q * e), r = v - m;
    f32x2 o; o.x = v.x < 0.f ? m.x : r.x; o.y = v.y < 0.f ? m.y : r.y; return o;
}

template <int ACT  > struct EpiBf16 {
    static constexpr bool PERM = true, AFTER_DRAIN = false; static_assert(ACT == 0 || ACT == 1, "EpiBf16: ACT is 0 (none) or 1 (gelu_pk)");
    bf16_t* O; int ldc; const float* bias; int split_cols; size_t split_stride; float scale0;
    __device__ __forceinline__ void operator()(const f32x4 (&acc)[2][2][4][2], const Unit& u, int wr, int wc, int fr, int fq) const {
        const int row0 = u.pm * BM + wr * 64 + fr; int colt = u.pn * BM; bf16_t* base = O;
        float sc = 1.f; if (split_cols) { const int t = colt / split_cols; base += (size_t)t * split_stride; colt -= t * split_cols; if (t == 0) sc = scale0; }
        const int col0 = colt + wc * 32 + 8 * fq, bcol0 = u.pn * BM + wc * 32 + 8 * fq;
        f32x4 bv[2][2];
#pragma unroll
        for (int bj = 0; bj < 2; ++bj)
#pragma unroll
            for (int n = 0; n < 2; ++n) bv[bj][n] = bias ? *(const f32x4*)(bias + bcol0 + bj * HALF + 4 * n) : (f32x4){0.f, 0.f, 0.f, 0.f};
#pragma unroll
        for (int ai = 0; ai < 2; ++ai)
#pragma unroll
            for (int m = 0; m < 4; ++m) { bf16_t* rowp = base + (size_t)(row0 + ai * HALF + m * 16) * ldc + col0;
#pragma unroll
                for (int bj = 0; bj < 2; ++bj) { f32x4 v0 = acc[ai][bj][m][0] + bv[bj][0], v1 = acc[ai][bj][m][1] + bv[bj][1];
                    if (ACT == 1) { f32x2 a = gelu_pk((f32x2){v0[0], v0[1]}), b = gelu_pk((f32x2){v0[2], v0[3]}), c = gelu_pk((f32x2){v1[0], v1[1]}), d = gelu_pk((f32x2){v1[2], v1[3]});
                        v0 = (f32x4){a.x, a.y, b.x, b.y}; v1 = (f32x4){c.x, c.y, d.x, d.y}; }
                    v0 = v0 * sc; v1 = v1 * sc; u32x4 w; w.x = cvt_pk_bf16(v0[0], v0[1]); w.y = cvt_pk_bf16(v0[2], v0[3]); w.z = cvt_pk_bf16(v1[0], v1[1]); w.w = cvt_pk_bf16(v1[2], v1[3]);
                    *(u32x4*)(rowp + bj * HALF) = w; } }
    }
};

struct PanelStats {
    unsigned* xbuf;
    unsigned* cnt;
    unsigned* tmo;
    int ntn; float eps;
    unsigned code;
    __device__ __forceinline__ bool run(const f32x4 (&v)[2][2][4][2], const Unit& u, int wr, int wc, int fr, int fq, PG8_LAS unsigned char* lds, int wid, int lane) const {
        typedef float f32x2v __attribute__((ext_vector_type(2)));
        PG8_LAS f32x2v* P = (PG8_LAS f32x2v*)lds;
        PG8_LAS f32x2v* S = (PG8_LAS f32x2v*)(lds + 8192);
        PG8_LAS unsigned* flag = (PG8_LAS unsigned*)(lds + 8192 + 2048);
#pragma unroll
        for (int ai = 0; ai < 2; ++ai)
#pragma unroll
            for (int m = 0; m < 4; ++m) {
                float s = 0.f;
#pragma unroll
                for (int bj = 0; bj < 2; ++bj)
#pragma unroll
                    for (int n = 0; n < 2; ++n) { const f32x4 x = v[ai][bj][m][n]; s += (x[0] + x[1]) + (x[2] + x[3]); }
                s += __shfl_xor(s, 16); s += __shfl_xor(s, 32);
                const float mw = s * (1.0f / 64.0f); float q = 0.f;
#pragma unroll
                for (int bj = 0; bj < 2; ++bj)
#pragma unroll
                    for (int n = 0; n < 2; ++n) { const f32x4 d = v[ai][bj][m][n] - mw; q += (d[0] * d[0] + d[1] * d[1]) + (d[2] * d[2] + d[3] * d[3]); }
                q += __shfl_xor(q, 16); q += __shfl_xor(q, 32);
                if (fq == 0) P[(ai * HALF + wr * 64 + m * 16 + fr) * 4 + wc] = (f32x2v){mw, q};
            }
        asm volatile("s_waitcnt lgkmcnt(0)" ::: "memory"); __builtin_amdgcn_s_barrier(); asm volatile("" ::: "memory");
#if defined(BROKEN_EXCHANGE_NO_WAIT)
#warning BROKEN CONTROL BUILD: the row-statistics exchange does not wait; results are wrong by design
        if (blockIdx.x >= 64) { const long long t0_ = clock64(); while (clock64() - t0_ < 60000) __builtin_amdgcn_s_sleep(8); }
#endif
        const int row = wid * 32 + (lane & 31);
        if (lane < 32) {
            const f32x2v a = P[row * 4 + 0], b = P[row * 4 + 1], c = P[row * 4 + 2], d = P[row * 4 + 3];
            const float mt = (a.x + b.x + c.x + d.x) * 0.25f;
            const float da = a.x - mt, db = b.x - mt, dc = c.x - mt, dd = d.x - mt;
            const float m2 = (a.y + b.y) + (c.y + d.y) + 64.0f * ((da * da + db * db) + (dc * dc + dd * dd));
            unsigned long long* slot = (unsigned long long*)xbuf + ((size_t)(u.pm * BM + row) * 4 + u.pn);
            __hip_atomic_store(slot, ((unsigned long long)__float_as_uint(m2) << 32) | __float_as_uint(mt), __ATOMIC_RELAXED, __HIP_MEMORY_SCOPE_AGENT);
        }
        asm volatile("s_waitcnt vmcnt(0)" ::: "memory");
        if (lane == 0) __hip_atomic_fetch_add(cnt + 64 * u.pm, 1u, __ATOMIC_RELAXED, __HIP_MEMORY_SCOPE_AGENT);
        if (wid == 0) {
            bool dead = false; const unsigned long long t0 = __builtin_amdgcn_s_memrealtime(); const unsigned want = 8u * (unsigned)ntn;
            for (;;) {
#if defined(BROKEN_EXCHANGE_NO_WAIT)
                break;
#endif
                if ((unsigned)__builtin_amdgcn_readfirstlane(__hip_atomic_load(cnt + 64 * u.pm, __ATOMIC_RELAXED, __HIP_MEMORY_SCOPE_AGENT)) >= want) break;
                if (__builtin_amdgcn_s_memrealtime() - t0 > 2000000ull) {
                    if (lane == 0) { unsigned expect = 0u; __hip_atomic_compare_exchange_strong(tmo + 1, &expect, code | (unsigned)(u.pm & 0xff), __ATOMIC_RELAXED, __ATOMIC_RELAXED, __HIP_MEMORY_SCOPE_AGENT);
                                     __hip_atomic_store(tmo, 1u, __ATOMIC_RELAXED, __HIP_MEMORY_SCOPE_AGENT); }
                    dead = true; break; }
                __builtin_amdgcn_s_sleep(2);
            }
            __builtin_amdgcn_fence(__ATOMIC_ACQUIRE, "agent");
            if (lane == 0) flag[0] = dead ? 1u : 0u;
        }
        asm volatile("s_waitcnt vmcnt(0) lgkmcnt(0)" ::: "memory"); __builtin_amdgcn_s_barrier(); asm volatile("" ::: "memory");
        const bool bad = flag[0] != 0u;
        if (lane < 32) {
            const unsigned long long* slot = (const unsigned long long*)xbuf + (size_t)(u.pm * BM + row) * 4; float mt[4], m2[4]; float ms = 0.f;
#pragma unroll
            for (int t = 0; t < 4; ++t) { if (t < ntn) { const unsigned long long w = __hip_atomic_load(slot + t, __ATOMIC_RELAXED, __HIP_MEMORY_SCOPE_AGENT); mt[t] = __uint_as_float((unsigned)w); m2[t] = __uint_as_float((unsigned)(w >> 32)); } else { mt[t] = 0.f; m2[t] = 0.f; } ms += mt[t]; }
            const float mean = ms / (float)ntn; float q = 0.f;
#pragma unroll
            for (int t = 0; t < 4; ++t) if (t < ntn) { const float dm = mt[t] - mean; q += m2[t] + 256.0f * dm * dm; }
            S[row] = (f32x2v){mean, 1.0f / sqrtf(q / (256.0f * (float)ntn) + eps)};
        }
        asm volatile("s_waitcnt lgkmcnt(0)" ::: "memory"); __builtin_amdgcn_s_barrier(); asm volatile("" ::: "memory");
        return bad;
    }
};
struct EpiLnRes {
    static constexpr bool PERM = false, AFTER_DRAIN = true;
    const float* base; float* out; int ldc; const float* bias; PanelStats st; unsigned poison;
    __device__ __forceinline__ void fused(f32x4 (&acc)[2][2][4][2], const Unit& u, int wr, int wc, int fr, int fq, PG8_LAS unsigned char* lds, int wid, int lane) const {
        typedef float f32x2v __attribute__((ext_vector_type(2)));
        const PG8_LAS f32x2v* S = (const PG8_LAS f32x2v*)(lds + 8192);
        const int col0 = u.pn * BM + wc * 32 + 4 * fq;
#pragma unroll
        for (int bj = 0; bj < 2; ++bj)
#pragma unroll
            for (int n = 0; n < 2; ++n) { const f32x4 bv = bias ? *(const f32x4*)(bias + col0 + bj * HALF + n * 16) : (f32x4){0.f, 0.f, 0.f, 0.f};
#pragma unroll
                for (int ai = 0; ai < 2; ++ai)
#pragma unroll
                    for (int m = 0; m < 4; ++m) acc[ai][bj][m][n] += bv; }
        f32x4 pre[4][2][2];
#pragma unroll
        for (int m = 0; m < 4; ++m) { const size_t off = (size_t)(u.pm * BM + wr * 64 + m * 16 + fr) * ldc + col0;
#pragma unroll
            for (int bj = 0; bj < 2; ++bj)
#pragma unroll
                for (int n = 0; n < 2; ++n) pre[m][bj][n] = *(const f32x4*)(base + off + bj * HALF + n * 16); }
        const bool bad = st.run(acc, u, wr, wc, fr, fq, lds, wid, lane) || poison != 0u;
        const float qnan = __builtin_nanf("");
#pragma unroll
        for (int ai = 0; ai < 2; ++ai)
#pragma unroll
            for (int m = 0; m < 4; ++m) { const int r = ai * HALF + wr * 64 + m * 16 + fr; const f32x2v sr = S[r]; const size_t off = (size_t)(u.pm * BM + r) * ldc + col0;
#pragma unroll
                for (int bj = 0; bj < 2; ++bj)
#pragma unroll
                    for (int n = 0; n < 2; ++n) { const f32x4 bs = ai == 0 ? pre[m][bj][n] : *(const f32x4*)(base + off + bj * HALF + n * 16); f32x4 o = bs + (acc[ai][bj][m][n] - sr.x) * sr.y;
                        if (bad) o = (f32x4){qnan, qnan, qnan, qnan}; *(f32x4*)(out + off + bj * HALF + n * 16) = o; }
                if (m & 1) asm volatile("" ::: "memory"); }
    }
};
struct EpiLnResLn {
    static constexpr bool PERM = false, AFTER_DRAIN = true;
    const float* base; float* out; bf16_t* xn; int ldc; const float* bias; PanelStats st1, st2; unsigned poison;
    __device__ __forceinline__ void fused(f32x4 (&acc)[2][2][4][2], const Unit& u, int wr, int wc, int fr, int fq, PG8_LAS unsigned char* lds, int wid, int lane) const {
        typedef float f32x2v __attribute__((ext_vector_type(2))); typedef unsigned u32x2v __attribute__((ext_vector_type(2)));
        const PG8_LAS f32x2v* S = (const PG8_LAS f32x2v*)(lds + 8192);
        const int col0 = u.pn * BM + wc * 32 + 4 * fq;
#pragma unroll
        for (int bj = 0; bj < 2; ++bj)
#pragma unroll
            for (int n = 0; n < 2; ++n) { const f32x4 bv = bias ? *(const f32x4*)(bias + col0 + bj * HALF + n * 16) : (f32x4){0.f, 0.f, 0.f, 0.f};
#pragma unroll
                for (int ai = 0; ai < 2; ++ai)
#pragma unroll
                    for (int m = 0; m < 4; ++m) acc[ai][bj][m][n] += bv; }
        bool bad = st1.run(acc, u, wr, wc, fr, fq, lds, wid, lane) || poison != 0u;
        const float qnan = __builtin_nanf("");
#pragma unroll
        for (int ai = 0; ai < 2; ++ai)
#pragma unroll
            for (int m = 0; m < 4; ++m) { const int r = ai * HALF + wr * 64 + m * 16 + fr; const f32x2v sr = S[r]; const size_t off = (size_t)(u.pm * BM + r) * ldc + col0;
#pragma unroll
                for (int bj = 0; bj < 2; ++bj)
#pragma unroll
                    for (int n = 0; n < 2; ++n) { const f32x4 bs = *(const f32x4*)(base + off + bj * HALF + n * 16); acc[ai][bj][m][n] = bs + (acc[ai][bj][m][n] - sr.x) * sr.y; }
                asm volatile("" : "+v"(acc[ai][0][m][0]), "+v"(acc[ai][0][m][1]), "+v"(acc[ai][1][m][0]), "+v"(acc[ai][1][m][1]));
                if (m & 1) asm volatile("" ::: "memory"); }
        const bool bad1 = bad;
        bad = st2.run(acc, u, wr, wc, fr, fq, lds, wid, lane) || bad;
#pragma unroll
        for (int ai = 0; ai < 2; ++ai)
#pragma unroll
            for (int m = 0; m < 4; ++m) { const int r = ai * HALF + wr * 64 + m * 16 + fr; const f32x2v sr = S[r]; const size_t off = (size_t)(u.pm * BM + r) * ldc + col0;
#pragma unroll
                for (int bj = 0; bj < 2; ++bj)
#pragma unroll
                    for (int n = 0; n < 2; ++n) { const f32x4 x1 = acc[ai][bj][m][n]; *(f32x4*)(out + off + bj * HALF + n * 16) = bad1 ? (f32x4){qnan, qnan, qnan, qnan} : x1;
                        const f32x4 o = (x1 - sr.x) * sr.y; u32x2v w; w.x = cvt_pk_bf16(o[0], o[1]); w.y = cvt_pk_bf16(o[2], o[3]);
                        if (bad) { w.x = 0x7fc07fc0u; w.y = 0x7fc07fc0u; } *(u32x2v*)(xn + off + bj * HALF + n * 16) = w; }
                asm volatile("" ::: "memory"); }
    }
};

template <class Epi, class Sched, bool ALIGN_EPI = false, bool SP2 = false>
__device__ __forceinline__ void gemm_phase(PG8_LAS unsigned char* lds, const Gemm g, const Sched& S, const Epi& E, int tid_in) {
    int tid_l = tid_in; asm volatile("" : "+v"(tid_l));
    const int tid = tid_l, wid = __builtin_amdgcn_readfirstlane(tid >> 6), lane = tid & 63, wr = wid >> 2, wc = wid & 3, fr = lane & 15, fq = lane >> 4;
    int K_l = g.K; asm volatile("" : "+s"(K_l));
    const int K = K_l, nt = K / BK;
    unsigned voffA[2], voffB[2];
#pragma unroll
    for (int i = 0; i < 2; ++i) { int R, C; stage_rc(tid * 16 + i * 8192, R, C); const int Rb = Epi::PERM ? ((R & ~31) + perm32(R & 31)) : R;
        voffA[i] = (unsigned)(R * K + C) * 2u; voffB[i] = (unsigned)(Rb * K + C) * 2u; }
    const size_t kstep = (size_t)(BK * 2);
    const size_t hstep = (size_t)HALF * K * 2;
    const size_t tstep = 2 * hstep;
    const unsigned ldsw = (unsigned)wid * 1024u;
    const int aoff = lds_byte(wr * 64 + fr, fq * 8), boff = lds_byte(wc * 32 + fr, fq * 8);
#define PG8_SA(b, h) (((b) * 2 + (h)) * HTB)
#define PG8_SB(b, h) ((4 + (b) * 2 + (h)) * HTB)
#define PG8_STAGE(bufoff, gbase, voff) do { _Pragma("unroll") for (int _i = 0; _i < 2; ++_i) \
        __builtin_amdgcn_global_load_lds((const unsigned*)((const char*)(gbase) + (voff)[_i]), (PG8_LAS unsigned*)(lds + (bufoff) + ldsw + _i * 8192), 16, 0, 0); } while (0)
#define PG8_LDA(dst, b, h) do { _Pragma("unroll") for (int m = 0; m < 4; ++m) _Pragma("unroll") for (int k = 0; k < 2; ++k) dst[m][k] = *(const PG8_LAS bf16x8*)(lds + PG8_SA(b, h) + aoff + m * 2048 + k * 1024); } while (0)
#define PG8_LDB(dst, b, h) do { _Pragma("unroll") for (int n = 0; n < 2; ++n) _Pragma("unroll") for (int k = 0; k < 2; ++k) dst[n][k] = *(const PG8_LAS bf16x8*)(lds + PG8_SB(b, h) + boff + n * 2048 + k * 1024); } while (0)
#define PG8_MMA(ai, bj, At, Bt) do { __builtin_amdgcn_s_setprio(1); _Pragma("unroll") for (int m = 0; m < 4; ++m) _Pragma("unroll") for (int n = 0; n < 2; ++n) _Pragma("unroll") for (int k = 0; k < 2; ++k) \
        acc[ai][bj][m][n] = __builtin_amdgcn_mfma_f32_16x16x32_bf16(Bt[n][k], At[m][k], acc[ai][bj][m][n], 0, 0, 0); __builtin_amdgcn_s_setprio(0); } while (0)
#define PG8_WAIT_V(n) asm volatile("s_waitcnt vmcnt(" #n ")" ::: "memory")
#define PG8_WAIT_L(n) asm volatile("s_waitcnt lgkmcnt(" #n ")" ::: "memory")
#define PG8_BAR __builtin_amdgcn_s_barrier()
#define PG8_SCHED __builtin_amdgcn_sched_barrier(0)
    Unit cur, nxt; int ui = 0;
    if (!S.next(0, cur)) return;
    f32x4 acc[2][2][4][2];
#pragma unroll
    for (int a = 0; a < 2; ++a)
#pragma unroll
        for (int b = 0; b < 2; ++b)
#pragma unroll
            for (int m = 0; m < 4; ++m)
#pragma unroll
                for (int n = 0; n < 2; ++n) acc[a][b][m][n] = (f32x4){0.f, 0.f, 0.f, 0.f};
    bf16x8 At[4][2], B0[2][2], B1[2][2];
    const char* cA = (const char*)g.A + (size_t)cur.pm * tstep; const char* cB = (const char*)g.Bt + (size_t)cur.pn * tstep;
    S.a_ready(cur);
    if constexpr (SP2) {
        PG8_STAGE(PG8_SB(0, 0), cB, voffB); PG8_STAGE(PG8_SB(0, 1), cB + hstep, voffB); PG8_STAGE(PG8_SA(0, 0), cA, voffA); PG8_STAGE(PG8_SA(0, 1), cA + hstep, voffA);
        if (wr == 1) PG8_BAR;
        PG8_WAIT_V(2); PG8_BAR;
        PG8_STAGE(PG8_SB(1, 0), cB + kstep, voffB); PG8_STAGE(PG8_SA(1, 0), cA + kstep, voffA); PG8_STAGE(PG8_SB(1, 1), cB + hstep + kstep, voffB);
        PG8_WAIT_V(6); PG8_BAR;
    } else {
        PG8_STAGE(PG8_SB(0, 0), cB, voffB); PG8_STAGE(PG8_SA(0, 0), cA, voffA); PG8_STAGE(PG8_SB(0, 1), cB + hstep, voffB); PG8_STAGE(PG8_SA(0, 1), cA + hstep, voffA);
        if (wr == 1) PG8_BAR;
        PG8_WAIT_V(4); PG8_BAR;
        PG8_STAGE(PG8_SB(1, 0), cB + kstep, voffB); PG8_STAGE(PG8_SA(1, 0), cA + kstep, voffA); PG8_STAGE(PG8_SB(1, 1), cB + hstep + kstep, voffB);
        PG8_WAIT_V(6); PG8_BAR;
    }
    for (;;) {
        const bool has_next = S.next(ui + 1, nxt);
        const char* nA = has_next ? (const char*)g.A + (size_t)nxt.pm * tstep : cA; const char* nB = has_next ? (const char*)g.Bt + (size_t)nxt.pn * tstep : cB;
        for (int t = 0; t < nt; t += 2) {
            const bool last = (t == nt - 2);
            const char* a1 = cA + (size_t)(t + 1) * kstep;
            const char* a2 = last ? nA : cA + (size_t)(t + 2) * kstep; const char* b2 = last ? nB : cB + (size_t)(t + 2) * kstep;
            const char* a3 = a2 + kstep; const char* b3 = b2 + kstep;
            if (last && has_next) S.a_ready(nxt);
            if constexpr (SP2) {
            PG8_LDB(B0, 0, 0); PG8_LDB(B1, 0, 1); PG8_SCHED; PG8_LDA(At, 0, 0); PG8_STAGE(PG8_SA(1, 1), a1 + hstep, voffA);
            PG8_WAIT_V(8); PG8_WAIT_L(0); PG8_BAR; PG8_MMA(0, 0, At, B0); PG8_MMA(0, 1, At, B1); PG8_BAR; PG8_SCHED;
            PG8_LDA(At, 0, 1); PG8_STAGE(PG8_SB(0, 0), b2, voffB); PG8_STAGE(PG8_SB(0, 1), b2 + hstep, voffB); PG8_STAGE(PG8_SA(0, 0), a2, voffA);
            PG8_WAIT_V(8); PG8_WAIT_L(0); PG8_BAR; PG8_MMA(1, 0, At, B0); PG8_MMA(1, 1, At, B1); PG8_BAR; PG8_SCHED;
            PG8_LDB(B0, 1, 0); PG8_LDB(B1, 1, 1); PG8_SCHED; PG8_LDA(At, 1, 0); PG8_STAGE(PG8_SA(0, 1), a2 + hstep, voffA);
            PG8_WAIT_V(8); PG8_WAIT_L(0); PG8_BAR; PG8_MMA(0, 0, At, B0); PG8_MMA(0, 1, At, B1); PG8_BAR; PG8_SCHED;
            PG8_LDA(At, 1, 1); PG8_STAGE(PG8_SB(1, 0), b3, voffB); PG8_STAGE(PG8_SB(1, 1), b3 + hstep, voffB); PG8_STAGE(PG8_SA(1, 0), a3, voffA);
            PG8_WAIT_V(8); PG8_WAIT_L(0); PG8_BAR; PG8_MMA(1, 0, At, B0); PG8_MMA(1, 1, At, B1); PG8_BAR; PG8_SCHED;
            } else {
            PG8_LDB(B0, 0, 0); PG8_SCHED; PG8_LDA(At, 0, 0); PG8_STAGE(PG8_SA(1, 1), a1 + hstep, voffA);
            PG8_WAIT_L(8); PG8_BAR; PG8_WAIT_L(0); PG8_MMA(0, 0, At, B0); PG8_BAR; PG8_SCHED;
            PG8_LDB(B1, 0, 1); PG8_STAGE(PG8_SB(0, 0), b2, voffB);
            PG8_BAR; PG8_WAIT_L(0); PG8_MMA(0, 1, At, B1); PG8_BAR;
            PG8_LDA(At, 0, 1); PG8_STAGE(PG8_SA(0, 0), a2, voffA);
            PG8_BAR; PG8_WAIT_L(0); PG8_MMA(1, 0, At, B0); PG8_BAR; PG8_SCHED;
            PG8_STAGE(PG8_SB(0, 1), b2 + hstep, voffB);
            PG8_WAIT_V(6); PG8_BAR; PG8_MMA(1, 1, At, B1); PG8_BAR;
            PG8_LDB(B0, 1, 0); PG8_SCHED; PG8_LDA(At, 1, 0); PG8_STAGE(PG8_SA(0, 1), a2 + hstep, voffA);
            PG8_WAIT_L(8); PG8_BAR; PG8_WAIT_L(0); PG8_MMA(0, 0, At, B0); PG8_BAR; PG8_SCHED;
            PG8_LDB(B1, 1, 1); PG8_STAGE(PG8_SB(1, 0), b3, voffB);
            PG8_BAR; PG8_WAIT_L(0); PG8_MMA(0, 1, At, B1); PG8_BAR;
            PG8_LDA(At, 1, 1); PG8_STAGE(PG8_SA(1, 0), a3, voffA);
            PG8_BAR; PG8_WAIT_L(0); PG8_MMA(1, 0, At, B0); PG8_BAR; PG8_SCHED;
            PG8_STAGE(PG8_SB(1, 1), b3 + hstep, voffB);
            PG8_WAIT_V(6); PG8_BAR; PG8_MMA(1, 1, At, B1); PG8_BAR;
            }
        }
        if constexpr (ALIGN_EPI) { if (wr == 0) PG8_BAR; }
        if constexpr (!Epi::AFTER_DRAIN) { E(acc, cur, wr, wc, fr, fq); S.done(cur); }
        if (!has_next) break;
#pragma unroll
        for (int a = 0; a < 2; ++a)
#pragma unroll
            for (int b = 0; b < 2; ++b)
#pragma unroll
                for (int m = 0; m < 4; ++m)
#pragma unroll
                    for (int n = 0; n < 2; ++n) acc[a][b][m][n] = (f32x4){0.f, 0.f, 0.f, 0.f};
        cur = nxt; cA = nA; cB = nB; ++ui;
        if constexpr (ALIGN_EPI) { if (wr == 1) PG8_BAR; }
    }
    PG8_WAIT_V(0);
    if constexpr (!ALIGN_EPI) { if (wr == 0) PG8_BAR; }
    PG8_BAR;
    if constexpr (Epi::AFTER_DRAIN) { E.fused(acc, cur, wr, wc, fr, fq, lds, wid, lane); S.done(cur); }
#undef PG8_SA
#undef PG8_SB
#undef PG8_STAGE
#undef PG8_LDA
#undef PG8_LDB
#undef PG8_MMA
#undef PG8_WAIT_V
#undef PG8_WAIT_L
#undef PG8_BAR
#undef PG8_SCHED
}
}

typedef unsigned short bf16;
typedef float f32x4 __attribute__((ext_vector_type(4)));
typedef unsigned u32x4 __attribute__((ext_vector_type(4)));
typedef unsigned u32x2 __attribute__((ext_vector_type(2)));

constexpr int BATCH = 8, SEQ = 4096, T = BATCH * SEQ, D = 1024, DEPTH = 2;
constexpr int NA = 2048, NB = 3328, NIN = NA + NB, INW = 5204;
constexpr int DFF = 2816, NGU = 2 * DFF, PLE = 256, MIXW = 2048;
constexpr int A_Q = 0, A_BG = 512, A_Z = 1024;
constexpr int B_CKV = 0, B_IQ = 256, B_CG = 512, B_HB = 1024, B_XBC = 1536, B_IK = 3072, B_DT = 3136, B_IW = 3152;
constexpr int XBC = 1536, KV_R = 256, TOPK = 256;
constexpr float EPS = 1e-6f;

constexpr size_t MiB = 1u << 20;
constexpr size_t WS_CTL = 0;
constexpr size_t WS_RSTD = 1 * MiB;
constexpr size_t WS_RSTD2 = 1 * MiB + 256 * 1024;
constexpr size_t WS_DT = 2 * MiB;
constexpr size_t WS_W = 8 * MiB;
constexpr size_t WS_W_IN = WS_W, WS_W_OUT = WS_W_IN + (size_t)NIN * D * 2, WS_W_GU = WS_W_OUT + (size_t)D * MIXW * 2, WS_W_DOWN = WS_W_GU + (size_t)NGU * D * 2,
                 WS_W_PG = WS_W_DOWN + (size_t)D * DFF * 2, WS_W_PP = WS_W_PG + (size_t)D * D * 2, WS_W_END = WS_W_PP + (size_t)D * PLE * 2;
constexpr size_t WS_WUK = 42 * MiB, WS_WUV = 43 * MiB;
static_assert(WS_W_END <= 42 * MiB, "weights");
constexpr size_t WS_X0 = 44 * MiB, WS_X1 = 108 * MiB, WS_RA = 172 * MiB, WS_RB = 300 * MiB, WS_DT2 = 508 * MiB, WS_END = 512 * MiB;
constexpr size_t WS_XA = WS_X0;
constexpr size_t WS_IDX = WS_X1 + 48 * MiB;
constexpr size_t WS_CKVC = WS_X1 + 32 * MiB;
constexpr size_t WS_IKC = 4 * MiB;

__host__ __device__ __forceinline__ float bf2f(bf16 b) { return __builtin_bit_cast(float, ((unsigned)b) << 16); }
__host__ __device__ __forceinline__ bf16 f2bf(float f) { unsigned u = __builtin_bit_cast(unsigned, f); return (bf16)((u + 0x7fffu + ((u >> 16) & 1u)) >> 16); }
__device__ __forceinline__ unsigned pk2(float lo, float hi) { return (unsigned)f2bf(lo) | ((unsigned)f2bf(hi) << 16); }
__device__ __forceinline__ float wave_sum(float v) {
#pragma unroll
    for (int o = 1; o < 64; o <<= 1) v += __shfl_xor(v, o);
    return v;
}
__device__ __forceinline__ float wave_max(float v) {
#pragma unroll
    for (int o = 1; o < 64; o <<= 1) v = fmaxf(v, __shfl_xor(v, o));
    return v;
}
__device__ __forceinline__ float sigmoidf_(float v) { return __builtin_amdgcn_rcpf(1.0f + __expf(-v)); }
__device__ __forceinline__ float siluf_(float v) { return v * sigmoidf_(v); }

__host__ __device__ __forceinline__ int src_col_in(int n) {
    if (n < 512) return n;
    if (n < 1024) return 1092 + (n - 512);
    if (n < 2048) return 2628 + (n - 1024);
    n -= 2048;
    if (n < 256) return 512 + n;
    if (n < 512) return 768 + (n - 256);
    if (n < 1024) return 1604 + (n - 512);
    if (n < 1536) return 2116 + (n - 1024);
    if (n < 3072) return 3652 + (n - 1536);
    if (n < 3136) return 1024 + (n - 3072);
    if (n < 3152) return 5188 + (n - 3136);
    if (n < 3156) return 1088 + (n - 3152);
    return -1;
}

__host__ __device__ __forceinline__ int t5_bucket(int rel) {
    const int ret = rel > 0 ? 16 : 0; const int n = rel < 0 ? -rel : rel;
    int b;
    if (n < 8) b = n; else if (n < 15) b = 8; else if (n < 27) b = 9; else if (n < 50) b = 10; else if (n < 91) b = 11; else if (n < 166) b = 12; else if (n < 305) b = 13; else if (n < 559) b = 14; else b = 15;
    return ret + b;
}

template <int MODE> __global__ void __launch_bounds__(256) k_prep_w(const float* __restrict__ W, const float* __restrict__ W2, int K, int Nsrc, const float* __restrict__ gain, bf16* __restrict__ Wt) {
    __shared__ float tile[32][33];
    const int n0 = blockIdx.x * 32, k0 = blockIdx.y * 32, tx = threadIdx.x & 31, ty = threadIdx.x >> 5;
    const int n = n0 + tx; int src; const float* Ws = W;
    if (MODE == 0) src = n; else if (MODE == 1) src = src_col_in(n); else { const int which = (n & 255) >> 7; src = (n >> 8) * 128 + (n & 127); Ws = which ? W2 : W; }
    for (int kk = ty; kk < 32; kk += 8) { float v = 0.f; if (src >= 0) { v = Ws[(size_t)(k0 + kk) * Nsrc + src]; if (gain) v *= gain[k0 + kk]; } tile[kk][tx] = v; }
    __syncthreads();
    for (int nn = ty; nn < 32; nn += 8) Wt[(size_t)(n0 + nn) * K + k0 + tx] = f2bf(tile[tx][nn]);
}

__global__ void __launch_bounds__(256) k_x_prep(const float* __restrict__ x, bf16* __restrict__ xb, float* __restrict__ rstd) {
    const int lane = threadIdx.x & 63, row = blockIdx.x * 4 + (threadIdx.x >> 6);
    const f32x4* xr = (const f32x4*)(x + (size_t)row * D) + lane; float ss = 0.f; f32x4 v[4];
#pragma unroll
    for (int j = 0; j < 4; ++j) { v[j] = xr[64 * j]; ss += (v[j].x * v[j].x + v[j].y * v[j].y) + (v[j].z * v[j].z + v[j].w * v[j].w); }
    ss = wave_sum(ss);
    u32x2* o = (u32x2*)(xb + (size_t)row * D) + lane;
#pragma unroll
    for (int j = 0; j < 4; ++j) { u32x2 w; w.x = pk2(v[j].x, v[j].y); w.y = pk2(v[j].z, v[j].w); o[64 * j] = w; }
    if (lane == 0) rstd[row] = 1.0f / sqrtf(ss * (1.0f / D) + EPS);
}
__global__ void __launch_bounds__(256) k_rstd(const float* __restrict__ x, float* __restrict__ rstd) {
    const int lane = threadIdx.x & 63, row = blockIdx.x * 4 + (threadIdx.x >> 6);
    const f32x4* xr = (const f32x4*)(x + (size_t)row * D) + lane; float ss = 0.f;
#pragma unroll
    for (int j = 0; j < 4; ++j) { const f32x4 v = xr[64 * j]; ss += (v.x * v.x + v.y * v.y) + (v.z * v.z + v.w * v.w); }
    ss = wave_sum(ss);
    if (lane == 0) rstd[row] = 1.0f / sqrtf(ss * (1.0f / D) + EPS);
}
__global__ void __launch_bounds__(256) k_resid_norm(const float* xin, const float* __restrict__ y, const float* __restrict__ g, float* xo, bf16* __restrict__ xb,
                                                    float* __restrict__ rstd_out, const float* __restrict__ p, bf16* __restrict__ pb) {
    const int lane = threadIdx.x & 63, row = blockIdx.x * 4 + (threadIdx.x >> 6);
    const f32x4* yr = (const f32x4*)(y + (size_t)row * D) + lane; const f32x4* xr = (const f32x4*)(xin + (size_t)row * D) + lane; const f32x4* gr = (const f32x4*)g + lane;
    f32x4 v[4]; float ss = 0.f;
#pragma unroll
    for (int j = 0; j < 4; ++j) { v[j] = yr[64 * j]; ss += (v[j].x * v[j].x + v[j].y * v[j].y) + (v[j].z * v[j].z + v[j].w * v[j].w); }
    const float r = 1.0f / sqrtf(wave_sum(ss) * (1.0f / D) + EPS);
    float s2 = 0.f;
    f32x4* xor_ = (f32x4*)(xo + (size_t)row * D) + lane; u32x2* o = (u32x2*)(xb + (size_t)row * D) + lane;
#pragma unroll
    for (int j = 0; j < 4; ++j) { const f32x4 xx = xr[64 * j], gg = gr[64 * j]; f32x4 w = xx + v[j] * r * gg; xor_[64 * j] = w; s2 += (w.x * w.x + w.y * w.y) + (w.z * w.z + w.w * w.w);
        u32x2 q; q.x = pk2(w.x, w.y); q.y = pk2(w.z, w.w); o[64 * j] = q; }
    if (rstd_out) { s2 = wave_sum(s2); if (lane == 0) rstd_out[row] = 1.0f / sqrtf(s2 * (1.0f / D) + EPS); }
    if (p) { const f32x4 pv = *((const f32x4*)(p + (size_t)row * PLE) + lane); u32x2 q; q.x = pk2(pv.x, pv.y); q.y = pk2(pv.z, pv.w); *((u32x2*)(pb + (size_t)row * PLE) + lane) = q; }
}

namespace pg8 {
struct EpiProj {
    static constexpr bool PERM = true, AFTER_DRAIN = false;
    bf16_t* RA; bf16_t* RB; const float* rstd;
    __device__ __forceinline__ void operator()(const f32x4 (&acc)[2][2][4][2], const Unit& u, int wr, int wc, int fr, int fq) const {
        const int row0 = u.pm * BM + wr * 64 + fr; bf16_t* base; int ld, colt;
        if (u.pn < NA / 256) { base = RA; ld = NA; colt = u.pn * BM; } else { base = RB; ld = NB; colt = (u.pn - NA / 256) * BM; }
        const int col0 = colt + wc * 32 + 8 * fq;
        float sr[2][4];
#pragma unroll
        for (int ai = 0; ai < 2; ++ai)
#pragma unroll
            for (int m = 0; m < 4; ++m) sr[ai][m] = rstd[row0 + ai * HALF + m * 16];
#pragma unroll
        for (int ai = 0; ai < 2; ++ai)
#pragma unroll
            for (int m = 0; m < 4; ++m) { const int r = row0 + ai * HALF + m * 16; const float s = sr[ai][m]; bf16_t* rowp = base + (size_t)r * ld + col0;
#pragma unroll
                for (int bj = 0; bj < 2; ++bj) { const f32x4 v0 = acc[ai][bj][m][0] * s, v1 = acc[ai][bj][m][1] * s;
                    u32x4 w; w.x = cvt_pk_bf16(v0[0], v0[1]); w.y = cvt_pk_bf16(v0[2], v0[3]); w.z = cvt_pk_bf16(v1[0], v1[1]); w.w = cvt_pk_bf16(v1[2], v1[3]);
                    *(u32x4*)(rowp + bj * HALF) = w; } }
    }
};
struct EpiF32 {
    static constexpr bool PERM = false, AFTER_DRAIN = false;
    float* C; long ldc;
    __device__ __forceinline__ void operator()(const f32x4 (&acc)[2][2][4][2], const Unit& u, int wr, int wc, int fr, int fq) const {
        const int row0 = u.pm * BM + wr * 64 + fr, col0 = u.pn * BM + wc * 32 + 4 * fq;
#pragma unroll
        for (int ai = 0; ai < 2; ++ai)
#pragma unroll
            for (int m = 0; m < 4; ++m) { float* rowp = C + (size_t)(row0 + ai * HALF + m * 16) * ldc + col0;
#pragma unroll
                for (int bj = 0; bj < 2; ++bj)
#pragma unroll
                    for (int n = 0; n < 2; ++n) *(f32x4*)(rowp + bj * HALF + n * 16) = acc[ai][bj][m][n]; }
    }
};
struct EpiBf16P {
    static constexpr bool PERM = true, AFTER_DRAIN = false;
    bf16_t* O; long ldc;
    __device__ __forceinline__ void operator()(const f32x4 (&acc)[2][2][4][2], const Unit& u, int wr, int wc, int fr, int fq) const {
        const int row0 = u.pm * BM + wr * 64 + fr, col0 = u.pn * BM + wc * 32 + 8 * fq;
#pragma unroll
        for (int ai = 0; ai < 2; ++ai)
#pragma unroll
            for (int m = 0; m < 4; ++m) { bf16_t* rowp = O + (size_t)(row0 + ai * HALF + m * 16) * ldc + col0;
#pragma unroll
                for (int bj = 0; bj < 2; ++bj) { const f32x4 v0 = acc[ai][bj][m][0], v1 = acc[ai][bj][m][1];
                    u32x4 w; w.x = cvt_pk_bf16(v0[0], v0[1]); w.y = cvt_pk_bf16(v0[2], v0[3]); w.z = cvt_pk_bf16(v1[0], v1[1]); w.w = cvt_pk_bf16(v1[2], v1[3]);
                    *(u32x4*)(rowp + bj * HALF) = w; } }
    }
};
struct EpiSwiGLU {
    static constexpr bool PERM = true, AFTER_DRAIN = false;
    bf16_t* G; const float* rstd;
    __device__ __forceinline__ void operator()(const f32x4 (&acc)[2][2][4][2], const Unit& u, int wr, int wc, int fr, int fq) const {
        const int row0 = u.pm * BM + wr * 64 + fr, col0 = u.pn * HALF + wc * 32 + 8 * fq;
        float sr[2][4];
#pragma unroll
        for (int ai = 0; ai < 2; ++ai)
#pragma unroll
            for (int m = 0; m < 4; ++m) sr[ai][m] = rstd[row0 + ai * HALF + m * 16];
#pragma unroll
        for (int ai = 0; ai < 2; ++ai)
#pragma unroll
            for (int m = 0; m < 4; ++m) { const int r = row0 + ai * HALF + m * 16; const float s = sr[ai][m]; float o[8];
#pragma unroll
                for (int n = 0; n < 2; ++n)
#pragma unroll
                    for (int j = 0; j < 4; ++j) { const float gt = acc[ai][0][m][n][j] * s, up = acc[ai][1][m][n][j] * s; o[n * 4 + j] = gt * __builtin_amdgcn_rcpf(1.0f + __expf(-gt)) * up; }
                u32x4 w; w.x = cvt_pk_bf16(o[0], o[1]); w.y = cvt_pk_bf16(o[2], o[3]); w.z = cvt_pk_bf16(o[4], o[5]); w.w = cvt_pk_bf16(o[6], o[7]);
                *(u32x4*)(G + (size_t)r * DFF + col0) = w; }
    }
};
struct EpiPle {
    static constexpr bool PERM = true, AFTER_DRAIN = false;
    const bf16_t* X; const bf16_t* Tt; bf16_t* XB; float* OUT;
    __device__ __forceinline__ void operator()(const f32x4 (&acc)[2][2][4][2], const Unit& u, int wr, int wc, int fr, int fq) const {
        const int row0 = u.pm * BM + wr * 64 + fr, col0 = u.pn * BM + wc * 32 + 8 * fq;
        u32x4 tv[2][2], xv[2][2];
#define PLE_LOAD(slot, grp) do { const size_t off_ = (size_t)(row0 + ((grp) >> 2) * HALF + ((grp) & 3) * 16) * D + col0; _Pragma("unroll") for (int bj_ = 0; bj_ < 2; ++bj_) { \
            tv[slot][bj_] = *(const u32x4*)(Tt + off_ + bj_ * HALF); xv[slot][bj_] = *(const u32x4*)(X + off_ + bj_ * HALF); } } while (0)
        PLE_LOAD(0, 0);
#pragma unroll
        for (int grp = 0; grp < 8; ++grp) { const int ai = grp >> 2, m = grp & 3, sl = grp & 1; const size_t off = (size_t)(row0 + ai * HALF + m * 16) * D + col0;
            if (grp + 1 < 8) PLE_LOAD((grp + 1) & 1, grp + 1);
#pragma unroll
            for (int bj = 0; bj < 2; ++bj) { const unsigned tw[4] = {tv[sl][bj].x, tv[sl][bj].y, tv[sl][bj].z, tv[sl][bj].w}, xw[4] = {xv[sl][bj].x, xv[sl][bj].y, xv[sl][bj].z, xv[sl][bj].w}; f32x4 x0, x1;
#pragma unroll
                for (int j = 0; j < 4; ++j) { const float t0 = __builtin_bit_cast(float, (j & 1) ? (tw[j >> 1] & 0xffff0000u) : (tw[j >> 1] << 16));
                    const float t1 = __builtin_bit_cast(float, (j & 1) ? (tw[2 + (j >> 1)] & 0xffff0000u) : (tw[2 + (j >> 1)] << 16));
                    const float a0 = __builtin_bit_cast(float, (j & 1) ? (xw[j >> 1] & 0xffff0000u) : (xw[j >> 1] << 16));
                    const float a1 = __builtin_bit_cast(float, (j & 1) ? (xw[2 + (j >> 1)] & 0xffff0000u) : (xw[2 + (j >> 1)] << 16));
                    x0[j] = a0 + __builtin_amdgcn_rcpf(1.0f + __expf(-acc[ai][bj][m][0][j])) * t0; x1[j] = a1 + __builtin_amdgcn_rcpf(1.0f + __expf(-acc[ai][bj][m][1][j])) * t1; }
                if (OUT) { *(f32x4*)(OUT + off + bj * HALF) = x0; *(f32x4*)(OUT + off + bj * HALF + 4) = x1; }
                else { u32x4 w; w.x = cvt_pk_bf16(x0[0], x0[1]); w.y = cvt_pk_bf16(x0[2], x0[3]); w.z = cvt_pk_bf16(x1[0], x1[1]); w.w = cvt_pk_bf16(x1[2], x1[3]);
                    *(u32x4*)(XB + off + bj * HALF) = w; } } }
#undef PLE_LOAD
    }
};
}

__device__ __forceinline__ unsigned ord_key(float f) { const unsigned u = __builtin_bit_cast(unsigned, f); return (u & 0x80000000u) ? ~u : (u | 0x80000000u); }
#define LAS __attribute__((address_space(3)))
#define XB_TMO      128
#define XB_XCNT(j)  (256  + 64 * (j))
#define XB_XSUB(j)  (1280 + 64 * (j))
#define XB_XGEN(j)  (2304 + 64 * (j))
#define XB_TOP      3328
#define XB_TOPGEN   3392
#define XCD_BAR_WORDS 3456
#define XB_SPIN_CAP (1u << 18)

__device__ __forceinline__ unsigned xb_ld(unsigned* p)              { return __hip_atomic_load(p, __ATOMIC_RELAXED, __HIP_MEMORY_SCOPE_AGENT); }
__device__ __forceinline__ unsigned xb_add(unsigned* p, unsigned v) { return __hip_atomic_fetch_add(p, v, __ATOMIC_RELAXED, __HIP_MEMORY_SCOPE_AGENT); }
__device__ __forceinline__ unsigned xb_xcc_id() { return (unsigned)__builtin_amdgcn_s_getreg((3 << 11) | 20) & 0xFu; }
#define XB_SPIN(cond, bar) do { unsigned _sp = 0; while (cond) { __builtin_amdgcn_s_sleep(1); \
    if ((++_sp & 255u) == 0u) { if (xb_ld(&(bar)[XB_TMO])) break; if (_sp > XB_SPIN_CAP) { atomicAdd(&(bar)[XB_TMO], 1u); break; } } } } while (0)

struct XcdBarrier {
    unsigned* bar; unsigned x;
    volatile LAS unsigned* st;
};

__device__ __forceinline__ XcdBarrier xcd_barrier_post(unsigned* bar, volatile LAS unsigned* st) {
    XcdBarrier b; b.bar = bar; b.x = xb_xcc_id(); b.st = st;
    if (threadIdx.x == 0) (void)xb_add(&bar[XB_XCNT(b.x)], 1u);
    return b;
}
__device__ __forceinline__ void xcd_barrier_complete(unsigned* bar, unsigned x, unsigned& nloc, unsigned& nx) {
    const unsigned G = gridDim.x * gridDim.y * gridDim.z;
    unsigned sum, cnt, mine, sp = 0u;
    for (;;) {
        sum = 0u; cnt = 0u; mine = 0u;
#pragma unroll
        for (unsigned j = 0; j < 16; ++j) { const unsigned c = xb_ld(&bar[XB_XCNT(j)]); sum += c; cnt += (c > 0u) ? 1u : 0u; mine = (j == x) ? c : mine; }
        if (sum == G) break;
        __builtin_amdgcn_s_sleep(1);
        if ((++sp & 255u) == 0u) { if (xb_ld(&bar[XB_TMO])) break; if (sp > XB_SPIN_CAP) { atomicAdd(&bar[XB_TMO], 1u); break; } }
    }
    nloc = mine > 0u ? mine : 1u; nx = cnt > 0u ? cnt : 1u;
}

__device__ __forceinline__ void xcd_barrier(const XcdBarrier& b, int tid_in) {
    asm volatile("s_waitcnt vmcnt(0)" ::: "memory");
    __syncthreads();
    if (tid_in == 0) {
        unsigned* bar = b.bar;
        __builtin_amdgcn_s_waitcnt(0);
        unsigned nloc = b.st[0], nx = b.st[1];
        if (nloc == 0u) { xcd_barrier_complete(bar, b.x, nloc, nx); b.st[0] = nloc; b.st[1] = nx; }
        const unsigned old = xb_add(&bar[XB_XSUB(b.x)], 1u);
        const unsigned gen = old / nloc;
        if (old + 1u == (gen + 1u) * nloc) {
            __builtin_amdgcn_fence(__ATOMIC_RELEASE, "agent");
            asm volatile("s_waitcnt vmcnt(0)" ::: "memory");
            const unsigned og = xb_add(&bar[XB_TOP], 1u);
            const unsigned tg = og / nx;
            if (og + 1u == (tg + 1u) * nx) xb_add(&bar[XB_TOPGEN], 1u);
            else XB_SPIN(xb_ld(&bar[XB_TOPGEN]) == tg, bar);
            __builtin_amdgcn_fence(__ATOMIC_ACQUIRE, "agent");
            xb_add(&bar[XB_XGEN(b.x)], 1u);
            asm volatile("s_waitcnt vmcnt(0)" ::: "memory");
        } else {
            XB_SPIN(xb_ld(&bar[XB_XGEN(b.x)]) == gen, bar);
            __builtin_amdgcn_fence(__ATOMIC_ACQUIRE, "agent");
            asm volatile("s_waitcnt vmcnt(0)" ::: "memory");
        }
    }
    __syncthreads();
}


constexpr int NTHR = 512, NWAVES = 8;
constexpr int RING_BYTES = 131072, LDS_BYTES = 147456, MISC_OFF = LDS_BYTES - 512;
constexpr int CW_BAR = 4096, CW_RANK = 8192;
constexpr size_t CTL_ZERO_BYTES = 1 * MiB;
constexpr int NPH = 14;

__device__ __forceinline__ int mk_tid(int wave_s) { int l_; asm volatile("v_mbcnt_lo_u32_b32 %0, -1, 0\n\tv_mbcnt_hi_u32_b32 %0, -1, %0" : "=v"(l_)); return wave_s * 64 + l_; }
struct Params { const float* in[26]; float* out; unsigned char* ws; int ph_lo, ph_hi, dbl_mask, pad; };
static_assert(sizeof(Params) == 26 * 8 + 8 + 8 + 16, "no padding");

#define LDSP __attribute__((address_space(3)))
#define LDS_WAIT() asm volatile("s_waitcnt lgkmcnt(0)" ::: "memory")
#ifndef NAIVE_SELECT
#define NAIVE_SELECT 0
#endif
#ifndef NAIVE_ATTN
#define NAIVE_ATTN 0
#endif
#ifndef NAIVE_SSM
#define NAIVE_SSM 0
#endif
#ifndef DBG_SSM
#define DBG_SSM 0
#endif
#ifndef TIMING
#define TIMING 0
#endif
#ifndef DBL_MASK
#define DBL_MASK 0
#endif
#ifndef GEMM_DRYK
#define GEMM_DRYK 0
#endif
#ifndef CLK_PROBE
#define CLK_PROBE 0
#endif
#ifndef ATT_FN
#define ATT_FN wg_attn16d
#endif
#ifndef XTRA_BAR
#define XTRA_BAR 0
#endif
#ifndef ATT_SUB_V
#define ATT_SUB_V 0
#endif
#ifndef TIMING_SHIFT
#define TIMING_SHIFT 0.0f
#endif
#ifndef TIMING_A
#define TIMING_A 2
#endif
#ifndef TIMING_B
#define TIMING_B 3
#endif

template <int MODE> __device__ __forceinline__ void ph_prep_w(LDSP float* scr, const float* __restrict__ W, const float* __restrict__ W2, int K, int Nsrc, const float* __restrict__ gain, bf16* __restrict__ Wt, int Ndst, int gw, int NGW, int lane) {
    const int ntn = Ndst / 32, nt = ntn * (K / 64), n4 = lane & 7, kr = lane >> 3;
    f32x4 v[8];
#define PW_LOAD(it_) { const int n0_ = ((it_) % ntn) * 32, k0_ = ((it_) / ntn) * 64, n_ = n0_ + 4 * n4; int src_; const float* Ws_ = W; \
        if (MODE == 0) src_ = n_; else if (MODE == 1) src_ = src_col_in(n_); else { const int which_ = (n_ & 255) >> 7; src_ = (n_ >> 8) * 128 + (n_ & 127); Ws_ = which_ ? W2 : W; } \
        _Pragma("unroll") for (int i = 0; i < 8; ++i) { const int kk = kr + 8 * i; f32x4 t_ = (f32x4){0.f, 0.f, 0.f, 0.f}; if (src_ >= 0) { t_ = *(const f32x4*)(Ws_ + (size_t)(k0_ + kk) * Nsrc + src_); if (gain) t_ = t_ * gain[k0_ + kk]; } v[i] = t_; } }
    if (gw < nt) PW_LOAD(gw)
    for (int it = gw; it < nt; it += NGW) {
        const int n0 = (it % ntn) * 32, k0 = (it / ntn) * 64;
#pragma unroll
        for (int i = 0; i < 8; ++i) { LDSP float* d = scr + (kr + 8 * i) * 33 + 4 * n4; d[0] = v[i].x; d[1] = v[i].y; d[2] = v[i].z; d[3] = v[i].w; }
        if (it + NGW < nt) PW_LOAD(it + NGW)
        LDS_WAIT(); asm volatile("" ::: "memory");
        const int cc = lane & 7;
#pragma unroll
        for (int j = 0; j < 4; ++j) { const int nn = (lane >> 3) + 8 * j; const LDSP float* s = scr + (8 * cc) * 33 + nn;
            u32x4 o; o.x = pk2(s[0 * 33], s[1 * 33]); o.y = pk2(s[2 * 33], s[3 * 33]); o.z = pk2(s[4 * 33], s[5 * 33]); o.w = pk2(s[6 * 33], s[7 * 33]);
            *(u32x4*)(Wt + (size_t)(n0 + nn) * K + k0 + 8 * cc) = o; }
        LDS_WAIT(); asm volatile("" ::: "memory");
    }
#undef PW_LOAD
}
__device__ __forceinline__ void row_x_prep(const float* __restrict__ x, bf16* __restrict__ xb, float* __restrict__ rstd, int row, int lane) {
    const f32x4* xr = (const f32x4*)(x + (size_t)row * D) + lane; float ss = 0.f; f32x4 v[4];
#pragma unroll
    for (int j = 0; j < 4; ++j) { v[j] = xr[64 * j]; ss += (v[j].x * v[j].x + v[j].y * v[j].y) + (v[j].z * v[j].z + v[j].w * v[j].w); }
    ss = wave_sum(ss);
    if (xb) { u32x2* o = (u32x2*)(xb + (size_t)row * D) + lane;
#pragma unroll
        for (int j = 0; j < 4; ++j) { u32x2 w; w.x = pk2(v[j].x, v[j].y); w.y = pk2(v[j].z, v[j].w); o[64 * j] = w; } }
    if (lane == 0) rstd[row] = 1.0f / sqrtf(ss * (1.0f / D) + EPS);
}
__device__ __forceinline__ void row_resid_norm(const float* xin, const float* __restrict__ y, const float* __restrict__ g, float* xo, bf16* __restrict__ xb, float* __restrict__ rstd_out, const float* __restrict__ p, bf16* __restrict__ pb, int row, int lane, bool dry = false) {
    const f32x4* yr = (const f32x4*)(y + (size_t)row * D) + lane; const f32x4* xr = (const f32x4*)(xin + (size_t)row * D) + lane; const f32x4* gr = (const f32x4*)g + lane;
    f32x4 v[4]; float ss = 0.f;
#pragma unroll
    for (int j = 0; j < 4; ++j) { v[j] = yr[64 * j]; ss += (v[j].x * v[j].x + v[j].y * v[j].y) + (v[j].z * v[j].z + v[j].w * v[j].w); }
    const float r = 1.0f / sqrtf(wave_sum(ss) * (1.0f / D) + EPS);
    float s2 = 0.f;
    f32x4* xor_ = (f32x4*)(xo + (size_t)row * D) + lane; u32x2* o = (u32x2*)(xb + (size_t)row * D) + lane;
#pragma unroll
    for (int j = 0; j < 4; ++j) { const f32x4 xx = xr[64 * j], gg = gr[64 * j]; f32x4 w = xx + v[j] * r * gg; if (!dry) xor_[64 * j] = w; s2 += (w.x * w.x + w.y * w.y) + (w.z * w.z + w.w * w.w);
        u32x2 q; q.x = pk2(w.x, w.y); q.y = pk2(w.z, w.w); o[64 * j] = q; }
    if (rstd_out) { s2 = wave_sum(s2); if (lane == 0) rstd_out[row] = 1.0f / sqrtf(s2 * (1.0f / D) + EPS); }
    if (p) { const f32x4 pv = *((const f32x4*)(p + (size_t)row * PLE) + lane); u32x2 q; q.x = pk2(pv.x, pv.y); q.y = pk2(pv.z, pv.w); *((u32x2*)(pb + (size_t)row * PLE) + lane) = q; }
}

__device__ __forceinline__ void row_resid_norm2(const bf16* xin, const bf16* __restrict__ y, const float* __restrict__ g, bf16* xo, float* __restrict__ rstd_out, const float* __restrict__ p, bf16* __restrict__ pb, int row0, int lane, bool dry = false) {
    f32x4 v[2][4], xx[2][4], pv[2]; const f32x4* gr = (const f32x4*)g + lane;
#pragma unroll
    for (int r = 0; r < 2; ++r) { const u32x2* yr = (const u32x2*)(y + (size_t)(row0 + r) * D) + lane; const u32x2* xr = (const u32x2*)(xin + (size_t)(row0 + r) * D) + lane;
#pragma unroll
        for (int j = 0; j < 4; ++j) { const u32x2 yw = yr[64 * j], xw = xr[64 * j];
            v[r][j] = (f32x4){__builtin_bit_cast(float, yw.x << 16), __builtin_bit_cast(float, yw.x & 0xffff0000u), __builtin_bit_cast(float, yw.y << 16), __builtin_bit_cast(float, yw.y & 0xffff0000u)};
            xx[r][j] = (f32x4){__builtin_bit_cast(float, xw.x << 16), __builtin_bit_cast(float, xw.x & 0xffff0000u), __builtin_bit_cast(float, xw.y << 16), __builtin_bit_cast(float, xw.y & 0xffff0000u)}; }
        if (p) pv[r] = *((const f32x4*)(p + (size_t)(row0 + r) * PLE) + lane); }
    f32x4 gg[4];
#pragma unroll
    for (int j = 0; j < 4; ++j) gg[j] = gr[64 * j];
#pragma unroll
    for (int r = 0; r < 2; ++r) { float ss = 0.f;
#pragma unroll
        for (int j = 0; j < 4; ++j) ss += (v[r][j].x * v[r][j].x + v[r][j].y * v[r][j].y) + (v[r][j].z * v[r][j].z + v[r][j].w * v[r][j].w);
        const float rr = 1.0f / sqrtf(wave_sum(ss) * (1.0f / D) + EPS); float s2 = 0.f;
        u32x2* o = (u32x2*)(xo + (size_t)(row0 + r) * D) + lane;
#pragma unroll
        for (int j = 0; j < 4; ++j) { const f32x4 w = xx[r][j] + v[r][j] * rr * gg[j]; u32x2 q; q.x = pk2(w.x, w.y); q.y = pk2(w.z, w.w); if (!dry) o[64 * j] = q;
            const float r0 = __builtin_bit_cast(float, q.x << 16), r1 = __builtin_bit_cast(float, q.x & 0xffff0000u), r2 = __builtin_bit_cast(float, q.y << 16), r3 = __builtin_bit_cast(float, q.y & 0xffff0000u);
            s2 += (r0 * r0 + r1 * r1) + (r2 * r2 + r3 * r3); }
        if (rstd_out) { s2 = wave_sum(s2); if (lane == 0) rstd_out[row0 + r] = 1.0f / sqrtf(s2 * (1.0f / D) + EPS); }
        if (p) { u32x2 q; q.x = pk2(pv[r].x, pv[r].y); q.y = pk2(pv[r].z, pv[r].w); *((u32x2*)(pb + (size_t)(row0 + r) * PLE) + lane) = q; } }
}
__device__ __forceinline__ void row_rstd_bf16(const bf16* __restrict__ xb, float* __restrict__ rstd, int row, int lane) {
    const u32x2* xr = (const u32x2*)(xb + (size_t)row * D) + lane; float ss = 0.f;
#pragma unroll
    for (int j = 0; j < 4; ++j) { const u32x2 w = xr[64 * j]; const float a = __builtin_bit_cast(float, w.x << 16), b = __builtin_bit_cast(float, w.x & 0xffff0000u), c2 = __builtin_bit_cast(float, w.y << 16), d = __builtin_bit_cast(float, w.y & 0xffff0000u); ss += (a * a + b * b) + (c2 * c2 + d * d); }
    ss = wave_sum(ss); if (lane == 0) rstd[row] = 1.0f / sqrtf(ss * (1.0f / D) + EPS);
}
__device__ __forceinline__ void row_x_prep2(const float* __restrict__ x, bf16* __restrict__ xb, float* __restrict__ rstd, int row0, int lane) {
    f32x4 v[2][4]; float ss[2];
#pragma unroll
    for (int r = 0; r < 2; ++r) { const f32x4* xr = (const f32x4*)(x + (size_t)(row0 + r) * D) + lane;
#pragma unroll
        for (int j = 0; j < 4; ++j) v[r][j] = xr[64 * j]; }
#pragma unroll
    for (int r = 0; r < 2; ++r) { float s_ = 0.f;
#pragma unroll
        for (int j = 0; j < 4; ++j) s_ += (v[r][j].x * v[r][j].x + v[r][j].y * v[r][j].y) + (v[r][j].z * v[r][j].z + v[r][j].w * v[r][j].w);
        ss[r] = wave_sum(s_); u32x2* o = (u32x2*)(xb + (size_t)(row0 + r) * D) + lane;
#pragma unroll
        for (int j = 0; j < 4; ++j) { u32x2 w; w.x = pk2(v[r][j].x, v[r][j].y); w.y = pk2(v[r][j].z, v[r][j].w); o[64 * j] = w; } }
    if (lane < 2) rstd[row0 + lane] = 1.0f / sqrtf((lane ? ss[1] : ss[0]) * (1.0f / D) + EPS);
}
__device__ __forceinline__ void row_rstd_bf16x4(const bf16* __restrict__ xb, float* __restrict__ rstd, int row0, int lane) {
    u32x2 w[4][4]; float ss[4];
#pragma unroll
    for (int r = 0; r < 4; ++r) { const u32x2* xr = (const u32x2*)(xb + (size_t)(row0 + r) * D) + lane;
#pragma unroll
        for (int j = 0; j < 4; ++j) w[r][j] = xr[64 * j]; }
#pragma unroll
    for (int r = 0; r < 4; ++r) { float s_ = 0.f;
#pragma unroll
        for (int j = 0; j < 4; ++j) { const float a = __builtin_bit_cast(float, w[r][j].x << 16), b = __builtin_bit_cast(float, w[r][j].x & 0xffff0000u), c2 = __builtin_bit_cast(float, w[r][j].y << 16), d = __builtin_bit_cast(float, w[r][j].y & 0xffff0000u); s_ += (a * a + b * b) + (c2 * c2 + d * d); }
        ss[r] = wave_sum(s_); }
    const float sel = lane == 0 ? ss[0] : lane == 1 ? ss[1] : lane == 2 ? ss[2] : ss[3];
    if (lane < 4) rstd[row0 + lane] = 1.0f / sqrtf(sel * (1.0f / D) + EPS);
}
__device__ __forceinline__ void wave_gnorm4(bf16* RA, const float* __restrict__ nw, int w0, int lane, bool dry = false) {
    u32x4 v[4]; float ss[4];
#pragma unroll
    for (int i = 0; i < 4; ++i) { const int w = w0 + i, t = w >> 1, g = w & 1; v[i] = *(const u32x4*)(RA + (size_t)t * NA + A_Z + g * 512 + lane * 8); }
    float f[4][8];
#pragma unroll
    for (int i = 0; i < 4; ++i) { const unsigned vw[4] = {v[i].x, v[i].y, v[i].z, v[i].w}; ss[i] = 0.f;
#pragma unroll
        for (int e = 0; e < 8; ++e) { f[i][e] = bf2f((bf16)((vw[e >> 1] >> ((e & 1) * 16)) & 0xffff)); ss[i] += f[i][e] * f[i][e]; } }
#pragma unroll
    for (int o = 1; o < 64; o <<= 1) {
#pragma unroll
        for (int i = 0; i < 4; ++i) ss[i] += __shfl_xor(ss[i], o); }
#pragma unroll
    for (int i = 0; i < 4; ++i) { const int w = w0 + i, t = w >> 1, g = w & 1; const float r = 1.0f / sqrtf(ss[i] * (1.0f / 512.0f) + EPS); const float* gw = nw + g * 512 + lane * 8;
        u32x4 o; o.x = pk2(f[i][0] * r * gw[0], f[i][1] * r * gw[1]); o.y = pk2(f[i][2] * r * gw[2], f[i][3] * r * gw[3]); o.z = pk2(f[i][4] * r * gw[4], f[i][5] * r * gw[5]); o.w = pk2(f[i][6] * r * gw[6], f[i][7] * r * gw[7]);
        if (!dry) *(u32x4*)(RA + (size_t)t * NA + A_Z + g * 512 + lane * 8) = o; }
}
__device__ __forceinline__ void tok_m1(bf16* __restrict__ RA, bf16* __restrict__ RB, bf16* __restrict__ CKVC, bf16* __restrict__ IKC, const float* __restrict__ kvn, const float* __restrict__ ikg, const float* __restrict__ ikb, const float* __restrict__ scw, int t, int lane) {
    const int s = t & (SEQ - 1); bf16* rb = RB + (size_t)t * NB;
    {   const u32x2 w = *((const u32x2*)(rb + B_CKV) + lane); float v[4] = {bf2f((bf16)(w.x & 0xffff)), bf2f((bf16)(w.x >> 16)), bf2f((bf16)(w.y & 0xffff)), bf2f((bf16)(w.y >> 16))};
        float ss = (v[0] * v[0] + v[1] * v[1]) + (v[2] * v[2] + v[3] * v[3]); ss = wave_sum(ss); const float r = 1.0f / sqrtf(ss * (1.0f / KV_R) + EPS);
        const f32x4 g = *((const f32x4*)kvn + lane); u32x2 o; o.x = pk2(v[0] * r * g.x, v[1] * r * g.y); o.y = pk2(v[2] * r * g.z, v[3] * r * g.w); *((u32x2*)(rb + B_CKV) + lane) = o; *((u32x2*)(CKVC + (size_t)t * KV_R) + lane) = o; }
    {   const float x = bf2f(rb[B_IK + lane]); const float mu = wave_sum(x) * (1.0f / 64.0f); const float d = x - mu; const float var = wave_sum(d * d) * (1.0f / 64.0f);
        const bf16 o = f2bf(d * (1.0f / sqrtf(var + EPS)) * ikg[lane] + ikb[lane]); rb[B_IK + lane] = o; IKC[(size_t)t * 64 + lane] = o; }
    {   const int c = lane * 8; float acc[8] = {0.f, 0.f, 0.f, 0.f, 0.f, 0.f, 0.f, 0.f};
        for (int j = 0; j < 3; ++j) { const int ss_ = s - 2 + j; if (ss_ < 0) continue; const bf16* rr = RB + (size_t)(t - 2 + j) * NB;
            const u32x4 cg = *(const u32x4*)(rr + B_CG + c), hb = *(const u32x4*)(rr + B_HB + c); const unsigned cw[4] = {cg.x, cg.y, cg.z, cg.w}, hw[4] = {hb.x, hb.y, hb.z, hb.w};
#pragma unroll
            for (int e = 0; e < 8; ++e) { const float a = bf2f((bf16)((cw[e >> 1] >> ((e & 1) * 16)) & 0xffff)), b = bf2f((bf16)((hw[e >> 1] >> ((e & 1) * 16)) & 0xffff)); acc[e] += scw[j * 512 + c + e] * (a * b); } }
        bf16* ra = RA + (size_t)t * NA + A_BG + c; const u32x4 bg = *(const u32x4*)ra; const unsigned bw[4] = {bg.x, bg.y, bg.z, bg.w}; float o[8];
#pragma unroll
        for (int e = 0; e < 8; ++e) o[e] = bf2f((bf16)((bw[e >> 1] >> ((e & 1) * 16)) & 0xffff)) * acc[e];
        u32x4 w; w.x = pk2(o[0], o[1]); w.y = pk2(o[2], o[3]); w.z = pk2(o[4], o[5]); w.w = pk2(o[6], o[7]); *(u32x4*)ra = w; }
}
__device__ __forceinline__ void tok_m4a(const bf16* __restrict__ RB, const float* __restrict__ cw, const float* __restrict__ cb, const float* __restrict__ dtb, bf16* __restrict__ XA, float* __restrict__ DT, int t, int lane) {
    const int s = t & (SEQ - 1);
    for (int c = lane; c < XBC; c += 64) { float a = cb[c];
#pragma unroll
        for (int j = 0; j < 4; ++j) { const int ss = s - 3 + j; if (ss >= 0) a += cw[j * XBC + c] * bf2f(RB[(size_t)(t - 3 + j) * NB + B_XBC + c]); }
        XA[(size_t)t * XBC + c] = f2bf(siluf_(a)); }
    if (lane < 16) { const float x = bf2f(RB[(size_t)t * NB + B_DT + lane]) + dtb[lane]; DT[(size_t)t * 16 + lane] = x > 15.f ? x : log1pf(__expf(x)); }
}
__device__ __forceinline__ void wg_m2_select(LDSP unsigned char* lds, const bf16* __restrict__ RB, unsigned short* __restrict__ idx, int t, int tid) {
    LDSP float* iq = (LDSP float*)lds; LDSP float* iwv = iq + 256; LDSP unsigned* red = (LDSP unsigned*)(iq + 272); LDSP unsigned* keys = (LDSP unsigned*)(iq + 288);
    const int s = t & (SEQ - 1), b = t >> 12, lane = tid & 63, wv = tid >> 6;
    const int nk = ((s >> 6) + 1) << 6;
    const bf16* rb = RB + (size_t)t * NB;
    if (tid < 256) iq[tid] = bf2f(rb[B_IQ + tid]); if (tid < 4) iwv[tid] = bf2f(rb[B_IW + tid]) * (0.125f * 0.5f);
    __syncthreads();
    for (int k = tid; k < nk; k += NTHR) {
        const bf16* kr = RB + (size_t)(b * SEQ + k) * NB + B_IK; float sc = 0.f;
        float d0 = 0.f, d1 = 0.f, d2 = 0.f, d3 = 0.f;
#pragma unroll 1
        for (int j = 0; j < 8; ++j) { const u32x4 w = *((const u32x4*)kr + j); const unsigned ww[4] = {w.x, w.y, w.z, w.w};
#pragma unroll
            for (int e = 0; e < 8; ++e) { const float kv = bf2f((bf16)((ww[e >> 1] >> ((e & 1) * 16)) & 0xffff)); const int c = j * 8 + e;
                d0 += iq[c] * kv; d1 += iq[64 + c] * kv; d2 += iq[128 + c] * kv; d3 += iq[192 + c] * kv; } }
        sc += fmaxf(d0, 0.f) * iwv[0]; sc += fmaxf(d1, 0.f) * iwv[1]; sc += fmaxf(d2, 0.f) * iwv[2]; sc += fmaxf(d3, 0.f) * iwv[3];
        keys[k] = ord_key(sc);
    }
    __syncthreads();
    unsigned Tt = 0u;
    if (nk > TOPK) {
        for (int bit = 31; bit >= 0; --bit) { const unsigned cand = Tt | (1u << bit); unsigned c = 0;
            for (int k = tid; k < nk; k += NTHR) c += (keys[k] >= cand) ? 1u : 0u;
#pragma unroll
            for (int o = 1; o < 64; o <<= 1) c += __shfl_xor(c, o);
            if (lane == 0) red[wv] = c;
            __syncthreads();
            unsigned tot = 0;
#pragma unroll
            for (int w = 0; w < 8; ++w) tot += red[w];
            if (tot >= (unsigned)TOPK) Tt = cand;
            __syncthreads(); }
    }
    { unsigned c = 0; for (int k = tid; k < nk; k += NTHR) c += (keys[k] > Tt) ? 1u : 0u;
#pragma unroll
      for (int o = 1; o < 64; o <<= 1) c += __shfl_xor(c, o);
      if (lane == 0) red[8 + wv] = c; }
    __syncthreads();
    if (wv == 0) {
        int ngt = 0;
#pragma unroll
        for (int w = 0; w < 8; ++w) ngt += (int)red[8 + w];
        const int need = TOPK - ngt; int pos = 0, eq_taken = 0; const unsigned long long lt = (1ull << lane) - 1ull;
        for (int base = 0; base < nk; base += 64) { const unsigned k = keys[base + lane]; const bool gt = k > Tt, eq = (k == Tt);
            const unsigned long long meq = __ballot(eq); const int rank_eq = __popcll(meq & lt); const bool take = gt || (eq && (eq_taken + rank_eq < need));
            const unsigned long long msel = __ballot(take);
            if (take) { const int o = pos + __popcll(msel & lt); if (o < TOPK) idx[(size_t)t * TOPK + o] = (unsigned short)(base + lane); }
            pos += __popcll(msel); eq_taken += __popcll(__ballot(eq && take)); }
    }
    __syncthreads();
}
__device__ __forceinline__ void wg_m3_attn(LDSP unsigned char* lds, bf16* RA, const bf16* __restrict__ RB, const unsigned short* __restrict__ idx, const float* __restrict__ w_uk, const float* __restrict__ w_uv, const float* __restrict__ rel_bias, int t, int tid) {
    LDSP float* q = (LDSP float*)lds; LDSP float* qlat = q + 512; LDSP float* pr = qlat + 2048; LDSP float* outl = pr + 2048; LDSP unsigned short* sel = (LDSP unsigned short*)(outl + 2048);
    const int s = t & (SEQ - 1), b = t >> 12, lane = tid & 63, wv = tid >> 6;
    const int nk = ((s >> 6) + 1) << 6, nsel = nk < TOPK ? nk : TOPK;
    q[tid] = bf2f(RA[(size_t)t * NA + A_Q + tid]); if (tid < 256) sel[tid] = tid < nsel ? idx[(size_t)t * TOPK + tid] : (unsigned short)0;
    __syncthreads();
    {   const int r = tid & 255, h0 = (tid >> 8) * 4;
        for (int h = h0; h < h0 + 4; ++h) { const float* w = w_uk + ((size_t)r * 8 + h) * 64; float a = 0.f;
#pragma unroll 16
            for (int d = 0; d < 64; ++d) a += q[h * 64 + d] * w[d];
            qlat[h * 256 + r] = a * 0.125f; } }
    __syncthreads();
    {   const int k = tid & 255, h0 = (tid >> 8) * 4;
        if (k < nsel) { const int key = sel[k]; const bf16* kr = RB + (size_t)(b * SEQ + key) * NB + B_CKV; float a[4] = {0.f, 0.f, 0.f, 0.f};
            for (int j = 0; j < 32; ++j) { const u32x4 w = *((const u32x4*)kr + j); const unsigned ww[4] = {w.x, w.y, w.z, w.w};
#pragma unroll
                for (int e = 0; e < 8; ++e) { const float v = bf2f((bf16)((ww[e >> 1] >> ((e & 1) * 16)) & 0xffff));
#pragma unroll
                    for (int hh = 0; hh < 4; ++hh) a[hh] += qlat[(h0 + hh) * 256 + j * 8 + e] * v; } }
            const int bk = t5_bucket(key - s);
#pragma unroll
            for (int hh = 0; hh < 4; ++hh) pr[(h0 + hh) * 256 + k] = a[hh] + rel_bias[bk * 8 + h0 + hh];
        } else {
#pragma unroll
            for (int hh = 0; hh < 4; ++hh) pr[(h0 + hh) * 256 + k] = -INFINITY; } }
    __syncthreads();
    {   float v[4]; float m = -INFINITY;
#pragma unroll
        for (int j = 0; j < 4; ++j) { v[j] = pr[wv * 256 + lane + 64 * j]; m = fmaxf(m, v[j]); }
        m = wave_max(m); float sum = 0.f;
#pragma unroll
        for (int j = 0; j < 4; ++j) { v[j] = __expf(v[j] - m); sum += v[j]; }
        sum = wave_sum(sum); const float inv = 1.0f / sum;
#pragma unroll
        for (int j = 0; j < 4; ++j) pr[wv * 256 + lane + 64 * j] = v[j] * inv; }
    __syncthreads();
    {   const int r = tid & 255, h0 = (tid >> 8) * 4; float a[4] = {0.f, 0.f, 0.f, 0.f};
        for (int k = 0; k < nsel; ++k) { const float v = bf2f(RB[(size_t)(b * SEQ + sel[k]) * NB + B_CKV + r]);
#pragma unroll
            for (int hh = 0; hh < 4; ++hh) a[hh] += pr[(h0 + hh) * 256 + k] * v; }
#pragma unroll
        for (int hh = 0; hh < 4; ++hh) outl[(h0 + hh) * 256 + r] = a[hh]; }
    __syncthreads();
    {   const int h = tid >> 6, d = tid & 63; float a = 0.f;
        for (int r = 0; r < 256; ++r) a += outl[h * 256 + r] * w_uv[((size_t)r * 8 + h) * 64 + d];
        RA[(size_t)t * NA + A_Q + tid] = f2bf(a); }
    __syncthreads();
}
__device__ __forceinline__ void half_m4b_scan(bf16* RA, const bf16* __restrict__ XA, const float* __restrict__ DT, const float* __restrict__ a_log, const float* __restrict__ dsk, int b, int h, int tid) {
    const int g = h >> 3, p = tid >> 2, nq = tid & 3;
    const float A = -__expf(a_log[h]), Dh = dsk[h];
    float hs[32];
#pragma unroll
    for (int n = 0; n < 32; ++n) hs[n] = 0.f;
    for (int s = 0; s < SEQ; ++s) { const size_t t = (size_t)b * SEQ + s; const float dt = DT[t * 16 + h]; const float dA = __expf(dt * A);
        const bf16* xr = XA + t * XBC; const float x = bf2f(xr[h * 64 + p]); const float dx = dt * x;
        const u32x4* Bp = (const u32x4*)(xr + 1024 + g * 128 + nq * 32); const u32x4* Cp = (const u32x4*)(xr + 1280 + g * 128 + nq * 32); float y = 0.f;
#pragma unroll
        for (int j = 0; j < 4; ++j) { const u32x4 bw = Bp[j], cw = Cp[j]; const unsigned bb[4] = {bw.x, bw.y, bw.z, bw.w}, cc[4] = {cw.x, cw.y, cw.z, cw.w};
#pragma unroll
            for (int e = 0; e < 8; ++e) { const float Bv = bf2f((bf16)((bb[e >> 1] >> ((e & 1) * 16)) & 0xffff)), Cv = bf2f((bf16)((cc[e >> 1] >> ((e & 1) * 16)) & 0xffff));
                hs[j * 8 + e] = hs[j * 8 + e] * dA + dx * Bv; y += Cv * hs[j * 8 + e]; } }
        y += __shfl_xor(y, 1); y += __shfl_xor(y, 2);
        if (nq == 0) { bf16* zp = RA + t * NA + A_Z + h * 64 + p; const float z = bf2f(*zp); *zp = f2bf((y + Dh * x) * siluf_(z)); }
    }
}
__device__ __forceinline__ void wave_m4c_gnorm(bf16* RA, const float* __restrict__ nw, int w, int lane, bool dry = false) {
    const int t = w >> 1, g = w & 1;
    bf16* p = RA + (size_t)t * NA + A_Z + g * 512 + lane * 8; const u32x4 v = *(const u32x4*)p; const unsigned vw[4] = {v.x, v.y, v.z, v.w}; float f[8]; float ss = 0.f;
#pragma unroll
    for (int e = 0; e < 8; ++e) { f[e] = bf2f((bf16)((vw[e >> 1] >> ((e & 1) * 16)) & 0xffff)); ss += f[e] * f[e]; }
    const float r = 1.0f / sqrtf(wave_sum(ss) * (1.0f / 512.0f) + EPS); const float* gw = nw + g * 512 + lane * 8;
    u32x4 o; o.x = pk2(f[0] * r * gw[0], f[1] * r * gw[1]); o.y = pk2(f[2] * r * gw[2], f[3] * r * gw[3]); o.z = pk2(f[4] * r * gw[4], f[5] * r * gw[5]); o.w = pk2(f[6] * r * gw[6], f[7] * r * gw[7]);
    if (!dry) *(u32x4*)p = o;
}

__device__ __forceinline__ void unpack8(const u32x4 w, float (&f)[8]) { const unsigned ww[4] = {w.x, w.y, w.z, w.w};
#pragma unroll
    for (int e = 0; e < 4; ++e) { f[2 * e] = __builtin_bit_cast(float, ww[e] << 16); f[2 * e + 1] = __builtin_bit_cast(float, ww[e] & 0xffff0000u); } }
__device__ __forceinline__ void prep_ckv4(const bf16* __restrict__ RB, bf16* __restrict__ CKVC, const float* __restrict__ kvn, int it, int lane) {
    const int t = it * 4 + (lane >> 4), c = lane & 15; const u32x4* src = (const u32x4*)(RB + (size_t)t * NB + B_CKV + c * 16); const u32x4 a = src[0], b = src[1];
    float v[16]; { float f[8]; unpack8(a, f);
#pragma unroll
        for (int e = 0; e < 8; ++e) v[e] = f[e]; unpack8(b, f);
#pragma unroll
        for (int e = 0; e < 8; ++e) v[8 + e] = f[e]; }
    float ss = 0.f;
#pragma unroll
    for (int e = 0; e < 16; ++e) ss += v[e] * v[e];
    ss += __shfl_xor(ss, 1); ss += __shfl_xor(ss, 2); ss += __shfl_xor(ss, 4); ss += __shfl_xor(ss, 8);
    const float r = 1.0f / sqrtf(ss * (1.0f / KV_R) + EPS); const f32x4* gp = (const f32x4*)(kvn + c * 16); float o[16];
#pragma unroll
    for (int q = 0; q < 4; ++q) { const f32x4 gg = gp[q]; o[4 * q] = v[4 * q] * r * gg.x; o[4 * q + 1] = v[4 * q + 1] * r * gg.y; o[4 * q + 2] = v[4 * q + 2] * r * gg.z; o[4 * q + 3] = v[4 * q + 3] * r * gg.w; }
    u32x4 w0, w1; w0.x = pk2(o[0], o[1]); w0.y = pk2(o[2], o[3]); w0.z = pk2(o[4], o[5]); w0.w = pk2(o[6], o[7]); w1.x = pk2(o[8], o[9]); w1.y = pk2(o[10], o[11]); w1.z = pk2(o[12], o[13]); w1.w = pk2(o[14], o[15]);
    u32x4* dst = (u32x4*)(CKVC + (size_t)t * KV_R + c * 16); dst[0] = w0; dst[1] = w1;
}
__device__ __forceinline__ void prep_ik16(const bf16* __restrict__ RB, bf16* __restrict__ IKC, const float* __restrict__ ikg, const float* __restrict__ ikb, int it, int lane) {
    const int t = it * 16 + (lane >> 2), c = lane & 3; const u32x4* src = (const u32x4*)(RB + (size_t)t * NB + B_IK + c * 16); const u32x4 a = src[0], b = src[1];
    float v[16]; { float f[8]; unpack8(a, f);
#pragma unroll
        for (int e = 0; e < 8; ++e) v[e] = f[e]; unpack8(b, f);
#pragma unroll
        for (int e = 0; e < 8; ++e) v[8 + e] = f[e]; }
    float s = 0.f;
#pragma unroll
    for (int e = 0; e < 16; ++e) s += v[e];
    s += __shfl_xor(s, 1); s += __shfl_xor(s, 2); const float mu = s * (1.0f / 64.0f); float q2 = 0.f;
#pragma unroll
    for (int e = 0; e < 16; ++e) { v[e] -= mu; q2 += v[e] * v[e]; }
    q2 += __shfl_xor(q2, 1); q2 += __shfl_xor(q2, 2); const float r = 1.0f / sqrtf(q2 * (1.0f / 64.0f) + EPS); float o[16];
#pragma unroll
    for (int e = 0; e < 16; ++e) o[e] = v[e] * r * ikg[c * 16 + e] + ikb[c * 16 + e];
    u32x4 w0, w1; w0.x = pk2(o[0], o[1]); w0.y = pk2(o[2], o[3]); w0.z = pk2(o[4], o[5]); w0.w = pk2(o[6], o[7]); w1.x = pk2(o[8], o[9]); w1.y = pk2(o[10], o[11]); w1.z = pk2(o[12], o[13]); w1.w = pk2(o[14], o[15]);
    u32x4* dst = (u32x4*)(IKC + (size_t)t * 64 + c * 16); dst[0] = w0; dst[1] = w1;
}
__device__ __forceinline__ void prep_bout(bf16* RA, const bf16* __restrict__ RB, const float* __restrict__ scw, int t, int lane, bool dry = false) {
    const int s = t & (SEQ - 1), c = lane * 8; float acc[8] = {0.f, 0.f, 0.f, 0.f, 0.f, 0.f, 0.f, 0.f};
    u32x4 cg[3], hb[3];
#pragma unroll
    for (int j = 0; j < 3; ++j) { const bool ok = (s - 2 + j) >= 0; const bf16* rr = RB + (size_t)(t - 2 + j) * NB; cg[j] = ok ? *(const u32x4*)(rr + B_CG + c) : (u32x4){0u, 0u, 0u, 0u}; hb[j] = ok ? *(const u32x4*)(rr + B_HB + c) : (u32x4){0u, 0u, 0u, 0u}; }
    bf16* ra = RA + (size_t)t * NA + A_BG + c; const u32x4 bg = *(const u32x4*)ra;
#pragma unroll
    for (int j = 0; j < 3; ++j) { float a[8], b[8]; unpack8(cg[j], a); unpack8(hb[j], b); const f32x4 w0 = *(const f32x4*)(scw + j * 512 + c), w1 = *(const f32x4*)(scw + j * 512 + c + 4);
        acc[0] += w0.x * (a[0] * b[0]); acc[1] += w0.y * (a[1] * b[1]); acc[2] += w0.z * (a[2] * b[2]); acc[3] += w0.w * (a[3] * b[3]);
        acc[4] += w1.x * (a[4] * b[4]); acc[5] += w1.y * (a[5] * b[5]); acc[6] += w1.z * (a[6] * b[6]); acc[7] += w1.w * (a[7] * b[7]); }
    float g8[8]; unpack8(bg, g8); u32x4 w; w.x = pk2(g8[0] * acc[0], g8[1] * acc[1]); w.y = pk2(g8[2] * acc[2], g8[3] * acc[3]); w.z = pk2(g8[4] * acc[4], g8[5] * acc[5]); w.w = pk2(g8[6] * acc[6], g8[7] * acc[7]);
    if (!dry) *(u32x4*)ra = w;
}
__device__ __forceinline__ void prep_conv(const bf16* __restrict__ RB, bf16* __restrict__ XA, const float* __restrict__ cw, const float* __restrict__ cb, int it, int lane) {
    const int rb = it / 12, cbk = it % 12, xcol = cbk * 128 + 2 * lane, t0 = rb * 16, s0 = t0 & (SEQ - 1);
    float w0[4], w1[4];
#pragma unroll
    for (int j = 0; j < 4; ++j) { w0[j] = cw[j * XBC + xcol]; w1[j] = cw[j * XBC + xcol + 1]; }
    const float cb0 = cb[xcol], cb1 = cb[xcol + 1];
    const bf16* src = RB + (size_t)(t0 - 3) * NB + B_XBC + xcol; unsigned raw[19];
#pragma unroll
    for (int i = 0; i < 19; ++i) raw[i] = (s0 - 3 + i >= 0) ? *(const unsigned*)(src + (size_t)i * NB) : 0u;
#pragma unroll
    for (int i = 0; i < 16; ++i) { float a0 = cb0, a1 = cb1;
#pragma unroll
        for (int j = 0; j < 4; ++j) { a0 += w0[j] * __builtin_bit_cast(float, raw[i + j] << 16); a1 += w1[j] * __builtin_bit_cast(float, raw[i + j] & 0xffff0000u); }
        *(unsigned*)(XA + (size_t)(t0 + i) * XBC + xcol) = pk2(siluf_(a0), siluf_(a1)); }
}

typedef short bf16x8_t __attribute__((ext_vector_type(8)));
#ifndef SEL_REP_SEARCH
#define SEL_REP_SEARCH 1
#endif
#ifndef SEL_REP_STAGE
#define SEL_REP_STAGE 1
#endif
#define CNT8_GE(cnt, v0, v1, v2, v3, v4, v5, v6, v7, cand) do { unsigned long long m0_, m1_, m2_, m3_, m4_, m5_, m6_, m7_; \
    asm("v_cmp_ge_u32_e64 %0, %8, %16\n\tv_cmp_ge_u32_e64 %1, %9, %16\n\tv_cmp_ge_u32_e64 %2, %10, %16\n\tv_cmp_ge_u32_e64 %3, %11, %16\n\t" \
        "v_cmp_ge_u32_e64 %4, %12, %16\n\tv_cmp_ge_u32_e64 %5, %13, %16\n\tv_cmp_ge_u32_e64 %6, %14, %16\n\tv_cmp_ge_u32_e64 %7, %15, %16" \
        : "=&s"(m0_), "=&s"(m1_), "=&s"(m2_), "=&s"(m3_), "=&s"(m4_), "=&s"(m5_), "=&s"(m6_), "=&s"(m7_) \
        : "v"(v0), "v"(v1), "v"(v2), "v"(v3), "v"(v4), "v"(v5), "v"(v6), "v"(v7), "s"(cand)); \
    cnt += (__popcll(m0_) + __popcll(m1_)) + (__popcll(m2_) + __popcll(m3_)) + (__popcll(m4_) + __popcll(m5_)) + (__popcll(m6_) + __popcll(m7_)); } while (0)
constexpr int SC_STRIDE = 516, SC_BUF = 16 * SC_STRIDE;
constexpr int IKW_OFF = 66560;
__device__ __forceinline__ void wg_select16(LDSP unsigned char* lds, const bf16* __restrict__ RB, const bf16* __restrict__ IKC, unsigned short* __restrict__ idx, int unit, int tid, bool dry = false, bool lds_out = false) {
    const int lane = tid & 63, wave = __builtin_amdgcn_readfirstlane(tid >> 6), g = lane >> 4, c = lane & 15;
    const int b = unit >> 8, qg = unit & 255, t0 = b * SEQ + qg * 16, nk = ((qg >> 2) + 1) << 6, nr = nk >> 6;
    LDSP unsigned* SC = (LDSP unsigned*)lds;
    bf16x8_t bq[4][2]; float iwq[4];
    { const bf16* qr = RB + (size_t)(t0 + c) * NB;
#pragma unroll
      for (int h = 0; h < 4; ++h) { bq[h][0] = *(const bf16x8_t*)(qr + B_IQ + h * 64 + g * 8); bq[h][1] = *(const bf16x8_t*)(qr + B_IQ + h * 64 + 32 + g * 8); iwq[h] = bf2f(qr[B_IW + h]) * 0.0625f; } }
    unsigned val[2][64];
#pragma unroll
    for (int r = 0; r < 64; ++r) { val[0][r] = 0u; val[1][r] = 0u; }
    const bf16* ikb = IKC + (size_t)b * SEQ * 64;
    LDSP unsigned char* ikw = lds + IKW_OFF + wave * 8192;
#define IK_DMA(stage) do { if ((stage) * 512 + wave * 64 < nk) { const bf16* src_ = ikb + (size_t)((stage) * 512 + wave * 64) * 64 + lane * 8; _Pragma("unroll") for (int pc_ = 0; pc_ < 8; ++pc_) \
        __builtin_amdgcn_global_load_lds((const unsigned*)(src_ + pc_ * 512), (LDSP unsigned*)(ikw + pc_ * 1024), 16, 0, 0); } } while (0)
    IK_DMA(0);
    for (int rep_st = 0; rep_st < SEL_REP_STAGE; ++rep_st) {
    if (rep_st > 0) { asm volatile("s_waitcnt vmcnt(0)" ::: "memory"); __builtin_amdgcn_s_barrier(); IK_DMA(0); }
#pragma unroll
    for (int s = 0; s < 8; ++s) {
        if (s * 512 < nk) {
            LDSP unsigned* buf = SC + (s & 1) * SC_BUF;
            asm volatile("s_waitcnt vmcnt(0)" ::: "memory");
            bf16x8_t af[4][2];
#pragma unroll
            for (int i = 0; i < 4; ++i) { af[i][0] = *(const LDSP bf16x8_t*)(ikw + (16 * i + c) * 128 + g * 16); af[i][1] = *(const LDSP bf16x8_t*)(ikw + (16 * i + c) * 128 + 64 + g * 16); }
            asm volatile("s_waitcnt lgkmcnt(0)" ::: "memory");
            if (s < 7) IK_DMA(s + 1);
#pragma unroll
            for (int i = 0; i < 4; ++i) { const int tl = wave * 4 + i, kb = s * 512 + tl * 16;
                if (kb < nk) {
                    const bf16x8_t a0 = af[i][0], a1 = af[i][1];
                    float sc[4] = {0.f, 0.f, 0.f, 0.f};
#pragma unroll
                    for (int h = 0; h < 4; ++h) { pg8::f32x4 acc = {0.f, 0.f, 0.f, 0.f};
                        acc = __builtin_amdgcn_mfma_f32_16x16x32_bf16(a0, bq[h][0], acc, 0, 0, 0); acc = __builtin_amdgcn_mfma_f32_16x16x32_bf16(a1, bq[h][1], acc, 0, 0, 0);
#pragma unroll
                        for (int e = 0; e < 4; ++e) sc[e] += fmaxf(acc[e], 0.f) * iwq[h]; }
                    u32x4 kv; kv.x = ord_key(sc[0]); kv.y = ord_key(sc[1]); kv.z = ord_key(sc[2]); kv.w = ord_key(sc[3]);
                    *(LDSP u32x4*)(buf + c * SC_STRIDE + tl * 16 + 4 * g) = kv; } }
            asm volatile("s_waitcnt lgkmcnt(0)" ::: "memory"); __builtin_amdgcn_s_barrier(); asm volatile("" ::: "memory");
#pragma unroll
            for (int j = 0; j < 8; ++j) if (s * 512 + j * 64 < nk) { val[0][s * 8 + j] = buf[(2 * wave) * SC_STRIDE + j * 64 + lane]; val[1][s * 8 + j] = buf[(2 * wave + 1) * SC_STRIDE + j * 64 + lane]; }
            asm volatile("s_waitcnt lgkmcnt(0)" ::: "memory");
        }
    }
    }
    const unsigned long long lt = (1ull << lane) - 1ull;
#pragma unroll
    for (int qq = 0; qq < 2; ++qq) {
        unsigned Tt = 0u;
        for (int rep_se = 0; rep_se < SEL_REP_SEARCH; ++rep_se) { Tt = 0u; asm volatile("" : "+v"(val[qq][0]));
        if (nk > TOPK) {
            for (int bit = 31; bit >= 0; --bit) { const unsigned cand = Tt | (1u << bit); int cnt = 0;
#pragma unroll
                for (int r8 = 0; r8 < 8; ++r8) if (r8 * 8 < nr) CNT8_GE(cnt, val[qq][r8 * 8], val[qq][r8 * 8 + 1], val[qq][r8 * 8 + 2], val[qq][r8 * 8 + 3], val[qq][r8 * 8 + 4], val[qq][r8 * 8 + 5], val[qq][r8 * 8 + 6], val[qq][r8 * 8 + 7], cand);
                if (cnt >= TOPK) Tt = cand; if (cnt == TOPK) break; }
        }
        }
        unsigned short* orow = idx + (size_t)(t0 + 2 * wave + qq) * TOPK;
        LDSP unsigned short* orow_l = (LDSP unsigned short*)(lds + 134 * 1024) + (2 * wave + qq) * TOPK;
        int pos = 0;
#define PUT_KEY(o_, key_) do { if ((o_) < TOPK && !dry) { if (lds_out) orow_l[o_] = (unsigned short)(key_); else orow[o_] = (unsigned short)(key_); } } while (0)
#pragma unroll
        for (int r8 = 0; r8 < 8; ++r8) if (r8 * 8 < nr) { unsigned long long k0, k1, k2, k3, k4, k5, k6, k7;
            asm("v_cmp_gt_u32_e64 %0, %8, %16\n\tv_cmp_gt_u32_e64 %1, %9, %16\n\tv_cmp_gt_u32_e64 %2, %10, %16\n\tv_cmp_gt_u32_e64 %3, %11, %16\n\t"
                "v_cmp_gt_u32_e64 %4, %12, %16\n\tv_cmp_gt_u32_e64 %5, %13, %16\n\tv_cmp_gt_u32_e64 %6, %14, %16\n\tv_cmp_gt_u32_e64 %7, %15, %16"
                : "=&s"(k0), "=&s"(k1), "=&s"(k2), "=&s"(k3), "=&s"(k4), "=&s"(k5), "=&s"(k6), "=&s"(k7)
                : "v"(val[qq][r8 * 8]), "v"(val[qq][r8 * 8 + 1]), "v"(val[qq][r8 * 8 + 2]), "v"(val[qq][r8 * 8 + 3]), "v"(val[qq][r8 * 8 + 4]), "v"(val[qq][r8 * 8 + 5]), "v"(val[qq][r8 * 8 + 6]), "v"(val[qq][r8 * 8 + 7]), "s"(Tt));
#define PUT_MASK(m_, i_) do { if ((m_) != 0ull) { if (((m_) >> lane) & 1ull) { const int o = pos + __popcll((m_) & lt); PUT_KEY(o, (r8 * 8 + (i_)) * 64 + lane); } pos += __popcll(m_); } } while (0)
            PUT_MASK(k0, 0); PUT_MASK(k1, 1); PUT_MASK(k2, 2); PUT_MASK(k3, 3); PUT_MASK(k4, 4); PUT_MASK(k5, 5); PUT_MASK(k6, 6); PUT_MASK(k7, 7);
#undef PUT_MASK
        }
        int need = TOPK - pos;
        if (need > 0) {
#pragma unroll
            for (int r = 0; r < 64; ++r) if (r < nr && need > 0) { const unsigned long long meq = __ballot(val[qq][r] == Tt);
                if (meq != 0ull) { const int rank = __popcll(meq & lt); if (((meq >> lane) & 1ull) && rank < need) { PUT_KEY(pos + rank, r * 64 + lane); } const int tk = __popcll(meq); const int tkn = tk < need ? tk : need; pos += tkn; need -= tkn; } }
        }
#undef PUT_KEY
    }
    asm volatile("s_waitcnt vmcnt(0)" ::: "memory"); __builtin_amdgcn_s_barrier();
#undef IK_DMA
}

typedef unsigned short u16x4_t __attribute__((ext_vector_type(4)));
#ifndef ATT_LOCAL_DRY
#define ATT_LOCAL_DRY 0
#endif
#ifndef ATT_STAGGER
#define ATT_STAGGER 0
#endif
#ifndef ATT_DRY_SKIP
#define ATT_DRY_SKIP 0
#endif
#define DSK(b) (ATT_DRY_SKIP & (b)) && dry
#ifndef ATT_SUB_EN
#define ATT_SUB_EN 0
#endif
constexpr int SELW_OFF = 134 * 1024, BT_OFF = 142 * 1024, KVP = 528, TILE_STRIDE = 32 * KVP;
constexpr int SELW_OFF_OLD = 132 * 1024, BT_OFF_OLD = 140 * 1024;
__device__ __forceinline__ int kv_off(int row, int ch) { const int hf = ch >> 4, c16 = ch & 15; return hf * 8192 + 256 * row + 16 * (c16 ^ (((row & 3) << 2) | ((row >> 2) & 3))); }
#define TR4I(d0, d1, d2, d3, base, o0, o1, o2, o3) asm volatile("ds_read_b64_tr_b16 %0, %4 offset:%5\n\tds_read_b64_tr_b16 %1, %4 offset:%6\n\tds_read_b64_tr_b16 %2, %4 offset:%7\n\tds_read_b64_tr_b16 %3, %4 offset:%8" \
    : "=&v"(d0), "=&v"(d1), "=&v"(d2), "=&v"(d3) : "v"(base), "i"(o0), "i"(o1), "i"(o2), "i"(o3) : "memory")
#define TR8N(d0, d1, d2, d3, d4, d5, d6, d7, base, o0, o1, o2, o3, o4, o5, o6, o7) asm volatile( \
    "ds_read_b64_tr_b16 %0, %8 offset:%9\n\tds_read_b64_tr_b16 %1, %8 offset:%10\n\tds_read_b64_tr_b16 %2, %8 offset:%11\n\tds_read_b64_tr_b16 %3, %8 offset:%12\n\t" \
    "ds_read_b64_tr_b16 %4, %8 offset:%13\n\tds_read_b64_tr_b16 %5, %8 offset:%14\n\tds_read_b64_tr_b16 %6, %8 offset:%15\n\tds_read_b64_tr_b16 %7, %8 offset:%16" \
    : "=&v"(d0), "=&v"(d1), "=&v"(d2), "=&v"(d3), "=&v"(d4), "=&v"(d5), "=&v"(d6), "=&v"(d7) : "v"(base), "i"(o0), "i"(o1), "i"(o2), "i"(o3), "i"(o4), "i"(o5), "i"(o6), "i"(o7) : "memory")
#define WAITPIN8(n, d0, d1, d2, d3, d4, d5, d6, d7) asm volatile("s_waitcnt lgkmcnt(" #n ")" : "+v"(d0), "+v"(d1), "+v"(d2), "+v"(d3), "+v"(d4), "+v"(d5), "+v"(d6), "+v"(d7) :: "memory")
#define WAITPIN4(n, d0, d1, d2, d3) asm volatile("s_waitcnt lgkmcnt(" #n ")" : "+v"(d0), "+v"(d1), "+v"(d2), "+v"(d3) :: "memory")
__device__ __forceinline__ bf16x8_t mk8a(u16x4_t a, u16x4_t b) { bf16x8_t r; r[0] = a[0]; r[1] = a[1]; r[2] = a[2]; r[3] = a[3]; r[4] = b[0]; r[5] = b[1]; r[6] = b[2]; r[7] = b[3]; return r; }
#define TR8I(d0, d1, d2, d3, d4, d5, d6, d7, base, o0, o1, o2, o3, o4, o5, o6, o7) asm volatile( \
    "ds_read_b64_tr_b16 %0, %8 offset:%9\n\tds_read_b64_tr_b16 %1, %8 offset:%10\n\tds_read_b64_tr_b16 %2, %8 offset:%11\n\tds_read_b64_tr_b16 %3, %8 offset:%12\n\t" \
    "ds_read_b64_tr_b16 %4, %8 offset:%13\n\tds_read_b64_tr_b16 %5, %8 offset:%14\n\tds_read_b64_tr_b16 %6, %8 offset:%15\n\tds_read_b64_tr_b16 %7, %8 offset:%16\n\ts_waitcnt lgkmcnt(0)" \
    : "=&v"(d0), "=&v"(d1), "=&v"(d2), "=&v"(d3), "=&v"(d4), "=&v"(d5), "=&v"(d6), "=&v"(d7) : "v"(base), "i"(o0), "i"(o1), "i"(o2), "i"(o3), "i"(o4), "i"(o5), "i"(o6), "i"(o7) : "memory")
#define TR8(d0, d1, d2, d3, d4, d5, d6, d7, a0, a1, a2, a3, a4, a5, a6, a7) asm volatile( \
    "ds_read_b64_tr_b16 %0, %8\n\tds_read_b64_tr_b16 %1, %9\n\tds_read_b64_tr_b16 %2, %10\n\tds_read_b64_tr_b16 %3, %11\n\t" \
    "ds_read_b64_tr_b16 %4, %12\n\tds_read_b64_tr_b16 %5, %13\n\tds_read_b64_tr_b16 %6, %14\n\tds_read_b64_tr_b16 %7, %15\n\ts_waitcnt lgkmcnt(0)" \
    : "=&v"(d0), "=&v"(d1), "=&v"(d2), "=&v"(d3), "=&v"(d4), "=&v"(d5), "=&v"(d6), "=&v"(d7) : "v"(a0), "v"(a1), "v"(a2), "v"(a3), "v"(a4), "v"(a5), "v"(a6), "v"(a7) : "memory")
__device__ __forceinline__ void wg_attn16(LDSP unsigned char* lds, bf16* RA, const bf16* __restrict__ CKVC, const unsigned short* __restrict__ idx, const bf16* __restrict__ WUK, const bf16* __restrict__ WUV,
                                          const float* __restrict__ rel_bias, int unit, int nxt_unit, int par, bool first, int tid, bool dry = false, int qmode = 0, bf16* qscr = nullptr) {
    const int lane = tid & 63, wave = __builtin_amdgcn_readfirstlane(tid >> 6), g = lane >> 4, c = lane & 15;
    const int b = unit >> 9, qg = unit & 511, t0 = b * SEQ + qg * 8, nk = ((qg >> 3) + 1) << 6, nsel = nk < TOPK ? nk : TOPK, ntile = nsel >> 5;
    LDSP unsigned char* QL = lds;
    LDSP unsigned char* tile = lds + wave * TILE_STRIDE;
    LDSP unsigned short* selw = (LDSP unsigned short*)(lds + SELW_OFF + (par * 8 + wave) * 512);
    LDSP unsigned short* selw_n = (LDSP unsigned short*)(lds + SELW_OFF + ((par ^ 1) * 8 + wave) * 512);
    if (first) { if (lane < 32) *((LDSP u32x4*)selw + lane) = *((const u32x4*)(idx + (size_t)(t0 + wave) * TOPK) + lane); }
    const bf16* kvb = CKVC + (size_t)b * SEQ * KV_R + g * 8;
    bf16x8_t kv0[8], kv1[8];
#define KV_LOAD(dst, key) do { const bf16* rp_ = kvb + (size_t)(key) * KV_R; _Pragma("unroll") for (int ks_ = 0; ks_ < 8; ++ks_) dst[ks_] = *(const bf16x8_t*)(rp_ + ks_ * 32); } while (0)
    int ka = (int)selw[c], kb = (int)selw[16 + c];
    KV_LOAD(kv0, ka); KV_LOAD(kv1, kb);
    bf16x8_t qf[8];
    if (qmode != 2) {
        const int h = wave; const bf16* qr = RA + (size_t)(t0 + (qmode == 1 ? c : (c & 7))) * NA + A_Q + h * 64 + g * 8;
        const bf16x8_t b0 = *(const bf16x8_t*)qr, b1 = *(const bf16x8_t*)(qr + 32);
        const bf16* wb = WUK + ((size_t)h * 256 + c) * 64 + g * 8;
#pragma unroll 4
        for (int rt = 0; rt < 16; ++rt) { const bf16x8_t a0 = *(const bf16x8_t*)(wb + rt * 16 * 64), a1 = *(const bf16x8_t*)(wb + rt * 16 * 64 + 32);
            pg8::f32x4 acc = {0.f, 0.f, 0.f, 0.f};
            acc = __builtin_amdgcn_mfma_f32_16x16x32_bf16(a0, b0, acc, 0, 0, 0); acc = __builtin_amdgcn_mfma_f32_16x16x32_bf16(a1, b1, acc, 0, 0, 0);
            u32x2 w; w.x = pk2(acc[0], acc[1]); w.y = pk2(acc[2], acc[3]);
            if (c < 8) *(LDSP u32x2*)(QL + (((c * 8 + h) * 256) + rt * 16 + 4 * g) * 2) = w;
            else if (qmode == 1) *(u32x2*)(qscr + ((((c - 8) * 8 + h) * 256) + rt * 16 + 4 * g)) = w; }
        asm volatile("s_waitcnt lgkmcnt(0)" ::: "memory"); __builtin_amdgcn_s_barrier(); asm volatile("" ::: "memory");
#pragma unroll
        for (int ks = 0; ks < 8; ++ks) qf[ks] = *(const LDSP bf16x8_t*)(QL + (((wave * 8 + (c & 7)) * 256) + ks * 32 + g * 8) * 2);
        asm volatile("s_waitcnt lgkmcnt(0)" ::: "memory"); __builtin_amdgcn_s_barrier(); asm volatile("" ::: "memory");
    } else {
        const unsigned long long* qs = (const unsigned long long*)(qscr + (((wave * 8 + (c & 7)) * 256) + g * 8));
#pragma unroll
        for (int ks = 0; ks < 8; ++ks) { const unsigned long long lo = __hip_atomic_load(qs + ks * 8, __ATOMIC_RELAXED, __HIP_MEMORY_SCOPE_AGENT), hi = __hip_atomic_load(qs + ks * 8 + 1, __ATOMIC_RELAXED, __HIP_MEMORY_SCOPE_AGENT);
            u32x4 w; w.x = (unsigned)lo; w.y = (unsigned)(lo >> 32); w.z = (unsigned)hi; w.w = (unsigned)(hi >> 32); qf[ks] = __builtin_bit_cast(bf16x8_t, w); }
    }
    const unsigned tile_a = (unsigned)(size_t)tile;
#if ATT_STAGGER
    if (wave >= 4) __builtin_amdgcn_s_sleep(ATT_STAGGER);
#endif
    bf16x8_t bbf; { float bv[8];
#pragma unroll
        for (int j = 0; j < 8; ++j) bv[j] = rel_bias[(8 * g + j) * 8 + (c & 7)];
        u32x4 w; w.x = pk2(bv[0], bv[1]); w.y = pk2(bv[2], bv[3]); w.z = pk2(bv[4], bv[5]); w.w = pk2(bv[6], bv[7]); bbf = __builtin_bit_cast(bf16x8_t, w); }
    {
        const int spos = (qg * 8 + wave);
        pg8::f32x4 acc[16];
#pragma unroll
        for (int nt = 0; nt < 16; ++nt) acc[nt] = (pg8::f32x4){0.f, 0.f, 0.f, 0.f};
        float m_run = -INFINITY, l_run = 0.f;
#define ONEHOT(dst, key) do { const int rel_ = (key) - spos, n_ = rel_ < 0 ? -rel_ : rel_; \
            const int big_ = 8 + (n_ >= 15) + (n_ >= 27) + (n_ >= 50) + (n_ >= 91) + (n_ >= 166) + (n_ >= 305) + (n_ >= 559); \
            const int pos_ = (n_ < 8 ? n_ : big_) + (rel_ > 0 ? 16 : 0) - 8 * g; const unsigned one_ = (pos_ & 1) ? 0x3F800000u : 0x3F80u; const int hi_ = pos_ >> 1; \
            u32x4 w_; w_.x = (hi_ == 0) ? one_ : 0u; w_.y = (hi_ == 1) ? one_ : 0u; w_.z = (hi_ == 2) ? one_ : 0u; w_.w = (hi_ == 3) ? one_ : 0u; dst = __builtin_bit_cast(bf16x8_t, w_); } while (0)
        const int q4 = c >> 2, p = c & 3;
        const unsigned trb = tile_a + (4 * g + q4) * KVP + 8 * p;
        for (int tl = 0; tl < ntile; ++tl) {
            int kan = 0, kbn = 0; const bool more = tl + 1 < ntile;
            if (more) { kan = (int)selw[(2 * tl + 2) * 16 + c]; kbn = (int)selw[(2 * tl + 3) * 16 + c]; }
            bf16x8_t oha, ohb; ONEHOT(oha, ka); ONEHOT(ohb, kb);
            asm volatile("s_waitcnt vmcnt(8)" ::: "memory");
            pg8::f32x4 s0 = {0.f, 0.f, 0.f, 0.f}, s1 = {0.f, 0.f, 0.f, 0.f};
            s0 = __builtin_amdgcn_mfma_f32_16x16x32_bf16(oha, bbf, s0, 0, 0, 0);
#pragma unroll
            for (int ks = 0; ks < 8; ++ks) { s0 = __builtin_amdgcn_mfma_f32_16x16x32_bf16(kv0[ks], qf[ks], s0, 0, 0, 0); *(LDSP bf16x8_t*)(tile + c * KVP + g * 16 + ks * 64) = kv0[ks]; }
            if (more) KV_LOAD(kv0, kan);
            if (more) asm volatile("s_waitcnt vmcnt(8)" ::: "memory"); else asm volatile("s_waitcnt vmcnt(0)" ::: "memory");
            s1 = __builtin_amdgcn_mfma_f32_16x16x32_bf16(ohb, bbf, s1, 0, 0, 0);
#pragma unroll
            for (int ks = 0; ks < 8; ++ks) { s1 = __builtin_amdgcn_mfma_f32_16x16x32_bf16(kv1[ks], qf[ks], s1, 0, 0, 0); *(LDSP bf16x8_t*)(tile + (16 + c) * KVP + g * 16 + ks * 64) = kv1[ks]; }
            if (more) KV_LOAD(kv1, kbn);
            ka = kan; kb = kbn;
            float sv[8];
#pragma unroll
            for (int j = 0; j < 4; ++j) { sv[j] = s0[j]; sv[4 + j] = s1[j]; }
            float tmax = fmaxf(fmaxf(fmaxf(sv[0], sv[1]), fmaxf(sv[2], sv[3])), fmaxf(fmaxf(sv[4], sv[5]), fmaxf(sv[6], sv[7])));
            tmax = fmaxf(tmax, __shfl_xor(tmax, 16)); tmax = fmaxf(tmax, __shfl_xor(tmax, 32));
            const float m_new = fmaxf(m_run, tmax); const float scl = __expf(m_run - m_new); const bool grow = m_new > m_run; m_run = m_new;
            float ps = 0.f;
#pragma unroll
            for (int j = 0; j < 8; ++j) { sv[j] = __expf(sv[j] - m_new); ps += sv[j]; }
            l_run = l_run * scl + ps;
            bf16x8_t pf; { u32x4 w; w.x = pk2(sv[0], sv[1]); w.y = pk2(sv[2], sv[3]); w.z = pk2(sv[4], sv[5]); w.w = pk2(sv[6], sv[7]); pf = __builtin_bit_cast(bf16x8_t, w); }
            if (__builtin_amdgcn_ballot_w64(grow) != 0ull) {
                float rs[4];
#pragma unroll
                for (int e = 0; e < 4; ++e) rs[e] = __shfl(scl, 4 * g + e);
#pragma unroll
                for (int nt = 0; nt < 16; ++nt) {
#pragma unroll
                    for (int e = 0; e < 4; ++e) acc[nt][e] *= rs[e]; } }
            asm volatile("s_waitcnt lgkmcnt(0)" ::: "memory");
            u16x4_t va[8], vb[8];
            TR8N(va[0], va[1], va[2], va[3], va[4], va[5], va[6], va[7], trb, 0, 16 * KVP, 32, 32 + 16 * KVP, 64, 64 + 16 * KVP, 96, 96 + 16 * KVP);
            TR8N(vb[0], vb[1], vb[2], vb[3], vb[4], vb[5], vb[6], vb[7], trb, 128, 128 + 16 * KVP, 160, 160 + 16 * KVP, 192, 192 + 16 * KVP, 224, 224 + 16 * KVP);
            WAITPIN8(8, va[0], va[1], va[2], va[3], va[4], va[5], va[6], va[7]);
#pragma unroll
            for (int k = 0; k < 4; ++k) acc[k] = __builtin_amdgcn_mfma_f32_16x16x32_bf16(pf, mk8a(va[2 * k], va[2 * k + 1]), acc[k], 0, 0, 0);
            TR8N(va[0], va[1], va[2], va[3], va[4], va[5], va[6], va[7], trb, 256, 256 + 16 * KVP, 288, 288 + 16 * KVP, 320, 320 + 16 * KVP, 352, 352 + 16 * KVP);
            WAITPIN8(8, vb[0], vb[1], vb[2], vb[3], vb[4], vb[5], vb[6], vb[7]);
#pragma unroll
            for (int k = 0; k < 4; ++k) acc[4 + k] = __builtin_amdgcn_mfma_f32_16x16x32_bf16(pf, mk8a(vb[2 * k], vb[2 * k + 1]), acc[4 + k], 0, 0, 0);
            TR8N(vb[0], vb[1], vb[2], vb[3], vb[4], vb[5], vb[6], vb[7], trb, 384, 384 + 16 * KVP, 416, 416 + 16 * KVP, 448, 448 + 16 * KVP, 480, 480 + 16 * KVP);
            WAITPIN8(8, va[0], va[1], va[2], va[3], va[4], va[5], va[6], va[7]);
#pragma unroll
            for (int k = 0; k < 4; ++k) acc[8 + k] = __builtin_amdgcn_mfma_f32_16x16x32_bf16(pf, mk8a(va[2 * k], va[2 * k + 1]), acc[8 + k], 0, 0, 0);
            WAITPIN8(0, vb[0], vb[1], vb[2], vb[3], vb[4], vb[5], vb[6], vb[7]);
#pragma unroll
            for (int k = 0; k < 4; ++k) acc[12 + k] = __builtin_amdgcn_mfma_f32_16x16x32_bf16(pf, mk8a(vb[2 * k], vb[2 * k + 1]), acc[12 + k], 0, 0, 0);
        }
#undef KV_LOAD
#undef ONEHOT
        float lt = l_run + __shfl_xor(l_run, 16); lt += __shfl_xor(lt, 32); const float inv = 1.0f / lt;
        float ri[4];
#pragma unroll
        for (int e = 0; e < 4; ++e) ri[e] = __shfl(inv, 4 * g + e);
        if (g < 2) {
#pragma unroll
            for (int nt = 0; nt < 16; ++nt) { LDSP unsigned short* o1 = (LDSP unsigned short*)(tile) + (4 * g) * 256 + nt * 16 + c;
                o1[0] = f2bf(acc[nt][0] * ri[0]); o1[256] = f2bf(acc[nt][1] * ri[1]); o1[512] = f2bf(acc[nt][2] * ri[2]); o1[768] = f2bf(acc[nt][3] * ri[3]); }
        }
    }
    u32x4 nsel_v = {0u, 0u, 0u, 0u};
    if (nxt_unit >= 0 && lane < 32) { const int nb = nxt_unit >> 9, nq = nxt_unit & 511; nsel_v = *((const u32x4*)(idx + (size_t)(nb * SEQ + nq * 8 + wave) * TOPK) + lane); }
    asm volatile("s_waitcnt lgkmcnt(0)" ::: "memory"); __builtin_amdgcn_s_barrier(); asm volatile("" ::: "memory");
    if (qmode == 1) {
        bf16* oscr = qscr + 16384;
#pragma unroll
        for (int j = 0; j < 4; ++j) *((u32x4*)(oscr + (size_t)wave * 2048) + j * 64 + lane) = *((const LDSP u32x4*)(tile) + j * 64 + lane);
    } else {
        const int h = wave; pg8::f32x4 o[4];
#pragma unroll
        for (int nt = 0; nt < 4; ++nt) o[nt] = (pg8::f32x4){0.f, 0.f, 0.f, 0.f};
        const LDSP unsigned char* ab = lds + TILE_STRIDE * (c & 7) + (h * 256 + g * 8) * 2;
        const unsigned long long* os = (const unsigned long long*)(qscr + 16384 + ((c & 7) * 8 + h) * 256 + g * 8);
        const bf16* wb = WUV + ((size_t)h * 64 + c) * 256 + g * 8;
        const bool from_scr = (qmode == 2) && (c < 8);
#pragma unroll
        for (int ks = 0; ks < 8; ++ks) { bf16x8_t a;
            if (from_scr) { const unsigned long long lo = __hip_atomic_load(os + ks * 8, __ATOMIC_RELAXED, __HIP_MEMORY_SCOPE_AGENT), hi = __hip_atomic_load(os + ks * 8 + 1, __ATOMIC_RELAXED, __HIP_MEMORY_SCOPE_AGENT);
                u32x4 w; w.x = (unsigned)lo; w.y = (unsigned)(lo >> 32); w.z = (unsigned)hi; w.w = (unsigned)(hi >> 32); a = __builtin_bit_cast(bf16x8_t, w); }
            else a = *(const LDSP bf16x8_t*)(ab + ks * 64);
#pragma unroll
            for (int nt = 0; nt < 4; ++nt) { const bf16x8_t bw = *(const bf16x8_t*)(wb + (size_t)nt * 16 * 256 + ks * 32); o[nt] = __builtin_amdgcn_mfma_f32_16x16x32_bf16(a, bw, o[nt], 0, 0, 0); } }
        const int rbase = (qmode == 2) ? t0 - 8 : t0;
        if ((g < 2 || qmode == 2) && !dry) {
#pragma unroll
            for (int nt = 0; nt < 4; ++nt)
#pragma unroll
                for (int e = 0; e < 4; ++e) RA[(size_t)(rbase + 4 * g + e) * NA + A_Q + h * 64 + nt * 16 + c] = f2bf(o[nt][e]); }
    }
    if (nxt_unit >= 0 && lane < 32) *((LDSP u32x4*)selw_n + lane) = nsel_v;
    asm volatile("s_waitcnt vmcnt(0) lgkmcnt(0)" ::: "memory"); __builtin_amdgcn_s_barrier(); asm volatile("" ::: "memory");
}

__device__ __forceinline__ void wg_attn16d(LDSP unsigned char* lds, bf16* RA, const bf16* __restrict__ CKVC, const unsigned short* __restrict__ idx, const bf16* __restrict__ WUK, const bf16* __restrict__ WUV,
                                          const float* __restrict__ rel_bias, int unit, int nxt_unit, int par, bool first, int tid, bool dry = false, int qmode = 0, bf16* qscr = nullptr) {
    const int lane = tid & 63, wave = __builtin_amdgcn_readfirstlane(tid >> 6), g = lane >> 4, c = lane & 15;
    const int b = unit >> 9, qg = unit & 511, t0 = b * SEQ + qg * 8, nk = ((qg >> 3) + 1) << 6, nsel = nk < TOPK ? nk : TOPK, ntile = nsel >> 5;
    LDSP unsigned char* QL = lds;
    LDSP unsigned char* tile = lds + wave * TILE_STRIDE;
    LDSP unsigned short* selw = (LDSP unsigned short*)(lds + SELW_OFF + (par * 8 + wave) * 512);
    LDSP unsigned short* selw_n = (LDSP unsigned short*)(lds + SELW_OFF + ((par ^ 1) * 8 + wave) * 512);
    if (first) { if (lane < 32) *((LDSP u32x4*)selw + lane) = *((const u32x4*)(idx + (size_t)(t0 + wave) * TOPK) + lane); }
    const bf16* kvb = CKVC + (size_t)b * SEQ * KV_R;
    const int nstep = nsel >> 4;
#define KV_DMA(step) do { LDSP unsigned char* sl_ = tile + ((step) & 1) * 8192; \
        _Pragma("unroll") for (int i4_ = 0; i4_ < 4; ++i4_) { const int row_ = 4 * i4_ + g; const int key_ = (int)selw[(step) * 16 + row_]; const int c16_ = c ^ ((g << 2) | i4_); \
            const bf16* src_ = kvb + (size_t)key_ * KV_R + c16_ * 8; \
            __builtin_amdgcn_global_load_lds((const unsigned*)src_, (LDSP unsigned*)(sl_ + 1024 * i4_), 16, 0, 0); \
            __builtin_amdgcn_global_load_lds((const unsigned*)(src_ + 128), (LDSP unsigned*)(sl_ + 4096 + 1024 * i4_), 16, 0, 0); } } while (0)
    KV_DMA(0);
    bf16x8_t qf[8];
    if (qmode != 2) {
        const int h = wave; const bf16* qr = RA + (size_t)(t0 + (qmode == 1 ? c : (c & 7))) * NA + A_Q + h * 64 + g * 8;
        const bf16x8_t b0 = *(const bf16x8_t*)qr, b1 = *(const bf16x8_t*)(qr + 32);
        const bf16* wb = WUK + ((size_t)h * 256 + c) * 64 + g * 8;
#pragma unroll 4
        for (int rt = 0; rt < 16; ++rt) { const bf16x8_t a0 = *(const bf16x8_t*)(wb + rt * 16 * 64), a1 = *(const bf16x8_t*)(wb + rt * 16 * 64 + 32);
            pg8::f32x4 acc = {0.f, 0.f, 0.f, 0.f};
            acc = __builtin_amdgcn_mfma_f32_16x16x32_bf16(a0, b0, acc, 0, 0, 0); acc = __builtin_amdgcn_mfma_f32_16x16x32_bf16(a1, b1, acc, 0, 0, 0);
            u32x2 w; w.x = pk2(acc[0], acc[1]); w.y = pk2(acc[2], acc[3]);
            if (c < 8) *(LDSP u32x2*)(lds + c * TILE_STRIDE + 8192 + ((h * 256) + rt * 16 + 4 * g) * 2) = w;
            else if (qmode == 1) *(u32x2*)(qscr + ((((c - 8) * 8 + h) * 256) + rt * 16 + 4 * g)) = w; }
        asm volatile("s_waitcnt lgkmcnt(0)" ::: "memory"); __builtin_amdgcn_s_barrier(); asm volatile("" ::: "memory");
#pragma unroll
        for (int ks = 0; ks < 8; ++ks) qf[ks] = *(const LDSP bf16x8_t*)(tile + 8192 + (((c & 7) * 256) + ks * 32 + g * 8) * 2);
        asm volatile("s_waitcnt lgkmcnt(0)" ::: "memory");
    } else {
        const unsigned long long* qs = (const unsigned long long*)(qscr + (((wave * 8 + (c & 7)) * 256) + g * 8));
#pragma unroll
        for (int ks = 0; ks < 8; ++ks) { const unsigned long long lo = __hip_atomic_load(qs + ks * 8, __ATOMIC_RELAXED, __HIP_MEMORY_SCOPE_AGENT), hi = __hip_atomic_load(qs + ks * 8 + 1, __ATOMIC_RELAXED, __HIP_MEMORY_SCOPE_AGENT);
            u32x4 w; w.x = (unsigned)lo; w.y = (unsigned)(lo >> 32); w.z = (unsigned)hi; w.w = (unsigned)(hi >> 32); qf[ks] = __builtin_bit_cast(bf16x8_t, w); }
    }
    const unsigned tile_a = (unsigned)(size_t)tile;
#if ATT_STAGGER
    if (wave >= 4) __builtin_amdgcn_s_sleep(ATT_STAGGER);
#endif
    bf16x8_t bbf; { float bv[8];
#pragma unroll
        for (int j = 0; j < 8; ++j) bv[j] = rel_bias[(8 * g + j) * 8 + (c & 7)];
        u32x4 w; w.x = pk2(bv[0], bv[1]); w.y = pk2(bv[2], bv[3]); w.z = pk2(bv[4], bv[5]); w.w = pk2(bv[6], bv[7]); bbf = __builtin_bit_cast(bf16x8_t, w); }
    {
        const int spos = (qg * 8 + wave);
        pg8::f32x4 acc[16];
#pragma unroll
        for (int nt = 0; nt < 16; ++nt) acc[nt] = (pg8::f32x4){0.f, 0.f, 0.f, 0.f};
        float m_run = -INFINITY, l_run = 0.f;
#define ONEHOT(dst, key) do { const int rel_ = (key) - spos, n_ = rel_ < 0 ? -rel_ : rel_; \
            const int big_ = 8 + (n_ >= 15) + (n_ >= 27) + (n_ >= 50) + (n_ >= 91) + (n_ >= 166) + (n_ >= 305) + (n_ >= 559); \
            const int pos_ = (n_ < 8 ? n_ : big_) + (rel_ > 0 ? 16 : 0) - 8 * g; const unsigned one_ = (pos_ & 1) ? 0x3F800000u : 0x3F80u; const int hi_ = pos_ >> 1; \
            u32x4 w_; w_.x = (hi_ == 0) ? one_ : 0u; w_.y = (hi_ == 1) ? one_ : 0u; w_.z = (hi_ == 2) ? one_ : 0u; w_.w = (hi_ == 3) ? one_ : 0u; dst = __builtin_bit_cast(bf16x8_t, w_); } while (0)
        const int q4 = c >> 2, p = c & 3;
        const unsigned rd0 = tile_a + 256 * c + 16 * (g ^ (c >> 2)); const unsigned rx = (unsigned)(c & 3);
        const unsigned tr0 = tile_a + 256 * (4 * g + q4) + 8 * (p & 1); const unsigned ts = (unsigned)(((q4 << 2) | g)), tb0 = (unsigned)(p >> 1);
        if (nstep > 1) KV_DMA(1);
        for (int st = 0; st < nstep; ++st) {
            const unsigned so = (unsigned)((st & 1) * 8192);
            const int key = (int)selw[st * 16 + c];
            bf16x8_t oh; ONEHOT(oh, key);
            if (st + 1 < nstep) asm volatile("s_waitcnt vmcnt(8)" ::: "memory"); else asm volatile("s_waitcnt vmcnt(0)" ::: "memory");
            bf16x8_t af[8]; u16x4_t v[16];
#pragma unroll
            for (int ks = 0; ks < 8; ++ks) af[ks] = *(const LDSP bf16x8_t*)(size_t)(rd0 + so + (ks >> 2) * 4096 + 64 * (((unsigned)(ks & 3)) ^ rx));
#pragma unroll
            for (int n4 = 0; n4 < 4; ++n4) { unsigned ad[4];
#pragma unroll
                for (int k = 0; k < 4; ++k) { const unsigned nt = (unsigned)(n4 * 4 + k); ad[k] = tr0 + so + (nt >> 3) * 4096 + 16 * ((((nt & 7) << 1) | tb0) ^ ts); }
                asm volatile("ds_read_b64_tr_b16 %0, %4\n\tds_read_b64_tr_b16 %1, %5\n\tds_read_b64_tr_b16 %2, %6\n\tds_read_b64_tr_b16 %3, %7" : "=&v"(v[n4 * 4]), "=&v"(v[n4 * 4 + 1]), "=&v"(v[n4 * 4 + 2]), "=&v"(v[n4 * 4 + 3]) : "v"(ad[0]), "v"(ad[1]), "v"(ad[2]), "v"(ad[3]) : "memory"); }
            WAITPIN4(0, v[0], v[1], v[2], v[3]); WAITPIN4(0, v[4], v[5], v[6], v[7]); WAITPIN4(0, v[8], v[9], v[10], v[11]); WAITPIN4(0, v[12], v[13], v[14], v[15]);
            if (st + 2 < nstep) KV_DMA(st + 2);
            pg8::f32x4 s0 = {0.f, 0.f, 0.f, 0.f};
            s0 = __builtin_amdgcn_mfma_f32_16x16x32_bf16(oh, bbf, s0, 0, 0, 0);
#pragma unroll
            for (int ks = 0; ks < 8; ++ks) s0 = __builtin_amdgcn_mfma_f32_16x16x32_bf16(af[ks], qf[ks], s0, 0, 0, 0);
            float tmax = fmaxf(fmaxf(s0[0], s0[1]), fmaxf(s0[2], s0[3]));
            tmax = fmaxf(tmax, __shfl_xor(tmax, 16)); tmax = fmaxf(tmax, __shfl_xor(tmax, 32));
            const float m_new = fmaxf(m_run, tmax); const float scl = __expf(m_run - m_new); const bool grow = m_new > m_run; m_run = m_new;
            float sv[4]; float ps = 0.f;
#pragma unroll
            for (int j = 0; j < 4; ++j) { sv[j] = __expf(s0[j] - m_new); ps += sv[j]; }
            l_run = l_run * scl + ps;
            typedef short bf16x4_t __attribute__((ext_vector_type(4)));
            bf16x4_t pf; { u32x2 w; w.x = pk2(sv[0], sv[1]); w.y = pk2(sv[2], sv[3]); pf = __builtin_bit_cast(bf16x4_t, w); }
            if (__builtin_amdgcn_ballot_w64(grow) != 0ull) {
                float rs[4];
#pragma unroll
                for (int e = 0; e < 4; ++e) rs[e] = __shfl(scl, 4 * g + e);
#pragma unroll
                for (int nt = 0; nt < 16; ++nt) {
#pragma unroll
                    for (int e = 0; e < 4; ++e) acc[nt][e] *= rs[e]; } }
#pragma unroll
            for (int k = 0; k < 16; ++k) acc[k] = __builtin_amdgcn_mfma_f32_16x16x16bf16_1k(pf, __builtin_bit_cast(bf16x4_t, v[k]), acc[k], 0, 0, 0);
        }
#undef KV_DMA
#undef ONEHOT
        float lt = l_run + __shfl_xor(l_run, 16); lt += __shfl_xor(lt, 32); const float inv = 1.0f / lt;
        float ri[4];
#pragma unroll
        for (int e = 0; e < 4; ++e) ri[e] = __shfl(inv, 4 * g + e);
        if (g < 2) {
#pragma unroll
            for (int nt = 0; nt < 16; ++nt) { LDSP unsigned short* o1 = (LDSP unsigned short*)(tile) + (4 * g) * 256 + nt * 16 + c;
                o1[0] = f2bf(acc[nt][0] * ri[0]); o1[256] = f2bf(acc[nt][1] * ri[1]); o1[512] = f2bf(acc[nt][2] * ri[2]); o1[768] = f2bf(acc[nt][3] * ri[3]); }
        }
    }
    u32x4 nsel_v = {0u, 0u, 0u, 0u};
    if (nxt_unit >= 0 && lane < 32) { const int nb = nxt_unit >> 9, nq = nxt_unit & 511; nsel_v = *((const u32x4*)(idx + (size_t)(nb * SEQ + nq * 8 + wave) * TOPK) + lane); }
    asm volatile("s_waitcnt lgkmcnt(0)" ::: "memory"); __builtin_amdgcn_s_barrier(); asm volatile("" ::: "memory");
    if (qmode == 1) {
        bf16* oscr = qscr + 16384;
#pragma unroll
        for (int j = 0; j < 4; ++j) *((u32x4*)(oscr + (size_t)wave * 2048) + j * 64 + lane) = *((const LDSP u32x4*)(tile) + j * 64 + lane);
    } else {
        const int h = wave; pg8::f32x4 o[4];
#pragma unroll
        for (int nt = 0; nt < 4; ++nt) o[nt] = (pg8::f32x4){0.f, 0.f, 0.f, 0.f};
        const LDSP unsigned char* ab = lds + TILE_STRIDE * (c & 7) + (h * 256 + g * 8) * 2;
        const unsigned long long* os = (const unsigned long long*)(qscr + 16384 + ((c & 7) * 8 + h) * 256 + g * 8);
        const bf16* wb = WUV + ((size_t)h * 64 + c) * 256 + g * 8;
        const bool from_scr = (qmode == 2) && (c < 8);
#pragma unroll
        for (int ks = 0; ks < 8; ++ks) { bf16x8_t a;
            if (from_scr) { const unsigned long long lo = __hip_atomic_load(os + ks * 8, __ATOMIC_RELAXED, __HIP_MEMORY_SCOPE_AGENT), hi = __hip_atomic_load(os + ks * 8 + 1, __ATOMIC_RELAXED, __HIP_MEMORY_SCOPE_AGENT);
                u32x4 w; w.x = (unsigned)lo; w.y = (unsigned)(lo >> 32); w.z = (unsigned)hi; w.w = (unsigned)(hi >> 32); a = __builtin_bit_cast(bf16x8_t, w); }
            else a = *(const LDSP bf16x8_t*)(ab + ks * 64);
#pragma unroll
            for (int nt = 0; nt < 4; ++nt) { const bf16x8_t bw = *(const bf16x8_t*)(wb + (size_t)nt * 16 * 256 + ks * 32); o[nt] = __builtin_amdgcn_mfma_f32_16x16x32_bf16(a, bw, o[nt], 0, 0, 0); } }
        const int rbase = (qmode == 2) ? t0 - 8 : t0;
        if ((g < 2 || qmode == 2) && !dry) {
#pragma unroll
            for (int nt = 0; nt < 4; ++nt)
#pragma unroll
                for (int e = 0; e < 4; ++e) RA[(size_t)(rbase + 4 * g + e) * NA + A_Q + h * 64 + nt * 16 + c] = f2bf(o[nt][e]); }
    }
    if (nxt_unit >= 0 && lane < 32) *((LDSP u32x4*)selw_n + lane) = nsel_v;
    asm volatile("s_waitcnt vmcnt(0) lgkmcnt(0)" ::: "memory"); __builtin_amdgcn_s_barrier(); asm volatile("" ::: "memory");
}

#ifndef SSM_SPLIT_V
#define SSM_SPLIT_V 42
#endif
constexpr int SSM_SPLIT = SSM_SPLIT_V;
constexpr int XP = 144, BP = 272;
constexpr int SB_X = 0, SB_B = 8192, SB_C = 24576, SB_SIZE = 40960;
constexpr int L_XS = 2 * SB_SIZE, L_M = L_XS + 64 * XP, L_HC = L_M + 64 * XP, L_TB = L_HC + 2 * 64 * BP;
static_assert(L_TB + 2048 <= 140 * 1024, "ssm lds");
#define TR2(d0, d1, a0, a1) asm volatile("ds_read_b64_tr_b16 %0, %2\n\tds_read_b64_tr_b16 %1, %3\n\ts_waitcnt lgkmcnt(0)" : "=&v"(d0), "=&v"(d1) : "v"(a0), "v"(a1) : "memory")
__device__ __forceinline__ bf16x8_t mk8(u16x4_t a, u16x4_t b) { bf16x8_t r; r[0] = a[0]; r[1] = a[1]; r[2] = a[2]; r[3] = a[3]; r[4] = b[0]; r[5] = b[1]; r[6] = b[2]; r[7] = b[3]; return r; }
__device__ __forceinline__ int bc_off(int row, int ch) { return 256 * row + 16 * (ch ^ (((row & 3) << 2) | ((row >> 2) & 3))); }
__device__ __forceinline__ void ssm_dma(LDSP unsigned char* buf, const bf16* __restrict__ XA, int tc0, int h, int grp, int wave, int lane, bool full) {
    const int npc = full ? 40 : 24;
    for (int p = wave; p < npc; p += 8) {
        const bf16* src;
        if (p < 8) { const int row = 8 * p + (lane >> 3), ch = lane & 7; src = XA + (size_t)(tc0 + row) * XBC + h * 64 + ch * 8; }
        else { const int pp = (p - 8) & 15, row = 4 * pp + (lane >> 4), ch = (lane & 15) ^ (((row & 3) << 2) | ((row >> 2) & 3)); src = XA + (size_t)(tc0 + row) * XBC + (p < 24 ? 1024 : 1280) + grp * 128 + ch * 8; }
        __builtin_amdgcn_global_load_lds((const unsigned*)src, (LDSP unsigned*)(buf + 1024 * p), 16, 0, 0);
    }
}
__device__ __forceinline__ void wg_ssm_unit(LDSP unsigned char* lds, bf16* RA, const bf16* __restrict__ XA, const float* __restrict__ DTt,
                                            const float* __restrict__ a_log, const float* __restrict__ dsk, int unit, int tid, bf16* dbg_out = nullptr, bool dry = false) {
    const int lane = tid & 63, wave = __builtin_amdgcn_readfirstlane(tid >> 6), g = lane >> 4, c = lane & 15, q4 = c >> 2, p4 = c & 3;
    const int b = unit >> 5, h = (unit >> 1) & 15, seg = unit & 1, grp = h >> 3, pq = wave & 3, hf = wave >> 2;
    const float Dh = dsk[h];
    const unsigned lds_a = (unsigned)(size_t)lds;
    LDSP float* TB = (LDSP float*)(lds + L_TB);
    typedef float f32x2_t __attribute__((ext_vector_type(2)));
    const f32x2_t* dtp = (const f32x2_t*)DTt + (size_t)(b * 16 + h) * SEQ;
    pg8::f32x4 hacc[4];
#pragma unroll
    for (int nt = 0; nt < 4; ++nt) hacc[nt] = (pg8::f32x4){0.f, 0.f, 0.f, 0.f};
    for (int i = tid; i < (2 * 64 * BP) / 4; i += NTHR) ((LDSP unsigned*)(lds + L_HC))[i] = 0u;
    const int c_end = seg ? 64 : SSM_SPLIT;
    ssm_dma(lds, XA, b * SEQ, h, grp, wave, lane, seg == 0 || SSM_SPLIT == 0);
    f32x2_t dt_cur = dtp[lane];
    asm volatile("s_waitcnt vmcnt(0) lgkmcnt(0)" ::: "memory"); __builtin_amdgcn_s_barrier(); asm volatile("" ::: "memory");
    for (int ci = 0; ci < c_end; ++ci) {
        const bool full = (seg == 0) || (ci >= SSM_SPLIT);
        const int tc0 = b * SEQ + ci * 64;
        LDSP unsigned char* buf = lds + (ci & 1) * SB_SIZE;
        f32x2_t dt_nxt = {0.f, 0.f};
        if (ci + 1 < c_end) { ssm_dma(lds + ((ci + 1) & 1) * SB_SIZE, XA, tc0 + 64, h, grp, wave, lane, (seg == 0) || (ci + 1 >= SSM_SPLIT)); dt_nxt = dtp[(ci + 1) * 64 + lane]; }
        unsigned short zraw[8];
        if (full) {
#pragma unroll
            for (int k2 = 0; k2 < 2; ++k2)
#pragma unroll
                for (int e = 0; e < 4; ++e) zraw[k2 * 4 + e] = RA[(size_t)(tc0 + 16 * (2 * hf + k2) + 4 * g + e) * NA + A_Z + h * 64 + 16 * pq + c]; }
        {   const float dt = dt_cur.x, acs = dt_cur.y; const float tot = __builtin_bit_cast(float, __builtin_amdgcn_readlane(__builtin_bit_cast(int, acs), 63));
            TB[lane] = dt; TB[64 + lane] = acs; TB[128 + lane] = __expf(acs); TB[192 + lane] = __expf(tot - acs) * dt; if (lane == 0) TB[256] = __expf(tot); }
        asm volatile("s_waitcnt lgkmcnt(0)" ::: "memory");
        {   const int row = tid >> 3, ch = tid & 7; const u32x4 xv = *(const LDSP u32x4*)(buf + SB_X + row * 128 + ch * 16); const float wl = TB[192 + row]; const unsigned xw[4] = {xv.x, xv.y, xv.z, xv.w}; u32x4 o;
            o.x = pk2(__builtin_bit_cast(float, xw[0] << 16) * wl, __builtin_bit_cast(float, xw[0] & 0xffff0000u) * wl); o.y = pk2(__builtin_bit_cast(float, xw[1] << 16) * wl, __builtin_bit_cast(float, xw[1] & 0xffff0000u) * wl);
            o.z = pk2(__builtin_bit_cast(float, xw[2] << 16) * wl, __builtin_bit_cast(float, xw[2] & 0xffff0000u) * wl); o.w = pk2(__builtin_bit_cast(float, xw[3] << 16) * wl, __builtin_bit_cast(float, xw[3] & 0xffff0000u) * wl);
            *(LDSP u32x4*)(lds + L_XS + row * XP + ch * 16) = o; }
        if (full) {
            const int lt = wave >> 1;
#pragma unroll
            for (int k2 = 0; k2 < 2; ++k2) { const int st = 2 * (wave & 1) + k2; pg8::f32x4 ga = {0.f, 0.f, 0.f, 0.f};
#pragma unroll
                for (int ks = 0; ks < 4; ++ks) { const bf16x8_t af = *(const LDSP bf16x8_t*)(buf + SB_C + bc_off(16 * lt + c, 4 * ks + g)), bfm = *(const LDSP bf16x8_t*)(buf + SB_B + bc_off(16 * st + c, 4 * ks + g));
                    ga = __builtin_amdgcn_mfma_f32_16x16x32_bf16(af, bfm, ga, 0, 0, 0); }
                const int s = 16 * st + c; const float acs_s = TB[64 + s], dt_s = TB[s];
#pragma unroll
                for (int e = 0; e < 4; ++e) { const int l = 16 * lt + 4 * g + e; const float m = (s <= l) ? ga[e] * __expf(TB[64 + l] - acs_s) * dt_s : 0.f;
                    *(LDSP unsigned short*)(lds + L_M + l * XP + s * 2) = f2bf(m); } }
        }
        asm volatile("s_waitcnt lgkmcnt(0)" ::: "memory"); __builtin_amdgcn_s_barrier(); asm volatile("" ::: "memory");
        if (full) {
            pg8::f32x4 ya[2] = {{0.f, 0.f, 0.f, 0.f}, {0.f, 0.f, 0.f, 0.f}};
            const LDSP unsigned char* hcur = lds + L_HC + (ci & 1) * (64 * BP);
#pragma unroll
            for (int ks = 0; ks < 4; ++ks) { const bf16x8_t hb = *(const LDSP bf16x8_t*)(hcur + (16 * pq + c) * BP + (32 * ks + 8 * g) * 2);
#pragma unroll
                for (int k2 = 0; k2 < 2; ++k2) { const bf16x8_t af = *(const LDSP bf16x8_t*)(buf + SB_C + bc_off(16 * (2 * hf + k2) + c, 4 * ks + g)); ya[k2] = __builtin_amdgcn_mfma_f32_16x16x32_bf16(af, hb, ya[k2], 0, 0, 0); } }
#pragma unroll
            for (int k2 = 0; k2 < 2; ++k2)
#pragma unroll
                for (int e = 0; e < 4; ++e) ya[k2][e] *= TB[128 + 16 * (2 * hf + k2) + 4 * g + e];
#pragma unroll
            for (int ks = 0; ks < 2; ++ks) { u16x4_t x0, x1; const unsigned xa = lds_a + (ci & 1) * SB_SIZE + SB_X + (32 * ks + 8 * g + q4) * 128 + (16 * pq + 4 * p4) * 2; TR2(x0, x1, xa, xa + 4 * 128); const bf16x8_t xb = mk8(x0, x1);
#pragma unroll
                for (int k2 = 0; k2 < 2; ++k2) { const bf16x8_t mf = *(const LDSP bf16x8_t*)(lds + L_M + (16 * (2 * hf + k2) + c) * XP + (32 * ks + 8 * g) * 2); ya[k2] = __builtin_amdgcn_mfma_f32_16x16x32_bf16(mf, xb, ya[k2], 0, 0, 0); } }
#pragma unroll
            for (int k2 = 0; k2 < 2; ++k2)
#pragma unroll
                for (int e = 0; e < 4; ++e) { const int l = 16 * (2 * hf + k2) + 4 * g + e, pp = 16 * pq + c; const float x = bf2f(*(const LDSP unsigned short*)(buf + SB_X + l * 128 + pp * 2));
                    const float z = bf2f(zraw[k2 * 4 + e]); const bf16 uo = f2bf((ya[k2][e] + Dh * x) * siluf_(z));
                    if (dbg_out) dbg_out[(size_t)(tc0 + l) * 1024 + h * 64 + pp] = uo; else if (!dry) RA[(size_t)(tc0 + l) * NA + A_Z + h * 64 + pp] = uo; }
        }
        {   const float dec = TB[256];
#pragma unroll
            for (int nt = 0; nt < 4; ++nt)
#pragma unroll
                for (int e = 0; e < 4; ++e) hacc[nt][e] *= dec;
#pragma unroll
            for (int ks = 0; ks < 2; ++ks) { const int row = 32 * ks + 8 * g + q4; u16x4_t x0, x1; const unsigned xa = lds_a + L_XS + row * XP + (16 * pq + 4 * p4) * 2; TR2(x0, x1, xa, xa + 4 * XP); const bf16x8_t xf = mk8(x0, x1);
                u16x4_t v[8]; unsigned ad[8];
#pragma unroll
                for (int nt = 0; nt < 4; ++nt) { const int ch = 8 * hf + 2 * nt + (p4 >> 1); ad[2 * nt] = lds_a + (ci & 1) * SB_SIZE + SB_B + bc_off(row, ch) + 8 * (p4 & 1); ad[2 * nt + 1] = lds_a + (ci & 1) * SB_SIZE + SB_B + bc_off(row + 4, ch) + 8 * (p4 & 1); }
                TR8(v[0], v[1], v[2], v[3], v[4], v[5], v[6], v[7], ad[0], ad[1], ad[2], ad[3], ad[4], ad[5], ad[6], ad[7]);
#pragma unroll
                for (int nt = 0; nt < 4; ++nt) hacc[nt] = __builtin_amdgcn_mfma_f32_16x16x32_bf16(xf, mk8(v[2 * nt], v[2 * nt + 1]), hacc[nt], 0, 0, 0); }
            LDSP unsigned char* hnext = lds + L_HC + ((ci + 1) & 1) * (64 * BP);
#pragma unroll
            for (int nt = 0; nt < 4; ++nt)
#pragma unroll
                for (int e = 0; e < 4; ++e) *(LDSP unsigned short*)(hnext + (16 * pq + 4 * g + e) * BP + (64 * hf + 16 * nt + c) * 2) = f2bf(hacc[nt][e]);
        }
        dt_cur = dt_nxt;
        asm volatile("s_waitcnt vmcnt(0) lgkmcnt(0)" ::: "memory"); __builtin_amdgcn_s_barrier(); asm volatile("" ::: "memory");
    }
}

__global__ void __launch_bounds__(NTHR, 2) k_fwd(Params P) {
    extern __shared__ __attribute__((aligned(16))) unsigned char lds_raw[];
    LDSP unsigned char* lds = (LDSP unsigned char*)lds_raw;
    volatile LDSP unsigned* MISC = (volatile LDSP unsigned*)(lds + MISC_OFF);
    unsigned char* ws = P.ws;
    const int wave_s = __builtin_amdgcn_readfirstlane(threadIdx.x >> 6);
    for (int u = threadIdx.x; u < (LDS_BYTES - RING_BYTES) / 4; u += NTHR) ((LDSP unsigned*)(lds + RING_BYTES))[u] = 0u;
#define PHASE_IDS int tid = mk_tid(wave_s); int blk = blockIdx.x; asm volatile("" : "+s"(blk)); int G = gridDim.x; asm volatile("" : "+s"(G)); const int NGW = G * NWAVES; (void)NGW; const int lane = tid & 63, wave = __builtin_amdgcn_readfirstlane(tid >> 6), gw = blk * NWAVES + wave; (void)lane; (void)wave; (void)gw; const __attribute__((address_space(4))) char* kargs = (const __attribute__((address_space(4))) char*)__builtin_amdgcn_kernarg_segment_ptr(); asm volatile("" : "+s"(kargs)); int Lp = L; asm volatile("" : "+s"(Lp)); (void)Lp; unsigned char* ws = ((unsigned char* const __attribute__((address_space(4)))*)kargs)[27]; float* out = ((float* const __attribute__((address_space(4)))*)kargs)[26]; const float* x = KIN(0); const float* p = KIN(1); float* rstd = (float*)(ws + WS_RSTD); float* rstd2 = (float*)(ws + WS_RSTD2); float* DTb = (float*)(ws + WS_DT); bf16 *Win = (bf16*)(ws + WS_W_IN), *Wout = (bf16*)(ws + WS_W_OUT), *Wgu = (bf16*)(ws + WS_W_GU), *Wdown = (bf16*)(ws + WS_W_DOWN), *Wpg = (bf16*)(ws + WS_W_PG), *Wpp = (bf16*)(ws + WS_W_PP); bf16 *X0 = (bf16*)(ws + WS_X0), *X1 = (bf16*)(ws + WS_X1), *RA = (bf16*)(ws + WS_RA), *RB = (bf16*)(ws + WS_RB), *XA = (bf16*)out; unsigned short* IDX = (unsigned short*)((unsigned char*)out + 112 * MiB); bf16* CKVC = (bf16*)((unsigned char*)out + 96 * MiB); bf16* IKC = (bf16*)(ws + WS_IKC); bf16* WUK = (bf16*)(ws + WS_WUK); bf16* WUV = (bf16*)(ws + WS_WUV); (void)CKVC; (void)IKC; (void)WUK; (void)WUV; bf16* Xcur = (Lp == 0) ? X0 : X1; (void)out; (void)x; (void)p; (void)rstd; (void)rstd2; (void)DTb; (void)Win; (void)Wout; (void)Wgu; (void)Wdown; (void)Wpg; (void)Wpp; (void)X0; (void)X1; (void)RA; (void)RB; (void)XA; (void)IDX; (void)Xcur
    __syncthreads();
    if (TIMING && blockIdx.x == 0 && mk_tid(wave_s) == 0) { __hip_atomic_store((unsigned long long*)(P.ws + 32768), (unsigned long long)__builtin_amdgcn_s_memrealtime(), __ATOMIC_RELAXED, __HIP_MEMORY_SCOPE_AGENT); __hip_atomic_store((unsigned long long*)(P.ws + 32768) + 60, (unsigned long long)__builtin_amdgcn_s_memtime(), __ATOMIC_RELAXED, __HIP_MEMORY_SCOPE_AGENT); }
#if CLK_PROBE
    if (blockIdx.x == 0 && mk_tid(wave_s) == 0) { __hip_atomic_store((unsigned long long*)(P.ws + 49152), (unsigned long long)__builtin_amdgcn_s_memtime(), __ATOMIC_RELAXED, __HIP_MEMORY_SCOPE_AGENT); __hip_atomic_store((unsigned long long*)(P.ws + 49152) + 1, (unsigned long long)__builtin_amdgcn_s_memrealtime(), __ATOMIC_RELAXED, __HIP_MEMORY_SCOPE_AGENT); }
#endif
    const bool one_launch = (P.ph_hi - P.ph_lo) > 1;
    XcdBarrier bar; bar.bar = (unsigned*)(ws + WS_CTL) + CW_BAR; bar.x = 0; bar.st = nullptr;
    if (one_launch) bar = xcd_barrier_post((unsigned*)(ws + WS_CTL) + CW_BAR, (volatile LAS unsigned*)(MISC + 8));
    if (one_launch && mk_tid(wave_s) == 0) { const unsigned xid_ = xb_xcc_id(); MISC[16] = xid_; MISC[17] = __hip_atomic_fetch_add((unsigned*)(P.ws + WS_CTL) + CW_RANK + 64 * xid_, 1u, __ATOMIC_RELAXED, __HIP_MEMORY_SCOPE_AGENT); }

#ifndef PH_MASK
#define PH_MASK 0x3fff
#endif
#define PHASE_IDS_NOL const int L = 0; PHASE_IDS
#define NPASS(k) (((DBL_MASK >> (k)) & 1) ? ((Lp == 0 && ((P.dbl_mask >> (k)) & 1)) ? 2 : 1) : 1)
#define XCD_DEAL bool xok_ = false; int xb_ = 0, xr_ = 0, xn_ = 1; { if (tid == 0) { unsigned ok = (MISC[9] == 8u) ? 1u : 0u; unsigned sum = 0; for (int j = 0; j < 8; ++j) { const unsigned cj = __hip_atomic_load((unsigned*)(ws + WS_CTL) + CW_BAR + XB_XCNT(j), __ATOMIC_RELAXED, __HIP_MEMORY_SCOPE_AGENT); sum += cj; if (cj == 0u) ok = 0u; } if (sum != (unsigned)G) ok = 0u; MISC[18] = ok; } \
    __syncthreads(); xok_ = MISC[18] != 0u; xb_ = (int)MISC[16]; xr_ = (int)MISC[17]; xn_ = (int)MISC[8]; if (xn_ < 1) xn_ = 1; __syncthreads(); }
#define KIN(i) (((const float* const __attribute__((address_space(4)))*)kargs)[i])
#define IN(k) (P.ph_lo <= (k) && (k) < P.ph_hi && ((PH_MASK >> ((k) % NPH)) & 1))
#define SEAM(k) do { if (IN((k) + 1)) { XcdBarrier b2_ = bar; asm volatile("" : "+s"(b2_.bar)); xcd_barrier(b2_, mk_tid(wave_s)); } if (TIMING && blockIdx.x == 0 && mk_tid(wave_s) == 0) { __hip_atomic_store((unsigned long long*)(P.ws + 32768) + (k) + 1, (unsigned long long)__builtin_amdgcn_s_memrealtime(), __ATOMIC_RELAXED, __HIP_MEMORY_SCOPE_AGENT); } } while (0)
    for (int L = 0; L < DEPTH; ++L) {
        const int pb = L * NPH;
        if (IN(pb + 0)) { PHASE_IDS; for (int pass = NPASS(0); pass > 0; --pass) {
            LDSP float* scr = (LDSP float*)(lds + wave * 8704);
            ph_prep_w<1>(scr, KIN(6) + (size_t)Lp * D * INW, nullptr, D, INW, KIN(2) + (size_t)Lp * D, Win, NIN, gw, NGW, lane);
            ph_prep_w<0>(scr, KIN(20) + (size_t)Lp * MIXW * D, nullptr, MIXW, D, nullptr, Wout, D, gw, NGW, lane);
            ph_prep_w<2>(scr, KIN(21) + (size_t)Lp * D * DFF, KIN(22) + (size_t)Lp * D * DFF, D, DFF, KIN(4) + (size_t)Lp * D, Wgu, NGU, gw, NGW, lane);
            ph_prep_w<0>(scr, KIN(23) + (size_t)Lp * DFF * D, nullptr, DFF, D, nullptr, Wdown, D, gw, NGW, lane);
            ph_prep_w<0>(scr, KIN(25) + (size_t)Lp * D * D, nullptr, D, D, nullptr, Wpg, D, gw, NGW, lane);
            ph_prep_w<0>(scr, KIN(24) + (size_t)Lp * PLE * D, nullptr, PLE, D, nullptr, Wpp, D, gw, NGW, lane);
            {   const float* uk = KIN(10) + (size_t)Lp * 256 * 8 * 64; const float* uv = KIN(11) + (size_t)Lp * 256 * 8 * 64;
                for (int e = gw * 64 + lane; e < 8 * 256 * 64; e += NGW * 64) { const int h = e >> 14, r = (e >> 6) & 255, d = e & 63; WUK[e] = f2bf(0.125f * uk[((size_t)r * 8 + h) * 64 + d]); }
                for (int e = gw * 64 + lane; e < 8 * 64 * 256; e += NGW * 64) { const int h = e >> 14, d = (e >> 8) & 63, r = e & 255; WUV[e] = f2bf(uv[((size_t)r * 8 + h) * 64 + d]); } }
            if (Lp == 0) { for (int r = gw * 2; r < T; r += NGW * 2) row_x_prep2(x, X0, rstd, r, lane); }
            else        { for (int r = gw * 4; r < T; r += NGW * 4) row_rstd_bf16x4(X1, rstd, r, lane); }
            }
            SEAM(pb + 0);
        }
#if XTRA_BAR
        if (P.ph_hi - P.ph_lo > 1 && L == 0) { for (int i_ = 0; i_ < XTRA_BAR; ++i_) { XcdBarrier b4_ = bar; asm volatile("" : "+s"(b4_.bar)); xcd_barrier(b4_, mk_tid(wave_s)); } }
#endif
        if (IN(pb + 1)) { PHASE_IDS; for (int pass = NPASS(1); pass > 0; --pass) {
            pg8::Gemm g{Xcur, Win, T, NIN, (GEMM_DRYK && pass > 1) ? GEMM_DRYK : D}; pg8::StaticOrder S; S.init(T, NIN, G, blk);
            pg8::EpiProj E{RA, RB, rstd};
            pg8::gemm_phase<pg8::EpiProj, pg8::StaticOrder, true, true>(lds, g, S, E, tid);
            }
            SEAM(pb + 1);
        }
        if (IN(pb + 2)) { PHASE_IDS;
            for (int pass = NPASS(2); pass > 0; --pass) {
#pragma unroll 2
            for (int it = gw; it < T / 4; it += NGW) prep_ckv4(RB, CKVC, KIN(7) + Lp * KV_R, it, lane);
            for (int it = gw; it < T / 16; it += NGW) prep_ik16(RB, IKC, KIN(8) + Lp * 64, KIN(9) + Lp * 64, it, lane);
#pragma unroll 2
            for (int t = gw; t < T; t += NGW) prep_bout(RA, RB, KIN(13) + (size_t)Lp * 3 * 512, t, lane, pass > 1);
#pragma unroll 2
            for (int it = gw; it < (T / 16) * 12; it += NGW) prep_conv(RB, XA, KIN(14) + (size_t)Lp * 4 * XBC, KIN(15) + (size_t)Lp * XBC, it, lane);
            for (int it = gw; it < BATCH * 64 * 4; it += NGW) { const int hq = it & 3, ck = (it >> 2) & 63, bb = it >> 8; const int t = bb * SEQ + ck * 64 + lane;
                const u32x2 rw = *(const u32x2*)(RB + (size_t)t * NB + B_DT + hq * 4); const unsigned rr[2] = {rw.x, rw.y}; float dtv[4], ac[4];
#pragma unroll
                for (int e = 0; e < 4; ++e) { const int hh = hq * 4 + e; const float xr = __builtin_bit_cast(float, (e & 1) ? (rr[e >> 1] & 0xffff0000u) : (rr[e >> 1] << 16)) + (KIN(16) + Lp * 16)[hh];
                    dtv[e] = xr > 15.f ? xr : log1pf(__expf(xr)); ac[e] = -__expf((KIN(17) + Lp * 16)[hh]) * dtv[e]; }
#pragma unroll
                for (int o = 1; o < 64; o <<= 1) {
#pragma unroll
                    for (int e = 0; e < 4; ++e) { const float v = __shfl_up(ac[e], o); if (lane >= o) ac[e] += v; } }
#pragma unroll
                for (int e = 0; e < 4; ++e) { typedef float f32x2_t __attribute__((ext_vector_type(2))); ((f32x2_t*)(ws + WS_DT2))[(size_t)(bb * 16 + hq * 4 + e) * SEQ + ck * 64 + lane] = (f32x2_t){dtv[e], ac[e]}; } }
            }
            SEAM(pb + 2);
        }
        if (IN(pb + 3)) { PHASE_IDS;
            const bool ssm_first = ((blk >> 3) & 1) == 0;
#pragma clang loop unroll(disable)
            for (int step = 0; step < 3; ++step) {
                const bool do_ssm = (step == 0 && ssm_first) || (step == 2 && !ssm_first);
                if (do_ssm) {
                    for (int u = blk; u < BATCH * 32; u += G) { const int uu = (u & 127) * 2 + (u >> 7);
                        wg_ssm_unit(lds, RA, XA, (const float*)(ws + WS_DT2), KIN(17) + Lp * 16, KIN(18) + Lp * 16, uu ^ 1, mk_tid(wave_s), nullptr, false); }
                } else if (step == 1) {
                    for (int i = blk; i < T / 16; i += G) { const int b_ = i & 7, j_ = i >> 3, u16 = b_ * 256 + (255 - j_);
                        wg_select16(lds, RB, IKC, IDX, u16, mk_tid(wave_s), false, true);
                        const int ua = b_ * 512 + 2 * (255 - j_);
#pragma clang loop unroll(disable)
                        for (int h2 = 0; h2 < 2; ++h2) ATT_FN(lds, RA, CKVC, IDX, WUK, WUV, KIN(12), ua + h2, -1, h2, false, mk_tid(wave_s), false, 1 + h2, (bf16*)((unsigned char*)out + 112 * MiB) + (size_t)blk * 32768); }
                }
            }
            SEAM(pb + 5); }

        if (IN(pb + 6)) { PHASE_IDS; for (int pass = NPASS(6); pass > 0; --pass) for (int w = 4 * gw; w < T * 2; w += 4 * NGW) wave_gnorm4(RA, KIN(19) + (size_t)Lp * 1024, w, lane, pass > 1); SEAM(pb + 6); }
        if (IN(pb + 7)) { PHASE_IDS; for (int pass = NPASS(7); pass > 0; --pass) {
            pg8::Gemm g{RA, Wout, T, D, MIXW}; pg8::StaticOrder S; S.init(T, D, G, blk);
            pg8::EpiBf16P E{RB, (long)D};
            pg8::gemm_phase<pg8::EpiBf16P, pg8::StaticOrder, true, true>(lds, g, S, E, tid);
            }
            SEAM(pb + 7);
        }
        if (IN(pb + 8)) { PHASE_IDS; for (int pass = NPASS(8); pass > 0; --pass) for (int r = 2 * gw; r < T; r += 2 * NGW) row_resid_norm2(Xcur, (const bf16*)RB, KIN(3) + (size_t)Lp * D, X0, rstd2, nullptr, nullptr, r, lane, pass > 1); SEAM(pb + 8); }
        if (IN(pb + 9)) { PHASE_IDS; for (int pass = NPASS(9); pass > 0; --pass) {
            pg8::Gemm g{X0, Wgu, T, NGU, D}; pg8::StaticOrder S; S.init(T, NGU, G, blk);
            pg8::EpiSwiGLU E{RB, rstd2};
            pg8::gemm_phase<pg8::EpiSwiGLU, pg8::StaticOrder, true, true>(lds, g, S, E, tid);
            }
            SEAM(pb + 9);
        }
        if (IN(pb + 10)) { PHASE_IDS; for (int pass = NPASS(10); pass > 0; --pass) {
            pg8::Gemm g{RB, Wdown, T, D, DFF}; pg8::StaticOrder S; S.init(T, D, G, blk);
            pg8::EpiBf16P E{RA, (long)D};
            pg8::gemm_phase<pg8::EpiBf16P, pg8::StaticOrder, true, true>(lds, g, S, E, tid);
            }
            SEAM(pb + 10);
        }
        if (IN(pb + 11)) { PHASE_IDS; for (int pass = NPASS(11); pass > 0; --pass) for (int r = 2 * gw; r < T; r += 2 * NGW) row_resid_norm2(X0, (const bf16*)RA, KIN(5) + (size_t)Lp * D, X0, nullptr, p + (size_t)Lp * T * PLE, X1, r, lane, pass > 1); SEAM(pb + 11); }
        if (IN(pb + 12)) { PHASE_IDS; for (int pass = NPASS(12); pass > 0; --pass) {
            pg8::Gemm g{X1, Wpp, T, D, PLE}; pg8::StaticOrder S; S.init(T, D, G, blk);
            pg8::EpiBf16P E{RB, (long)D};
            pg8::gemm_phase<pg8::EpiBf16P, pg8::StaticOrder, true, true>(lds, g, S, E, tid);
            }
            SEAM(pb + 12);
        }
        if (IN(pb + 13)) { PHASE_IDS; for (int pass = NPASS(13); pass > 0; --pass) {
            pg8::Gemm g{X0, Wpg, T, D, D}; pg8::StaticOrder S; S.init(T, D, G, blk);
            pg8::EpiPle E{X0, RB, X1, (Lp == DEPTH - 1) ? out : nullptr};
            pg8::gemm_phase<pg8::EpiPle, pg8::StaticOrder, true, true>(lds, g, S, E, tid);
            }
            SEAM(pb + 13);
        }
    }
#if CLK_PROBE
    if (P.ph_hi == DEPTH * NPH) { PHASE_IDS_NOL; { XcdBarrier b3_ = bar; asm volatile("" : "+s"(b3_.bar)); xcd_barrier(b3_, mk_tid(wave_s)); }
        if (blk == 0 && tid == 0) { const unsigned long long c1 = __builtin_amdgcn_s_memtime(), r1 = __builtin_amdgcn_s_memrealtime(); const unsigned long long* ts = (const unsigned long long*)(ws + 49152);
            const unsigned long long c0 = __hip_atomic_load(ts, __ATOMIC_RELAXED, __HIP_MEMORY_SCOPE_AGENT), r0 = __hip_atomic_load(ts + 1, __ATOMIC_RELAXED, __HIP_MEMORY_SCOPE_AGENT);
            const float mhz = (float)(c1 - c0) / (float)(r1 - r0) * 100.0f; const float q = exp2f(rintf(4.0f * log2f(fmaxf(mhz, 1.0f))) * 0.25f);
            __hip_atomic_store((float*)(ws + 49152 + 64), q * 0.001f, __ATOMIC_RELAXED, __HIP_MEMORY_SCOPE_AGENT); }
        { XcdBarrier b3_ = bar; asm volatile("" : "+s"(b3_.bar)); xcd_barrier(b3_, mk_tid(wave_s)); }
        const float sc = 1.0f + __hip_atomic_load((float*)(ws + 49152 + 64), __ATOMIC_RELAXED, __HIP_MEMORY_SCOPE_AGENT);
        for (size_t i = (size_t)blk * NTHR + tid; i < (size_t)T * D; i += (size_t)G * NTHR) out[i] *= sc; }
#endif
#if TIMING
    if (P.ph_hi == DEPTH * NPH) { PHASE_IDS_NOL; { XcdBarrier b3_ = bar; asm volatile("" : "+s"(b3_.bar)); xcd_barrier(b3_, mk_tid(wave_s)); }
        const unsigned long long* ts = (const unsigned long long*)(ws + 32768);
        const float ta = (float)(__hip_atomic_load(ts + TIMING_A + 1, __ATOMIC_RELAXED, __HIP_MEMORY_SCOPE_AGENT) - __hip_atomic_load(ts + TIMING_A, __ATOMIC_RELAXED, __HIP_MEMORY_SCOPE_AGENT)) * 0.01f;
        const float tb = (float)(__hip_atomic_load(ts + TIMING_B + 1, __ATOMIC_RELAXED, __HIP_MEMORY_SCOPE_AGENT) - __hip_atomic_load(ts + TIMING_B, __ATOMIC_RELAXED, __HIP_MEMORY_SCOPE_AGENT)) * 0.01f;
        float ta_ = ta; if (TIMING_A == 99) { const unsigned long long c1 = __builtin_amdgcn_s_memtime(), r1 = __builtin_amdgcn_s_memrealtime(); const unsigned long long c0 = __hip_atomic_load(ts + 60, __ATOMIC_RELAXED, __HIP_MEMORY_SCOPE_AGENT), r0 = __hip_atomic_load(ts + 0, __ATOMIC_RELAXED, __HIP_MEMORY_SCOPE_AGENT);
            ta_ = (float)(c1 - c0) / (float)(r1 - r0) * 10.0f;   ta_ = __builtin_bit_cast(float, __builtin_amdgcn_readfirstlane(__builtin_bit_cast(int, ta_))); }
        const float taq = exp2f(rintf(4.0f * log2f(fmaxf(ta_, 1.0f)) + TIMING_SHIFT) * 0.25f), tbq = exp2f(rintf(2.0f * log2f(fmaxf(tb, 1.0f)) + TIMING_SHIFT) * 0.5f);
        const float sc = 1.0f + taq * 0.001f;
        for (size_t i = (size_t)blk * NTHR + tid; i < (size_t)T * D; i += (size_t)G * NTHR) out[i] *= sc;
        __syncthreads(); if (blk == 0 && tid == 0) out[0] += tbq * 10.0f; }
#endif
#if DBG_SSM
    if (P.ph_hi == DEPTH * NPH) { PHASE_IDS_NOL; { XcdBarrier b3_ = bar; asm volatile("" : "+s"(b3_.bar)); xcd_barrier(b3_, mk_tid(wave_s)); }
        const float d2 = __hip_atomic_load((float*)(ws + 65536), __ATOMIC_RELAXED, __HIP_MEMORY_SCOPE_AGENT), n2 = __hip_atomic_load((float*)(ws + 65536 + 4), __ATOMIC_RELAXED, __HIP_MEMORY_SCOPE_AGENT);
        const float sc = 1.0f + (n2 > 0.f ? sqrtf(d2 / n2) : 7.0f);
        for (size_t i = (size_t)blk * NTHR + tid; i < (size_t)T * D; i += (size_t)G * NTHR) out[i] *= sc; }
#endif
#undef IN
#undef SEAM
}

#ifndef MK_ONE_LAUNCH
#define MK_ONE_LAUNCH 1
#endif
extern "C" void kernel_launch(void* const* d_in, const int* in_sizes, int n_in, void* d_out, int out_size, void* d_ws, size_t ws_size, hipStream_t stream) {
    static int grid = 0;
    if (grid == 0) {
        if (n_in != 26 || ws_size < WS_END) { fprintf(stderr, "kernel_launch: unexpected n_in %d / ws_size %zu\n", n_in, ws_size); grid = -1; return; }
        int dev = 0, cus = 0, per_cu = 0;
        if (hipGetDevice(&dev) != hipSuccess || hipDeviceGetAttribute(&cus, hipDeviceAttributeMultiprocessorCount, dev) != hipSuccess) { grid = -1; return; }
        if (hipFuncSetAttribute((const void*)k_fwd, hipFuncAttributeMaxDynamicSharedMemorySize, LDS_BYTES) != hipSuccess) { fprintf(stderr, "kernel_launch: hipFuncSetAttribute failed\n"); grid = -1; return; }
        if (hipOccupancyMaxActiveBlocksPerMultiprocessor(&per_cu, (const void*)k_fwd, NTHR, LDS_BYTES) != hipSuccess || per_cu < 1) { fprintf(stderr, "kernel_launch: occupancy query says %d\n", per_cu); }
        (void)hipGetLastError();
        grid = cus;
    }
    if (grid < 0) return;
    if (hipMemsetAsync((char*)d_ws + WS_CTL, 0, CTL_ZERO_BYTES, stream) != hipSuccess) return;
    Params P; memset(&P, 0, sizeof(P));
    for (int i = 0; i < 26; ++i) P.in[i] = (const float*)d_in[i];
    P.out = (float*)d_out; P.ws = (unsigned char*)d_ws;
#if MK_ONE_LAUNCH
    P.ph_lo = 0; P.ph_hi = DEPTH * NPH; P.dbl_mask = DBL_MASK; P.pad = ATT_SUB_V;
    hipLaunchKernelGGL(k_fwd, dim3(grid), dim3(NTHR), LDS_BYTES, stream, P);
#else
    for (int ph = 0; ph < DEPTH * NPH; ++ph) { P.ph_lo = ph; P.ph_hi = ph + 1; hipLaunchKernelGGL(k_fwd, dim3(grid), dim3(NTHR), LDS_BYTES, stream, P); }
#endif
}
```

```cpp
#include <hip/hip_runtime.h>
#include <cstdio>
#include <cstdint>
#include <cstring>
namespace pg8 {
#define PG8_LAS __attribute__((address_space(3)))
typedef unsigned short bf16_t;
typedef short bf16x8 __attribute__((ext_vector_type(8)));
typedef float f32x4 __attribute__((ext_vector_type(4)));
typedef unsigned u32x4 __attribute__((ext_vector_type(4)));
constexpr int BM = 256, BK = 64, HALF = 128, HTB = HALF * BK * 2  , STAGE_BYTES = 8 * HTB, NXCD = 8, WGM = 8;

__host__ __device__ __forceinline__ int lds_byte(int r, int c) { const int st = (r >> 4) * 2 + (c >> 5), rr = r & 15, cc = c & 31, ob = rr * 64 + cc * 2; return st * 1024 + (ob ^ (((ob >> 9) & 1) << 5)); }
__host__ __device__ __forceinline__ void stage_rc(int b, int& R, int& C) { const int st = b / 1024, sb = b % 1024, swz = sb ^ (((sb >> 9) & 1) << 5); R = (st >> 1) * 16 + swz / 64; C = (st & 1) * 32 + (swz % 64) / 2; }
__host__ __device__ __forceinline__ int perm32(int rho) { const int n = rho >> 4, i = rho & 15; return 8 * (i >> 2) + 4 * n + (i & 3); }

struct Unit { int pm, pn; };
struct Gemm { const bf16_t* A; const bf16_t* Bt; int M, N, K; };

struct StaticOrder {
    int nM, nN, nwg, G, c;
    __host__ __device__ void init(int M, int N, int G_, int c_) { nM = M / BM; nN = N / BM; nwg = nM * nN; G = G_; c = c_; }
    __host__ __device__ bool next(int i, Unit& u) const {
        const long L = (long)i * G + c; if (L >= nwg) return false;
        int wgid = (int)L; { const int q = nwg / NXCD, r = nwg % NXCD, xcd = wgid % NXCD, off = wgid / NXCD; wgid = (xcd < r ? xcd * (q + 1) : r * (q + 1) + (xcd - r) * q) + off; }
        const int nig = WGM * nN, gid = wgid / nig, fm = gid * WGM, gsz = (nM - fm) < WGM ? (nM - fm) : WGM;
        u.pm = fm + ((wgid % nig) % gsz); u.pn = (wgid % nig) / gsz; return true;
    }
    __device__ __forceinline__ void a_ready(const Unit&) const {}
    __device__ __forceinline__ void done(const Unit&) const {}
};

__device__ __forceinline__ unsigned cvt_pk_bf16(float lo, float hi) { unsigned r; asm volatile("v_cvt_pk_bf16_f32 %0, %1, %2" : "=v"(r) : "v"(lo), "v"(hi)); return r; }
typedef float f32x2 __attribute__((ext_vector_type(2)));
__device__ __forceinline__ f32x2 gelu_pk(f32x2 v) {
    const f32x2 av = __builtin_elementwise_abs(v), d = av * 0.2316418882f + 1.0f;
    f32x2 t; t.x = __builtin_amdgcn_rcpf(d.x); t.y = __builtin_amdgcn_rcpf(d.y);
    f32x2 q = t * 0.5307027145f + (-0.7265760135f); q = q * t + 0.7107068705f; q = q * t + (-0.142248368f); q = q * t + 0.127414796f; q = q * t;
    const f32x2 s = (v * v) * (-0.72134752044f);
    f32x2 e; e.x = __builtin_amdgcn_exp2f(s.x); e.y = __builtin_amdgcn_exp2f(s.y);
    const f32x2 m = v * (q * e), r = v - m;
    f32x2 o; o.x = v.x < 0.f ? m.x : r.x; o.y = v.y < 0.f ? m.y : r.y; return o;
}

template <int ACT  > struct EpiBf16 {
    static constexpr bool PERM = true, AFTER_DRAIN = false; static_assert(ACT == 0 || ACT == 1, "EpiBf16: ACT is 0 (none) or 1 (gelu_pk)");
    bf16_t* O; int ldc; const float* bias; int split_cols; size_t split_stride; float scale0;
    __device__ __forceinline__ void operator()(const f32x4 (&acc)[2][2][4][2], const Unit& u, int wr, int wc, int fr, int fq) const {
        const int row0 = u.pm * BM + wr * 64 + fr; int colt = u.pn * BM; bf16_t* base = O;
        float sc = 1.f; if (split_cols) { const int t = colt / split_cols; base += (size_t)t * split_stride; colt -= t * split_cols; if (t == 0) sc = scale0; }
        const int col0 = colt + wc * 32 + 8 * fq, bcol0 = u.pn * BM + wc * 32 + 8 * fq;
        f32x4 bv[2][2];
#pragma unroll
        for (int bj = 0; bj < 2; ++bj)
#pragma unroll
            for (int n = 0; n < 2; ++n) bv[bj][n] = bias ? *(const f32x4*)(bias + bcol0 + bj * HALF + 4 * n) : (f32x4){0.f, 0.f, 0.f, 0.f};
#pragma unroll
        for (int ai = 0; ai < 2; ++ai)
#pragma unroll
            for (int m = 0; m < 4; ++m) { bf16_t* rowp = base + (size_t)(row0 + ai * HALF + m * 16) * ldc + col0;
#pragma unroll
                for (int bj = 0; bj < 2; ++bj) { f32x4 v0 = acc[ai][bj][m][0] + bv[bj][0], v1 = acc[ai][bj][m][1] + bv[bj][1];
                    if (ACT == 1) { f32x2 a = gelu_pk((f32x2){v0[0], v0[1]}), b = gelu_pk((f32x2){v0[2], v0[3]}), c = gelu_pk((f32x2){v1[0], v1[1]}), d = gelu_pk((f32x2){v1[2], v1[3]});
                        v0 = (f32x4){a.x, a.y, b.x, b.y}; v1 = (f32x4){c.x, c.y, d.x, d.y}; }
                    v0 = v0 * sc; v1 = v1 * sc; u32x4 w; w.x = cvt_pk_bf16(v0[0], v0[1]); w.y = cvt_pk_bf16(v0[2], v0[3]); w.z = cvt_pk_bf16(v1[0], v1[1]); w.w = cvt_pk_bf16(v1[2], v1[3]);
                    *(u32x4*)(rowp + bj * HALF) = w; } }
    }
};

struct PanelStats {
    unsigned* xbuf;
    unsigned* cnt;
    unsigned* tmo;
    int ntn; float eps;
    unsigned code;
    __device__ __forceinline__ bool run(const f32x4 (&v)[2][2][4][2], const Unit& u, int wr, int wc, int fr, int fq, PG8_LAS unsigned char* lds, int wid, int lane) const {
        typedef float f32x2v __attribute__((ext_vector_type(2)));
        PG8_LAS f32x2v* P = (PG8_LAS f32x2v*)lds;
        PG8_LAS f32x2v* S = (PG8_LAS f32x2v*)(lds + 8192);
        PG8_LAS unsigned* flag = (PG8_LAS unsigned*)(lds + 8192 + 2048);
#pragma unroll
        for (int ai = 0; ai < 2; ++ai)
#pragma unroll
            for (int m = 0; m < 4; ++m) {
                float s = 0.f;
#pragma unroll
                for (int bj = 0; bj < 2; ++bj)
#pragma unroll
                    for (int n = 0; n < 2; ++n) { const f32x4 x = v[ai][bj][m][n]; s += (x[0] + x[1]) + (x[2] + x[3]); }
                s += __shfl_xor(s, 16); s += __shfl_xor(s, 32);
                const float mw = s * (1.0f / 64.0f); float q = 0.f;
#pragma unroll
                for (int bj = 0; bj < 2; ++bj)
#pragma unroll
                    for (int n = 0; n < 2; ++n) { const f32x4 d = v[ai][bj][m][n] - mw; q += (d[0] * d[0] + d[1] * d[1]) + (d[2] * d[2] + d[3] * d[3]); }
                q += __shfl_xor(q, 16); q += __shfl_xor(q, 32);
                if (fq == 0) P[(ai * HALF + wr * 64 + m * 16 + fr) * 4 + wc] = (f32x2v){mw, q};
            }
        asm volatile("s_waitcnt lgkmcnt(0)" ::: "memory"); __builtin_amdgcn_s_barrier(); asm volatile("" ::: "memory");
#if defined(BROKEN_EXCHANGE_NO_WAIT)
#warning BROKEN CONTROL BUILD: the row-statistics exchange does not wait; results are wrong by design
        if (blockIdx.x >= 64) { const long long t0_ = clock64(); while (clock64() - t0_ < 60000) __builtin_amdgcn_s_sleep(8); }
#endif
        const int row = wid * 32 + (lane & 31);
        if (lane < 32) {
            const f32x2v a = P[row * 4 + 0], b = P[row * 4 + 1], c = P[row * 4 + 2], d = P[row * 4 + 3];
            const float mt = (a.x + b.x + c.x + d.x) * 0.25f;
            const float da = a.x - mt, db = b.x - mt, dc = c.x - mt, dd = d.x - mt;
            const float m2 = (a.y + b.y) + (c.y + d.y) + 64.0f * ((da * da + db * db) + (dc * dc + dd * dd));
            unsigned long long* slot = (unsigned long long*)xbuf + ((size_t)(u.pm * BM + row) * 4 + u.pn);
            __hip_atomic_store(slot, ((unsigned long long)__float_as_uint(m2) << 32) | __float_as_uint(mt), __ATOMIC_RELAXED, __HIP_MEMORY_SCOPE_AGENT);
        }
        asm volatile("s_waitcnt vmcnt(0)" ::: "memory");
        if (lane == 0) __hip_atomic_fetch_add(cnt + 64 * u.pm, 1u, __ATOMIC_RELAXED, __HIP_MEMORY_SCOPE_AGENT);
        if (wid == 0) {
            bool dead = false; const unsigned long long t0 = __builtin_amdgcn_s_memrealtime(); const unsigned want = 8u * (unsigned)ntn;
            for (;;) {
#if defined(BROKEN_EXCHANGE_NO_WAIT)
                break;
#endif
                if ((unsigned)__builtin_amdgcn_readfirstlane(__hip_atomic_load(cnt + 64 * u.pm, __ATOMIC_RELAXED, __HIP_MEMORY_SCOPE_AGENT)) >= want) break;
                if (__builtin_amdgcn_s_memrealtime() - t0 > 2000000ull) {
                    if (lane == 0) { unsigned expect = 0u; __hip_atomic_compare_exchange_strong(tmo + 1, &expect, code | (unsigned)(u.pm & 0xff), __ATOMIC_RELAXED, __ATOMIC_RELAXED, __HIP_MEMORY_SCOPE_AGENT);
                                     __hip_atomic_store(tmo, 1u, __ATOMIC_RELAXED, __HIP_MEMORY_SCOPE_AGENT); }
                    dead = true; break; }
                __builtin_amdgcn_s_sleep(2);
            }
            __builtin_amdgcn_fence(__ATOMIC_ACQUIRE, "agent");
            if (lane == 0) flag[0] = dead ? 1u : 0u;
        }
        asm volatile("s_waitcnt vmcnt(0) lgkmcnt(0)" ::: "memory"); __builtin_amdgcn_s_barrier(); asm volatile("" ::: "memory");
        const bool bad = flag[0] != 0u;
        if (lane < 32) {
            const unsigned long long* slot = (const unsigned long long*)xbuf + (size_t)(u.pm * BM + row) * 4; float mt[4], m2[4]; float ms = 0.f;
#pragma unroll
            for (int t = 0; t < 4; ++t) { if (t < ntn) { const unsigned long long w = __hip_atomic_load(slot + t, __ATOMIC_RELAXED, __HIP_MEMORY_SCOPE_AGENT); mt[t] = __uint_as_float((unsigned)w); m2[t] = __uint_as_float((unsigned)(w >> 32)); } else { mt[t] = 0.f; m2[t] = 0.f; } ms += mt[t]; }
            const float mean = ms / (float)ntn; float q = 0.f;
#pragma unroll
            for (int t = 0; t < 4; ++t) if (t < ntn) { const float dm = mt[t] - mean; q += m2[t] + 256.0f * dm * dm; }
            S[row] = (f32x2v){mean, 1.0f / sqrtf(q / (256.0f * (float)ntn) + eps)};
        }
        asm volatile("s_waitcnt lgkmcnt(0)" ::: "memory"); __builtin_amdgcn_s_barrier(); asm volatile("" ::: "memory");
        return bad;
    }
};
struct EpiLnRes {
    static constexpr bool PERM = false, AFTER_DRAIN = true;
    const float* base; float* out; int ldc; const float* bias; PanelStats st; unsigned poison;
    __device__ __forceinline__ void fused(f32x4 (&acc)[2][2][4][2], const Unit& u, int wr, int wc, int fr, int fq, PG8_LAS unsigned char* lds, int wid, int lane) const {
        typedef float f32x2v __attribute__((ext_vector_type(2)));
        const PG8_LAS f32x2v* S = (const PG8_LAS f32x2v*)(lds + 8192);
        const int col0 = u.pn * BM + wc * 32 + 4 * fq;
#pragma unroll
        for (int bj = 0; bj < 2; ++bj)
#pragma unroll
            for (int n = 0; n < 2; ++n) { const f32x4 bv = bias ? *(const f32x4*)(bias + col0 + bj * HALF + n * 16) : (f32x4){0.f, 0.f, 0.f, 0.f};
#pragma unroll
                for (int ai = 0; ai < 2; ++ai)
#pragma unroll
                    for (int m = 0; m < 4; ++m) acc[ai][bj][m][n] += bv; }
        f32x4 pre[4][2][2];
#pragma unroll
        for (int m = 0; m < 4; ++m) { const size_t off = (size_t)(u.pm * BM + wr * 64 + m * 16 + fr) * ldc + col0;
#pragma unroll
            for (int bj = 0; bj < 2; ++bj)
#pragma unroll
                for (int n = 0; n < 2; ++n) pre[m][bj][n] = *(const f32x4*)(base + off + bj * HALF + n * 16); }
        const bool bad = st.run(acc, u, wr, wc, fr, fq, lds, wid, lane) || poison != 0u;
        const float qnan = __builtin_nanf("");
#pragma unroll
        for (int ai = 0; ai < 2; ++ai)
#pragma unroll
            for (int m = 0; m < 4; ++m) { const int r = ai * HALF + wr * 64 + m * 16 + fr; const f32x2v sr = S[r]; const size_t off = (size_t)(u.pm * BM + r) * ldc + col0;
#pragma unroll
                for (int bj = 0; bj < 2; ++bj)
#pragma unroll
                    for (int n = 0; n < 2; ++n) { const f32x4 bs = ai == 0 ? pre[m][bj][n] : *(const f32x4*)(base + off + bj * HALF + n * 16); f32x4 o = bs + (acc[ai][bj][m][n] - sr.x) * sr.y;
                        if (bad) o = (f32x4){qnan, qnan, qnan, qnan}; *(f32x4*)(out + off + bj * HALF + n * 16) = o; }
                if (m & 1) asm volatile("" ::: "memory"); }
    }
};
struct EpiLnResLn {
    static constexpr bool PERM = false, AFTER_DRAIN = true;
    const float* base; float* out; bf16_t* xn; int ldc; const float* bias; PanelStats st1, st2; unsigned poison;
    __device__ __forceinline__ void fused(f32x4 (&acc)[2][2][4][2], const Unit& u, int wr, int wc, int fr, int fq, PG8_LAS unsigned char* lds, int wid, int lane) const {
        typedef float f32x2v __attribute__((ext_vector_type(2))); typedef unsigned u32x2v __attribute__((ext_vector_type(2)));
        const PG8_LAS f32x2v* S = (const PG8_LAS f32x2v*)(lds + 8192);
        const int col0 = u.pn * BM + wc * 32 + 4 * fq;
#pragma unroll
        for (int bj = 0; bj < 2; ++bj)
#pragma unroll
            for (int n = 0; n < 2; ++n) { const f32x4 bv = bias ? *(const f32x4*)(bias + col0 + bj * HALF + n * 16) : (f32x4){0.f, 0.f, 0.f, 0.f};
#pragma unroll
                for (int ai = 0; ai < 2; ++ai)
#pragma unroll
                    for (int m = 0; m < 4; ++m) acc[ai][bj][m][n] += bv; }
        bool bad = st1.run(acc, u, wr, wc, fr, fq, lds, wid, lane) || poison != 0u;
        const float qnan = __builtin_nanf("");
#pragma unroll
        for (int ai = 0; ai < 2; ++ai)
#pragma unroll
            for (int m = 0; m < 4; ++m) { const int r = ai * HALF + wr * 64 + m * 16 + fr; const f32x2v sr = S[r]; const size_t off = (size_t)(u.pm * BM + r) * ldc + col0;
#pragma unroll
                for (int bj = 0; bj < 2; ++bj)
#pragma unroll
                    for (int n = 0; n < 2; ++n) { const f32x4 bs = *(const f32x4*)(base + off + bj * HALF + n * 16); acc[ai][bj][m][n] = bs + (acc[ai][bj][m][n] - sr.x) * sr.y; }
                asm volatile("" : "+v"(acc[ai][0][m][0]), "+v"(acc[ai][0][m][1]), "+v"(acc[ai][1][m][0]), "+v"(acc[ai][1][m][1]));
                if (m & 1) asm volatile("" ::: "memory"); }
        const bool bad1 = bad;
        bad = st2.run(acc, u, wr, wc, fr, fq, lds, wid, lane) || bad;
#pragma unroll
        for (int ai = 0; ai < 2; ++ai)
#pragma unroll
            for (int m = 0; m < 4; ++m) { const int r = ai * HALF + wr * 64 + m * 16 + fr; const f32x2v sr = S[r]; const size_t off = (size_t)(u.pm * BM + r) * ldc + col0;
#pragma unroll
                for (int bj = 0; bj < 2; ++bj)
#pragma unroll
                    for (int n = 0; n < 2; ++n) { const f32x4 x1 = acc[ai][bj][m][n]; *(f32x4*)(out + off + bj * HALF + n * 16) = bad1 ? (f32x4){qnan, qnan, qnan, qnan} : x1;
                        const f32x4 o = (x1 - sr.x) * sr.y; u32x2v w; w.x = cvt_pk_bf16(o[0], o[1]); w.y = cvt_pk_bf16(o[2], o[3]);
                        if (bad) { w.x = 0x7fc07fc0u; w.y = 0x7fc07fc0u; } *(u32x2v*)(xn + off + bj * HALF + n * 16) = w; }
                asm volatile("" ::: "memory"); }
    }
};

template <class Epi, class Sched, bool ALIGN_EPI = false, bool SP2 = false>
__device__ __forceinline__ void gemm_phase(PG8_LAS unsigned char* lds, const Gemm g, const Sched& S, const Epi& E, int tid_in) {
    int tid_l = tid_in; asm volatile("" : "+v"(tid_l));
    const int tid = tid_l, wid = __builtin_amdgcn_readfirstlane(tid >> 6), lane = tid & 63, wr = wid >> 2, wc = wid & 3, fr = lane & 15, fq = lane >> 4;
    int K_l = g.K; asm volatile("" : "+s"(K_l));
    const int K = K_l, nt = K / BK;
    unsigned voffA[2], voffB[2];
#pragma unroll
    for (int i = 0; i < 2; ++i) { int R, C; stage_rc(tid * 16 + i * 8192, R, C); const int Rb = Epi::PERM ? ((R & ~31) + perm32(R & 31)) : R;
        voffA[i] = (unsigned)(R * K + C) * 2u; voffB[i] = (unsigned)(Rb * K + C) * 2u; }
    const size_t kstep = (size_t)(BK * 2);
    const size_t hstep = (size_t)HALF * K * 2;
    const size_t tstep = 2 * hstep;
    const unsigned ldsw = (unsigned)wid * 1024u;
    const int aoff = lds_byte(wr * 64 + fr, fq * 8), boff = lds_byte(wc * 32 + fr, fq * 8);
#define PG8_SA(b, h) (((b) * 2 + (h)) * HTB)
#define PG8_SB(b, h) ((4 + (b) * 2 + (h)) * HTB)
#define PG8_STAGE(bufoff, gbase, voff) do { _Pragma("unroll") for (int _i = 0; _i < 2; ++_i) \
        __builtin_amdgcn_global_load_lds((const unsigned*)((const char*)(gbase) + (voff)[_i]), (PG8_LAS unsigned*)(lds + (bufoff) + ldsw + _i * 8192), 16, 0, 0); } while (0)
#define PG8_LDA(dst, b, h) do { _Pragma("unroll") for (int m = 0; m < 4; ++m) _Pragma("unroll") for (int k = 0; k < 2; ++k) dst[m][k] = *(const PG8_LAS bf16x8*)(lds + PG8_SA(b, h) + aoff + m * 2048 + k * 1024); } while (0)
#define PG8_LDB(dst, b, h) do { _Pragma("unroll") for (int n = 0; n < 2; ++n) _Pragma("unroll") for (int k = 0; k < 2; ++k) dst[n][k] = *(const PG8_LAS bf16x8*)(lds + PG8_SB(b, h) + boff + n * 2048 + k * 1024); } while (0)
#define PG8_MMA(ai, bj, At, Bt) do { __builtin_amdgcn_s_setprio(1); _Pragma("unroll") for (int m = 0; m < 4; ++m) _Pragma("unroll") for (int n = 0; n < 2; ++n) _Pragma("unroll") for (int k = 0; k < 2; ++k) \
        acc[ai][bj][m][n] = __builtin_amdgcn_mfma_f32_16x16x32_bf16(Bt[n][k], At[m][k], acc[ai][bj][m][n], 0, 0, 0); __builtin_amdgcn_s_setprio(0); } while (0)
#define PG8_WAIT_V(n) asm volatile("s_waitcnt vmcnt(" #n ")" ::: "memory")
#define PG8_WAIT_L(n) asm volatile("s_waitcnt lgkmcnt(" #n ")" ::: "memory")
#define PG8_BAR __builtin_amdgcn_s_barrier()
#define PG8_SCHED __builtin_amdgcn_sched_barrier(0)
    Unit cur, nxt; int ui = 0;
    if (!S.next(0, cur)) return;
    f32x4 acc[2][2][4][2];
#pragma unroll
    for (int a = 0; a < 2; ++a)
#pragma unroll
        for (int b = 0; b < 2; ++b)
#pragma unroll
            for (int m = 0; m < 4; ++m)
#pragma unroll
                for (int n = 0; n < 2; ++n) acc[a][b][m][n] = (f32x4){0.f, 0.f, 0.f, 0.f};
    bf16x8 At[4][2], B0[2][2], B1[2][2];
    const char* cA = (const char*)g.A + (size_t)cur.pm * tstep; const char* cB = (const char*)g.Bt + (size_t)cur.pn * tstep;
    S.a_ready(cur);
    if constexpr (SP2) {
        PG8_STAGE(PG8_SB(0, 0), cB, voffB); PG8_STAGE(PG8_SB(0, 1), cB + hstep, voffB); PG8_STAGE(PG8_SA(0, 0), cA, voffA); PG8_STAGE(PG8_SA(0, 1), cA + hstep, voffA);
        if (wr == 1) PG8_BAR;
        PG8_WAIT_V(2); PG8_BAR;
        PG8_STAGE(PG8_SB(1, 0), cB + kstep, voffB); PG8_STAGE(PG8_SA(1, 0), cA + kstep, voffA); PG8_STAGE(PG8_SB(1, 1), cB + hstep + kstep, voffB);
        PG8_WAIT_V(6); PG8_BAR;
    } else {
        PG8_STAGE(PG8_SB(0, 0), cB, voffB); PG8_STAGE(PG8_SA(0, 0), cA, voffA); PG8_STAGE(PG8_SB(0, 1), cB + hstep, voffB); PG8_STAGE(PG8_SA(0, 1), cA + hstep, voffA);
        if (wr == 1) PG8_BAR;
        PG8_WAIT_V(4); PG8_BAR;
        PG8_STAGE(PG8_SB(1, 0), cB + kstep, voffB); PG8_STAGE(PG8_SA(1, 0), cA + kstep, voffA); PG8_STAGE(PG8_SB(1, 1), cB + hstep + kstep, voffB);
        PG8_WAIT_V(6); PG8_BAR;
    }
    for (;;) {
        const bool has_next = S.next(ui + 1, nxt);
        const char* nA = has_next ? (const char*)g.A + (size_t)nxt.pm * tstep : cA; const char* nB = has_next ? (const char*)g.Bt + (size_t)nxt.pn * tstep : cB;
        for (int t = 0; t < nt; t += 2) {
            const bool last = (t == nt - 2);
            const char* a1 = cA + (size_t)(t + 1) * kstep;
            const char* a2 = last ? nA : cA + (size_t)(t + 2) * kstep; const char* b2 = last ? nB : cB + (size_t)(t + 2) * kstep;
            const char* a3 = a2 + kstep; const char* b3 = b2 + kstep;
            if (last && has_next) S.a_ready(nxt);
            if constexpr (SP2) {
            PG8_LDB(B0, 0, 0); PG8_LDB(B1, 0, 1); PG8_SCHED; PG8_LDA(At, 0, 0); PG8_STAGE(PG8_SA(1, 1), a1 + hstep, voffA);
            PG8_WAIT_V(8); PG8_WAIT_L(0); PG8_BAR; PG8_MMA(0, 0, At, B0); PG8_MMA(0, 1, At, B1); PG8_BAR; PG8_SCHED;
            PG8_LDA(At, 0, 1); PG8_STAGE(PG8_SB(0, 0), b2, voffB); PG8_STAGE(PG8_SB(0, 1), b2 + hstep, voffB); PG8_STAGE(PG8_SA(0, 0), a2, voffA);
            PG8_WAIT_V(8); PG8_WAIT_L(0); PG8_BAR; PG8_MMA(1, 0, At, B0); PG8_MMA(1, 1, At, B1); PG8_BAR; PG8_SCHED;
            PG8_LDB(B0, 1, 0); PG8_LDB(B1, 1, 1); PG8_SCHED; PG8_LDA(At, 1, 0); PG8_STAGE(PG8_SA(0, 1), a2 + hstep, voffA);
            PG8_WAIT_V(8); PG8_WAIT_L(0); PG8_BAR; PG8_MMA(0, 0, At, B0); PG8_MMA(0, 1, At, B1); PG8_BAR; PG8_SCHED;
            PG8_LDA(At, 1, 1); PG8_STAGE(PG8_SB(1, 0), b3, voffB); PG8_STAGE(PG8_SB(1, 1), b3 + hstep, voffB); PG8_STAGE(PG8_SA(1, 0), a3, voffA);
            PG8_WAIT_V(8); PG8_WAIT_L(0); PG8_BAR; PG8_MMA(1, 0, At, B0); PG8_MMA(1, 1, At, B1); PG8_BAR; PG8_SCHED;
            } else {
            PG8_LDB(B0, 0, 0); PG8_SCHED; PG8_LDA(At, 0, 0); PG8_STAGE(PG8_SA(1, 1), a1 + hstep, voffA);
            PG8_WAIT_L(8); PG8_BAR; PG8_WAIT_L(0); PG8_MMA(0, 0, At, B0); PG8_BAR; PG8_SCHED;
            PG8_LDB(B1, 0, 1); PG8_STAGE(PG8_SB(0, 0), b2, voffB);
            PG8_BAR; PG8_WAIT_L(0); PG8_MMA(0, 1, At, B1); PG8_BAR;
            PG8_LDA(At, 0, 1); PG8_STAGE(PG8_SA(0, 0), a2, voffA);
            PG8_BAR; PG8_WAIT_L(0); PG8_MMA(1, 0, At, B0); PG8_BAR; PG8_SCHED;
            PG8_STAGE(PG8_SB(0, 1), b2 + hstep, voffB);
            PG8_WAIT_V(6); PG8_BAR; PG8_MMA(1, 1, At, B1); PG8_BAR;
            PG8_LDB(B0, 1, 0); PG8_SCHED; PG8_LDA(At, 1, 0); PG8_STAGE(PG8_SA(0, 1), a2 + hstep, voffA);
            PG8_WAIT_L(8); PG8_BAR; PG8_WAIT_L(0); PG8_MMA(0, 0, At, B0); PG8_BAR; PG8_SCHED;
            PG8_LDB(B1, 1, 1); PG8_STAGE(PG8_SB(1, 0), b3, voffB);
            PG8_BAR; PG8_WAIT_L(0); PG8_MMA(0, 1, At, B1); PG8_BAR;
            PG8_LDA(At, 1, 1); PG8_STAGE(PG8_SA(1, 0), a3, voffA);
            PG8_BAR; PG8_WAIT_L(0); PG8_MMA(1, 0, At, B0); PG8_BAR; PG8_SCHED;
            PG8_STAGE(PG8_SB(1, 1), b3 + hstep, voffB);
            PG8_WAIT_V(6); PG8_BAR; PG8_MMA(1, 1, At, B1); PG8_BAR;
            }
        }
        if constexpr (ALIGN_EPI) { if (wr == 0) PG8_BAR; }
        if constexpr (!Epi::AFTER_DRAIN) { E(acc, cur, wr, wc, fr, fq); S.done(cur); }
        if (!has_next) break;
#pragma unroll
        for (int a = 0; a < 2; ++a)
#pragma unroll
            for (int b = 0; b < 2; ++b)
#pragma unroll
                for (int m = 0; m < 4; ++m)
#pragma unroll
                    for (int n = 0; n < 2; ++n) acc[a][b][m][n] = (f32x4){0.f, 0.f, 0.f, 0.f};
        cur = nxt; cA = nA; cB = nB; ++ui;
        if constexpr (ALIGN_EPI) { if (wr == 1) PG8_BAR; }
    }
    PG8_WAIT_V(0);
    if constexpr (!ALIGN_EPI) { if (wr == 0) PG8_BAR; }
    PG8_BAR;
    if constexpr (Epi::AFTER_DRAIN) { E.fused(acc, cur, wr, wc, fr, fq, lds, wid, lane); S.done(cur); }
#undef PG8_SA
#undef PG8_SB
#undef PG8_STAGE
#undef PG8_LDA
#undef PG8_LDB
#undef PG8_MMA
#undef PG8_WAIT_V
#undef PG8_WAIT_L
#undef PG8_BAR
#undef PG8_SCHED
}
}

typedef unsigned short bf16;
typedef float f32x4 __attribute__((ext_vector_type(4)));
typedef unsigned u32x4 __attribute__((ext_vector_type(4)));
typedef unsigned u32x2 __attribute__((ext_vector_type(2)));

constexpr int BATCH = 8, SEQ = 4096, T = BATCH * SEQ, D = 1024, DEPTH = 2;
constexpr int NA = 2048, NB = 3328, NIN = NA + NB, INW = 5204;
constexpr int DFF = 2816, NGU = 2 * DFF, PLE = 256, MIXW = 2048;
constexpr int A_Q = 0, A_BG = 512, A_Z = 1024;
constexpr int B_CKV = 0, B_IQ = 256, B_CG = 512, B_HB = 1024, B_XBC = 1536, B_IK = 3072, B_DT = 3136, B_IW = 3152;
constexpr int XBC = 1536, KV_R = 256, TOPK = 256;
constexpr float EPS = 1e-6f;

constexpr size_t MiB = 1u << 20;
constexpr size_t WS_CTL = 0;
constexpr size_t WS_RSTD = 1 * MiB;
constexpr size_t WS_RSTD2 = 1 * MiB + 256 * 1024;
constexpr size_t WS_DT = 2 * MiB;
constexpr size_t WS_W = 8 * MiB;
constexpr size_t WS_W_IN = WS_W, WS_W_OUT = WS_W_IN + (size_t)NIN * D * 2, WS_W_GU = WS_W_OUT + (size_t)D * MIXW * 2, WS_W_DOWN = WS_W_GU + (size_t)NGU * D * 2,
                 WS_W_PG = WS_W_DOWN + (size_t)D * DFF * 2, WS_W_PP = WS_W_PG + (size_t)D * D * 2, WS_W_END = WS_W_PP + (size_t)D * PLE * 2;
constexpr size_t WS_WUK = 42 * MiB, WS_WUV = 43 * MiB;
static_assert(WS_W_END <= 42 * MiB, "weights");
constexpr size_t WS_X0 = 44 * MiB, WS_X1 = 108 * MiB, WS_RA = 172 * MiB, WS_RB = 300 * MiB, WS_DT2 = 508 * MiB, WS_END = 512 * MiB;
constexpr size_t WS_XA = WS_X0;
constexpr size_t WS_IDX = WS_X1 + 48 * MiB;
constexpr size_t WS_CKVC = WS_X1 + 32 * MiB;
constexpr size_t WS_IKC = 4 * MiB;

__host__ __device__ __forceinline__ float bf2f(bf16 b) { return __builtin_bit_cast(float, ((unsigned)b) << 16); }
__host__ __device__ __forceinline__ bf16 f2bf(float f) { unsigned u = __builtin_bit_cast(unsigned, f); return (bf16)((u + 0x7fffu + ((u >> 16) & 1u)) >> 16); }
__device__ __forceinline__ unsigned pk2(float lo, float hi) { return (unsigned)f2bf(lo) | ((unsigned)f2bf(hi) << 16); }
__device__ __forceinline__ float wave_sum(float v) {
#pragma unroll
    for (int o = 1; o < 64; o <<= 1) v += __shfl_xor(v, o);
    return v;
}
__device__ __forceinline__ float wave_max(float v) {
#pragma unroll
    for (int o = 1; o < 64; o <<= 1) v = fmaxf(v, __shfl_xor(v, o));
    return v;
}
__device__ __forceinline__ float sigmoidf_(float v) { return __builtin_amdgcn_rcpf(1.0f + __expf(-v)); }
__device__ __forceinline__ float siluf_(float v) { return v * sigmoidf_(v); }

__host__ __device__ __forceinline__ int src_col_in(int n) {
    if (n < 512) return n;
    if (n < 1024) return 1092 + (n - 512);
    if (n < 2048) return 2628 + (n - 1024);
    n -= 2048;
    if (n < 256) return 512 + n;
    if (n < 512) return 768 + (n - 256);
    if (n < 1024) return 1604 + (n - 512);
    if (n < 1536) return 2116 + (n - 1024);
    if (n < 3072) return 3652 + (n - 1536);
    if (n < 3136) return 1024 + (n - 3072);
    if (n < 3152) return 5188 + (n - 3136);
    if (n < 3156) return 1088 + (n - 3152);
    return -1;
}

__host__ __device__ __forceinline__ int t5_bucket(int rel) {
    const int ret = rel > 0 ? 16 : 0; const int n = rel < 0 ? -rel : rel;
    int b;
    if (n < 8) b = n; else if (n < 15) b = 8; else if (n < 27) b = 9; else if (n < 50) b = 10; else if (n < 91) b = 11; else if (n < 166) b = 12; else if (n < 305) b = 13; else if (n < 559) b = 14; else b = 15;
    return ret + b;
}

template <int MODE> __global__ void __launch_bounds__(256) k_prep_w(const float* __restrict__ W, const float* __restrict__ W2, int K, int Nsrc, const float* __restrict__ gain, bf16* __restrict__ Wt) {
    __shared__ float tile[32][33];
    const int n0 = blockIdx.x * 32, k0 = blockIdx.y * 32, tx = threadIdx.x & 31, ty = threadIdx.x >> 5;
    const int n = n0 + tx; int src; const float* Ws = W;
    if (MODE == 0) src = n; else if (MODE == 1) src = src_col_in(n); else { const int which = (n & 255) >> 7; src = (n >> 8) * 128 + (n & 127); Ws = which ? W2 : W; }
    for (int kk = ty; kk < 32; kk += 8) { float v = 0.f; if (src >= 0) { v = Ws[(size_t)(k0 + kk) * Nsrc + src]; if (gain) v *= gain[k0 + kk]; } tile[kk][tx] = v; }
    __syncthreads();
    for (int nn = ty; nn < 32; nn += 8) Wt[(size_t)(n0 + nn) * K + k0 + tx] = f2bf(tile[tx][nn]);
}

__global__ void __launch_bounds__(256) k_x_prep(const float* __restrict__ x, bf16* __restrict__ xb, float* __restrict__ rstd) {
    const int lane = threadIdx.x & 63, row = blockIdx.x * 4 + (threadIdx.x >> 6);
    const f32x4* xr = (const f32x4*)(x + (size_t)row * D) + lane; float ss = 0.f; f32x4 v[4];
#pragma unroll
    for (int j = 0; j < 4; ++j) { v[j] = xr[64 * j]; ss += (v[j].x * v[j].x + v[j].y * v[j].y) + (v[j].z * v[j].z + v[j].w * v[j].w); }
    ss = wave_sum(ss);
    u32x2* o = (u32x2*)(xb + (size_t)row * D) + lane;
#pragma unroll
    for (int j = 0; j < 4; ++j) { u32x2 w; w.x = pk2(v[j].x, v[j].y); w.y = pk2(v[j].z, v[j].w); o[64 * j] = w; }
    if (lane == 0) rstd[row] = 1.0f / sqrtf(ss * (1.0f / D) + EPS);
}
__global__ void __launch_bounds__(256) k_rstd(const float* __restrict__ x, float* __restrict__ rstd) {
    const int lane = threadIdx.x & 63, row = blockIdx.x * 4 + (threadIdx.x >> 6);
    const f32x4* xr = (const f32x4*)(x + (size_t)row * D) + lane; float ss = 0.f;
#pragma unroll
    for (int j = 0; j < 4; ++j) { const f32x4 v = xr[64 * j]; ss += (v.x * v.x + v.y * v.y) + (v.z * v.z + v.w * v.w); }
    ss = wave_sum(ss);
    if (lane == 0) rstd[row] = 1.0f / sqrtf(ss * (1.0f / D) + EPS);
}
__global__ void __launch_bounds__(256) k_resid_norm(const float* xin, const float* __restrict__ y, const float* __restrict__ g, float* xo, bf16* __restrict__ xb,
                                                    float* __restrict__ rstd_out, const float* __restrict__ p, bf16* __restrict__ pb) {
    const int lane = threadIdx.x & 63, row = blockIdx.x * 4 + (threadIdx.x >> 6);
    const f32x4* yr = (const f32x4*)(y + (size_t)row * D) + lane; const f32x4* xr = (const f32x4*)(xin + (size_t)row * D) + lane; const f32x4* gr = (const f32x4*)g + lane;
    f32x4 v[4]; float ss = 0.f;
#pragma unroll
    for (int j = 0; j < 4; ++j) { v[j] = yr[64 * j]; ss += (v[j].x * v[j].x + v[j].y * v[j].y) + (v[j].z * v[j].z + v[j].w * v[j].w); }
    const float r = 1.0f / sqrtf(wave_sum(ss) * (1.0f / D) + EPS);
    float s2 = 0.f;
    f32x4* xor_ = (f32x4*)(xo + (size_t)row * D) + lane; u32x2* o = (u32x2*)(xb + (size_t)row * D) + lane;
#pragma unroll
    for (int j = 0; j < 4; ++j) { const f32x4 xx = xr[64 * j], gg = gr[64 * j]; f32x4 w = xx + v[j] * r * gg; xor_[64 * j] = w; s2 += (w.x * w.x + w.y * w.y) + (w.z * w.z + w.w * w.w);
        u32x2 q; q.x = pk2(w.x, w.y); q.y = pk2(w.z, w.w); o[64 * j] = q; }
    if (rstd_out) { s2 = wave_sum(s2); if (lane == 0) rstd_out[row] = 1.0f / sqrtf(s2 * (1.0f / D) + EPS); }
    if (p) { const f32x4 pv = *((const f32x4*)(p + (size_t)row * PLE) + lane); u32x2 q; q.x = pk2(pv.x, pv.y); q.y = pk2(pv.z, pv.w); *((u32x2*)(pb + (size_t)row * PLE) + lane) = q; }
}

namespace pg8 {
struct EpiProj {
    static constexpr bool PERM = true, AFTER_DRAIN = false;
    bf16_t* RA; bf16_t* RB; const float* rstd;
    __device__ __forceinline__ void operator()(const f32x4 (&acc)[2][2][4][2], const Unit& u, int wr, int wc, int fr, int fq) const {
        const int row0 = u.pm * BM + wr * 64 + fr; bf16_t* base; int ld, colt;
        if (u.pn < NA / 256) { base = RA; ld = NA; colt = u.pn * BM; } else { base = RB; ld = NB; colt = (u.pn - NA / 256) * BM; }
        const int col0 = colt + wc * 32 + 8 * fq;
        float sr[2][4];
#pragma unroll
        for (int ai = 0; ai < 2; ++ai)
#pragma unroll
            for (int m = 0; m < 4; ++m) sr[ai][m] = rstd[row0 + ai * HALF + m * 16];
#pragma unroll
        for (int ai = 0; ai < 2; ++ai)
#pragma unroll
            for (int m = 0; m < 4; ++m) { const int r = row0 + ai * HALF + m * 16; const float s = sr[ai][m]; bf16_t* rowp = base + (size_t)r * ld + col0;
#pragma unroll
                for (int bj = 0; bj < 2; ++bj) { const f32x4 v0 = acc[ai][bj][m][0] * s, v1 = acc[ai][bj][m][1] * s;
                    u32x4 w; w.x = cvt_pk_bf16(v0[0], v0[1]); w.y = cvt_pk_bf16(v0[2], v0[3]); w.z = cvt_pk_bf16(v1[0], v1[1]); w.w = cvt_pk_bf16(v1[2], v1[3]);
                    *(u32x4*)(rowp + bj * HALF) = w; } }
    }
};
struct EpiF32 {
    static constexpr bool PERM = false, AFTER_DRAIN = false;
    float* C; long ldc;
    __device__ __forceinline__ void operator()(const f32x4 (&acc)[2][2][4][2], const Unit& u, int wr, int wc, int fr, int fq) const {
        const int row0 = u.pm * BM + wr * 64 + fr, col0 = u.pn * BM + wc * 32 + 4 * fq;
#pragma unroll
        for (int ai = 0; ai < 2; ++ai)
#pragma unroll
            for (int m = 0; m < 4; ++m) { float* rowp = C + (size_t)(row0 + ai * HALF + m * 16) * ldc + col0;
#pragma unroll
                for (int bj = 0; bj < 2; ++bj)
#pragma unroll
                    for (int n = 0; n < 2; ++n) *(f32x4*)(rowp + bj * HALF + n * 16) = acc[ai][bj][m][n]; }
    }
};
struct EpiBf16P {
    static constexpr bool PERM = true, AFTER_DRAIN = false;
    bf16_t* O; long ldc;
    __device__ __forceinline__ void operator()(const f32x4 (&acc)[2][2][4][2], const Unit& u, int wr, int wc, int fr, int fq) const {
        const int row0 = u.pm * BM + wr * 64 + fr, col0 = u.pn * BM + wc * 32 + 8 * fq;
#pragma unroll
        for (int ai = 0; ai < 2; ++ai)
#pragma unroll
            for (int m = 0; m < 4; ++m) { bf16_t* rowp = O + (size_t)(row0 + ai * HALF + m * 16) * ldc + col0;
#pragma unroll
                for (int bj = 0; bj < 2; ++bj) { const f32x4 v0 = acc[ai][bj][m][0], v1 = acc[ai][bj][m][1];
                    u32x4 w; w.x = cvt_pk_bf16(v0[0], v0[1]); w.y = cvt_pk_bf16(v0[2], v0[3]); w.z = cvt_pk_bf16(v1[0], v1[1]); w.w = cvt_pk_bf16(v1[2], v1[3]);
                    *(u32x4*)(rowp + bj * HALF) = w; } }
    }
};
struct EpiSwiGLU {
    static constexpr bool PERM = true, AFTER_DRAIN = false;
    bf16_t* G; const float* rstd;
    __device__ __forceinline__ void operator()(const f32x4 (&acc)[2][2][4][2], const Unit& u, int wr, int wc, int fr, int fq) const {
        const int row0 = u.pm * BM + wr * 64 + fr, col0 = u.pn * HALF + wc * 32 + 8 * fq;
        float sr[2][4];
#pragma unroll
        for (int ai = 0; ai < 2; ++ai)
#pragma unroll
            for (int m = 0; m < 4; ++m) sr[ai][m] = rstd[row0 + ai * HALF + m * 16];
#pragma unroll
        for (int ai = 0; ai < 2; ++ai)
#pragma unroll
            for (int m = 0; m < 4; ++m) { const int r = row0 + ai * HALF + m * 16; const float s = sr[ai][m]; float o[8];
#pragma unroll
                for (int n = 0; n < 2; ++n)
#pragma unroll
                    for (int j = 0; j < 4; ++j) { const float gt = acc[ai][0][m][n][j] * s, up = acc[ai][1][m][n][j] * s; o[n * 4 + j] = gt * __builtin_amdgcn_rcpf(1.0f + __expf(-gt)) * up; }
                u32x4 w; w.x = cvt_pk_bf16(o[0], o[1]); w.y = cvt_pk_bf16(o[2], o[3]); w.z = cvt_pk_bf16(o[4], o[5]); w.w = cvt_pk_bf16(o[6], o[7]);
                *(u32x4*)(G + (size_t)r * DFF + col0) = w; }
    }
};
struct EpiPle {
    static constexpr bool PERM = true, AFTER_DRAIN = false;
    const bf16_t* X; const bf16_t* Tt; bf16_t* XB; float* OUT;
    __device__ __forceinline__ void operator()(const f32x4 (&acc)[2][2][4][2], const Unit& u, int wr, int wc, int fr, int fq) const {
        const int row0 = u.pm * BM + wr * 64 + fr, col0 = u.pn * BM + wc * 32 + 8 * fq;
        u32x4 tv[2][2], xv[2][2];
#define PLE_LOAD(slot, grp) do { const size_t off_ = (size_t)(row0 + ((grp) >> 2) * HALF + ((grp) & 3) * 16) * D + col0; _Pragma("unroll") for (int bj_ = 0; bj_ < 2; ++bj_) { \
            tv[slot][bj_] = *(const u32x4*)(Tt + off_ + bj_ * HALF); xv[slot][bj_] = *(const u32x4*)(X + off_ + bj_ * HALF); } } while (0)
        PLE_LOAD(0, 0);
#pragma unroll
        for (int grp = 0; grp < 8; ++grp) { const int ai = grp >> 2, m = grp & 3, sl = grp & 1; const size_t off = (size_t)(row0 + ai * HALF + m * 16) * D + col0;
            if (grp + 1 < 8) PLE_LOAD((grp + 1) & 1, grp + 1);
#pragma unroll
            for (int bj = 0; bj < 2; ++bj) { const unsigned tw[4] = {tv[sl][bj].x, tv[sl][bj].y, tv[sl][bj].z, tv[sl][bj].w}, xw[4] = {xv[sl][bj].x, xv[sl][bj].y, xv[sl][bj].z, xv[sl][bj].w}; f32x4 x0, x1;
#pragma unroll
                for (int j = 0; j < 4; ++j) { const float t0 = __builtin_bit_cast(float, (j & 1) ? (tw[j >> 1] & 0xffff0000u) : (tw[j >> 1] << 16));
                    const float t1 = __builtin_bit_cast(float, (j & 1) ? (tw[2 + (j >> 1)] & 0xffff0000u) : (tw[2 + (j >> 1)] << 16));
                    const float a0 = __builtin_bit_cast(float, (j & 1) ? (xw[j >> 1] & 0xffff0000u) : (xw[j >> 1] << 16));
                    const float a1 = __builtin_bit_cast(float, (j & 1) ? (xw[2 + (j >> 1)] & 0xffff0000u) : (xw[2 + (j >> 1)] << 16));
                    x0[j] = a0 + __builtin_amdgcn_rcpf(1.0f + __expf(-acc[ai][bj][m][0][j])) * t0; x1[j] = a1 + __builtin_amdgcn_rcpf(1.0f + __expf(-acc[ai][bj][m][1][j])) * t1; }
                if (OUT) { *(f32x4*)(OUT + off + bj * HALF) = x0; *(f32x4*)(OUT + off + bj * HALF + 4) = x1; }
                else { u32x4 w; w.x = cvt_pk_bf16(x0[0], x0[1]); w.y = cvt_pk_bf16(x0[2], x0[3]); w.z = cvt_pk_bf16(x1[0], x1[1]); w.w = cvt_pk_bf16(x1[2], x1[3]);
                    *(u32x4*)(XB + off + bj * HALF) = w; } } }
#undef PLE_LOAD
    }
};
}

__device__ __forceinline__ unsigned ord_key(float f) { const unsigned u = __builtin_bit_cast(unsigned, f); return (u & 0x80000000u) ? ~u : (u | 0x80000000u); }
#define LAS __attribute__((address_space(3)))
#define XB_TMO      128
#define XB_XCNT(j)  (256  + 64 * (j))
#define XB_XSUB(j)  (1280 + 64 * (j))
#define XB_XGEN(j)  (2304 + 64 * (j))
#define XB_TOP      3328
#define XB_TOPGEN   3392
#define XCD_BAR_WORDS 3456
#define XB_SPIN_CAP (1u << 18)

__device__ __forceinline__ unsigned xb_ld(unsigned* p)              { return __hip_atomic_load(p, __ATOMIC_RELAXED, __HIP_MEMORY_SCOPE_AGENT); }
__device__ __forceinline__ unsigned xb_add(unsigned* p, unsigned v) { return __hip_atomic_fetch_add(p, v, __ATOMIC_RELAXED, __HIP_MEMORY_SCOPE_AGENT); }
__device__ __forceinline__ unsigned xb_xcc_id() { return (unsigned)__builtin_amdgcn_s_getreg((3 << 11) | 20) & 0xFu; }
#define XB_SPIN(cond, bar) do { unsigned _sp = 0; while (cond) { __builtin_amdgcn_s_sleep(1); \
    if ((++_sp & 255u) == 0u) { if (xb_ld(&(bar)[XB_TMO])) break; if (_sp > XB_SPIN_CAP) { atomicAdd(&(bar)[XB_TMO], 1u); break; } } } } while (0)

struct XcdBarrier {
    unsigned* bar; unsigned x;
    volatile LAS unsigned* st;
};

__device__ __forceinline__ XcdBarrier xcd_barrier_post(unsigned* bar, volatile LAS unsigned* st) {
    XcdBarrier b; b.bar = bar; b.x = xb_xcc_id(); b.st = st;
    if (threadIdx.x == 0) (void)xb_add(&bar[XB_XCNT(b.x)], 1u);
    return b;
}
__device__ __forceinline__ void xcd_barrier_complete(unsigned* bar, unsigned x, unsigned& nloc, unsigned& nx) {
    const unsigned G = gridDim.x * gridDim.y * gridDim.z;
    unsigned sum, cnt, mine, sp = 0u;
    for (;;) {
        sum = 0u; cnt = 0u; mine = 0u;
#pragma unroll
        for (unsigned j = 0; j < 16; ++j) { const unsigned c = xb_ld(&bar[XB_XCNT(j)]); sum += c; cnt += (c > 0u) ? 1u : 0u; mine = (j == x) ? c : mine; }
        if (sum == G) break;
        __builtin_amdgcn_s_sleep(1);
        if ((++sp & 255u) == 0u) { if (xb_ld(&bar[XB_TMO])) break; if (sp > XB_SPIN_CAP) { atomicAdd(&bar[XB_TMO], 1u); break; } }
    }
    nloc = mine > 0u ? mine : 1u; nx = cnt > 0u ? cnt : 1u;
}

__device__ __forceinline__ void xcd_barrier(const XcdBarrier& b, int tid_in) {
    asm volatile("s_waitcnt vmcnt(0)" ::: "memory");
    __syncthreads();
    if (tid_in == 0) {
        unsigned* bar = b.bar;
        __builtin_amdgcn_s_waitcnt(0);
        unsigned nloc = b.st[0], nx = b.st[1];
        if (nloc == 0u) { xcd_barrier_complete(bar, b.x, nloc, nx); b.st[0] = nloc; b.st[1] = nx; }
        const unsigned old = xb_add(&bar[XB_XSUB(b.x)], 1u);
        const unsigned gen = old / nloc;
        if (old + 1u == (gen + 1u) * nloc) {
            __builtin_amdgcn_fence(__ATOMIC_RELEASE, "agent");
            asm volatile("s_waitcnt vmcnt(0)" ::: "memory");
            const unsigned og = xb_add(&bar[XB_TOP], 1u);
            const unsigned tg = og / nx;
            if (og + 1u == (tg + 1u) * nx) xb_add(&bar[XB_TOPGEN], 1u);
            else XB_SPIN(xb_ld(&bar[XB_TOPGEN]) == tg, bar);
            __builtin_amdgcn_fence(__ATOMIC_ACQUIRE, "agent");
            xb_add(&bar[XB_XGEN(b.x)], 1u);
            asm volatile("s_waitcnt vmcnt(0)" ::: "memory");
        } else {
            XB_SPIN(xb_ld(&bar[XB_XGEN(b.x)]) == gen, bar);
            __builtin_amdgcn_fence(__ATOMIC_ACQUIRE, "agent");
            asm volatile("s_waitcnt vmcnt(0)" ::: "memory");
        }
    }
    __syncthreads();
}


constexpr int NTHR = 512, NWAVES = 8;
constexpr int RING_BYTES = 131072, LDS_BYTES = 147456, MISC_OFF = LDS_BYTES - 512;
constexpr int CW_BAR = 4096, CW_RANK = 8192;
constexpr size_t CTL_ZERO_BYTES = 1 * MiB;
constexpr int NPH = 14;

__device__ __forceinline__ int mk_tid(int wave_s) { int l_; asm volatile("v_mbcnt_lo_u32_b32 %0, -1, 0\n\tv_mbcnt_hi_u32_b32 %0, -1, %0" : "=v"(l_)); return wave_s * 64 + l_; }
struct Params { const float* in[26]; float* out; unsigned char* ws; int ph_lo, ph_hi, dbl_mask, pad; };
static_assert(sizeof(Params) == 26 * 8 + 8 + 8 + 16, "no padding");

#define LDSP __attribute__((address_space(3)))
#define LDS_WAIT() asm volatile("s_waitcnt lgkmcnt(0)" ::: "memory")
#ifndef NAIVE_SELECT
#define NAIVE_SELECT 0
#endif
#ifndef NAIVE_ATTN
#define NAIVE_ATTN 0
#endif
#ifndef NAIVE_SSM
#define NAIVE_SSM 0
#endif
#ifndef DBG_SSM
#define DBG_SSM 0
#endif
#ifndef TIMING
#define TIMING 0
#endif
#ifndef DBL_MASK
#define DBL_MASK 0
#endif
#ifndef GEMM_DRYK
#define GEMM_DRYK 0
#endif
#ifndef CLK_PROBE
#define CLK_PROBE 0
#endif
#ifndef ATT_FN
#define ATT_FN wg_attn16d
#endif
#ifndef XTRA_BAR
#define XTRA_BAR 0
#endif
#ifndef ATT_SUB_V
#define ATT_SUB_V 0
#endif
#ifndef TIMING_SHIFT
#define TIMING_SHIFT 0.0f
#endif
#ifndef TIMING_A
#define TIMING_A 2
#endif
#ifndef TIMING_B
#define TIMING_B 3
#endif

template <int MODE> __device__ __forceinline__ void ph_prep_w(LDSP float* scr, const float* __restrict__ W, const float* __restrict__ W2, int K, int Nsrc, const float* __restrict__ gain, bf16* __restrict__ Wt, int Ndst, int gw, int NGW, int lane) {
    const int ntn = Ndst / 32, nt = ntn * (K / 64), n4 = lane & 7, kr = lane >> 3;
    f32x4 v[8];
#define PW_LOAD(it_) { const int n0_ = ((it_) % ntn) * 32, k0_ = ((it_) / ntn) * 64, n_ = n0_ + 4 * n4; int src_; const float* Ws_ = W; \
        if (MODE == 0) src_ = n_; else if (MODE == 1) src_ = src_col_in(n_); else { const int which_ = (n_ & 255) >> 7; src_ = (n_ >> 8) * 128 + (n_ & 127); Ws_ = which_ ? W2 : W; } \
        _Pragma("unroll") for (int i = 0; i < 8; ++i) { const int kk = kr + 8 * i; f32x4 t_ = (f32x4){0.f, 0.f, 0.f, 0.f}; if (src_ >= 0) { t_ = *(const f32x4*)(Ws_ + (size_t)(k0_ + kk) * Nsrc + src_); if (gain) t_ = t_ * gain[k0_ + kk]; } v[i] = t_; } }
    if (gw < nt) PW_LOAD(gw)
    for (int it = gw; it < nt; it += NGW) {
        const int n0 = (it % ntn) * 32, k0 = (it / ntn) * 64;
#pragma unroll
        for (int i = 0; i < 8; ++i) { LDSP float* d = scr + (kr + 8 * i) * 33 + 4 * n4; d[0] = v[i].x; d[1] = v[i].y; d[2] = v[i].z; d[3] = v[i].w; }
        if (it + NGW < nt) PW_LOAD(it + NGW)
        LDS_WAIT(); asm volatile("" ::: "memory");
        const int cc = lane & 7;
#pragma unroll
        for (int j = 0; j < 4; ++j) { const int nn = (lane >> 3) + 8 * j; const LDSP float* s = scr + (8 * cc) * 33 + nn;
            u32x4 o; o.x = pk2(s[0 * 33], s[1 * 33]); o.y = pk2(s[2 * 33], s[3 * 33]); o.z = pk2(s[4 * 33], s[5 * 33]); o.w = pk2(s[6 * 33], s[7 * 33]);
            *(u32x4*)(Wt + (size_t)(n0 + nn) * K + k0 + 8 * cc) = o; }
        LDS_WAIT(); asm volatile("" ::: "memory");
    }
#undef PW_LOAD
}
__device__ __forceinline__ void row_x_prep(const float* __restrict__ x, bf16* __restrict__ xb, float* __restrict__ rstd, int row, int lane) {
    const f32x4* xr = (const f32x4*)(x + (size_t)row * D) + lane; float ss = 0.f; f32x4 v[4];
#pragma unroll
    for (int j = 0; j < 4; ++j) { v[j] = xr[64 * j]; ss += (v[j].x * v[j].x + v[j].y * v[j].y) + (v[j].z * v[j].z + v[j].w * v[j].w); }
    ss = wave_sum(ss);
    if (xb) { u32x2* o = (u32x2*)(xb + (size_t)row * D) + lane;
#pragma unroll
        for (int j = 0; j < 4; ++j) { u32x2 w; w.x = pk2(v[j].x, v[j].y); w.y = pk2(v[j].z, v[j].w); o[64 * j] = w; } }
    if (lane == 0) rstd[row] = 1.0f / sqrtf(ss * (1.0f / D) + EPS);
}
__device__ __forceinline__ void row_resid_norm(const float* xin, const float* __restrict__ y, const float* __restrict__ g, float* xo, bf16* __restrict__ xb, float* __restrict__ rstd_out, const float* __restrict__ p, bf16* __restrict__ pb, int row, int lane, bool dry = false) {
    const f32x4* yr = (const f32x4*)(y + (size_t)row * D) + lane; const f32x4* xr = (const f32x4*)(xin + (size_t)row * D) + lane; const f32x4* gr = (const f32x4*)g + lane;
    f32x4 v[4]; float ss = 0.f;
#pragma unroll
    for (int j = 0; j < 4; ++j) { v[j] = yr[64 * j]; ss += (v[j].x * v[j].x + v[j].y * v[j].y) + (v[j].z * v[j].z + v[j].w * v[j].w); }
    const float r = 1.0f / sqrtf(wave_sum(ss) * (1.0f / D) + EPS);
    float s2 = 0.f;
    f32x4* xor_ = (f32x4*)(xo + (size_t)row * D) + lane; u32x2* o = (u32x2*)(xb + (size_t)row * D) + lane;
#pragma unroll
    for (int j = 0; j < 4; ++j) { const f32x4 xx = xr[64 * j], gg = gr[64 * j]; f32x4 w = xx + v[j] * r * gg; if (!dry) xor_[64 * j] = w; s2 += (w.x * w.x + w.y * w.y) + (w.z * w.z + w.w * w.w);
        u32x2 q; q.x = pk2(w.x, w.y); q.y = pk2(w.z, w.w); o[64 * j] = q; }
    if (rstd_out) { s2 = wave_sum(s2); if (lane == 0) rstd_out[row] = 1.0f / sqrtf(s2 * (1.0f / D) + EPS); }
    if (p) { const f32x4 pv = *((const f32x4*)(p + (size_t)row * PLE) + lane); u32x2 q; q.x = pk2(pv.x, pv.y); q.y = pk2(pv.z, pv.w); *((u32x2*)(pb + (size_t)row * PLE) + lane) = q; }
}

__device__ __forceinline__ void row_resid_norm2(const bf16* xin, const bf16* __restrict__ y, const float* __restrict__ g, bf16* xo, float* __restrict__ rstd_out, const float* __restrict__ p, bf16* __restrict__ pb, int row0, int lane, bool dry = false) {
    f32x4 v[2][4], xx[2][4], pv[2]; const f32x4* gr = (const f32x4*)g + lane;
#pragma unroll
    for (int r = 0; r < 2; ++r) { const u32x2* yr = (const u32x2*)(y + (size_t)(row0 + r) * D) + lane; const u32x2* xr = (const u32x2*)(xin + (size_t)(row0 + r) * D) + lane;
#pragma unroll
        for (int j = 0; j < 4; ++j) { const u32x2 yw = yr[64 * j], xw = xr[64 * j];
            v[r][j] = (f32x4){__builtin_bit_cast(float, yw.x << 16), __builtin_bit_cast(float, yw.x & 0xffff0000u), __builtin_bit_cast(float, yw.y << 16), __builtin_bit_cast(float, yw.y & 0xffff0000u)};
            xx[r][j] = (f32x4){__builtin_bit_cast(float, xw.x << 16), __builtin_bit_cast(float, xw.x & 0xffff0000u), __builtin_bit_cast(float, xw.y << 16), __builtin_bit_cast(float, xw.y & 0xffff0000u)}; }
        if (p) pv[r] = *((const f32x4*)(p + (size_t)(row0 + r) * PLE) + lane); }
    f32x4 gg[4];
#pragma unroll
    for (int j = 0; j < 4; ++j) gg[j] = gr[64 * j];
#pragma unroll
    for (int r = 0; r < 2; ++r) { float ss = 0.f;
#pragma unroll
        for (int j = 0; j < 4; ++j) ss += (v[r][j].x * v[r][j].x + v[r][j].y * v[r][j].y) + (v[r][j].z * v[r][j].z + v[r][j].w * v[r][j].w);
        const float rr = 1.0f / sqrtf(wave_sum(ss) * (1.0f / D) + EPS); float s2 = 0.f;
        u32x2* o = (u32x2*)(xo + (size_t)(row0 + r) * D) + lane;
#pragma unroll
        for (int j = 0; j < 4; ++j) { const f32x4 w = xx[r][j] + v[r][j] * rr * gg[j]; u32x2 q; q.x = pk2(w.x, w.y); q.y = pk2(w.z, w.w); if (!dry) o[64 * j] = q;
            const float r0 = __builtin_bit_cast(float, q.x << 16), r1 = __builtin_bit_cast(float, q.x & 0xffff0000u), r2 = __builtin_bit_cast(float, q.y << 16), r3 = __builtin_bit_cast(float, q.y & 0xffff0000u);
            s2 += (r0 * r0 + r1 * r1) + (r2 * r2 + r3 * r3); }
        if (rstd_out) { s2 = wave_sum(s2); if (lane == 0) rstd_out[row0 + r] = 1.0f / sqrtf(s2 * (1.0f / D) + EPS); }
        if (p) { u32x2 q; q.x = pk2(pv[r].x, pv[r].y); q.y = pk2(pv[r].z, pv[r].w); *((u32x2*)(pb + (size_t)(row0 + r) * PLE) + lane) = q; } }
}
__device__ __forceinline__ void row_rstd_bf16(const bf16* __restrict__ xb, float* __restrict__ rstd, int row, int lane) {
    const u32x2* xr = (const u32x2*)(xb + (size_t)row * D) + lane; float ss = 0.f;
#pragma unroll
    for (int j = 0; j < 4; ++j) { const u32x2 w = xr[64 * j]; const float a = __builtin_bit_cast(float, w.x << 16), b = __builtin_bit_cast(float, w.x & 0xffff0000u), c2 = __builtin_bit_cast(float, w.y << 16), d = __builtin_bit_cast(float, w.y & 0xffff0000u); ss += (a * a + b * b) + (c2 * c2 + d * d); }
    ss = wave_sum(ss); if (lane == 0) rstd[row] = 1.0f / sqrtf(ss * (1.0f / D) + EPS);
}
__device__ __forceinline__ void row_x_prep2(const float* __restrict__ x, bf16* __restrict__ xb, float* __restrict__ rstd, int row0, int lane) {
    f32x4 v[2][4]; float ss[2];
#pragma unroll
    for (int r = 0; r < 2; ++r) { const f32x4* xr = (const f32x4*)(x + (size_t)(row0 + r) * D) + lane;
#pragma unroll
        for (int j = 0; j < 4; ++j) v[r][j] = xr[64 * j]; }
#pragma unroll
    for (int r = 0; r < 2; ++r) { float s_ = 0.f;
#pragma unroll
        for (int j = 0; j < 4; ++j) s_ += (v[r][j].x * v[r][j].x + v[r][j].y * v[r][j].y) + (v[r][j].z * v[r][j].z + v[r][j].w * v[r][j].w);
        ss[r] = wave_sum(s_); u32x2* o = (u32x2*)(xb + (size_t)(row0 + r) * D) + lane;
#pragma unroll
        for (int j = 0; j < 4; ++j) { u32x2 w; w.x = pk2(v[r][j].x, v[r][j].y); w.y = pk2(v[r][j].z, v[r][j].w); o[64 * j] = w; } }
    if (lane < 2) rstd[row0 + lane] = 1.0f / sqrtf((lane ? ss[1] : ss[0]) * (1.0f / D) + EPS);
}
__device__ __forceinline__ void row_rstd_bf16x4(const bf16* __restrict__ xb, float* __restrict__ rstd, int row0, int lane) {
    u32x2 w[4][4]; float ss[4];
#pragma unroll
    for (int r = 0; r < 4; ++r) { const u32x2* xr = (const u32x2*)(xb + (size_t)(row0 + r) * D) + lane;
#pragma unroll
        for (int j = 0; j < 4; ++j) w[r][j] = xr[64 * j]; }
#pragma unroll
    for (int r = 0; r < 4; ++r) { float s_ = 0.f;
#pragma unroll
        for (int j = 0; j < 4; ++j) { const float a = __builtin_bit_cast(float, w[r][j].x << 16), b = __builtin_bit_cast(float, w[r][j].x & 0xffff0000u), c2 = __builtin_bit_cast(float, w[r][j].y << 16), d = __builtin_bit_cast(float, w[r][j].y & 0xffff0000u); s_ += (a * a + b * b) + (c2 * c2 + d * d); }
        ss[r] = wave_sum(s_); }
    const float sel = lane == 0 ? ss[0] : lane == 1 ? ss[1] : lane == 2 ? ss[2] : ss[3];
    if (lane < 4) rstd[row0 + lane] = 1.0f / sqrtf(sel * (1.0f / D) + EPS);
}
__device__ __forceinline__ void wave_gnorm4(bf16* RA, const float* __restrict__ nw, int w0, int lane, bool dry = false) {
    u32x4 v[4]; float ss[4];
#pragma unroll
    for (int i = 0; i < 4; ++i) { const int w = w0 + i, t = w >> 1, g = w & 1; v[i] = *(const u32x4*)(RA + (size_t)t * NA + A_Z + g * 512 + lane * 8); }
    float f[4][8];
#pragma unroll
    for (int i = 0; i < 4; ++i) { const unsigned vw[4] = {v[i].x, v[i].y, v[i].z, v[i].w}; ss[i] = 0.f;
#pragma unroll
        for (int e = 0; e < 8; ++e) { f[i][e] = bf2f((bf16)((vw[e >> 1] >> ((e & 1) * 16)) & 0xffff)); ss[i] += f[i][e] * f[i][e]; } }
#pragma unroll
    for (int o = 1; o < 64; o <<= 1) {
#pragma unroll
        for (int i = 0; i < 4; ++i) ss[i] += __shfl_xor(ss[i], o); }
#pragma unroll
    for (int i = 0; i < 4; ++i) { const int w = w0 + i, t = w >> 1, g = w & 1; const float r = 1.0f / sqrtf(ss[i] * (1.0f / 512.0f) + EPS); const float* gw = nw + g * 512 + lane * 8;
        u32x4 o; o.x = pk2(f[i][0] * r * gw[0], f[i][1] * r * gw[1]); o.y = pk2(f[i][2] * r * gw[2], f[i][3] * r * gw[3]); o.z = pk2(f[i][4] * r * gw[4], f[i][5] * r * gw[5]); o.w = pk2(f[i][6] * r * gw[6], f[i][7] * r * gw[7]);
        if (!dry) *(u32x4*)(RA + (size_t)t * NA + A_Z + g * 512 + lane * 8) = o; }
}
__device__ __forceinline__ void tok_m1(bf16* __restrict__ RA, bf16* __restrict__ RB, bf16* __restrict__ CKVC, bf16* __restrict__ IKC, const float* __restrict__ kvn, const float* __restrict__ ikg, const float* __restrict__ ikb, const float* __restrict__ scw, int t, int lane) {
    const int s = t & (SEQ - 1); bf16* rb = RB + (size_t)t * NB;
    {   const u32x2 w = *((const u32x2*)(rb + B_CKV) + lane); float v[4] = {bf2f((bf16)(w.x & 0xffff)), bf2f((bf16)(w.x >> 16)), bf2f((bf16)(w.y & 0xffff)), bf2f((bf16)(w.y >> 16))};
        float ss = (v[0] * v[0] + v[1] * v[1]) + (v[2] * v[2] + v[3] * v[3]); ss = wave_sum(ss); const float r = 1.0f / sqrtf(ss * (1.0f / KV_R) + EPS);
        const f32x4 g = *((const f32x4*)kvn + lane); u32x2 o; o.x = pk2(v[0] * r * g.x, v[1] * r * g.y); o.y = pk2(v[2] * r * g.z, v[3] * r * g.w); *((u32x2*)(rb + B_CKV) + lane) = o; *((u32x2*)(CKVC + (size_t)t * KV_R) + lane) = o; }
    {   const float x = bf2f(rb[B_IK + lane]); const float mu = wave_sum(x) * (1.0f / 64.0f); const float d = x - mu; const float var = wave_sum(d * d) * (1.0f / 64.0f);
        const bf16 o = f2bf(d * (1.0f / sqrtf(var + EPS)) * ikg[lane] + ikb[lane]); rb[B_IK + lane] = o; IKC[(size_t)t * 64 + lane] = o; }
    {   const int c = lane * 8; float acc[8] = {0.f, 0.f, 0.f, 0.f, 0.f, 0.f, 0.f, 0.f};
        for (int j = 0; j < 3; ++j) { const int ss_ = s - 2 + j; if (ss_ < 0) continue; const bf16* rr = RB + (size_t)(t - 2 + j) * NB;
            const u32x4 cg = *(const u32x4*)(rr + B_CG + c), hb = *(const u32x4*)(rr + B_HB + c); const unsigned cw[4] = {cg.x, cg.y, cg.z, cg.w}, hw[4] = {hb.x, hb.y, hb.z, hb.w};
#pragma unroll
            for (int e = 0; e < 8; ++e) { const float a = bf2f((bf16)((cw[e >> 1] >> ((e & 1) * 16)) & 0xffff)), b = bf2f((bf16)((hw[e >> 1] >> ((e & 1) * 16)) & 0xffff)); acc[e] += scw[j * 512 + c + e] * (a * b); } }
        bf16* ra = RA + (size_t)t * NA + A_BG + c; const u32x4 bg = *(const u32x4*)ra; const unsigned bw[4] = {bg.x, bg.y, bg.z, bg.w}; float o[8];
#pragma unroll
        for (int e = 0; e < 8; ++e) o[e] = bf2f((bf16)((bw[e >> 1] >> ((e & 1) * 16)) & 0xffff)) * acc[e];
        u32x4 w; w.x = pk2(o[0], o[1]); w.y = pk2(o[2], o[3]); w.z = pk2(o[4], o[5]); w.w = pk2(o[6], o[7]); *(u32x4*)ra = w; }
}
__device__ __forceinline__ void tok_m4a(const bf16* __restrict__ RB, const float* __restrict__ cw, const float* __restrict__ cb, const float* __restrict__ dtb, bf16* __restrict__ XA, float* __restrict__ DT, int t, int lane) {
    const int s = t & (SEQ - 1);
    for (int c = lane; c < XBC; c += 64) { float a = cb[c];
#pragma unroll
        for (int j = 0; j < 4; ++j) { const int ss = s - 3 + j; if (ss >= 0) a += cw[j * XBC + c] * bf2f(RB[(size_t)(t - 3 + j) * NB + B_XBC + c]); }
        XA[(size_t)t * XBC + c] = f2bf(siluf_(a)); }
    if (lane < 16) { const float x = bf2f(RB[(size_t)t * NB + B_DT + lane]) + dtb[lane]; DT[(size_t)t * 16 + lane] = x > 15.f ? x : log1pf(__expf(x)); }
}
__device__ __forceinline__ void wg_m2_select(LDSP unsigned char* lds, const bf16* __restrict__ RB, unsigned short* __restrict__ idx, int t, int tid) {
    LDSP float* iq = (LDSP float*)lds; LDSP float* iwv = iq + 256; LDSP unsigned* red = (LDSP unsigned*)(iq + 272); LDSP unsigned* keys = (LDSP unsigned*)(iq + 288);
    const int s = t & (SEQ - 1), b = t >> 12, lane = tid & 63, wv = tid >> 6;
    const int nk = ((s >> 6) + 1) << 6;
    const bf16* rb = RB + (size_t)t * NB;
    if (tid < 256) iq[tid] = bf2f(rb[B_IQ + tid]); if (tid < 4) iwv[tid] = bf2f(rb[B_IW + tid]) * (0.125f * 0.5f);
    __syncthreads();
    for (int k = tid; k < nk; k += NTHR) {
        const bf16* kr = RB + (size_t)(b * SEQ + k) * NB + B_IK; float sc = 0.f;
        float d0 = 0.f, d1 = 0.f, d2 = 0.f, d3 = 0.f;
#pragma unroll 1
        for (int j = 0; j < 8; ++j) { const u32x4 w = *((const u32x4*)kr + j); const unsigned ww[4] = {w.x, w.y, w.z, w.w};
#pragma unroll
            for (int e = 0; e < 8; ++e) { const float kv = bf2f((bf16)((ww[e >> 1] >> ((e & 1) * 16)) & 0xffff)); const int c = j * 8 + e;
                d0 += iq[c] * kv; d1 += iq[64 + c] * kv; d2 += iq[128 + c] * kv; d3 += iq[192 + c] * kv; } }
        sc += fmaxf(d0, 0.f) * iwv[0]; sc += fmaxf(d1, 0.f) * iwv[1]; sc += fmaxf(d2, 0.f) * iwv[2]; sc += fmaxf(d3, 0.f) * iwv[3];
        keys[k] = ord_key(sc);
    }
    __syncthreads();
    unsigned Tt = 0u;
    if (nk > TOPK) {
        for (int bit = 31; bit >= 0; --bit) { const unsigned cand = Tt | (1u << bit); unsigned c = 0;
            for (int k = tid; k < nk; k += NTHR) c += (keys[k] >= cand) ? 1u : 0u;
#pragma unroll
            for (int o = 1; o < 64; o <<= 1) c += __shfl_xor(c, o);
            if (lane == 0) red[wv] = c;
            __syncthreads();
            unsigned tot = 0;
#pragma unroll
            for (int w = 0; w < 8; ++w) tot += red[w];
            if (tot >= (unsigned)TOPK) Tt = cand;
            __syncthreads(); }
    }
    { unsigned c = 0; for (int k = tid; k < nk; k += NTHR) c += (keys[k] > Tt) ? 1u : 0u;
#pragma unroll
      for (int o = 1; o < 64; o <<= 1) c += __shfl_xor(c, o);
      if (lane == 0) red[8 + wv] = c; }
    __syncthreads();
    if (wv == 0) {
        int ngt = 0;
#pragma unroll
        for (int w = 0; w < 8; ++w) ngt += (int)red[8 + w];
        const int need = TOPK - ngt; int pos = 0, eq_taken = 0; const unsigned long long lt = (1ull << lane) - 1ull;
        for (int base = 0; base < nk; base += 64) { const unsigned k = keys[base + lane]; const bool gt = k > Tt, eq = (k == Tt);
            const unsigned long long meq = __ballot(eq); const int rank_eq = __popcll(meq & lt); const bool take = gt || (eq && (eq_taken + rank_eq < need));
            const unsigned long long msel = __ballot(take);
            if (take) { const int o = pos + __popcll(msel & lt); if (o < TOPK) idx[(size_t)t * TOPK + o] = (unsigned short)(base + lane); }
            pos += __popcll(msel); eq_taken += __popcll(__ballot(eq && take)); }
    }
    __syncthreads();
}
__device__ __forceinline__ void wg_m3_attn(LDSP unsigned char* lds, bf16* RA, const bf16* __restrict__ RB, const unsigned short* __restrict__ idx, const float* __restrict__ w_uk, const float* __restrict__ w_uv, const float* __restrict__ rel_bias, int t, int tid) {
    LDSP float* q = (LDSP float*)lds; LDSP float* qlat = q + 512; LDSP float* pr = qlat + 2048; LDSP float* outl = pr + 2048; LDSP unsigned short* sel = (LDSP unsigned short*)(outl + 2048);
    const int s = t & (SEQ - 1), b = t >> 12, lane = tid & 63, wv = tid >> 6;
    const int nk = ((s >> 6) + 1) << 6, nsel = nk < TOPK ? nk : TOPK;
    q[tid] = bf2f(RA[(size_t)t * NA + A_Q + tid]); if (tid < 256) sel[tid] = tid < nsel ? idx[(size_t)t * TOPK + tid] : (unsigned short)0;
    __syncthreads();
    {   const int r = tid & 255, h0 = (tid >> 8) * 4;
        for (int h = h0; h < h0 + 4; ++h) { const float* w = w_uk + ((size_t)r * 8 + h) * 64; float a = 0.f;
#pragma unroll 16
            for (int d = 0; d < 64; ++d) a += q[h * 64 + d] * w[d];
            qlat[h * 256 + r] = a * 0.125f; } }
    __syncthreads();
    {   const int k = tid & 255, h0 = (tid >> 8) * 4;
        if (k < nsel) { const int key = sel[k]; const bf16* kr = RB + (size_t)(b * SEQ + key) * NB + B_CKV; float a[4] = {0.f, 0.f, 0.f, 0.f};
            for (int j = 0; j < 32; ++j) { const u32x4 w = *((const u32x4*)kr + j); const unsigned ww[4] = {w.x, w.y, w.z, w.w};
#pragma unroll
                for (int e = 0; e < 8; ++e) { const float v = bf2f((bf16)((ww[e >> 1] >> ((e & 1) * 16)) & 0xffff));
#pragma unroll
                    for (int hh = 0; hh < 4; ++hh) a[hh] += qlat[(h0 + hh) * 256 + j * 8 + e] * v; } }
            const int bk = t5_bucket(key - s);
#pragma unroll
            for (int hh = 0; hh < 4; ++hh) pr[(h0 + hh) * 256 + k] = a[hh] + rel_bias[bk * 8 + h0 + hh];
        } else {
#pragma unroll
            for (int hh = 0; hh < 4; ++hh) pr[(h0 + hh) * 256 + k] = -INFINITY; } }
    __syncthreads();
    {   float v[4]; float m = -INFINITY;
#pragma unroll
        for (int j = 0; j < 4; ++j) { v[j] = pr[wv * 256 + lane + 64 * j]; m = fmaxf(m, v[j]); }
        m = wave_max(m); float sum = 0.f;
#pragma unroll
        for (int j = 0; j < 4; ++j) { v[j] = __expf(v[j] - m); sum += v[j]; }
        sum = wave_sum(sum); const float inv = 1.0f / sum;
#pragma unroll
        for (int j = 0; j < 4; ++j) pr[wv * 256 + lane + 64 * j] = v[j] * inv; }
    __syncthreads();
    {   const int r = tid & 255, h0 = (tid >> 8) * 4; float a[4] = {0.f, 0.f, 0.f, 0.f};
        for (int k = 0; k < nsel; ++k) { const float v = bf2f(RB[(size_t)(b * SEQ + sel[k]) * NB + B_CKV + r]);
#pragma unroll
            for (int hh = 0; hh < 4; ++hh) a[hh] += pr[(h0 + hh) * 256 + k] * v; }
#pragma unroll
        for (int hh = 0; hh < 4; ++hh) outl[(h0 + hh) * 256 + r] = a[hh]; }
    __syncthreads();
    {   const int h = tid >> 6, d = tid & 63; float a = 0.f;
        for (int r = 0; r < 256; ++r) a += outl[h * 256 + r] * w_uv[((size_t)r * 8 + h) * 64 + d];
        RA[(size_t)t * NA + A_Q + tid] = f2bf(a); }
    __syncthreads();
}
__device__ __forceinline__ void half_m4b_scan(bf16* RA, const bf16* __restrict__ XA, const float* __restrict__ DT, const float* __restrict__ a_log, const float* __restrict__ dsk, int b, int h, int tid) {
    const int g = h >> 3, p = tid >> 2, nq = tid & 3;
    const float A = -__expf(a_log[h]), Dh = dsk[h];
    float hs[32];
#pragma unroll
    for (int n = 0; n < 32; ++n) hs[n] = 0.f;
    for (int s = 0; s < SEQ; ++s) { const size_t t = (size_t)b * SEQ + s; const float dt = DT[t * 16 + h]; const float dA = __expf(dt * A);
        const bf16* xr = XA + t * XBC; const float x = bf2f(xr[h * 64 + p]); const float dx = dt * x;
        const u32x4* Bp = (const u32x4*)(xr + 1024 + g * 128 + nq * 32); const u32x4* Cp = (const u32x4*)(xr + 1280 + g * 128 + nq * 32); float y = 0.f;
#pragma unroll
        for (int j = 0; j < 4; ++j) { const u32x4 bw = Bp[j], cw = Cp[j]; const unsigned bb[4] = {bw.x, bw.y, bw.z, bw.w}, cc[4] = {cw.x, cw.y, cw.z, cw.w};
#pragma unroll
            for (int e = 0; e < 8; ++e) { const float Bv = bf2f((bf16)((bb[e >> 1] >> ((e & 1) * 16)) & 0xffff)), Cv = bf2f((bf16)((cc[e >> 1] >> ((e & 1) * 16)) & 0xffff));
                hs[j * 8 + e] = hs[j * 8 + e] * dA + dx * Bv; y += Cv * hs[j * 8 + e]; } }
        y += __shfl_xor(y, 1); y += __shfl_xor(y, 2);
        if (nq == 0) { bf16* zp = RA + t * NA + A_Z + h * 64 + p; const float z = bf2f(*zp); *zp = f2bf((y + Dh * x) * siluf_(z)); }
    }
}
__device__ __forceinline__ void wave_m4c_gnorm(bf16* RA, const float* __restrict__ nw, int w, int lane, bool dry = false) {
    const int t = w >> 1, g = w & 1;
    bf16* p = RA + (size_t)t * NA + A_Z + g * 512 + lane * 8; const u32x4 v = *(const u32x4*)p; const unsigned vw[4] = {v.x, v.y, v.z, v.w}; float f[8]; float ss = 0.f;
#pragma unroll
    for (int e = 0; e < 8; ++e) { f[e] = bf2f((bf16)((vw[e >> 1] >> ((e & 1) * 16)) & 0xffff)); ss += f[e] * f[e]; }
    const float r = 1.0f / sqrtf(wave_sum(ss) * (1.0f / 512.0f) + EPS); const float* gw = nw + g * 512 + lane * 8;
    u32x4 o; o.x = pk2(f[0] * r * gw[0], f[1] * r * gw[1]); o.y = pk2(f[2] * r * gw[2], f[3] * r * gw[3]); o.z = pk2(f[4] * r * gw[4], f[5] * r * gw[5]); o.w = pk2(f[6] * r * gw[6], f[7] * r * gw[7]);
    if (!dry) *(u32x4*)p = o;
}

__device__ __forceinline__ void unpack8(const u32x4 w, float (&f)[8]) { const unsigned ww[4] = {w.x, w.y, w.z, w.w};
#pragma unroll
    for (int e = 0; e < 4; ++e) { f[2 * e] = __builtin_bit_cast(float, ww[e] << 16); f[2 * e + 1] = __builtin_bit_cast(float, ww[e] & 0xffff0000u); } }
__device__ __forceinline__ void prep_ckv4(const bf16* __restrict__ RB, bf16* __restrict__ CKVC, const float* __restrict__ kvn, int it, int lane) {
    const int t = it * 4 + (lane >> 4), c = lane & 15; const u32x4* src = (const u32x4*)(RB + (size_t)t * NB + B_CKV + c * 16); const u32x4 a = src[0], b = src[1];
    float v[16]; { float f[8]; unpack8(a, f);
#pragma unroll
        for (int e = 0; e < 8; ++e) v[e] = f[e]; unpack8(b, f);
#pragma unroll
        for (int e = 0; e < 8; ++e) v[8 + e] = f[e]; }
    float ss = 0.f;
#pragma unroll
    for (int e = 0; e < 16; ++e) ss += v[e] * v[e];
    ss += __shfl_xor(ss, 1); ss += __shfl_xor(ss, 2); ss += __shfl_xor(ss, 4); ss += __shfl_xor(ss, 8);
    const float r = 1.0f / sqrtf(ss * (1.0f / KV_R) + EPS); const f32x4* gp = (const f32x4*)(kvn + c * 16); float o[16];
#pragma unroll
    for (int q = 0; q < 4; ++q) { const f32x4 gg = gp[q]; o[4 * q] = v[4 * q] * r * gg.x; o[4 * q + 1] = v[4 * q + 1] * r * gg.y; o[4 * q + 2] = v[4 * q + 2] * r * gg.z; o[4 * q + 3] = v[4 * q + 3] * r * gg.w; }
    u32x4 w0, w1; w0.x = pk2(o[0], o[1]); w0.y = pk2(o[2], o[3]); w0.z = pk2(o[4], o[5]); w0.w = pk2(o[6], o[7]); w1.x = pk2(o[8], o[9]); w1.y = pk2(o[10], o[11]); w1.z = pk2(o[12], o[13]); w1.w = pk2(o[14], o[15]);
    u32x4* dst = (u32x4*)(CKVC + (size_t)t * KV_R + c * 16); dst[0] = w0; dst[1] = w1;
}
__device__ __forceinline__ void prep_ik16(const bf16* __restrict__ RB, bf16* __restrict__ IKC, const float* __restrict__ ikg, const float* __restrict__ ikb, int it, int lane) {
    const int t = it * 16 + (lane >> 2), c = lane & 3; const u32x4* src = (const u32x4*)(RB + (size_t)t * NB + B_IK + c * 16); const u32x4 a = src[0], b = src[1];
    float v[16]; { float f[8]; unpack8(a, f);
#pragma unroll
        for (int e = 0; e < 8; ++e) v[e] = f[e]; unpack8(b, f);
#pragma unroll
        for (int e = 0; e < 8; ++e) v[8 + e] = f[e]; }
    float s = 0.f;
#pragma unroll
    for (int e = 0; e < 16; ++e) s += v[e];
    s += __shfl_xor(s, 1); s += __shfl_xor(s, 2); const float mu = s * (1.0f / 64.0f); float q2 = 0.f;
#pragma unroll
    for (int e = 0; e < 16; ++e) { v[e] -= mu; q2 += v[e] * v[e]; }
    q2 += __shfl_xor(q2, 1); q2 += __shfl_xor(q2, 2); const float r = 1.0f / sqrtf(q2 * (1.0f / 64.0f) + EPS); float o[16];
#pragma unroll
    for (int e = 0; e < 16; ++e) o[e] = v[e] * r * ikg[c * 16 + e] + ikb[c * 16 + e];
    u32x4 w0, w1; w0.x = pk2(o[0], o[1]); w0.y = pk2(o[2], o[3]); w0.z = pk2(o[4], o[5]); w0.w = pk2(o[6], o[7]); w1.x = pk2(o[8], o[9]); w1.y = pk2(o[10], o[11]); w1.z = pk2(o[12], o[13]); w1.w = pk2(o[14], o[15]);
    u32x4* dst = (u32x4*)(IKC + (size_t)t * 64 + c * 16); dst[0] = w0; dst[1] = w1;
}
__device__ __forceinline__ void prep_bout(bf16* RA, const bf16* __restrict__ RB, const float* __restrict__ scw, int t, int lane, bool dry = false) {
    const int s = t & (SEQ - 1), c = lane * 8; float acc[8] = {0.f, 0.f, 0.f, 0.f, 0.f, 0.f, 0.f, 0.f};
    u32x4 cg[3], hb[3];
#pragma unroll
    for (int j = 0; j < 3; ++j) { const bool ok = (s - 2 + j) >= 0; const bf16* rr = RB + (size_t)(t - 2 + j) * NB; cg[j] = ok ? *(const u32x4*)(rr + B_CG + c) : (u32x4){0u, 0u, 0u, 0u}; hb[j] = ok ? *(const u32x4*)(rr + B_HB + c) : (u32x4){0u, 0u, 0u, 0u}; }
    bf16* ra = RA + (size_t)t * NA + A_BG + c; const u32x4 bg = *(const u32x4*)ra;
#pragma unroll
    for (int j = 0; j < 3; ++j) { float a[8], b[8]; unpack8(cg[j], a); unpack8(hb[j], b); const f32x4 w0 = *(const f32x4*)(scw + j * 512 + c), w1 = *(const f32x4*)(scw + j * 512 + c + 4);
        acc[0] += w0.x * (a[0] * b[0]); acc[1] += w0.y * (a[1] * b[1]); acc[2] += w0.z * (a[2] * b[2]); acc[3] += w0.w * (a[3] * b[3]);
        acc[4] += w1.x * (a[4] * b[4]); acc[5] += w1.y * (a[5] * b[5]); acc[6] += w1.z * (a[6] * b[6]); acc[7] += w1.w * (a[7] * b[7]); }
    float g8[8]; unpack8(bg, g8); u32x4 w; w.x = pk2(g8[0] * acc[0], g8[1] * acc[1]); w.y = pk2(g8[2] * acc[2], g8[3] * acc[3]); w.z = pk2(g8[4] * acc[4], g8[5] * acc[5]); w.w = pk2(g8[6] * acc[6], g8[7] * acc[7]);
    if (!dry) *(u32x4*)ra = w;
}
__device__ __forceinline__ void prep_conv(const bf16* __restrict__ RB, bf16* __restrict__ XA, const float* __restrict__ cw, const float* __restrict__ cb, int it, int lane) {
    const int rb = it / 12, cbk = it % 12, xcol = cbk * 128 + 2 * lane, t0 = rb * 16, s0 = t0 & (SEQ - 1);
    float w0[4], w1[4];
#pragma unroll
    for (int j = 0; j < 4; ++j) { w0[j] = cw[j * XBC + xcol]; w1[j] = cw[j * XBC + xcol + 1]; }
    const float cb0 = cb[xcol], cb1 = cb[xcol + 1];
    const bf16* src = RB + (size_t)(t0 - 3) * NB + B_XBC + xcol; unsigned raw[19];
#pragma unroll
    for (int i = 0; i < 19; ++i) raw[i] = (s0 - 3 + i >= 0) ? *(const unsigned*)(src + (size_t)i * NB) : 0u;
#pragma unroll
    for (int i = 0; i < 16; ++i) { float a0 = cb0, a1 = cb1;
#pragma unroll
        for (int j = 0; j < 4; ++j) { a0 += w0[j] * __builtin_bit_cast(float, raw[i + j] << 16); a1 += w1[j] * __builtin_bit_cast(float, raw[i + j] & 0xffff0000u); }
        *(unsigned*)(XA + (size_t)(t0 + i) * XBC + xcol) = pk2(siluf_(a0), siluf_(a1)); }
}

typedef short bf16x8_t __attribute__((ext_vector_type(8)));
#ifndef SEL_REP_SEARCH
#define SEL_REP_SEARCH 1
#endif
#ifndef SEL_REP_STAGE
#define SEL_REP_STAGE 1
#endif
#define CNT8_GE(cnt, v0, v1, v2, v3, v4, v5, v6, v7, cand) do { unsigned long long m0_, m1_, m2_, m3_, m4_, m5_, m6_, m7_; \
    asm("v_cmp_ge_u32_e64 %0, %8, %16\n\tv_cmp_ge_u32_e64 %1, %9, %16\n\tv_cmp_ge_u32_e64 %2, %10, %16\n\tv_cmp_ge_u32_e64 %3, %11, %16\n\t" \
        "v_cmp_ge_u32_e64 %4, %12, %16\n\tv_cmp_ge_u32_e64 %5, %13, %16\n\tv_cmp_ge_u32_e64 %6, %14, %16\n\tv_cmp_ge_u32_e64 %7, %15, %16" \
        : "=&s"(m0_), "=&s"(m1_), "=&s"(m2_), "=&s"(m3_), "=&s"(m4_), "=&s"(m5_), "=&s"(m6_), "=&s"(m7_) \
        : "v"(v0), "v"(v1), "v"(v2), "v"(v3), "v"(v4), "v"(v5), "v"(v6), "v"(v7), "s"(cand)); \
    cnt += (__popcll(m0_) + __popcll(m1_)) + (__popcll(m2_) + __popcll(m3_)) + (__popcll(m4_) + __popcll(m5_)) + (__popcll(m6_) + __popcll(m7_)); } while (0)
constexpr int SC_STRIDE = 516, SC_BUF = 16 * SC_STRIDE;
constexpr int IKW_OFF = 66560;
__device__ __forceinline__ void wg_select16(LDSP unsigned char* lds, const bf16* __restrict__ RB, const bf16* __restrict__ IKC, unsigned short* __restrict__ idx, int unit, int tid, bool dry = false, bool lds_out = false) {
    const int lane = tid & 63, wave = __builtin_amdgcn_readfirstlane(tid >> 6), g = lane >> 4, c = lane & 15;
    const int b = unit >> 8, qg = unit & 255, t0 = b * SEQ + qg * 16, nk = ((qg >> 2) + 1) << 6, nr = nk >> 6;
    LDSP unsigned* SC = (LDSP unsigned*)lds;
    bf16x8_t bq[4][2]; float iwq[4];
    { const bf16* qr = RB + (size_t)(t0 + c) * NB;
#pragma unroll
      for (int h = 0; h < 4; ++h) { bq[h][0] = *(const bf16x8_t*)(qr + B_IQ + h * 64 + g * 8); bq[h][1] = *(const bf16x8_t*)(qr + B_IQ + h * 64 + 32 + g * 8); iwq[h] = bf2f(qr[B_IW + h]) * 0.0625f; } }
    unsigned val[2][64];
#pragma unroll
    for (int r = 0; r < 64; ++r) { val[0][r] = 0u; val[1][r] = 0u; }
    const bf16* ikb = IKC + (size_t)b * SEQ * 64;
    LDSP unsigned char* ikw = lds + IKW_OFF + wave * 8192;
#define IK_DMA(stage) do { if ((stage) * 512 + wave * 64 < nk) { const bf16* src_ = ikb + (size_t)((stage) * 512 + wave * 64) * 64 + lane * 8; _Pragma("unroll") for (int pc_ = 0; pc_ < 8; ++pc_) \
        __builtin_amdgcn_global_load_lds((const unsigned*)(src_ + pc_ * 512), (LDSP unsigned*)(ikw + pc_ * 1024), 16, 0, 0); } } while (0)
    IK_DMA(0);
    for (int rep_st = 0; rep_st < SEL_REP_STAGE; ++rep_st) {
    if (rep_st > 0) { asm volatile("s_waitcnt vmcnt(0)" ::: "memory"); __builtin_amdgcn_s_barrier(); IK_DMA(0); }
#pragma unroll
    for (int s = 0; s < 8; ++s) {
        if (s * 512 < nk) {
            LDSP unsigned* buf = SC + (s & 1) * SC_BUF;
            asm volatile("s_waitcnt vmcnt(0)" ::: "memory");
            bf16x8_t af[4][2];
#pragma unroll
            for (int i = 0; i < 4; ++i) { af[i][0] = *(const LDSP bf16x8_t*)(ikw + (16 * i + c) * 128 + g * 16); af[i][1] = *(const LDSP bf16x8_t*)(ikw + (16 * i + c) * 128 + 64 + g * 16); }
            asm volatile("s_waitcnt lgkmcnt(0)" ::: "memory");
            if (s < 7) IK_DMA(s + 1);
#pragma unroll
            for (int i = 0; i < 4; ++i) { const int tl = wave * 4 + i, kb = s * 512 + tl * 16;
                if (kb < nk) {
                    const bf16x8_t a0 = af[i][0], a1 = af[i][1];
                    float sc[4] = {0.f, 0.f, 0.f, 0.f};
#pragma unroll
                    for (int h = 0; h < 4; ++h) { pg8::f32x4 acc = {0.f, 0.f, 0.f, 0.f};
                        acc = __builtin_amdgcn_mfma_f32_16x16x32_bf16(a0, bq[h][0], acc, 0, 0, 0); acc = __builtin_amdgcn_mfma_f32_16x16x32_bf16(a1, bq[h][1], acc, 0, 0, 0);
#pragma unroll
                        for (int e = 0; e < 4; ++e) sc[e] += fmaxf(acc[e], 0.f) * iwq[h]; }
                    u32x4 kv; kv.x = ord_key(sc[0]); kv.y = ord_key(sc[1]); kv.z = ord_key(sc[2]); kv.w = ord_key(sc[3]);
                    *(LDSP u32x4*)(buf + c * SC_STRIDE + tl * 16 + 4 * g) = kv; } }
            asm volatile("s_waitcnt lgkmcnt(0)" ::: "memory"); __builtin_amdgcn_s_barrier(); asm volatile("" ::: "memory");
#pragma unroll
            for (int j = 0; j < 8; ++j) if (s * 512 + j * 64 < nk) { val[0][s * 8 + j] = buf[(2 * wave) * SC_STRIDE + j * 64 + lane]; val[1][s * 8 + j] = buf[(2 * wave + 1) * SC_STRIDE + j * 64 + lane]; }
            asm volatile("s_waitcnt lgkmcnt(0)" ::: "memory");
        }
    }
    }
    const unsigned long long lt = (1ull << lane) - 1ull;
#pragma unroll
    for (int qq = 0; qq < 2; ++qq) {
        unsigned Tt = 0u;
        for (int rep_se = 0; rep_se < SEL_REP_SEARCH; ++rep_se) { Tt = 0u; asm volatile("" : "+v"(val[qq][0]));
        if (nk > TOPK) {
            for (int bit = 31; bit >= 0; --bit) { const unsigned cand = Tt | (1u << bit); int cnt = 0;
#pragma unroll
                for (int r8 = 0; r8 < 8; ++r8) if (r8 * 8 < nr) CNT8_GE(cnt, val[qq][r8 * 8], val[qq][r8 * 8 + 1], val[qq][r8 * 8 + 2], val[qq][r8 * 8 + 3], val[qq][r8 * 8 + 4], val[qq][r8 * 8 + 5], val[qq][r8 * 8 + 6], val[qq][r8 * 8 + 7], cand);
                if (cnt >= TOPK) Tt = cand; if (cnt == TOPK) break; }
        }
        }
        unsigned short* orow = idx + (size_t)(t0 + 2 * wave + qq) * TOPK;
        LDSP unsigned short* orow_l = (LDSP unsigned short*)(lds + 134 * 1024) + (2 * wave + qq) * TOPK;
        int pos = 0;
#define PUT_KEY(o_, key_) do { if ((o_) < TOPK && !dry) { if (lds_out) orow_l[o_] = (unsigned short)(key_); else orow[o_] = (unsigned short)(key_); } } while (0)
#pragma unroll
        for (int r8 = 0; r8 < 8; ++r8) if (r8 * 8 < nr) { unsigned long long k0, k1, k2, k3, k4, k5, k6, k7;
            asm("v_cmp_gt_u32_e64 %0, %8, %16\n\tv_cmp_gt_u32_e64 %1, %9, %16\n\tv_cmp_gt_u32_e64 %2, %10, %16\n\tv_cmp_gt_u32_e64 %3, %11, %16\n\t"
                "v_cmp_gt_u32_e64 %4, %12, %16\n\tv_cmp_gt_u32_e64 %5, %13, %16\n\tv_cmp_gt_u32_e64 %6, %14, %16\n\tv_cmp_gt_u32_e64 %7, %15, %16"
                : "=&s"(k0), "=&s"(k1), "=&s"(k2), "=&s"(k3), "=&s"(k4), "=&s"(k5), "=&s"(k6), "=&s"(k7)
                : "v"(val[qq][r8 * 8]), "v"(val[qq][r8 * 8 + 1]), "v"(val[qq][r8 * 8 + 2]), "v"(val[qq][r8 * 8 + 3]), "v"(val[qq][r8 * 8 + 4]), "v"(val[qq][r8 * 8 + 5]), "v"(val[qq][r8 * 8 + 6]), "v"(val[qq][r8 * 8 + 7]), "s"(Tt));
#define PUT_MASK(m_, i_) do { if ((m_) != 0ull) { if (((m_) >> lane) & 1ull) { const int o = pos + __popcll((m_) & lt); PUT_KEY(o, (r8 * 8 + (i_)) * 64 + lane); } pos += __popcll(m_); } } while (0)
            PUT_MASK(k0, 0); PUT_MASK(k1, 1); PUT_MASK(k2, 2); PUT_MASK(k3, 3); PUT_MASK(k4, 4); PUT_MASK(k5, 5); PUT_MASK(k6, 6); PUT_MASK(k7, 7);
#undef PUT_MASK
        }
        int need = TOPK - pos;
        if (need > 0) {
#pragma unroll
            for (int r = 0; r < 64; ++r) if (r < nr && need > 0) { const unsigned long long meq = __ballot(val[qq][r] == Tt);
                if (meq != 0ull) { const int rank = __popcll(meq & lt); if (((meq >> lane) & 1ull) && rank < need) { PUT_KEY(pos + rank, r * 64 + lane); } const int tk = __popcll(meq); const int tkn = tk < need ? tk : need; pos += tkn; need -= tkn; } }
        }
#undef PUT_KEY
    }
    asm volatile("s_waitcnt vmcnt(0) lgkmcnt(0)" ::: "memory"); __builtin_amdgcn_s_barrier();
#undef IK_DMA
}

typedef unsigned short u16x4_t __attribute__((ext_vector_type(4)));
#ifndef ATT_LOCAL_DRY
#define ATT_LOCAL_DRY 0
#endif
#ifndef ATT_STAGGER
#define ATT_STAGGER 0
#endif
#ifndef ATT_DRY_SKIP
#define ATT_DRY_SKIP 0
#endif
#define DSK(b) (ATT_DRY_SKIP & (b)) && dry
#ifndef ATT_SUB_EN
#define ATT_SUB_EN 0
#endif
constexpr int SELW_OFF = 134 * 1024, BT_OFF = 142 * 1024, KVP = 528, TILE_STRIDE = 32 * KVP;
constexpr int SELW_OFF_OLD = 132 * 1024, BT_OFF_OLD = 140 * 1024;
__device__ __forceinline__ int kv_off(int row, int ch) { const int hf = ch >> 4, c16 = ch & 15; return hf * 8192 + 256 * row + 16 * (c16 ^ (((row & 3) << 2) | ((row >> 2) & 3))); }
#define TR4I(d0, d1, d2, d3, base, o0, o1, o2, o3) asm volatile("ds_read_b64_tr_b16 %0, %4 offset:%5\n\tds_read_b64_tr_b16 %1, %4 offset:%6\n\tds_read_b64_tr_b16 %2, %4 offset:%7\n\tds_read_b64_tr_b16 %3, %4 offset:%8" \
    : "=&v"(d0), "=&v"(d1), "=&v"(d2), "=&v"(d3) : "v"(base), "i"(o0), "i"(o1), "i"(o2), "i"(o3) : "memory")
#define TR8N(d0, d1, d2, d3, d4, d5, d6, d7, base, o0, o1, o2, o3, o4, o5, o6, o7) asm volatile( \
    "ds_read_b64_tr_b16 %0, %8 offset:%9\n\tds_read_b64_tr_b16 %1, %8 offset:%10\n\tds_read_b64_tr_b16 %2, %8 offset:%11\n\tds_read_b64_tr_b16 %3, %8 offset:%12\n\t" \
    "ds_read_b64_tr_b16 %4, %8 offset:%13\n\tds_read_b64_tr_b16 %5, %8 offset:%14\n\tds_read_b64_tr_b16 %6, %8 offset:%15\n\tds_read_b64_tr_b16 %7, %8 offset:%16" \
    : "=&v"(d0), "=&v"(d1), "=&v"(d2), "=&v"(d3), "=&v"(d4), "=&v"(d5), "=&v"(d6), "=&v"(d7) : "v"(base), "i"(o0), "i"(o1), "i"(o2), "i"(o3), "i"(o4), "i"(o5), "i"(o6), "i"(o7) : "memory")
#define WAITPIN8(n, d0, d1, d2, d3, d4, d5, d6, d7) asm volatile("s_waitcnt lgkmcnt(" #n ")" : "+v"(d0), "+v"(d1), "+v"(d2), "+v"(d3), "+v"(d4), "+v"(d5), "+v"(d6), "+v"(d7) :: "memory")
#define WAITPIN4(n, d0, d1, d2, d3) asm volatile("s_waitcnt lgkmcnt(" #n ")" : "+v"(d0), "+v"(d1), "+v"(d2), "+v"(d3) :: "memory")
__device__ __forceinline__ bf16x8_t mk8a(u16x4_t a, u16x4_t b) { bf16x8_t r; r[0] = a[0]; r[1] = a[1]; r[2] = a[2]; r[3] = a[3]; r[4] = b[0]; r[5] = b[1]; r[6] = b[2]; r[7] = b[3]; return r; }
#define TR8I(d0, d1, d2, d3, d4, d5, d6, d7, base, o0, o1, o2, o3, o4, o5, o6, o7) asm volatile( \
    "ds_read_b64_tr_b16 %0, %8 offset:%9\n\tds_read_b64_tr_b16 %1, %8 offset:%10\n\tds_read_b64_tr_b16 %2, %8 offset:%11\n\tds_read_b64_tr_b16 %3, %8 offset:%12\n\t" \
    "ds_read_b64_tr_b16 %4, %8 offset:%13\n\tds_read_b64_tr_b16 %5, %8 offset:%14\n\tds_read_b64_tr_b16 %6, %8 offset:%15\n\tds_read_b64_tr_b16 %7, %8 offset:%16\n\ts_waitcnt lgkmcnt(0)" \
    : "=&v"(d0), "=&v"(d1), "=&v"(d2), "=&v"(d3), "=&v"(d4), "=&v"(d5), "=&v"(d6), "=&v"(d7) : "v"(base), "i"(o0), "i"(o1), "i"(o2), "i"(o3), "i"(o4), "i"(o5), "i"(o6), "i"(o7) : "memory")
#define TR8(d0, d1, d2, d3, d4, d5, d6, d7, a0, a1, a2, a3, a4, a5, a6, a7) asm volatile( \
    "ds_read_b64_tr_b16 %0, %8\n\tds_read_b64_tr_b16 %1, %9\n\tds_read_b64_tr_b16 %2, %10\n\tds_read_b64_tr_b16 %3, %11\n\t" \
    "ds_read_b64_tr_b16 %4, %12\n\tds_read_b64_tr_b16 %5, %13\n\tds_read_b64_tr_b16 %6, %14\n\tds_read_b64_tr_b16 %7, %15\n\ts_waitcnt lgkmcnt(0)" \
    : "=&v"(d0), "=&v"(d1), "=&v"(d2), "=&v"(d3), "=&v"(d4), "=&v"(d5), "=&v"(d6), "=&v"(d7) : "v"(a0), "v"(a1), "v"(a2), "v"(a3), "v"(a4), "v"(a5), "v"(a6), "v"(a7) : "memory")
__device__ __forceinline__ void wg_attn16(LDSP unsigned char* lds, bf16* RA, const bf16* __restrict__ CKVC, const unsigned short* __restrict__ idx, const bf16* __restrict__ WUK, const bf16* __restrict__ WUV,
                                          const float* __restrict__ rel_bias, int unit, int nxt_unit, int par, bool first, int tid, bool dry = false, int qmode = 0, bf16* qscr = nullptr) {
    const int lane = tid & 63, wave = __builtin_amdgcn_readfirstlane(tid >> 6), g = lane >> 4, c = lane & 15;
    const int b = unit >> 9, qg = unit & 511, t0 = b * SEQ + qg * 8, nk = ((qg >> 3) + 1) << 6, nsel = nk < TOPK ? nk : TOPK, ntile = nsel >> 5;
    LDSP unsigned char* QL = lds;
    LDSP unsigned char* tile = lds + wave * TILE_STRIDE;
    LDSP unsigned short* selw = (LDSP unsigned short*)(lds + SELW_OFF + (par * 8 + wave) * 512);
    LDSP unsigned short* selw_n = (LDSP unsigned short*)(lds + SELW_OFF + ((par ^ 1) * 8 + wave) * 512);
    if (first) { if (lane < 32) *((LDSP u32x4*)selw + lane) = *((const u32x4*)(idx + (size_t)(t0 + wave) * TOPK) + lane); }
    const bf16* kvb = CKVC + (size_t)b * SEQ * KV_R + g * 8;
    bf16x8_t kv0[8], kv1[8];
#define KV_LOAD(dst, key) do { const bf16* rp_ = kvb + (size_t)(key) * KV_R; _Pragma("unroll") for (int ks_ = 0; ks_ < 8; ++ks_) dst[ks_] = *(const bf16x8_t*)(rp_ + ks_ * 32); } while (0)
    int ka = (int)selw[c], kb = (int)selw[16 + c];
    KV_LOAD(kv0, ka); KV_LOAD(kv1, kb);
    bf16x8_t qf[8];
    if (qmode != 2) {
        const int h = wave; const bf16* qr = RA + (size_t)(t0 + (qmode == 1 ? c : (c & 7))) * NA + A_Q + h * 64 + g * 8;
        const bf16x8_t b0 = *(const bf16x8_t*)qr, b1 = *(const bf16x8_t*)(qr + 32);
        const bf16* wb = WUK + ((size_t)h * 256 + c) * 64 + g * 8;
#pragma unroll 4
        for (int rt = 0; rt < 16; ++rt) { const bf16x8_t a0 = *(const bf16x8_t*)(wb + rt * 16 * 64), a1 = *(const bf16x8_t*)(wb + rt * 16 * 64 + 32);
            pg8::f32x4 acc = {0.f, 0.f, 0.f, 0.f};
            acc = __builtin_amdgcn_mfma_f32_16x16x32_bf16(a0, b0, acc, 0, 0, 0); acc = __builtin_amdgcn_mfma_f32_16x16x32_bf16(a1, b1, acc, 0, 0, 0);
            u32x2 w; w.x = pk2(acc[0], acc[1]); w.y = pk2(acc[2], acc[3]);
            if (c < 8) *(LDSP u32x2*)(QL + (((c * 8 + h) * 256) + rt * 16 + 4 * g) * 2) = w;
            else if (qmode == 1) *(u32x2*)(qscr + ((((c - 8) * 8 + h) * 256) + rt * 16 + 4 * g)) = w; }
        asm volatile("s_waitcnt lgkmcnt(0)" ::: "memory"); __builtin_amdgcn_s_barrier(); asm volatile("" ::: "memory");
#pragma unroll
        for (int ks = 0; ks < 8; ++ks) qf[ks] = *(const LDSP bf16x8_t*)(QL + (((wave * 8 + (c & 7)) * 256) + ks * 32 + g * 8) * 2);
        asm volatile("s_waitcnt lgkmcnt(0)" ::: "memory"); __builtin_amdgcn_s_barrier(); asm volatile("" ::: "memory");
    } else {
        const unsigned long long* qs = (const unsigned long long*)(qscr + (((wave * 8 + (c & 7)) * 256) + g * 8));
#pragma unroll
        for (int ks = 0; ks < 8; ++ks) { const unsigned long long lo = __hip_atomic_load(qs + ks * 8, __ATOMIC_RELAXED, __HIP_MEMORY_SCOPE_AGENT), hi = __hip_atomic_load(qs + ks * 8 + 1, __ATOMIC_RELAXED, __HIP_MEMORY_SCOPE_AGENT);
            u32x4 w; w.x = (unsigned)lo; w.y = (unsigned)(lo >> 32); w.z = (unsigned)hi; w.w = (unsigned)(hi >> 32); qf[ks] = __builtin_bit_cast(bf16x8_t, w); }
    }
    const unsigned tile_a = (unsigned)(size_t)tile;
#if ATT_STAGGER
    if (wave >= 4) __builtin_amdgcn_s_sleep(ATT_STAGGER);
#endif
    bf16x8_t bbf; { float bv[8];
#pragma unroll
        for (int j = 0; j < 8; ++j) bv[j] = rel_bias[(8 * g + j) * 8 + (c & 7)];
        u32x4 w; w.x = pk2(bv[0], bv[1]); w.y = pk2(bv[2], bv[3]); w.z = pk2(bv[4], bv[5]); w.w = pk2(bv[6], bv[7]); bbf = __builtin_bit_cast(bf16x8_t, w); }
    {
        const int spos = (qg * 8 + wave);
        pg8::f32x4 acc[16];
#pragma unroll
        for (int nt = 0; nt < 16; ++nt) acc[nt] = (pg8::f32x4){0.f, 0.f, 0.f, 0.f};
        float m_run = -INFINITY, l_run = 0.f;
#define ONEHOT(dst, key) do { const int rel_ = (key) - spos, n_ = rel_ < 0 ? -rel_ : rel_; \
            const int big_ = 8 + (n_ >= 15) + (n_ >= 27) + (n_ >= 50) + (n_ >= 91) + (n_ >= 166) + (n_ >= 305) + (n_ >= 559); \
            const int pos_ = (n_ < 8 ? n_ : big_) + (rel_ > 0 ? 16 : 0) - 8 * g; const unsigned one_ = (pos_ & 1) ? 0x3F800000u : 0x3F80u; const int hi_ = pos_ >> 1; \
            u32x4 w_; w_.x = (hi_ == 0) ? one_ : 0u; w_.y = (hi_ == 1) ? one_ : 0u; w_.z = (hi_ == 2) ? one_ : 0u; w_.w = (hi_ == 3) ? one_ : 0u; dst = __builtin_bit_cast(bf16x8_t, w_); } while (0)
        const int q4 = c >> 2, p = c & 3;
        const unsigned trb = tile_a + (4 * g + q4) * KVP + 8 * p;
        for (int tl = 0; tl < ntile; ++tl) {
            int kan = 0, kbn = 0; const bool more = tl + 1 < ntile;
            if (more) { kan = (int)selw[(2 * tl + 2) * 16 + c]; kbn = (int)selw[(2 * tl + 3) * 16 + c]; }
            bf16x8_t oha, ohb; ONEHOT(oha, ka); ONEHOT(ohb, kb);
            asm volatile("s_waitcnt vmcnt(8)" ::: "memory");
            pg8::f32x4 s0 = {0.f, 0.f, 0.f, 0.f}, s1 = {0.f, 0.f, 0.f, 0.f};
            s0 = __builtin_amdgcn_mfma_f32_16x16x32_bf16(oha, bbf, s0, 0, 0, 0);
#pragma unroll
            for (int ks = 0; ks < 8; ++ks) { s0 = __builtin_amdgcn_mfma_f32_16x16x32_bf16(kv0[ks], qf[ks], s0, 0, 0, 0); *(LDSP bf16x8_t*)(tile + c * KVP + g * 16 + ks * 64) = kv0[ks]; }
            if (more) KV_LOAD(kv0, kan);
            if (more) asm volatile("s_waitcnt vmcnt(8)" ::: "memory"); else asm volatile("s_waitcnt vmcnt(0)" ::: "memory");
            s1 = __builtin_amdgcn_mfma_f32_16x16x32_bf16(ohb, bbf, s1, 0, 0, 0);
#pragma unroll
            for (int ks = 0; ks < 8; ++ks) { s1 = __builtin_amdgcn_mfma_f32_16x16x32_bf16(kv1[ks], qf[ks], s1, 0, 0, 0); *(LDSP bf16x8_t*)(tile + (16 + c) * KVP + g * 16 + ks * 64) = kv1[ks]; }
            if (more) KV_LOAD(kv1, kbn);
            ka = kan; kb = kbn;
            float sv[8];
#pragma unroll
            for (int j = 0; j < 4; ++j) { sv[j] = s0[j]; sv[4 + j] = s1[j]; }
            float tmax = fmaxf(fmaxf(fmaxf(sv[0], sv[1]), fmaxf(sv[2], sv[3])), fmaxf(fmaxf(sv[4], sv[5]), fmaxf(sv[6], sv[7])));
            tmax = fmaxf(tmax, __shfl_xor(tmax, 16)); tmax = fmaxf(tmax, __shfl_xor(tmax, 32));
            const float m_new = fmaxf(m_run, tmax); const float scl = __expf(m_run - m_new); const bool grow = m_new > m_run; m_run = m_new;
            float ps = 0.f;
#pragma unroll
            for (int j = 0; j < 8; ++j) { sv[j] = __expf(sv[j] - m_new); ps += sv[j]; }
            l_run = l_run * scl + ps;
            bf16x8_t pf; { u32x4 w; w.x = pk2(sv[0], sv[1]); w.y = pk2(sv[2], sv[3]); w.z = pk2(sv[4], sv[5]); w.w = pk2(sv[6], sv[7]); pf = __builtin_bit_cast(bf16x8_t, w); }
            if (__builtin_amdgcn_ballot_w64(grow) != 0ull) {
                float rs[4];
#pragma unroll
                for (int e = 0; e < 4; ++e) rs[e] = __shfl(scl, 4 * g + e);
#pragma unroll
                for (int nt = 0; nt < 16; ++nt) {
#pragma unroll
                    for (int e = 0; e < 4; ++e) acc[nt][e] *= rs[e]; } }
            asm volatile("s_waitcnt lgkmcnt(0)" ::: "memory");
            u16x4_t va[8], vb[8];
            TR8N(va[0], va[1], va[2], va[3], va[4], va[5], va[6], va[7], trb, 0, 16 * KVP, 32, 32 + 16 * KVP, 64, 64 + 16 * KVP, 96, 96 + 16 * KVP);
            TR8N(vb[0], vb[1], vb[2], vb[3], vb[4], vb[5], vb[6], vb[7], trb, 128, 128 + 16 * KVP, 160, 160 + 16 * KVP, 192, 192 + 16 * KVP, 224, 224 + 16 * KVP);
            WAITPIN8(8, va[0], va[1], va[2], va[3], va[4], va[5], va[6], va[7]);
#pragma unroll
            for (int k = 0; k < 4; ++k) acc[k] = __builtin_amdgcn_mfma_f32_16x16x32_bf16(pf, mk8a(va[2 * k], va[2 * k + 1]), acc[k], 0, 0, 0);
            TR8N(va[0], va[1], va[2], va[3], va[4], va[5], va[6], va[7], trb, 256, 256 + 16 * KVP, 288, 288 + 16 * KVP, 320, 320 + 16 * KVP, 352, 352 + 16 * KVP);
            WAITPIN8(8, vb[0], vb[1], vb[2], vb[3], vb[4], vb[5], vb[6], vb[7]);
#pragma unroll
            for (int k = 0; k < 4; ++k) acc[4 + k] = __builtin_amdgcn_mfma_f32_16x16x32_bf16(pf, mk8a(vb[2 * k], vb[2 * k + 1]), acc[4 + k], 0, 0, 0);
            TR8N(vb[0], vb[1], vb[2], vb[3], vb[4], vb[5], vb[6], vb[7], trb, 384, 384 + 16 * KVP, 416, 416 + 16 * KVP, 448, 448 + 16 * KVP, 480, 480 + 16 * KVP);
            WAITPIN8(8, va[0], va[1], va[2], va[3], va[4], va[5], va[6], va[7]);
#pragma unroll
            for (int k = 0; k < 4; ++k) acc[8 + k] = __builtin_amdgcn_mfma_f32_16x16x32_bf16(pf, mk8a(va[2 * k], va[2 * k + 1]), acc[8 + k], 0, 0, 0);
            WAITPIN8(0, vb[0], vb[1], vb[2], vb[3], vb[4], vb[5], vb[6], vb[7]);
#pragma unroll
            for (int k = 0; k < 4; ++k) acc[12 + k] = __builtin_amdgcn_mfma_f32_16x16x32_bf16(pf, mk8a(vb[2 * k], vb[2 * k + 1]), acc[12 + k], 0, 0, 0);
        }
#undef KV_LOAD
#undef ONEHOT
        float lt = l_run + __shfl_xor(l_run, 16); lt += __shfl_xor(lt, 32); const float inv = 1.0f / lt;
        float ri[4];
#pragma unroll
        for (int e = 0; e < 4; ++e) ri[e] = __shfl(inv, 4 * g + e);
        if (g < 2) {
#pragma unroll
            for (int nt = 0; nt < 16; ++nt) { LDSP unsigned short* o1 = (LDSP unsigned short*)(tile) + (4 * g) * 256 + nt * 16 + c;
                o1[0] = f2bf(acc[nt][0] * ri[0]); o1[256] = f2bf(acc[nt][1] * ri[1]); o1[512] = f2bf(acc[nt][2] * ri[2]); o1[768] = f2bf(acc[nt][3] * ri[3]); }
        }
    }
    u32x4 nsel_v = {0u, 0u, 0u, 0u};
    if (nxt_unit >= 0 && lane < 32) { const int nb = nxt_unit >> 9, nq = nxt_unit & 511; nsel_v = *((const u32x4*)(idx + (size_t)(nb * SEQ + nq * 8 + wave) * TOPK) + lane); }
    asm volatile("s_waitcnt lgkmcnt(0)" ::: "memory"); __builtin_amdgcn_s_barrier(); asm volatile("" ::: "memory");
    if (qmode == 1) {
        bf16* oscr = qscr + 16384;
#pragma unroll
        for (int j = 0; j < 4; ++j) *((u32x4*)(oscr + (size_t)wave * 2048) + j * 64 + lane) = *((const LDSP u32x4*)(tile) + j * 64 + lane);
    } else {
        const int h = wave; pg8::f32x4 o[4];
#pragma unroll
        for (int nt = 0; nt < 4; ++nt) o[nt] = (pg8::f32x4){0.f, 0.f, 0.f, 0.f};
        const LDSP unsigned char* ab = lds + TILE_STRIDE * (c & 7) + (h * 256 + g * 8) * 2;
        const unsigned long long* os = (const unsigned long long*)(qscr + 16384 + ((c & 7) * 8 + h) * 256 + g * 8);
        const bf16* wb = WUV + ((size_t)h * 64 + c) * 256 + g * 8;
        const bool from_scr = (qmode == 2) && (c < 8);
#pragma unroll
        for (int ks = 0; ks < 8; ++ks) { bf16x8_t a;
            if (from_scr) { const unsigned long long lo = __hip_atomic_load(os + ks * 8, __ATOMIC_RELAXED, __HIP_MEMORY_SCOPE_AGENT), hi = __hip_atomic_load(os + ks * 8 + 1, __ATOMIC_RELAXED, __HIP_MEMORY_SCOPE_AGENT);
                u32x4 w; w.x = (unsigned)lo; w.y = (unsigned)(lo >> 32); w.z = (unsigned)hi; w.w = (unsigned)(hi >> 32); a = __builtin_bit_cast(bf16x8_t, w); }
            else a = *(const LDSP bf16x8_t*)(ab + ks * 64);
#pragma unroll
            for (int nt = 0; nt < 4; ++nt) { const bf16x8_t bw = *(const bf16x8_t*)(wb + (size_t)nt * 16 * 256 + ks * 32); o[nt] = __builtin_amdgcn_mfma_f32_16x16x32_bf16(a, bw, o[nt], 0, 0, 0); } }
        const int rbase = (qmode == 2) ? t0 - 8 : t0;
        if ((g < 2 || qmode == 2) && !dry) {
#pragma unroll
            for (int nt = 0; nt < 4; ++nt)
#pragma unroll
                for (int e = 0; e < 4; ++e) RA[(size_t)(rbase + 4 * g + e) * NA + A_Q + h * 64 + nt * 16 + c] = f2bf(o[nt][e]); }
    }
    if (nxt_unit >= 0 && lane < 32) *((LDSP u32x4*)selw_n + lane) = nsel_v;
    asm volatile("s_waitcnt vmcnt(0) lgkmcnt(0)" ::: "memory"); __builtin_amdgcn_s_barrier(); asm volatile("" ::: "memory");
}

template <int VAR = 0> __device__ __forceinline__ void wg_attn16d(LDSP unsigned char* lds, bf16* RA, const bf16* __restrict__ CKVC, const unsigned short* __restrict__ idx, const bf16* __restrict__ WUK, const bf16* __restrict__ WUV,
                                          const float* __restrict__ rel_bias, int unit, int nxt_unit, int par, bool first, int tid, bool dry = false, int qmode = 0, bf16* qscr = nullptr) {
    const int lane = tid & 63, wave = __builtin_amdgcn_readfirstlane(tid >> 6), g = lane >> 4, c = lane & 15;
    const int b = unit >> 9, qg = unit & 511, t0 = b * SEQ + qg * 8, nk = ((qg >> 3) + 1) << 6, nsel = nk < TOPK ? nk : TOPK, ntile = nsel >> 5;
    LDSP unsigned char* QL = lds;
    LDSP unsigned char* tile = lds + wave * TILE_STRIDE;
    LDSP unsigned short* selw = (LDSP unsigned short*)(lds + SELW_OFF + (par * 8 + wave) * 512);
    LDSP unsigned short* selw_n = (LDSP unsigned short*)(lds + SELW_OFF + ((par ^ 1) * 8 + wave) * 512);
    if (first) { if (lane < 32) *((LDSP u32x4*)selw + lane) = *((const u32x4*)(idx + (size_t)(t0 + wave) * TOPK) + lane); }
    const bf16* kvb = CKVC + (size_t)b * SEQ * KV_R;
    const int nstep = (VAR & 64) ? 0 : (nsel >> 4);
    constexpr bool halfdma = (VAR & 1) != 0, nodma = (VAR & 2) != 0, nolds = (VAR & 4) != 0, nopv = (VAR & 8) != 0, noqk = (VAR & 16) != 0, nosm = (VAR & 32) != 0;
#define KV_DMA(step) do { if (nodma) break; LDSP unsigned char* sl_ = tile + ((step) & 1) * 8192; \
        _Pragma("unroll") for (int i4_ = 0; i4_ < 4; ++i4_) { const int row_ = 4 * i4_ + g; const int key_ = (int)selw[(step) * 16 + row_]; const int c16_ = c ^ ((g << 2) | i4_); \
            const bf16* src_ = kvb + (size_t)key_ * KV_R + c16_ * 8; \
            __builtin_amdgcn_global_load_lds((const unsigned*)src_, (LDSP unsigned*)(sl_ + 1024 * i4_), 16, 0, 0); \
            if (!halfdma) __builtin_amdgcn_global_load_lds((const unsigned*)(src_ + 128), (LDSP unsigned*)(sl_ + 4096 + 1024 * i4_), 16, 0, 0); } } while (0)
    if (nstep > 0) KV_DMA(0);
    bf16x8_t qf[8];
    if (qmode != 2) {
        const int h = wave; const bf16* qr = RA + (size_t)(t0 + (qmode == 1 ? c : (c & 7))) * NA + A_Q + h * 64 + g * 8;
        const bf16x8_t b0 = *(const bf16x8_t*)qr, b1 = *(const bf16x8_t*)(qr + 32);
        const bf16* wb = WUK + ((size_t)h * 256 + c) * 64 + g * 8;
#pragma unroll 4
        for (int rt = 0; rt < 16; ++rt) { const bf16x8_t a0 = *(const bf16x8_t*)(wb + rt * 16 * 64), a1 = *(const bf16x8_t*)(wb + rt * 16 * 64 + 32);
            pg8::f32x4 acc = {0.f, 0.f, 0.f, 0.f};
            acc = __builtin_amdgcn_mfma_f32_16x16x32_bf16(a0, b0, acc, 0, 0, 0); acc = __builtin_amdgcn_mfma_f32_16x16x32_bf16(a1, b1, acc, 0, 0, 0);
            u32x2 w; w.x = pk2(acc[0], acc[1]); w.y = pk2(acc[2], acc[3]);
            if (c < 8) *(LDSP u32x2*)(lds + c * TILE_STRIDE + 8192 + ((h * 256) + rt * 16 + 4 * g) * 2) = w;
            else if (qmode == 1) *(u32x2*)(qscr + ((((c - 8) * 8 + h) * 256) + rt * 16 + 4 * g)) = w; }
        asm volatile("s_waitcnt lgkmcnt(0)" ::: "memory"); __builtin_amdgcn_s_barrier(); asm volatile("" ::: "memory");
#pragma unroll
        for (int ks = 0; ks < 8; ++ks) qf[ks] = *(const LDSP bf16x8_t*)(tile + 8192 + (((c & 7) * 256) + ks * 32 + g * 8) * 2);
        asm volatile("s_waitcnt lgkmcnt(0)" ::: "memory");
    } else {
        const unsigned long long* qs = (const unsigned long long*)(qscr + (((wave * 8 + (c & 7)) * 256) + g * 8));
#pragma unroll
        for (int ks = 0; ks < 8; ++ks) { const unsigned long long lo = __hip_atomic_load(qs + ks * 8, __ATOMIC_RELAXED, __HIP_MEMORY_SCOPE_AGENT), hi = __hip_atomic_load(qs + ks * 8 + 1, __ATOMIC_RELAXED, __HIP_MEMORY_SCOPE_AGENT);
            u32x4 w; w.x = (unsigned)lo; w.y = (unsigned)(lo >> 32); w.z = (unsigned)hi; w.w = (unsigned)(hi >> 32); qf[ks] = __builtin_bit_cast(bf16x8_t, w); }
    }
    const unsigned tile_a = (unsigned)(size_t)tile;
#if ATT_STAGGER
    if (wave >= 4) __builtin_amdgcn_s_sleep(ATT_STAGGER);
#endif
    bf16x8_t bbf; { float bv[8];
#pragma unroll
        for (int j = 0; j < 8; ++j) bv[j] = rel_bias[(8 * g + j) * 8 + (c & 7)];
        u32x4 w; w.x = pk2(bv[0], bv[1]); w.y = pk2(bv[2], bv[3]); w.z = pk2(bv[4], bv[5]); w.w = pk2(bv[6], bv[7]); bbf = __builtin_bit_cast(bf16x8_t, w); }
    {
        const int spos = (qg * 8 + wave);
        pg8::f32x4 acc[16];
#pragma unroll
        for (int nt = 0; nt < 16; ++nt) acc[nt] = (pg8::f32x4){0.f, 0.f, 0.f, 0.f};
        float m_run = -INFINITY, l_run = 0.f;
#define ONEHOT(dst, key) do { const int rel_ = (key) - spos, n_ = rel_ < 0 ? -rel_ : rel_; \
            const int big_ = 8 + (n_ >= 15) + (n_ >= 27) + (n_ >= 50) + (n_ >= 91) + (n_ >= 166) + (n_ >= 305) + (n_ >= 559); \
            const int pos_ = (n_ < 8 ? n_ : big_) + (rel_ > 0 ? 16 : 0) - 8 * g; const unsigned one_ = (pos_ & 1) ? 0x3F800000u : 0x3F80u; const int hi_ = pos_ >> 1; \
            u32x4 w_; w_.x = (hi_ == 0) ? one_ : 0u; w_.y = (hi_ == 1) ? one_ : 0u; w_.z = (hi_ == 2) ? one_ : 0u; w_.w = (hi_ == 3) ? one_ : 0u; dst = __builtin_bit_cast(bf16x8_t, w_); } while (0)
        const int q4 = c >> 2, p = c & 3;
        const unsigned rd0 = tile_a + 256 * c + 16 * (g ^ (c >> 2)); const unsigned rx = (unsigned)(c & 3);
        const unsigned tr0 = tile_a + 256 * (4 * g + q4) + 8 * (p & 1); const unsigned ts = (unsigned)(((q4 << 2) | g)), tb0 = (unsigned)(p >> 1);
        if (nstep > 1) KV_DMA(1);
        for (int st = 0; st < nstep; ++st) {
            const unsigned so = (unsigned)((st & 1) * 8192);
            const int key = (int)selw[st * 16 + c];
            bf16x8_t oh; ONEHOT(oh, key);
            if (st + 1 < nstep) { if (nodma) {} else if (halfdma) asm volatile("s_waitcnt vmcnt(4)" ::: "memory"); else asm volatile("s_waitcnt vmcnt(8)" ::: "memory"); } else asm volatile("s_waitcnt vmcnt(0)" ::: "memory");
            bf16x8_t af[8]; u16x4_t v[16];
#pragma unroll
            for (int ks = 0; ks < 8; ++ks) { if (nolds) af[ks] = qf[ks]; else af[ks] = *(const LDSP bf16x8_t*)(size_t)(rd0 + so + (ks >> 2) * 4096 + 64 * (((unsigned)(ks & 3)) ^ rx)); }
#pragma unroll
            for (int n4 = 0; n4 < 4; ++n4) { unsigned ad[4]; if (nolds) { v[n4 * 4] = v[n4 * 4 + 1] = v[n4 * 4 + 2] = v[n4 * 4 + 3] = (u16x4_t){(unsigned short)st, 1, 2, 3}; continue; }
#pragma unroll
                for (int k = 0; k < 4; ++k) { const unsigned nt = (unsigned)(n4 * 4 + k); ad[k] = tr0 + so + (nt >> 3) * 4096 + 16 * ((((nt & 7) << 1) | tb0) ^ ts); }
                asm volatile("ds_read_b64_tr_b16 %0, %4\n\tds_read_b64_tr_b16 %1, %5\n\tds_read_b64_tr_b16 %2, %6\n\tds_read_b64_tr_b16 %3, %7" : "=&v"(v[n4 * 4]), "=&v"(v[n4 * 4 + 1]), "=&v"(v[n4 * 4 + 2]), "=&v"(v[n4 * 4 + 3]) : "v"(ad[0]), "v"(ad[1]), "v"(ad[2]), "v"(ad[3]) : "memory"); }
            WAITPIN4(0, v[0], v[1], v[2], v[3]); WAITPIN4(0, v[4], v[5], v[6], v[7]); WAITPIN4(0, v[8], v[9], v[10], v[11]); WAITPIN4(0, v[12], v[13], v[14], v[15]);
            if (st + 2 < nstep) KV_DMA(st + 2);
            pg8::f32x4 s0 = {0.f, 0.f, 0.f, 0.f};
            s0 = __builtin_amdgcn_mfma_f32_16x16x32_bf16(oh, bbf, s0, 0, 0, 0);
#pragma unroll
            for (int ks = 0; ks < 8; ++ks) { if (noqk) { if (ks == 0) s0[0] += __builtin_bit_cast(float, ((unsigned)af[0][0] << 16) ^ ((unsigned)af[1][1] << 16) ^ ((unsigned)af[2][1] << 16) ^ ((unsigned)af[3][1] << 16) ^ ((unsigned)af[4][1] << 16) ^ ((unsigned)af[5][1] << 16) ^ ((unsigned)af[6][1] << 16) ^ ((unsigned)af[7][1] << 16)); } else s0 = __builtin_amdgcn_mfma_f32_16x16x32_bf16(af[ks], qf[ks], s0, 0, 0, 0); }
            float tmax = fmaxf(fmaxf(s0[0], s0[1]), fmaxf(s0[2], s0[3]));
            if (!nosm) { tmax = fmaxf(tmax, __shfl_xor(tmax, 16)); tmax = fmaxf(tmax, __shfl_xor(tmax, 32)); }
            const float m_new = fmaxf(m_run, tmax); const float scl = __expf(m_run - m_new); const bool grow = m_new > m_run; m_run = m_new;
            float sv[4]; float ps = 0.f;
#pragma unroll
            for (int j = 0; j < 4; ++j) { sv[j] = __expf(s0[j] - m_new); ps += sv[j]; }
            l_run = l_run * scl + ps;
            typedef short bf16x4_t __attribute__((ext_vector_type(4)));
            bf16x4_t pf; { u32x2 w; w.x = pk2(sv[0], sv[1]); w.y = pk2(sv[2], sv[3]); pf = __builtin_bit_cast(bf16x4_t, w); }
            if (__builtin_amdgcn_ballot_w64(grow) != 0ull) {
                float rs[4];
#pragma unroll
                for (int e = 0; e < 4; ++e) rs[e] = __shfl(scl, 4 * g + e);
#pragma unroll
                for (int nt = 0; nt < 16; ++nt) {
#pragma unroll
                    for (int e = 0; e < 4; ++e) acc[nt][e] *= rs[e]; } }
#pragma unroll
            for (int k = 0; k < 16; ++k) { if (nopv) { acc[k][0] += __builtin_bit_cast(float, (unsigned)v[k][0] << 16) * sv[0]; } else acc[k] = __builtin_amdgcn_mfma_f32_16x16x16bf16_1k(pf, __builtin_bit_cast(bf16x4_t, v[k]), acc[k], 0, 0, 0); }
        }
#undef KV_DMA
#undef ONEHOT
        float lt = l_run + __shfl_xor(l_run, 16); lt += __shfl_xor(lt, 32); const float inv = 1.0f / lt;
        float ri[4];
#pragma unroll
        for (int e = 0; e < 4; ++e) ri[e] = __shfl(inv, 4 * g + e);
        if (g < 2) {
#pragma unroll
            for (int nt = 0; nt < 16; ++nt) { LDSP unsigned short* o1 = (LDSP unsigned short*)(tile) + (4 * g) * 256 + nt * 16 + c;
                o1[0] = f2bf(acc[nt][0] * ri[0]); o1[256] = f2bf(acc[nt][1] * ri[1]); o1[512] = f2bf(acc[nt][2] * ri[2]); o1[768] = f2bf(acc[nt][3] * ri[3]); }
        }
    }
    u32x4 nsel_v = {0u, 0u, 0u, 0u};
    if (nxt_unit >= 0 && lane < 32) { const int nb = nxt_unit >> 9, nq = nxt_unit & 511; nsel_v = *((const u32x4*)(idx + (size_t)(nb * SEQ + nq * 8 + wave) * TOPK) + lane); }
    asm volatile("s_waitcnt lgkmcnt(0)" ::: "memory"); __builtin_amdgcn_s_barrier(); asm volatile("" ::: "memory");
    if (qmode == 1) {
        bf16* oscr = qscr + 16384;
#pragma unroll
        for (int j = 0; j < 4; ++j) *((u32x4*)(oscr + (size_t)wave * 2048) + j * 64 + lane) = *((const LDSP u32x4*)(tile) + j * 64 + lane);
    } else {
        const int h = wave; pg8::f32x4 o[4];
#pragma unroll
        for (int nt = 0; nt < 4; ++nt) o[nt] = (pg8::f32x4){0.f, 0.f, 0.f, 0.f};
        const LDSP unsigned char* ab = lds + TILE_STRIDE * (c & 7) + (h * 256 + g * 8) * 2;
        const unsigned long long* os = (const unsigned long long*)(qscr + 16384 + ((c & 7) * 8 + h) * 256 + g * 8);
        const bf16* wb = WUV + ((size_t)h * 64 + c) * 256 + g * 8;
        const bool from_scr = (qmode == 2) && (c < 8);
#pragma unroll
        for (int ks = 0; ks < 8; ++ks) { bf16x8_t a;
            if (from_scr) { const unsigned long long lo = __hip_atomic_load(os + ks * 8, __ATOMIC_RELAXED, __HIP_MEMORY_SCOPE_AGENT), hi = __hip_atomic_load(os + ks * 8 + 1, __ATOMIC_RELAXED, __HIP_MEMORY_SCOPE_AGENT);
                u32x4 w; w.x = (unsigned)lo; w.y = (unsigned)(lo >> 32); w.z = (unsigned)hi; w.w = (unsigned)(hi >> 32); a = __builtin_bit_cast(bf16x8_t, w); }
            else a = *(const LDSP bf16x8_t*)(ab + ks * 64);
#pragma unroll
            for (int nt = 0; nt < 4; ++nt) { const bf16x8_t bw = *(const bf16x8_t*)(wb + (size_t)nt * 16 * 256 + ks * 32); o[nt] = __builtin_amdgcn_mfma_f32_16x16x32_bf16(a, bw, o[nt], 0, 0, 0); } }
        const int rbase = (qmode == 2) ? t0 - 8 : t0;
        if ((g < 2 || qmode == 2) && !dry) {
#pragma unroll
            for (int nt = 0; nt < 4; ++nt)
#pragma unroll
                for (int e = 0; e < 4; ++e) RA[(size_t)(rbase + 4 * g + e) * NA + A_Q + h * 64 + nt * 16 + c] = f2bf(o[nt][e]); }
    }
    if (nxt_unit >= 0 && lane < 32) *((LDSP u32x4*)selw_n + lane) = nsel_v;
    asm volatile("s_waitcnt vmcnt(0) lgkmcnt(0)" ::: "memory"); __builtin_amdgcn_s_barrier(); asm volatile("" ::: "memory");
}

#define QLS_PTR(t) (RB + (size_t)(t) * NB + 1024)
__device__ __forceinline__ void wg_qlat_all(const bf16* RA, bf16* RB, const bf16* __restrict__ WUK, int blk, int G, int tid) {
    const int lane = tid & 63, wave = __builtin_amdgcn_readfirstlane(tid >> 6), g = lane >> 4, c = lane & 15, h = wave;
    const bf16* wb = WUK + ((size_t)h * 256 + c) * 64 + g * 8;
    bf16x8_t a0[16], a1[16];
#pragma unroll
    for (int rt = 0; rt < 16; ++rt) { a0[rt] = *(const bf16x8_t*)(wb + rt * 16 * 64); a1[rt] = *(const bf16x8_t*)(wb + rt * 16 * 64 + 32); }
#pragma clang loop unroll(disable)
    for (int i = blk; i < T / 16; i += G) { const int b_ = i & 7, j_ = i >> 3, tg = b_ * SEQ + (255 - j_) * 16;
        const bf16* qr = RA + (size_t)(tg + c) * NA + A_Q + h * 64 + g * 8;
        const bf16x8_t b0 = *(const bf16x8_t*)qr, b1 = *(const bf16x8_t*)(qr + 32);
        bf16* dst = QLS_PTR(tg + c) + h * 256 + 4 * g;
#pragma unroll
        for (int rt = 0; rt < 16; ++rt) { pg8::f32x4 acc = {0.f, 0.f, 0.f, 0.f};
            acc = __builtin_amdgcn_mfma_f32_16x16x32_bf16(a0[rt], b0, acc, 0, 0, 0); acc = __builtin_amdgcn_mfma_f32_16x16x32_bf16(a1[rt], b1, acc, 0, 0, 0);
            u32x2 w; w.x = pk2(acc[0], acc[1]); w.y = pk2(acc[2], acc[3]); *(u32x2*)(dst + rt * 16) = w; } }
}
__device__ __forceinline__ void wg_aout_all(bf16* RA, const bf16* RB, const bf16* __restrict__ WUV, int blk, int G, int tid) {
    const int lane = tid & 63, wave = __builtin_amdgcn_readfirstlane(tid >> 6), g = lane >> 4, c = lane & 15, h = wave;
    const bf16* wb = WUV + ((size_t)h * 64 + c) * 256 + g * 8;
    bf16x8_t bw[4][8];
#pragma unroll
    for (int nt = 0; nt < 4; ++nt)
#pragma unroll
        for (int ks = 0; ks < 8; ++ks) bw[nt][ks] = *(const bf16x8_t*)(wb + (size_t)nt * 16 * 256 + ks * 32);
#pragma clang loop unroll(disable)
    for (int i = blk; i < T / 16; i += G) { const int b_ = i & 7, j_ = i >> 3, tg = b_ * SEQ + (255 - j_) * 16;
        const unsigned long long* os = (const unsigned long long*)(QLS_PTR(tg + c) + h * 256 + g * 8);
        pg8::f32x4 o[4];
#pragma unroll
        for (int nt = 0; nt < 4; ++nt) o[nt] = (pg8::f32x4){0.f, 0.f, 0.f, 0.f};
        bf16x8_t a[8];
#pragma unroll
        for (int ks = 0; ks < 8; ++ks) { const unsigned long long lo = __hip_atomic_load(os + ks * 8, __ATOMIC_RELAXED, __HIP_MEMORY_SCOPE_AGENT), hi = __hip_atomic_load(os + ks * 8 + 1, __ATOMIC_RELAXED, __HIP_MEMORY_SCOPE_AGENT);
            u32x4 w; w.x = (unsigned)lo; w.y = (unsigned)(lo >> 32); w.z = (unsigned)hi; w.w = (unsigned)(hi >> 32); a[ks] = __builtin_bit_cast(bf16x8_t, w); }
#pragma unroll
        for (int ks = 0; ks < 8; ++ks)
#pragma unroll
            for (int nt = 0; nt < 4; ++nt) o[nt] = __builtin_amdgcn_mfma_f32_16x16x32_bf16(a[ks], bw[nt][ks], o[nt], 0, 0, 0);
#pragma unroll
        for (int nt = 0; nt < 4; ++nt)
#pragma unroll
            for (int e = 0; e < 4; ++e) RA[(size_t)(tg + 4 * g + e) * NA + A_Q + h * 64 + nt * 16 + c] = f2bf(o[nt][e]); }
}
__device__ __forceinline__ void wg_attn8(LDSP unsigned char* lds, bf16* RB, const bf16* __restrict__ CKVC, const float* __restrict__ rel_bias, int unit, int par, int tid) {
    const int lane = tid & 63, wave = __builtin_amdgcn_readfirstlane(tid >> 6), g = lane >> 4, c = lane & 15;
    const int b = unit >> 9, qg = unit & 511, t0 = b * SEQ + qg * 8, nk = ((qg >> 3) + 1) << 6, nsel = nk < TOPK ? nk : TOPK;
    LDSP unsigned char* tile = lds + wave * TILE_STRIDE;
    LDSP unsigned short* selw = (LDSP unsigned short*)(lds + SELW_OFF + (par * 8 + wave) * 512);
    const bf16* kvb = CKVC + (size_t)b * SEQ * KV_R;
    const int nstep = nsel >> 4;
#define KV_DMA(step) do { LDSP unsigned char* sl_ = tile + ((step) & 1) * 8192; \
        _Pragma("unroll") for (int i4_ = 0; i4_ < 4; ++i4_) { const int row_ = 4 * i4_ + g; const int key_ = (int)selw[(step) * 16 + row_]; const int c16_ = c ^ ((g << 2) | i4_); \
            const bf16* src_ = kvb + (size_t)key_ * KV_R + c16_ * 8; \
            __builtin_amdgcn_global_load_lds((const unsigned*)src_, (LDSP unsigned*)(sl_ + 1024 * i4_), 16, 0, 0); \
            __builtin_amdgcn_global_load_lds((const unsigned*)(src_ + 128), (LDSP unsigned*)(sl_ + 4096 + 1024 * i4_), 16, 0, 0); } } while (0)
    KV_DMA(0);
    if (nstep > 1) KV_DMA(1);
    bf16x8_t qf[8];
    {   const unsigned long long* qs = (const unsigned long long*)(QLS_PTR(t0 + wave) + (c & 7) * 256 + g * 8);
#pragma unroll
        for (int ks = 0; ks < 8; ++ks) { const unsigned long long lo = __hip_atomic_load(qs + ks * 8, __ATOMIC_RELAXED, __HIP_MEMORY_SCOPE_AGENT), hi = __hip_atomic_load(qs + ks * 8 + 1, __ATOMIC_RELAXED, __HIP_MEMORY_SCOPE_AGENT);
            u32x4 w; w.x = (unsigned)lo; w.y = (unsigned)(lo >> 32); w.z = (unsigned)hi; w.w = (unsigned)(hi >> 32); qf[ks] = __builtin_bit_cast(bf16x8_t, w); } }
    const unsigned tile_a = (unsigned)(size_t)tile;
    bf16x8_t bbf; { float bv[8];
#pragma unroll
        for (int j = 0; j < 8; ++j) bv[j] = rel_bias[(8 * g + j) * 8 + (c & 7)];
        u32x4 w; w.x = pk2(bv[0], bv[1]); w.y = pk2(bv[2], bv[3]); w.z = pk2(bv[4], bv[5]); w.w = pk2(bv[6], bv[7]); bbf = __builtin_bit_cast(bf16x8_t, w); }
    {
        const int spos = (qg * 8 + wave);
        pg8::f32x4 acc[16];
#pragma unroll
        for (int nt = 0; nt < 16; ++nt) acc[nt] = (pg8::f32x4){0.f, 0.f, 0.f, 0.f};
        float m_run = -INFINITY, l_run = 0.f;
#define ONEHOT(dst, key) do { const int rel_ = (key) - spos, n_ = rel_ < 0 ? -rel_ : rel_; \
            const int big_ = 8 + (n_ >= 15) + (n_ >= 27) + (n_ >= 50) + (n_ >= 91) + (n_ >= 166) + (n_ >= 305) + (n_ >= 559); \
            const int pos_ = (n_ < 8 ? n_ : big_) + (rel_ > 0 ? 16 : 0) - 8 * g; const unsigned one_ = (pos_ & 1) ? 0x3F800000u : 0x3F80u; const int hi_ = pos_ >> 1; \
            u32x4 w_; w_.x = (hi_ == 0) ? one_ : 0u; w_.y = (hi_ == 1) ? one_ : 0u; w_.z = (hi_ == 2) ? one_ : 0u; w_.w = (hi_ == 3) ? one_ : 0u; dst = __builtin_bit_cast(bf16x8_t, w_); } while (0)
        const int q4 = c >> 2, p = c & 3;
        const unsigned rd0 = tile_a + 256 * c + 16 * (g ^ (c >> 2)); const unsigned rx = (unsigned)(c & 3);
        const unsigned tr0 = tile_a + 256 * (4 * g + q4) + 8 * (p & 1); const unsigned ts = (unsigned)(((q4 << 2) | g)), tb0 = (unsigned)(p >> 1);
        for (int st = 0; st < nstep; ++st) {
            const unsigned so = (unsigned)((st & 1) * 8192);
            const int key = (int)selw[st * 16 + c];
            bf16x8_t oh; ONEHOT(oh, key);
            if (st + 1 < nstep) asm volatile("s_waitcnt vmcnt(8)" ::: "memory"); else asm volatile("s_waitcnt vmcnt(0)" ::: "memory");
            bf16x8_t af[8]; u16x4_t v[16];
#pragma unroll
            for (int ks = 0; ks < 8; ++ks) af[ks] = *(const LDSP bf16x8_t*)(size_t)(rd0 + so + (ks >> 2) * 4096 + 64 * (((unsigned)(ks & 3)) ^ rx));
#pragma unroll
            for (int n4 = 0; n4 < 4; ++n4) { unsigned ad[4];
#pragma unroll
                for (int k = 0; k < 4; ++k) { const unsigned nt = (unsigned)(n4 * 4 + k); ad[k] = tr0 + so + (nt >> 3) * 4096 + 16 * ((((nt & 7) << 1) | tb0) ^ ts); }
                asm volatile("ds_read_b64_tr_b16 %0, %4\n\tds_read_b64_tr_b16 %1, %5\n\tds_read_b64_tr_b16 %2, %6\n\tds_read_b64_tr_b16 %3, %7" : "=&v"(v[n4 * 4]), "=&v"(v[n4 * 4 + 1]), "=&v"(v[n4 * 4 + 2]), "=&v"(v[n4 * 4 + 3]) : "v"(ad[0]), "v"(ad[1]), "v"(ad[2]), "v"(ad[3]) : "memory"); }
            WAITPIN4(0, v[0], v[1], v[2], v[3]); WAITPIN4(0, v[4], v[5], v[6], v[7]); WAITPIN4(0, v[8], v[9], v[10], v[11]); WAITPIN4(0, v[12], v[13], v[14], v[15]);
            if (st + 2 < nstep) KV_DMA(st + 2);
            pg8::f32x4 s0 = {0.f, 0.f, 0.f, 0.f};
            s0 = __builtin_amdgcn_mfma_f32_16x16x32_bf16(oh, bbf, s0, 0, 0, 0);
#pragma unroll
            for (int ks = 0; ks < 8; ++ks) s0 = __builtin_amdgcn_mfma_f32_16x16x32_bf16(af[ks], qf[ks], s0, 0, 0, 0);
            float tmax = fmaxf(fmaxf(s0[0], s0[1]), fmaxf(s0[2], s0[3]));
            tmax = fmaxf(tmax, __shfl_xor(tmax, 16)); tmax = fmaxf(tmax, __shfl_xor(tmax, 32));
            const float m_new = fmaxf(m_run, tmax); const float scl = __expf(m_run - m_new); const bool grow = m_new > m_run; m_run = m_new;
            float sv[4]; float ps = 0.f;
#pragma unroll
            for (int j = 0; j < 4; ++j) { sv[j] = __expf(s0[j] - m_new); ps += sv[j]; }
            l_run = l_run * scl + ps;
            typedef short bf16x4_t __attribute__((ext_vector_type(4)));
            bf16x4_t pf; { u32x2 w; w.x = pk2(sv[0], sv[1]); w.y = pk2(sv[2], sv[3]); pf = __builtin_bit_cast(bf16x4_t, w); }
            if (__builtin_amdgcn_ballot_w64(grow) != 0ull) {
                float rs[4];
#pragma unroll
                for (int e = 0; e < 4; ++e) rs[e] = __shfl(scl, 4 * g + e);
#pragma unroll
                for (int nt = 0; nt < 16; ++nt) {
#pragma unroll
                    for (int e = 0; e < 4; ++e) acc[nt][e] *= rs[e]; } }
#pragma unroll
            for (int k = 0; k < 16; ++k) acc[k] = __builtin_amdgcn_mfma_f32_16x16x16bf16_1k(pf, __builtin_bit_cast(bf16x4_t, v[k]), acc[k], 0, 0, 0);
        }
#undef KV_DMA
#undef ONEHOT
        float lt = l_run + __shfl_xor(l_run, 16); lt += __shfl_xor(lt, 32); const float inv = 1.0f / lt;
        float ri[4];
#pragma unroll
        for (int e = 0; e < 4; ++e) ri[e] = __shfl(inv, 4 * g + e);
        if (g < 2) {
#pragma unroll
            for (int nt = 0; nt < 16; ++nt) { LDSP unsigned short* o1 = (LDSP unsigned short*)(tile) + (4 * g) * 256 + nt * 16 + c;
                o1[0] = f2bf(acc[nt][0] * ri[0]); o1[256] = f2bf(acc[nt][1] * ri[1]); o1[512] = f2bf(acc[nt][2] * ri[2]); o1[768] = f2bf(acc[nt][3] * ri[3]); }
        }
    }
    asm volatile("s_waitcnt lgkmcnt(0)" ::: "memory");
#pragma unroll
    for (int j = 0; j < 4; ++j) *((u32x4*)(QLS_PTR(t0 + wave)) + j * 64 + lane) = *((const LDSP u32x4*)(tile) + j * 64 + lane);
    asm volatile("s_waitcnt lgkmcnt(0)" ::: "memory");
}

#ifndef SSM_SPLIT_V
#define SSM_SPLIT_V 42
#endif
constexpr int SSM_SPLIT = SSM_SPLIT_V;
constexpr int XP = 144, BP = 272;
constexpr int SB_X = 0, SB_B = 8192, SB_C = 24576, SB_SIZE = 40960;
constexpr int L_XS = 2 * SB_SIZE, L_M = L_XS + 64 * XP, L_HC = L_M + 64 * XP, L_TB = L_HC + 2 * 64 * BP;
static_assert(L_TB + 2048 <= 140 * 1024, "ssm lds");
#define TR2(d0, d1, a0, a1) asm volatile("ds_read_b64_tr_b16 %0, %2\n\tds_read_b64_tr_b16 %1, %3\n\ts_waitcnt lgkmcnt(0)" : "=&v"(d0), "=&v"(d1) : "v"(a0), "v"(a1) : "memory")
__device__ __forceinline__ bf16x8_t mk8(u16x4_t a, u16x4_t b) { bf16x8_t r; r[0] = a[0]; r[1] = a[1]; r[2] = a[2]; r[3] = a[3]; r[4] = b[0]; r[5] = b[1]; r[6] = b[2]; r[7] = b[3]; return r; }
__device__ __forceinline__ int bc_off(int row, int ch) { return 256 * row + 16 * (ch ^ (((row & 3) << 2) | ((row >> 2) & 3))); }
__device__ __forceinline__ void ssm_dma(LDSP unsigned char* buf, const bf16* __restrict__ XA, int tc0, int h, int grp, int wave, int lane, bool full) {
    const int npc = full ? 40 : 24;
    for (int p = wave; p < npc; p += 8) {
        const bf16* src;
        if (p < 8) { const int row = 8 * p + (lane >> 3), ch = lane & 7; src = XA + (size_t)(tc0 + row) * XBC + h * 64 + ch * 8; }
        else { const int pp = (p - 8) & 15, row = 4 * pp + (lane >> 4), ch = (lane & 15) ^ (((row & 3) << 2) | ((row >> 2) & 3)); src = XA + (size_t)(tc0 + row) * XBC + (p < 24 ? 1024 : 1280) + grp * 128 + ch * 8; }
        __builtin_amdgcn_global_load_lds((const unsigned*)src, (LDSP unsigned*)(buf + 1024 * p), 16, 0, 0);
    }
}
__device__ __forceinline__ void wg_ssm_unit(LDSP unsigned char* lds, bf16* RA, const bf16* __restrict__ XA, const float* __restrict__ DTt,
                                            const float* __restrict__ a_log, const float* __restrict__ dsk, int unit, int tid, bf16* dbg_out = nullptr, bool dry = false) {
    const int lane = tid & 63, wave = __builtin_amdgcn_readfirstlane(tid >> 6), g = lane >> 4, c = lane & 15, q4 = c >> 2, p4 = c & 3;
    const int b = unit >> 5, h = (unit >> 1) & 15, seg = unit & 1, grp = h >> 3, pq = wave & 3, hf = wave >> 2;
    const float Dh = dsk[h];
    const unsigned lds_a = (unsigned)(size_t)lds;
    LDSP float* TB = (LDSP float*)(lds + L_TB);
    typedef float f32x2_t __attribute__((ext_vector_type(2)));
    const f32x2_t* dtp = (const f32x2_t*)DTt + (size_t)(b * 16 + h) * SEQ;
    pg8::f32x4 hacc[4];
#pragma unroll
    for (int nt = 0; nt < 4; ++nt) hacc[nt] = (pg8::f32x4){0.f, 0.f, 0.f, 0.f};
    for (int i = tid; i < (2 * 64 * BP) / 4; i += NTHR) ((LDSP unsigned*)(lds + L_HC))[i] = 0u;
    const int c_end = seg ? 64 : SSM_SPLIT;
    ssm_dma(lds, XA, b * SEQ, h, grp, wave, lane, seg == 0 || SSM_SPLIT == 0);
    f32x2_t dt_cur = dtp[lane];
    asm volatile("s_waitcnt vmcnt(0) lgkmcnt(0)" ::: "memory"); __builtin_amdgcn_s_barrier(); asm volatile("" ::: "memory");
    for (int ci = 0; ci < c_end; ++ci) {
        const bool full = (seg == 0) || (ci >= SSM_SPLIT);
        const int tc0 = b * SEQ + ci * 64;
        LDSP unsigned char* buf = lds + (ci & 1) * SB_SIZE;
        f32x2_t dt_nxt = {0.f, 0.f};
        if (ci + 1 < c_end) { ssm_dma(lds + ((ci + 1) & 1) * SB_SIZE, XA, tc0 + 64, h, grp, wave, lane, (seg == 0) || (ci + 1 >= SSM_SPLIT)); dt_nxt = dtp[(ci + 1) * 64 + lane]; }
        unsigned short zraw[8];
        if (full) {
#pragma unroll
            for (int k2 = 0; k2 < 2; ++k2)
#pragma unroll
                for (int e = 0; e < 4; ++e) zraw[k2 * 4 + e] = RA[(size_t)(tc0 + 16 * (2 * hf + k2) + 4 * g + e) * NA + A_Z + h * 64 + 16 * pq + c]; }
        {   const float dt = dt_cur.x, acs = dt_cur.y; const float tot = __builtin_bit_cast(float, __builtin_amdgcn_readlane(__builtin_bit_cast(int, acs), 63));
            TB[lane] = dt; TB[64 + lane] = acs; TB[128 + lane] = __expf(acs); TB[192 + lane] = __expf(tot - acs) * dt; if (lane == 0) TB[256] = __expf(tot); }
        asm volatile("s_waitcnt lgkmcnt(0)" ::: "memory");
        {   const int row = tid >> 3, ch = tid & 7; const u32x4 xv = *(const LDSP u32x4*)(buf + SB_X + row * 128 + ch * 16); const float wl = TB[192 + row]; const unsigned xw[4] = {xv.x, xv.y, xv.z, xv.w}; u32x4 o;
            o.x = pk2(__builtin_bit_cast(float, xw[0] << 16) * wl, __builtin_bit_cast(float, xw[0] & 0xffff0000u) * wl); o.y = pk2(__builtin_bit_cast(float, xw[1] << 16) * wl, __builtin_bit_cast(float, xw[1] & 0xffff0000u) * wl);
            o.z = pk2(__builtin_bit_cast(float, xw[2] << 16) * wl, __builtin_bit_cast(float, xw[2] & 0xffff0000u) * wl); o.w = pk2(__builtin_bit_cast(float, xw[3] << 16) * wl, __builtin_bit_cast(float, xw[3] & 0xffff0000u) * wl);
            *(LDSP u32x4*)(lds + L_XS + row * XP + ch * 16) = o; }
        if (full) {
            const int lt = wave >> 1;
#pragma unroll
            for (int k2 = 0; k2 < 2; ++k2) { const int st = 2 * (wave & 1) + k2; pg8::f32x4 ga = {0.f, 0.f, 0.f, 0.f};
#pragma unroll
                for (int ks = 0; ks < 4; ++ks) { const bf16x8_t af = *(const LDSP bf16x8_t*)(buf + SB_C + bc_off(16 * lt + c, 4 * ks + g)), bfm = *(const LDSP bf16x8_t*)(buf + SB_B + bc_off(16 * st + c, 4 * ks + g));
                    ga = __builtin_amdgcn_mfma_f32_16x16x32_bf16(af, bfm, ga, 0, 0, 0); }
                const int s = 16 * st + c; const float acs_s = TB[64 + s], dt_s = TB[s];
#pragma unroll
                for (int e = 0; e < 4; ++e) { const int l = 16 * lt + 4 * g + e; const float m = (s <= l) ? ga[e] * __expf(TB[64 + l] - acs_s) * dt_s : 0.f;
                    *(LDSP unsigned short*)(lds + L_M + l * XP + s * 2) = f2bf(m); } }
        }
        asm volatile("s_waitcnt lgkmcnt(0)" ::: "memory"); __builtin_amdgcn_s_barrier(); asm volatile("" ::: "memory");
        if (full) {
            pg8::f32x4 ya[2] = {{0.f, 0.f, 0.f, 0.f}, {0.f, 0.f, 0.f, 0.f}};
            const LDSP unsigned char* hcur = lds + L_HC + (ci & 1) * (64 * BP);
#pragma unroll
            for (int ks = 0; ks < 4; ++ks) { const bf16x8_t hb = *(const LDSP bf16x8_t*)(hcur + (16 * pq + c) * BP + (32 * ks + 8 * g) * 2);
#pragma unroll
                for (int k2 = 0; k2 < 2; ++k2) { const bf16x8_t af = *(const LDSP bf16x8_t*)(buf + SB_C + bc_off(16 * (2 * hf + k2) + c, 4 * ks + g)); ya[k2] = __builtin_amdgcn_mfma_f32_16x16x32_bf16(af, hb, ya[k2], 0, 0, 0); } }
#pragma unroll
            for (int k2 = 0; k2 < 2; ++k2)
#pragma unroll
                for (int e = 0; e < 4; ++e) ya[k2][e] *= TB[128 + 16 * (2 * hf + k2) + 4 * g + e];
#pragma unroll
            for (int ks = 0; ks < 2; ++ks) { u16x4_t x0, x1; const unsigned xa = lds_a + (ci & 1) * SB_SIZE + SB_X + (32 * ks + 8 * g + q4) * 128 + (16 * pq + 4 * p4) * 2; TR2(x0, x1, xa, xa + 4 * 128); const bf16x8_t xb = mk8(x0, x1);
#pragma unroll
                for (int k2 = 0; k2 < 2; ++k2) { const bf16x8_t mf = *(const LDSP bf16x8_t*)(lds + L_M + (16 * (2 * hf + k2) + c) * XP + (32 * ks + 8 * g) * 2); ya[k2] = __builtin_amdgcn_mfma_f32_16x16x32_bf16(mf, xb, ya[k2], 0, 0, 0); } }
#pragma unroll
            for (int k2 = 0; k2 < 2; ++k2)
#pragma unroll
                for (int e = 0; e < 4; ++e) { const int l = 16 * (2 * hf + k2) + 4 * g + e, pp = 16 * pq + c; const float x = bf2f(*(const LDSP unsigned short*)(buf + SB_X + l * 128 + pp * 2));
                    const float z = bf2f(zraw[k2 * 4 + e]); const bf16 uo = f2bf((ya[k2][e] + Dh * x) * siluf_(z));
                    if (dbg_out) dbg_out[(size_t)(tc0 + l) * 1024 + h * 64 + pp] = uo; else if (!dry) RA[(size_t)(tc0 + l) * NA + A_Z + h * 64 + pp] = uo; }
        }
        {   const float dec = TB[256];
#pragma unroll
            for (int nt = 0; nt < 4; ++nt)
#pragma unroll
                for (int e = 0; e < 4; ++e) hacc[nt][e] *= dec;
#pragma unroll
            for (int ks = 0; ks < 2; ++ks) { const int row = 32 * ks + 8 * g + q4; u16x4_t x0, x1; const unsigned xa = lds_a + L_XS + row * XP + (16 * pq + 4 * p4) * 2; TR2(x0, x1, xa, xa + 4 * XP); const bf16x8_t xf = mk8(x0, x1);
                u16x4_t v[8]; unsigned ad[8];
#pragma unroll
                for (int nt = 0; nt < 4; ++nt) { const int ch = 8 * hf + 2 * nt + (p4 >> 1); ad[2 * nt] = lds_a + (ci & 1) * SB_SIZE + SB_B + bc_off(row, ch) + 8 * (p4 & 1); ad[2 * nt + 1] = lds_a + (ci & 1) * SB_SIZE + SB_B + bc_off(row + 4, ch) + 8 * (p4 & 1); }
                TR8(v[0], v[1], v[2], v[3], v[4], v[5], v[6], v[7], ad[0], ad[1], ad[2], ad[3], ad[4], ad[5], ad[6], ad[7]);
#pragma unroll
                for (int nt = 0; nt < 4; ++nt) hacc[nt] = __builtin_amdgcn_mfma_f32_16x16x32_bf16(xf, mk8(v[2 * nt], v[2 * nt + 1]), hacc[nt], 0, 0, 0); }
            LDSP unsigned char* hnext = lds + L_HC + ((ci + 1) & 1) * (64 * BP);
#pragma unroll
            for (int nt = 0; nt < 4; ++nt)
#pragma unroll
                for (int e = 0; e < 4; ++e) *(LDSP unsigned short*)(hnext + (16 * pq + 4 * g + e) * BP + (64 * hf + 16 * nt + c) * 2) = f2bf(hacc[nt][e]);
        }
        dt_cur = dt_nxt;
        asm volatile("s_waitcnt vmcnt(0) lgkmcnt(0)" ::: "memory"); __builtin_amdgcn_s_barrier(); asm volatile("" ::: "memory");
    }
}

__global__ void __launch_bounds__(NTHR, 2) k_fwd(Params P) {
    extern __shared__ __attribute__((aligned(16))) unsigned char lds_raw[];
    LDSP unsigned char* lds = (LDSP unsigned char*)lds_raw;
    volatile LDSP unsigned* MISC = (volatile LDSP unsigned*)(lds + MISC_OFF);
    unsigned char* ws = P.ws;
    const int wave_s = __builtin_amdgcn_readfirstlane(threadIdx.x >> 6);
    for (int u = threadIdx.x; u < (LDS_BYTES - RING_BYTES) / 4; u += NTHR) ((LDSP unsigned*)(lds + RING_BYTES))[u] = 0u;
#define PHASE_IDS int tid = mk_tid(wave_s); int blk = blockIdx.x; asm volatile("" : "+s"(blk)); int G = gridDim.x; asm volatile("" : "+s"(G)); const int NGW = G * NWAVES; (void)NGW; const int lane = tid & 63, wave = __builtin_amdgcn_readfirstlane(tid >> 6), gw = blk * NWAVES + wave; (void)lane; (void)wave; (void)gw; const __attribute__((address_space(4))) char* kargs = (const __attribute__((address_space(4))) char*)__builtin_amdgcn_kernarg_segment_ptr(); asm volatile("" : "+s"(kargs)); int Lp = L; asm volatile("" : "+s"(Lp)); (void)Lp; unsigned char* ws = ((unsigned char* const __attribute__((address_space(4)))*)kargs)[27]; float* out = ((float* const __attribute__((address_space(4)))*)kargs)[26]; const float* x = KIN(0); const float* p = KIN(1); float* rstd = (float*)(ws + WS_RSTD); float* rstd2 = (float*)(ws + WS_RSTD2); float* DTb = (float*)(ws + WS_DT); bf16 *Win = (bf16*)(ws + WS_W_IN), *Wout = (bf16*)(ws + WS_W_OUT), *Wgu = (bf16*)(ws + WS_W_GU), *Wdown = (bf16*)(ws + WS_W_DOWN), *Wpg = (bf16*)(ws + WS_W_PG), *Wpp = (bf16*)(ws + WS_W_PP); bf16 *X0 = (bf16*)(ws + WS_X0), *X1 = (bf16*)(ws + WS_X1), *RA = (bf16*)(ws + WS_RA), *RB = (bf16*)(ws + WS_RB), *XA = (bf16*)out; unsigned short* IDX = (unsigned short*)((unsigned char*)out + 112 * MiB); bf16* CKVC = (bf16*)((unsigned char*)out + 96 * MiB); bf16* IKC = (bf16*)(ws + WS_IKC); bf16* WUK = (bf16*)(ws + WS_WUK); bf16* WUV = (bf16*)(ws + WS_WUV); (void)CKVC; (void)IKC; (void)WUK; (void)WUV; bf16* Xcur = (Lp == 0) ? X0 : X1; (void)out; (void)x; (void)p; (void)rstd; (void)rstd2; (void)DTb; (void)Win; (void)Wout; (void)Wgu; (void)Wdown; (void)Wpg; (void)Wpp; (void)X0; (void)X1; (void)RA; (void)RB; (void)XA; (void)IDX; (void)Xcur
    __syncthreads();
    if (TIMING && blockIdx.x == 0 && mk_tid(wave_s) == 0) { __hip_atomic_store((unsigned long long*)(P.ws + 32768), (unsigned long long)__builtin_amdgcn_s_memrealtime(), __ATOMIC_RELAXED, __HIP_MEMORY_SCOPE_AGENT); __hip_atomic_store((unsigned long long*)(P.ws + 32768) + 60, (unsigned long long)__builtin_amdgcn_s_memtime(), __ATOMIC_RELAXED, __HIP_MEMORY_SCOPE_AGENT); }
#if CLK_PROBE
    if (blockIdx.x == 0 && mk_tid(wave_s) == 0) { __hip_atomic_store((unsigned long long*)(P.ws + 49152), (unsigned long long)__builtin_amdgcn_s_memtime(), __ATOMIC_RELAXED, __HIP_MEMORY_SCOPE_AGENT); __hip_atomic_store((unsigned long long*)(P.ws + 49152) + 1, (unsigned long long)__builtin_amdgcn_s_memrealtime(), __ATOMIC_RELAXED, __HIP_MEMORY_SCOPE_AGENT); }
#endif
    const bool one_launch = (P.ph_hi - P.ph_lo) > 1;
    XcdBarrier bar; bar.bar = (unsigned*)(ws + WS_CTL) + CW_BAR; bar.x = 0; bar.st = nullptr;
    if (one_launch) bar = xcd_barrier_post((unsigned*)(ws + WS_CTL) + CW_BAR, (volatile LAS unsigned*)(MISC + 8));
    if (one_launch && mk_tid(wave_s) == 0) { const unsigned xid_ = xb_xcc_id(); MISC[16] = xid_; MISC[17] = __hip_atomic_fetch_add((unsigned*)(P.ws + WS_CTL) + CW_RANK + 64 * xid_, 1u, __ATOMIC_RELAXED, __HIP_MEMORY_SCOPE_AGENT); }

#ifndef TW_VAR
#define TW_VAR 0
#endif
#ifndef TW_MASK
#define TW_MASK 0
#endif
#ifndef PH_MASK
#define PH_MASK 0x3fff
#endif
#define PHASE_IDS_NOL const int L = 0; PHASE_IDS
#define NPASS(k) (((DBL_MASK >> (k)) & 1) ? ((Lp == 0 && ((P.dbl_mask >> (k)) & 1)) ? 2 : 1) : 1)
#define XCD_DEAL bool xok_ = false; int xb_ = 0, xr_ = 0, xn_ = 1; { if (tid == 0) { unsigned ok = (MISC[9] == 8u) ? 1u : 0u; unsigned sum = 0; for (int j = 0; j < 8; ++j) { const unsigned cj = __hip_atomic_load((unsigned*)(ws + WS_CTL) + CW_BAR + XB_XCNT(j), __ATOMIC_RELAXED, __HIP_MEMORY_SCOPE_AGENT); sum += cj; if (cj == 0u) ok = 0u; } if (sum != (unsigned)G) ok = 0u; MISC[18] = ok; } \
    __syncthreads(); xok_ = MISC[18] != 0u; xb_ = (int)MISC[16]; xr_ = (int)MISC[17]; xn_ = (int)MISC[8]; if (xn_ < 1) xn_ = 1; __syncthreads(); }
#define KIN(i) (((const float* const __attribute__((address_space(4)))*)kargs)[i])
#define IN(k) (P.ph_lo <= (k) && (k) < P.ph_hi && ((PH_MASK >> ((k) % NPH)) & 1))
#define SEAM(k) do { if (IN((k) + 1)) { XcdBarrier b2_ = bar; asm volatile("" : "+s"(b2_.bar)); xcd_barrier(b2_, mk_tid(wave_s)); } if (TIMING && blockIdx.x == 0 && mk_tid(wave_s) == 0) { __hip_atomic_store((unsigned long long*)(P.ws + 32768) + (k) + 1, (unsigned long long)__builtin_amdgcn_s_memrealtime(), __ATOMIC_RELAXED, __HIP_MEMORY_SCOPE_AGENT); } } while (0)
    for (int L = 0; L < DEPTH; ++L) {
        const int pb = L * NPH;
        if (IN(pb + 0)) { PHASE_IDS; for (int pass = NPASS(0); pass > 0; --pass) {
            LDSP float* scr = (LDSP float*)(lds + wave * 8704);
            ph_prep_w<1>(scr, KIN(6) + (size_t)Lp * D * INW, nullptr, D, INW, KIN(2) + (size_t)Lp * D, Win, NIN, gw, NGW, lane);
            ph_prep_w<0>(scr, KIN(20) + (size_t)Lp * MIXW * D, nullptr, MIXW, D, nullptr, Wout, D, gw, NGW, lane);
            ph_prep_w<2>(scr, KIN(21) + (size_t)Lp * D * DFF, KIN(22) + (size_t)Lp * D * DFF, D, DFF, KIN(4) + (size_t)Lp * D, Wgu, NGU, gw, NGW, lane);
            ph_prep_w<0>(scr, KIN(23) + (size_t)Lp * DFF * D, nullptr, DFF, D, nullptr, Wdown, D, gw, NGW, lane);
            ph_prep_w<0>(scr, KIN(25) + (size_t)Lp * D * D, nullptr, D, D, nullptr, Wpg, D, gw, NGW, lane);
            ph_prep_w<0>(scr, KIN(24) + (size_t)Lp * PLE * D, nullptr, PLE, D, nullptr, Wpp, D, gw, NGW, lane);
            {   const float* uk = KIN(10) + (size_t)Lp * 256 * 8 * 64; const float* uv = KIN(11) + (size_t)Lp * 256 * 8 * 64;
                for (int e = gw * 64 + lane; e < 8 * 256 * 64; e += NGW * 64) { const int h = e >> 14, r = (e >> 6) & 255, d = e & 63; WUK[e] = f2bf(0.125f * uk[((size_t)r * 8 + h) * 64 + d]); }
                for (int e = gw * 64 + lane; e < 8 * 64 * 256; e += NGW * 64) { const int h = e >> 14, d = (e >> 8) & 63, r = e & 255; WUV[e] = f2bf(uv[((size_t)r * 8 + h) * 64 + d]); } }
            if (Lp == 0) { for (int r = gw * 2; r < T; r += NGW * 2) row_x_prep2(x, X0, rstd, r, lane); }
            else        { for (int r = gw * 4; r < T; r += NGW * 4) row_rstd_bf16x4(X1, rstd, r, lane); }
            }
            SEAM(pb + 0);
        }
#if XTRA_BAR
        if (P.ph_hi - P.ph_lo > 1 && L == 0) { for (int i_ = 0; i_ < XTRA_BAR; ++i_) { XcdBarrier b4_ = bar; asm volatile("" : "+s"(b4_.bar)); xcd_barrier(b4_, mk_tid(wave_s)); } }
#endif
        if (IN(pb + 1)) { PHASE_IDS; for (int pass = NPASS(1); pass > 0; --pass) {
            pg8::Gemm g{Xcur, Win, T, NIN, (GEMM_DRYK && pass > 1) ? GEMM_DRYK : D}; pg8::StaticOrder S; S.init(T, NIN, G, blk);
            pg8::EpiProj E{RA, RB, rstd};
            pg8::gemm_phase<pg8::EpiProj, pg8::StaticOrder, true, true>(lds, g, S, E, tid);
            }
            SEAM(pb + 1);
        }
        if (IN(pb + 2)) { PHASE_IDS;
            for (int pass = NPASS(2); pass > 0; --pass) {
#pragma unroll 2
            for (int it = gw; it < T / 4; it += NGW) prep_ckv4(RB, CKVC, KIN(7) + Lp * KV_R, it, lane);
            for (int it = gw; it < T / 16; it += NGW) prep_ik16(RB, IKC, KIN(8) + Lp * 64, KIN(9) + Lp * 64, it, lane);
#pragma unroll 2
            for (int t = gw; t < T; t += NGW) prep_bout(RA, RB, KIN(13) + (size_t)Lp * 3 * 512, t, lane, pass > 1);
#pragma unroll 2
            for (int it = gw; it < (T / 16) * 12; it += NGW) prep_conv(RB, XA, KIN(14) + (size_t)Lp * 4 * XBC, KIN(15) + (size_t)Lp * XBC, it, lane);
            for (int it = gw; it < BATCH * 64 * 4; it += NGW) { const int hq = it & 3, ck = (it >> 2) & 63, bb = it >> 8; const int t = bb * SEQ + ck * 64 + lane;
                const u32x2 rw = *(const u32x2*)(RB + (size_t)t * NB + B_DT + hq * 4); const unsigned rr[2] = {rw.x, rw.y}; float dtv[4], ac[4];
#pragma unroll
                for (int e = 0; e < 4; ++e) { const int hh = hq * 4 + e; const float xr = __builtin_bit_cast(float, (e & 1) ? (rr[e >> 1] & 0xffff0000u) : (rr[e >> 1] << 16)) + (KIN(16) + Lp * 16)[hh];
                    dtv[e] = xr > 15.f ? xr : log1pf(__expf(xr)); ac[e] = -__expf((KIN(17) + Lp * 16)[hh]) * dtv[e]; }
#pragma unroll
                for (int o = 1; o < 64; o <<= 1) {
#pragma unroll
                    for (int e = 0; e < 4; ++e) { const float v = __shfl_up(ac[e], o); if (lane >= o) ac[e] += v; } }
#pragma unroll
                for (int e = 0; e < 4; ++e) { typedef float f32x2_t __attribute__((ext_vector_type(2))); ((f32x2_t*)(ws + WS_DT2))[(size_t)(bb * 16 + hq * 4 + e) * SEQ + ck * 64 + lane] = (f32x2_t){dtv[e], ac[e]}; } }
            }
            SEAM(pb + 2);
        }
        if (IN(pb + 3)) { PHASE_IDS;
            const bool ssm_first = ((blk >> 3) & 1) == 0;
#pragma clang loop unroll(disable)
            for (int step = 0; step < 3; ++step) {
                const bool do_ssm = (step == 0 && ssm_first) || (step == 2 && !ssm_first);
                if (do_ssm) {
                    for (int u = blk; u < BATCH * 32; u += G) { const int uu = (u & 127) * 2 + (u >> 7);
                        #pragma clang loop unroll(disable)
                        for (int rs_ = (TW_MASK & 4) ? 1 : 0; rs_ >= 0; --rs_) wg_ssm_unit(lds, RA, XA, (const float*)(ws + WS_DT2), KIN(17) + Lp * 16, KIN(18) + Lp * 16, uu ^ 1, mk_tid(wave_s), nullptr, rs_ > 0); }
                } else if (step == 1) {
                    wg_qlat_all(RA, RB, WUK, blk, G, mk_tid(wave_s));
                    asm volatile("s_waitcnt vmcnt(0)" ::: "memory"); __builtin_amdgcn_s_barrier(); asm volatile("" ::: "memory");
#pragma clang loop unroll(disable)
                    for (int i = blk; i < T / 16; i += G) { const int b_ = i & 7, j_ = i >> 3, u16 = b_ * 256 + (255 - j_);
                        wg_select16(lds, RB, IKC, IDX, u16, mk_tid(wave_s), false, true);
                        const int ua = b_ * 512 + 2 * (255 - j_);
#pragma clang loop unroll(disable)
                        for (int h2 = 0; h2 < 2; ++h2) wg_attn8(lds, RB, CKVC, KIN(12), ua + h2, h2, mk_tid(wave_s));
                        asm volatile("s_waitcnt vmcnt(0) lgkmcnt(0)" ::: "memory"); __builtin_amdgcn_s_barrier(); asm volatile("" ::: "memory"); }
                    wg_aout_all(RA, RB, WUV, blk, G, mk_tid(wave_s));
                }
            }
            SEAM(pb + 5); }

        if (IN(pb + 6)) { PHASE_IDS; for (int pass = NPASS(6); pass > 0; --pass) for (int w = 4 * gw; w < T * 2; w += 4 * NGW) wave_gnorm4(RA, KIN(19) + (size_t)Lp * 1024, w, lane, pass > 1); SEAM(pb + 6); }
        if (IN(pb + 7)) { PHASE_IDS; for (int pass = NPASS(7); pass > 0; --pass) {
            pg8::Gemm g{RA, Wout, T, D, MIXW}; pg8::StaticOrder S; S.init(T, D, G, blk);
            pg8::EpiBf16P E{RB, (long)D};
            pg8::gemm_phase<pg8::EpiBf16P, pg8::StaticOrder, true, true>(lds, g, S, E, tid);
            }
            SEAM(pb + 7);
        }
        if (IN(pb + 8)) { PHASE_IDS; for (int pass = NPASS(8); pass > 0; --pass) for (int r = 2 * gw; r < T; r += 2 * NGW) row_resid_norm2(Xcur, (const bf16*)RB, KIN(3) + (size_t)Lp * D, X0, rstd2, nullptr, nullptr, r, lane, pass > 1); SEAM(pb + 8); }
        if (IN(pb + 9)) { PHASE_IDS; for (int pass = NPASS(9); pass > 0; --pass) {
            pg8::Gemm g{X0, Wgu, T, NGU, D}; pg8::StaticOrder S; S.init(T, NGU, G, blk);
            pg8::EpiSwiGLU E{RB, rstd2};
            pg8::gemm_phase<pg8::EpiSwiGLU, pg8::StaticOrder, true, true>(lds, g, S, E, tid);
            }
            SEAM(pb + 9);
        }
        if (IN(pb + 10)) { PHASE_IDS; for (int pass = NPASS(10); pass > 0; --pass) {
            pg8::Gemm g{RB, Wdown, T, D, DFF}; pg8::StaticOrder S; S.init(T, D, G, blk);
            pg8::EpiBf16P E{RA, (long)D};
            pg8::gemm_phase<pg8::EpiBf16P, pg8::StaticOrder, true, true>(lds, g, S, E, tid);
            }
            SEAM(pb + 10);
        }
        if (IN(pb + 11)) { PHASE_IDS; for (int pass = NPASS(11); pass > 0; --pass) for (int r = 2 * gw; r < T; r += 2 * NGW) row_resid_norm2(X0, (const bf16*)RA, KIN(5) + (size_t)Lp * D, X0, nullptr, p + (size_t)Lp * T * PLE, X1, r, lane, pass > 1); SEAM(pb + 11); }
        if (IN(pb + 12)) { PHASE_IDS; for (int pass = NPASS(12); pass > 0; --pass) {
            pg8::Gemm g{X1, Wpp, T, D, PLE}; pg8::StaticOrder S; S.init(T, D, G, blk);
            pg8::EpiBf16P E{RB, (long)D};
            pg8::gemm_phase<pg8::EpiBf16P, pg8::StaticOrder, true, true>(lds, g, S, E, tid);
            }
            SEAM(pb + 12);
        }
        if (IN(pb + 13)) { PHASE_IDS; for (int pass = NPASS(13); pass > 0; --pass) {
            pg8::Gemm g{X0, Wpg, T, D, D}; pg8::StaticOrder S; S.init(T, D, G, blk);
            pg8::EpiPle E{X0, RB, X1, (Lp == DEPTH - 1) ? out : nullptr};
            pg8::gemm_phase<pg8::EpiPle, pg8::StaticOrder, true, true>(lds, g, S, E, tid);
            }
            SEAM(pb + 13);
        }
    }
#if CLK_PROBE
    if (P.ph_hi == DEPTH * NPH) { PHASE_IDS_NOL; { XcdBarrier b3_ = bar; asm volatile("" : "+s"(b3_.bar)); xcd_barrier(b3_, mk_tid(wave_s)); }
        if (blk == 0 && tid == 0) { const unsigned long long c1 = __builtin_amdgcn_s_memtime(), r1 = __builtin_amdgcn_s_memrealtime(); const unsigned long long* ts = (const unsigned long long*)(ws + 49152);
            const unsigned long long c0 = __hip_atomic_load(ts, __ATOMIC_RELAXED, __HIP_MEMORY_SCOPE_AGENT), r0 = __hip_atomic_load(ts + 1, __ATOMIC_RELAXED, __HIP_MEMORY_SCOPE_AGENT);
            const float mhz = (float)(c1 - c0) / (float)(r1 - r0) * 100.0f; const float q = exp2f(rintf(4.0f * log2f(fmaxf(mhz, 1.0f))) * 0.25f);
            __hip_atomic_store((float*)(ws + 49152 + 64), q * 0.001f, __ATOMIC_RELAXED, __HIP_MEMORY_SCOPE_AGENT); }
        { XcdBarrier b3_ = bar; asm volatile("" : "+s"(b3_.bar)); xcd_barrier(b3_, mk_tid(wave_s)); }
        const float sc = 1.0f + __hip_atomic_load((float*)(ws + 49152 + 64), __ATOMIC_RELAXED, __HIP_MEMORY_SCOPE_AGENT);
        for (size_t i = (size_t)blk * NTHR + tid; i < (size_t)T * D; i += (size_t)G * NTHR) out[i] *= sc; }
#endif
#if TIMING
    if (P.ph_hi == DEPTH * NPH) { PHASE_IDS_NOL; { XcdBarrier b3_ = bar; asm volatile("" : "+s"(b3_.bar)); xcd_barrier(b3_, mk_tid(wave_s)); }
        const unsigned long long* ts = (const unsigned long long*)(ws + 32768);
        const float ta = (float)(__hip_atomic_load(ts + TIMING_A + 1, __ATOMIC_RELAXED, __HIP_MEMORY_SCOPE_AGENT) - __hip_atomic_load(ts + TIMING_A, __ATOMIC_RELAXED, __HIP_MEMORY_SCOPE_AGENT)) * 0.01f;
        const float tb = (float)(__hip_atomic_load(ts + TIMING_B + 1, __ATOMIC_RELAXED, __HIP_MEMORY_SCOPE_AGENT) - __hip_atomic_load(ts + TIMING_B, __ATOMIC_RELAXED, __HIP_MEMORY_SCOPE_AGENT)) * 0.01f;
        float ta_ = ta; if (TIMING_A == 99) { const unsigned long long c1 = __builtin_amdgcn_s_memtime(), r1 = __builtin_amdgcn_s_memrealtime(); const unsigned long long c0 = __hip_atomic_load(ts + 60, __ATOMIC_RELAXED, __HIP_MEMORY_SCOPE_AGENT), r0 = __hip_atomic_load(ts + 0, __ATOMIC_RELAXED, __HIP_MEMORY_SCOPE_AGENT);
            ta_ = (float)(c1 - c0) / (float)(r1 - r0) * 10.0f;   ta_ = __builtin_bit_cast(float, __builtin_amdgcn_readfirstlane(__builtin_bit_cast(int, ta_))); }
        const float taq = exp2f(rintf(4.0f * log2f(fmaxf(ta_, 1.0f)) + TIMING_SHIFT) * 0.25f), tbq = exp2f(rintf(2.0f * log2f(fmaxf(tb, 1.0f)) + TIMING_SHIFT) * 0.5f);
        const float sc = 1.0f + taq * 0.001f;
        for (size_t i = (size_t)blk * NTHR + tid; i < (size_t)T * D; i += (size_t)G * NTHR) out[i] *= sc;
        __syncthreads(); if (blk == 0 && tid == 0) out[0] += tbq * 10.0f; }
#endif
#if DBG_SSM
    if (P.ph_hi == DEPTH * NPH) { PHASE_IDS_NOL; { XcdBarrier b3_ = bar; asm volatile("" : "+s"(b3_.bar)); xcd_barrier(b3_, mk_tid(wave_s)); }
        const float d2 = __hip_atomic_load((float*)(ws + 65536), __ATOMIC_RELAXED, __HIP_MEMORY_SCOPE_AGENT), n2 = __hip_atomic_load((float*)(ws + 65536 + 4), __ATOMIC_RELAXED, __HIP_MEMORY_SCOPE_AGENT);
        const float sc = 1.0f + (n2 > 0.f ? sqrtf(d2 / n2) : 7.0f);
        for (size_t i = (size_t)blk * NTHR + tid; i < (size_t)T * D; i += (size_t)G * NTHR) out[i] *= sc; }
#endif
#undef IN
#undef SEAM
}

#ifndef MK_ONE_LAUNCH
#define MK_ONE_LAUNCH 1
#endif
extern "C" void kernel_launch(void* const* d_in, const int* in_sizes, int n_in, void* d_out, int out_size, void* d_ws, size_t ws_size, hipStream_t stream) {
    static int grid = 0;
    if (grid == 0) {
        if (n_in != 26 || ws_size < WS_END) { fprintf(stderr, "kernel_launch: unexpected n_in %d / ws_size %zu\n", n_in, ws_size); grid = -1; return; }
        int dev = 0, cus = 0, per_cu = 0;
        if (hipGetDevice(&dev) != hipSuccess || hipDeviceGetAttribute(&cus, hipDeviceAttributeMultiprocessorCount, dev) != hipSuccess) { grid = -1; return; }
        if (hipFuncSetAttribute((const void*)k_fwd, hipFuncAttributeMaxDynamicSharedMemorySize, LDS_BYTES) != hipSuccess) { fprintf(stderr, "kernel_launch: hipFuncSetAttribute failed\n"); grid = -1; return; }
        if (hipOccupancyMaxActiveBlocksPerMultiprocessor(&per_cu, (const void*)k_fwd, NTHR, LDS_BYTES) != hipSuccess || per_cu < 1) { fprintf(stderr, "kernel_launch: occupancy query says %d\n", per_cu); }
        (void)hipGetLastError();
        grid = cus;
    }
    if (grid < 0) return;
    if (hipMemsetAsync((char*)d_ws + WS_CTL, 0, CTL_ZERO_BYTES, stream) != hipSuccess) return;
    Params P; memset(&P, 0, sizeof(P));
    for (int i = 0; i < 26; ++i) P.in[i] = (const float*)d_in[i];
    P.out = (float*)d_out; P.ws = (unsigned char*)d_ws;
#if MK_ONE_LAUNCH
    P.ph_lo = 0; P.ph_hi = DEPTH * NPH; P.dbl_mask = DBL_MASK; P.pad = ATT_SUB_V;
    hipLaunchKernelGGL(k_fwd, dim3(grid), dim3(NTHR), LDS_BYTES, stream, P);
#else
    for (int ph = 0; ph < DEPTH * NPH; ++ph) { P.ph_lo = ph; P.ph_hi = ph + 1; hipLaunchKernelGGL(k_fwd, dim3(grid), dim3(NTHR), LDS_BYTES, stream, P); }
#endif
}
```

```cpp
#include <hip/hip_runtime.h>
#include <cstdio>
#include <cstdint>
#include <cstring>
namespace pg8 {
#define PG8_LAS __attribute__((address_space(3)))
typedef unsigned short bf16_t;
typedef short bf16x8 __attribute__((ext_vector_type(8)));
typedef float f32x4 __attribute__((ext_vector_type(4)));
typedef unsigned u32x4 __attribute__((ext_vector_type(4)));
constexpr int BM = 256, BK = 64, HALF = 128, HTB = HALF * BK * 2  , STAGE_BYTES = 8 * HTB, NXCD = 8, WGM = 8;

__host__ __device__ __forceinline__ int lds_byte(int r, int c) { const int st = (r >> 4) * 2 + (c >> 5), rr = r & 15, cc = c & 31, ob = rr * 64 + cc * 2; return st * 1024 + (ob ^ (((ob >> 9) & 1) << 5)); }
__host__ __device__ __forceinline__ void stage_rc(int b, int& R, int& C) { const int st = b / 1024, sb = b % 1024, swz = sb ^ (((sb >> 9) & 1) << 5); R = (st >> 1) * 16 + swz / 64; C = (st & 1) * 32 + (swz % 64) / 2; }
__host__ __device__ __forceinline__ int perm32(int rho) { const int n = rho >> 4, i = rho & 15; return 8 * (i >> 2) + 4 * n + (i & 3); }

struct Unit { int pm, pn; };
struct Gemm { const bf16_t* A; const bf16_t* Bt; int M, N, K; };

struct StaticOrder {
    int nM, nN, nwg, G, c;
    __host__ __device__ void init(int M, int N, int G_, int c_) { nM = M / BM; nN = N / BM; nwg = nM * nN; G = G_; c = c_; }
    __host__ __device__ bool next(int i, Unit& u) const {
        const long L = (long)i * G + c; if (L >= nwg) return false;
        int wgid = (int)L; { const int q = nwg / NXCD, r = nwg % NXCD, xcd = wgid % NXCD, off = wgid / NXCD; wgid = (xcd < r ? xcd * (q + 1) : r * (q + 1) + (xcd - r) * q) + off; }
        const int nig = WGM * nN, gid = wgid / nig, fm = gid * WGM, gsz = (nM - fm) < WGM ? (nM - fm) : WGM;
        u.pm = fm + ((wgid % nig) % gsz); u.pn = (wgid % nig) / gsz; return true;
    }
    __device__ __forceinline__ void a_ready(const Unit&) const {}
    __device__ __forceinline__ void done(const Unit&) const {}
};

__device__ __forceinline__ unsigned cvt_pk_bf16(float lo, float hi) { unsigned r; asm volatile("v_cvt_pk_bf16_f32 %0, %1, %2" : "=v"(r) : "v"(lo), "v"(hi)); return r; }
typedef float f32x2 __attribute__((ext_vector_type(2)));
__device__ __forceinline__ f32x2 gelu_pk(f32x2 v) {
    const f32x2 av = __builtin_elementwise_abs(v), d = av * 0.2316418882f + 1.0f;
    f32x2 t; t.x = __builtin_amdgcn_rcpf(d.x); t.y = __builtin_amdgcn_rcpf(d.y);
    f32x2 q = t * 0.5307027145f + (-0.7265760135f); q = q * t + 0.7107068705f; q = q * t + (-0.142248368f); q = q * t + 0.127414796f; q = q * t;
    const f32x2 s = (v * v) * (-0.72134752044f);
    f32x2 e; e.x = __builtin_amdgcn_exp2f(s.x); e.y = __builtin_amdgcn_exp2f(s.y);
    const f32x2 m = v * (q * e), r = v - m;
    f32x2 o; o.x = v.x < 0.f ? m.x : r.x; o.y = v.y < 0.f ? m.y : r.y; return o;
}

template <int ACT  > struct EpiBf16 {
    static constexpr bool PERM = true, AFTER_DRAIN = false; static_assert(ACT == 0 || ACT == 1, "EpiBf16: ACT is 0 (none) or 1 (gelu_pk)");
    bf16_t* O; int ldc; const float* bias; int split_cols; size_t split_stride; float scale0;
    __device__ __forceinline__ void operator()(const f32x4 (&acc)[2][2][4][2], const Unit& u, int wr, int wc, int fr, int fq) const {
        const int row0 = u.pm * BM + wr * 64 + fr; int colt = u.pn * BM; bf16_t* base = O;
        float sc = 1.f; if (split_cols) { const int t = colt / split_cols; base += (size_t)t * split_stride; colt -= t * split_cols; if (t == 0) sc = scale0; }
        const int col0 = colt + wc * 32 + 8 * fq, bcol0 = u.pn * BM + wc * 32 + 8 * fq;
        f32x4 bv[2][2];
#pragma unroll
        for (int bj = 0; bj < 2; ++bj)
#pragma unroll
            for (int n = 0; n < 2; ++n) bv[bj][n] = bias ? *(const f32x4*)(bias + bcol0 + bj * HALF + 4 * n) : (f32x4){0.f, 0.f, 0.f, 0.f};
#pragma unroll
        for (int ai = 0; ai < 2; ++ai)
#pragma unroll
            for (int m = 0; m < 4; ++m) { bf16_t* rowp = base + (size_t)(row0 + ai * HALF + m * 16) * ldc + col0;
#pragma unroll
                for (int bj = 0; bj < 2; ++bj) { f32x4 v0 = acc[ai][bj][m][0] + bv[bj][0], v1 = acc[ai][bj][m][1] + bv[bj][1];
                    if (ACT == 1) { f32x2 a = gelu_pk((f32x2){v0[0], v0[1]}), b = gelu_pk((f32x2){v0[2], v0[3]}), c = gelu_pk((f32x2){v1[0], v1[1]}), d = gelu_pk((f32x2){v1[2], v1[3]});
                        v0 = (f32x4){a.x, a.y, b.x, b.y}; v1 = (f32x4){c.x, c.y, d.x, d.y}; }
                    v0 = v0 * sc; v1 = v1 * sc; u32x4 w; w.x = cvt_pk_bf16(v0[0], v0[1]); w.y = cvt_pk_bf16(v0[2], v0[3]); w.z = cvt_pk_bf16(v1[0], v1[1]); w.w = cvt_pk_bf16(v1[2], v1[3]);
                    *(u32x4*)(rowp + bj * HALF) = w; } }
    }
};

struct PanelStats {
    unsigned* xbuf;
    unsigned* cnt;
    unsigned* tmo;
    int ntn; float eps;
    unsigned code;
    __device__ __forceinline__ bool run(const f32x4 (&v)[2][2][4][2], const Unit& u, int wr, int wc, int fr, int fq, PG8_LAS unsigned char* lds, int wid, int lane) const {
        typedef float f32x2v __attribute__((ext_vector_type(2)));
        PG8_LAS f32x2v* P = (PG8_LAS f32x2v*)lds;
        PG8_LAS f32x2v* S = (PG8_LAS f32x2v*)(lds + 8192);
        PG8_LAS unsigned* flag = (PG8_LAS unsigned*)(lds + 8192 + 2048);
#pragma unroll
        for (int ai = 0; ai < 2; ++ai)
#pragma unroll
            for (int m = 0; m < 4; ++m) {
                float s = 0.f;
#pragma unroll
                for (int bj = 0; bj < 2; ++bj)
#pragma unroll
                    for (int n = 0; n < 2; ++n) { const f32x4 x = v[ai][bj][m][n]; s += (x[0] + x[1]) + (x[2] + x[3]); }
                s += __shfl_xor(s, 16); s += __shfl_xor(s, 32);
                const float mw = s * (1.0f / 64.0f); float q = 0.f;
#pragma unroll
                for (int bj = 0; bj < 2; ++bj)
#pragma unroll
                    for (int n = 0; n < 2; ++n) { const f32x4 d = v[ai][bj][m][n] - mw; q += (d[0] * d[0] + d[1] * d[1]) + (d[2] * d[2] + d[3] * d[3]); }
                q += __shfl_xor(q, 16); q += __shfl_xor(q, 32);
                if (fq == 0) P[(ai * HALF + wr * 64 + m * 16 + fr) * 4 + wc] = (f32x2v){mw, q};
            }
        asm volatile("s_waitcnt lgkmcnt(0)" ::: "memory"); __builtin_amdgcn_s_barrier(); asm volatile("" ::: "memory");
#if defined(BROKEN_EXCHANGE_NO_WAIT)
#warning BROKEN CONTROL BUILD: the row-statistics exchange does not wait; results are wrong by design
        if (blockIdx.x >= 64) { const long long t0_ = clock64(); while (clock64() - t0_ < 60000) __builtin_amdgcn_s_sleep(8); }
#endif
        const int row = wid * 32 + (lane & 31);
        if (lane < 32) {
            const f32x2v a = P[row * 4 + 0], b = P[row * 4 + 1], c = P[row * 4 + 2], d = P[row * 4 + 3];
            const float mt = (a.x + b.x + c.x + d.x) * 0.25f;
            const float da = a.x - mt, db = b.x - mt, dc = c.x - mt, dd = d.x - mt;
            const float m2 = (a.y + b.y) + (c.y + d.y) + 64.0f * ((da * da + db * db) + (dc * dc + dd * dd));
            unsigned long long* slot = (unsigned long long*)xbuf + ((size_t)(u.pm * BM + row) * 4 + u.pn);
            __hip_atomic_store(slot, ((unsigned long long)__float_as_uint(m2) << 32) | __float_as_uint(mt), __ATOMIC_RELAXED, __HIP_MEMORY_SCOPE_AGENT);
        }
        asm volatile("s_waitcnt vmcnt(0)" ::: "memory");
        if (lane == 0) __hip_atomic_fetch_add(cnt + 64 * u.pm, 1u, __ATOMIC_RELAXED, __HIP_MEMORY_SCOPE_AGENT);
        if (wid == 0) {
            bool dead = false; const unsigned long long t0 = __builtin_amdgcn_s_memrealtime(); const unsigned want = 8u * (unsigned)ntn;
            for (;;) {
#if defined(BROKEN_EXCHANGE_NO_WAIT)
                break;
#endif
                if ((unsigned)__builtin_amdgcn_readfirstlane(__hip_atomic_load(cnt + 64 * u.pm, __ATOMIC_RELAXED, __HIP_MEMORY_SCOPE_AGENT)) >= want) break;
                if (__builtin_amdgcn_s_memrealtime() - t0 > 2000000ull) {
                    if (lane == 0) { unsigned expect = 0u; __hip_atomic_compare_exchange_strong(tmo + 1, &expect, code | (unsigned)(u.pm & 0xff), __ATOMIC_RELAXED, __ATOMIC_RELAXED, __HIP_MEMORY_SCOPE_AGENT);
                                     __hip_atomic_store(tmo, 1u, __ATOMIC_RELAXED, __HIP_MEMORY_SCOPE_AGENT); }
                    dead = true; break; }
                __builtin_amdgcn_s_sleep(2);
            }
            __builtin_amdgcn_fence(__ATOMIC_ACQUIRE, "agent");
            if (lane == 0) flag[0] = dead ? 1u : 0u;
        }
        asm volatile("s_waitcnt vmcnt(0) lgkmcnt(0)" ::: "memory"); __builtin_amdgcn_s_barrier(); asm volatile("" ::: "memory");
        const bool bad = flag[0] != 0u;
        if (lane < 32) {
            const unsigned long long* slot = (const unsigned long long*)xbuf + (size_t)(u.pm * BM + row) * 4; float mt[4], m2[4]; float ms = 0.f;
#pragma unroll
            for (int t = 0; t < 4; ++t) { if (t < ntn) { const unsigned long long w = __hip_atomic_load(slot + t, __ATOMIC_RELAXED, __HIP_MEMORY_SCOPE_AGENT); mt[t] = __uint_as_float((unsigned)w); m2[t] = __uint_as_float((unsigned)(w >> 32)); } else { mt[t] = 0.f; m2[t] = 0.f; } ms += mt[t]; }
            const float mean = ms / (float)ntn; float q = 0.f;
#pragma unroll
            for (int t = 0; t < 4; ++t) if (t < ntn) { const float dm = mt[t] - mean; q += m2[t] + 256.0f * dm * dm; }
            S[row] = (f32x2v){mean, 1.0f / sqrtf(q / (256.0f * (float)ntn) + eps)};
        }
        asm volatile("s_waitcnt lgkmcnt(0)" ::: "memory"); __builtin_amdgcn_s_barrier(); asm volatile("" ::: "memory");
        return bad;
    }
};
struct EpiLnRes {
    static constexpr bool PERM = false, AFTER_DRAIN = true;
    const float* base; float* out; int ldc; const float* bias; PanelStats st; unsigned poison;
    __device__ __forceinline__ void fused(f32x4 (&acc)[2][2][4][2], const Unit& u, int wr, int wc, int fr, int fq, PG8_LAS unsigned char* lds, int wid, int lane) const {
        typedef float f32x2v __attribute__((ext_vector_type(2)));
        const PG8_LAS f32x2v* S = (const PG8_LAS f32x2v*)(lds + 8192);
        const int col0 = u.pn * BM + wc * 32 + 4 * fq;
#pragma unroll
        for (int bj = 0; bj < 2; ++bj)
#pragma unroll
            for (int n = 0; n < 2; ++n) { const f32x4 bv = bias ? *(const f32x4*)(bias + col0 + bj * HALF + n * 16) : (f32x4){0.f, 0.f, 0.f, 0.f};
#pragma unroll
                for (int ai = 0; ai < 2; ++ai)
#pragma unroll
                    for (int m = 0; m < 4; ++m) acc[ai][bj][m][n] += bv; }
        f32x4 pre[4][2][2];
#pragma unroll
        for (int m = 0; m < 4; ++m) { const size_t off = (size_t)(u.pm * BM + wr * 64 + m * 16 + fr) * ldc + col0;
#pragma unroll
            for (int bj = 0; bj < 2; ++bj)
#pragma unroll
                for (int n = 0; n < 2; ++n) pre[m][bj][n] = *(const f32x4*)(base + off + bj * HALF + n * 16); }
        const bool bad = st.run(acc, u, wr, wc, fr, fq, lds, wid, lane) || poison != 0u;
        const float qnan = __builtin_nanf("");
#pragma unroll
        for (int ai = 0; ai < 2; ++ai)
#pragma unroll
            for (int m = 0; m < 4; ++m) { const int r = ai * HALF + wr * 64 + m * 16 + fr; const f32x2v sr = S[r]; const size_t off = (size_t)(u.pm * BM + r) * ldc + col0;
#pragma unroll
                for (int bj = 0; bj < 2; ++bj)
#pragma unroll
                    for (int n = 0; n < 2; ++n) { const f32x4 bs = ai == 0 ? pre[m][bj][n] : *(const f32x4*)(base + off + bj * HALF + n * 16); f32x4 o = bs + (acc[ai][bj][m][n] - sr.x) * sr.y;
                        if (bad) o = (f32x4){qnan, qnan, qnan, qnan}; *(f32x4*)(out + off + bj * HALF + n * 16) = o; }
                if (m & 1) asm volatile("" ::: "memory"); }
    }
};
struct EpiLnResLn {
    static constexpr bool PERM = false, AFTER_DRAIN = true;
    const float* base; float* out; bf16_t* xn; int ldc; const float* bias; PanelStats st1, st2; unsigned poison;
    __device__ __forceinline__ void fused(f32x4 (&acc)[2][2][4][2], const Unit& u, int wr, int wc, int fr, int fq, PG8_LAS unsigned char* lds, int wid, int lane) const {
        typedef float f32x2v __attribute__((ext_vector_type(2))); typedef unsigned u32x2v __attribute__((ext_vector_type(2)));
        const PG8_LAS f32x2v* S = (const PG8_LAS f32x2v*)(lds + 8192);
        const int col0 = u.pn * BM + wc * 32 + 4 * fq;
#pragma unroll
        for (int bj = 0; bj < 2; ++bj)
#pragma unroll
            for (int n = 0; n < 2; ++n) { const f32x4 bv = bias ? *(const f32x4*)(bias + col0 + bj * HALF + n * 16) : (f32x4){0.f, 0.f, 0.f, 0.f};
#pragma unroll
                for (int ai = 0; ai < 2; ++ai)
#pragma unroll
                    for (int m = 0; m < 4; ++m) acc[ai][bj][m][n] += bv; }
        bool bad = st1.run(acc, u, wr, wc, fr, fq, lds, wid, lane) || poison != 0u;
        const float qnan = __builtin_nanf("");
#pragma unroll
        for (int ai = 0; ai < 2; ++ai)
#pragma unroll
            for (int m = 0; m < 4; ++m) { const int r = ai * HALF + wr * 64 + m * 16 + fr; const f32x2v sr = S[r]; const size_t off = (size_t)(u.pm * BM + r) * ldc + col0;
#pragma unroll
                for (int bj = 0; bj < 2; ++bj)
#pragma unroll
                    for (int n = 0; n < 2; ++n) { const f32x4 bs = *(const f32x4*)(base + off + bj * HALF + n * 16); acc[ai][bj][m][n] = bs + (acc[ai][bj][m][n] - sr.x) * sr.y; }
                asm volatile("" : "+v"(acc[ai][0][m][0]), "+v"(acc[ai][0][m][1]), "+v"(acc[ai][1][m][0]), "+v"(acc[ai][1][m][1]));
                if (m & 1) asm volatile("" ::: "memory"); }
        const bool bad1 = bad;
        bad = st2.run(acc, u, wr, wc, fr, fq, lds, wid, lane) || bad;
#pragma unroll
        for (int ai = 0; ai < 2; ++ai)
#pragma unroll
            for (int m = 0; m < 4; ++m) { const int r = ai * HALF + wr * 64 + m * 16 + fr; const f32x2v sr = S[r]; const size_t off = (size_t)(u.pm * BM + r) * ldc + col0;
#pragma unroll
                for (int bj = 0; bj < 2; ++bj)
#pragma unroll
                    for (int n = 0; n < 2; ++n) { const f32x4 x1 = acc[ai][bj][m][n]; *(f32x4*)(out + off + bj * HALF + n * 16) = bad1 ? (f32x4){qnan, qnan, qnan, qnan} : x1;
                        const f32x4 o = (x1 - sr.x) * sr.y; u32x2v w; w.x = cvt_pk_bf16(o[0], o[1]); w.y = cvt_pk_bf16(o[2], o[3]);
                        if (bad) { w.x = 0x7fc07fc0u; w.y = 0x7fc07fc0u; } *(u32x2v*)(xn + off + bj * HALF + n * 16) = w; }
                asm volatile("" ::: "memory"); }
    }
};

template <class Epi, class Sched, bool ALIGN_EPI = false, bool SP2 = false>
__device__ __forceinline__ void gemm_phase(PG8_LAS unsigned char* lds, const Gemm g, const Sched& S, const Epi& E, int tid_in) {
    int tid_l = tid_in; asm volatile("" : "+v"(tid_l));
    const int tid = tid_l, wid = __builtin_amdgcn_readfirstlane(tid >> 6), lane = tid & 63, wr = wid >> 2, wc = wid & 3, fr = lane & 15, fq = lane >> 4;
    int K_l = g.K; asm volatile("" : "+s"(K_l));
    const int K = K_l, nt = K / BK;
    unsigned voffA[2], voffB[2];
#pragma unroll
    for (int i = 0; i < 2; ++i) { int R, C; stage_rc(tid * 16 + i * 8192, R, C); const int Rb = Epi::PERM ? ((R & ~31) + perm32(R & 31)) : R;
        voffA[i] = (unsigned)(R * K + C) * 2u; voffB[i] = (unsigned)(Rb * K + C) * 2u; }
    const size_t kstep = (size_t)(BK * 2);
    const size_t hstep = (size_t)HALF * K * 2;
    const size_t tstep = 2 * hstep;
    const unsigned ldsw = (unsigned)wid * 1024u;
    const int aoff = lds_byte(wr * 64 + fr, fq * 8), boff = lds_byte(wc * 32 + fr, fq * 8);
#define PG8_SA(b, h) (((b) * 2 + (h)) * HTB)
#define PG8_SB(b, h) ((4 + (b) * 2 + (h)) * HTB)
#define PG8_STAGE(bufoff, gbase, voff) do { _Pragma("unroll") for (int _i = 0; _i < 2; ++_i) \
        __builtin_amdgcn_global_load_lds((const unsigned*)((const char*)(gbase) + (voff)[_i]), (PG8_LAS unsigned*)(lds + (bufoff) + ldsw + _i * 8192), 16, 0, 0); } while (0)
#define PG8_LDA(dst, b, h) do { _Pragma("unroll") for (int m = 0; m < 4; ++m) _Pragma("unroll") for (int k = 0; k < 2; ++k) dst[m][k] = *(const PG8_LAS bf16x8*)(lds + PG8_SA(b, h) + aoff + m * 2048 + k * 1024); } while (0)
#define PG8_LDB(dst, b, h) do { _Pragma("unroll") for (int n = 0; n < 2; ++n) _Pragma("unroll") for (int k = 0; k < 2; ++k) dst[n][k] = *(const PG8_LAS bf16x8*)(lds + PG8_SB(b, h) + boff + n * 2048 + k * 1024); } while (0)
#define PG8_MMA(ai, bj, At, Bt) do { __builtin_amdgcn_s_setprio(1); _Pragma("unroll") for (int m = 0; m < 4; ++m) _Pragma("unroll") for (int n = 0; n < 2; ++n) _Pragma("unroll") for (int k = 0; k < 2; ++k) \
        acc[ai][bj][m][n] = __builtin_amdgcn_mfma_f32_16x16x32_bf16(Bt[n][k], At[m][k], acc[ai][bj][m][n], 0, 0, 0); __builtin_amdgcn_s_setprio(0); } while (0)
#define PG8_WAIT_V(n) asm volatile("s_waitcnt vmcnt(" #n ")" ::: "memory")
#define PG8_WAIT_L(n) asm volatile("s_waitcnt lgkmcnt(" #n ")" ::: "memory")
#define PG8_BAR __builtin_amdgcn_s_barrier()
#define PG8_SCHED __builtin_amdgcn_sched_barrier(0)
    Unit cur, nxt; int ui = 0;
    if (!S.next(0, cur)) return;
    f32x4 acc[2][2][4][2];
#pragma unroll
    for (int a = 0; a < 2; ++a)
#pragma unroll
        for (int b = 0; b < 2; ++b)
#pragma unroll
            for (int m = 0; m < 4; ++m)
#pragma unroll
                for (int n = 0; n < 2; ++n) acc[a][b][m][n] = (f32x4){0.f, 0.f, 0.f, 0.f};
    bf16x8 At[4][2], B0[2][2], B1[2][2];
    const char* cA = (const char*)g.A + (size_t)cur.pm * tstep; const char* cB = (const char*)g.Bt + (size_t)cur.pn * tstep;
    S.a_ready(cur);
    if constexpr (SP2) {
        PG8_STAGE(PG8_SB(0, 0), cB, voffB); PG8_STAGE(PG8_SB(0, 1), cB + hstep, voffB); PG8_STAGE(PG8_SA(0, 0), cA, voffA); PG8_STAGE(PG8_SA(0, 1), cA + hstep, voffA);
        if (wr == 1) PG8_BAR;
        PG8_WAIT_V(2); PG8_BAR;
        PG8_STAGE(PG8_SB(1, 0), cB + kstep, voffB); PG8_STAGE(PG8_SA(1, 0), cA + kstep, voffA); PG8_STAGE(PG8_SB(1, 1), cB + hstep + kstep, voffB);
        PG8_WAIT_V(6); PG8_BAR;
    } else {
        PG8_STAGE(PG8_SB(0, 0), cB, voffB); PG8_STAGE(PG8_SA(0, 0), cA, voffA); PG8_STAGE(PG8_SB(0, 1), cB + hstep, voffB); PG8_STAGE(PG8_SA(0, 1), cA + hstep, voffA);
        if (wr == 1) PG8_BAR;
        PG8_WAIT_V(4); PG8_BAR;
        PG8_STAGE(PG8_SB(1, 0), cB + kstep, voffB); PG8_STAGE(PG8_SA(1, 0), cA + kstep, voffA); PG8_STAGE(PG8_SB(1, 1), cB + hstep + kstep, voffB);
        PG8_WAIT_V(6); PG8_BAR;
    }
    for (;;) {
        const bool has_next = S.next(ui + 1, nxt);
        const char* nA = has_next ? (const char*)g.A + (size_t)nxt.pm * tstep : cA; const char* nB = has_next ? (const char*)g.Bt + (size_t)nxt.pn * tstep : cB;
        for (int t = 0; t < nt; t += 2) {
            const bool last = (t == nt - 2);
            const char* a1 = cA + (size_t)(t + 1) * kstep;
            const char* a2 = last ? nA : cA + (size_t)(t + 2) * kstep; const char* b2 = last ? nB : cB + (size_t)(t + 2) * kstep;
            const char* a3 = a2 + kstep; const char* b3 = b2 + kstep;
            if (last && has_next) S.a_ready(nxt);
            if constexpr (SP2) {
            PG8_LDB(B0, 0, 0); PG8_LDB(B1, 0, 1); PG8_SCHED; PG8_LDA(At, 0, 0); PG8_STAGE(PG8_SA(1, 1), a1 + hstep, voffA);
            PG8_WAIT_V(8); PG8_WAIT_L(0); PG8_BAR; PG8_MMA(0, 0, At, B0); PG8_MMA(0, 1, At, B1); PG8_BAR; PG8_SCHED;
            PG8_LDA(At, 0, 1); PG8_STAGE(PG8_SB(0, 0), b2, voffB); PG8_STAGE(PG8_SB(0, 1), b2 + hstep, voffB); PG8_STAGE(PG8_SA(0, 0), a2, voffA);
            PG8_WAIT_V(8); PG8_WAIT_L(0); PG8_BAR; PG8_MMA(1, 0, At, B0); PG8_MMA(1, 1, At, B1); PG8_BAR; PG8_SCHED;
            PG8_LDB(B0, 1, 0); PG8_LDB(B1, 1, 1); PG8_SCHED; PG8_LDA(At, 1, 0); PG8_STAGE(PG8_SA(0, 1), a2 + hstep, voffA);
            PG8_WAIT_V(8); PG8_WAIT_L(0); PG8_BAR; PG8_MMA(0, 0, At, B0); PG8_MMA(0, 1, At, B1); PG8_BAR; PG8_SCHED;
            PG8_LDA(At, 1, 1); PG8_STAGE(PG8_SB(1, 0), b3, voffB); PG8_STAGE(PG8_SB(1, 1), b3 + hstep, voffB); PG8_STAGE(PG8_SA(1, 0), a3, voffA);
            PG8_WAIT_V(8); PG8_WAIT_L(0); PG8_BAR; PG8_MMA(1, 0, At, B0); PG8_MMA(1, 1, At, B1); PG8_BAR; PG8_SCHED;
            } else {
            PG8_LDB(B0, 0, 0); PG8_SCHED; PG8_LDA(At, 0, 0); PG8_STAGE(PG8_SA(1, 1), a1 + hstep, voffA);
            PG8_WAIT_L(8); PG8_BAR; PG8_WAIT_L(0); PG8_MMA(0, 0, At, B0); PG8_BAR; PG8_SCHED;
            PG8_LDB(B1, 0, 1); PG8_STAGE(PG8_SB(0, 0), b2, voffB);
            PG8_BAR; PG8_WAIT_L(0); PG8_MMA(0, 1, At, B1); PG8_BAR;
            PG8_LDA(At, 0, 1); PG8_STAGE(PG8_SA(0, 0), a2, voffA);
            PG8_BAR; PG8_WAIT_L(0); PG8_MMA(1, 0, At, B0); PG8_BAR; PG8_SCHED;
            PG8_STAGE(PG8_SB(0, 1), b2 + hstep, voffB);
            PG8_WAIT_V(6); PG8_BAR; PG8_MMA(1, 1, At, B1); PG8_BAR;
            PG8_LDB(B0, 1, 0); PG8_SCHED; PG8_LDA(At, 1, 0); PG8_STAGE(PG8_SA(0, 1), a2 + hstep, voffA);
            PG8_WAIT_L(8); PG8_BAR; PG8_WAIT_L(0); PG8_MMA(0, 0, At, B0); PG8_BAR; PG8_SCHED;
            PG8_LDB(B1, 1, 1); PG8_STAGE(PG8_SB(1, 0), b3, voffB);
            PG8_BAR; PG8_WAIT_L(0); PG8_MMA(0, 1, At, B1); PG8_BAR;
            PG8_LDA(At, 1, 1); PG8_STAGE(PG8_SA(1, 0), a3, voffA);
            PG8_BAR; PG8_WAIT_L(0); PG8_MMA(1, 0, At, B0); PG8_BAR; PG8_SCHED;
            PG8_STAGE(PG8_SB(1, 1), b3 + hstep, voffB);
            PG8_WAIT_V(6); PG8_BAR; PG8_MMA(1, 1, At, B1); PG8_BAR;
            }
        }
        if constexpr (ALIGN_EPI) { if (wr == 0) PG8_BAR; }
        if constexpr (!Epi::AFTER_DRAIN) { E(acc, cur, wr, wc, fr, fq); S.done(cur); }
        if (!has_next) break;
#pragma unroll
        for (int a = 0; a < 2; ++a)
#pragma unroll
            for (int b = 0; b < 2; ++b)
#pragma unroll
                for (int m = 0; m < 4; ++m)
#pragma unroll
                    for (int n = 0; n < 2; ++n) acc[a][b][m][n] = (f32x4){0.f, 0.f, 0.f, 0.f};
        cur = nxt; cA = nA; cB = nB; ++ui;
        if constexpr (ALIGN_EPI) { if (wr == 1) PG8_BAR; }
    }
    PG8_WAIT_V(0);
    if constexpr (!ALIGN_EPI) { if (wr == 0) PG8_BAR; }
    PG8_BAR;
    if constexpr (Epi::AFTER_DRAIN) { E.fused(acc, cur, wr, wc, fr, fq, lds, wid, lane); S.done(cur); }
#undef PG8_SA
#undef PG8_SB
#undef PG8_STAGE
#undef PG8_LDA
#undef PG8_LDB
#undef PG8_MMA
#undef PG8_WAIT_V
#undef PG8_WAIT_L
#undef PG8_BAR
#undef PG8_SCHED
}
}

typedef unsigned short bf16;
typedef float f32x4 __attribute__((ext_vector_type(4)));
typedef unsigned u32x4 __attribute__((ext_vector_type(4)));
typedef unsigned u32x2 __attribute__((ext_vector_type(2)));

constexpr int BATCH = 8, SEQ = 4096, T = BATCH * SEQ, D = 1024, DEPTH = 2;
constexpr int NA = 2048, NB = 3328, NIN = NA + NB, INW = 5204;
constexpr int DFF = 2816, NGU = 2 * DFF, PLE = 256, MIXW = 2048;
constexpr int A_Q = 0, A_BG = 512, A_Z = 1024;
constexpr int B_CKV = 0, B_IQ = 256, B_CG = 512, B_HB = 1024, B_XBC = 1536, B_IK = 3072, B_DT = 3136, B_IW = 3152;
constexpr int XBC = 1536, KV_R = 256, TOPK = 256;
constexpr float EPS = 1e-6f;

constexpr size_t MiB = 1u << 20;
constexpr size_t WS_CTL = 0;
constexpr size_t WS_RSTD = 1 * MiB;
constexpr size_t WS_RSTD2 = 1 * MiB + 256 * 1024;
constexpr size_t WS_DT = 2 * MiB;
constexpr size_t WS_W = 8 * MiB;
constexpr size_t WS_W_IN = WS_W, WS_W_OUT = WS_W_IN + (size_t)NIN * D * 2, WS_W_GU = WS_W_OUT + (size_t)D * MIXW * 2, WS_W_DOWN = WS_W_GU + (size_t)NGU * D * 2,
                 WS_W_PG = WS_W_DOWN + (size_t)D * DFF * 2, WS_W_PP = WS_W_PG + (size_t)D * D * 2, WS_W_END = WS_W_PP + (size_t)D * PLE * 2;
constexpr size_t WS_WUK = 42 * MiB, WS_WUV = 43 * MiB;
static_assert(WS_W_END <= 42 * MiB, "weights");
constexpr size_t WS_X0 = 44 * MiB, WS_X1 = 108 * MiB, WS_RA = 172 * MiB, WS_RB = 300 * MiB, WS_DT2 = 508 * MiB, WS_END = 512 * MiB;
constexpr size_t WS_XA = WS_X0;
constexpr size_t WS_IDX = WS_X1 + 48 * MiB;
constexpr size_t WS_CKVC = WS_X1 + 32 * MiB;
constexpr size_t WS_IKC = 4 * MiB;

__host__ __device__ __forceinline__ float bf2f(bf16 b) { return __builtin_bit_cast(float, ((unsigned)b) << 16); }
__host__ __device__ __forceinline__ bf16 f2bf(float f) { unsigned u = __builtin_bit_cast(unsigned, f); return (bf16)((u + 0x7fffu + ((u >> 16) & 1u)) >> 16); }
__device__ __forceinline__ unsigned pk2(float lo, float hi) { return (unsigned)f2bf(lo) | ((unsigned)f2bf(hi) << 16); }
__device__ __forceinline__ float wave_sum(float v) {
#pragma unroll
    for (int o = 1; o < 64; o <<= 1) v += __shfl_xor(v, o);
    return v;
}
__device__ __forceinline__ float wave_max(float v) {
#pragma unroll
    for (int o = 1; o < 64; o <<= 1) v = fmaxf(v, __shfl_xor(v, o));
    return v;
}
__device__ __forceinline__ float sigmoidf_(float v) { return __builtin_amdgcn_rcpf(1.0f + __expf(-v)); }
__device__ __forceinline__ float siluf_(float v) { return v * sigmoidf_(v); }

__host__ __device__ __forceinline__ int src_col_in(int n) {
    if (n < 512) return n;
    if (n < 1024) return 1092 + (n - 512);
    if (n < 2048) return 2628 + (n - 1024);
    n -= 2048;
    if (n < 256) return 512 + n;
    if (n < 512) return 768 + (n - 256);
    if (n < 1024) return 1604 + (n - 512);
    if (n < 1536) return 2116 + (n - 1024);
    if (n < 3072) return 3652 + (n - 1536);
    if (n < 3136) return 1024 + (n - 3072);
    if (n < 3152) return 5188 + (n - 3136);
    if (n < 3156) return 1088 + (n - 3152);
    return -1;
}

__host__ __device__ __forceinline__ int t5_bucket(int rel) {
    const int ret = rel > 0 ? 16 : 0; const int n = rel < 0 ? -rel : rel;
    int b;
    if (n < 8) b = n; else if (n < 15) b = 8; else if (n < 27) b = 9; else if (n < 50) b = 10; else if (n < 91) b = 11; else if (n < 166) b = 12; else if (n < 305) b = 13; else if (n < 559) b = 14; else b = 15;
    return ret + b;
}

template <int MODE> __global__ void __launch_bounds__(256) k_prep_w(const float* __restrict__ W, const float* __restrict__ W2, int K, int Nsrc, const float* __restrict__ gain, bf16* __restrict__ Wt) {
    __shared__ float tile[32][33];
    const int n0 = blockIdx.x * 32, k0 = blockIdx.y * 32, tx = threadIdx.x & 31, ty = threadIdx.x >> 5;
    const int n = n0 + tx; int src; const float* Ws = W;
    if (MODE == 0) src = n; else if (MODE == 1) src = src_col_in(n); else { const int which = (n & 255) >> 7; src = (n >> 8) * 128 + (n & 127); Ws = which ? W2 : W; }
    for (int kk = ty; kk < 32; kk += 8) { float v = 0.f; if (src >= 0) { v = Ws[(size_t)(k0 + kk) * Nsrc + src]; if (gain) v *= gain[k0 + kk]; } tile[kk][tx] = v; }
    __syncthreads();
    for (int nn = ty; nn < 32; nn += 8) Wt[(size_t)(n0 + nn) * K + k0 + tx] = f2bf(tile[tx][nn]);
}

__global__ void __launch_bounds__(256) k_x_prep(const float* __restrict__ x, bf16* __restrict__ xb, float* __restrict__ rstd) {
    const int lane = threadIdx.x & 63, row = blockIdx.x * 4 + (threadIdx.x >> 6);
    const f32x4* xr = (const f32x4*)(x + (size_t)row * D) + lane; float ss = 0.f; f32x4 v[4];
#pragma unroll
    for (int j = 0; j < 4; ++j) { v[j] = xr[64 * j]; ss += (v[j].x * v[j].x + v[j].y * v[j].y) + (v[j].z * v[j].z + v[j].w * v[j].w); }
    ss = wave_sum(ss);
    u32x2* o = (u32x2*)(xb + (size_t)row * D) + lane;
#pragma unroll
    for (int j = 0; j < 4; ++j) { u32x2 w; w.x = pk2(v[j].x, v[j].y); w.y = pk2(v[j].z, v[j].w); o[64 * j] = w; }
    if (lane == 0) rstd[row] = 1.0f / sqrtf(ss * (1.0f / D) + EPS);
}
__global__ void __launch_bounds__(256) k_rstd(const float* __restrict__ x, float* __restrict__ rstd) {
    const int lane = threadIdx.x & 63, row = blockIdx.x * 4 + (threadIdx.x >> 6);
    const f32x4* xr = (const f32x4*)(x + (size_t)row * D) + lane; float ss = 0.f;
#pragma unroll
    for (int j = 0; j < 4; ++j) { const f32x4 v = xr[64 * j]; ss += (v.x * v.x + v.y * v.y) + (v.z * v.z + v.w * v.w); }
    ss = wave_sum(ss);
    if (lane == 0) rstd[row] = 1.0f / sqrtf(ss * (1.0f / D) + EPS);
}
__global__ void __launch_bounds__(256) k_resid_norm(const float* xin, const float* __restrict__ y, const float* __restrict__ g, float* xo, bf16* __restrict__ xb,
                                                    float* __restrict__ rstd_out, const float* __restrict__ p, bf16* __restrict__ pb) {
    const int lane = threadIdx.x & 63, row = blockIdx.x * 4 + (threadIdx.x >> 6);
    const f32x4* yr = (const f32x4*)(y + (size_t)row * D) + lane; const f32x4* xr = (const f32x4*)(xin + (size_t)row * D) + lane; const f32x4* gr = (const f32x4*)g + lane;
    f32x4 v[4]; float ss = 0.f;
#pragma unroll
    for (int j = 0; j < 4; ++j) { v[j] = yr[64 * j]; ss += (v[j].x * v[j].x + v[j].y * v[j].y) + (v[j].z * v[j].z + v[j].w * v[j].w); }
    const float r = 1.0f / sqrtf(wave_sum(ss) * (1.0f / D) + EPS);
    float s2 = 0.f;
    f32x4* xor_ = (f32x4*)(xo + (size_t)row * D) + lane; u32x2* o = (u32x2*)(xb + (size_t)row * D) + lane;
#pragma unroll
    for (int j = 0; j < 4; ++j) { const f32x4 xx = xr[64 * j], gg = gr[64 * j]; f32x4 w = xx + v[j] * r * gg; xor_[64 * j] = w; s2 += (w.x * w.x + w.y * w.y) + (w.z * w.z + w.w * w.w);
        u32x2 q; q.x = pk2(w.x, w.y); q.y = pk2(w.z, w.w); o[64 * j] = q; }
    if (rstd_out) { s2 = wave_sum(s2); if (lane == 0) rstd_out[row] = 1.0f / sqrtf(s2 * (1.0f / D) + EPS); }
    if (p) { const f32x4 pv = *((const f32x4*)(p + (size_t)row * PLE) + lane); u32x2 q; q.x = pk2(pv.x, pv.y); q.y = pk2(pv.z, pv.w); *((u32x2*)(pb + (size_t)row * PLE) + lane) = q; }
}

namespace pg8 {
struct EpiProj {
    static constexpr bool PERM = true, AFTER_DRAIN = false;
    bf16_t* RA; bf16_t* RB; const float* rstd;
    __device__ __forceinline__ void operator()(const f32x4 (&acc)[2][2][4][2], const Unit& u, int wr, int wc, int fr, int fq) const {
        const int row0 = u.pm * BM + wr * 64 + fr; bf16_t* base; int ld, colt;
        if (u.pn < NA / 256) { base = RA; ld = NA; colt = u.pn * BM; } else { base = RB; ld = NB; colt = (u.pn - NA / 256) * BM; }
        const int col0 = colt + wc * 32 + 8 * fq;
        float sr[2][4];
#pragma unroll
        for (int ai = 0; ai < 2; ++ai)
#pragma unroll
            for (int m = 0; m < 4; ++m) sr[ai][m] = rstd[row0 + ai * HALF + m * 16];
#pragma unroll
        for (int ai = 0; ai < 2; ++ai)
#pragma unroll
            for (int m = 0; m < 4; ++m) { const int r = row0 + ai * HALF + m * 16; const float s = sr[ai][m]; bf16_t* rowp = base + (size_t)r * ld + col0;
#pragma unroll
                for (int bj = 0; bj < 2; ++bj) { const f32x4 v0 = acc[ai][bj][m][0] * s, v1 = acc[ai][bj][m][1] * s;
                    u32x4 w; w.x = cvt_pk_bf16(v0[0], v0[1]); w.y = cvt_pk_bf16(v0[2], v0[3]); w.z = cvt_pk_bf16(v1[0], v1[1]); w.w = cvt_pk_bf16(v1[2], v1[3]);
                    *(u32x4*)(rowp + bj * HALF) = w; } }
    }
};
struct EpiF32 {
    static constexpr bool PERM = false, AFTER_DRAIN = false;
    float* C; long ldc;
    __device__ __forceinline__ void operator()(const f32x4 (&acc)[2][2][4][2], const Unit& u, int wr, int wc, int fr, int fq) const {
        const int row0 = u.pm * BM + wr * 64 + fr, col0 = u.pn * BM + wc * 32 + 4 * fq;
#pragma unroll
        for (int ai = 0; ai < 2; ++ai)
#pragma unroll
            for (int m = 0; m < 4; ++m) { float* rowp = C + (size_t)(row0 + ai * HALF + m * 16) * ldc + col0;
#pragma unroll
                for (int bj = 0; bj < 2; ++bj)
#pragma unroll
                    for (int n = 0; n < 2; ++n) *(f32x4*)(rowp + bj * HALF + n * 16) = acc[ai][bj][m][n]; }
    }
};
struct EpiBf16P {
    static constexpr bool PERM = true, AFTER_DRAIN = false;
    bf16_t* O; long ldc;
    __device__ __forceinline__ void operator()(const f32x4 (&acc)[2][2][4][2], const Unit& u, int wr, int wc, int fr, int fq) const {
        const int row0 = u.pm * BM + wr * 64 + fr, col0 = u.pn * BM + wc * 32 + 8 * fq;
#pragma unroll
        for (int ai = 0; ai < 2; ++ai)
#pragma unroll
            for (int m = 0; m < 4; ++m) { bf16_t* rowp = O + (size_t)(row0 + ai * HALF + m * 16) * ldc + col0;
#pragma unroll
                for (int bj = 0; bj < 2; ++bj) { const f32x4 v0 = acc[ai][bj][m][0], v1 = acc[ai][bj][m][1];
                    u32x4 w; w.x = cvt_pk_bf16(v0[0], v0[1]); w.y = cvt_pk_bf16(v0[2], v0[3]); w.z = cvt_pk_bf16(v1[0], v1[1]); w.w = cvt_pk_bf16(v1[2], v1[3]);
                    *(u32x4*)(rowp + bj * HALF) = w; } }
    }
};
struct EpiSwiGLU {
    static constexpr bool PERM = true, AFTER_DRAIN = false;
    bf16_t* G; const float* rstd;
    __device__ __forceinline__ void operator()(const f32x4 (&acc)[2][2][4][2], const Unit& u, int wr, int wc, int fr, int fq) const {
        const int row0 = u.pm * BM + wr * 64 + fr, col0 = u.pn * HALF + wc * 32 + 8 * fq;
        float sr[2][4];
#pragma unroll
        for (int ai = 0; ai < 2; ++ai)
#pragma unroll
            for (int m = 0; m < 4; ++m) sr[ai][m] = rstd[row0 + ai * HALF + m * 16];
#pragma unroll
        for (int ai = 0; ai < 2; ++ai)
#pragma unroll
            for (int m = 0; m < 4; ++m) { const int r = row0 + ai * HALF + m * 16; const float s = sr[ai][m]; float o[8];
#pragma unroll
                for (int n = 0; n < 2; ++n)
#pragma unroll
                    for (int j = 0; j < 4; ++j) { const float gt = acc[ai][0][m][n][j] * s, up = acc[ai][1][m][n][j] * s; o[n * 4 + j] = gt * __builtin_amdgcn_rcpf(1.0f + __expf(-gt)) * up; }
                u32x4 w; w.x = cvt_pk_bf16(o[0], o[1]); w.y = cvt_pk_bf16(o[2], o[3]); w.z = cvt_pk_bf16(o[4], o[5]); w.w = cvt_pk_bf16(o[6], o[7]);
                *(u32x4*)(G + (size_t)r * DFF + col0) = w; }
    }
};
struct EpiPle {
    static constexpr bool PERM = true, AFTER_DRAIN = false;
    const bf16_t* X; const bf16_t* Tt; bf16_t* XB; float* OUT;
    __device__ __forceinline__ void operator()(const f32x4 (&acc)[2][2][4][2], const Unit& u, int wr, int wc, int fr, int fq) const {
        const int row0 = u.pm * BM + wr * 64 + fr, col0 = u.pn * BM + wc * 32 + 8 * fq;
        u32x4 tv[2][2], xv[2][2];
#define PLE_LOAD(slot, grp) do { const size_t off_ = (size_t)(row0 + ((grp) >> 2) * HALF + ((grp) & 3) * 16) * D + col0; _Pragma("unroll") for (int bj_ = 0; bj_ < 2; ++bj_) { \
            tv[slot][bj_] = *(const u32x4*)(Tt + off_ + bj_ * HALF); xv[slot][bj_] = *(const u32x4*)(X + off_ + bj_ * HALF); } } while (0)
        PLE_LOAD(0, 0);
#pragma unroll
        for (int grp = 0; grp < 8; ++grp) { const int ai = grp >> 2, m = grp & 3, sl = grp & 1; const size_t off = (size_t)(row0 + ai * HALF + m * 16) * D + col0;
            if (grp + 1 < 8) PLE_LOAD((grp + 1) & 1, grp + 1);
#pragma unroll
            for (int bj = 0; bj < 2; ++bj) { const unsigned tw[4] = {tv[sl][bj].x, tv[sl][bj].y, tv[sl][bj].z, tv[sl][bj].w}, xw[4] = {xv[sl][bj].x, xv[sl][bj].y, xv[sl][bj].z, xv[sl][bj].w}; f32x4 x0, x1;
#pragma unroll
                for (int j = 0; j < 4; ++j) { const float t0 = __builtin_bit_cast(float, (j & 1) ? (tw[j >> 1] & 0xffff0000u) : (tw[j >> 1] << 16));
                    const float t1 = __builtin_bit_cast(float, (j & 1) ? (tw[2 + (j >> 1)] & 0xffff0000u) : (tw[2 + (j >> 1)] << 16));
                    const float a0 = __builtin_bit_cast(float, (j & 1) ? (xw[j >> 1] & 0xffff0000u) : (xw[j >> 1] << 16));
                    const float a1 = __builtin_bit_cast(float, (j & 1) ? (xw[2 + (j >> 1)] & 0xffff0000u) : (xw[2 + (j >> 1)] << 16));
                    x0[j] = a0 + __builtin_amdgcn_rcpf(1.0f + __expf(-acc[ai][bj][m][0][j])) * t0; x1[j] = a1 + __builtin_amdgcn_rcpf(1.0f + __expf(-acc[ai][bj][m][1][j])) * t1; }
                if (OUT) { *(f32x4*)(OUT + off + bj * HALF) = x0; *(f32x4*)(OUT + off + bj * HALF + 4) = x1; }
                else { u32x4 w; w.x = cvt_pk_bf16(x0[0], x0[1]); w.y = cvt_pk_bf16(x0[2], x0[3]); w.z = cvt_pk_bf16(x1[0], x1[1]); w.w = cvt_pk_bf16(x1[2], x1[3]);
                    *(u32x4*)(XB + off + bj * HALF) = w; } } }
#undef PLE_LOAD
    }
};
}

__device__ __forceinline__ unsigned ord_key(float f) { const unsigned u = __builtin_bit_cast(unsigned, f); return (u & 0x80000000u) ? ~u : (u | 0x80000000u); }
#define LAS __attribute__((address_space(3)))
#define XB_TMO      128
#define XB_XCNT(j)  (256  + 64 * (j))
#define XB_XSUB(j)  (1280 + 64 * (j))
#define XB_XGEN(j)  (2304 + 64 * (j))
#define XB_TOP      3328
#define XB_TOPGEN   3392
#define XCD_BAR_WORDS 3456
#define XB_SPIN_CAP (1u << 18)

__device__ __forceinline__ unsigned xb_ld(unsigned* p)              { return __hip_atomic_load(p, __ATOMIC_RELAXED, __HIP_MEMORY_SCOPE_AGENT); }
__device__ __forceinline__ unsigned xb_add(unsigned* p, unsigned v) { return __hip_atomic_fetch_add(p, v, __ATOMIC_RELAXED, __HIP_MEMORY_SCOPE_AGENT); }
__device__ __forceinline__ unsigned xb_xcc_id() { return (unsigned)__builtin_amdgcn_s_getreg((3 << 11) | 20) & 0xFu; }
#define XB_SPIN(cond, bar) do { unsigned _sp = 0; while (cond) { __builtin_amdgcn_s_sleep(1); \
    if ((++_sp & 255u) == 0u) { if (xb_ld(&(bar)[XB_TMO])) break; if (_sp > XB_SPIN_CAP) { atomicAdd(&(bar)[XB_TMO], 1u); break; } } } } while (0)

struct XcdBarrier {
    unsigned* bar; unsigned x;
    volatile LAS unsigned* st;
};

__device__ __forceinline__ XcdBarrier xcd_barrier_post(unsigned* bar, volatile LAS unsigned* st) {
    XcdBarrier b; b.bar = bar; b.x = xb_xcc_id(); b.st = st;
    if (threadIdx.x == 0) (void)xb_add(&bar[XB_XCNT(b.x)], 1u);
    return b;
}
__device__ __forceinline__ void xcd_barrier_complete(unsigned* bar, unsigned x, unsigned& nloc, unsigned& nx) {
    const unsigned G = gridDim.x * gridDim.y * gridDim.z;
    unsigned sum, cnt, mine, sp = 0u;
    for (;;) {
        sum = 0u; cnt = 0u; mine = 0u;
#pragma unroll
        for (unsigned j = 0; j < 16; ++j) { const unsigned c = xb_ld(&bar[XB_XCNT(j)]); sum += c; cnt += (c > 0u) ? 1u : 0u; mine = (j == x) ? c : mine; }
        if (sum == G) break;
        __builtin_amdgcn_s_sleep(1);
        if ((++sp & 255u) == 0u) { if (xb_ld(&bar[XB_TMO])) break; if (sp > XB_SPIN_CAP) { atomicAdd(&bar[XB_TMO], 1u); break; } }
    }
    nloc = mine > 0u ? mine : 1u; nx = cnt > 0u ? cnt : 1u;
}

__device__ __forceinline__ void xcd_barrier(const XcdBarrier& b, int tid_in) {
    asm volatile("s_waitcnt vmcnt(0)" ::: "memory");
    __syncthreads();
    if (tid_in == 0) {
        unsigned* bar = b.bar;
        __builtin_amdgcn_s_waitcnt(0);
        unsigned nloc = b.st[0], nx = b.st[1];
        if (nloc == 0u) { xcd_barrier_complete(bar, b.x, nloc, nx); b.st[0] = nloc; b.st[1] = nx; }
        const unsigned old = xb_add(&bar[XB_XSUB(b.x)], 1u);
        const unsigned gen = old / nloc;
        if (old + 1u == (gen + 1u) * nloc) {
            __builtin_amdgcn_fence(__ATOMIC_RELEASE, "agent");
            asm volatile("s_waitcnt vmcnt(0)" ::: "memory");
            const unsigned og = xb_add(&bar[XB_TOP], 1u);
            const unsigned tg = og / nx;
            if (og + 1u == (tg + 1u) * nx) xb_add(&bar[XB_TOPGEN], 1u);
            else XB_SPIN(xb_ld(&bar[XB_TOPGEN]) == tg, bar);
            __builtin_amdgcn_fence(__ATOMIC_ACQUIRE, "agent");
            xb_add(&bar[XB_XGEN(b.x)], 1u);
            asm volatile("s_waitcnt vmcnt(0)" ::: "memory");
        } else {
            XB_SPIN(xb_ld(&bar[XB_XGEN(b.x)]) == gen, bar);
            __builtin_amdgcn_fence(__ATOMIC_ACQUIRE, "agent");
            asm volatile("s_waitcnt vmcnt(0)" ::: "memory");
        }
    }
    __syncthreads();
}


constexpr int NTHR = 512, NWAVES = 8;
constexpr int RING_BYTES = 131072, LDS_BYTES = 147456, MISC_OFF = LDS_BYTES - 512;
constexpr int CW_BAR = 4096, CW_RANK = 8192;
constexpr size_t CTL_ZERO_BYTES = 1 * MiB;
constexpr int NPH = 14;

__device__ __forceinline__ int mk_tid(int wave_s) { int l_; asm volatile("v_mbcnt_lo_u32_b32 %0, -1, 0\n\tv_mbcnt_hi_u32_b32 %0, -1, %0" : "=v"(l_)); return wave_s * 64 + l_; }
struct Params { const float* in[26]; float* out; unsigned char* ws; int ph_lo, ph_hi, dbl_mask, pad; };
static_assert(sizeof(Params) == 26 * 8 + 8 + 8 + 16, "no padding");

#define LDSP __attribute__((address_space(3)))
#define LDS_WAIT() asm volatile("s_waitcnt lgkmcnt(0)" ::: "memory")
#ifndef NAIVE_SELECT
#define NAIVE_SELECT 0
#endif
#ifndef NAIVE_ATTN
#define NAIVE_ATTN 0
#endif
#ifndef NAIVE_SSM
#define NAIVE_SSM 0
#endif
#ifndef DBG_SSM
#define DBG_SSM 0
#endif
#ifndef TIMING
#define TIMING 0
#endif
#ifndef DBL_MASK
#define DBL_MASK 0
#endif
#ifndef GEMM_DRYK
#define GEMM_DRYK 0
#endif
#ifndef CLK_PROBE
#define CLK_PROBE 0
#endif
#ifndef ATT_FN
#define ATT_FN wg_attn16d
#endif
#ifndef XTRA_BAR
#define XTRA_BAR 0
#endif
#ifndef ATT_SUB_V
#define ATT_SUB_V 0
#endif
#ifndef TIMING_SHIFT
#define TIMING_SHIFT 0.0f
#endif
#ifndef TIMING_A
#define TIMING_A 2
#endif
#ifndef TIMING_B
#define TIMING_B 3
#endif

template <int MODE> __device__ __forceinline__ void ph_prep_w(LDSP float* scr, const float* __restrict__ W, const float* __restrict__ W2, int K, int Nsrc, const float* __restrict__ gain, bf16* __restrict__ Wt, int Ndst, int gw, int NGW, int lane) {
    const int ntn = Ndst / 32, nt = ntn * (K / 64), n4 = lane & 7, kr = lane >> 3;
    f32x4 v[8];
#define PW_LOAD(it_) { const int n0_ = ((it_) % ntn) * 32, k0_ = ((it_) / ntn) * 64, n_ = n0_ + 4 * n4; int src_; const float* Ws_ = W; \
        if (MODE == 0) src_ = n_; else if (MODE == 1) src_ = src_col_in(n_); else { const int which_ = (n_ & 255) >> 7; src_ = (n_ >> 8) * 128 + (n_ & 127); Ws_ = which_ ? W2 : W; } \
        _Pragma("unroll") for (int i = 0; i < 8; ++i) { const int kk = kr + 8 * i; f32x4 t_ = (f32x4){0.f, 0.f, 0.f, 0.f}; if (src_ >= 0) { t_ = *(const f32x4*)(Ws_ + (size_t)(k0_ + kk) * Nsrc + src_); if (gain) t_ = t_ * gain[k0_ + kk]; } v[i] = t_; } }
    if (gw < nt) PW_LOAD(gw)
    for (int it = gw; it < nt; it += NGW) {
        const int n0 = (it % ntn) * 32, k0 = (it / ntn) * 64;
#pragma unroll
        for (int i = 0; i < 8; ++i) { LDSP float* d = scr + (kr + 8 * i) * 33 + 4 * n4; d[0] = v[i].x; d[1] = v[i].y; d[2] = v[i].z; d[3] = v[i].w; }
        if (it + NGW < nt) PW_LOAD(it + NGW)
        LDS_WAIT(); asm volatile("" ::: "memory");
        const int cc = lane & 7;
#pragma unroll
        for (int j = 0; j < 4; ++j) { const int nn = (lane >> 3) + 8 * j; const LDSP float* s = scr + (8 * cc) * 33 + nn;
            u32x4 o; o.x = pk2(s[0 * 33], s[1 * 33]); o.y = pk2(s[2 * 33], s[3 * 33]); o.z = pk2(s[4 * 33], s[5 * 33]); o.w = pk2(s[6 * 33], s[7 * 33]);
            *(u32x4*)(Wt + (size_t)(n0 + nn) * K + k0 + 8 * cc) = o; }
        LDS_WAIT(); asm volatile("" ::: "memory");
    }
#undef PW_LOAD
}
__device__ __forceinline__ void row_x_prep(const float* __restrict__ x, bf16* __restrict__ xb, float* __restrict__ rstd, int row, int lane) {
    const f32x4* xr = (const f32x4*)(x + (size_t)row * D) + lane; float ss = 0.f; f32x4 v[4];
#pragma unroll
    for (int j = 0; j < 4; ++j) { v[j] = xr[64 * j]; ss += (v[j].x * v[j].x + v[j].y * v[j].y) + (v[j].z * v[j].z + v[j].w * v[j].w); }
    ss = wave_sum(ss);
    if (xb) { u32x2* o = (u32x2*)(xb + (size_t)row * D) + lane;
#pragma unroll
        for (int j = 0; j < 4; ++j) { u32x2 w; w.x = pk2(v[j].x, v[j].y); w.y = pk2(v[j].z, v[j].w); o[64 * j] = w; } }
    if (lane == 0) rstd[row] = 1.0f / sqrtf(ss * (1.0f / D) + EPS);
}
__device__ __forceinline__ void row_resid_norm(const float* xin, const float* __restrict__ y, const float* __restrict__ g, float* xo, bf16* __restrict__ xb, float* __restrict__ rstd_out, const float* __restrict__ p, bf16* __restrict__ pb, int row, int lane, bool dry = false) {
    const f32x4* yr = (const f32x4*)(y + (size_t)row * D) + lane; const f32x4* xr = (const f32x4*)(xin + (size_t)row * D) + lane; const f32x4* gr = (const f32x4*)g + lane;
    f32x4 v[4]; float ss = 0.f;
#pragma unroll
    for (int j = 0; j < 4; ++j) { v[j] = yr[64 * j]; ss += (v[j].x * v[j].x + v[j].y * v[j].y) + (v[j].z * v[j].z + v[j].w * v[j].w); }
    const float r = 1.0f / sqrtf(wave_sum(ss) * (1.0f / D) + EPS);
    float s2 = 0.f;
    f32x4* xor_ = (f32x4*)(xo + (size_t)row * D) + lane; u32x2* o = (u32x2*)(xb + (size_t)row * D) + lane;
#pragma unroll
    for (int j = 0; j < 4; ++j) { const f32x4 xx = xr[64 * j], gg = gr[64 * j]; f32x4 w = xx + v[j] * r * gg; if (!dry) xor_[64 * j] = w; s2 += (w.x * w.x + w.y * w.y) + (w.z * w.z + w.w * w.w);
        u32x2 q; q.x = pk2(w.x, w.y); q.y = pk2(w.z, w.w); o[64 * j] = q; }
    if (rstd_out) { s2 = wave_sum(s2); if (lane == 0) rstd_out[row] = 1.0f / sqrtf(s2 * (1.0f / D) + EPS); }
    if (p) { const f32x4 pv = *((const f32x4*)(p + (size_t)row * PLE) + lane); u32x2 q; q.x = pk2(pv.x, pv.y); q.y = pk2(pv.z, pv.w); *((u32x2*)(pb + (size_t)row * PLE) + lane) = q; }
}

__device__ __forceinline__ void row_resid_norm2(const bf16* xin, const bf16* __restrict__ y, const float* __restrict__ g, bf16* xo, float* __restrict__ rstd_out, const float* __restrict__ p, bf16* __restrict__ pb, int row0, int lane, bool dry = false) {
    f32x4 v[2][4], xx[2][4], pv[2]; const f32x4* gr = (const f32x4*)g + lane;
#pragma unroll
    for (int r = 0; r < 2; ++r) { const u32x2* yr = (const u32x2*)(y + (size_t)(row0 + r) * D) + lane; const u32x2* xr = (const u32x2*)(xin + (size_t)(row0 + r) * D) + lane;
#pragma unroll
        for (int j = 0; j < 4; ++j) { const u32x2 yw = yr[64 * j], xw = xr[64 * j];
            v[r][j] = (f32x4){__builtin_bit_cast(float, yw.x << 16), __builtin_bit_cast(float, yw.x & 0xffff0000u), __builtin_bit_cast(float, yw.y << 16), __builtin_bit_cast(float, yw.y & 0xffff0000u)};
            xx[r][j] = (f32x4){__builtin_bit_cast(float, xw.x << 16), __builtin_bit_cast(float, xw.x & 0xffff0000u), __builtin_bit_cast(float, xw.y << 16), __builtin_bit_cast(float, xw.y & 0xffff0000u)}; }
        if (p) pv[r] = *((const f32x4*)(p + (size_t)(row0 + r) * PLE) + lane); }
    f32x4 gg[4];
#pragma unroll
    for (int j = 0; j < 4; ++j) gg[j] = gr[64 * j];
#pragma unroll
    for (int r = 0; r < 2; ++r) { float ss = 0.f;
#pragma unroll
        for (int j = 0; j < 4; ++j) ss += (v[r][j].x * v[r][j].x + v[r][j].y * v[r][j].y) + (v[r][j].z * v[r][j].z + v[r][j].w * v[r][j].w);
        const float rr = 1.0f / sqrtf(wave_sum(ss) * (1.0f / D) + EPS); float s2 = 0.f;
        u32x2* o = (u32x2*)(xo + (size_t)(row0 + r) * D) + lane;
#pragma unroll
        for (int j = 0; j < 4; ++j) { const f32x4 w = xx[r][j] + v[r][j] * rr * gg[j]; u32x2 q; q.x = pk2(w.x, w.y); q.y = pk2(w.z, w.w); if (!dry) o[64 * j] = q;
            const float r0 = __builtin_bit_cast(float, q.x << 16), r1 = __builtin_bit_cast(float, q.x & 0xffff0000u), r2 = __builtin_bit_cast(float, q.y << 16), r3 = __builtin_bit_cast(float, q.y & 0xffff0000u);
            s2 += (r0 * r0 + r1 * r1) + (r2 * r2 + r3 * r3); }
        if (rstd_out) { s2 = wave_sum(s2); if (lane == 0) rstd_out[row0 + r] = 1.0f / sqrtf(s2 * (1.0f / D) + EPS); }
        if (p) { u32x2 q; q.x = pk2(pv[r].x, pv[r].y); q.y = pk2(pv[r].z, pv[r].w); *((u32x2*)(pb + (size_t)(row0 + r) * PLE) + lane) = q; } }
}
__device__ __forceinline__ void row_rstd_bf16(const bf16* __restrict__ xb, float* __restrict__ rstd, int row, int lane) {
    const u32x2* xr = (const u32x2*)(xb + (size_t)row * D) + lane; float ss = 0.f;
#pragma unroll
    for (int j = 0; j < 4; ++j) { const u32x2 w = xr[64 * j]; const float a = __builtin_bit_cast(float, w.x << 16), b = __builtin_bit_cast(float, w.x & 0xffff0000u), c2 = __builtin_bit_cast(float, w.y << 16), d = __builtin_bit_cast(float, w.y & 0xffff0000u); ss += (a * a + b * b) + (c2 * c2 + d * d); }
    ss = wave_sum(ss); if (lane == 0) rstd[row] = 1.0f / sqrtf(ss * (1.0f / D) + EPS);
}
__device__ __forceinline__ void row_x_prep2(const float* __restrict__ x, bf16* __restrict__ xb, float* __restrict__ rstd, int row0, int lane) {
    f32x4 v[2][4]; float ss[2];
#pragma unroll
    for (int r = 0; r < 2; ++r) { const f32x4* xr = (const f32x4*)(x + (size_t)(row0 + r) * D) + lane;
#pragma unroll
        for (int j = 0; j < 4; ++j) v[r][j] = xr[64 * j]; }
#pragma unroll
    for (int r = 0; r < 2; ++r) { float s_ = 0.f;
#pragma unroll
        for (int j = 0; j < 4; ++j) s_ += (v[r][j].x * v[r][j].x + v[r][j].y * v[r][j].y) + (v[r][j].z * v[r][j].z + v[r][j].w * v[r][j].w);
        ss[r] = wave_sum(s_); u32x2* o = (u32x2*)(xb + (size_t)(row0 + r) * D) + lane;
#pragma unroll
        for (int j = 0; j < 4; ++j) { u32x2 w; w.x = pk2(v[r][j].x, v[r][j].y); w.y = pk2(v[r][j].z, v[r][j].w); o[64 * j] = w; } }
    if (lane < 2) rstd[row0 + lane] = 1.0f / sqrtf((lane ? ss[1] : ss[0]) * (1.0f / D) + EPS);
}
__device__ __forceinline__ void row_rstd_bf16x4(const bf16* __restrict__ xb, float* __restrict__ rstd, int row0, int lane) {
    u32x2 w[4][4]; float ss[4];
#pragma unroll
    for (int r = 0; r < 4; ++r) { const u32x2* xr = (const u32x2*)(xb + (size_t)(row0 + r) * D) + lane;
#pragma unroll
        for (int j = 0; j < 4; ++j) w[r][j] = xr[64 * j]; }
#pragma unroll
    for (int r = 0; r < 4; ++r) { float s_ = 0.f;
#pragma unroll
        for (int j = 0; j < 4; ++j) { const float a = __builtin_bit_cast(float, w[r][j].x << 16), b = __builtin_bit_cast(float, w[r][j].x & 0xffff0000u), c2 = __builtin_bit_cast(float, w[r][j].y << 16), d = __builtin_bit_cast(float, w[r][j].y & 0xffff0000u); s_ += (a * a + b * b) + (c2 * c2 + d * d); }
        ss[r] = wave_sum(s_); }
    const float sel = lane == 0 ? ss[0] : lane == 1 ? ss[1] : lane == 2 ? ss[2] : ss[3];
    if (lane < 4) rstd[row0 + lane] = 1.0f / sqrtf(sel * (1.0f / D) + EPS);
}
__device__ __forceinline__ void wave_gnorm4(bf16* RA, const float* __restrict__ nw, int w0, int lane, bool dry = false) {
    u32x4 v[4]; float ss[4];
#pragma unroll
    for (int i = 0; i < 4; ++i) { const int w = w0 + i, t = w >> 1, g = w & 1; v[i] = *(const u32x4*)(RA + (size_t)t * NA + A_Z + g * 512 + lane * 8); }
    float f[4][8];
#pragma unroll
    for (int i = 0; i < 4; ++i) { const unsigned vw[4] = {v[i].x, v[i].y, v[i].z, v[i].w}; ss[i] = 0.f;
#pragma unroll
        for (int e = 0; e < 8; ++e) { f[i][e] = bf2f((bf16)((vw[e >> 1] >> ((e & 1) * 16)) & 0xffff)); ss[i] += f[i][e] * f[i][e]; } }
#pragma unroll
    for (int o = 1; o < 64; o <<= 1) {
#pragma unroll
        for (int i = 0; i < 4; ++i) ss[i] += __shfl_xor(ss[i], o); }
#pragma unroll
    for (int i = 0; i < 4; ++i) { const int w = w0 + i, t = w >> 1, g = w & 1; const float r = 1.0f / sqrtf(ss[i] * (1.0f / 512.0f) + EPS); const float* gw = nw + g * 512 + lane * 8;
        u32x4 o; o.x = pk2(f[i][0] * r * gw[0], f[i][1] * r * gw[1]); o.y = pk2(f[i][2] * r * gw[2], f[i][3] * r * gw[3]); o.z = pk2(f[i][4] * r * gw[4], f[i][5] * r * gw[5]); o.w = pk2(f[i][6] * r * gw[6], f[i][7] * r * gw[7]);
        if (!dry) *(u32x4*)(RA + (size_t)t * NA + A_Z + g * 512 + lane * 8) = o; }
}
__device__ __forceinline__ void tok_m1(bf16* __restrict__ RA, bf16* __restrict__ RB, bf16* __restrict__ CKVC, bf16* __restrict__ IKC, const float* __restrict__ kvn, const float* __restrict__ ikg, const float* __restrict__ ikb, const float* __restrict__ scw, int t, int lane) {
    const int s = t & (SEQ - 1); bf16* rb = RB + (size_t)t * NB;
    {   const u32x2 w = *((const u32x2*)(rb + B_CKV) + lane); float v[4] = {bf2f((bf16)(w.x & 0xffff)), bf2f((bf16)(w.x >> 16)), bf2f((bf16)(w.y & 0xffff)), bf2f((bf16)(w.y >> 16))};
        float ss = (v[0] * v[0] + v[1] * v[1]) + (v[2] * v[2] + v[3] * v[3]); ss = wave_sum(ss); const float r = 1.0f / sqrtf(ss * (1.0f / KV_R) + EPS);
        const f32x4 g = *((const f32x4*)kvn + lane); u32x2 o; o.x = pk2(v[0] * r * g.x, v[1] * r * g.y); o.y = pk2(v[2] * r * g.z, v[3] * r * g.w); *((u32x2*)(rb + B_CKV) + lane) = o; *((u32x2*)(CKVC + (size_t)t * KV_R) + lane) = o; }
    {   const float x = bf2f(rb[B_IK + lane]); const float mu = wave_sum(x) * (1.0f / 64.0f); const float d = x - mu; const float var = wave_sum(d * d) * (1.0f / 64.0f);
        const bf16 o = f2bf(d * (1.0f / sqrtf(var + EPS)) * ikg[lane] + ikb[lane]); rb[B_IK + lane] = o; IKC[(size_t)t * 64 + lane] = o; }
    {   const int c = lane * 8; float acc[8] = {0.f, 0.f, 0.f, 0.f, 0.f, 0.f, 0.f, 0.f};
        for (int j = 0; j < 3; ++j) { const int ss_ = s - 2 + j; if (ss_ < 0) continue; const bf16* rr = RB + (size_t)(t - 2 + j) * NB;
            const u32x4 cg = *(const u32x4*)(rr + B_CG + c), hb = *(const u32x4*)(rr + B_HB + c); const unsigned cw[4] = {cg.x, cg.y, cg.z, cg.w}, hw[4] = {hb.x, hb.y, hb.z, hb.w};
#pragma unroll
            for (int e = 0; e < 8; ++e) { const float a = bf2f((bf16)((cw[e >> 1] >> ((e & 1) * 16)) & 0xffff)), b = bf2f((bf16)((hw[e >> 1] >> ((e & 1) * 16)) & 0xffff)); acc[e] += scw[j * 512 + c + e] * (a * b); } }
        bf16* ra = RA + (size_t)t * NA + A_BG + c; const u32x4 bg = *(const u32x4*)ra; const unsigned bw[4] = {bg.x, bg.y, bg.z, bg.w}; float o[8];
#pragma unroll
        for (int e = 0; e < 8; ++e) o[e] = bf2f((bf16)((bw[e >> 1] >> ((e & 1) * 16)) & 0xffff)) * acc[e];
        u32x4 w; w.x = pk2(o[0], o[1]); w.y = pk2(o[2], o[3]); w.z = pk2(o[4], o[5]); w.w = pk2(o[6], o[7]); *(u32x4*)ra = w; }
}
__device__ __forceinline__ void tok_m4a(const bf16* __restrict__ RB, const float* __restrict__ cw, const float* __restrict__ cb, const float* __restrict__ dtb, bf16* __restrict__ XA, float* __restrict__ DT, int t, int lane) {
    const int s = t & (SEQ - 1);
    for (int c = lane; c < XBC; c += 64) { float a = cb[c];
#pragma unroll
        for (int j = 0; j < 4; ++j) { const int ss = s - 3 + j; if (ss >= 0) a += cw[j * XBC + c] * bf2f(RB[(size_t)(t - 3 + j) * NB + B_XBC + c]); }
        XA[(size_t)t * XBC + c] = f2bf(siluf_(a)); }
    if (lane < 16) { const float x = bf2f(RB[(size_t)t * NB + B_DT + lane]) + dtb[lane]; DT[(size_t)t * 16 + lane] = x > 15.f ? x : log1pf(__expf(x)); }
}
__device__ __forceinline__ void wg_m2_select(LDSP unsigned char* lds, const bf16* __restrict__ RB, unsigned short* __restrict__ idx, int t, int tid) {
    LDSP float* iq = (LDSP float*)lds; LDSP float* iwv = iq + 256; LDSP unsigned* red = (LDSP unsigned*)(iq + 272); LDSP unsigned* keys = (LDSP unsigned*)(iq + 288);
    const int s = t & (SEQ - 1), b = t >> 12, lane = tid & 63, wv = tid >> 6;
    const int nk = ((s >> 6) + 1) << 6;
    const bf16* rb = RB + (size_t)t * NB;
    if (tid < 256) iq[tid] = bf2f(rb[B_IQ + tid]); if (tid < 4) iwv[tid] = bf2f(rb[B_IW + tid]) * (0.125f * 0.5f);
    __syncthreads();
    for (int k = tid; k < nk; k += NTHR) {
        const bf16* kr = RB + (size_t)(b * SEQ + k) * NB + B_IK; float sc = 0.f;
        float d0 = 0.f, d1 = 0.f, d2 = 0.f, d3 = 0.f;
#pragma unroll 1
        for (int j = 0; j < 8; ++j) { const u32x4 w = *((const u32x4*)kr + j); const unsigned ww[4] = {w.x, w.y, w.z, w.w};
#pragma unroll
            for (int e = 0; e < 8; ++e) { const float kv = bf2f((bf16)((ww[e >> 1] >> ((e & 1) * 16)) & 0xffff)); const int c = j * 8 + e;
                d0 += iq[c] * kv; d1 += iq[64 + c] * kv; d2 += iq[128 + c] * kv; d3 += iq[192 + c] * kv; } }
        sc += fmaxf(d0, 0.f) * iwv[0]; sc += fmaxf(d1, 0.f) * iwv[1]; sc += fmaxf(d2, 0.f) * iwv[2]; sc += fmaxf(d3, 0.f) * iwv[3];
        keys[k] = ord_key(sc);
    }
    __syncthreads();
    unsigned Tt = 0u;
    if (nk > TOPK) {
        for (int bit = 31; bit >= 0; --bit) { const unsigned cand = Tt | (1u << bit); unsigned c = 0;
            for (int k = tid; k < nk; k += NTHR) c += (keys[k] >= cand) ? 1u : 0u;
#pragma unroll
            for (int o = 1; o < 64; o <<= 1) c += __shfl_xor(c, o);
            if (lane == 0) red[wv] = c;
            __syncthreads();
            unsigned tot = 0;
#pragma unroll
            for (int w = 0; w < 8; ++w) tot += red[w];
            if (tot >= (unsigned)TOPK) Tt = cand;
            __syncthreads(); }
    }
    { unsigned c = 0; for (int k = tid; k < nk; k += NTHR) c += (keys[k] > Tt) ? 1u : 0u;
#pragma unroll
      for (int o = 1; o < 64; o <<= 1) c += __shfl_xor(c, o);
      if (lane == 0) red[8 + wv] = c; }
    __syncthreads();
    if (wv == 0) {
        int ngt = 0;
#pragma unroll
        for (int w = 0; w < 8; ++w) ngt += (int)red[8 + w];
        const int need = TOPK - ngt; int pos = 0, eq_taken = 0; const unsigned long long lt = (1ull << lane) - 1ull;
        for (int base = 0; base < nk; base += 64) { const unsigned k = keys[base + lane]; const bool gt = k > Tt, eq = (k == Tt);
            const unsigned long long meq = __ballot(eq); const int rank_eq = __popcll(meq & lt); const bool take = gt || (eq && (eq_taken + rank_eq < need));
            const unsigned long long msel = __ballot(take);
            if (take) { const int o = pos + __popcll(msel & lt); if (o < TOPK) idx[(size_t)t * TOPK + o] = (unsigned short)(base + lane); }
            pos += __popcll(msel); eq_taken += __popcll(__ballot(eq && take)); }
    }
    __syncthreads();
}
__device__ __forceinline__ void wg_m3_attn(LDSP unsigned char* lds, bf16* RA, const bf16* __restrict__ RB, const unsigned short* __restrict__ idx, const float* __restrict__ w_uk, const float* __restrict__ w_uv, const float* __restrict__ rel_bias, int t, int tid) {
    LDSP float* q = (LDSP float*)lds; LDSP float* qlat = q + 512; LDSP float* pr = qlat + 2048; LDSP float* outl = pr + 2048; LDSP unsigned short* sel = (LDSP unsigned short*)(outl + 2048);
    const int s = t & (SEQ - 1), b = t >> 12, lane = tid & 63, wv = tid >> 6;
    const int nk = ((s >> 6) + 1) << 6, nsel = nk < TOPK ? nk : TOPK;
    q[tid] = bf2f(RA[(size_t)t * NA + A_Q + tid]); if (tid < 256) sel[tid] = tid < nsel ? idx[(size_t)t * TOPK + tid] : (unsigned short)0;
    __syncthreads();
    {   const int r = tid & 255, h0 = (tid >> 8) * 4;
        for (int h = h0; h < h0 + 4; ++h) { const float* w = w_uk + ((size_t)r * 8 + h) * 64; float a = 0.f;
#pragma unroll 16
            for (int d = 0; d < 64; ++d) a += q[h * 64 + d] * w[d];
            qlat[h * 256 + r] = a * 0.125f; } }
    __syncthreads();
    {   const int k = tid & 255, h0 = (tid >> 8) * 4;
        if (k < nsel) { const int key = sel[k]; const bf16* kr = RB + (size_t)(b * SEQ + key) * NB + B_CKV; float a[4] = {0.f, 0.f, 0.f, 0.f};
            for (int j = 0; j < 32; ++j) { const u32x4 w = *((const u32x4*)kr + j); const unsigned ww[4] = {w.x, w.y, w.z, w.w};
#pragma unroll
                for (int e = 0; e < 8; ++e) { const float v = bf2f((bf16)((ww[e >> 1] >> ((e & 1) * 16)) & 0xffff));
#pragma unroll
                    for (int hh = 0; hh < 4; ++hh) a[hh] += qlat[(h0 + hh) * 256 + j * 8 + e] * v; } }
            const int bk = t5_bucket(key - s);
#pragma unroll
            for (int hh = 0; hh < 4; ++hh) pr[(h0 + hh) * 256 + k] = a[hh] + rel_bias[bk * 8 + h0 + hh];
        } else {
#pragma unroll
            for (int hh = 0; hh < 4; ++hh) pr[(h0 + hh) * 256 + k] = -INFINITY; } }
    __syncthreads();
    {   float v[4]; float m = -INFINITY;
#pragma unroll
        for (int j = 0; j < 4; ++j) { v[j] = pr[wv * 256 + lane + 64 * j]; m = fmaxf(m, v[j]); }
        m = wave_max(m); float sum = 0.f;
#pragma unroll
        for (int j = 0; j < 4; ++j) { v[j] = __expf(v[j] - m); sum += v[j]; }
        sum = wave_sum(sum); const float inv = 1.0f / sum;
#pragma unroll
        for (int j = 0; j < 4; ++j) pr[wv * 256 + lane + 64 * j] = v[j] * inv; }
    __syncthreads();
    {   const int r = tid & 255, h0 = (tid >> 8) * 4; float a[4] = {0.f, 0.f, 0.f, 0.f};
        for (int k = 0; k < nsel; ++k) { const float v = bf2f(RB[(size_t)(b * SEQ + sel[k]) * NB + B_CKV + r]);
#pragma unroll
            for (int hh = 0; hh < 4; ++hh) a[hh] += pr[(h0 + hh) * 256 + k] * v; }
#pragma unroll
        for (int hh = 0; hh < 4; ++hh) outl[(h0 + hh) * 256 + r] = a[hh]; }
    __syncthreads();
    {   const int h = tid >> 6, d = tid & 63; float a = 0.f;
        for (int r = 0; r < 256; ++r) a += outl[h * 256 + r] * w_uv[((size_t)r * 8 + h) * 64 + d];
        RA[(size_t)t * NA + A_Q + tid] = f2bf(a); }
    __syncthreads();
}
__device__ __forceinline__ void half_m4b_scan(bf16* RA, const bf16* __restrict__ XA, const float* __restrict__ DT, const float* __restrict__ a_log, const float* __restrict__ dsk, int b, int h, int tid) {
    const int g = h >> 3, p = tid >> 2, nq = tid & 3;
    const float A = -__expf(a_log[h]), Dh = dsk[h];
    float hs[32];
#pragma unroll
    for (int n = 0; n < 32; ++n) hs[n] = 0.f;
    for (int s = 0; s < SEQ; ++s) { const size_t t = (size_t)b * SEQ + s; const float dt = DT[t * 16 + h]; const float dA = __expf(dt * A);
        const bf16* xr = XA + t * XBC; const float x = bf2f(xr[h * 64 + p]); const float dx = dt * x;
        const u32x4* Bp = (const u32x4*)(xr + 1024 + g * 128 + nq * 32); const u32x4* Cp = (const u32x4*)(xr + 1280 + g * 128 + nq * 32); float y = 0.f;
#pragma unroll
        for (int j = 0; j < 4; ++j) { const u32x4 bw = Bp[j], cw = Cp[j]; const unsigned bb[4] = {bw.x, bw.y, bw.z, bw.w}, cc[4] = {cw.x, cw.y, cw.z, cw.w};
#pragma unroll
            for (int e = 0; e < 8; ++e) { const float Bv = bf2f((bf16)((bb[e >> 1] >> ((e & 1) * 16)) & 0xffff)), Cv = bf2f((bf16)((cc[e >> 1] >> ((e & 1) * 16)) & 0xffff));
                hs[j * 8 + e] = hs[j * 8 + e] * dA + dx * Bv; y += Cv * hs[j * 8 + e]; } }
        y += __shfl_xor(y, 1); y += __shfl_xor(y, 2);
        if (nq == 0) { bf16* zp = RA + t * NA + A_Z + h * 64 + p; const float z = bf2f(*zp); *zp = f2bf((y + Dh * x) * siluf_(z)); }
    }
}
__device__ __forceinline__ void wave_m4c_gnorm(bf16* RA, const float* __restrict__ nw, int w, int lane, bool dry = false) {
    const int t = w >> 1, g = w & 1;
    bf16* p = RA + (size_t)t * NA + A_Z + g * 512 + lane * 8; const u32x4 v = *(const u32x4*)p; const unsigned vw[4] = {v.x, v.y, v.z, v.w}; float f[8]; float ss = 0.f;
#pragma unroll
    for (int e = 0; e < 8; ++e) { f[e] = bf2f((bf16)((vw[e >> 1] >> ((e & 1) * 16)) & 0xffff)); ss += f[e] * f[e]; }
    const float r = 1.0f / sqrtf(wave_sum(ss) * (1.0f / 512.0f) + EPS); const float* gw = nw + g * 512 + lane * 8;
    u32x4 o; o.x = pk2(f[0] * r * gw[0], f[1] * r * gw[1]); o.y = pk2(f[2] * r * gw[2], f[3] * r * gw[3]); o.z = pk2(f[4] * r * gw[4], f[5] * r * gw[5]); o.w = pk2(f[6] * r * gw[6], f[7] * r * gw[7]);
    if (!dry) *(u32x4*)p = o;
}

__device__ __forceinline__ void unpack8(const u32x4 w, float (&f)[8]) { const unsigned ww[4] = {w.x, w.y, w.z, w.w};
#pragma unroll
    for (int e = 0; e < 4; ++e) { f[2 * e] = __builtin_bit_cast(float, ww[e] << 16); f[2 * e + 1] = __builtin_bit_cast(float, ww[e] & 0xffff0000u); } }
__device__ __forceinline__ void prep_ckv4(const bf16* __restrict__ RB, bf16* __restrict__ CKVC, const float* __restrict__ kvn, int it, int lane) {
    const int t = it * 4 + (lane >> 4), c = lane & 15; const u32x4* src = (const u32x4*)(RB + (size_t)t * NB + B_CKV + c * 16); const u32x4 a = src[0], b = src[1];
    float v[16]; { float f[8]; unpack8(a, f);
#pragma unroll
        for (int e = 0; e < 8; ++e) v[e] = f[e]; unpack8(b, f);
#pragma unroll
        for (int e = 0; e < 8; ++e) v[8 + e] = f[e]; }
    float ss = 0.f;
#pragma unroll
    for (int e = 0; e < 16; ++e) ss += v[e] * v[e];
    ss += __shfl_xor(ss, 1); ss += __shfl_xor(ss, 2); ss += __shfl_xor(ss, 4); ss += __shfl_xor(ss, 8);
    const float r = 1.0f / sqrtf(ss * (1.0f / KV_R) + EPS); const f32x4* gp = (const f32x4*)(kvn + c * 16); float o[16];
#pragma unroll
    for (int q = 0; q < 4; ++q) { const f32x4 gg = gp[q]; o[4 * q] = v[4 * q] * r * gg.x; o[4 * q + 1] = v[4 * q + 1] * r * gg.y; o[4 * q + 2] = v[4 * q + 2] * r * gg.z; o[4 * q + 3] = v[4 * q + 3] * r * gg.w; }
    u32x4 w0, w1; w0.x = pk2(o[0], o[1]); w0.y = pk2(o[2], o[3]); w0.z = pk2(o[4], o[5]); w0.w = pk2(o[6], o[7]); w1.x = pk2(o[8], o[9]); w1.y = pk2(o[10], o[11]); w1.z = pk2(o[12], o[13]); w1.w = pk2(o[14], o[15]);
    u32x4* dst = (u32x4*)(CKVC + (size_t)t * KV_R + c * 16); dst[0] = w0; dst[1] = w1;
}
__device__ __forceinline__ void prep_ik16(const bf16* __restrict__ RB, bf16* __restrict__ IKC, const float* __restrict__ ikg, const float* __restrict__ ikb, int it, int lane) {
    const int t = it * 16 + (lane >> 2), c = lane & 3; const u32x4* src = (const u32x4*)(RB + (size_t)t * NB + B_IK + c * 16); const u32x4 a = src[0], b = src[1];
    float v[16]; { float f[8]; unpack8(a, f);
#pragma unroll
        for (int e = 0; e < 8; ++e) v[e] = f[e]; unpack8(b, f);
#pragma unroll
        for (int e = 0; e < 8; ++e) v[8 + e] = f[e]; }
    float s = 0.f;
#pragma unroll
    for (int e = 0; e < 16; ++e) s += v[e];
    s += __shfl_xor(s, 1); s += __shfl_xor(s, 2); const float mu = s * (1.0f / 64.0f); float q2 = 0.f;
#pragma unroll
    for (int e = 0; e < 16; ++e) { v[e] -= mu; q2 += v[e] * v[e]; }
    q2 += __shfl_xor(q2, 1); q2 += __shfl_xor(q2, 2); const float r = 1.0f / sqrtf(q2 * (1.0f / 64.0f) + EPS); float o[16];
#pragma unroll
    for (int e = 0; e < 16; ++e) o[e] = v[e] * r * ikg[c * 16 + e] + ikb[c * 16 + e];
    u32x4 w0, w1; w0.x = pk2(o[0], o[1]); w0.y = pk2(o[2], o[3]); w0.z = pk2(o[4], o[5]); w0.w = pk2(o[6], o[7]); w1.x = pk2(o[8], o[9]); w1.y = pk2(o[10], o[11]); w1.z = pk2(o[12], o[13]); w1.w = pk2(o[14], o[15]);
    u32x4* dst = (u32x4*)(IKC + (size_t)t * 64 + c * 16); dst[0] = w0; dst[1] = w1;
}
__device__ __forceinline__ void prep_bout(bf16* RA, const bf16* __restrict__ RB, const float* __restrict__ scw, int t, int lane, bool dry = false) {
    const int s = t & (SEQ - 1), c = lane * 8; float acc[8] = {0.f, 0.f, 0.f, 0.f, 0.f, 0.f, 0.f, 0.f};
    u32x4 cg[3], hb[3];
#pragma unroll
    for (int j = 0; j < 3; ++j) { const bool ok = (s - 2 + j) >= 0; const bf16* rr = RB + (size_t)(t - 2 + j) * NB; cg[j] = ok ? *(const u32x4*)(rr + B_CG + c) : (u32x4){0u, 0u, 0u, 0u}; hb[j] = ok ? *(const u32x4*)(rr + B_HB + c) : (u32x4){0u, 0u, 0u, 0u}; }
    bf16* ra = RA + (size_t)t * NA + A_BG + c; const u32x4 bg = *(const u32x4*)ra;
#pragma unroll
    for (int j = 0; j < 3; ++j) { float a[8], b[8]; unpack8(cg[j], a); unpack8(hb[j], b); const f32x4 w0 = *(const f32x4*)(scw + j * 512 + c), w1 = *(const f32x4*)(scw + j * 512 + c + 4);
        acc[0] += w0.x * (a[0] * b[0]); acc[1] += w0.y * (a[1] * b[1]); acc[2] += w0.z * (a[2] * b[2]); acc[3] += w0.w * (a[3] * b[3]);
        acc[4] += w1.x * (a[4] * b[4]); acc[5] += w1.y * (a[5] * b[5]); acc[6] += w1.z * (a[6] * b[6]); acc[7] += w1.w * (a[7] * b[7]); }
    float g8[8]; unpack8(bg, g8); u32x4 w; w.x = pk2(g8[0] * acc[0], g8[1] * acc[1]); w.y = pk2(g8[2] * acc[2], g8[3] * acc[3]); w.z = pk2(g8[4] * acc[4], g8[5] * acc[5]); w.w = pk2(g8[6] * acc[6], g8[7] * acc[7]);
    if (!dry) *(u32x4*)ra = w;
}
__device__ __forceinline__ void prep_conv(const bf16* __restrict__ RB, bf16* __restrict__ XA, const float* __restrict__ cw, const float* __restrict__ cb, int it, int lane) {
    const int rb = it / 12, cbk = it % 12, xcol = cbk * 128 + 2 * lane, t0 = rb * 16, s0 = t0 & (SEQ - 1);
    float w0[4], w1[4];
#pragma unroll
    for (int j = 0; j < 4; ++j) { w0[j] = cw[j * XBC + xcol]; w1[j] = cw[j * XBC + xcol + 1]; }
    const float cb0 = cb[xcol], cb1 = cb[xcol + 1];
    const bf16* src = RB + (size_t)(t0 - 3) * NB + B_XBC + xcol; unsigned raw[19];
#pragma unroll
    for (int i = 0; i < 19; ++i) raw[i] = (s0 - 3 + i >= 0) ? *(const unsigned*)(src + (size_t)i * NB) : 0u;
#pragma unroll
    for (int i = 0; i < 16; ++i) { float a0 = cb0, a1 = cb1;
#pragma unroll
        for (int j = 0; j < 4; ++j) { a0 += w0[j] * __builtin_bit_cast(float, raw[i + j] << 16); a1 += w1[j] * __builtin_bit_cast(float, raw[i + j] & 0xffff0000u); }
        *(unsigned*)(XA + (size_t)(t0 + i) * XBC + xcol) = pk2(siluf_(a0), siluf_(a1)); }
}

typedef short bf16x8_t __attribute__((ext_vector_type(8)));
#ifndef SEL_REP_SEARCH
#define SEL_REP_SEARCH 1
#endif
#ifndef SEL_REP_STAGE
#define SEL_REP_STAGE 1
#endif
#define CNT8_GE(cnt, v0, v1, v2, v3, v4, v5, v6, v7, cand) do { unsigned long long m0_, m1_, m2_, m3_, m4_, m5_, m6_, m7_; \
    asm("v_cmp_ge_u32_e64 %0, %8, %16\n\tv_cmp_ge_u32_e64 %1, %9, %16\n\tv_cmp_ge_u32_e64 %2, %10, %16\n\tv_cmp_ge_u32_e64 %3, %11, %16\n\t" \
        "v_cmp_ge_u32_e64 %4, %12, %16\n\tv_cmp_ge_u32_e64 %5, %13, %16\n\tv_cmp_ge_u32_e64 %6, %14, %16\n\tv_cmp_ge_u32_e64 %7, %15, %16" \
        : "=&s"(m0_), "=&s"(m1_), "=&s"(m2_), "=&s"(m3_), "=&s"(m4_), "=&s"(m5_), "=&s"(m6_), "=&s"(m7_) \
        : "v"(v0), "v"(v1), "v"(v2), "v"(v3), "v"(v4), "v"(v5), "v"(v6), "v"(v7), "s"(cand)); \
    cnt += (__popcll(m0_) + __popcll(m1_)) + (__popcll(m2_) + __popcll(m3_)) + (__popcll(m4_) + __popcll(m5_)) + (__popcll(m6_) + __popcll(m7_)); } while (0)
constexpr int SC_STRIDE = 516, SC_BUF = 16 * SC_STRIDE;
constexpr int IKW_OFF = 66560;
__device__ __forceinline__ void wg_select16(LDSP unsigned char* lds, const bf16* __restrict__ RB, const bf16* __restrict__ IKC, unsigned short* __restrict__ idx, int unit, int tid, bool dry = false, bool lds_out = false) {
    const int lane = tid & 63, wave = __builtin_amdgcn_readfirstlane(tid >> 6), g = lane >> 4, c = lane & 15;
    const int b = unit >> 8, qg = unit & 255, t0 = b * SEQ + qg * 16, nk = ((qg >> 2) + 1) << 6, nr = nk >> 6;
    LDSP unsigned* SC = (LDSP unsigned*)lds;
    bf16x8_t bq[4][2]; float iwq[4];
    { const bf16* qr = RB + (size_t)(t0 + c) * NB;
#pragma unroll
      for (int h = 0; h < 4; ++h) { bq[h][0] = *(const bf16x8_t*)(qr + B_IQ + h * 64 + g * 8); bq[h][1] = *(const bf16x8_t*)(qr + B_IQ + h * 64 + 32 + g * 8); iwq[h] = bf2f(qr[B_IW + h]) * 0.0625f; } }
    unsigned val[2][64];
#pragma unroll
    for (int r = 0; r < 64; ++r) { val[0][r] = 0u; val[1][r] = 0u; }
    const bf16* ikb = IKC + (size_t)b * SEQ * 64;
    LDSP unsigned char* ikw = lds + IKW_OFF + wave * 8192;
#define IK_DMA(stage) do { if ((stage) * 512 + wave * 64 < nk) { const bf16* src_ = ikb + (size_t)((stage) * 512 + wave * 64) * 64 + lane * 8; _Pragma("unroll") for (int pc_ = 0; pc_ < 8; ++pc_) \
        __builtin_amdgcn_global_load_lds((const unsigned*)(src_ + pc_ * 512), (LDSP unsigned*)(ikw + pc_ * 1024), 16, 0, 0); } } while (0)
    IK_DMA(0);
    for (int rep_st = 0; rep_st < SEL_REP_STAGE; ++rep_st) {
    if (rep_st > 0) { asm volatile("s_waitcnt vmcnt(0)" ::: "memory"); __builtin_amdgcn_s_barrier(); IK_DMA(0); }
#pragma unroll
    for (int s = 0; s < 8; ++s) {
        if (s * 512 < nk) {
            LDSP unsigned* buf = SC + (s & 1) * SC_BUF;
            asm volatile("s_waitcnt vmcnt(0)" ::: "memory");
            bf16x8_t af[4][2];
#pragma unroll
            for (int i = 0; i < 4; ++i) { af[i][0] = *(const LDSP bf16x8_t*)(ikw + (16 * i + c) * 128 + g * 16); af[i][1] = *(const LDSP bf16x8_t*)(ikw + (16 * i + c) * 128 + 64 + g * 16); }
            asm volatile("s_waitcnt lgkmcnt(0)" ::: "memory");
            if (s < 7) IK_DMA(s + 1);
#pragma unroll
            for (int i = 0; i < 4; ++i) { const int tl = wave * 4 + i, kb = s * 512 + tl * 16;
                if (kb < nk) {
                    const bf16x8_t a0 = af[i][0], a1 = af[i][1];
                    float sc[4] = {0.f, 0.f, 0.f, 0.f};
#pragma unroll
                    for (int h = 0; h < 4; ++h) { pg8::f32x4 acc = {0.f, 0.f, 0.f, 0.f};
                        acc = __builtin_amdgcn_mfma_f32_16x16x32_bf16(a0, bq[h][0], acc, 0, 0, 0); acc = __builtin_amdgcn_mfma_f32_16x16x32_bf16(a1, bq[h][1], acc, 0, 0, 0);
#pragma unroll
                        for (int e = 0; e < 4; ++e) sc[e] += fmaxf(acc[e], 0.f) * iwq[h]; }
                    u32x4 kv; kv.x = ord_key(sc[0]); kv.y = ord_key(sc[1]); kv.z = ord_key(sc[2]); kv.w = ord_key(sc[3]);
                    *(LDSP u32x4*)(buf + c * SC_STRIDE + tl * 16 + 4 * g) = kv; } }
            asm volatile("s_waitcnt lgkmcnt(0)" ::: "memory"); __builtin_amdgcn_s_barrier(); asm volatile("" ::: "memory");
#pragma unroll
            for (int j = 0; j < 8; ++j) if (s * 512 + j * 64 < nk) { val[0][s * 8 + j] = buf[(2 * wave) * SC_STRIDE + j * 64 + lane]; val[1][s * 8 + j] = buf[(2 * wave + 1) * SC_STRIDE + j * 64 + lane]; }
            asm volatile("s_waitcnt lgkmcnt(0)" ::: "memory");
        }
    }
    }
    const unsigned long long lt = (1ull << lane) - 1ull;
#pragma unroll
    for (int qq = 0; qq < 2; ++qq) {
        unsigned Tt = 0u;
        for (int rep_se = 0; rep_se < SEL_REP_SEARCH; ++rep_se) { Tt = 0u; asm volatile("" : "+v"(val[qq][0]));
        if (nk > TOPK) {
            for (int bit = 31; bit >= 0; --bit) { const unsigned cand = Tt | (1u << bit); int cnt = 0;
#pragma unroll
                for (int r8 = 0; r8 < 8; ++r8) if (r8 * 8 < nr) CNT8_GE(cnt, val[qq][r8 * 8], val[qq][r8 * 8 + 1], val[qq][r8 * 8 + 2], val[qq][r8 * 8 + 3], val[qq][r8 * 8 + 4], val[qq][r8 * 8 + 5], val[qq][r8 * 8 + 6], val[qq][r8 * 8 + 7], cand);
                if (cnt >= TOPK) Tt = cand; if (cnt == TOPK) break; }
        }
        }
        unsigned short* orow = idx + (size_t)(t0 + 2 * wave + qq) * TOPK;
        LDSP unsigned short* orow_l = (LDSP unsigned short*)(lds + 134 * 1024) + (2 * wave + qq) * TOPK;
        int pos = 0;
#define PUT_KEY(o_, key_) do { if ((o_) < TOPK && !dry) { if (lds_out) orow_l[o_] = (unsigned short)(key_); else orow[o_] = (unsigned short)(key_); } } while (0)
#pragma unroll
        for (int r8 = 0; r8 < 8; ++r8) if (r8 * 8 < nr) { unsigned long long k0, k1, k2, k3, k4, k5, k6, k7;
            asm("v_cmp_gt_u32_e64 %0, %8, %16\n\tv_cmp_gt_u32_e64 %1, %9, %16\n\tv_cmp_gt_u32_e64 %2, %10, %16\n\tv_cmp_gt_u32_e64 %3, %11, %16\n\t"
                "v_cmp_gt_u32_e64 %4, %12, %16\n\tv_cmp_gt_u32_e64 %5, %13, %16\n\tv_cmp_gt_u32_e64 %6, %14, %16\n\tv_cmp_gt_u32_e64 %7, %15, %16"
                : "=&s"(k0), "=&s"(k1), "=&s"(k2), "=&s"(k3), "=&s"(k4), "=&s"(k5), "=&s"(k6), "=&s"(k7)
                : "v"(val[qq][r8 * 8]), "v"(val[qq][r8 * 8 + 1]), "v"(val[qq][r8 * 8 + 2]), "v"(val[qq][r8 * 8 + 3]), "v"(val[qq][r8 * 8 + 4]), "v"(val[qq][r8 * 8 + 5]), "v"(val[qq][r8 * 8 + 6]), "v"(val[qq][r8 * 8 + 7]), "s"(Tt));
#define PUT_MASK(m_, i_) do { if ((m_) != 0ull) { if (((m_) >> lane) & 1ull) { const int o = pos + __popcll((m_) & lt); PUT_KEY(o, (r8 * 8 + (i_)) * 64 + lane); } pos += __popcll(m_); } } while (0)
            PUT_MASK(k0, 0); PUT_MASK(k1, 1); PUT_MASK(k2, 2); PUT_MASK(k3, 3); PUT_MASK(k4, 4); PUT_MASK(k5, 5); PUT_MASK(k6, 6); PUT_MASK(k7, 7);
#undef PUT_MASK
        }
        int need = TOPK - pos;
        if (need > 0) {
#pragma unroll
            for (int r = 0; r < 64; ++r) if (r < nr && need > 0) { const unsigned long long meq = __ballot(val[qq][r] == Tt);
                if (meq != 0ull) { const int rank = __popcll(meq & lt); if (((meq >> lane) & 1ull) && rank < need) { PUT_KEY(pos + rank, r * 64 + lane); } const int tk = __popcll(meq); const int tkn = tk < need ? tk : need; pos += tkn; need -= tkn; } }
        }
#undef PUT_KEY
    }
    asm volatile("s_waitcnt vmcnt(0) lgkmcnt(0)" ::: "memory"); __builtin_amdgcn_s_barrier();
#undef IK_DMA
}

typedef unsigned short u16x4_t __attribute__((ext_vector_type(4)));
#ifndef ATT_LOCAL_DRY
#define ATT_LOCAL_DRY 0
#endif
#ifndef ATT_STAGGER
#define ATT_STAGGER 0
#endif
#ifndef ATT_DRY_SKIP
#define ATT_DRY_SKIP 0
#endif
#define DSK(b) (ATT_DRY_SKIP & (b)) && dry
#ifndef ATT_SUB_EN
#define ATT_SUB_EN 0
#endif
constexpr int SELW_OFF = 134 * 1024, BT_OFF = 142 * 1024, KVP = 528, TILE_STRIDE = 32 * KVP;
constexpr int SELW_OFF_OLD = 132 * 1024, BT_OFF_OLD = 140 * 1024;
__device__ __forceinline__ int kv_off(int row, int ch) { const int hf = ch >> 4, c16 = ch & 15; return hf * 8192 + 256 * row + 16 * (c16 ^ (((row & 3) << 2) | ((row >> 2) & 3))); }
#define TR4I(d0, d1, d2, d3, base, o0, o1, o2, o3) asm volatile("ds_read_b64_tr_b16 %0, %4 offset:%5\n\tds_read_b64_tr_b16 %1, %4 offset:%6\n\tds_read_b64_tr_b16 %2, %4 offset:%7\n\tds_read_b64_tr_b16 %3, %4 offset:%8" \
    : "=&v"(d0), "=&v"(d1), "=&v"(d2), "=&v"(d3) : "v"(base), "i"(o0), "i"(o1), "i"(o2), "i"(o3) : "memory")
#define TR8N(d0, d1, d2, d3, d4, d5, d6, d7, base, o0, o1, o2, o3, o4, o5, o6, o7) asm volatile( \
    "ds_read_b64_tr_b16 %0, %8 offset:%9\n\tds_read_b64_tr_b16 %1, %8 offset:%10\n\tds_read_b64_tr_b16 %2, %8 offset:%11\n\tds_read_b64_tr_b16 %3, %8 offset:%12\n\t" \
    "ds_read_b64_tr_b16 %4, %8 offset:%13\n\tds_read_b64_tr_b16 %5, %8 offset:%14\n\tds_read_b64_tr_b16 %6, %8 offset:%15\n\tds_read_b64_tr_b16 %7, %8 offset:%16" \
    : "=&v"(d0), "=&v"(d1), "=&v"(d2), "=&v"(d3), "=&v"(d4), "=&v"(d5), "=&v"(d6), "=&v"(d7) : "v"(base), "i"(o0), "i"(o1), "i"(o2), "i"(o3), "i"(o4), "i"(o5), "i"(o6), "i"(o7) : "memory")
#define WAITPIN8(n, d0, d1, d2, d3, d4, d5, d6, d7) asm volatile("s_waitcnt lgkmcnt(" #n ")" : "+v"(d0), "+v"(d1), "+v"(d2), "+v"(d3), "+v"(d4), "+v"(d5), "+v"(d6), "+v"(d7) :: "memory")
#define WAITPIN4(n, d0, d1, d2, d3) asm volatile("s_waitcnt lgkmcnt(" #n ")" : "+v"(d0), "+v"(d1), "+v"(d2), "+v"(d3) :: "memory")
__device__ __forceinline__ bf16x8_t mk8a(u16x4_t a, u16x4_t b) { bf16x8_t r; r[0] = a[0]; r[1] = a[1]; r[2] = a[2]; r[3] = a[3]; r[4] = b[0]; r[5] = b[1]; r[6] = b[2]; r[7] = b[3]; return r; }
#define TR8I(d0, d1, d2, d3, d4, d5, d6, d7, base, o0, o1, o2, o3, o4, o5, o6, o7) asm volatile( \
    "ds_read_b64_tr_b16 %0, %8 offset:%9\n\tds_read_b64_tr_b16 %1, %8 offset:%10\n\tds_read_b64_tr_b16 %2, %8 offset:%11\n\tds_read_b64_tr_b16 %3, %8 offset:%12\n\t" \
    "ds_read_b64_tr_b16 %4, %8 offset:%13\n\tds_read_b64_tr_b16 %5, %8 offset:%14\n\tds_read_b64_tr_b16 %6, %8 offset:%15\n\tds_read_b64_tr_b16 %7, %8 offset:%16\n\ts_waitcnt lgkmcnt(0)" \
    : "=&v"(d0), "=&v"(d1), "=&v"(d2), "=&v"(d3), "=&v"(d4), "=&v"(d5), "=&v"(d6), "=&v"(d7) : "v"(base), "i"(o0), "i"(o1), "i"(o2), "i"(o3), "i"(o4), "i"(o5), "i"(o6), "i"(o7) : "memory")
#define TR8(d0, d1, d2, d3, d4, d5, d6, d7, a0, a1, a2, a3, a4, a5, a6, a7) asm volatile( \
    "ds_read_b64_tr_b16 %0, %8\n\tds_read_b64_tr_b16 %1, %9\n\tds_read_b64_tr_b16 %2, %10\n\tds_read_b64_tr_b16 %3, %11\n\t" \
    "ds_read_b64_tr_b16 %4, %12\n\tds_read_b64_tr_b16 %5, %13\n\tds_read_b64_tr_b16 %6, %14\n\tds_read_b64_tr_b16 %7, %15\n\ts_waitcnt lgkmcnt(0)" \
    : "=&v"(d0), "=&v"(d1), "=&v"(d2), "=&v"(d3), "=&v"(d4), "=&v"(d5), "=&v"(d6), "=&v"(d7) : "v"(a0), "v"(a1), "v"(a2), "v"(a3), "v"(a4), "v"(a5), "v"(a6), "v"(a7) : "memory")
__device__ __forceinline__ void wg_attn16(LDSP unsigned char* lds, bf16* RA, const bf16* __restrict__ CKVC, const unsigned short* __restrict__ idx, const bf16* __restrict__ WUK, const bf16* __restrict__ WUV,
                                          const float* __restrict__ rel_bias, int unit, int nxt_unit, int par, bool first, int tid, bool dry = false, int qmode = 0, bf16* qscr = nullptr) {
    const int lane = tid & 63, wave = __builtin_amdgcn_readfirstlane(tid >> 6), g = lane >> 4, c = lane & 15;
    const int b = unit >> 9, qg = unit & 511, t0 = b * SEQ + qg * 8, nk = ((qg >> 3) + 1) << 6, nsel = nk < TOPK ? nk : TOPK, ntile = nsel >> 5;
    LDSP unsigned char* QL = lds;
    LDSP unsigned char* tile = lds + wave * TILE_STRIDE;
    LDSP unsigned short* selw = (LDSP unsigned short*)(lds + SELW_OFF + (par * 8 + wave) * 512);
    LDSP unsigned short* selw_n = (LDSP unsigned short*)(lds + SELW_OFF + ((par ^ 1) * 8 + wave) * 512);
    if (first) { if (lane < 32) *((LDSP u32x4*)selw + lane) = *((const u32x4*)(idx + (size_t)(t0 + wave) * TOPK) + lane); }
    const bf16* kvb = CKVC + (size_t)b * SEQ * KV_R + g * 8;
    bf16x8_t kv0[8], kv1[8];
#define KV_LOAD(dst, key) do { const bf16* rp_ = kvb + (size_t)(key) * KV_R; _Pragma("unroll") for (int ks_ = 0; ks_ < 8; ++ks_) dst[ks_] = *(const bf16x8_t*)(rp_ + ks_ * 32); } while (0)
    int ka = (int)selw[c], kb = (int)selw[16 + c];
    KV_LOAD(kv0, ka); KV_LOAD(kv1, kb);
    bf16x8_t qf[8];
    if (qmode != 2) {
        const int h = wave; const bf16* qr = RA + (size_t)(t0 + (qmode == 1 ? c : (c & 7))) * NA + A_Q + h * 64 + g * 8;
        const bf16x8_t b0 = *(const bf16x8_t*)qr, b1 = *(const bf16x8_t*)(qr + 32);
        const bf16* wb = WUK + ((size_t)h * 256 + c) * 64 + g * 8;
#pragma unroll 4
        for (int rt = 0; rt < 16; ++rt) { const bf16x8_t a0 = *(const bf16x8_t*)(wb + rt * 16 * 64), a1 = *(const bf16x8_t*)(wb + rt * 16 * 64 + 32);
            pg8::f32x4 acc = {0.f, 0.f, 0.f, 0.f};
            acc = __builtin_amdgcn_mfma_f32_16x16x32_bf16(a0, b0, acc, 0, 0, 0); acc = __builtin_amdgcn_mfma_f32_16x16x32_bf16(a1, b1, acc, 0, 0, 0);
            u32x2 w; w.x = pk2(acc[0], acc[1]); w.y = pk2(acc[2], acc[3]);
            if (c < 8) *(LDSP u32x2*)(QL + (((c * 8 + h) * 256) + rt * 16 + 4 * g) * 2) = w;
            else if (qmode == 1) *(u32x2*)(qscr + ((((c - 8) * 8 + h) * 256) + rt * 16 + 4 * g)) = w; }
        asm volatile("s_waitcnt lgkmcnt(0)" ::: "memory"); __builtin_amdgcn_s_barrier(); asm volatile("" ::: "memory");
#pragma unroll
        for (int ks = 0; ks < 8; ++ks) qf[ks] = *(const LDSP bf16x8_t*)(QL + (((wave * 8 + (c & 7)) * 256) + ks * 32 + g * 8) * 2);
        asm volatile("s_waitcnt lgkmcnt(0)" ::: "memory"); __builtin_amdgcn_s_barrier(); asm volatile("" ::: "memory");
    } else {
        const unsigned long long* qs = (const unsigned long long*)(qscr + (((wave * 8 + (c & 7)) * 256) + g * 8));
#pragma unroll
        for (int ks = 0; ks < 8; ++ks) { const unsigned long long lo = __hip_atomic_load(qs + ks * 8, __ATOMIC_RELAXED, __HIP_MEMORY_SCOPE_AGENT), hi = __hip_atomic_load(qs + ks * 8 + 1, __ATOMIC_RELAXED, __HIP_MEMORY_SCOPE_AGENT);
            u32x4 w; w.x = (unsigned)lo; w.y = (unsigned)(lo >> 32); w.z = (unsigned)hi; w.w = (unsigned)(hi >> 32); qf[ks] = __builtin_bit_cast(bf16x8_t, w); }
    }
    const unsigned tile_a = (unsigned)(size_t)tile;
#if ATT_STAGGER
    if (wave >= 4) __builtin_amdgcn_s_sleep(ATT_STAGGER);
#endif
    bf16x8_t bbf; { float bv[8];
#pragma unroll
        for (int j = 0; j < 8; ++j) bv[j] = rel_bias[(8 * g + j) * 8 + (c & 7)];
        u32x4 w; w.x = pk2(bv[0], bv[1]); w.y = pk2(bv[2], bv[3]); w.z = pk2(bv[4], bv[5]); w.w = pk2(bv[6], bv[7]); bbf = __builtin_bit_cast(bf16x8_t, w); }
    {
        const int spos = (qg * 8 + wave);
        pg8::f32x4 acc[16];
#pragma unroll
        for (int nt = 0; nt < 16; ++nt) acc[nt] = (pg8::f32x4){0.f, 0.f, 0.f, 0.f};
        float m_run = -INFINITY, l_run = 0.f;
#define ONEHOT(dst, key) do { const int rel_ = (key) - spos, n_ = rel_ < 0 ? -rel_ : rel_; \
            const int big_ = 8 + (n_ >= 15) + (n_ >= 27) + (n_ >= 50) + (n_ >= 91) + (n_ >= 166) + (n_ >= 305) + (n_ >= 559); \
            const int pos_ = (n_ < 8 ? n_ : big_) + (rel_ > 0 ? 16 : 0) - 8 * g; const unsigned one_ = (pos_ & 1) ? 0x3F800000u : 0x3F80u; const int hi_ = pos_ >> 1; \
            u32x4 w_; w_.x = (hi_ == 0) ? one_ : 0u; w_.y = (hi_ == 1) ? one_ : 0u; w_.z = (hi_ == 2) ? one_ : 0u; w_.w = (hi_ == 3) ? one_ : 0u; dst = __builtin_bit_cast(bf16x8_t, w_); } while (0)
        const int q4 = c >> 2, p = c & 3;
        const unsigned trb = tile_a + (4 * g + q4) * KVP + 8 * p;
        for (int tl = 0; tl < ntile; ++tl) {
            int kan = 0, kbn = 0; const bool more = tl + 1 < ntile;
            if (more) { kan = (int)selw[(2 * tl + 2) * 16 + c]; kbn = (int)selw[(2 * tl + 3) * 16 + c]; }
            bf16x8_t oha, ohb; ONEHOT(oha, ka); ONEHOT(ohb, kb);
            asm volatile("s_waitcnt vmcnt(8)" ::: "memory");
            pg8::f32x4 s0 = {0.f, 0.f, 0.f, 0.f}, s1 = {0.f, 0.f, 0.f, 0.f};
            s0 = __builtin_amdgcn_mfma_f32_16x16x32_bf16(oha, bbf, s0, 0, 0, 0);
#pragma unroll
            for (int ks = 0; ks < 8; ++ks) { s0 = __builtin_amdgcn_mfma_f32_16x16x32_bf16(kv0[ks], qf[ks], s0, 0, 0, 0); *(LDSP bf16x8_t*)(tile + c * KVP + g * 16 + ks * 64) = kv0[ks]; }
            if (more) KV_LOAD(kv0, kan);
            if (more) asm volatile("s_waitcnt vmcnt(8)" ::: "memory"); else asm volatile("s_waitcnt vmcnt(0)" ::: "memory");
            s1 = __builtin_amdgcn_mfma_f32_16x16x32_bf16(ohb, bbf, s1, 0, 0, 0);
#pragma unroll
            for (int ks = 0; ks < 8; ++ks) { s1 = __builtin_amdgcn_mfma_f32_16x16x32_bf16(kv1[ks], qf[ks], s1, 0, 0, 0); *(LDSP bf16x8_t*)(tile + (16 + c) * KVP + g * 16 + ks * 64) = kv1[ks]; }
            if (more) KV_LOAD(kv1, kbn);
            ka = kan; kb = kbn;
            float sv[8];
#pragma unroll
            for (int j = 0; j < 4; ++j) { sv[j] = s0[j]; sv[4 + j] = s1[j]; }
            float tmax = fmaxf(fmaxf(fmaxf(sv[0], sv[1]), fmaxf(sv[2], sv[3])), fmaxf(fmaxf(sv[4], sv[5]), fmaxf(sv[6], sv[7])));
            tmax = fmaxf(tmax, __shfl_xor(tmax, 16)); tmax = fmaxf(tmax, __shfl_xor(tmax, 32));
            const float m_new = fmaxf(m_run, tmax); const float scl = __expf(m_run - m_new); const bool grow = m_new > m_run; m_run = m_new;
            float ps = 0.f;
#pragma unroll
            for (int j = 0; j < 8; ++j) { sv[j] = __expf(sv[j] - m_new); ps += sv[j]; }
            l_run = l_run * scl + ps;
            bf16x8_t pf; { u32x4 w; w.x = pk2(sv[0], sv[1]); w.y = pk2(sv[2], sv[3]); w.z = pk2(sv[4], sv[5]); w.w = pk2(sv[6], sv[7]); pf = __builtin_bit_cast(bf16x8_t, w); }
            if (__builtin_amdgcn_ballot_w64(grow) != 0ull) {
                float rs[4];
#pragma unroll
                for (int e = 0; e < 4; ++e) rs[e] = __shfl(scl, 4 * g + e);
#pragma unroll
                for (int nt = 0; nt < 16; ++nt) {
#pragma unroll
                    for (int e = 0; e < 4; ++e) acc[nt][e] *= rs[e]; } }
            asm volatile("s_waitcnt lgkmcnt(0)" ::: "memory");
            u16x4_t va[8], vb[8];
            TR8N(va[0], va[1], va[2], va[3], va[4], va[5], va[6], va[7], trb, 0, 16 * KVP, 32, 32 + 16 * KVP, 64, 64 + 16 * KVP, 96, 96 + 16 * KVP);
            TR8N(vb[0], vb[1], vb[2], vb[3], vb[4], vb[5], vb[6], vb[7], trb, 128, 128 + 16 * KVP, 160, 160 + 16 * KVP, 192, 192 + 16 * KVP, 224, 224 + 16 * KVP);
            WAITPIN8(8, va[0], va[1], va[2], va[3], va[4], va[5], va[6], va[7]);
#pragma unroll
            for (int k = 0; k < 4; ++k) acc[k] = __builtin_amdgcn_mfma_f32_16x16x32_bf16(pf, mk8a(va[2 * k], va[2 * k + 1]), acc[k], 0, 0, 0);
            TR8N(va[0], va[1], va[2], va[3], va[4], va[5], va[6], va[7], trb, 256, 256 + 16 * KVP, 288, 288 + 16 * KVP, 320, 320 + 16 * KVP, 352, 352 + 16 * KVP);
            WAITPIN8(8, vb[0], vb[1], vb[2], vb[3], vb[4], vb[5], vb[6], vb[7]);
#pragma unroll
            for (int k = 0; k < 4; ++k) acc[4 + k] = __builtin_amdgcn_mfma_f32_16x16x32_bf16(pf, mk8a(vb[2 * k], vb[2 * k + 1]), acc[4 + k], 0, 0, 0);
            TR8N(vb[0], vb[1], vb[2], vb[3], vb[4], vb[5], vb[6], vb[7], trb, 384, 384 + 16 * KVP, 416, 416 + 16 * KVP, 448, 448 + 16 * KVP, 480, 480 + 16 * KVP);
            WAITPIN8(8, va[0], va[1], va[2], va[3], va[4], va[5], va[6], va[7]);
#pragma unroll
            for (int k = 0; k < 4; ++k) acc[8 + k] = __builtin_amdgcn_mfma_f32_16x16x32_bf16(pf, mk8a(va[2 * k], va[2 * k + 1]), acc[8 + k], 0, 0, 0);
            WAITPIN8(0, vb[0], vb[1], vb[2], vb[3], vb[4], vb[5], vb[6], vb[7]);
#pragma unroll
            for (int k = 0; k < 4; ++k) acc[12 + k] = __builtin_amdgcn_mfma_f32_16x16x32_bf16(pf, mk8a(vb[2 * k], vb[2 * k + 1]), acc[12 + k], 0, 0, 0);
        }
#undef KV_LOAD
#undef ONEHOT
        float lt = l_run + __shfl_xor(l_run, 16); lt += __shfl_xor(lt, 32); const float inv = 1.0f / lt;
        float ri[4];
#pragma unroll
        for (int e = 0; e < 4; ++e) ri[e] = __shfl(inv, 4 * g + e);
        if (g < 2) {
#pragma unroll
            for (int nt = 0; nt < 16; ++nt) { LDSP unsigned short* o1 = (LDSP unsigned short*)(tile) + (4 * g) * 256 + nt * 16 + c;
                o1[0] = f2bf(acc[nt][0] * ri[0]); o1[256] = f2bf(acc[nt][1] * ri[1]); o1[512] = f2bf(acc[nt][2] * ri[2]); o1[768] = f2bf(acc[nt][3] * ri[3]); }
        }
    }
    u32x4 nsel_v = {0u, 0u, 0u, 0u};
    if (nxt_unit >= 0 && lane < 32) { const int nb = nxt_unit >> 9, nq = nxt_unit & 511; nsel_v = *((const u32x4*)(idx + (size_t)(nb * SEQ + nq * 8 + wave) * TOPK) + lane); }
    asm volatile("s_waitcnt lgkmcnt(0)" ::: "memory"); __builtin_amdgcn_s_barrier(); asm volatile("" ::: "memory");
    if (qmode == 1) {
        bf16* oscr = qscr + 16384;
#pragma unroll
        for (int j = 0; j < 4; ++j) *((u32x4*)(oscr + (size_t)wave * 2048) + j * 64 + lane) = *((const LDSP u32x4*)(tile) + j * 64 + lane);
    } else {
        const int h = wave; pg8::f32x4 o[4];
#pragma unroll
        for (int nt = 0; nt < 4; ++nt) o[nt] = (pg8::f32x4){0.f, 0.f, 0.f, 0.f};
        const LDSP unsigned char* ab = lds + TILE_STRIDE * (c & 7) + (h * 256 + g * 8) * 2;
        const unsigned long long* os = (const unsigned long long*)(qscr + 16384 + ((c & 7) * 8 + h) * 256 + g * 8);
        const bf16* wb = WUV + ((size_t)h * 64 + c) * 256 + g * 8;
        const bool from_scr = (qmode == 2) && (c < 8);
#pragma unroll
        for (int ks = 0; ks < 8; ++ks) { bf16x8_t a;
            if (from_scr) { const unsigned long long lo = __hip_atomic_load(os + ks * 8, __ATOMIC_RELAXED, __HIP_MEMORY_SCOPE_AGENT), hi = __hip_atomic_load(os + ks * 8 + 1, __ATOMIC_RELAXED, __HIP_MEMORY_SCOPE_AGENT);
                u32x4 w; w.x = (unsigned)lo; w.y = (unsigned)(lo >> 32); w.z = (unsigned)hi; w.w = (unsigned)(hi >> 32); a = __builtin_bit_cast(bf16x8_t, w); }
            else a = *(const LDSP bf16x8_t*)(ab + ks * 64);
#pragma unroll
            for (int nt = 0; nt < 4; ++nt) { const bf16x8_t bw = *(const bf16x8_t*)(wb + (size_t)nt * 16 * 256 + ks * 32); o[nt] = __builtin_amdgcn_mfma_f32_16x16x32_bf16(a, bw, o[nt], 0, 0, 0); } }
        const int rbase = (qmode == 2) ? t0 - 8 : t0;
        if ((g < 2 || qmode == 2) && !dry) {
#pragma unroll
            for (int nt = 0; nt < 4; ++nt)
#pragma unroll
                for (int e = 0; e < 4; ++e) RA[(size_t)(rbase + 4 * g + e) * NA + A_Q + h * 64 + nt * 16 + c] = f2bf(o[nt][e]); }
    }
    if (nxt_unit >= 0 && lane < 32) *((LDSP u32x4*)selw_n + lane) = nsel_v;
    asm volatile("s_waitcnt vmcnt(0) lgkmcnt(0)" ::: "memory"); __builtin_amdgcn_s_barrier(); asm volatile("" ::: "memory");
}

template <int VAR = 0> __device__ __forceinline__ void wg_attn16d(LDSP unsigned char* lds, bf16* RA, const bf16* __restrict__ CKVC, const unsigned short* __restrict__ idx, const bf16* __restrict__ WUK, const bf16* __restrict__ WUV,
                                          const float* __restrict__ rel_bias, int unit, int nxt_unit, int par, bool first, int tid, bool dry = false, int qmode = 0, bf16* qscr = nullptr) {
    const int lane = tid & 63, wave = __builtin_amdgcn_readfirstlane(tid >> 6), g = lane >> 4, c = lane & 15;
    const int b = unit >> 9, qg = unit & 511, t0 = b * SEQ + qg * 8, nk = ((qg >> 3) + 1) << 6, nsel = nk < TOPK ? nk : TOPK, ntile = nsel >> 5;
    LDSP unsigned char* QL = lds;
    LDSP unsigned char* tile = lds + wave * TILE_STRIDE;
    LDSP unsigned short* selw = (LDSP unsigned short*)(lds + SELW_OFF + (par * 8 + wave) * 512);
    LDSP unsigned short* selw_n = (LDSP unsigned short*)(lds + SELW_OFF + ((par ^ 1) * 8 + wave) * 512);
    if (first) { if (lane < 32) *((LDSP u32x4*)selw + lane) = *((const u32x4*)(idx + (size_t)(t0 + wave) * TOPK) + lane); }
    const bf16* kvb = CKVC + (size_t)b * SEQ * KV_R;
    const int nstep = (VAR & 64) ? 0 : (nsel >> 4);
    constexpr bool halfdma = (VAR & 1) != 0, nodma = (VAR & 2) != 0, nolds = (VAR & 4) != 0, nopv = (VAR & 8) != 0, noqk = (VAR & 16) != 0, nosm = (VAR & 32) != 0;
#define KV_DMA(step) do { if (nodma) break; LDSP unsigned char* sl_ = tile + ((step) & 1) * 8192; \
        _Pragma("unroll") for (int i4_ = 0; i4_ < 4; ++i4_) { const int row_ = 4 * i4_ + g; const int key_ = (int)selw[(step) * 16 + row_]; const int c16_ = c ^ ((g << 2) | i4_); \
            const bf16* src_ = kvb + (size_t)key_ * KV_R + c16_ * 8; \
            __builtin_amdgcn_global_load_lds((const unsigned*)src_, (LDSP unsigned*)(sl_ + 1024 * i4_), 16, 0, 0); \
            if (!halfdma) __builtin_amdgcn_global_load_lds((const unsigned*)(src_ + 128), (LDSP unsigned*)(sl_ + 4096 + 1024 * i4_), 16, 0, 0); } } while (0)
    if (nstep > 0) KV_DMA(0);
    bf16x8_t qf[8];
    if (qmode != 2) {
        const int h = wave; const bf16* qr = RA + (size_t)(t0 + (qmode == 1 ? c : (c & 7))) * NA + A_Q + h * 64 + g * 8;
        const bf16x8_t b0 = *(const bf16x8_t*)qr, b1 = *(const bf16x8_t*)(qr + 32);
        const bf16* wb = WUK + ((size_t)h * 256 + c) * 64 + g * 8;
#pragma unroll 4
        for (int rt = 0; rt < 16; ++rt) { const bf16x8_t a0 = *(const bf16x8_t*)(wb + rt * 16 * 64), a1 = *(const bf16x8_t*)(wb + rt * 16 * 64 + 32);
            pg8::f32x4 acc = {0.f, 0.f, 0.f, 0.f};
            acc = __builtin_amdgcn_mfma_f32_16x16x32_bf16(a0, b0, acc, 0, 0, 0); acc = __builtin_amdgcn_mfma_f32_16x16x32_bf16(a1, b1, acc, 0, 0, 0);
            u32x2 w; w.x = pk2(acc[0], acc[1]); w.y = pk2(acc[2], acc[3]);
            if (c < 8) *(LDSP u32x2*)(lds + c * TILE_STRIDE + 8192 + ((h * 256) + rt * 16 + 4 * g) * 2) = w;
            else if (qmode == 1) *(u32x2*)(qscr + ((((c - 8) * 8 + h) * 256) + rt * 16 + 4 * g)) = w; }
        asm volatile("s_waitcnt lgkmcnt(0)" ::: "memory"); __builtin_amdgcn_s_barrier(); asm volatile("" ::: "memory");
#pragma unroll
        for (int ks = 0; ks < 8; ++ks) qf[ks] = *(const LDSP bf16x8_t*)(tile + 8192 + (((c & 7) * 256) + ks * 32 + g * 8) * 2);
        asm volatile("s_waitcnt lgkmcnt(0)" ::: "memory");
    } else {
        const unsigned long long* qs = (const unsigned long long*)(qscr + (((wave * 8 + (c & 7)) * 256) + g * 8));
#pragma unroll
        for (int ks = 0; ks < 8; ++ks) { const unsigned long long lo = __hip_atomic_load(qs + ks * 8, __ATOMIC_RELAXED, __HIP_MEMORY_SCOPE_AGENT), hi = __hip_atomic_load(qs + ks * 8 + 1, __ATOMIC_RELAXED, __HIP_MEMORY_SCOPE_AGENT);
            u32x4 w; w.x = (unsigned)lo; w.y = (unsigned)(lo >> 32); w.z = (unsigned)hi; w.w = (unsigned)(hi >> 32); qf[ks] = __builtin_bit_cast(bf16x8_t, w); }
    }
    const unsigned tile_a = (unsigned)(size_t)tile;
#if ATT_STAGGER
    if (wave >= 4) __builtin_amdgcn_s_sleep(ATT_STAGGER);
#endif
    bf16x8_t bbf; { float bv[8];
#pragma unroll
        for (int j = 0; j < 8; ++j) bv[j] = rel_bias[(8 * g + j) * 8 + (c & 7)];
        u32x4 w; w.x = pk2(bv[0], bv[1]); w.y = pk2(bv[2], bv[3]); w.z = pk2(bv[4], bv[5]); w.w = pk2(bv[6], bv[7]); bbf = __builtin_bit_cast(bf16x8_t, w); }
    {
        const int spos = (qg * 8 + wave);
        pg8::f32x4 acc[16];
#pragma unroll
        for (int nt = 0; nt < 16; ++nt) acc[nt] = (pg8::f32x4){0.f, 0.f, 0.f, 0.f};
        float m_run = -INFINITY, l_run = 0.f;
#define ONEHOT(dst, key) do { const int rel_ = (key) - spos, n_ = rel_ < 0 ? -rel_ : rel_; \
            const int big_ = 8 + (n_ >= 15) + (n_ >= 27) + (n_ >= 50) + (n_ >= 91) + (n_ >= 166) + (n_ >= 305) + (n_ >= 559); \
            const int pos_ = (n_ < 8 ? n_ : big_) + (rel_ > 0 ? 16 : 0) - 8 * g; const unsigned one_ = (pos_ & 1) ? 0x3F800000u : 0x3F80u; const int hi_ = pos_ >> 1; \
            u32x4 w_; w_.x = (hi_ == 0) ? one_ : 0u; w_.y = (hi_ == 1) ? one_ : 0u; w_.z = (hi_ == 2) ? one_ : 0u; w_.w = (hi_ == 3) ? one_ : 0u; dst = __builtin_bit_cast(bf16x8_t, w_); } while (0)
        const int q4 = c >> 2, p = c & 3;
        const unsigned rd0 = tile_a + 256 * c + 16 * (g ^ (c >> 2)); const unsigned rx = (unsigned)(c & 3);
        const unsigned tr0 = tile_a + 256 * (4 * g + q4) + 8 * (p & 1); const unsigned ts = (unsigned)(((q4 << 2) | g)), tb0 = (unsigned)(p >> 1);
        if (nstep > 1) KV_DMA(1);
        for (int st = 0; st < nstep; ++st) {
            const unsigned so = (unsigned)((st & 1) * 8192);
            const int key = (int)selw[st * 16 + c];
            bf16x8_t oh; ONEHOT(oh, key);
            if (st + 1 < nstep) { if (nodma) {} else if (halfdma) asm volatile("s_waitcnt vmcnt(4)" ::: "memory"); else asm volatile("s_waitcnt vmcnt(8)" ::: "memory"); } else asm volatile("s_waitcnt vmcnt(0)" ::: "memory");
            bf16x8_t af[8]; u16x4_t v[16];
#pragma unroll
            for (int ks = 0; ks < 8; ++ks) { if (nolds) af[ks] = qf[ks]; else af[ks] = *(const LDSP bf16x8_t*)(size_t)(rd0 + so + (ks >> 2) * 4096 + 64 * (((unsigned)(ks & 3)) ^ rx)); }
#pragma unroll
            for (int n4 = 0; n4 < 4; ++n4) { unsigned ad[4]; if (nolds) { v[n4 * 4] = v[n4 * 4 + 1] = v[n4 * 4 + 2] = v[n4 * 4 + 3] = (u16x4_t){(unsigned short)st, 1, 2, 3}; continue; }
#pragma unroll
                for (int k = 0; k < 4; ++k) { const unsigned nt = (unsigned)(n4 * 4 + k); ad[k] = tr0 + so + (nt >> 3) * 4096 + 16 * ((((nt & 7) << 1) | tb0) ^ ts); }
                asm volatile("ds_read_b64_tr_b16 %0, %4\n\tds_read_b64_tr_b16 %1, %5\n\tds_read_b64_tr_b16 %2, %6\n\tds_read_b64_tr_b16 %3, %7" : "=&v"(v[n4 * 4]), "=&v"(v[n4 * 4 + 1]), "=&v"(v[n4 * 4 + 2]), "=&v"(v[n4 * 4 + 3]) : "v"(ad[0]), "v"(ad[1]), "v"(ad[2]), "v"(ad[3]) : "memory"); }
            WAITPIN4(0, v[0], v[1], v[2], v[3]); WAITPIN4(0, v[4], v[5], v[6], v[7]); WAITPIN4(0, v[8], v[9], v[10], v[11]); WAITPIN4(0, v[12], v[13], v[14], v[15]);
            if (st + 2 < nstep) KV_DMA(st + 2);
            pg8::f32x4 s0 = {0.f, 0.f, 0.f, 0.f};
            s0 = __builtin_amdgcn_mfma_f32_16x16x32_bf16(oh, bbf, s0, 0, 0, 0);
#pragma unroll
            for (int ks = 0; ks < 8; ++ks) { if (noqk) { if (ks == 0) s0[0] += __builtin_bit_cast(float, ((unsigned)af[0][0] << 16) ^ ((unsigned)af[1][1] << 16) ^ ((unsigned)af[2][1] << 16) ^ ((unsigned)af[3][1] << 16) ^ ((unsigned)af[4][1] << 16) ^ ((unsigned)af[5][1] << 16) ^ ((unsigned)af[6][1] << 16) ^ ((unsigned)af[7][1] << 16)); } else s0 = __builtin_amdgcn_mfma_f32_16x16x32_bf16(af[ks], qf[ks], s0, 0, 0, 0); }
            float tmax = fmaxf(fmaxf(s0[0], s0[1]), fmaxf(s0[2], s0[3]));
            if (!nosm) { tmax = fmaxf(tmax, __shfl_xor(tmax, 16)); tmax = fmaxf(tmax, __shfl_xor(tmax, 32)); }
            const float m_new = fmaxf(m_run, tmax); const float scl = __expf(m_run - m_new); const bool grow = m_new > m_run; m_run = m_new;
            float sv[4]; float ps = 0.f;
#pragma unroll
            for (int j = 0; j < 4; ++j) { sv[j] = __expf(s0[j] - m_new); ps += sv[j]; }
            l_run = l_run * scl + ps;
            typedef short bf16x4_t __attribute__((ext_vector_type(4)));
            bf16x4_t pf; { u32x2 w; w.x = pk2(sv[0], sv[1]); w.y = pk2(sv[2], sv[3]); pf = __builtin_bit_cast(bf16x4_t, w); }
            if (__builtin_amdgcn_ballot_w64(grow) != 0ull) {
                float rs[4];
#pragma unroll
                for (int e = 0; e < 4; ++e) rs[e] = __shfl(scl, 4 * g + e);
#pragma unroll
                for (int nt = 0; nt < 16; ++nt) {
#pragma unroll
                    for (int e = 0; e < 4; ++e) acc[nt][e] *= rs[e]; } }
#pragma unroll
            for (int k = 0; k < 16; ++k) { if (nopv) { acc[k][0] += __builtin_bit_cast(float, (unsigned)v[k][0] << 16) * sv[0]; } else acc[k] = __builtin_amdgcn_mfma_f32_16x16x16bf16_1k(pf, __builtin_bit_cast(bf16x4_t, v[k]), acc[k], 0, 0, 0); }
        }
#undef KV_DMA
#undef ONEHOT
        float lt = l_run + __shfl_xor(l_run, 16); lt += __shfl_xor(lt, 32); const float inv = 1.0f / lt;
        float ri[4];
#pragma unroll
        for (int e = 0; e < 4; ++e) ri[e] = __shfl(inv, 4 * g + e);
        if (g < 2) {
#pragma unroll
            for (int nt = 0; nt < 16; ++nt) { LDSP unsigned short* o1 = (LDSP unsigned short*)(tile) + (4 * g) * 256 + nt * 16 + c;
                o1[0] = f2bf(acc[nt][0] * ri[0]); o1[256] = f2bf(acc[nt][1] * ri[1]); o1[512] = f2bf(acc[nt][2] * ri[2]); o1[768] = f2bf(acc[nt][3] * ri[3]); }
        }
    }
    u32x4 nsel_v = {0u, 0u, 0u, 0u};
    if (nxt_unit >= 0 && lane < 32) { const int nb = nxt_unit >> 9, nq = nxt_unit & 511; nsel_v = *((const u32x4*)(idx + (size_t)(nb * SEQ + nq * 8 + wave) * TOPK) + lane); }
    asm volatile("s_waitcnt lgkmcnt(0)" ::: "memory"); __builtin_amdgcn_s_barrier(); asm volatile("" ::: "memory");
    if (qmode == 1) {
        bf16* oscr = qscr + 16384;
#pragma unroll
        for (int j = 0; j < 4; ++j) *((u32x4*)(oscr + (size_t)wave * 2048) + j * 64 + lane) = *((const LDSP u32x4*)(tile) + j * 64 + lane);
    } else {
        const int h = wave; pg8::f32x4 o[4];
#pragma unroll
        for (int nt = 0; nt < 4; ++nt) o[nt] = (pg8::f32x4){0.f, 0.f, 0.f, 0.f};
        const LDSP unsigned char* ab = lds + TILE_STRIDE * (c & 7) + (h * 256 + g * 8) * 2;
        const unsigned long long* os = (const unsigned long long*)(qscr + 16384 + ((c & 7) * 8 + h) * 256 + g * 8);
        const bf16* wb = WUV + ((size_t)h * 64 + c) * 256 + g * 8;
        const bool from_scr = (qmode == 2) && (c < 8);
#pragma unroll
        for (int ks = 0; ks < 8; ++ks) { bf16x8_t a;
            if (from_scr) { const unsigned long long lo = __hip_atomic_load(os + ks * 8, __ATOMIC_RELAXED, __HIP_MEMORY_SCOPE_AGENT), hi = __hip_atomic_load(os + ks * 8 + 1, __ATOMIC_RELAXED, __HIP_MEMORY_SCOPE_AGENT);
                u32x4 w; w.x = (unsigned)lo; w.y = (unsigned)(lo >> 32); w.z = (unsigned)hi; w.w = (unsigned)(hi >> 32); a = __builtin_bit_cast(bf16x8_t, w); }
            else a = *(const LDSP bf16x8_t*)(ab + ks * 64);
#pragma unroll
            for (int nt = 0; nt < 4; ++nt) { const bf16x8_t bw = *(const bf16x8_t*)(wb + (size_t)nt * 16 * 256 + ks * 32); o[nt] = __builtin_amdgcn_mfma_f32_16x16x32_bf16(a, bw, o[nt], 0, 0, 0); } }
        const int rbase = (qmode == 2) ? t0 - 8 : t0;
        if ((g < 2 || qmode == 2) && !dry) {
#pragma unroll
            for (int nt = 0; nt < 4; ++nt)
#pragma unroll
                for (int e = 0; e < 4; ++e) RA[(size_t)(rbase + 4 * g + e) * NA + A_Q + h * 64 + nt * 16 + c] = f2bf(o[nt][e]); }
    }
    if (nxt_unit >= 0 && lane < 32) *((LDSP u32x4*)selw_n + lane) = nsel_v;
    asm volatile("s_waitcnt vmcnt(0) lgkmcnt(0)" ::: "memory"); __builtin_amdgcn_s_barrier(); asm volatile("" ::: "memory");
}

#define QLS_PTR(t) (RB + (size_t)(t) * NB + 1024)
__device__ __forceinline__ void wg_qlat_all(const bf16* RA, bf16* RB, const bf16* __restrict__ WUK, int blk, int G, int tid) {
    const int lane = tid & 63, wave = __builtin_amdgcn_readfirstlane(tid >> 6), g = lane >> 4, c = lane & 15, h = wave;
    const bf16* wb = WUK + ((size_t)h * 256 + c) * 64 + g * 8;
    bf16x8_t a0[16], a1[16];
#pragma unroll
    for (int rt = 0; rt < 16; ++rt) { a0[rt] = *(const bf16x8_t*)(wb + rt * 16 * 64); a1[rt] = *(const bf16x8_t*)(wb + rt * 16 * 64 + 32); }
#pragma clang loop unroll(disable)
    for (int i = blk; i < T / 16; i += G) { const int b_ = i & 7, j_ = i >> 3, tg = b_ * SEQ + (255 - j_) * 16;
        const bf16* qr = RA + (size_t)(tg + c) * NA + A_Q + h * 64 + g * 8;
        const bf16x8_t b0 = *(const bf16x8_t*)qr, b1 = *(const bf16x8_t*)(qr + 32);
        bf16* dst = QLS_PTR(tg + c) + h * 256 + 4 * g;
#pragma unroll
        for (int rt = 0; rt < 16; ++rt) { pg8::f32x4 acc = {0.f, 0.f, 0.f, 0.f};
            acc = __builtin_amdgcn_mfma_f32_16x16x32_bf16(a0[rt], b0, acc, 0, 0, 0); acc = __builtin_amdgcn_mfma_f32_16x16x32_bf16(a1[rt], b1, acc, 0, 0, 0);
            u32x2 w; w.x = pk2(acc[0], acc[1]); w.y = pk2(acc[2], acc[3]); *(u32x2*)(dst + rt * 16) = w; } }
}
__device__ __forceinline__ void wg_aout_all(bf16* RA, const bf16* RB, const bf16* __restrict__ WUV, int blk, int G, int tid) {
    const int lane = tid & 63, wave = __builtin_amdgcn_readfirstlane(tid >> 6), g = lane >> 4, c = lane & 15, h = wave;
    const bf16* wb = WUV + ((size_t)h * 64 + c) * 256 + g * 8;
    bf16x8_t bw[4][8];
#pragma unroll
    for (int nt = 0; nt < 4; ++nt)
#pragma unroll
        for (int ks = 0; ks < 8; ++ks) bw[nt][ks] = *(const bf16x8_t*)(wb + (size_t)nt * 16 * 256 + ks * 32);
#pragma clang loop unroll(disable)
    for (int i = blk; i < T / 16; i += G) { const int b_ = i & 7, j_ = i >> 3, tg = b_ * SEQ + (255 - j_) * 16;
        const unsigned long long* os = (const unsigned long long*)(QLS_PTR(tg + c) + h * 256 + g * 8);
        pg8::f32x4 o[4];
#pragma unroll
        for (int nt = 0; nt < 4; ++nt) o[nt] = (pg8::f32x4){0.f, 0.f, 0.f, 0.f};
        bf16x8_t a[8];
#pragma unroll
        for (int ks = 0; ks < 8; ++ks) { const unsigned long long lo = __hip_atomic_load(os + ks * 8, __ATOMIC_RELAXED, __HIP_MEMORY_SCOPE_AGENT), hi = __hip_atomic_load(os + ks * 8 + 1, __ATOMIC_RELAXED, __HIP_MEMORY_SCOPE_AGENT);
            u32x4 w; w.x = (unsigned)lo; w.y = (unsigned)(lo >> 32); w.z = (unsigned)hi; w.w = (unsigned)(hi >> 32); a[ks] = __builtin_bit_cast(bf16x8_t, w); }
#pragma unroll
        for (int ks = 0; ks < 8; ++ks)
#pragma unroll
            for (int nt = 0; nt < 4; ++nt) o[nt] = __builtin_amdgcn_mfma_f32_16x16x32_bf16(a[ks], bw[nt][ks], o[nt], 0, 0, 0);
#pragma unroll
        for (int nt = 0; nt < 4; ++nt)
#pragma unroll
            for (int e = 0; e < 4; ++e) RA[(size_t)(tg + 4 * g + e) * NA + A_Q + h * 64 + nt * 16 + c] = f2bf(o[nt][e]); }
}
__device__ __forceinline__ void wg_attn8(LDSP unsigned char* lds, bf16* RB, const bf16* __restrict__ CKVC, const float* __restrict__ rel_bias, int unit, int par, int tid) {
    const int lane = tid & 63, wave = __builtin_amdgcn_readfirstlane(tid >> 6), g = lane >> 4, c = lane & 15;
    const int b = unit >> 9, qg = unit & 511, t0 = b * SEQ + qg * 8, nk = ((qg >> 3) + 1) << 6, nsel = nk < TOPK ? nk : TOPK;
    LDSP unsigned char* tile = lds + wave * TILE_STRIDE;
    LDSP unsigned short* selw = (LDSP unsigned short*)(lds + SELW_OFF + (par * 8 + wave) * 512);
    const bf16* kvb = CKVC + (size_t)b * SEQ * KV_R;
    const int nstep = nsel >> 4;
#define KV_DMA(step) do { LDSP unsigned char* sl_ = tile + ((step) & 1) * 8192; \
        const u32x2 kk_ = *(const LDSP u32x2*)(selw + (step) * 16 + 4 * g); \
        _Pragma("unroll") for (int i4_ = 0; i4_ < 4; ++i4_) { const unsigned kw_ = (i4_ >> 1) ? kk_.y : kk_.x; const int key_ = (int)((i4_ & 1) ? (kw_ >> 16) : (kw_ & 0xffffu)); const int c16_ = c ^ ((g << 2) | i4_); \
            const bf16* src_ = kvb + (size_t)key_ * KV_R + c16_ * 8; \
            __builtin_amdgcn_global_load_lds((const unsigned*)src_, (LDSP unsigned*)(sl_ + 1024 * i4_), 16, 0, 0); \
            __builtin_amdgcn_global_load_lds((const unsigned*)(src_ + 128), (LDSP unsigned*)(sl_ + 4096 + 1024 * i4_), 16, 0, 0); } } while (0)
    KV_DMA(0);
    if (nstep > 1) KV_DMA(1);
    bf16x8_t qf[8];
    {   const unsigned long long* qs = (const unsigned long long*)(QLS_PTR(t0 + wave) + (c & 7) * 256 + g * 8);
#pragma unroll
        for (int ks = 0; ks < 8; ++ks) { const unsigned long long lo = __hip_atomic_load(qs + ks * 8, __ATOMIC_RELAXED, __HIP_MEMORY_SCOPE_AGENT), hi = __hip_atomic_load(qs + ks * 8 + 1, __ATOMIC_RELAXED, __HIP_MEMORY_SCOPE_AGENT);
            u32x4 w; w.x = (unsigned)lo; w.y = (unsigned)(lo >> 32); w.z = (unsigned)hi; w.w = (unsigned)(hi >> 32); qf[ks] = __builtin_bit_cast(bf16x8_t, w); } }
    const unsigned tile_a = (unsigned)(size_t)tile;
    bf16x8_t bbf; { float bv[8];
#pragma unroll
        for (int j = 0; j < 8; ++j) bv[j] = rel_bias[(8 * g + j) * 8 + (c & 7)];
        u32x4 w; w.x = pk2(bv[0], bv[1]); w.y = pk2(bv[2], bv[3]); w.z = pk2(bv[4], bv[5]); w.w = pk2(bv[6], bv[7]); bbf = __builtin_bit_cast(bf16x8_t, w); }
    {
        const int spos = (qg * 8 + wave);
        pg8::f32x4 acc[16];
#pragma unroll
        for (int nt = 0; nt < 16; ++nt) acc[nt] = (pg8::f32x4){0.f, 0.f, 0.f, 0.f};
        float m_run = -INFINITY, l_run = 0.f;
#define ONEHOT(dst, key) do { const int rel_ = (key) - spos, n_ = rel_ < 0 ? -rel_ : rel_; \
            const int big_ = 8 + (n_ >= 15) + (n_ >= 27) + (n_ >= 50) + (n_ >= 91) + (n_ >= 166) + (n_ >= 305) + (n_ >= 559); \
            const int pos_ = (n_ < 8 ? n_ : big_) + (rel_ > 0 ? 16 : 0) - 8 * g; const unsigned one_ = (pos_ & 1) ? 0x3F800000u : 0x3F80u; const int hi_ = pos_ >> 1; \
            u32x4 w_; w_.x = (hi_ == 0) ? one_ : 0u; w_.y = (hi_ == 1) ? one_ : 0u; w_.z = (hi_ == 2) ? one_ : 0u; w_.w = (hi_ == 3) ? one_ : 0u; dst = __builtin_bit_cast(bf16x8_t, w_); } while (0)
        const int q4 = c >> 2, p = c & 3;
        const unsigned rd0 = tile_a + 256 * c + 16 * (g ^ (c >> 2)); const unsigned rx = (unsigned)(c & 3);
        const unsigned tr0 = tile_a + 256 * (4 * g + q4) + 8 * (p & 1); const unsigned ts = (unsigned)(((q4 << 2) | g)), tb0 = (unsigned)(p >> 1);
        for (int st = 0; st < nstep; ++st) {
            const unsigned so = (unsigned)((st & 1) * 8192);
            const int key = (int)selw[st * 16 + 4 * (c & 3) + (c >> 2)];
            bf16x8_t oh; ONEHOT(oh, key);
            if (st + 1 < nstep) asm volatile("s_waitcnt vmcnt(8)" ::: "memory"); else asm volatile("s_waitcnt vmcnt(0)" ::: "memory");
            bf16x8_t af[8]; u16x4_t v[16];
#pragma unroll
            for (int ks = 0; ks < 8; ++ks) af[ks] = *(const LDSP bf16x8_t*)(size_t)(rd0 + so + (ks >> 2) * 4096 + 64 * (((unsigned)(ks & 3)) ^ rx));
#pragma unroll
            for (int n4 = 0; n4 < 4; ++n4) { unsigned ad[4];
#pragma unroll
                for (int k = 0; k < 4; ++k) { const unsigned nt = (unsigned)(n4 * 4 + k); ad[k] = tr0 + so + (nt >> 3) * 4096 + 16 * ((((nt & 7) << 1) | tb0) ^ ts); }
                asm volatile("ds_read_b64_tr_b16 %0, %4\n\tds_read_b64_tr_b16 %1, %5\n\tds_read_b64_tr_b16 %2, %6\n\tds_read_b64_tr_b16 %3, %7" : "=&v"(v[n4 * 4]), "=&v"(v[n4 * 4 + 1]), "=&v"(v[n4 * 4 + 2]), "=&v"(v[n4 * 4 + 3]) : "v"(ad[0]), "v"(ad[1]), "v"(ad[2]), "v"(ad[3]) : "memory"); }
            WAITPIN4(0, v[0], v[1], v[2], v[3]); WAITPIN4(0, v[4], v[5], v[6], v[7]); WAITPIN4(0, v[8], v[9], v[10], v[11]); WAITPIN4(0, v[12], v[13], v[14], v[15]);
            if (st + 2 < nstep) KV_DMA(st + 2);
            pg8::f32x4 s0 = {0.f, 0.f, 0.f, 0.f};
            s0 = __builtin_amdgcn_mfma_f32_16x16x32_bf16(oh, bbf, s0, 0, 0, 0);
#pragma unroll
            for (int ks = 0; ks < 8; ++ks) s0 = __builtin_amdgcn_mfma_f32_16x16x32_bf16(af[ks], qf[ks], s0, 0, 0, 0);
            float tmax = fmaxf(fmaxf(s0[0], s0[1]), fmaxf(s0[2], s0[3]));
            {   float ta = tmax, tb = tmax;
                asm volatile("s_nop 1\n\tv_permlane16_swap_b32 %0, %1" : "+v"(ta), "+v"(tb)); tmax = fmaxf(ta, tb); ta = tmax; tb = tmax;
                asm volatile("s_nop 1\n\tv_permlane32_swap_b32 %0, %1" : "+v"(ta), "+v"(tb)); tmax = fmaxf(ta, tb); }
            if (__builtin_amdgcn_ballot_w64(tmax > m_run + 8.0f) != 0ull) {
                const float m_new = fmaxf(m_run, tmax); const float scl = __expf(m_run - m_new); m_run = m_new; l_run *= scl;
                float rs[4];
#pragma unroll
                for (int e = 0; e < 4; ++e) rs[e] = __shfl(scl, 4 * g + e);
#pragma unroll
                for (int nt = 0; nt < 16; ++nt) {
#pragma unroll
                    for (int e = 0; e < 4; ++e) acc[nt][e] *= rs[e]; } }
            float sv[4]; float ps = 0.f;
#pragma unroll
            for (int j = 0; j < 4; ++j) { sv[j] = __expf(s0[j] - m_run); ps += sv[j]; }
            l_run += ps;
            typedef short bf16x4_t __attribute__((ext_vector_type(4)));
            bf16x4_t pf; { u32x2 w; w.x = pk2(sv[0], sv[1]); w.y = pk2(sv[2], sv[3]); pf = __builtin_bit_cast(bf16x4_t, w); }
#pragma unroll
            for (int k = 0; k < 16; ++k) acc[k] = __builtin_amdgcn_mfma_f32_16x16x16bf16_1k(pf, __builtin_bit_cast(bf16x4_t, v[k]), acc[k], 0, 0, 0);
        }
#undef KV_DMA
#undef ONEHOT
        float lt = l_run + __shfl_xor(l_run, 16); lt += __shfl_xor(lt, 32); const float inv = 1.0f / lt;
        float ri[4];
#pragma unroll
        for (int e = 0; e < 4; ++e) ri[e] = __shfl(inv, 4 * g + e);
        if (g < 2) {
#pragma unroll
            for (int nt = 0; nt < 16; ++nt) { LDSP unsigned short* o1 = (LDSP unsigned short*)(tile) + (4 * g) * 256 + nt * 16 + c;
                o1[0] = f2bf(acc[nt][0] * ri[0]); o1[256] = f2bf(acc[nt][1] * ri[1]); o1[512] = f2bf(acc[nt][2] * ri[2]); o1[768] = f2bf(acc[nt][3] * ri[3]); }
        }
    }
    asm volatile("s_waitcnt lgkmcnt(0)" ::: "memory");
#pragma unroll
    for (int j = 0; j < 4; ++j) *((u32x4*)(QLS_PTR(t0 + wave)) + j * 64 + lane) = *((const LDSP u32x4*)(tile) + j * 64 + lane);
    asm volatile("s_waitcnt lgkmcnt(0)" ::: "memory");
}

#ifndef SSM_SPLIT_V
#define SSM_SPLIT_V 42
#endif
constexpr int SSM_SPLIT = SSM_SPLIT_V;
constexpr int XP = 144, BP = 272;
constexpr int SB_X = 0, SB_B = 8192, SB_C = 24576, SB_SIZE = 40960;
constexpr int L_XS = 2 * SB_SIZE, L_M = L_XS + 64 * XP, L_HC = L_M + 64 * XP, L_TB = L_HC + 2 * 64 * BP;
static_assert(L_TB + 2048 <= 140 * 1024, "ssm lds");
#define TR2(d0, d1, a0, a1) asm volatile("ds_read_b64_tr_b16 %0, %2\n\tds_read_b64_tr_b16 %1, %3\n\ts_waitcnt lgkmcnt(0)" : "=&v"(d0), "=&v"(d1) : "v"(a0), "v"(a1) : "memory")
__device__ __forceinline__ bf16x8_t mk8(u16x4_t a, u16x4_t b) { bf16x8_t r; r[0] = a[0]; r[1] = a[1]; r[2] = a[2]; r[3] = a[3]; r[4] = b[0]; r[5] = b[1]; r[6] = b[2]; r[7] = b[3]; return r; }
__device__ __forceinline__ int bc_off(int row, int ch) { return 256 * row + 16 * (ch ^ (((row & 3) << 2) | ((row >> 2) & 3))); }
__device__ __forceinline__ void ssm_dma(LDSP unsigned char* buf, const bf16* __restrict__ XA, int tc0, int h, int grp, int wave, int lane, bool full) {
    const int npc = full ? 40 : 24;
    for (int p = wave; p < npc; p += 8) {
        const bf16* src;
        if (p < 8) { const int row = 8 * p + (lane >> 3), ch = lane & 7; src = XA + (size_t)(tc0 + row) * XBC + h * 64 + ch * 8; }
        else { const int pp = (p - 8) & 15, row = 4 * pp + (lane >> 4), ch = (lane & 15) ^ (((row & 3) << 2) | ((row >> 2) & 3)); src = XA + (size_t)(tc0 + row) * XBC + (p < 24 ? 1024 : 1280) + grp * 128 + ch * 8; }
        __builtin_amdgcn_global_load_lds((const unsigned*)src, (LDSP unsigned*)(buf + 1024 * p), 16, 0, 0);
    }
}
__device__ __forceinline__ void wg_ssm_unit(LDSP unsigned char* lds, bf16* RA, const bf16* __restrict__ XA, const float* __restrict__ DTt,
                                            const float* __restrict__ a_log, const float* __restrict__ dsk, int unit, int tid, bf16* dbg_out = nullptr, bool dry = false) {
    const int lane = tid & 63, wave = __builtin_amdgcn_readfirstlane(tid >> 6), g = lane >> 4, c = lane & 15, q4 = c >> 2, p4 = c & 3;
    const int b = unit >> 5, h = (unit >> 1) & 15, seg = unit & 1, grp = h >> 3, pq = wave & 3, hf = wave >> 2;
    const float Dh = dsk[h];
    const unsigned lds_a = (unsigned)(size_t)lds;
    LDSP float* TB = (LDSP float*)(lds + L_TB);
    typedef float f32x2_t __attribute__((ext_vector_type(2)));
    const f32x2_t* dtp = (const f32x2_t*)DTt + (size_t)(b * 16 + h) * SEQ;
    pg8::f32x4 hacc[4];
#pragma unroll
    for (int nt = 0; nt < 4; ++nt) hacc[nt] = (pg8::f32x4){0.f, 0.f, 0.f, 0.f};
    for (int i = tid; i < (2 * 64 * BP) / 4; i += NTHR) ((LDSP unsigned*)(lds + L_HC))[i] = 0u;
    const int c_end = seg ? 64 : SSM_SPLIT;
    ssm_dma(lds, XA, b * SEQ, h, grp, wave, lane, seg == 0 || SSM_SPLIT == 0);
    f32x2_t dt_cur = dtp[lane];
    asm volatile("s_waitcnt vmcnt(0) lgkmcnt(0)" ::: "memory"); __builtin_amdgcn_s_barrier(); asm volatile("" ::: "memory");
    for (int ci = 0; ci < c_end; ++ci) {
        const bool full = (seg == 0) || (ci >= SSM_SPLIT);
        const int tc0 = b * SEQ + ci * 64;
        LDSP unsigned char* buf = lds + (ci & 1) * SB_SIZE;
        f32x2_t dt_nxt = {0.f, 0.f};
        if (ci + 1 < c_end) { ssm_dma(lds + ((ci + 1) & 1) * SB_SIZE, XA, tc0 + 64, h, grp, wave, lane, (seg == 0) || (ci + 1 >= SSM_SPLIT)); dt_nxt = dtp[(ci + 1) * 64 + lane]; }
        unsigned short zraw[8];
        if (full) {
#pragma unroll
            for (int k2 = 0; k2 < 2; ++k2)
#pragma unroll
                for (int e = 0; e < 4; ++e) zraw[k2 * 4 + e] = RA[(size_t)(tc0 + 16 * (2 * hf + k2) + 4 * g + e) * NA + A_Z + h * 64 + 16 * pq + c]; }
        {   const float dt = dt_cur.x, acs = dt_cur.y; const float tot = __builtin_bit_cast(float, __builtin_amdgcn_readlane(__builtin_bit_cast(int, acs), 63));
            TB[lane] = dt; TB[64 + lane] = acs; TB[128 + lane] = __expf(acs); TB[192 + lane] = __expf(tot - acs) * dt; if (lane == 0) TB[256] = __expf(tot); }
        asm volatile("s_waitcnt lgkmcnt(0)" ::: "memory");
        {   const int row = tid >> 3, ch = tid & 7; const u32x4 xv = *(const LDSP u32x4*)(buf + SB_X + row * 128 + ch * 16); const float wl = TB[192 + row]; const unsigned xw[4] = {xv.x, xv.y, xv.z, xv.w}; u32x4 o;
            o.x = pk2(__builtin_bit_cast(float, xw[0] << 16) * wl, __builtin_bit_cast(float, xw[0] & 0xffff0000u) * wl); o.y = pk2(__builtin_bit_cast(float, xw[1] << 16) * wl, __builtin_bit_cast(float, xw[1] & 0xffff0000u) * wl);
            o.z = pk2(__builtin_bit_cast(float, xw[2] << 16) * wl, __builtin_bit_cast(float, xw[2] & 0xffff0000u) * wl); o.w = pk2(__builtin_bit_cast(float, xw[3] << 16) * wl, __builtin_bit_cast(float, xw[3] & 0xffff0000u) * wl);
            *(LDSP u32x4*)(lds + L_XS + row * XP + ch * 16) = o; }
        if (full) {
            const int lt = wave >> 1;
#pragma unroll
            for (int k2 = 0; k2 < 2; ++k2) { const int st = 2 * (wave & 1) + k2; pg8::f32x4 ga = {0.f, 0.f, 0.f, 0.f};
#pragma unroll
                for (int ks = 0; ks < 4; ++ks) { const bf16x8_t af = *(const LDSP bf16x8_t*)(buf + SB_C + bc_off(16 * lt + c, 4 * ks + g)), bfm = *(const LDSP bf16x8_t*)(buf + SB_B + bc_off(16 * st + c, 4 * ks + g));
                    ga = __builtin_amdgcn_mfma_f32_16x16x32_bf16(af, bfm, ga, 0, 0, 0); }
                const int s = 16 * st + c; const float acs_s = TB[64 + s], dt_s = TB[s];
#pragma unroll
                for (int e = 0; e < 4; ++e) { const int l = 16 * lt + 4 * g + e; const float m = (s <= l) ? ga[e] * __expf(TB[64 + l] - acs_s) * dt_s : 0.f;
                    *(LDSP unsigned short*)(lds + L_M + l * XP + s * 2) = f2bf(m); } }
        }
        asm volatile("s_waitcnt lgkmcnt(0)" ::: "memory"); __builtin_amdgcn_s_barrier(); asm volatile("" ::: "memory");
        if (full) {
            pg8::f32x4 ya[2] = {{0.f, 0.f, 0.f, 0.f}, {0.f, 0.f, 0.f, 0.f}};
            const LDSP unsigned char* hcur = lds + L_HC + (ci & 1) * (64 * BP);
#pragma unroll
            for (int ks = 0; ks < 4; ++ks) { const bf16x8_t hb = *(const LDSP bf16x8_t*)(hcur + (16 * pq + c) * BP + (32 * ks + 8 * g) * 2);
#pragma unroll
                for (int k2 = 0; k2 < 2; ++k2) { const bf16x8_t af = *(const LDSP bf16x8_t*)(buf + SB_C + bc_off(16 * (2 * hf + k2) + c, 4 * ks + g)); ya[k2] = __builtin_amdgcn_mfma_f32_16x16x32_bf16(af, hb, ya[k2], 0, 0, 0); } }
#pragma unroll
            for (int k2 = 0; k2 < 2; ++k2)
#pragma unroll
                for (int e = 0; e < 4; ++e) ya[k2][e] *= TB[128 + 16 * (2 * hf + k2) + 4 * g + e];
#pragma unroll
            for (int ks = 0; ks < 2; ++ks) { u16x4_t x0, x1; const unsigned xa = lds_a + (ci & 1) * SB_SIZE + SB_X + (32 * ks + 8 * g + q4) * 128 + (16 * pq + 4 * p4) * 2; TR2(x0, x1, xa, xa + 4 * 128); const bf16x8_t xb = mk8(x0, x1);
#pragma unroll
                for (int k2 = 0; k2 < 2; ++k2) { const bf16x8_t mf = *(const LDSP bf16x8_t*)(lds + L_M + (16 * (2 * hf + k2) + c) * XP + (32 * ks + 8 * g) * 2); ya[k2] = __builtin_amdgcn_mfma_f32_16x16x32_bf16(mf, xb, ya[k2], 0, 0, 0); } }
#pragma unroll
            for (int k2 = 0; k2 < 2; ++k2)
#pragma unroll
                for (int e = 0; e < 4; ++e) { const int l = 16 * (2 * hf + k2) + 4 * g + e, pp = 16 * pq + c; const float x = bf2f(*(const LDSP unsigned short*)(buf + SB_X + l * 128 + pp * 2));
                    const float z = bf2f(zraw[k2 * 4 + e]); const bf16 uo = f2bf((ya[k2][e] + Dh * x) * siluf_(z));
                    if (dbg_out) dbg_out[(size_t)(tc0 + l) * 1024 + h * 64 + pp] = uo; else if (!dry) RA[(size_t)(tc0 + l) * NA + A_Z + h * 64 + pp] = uo; }
        }
        {   const float dec = TB[256];
#pragma unroll
            for (int nt = 0; nt < 4; ++nt)
#pragma unroll
                for (int e = 0; e < 4; ++e) hacc[nt][e] *= dec;
#pragma unroll
            for (int ks = 0; ks < 2; ++ks) { const int row = 32 * ks + 8 * g + q4; u16x4_t x0, x1; const unsigned xa = lds_a + L_XS + row * XP + (16 * pq + 4 * p4) * 2; TR2(x0, x1, xa, xa + 4 * XP); const bf16x8_t xf = mk8(x0, x1);
                u16x4_t v[8]; unsigned ad[8];
#pragma unroll
                for (int nt = 0; nt < 4; ++nt) { const int ch = 8 * hf + 2 * nt + (p4 >> 1); ad[2 * nt] = lds_a + (ci & 1) * SB_SIZE + SB_B + bc_off(row, ch) + 8 * (p4 & 1); ad[2 * nt + 1] = lds_a + (ci & 1) * SB_SIZE + SB_B + bc_off(row + 4, ch) + 8 * (p4 & 1); }
                TR8(v[0], v[1], v[2], v[3], v[4], v[5], v[6], v[7], ad[0], ad[1], ad[2], ad[3], ad[4], ad[5], ad[6], ad[7]);
#pragma unroll
                for (int nt = 0; nt < 4; ++nt) hacc[nt] = __builtin_amdgcn_mfma_f32_16x16x32_bf16(xf, mk8(v[2 * nt], v[2 * nt + 1]), hacc[nt], 0, 0, 0); }
            LDSP unsigned char* hnext = lds + L_HC + ((ci + 1) & 1) * (64 * BP);
#pragma unroll
            for (int nt = 0; nt < 4; ++nt)
#pragma unroll
                for (int e = 0; e < 4; ++e) *(LDSP unsigned short*)(hnext + (16 * pq + 4 * g + e) * BP + (64 * hf + 16 * nt + c) * 2) = f2bf(hacc[nt][e]);
        }
        dt_cur = dt_nxt;
        asm volatile("s_waitcnt vmcnt(0) lgkmcnt(0)" ::: "memory"); __builtin_amdgcn_s_barrier(); asm volatile("" ::: "memory");
    }
}

__global__ void __launch_bounds__(NTHR, 2) k_fwd(Params P) {
    extern __shared__ __attribute__((aligned(16))) unsigned char lds_raw[];
    LDSP unsigned char* lds = (LDSP unsigned char*)lds_raw;
    volatile LDSP unsigned* MISC = (volatile LDSP unsigned*)(lds + MISC_OFF);
    unsigned char* ws = P.ws;
    const int wave_s = __builtin_amdgcn_readfirstlane(threadIdx.x >> 6);
    for (int u = threadIdx.x; u < (LDS_BYTES - RING_BYTES) / 4; u += NTHR) ((LDSP unsigned*)(lds + RING_BYTES))[u] = 0u;
#define PHASE_IDS int tid = mk_tid(wave_s); int blk = blockIdx.x; asm volatile("" : "+s"(blk)); int G = gridDim.x; asm volatile("" : "+s"(G)); const int NGW = G * NWAVES; (void)NGW; const int lane = tid & 63, wave = __builtin_amdgcn_readfirstlane(tid >> 6), gw = blk * NWAVES + wave; (void)lane; (void)wave; (void)gw; const __attribute__((address_space(4))) char* kargs = (const __attribute__((address_space(4))) char*)__builtin_amdgcn_kernarg_segment_ptr(); asm volatile("" : "+s"(kargs)); int Lp = L; asm volatile("" : "+s"(Lp)); (void)Lp; unsigned char* ws = ((unsigned char* const __attribute__((address_space(4)))*)kargs)[27]; float* out = ((float* const __attribute__((address_space(4)))*)kargs)[26]; const float* x = KIN(0); const float* p = KIN(1); float* rstd = (float*)(ws + WS_RSTD); float* rstd2 = (float*)(ws + WS_RSTD2); float* DTb = (float*)(ws + WS_DT); bf16 *Win = (bf16*)(ws + WS_W_IN), *Wout = (bf16*)(ws + WS_W_OUT), *Wgu = (bf16*)(ws + WS_W_GU), *Wdown = (bf16*)(ws + WS_W_DOWN), *Wpg = (bf16*)(ws + WS_W_PG), *Wpp = (bf16*)(ws + WS_W_PP); bf16 *X0 = (bf16*)(ws + WS_X0), *X1 = (bf16*)(ws + WS_X1), *RA = (bf16*)(ws + WS_RA), *RB = (bf16*)(ws + WS_RB), *XA = (bf16*)out; unsigned short* IDX = (unsigned short*)((unsigned char*)out + 112 * MiB); bf16* CKVC = (bf16*)((unsigned char*)out + 96 * MiB); bf16* IKC = (bf16*)(ws + WS_IKC); bf16* WUK = (bf16*)(ws + WS_WUK); bf16* WUV = (bf16*)(ws + WS_WUV); (void)CKVC; (void)IKC; (void)WUK; (void)WUV; bf16* Xcur = (Lp == 0) ? X0 : X1; (void)out; (void)x; (void)p; (void)rstd; (void)rstd2; (void)DTb; (void)Win; (void)Wout; (void)Wgu; (void)Wdown; (void)Wpg; (void)Wpp; (void)X0; (void)X1; (void)RA; (void)RB; (void)XA; (void)IDX; (void)Xcur
    __syncthreads();
    if (TIMING && blockIdx.x == 0 && mk_tid(wave_s) == 0) { __hip_atomic_store((unsigned long long*)(P.ws + 32768), (unsigned long long)__builtin_amdgcn_s_memrealtime(), __ATOMIC_RELAXED, __HIP_MEMORY_SCOPE_AGENT); __hip_atomic_store((unsigned long long*)(P.ws + 32768) + 60, (unsigned long long)__builtin_amdgcn_s_memtime(), __ATOMIC_RELAXED, __HIP_MEMORY_SCOPE_AGENT); }
#if CLK_PROBE
    if (blockIdx.x == 0 && mk_tid(wave_s) == 0) { __hip_atomic_store((unsigned long long*)(P.ws + 49152), (unsigned long long)__builtin_amdgcn_s_memtime(), __ATOMIC_RELAXED, __HIP_MEMORY_SCOPE_AGENT); __hip_atomic_store((unsigned long long*)(P.ws + 49152) + 1, (unsigned long long)__builtin_amdgcn_s_memrealtime(), __ATOMIC_RELAXED, __HIP_MEMORY_SCOPE_AGENT); }
#endif
    const bool one_launch = (P.ph_hi - P.ph_lo) > 1;
    XcdBarrier bar; bar.bar = (unsigned*)(ws + WS_CTL) + CW_BAR; bar.x = 0; bar.st = nullptr;
    if (one_launch) bar = xcd_barrier_post((unsigned*)(ws + WS_CTL) + CW_BAR, (volatile LAS unsigned*)(MISC + 8));
    if (one_launch && mk_tid(wave_s) == 0) { const unsigned xid_ = xb_xcc_id(); MISC[16] = xid_; MISC[17] = __hip_atomic_fetch_add((unsigned*)(P.ws + WS_CTL) + CW_RANK + 64 * xid_, 1u, __ATOMIC_RELAXED, __HIP_MEMORY_SCOPE_AGENT); }

#ifndef TW_VAR
#define TW_VAR 0
#endif
#ifndef TW_MASK
#define TW_MASK 0
#endif
#ifndef PH_MASK
#define PH_MASK 0x3fff
#endif
#define PHASE_IDS_NOL const int L = 0; PHASE_IDS
#define NPASS(k) (((DBL_MASK >> (k)) & 1) ? ((Lp == 0 && ((P.dbl_mask >> (k)) & 1)) ? 2 : 1) : 1)
#define XCD_DEAL bool xok_ = false; int xb_ = 0, xr_ = 0, xn_ = 1; { if (tid == 0) { unsigned ok = (MISC[9] == 8u) ? 1u : 0u; unsigned sum = 0; for (int j = 0; j < 8; ++j) { const unsigned cj = __hip_atomic_load((unsigned*)(ws + WS_CTL) + CW_BAR + XB_XCNT(j), __ATOMIC_RELAXED, __HIP_MEMORY_SCOPE_AGENT); sum += cj; if (cj == 0u) ok = 0u; } if (sum != (unsigned)G) ok = 0u; MISC[18] = ok; } \
    __syncthreads(); xok_ = MISC[18] != 0u; xb_ = (int)MISC[16]; xr_ = (int)MISC[17]; xn_ = (int)MISC[8]; if (xn_ < 1) xn_ = 1; __syncthreads(); }
#define KIN(i) (((const float* const __attribute__((address_space(4)))*)kargs)[i])
#define IN(k) (P.ph_lo <= (k) && (k) < P.ph_hi && ((PH_MASK >> ((k) % NPH)) & 1))
#define SEAM(k) do { if (IN((k) + 1)) { XcdBarrier b2_ = bar; asm volatile("" : "+s"(b2_.bar)); xcd_barrier(b2_, mk_tid(wave_s)); } if (TIMING && blockIdx.x == 0 && mk_tid(wave_s) == 0) { __hip_atomic_store((unsigned long long*)(P.ws + 32768) + (k) + 1, (unsigned long long)__builtin_amdgcn_s_memrealtime(), __ATOMIC_RELAXED, __HIP_MEMORY_SCOPE_AGENT); } } while (0)
    for (int L = 0; L < DEPTH; ++L) {
        const int pb = L * NPH;
        if (IN(pb + 0)) { PHASE_IDS; for (int pass = NPASS(0); pass > 0; --pass) {
            LDSP float* scr = (LDSP float*)(lds + wave * 8704);
            ph_prep_w<1>(scr, KIN(6) + (size_t)Lp * D * INW, nullptr, D, INW, KIN(2) + (size_t)Lp * D, Win, NIN, gw, NGW, lane);
            ph_prep_w<0>(scr, KIN(20) + (size_t)Lp * MIXW * D, nullptr, MIXW, D, nullptr, Wout, D, gw, NGW, lane);
            ph_prep_w<2>(scr, KIN(21) + (size_t)Lp * D * DFF, KIN(22) + (size_t)Lp * D * DFF, D, DFF, KIN(4) + (size_t)Lp * D, Wgu, NGU, gw, NGW, lane);
            ph_prep_w<0>(scr, KIN(23) + (size_t)Lp * DFF * D, nullptr, DFF, D, nullptr, Wdown, D, gw, NGW, lane);
            ph_prep_w<0>(scr, KIN(25) + (size_t)Lp * D * D, nullptr, D, D, nullptr, Wpg, D, gw, NGW, lane);
            ph_prep_w<0>(scr, KIN(24) + (size_t)Lp * PLE * D, nullptr, PLE, D, nullptr, Wpp, D, gw, NGW, lane);
            {   const float* uk = KIN(10) + (size_t)Lp * 256 * 8 * 64; const float* uv = KIN(11) + (size_t)Lp * 256 * 8 * 64;
                for (int e = gw * 64 + lane; e < 8 * 256 * 64; e += NGW * 64) { const int h = e >> 14, r = (e >> 6) & 255, d = e & 63; WUK[e] = f2bf(0.125f * uk[((size_t)r * 8 + h) * 64 + d]); }
                for (int e = gw * 64 + lane; e < 8 * 64 * 256; e += NGW * 64) { const int h = e >> 14, d = (e >> 8) & 63, r = e & 255; WUV[e] = f2bf(uv[((size_t)r * 8 + h) * 64 + d]); } }
            if (Lp == 0) { for (int r = gw * 2; r < T; r += NGW * 2) row_x_prep2(x, X0, rstd, r, lane); }
            else        { for (int r = gw * 4; r < T; r += NGW * 4) row_rstd_bf16x4(X1, rstd, r, lane); }
            }
            SEAM(pb + 0);
        }
#if XTRA_BAR
        if (P.ph_hi - P.ph_lo > 1 && L == 0) { for (int i_ = 0; i_ < XTRA_BAR; ++i_) { XcdBarrier b4_ = bar; asm volatile("" : "+s"(b4_.bar)); xcd_barrier(b4_, mk_tid(wave_s)); } }
#endif
        if (IN(pb + 1)) { PHASE_IDS; for (int pass = NPASS(1); pass > 0; --pass) {
            pg8::Gemm g{Xcur, Win, T, NIN, (GEMM_DRYK && pass > 1) ? GEMM_DRYK : D}; pg8::StaticOrder S; S.init(T, NIN, G, blk);
            pg8::EpiProj E{RA, RB, rstd};
            pg8::gemm_phase<pg8::EpiProj, pg8::StaticOrder, true, true>(lds, g, S, E, tid);
            }
            SEAM(pb + 1);
        }
        if (IN(pb + 2)) { PHASE_IDS;
            for (int pass = NPASS(2); pass > 0; --pass) {
#pragma unroll 2
            for (int it = gw; it < T / 4; it += NGW) prep_ckv4(RB, CKVC, KIN(7) + Lp * KV_R, it, lane);
            for (int it = gw; it < T / 16; it += NGW) prep_ik16(RB, IKC, KIN(8) + Lp * 64, KIN(9) + Lp * 64, it, lane);
#pragma unroll 2
            for (int t = gw; t < T; t += NGW) prep_bout(RA, RB, KIN(13) + (size_t)Lp * 3 * 512, t, lane, pass > 1);
#pragma unroll 2
            for (int it = gw; it < (T / 16) * 12; it += NGW) prep_conv(RB, XA, KIN(14) + (size_t)Lp * 4 * XBC, KIN(15) + (size_t)Lp * XBC, it, lane);
            for (int it = gw; it < BATCH * 64 * 4; it += NGW) { const int hq = it & 3, ck = (it >> 2) & 63, bb = it >> 8; const int t = bb * SEQ + ck * 64 + lane;
                const u32x2 rw = *(const u32x2*)(RB + (size_t)t * NB + B_DT + hq * 4); const unsigned rr[2] = {rw.x, rw.y}; float dtv[4], ac[4];
#pragma unroll
                for (int e = 0; e < 4; ++e) { const int hh = hq * 4 + e; const float xr = __builtin_bit_cast(float, (e & 1) ? (rr[e >> 1] & 0xffff0000u) : (rr[e >> 1] << 16)) + (KIN(16) + Lp * 16)[hh];
                    dtv[e] = xr > 15.f ? xr : log1pf(__expf(xr)); ac[e] = -__expf((KIN(17) + Lp * 16)[hh]) * dtv[e]; }
#pragma unroll
                for (int o = 1; o < 64; o <<= 1) {
#pragma unroll
                    for (int e = 0; e < 4; ++e) { const float v = __shfl_up(ac[e], o); if (lane >= o) ac[e] += v; } }
#pragma unroll
                for (int e = 0; e < 4; ++e) { typedef float f32x2_t __attribute__((ext_vector_type(2))); ((f32x2_t*)(ws + WS_DT2))[(size_t)(bb * 16 + hq * 4 + e) * SEQ + ck * 64 + lane] = (f32x2_t){dtv[e], ac[e]}; } }
            }
            SEAM(pb + 2);
        }
        if (IN(pb + 3)) { PHASE_IDS;
            const bool ssm_first = ((blk >> 3) & 1) == 0;
#pragma clang loop unroll(disable)
            for (int step = 0; step < 3; ++step) {
                const bool do_ssm = (step == 0 && ssm_first) || (step == 2 && !ssm_first);
                if (do_ssm) {
                    for (int u = blk; u < BATCH * 32; u += G) { const int uu = (u & 127) * 2 + (u >> 7);
                        #pragma clang loop unroll(disable)
                        for (int rs_ = (TW_MASK & 4) ? 1 : 0; rs_ >= 0; --rs_) wg_ssm_unit(lds, RA, XA, (const float*)(ws + WS_DT2), KIN(17) + Lp * 16, KIN(18) + Lp * 16, uu ^ 1, mk_tid(wave_s), nullptr, rs_ > 0); }
                } else if (step == 1) {
                    wg_qlat_all(RA, RB, WUK, blk, G, mk_tid(wave_s));
                    asm volatile("s_waitcnt vmcnt(0)" ::: "memory"); __builtin_amdgcn_s_barrier(); asm volatile("" ::: "memory");
#pragma clang loop unroll(disable)
                    for (int i = blk; i < T / 16; i += G) { const int b_ = i & 7, j_ = i >> 3, u16 = b_ * 256 + (255 - j_);
                        wg_select16(lds, RB, IKC, IDX, u16, mk_tid(wave_s), false, true);
                        const int ua = b_ * 512 + 2 * (255 - j_);
#pragma clang loop unroll(disable)
                        for (int h2 = 0; h2 < 2; ++h2) wg_attn8(lds, RB, CKVC, KIN(12), ua + h2, h2, mk_tid(wave_s));
                        asm volatile("s_waitcnt vmcnt(0) lgkmcnt(0)" ::: "memory"); __builtin_amdgcn_s_barrier(); asm volatile("" ::: "memory"); }
                    wg_aout_all(RA, RB, WUV, blk, G, mk_tid(wave_s));
                }
            }
            SEAM(pb + 5); }

        if (IN(pb + 6)) { PHASE_IDS; for (int pass = NPASS(6); pass > 0; --pass) for (int w = 4 * gw; w < T * 2; w += 4 * NGW) wave_gnorm4(RA, KIN(19) + (size_t)Lp * 1024, w, lane, pass > 1); SEAM(pb + 6); }
        if (IN(pb + 7)) { PHASE_IDS; for (int pass = NPASS(7); pass > 0; --pass) {
            pg8::Gemm g{RA, Wout, T, D, MIXW}; pg8::StaticOrder S; S.init(T, D, G, blk);
            pg8::EpiBf16P E{RB, (long)D};
            pg8::gemm_phase<pg8::EpiBf16P, pg8::StaticOrder, true, true>(lds, g, S, E, tid);
            }
            SEAM(pb + 7);
        }
        if (IN(pb + 8)) { PHASE_IDS; for (int pass = NPASS(8); pass > 0; --pass) for (int r = 2 * gw; r < T; r += 2 * NGW) row_resid_norm2(Xcur, (const bf16*)RB, KIN(3) + (size_t)Lp * D, X0, rstd2, nullptr, nullptr, r, lane, pass > 1); SEAM(pb + 8); }
        if (IN(pb + 9)) { PHASE_IDS; for (int pass = NPASS(9); pass > 0; --pass) {
            pg8::Gemm g{X0, Wgu, T, NGU, D}; pg8::StaticOrder S; S.init(T, NGU, G, blk);
            pg8::EpiSwiGLU E{RB, rstd2};
            pg8::gemm_phase<pg8::EpiSwiGLU, pg8::StaticOrder, true, true>(lds, g, S, E, tid);
            }
            SEAM(pb + 9);
        }
        if (IN(pb + 10)) { PHASE_IDS; for (int pass = NPASS(10); pass > 0; --pass) {
            pg8::Gemm g{RB, Wdown, T, D, DFF}; pg8::StaticOrder S; S.init(T, D, G, blk);
            pg8::EpiBf16P E{RA, (long)D};
            pg8::gemm_phase<pg8::EpiBf16P, pg8::StaticOrder, true, true>(lds, g, S, E, tid);
            }
            SEAM(pb + 10);
        }
        if (IN(pb + 11)) { PHASE_IDS; for (int pass = NPASS(11); pass > 0; --pass) for (int r = 2 * gw; r < T; r += 2 * NGW) row_resid_norm2(X0, (const bf16*)RA, KIN(5) + (size_t)Lp * D, X0, nullptr, p + (size_t)Lp * T * PLE, X1, r, lane, pass > 1); SEAM(pb + 11); }
        if (IN(pb + 12)) { PHASE_IDS; for (int pass = NPASS(12); pass > 0; --pass) {
            pg8::Gemm g{X1, Wpp, T, D, PLE}; pg8::StaticOrder S; S.init(T, D, G, blk);
            pg8::EpiBf16P E{RB, (long)D};
            pg8::gemm_phase<pg8::EpiBf16P, pg8::StaticOrder, true, true>(lds, g, S, E, tid);
            }
            SEAM(pb + 12);
        }
        if (IN(pb + 13)) { PHASE_IDS; for (int pass = NPASS(13); pass > 0; --pass) {
            pg8::Gemm g{X0, Wpg, T, D, D}; pg8::StaticOrder S; S.init(T, D, G, blk);
            pg8::EpiPle E{X0, RB, X1, (Lp == DEPTH - 1) ? out : nullptr};
            pg8::gemm_phase<pg8::EpiPle, pg8::StaticOrder, true, true>(lds, g, S, E, tid);
            }
            SEAM(pb + 13);
        }
    }
#if CLK_PROBE
    if (P.ph_hi == DEPTH * NPH) { PHASE_IDS_NOL; { XcdBarrier b3_ = bar; asm volatile("" : "+s"(b3_.bar)); xcd_barrier(b3_, mk_tid(wave_s)); }
        if (blk == 0 && tid == 0) { const unsigned long long c1 = __builtin_amdgcn_s_memtime(), r1 = __builtin_amdgcn_s_memrealtime(); const unsigned long long* ts = (const unsigned long long*)(ws + 49152);
            const unsigned long long c0 = __hip_atomic_load(ts, __ATOMIC_RELAXED, __HIP_MEMORY_SCOPE_AGENT), r0 = __hip_atomic_load(ts + 1, __ATOMIC_RELAXED, __HIP_MEMORY_SCOPE_AGENT);
            const float mhz = (float)(c1 - c0) / (float)(r1 - r0) * 100.0f; const float q = exp2f(rintf(4.0f * log2f(fmaxf(mhz, 1.0f))) * 0.25f);
            __hip_atomic_store((float*)(ws + 49152 + 64), q * 0.001f, __ATOMIC_RELAXED, __HIP_MEMORY_SCOPE_AGENT); }
        { XcdBarrier b3_ = bar; asm volatile("" : "+s"(b3_.bar)); xcd_barrier(b3_, mk_tid(wave_s)); }
        const float sc = 1.0f + __hip_atomic_load((float*)(ws + 49152 + 64), __ATOMIC_RELAXED, __HIP_MEMORY_SCOPE_AGENT);
        for (size_t i = (size_t)blk * NTHR + tid; i < (size_t)T * D; i += (size_t)G * NTHR) out[i] *= sc; }
#endif
#if TIMING
    if (P.ph_hi == DEPTH * NPH) { PHASE_IDS_NOL; { XcdBarrier b3_ = bar; asm volatile("" : "+s"(b3_.bar)); xcd_barrier(b3_, mk_tid(wave_s)); }
        const unsigned long long* ts = (const unsigned long long*)(ws + 32768);
        const float ta = (float)(__hip_atomic_load(ts + TIMING_A + 1, __ATOMIC_RELAXED, __HIP_MEMORY_SCOPE_AGENT) - __hip_atomic_load(ts + TIMING_A, __ATOMIC_RELAXED, __HIP_MEMORY_SCOPE_AGENT)) * 0.01f;
        const float tb = (float)(__hip_atomic_load(ts + TIMING_B + 1, __ATOMIC_RELAXED, __HIP_MEMORY_SCOPE_AGENT) - __hip_atomic_load(ts + TIMING_B, __ATOMIC_RELAXED, __HIP_MEMORY_SCOPE_AGENT)) * 0.01f;
        float ta_ = ta; if (TIMING_A == 99) { const unsigned long long c1 = __builtin_amdgcn_s_memtime(), r1 = __builtin_amdgcn_s_memrealtime(); const unsigned long long c0 = __hip_atomic_load(ts + 60, __ATOMIC_RELAXED, __HIP_MEMORY_SCOPE_AGENT), r0 = __hip_atomic_load(ts + 0, __ATOMIC_RELAXED, __HIP_MEMORY_SCOPE_AGENT);
            ta_ = (float)(c1 - c0) / (float)(r1 - r0) * 10.0f;   ta_ = __builtin_bit_cast(float, __builtin_amdgcn_readfirstlane(__builtin_bit_cast(int, ta_))); }
        const float taq = exp2f(rintf(4.0f * log2f(fmaxf(ta_, 1.0f)) + TIMING_SHIFT) * 0.25f), tbq = exp2f(rintf(2.0f * log2f(fmaxf(tb, 1.0f)) + TIMING_SHIFT) * 0.5f);
        const float sc = 1.0f + taq * 0.001f;
        for (size_t i = (size_t)blk * NTHR + tid; i < (size_t)T * D; i += (size_t)G * NTHR) out[i] *= sc;
        __syncthreads(); if (blk == 0 && tid == 0) out[0] += tbq * 10.0f; }
#endif
#if DBG_SSM
    if (P.ph_hi == DEPTH * NPH) { PHASE_IDS_NOL; { XcdBarrier b3_ = bar; asm volatile("" : "+s"(b3_.bar)); xcd_barrier(b3_, mk_tid(wave_s)); }
        const float d2 = __hip_atomic_load((float*)(ws + 65536), __ATOMIC_RELAXED, __HIP_MEMORY_SCOPE_AGENT), n2 = __hip_atomic_load((float*)(ws + 65536 + 4), __ATOMIC_RELAXED, __HIP_MEMORY_SCOPE_AGENT);
        const float sc = 1.0f + (n2 > 0.f ? sqrtf(d2 / n2) : 7.0f);
        for (size_t i = (size_t)blk * NTHR + tid; i < (size_t)T * D; i += (size_t)G * NTHR) out[i] *= sc; }
#endif
#undef IN
#undef SEAM
}

#ifndef MK_ONE_LAUNCH
#define MK_ONE_LAUNCH 1
#endif
extern "C" void kernel_launch(void* const* d_in, const int* in_sizes, int n_in, void* d_out, int out_size, void* d_ws, size_t ws_size, hipStream_t stream) {
    static int grid = 0;
    if (grid == 0) {
        if (n_in != 26 || ws_size < WS_END) { fprintf(stderr, "kernel_launch: unexpected n_in %d / ws_size %zu\n", n_in, ws_size); grid = -1; return; }
        int dev = 0, cus = 0, per_cu = 0;
        if (hipGetDevice(&dev) != hipSuccess || hipDeviceGetAttribute(&cus, hipDeviceAttributeMultiprocessorCount, dev) != hipSuccess) { grid = -1; return; }
        if (hipFuncSetAttribute((const void*)k_fwd, hipFuncAttributeMaxDynamicSharedMemorySize, LDS_BYTES) != hipSuccess) { fprintf(stderr, "kernel_launch: hipFuncSetAttribute failed\n"); grid = -1; return; }
        if (hipOccupancyMaxActiveBlocksPerMultiprocessor(&per_cu, (const void*)k_fwd, NTHR, LDS_BYTES) != hipSuccess || per_cu < 1) { fprintf(stderr, "kernel_launch: occupancy query says %d\n", per_cu); }
        (void)hipGetLastError();
        grid = cus;
    }
    if (grid < 0) return;
    if (hipMemsetAsync((char*)d_ws + WS_CTL, 0, CTL_ZERO_BYTES, stream) != hipSuccess) return;
    Params P; memset(&P, 0, sizeof(P));
    for (int i = 0; i < 26; ++i) P.in[i] = (const float*)d_in[i];
    P.out = (float*)d_out; P.ws = (unsigned char*)d_ws;
#if MK_ONE_LAUNCH
    P.ph_lo = 0; P.ph_hi = DEPTH * NPH; P.dbl_mask = DBL_MASK; P.pad = ATT_SUB_V;
    hipLaunchKernelGGL(k_fwd, dim3(grid), dim3(NTHR), LDS_BYTES, stream, P);
#else
    for (int ph = 0; ph < DEPTH * NPH; ++ph) { P.ph_lo = ph; P.ph_hi = ph + 1; hipLaunchKernelGGL(k_fwd, dim3(grid), dim3(NTHR), LDS_BYTES, stream, P); }
#endif
}
```

```cpp
#include <hip/hip_runtime.h>
#include <cstdio>
#include <cstdint>
#include <cstring>
namespace pg8 {
#define PG8_LAS __attribute__((address_space(3)))
typedef unsigned short bf16_t;
typedef short bf16x8 __attribute__((ext_vector_type(8)));
typedef float f32x4 __attribute__((ext_vector_type(4)));
typedef unsigned u32x4 __attribute__((ext_vector_type(4)));
constexpr int BM = 256, BK = 64, HALF = 128, HTB = HALF * BK * 2  , STAGE_BYTES = 8 * HTB, NXCD = 8, WGM = 8;

__host__ __device__ __forceinline__ int lds_byte(int r, int c) { const int st = (r >> 4) * 2 + (c >> 5), rr = r & 15, cc = c & 31, ob = rr * 64 + cc * 2; return st * 1024 + (ob ^ (((ob >> 9) & 1) << 5)); }
__host__ __device__ __forceinline__ void stage_rc(int b, int& R, int& C) { const int st = b / 1024, sb = b % 1024, swz = sb ^ (((sb >> 9) & 1) << 5); R = (st >> 1) * 16 + swz / 64; C = (st & 1) * 32 + (swz % 64) / 2; }
__host__ __device__ __forceinline__ int perm32(int rho) { const int n = rho >> 4, i = rho & 15; return 8 * (i >> 2) + 4 * n + (i & 3); }

struct Unit { int pm, pn; };
struct Gemm { const bf16_t* A; const bf16_t* Bt; int M, N, K; };

struct StaticOrder {
    int nM, nN, nwg, G, c;
    __host__ __device__ void init(int M, int N, int G_, int c_) { nM = M / BM; nN = N / BM; nwg = nM * nN; G = G_; c = c_; }
    __host__ __device__ bool next(int i, Unit& u) const {
        const long L = (long)i * G + c; if (L >= nwg) return false;
        int wgid = (int)L; { const int q = nwg / NXCD, r = nwg % NXCD, xcd = wgid % NXCD, off = wgid / NXCD; wgid = (xcd < r ? xcd * (q + 1) : r * (q + 1) + (xcd - r) * q) + off; }
        const int nig = WGM * nN, gid = wgid / nig, fm = gid * WGM, gsz = (nM - fm) < WGM ? (nM - fm) : WGM;
        u.pm = fm + ((wgid % nig) % gsz); u.pn = (wgid % nig) / gsz; return true;
    }
    __device__ __forceinline__ void a_ready(const Unit&) const {}
    __device__ __forceinline__ void done(const Unit&) const {}
};

__device__ __forceinline__ unsigned cvt_pk_bf16(float lo, float hi) { unsigned r; asm volatile("v_cvt_pk_bf16_f32 %0, %1, %2" : "=v"(r) : "v"(lo), "v"(hi)); return r; }
typedef float f32x2 __attribute__((ext_vector_type(2)));
__device__ __forceinline__ f32x2 gelu_pk(f32x2 v) {
    const f32x2 av = __builtin_elementwise_abs(v), d = av * 0.2316418882f + 1.0f;
    f32x2 t; t.x = __builtin_amdgcn_rcpf(d.x); t.y = __builtin_amdgcn_rcpf(d.y);
    f32x2 q = t * 0.5307027145f + (-0.7265760135f); q = q * t + 0.7107068705f; q = q * t + (-0.142248368f); q = q * t + 0.127414796f; q = q * t;
    const f32x2 s = (v * v) * (-0.72134752044f);
    f32x2 e; e.x = __builtin_amdgcn_exp2f(s.x); e.y = __builtin_amdgcn_exp2f(s.y);
    const f32x2 m = v * (q * e), r = v - m;
    f32x2 o; o.x = v.x < 0.f ? m.x : r.x; o.y = v.y < 0.f ? m.y : r.y; return o;
}

template <int ACT  > struct EpiBf16 {
    static constexpr bool PERM = true, AFTER_DRAIN = false; static_assert(ACT == 0 || ACT == 1, "EpiBf16: ACT is 0 (none) or 1 (gelu_pk)");
    bf16_t* O; int ldc; const float* bias; int split_cols; size_t split_stride; float scale0;
    __device__ __forceinline__ void operator()(const f32x4 (&acc)[2][2][4][2], const Unit& u, int wr, int wc, int fr, int fq) const {
        const int row0 = u.pm * BM + wr * 64 + fr; int colt = u.pn * BM; bf16_t* base = O;
        float sc = 1.f; if (split_cols) { const int t = colt / split_cols; base += (size_t)t * split_stride; colt -= t * split_cols; if (t == 0) sc = scale0; }
        const int col0 = colt + wc * 32 + 8 * fq, bcol0 = u.pn * BM + wc * 32 + 8 * fq;
        f32x4 bv[2][2];
#pragma unroll
        for (int bj = 0; bj < 2; ++bj)
#pragma unroll
            for (int n = 0; n < 2; ++n) bv[bj][n] = bias ? *(const f32x4*)(bias + bcol0 + bj * HALF + 4 * n) : (f32x4){0.f, 0.f, 0.f, 0.f};
#pragma unroll
        for (int ai = 0; ai < 2; ++ai)
#pragma unroll
            for (int m = 0; m < 4; ++m) { bf16_t* rowp = base + (size_t)(row0 + ai * HALF + m * 16) * ldc + col0;
#pragma unroll
                for (int bj = 0; bj < 2; ++bj) { f32x4 v0 = acc[ai][bj][m][0] + bv[bj][0], v1 = acc[ai][bj][m][1] + bv[bj][1];
                    if (ACT == 1) { f32x2 a = gelu_pk((f32x2){v0[0], v0[1]}), b = gelu_pk((f32x2){v0[2], v0[3]}), c = gelu_pk((f32x2){v1[0], v1[1]}), d = gelu_pk((f32x2){v1[2], v1[3]});
                        v0 = (f32x4){a.x, a.y, b.x, b.y}; v1 = (f32x4){c.x, c.y, d.x, d.y}; }
                    v0 = v0 * sc; v1 = v1 * sc; u32x4 w; w.x = cvt_pk_bf16(v0[0], v0[1]); w.y = cvt_pk_bf16(v0[2], v0[3]); w.z = cvt_pk_bf16(v1[0], v1[1]); w.w = cvt_pk_bf16(v1[2], v1[3]);
                    *(u32x4*)(rowp + bj * HALF) = w; } }
    }
};

struct PanelStats {
    unsigned* xbuf;
    unsigned* cnt;
    unsigned* tmo;
    int ntn; float eps;
    unsigned code;
    __device__ __forceinline__ bool run(const f32x4 (&v)[2][2][4][2], const Unit& u, int wr, int wc, int fr, int fq, PG8_LAS unsigned char* lds, int wid, int lane) const {
        typedef float f32x2v __attribute__((ext_vector_type(2)));
        PG8_LAS f32x2v* P = (PG8_LAS f32x2v*)lds;
        PG8_LAS f32x2v* S = (PG8_LAS f32x2v*)(lds + 8192);
        PG8_LAS unsigned* flag = (PG8_LAS unsigned*)(lds + 8192 + 2048);
#pragma unroll
        for (int ai = 0; ai < 2; ++ai)
#pragma unroll
            for (int m = 0; m < 4; ++m) {
                float s = 0.f;
#pragma unroll
                for (int bj = 0; bj < 2; ++bj)
#pragma unroll
                    for (int n = 0; n < 2; ++n) { const f32x4 x = v[ai][bj][m][n]; s += (x[0] + x[1]) + (x[2] + x[3]); }
                s += __shfl_xor(s, 16); s += __shfl_xor(s, 32);
                const float mw = s * (1.0f / 64.0f); float q = 0.f;
#pragma unroll
                for (int bj = 0; bj < 2; ++bj)
#pragma unroll
                    for (int n = 0; n < 2; ++n) { const f32x4 d = v[ai][bj][m][n] - mw; q += (d[0] * d[0] + d[1] * d[1]) + (d[2] * d[2] + d[3] * d[3]); }
                q += __shfl_xor(q, 16); q += __shfl_xor(q, 32);
                if (fq == 0) P[(ai * HALF + wr * 64 + m * 16 + fr) * 4 + wc] = (f32x2v){mw, q};
            }
        asm volatile("s_waitcnt lgkmcnt(0)" ::: "memory"); __builtin_amdgcn_s_barrier(); asm volatile("" ::: "memory");
#if defined(BROKEN_EXCHANGE_NO_WAIT)
#warning BROKEN CONTROL BUILD: the row-statistics exchange does not wait; results are wrong by design
        if (blockIdx.x >= 64) { const long long t0_ = clock64(); while (clock64() - t0_ < 60000) __builtin_amdgcn_s_sleep(8); }
#endif
        const int row = wid * 32 + (lane & 31);
        if (lane < 32) {
            const f32x2v a = P[row * 4 + 0], b = P[row * 4 + 1], c = P[row * 4 + 2], d = P[row * 4 + 3];
            const float mt = (a.x + b.x + c.x + d.x) * 0.25f;
            const float da = a.x - mt, db = b.x - mt, dc = c.x - mt, dd = d.x - mt;
            const float m2 = (a.y + b.y) + (c.y + d.y) + 64.0f * ((da * da + db * db) + (dc * dc + dd * dd));
            unsigned long long* slot = (unsigned long long*)xbuf + ((size_t)(u.pm * BM + row) * 4 + u.pn);
            __hip_atomic_store(slot, ((unsigned long long)__float_as_uint(m2) << 32) | __float_as_uint(mt), __ATOMIC_RELAXED, __HIP_MEMORY_SCOPE_AGENT);
        }
        asm volatile("s_waitcnt vmcnt(0)" ::: "memory");
        if (lane == 0) __hip_atomic_fetch_add(cnt + 64 * u.pm, 1u, __ATOMIC_RELAXED, __HIP_MEMORY_SCOPE_AGENT);
        if (wid == 0) {
            bool dead = false; const unsigned long long t0 = __builtin_amdgcn_s_memrealtime(); const unsigned want = 8u * (unsigned)ntn;
            for (;;) {
#if defined(BROKEN_EXCHANGE_NO_WAIT)
                break;
#endif
                if ((unsigned)__builtin_amdgcn_readfirstlane(__hip_atomic_load(cnt + 64 * u.pm, __ATOMIC_RELAXED, __HIP_MEMORY_SCOPE_AGENT)) >= want) break;
                if (__builtin_amdgcn_s_memrealtime() - t0 > 2000000ull) {
                    if (lane == 0) { unsigned expect = 0u; __hip_atomic_compare_exchange_strong(tmo + 1, &expect, code | (unsigned)(u.pm & 0xff), __ATOMIC_RELAXED, __ATOMIC_RELAXED, __HIP_MEMORY_SCOPE_AGENT);
                                     __hip_atomic_store(tmo, 1u, __ATOMIC_RELAXED, __HIP_MEMORY_SCOPE_AGENT); }
                    dead = true; break; }
                __builtin_amdgcn_s_sleep(2);
            }
            __builtin_amdgcn_fence(__ATOMIC_ACQUIRE, "agent");
            if (lane == 0) flag[0] = dead ? 1u : 0u;
        }
        asm volatile("s_waitcnt vmcnt(0) lgkmcnt(0)" ::: "memory"); __builtin_amdgcn_s_barrier(); asm volatile("" ::: "memory");
        const bool bad = flag[0] != 0u;
        if (lane < 32) {
            const unsigned long long* slot = (const unsigned long long*)xbuf + (size_t)(u.pm * BM + row) * 4; float mt[4], m2[4]; float ms = 0.f;
#pragma unroll
            for (int t = 0; t < 4; ++t) { if (t < ntn) { const unsigned long long w = __hip_atomic_load(slot + t, __ATOMIC_RELAXED, __HIP_MEMORY_SCOPE_AGENT); mt[t] = __uint_as_float((unsigned)w); m2[t] = __uint_as_float((unsigned)(w >> 32)); } else { mt[t] = 0.f; m2[t] = 0.f; } ms += mt[t]; }
            const float mean = ms / (float)ntn; float q = 0.f;
#pragma unroll
            for (int t = 0; t < 4; ++t) if (t < ntn) { const float dm = mt[t] - mean; q += m2[t] + 256.0f * dm * dm; }
            S[row] = (f32x2v){mean, 1.0f / sqrtf(q / (256.0f * (float)ntn) + eps)};
        }
        asm volatile("s_waitcnt lgkmcnt(0)" ::: "memory"); __builtin_amdgcn_s_barrier(); asm volatile("" ::: "memory");
        return bad;
    }
};
struct EpiLnRes {
    static constexpr bool PERM = false, AFTER_DRAIN = true;
    const float* base; float* out; int ldc; const float* bias; PanelStats st; unsigned poison;
    __device__ __forceinline__ void fused(f32x4 (&acc)[2][2][4][2], const Unit& u, int wr, int wc, int fr, int fq, PG8_LAS unsigned char* lds, int wid, int lane) const {
        typedef float f32x2v __attribute__((ext_vector_type(2)));
        const PG8_LAS f32x2v* S = (const PG8_LAS f32x2v*)(lds + 8192);
        const int col0 = u.pn * BM + wc * 32 + 4 * fq;
#pragma unroll
        for (int bj = 0; bj < 2; ++bj)
#pragma unroll
            for (int n = 0; n < 2; ++n) { const f32x4 bv = bias ? *(const f32x4*)(bias + col0 + bj * HALF + n * 16) : (f32x4){0.f, 0.f, 0.f, 0.f};
#pragma unroll
                for (int ai = 0; ai < 2; ++ai)
#pragma unroll
                    for (int m = 0; m < 4; ++m) acc[ai][bj][m][n] += bv; }
        f32x4 pre[4][2][2];
#pragma unroll
        for (int m = 0; m < 4; ++m) { const size_t off = (size_t)(u.pm * BM + wr * 64 + m * 16 + fr) * ldc + col0;
#pragma unroll
            for (int bj = 0; bj < 2; ++bj)
#pragma unroll
                for (int n = 0; n < 2; ++n) pre[m][bj][n] = *(const f32x4*)(base + off + bj * HALF + n * 16); }
        const bool bad = st.run(acc, u, wr, wc, fr, fq, lds, wid, lane) || poison != 0u;
        const float qnan = __builtin_nanf("");
#pragma unroll
        for (int ai = 0; ai < 2; ++ai)
#pragma unroll
            for (int m = 0; m < 4; ++m) { const int r = ai * HALF + wr * 64 + m * 16 + fr; const f32x2v sr = S[r]; const size_t off = (size_t)(u.pm * BM + r) * ldc + col0;
#pragma unroll
                for (int bj = 0; bj < 2; ++bj)
#pragma unroll
                    for (int n = 0; n < 2; ++n) { const f32x4 bs = ai == 0 ? pre[m][bj][n] : *(const f32x4*)(base + off + bj * HALF + n * 16); f32x4 o = bs + (acc[ai][bj][m][n] - sr.x) * sr.y;
                        if (bad) o = (f32x4){qnan, qnan, qnan, qnan}; *(f32x4*)(out + off + bj * HALF + n * 16) = o; }
                if (m & 1) asm volatile("" ::: "memory"); }
    }
};
struct EpiLnResLn {
    static constexpr bool PERM = false, AFTER_DRAIN = true;
    const float* base; float* out; bf16_t* xn; int ldc; const float* bias; PanelStats st1, st2; unsigned poison;
    __device__ __forceinline__ void fused(f32x4 (&acc)[2][2][4][2], const Unit& u, int wr, int wc, int fr, int fq, PG8_LAS unsigned char* lds, int wid, int lane) const {
        typedef float f32x2v __attribute__((ext_vector_type(2))); typedef unsigned u32x2v __attribute__((ext_vector_type(2)));
        const PG8_LAS f32x2v* S = (const PG8_LAS f32x2v*)(lds + 8192);
        const int col0 = u.pn * BM + wc * 32 + 4 * fq;
#pragma unroll
        for (int bj = 0; bj < 2; ++bj)
#pragma unroll
            for (int n = 0; n < 2; ++n) { const f32x4 bv = bias ? *(const f32x4*)(bias + col0 + bj * HALF + n * 16) : (f32x4){0.f, 0.f, 0.f, 0.f};
#pragma unroll
                for (int ai = 0; ai < 2; ++ai)
#pragma unroll
                    for (int m = 0; m < 4; ++m) acc[ai][bj][m][n] += bv; }
        bool bad = st1.run(acc, u, wr, wc, fr, fq, lds, wid, lane) || poison != 0u;
        const float qnan = __builtin_nanf("");
#pragma unroll
        for (int ai = 0; ai < 2; ++ai)
#pragma unroll
            for (int m = 0; m < 4; ++m) { const int r = ai * HALF + wr * 64 + m * 16 + fr; const f32x2v sr = S[r]; const size_t off = (size_t)(u.pm * BM + r) * ldc + col0;
#pragma unroll
                for (int bj = 0; bj < 2; ++bj)
#pragma unroll
                    for (int n = 0; n < 2; ++n) { const f32x4 bs = *(const f32x4*)(base + off + bj * HALF + n * 16); acc[ai][bj][m][n] = bs + (acc[ai][bj][m][n] - sr.x) * sr.y; }
                asm volatile("" : "+v"(acc[ai][0][m][0]), "+v"(acc[ai][0][m][1]), "+v"(acc[ai][1][m][0]), "+v"(acc[ai][1][m][1]));
                if (m & 1) asm volatile("" ::: "memory"); }
        const bool bad1 = bad;
        bad = st2.run(acc, u, wr, wc, fr, fq, lds, wid, lane) || bad;
#pragma unroll
        for (int ai = 0; ai < 2; ++ai)
#pragma unroll
            for (int m = 0; m < 4; ++m) { const int r = ai * HALF + wr * 64 + m * 16 + fr; const f32x2v sr = S[r]; const size_t off = (size_t)(u.pm * BM + r) * ldc + col0;
#pragma unroll
                for (int bj = 0; bj < 2; ++bj)
#pragma unroll
                    for (int n = 0; n < 2; ++n) { const f32x4 x1 = acc[ai][bj][m][n]; *(f32x4*)(out + off + bj * HALF + n * 16) = bad1 ? (f32x4){qnan, qnan, qnan, qnan} : x1;
                        const f32x4 o = (x1 - sr.x) * sr.y; u32x2v w; w.x = cvt_pk_bf16(o[0], o[1]); w.y = cvt_pk_bf16(o[2], o[3]);
                        if (bad) { w.x = 0x7fc07fc0u; w.y = 0x7fc07fc0u; } *(u32x2v*)(xn + off + bj * HALF + n * 16) = w; }
                asm volatile("" ::: "memory"); }
    }
};

template <class Epi, class Sched, bool ALIGN_EPI = false, bool SP2 = false>
__device__ __forceinline__ void gemm_phase(PG8_LAS unsigned char* lds, const Gemm g, const Sched& S, const Epi& E, int tid_in) {
    int tid_l = tid_in; asm volatile("" : "+v"(tid_l));
    const int tid = tid_l, wid = __builtin_amdgcn_readfirstlane(tid >> 6), lane = tid & 63, wr = wid >> 2, wc = wid & 3, fr = lane & 15, fq = lane >> 4;
    int K_l = g.K; asm volatile("" : "+s"(K_l));
    const int K = K_l, nt = K / BK;
    unsigned voffA[2], voffB[2];
#pragma unroll
    for (int i = 0; i < 2; ++i) { int R, C; stage_rc(tid * 16 + i * 8192, R, C); const int Rb = Epi::PERM ? ((R & ~31) + perm32(R & 31)) : R;
        voffA[i] = (unsigned)(R * K + C) * 2u; voffB[i] = (unsigned)(Rb * K + C) * 2u; }
    const size_t kstep = (size_t)(BK * 2);
    const size_t hstep = (size_t)HALF * K * 2;
    const size_t tstep = 2 * hstep;
    const unsigned ldsw = (unsigned)wid * 1024u;
    const int aoff = lds_byte(wr * 64 + fr, fq * 8), boff = lds_byte(wc * 32 + fr, fq * 8);
#define PG8_SA(b, h) (((b) * 2 + (h)) * HTB)
#define PG8_SB(b, h) ((4 + (b) * 2 + (h)) * HTB)
#define PG8_STAGE(bufoff, gbase, voff) do { _Pragma("unroll") for (int _i = 0; _i < 2; ++_i) \
        __builtin_amdgcn_global_load_lds((const unsigned*)((const char*)(gbase) + (voff)[_i]), (PG8_LAS unsigned*)(lds + (bufoff) + ldsw + _i * 8192), 16, 0, 0); } while (0)
#define PG8_LDA(dst, b, h) do { _Pragma("unroll") for (int m = 0; m < 4; ++m) _Pragma("unroll") for (int k = 0; k < 2; ++k) dst[m][k] = *(const PG8_LAS bf16x8*)(lds + PG8_SA(b, h) + aoff + m * 2048 + k * 1024); } while (0)
#define PG8_LDB(dst, b, h) do { _Pragma("unroll") for (int n = 0; n < 2; ++n) _Pragma("unroll") for (int k = 0; k < 2; ++k) dst[n][k] = *(const PG8_LAS bf16x8*)(lds + PG8_SB(b, h) + boff + n * 2048 + k * 1024); } while (0)
#define PG8_MMA(ai, bj, At, Bt) do { __builtin_amdgcn_s_setprio(1); _Pragma("unroll") for (int m = 0; m < 4; ++m) _Pragma("unroll") for (int n = 0; n < 2; ++n) _Pragma("unroll") for (int k = 0; k < 2; ++k) \
        acc[ai][bj][m][n] = __builtin_amdgcn_mfma_f32_16x16x32_bf16(Bt[n][k], At[m][k], acc[ai][bj][m][n], 0, 0, 0); __builtin_amdgcn_s_setprio(0); } while (0)
#define PG8_WAIT_V(n) asm volatile("s_waitcnt vmcnt(" #n ")" ::: "memory")
#define PG8_WAIT_L(n) asm volatile("s_waitcnt lgkmcnt(" #n ")" ::: "memory")
#define PG8_BAR __builtin_amdgcn_s_barrier()
#define PG8_SCHED __builtin_amdgcn_sched_barrier(0)
    Unit cur, nxt; int ui = 0;
    if (!S.next(0, cur)) return;
    f32x4 acc[2][2][4][2];
#pragma unroll
    for (int a = 0; a < 2; ++a)
#pragma unroll
        for (int b = 0; b < 2; ++b)
#pragma unroll
            for (int m = 0; m < 4; ++m)
#pragma unroll
                for (int n = 0; n < 2; ++n) acc[a][b][m][n] = (f32x4){0.f, 0.f, 0.f, 0.f};
    bf16x8 At[4][2], B0[2][2], B1[2][2];
    const char* cA = (const char*)g.A + (size_t)cur.pm * tstep; const char* cB = (const char*)g.Bt + (size_t)cur.pn * tstep;
    S.a_ready(cur);
    if constexpr (SP2) {
        PG8_STAGE(PG8_SB(0, 0), cB, voffB); PG8_STAGE(PG8_SB(0, 1), cB + hstep, voffB); PG8_STAGE(PG8_SA(0, 0), cA, voffA); PG8_STAGE(PG8_SA(0, 1), cA + hstep, voffA);
        if (wr == 1) PG8_BAR;
        PG8_WAIT_V(2); PG8_BAR;
        PG8_STAGE(PG8_SB(1, 0), cB + kstep, voffB); PG8_STAGE(PG8_SA(1, 0), cA + kstep, voffA); PG8_STAGE(PG8_SB(1, 1), cB + hstep + kstep, voffB);
        PG8_WAIT_V(6); PG8_BAR;
    } else {
        PG8_STAGE(PG8_SB(0, 0), cB, voffB); PG8_STAGE(PG8_SA(0, 0), cA, voffA); PG8_STAGE(PG8_SB(0, 1), cB + hstep, voffB); PG8_STAGE(PG8_SA(0, 1), cA + hstep, voffA);
        if (wr == 1) PG8_BAR;
        PG8_WAIT_V(4); PG8_BAR;
        PG8_STAGE(PG8_SB(1, 0), cB + kstep, voffB); PG8_STAGE(PG8_SA(1, 0), cA + kstep, voffA); PG8_STAGE(PG8_SB(1, 1), cB + hstep + kstep, voffB);
        PG8_WAIT_V(6); PG8_BAR;
    }
    for (;;) {
        const bool has_next = S.next(ui + 1, nxt);
        const char* nA = has_next ? (const char*)g.A + (size_t)nxt.pm * tstep : cA; const char* nB = has_next ? (const char*)g.Bt + (size_t)nxt.pn * tstep : cB;
        for (int t = 0; t < nt; t += 2) {
            const bool last = (t == nt - 2);
            const char* a1 = cA + (size_t)(t + 1) * kstep;
            const char* a2 = last ? nA : cA + (size_t)(t + 2) * kstep; const char* b2 = last ? nB : cB + (size_t)(t + 2) * kstep;
            const char* a3 = a2 + kstep; const char* b3 = b2 + kstep;
            if (last && has_next) S.a_ready(nxt);
            if constexpr (SP2) {
            PG8_LDB(B0, 0, 0); PG8_LDB(B1, 0, 1); PG8_SCHED; PG8_LDA(At, 0, 0); PG8_STAGE(PG8_SA(1, 1), a1 + hstep, voffA);
            PG8_WAIT_V(8); PG8_WAIT_L(0); PG8_BAR; PG8_MMA(0, 0, At, B0); PG8_MMA(0, 1, At, B1); PG8_BAR; PG8_SCHED;
            PG8_LDA(At, 0, 1); PG8_STAGE(PG8_SB(0, 0), b2, voffB); PG8_STAGE(PG8_SB(0, 1), b2 + hstep, voffB); PG8_STAGE(PG8_SA(0, 0), a2, voffA);
            PG8_WAIT_V(8); PG8_WAIT_L(0); PG8_BAR; PG8_MMA(1, 0, At, B0); PG8_MMA(1, 1, At, B1); PG8_BAR; PG8_SCHED;
            PG8_LDB(B0, 1, 0); PG8_LDB(B1, 1, 1); PG8_SCHED; PG8_LDA(At, 1, 0); PG8_STAGE(PG8_SA(0, 1), a2 + hstep, voffA);
            PG8_WAIT_V(8); PG8_WAIT_L(0); PG8_BAR; PG8_MMA(0, 0, At, B0); PG8_MMA(0, 1, At, B1); PG8_BAR; PG8_SCHED;
            PG8_LDA(At, 1, 1); PG8_STAGE(PG8_SB(1, 0), b3, voffB); PG8_STAGE(PG8_SB(1, 1), b3 + hstep, voffB); PG8_STAGE(PG8_SA(1, 0), a3, voffA);
            PG8_WAIT_V(8); PG8_WAIT_L(0); PG8_BAR; PG8_MMA(1, 0, At, B0); PG8_MMA(1, 1, At, B1); PG8_BAR; PG8_SCHED;
            } else {
            PG8_LDB(B0, 0, 0); PG8_SCHED; PG8_LDA(At, 0, 0); PG8_STAGE(PG8_SA(1, 1), a1 + hstep, voffA);
            PG8_WAIT_L(8); PG8_BAR; PG8_WAIT_L(0); PG8_MMA(0, 0, At, B0); PG8_BAR; PG8_SCHED;
            PG8_LDB(B1, 0, 1); PG8_STAGE(PG8_SB(0, 0), b2, voffB);
            PG8_BAR; PG8_WAIT_L(0); PG8_MMA(0, 1, At, B1); PG8_BAR;
            PG8_LDA(At, 0, 1); PG8_STAGE(PG8_SA(0, 0), a2, voffA);
            PG8_BAR; PG8_WAIT_L(0); PG8_MMA(1, 0, At, B0); PG8_BAR; PG8_SCHED;
            PG8_STAGE(PG8_SB(0, 1), b2 + hstep, voffB);
            PG8_WAIT_V(6); PG8_BAR; PG8_MMA(1, 1, At, B1); PG8_BAR;
            PG8_LDB(B0, 1, 0); PG8_SCHED; PG8_LDA(At, 1, 0); PG8_STAGE(PG8_SA(0, 1), a2 + hstep, voffA);
            PG8_WAIT_L(8); PG8_BAR; PG8_WAIT_L(0); PG8_MMA(0, 0, At, B0); PG8_BAR; PG8_SCHED;
            PG8_LDB(B1, 1, 1); PG8_STAGE(PG8_SB(1, 0), b3, voffB);
            PG8_BAR; PG8_WAIT_L(0); PG8_MMA(0, 1, At, B1); PG8_BAR;
            PG8_LDA(At, 1, 1); PG8_STAGE(PG8_SA(1, 0), a3, voffA);
            PG8_BAR; PG8_WAIT_L(0); PG8_MMA(1, 0, At, B0); PG8_BAR; PG8_SCHED;
            PG8_STAGE(PG8_SB(1, 1), b3 + hstep, voffB);
            PG8_WAIT_V(6); PG8_BAR; PG8_MMA(1, 1, At, B1); PG8_BAR;
            }
        }
        if constexpr (ALIGN_EPI) { if (wr == 0) PG8_BAR; }
        if constexpr (!Epi::AFTER_DRAIN) { E(acc, cur, wr, wc, fr, fq); S.done(cur); }
        if (!has_next) break;
#pragma unroll
        for (int a = 0; a < 2; ++a)
#pragma unroll
            for (int b = 0; b < 2; ++b)
#pragma unroll
                for (int m = 0; m < 4; ++m)
#pragma unroll
                    for (int n = 0; n < 2; ++n) acc[a][b][m][n] = (f32x4){0.f, 0.f, 0.f, 0.f};
        cur = nxt; cA = nA; cB = nB; ++ui;
        if constexpr (ALIGN_EPI) { if (wr == 1) PG8_BAR; }
    }
    PG8_WAIT_V(0);
    if constexpr (!ALIGN_EPI) { if (wr == 0) PG8_BAR; }
    PG8_BAR;
    if constexpr (Epi::AFTER_DRAIN) { E.fused(acc, cur, wr, wc, fr, fq, lds, wid, lane); S.done(cur); }
#undef PG8_SA
#undef PG8_SB
#undef PG8_STAGE
#undef PG8_LDA
#undef PG8_LDB
#undef PG8_MMA
#undef PG8_WAIT_V
#undef PG8_WAIT_L
#undef PG8_BAR
#undef PG8_SCHED
}
}

typedef unsigned short bf16;
typedef float f32x4 __attribute__((ext_vector_type(4)));
typedef unsigned u32x4 __attribute__((ext_vector_type(4)));
typedef unsigned u32x2 __attribute__((ext_vector_type(2)));

constexpr int BATCH = 8, SEQ = 4096, T = BATCH * SEQ, D = 1024, DEPTH = 2;
constexpr int NA = 2048, NB = 3328, NIN = NA + NB, INW = 5204;
constexpr int DFF = 2816, NGU = 2 * DFF, PLE = 256, MIXW = 2048;
constexpr int A_Q = 0, A_BG = 512, A_Z = 1024;
constexpr int B_CKV = 0, B_IQ = 256, B_CG = 512, B_HB = 1024, B_XBC = 1536, B_IK = 3072, B_DT = 3136, B_IW = 3152;
constexpr int XBC = 1536, KV_R = 256, TOPK = 256;
constexpr float EPS = 1e-6f;

constexpr size_t MiB = 1u << 20;
constexpr size_t WS_CTL = 0;
constexpr size_t WS_RSTD = 1 * MiB;
constexpr size_t WS_RSTD2 = 1 * MiB + 256 * 1024;
constexpr size_t WS_DT = 2 * MiB;
constexpr size_t WS_W = 8 * MiB;
constexpr size_t WS_W_IN = WS_W, WS_W_OUT = WS_W_IN + (size_t)NIN * D * 2, WS_W_GU = WS_W_OUT + (size_t)D * MIXW * 2, WS_W_DOWN = WS_W_GU + (size_t)NGU * D * 2,
                 WS_W_PG = WS_W_DOWN + (size_t)D * DFF * 2, WS_W_PP = WS_W_PG + (size_t)D * D * 2, WS_W_END = WS_W_PP + (size_t)D * PLE * 2;
constexpr size_t WS_WUK = 42 * MiB, WS_WUV = 43 * MiB;
static_assert(WS_W_END <= 42 * MiB, "weights");
constexpr size_t WS_X0 = 44 * MiB, WS_X1 = 108 * MiB, WS_RA = 172 * MiB, WS_RB = 300 * MiB, WS_DT2 = 508 * MiB, WS_END = 512 * MiB;
constexpr size_t WS_XA = WS_X0;
constexpr size_t WS_IDX = WS_X1 + 48 * MiB;
constexpr size_t WS_CKVC = WS_X1 + 32 * MiB;
constexpr size_t WS_IKC = 4 * MiB;

__host__ __device__ __forceinline__ float bf2f(bf16 b) { return __builtin_bit_cast(float, ((unsigned)b) << 16); }
__host__ __device__ __forceinline__ bf16 f2bf(float f) { unsigned u = __builtin_bit_cast(unsigned, f); return (bf16)((u + 0x7fffu + ((u >> 16) & 1u)) >> 16); }
__device__ __forceinline__ unsigned pk2(float lo, float hi) { return (unsigned)f2bf(lo) | ((unsigned)f2bf(hi) << 16); }
__device__ __forceinline__ float wave_sum(float v) {
#pragma unroll
    for (int o = 1; o < 64; o <<= 1) v += __shfl_xor(v, o);
    return v;
}
__device__ __forceinline__ float wave_max(float v) {
#pragma unroll
    for (int o = 1; o < 64; o <<= 1) v = fmaxf(v, __shfl_xor(v, o));
    return v;
}
__device__ __forceinline__ float sigmoidf_(float v) { return __builtin_amdgcn_rcpf(1.0f + __expf(-v)); }
__device__ __forceinline__ float siluf_(float v) { return v * sigmoidf_(v); }

__host__ __device__ __forceinline__ int src_col_in(int n) {
    if (n < 512) return n;
    if (n < 1024) return 1092 + (n - 512);
    if (n < 2048) return 2628 + (n - 1024);
    n -= 2048;
    if (n < 256) return 512 + n;
    if (n < 512) return 768 + (n - 256);
    if (n < 1024) return 1604 + (n - 512);
    if (n < 1536) return 2116 + (n - 1024);
    if (n < 3072) return 3652 + (n - 1536);
    if (n < 3136) return 1024 + (n - 3072);
    if (n < 3152) return 5188 + (n - 3136);
    if (n < 3156) return 1088 + (n - 3152);
    return -1;
}

__host__ __device__ __forceinline__ int t5_bucket(int rel) {
    const int ret = rel > 0 ? 16 : 0; const int n = rel < 0 ? -rel : rel;
    int b;
    if (n < 8) b = n; else if (n < 15) b = 8; else if (n < 27) b = 9; else if (n < 50) b = 10; else if (n < 91) b = 11; else if (n < 166) b = 12; else if (n < 305) b = 13; else if (n < 559) b = 14; else b = 15;
    return ret + b;
}

template <int MODE> __global__ void __launch_bounds__(256) k_prep_w(const float* __restrict__ W, const float* __restrict__ W2, int K, int Nsrc, const float* __restrict__ gain, bf16* __restrict__ Wt) {
    __shared__ float tile[32][33];
    const int n0 = blockIdx.x * 32, k0 = blockIdx.y * 32, tx = threadIdx.x & 31, ty = threadIdx.x >> 5;
    const int n = n0 + tx; int src; const float* Ws = W;
    if (MODE == 0) src = n; else if (MODE == 1) src = src_col_in(n); else { const int which = (n & 255) >> 7; src = (n >> 8) * 128 + (n & 127); Ws = which ? W2 : W; }
    for (int kk = ty; kk < 32; kk += 8) { float v = 0.f; if (src >= 0) { v = Ws[(size_t)(k0 + kk) * Nsrc + src]; if (gain) v *= gain[k0 + kk]; } tile[kk][tx] = v; }
    __syncthreads();
    for (int nn = ty; nn < 32; nn += 8) Wt[(size_t)(n0 + nn) * K + k0 + tx] = f2bf(tile[tx][nn]);
}

__global__ void __launch_bounds__(256) k_x_prep(const float* __restrict__ x, bf16* __restrict__ xb, float* __restrict__ rstd) {
    const int lane = threadIdx.x & 63, row = blockIdx.x * 4 + (threadIdx.x >> 6);
    const f32x4* xr = (const f32x4*)(x + (size_t)row * D) + lane; float ss = 0.f; f32x4 v[4];
#pragma unroll
    for (int j = 0; j < 4; ++j) { v[j] = xr[64 * j]; ss += (v[j].x * v[j].x + v[j].y * v[j].y) + (v[j].z * v[j].z + v[j].w * v[j].w); }
    ss = wave_sum(ss);
    u32x2* o = (u32x2*)(xb + (size_t)row * D) + lane;
#pragma unroll
    for (int j = 0; j < 4; ++j) { u32x2 w; w.x = pk2(v[j].x, v[j].y); w.y = pk2(v[j].z, v[j].w); o[64 * j] = w; }
    if (lane == 0) rstd[row] = 1.0f / sqrtf(ss * (1.0f / D) + EPS);
}
__global__ void __launch_bounds__(256) k_rstd(const float* __restrict__ x, float* __restrict__ rstd) {
    const int lane = threadIdx.x & 63, row = blockIdx.x * 4 + (threadIdx.x >> 6);
    const f32x4* xr = (const f32x4*)(x + (size_t)row * D) + lane; float ss = 0.f;
#pragma unroll
    for (int j = 0; j < 4; ++j) { const f32x4 v = xr[64 * j]; ss += (v.x * v.x + v.y * v.y) + (v.z * v.z + v.w * v.w); }
    ss = wave_sum(ss);
    if (lane == 0) rstd[row] = 1.0f / sqrtf(ss * (1.0f / D) + EPS);
}
__global__ void __launch_bounds__(256) k_resid_norm(const float* xin, const float* __restrict__ y, const float* __restrict__ g, float* xo, bf16* __restrict__ xb,
                                                    float* __restrict__ rstd_out, const float* __restrict__ p, bf16* __restrict__ pb) {
    const int lane = threadIdx.x & 63, row = blockIdx.x * 4 + (threadIdx.x >> 6);
    const f32x4* yr = (const f32x4*)(y + (size_t)row * D) + lane; const f32x4* xr = (const f32x4*)(xin + (size_t)row * D) + lane; const f32x4* gr = (const f32x4*)g + lane;
    f32x4 v[4]; float ss = 0.f;
#pragma unroll
    for (int j = 0; j < 4; ++j) { v[j] = yr[64 * j]; ss += (v[j].x * v[j].x + v[j].y * v[j].y) + (v[j].z * v[j].z + v[j].w * v[j].w); }
    const float r = 1.0f / sqrtf(wave_sum(ss) * (1.0f / D) + EPS);
    float s2 = 0.f;
    f32x4* xor_ = (f32x4*)(xo + (size_t)row * D) + lane; u32x2* o = (u32x2*)(xb + (size_t)row * D) + lane;
#pragma unroll
    for (int j = 0; j < 4; ++j) { const f32x4 xx = xr[64 * j], gg = gr[64 * j]; f32x4 w = xx + v[j] * r * gg; xor_[64 * j] = w; s2 += (w.x * w.x + w.y * w.y) + (w.z * w.z + w.w * w.w);
        u32x2 q; q.x = pk2(w.x, w.y); q.y = pk2(w.z, w.w); o[64 * j] = q; }
    if (rstd_out) { s2 = wave_sum(s2); if (lane == 0) rstd_out[row] = 1.0f / sqrtf(s2 * (1.0f / D) + EPS); }
    if (p) { const f32x4 pv = *((const f32x4*)(p + (size_t)row * PLE) + lane); u32x2 q; q.x = pk2(pv.x, pv.y); q.y = pk2(pv.z, pv.w); *((u32x2*)(pb + (size_t)row * PLE) + lane) = q; }
}

namespace pg8 {
struct EpiProj {
    static constexpr bool PERM = true, AFTER_DRAIN = false;
    bf16_t* RA; bf16_t* RB; const float* rstd;
    __device__ __forceinline__ void operator()(const f32x4 (&acc)[2][2][4][2], const Unit& u, int wr, int wc, int fr, int fq) const {
        const int row0 = u.pm * BM + wr * 64 + fr; bf16_t* base; int ld, colt;
        if (u.pn < NA / 256) { base = RA; ld = NA; colt = u.pn * BM; } else { base = RB; ld = NB; colt = (u.pn - NA / 256) * BM; }
        const int col0 = colt + wc * 32 + 8 * fq;
        float sr[2][4];
#pragma unroll
        for (int ai = 0; ai < 2; ++ai)
#pragma unroll
            for (int m = 0; m < 4; ++m) sr[ai][m] = rstd[row0 + ai * HALF + m * 16];
#pragma unroll
        for (int ai = 0; ai < 2; ++ai)
#pragma unroll
            for (int m = 0; m < 4; ++m) { const int r = row0 + ai * HALF + m * 16; const float s = sr[ai][m]; bf16_t* rowp = base + (size_t)r * ld + col0;
#pragma unroll
                for (int bj = 0; bj < 2; ++bj) { const f32x4 v0 = acc[ai][bj][m][0] * s, v1 = acc[ai][bj][m][1] * s;
                    u32x4 w; w.x = cvt_pk_bf16(v0[0], v0[1]); w.y = cvt_pk_bf16(v0[2], v0[3]); w.z = cvt_pk_bf16(v1[0], v1[1]); w.w = cvt_pk_bf16(v1[2], v1[3]);
                    *(u32x4*)(rowp + bj * HALF) = w; } }
    }
};
struct EpiF32 {
    static constexpr bool PERM = false, AFTER_DRAIN = false;
    float* C; long ldc;
    __device__ __forceinline__ void operator()(const f32x4 (&acc)[2][2][4][2], const Unit& u, int wr, int wc, int fr, int fq) const {
        const int row0 = u.pm * BM + wr * 64 + fr, col0 = u.pn * BM + wc * 32 + 4 * fq;
#pragma unroll
        for (int ai = 0; ai < 2; ++ai)
#pragma unroll
            for (int m = 0; m < 4; ++m) { float* rowp = C + (size_t)(row0 + ai * HALF + m * 16) * ldc + col0;
#pragma unroll
                for (int bj = 0; bj < 2; ++bj)
#pragma unroll
                    for (int n = 0; n < 2; ++n) *(f32x4*)(rowp + bj * HALF + n * 16) = acc[ai][bj][m][n]; }
    }
};
struct EpiBf16P {
    static constexpr bool PERM = true, AFTER_DRAIN = false;
    bf16_t* O; long ldc;
    __device__ __forceinline__ void operator()(const f32x4 (&acc)[2][2][4][2], const Unit& u, int wr, int wc, int fr, int fq) const {
        const int row0 = u.pm * BM + wr * 64 + fr, col0 = u.pn * BM + wc * 32 + 8 * fq;
#pragma unroll
        for (int ai = 0; ai < 2; ++ai)
#pragma unroll
            for (int m = 0; m < 4; ++m) { bf16_t* rowp = O + (size_t)(row0 + ai * HALF + m * 16) * ldc + col0;
#pragma unroll
                for (int bj = 0; bj < 2; ++bj) { const f32x4 v0 = acc[ai][bj][m][0], v1 = acc[ai][bj][m][1];
                    u32x4 w; w.x = cvt_pk_bf16(v0[0], v0[1]); w.y = cvt_pk_bf16(v0[2], v0[3]); w.z = cvt_pk_bf16(v1[0], v1[1]); w.w = cvt_pk_bf16(v1[2], v1[3]);
                    *(u32x4*)(rowp + bj * HALF) = w; } }
    }
};
struct EpiSwiGLU {
    static constexpr bool PERM = true, AFTER_DRAIN = false;
    bf16_t* G; const float* rstd;
    __device__ __forceinline__ void operator()(const f32x4 (&acc)[2][2][4][2], const Unit& u, int wr, int wc, int fr, int fq) const {
        const int row0 = u.pm * BM + wr * 64 + fr, col0 = u.pn * HALF + wc * 32 + 8 * fq;
        float sr[2][4];
#pragma unroll
        for (int ai = 0; ai < 2; ++ai)
#pragma unroll
            for (int m = 0; m < 4; ++m) sr[ai][m] = rstd[row0 + ai * HALF + m * 16];
#pragma unroll
        for (int ai = 0; ai < 2; ++ai)
#pragma unroll
            for (int m = 0; m < 4; ++m) { const int r = row0 + ai * HALF + m * 16; const float s = sr[ai][m]; float o[8];
#pragma unroll
                for (int n = 0; n < 2; ++n)
#pragma unroll
                    for (int j = 0; j < 4; ++j) { const float gt = acc[ai][0][m][n][j] * s, up = acc[ai][1][m][n][j] * s; o[n * 4 + j] = gt * __builtin_amdgcn_rcpf(1.0f + __expf(-gt)) * up; }
                u32x4 w; w.x = cvt_pk_bf16(o[0], o[1]); w.y = cvt_pk_bf16(o[2], o[3]); w.z = cvt_pk_bf16(o[4], o[5]); w.w = cvt_pk_bf16(o[6], o[7]);
                *(u32x4*)(G + (size_t)r * DFF + col0) = w; }
    }
};
struct EpiPle {
    static constexpr bool PERM = true, AFTER_DRAIN = false;
    const bf16_t* X; const bf16_t* Tt; bf16_t* XB; float* OUT;
    __device__ __forceinline__ void operator()(const f32x4 (&acc)[2][2][4][2], const Unit& u, int wr, int wc, int fr, int fq) const {
        const int row0 = u.pm * BM + wr * 64 + fr, col0 = u.pn * BM + wc * 32 + 8 * fq;
        u32x4 tv[2][2], xv[2][2];
#define PLE_LOAD(slot, grp) do { const size_t off_ = (size_t)(row0 + ((grp) >> 2) * HALF + ((grp) & 3) * 16) * D + col0; _Pragma("unroll") for (int bj_ = 0; bj_ < 2; ++bj_) { \
            tv[slot][bj_] = *(const u32x4*)(Tt + off_ + bj_ * HALF); xv[slot][bj_] = *(const u32x4*)(X + off_ + bj_ * HALF); } } while (0)
        PLE_LOAD(0, 0);
#pragma unroll
        for (int grp = 0; grp < 8; ++grp) { const int ai = grp >> 2, m = grp & 3, sl = grp & 1; const size_t off = (size_t)(row0 + ai * HALF + m * 16) * D + col0;
            if (grp + 1 < 8) PLE_LOAD((grp + 1) & 1, grp + 1);
#pragma unroll
            for (int bj = 0; bj < 2; ++bj) { const unsigned tw[4] = {tv[sl][bj].x, tv[sl][bj].y, tv[sl][bj].z, tv[sl][bj].w}, xw[4] = {xv[sl][bj].x, xv[sl][bj].y, xv[sl][bj].z, xv[sl][bj].w}; f32x4 x0, x1;
#pragma unroll
                for (int j = 0; j < 4; ++j) { const float t0 = __builtin_bit_cast(float, (j & 1) ? (tw[j >> 1] & 0xffff0000u) : (tw[j >> 1] << 16));
                    const float t1 = __builtin_bit_cast(float, (j & 1) ? (tw[2 + (j >> 1)] & 0xffff0000u) : (tw[2 + (j >> 1)] << 16));
                    const float a0 = __builtin_bit_cast(float, (j & 1) ? (xw[j >> 1] & 0xffff0000u) : (xw[j >> 1] << 16));
                    const float a1 = __builtin_bit_cast(float, (j & 1) ? (xw[2 + (j >> 1)] & 0xffff0000u) : (xw[2 + (j >> 1)] << 16));
                    x0[j] = a0 + __builtin_amdgcn_rcpf(1.0f + __expf(-acc[ai][bj][m][0][j])) * t0; x1[j] = a1 + __builtin_amdgcn_rcpf(1.0f + __expf(-acc[ai][bj][m][1][j])) * t1; }
                if (OUT) { *(f32x4*)(OUT + off + bj * HALF) = x0; *(f32x4*)(OUT + off + bj * HALF + 4) = x1; }
                else { u32x4 w; w.x = cvt_pk_bf16(x0[0], x0[1]); w.y = cvt_pk_bf16(x0[2], x0[3]); w.z = cvt_pk_bf16(x1[0], x1[1]); w.w = cvt_pk_bf16(x1[2], x1[3]);
                    *(u32x4*)(XB + off + bj * HALF) = w; } } }
#undef PLE_LOAD
    }
};
}

__device__ __forceinline__ unsigned ord_key(float f) { const unsigned u = __builtin_bit_cast(unsigned, f); return (u & 0x80000000u) ? ~u : (u | 0x80000000u); }
#define LAS __attribute__((address_space(3)))
#define XB_TMO      128
#define XB_XCNT(j)  (256  + 64 * (j))
#define XB_XSUB(j)  (1280 + 64 * (j))
#define XB_XGEN(j)  (2304 + 64 * (j))
#define XB_TOP      3328
#define XB_TOPGEN   3392
#define XCD_BAR_WORDS 3456
#define XB_SPIN_CAP (1u << 18)

__device__ __forceinline__ unsigned xb_ld(unsigned* p)              { return __hip_atomic_load(p, __ATOMIC_RELAXED, __HIP_MEMORY_SCOPE_AGENT); }
__device__ __forceinline__ unsigned xb_add(unsigned* p, unsigned v) { return __hip_atomic_fetch_add(p, v, __ATOMIC_RELAXED, __HIP_MEMORY_SCOPE_AGENT); }
__device__ __forceinline__ unsigned xb_xcc_id() { return (unsigned)__builtin_amdgcn_s_getreg((3 << 11) | 20) & 0xFu; }
#define XB_SPIN(cond, bar) do { unsigned _sp = 0; while (cond) { __builtin_amdgcn_s_sleep(1); \
    if ((++_sp & 255u) == 0u) { if (xb_ld(&(bar)[XB_TMO])) break; if (_sp > XB_SPIN_CAP) { atomicAdd(&(bar)[XB_TMO], 1u); break; } } } } while (0)

struct XcdBarrier {
    unsigned* bar; unsigned x;
    volatile LAS unsigned* st;
};

__device__ __forceinline__ XcdBarrier xcd_barrier_post(unsigned* bar, volatile LAS unsigned* st) {
    XcdBarrier b; b.bar = bar; b.x = xb_xcc_id(); b.st = st;
    if (threadIdx.x == 0) (void)xb_add(&bar[XB_XCNT(b.x)], 1u);
    return b;
}
__device__ __forceinline__ void xcd_barrier_complete(unsigned* bar, unsigned x, unsigned& nloc, unsigned& nx) {
    const unsigned G = gridDim.x * gridDim.y * gridDim.z;
    unsigned sum, cnt, mine, sp = 0u;
    for (;;) {
        sum = 0u; cnt = 0u; mine = 0u;
#pragma unroll
        for (unsigned j = 0; j < 16; ++j) { const unsigned c = xb_ld(&bar[XB_XCNT(j)]); sum += c; cnt += (c > 0u) ? 1u : 0u; mine = (j == x) ? c : mine; }
        if (sum == G) break;
        __builtin_amdgcn_s_sleep(1);
        if ((++sp & 255u) == 0u) { if (xb_ld(&bar[XB_TMO])) break; if (sp > XB_SPIN_CAP) { atomicAdd(&bar[XB_TMO], 1u); break; } }
    }
    nloc = mine > 0u ? mine : 1u; nx = cnt > 0u ? cnt : 1u;
}

__device__ __forceinline__ void xcd_barrier(const XcdBarrier& b, int tid_in) {
    asm volatile("s_waitcnt vmcnt(0)" ::: "memory");
    __syncthreads();
    if (tid_in == 0) {
        unsigned* bar = b.bar;
        __builtin_amdgcn_s_waitcnt(0);
        unsigned nloc = b.st[0], nx = b.st[1];
        if (nloc == 0u) { xcd_barrier_complete(bar, b.x, nloc, nx); b.st[0] = nloc; b.st[1] = nx; }
        const unsigned old = xb_add(&bar[XB_XSUB(b.x)], 1u);
        const unsigned gen = old / nloc;
        if (old + 1u == (gen + 1u) * nloc) {
            __builtin_amdgcn_fence(__ATOMIC_RELEASE, "agent");
            asm volatile("s_waitcnt vmcnt(0)" ::: "memory");
            const unsigned og = xb_add(&bar[XB_TOP], 1u);
            const unsigned tg = og / nx;
            if (og + 1u == (tg + 1u) * nx) xb_add(&bar[XB_TOPGEN], 1u);
            else XB_SPIN(xb_ld(&bar[XB_TOPGEN]) == tg, bar);
            __builtin_amdgcn_fence(__ATOMIC_ACQUIRE, "agent");
            xb_add(&bar[XB_XGEN(b.x)], 1u);
            asm volatile("s_waitcnt vmcnt(0)" ::: "memory");
        } else {
            XB_SPIN(xb_ld(&bar[XB_XGEN(b.x)]) == gen, bar);
            __builtin_amdgcn_fence(__ATOMIC_ACQUIRE, "agent");
            asm volatile("s_waitcnt vmcnt(0)" ::: "memory");
        }
    }
    __syncthreads();
}


constexpr int NTHR = 512, NWAVES = 8;
constexpr int RING_BYTES = 131072, LDS_BYTES = 147456, MISC_OFF = LDS_BYTES - 512;
constexpr int CW_BAR = 4096, CW_RANK = 8192;
constexpr size_t CTL_ZERO_BYTES = 1 * MiB;
constexpr int NPH = 14;

__device__ __forceinline__ int mk_tid(int wave_s) { int l_; asm volatile("v_mbcnt_lo_u32_b32 %0, -1, 0\n\tv_mbcnt_hi_u32_b32 %0, -1, %0" : "=v"(l_)); return wave_s * 64 + l_; }
struct Params { const float* in[26]; float* out; unsigned char* ws; int ph_lo, ph_hi, dbl_mask, pad; };
static_assert(sizeof(Params) == 26 * 8 + 8 + 8 + 16, "no padding");

#define LDSP __attribute__((address_space(3)))
#define LDS_WAIT() asm volatile("s_waitcnt lgkmcnt(0)" ::: "memory")
#ifndef NAIVE_SELECT
#define NAIVE_SELECT 0
#endif
#ifndef NAIVE_ATTN
#define NAIVE_ATTN 0
#endif
#ifndef NAIVE_SSM
#define NAIVE_SSM 0
#endif
#ifndef DBG_SSM
#define DBG_SSM 0
#endif
#ifndef TIMING
#define TIMING 0
#endif
#ifndef DBL_MASK
#define DBL_MASK 0
#endif
#ifndef GEMM_DRYK
#define GEMM_DRYK 0
#endif
#ifndef CLK_PROBE
#define CLK_PROBE 0
#endif
#ifndef ATT_FN
#define ATT_FN wg_attn16d
#endif
#ifndef XTRA_BAR
#define XTRA_BAR 0
#endif
#ifndef ATT_SUB_V
#define ATT_SUB_V 0
#endif
#ifndef TIMING_SHIFT
#define TIMING_SHIFT 0.0f
#endif
#ifndef TIMING_A
#define TIMING_A 2
#endif
#ifndef TIMING_B
#define TIMING_B 3
#endif

template <int MODE> __device__ __forceinline__ void ph_prep_w(LDSP float* scr, const float* __restrict__ W, const float* __restrict__ W2, int K, int Nsrc, const float* __restrict__ gain, bf16* __restrict__ Wt, int Ndst, int gw, int NGW, int lane) {
    const int ntn = Ndst / 32, nt = ntn * (K / 64), n4 = lane & 7, kr = lane >> 3;
    f32x4 v[8];
#define PW_LOAD(it_) { const int n0_ = ((it_) % ntn) * 32, k0_ = ((it_) / ntn) * 64, n_ = n0_ + 4 * n4; int src_; const float* Ws_ = W; \
        if (MODE == 0) src_ = n_; else if (MODE == 1) src_ = src_col_in(n_); else { const int which_ = (n_ & 255) >> 7; src_ = (n_ >> 8) * 128 + (n_ & 127); Ws_ = which_ ? W2 : W; } \
        _Pragma("unroll") for (int i = 0; i < 8; ++i) { const int kk = kr + 8 * i; f32x4 t_ = (f32x4){0.f, 0.f, 0.f, 0.f}; if (src_ >= 0) { t_ = *(const f32x4*)(Ws_ + (size_t)(k0_ + kk) * Nsrc + src_); if (gain) t_ = t_ * gain[k0_ + kk]; } v[i] = t_; } }
    if (gw < nt) PW_LOAD(gw)
    for (int it = gw; it < nt; it += NGW) {
        const int n0 = (it % ntn) * 32, k0 = (it / ntn) * 64;
#pragma unroll
        for (int i = 0; i < 8; ++i) { LDSP float* d = scr + (kr + 8 * i) * 33 + 4 * n4; d[0] = v[i].x; d[1] = v[i].y; d[2] = v[i].z; d[3] = v[i].w; }
        if (it + NGW < nt) PW_LOAD(it + NGW)
        LDS_WAIT(); asm volatile("" ::: "memory");
        const int cc = lane & 7;
#pragma unroll
        for (int j = 0; j < 4; ++j) { const int nn = (lane >> 3) + 8 * j; const LDSP float* s = scr + (8 * cc) * 33 + nn;
            u32x4 o; o.x = pk2(s[0 * 33], s[1 * 33]); o.y = pk2(s[2 * 33], s[3 * 33]); o.z = pk2(s[4 * 33], s[5 * 33]); o.w = pk2(s[6 * 33], s[7 * 33]);
            *(u32x4*)(Wt + (size_t)(n0 + nn) * K + k0 + 8 * cc) = o; }
        LDS_WAIT(); asm volatile("" ::: "memory");
    }
#undef PW_LOAD
}
__device__ __forceinline__ void row_x_prep(const float* __restrict__ x, bf16* __restrict__ xb, float* __restrict__ rstd, int row, int lane) {
    const f32x4* xr = (const f32x4*)(x + (size_t)row * D) + lane; float ss = 0.f; f32x4 v[4];
#pragma unroll
    for (int j = 0; j < 4; ++j) { v[j] = xr[64 * j]; ss += (v[j].x * v[j].x + v[j].y * v[j].y) + (v[j].z * v[j].z + v[j].w * v[j].w); }
    ss = wave_sum(ss);
    if (xb) { u32x2* o = (u32x2*)(xb + (size_t)row * D) + lane;
#pragma unroll
        for (int j = 0; j < 4; ++j) { u32x2 w; w.x = pk2(v[j].x, v[j].y); w.y = pk2(v[j].z, v[j].w); o[64 * j] = w; } }
    if (lane == 0) rstd[row] = 1.0f / sqrtf(ss * (1.0f / D) + EPS);
}
__device__ __forceinline__ void row_resid_norm(const float* xin, const float* __restrict__ y, const float* __restrict__ g, float* xo, bf16* __restrict__ xb, float* __restrict__ rstd_out, const float* __restrict__ p, bf16* __restrict__ pb, int row, int lane, bool dry = false) {
    const f32x4* yr = (const f32x4*)(y + (size_t)row * D) + lane; const f32x4* xr = (const f32x4*)(xin + (size_t)row * D) + lane; const f32x4* gr = (const f32x4*)g + lane;
    f32x4 v[4]; float ss = 0.f;
#pragma unroll
    for (int j = 0; j < 4; ++j) { v[j] = yr[64 * j]; ss += (v[j].x * v[j].x + v[j].y * v[j].y) + (v[j].z * v[j].z + v[j].w * v[j].w); }
    const float r = 1.0f / sqrtf(wave_sum(ss) * (1.0f / D) + EPS);
    float s2 = 0.f;
    f32x4* xor_ = (f32x4*)(xo + (size_t)row * D) + lane; u32x2* o = (u32x2*)(xb + (size_t)row * D) + lane;
#pragma unroll
    for (int j = 0; j < 4; ++j) { const f32x4 xx = xr[64 * j], gg = gr[64 * j]; f32x4 w = xx + v[j] * r * gg; if (!dry) xor_[64 * j] = w; s2 += (w.x * w.x + w.y * w.y) + (w.z * w.z + w.w * w.w);
        u32x2 q; q.x = pk2(w.x, w.y); q.y = pk2(w.z, w.w); o[64 * j] = q; }
    if (rstd_out) { s2 = wave_sum(s2); if (lane == 0) rstd_out[row] = 1.0f / sqrtf(s2 * (1.0f / D) + EPS); }
    if (p) { const f32x4 pv = *((const f32x4*)(p + (size_t)row * PLE) + lane); u32x2 q; q.x = pk2(pv.x, pv.y); q.y = pk2(pv.z, pv.w); *((u32x2*)(pb + (size_t)row * PLE) + lane) = q; }
}

__device__ __forceinline__ void row_resid_norm2(const bf16* xin, const bf16* __restrict__ y, const float* __restrict__ g, bf16* xo, float* __restrict__ rstd_out, const float* __restrict__ p, bf16* __restrict__ pb, int row0, int lane, bool dry = false) {
    f32x4 v[2][4], xx[2][4], pv[2]; const f32x4* gr = (const f32x4*)g + lane;
#pragma unroll
    for (int r = 0; r < 2; ++r) { const u32x2* yr = (const u32x2*)(y + (size_t)(row0 + r) * D) + lane; const u32x2* xr = (const u32x2*)(xin + (size_t)(row0 + r) * D) + lane;
#pragma unroll
        for (int j = 0; j < 4; ++j) { const u32x2 yw = yr[64 * j], xw = xr[64 * j];
            v[r][j] = (f32x4){__builtin_bit_cast(float, yw.x << 16), __builtin_bit_cast(float, yw.x & 0xffff0000u), __builtin_bit_cast(float, yw.y << 16), __builtin_bit_cast(float, yw.y & 0xffff0000u)};
            xx[r][j] = (f32x4){__builtin_bit_cast(float, xw.x << 16), __builtin_bit_cast(float, xw.x & 0xffff0000u), __builtin_bit_cast(float, xw.y << 16), __builtin_bit_cast(float, xw.y & 0xffff0000u)}; }
        if (p) pv[r] = *((const f32x4*)(p + (size_t)(row0 + r) * PLE) + lane); }
    f32x4 gg[4];
#pragma unroll
    for (int j = 0; j < 4; ++j) gg[j] = gr[64 * j];
#pragma unroll
    for (int r = 0; r < 2; ++r) { float ss = 0.f;
#pragma unroll
        for (int j = 0; j < 4; ++j) ss += (v[r][j].x * v[r][j].x + v[r][j].y * v[r][j].y) + (v[r][j].z * v[r][j].z + v[r][j].w * v[r][j].w);
        const float rr = 1.0f / sqrtf(wave_sum(ss) * (1.0f / D) + EPS); float s2 = 0.f;
        u32x2* o = (u32x2*)(xo + (size_t)(row0 + r) * D) + lane;
#pragma unroll
        for (int j = 0; j < 4; ++j) { const f32x4 w = xx[r][j] + v[r][j] * rr * gg[j]; u32x2 q; q.x = pk2(w.x, w.y); q.y = pk2(w.z, w.w); if (!dry) o[64 * j] = q;
            const float r0 = __builtin_bit_cast(float, q.x << 16), r1 = __builtin_bit_cast(float, q.x & 0xffff0000u), r2 = __builtin_bit_cast(float, q.y << 16), r3 = __builtin_bit_cast(float, q.y & 0xffff0000u);
            s2 += (r0 * r0 + r1 * r1) + (r2 * r2 + r3 * r3); }
        if (rstd_out) { s2 = wave_sum(s2); if (lane == 0) rstd_out[row0 + r] = 1.0f / sqrtf(s2 * (1.0f / D) + EPS); }
        if (p) { u32x2 q; q.x = pk2(pv[r].x, pv[r].y); q.y = pk2(pv[r].z, pv[r].w); *((u32x2*)(pb + (size_t)(row0 + r) * PLE) + lane) = q; } }
}
__device__ __forceinline__ void row_rstd_bf16(const bf16* __restrict__ xb, float* __restrict__ rstd, int row, int lane) {
    const u32x2* xr = (const u32x2*)(xb + (size_t)row * D) + lane; float ss = 0.f;
#pragma unroll
    for (int j = 0; j < 4; ++j) { const u32x2 w = xr[64 * j]; const float a = __builtin_bit_cast(float, w.x << 16), b = __builtin_bit_cast(float, w.x & 0xffff0000u), c2 = __builtin_bit_cast(float, w.y << 16), d = __builtin_bit_cast(float, w.y & 0xffff0000u); ss += (a * a + b * b) + (c2 * c2 + d * d); }
    ss = wave_sum(ss); if (lane == 0) rstd[row] = 1.0f / sqrtf(ss * (1.0f / D) + EPS);
}
__device__ __forceinline__ void row_x_prep2(const float* __restrict__ x, bf16* __restrict__ xb, float* __restrict__ rstd, int row0, int lane) {
    f32x4 v[2][4]; float ss[2];
#pragma unroll
    for (int r = 0; r < 2; ++r) { const f32x4* xr = (const f32x4*)(x + (size_t)(row0 + r) * D) + lane;
#pragma unroll
        for (int j = 0; j < 4; ++j) v[r][j] = xr[64 * j]; }
#pragma unroll
    for (int r = 0; r < 2; ++r) { float s_ = 0.f;
#pragma unroll
        for (int j = 0; j < 4; ++j) s_ += (v[r][j].x * v[r][j].x + v[r][j].y * v[r][j].y) + (v[r][j].z * v[r][j].z + v[r][j].w * v[r][j].w);
        ss[r] = wave_sum(s_); u32x2* o = (u32x2*)(xb + (size_t)(row0 + r) * D) + lane;
#pragma unroll
        for (int j = 0; j < 4; ++j) { u32x2 w; w.x = pk2(v[r][j].x, v[r][j].y); w.y = pk2(v[r][j].z, v[r][j].w); o[64 * j] = w; } }
    if (lane < 2) rstd[row0 + lane] = 1.0f / sqrtf((lane ? ss[1] : ss[0]) * (1.0f / D) + EPS);
}
__device__ __forceinline__ void row_rstd_bf16x4(const bf16* __restrict__ xb, float* __restrict__ rstd, int row0, int lane) {
    u32x2 w[4][4]; float ss[4];
#pragma unroll
    for (int r = 0; r < 4; ++r) { const u32x2* xr = (const u32x2*)(xb + (size_t)(row0 + r) * D) + lane;
#pragma unroll
        for (int j = 0; j < 4; ++j) w[r][j] = xr[64 * j]; }
#pragma unroll
    for (int r = 0; r < 4; ++r) { float s_ = 0.f;
#pragma unroll
        for (int j = 0; j < 4; ++j) { const float a = __builtin_bit_cast(float, w[r][j].x << 16), b = __builtin_bit_cast(float, w[r][j].x & 0xffff0000u), c2 = __builtin_bit_cast(float, w[r][j].y << 16), d = __builtin_bit_cast(float, w[r][j].y & 0xffff0000u); s_ += (a * a + b * b) + (c2 * c2 + d * d); }
        ss[r] = wave_sum(s_); }
    const float sel = lane == 0 ? ss[0] : lane == 1 ? ss[1] : lane == 2 ? ss[2] : ss[3];
    if (lane < 4) rstd[row0 + lane] = 1.0f / sqrtf(sel * (1.0f / D) + EPS);
}
__device__ __forceinline__ void wave_gnorm4(bf16* RA, const float* __restrict__ nw, int w0, int lane, bool dry = false) {
    u32x4 v[4]; float ss[4];
#pragma unroll
    for (int i = 0; i < 4; ++i) { const int w = w0 + i, t = w >> 1, g = w & 1; v[i] = *(const u32x4*)(RA + (size_t)t * NA + A_Z + g * 512 + lane * 8); }
    float f[4][8];
#pragma unroll
    for (int i = 0; i < 4; ++i) { const unsigned vw[4] = {v[i].x, v[i].y, v[i].z, v[i].w}; ss[i] = 0.f;
#pragma unroll
        for (int e = 0; e < 8; ++e) { f[i][e] = bf2f((bf16)((vw[e >> 1] >> ((e & 1) * 16)) & 0xffff)); ss[i] += f[i][e] * f[i][e]; } }
#pragma unroll
    for (int o = 1; o < 64; o <<= 1) {
#pragma unroll
        for (int i = 0; i < 4; ++i) ss[i] += __shfl_xor(ss[i], o); }
#pragma unroll
    for (int i = 0; i < 4; ++i) { const int w = w0 + i, t = w >> 1, g = w & 1; const float r = 1.0f / sqrtf(ss[i] * (1.0f / 512.0f) + EPS); const float* gw = nw + g * 512 + lane * 8;
        u32x4 o; o.x = pk2(f[i][0] * r * gw[0], f[i][1] * r * gw[1]); o.y = pk2(f[i][2] * r * gw[2], f[i][3] * r * gw[3]); o.z = pk2(f[i][4] * r * gw[4], f[i][5] * r * gw[5]); o.w = pk2(f[i][6] * r * gw[6], f[i][7] * r * gw[7]);
        if (!dry) *(u32x4*)(RA + (size_t)t * NA + A_Z + g * 512 + lane * 8) = o; }
}
__device__ __forceinline__ void tok_m1(bf16* __restrict__ RA, bf16* __restrict__ RB, bf16* __restrict__ CKVC, bf16* __restrict__ IKC, const float* __restrict__ kvn, const float* __restrict__ ikg, const float* __restrict__ ikb, const float* __restrict__ scw, int t, int lane) {
    const int s = t & (SEQ - 1); bf16* rb = RB + (size_t)t * NB;
    {   const u32x2 w = *((const u32x2*)(rb + B_CKV) + lane); float v[4] = {bf2f((bf16)(w.x & 0xffff)), bf2f((bf16)(w.x >> 16)), bf2f((bf16)(w.y & 0xffff)), bf2f((bf16)(w.y >> 16))};
        float ss = (v[0] * v[0] + v[1] * v[1]) + (v[2] * v[2] + v[3] * v[3]); ss = wave_sum(ss); const float r = 1.0f / sqrtf(ss * (1.0f / KV_R) + EPS);
        const f32x4 g = *((const f32x4*)kvn + lane); u32x2 o; o.x = pk2(v[0] * r * g.x, v[1] * r * g.y); o.y = pk2(v[2] * r * g.z, v[3] * r * g.w); *((u32x2*)(rb + B_CKV) + lane) = o; *((u32x2*)(CKVC + (size_t)t * KV_R) + lane) = o; }
    {   const float x = bf2f(rb[B_IK + lane]); const float mu = wave_sum(x) * (1.0f / 64.0f); const float d = x - mu; const float var = wave_sum(d * d) * (1.0f / 64.0f);
        const bf16 o = f2bf(d * (1.0f / sqrtf(var + EPS)) * ikg[lane] + ikb[lane]); rb[B_IK + lane] = o; IKC[(size_t)t * 64 + lane] = o; }
    {   const int c = lane * 8; float acc[8] = {0.f, 0.f, 0.f, 0.f, 0.f, 0.f, 0.f, 0.f};
        for (int j = 0; j < 3; ++j) { const int ss_ = s - 2 + j; if (ss_ < 0) continue; const bf16* rr = RB + (size_t)(t - 2 + j) * NB;
            const u32x4 cg = *(const u32x4*)(rr + B_CG + c), hb = *(const u32x4*)(rr + B_HB + c); const unsigned cw[4] = {cg.x, cg.y, cg.z, cg.w}, hw[4] = {hb.x, hb.y, hb.z, hb.w};
#pragma unroll
            for (int e = 0; e < 8; ++e) { const float a = bf2f((bf16)((cw[e >> 1] >> ((e & 1) * 16)) & 0xffff)), b = bf2f((bf16)((hw[e >> 1] >> ((e & 1) * 16)) & 0xffff)); acc[e] += scw[j * 512 + c + e] * (a * b); } }
        bf16* ra = RA + (size_t)t * NA + A_BG + c; const u32x4 bg = *(const u32x4*)ra; const unsigned bw[4] = {bg.x, bg.y, bg.z, bg.w}; float o[8];
#pragma unroll
        for (int e = 0; e < 8; ++e) o[e] = bf2f((bf16)((bw[e >> 1] >> ((e & 1) * 16)) & 0xffff)) * acc[e];
        u32x4 w; w.x = pk2(o[0], o[1]); w.y = pk2(o[2], o[3]); w.z = pk2(o[4], o[5]); w.w = pk2(o[6], o[7]); *(u32x4*)ra = w; }
}
__device__ __forceinline__ void tok_m4a(const bf16* __restrict__ RB, const float* __restrict__ cw, const float* __restrict__ cb, const float* __restrict__ dtb, bf16* __restrict__ XA, float* __restrict__ DT, int t, int lane) {
    const int s = t & (SEQ - 1);
    for (int c = lane; c < XBC; c += 64) { float a = cb[c];
#pragma unroll
        for (int j = 0; j < 4; ++j) { const int ss = s - 3 + j; if (ss >= 0) a += cw[j * XBC + c] * bf2f(RB[(size_t)(t - 3 + j) * NB + B_XBC + c]); }
        XA[(size_t)t * XBC + c] = f2bf(siluf_(a)); }
    if (lane < 16) { const float x = bf2f(RB[(size_t)t * NB + B_DT + lane]) + dtb[lane]; DT[(size_t)t * 16 + lane] = x > 15.f ? x : log1pf(__expf(x)); }
}
__device__ __forceinline__ void wg_m2_select(LDSP unsigned char* lds, const bf16* __restrict__ RB, unsigned short* __restrict__ idx, int t, int tid) {
    LDSP float* iq = (LDSP float*)lds; LDSP float* iwv = iq + 256; LDSP unsigned* red = (LDSP unsigned*)(iq + 272); LDSP unsigned* keys = (LDSP unsigned*)(iq + 288);
    const int s = t & (SEQ - 1), b = t >> 12, lane = tid & 63, wv = tid >> 6;
    const int nk = ((s >> 6) + 1) << 6;
    const bf16* rb = RB + (size_t)t * NB;
    if (tid < 256) iq[tid] = bf2f(rb[B_IQ + tid]); if (tid < 4) iwv[tid] = bf2f(rb[B_IW + tid]) * (0.125f * 0.5f);
    __syncthreads();
    for (int k = tid; k < nk; k += NTHR) {
        const bf16* kr = RB + (size_t)(b * SEQ + k) * NB + B_IK; float sc = 0.f;
        float d0 = 0.f, d1 = 0.f, d2 = 0.f, d3 = 0.f;
#pragma unroll 1
        for (int j = 0; j < 8; ++j) { const u32x4 w = *((const u32x4*)kr + j); const unsigned ww[4] = {w.x, w.y, w.z, w.w};
#pragma unroll
            for (int e = 0; e < 8; ++e) { const float kv = bf2f((bf16)((ww[e >> 1] >> ((e & 1) * 16)) & 0xffff)); const int c = j * 8 + e;
                d0 += iq[c] * kv; d1 += iq[64 + c] * kv; d2 += iq[128 + c] * kv; d3 += iq[192 + c] * kv; } }
        sc += fmaxf(d0, 0.f) * iwv[0]; sc += fmaxf(d1, 0.f) * iwv[1]; sc += fmaxf(d2, 0.f) * iwv[2]; sc += fmaxf(d3, 0.f) * iwv[3];
        keys[k] = ord_key(sc);
    }
    __syncthreads();
    unsigned Tt = 0u;
    if (nk > TOPK) {
        for (int bit = 31; bit >= 0; --bit) { const unsigned cand = Tt | (1u << bit); unsigned c = 0;
            for (int k = tid; k < nk; k += NTHR) c += (keys[k] >= cand) ? 1u : 0u;
#pragma unroll
            for (int o = 1; o < 64; o <<= 1) c += __shfl_xor(c, o);
            if (lane == 0) red[wv] = c;
            __syncthreads();
            unsigned tot = 0;
#pragma unroll
            for (int w = 0; w < 8; ++w) tot += red[w];
            if (tot >= (unsigned)TOPK) Tt = cand;
            __syncthreads(); }
    }
    { unsigned c = 0; for (int k = tid; k < nk; k += NTHR) c += (keys[k] > Tt) ? 1u : 0u;
#pragma unroll
      for (int o = 1; o < 64; o <<= 1) c += __shfl_xor(c, o);
      if (lane == 0) red[8 + wv] = c; }
    __syncthreads();
    if (wv == 0) {
        int ngt = 0;
#pragma unroll
        for (int w = 0; w < 8; ++w) ngt += (int)red[8 + w];
        const int need = TOPK - ngt; int pos = 0, eq_taken = 0; const unsigned long long lt = (1ull << lane) - 1ull;
        for (int base = 0; base < nk; base += 64) { const unsigned k = keys[base + lane]; const bool gt = k > Tt, eq = (k == Tt);
            const unsigned long long meq = __ballot(eq); const int rank_eq = __popcll(meq & lt); const bool take = gt || (eq && (eq_taken + rank_eq < need));
            const unsigned long long msel = __ballot(take);
            if (take) { const int o = pos + __popcll(msel & lt); if (o < TOPK) idx[(size_t)t * TOPK + o] = (unsigned short)(base + lane); }
            pos += __popcll(msel); eq_taken += __popcll(__ballot(eq && take)); }
    }
    __syncthreads();
}
__device__ __forceinline__ void wg_m3_attn(LDSP unsigned char* lds, bf16* RA, const bf16* __restrict__ RB, const unsigned short* __restrict__ idx, const float* __restrict__ w_uk, const float* __restrict__ w_uv, const float* __restrict__ rel_bias, int t, int tid) {
    LDSP float* q = (LDSP float*)lds; LDSP float* qlat = q + 512; LDSP float* pr = qlat + 2048; LDSP float* outl = pr + 2048; LDSP unsigned short* sel = (LDSP unsigned short*)(outl + 2048);
    const int s = t & (SEQ - 1), b = t >> 12, lane = tid & 63, wv = tid >> 6;
    const int nk = ((s >> 6) + 1) << 6, nsel = nk < TOPK ? nk : TOPK;
    q[tid] = bf2f(RA[(size_t)t * NA + A_Q + tid]); if (tid < 256) sel[tid] = tid < nsel ? idx[(size_t)t * TOPK + tid] : (unsigned short)0;
    __syncthreads();
    {   const int r = tid & 255, h0 = (tid >> 8) * 4;
        for (int h = h0; h < h0 + 4; ++h) { const float* w = w_uk + ((size_t)r * 8 + h) * 64; float a = 0.f;
#pragma unroll 16
            for (int d = 0; d < 64; ++d) a += q[h * 64 + d] * w[d];
            qlat[h * 256 + r] = a * 0.125f; } }
    __syncthreads();
    {   const int k = tid & 255, h0 = (tid >> 8) * 4;
        if (k < nsel) { const int key = sel[k]; const bf16* kr = RB + (size_t)(b * SEQ + key) * NB + B_CKV; float a[4] = {0.f, 0.f, 0.f, 0.f};
            for (int j = 0; j < 32; ++j) { const u32x4 w = *((const u32x4*)kr + j); const unsigned ww[4] = {w.x, w.y, w.z, w.w};
#pragma unroll
                for (int e = 0; e < 8; ++e) { const float v = bf2f((bf16)((ww[e >> 1] >> ((e & 1) * 16)) & 0xffff));
#pragma unroll
                    for (int hh = 0; hh < 4; ++hh) a[hh] += qlat[(h0 + hh) * 256 + j * 8 + e] * v; } }
            const int bk = t5_bucket(key - s);
#pragma unroll
            for (int hh = 0; hh < 4; ++hh) pr[(h0 + hh) * 256 + k] = a[hh] + rel_bias[bk * 8 + h0 + hh];
        } else {
#pragma unroll
            for (int hh = 0; hh < 4; ++hh) pr[(h0 + hh) * 256 + k] = -INFINITY; } }
    __syncthreads();
    {   float v[4]; float m = -INFINITY;
#pragma unroll
        for (int j = 0; j < 4; ++j) { v[j] = pr[wv * 256 + lane + 64 * j]; m = fmaxf(m, v[j]); }
        m = wave_max(m); float sum = 0.f;
#pragma unroll
        for (int j = 0; j < 4; ++j) { v[j] = __expf(v[j] - m); sum += v[j]; }
        sum = wave_sum(sum); const float inv = 1.0f / sum;
#pragma unroll
        for (int j = 0; j < 4; ++j) pr[wv * 256 + lane + 64 * j] = v[j] * inv; }
    __syncthreads();
    {   const int r = tid & 255, h0 = (tid >> 8) * 4; float a[4] = {0.f, 0.f, 0.f, 0.f};
        for (int k = 0; k < nsel; ++k) { const float v = bf2f(RB[(size_t)(b * SEQ + sel[k]) * NB + B_CKV + r]);
#pragma unroll
            for (int hh = 0; hh < 4; ++hh) a[hh] += pr[(h0 + hh) * 256 + k] * v; }
#pragma unroll
        for (int hh = 0; hh < 4; ++hh) outl[(h0 + hh) * 256 + r] = a[hh]; }
    __syncthreads();
    {   const int h = tid >> 6, d = tid & 63; float a = 0.f;
        for (int r = 0; r < 256; ++r) a += outl[h * 256 + r] * w_uv[((size_t)r * 8 + h) * 64 + d];
        RA[(size_t)t * NA + A_Q + tid] = f2bf(a); }
    __syncthreads();
}
__device__ __forceinline__ void half_m4b_scan(bf16* RA, const bf16* __restrict__ XA, const float* __restrict__ DT, const float* __restrict__ a_log, const float* __restrict__ dsk, int b, int h, int tid) {
    const int g = h >> 3, p = tid >> 2, nq = tid & 3;
    const float A = -__expf(a_log[h]), Dh = dsk[h];
    float hs[32];
#pragma unroll
    for (int n = 0; n < 32; ++n) hs[n] = 0.f;
    for (int s = 0; s < SEQ; ++s) { const size_t t = (size_t)b * SEQ + s; const float dt = DT[t * 16 + h]; const float dA = __expf(dt * A);
        const bf16* xr = XA + t * XBC; const float x = bf2f(xr[h * 64 + p]); const float dx = dt * x;
        const u32x4* Bp = (const u32x4*)(xr + 1024 + g * 128 + nq * 32); const u32x4* Cp = (const u32x4*)(xr + 1280 + g * 128 + nq * 32); float y = 0.f;
#pragma unroll
        for (int j = 0; j < 4; ++j) { const u32x4 bw = Bp[j], cw = Cp[j]; const unsigned bb[4] = {bw.x, bw.y, bw.z, bw.w}, cc[4] = {cw.x, cw.y, cw.z, cw.w};
#pragma unroll
            for (int e = 0; e < 8; ++e) { const float Bv = bf2f((bf16)((bb[e >> 1] >> ((e & 1) * 16)) & 0xffff)), Cv = bf2f((bf16)((cc[e >> 1] >> ((e & 1) * 16)) & 0xffff));
                hs[j * 8 + e] = hs[j * 8 + e] * dA + dx * Bv; y += Cv * hs[j * 8 + e]; } }
        y += __shfl_xor(y, 1); y += __shfl_xor(y, 2);
        if (nq == 0) { bf16* zp = RA + t * NA + A_Z + h * 64 + p; const float z = bf2f(*zp); *zp = f2bf((y + Dh * x) * siluf_(z)); }
    }
}
__device__ __forceinline__ void wave_m4c_gnorm(bf16* RA, const float* __restrict__ nw, int w, int lane, bool dry = false) {
    const int t = w >> 1, g = w & 1;
    bf16* p = RA + (size_t)t * NA + A_Z + g * 512 + lane * 8; const u32x4 v = *(const u32x4*)p; const unsigned vw[4] = {v.x, v.y, v.z, v.w}; float f[8]; float ss = 0.f;
#pragma unroll
    for (int e = 0; e < 8; ++e) { f[e] = bf2f((bf16)((vw[e >> 1] >> ((e & 1) * 16)) & 0xffff)); ss += f[e] * f[e]; }
    const float r = 1.0f / sqrtf(wave_sum(ss) * (1.0f / 512.0f) + EPS); const float* gw = nw + g * 512 + lane * 8;
    u32x4 o; o.x = pk2(f[0] * r * gw[0], f[1] * r * gw[1]); o.y = pk2(f[2] * r * gw[2], f[3] * r * gw[3]); o.z = pk2(f[4] * r * gw[4], f[5] * r * gw[5]); o.w = pk2(f[6] * r * gw[6], f[7] * r * gw[7]);
    if (!dry) *(u32x4*)p = o;
}

__device__ __forceinline__ void unpack8(const u32x4 w, float (&f)[8]) { const unsigned ww[4] = {w.x, w.y, w.z, w.w};
#pragma unroll
    for (int e = 0; e < 4; ++e) { f[2 * e] = __builtin_bit_cast(float, ww[e] << 16); f[2 * e + 1] = __builtin_bit_cast(float, ww[e] & 0xffff0000u); } }
__device__ __forceinline__ void prep_ckv4(const bf16* __restrict__ RB, bf16* __restrict__ CKVC, const float* __restrict__ kvn, int it, int lane) {
    const int t = it * 4 + (lane >> 4), c = lane & 15; const u32x4* src = (const u32x4*)(RB + (size_t)t * NB + B_CKV + c * 16); const u32x4 a = src[0], b = src[1];
    float v[16]; { float f[8]; unpack8(a, f);
#pragma unroll
        for (int e = 0; e < 8; ++e) v[e] = f[e]; unpack8(b, f);
#pragma unroll
        for (int e = 0; e < 8; ++e) v[8 + e] = f[e]; }
    float ss = 0.f;
#pragma unroll
    for (int e = 0; e < 16; ++e) ss += v[e] * v[e];
    ss += __shfl_xor(ss, 1); ss += __shfl_xor(ss, 2); ss += __shfl_xor(ss, 4); ss += __shfl_xor(ss, 8);
    const float r = 1.0f / sqrtf(ss * (1.0f / KV_R) + EPS); const f32x4* gp = (const f32x4*)(kvn + c * 16); float o[16];
#pragma unroll
    for (int q = 0; q < 4; ++q) { const f32x4 gg = gp[q]; o[4 * q] = v[4 * q] * r * gg.x; o[4 * q + 1] = v[4 * q + 1] * r * gg.y; o[4 * q + 2] = v[4 * q + 2] * r * gg.z; o[4 * q + 3] = v[4 * q + 3] * r * gg.w; }
    u32x4 w0, w1; w0.x = pk2(o[0], o[1]); w0.y = pk2(o[2], o[3]); w0.z = pk2(o[4], o[5]); w0.w = pk2(o[6], o[7]); w1.x = pk2(o[8], o[9]); w1.y = pk2(o[10], o[11]); w1.z = pk2(o[12], o[13]); w1.w = pk2(o[14], o[15]);
    u32x4* dst = (u32x4*)(CKVC + (size_t)t * KV_R + c * 16); dst[0] = w0; dst[1] = w1;
}
__device__ __forceinline__ void prep_ik16(const bf16* __restrict__ RB, bf16* __restrict__ IKC, const float* __restrict__ ikg, const float* __restrict__ ikb, int it, int lane) {
    const int t = it * 16 + (lane >> 2), c = lane & 3; const u32x4* src = (const u32x4*)(RB + (size_t)t * NB + B_IK + c * 16); const u32x4 a = src[0], b = src[1];
    float v[16]; { float f[8]; unpack8(a, f);
#pragma unroll
        for (int e = 0; e < 8; ++e) v[e] = f[e]; unpack8(b, f);
#pragma unroll
        for (int e = 0; e < 8; ++e) v[8 + e] = f[e]; }
    float s = 0.f;
#pragma unroll
    for (int e = 0; e < 16; ++e) s += v[e];
    s += __shfl_xor(s, 1); s += __shfl_xor(s, 2); const float mu = s * (1.0f / 64.0f); float q2 = 0.f;
#pragma unroll
    for (int e = 0; e < 16; ++e) { v[e] -= mu; q2 += v[e] * v[e]; }
    q2 += __shfl_xor(q2, 1); q2 += __shfl_xor(q2, 2); const float r = 1.0f / sqrtf(q2 * (1.0f / 64.0f) + EPS); float o[16];
#pragma unroll
    for (int e = 0; e < 16; ++e) o[e] = v[e] * r * ikg[c * 16 + e] + ikb[c * 16 + e];
    u32x4 w0, w1; w0.x = pk2(o[0], o[1]); w0.y = pk2(o[2], o[3]); w0.z = pk2(o[4], o[5]); w0.w = pk2(o[6], o[7]); w1.x = pk2(o[8], o[9]); w1.y = pk2(o[10], o[11]); w1.z = pk2(o[12], o[13]); w1.w = pk2(o[14], o[15]);
    u32x4* dst = (u32x4*)(IKC + (size_t)t * 64 + c * 16); dst[0] = w0; dst[1] = w1;
}
__device__ __forceinline__ void prep_bout(bf16* RA, const bf16* __restrict__ RB, const float* __restrict__ scw, int t, int lane, bool dry = false) {
    const int s = t & (SEQ - 1), c = lane * 8; float acc[8] = {0.f, 0.f, 0.f, 0.f, 0.f, 0.f, 0.f, 0.f};
    u32x4 cg[3], hb[3];
#pragma unroll
    for (int j = 0; j < 3; ++j) { const bool ok = (s - 2 + j) >= 0; const bf16* rr = RB + (size_t)(t - 2 + j) * NB; cg[j] = ok ? *(const u32x4*)(rr + B_CG + c) : (u32x4){0u, 0u, 0u, 0u}; hb[j] = ok ? *(const u32x4*)(rr + B_HB + c) : (u32x4){0u, 0u, 0u, 0u}; }
    bf16* ra = RA + (size_t)t * NA + A_BG + c; const u32x4 bg = *(const u32x4*)ra;
#pragma unroll
    for (int j = 0; j < 3; ++j) { float a[8], b[8]; unpack8(cg[j], a); unpack8(hb[j], b); const f32x4 w0 = *(const f32x4*)(scw + j * 512 + c), w1 = *(const f32x4*)(scw + j * 512 + c + 4);
        acc[0] += w0.x * (a[0] * b[0]); acc[1] += w0.y * (a[1] * b[1]); acc[2] += w0.z * (a[2] * b[2]); acc[3] += w0.w * (a[3] * b[3]);
        acc[4] += w1.x * (a[4] * b[4]); acc[5] += w1.y * (a[5] * b[5]); acc[6] += w1.z * (a[6] * b[6]); acc[7] += w1.w * (a[7] * b[7]); }
    float g8[8]; unpack8(bg, g8); u32x4 w; w.x = pk2(g8[0] * acc[0], g8[1] * acc[1]); w.y = pk2(g8[2] * acc[2], g8[3] * acc[3]); w.z = pk2(g8[4] * acc[4], g8[5] * acc[5]); w.w = pk2(g8[6] * acc[6], g8[7] * acc[7]);
    if (!dry) *(u32x4*)ra = w;
}
__device__ __forceinline__ void prep_conv(const bf16* __restrict__ RB, bf16* __restrict__ XA, const float* __restrict__ cw, const float* __restrict__ cb, int it, int lane) {
    const int rb = it / 12, cbk = it % 12, xcol = cbk * 128 + 2 * lane, t0 = rb * 16, s0 = t0 & (SEQ - 1);
    float w0[4], w1[4];
#pragma unroll
    for (int j = 0; j < 4; ++j) { w0[j] = cw[j * XBC + xcol]; w1[j] = cw[j * XBC + xcol + 1]; }
    const float cb0 = cb[xcol], cb1 = cb[xcol + 1];
    const bf16* src = RB + (size_t)(t0 - 3) * NB + B_XBC + xcol; unsigned raw[19];
#pragma unroll
    for (int i = 0; i < 19; ++i) raw[i] = (s0 - 3 + i >= 0) ? *(const unsigned*)(src + (size_t)i * NB) : 0u;
#pragma unroll
    for (int i = 0; i < 16; ++i) { float a0 = cb0, a1 = cb1;
#pragma unroll
        for (int j = 0; j < 4; ++j) { a0 += w0[j] * __builtin_bit_cast(float, raw[i + j] << 16); a1 += w1[j] * __builtin_bit_cast(float, raw[i + j] & 0xffff0000u); }
        *(unsigned*)(XA + (size_t)(t0 + i) * XBC + xcol) = pk2(siluf_(a0), siluf_(a1)); }
}

typedef short bf16x8_t __attribute__((ext_vector_type(8)));
#ifndef SEL_REP_SEARCH
#define SEL_REP_SEARCH 1
#endif
#ifndef SEL_REP_STAGE
#define SEL_REP_STAGE 1
#endif
#define CNT8_GE(cnt, v0, v1, v2, v3, v4, v5, v6, v7, cand) do { unsigned long long m0_, m1_, m2_, m3_, m4_, m5_, m6_, m7_; \
    asm("v_cmp_ge_u32_e64 %0, %8, %16\n\tv_cmp_ge_u32_e64 %1, %9, %16\n\tv_cmp_ge_u32_e64 %2, %10, %16\n\tv_cmp_ge_u32_e64 %3, %11, %16\n\t" \
        "v_cmp_ge_u32_e64 %4, %12, %16\n\tv_cmp_ge_u32_e64 %5, %13, %16\n\tv_cmp_ge_u32_e64 %6, %14, %16\n\tv_cmp_ge_u32_e64 %7, %15, %16" \
        : "=&s"(m0_), "=&s"(m1_), "=&s"(m2_), "=&s"(m3_), "=&s"(m4_), "=&s"(m5_), "=&s"(m6_), "=&s"(m7_) \
        : "v"(v0), "v"(v1), "v"(v2), "v"(v3), "v"(v4), "v"(v5), "v"(v6), "v"(v7), "s"(cand)); \
    cnt += (__popcll(m0_) + __popcll(m1_)) + (__popcll(m2_) + __popcll(m3_)) + (__popcll(m4_) + __popcll(m5_)) + (__popcll(m6_) + __popcll(m7_)); } while (0)
constexpr int SC_STRIDE = 516, SC_BUF = 16 * SC_STRIDE;
constexpr int IKW_OFF = 66560;
__device__ __forceinline__ void wg_select16(LDSP unsigned char* lds, const bf16* __restrict__ RB, const bf16* __restrict__ IKC, unsigned short* __restrict__ idx, int unit, int tid, bool dry = false, bool lds_out = false) {
    const int lane = tid & 63, wave = __builtin_amdgcn_readfirstlane(tid >> 6), g = lane >> 4, c = lane & 15;
    const int b = unit >> 8, qg = unit & 255, t0 = b * SEQ + qg * 16, nk = ((qg >> 2) + 1) << 6, nr = nk >> 6;
    LDSP unsigned* SC = (LDSP unsigned*)lds;
    bf16x8_t bq[4][2]; float iwq[4];
    { const bf16* qr = RB + (size_t)(t0 + c) * NB;
#pragma unroll
      for (int h = 0; h < 4; ++h) { bq[h][0] = *(const bf16x8_t*)(qr + B_IQ + h * 64 + g * 8); bq[h][1] = *(const bf16x8_t*)(qr + B_IQ + h * 64 + 32 + g * 8); iwq[h] = bf2f(qr[B_IW + h]) * 0.0625f; } }
    unsigned val[2][64];
#pragma unroll
    for (int r = 0; r < 64; ++r) { val[0][r] = 0u; val[1][r] = 0u; }
    const bf16* ikb = IKC + (size_t)b * SEQ * 64;
    LDSP unsigned char* ikw = lds + IKW_OFF + wave * 8192;
#define IK_DMA(stage) do { if ((stage) * 512 + wave * 64 < nk) { const bf16* src_ = ikb + (size_t)((stage) * 512 + wave * 64) * 64 + lane * 8; _Pragma("unroll") for (int pc_ = 0; pc_ < 8; ++pc_) \
        __builtin_amdgcn_global_load_lds((const unsigned*)(src_ + pc_ * 512), (LDSP unsigned*)(ikw + pc_ * 1024), 16, 0, 0); } } while (0)
    IK_DMA(0);
    for (int rep_st = 0; rep_st < SEL_REP_STAGE; ++rep_st) {
    if (rep_st > 0) { asm volatile("s_waitcnt vmcnt(0)" ::: "memory"); __builtin_amdgcn_s_barrier(); IK_DMA(0); }
#pragma unroll
    for (int s = 0; s < 8; ++s) {
        if (s * 512 < nk) {
            LDSP unsigned* buf = SC + (s & 1) * SC_BUF;
            asm volatile("s_waitcnt vmcnt(0)" ::: "memory");
            bf16x8_t af[4][2];
#pragma unroll
            for (int i = 0; i < 4; ++i) { af[i][0] = *(const LDSP bf16x8_t*)(ikw + (16 * i + c) * 128 + g * 16); af[i][1] = *(const LDSP bf16x8_t*)(ikw + (16 * i + c) * 128 + 64 + g * 16); }
            asm volatile("s_waitcnt lgkmcnt(0)" ::: "memory");
            if (s < 7) IK_DMA(s + 1);
#pragma unroll
            for (int i = 0; i < 4; ++i) { const int tl = wave * 4 + i, kb = s * 512 + tl * 16;
                if (kb < nk) {
                    const bf16x8_t a0 = af[i][0], a1 = af[i][1];
                    float sc[4] = {0.f, 0.f, 0.f, 0.f};
#pragma unroll
                    for (int h = 0; h < 4; ++h) { pg8::f32x4 acc = {0.f, 0.f, 0.f, 0.f};
                        acc = __builtin_amdgcn_mfma_f32_16x16x32_bf16(a0, bq[h][0], acc, 0, 0, 0); acc = __builtin_amdgcn_mfma_f32_16x16x32_bf16(a1, bq[h][1], acc, 0, 0, 0);
#pragma unroll
                        for (int e = 0; e < 4; ++e) sc[e] += fmaxf(acc[e], 0.f) * iwq[h]; }
                    u32x4 kv; kv.x = ord_key(sc[0]); kv.y = ord_key(sc[1]); kv.z = ord_key(sc[2]); kv.w = ord_key(sc[3]);
                    *(LDSP u32x4*)(buf + c * SC_STRIDE + tl * 16 + 4 * g) = kv; } }
            asm volatile("s_waitcnt lgkmcnt(0)" ::: "memory"); __builtin_amdgcn_s_barrier(); asm volatile("" ::: "memory");
#pragma unroll
            for (int j = 0; j < 8; ++j) if (s * 512 + j * 64 < nk) { val[0][s * 8 + j] = buf[(2 * wave) * SC_STRIDE + j * 64 + lane]; val[1][s * 8 + j] = buf[(2 * wave + 1) * SC_STRIDE + j * 64 + lane]; }
            asm volatile("s_waitcnt lgkmcnt(0)" ::: "memory");
        }
    }
    }
    const unsigned long long lt = (1ull << lane) - 1ull;
#pragma unroll
    for (int qq = 0; qq < 2; ++qq) {
        unsigned Tt = 0u;
        for (int rep_se = 0; rep_se < SEL_REP_SEARCH; ++rep_se) { Tt = 0u; asm volatile("" : "+v"(val[qq][0]));
        if (nk > TOPK) {
            for (int bit = 31; bit >= 0; --bit) { const unsigned cand = Tt | (1u << bit); int cnt = 0;
#pragma unroll
                for (int r8 = 0; r8 < 8; ++r8) if (r8 * 8 < nr) CNT8_GE(cnt, val[qq][r8 * 8], val[qq][r8 * 8 + 1], val[qq][r8 * 8 + 2], val[qq][r8 * 8 + 3], val[qq][r8 * 8 + 4], val[qq][r8 * 8 + 5], val[qq][r8 * 8 + 6], val[qq][r8 * 8 + 7], cand);
                if (cnt >= TOPK) Tt = cand; if (cnt == TOPK) break; }
        }
        }
        unsigned short* orow = idx + (size_t)(t0 + 2 * wave + qq) * TOPK;
        LDSP unsigned short* orow_l = (LDSP unsigned short*)(lds + 134 * 1024) + (2 * wave + qq) * TOPK;
        int pos = 0;
#define PUT_KEY(o_, key_) do { if ((o_) < TOPK && !dry) { if (lds_out) orow_l[o_] = (unsigned short)(key_); else orow[o_] = (unsigned short)(key_); } } while (0)
#pragma unroll
        for (int r8 = 0; r8 < 8; ++r8) if (r8 * 8 < nr) { unsigned long long k0, k1, k2, k3, k4, k5, k6, k7;
            asm("v_cmp_gt_u32_e64 %0, %8, %16\n\tv_cmp_gt_u32_e64 %1, %9, %16\n\tv_cmp_gt_u32_e64 %2, %10, %16\n\tv_cmp_gt_u32_e64 %3, %11, %16\n\t"
                "v_cmp_gt_u32_e64 %4, %12, %16\n\tv_cmp_gt_u32_e64 %5, %13, %16\n\tv_cmp_gt_u32_e64 %6, %14, %16\n\tv_cmp_gt_u32_e64 %7, %15, %16"
                : "=&s"(k0), "=&s"(k1), "=&s"(k2), "=&s"(k3), "=&s"(k4), "=&s"(k5), "=&s"(k6), "=&s"(k7)
                : "v"(val[qq][r8 * 8]), "v"(val[qq][r8 * 8 + 1]), "v"(val[qq][r8 * 8 + 2]), "v"(val[qq][r8 * 8 + 3]), "v"(val[qq][r8 * 8 + 4]), "v"(val[qq][r8 * 8 + 5]), "v"(val[qq][r8 * 8 + 6]), "v"(val[qq][r8 * 8 + 7]), "s"(Tt));
#define PUT_MASK(m_, i_) do { if ((m_) != 0ull) { if (((m_) >> lane) & 1ull) { const int o = pos + __popcll((m_) & lt); PUT_KEY(o, (r8 * 8 + (i_)) * 64 + lane); } pos += __popcll(m_); } } while (0)
            PUT_MASK(k0, 0); PUT_MASK(k1, 1); PUT_MASK(k2, 2); PUT_MASK(k3, 3); PUT_MASK(k4, 4); PUT_MASK(k5, 5); PUT_MASK(k6, 6); PUT_MASK(k7, 7);
#undef PUT_MASK
        }
        int need = TOPK - pos;
        if (need > 0) {
#pragma unroll
            for (int r = 0; r < 64; ++r) if (r < nr && need > 0) { const unsigned long long meq = __ballot(val[qq][r] == Tt);
                if (meq != 0ull) { const int rank = __popcll(meq & lt); if (((meq >> lane) & 1ull) && rank < need) { PUT_KEY(pos + rank, r * 64 + lane); } const int tk = __popcll(meq); const int tkn = tk < need ? tk : need; pos += tkn; need -= tkn; } }
        }
#undef PUT_KEY
    }
    asm volatile("s_waitcnt vmcnt(0) lgkmcnt(0)" ::: "memory"); __builtin_amdgcn_s_barrier();
#undef IK_DMA
}

typedef unsigned short u16x4_t __attribute__((ext_vector_type(4)));
#ifndef ATT_LOCAL_DRY
#define ATT_LOCAL_DRY 0
#endif
#ifndef ATT_STAGGER
#define ATT_STAGGER 0
#endif
#ifndef ATT_DRY_SKIP
#define ATT_DRY_SKIP 0
#endif
#define DSK(b) (ATT_DRY_SKIP & (b)) && dry
#ifndef ATT_SUB_EN
#define ATT_SUB_EN 0
#endif
constexpr int SELW_OFF = 134 * 1024, BT_OFF = 142 * 1024, KVP = 528, TILE_STRIDE = 32 * KVP;
constexpr int SELW_OFF_OLD = 132 * 1024, BT_OFF_OLD = 140 * 1024;
__device__ __forceinline__ int kv_off(int row, int ch) { const int hf = ch >> 4, c16 = ch & 15; return hf * 8192 + 256 * row + 16 * (c16 ^ (((row & 3) << 2) | ((row >> 2) & 3))); }
#define TR4I(d0, d1, d2, d3, base, o0, o1, o2, o3) asm volatile("ds_read_b64_tr_b16 %0, %4 offset:%5\n\tds_read_b64_tr_b16 %1, %4 offset:%6\n\tds_read_b64_tr_b16 %2, %4 offset:%7\n\tds_read_b64_tr_b16 %3, %4 offset:%8" \
    : "=&v"(d0), "=&v"(d1), "=&v"(d2), "=&v"(d3) : "v"(base), "i"(o0), "i"(o1), "i"(o2), "i"(o3) : "memory")
#define TR8N(d0, d1, d2, d3, d4, d5, d6, d7, base, o0, o1, o2, o3, o4, o5, o6, o7) asm volatile( \
    "ds_read_b64_tr_b16 %0, %8 offset:%9\n\tds_read_b64_tr_b16 %1, %8 offset:%10\n\tds_read_b64_tr_b16 %2, %8 offset:%11\n\tds_read_b64_tr_b16 %3, %8 offset:%12\n\t" \
    "ds_read_b64_tr_b16 %4, %8 offset:%13\n\tds_read_b64_tr_b16 %5, %8 offset:%14\n\tds_read_b64_tr_b16 %6, %8 offset:%15\n\tds_read_b64_tr_b16 %7, %8 offset:%16" \
    : "=&v"(d0), "=&v"(d1), "=&v"(d2), "=&v"(d3), "=&v"(d4), "=&v"(d5), "=&v"(d6), "=&v"(d7) : "v"(base), "i"(o0), "i"(o1), "i"(o2), "i"(o3), "i"(o4), "i"(o5), "i"(o6), "i"(o7) : "memory")
#define WAITPIN8(n, d0, d1, d2, d3, d4, d5, d6, d7) asm volatile("s_waitcnt lgkmcnt(" #n ")" : "+v"(d0), "+v"(d1), "+v"(d2), "+v"(d3), "+v"(d4), "+v"(d5), "+v"(d6), "+v"(d7) :: "memory")
#define WAITPIN4(n, d0, d1, d2, d3) asm volatile("s_waitcnt lgkmcnt(" #n ")" : "+v"(d0), "+v"(d1), "+v"(d2), "+v"(d3) :: "memory")
__device__ __forceinline__ bf16x8_t mk8a(u16x4_t a, u16x4_t b) { bf16x8_t r; r[0] = a[0]; r[1] = a[1]; r[2] = a[2]; r[3] = a[3]; r[4] = b[0]; r[5] = b[1]; r[6] = b[2]; r[7] = b[3]; return r; }
#define TR8I(d0, d1, d2, d3, d4, d5, d6, d7, base, o0, o1, o2, o3, o4, o5, o6, o7) asm volatile( \
    "ds_read_b64_tr_b16 %0, %8 offset:%9\n\tds_read_b64_tr_b16 %1, %8 offset:%10\n\tds_read_b64_tr_b16 %2, %8 offset:%11\n\tds_read_b64_tr_b16 %3, %8 offset:%12\n\t" \
    "ds_read_b64_tr_b16 %4, %8 offset:%13\n\tds_read_b64_tr_b16 %5, %8 offset:%14\n\tds_read_b64_tr_b16 %6, %8 offset:%15\n\tds_read_b64_tr_b16 %7, %8 offset:%16\n\ts_waitcnt lgkmcnt(0)" \
    : "=&v"(d0), "=&v"(d1), "=&v"(d2), "=&v"(d3), "=&v"(d4), "=&v"(d5), "=&v"(d6), "=&v"(d7) : "v"(base), "i"(o0), "i"(o1), "i"(o2), "i"(o3), "i"(o4), "i"(o5), "i"(o6), "i"(o7) : "memory")
#define TR8(d0, d1, d2, d3, d4, d5, d6, d7, a0, a1, a2, a3, a4, a5, a6, a7) asm volatile( \
    "ds_read_b64_tr_b16 %0, %8\n\tds_read_b64_tr_b16 %1, %9\n\tds_read_b64_tr_b16 %2, %10\n\tds_read_b64_tr_b16 %3, %11\n\t" \
    "ds_read_b64_tr_b16 %4, %12\n\tds_read_b64_tr_b16 %5, %13\n\tds_read_b64_tr_b16 %6, %14\n\tds_read_b64_tr_b16 %7, %15\n\ts_waitcnt lgkmcnt(0)" \
    : "=&v"(d0), "=&v"(d1), "=&v"(d2), "=&v"(d3), "=&v"(d4), "=&v"(d5), "=&v"(d6), "=&v"(d7) : "v"(a0), "v"(a1), "v"(a2), "v"(a3), "v"(a4), "v"(a5), "v"(a6), "v"(a7) : "memory")
__device__ __forceinline__ void wg_attn16(LDSP unsigned char* lds, bf16* RA, const bf16* __restrict__ CKVC, const unsigned short* __restrict__ idx, const bf16* __restrict__ WUK, const bf16* __restrict__ WUV,
                                          const float* __restrict__ rel_bias, int unit, int nxt_unit, int par, bool first, int tid, bool dry = false, int qmode = 0, bf16* qscr = nullptr) {
    const int lane = tid & 63, wave = __builtin_amdgcn_readfirstlane(tid >> 6), g = lane >> 4, c = lane & 15;
    const int b = unit >> 9, qg = unit & 511, t0 = b * SEQ + qg * 8, nk = ((qg >> 3) + 1) << 6, nsel = nk < TOPK ? nk : TOPK, ntile = nsel >> 5;
    LDSP unsigned char* QL = lds;
    LDSP unsigned char* tile = lds + wave * TILE_STRIDE;
    LDSP unsigned short* selw = (LDSP unsigned short*)(lds + SELW_OFF + (par * 8 + wave) * 512);
    LDSP unsigned short* selw_n = (LDSP unsigned short*)(lds + SELW_OFF + ((par ^ 1) * 8 + wave) * 512);
    if (first) { if (lane < 32) *((LDSP u32x4*)selw + lane) = *((const u32x4*)(idx + (size_t)(t0 + wave) * TOPK) + lane); }
    const bf16* kvb = CKVC + (size_t)b * SEQ * KV_R + g * 8;
    bf16x8_t kv0[8], kv1[8];
#define KV_LOAD(dst, key) do { const bf16* rp_ = kvb + (size_t)(key) * KV_R; _Pragma("unroll") for (int ks_ = 0; ks_ < 8; ++ks_) dst[ks_] = *(const bf16x8_t*)(rp_ + ks_ * 32); } while (0)
    int ka = (int)selw[c], kb = (int)selw[16 + c];
    KV_LOAD(kv0, ka); KV_LOAD(kv1, kb);
    bf16x8_t qf[8];
    if (qmode != 2) {
        const int h = wave; const bf16* qr = RA + (size_t)(t0 + (qmode == 1 ? c : (c & 7))) * NA + A_Q + h * 64 + g * 8;
        const bf16x8_t b0 = *(const bf16x8_t*)qr, b1 = *(const bf16x8_t*)(qr + 32);
        const bf16* wb = WUK + ((size_t)h * 256 + c) * 64 + g * 8;
#pragma unroll 4
        for (int rt = 0; rt < 16; ++rt) { const bf16x8_t a0 = *(const bf16x8_t*)(wb + rt * 16 * 64), a1 = *(const bf16x8_t*)(wb + rt * 16 * 64 + 32);
            pg8::f32x4 acc = {0.f, 0.f, 0.f, 0.f};
            acc = __builtin_amdgcn_mfma_f32_16x16x32_bf16(a0, b0, acc, 0, 0, 0); acc = __builtin_amdgcn_mfma_f32_16x16x32_bf16(a1, b1, acc, 0, 0, 0);
            u32x2 w; w.x = pk2(acc[0], acc[1]); w.y = pk2(acc[2], acc[3]);
            if (c < 8) *(LDSP u32x2*)(QL + (((c * 8 + h) * 256) + rt * 16 + 4 * g) * 2) = w;
            else if (qmode == 1) *(u32x2*)(qscr + ((((c - 8) * 8 + h) * 256) + rt * 16 + 4 * g)) = w; }
        asm volatile("s_waitcnt lgkmcnt(0)" ::: "memory"); __builtin_amdgcn_s_barrier(); asm volatile("" ::: "memory");
#pragma unroll
        for (int ks = 0; ks < 8; ++ks) qf[ks] = *(const LDSP bf16x8_t*)(QL + (((wave * 8 + (c & 7)) * 256) + ks * 32 + g * 8) * 2);
        asm volatile("s_waitcnt lgkmcnt(0)" ::: "memory"); __builtin_amdgcn_s_barrier(); asm volatile("" ::: "memory");
    } else {
        const unsigned long long* qs = (const unsigned long long*)(qscr + (((wave * 8 + (c & 7)) * 256) + g * 8));
#pragma unroll
        for (int ks = 0; ks < 8; ++ks) { const unsigned long long lo = __hip_atomic_load(qs + ks * 8, __ATOMIC_RELAXED, __HIP_MEMORY_SCOPE_AGENT), hi = __hip_atomic_load(qs + ks * 8 + 1, __ATOMIC_RELAXED, __HIP_MEMORY_SCOPE_AGENT);
            u32x4 w; w.x = (unsigned)lo; w.y = (unsigned)(lo >> 32); w.z = (unsigned)hi; w.w = (unsigned)(hi >> 32); qf[ks] = __builtin_bit_cast(bf16x8_t, w); }
    }
    const unsigned tile_a = (unsigned)(size_t)tile;
#if ATT_STAGGER
    if (wave >= 4) __builtin_amdgcn_s_sleep(ATT_STAGGER);
#endif
    bf16x8_t bbf; { float bv[8];
#pragma unroll
        for (int j = 0; j < 8; ++j) bv[j] = rel_bias[(8 * g + j) * 8 + (c & 7)];
        u32x4 w; w.x = pk2(bv[0], bv[1]); w.y = pk2(bv[2], bv[3]); w.z = pk2(bv[4], bv[5]); w.w = pk2(bv[6], bv[7]); bbf = __builtin_bit_cast(bf16x8_t, w); }
    {
        const int spos = (qg * 8 + wave);
        pg8::f32x4 acc[16];
#pragma unroll
        for (int nt = 0; nt < 16; ++nt) acc[nt] = (pg8::f32x4){0.f, 0.f, 0.f, 0.f};
        float m_run = -INFINITY, l_run = 0.f;
#define ONEHOT(dst, key) do { const int rel_ = (key) - spos, n_ = rel_ < 0 ? -rel_ : rel_; \
            const int big_ = 8 + (n_ >= 15) + (n_ >= 27) + (n_ >= 50) + (n_ >= 91) + (n_ >= 166) + (n_ >= 305) + (n_ >= 559); \
            const int pos_ = (n_ < 8 ? n_ : big_) + (rel_ > 0 ? 16 : 0) - 8 * g; const unsigned one_ = (pos_ & 1) ? 0x3F800000u : 0x3F80u; const int hi_ = pos_ >> 1; \
            u32x4 w_; w_.x = (hi_ == 0) ? one_ : 0u; w_.y = (hi_ == 1) ? one_ : 0u; w_.z = (hi_ == 2) ? one_ : 0u; w_.w = (hi_ == 3) ? one_ : 0u; dst = __builtin_bit_cast(bf16x8_t, w_); } while (0)
        const int q4 = c >> 2, p = c & 3;
        const unsigned trb = tile_a + (4 * g + q4) * KVP + 8 * p;
        for (int tl = 0; tl < ntile; ++tl) {
            int kan = 0, kbn = 0; const bool more = tl + 1 < ntile;
            if (more) { kan = (int)selw[(2 * tl + 2) * 16 + c]; kbn = (int)selw[(2 * tl + 3) * 16 + c]; }
            bf16x8_t oha, ohb; ONEHOT(oha, ka); ONEHOT(ohb, kb);
            asm volatile("s_waitcnt vmcnt(8)" ::: "memory");
            pg8::f32x4 s0 = {0.f, 0.f, 0.f, 0.f}, s1 = {0.f, 0.f, 0.f, 0.f};
            s0 = __builtin_amdgcn_mfma_f32_16x16x32_bf16(oha, bbf, s0, 0, 0, 0);
#pragma unroll
            for (int ks = 0; ks < 8; ++ks) { s0 = __builtin_amdgcn_mfma_f32_16x16x32_bf16(kv0[ks], qf[ks], s0, 0, 0, 0); *(LDSP bf16x8_t*)(tile + c * KVP + g * 16 + ks * 64) = kv0[ks]; }
            if (more) KV_LOAD(kv0, kan);
            if (more) asm volatile("s_waitcnt vmcnt(8)" ::: "memory"); else asm volatile("s_waitcnt vmcnt(0)" ::: "memory");
            s1 = __builtin_amdgcn_mfma_f32_16x16x32_bf16(ohb, bbf, s1, 0, 0, 0);
#pragma unroll
            for (int ks = 0; ks < 8; ++ks) { s1 = __builtin_amdgcn_mfma_f32_16x16x32_bf16(kv1[ks], qf[ks], s1, 0, 0, 0); *(LDSP bf16x8_t*)(tile + (16 + c) * KVP + g * 16 + ks * 64) = kv1[ks]; }
            if (more) KV_LOAD(kv1, kbn);
            ka = kan; kb = kbn;
            float sv[8];
#pragma unroll
            for (int j = 0; j < 4; ++j) { sv[j] = s0[j]; sv[4 + j] = s1[j]; }
            float tmax = fmaxf(fmaxf(fmaxf(sv[0], sv[1]), fmaxf(sv[2], sv[3])), fmaxf(fmaxf(sv[4], sv[5]), fmaxf(sv[6], sv[7])));
            tmax = fmaxf(tmax, __shfl_xor(tmax, 16)); tmax = fmaxf(tmax, __shfl_xor(tmax, 32));
            const float m_new = fmaxf(m_run, tmax); const float scl = __expf(m_run - m_new); const bool grow = m_new > m_run; m_run = m_new;
            float ps = 0.f;
#pragma unroll
            for (int j = 0; j < 8; ++j) { sv[j] = __expf(sv[j] - m_new); ps += sv[j]; }
            l_run = l_run * scl + ps;
            bf16x8_t pf; { u32x4 w; w.x = pk2(sv[0], sv[1]); w.y = pk2(sv[2], sv[3]); w.z = pk2(sv[4], sv[5]); w.w = pk2(sv[6], sv[7]); pf = __builtin_bit_cast(bf16x8_t, w); }
            if (__builtin_amdgcn_ballot_w64(grow) != 0ull) {
                float rs[4];
#pragma unroll
                for (int e = 0; e < 4; ++e) rs[e] = __shfl(scl, 4 * g + e);
#pragma unroll
                for (int nt = 0; nt < 16; ++nt) {
#pragma unroll
                    for (int e = 0; e < 4; ++e) acc[nt][e] *= rs[e]; } }
            asm volatile("s_waitcnt lgkmcnt(0)" ::: "memory");
            u16x4_t va[8], vb[8];
            TR8N(va[0], va[1], va[2], va[3], va[4], va[5], va[6], va[7], trb, 0, 16 * KVP, 32, 32 + 16 * KVP, 64, 64 + 16 * KVP, 96, 96 + 16 * KVP);
            TR8N(vb[0], vb[1], vb[2], vb[3], vb[4], vb[5], vb[6], vb[7], trb, 128, 128 + 16 * KVP, 160, 160 + 16 * KVP, 192, 192 + 16 * KVP, 224, 224 + 16 * KVP);
            WAITPIN8(8, va[0], va[1], va[2], va[3], va[4], va[5], va[6], va[7]);
#pragma unroll
            for (int k = 0; k < 4; ++k) acc[k] = __builtin_amdgcn_mfma_f32_16x16x32_bf16(pf, mk8a(va[2 * k], va[2 * k + 1]), acc[k], 0, 0, 0);
            TR8N(va[0], va[1], va[2], va[3], va[4], va[5], va[6], va[7], trb, 256, 256 + 16 * KVP, 288, 288 + 16 * KVP, 320, 320 + 16 * KVP, 352, 352 + 16 * KVP);
            WAITPIN8(8, vb[0], vb[1], vb[2], vb[3], vb[4], vb[5], vb[6], vb[7]);
#pragma unroll
            for (int k = 0; k < 4; ++k) acc[4 + k] = __builtin_amdgcn_mfma_f32_16x16x32_bf16(pf, mk8a(vb[2 * k], vb[2 * k + 1]), acc[4 + k], 0, 0, 0);
            TR8N(vb[0], vb[1], vb[2], vb[3], vb[4], vb[5], vb[6], vb[7], trb, 384, 384 + 16 * KVP, 416, 416 + 16 * KVP, 448, 448 + 16 * KVP, 480, 480 + 16 * KVP);
            WAITPIN8(8, va[0], va[1], va[2], va[3], va[4], va[5], va[6], va[7]);
#pragma unroll
            for (int k = 0; k < 4; ++k) acc[8 + k] = __builtin_amdgcn_mfma_f32_16x16x32_bf16(pf, mk8a(va[2 * k], va[2 * k + 1]), acc[8 + k], 0, 0, 0);
            WAITPIN8(0, vb[0], vb[1], vb[2], vb[3], vb[4], vb[5], vb[6], vb[7]);
#pragma unroll
            for (int k = 0; k < 4; ++k) acc[12 + k] = __builtin_amdgcn_mfma_f32_16x16x32_bf16(pf, mk8a(vb[2 * k], vb[2 * k + 1]), acc[12 + k], 0, 0, 0);
        }
#undef KV_LOAD
#undef ONEHOT
        float lt = l_run + __shfl_xor(l_run, 16); lt += __shfl_xor(lt, 32); const float inv = 1.0f / lt;
        float ri[4];
#pragma unroll
        for (int e = 0; e < 4; ++e) ri[e] = __shfl(inv, 4 * g + e);
        if (g < 2) {
#pragma unroll
            for (int nt = 0; nt < 16; ++nt) { LDSP unsigned short* o1 = (LDSP unsigned short*)(tile) + (4 * g) * 256 + nt * 16 + c;
                o1[0] = f2bf(acc[nt][0] * ri[0]); o1[256] = f2bf(acc[nt][1] * ri[1]); o1[512] = f2bf(acc[nt][2] * ri[2]); o1[768] = f2bf(acc[nt][3] * ri[3]); }
        }
    }
    u32x4 nsel_v = {0u, 0u, 0u, 0u};
    if (nxt_unit >= 0 && lane < 32) { const int nb = nxt_unit >> 9, nq = nxt_unit & 511; nsel_v = *((const u32x4*)(idx + (size_t)(nb * SEQ + nq * 8 + wave) * TOPK) + lane); }
    asm volatile("s_waitcnt lgkmcnt(0)" ::: "memory"); __builtin_amdgcn_s_barrier(); asm volatile("" ::: "memory");
    if (qmode == 1) {
        bf16* oscr = qscr + 16384;
#pragma unroll
        for (int j = 0; j < 4; ++j) *((u32x4*)(oscr + (size_t)wave * 2048) + j * 64 + lane) = *((const LDSP u32x4*)(tile) + j * 64 + lane);
    } else {
        const int h = wave; pg8::f32x4 o[4];
#pragma unroll
        for (int nt = 0; nt < 4; ++nt) o[nt] = (pg8::f32x4){0.f, 0.f, 0.f, 0.f};
        const LDSP unsigned char* ab = lds + TILE_STRIDE * (c & 7) + (h * 256 + g * 8) * 2;
        const unsigned long long* os = (const unsigned long long*)(qscr + 16384 + ((c & 7) * 8 + h) * 256 + g * 8);
        const bf16* wb = WUV + ((size_t)h * 64 + c) * 256 + g * 8;
        const bool from_scr = (qmode == 2) && (c < 8);
#pragma unroll
        for (int ks = 0; ks < 8; ++ks) { bf16x8_t a;
            if (from_scr) { const unsigned long long lo = __hip_atomic_load(os + ks * 8, __ATOMIC_RELAXED, __HIP_MEMORY_SCOPE_AGENT), hi = __hip_atomic_load(os + ks * 8 + 1, __ATOMIC_RELAXED, __HIP_MEMORY_SCOPE_AGENT);
                u32x4 w; w.x = (unsigned)lo; w.y = (unsigned)(lo >> 32); w.z = (unsigned)hi; w.w = (unsigned)(hi >> 32); a = __builtin_bit_cast(bf16x8_t, w); }
            else a = *(const LDSP bf16x8_t*)(ab + ks * 64);
#pragma unroll
            for (int nt = 0; nt < 4; ++nt) { const bf16x8_t bw = *(const bf16x8_t*)(wb + (size_t)nt * 16 * 256 + ks * 32); o[nt] = __builtin_amdgcn_mfma_f32_16x16x32_bf16(a, bw, o[nt], 0, 0, 0); } }
        const int rbase = (qmode == 2) ? t0 - 8 : t0;
        if ((g < 2 || qmode == 2) && !dry) {
#pragma unroll
            for (int nt = 0; nt < 4; ++nt)
#pragma unroll
                for (int e = 0; e < 4; ++e) RA[(size_t)(rbase + 4 * g + e) * NA + A_Q + h * 64 + nt * 16 + c] = f2bf(o[nt][e]); }
    }
    if (nxt_unit >= 0 && lane < 32) *((LDSP u32x4*)selw_n + lane) = nsel_v;
    asm volatile("s_waitcnt vmcnt(0) lgkmcnt(0)" ::: "memory"); __builtin_amdgcn_s_barrier(); asm volatile("" ::: "memory");
}

template <int VAR = 0> __device__ __forceinline__ void wg_attn16d(LDSP unsigned char* lds, bf16* RA, const bf16* __restrict__ CKVC, const unsigned short* __restrict__ idx, const bf16* __restrict__ WUK, const bf16* __restrict__ WUV,
                                          const float* __restrict__ rel_bias, int unit, int nxt_unit, int par, bool first, int tid, bool dry = false, int qmode = 0, bf16* qscr = nullptr) {
    const int lane = tid & 63, wave = __builtin_amdgcn_readfirstlane(tid >> 6), g = lane >> 4, c = lane & 15;
    const int b = unit >> 9, qg = unit & 511, t0 = b * SEQ + qg * 8, nk = ((qg >> 3) + 1) << 6, nsel = nk < TOPK ? nk : TOPK, ntile = nsel >> 5;
    LDSP unsigned char* QL = lds;
    LDSP unsigned char* tile = lds + wave * TILE_STRIDE;
    LDSP unsigned short* selw = (LDSP unsigned short*)(lds + SELW_OFF + (par * 8 + wave) * 512);
    LDSP unsigned short* selw_n = (LDSP unsigned short*)(lds + SELW_OFF + ((par ^ 1) * 8 + wave) * 512);
    if (first) { if (lane < 32) *((LDSP u32x4*)selw + lane) = *((const u32x4*)(idx + (size_t)(t0 + wave) * TOPK) + lane); }
    const bf16* kvb = CKVC + (size_t)b * SEQ * KV_R;
    const int nstep = (VAR & 64) ? 0 : (nsel >> 4);
    constexpr bool halfdma = (VAR & 1) != 0, nodma = (VAR & 2) != 0, nolds = (VAR & 4) != 0, nopv = (VAR & 8) != 0, noqk = (VAR & 16) != 0, nosm = (VAR & 32) != 0;
#define KV_DMA(step) do { if (nodma) break; LDSP unsigned char* sl_ = tile + ((step) & 1) * 8192; \
        _Pragma("unroll") for (int i4_ = 0; i4_ < 4; ++i4_) { const int row_ = 4 * i4_ + g; const int key_ = (int)selw[(step) * 16 + row_]; const int c16_ = c ^ ((g << 2) | i4_); \
            const bf16* src_ = kvb + (size_t)key_ * KV_R + c16_ * 8; \
            __builtin_amdgcn_global_load_lds((const unsigned*)src_, (LDSP unsigned*)(sl_ + 1024 * i4_), 16, 0, 0); \
            if (!halfdma) __builtin_amdgcn_global_load_lds((const unsigned*)(src_ + 128), (LDSP unsigned*)(sl_ + 4096 + 1024 * i4_), 16, 0, 0); } } while (0)
    if (nstep > 0) KV_DMA(0);
    bf16x8_t qf[8];
    if (qmode != 2) {
        const int h = wave; const bf16* qr = RA + (size_t)(t0 + (qmode == 1 ? c : (c & 7))) * NA + A_Q + h * 64 + g * 8;
        const bf16x8_t b0 = *(const bf16x8_t*)qr, b1 = *(const bf16x8_t*)(qr + 32);
        const bf16* wb = WUK + ((size_t)h * 256 + c) * 64 + g * 8;
#pragma unroll 4
        for (int rt = 0; rt < 16; ++rt) { const bf16x8_t a0 = *(const bf16x8_t*)(wb + rt * 16 * 64), a1 = *(const bf16x8_t*)(wb + rt * 16 * 64 + 32);
            pg8::f32x4 acc = {0.f, 0.f, 0.f, 0.f};
            acc = __builtin_amdgcn_mfma_f32_16x16x32_bf16(a0, b0, acc, 0, 0, 0); acc = __builtin_amdgcn_mfma_f32_16x16x32_bf16(a1, b1, acc, 0, 0, 0);
            u32x2 w; w.x = pk2(acc[0], acc[1]); w.y = pk2(acc[2], acc[3]);
            if (c < 8) *(LDSP u32x2*)(lds + c * TILE_STRIDE + 8192 + ((h * 256) + rt * 16 + 4 * g) * 2) = w;
            else if (qmode == 1) *(u32x2*)(qscr + ((((c - 8) * 8 + h) * 256) + rt * 16 + 4 * g)) = w; }
        asm volatile("s_waitcnt lgkmcnt(0)" ::: "memory"); __builtin_amdgcn_s_barrier(); asm volatile("" ::: "memory");
#pragma unroll
        for (int ks = 0; ks < 8; ++ks) qf[ks] = *(const LDSP bf16x8_t*)(tile + 8192 + (((c & 7) * 256) + ks * 32 + g * 8) * 2);
        asm volatile("s_waitcnt lgkmcnt(0)" ::: "memory");
    } else {
        const unsigned long long* qs = (const unsigned long long*)(qscr + (((wave * 8 + (c & 7)) * 256) + g * 8));
#pragma unroll
        for (int ks = 0; ks < 8; ++ks) { const unsigned long long lo = __hip_atomic_load(qs + ks * 8, __ATOMIC_RELAXED, __HIP_MEMORY_SCOPE_AGENT), hi = __hip_atomic_load(qs + ks * 8 + 1, __ATOMIC_RELAXED, __HIP_MEMORY_SCOPE_AGENT);
            u32x4 w; w.x = (unsigned)lo; w.y = (unsigned)(lo >> 32); w.z = (unsigned)hi; w.w = (unsigned)(hi >> 32); qf[ks] = __builtin_bit_cast(bf16x8_t, w); }
    }
    const unsigned tile_a = (unsigned)(size_t)tile;
#if ATT_STAGGER
    if (wave >= 4) __builtin_amdgcn_s_sleep(ATT_STAGGER);
#endif
    bf16x8_t bbf; { float bv[8];
#pragma unroll
        for (int j = 0; j < 8; ++j) bv[j] = rel_bias[(8 * g + j) * 8 + (c & 7)];
        u32x4 w; w.x = pk2(bv[0], bv[1]); w.y = pk2(bv[2], bv[3]); w.z = pk2(bv[4], bv[5]); w.w = pk2(bv[6], bv[7]); bbf = __builtin_bit_cast(bf16x8_t, w); }
    {
        const int spos = (qg * 8 + wave);
        pg8::f32x4 acc[16];
#pragma unroll
        for (int nt = 0; nt < 16; ++nt) acc[nt] = (pg8::f32x4){0.f, 0.f, 0.f, 0.f};
        float m_run = -INFINITY, l_run = 0.f;
#define ONEHOT(dst, key) do { const int rel_ = (key) - spos, n_ = rel_ < 0 ? -rel_ : rel_; \
            const int big_ = 8 + (n_ >= 15) + (n_ >= 27) + (n_ >= 50) + (n_ >= 91) + (n_ >= 166) + (n_ >= 305) + (n_ >= 559); \
            const int pos_ = (n_ < 8 ? n_ : big_) + (rel_ > 0 ? 16 : 0) - 8 * g; const unsigned one_ = (pos_ & 1) ? 0x3F800000u : 0x3F80u; const int hi_ = pos_ >> 1; \
            u32x4 w_; w_.x = (hi_ == 0) ? one_ : 0u; w_.y = (hi_ == 1) ? one_ : 0u; w_.z = (hi_ == 2) ? one_ : 0u; w_.w = (hi_ == 3) ? one_ : 0u; dst = __builtin_bit_cast(bf16x8_t, w_); } while (0)
        const int q4 = c >> 2, p = c & 3;
        const unsigned rd0 = tile_a + 256 * c + 16 * (g ^ (c >> 2)); const unsigned rx = (unsigned)(c & 3);
        const unsigned tr0 = tile_a + 256 * (4 * g + q4) + 8 * (p & 1); const unsigned ts = (unsigned)(((q4 << 2) | g)), tb0 = (unsigned)(p >> 1);
        if (nstep > 1) KV_DMA(1);
        for (int st = 0; st < nstep; ++st) {
            const unsigned so = (unsigned)((st & 1) * 8192);
            const int key = (int)selw[st * 16 + c];
            bf16x8_t oh; ONEHOT(oh, key);
            if (st + 1 < nstep) { if (nodma) {} else if (halfdma) asm volatile("s_waitcnt vmcnt(4)" ::: "memory"); else asm volatile("s_waitcnt vmcnt(8)" ::: "memory"); } else asm volatile("s_waitcnt vmcnt(0)" ::: "memory");
            bf16x8_t af[8]; u16x4_t v[16];
#pragma unroll
            for (int ks = 0; ks < 8; ++ks) { if (nolds) af[ks] = qf[ks]; else af[ks] = *(const LDSP bf16x8_t*)(size_t)(rd0 + so + (ks >> 2) * 4096 + 64 * (((unsigned)(ks & 3)) ^ rx)); }
#pragma unroll
            for (int n4 = 0; n4 < 4; ++n4) { unsigned ad[4]; if (nolds) { v[n4 * 4] = v[n4 * 4 + 1] = v[n4 * 4 + 2] = v[n4 * 4 + 3] = (u16x4_t){(unsigned short)st, 1, 2, 3}; continue; }
#pragma unroll
                for (int k = 0; k < 4; ++k) { const unsigned nt = (unsigned)(n4 * 4 + k); ad[k] = tr0 + so + (nt >> 3) * 4096 + 16 * ((((nt & 7) << 1) | tb0) ^ ts); }
                asm volatile("ds_read_b64_tr_b16 %0, %4\n\tds_read_b64_tr_b16 %1, %5\n\tds_read_b64_tr_b16 %2, %6\n\tds_read_b64_tr_b16 %3, %7" : "=&v"(v[n4 * 4]), "=&v"(v[n4 * 4 + 1]), "=&v"(v[n4 * 4 + 2]), "=&v"(v[n4 * 4 + 3]) : "v"(ad[0]), "v"(ad[1]), "v"(ad[2]), "v"(ad[3]) : "memory"); }
            WAITPIN4(0, v[0], v[1], v[2], v[3]); WAITPIN4(0, v[4], v[5], v[6], v[7]); WAITPIN4(0, v[8], v[9], v[10], v[11]); WAITPIN4(0, v[12], v[13], v[14], v[15]);
            if (st + 2 < nstep) KV_DMA(st + 2);
            pg8::f32x4 s0 = {0.f, 0.f, 0.f, 0.f};
            s0 = __builtin_amdgcn_mfma_f32_16x16x32_bf16(oh, bbf, s0, 0, 0, 0);
#pragma unroll
            for (int ks = 0; ks < 8; ++ks) { if (noqk) { if (ks == 0) s0[0] += __builtin_bit_cast(float, ((unsigned)af[0][0] << 16) ^ ((unsigned)af[1][1] << 16) ^ ((unsigned)af[2][1] << 16) ^ ((unsigned)af[3][1] << 16) ^ ((unsigned)af[4][1] << 16) ^ ((unsigned)af[5][1] << 16) ^ ((unsigned)af[6][1] << 16) ^ ((unsigned)af[7][1] << 16)); } else s0 = __builtin_amdgcn_mfma_f32_16x16x32_bf16(af[ks], qf[ks], s0, 0, 0, 0); }
            float tmax = fmaxf(fmaxf(s0[0], s0[1]), fmaxf(s0[2], s0[3]));
            if (!nosm) { tmax = fmaxf(tmax, __shfl_xor(tmax, 16)); tmax = fmaxf(tmax, __shfl_xor(tmax, 32)); }
            const float m_new = fmaxf(m_run, tmax); const float scl = __expf(m_run - m_new); const bool grow = m_new > m_run; m_run = m_new;
            float sv[4]; float ps = 0.f;
#pragma unroll
            for (int j = 0; j < 4; ++j) { sv[j] = __expf(s0[j] - m_new); ps += sv[j]; }
            l_run = l_run * scl + ps;
            typedef short bf16x4_t __attribute__((ext_vector_type(4)));
            bf16x4_t pf; { u32x2 w; w.x = pk2(sv[0], sv[1]); w.y = pk2(sv[2], sv[3]); pf = __builtin_bit_cast(bf16x4_t, w); }
            if (__builtin_amdgcn_ballot_w64(grow) != 0ull) {
                float rs[4];
#pragma unroll
                for (int e = 0; e < 4; ++e) rs[e] = __shfl(scl, 4 * g + e);
#pragma unroll
                for (int nt = 0; nt < 16; ++nt) {
#pragma unroll
                    for (int e = 0; e < 4; ++e) acc[nt][e] *= rs[e]; } }
#pragma unroll
            for (int k = 0; k < 16; ++k) { if (nopv) { acc[k][0] += __builtin_bit_cast(float, (unsigned)v[k][0] << 16) * sv[0]; } else acc[k] = __builtin_amdgcn_mfma_f32_16x16x16bf16_1k(pf, __builtin_bit_cast(bf16x4_t, v[k]), acc[k], 0, 0, 0); }
        }
#undef KV_DMA
#undef ONEHOT
        float lt = l_run + __shfl_xor(l_run, 16); lt += __shfl_xor(lt, 32); const float inv = 1.0f / lt;
        float ri[4];
#pragma unroll
        for (int e = 0; e < 4; ++e) ri[e] = __shfl(inv, 4 * g + e);
        if (g < 2) {
#pragma unroll
            for (int nt = 0; nt < 16; ++nt) { LDSP unsigned short* o1 = (LDSP unsigned short*)(tile) + (4 * g) * 256 + nt * 16 + c;
                o1[0] = f2bf(acc[nt][0] * ri[0]); o1[256] = f2bf(acc[nt][1] * ri[1]); o1[512] = f2bf(acc[nt][2] * ri[2]); o1[768] = f2bf(acc[nt][3] * ri[3]); }
        }
    }
    u32x4 nsel_v = {0u, 0u, 0u, 0u};
    if (nxt_unit >= 0 && lane < 32) { const int nb = nxt_unit >> 9, nq = nxt_unit & 511; nsel_v = *((const u32x4*)(idx + (size_t)(nb * SEQ + nq * 8 + wave) * TOPK) + lane); }
    asm volatile("s_waitcnt lgkmcnt(0)" ::: "memory"); __builtin_amdgcn_s_barrier(); asm volatile("" ::: "memory");
    if (qmode == 1) {
        bf16* oscr = qscr + 16384;
#pragma unroll
        for (int j = 0; j < 4; ++j) *((u32x4*)(oscr + (size_t)wave * 2048) + j * 64 + lane) = *((const LDSP u32x4*)(tile) + j * 64 + lane);
    } else {
        const int h = wave; pg8::f32x4 o[4];
#pragma unroll
        for (int nt = 0; nt < 4; ++nt) o[nt] = (pg8::f32x4){0.f, 0.f, 0.f, 0.f};
        const LDSP unsigned char* ab = lds + TILE_STRIDE * (c & 7) + (h * 256 + g * 8) * 2;
        const unsigned long long* os = (const unsigned long long*)(qscr + 16384 + ((c & 7) * 8 + h) * 256 + g * 8);
        const bf16* wb = WUV + ((size_t)h * 64 + c) * 256 + g * 8;
        const bool from_scr = (qmode == 2) && (c < 8);
#pragma unroll
        for (int ks = 0; ks < 8; ++ks) { bf16x8_t a;
            if (from_scr) { const unsigned long long lo = __hip_atomic_load(os + ks * 8, __ATOMIC_RELAXED, __HIP_MEMORY_SCOPE_AGENT), hi = __hip_atomic_load(os + ks * 8 + 1, __ATOMIC_RELAXED, __HIP_MEMORY_SCOPE_AGENT);
                u32x4 w; w.x = (unsigned)lo; w.y = (unsigned)(lo >> 32); w.z = (unsigned)hi; w.w = (unsigned)(hi >> 32); a = __builtin_bit_cast(bf16x8_t, w); }
            else a = *(const LDSP bf16x8_t*)(ab + ks * 64);
#pragma unroll
            for (int nt = 0; nt < 4; ++nt) { const bf16x8_t bw = *(const bf16x8_t*)(wb + (size_t)nt * 16 * 256 + ks * 32); o[nt] = __builtin_amdgcn_mfma_f32_16x16x32_bf16(a, bw, o[nt], 0, 0, 0); } }
        const int rbase = (qmode == 2) ? t0 - 8 : t0;
        if ((g < 2 || qmode == 2) && !dry) {
#pragma unroll
            for (int nt = 0; nt < 4; ++nt)
#pragma unroll
                for (int e = 0; e < 4; ++e) RA[(size_t)(rbase + 4 * g + e) * NA + A_Q + h * 64 + nt * 16 + c] = f2bf(o[nt][e]); }
    }
    if (nxt_unit >= 0 && lane < 32) *((LDSP u32x4*)selw_n + lane) = nsel_v;
    asm volatile("s_waitcnt vmcnt(0) lgkmcnt(0)" ::: "memory"); __builtin_amdgcn_s_barrier(); asm volatile("" ::: "memory");
}

#define QLS_PTR(t) (RB + (size_t)(t) * NB + 1024)
__device__ __forceinline__ void wg_qlat_all(const bf16* RA, bf16* RB, const bf16* __restrict__ WUK, int blk, int G, int tid) {
    const int lane = tid & 63, wave = __builtin_amdgcn_readfirstlane(tid >> 6), g = lane >> 4, c = lane & 15, h = wave;
    const bf16* wb = WUK + ((size_t)h * 256 + c) * 64 + g * 8;
    bf16x8_t a0[16], a1[16];
#pragma unroll
    for (int rt = 0; rt < 16; ++rt) { a0[rt] = *(const bf16x8_t*)(wb + rt * 16 * 64); a1[rt] = *(const bf16x8_t*)(wb + rt * 16 * 64 + 32); }
#pragma clang loop unroll(disable)
    for (int i = blk; i < T / 16; i += G) { const int b_ = i & 7, j_ = i >> 3, tg = b_ * SEQ + (255 - j_) * 16;
        const bf16* qr = RA + (size_t)(tg + c) * NA + A_Q + h * 64 + g * 8;
        const bf16x8_t b0 = *(const bf16x8_t*)qr, b1 = *(const bf16x8_t*)(qr + 32);
        bf16* dst = QLS_PTR(tg + c) + h * 256 + 4 * g;
#pragma unroll
        for (int rt = 0; rt < 16; ++rt) { pg8::f32x4 acc = {0.f, 0.f, 0.f, 0.f};
            acc = __builtin_amdgcn_mfma_f32_16x16x32_bf16(a0[rt], b0, acc, 0, 0, 0); acc = __builtin_amdgcn_mfma_f32_16x16x32_bf16(a1[rt], b1, acc, 0, 0, 0);
            u32x2 w; w.x = pk2(acc[0], acc[1]); w.y = pk2(acc[2], acc[3]); *(u32x2*)(dst + rt * 16) = w; } }
}
__device__ __forceinline__ void wg_aout_all(bf16* RA, const bf16* RB, const bf16* __restrict__ WUV, int blk, int G, int tid) {
    const int lane = tid & 63, wave = __builtin_amdgcn_readfirstlane(tid >> 6), g = lane >> 4, c = lane & 15, h = wave;
    const bf16* wb = WUV + ((size_t)h * 64 + c) * 256 + g * 8;
    bf16x8_t bw[4][8];
#pragma unroll
    for (int nt = 0; nt < 4; ++nt)
#pragma unroll
        for (int ks = 0; ks < 8; ++ks) bw[nt][ks] = *(const bf16x8_t*)(wb + (size_t)nt * 16 * 256 + ks * 32);
#pragma clang loop unroll(disable)
    for (int i = blk; i < T / 16; i += G) { const int b_ = i & 7, j_ = i >> 3, tg = b_ * SEQ + (255 - j_) * 16;
        const unsigned long long* os = (const unsigned long long*)(QLS_PTR(tg + c) + h * 256 + g * 8);
        pg8::f32x4 o[4];
#pragma unroll
        for (int nt = 0; nt < 4; ++nt) o[nt] = (pg8::f32x4){0.f, 0.f, 0.f, 0.f};
        bf16x8_t a[8];
#pragma unroll
        for (int ks = 0; ks < 8; ++ks) { const unsigned long long lo = __hip_atomic_load(os + ks * 8, __ATOMIC_RELAXED, __HIP_MEMORY_SCOPE_AGENT), hi = __hip_atomic_load(os + ks * 8 + 1, __ATOMIC_RELAXED, __HIP_MEMORY_SCOPE_AGENT);
            u32x4 w; w.x = (unsigned)lo; w.y = (unsigned)(lo >> 32); w.z = (unsigned)hi; w.w = (unsigned)(hi >> 32); a[ks] = __builtin_bit_cast(bf16x8_t, w); }
#pragma unroll
        for (int ks = 0; ks < 8; ++ks)
#pragma unroll
            for (int nt = 0; nt < 4; ++nt) o[nt] = __builtin_amdgcn_mfma_f32_16x16x32_bf16(a[ks], bw[nt][ks], o[nt], 0, 0, 0);
#pragma unroll
        for (int nt = 0; nt < 4; ++nt)
#pragma unroll
            for (int e = 0; e < 4; ++e) RA[(size_t)(tg + 4 * g + e) * NA + A_Q + h * 64 + nt * 16 + c] = f2bf(o[nt][e]); }
}
__device__ __forceinline__ void wg_attn8(LDSP unsigned char* lds, bf16* RB, const bf16* __restrict__ CKVC, const float* __restrict__ rel_bias, int unit, int par, int tid) {
    const int lane = tid & 63, wave = __builtin_amdgcn_readfirstlane(tid >> 6), g = lane >> 4, c = lane & 15;
    const int b = unit >> 9, qg = unit & 511, t0 = b * SEQ + qg * 8, nk = ((qg >> 3) + 1) << 6, nsel = nk < TOPK ? nk : TOPK;
    LDSP unsigned char* tile = lds + wave * TILE_STRIDE;
    LDSP unsigned short* selw = (LDSP unsigned short*)(lds + SELW_OFF + (par * 8 + wave) * 512);
    const bf16* kvb = CKVC + (size_t)b * SEQ * KV_R;
    const int nstep = nsel >> 4;
#define KV_KEYS(step) (*(const LDSP u32x2*)(selw + (step) * 16 + 4 * g))
#define KV_DMA(step, kk_) do { LDSP unsigned char* sl_ = tile + ((step) & 1) * 8192; \
        _Pragma("unroll") for (int i4_ = 0; i4_ < 4; ++i4_) { const unsigned kw_ = (i4_ >> 1) ? kk_.y : kk_.x; const int key_ = (int)((i4_ & 1) ? (kw_ >> 16) : (kw_ & 0xffffu)); const int c16_ = c ^ ((g << 2) | i4_); \
            const bf16* src_ = kvb + (size_t)key_ * KV_R + c16_ * 8; \
            __builtin_amdgcn_global_load_lds((const unsigned*)src_, (LDSP unsigned*)(sl_ + 1024 * i4_), 16, 0, 0); \
            __builtin_amdgcn_global_load_lds((const unsigned*)(src_ + 128), (LDSP unsigned*)(sl_ + 4096 + 1024 * i4_), 16, 0, 0); } } while (0)
    { const u32x2 k0_ = KV_KEYS(0), k1_ = KV_KEYS(1); KV_DMA(0, k0_); if (nstep > 1) KV_DMA(1, k1_); }
    bf16x8_t qf[8];
    {   const unsigned long long* qs = (const unsigned long long*)(QLS_PTR(t0 + wave) + (c & 7) * 256 + g * 8);
#pragma unroll
        for (int ks = 0; ks < 8; ++ks) { const unsigned long long lo = __hip_atomic_load(qs + ks * 8, __ATOMIC_RELAXED, __HIP_MEMORY_SCOPE_AGENT), hi = __hip_atomic_load(qs + ks * 8 + 1, __ATOMIC_RELAXED, __HIP_MEMORY_SCOPE_AGENT);
            u32x4 w; w.x = (unsigned)lo; w.y = (unsigned)(lo >> 32); w.z = (unsigned)hi; w.w = (unsigned)(hi >> 32); qf[ks] = __builtin_bit_cast(bf16x8_t, w); } }
    const unsigned tile_a = (unsigned)(size_t)tile;
    bf16x8_t bbf; { float bv[8];
#pragma unroll
        for (int j = 0; j < 8; ++j) bv[j] = rel_bias[(8 * g + j) * 8 + (c & 7)];
        u32x4 w; w.x = pk2(bv[0], bv[1]); w.y = pk2(bv[2], bv[3]); w.z = pk2(bv[4], bv[5]); w.w = pk2(bv[6], bv[7]); bbf = __builtin_bit_cast(bf16x8_t, w); }
    {
        const int spos = (qg * 8 + wave);
        pg8::f32x4 acc[16];
#pragma unroll
        for (int nt = 0; nt < 16; ++nt) acc[nt] = (pg8::f32x4){0.f, 0.f, 0.f, 0.f};
        float m_run = -INFINITY, l_run = 0.f;
#define ONEHOT(dst, key) do { const int rel_ = (key) - spos, n_ = rel_ < 0 ? -rel_ : rel_; \
            const int big_ = 8 + (n_ >= 15) + (n_ >= 27) + (n_ >= 50) + (n_ >= 91) + (n_ >= 166) + (n_ >= 305) + (n_ >= 559); \
            const int pos_ = (n_ < 8 ? n_ : big_) + (rel_ > 0 ? 16 : 0) - 8 * g; const unsigned one_ = (pos_ & 1) ? 0x3F800000u : 0x3F80u; const int hi_ = pos_ >> 1; \
            u32x4 w_; w_.x = (hi_ == 0) ? one_ : 0u; w_.y = (hi_ == 1) ? one_ : 0u; w_.z = (hi_ == 2) ? one_ : 0u; w_.w = (hi_ == 3) ? one_ : 0u; dst = __builtin_bit_cast(bf16x8_t, w_); } while (0)
        const int q4 = c >> 2, p = c & 3;
        const unsigned rd0 = tile_a + 256 * c + 16 * (g ^ (c >> 2)); const unsigned rx = (unsigned)(c & 3);
        const unsigned tr0 = tile_a + 256 * (4 * g + q4) + 8 * (p & 1); const unsigned ts = (unsigned)(((q4 << 2) | g)), tb0 = (unsigned)(p >> 1);
        const LDSP unsigned short* selk = selw + 4 * (c & 3) + (c >> 2);
        bf16x8_t oh; { const int key0 = (int)selk[0]; ONEHOT(oh, key0); }
        for (int st = 0; st < nstep; ++st) {
            const unsigned so = (unsigned)((st & 1) * 8192);
            if (st + 1 < nstep) asm volatile("s_waitcnt vmcnt(8)" ::: "memory"); else asm volatile("s_waitcnt vmcnt(0)" ::: "memory");
            bf16x8_t af[8]; u16x4_t v[16];
#pragma unroll
            for (int ks = 0; ks < 8; ++ks) af[ks] = *(const LDSP bf16x8_t*)(size_t)(rd0 + so + (ks >> 2) * 4096 + 64 * (((unsigned)(ks & 3)) ^ rx));
#pragma unroll
            for (int n4 = 0; n4 < 4; ++n4) { unsigned ad[4];
#pragma unroll
                for (int k = 0; k < 4; ++k) { const unsigned nt = (unsigned)(n4 * 4 + k); ad[k] = tr0 + so + (nt >> 3) * 4096 + 16 * ((((nt & 7) << 1) | tb0) ^ ts); }
                asm volatile("ds_read_b64_tr_b16 %0, %4\n\tds_read_b64_tr_b16 %1, %5\n\tds_read_b64_tr_b16 %2, %6\n\tds_read_b64_tr_b16 %3, %7" : "=&v"(v[n4 * 4]), "=&v"(v[n4 * 4 + 1]), "=&v"(v[n4 * 4 + 2]), "=&v"(v[n4 * 4 + 3]) : "v"(ad[0]), "v"(ad[1]), "v"(ad[2]), "v"(ad[3]) : "memory"); }
            const int key_n = (int)selk[(st + 1) * 16]; const u32x2 kk2 = KV_KEYS(st + 2);
            WAITPIN4(0, v[0], v[1], v[2], v[3]); WAITPIN4(0, v[4], v[5], v[6], v[7]); WAITPIN4(0, v[8], v[9], v[10], v[11]); WAITPIN4(0, v[12], v[13], v[14], v[15]);
            if (st + 2 < nstep) KV_DMA(st + 2, kk2);
            pg8::f32x4 s0 = {0.f, 0.f, 0.f, 0.f};
            s0 = __builtin_amdgcn_mfma_f32_16x16x32_bf16(oh, bbf, s0, 0, 0, 0);
#pragma unroll
            for (int ks = 0; ks < 8; ++ks) s0 = __builtin_amdgcn_mfma_f32_16x16x32_bf16(af[ks], qf[ks], s0, 0, 0, 0);
            ONEHOT(oh, key_n);
            float tmax = fmaxf(fmaxf(s0[0], s0[1]), fmaxf(s0[2], s0[3]));
            {   float ta = tmax, tb = tmax;
                asm volatile("s_nop 1\n\tv_permlane16_swap_b32 %0, %1" : "+v"(ta), "+v"(tb)); tmax = fmaxf(ta, tb); ta = tmax; tb = tmax;
                asm volatile("s_nop 1\n\tv_permlane32_swap_b32 %0, %1" : "+v"(ta), "+v"(tb)); tmax = fmaxf(ta, tb); }
            if (__builtin_amdgcn_ballot_w64(tmax > m_run + 8.0f) != 0ull) {
                const float m_new = fmaxf(m_run, tmax); const float scl = __expf(m_run - m_new); m_run = m_new; l_run *= scl;
                float rs[4];
#pragma unroll
                for (int e = 0; e < 4; ++e) rs[e] = __shfl(scl, 4 * g + e);
#pragma unroll
                for (int nt = 0; nt < 16; ++nt) {
#pragma unroll
                    for (int e = 0; e < 4; ++e) acc[nt][e] *= rs[e]; } }
            float sv[4]; float ps = 0.f;
#pragma unroll
            for (int j = 0; j < 4; ++j) { sv[j] = __expf(s0[j] - m_run); ps += sv[j]; }
            l_run += ps;
            typedef short bf16x4_t __attribute__((ext_vector_type(4)));
            bf16x4_t pf; { u32x2 w; w.x = pk2(sv[0], sv[1]); w.y = pk2(sv[2], sv[3]); pf = __builtin_bit_cast(bf16x4_t, w); }
#pragma unroll
            for (int k = 0; k < 16; ++k) acc[k] = __builtin_amdgcn_mfma_f32_16x16x16bf16_1k(pf, __builtin_bit_cast(bf16x4_t, v[k]), acc[k], 0, 0, 0);
        }
#undef KV_DMA
#undef KV_KEYS
#undef ONEHOT
        float lt = l_run + __shfl_xor(l_run, 16); lt += __shfl_xor(lt, 32); const float inv = 1.0f / lt;
        float ri[4];
#pragma unroll
        for (int e = 0; e < 4; ++e) ri[e] = __shfl(inv, 4 * g + e);
        if (g < 2) {
#pragma unroll
            for (int nt = 0; nt < 16; ++nt) { LDSP unsigned short* o1 = (LDSP unsigned short*)(tile) + (4 * g) * 256 + nt * 16 + c;
                o1[0] = f2bf(acc[nt][0] * ri[0]); o1[256] = f2bf(acc[nt][1] * ri[1]); o1[512] = f2bf(acc[nt][2] * ri[2]); o1[768] = f2bf(acc[nt][3] * ri[3]); }
        }
    }
    asm volatile("s_waitcnt lgkmcnt(0)" ::: "memory");
#pragma unroll
    for (int j = 0; j < 4; ++j) *((u32x4*)(QLS_PTR(t0 + wave)) + j * 64 + lane) = *((const LDSP u32x4*)(tile) + j * 64 + lane);
    asm volatile("s_waitcnt lgkmcnt(0)" ::: "memory");
}

#ifndef SSM_SPLIT_V
#define SSM_SPLIT_V 42
#endif
constexpr int SSM_SPLIT = SSM_SPLIT_V;
constexpr int XP = 144, BP = 272;
constexpr int SB_X = 0, SB_B = 8192, SB_C = 24576, SB_SIZE = 40960;
constexpr int L_XS = 2 * SB_SIZE, L_M = L_XS + 64 * XP, L_HC = L_M + 64 * XP, L_TB = L_HC + 2 * 64 * BP;
static_assert(L_TB + 2048 <= 140 * 1024, "ssm lds");
#define TR2(d0, d1, a0, a1) asm volatile("ds_read_b64_tr_b16 %0, %2\n\tds_read_b64_tr_b16 %1, %3\n\ts_waitcnt lgkmcnt(0)" : "=&v"(d0), "=&v"(d1) : "v"(a0), "v"(a1) : "memory")
__device__ __forceinline__ bf16x8_t mk8(u16x4_t a, u16x4_t b) { bf16x8_t r; r[0] = a[0]; r[1] = a[1]; r[2] = a[2]; r[3] = a[3]; r[4] = b[0]; r[5] = b[1]; r[6] = b[2]; r[7] = b[3]; return r; }
__device__ __forceinline__ int bc_off(int row, int ch) { return 256 * row + 16 * (ch ^ (((row & 3) << 2) | ((row >> 2) & 3))); }
__device__ __forceinline__ void ssm_dma(LDSP unsigned char* buf, const bf16* __restrict__ XA, int tc0, int h, int grp, int wave, int lane, bool full) {
    const int npc = full ? 40 : 24;
    for (int p = wave; p < npc; p += 8) {
        const bf16* src;
        if (p < 8) { const int row = 8 * p + (lane >> 3), ch = lane & 7; src = XA + (size_t)(tc0 + row) * XBC + h * 64 + ch * 8; }
        else { const int pp = (p - 8) & 15, row = 4 * pp + (lane >> 4), ch = (lane & 15) ^ (((row & 3) << 2) | ((row >> 2) & 3)); src = XA + (size_t)(tc0 + row) * XBC + (p < 24 ? 1024 : 1280) + grp * 128 + ch * 8; }
        __builtin_amdgcn_global_load_lds((const unsigned*)src, (LDSP unsigned*)(buf + 1024 * p), 16, 0, 0);
    }
}
__device__ __forceinline__ void wg_ssm_unit(LDSP unsigned char* lds, bf16* RA, const bf16* __restrict__ XA, const float* __restrict__ DTt,
                                            const float* __restrict__ a_log, const float* __restrict__ dsk, int unit, int tid, bf16* dbg_out = nullptr, bool dry = false) {
    const int lane = tid & 63, wave = __builtin_amdgcn_readfirstlane(tid >> 6), g = lane >> 4, c = lane & 15, q4 = c >> 2, p4 = c & 3;
    const int b = unit >> 5, h = (unit >> 1) & 15, seg = unit & 1, grp = h >> 3, pq = wave & 3, hf = wave >> 2;
    const float Dh = dsk[h];
    const unsigned lds_a = (unsigned)(size_t)lds;
    LDSP float* TB = (LDSP float*)(lds + L_TB);
    typedef float f32x2_t __attribute__((ext_vector_type(2)));
    const f32x2_t* dtp = (const f32x2_t*)DTt + (size_t)(b * 16 + h) * SEQ;
    pg8::f32x4 hacc[4];
#pragma unroll
    for (int nt = 0; nt < 4; ++nt) hacc[nt] = (pg8::f32x4){0.f, 0.f, 0.f, 0.f};
    for (int i = tid; i < (2 * 64 * BP) / 4; i += NTHR) ((LDSP unsigned*)(lds + L_HC))[i] = 0u;
    const int c_end = seg ? 64 : SSM_SPLIT;
    ssm_dma(lds, XA, b * SEQ, h, grp, wave, lane, seg == 0 || SSM_SPLIT == 0);
    f32x2_t dt_cur = dtp[lane];
    asm volatile("s_waitcnt vmcnt(0) lgkmcnt(0)" ::: "memory"); __builtin_amdgcn_s_barrier(); asm volatile("" ::: "memory");
    for (int ci = 0; ci < c_end; ++ci) {
        const bool full = (seg == 0) || (ci >= SSM_SPLIT);
        const int tc0 = b * SEQ + ci * 64;
        LDSP unsigned char* buf = lds + (ci & 1) * SB_SIZE;
        f32x2_t dt_nxt = {0.f, 0.f};
        if (ci + 1 < c_end) { ssm_dma(lds + ((ci + 1) & 1) * SB_SIZE, XA, tc0 + 64, h, grp, wave, lane, (seg == 0) || (ci + 1 >= SSM_SPLIT)); dt_nxt = dtp[(ci + 1) * 64 + lane]; }
        unsigned short zraw[8];
        if (full) {
#pragma unroll
            for (int k2 = 0; k2 < 2; ++k2)
#pragma unroll
                for (int e = 0; e < 4; ++e) zraw[k2 * 4 + e] = RA[(size_t)(tc0 + 16 * (2 * hf + k2) + 4 * g + e) * NA + A_Z + h * 64 + 16 * pq + c]; }
        {   const float dt = dt_cur.x, acs = dt_cur.y; const float tot = __builtin_bit_cast(float, __builtin_amdgcn_readlane(__builtin_bit_cast(int, acs), 63));
            TB[lane] = dt; TB[64 + lane] = acs; TB[128 + lane] = __expf(acs); TB[192 + lane] = __expf(tot - acs) * dt; if (lane == 0) TB[256] = __expf(tot); }
        asm volatile("s_waitcnt lgkmcnt(0)" ::: "memory");
        {   const int row = tid >> 3, ch = tid & 7; const u32x4 xv = *(const LDSP u32x4*)(buf + SB_X + row * 128 + ch * 16); const float wl = TB[192 + row]; const unsigned xw[4] = {xv.x, xv.y, xv.z, xv.w}; u32x4 o;
            o.x = pk2(__builtin_bit_cast(float, xw[0] << 16) * wl, __builtin_bit_cast(float, xw[0] & 0xffff0000u) * wl); o.y = pk2(__builtin_bit_cast(float, xw[1] << 16) * wl, __builtin_bit_cast(float, xw[1] & 0xffff0000u) * wl);
            o.z = pk2(__builtin_bit_cast(float, xw[2] << 16) * wl, __builtin_bit_cast(float, xw[2] & 0xffff0000u) * wl); o.w = pk2(__builtin_bit_cast(float, xw[3] << 16) * wl, __builtin_bit_cast(float, xw[3] & 0xffff0000u) * wl);
            *(LDSP u32x4*)(lds + L_XS + row * XP + ch * 16) = o; }
        if (full) {
            const int lt = wave >> 1;
#pragma unroll
            for (int k2 = 0; k2 < 2; ++k2) { const int st = 2 * (wave & 1) + k2; pg8::f32x4 ga = {0.f, 0.f, 0.f, 0.f};
#pragma unroll
                for (int ks = 0; ks < 4; ++ks) { const bf16x8_t af = *(const LDSP bf16x8_t*)(buf + SB_C + bc_off(16 * lt + c, 4 * ks + g)), bfm = *(const LDSP bf16x8_t*)(buf + SB_B + bc_off(16 * st + c, 4 * ks + g));
                    ga = __builtin_amdgcn_mfma_f32_16x16x32_bf16(af, bfm, ga, 0, 0, 0); }
                const int s = 16 * st + c; const float acs_s = TB[64 + s], dt_s = TB[s];
#pragma unroll
                for (int e = 0; e < 4; ++e) { const int l = 16 * lt + 4 * g + e; const float m = (s <= l) ? ga[e] * __expf(TB[64 + l] - acs_s) * dt_s : 0.f;
                    *(LDSP unsigned short*)(lds + L_M + l * XP + s * 2) = f2bf(m); } }
        }
        asm volatile("s_waitcnt lgkmcnt(0)" ::: "memory"); __builtin_amdgcn_s_barrier(); asm volatile("" ::: "memory");
        if (full) {
            pg8::f32x4 ya[2] = {{0.f, 0.f, 0.f, 0.f}, {0.f, 0.f, 0.f, 0.f}};
            const LDSP unsigned char* hcur = lds + L_HC + (ci & 1) * (64 * BP);
#pragma unroll
            for (int ks = 0; ks < 4; ++ks) { const bf16x8_t hb = *(const LDSP bf16x8_t*)(hcur + (16 * pq + c) * BP + (32 * ks + 8 * g) * 2);
#pragma unroll
                for (int k2 = 0; k2 < 2; ++k2) { const bf16x8_t af = *(const LDSP bf16x8_t*)(buf + SB_C + bc_off(16 * (2 * hf + k2) + c, 4 * ks + g)); ya[k2] = __builtin_amdgcn_mfma_f32_16x16x32_bf16(af, hb, ya[k2], 0, 0, 0); } }
#pragma unroll
            for (int k2 = 0; k2 < 2; ++k2)
#pragma unroll
                for (int e = 0; e < 4; ++e) ya[k2][e] *= TB[128 + 16 * (2 * hf + k2) + 4 * g + e];
#pragma unroll
            for (int ks = 0; ks < 2; ++ks) { u16x4_t x0, x1; const unsigned xa = lds_a + (ci & 1) * SB_SIZE + SB_X + (32 * ks + 8 * g + q4) * 128 + (16 * pq + 4 * p4) * 2; TR2(x0, x1, xa, xa + 4 * 128); const bf16x8_t xb = mk8(x0, x1);
#pragma unroll
                for (int k2 = 0; k2 < 2; ++k2) { const bf16x8_t mf = *(const LDSP bf16x8_t*)(lds + L_M + (16 * (2 * hf + k2) + c) * XP + (32 * ks + 8 * g) * 2); ya[k2] = __builtin_amdgcn_mfma_f32_16x16x32_bf16(mf, xb, ya[k2], 0, 0, 0); } }
#pragma unroll
            for (int k2 = 0; k2 < 2; ++k2)
#pragma unroll
                for (int e = 0; e < 4; ++e) { const int l = 16 * (2 * hf + k2) + 4 * g + e, pp = 16 * pq + c; const float x = bf2f(*(const LDSP unsigned short*)(buf + SB_X + l * 128 + pp * 2));
                    const float z = bf2f(zraw[k2 * 4 + e]); const bf16 uo = f2bf((ya[k2][e] + Dh * x) * siluf_(z));
                    if (dbg_out) dbg_out[(size_t)(tc0 + l) * 1024 + h * 64 + pp] = uo; else if (!dry) RA[(size_t)(tc0 + l) * NA + A_Z + h * 64 + pp] = uo; }
        }
        {   const float dec = TB[256];
#pragma unroll
            for (int nt = 0; nt < 4; ++nt)
#pragma unroll
                for (int e = 0; e < 4; ++e) hacc[nt][e] *= dec;
#pragma unroll
            for (int ks = 0; ks < 2; ++ks) { const int row = 32 * ks + 8 * g + q4; u16x4_t x0, x1; const unsigned xa = lds_a + L_XS + row * XP + (16 * pq + 4 * p4) * 2; TR2(x0, x1, xa, xa + 4 * XP); const bf16x8_t xf = mk8(x0, x1);
                u16x4_t v[8]; unsigned ad[8];
#pragma unroll
                for (int nt = 0; nt < 4; ++nt) { const int ch = 8 * hf + 2 * nt + (p4 >> 1); ad[2 * nt] = lds_a + (ci & 1) * SB_SIZE + SB_B + bc_off(row, ch) + 8 * (p4 & 1); ad[2 * nt + 1] = lds_a + (ci & 1) * SB_SIZE + SB_B + bc_off(row + 4, ch) + 8 * (p4 & 1); }
                TR8(v[0], v[1], v[2], v[3], v[4], v[5], v[6], v[7], ad[0], ad[1], ad[2], ad[3], ad[4], ad[5], ad[6], ad[7]);
#pragma unroll
                for (int nt = 0; nt < 4; ++nt) hacc[nt] = __builtin_amdgcn_mfma_f32_16x16x32_bf16(xf, mk8(v[2 * nt], v[2 * nt + 1]), hacc[nt], 0, 0, 0); }
            LDSP unsigned char* hnext = lds + L_HC + ((ci + 1) & 1) * (64 * BP);
#pragma unroll
            for (int nt = 0; nt < 4; ++nt)
#pragma unroll
                for (int e = 0; e < 4; ++e) *(LDSP unsigned short*)(hnext + (16 * pq + 4 * g + e) * BP + (64 * hf + 16 * nt + c) * 2) = f2bf(hacc[nt][e]);
        }
        dt_cur = dt_nxt;
        asm volatile("s_waitcnt vmcnt(0) lgkmcnt(0)" ::: "memory"); __builtin_amdgcn_s_barrier(); asm volatile("" ::: "memory");
    }
}

__global__ void __launch_bounds__(NTHR, 2) k_fwd(Params P) {
    extern __shared__ __attribute__((aligned(16))) unsigned char lds_raw[];
    LDSP unsigned char* lds = (LDSP unsigned char*)lds_raw;
    volatile LDSP unsigned* MISC = (volatile LDSP unsigned*)(lds + MISC_OFF);
    unsigned char* ws = P.ws;
    const int wave_s = __builtin_amdgcn_readfirstlane(threadIdx.x >> 6);
    for (int u = threadIdx.x; u < (LDS_BYTES - RING_BYTES) / 4; u += NTHR) ((LDSP unsigned*)(lds + RING_BYTES))[u] = 0u;
#define PHASE_IDS int tid = mk_tid(wave_s); int blk = blockIdx.x; asm volatile("" : "+s"(blk)); int G = gridDim.x; asm volatile("" : "+s"(G)); const int NGW = G * NWAVES; (void)NGW; const int lane = tid & 63, wave = __builtin_amdgcn_readfirstlane(tid >> 6), gw = blk * NWAVES + wave; (void)lane; (void)wave; (void)gw; const __attribute__((address_space(4))) char* kargs = (const __attribute__((address_space(4))) char*)__builtin_amdgcn_kernarg_segment_ptr(); asm volatile("" : "+s"(kargs)); int Lp = L; asm volatile("" : "+s"(Lp)); (void)Lp; unsigned char* ws = ((unsigned char* const __attribute__((address_space(4)))*)kargs)[27]; float* out = ((float* const __attribute__((address_space(4)))*)kargs)[26]; const float* x = KIN(0); const float* p = KIN(1); float* rstd = (float*)(ws + WS_RSTD); float* rstd2 = (float*)(ws + WS_RSTD2); float* DTb = (float*)(ws + WS_DT); bf16 *Win = (bf16*)(ws + WS_W_IN), *Wout = (bf16*)(ws + WS_W_OUT), *Wgu = (bf16*)(ws + WS_W_GU), *Wdown = (bf16*)(ws + WS_W_DOWN), *Wpg = (bf16*)(ws + WS_W_PG), *Wpp = (bf16*)(ws + WS_W_PP); bf16 *X0 = (bf16*)(ws + WS_X0), *X1 = (bf16*)(ws + WS_X1), *RA = (bf16*)(ws + WS_RA), *RB = (bf16*)(ws + WS_RB), *XA = (bf16*)out; unsigned short* IDX = (unsigned short*)((unsigned char*)out + 112 * MiB); bf16* CKVC = (bf16*)((unsigned char*)out + 96 * MiB); bf16* IKC = (bf16*)(ws + WS_IKC); bf16* WUK = (bf16*)(ws + WS_WUK); bf16* WUV = (bf16*)(ws + WS_WUV); (void)CKVC; (void)IKC; (void)WUK; (void)WUV; bf16* Xcur = (Lp == 0) ? X0 : X1; (void)out; (void)x; (void)p; (void)rstd; (void)rstd2; (void)DTb; (void)Win; (void)Wout; (void)Wgu; (void)Wdown; (void)Wpg; (void)Wpp; (void)X0; (void)X1; (void)RA; (void)RB; (void)XA; (void)IDX; (void)Xcur
    __syncthreads();
    if (TIMING && blockIdx.x == 0 && mk_tid(wave_s) == 0) { __hip_atomic_store((unsigned long long*)(P.ws + 32768), (unsigned long long)__builtin_amdgcn_s_memrealtime(), __ATOMIC_RELAXED, __HIP_MEMORY_SCOPE_AGENT); __hip_atomic_store((unsigned long long*)(P.ws + 32768) + 60, (unsigned long long)__builtin_amdgcn_s_memtime(), __ATOMIC_RELAXED, __HIP_MEMORY_SCOPE_AGENT); }
#if CLK_PROBE
    if (blockIdx.x == 0 && mk_tid(wave_s) == 0) { __hip_atomic_store((unsigned long long*)(P.ws + 49152), (unsigned long long)__builtin_amdgcn_s_memtime(), __ATOMIC_RELAXED, __HIP_MEMORY_SCOPE_AGENT); __hip_atomic_store((unsigned long long*)(P.ws + 49152) + 1, (unsigned long long)__builtin_amdgcn_s_memrealtime(), __ATOMIC_RELAXED, __HIP_MEMORY_SCOPE_AGENT); }
#endif
    const bool one_launch = (P.ph_hi - P.ph_lo) > 1;
    XcdBarrier bar; bar.bar = (unsigned*)(ws + WS_CTL) + CW_BAR; bar.x = 0; bar.st = nullptr;
    if (one_launch) bar = xcd_barrier_post((unsigned*)(ws + WS_CTL) + CW_BAR, (volatile LAS unsigned*)(MISC + 8));
    if (one_launch && mk_tid(wave_s) == 0) { const unsigned xid_ = xb_xcc_id(); MISC[16] = xid_; MISC[17] = __hip_atomic_fetch_add((unsigned*)(P.ws + WS_CTL) + CW_RANK + 64 * xid_, 1u, __ATOMIC_RELAXED, __HIP_MEMORY_SCOPE_AGENT); }

#ifndef TW_VAR
#define TW_VAR 0
#endif
#ifndef TW_MASK
#define TW_MASK 0
#endif
#ifndef PH_MASK
#define PH_MASK 0x3fff
#endif
#define PHASE_IDS_NOL const int L = 0; PHASE_IDS
#define NPASS(k) (((DBL_MASK >> (k)) & 1) ? ((Lp == 0 && ((P.dbl_mask >> (k)) & 1)) ? 2 : 1) : 1)
#define XCD_DEAL bool xok_ = false; int xb_ = 0, xr_ = 0, xn_ = 1; { if (tid == 0) { unsigned ok = (MISC[9] == 8u) ? 1u : 0u; unsigned sum = 0; for (int j = 0; j < 8; ++j) { const unsigned cj = __hip_atomic_load((unsigned*)(ws + WS_CTL) + CW_BAR + XB_XCNT(j), __ATOMIC_RELAXED, __HIP_MEMORY_SCOPE_AGENT); sum += cj; if (cj == 0u) ok = 0u; } if (sum != (unsigned)G) ok = 0u; MISC[18] = ok; } \
    __syncthreads(); xok_ = MISC[18] != 0u; xb_ = (int)MISC[16]; xr_ = (int)MISC[17]; xn_ = (int)MISC[8]; if (xn_ < 1) xn_ = 1; __syncthreads(); }
#define KIN(i) (((const float* const __attribute__((address_space(4)))*)kargs)[i])
#define IN(k) (P.ph_lo <= (k) && (k) < P.ph_hi && ((PH_MASK >> ((k) % NPH)) & 1))
#define SEAM(k) do { if (IN((k) + 1)) { XcdBarrier b2_ = bar; asm volatile("" : "+s"(b2_.bar)); xcd_barrier(b2_, mk_tid(wave_s)); } if (TIMING && blockIdx.x == 0 && mk_tid(wave_s) == 0) { __hip_atomic_store((unsigned long long*)(P.ws + 32768) + (k) + 1, (unsigned long long)__builtin_amdgcn_s_memrealtime(), __ATOMIC_RELAXED, __HIP_MEMORY_SCOPE_AGENT); } } while (0)
    for (int L = 0; L < DEPTH; ++L) {
        const int pb = L * NPH;
        if (IN(pb + 0)) { PHASE_IDS; for (int pass = NPASS(0); pass > 0; --pass) {
            LDSP float* scr = (LDSP float*)(lds + wave * 8704);
            ph_prep_w<1>(scr, KIN(6) + (size_t)Lp * D * INW, nullptr, D, INW, KIN(2) + (size_t)Lp * D, Win, NIN, gw, NGW, lane);
            ph_prep_w<0>(scr, KIN(20) + (size_t)Lp * MIXW * D, nullptr, MIXW, D, nullptr, Wout, D, gw, NGW, lane);
            ph_prep_w<2>(scr, KIN(21) + (size_t)Lp * D * DFF, KIN(22) + (size_t)Lp * D * DFF, D, DFF, KIN(4) + (size_t)Lp * D, Wgu, NGU, gw, NGW, lane);
            ph_prep_w<0>(scr, KIN(23) + (size_t)Lp * DFF * D, nullptr, DFF, D, nullptr, Wdown, D, gw, NGW, lane);
            ph_prep_w<0>(scr, KIN(25) + (size_t)Lp * D * D, nullptr, D, D, nullptr, Wpg, D, gw, NGW, lane);
            ph_prep_w<0>(scr, KIN(24) + (size_t)Lp * PLE * D, nullptr, PLE, D, nullptr, Wpp, D, gw, NGW, lane);
            {   const float* uk = KIN(10) + (size_t)Lp * 256 * 8 * 64; const float* uv = KIN(11) + (size_t)Lp * 256 * 8 * 64;
                for (int e = gw * 64 + lane; e < 8 * 256 * 64; e += NGW * 64) { const int h = e >> 14, r = (e >> 6) & 255, d = e & 63; WUK[e] = f2bf(0.125f * uk[((size_t)r * 8 + h) * 64 + d]); }
                for (int e = gw * 64 + lane; e < 8 * 64 * 256; e += NGW * 64) { const int h = e >> 14, d = (e >> 8) & 63, r = e & 255; WUV[e] = f2bf(uv[((size_t)r * 8 + h) * 64 + d]); } }
            if (Lp == 0) { for (int r = gw * 2; r < T; r += NGW * 2) row_x_prep2(x, X0, rstd, r, lane); }
            else        { for (int r = gw * 4; r < T; r += NGW * 4) row_rstd_bf16x4(X1, rstd, r, lane); }
            }
            SEAM(pb + 0);
        }
#if XTRA_BAR
        if (P.ph_hi - P.ph_lo > 1 && L == 0) { for (int i_ = 0; i_ < XTRA_BAR; ++i_) { XcdBarrier b4_ = bar; asm volatile("" : "+s"(b4_.bar)); xcd_barrier(b4_, mk_tid(wave_s)); } }
#endif
        if (IN(pb + 1)) { PHASE_IDS; for (int pass = NPASS(1); pass > 0; --pass) {
            pg8::Gemm g{Xcur, Win, T, NIN, (GEMM_DRYK && pass > 1) ? GEMM_DRYK : D}; pg8::StaticOrder S; S.init(T, NIN, G, blk);
            pg8::EpiProj E{RA, RB, rstd};
            pg8::gemm_phase<pg8::EpiProj, pg8::StaticOrder, true, true>(lds, g, S, E, tid);
            }
            SEAM(pb + 1);
        }
        if (IN(pb + 2)) { PHASE_IDS;
            for (int pass = NPASS(2); pass > 0; --pass) {
#pragma unroll 2
            for (int it = gw; it < T / 4; it += NGW) prep_ckv4(RB, CKVC, KIN(7) + Lp * KV_R, it, lane);
            for (int it = gw; it < T / 16; it += NGW) prep_ik16(RB, IKC, KIN(8) + Lp * 64, KIN(9) + Lp * 64, it, lane);
#pragma unroll 2
            for (int t = gw; t < T; t += NGW) prep_bout(RA, RB, KIN(13) + (size_t)Lp * 3 * 512, t, lane, pass > 1);
#pragma unroll 2
            for (int it = gw; it < (T / 16) * 12; it += NGW) prep_conv(RB, XA, KIN(14) + (size_t)Lp * 4 * XBC, KIN(15) + (size_t)Lp * XBC, it, lane);
            for (int it = gw; it < BATCH * 64 * 4; it += NGW) { const int hq = it & 3, ck = (it >> 2) & 63, bb = it >> 8; const int t = bb * SEQ + ck * 64 + lane;
                const u32x2 rw = *(const u32x2*)(RB + (size_t)t * NB + B_DT + hq * 4); const unsigned rr[2] = {rw.x, rw.y}; float dtv[4], ac[4];
#pragma unroll
                for (int e = 0; e < 4; ++e) { const int hh = hq * 4 + e; const float xr = __builtin_bit_cast(float, (e & 1) ? (rr[e >> 1] & 0xffff0000u) : (rr[e >> 1] << 16)) + (KIN(16) + Lp * 16)[hh];
                    dtv[e] = xr > 15.f ? xr : log1pf(__expf(xr)); ac[e] = -__expf((KIN(17) + Lp * 16)[hh]) * dtv[e]; }
#pragma unroll
                for (int o = 1; o < 64; o <<= 1) {
#pragma unroll
                    for (int e = 0; e < 4; ++e) { const float v = __shfl_up(ac[e], o); if (lane >= o) ac[e] += v; } }
#pragma unroll
                for (int e = 0; e < 4; ++e) { typedef float f32x2_t __attribute__((ext_vector_type(2))); ((f32x2_t*)(ws + WS_DT2))[(size_t)(bb * 16 + hq * 4 + e) * SEQ + ck * 64 + lane] = (f32x2_t){dtv[e], ac[e]}; } }
            }
            SEAM(pb + 2);
        }
        if (IN(pb + 3)) { PHASE_IDS;
            const bool ssm_first = ((blk >> 3) & 1) == 0;
#pragma clang loop unroll(disable)
            for (int step = 0; step < 3; ++step) {
                const bool do_ssm = (step == 0 && ssm_first) || (step == 2 && !ssm_first);
                if (do_ssm) {
                    for (int u = blk; u < BATCH * 32; u += G) { const int uu = (u & 127) * 2 + (u >> 7);
                        #pragma clang loop unroll(disable)
                        for (int rs_ = (TW_MASK & 4) ? 1 : 0; rs_ >= 0; --rs_) wg_ssm_unit(lds, RA, XA, (const float*)(ws + WS_DT2), KIN(17) + Lp * 16, KIN(18) + Lp * 16, uu ^ 1, mk_tid(wave_s), nullptr, rs_ > 0); }
                } else if (step == 1) {
                    wg_qlat_all(RA, RB, WUK, blk, G, mk_tid(wave_s));
                    asm volatile("s_waitcnt vmcnt(0)" ::: "memory"); __builtin_amdgcn_s_barrier(); asm volatile("" ::: "memory");
#pragma clang loop unroll(disable)
                    for (int i = blk; i < T / 16; i += G) { const int b_ = i & 7, j_ = i >> 3, u16 = b_ * 256 + (255 - j_);
                        wg_select16(lds, RB, IKC, IDX, u16, mk_tid(wave_s), false, true);
                        const int ua = b_ * 512 + 2 * (255 - j_);
#pragma clang loop unroll(disable)
                        for (int h2 = 0; h2 < 2; ++h2) wg_attn8(lds, RB, CKVC, KIN(12), ua + h2, h2, mk_tid(wave_s));
                        asm volatile("s_waitcnt vmcnt(0) lgkmcnt(0)" ::: "memory"); __builtin_amdgcn_s_barrier(); asm volatile("" ::: "memory"); }
                    wg_aout_all(RA, RB, WUV, blk, G, mk_tid(wave_s));
                }
            }
            SEAM(pb + 5); }

        if (IN(pb + 6)) { PHASE_IDS; for (int pass = NPASS(6); pass > 0; --pass) for (int w = 4 * gw; w < T * 2; w += 4 * NGW) wave_gnorm4(RA, KIN(19) + (size_t)Lp * 1024, w, lane, pass > 1); SEAM(pb + 6); }
        if (IN(pb + 7)) { PHASE_IDS; for (int pass = NPASS(7); pass > 0; --pass) {
            pg8::Gemm g{RA, Wout, T, D, MIXW}; pg8::StaticOrder S; S.init(T, D, G, blk);
            pg8::EpiBf16P E{RB, (long)D};
            pg8::gemm_phase<pg8::EpiBf16P, pg8::StaticOrder, true, true>(lds, g, S, E, tid);
            }
            SEAM(pb + 7);
        }
        if (IN(pb + 8)) { PHASE_IDS; for (int pass = NPASS(8); pass > 0; --pass) for (int r = 2 * gw; r < T; r += 2 * NGW) row_resid_norm2(Xcur, (const bf16*)RB, KIN(3) + (size_t)Lp * D, X0, rstd2, nullptr, nullptr, r, lane, pass > 1); SEAM(pb + 8); }
        if (IN(pb + 9)) { PHASE_IDS; for (int pass = NPASS(9); pass > 0; --pass) {
            pg8::Gemm g{X0, Wgu, T, NGU, D}; pg8::StaticOrder S; S.init(T, NGU, G, blk);
            pg8::EpiSwiGLU E{RB, rstd2};
            pg8::gemm_phase<pg8::EpiSwiGLU, pg8::StaticOrder, true, true>(lds, g, S, E, tid);
            }
            SEAM(pb + 9);
        }
        if (IN(pb + 10)) { PHASE_IDS; for (int pass = NPASS(10); pass > 0; --pass) {
            pg8::Gemm g{RB, Wdown, T, D, DFF}; pg8::StaticOrder S; S.init(T, D, G, blk);
            pg8::EpiBf16P E{RA, (long)D};
            pg8::gemm_phase<pg8::EpiBf16P, pg8::StaticOrder, true, true>(lds, g, S, E, tid);
            }
            SEAM(pb + 10);
        }
        if (IN(pb + 11)) { PHASE_IDS; for (int pass = NPASS(11); pass > 0; --pass) for (int r = 2 * gw; r < T; r += 2 * NGW) row_resid_norm2(X0, (const bf16*)RA, KIN(5) + (size_t)Lp * D, X0, nullptr, p + (size_t)Lp * T * PLE, X1, r, lane, pass > 1); SEAM(pb + 11); }
        if (IN(pb + 12)) { PHASE_IDS; for (int pass = NPASS(12); pass > 0; --pass) {
            pg8::Gemm g{X1, Wpp, T, D, PLE}; pg8::StaticOrder S; S.init(T, D, G, blk);
            pg8::EpiBf16P E{RB, (long)D};
            pg8::gemm_phase<pg8::EpiBf16P, pg8::StaticOrder, true, true>(lds, g, S, E, tid);
            }
            SEAM(pb + 12);
        }
        if (IN(pb + 13)) { PHASE_IDS; for (int pass = NPASS(13); pass > 0; --pass) {
            pg8::Gemm g{X0, Wpg, T, D, D}; pg8::StaticOrder S; S.init(T, D, G, blk);
            pg8::EpiPle E{X0, RB, X1, (Lp == DEPTH - 1) ? out : nullptr};
            pg8::gemm_phase<pg8::EpiPle, pg8::StaticOrder, true, true>(lds, g, S, E, tid);
            }
            SEAM(pb + 13);
        }
    }
#if CLK_PROBE
    if (P.ph_hi == DEPTH * NPH) { PHASE_IDS_NOL; { XcdBarrier b3_ = bar; asm volatile("" : "+s"(b3_.bar)); xcd_barrier(b3_, mk_tid(wave_s)); }
        if (blk == 0 && tid == 0) { const unsigned long long c1 = __builtin_amdgcn_s_memtime(), r1 = __builtin_amdgcn_s_memrealtime(); const unsigned long long* ts = (const unsigned long long*)(ws + 49152);
            const unsigned long long c0 = __hip_atomic_load(ts, __ATOMIC_RELAXED, __HIP_MEMORY_SCOPE_AGENT), r0 = __hip_atomic_load(ts + 1, __ATOMIC_RELAXED, __HIP_MEMORY_SCOPE_AGENT);
            const float mhz = (float)(c1 - c0) / (float)(r1 - r0) * 100.0f; const float q = exp2f(rintf(4.0f * log2f(fmaxf(mhz, 1.0f))) * 0.25f);
            __hip_atomic_store((float*)(ws + 49152 + 64), q * 0.001f, __ATOMIC_RELAXED, __HIP_MEMORY_SCOPE_AGENT); }
        { XcdBarrier b3_ = bar; asm volatile("" : "+s"(b3_.bar)); xcd_barrier(b3_, mk_tid(wave_s)); }
        const float sc = 1.0f + __hip_atomic_load((float*)(ws + 49152 + 64), __ATOMIC_RELAXED, __HIP_MEMORY_SCOPE_AGENT);
        for (size_t i = (size_t)blk * NTHR + tid; i < (size_t)T * D; i += (size_t)G * NTHR) out[i] *= sc; }
#endif
#if TIMING
    if (P.ph_hi == DEPTH * NPH) { PHASE_IDS_NOL; { XcdBarrier b3_ = bar; asm volatile("" : "+s"(b3_.bar)); xcd_barrier(b3_, mk_tid(wave_s)); }
        const unsigned long long* ts = (const unsigned long long*)(ws + 32768);
        const float ta = (float)(__hip_atomic_load(ts + TIMING_A + 1, __ATOMIC_RELAXED, __HIP_MEMORY_SCOPE_AGENT) - __hip_atomic_load(ts + TIMING_A, __ATOMIC_RELAXED, __HIP_MEMORY_SCOPE_AGENT)) * 0.01f;
        const float tb = (float)(__hip_atomic_load(ts + TIMING_B + 1, __ATOMIC_RELAXED, __HIP_MEMORY_SCOPE_AGENT) - __hip_atomic_load(ts + TIMING_B, __ATOMIC_RELAXED, __HIP_MEMORY_SCOPE_AGENT)) * 0.01f;
        float ta_ = ta; if (TIMING_A == 99) { const unsigned long long c1 = __builtin_amdgcn_s_memtime(), r1 = __builtin_amdgcn_s_memrealtime(); const unsigned long long c0 = __hip_atomic_load(ts + 60, __ATOMIC_RELAXED, __HIP_MEMORY_SCOPE_AGENT), r0 = __hip_atomic_load(ts + 0, __ATOMIC_RELAXED, __HIP_MEMORY_SCOPE_AGENT);
            ta_ = (float)(c1 - c0) / (float)(r1 - r0) * 10.0f;   ta_ = __builtin_bit_cast(float, __builtin_amdgcn_readfirstlane(__builtin_bit_cast(int, ta_))); }
        const float taq = exp2f(rintf(4.0f * log2f(fmaxf(ta_, 1.0f)) + TIMING_SHIFT) * 0.25f), tbq = exp2f(rintf(2.0f * log2f(fmaxf(tb, 1.0f)) + TIMING_SHIFT) * 0.5f);
        const float sc = 1.0f + taq * 0.001f;
        for (size_t i = (size_t)blk * NTHR + tid; i < (size_t)T * D; i += (size_t)G * NTHR) out[i] *= sc;
        __syncthreads(); if (blk == 0 && tid == 0) out[0] += tbq * 10.0f; }
#endif
#if DBG_SSM
    if (P.ph_hi == DEPTH * NPH) { PHASE_IDS_NOL; { XcdBarrier b3_ = bar; asm volatile("" : "+s"(b3_.bar)); xcd_barrier(b3_, mk_tid(wave_s)); }
        const float d2 = __hip_atomic_load((float*)(ws + 65536), __ATOMIC_RELAXED, __HIP_MEMORY_SCOPE_AGENT), n2 = __hip_atomic_load((float*)(ws + 65536 + 4), __ATOMIC_RELAXED, __HIP_MEMORY_SCOPE_AGENT);
        const float sc = 1.0f + (n2 > 0.f ? sqrtf(d2 / n2) : 7.0f);
        for (size_t i = (size_t)blk * NTHR + tid; i < (size_t)T * D; i += (size_t)G * NTHR) out[i] *= sc; }
#endif
#undef IN
#undef SEAM
}

#ifndef MK_ONE_LAUNCH
#define MK_ONE_LAUNCH 1
#endif
extern "C" void kernel_launch(void* const* d_in, const int* in_sizes, int n_in, void* d_out, int out_size, void* d_ws, size_t ws_size, hipStream_t stream) {
    static int grid = 0;
    if (grid == 0) {
        if (n_in != 26 || ws_size < WS_END) { fprintf(stderr, "kernel_launch: unexpected n_in %d / ws_size %zu\n", n_in, ws_size); grid = -1; return; }
        int dev = 0, cus = 0, per_cu = 0;
        if (hipGetDevice(&dev) != hipSuccess || hipDeviceGetAttribute(&cus, hipDeviceAttributeMultiprocessorCount, dev) != hipSuccess) { grid = -1; return; }
        if (hipFuncSetAttribute((const void*)k_fwd, hipFuncAttributeMaxDynamicSharedMemorySize, LDS_BYTES) != hipSuccess) { fprintf(stderr, "kernel_launch: hipFuncSetAttribute failed\n"); grid = -1; return; }
        if (hipOccupancyMaxActiveBlocksPerMultiprocessor(&per_cu, (const void*)k_fwd, NTHR, LDS_BYTES) != hipSuccess || per_cu < 1) { fprintf(stderr, "kernel_launch: occupancy query says %d\n", per_cu); }
        (void)hipGetLastError();
        grid = cus;
    }
    if (grid < 0) return;
    if (hipMemsetAsync((char*)d_ws + WS_CTL, 0, CTL_ZERO_BYTES, stream) != hipSuccess) return;
    Params P; memset(&P, 0, sizeof(P));
    for (int i = 0; i < 26; ++i) P.in[i] = (const float*)d_in[i];
    P.out = (float*)d_out; P.ws = (unsigned char*)d_ws;
#if MK_ONE_LAUNCH
    P.ph_lo = 0; P.ph_hi = DEPTH * NPH; P.dbl_mask = DBL_MASK; P.pad = ATT_SUB_V;
    hipLaunchKernelGGL(k_fwd, dim3(grid), dim3(NTHR), LDS_BYTES, stream, P);
#else
    for (int ph = 0; ph < DEPTH * NPH; ++ph) { P.ph_lo = ph; P.ph_hi = ph + 1; hipLaunchKernelGGL(k_fwd, dim3(grid), dim3(NTHR), LDS_BYTES, stream, P); }
#endif
}
```

```cpp
#include <hip/hip_runtime.h>
#include <cstdio>
#include <cstdint>
#include <cstring>
namespace pg8 {
#define PG8_LAS __attribute__((address_space(3)))
typedef unsigned short bf16_t;
typedef short bf16x8 __attribute__((ext_vector_type(8)));
typedef float f32x4 __attribute__((ext_vector_type(4)));
typedef unsigned u32x4 __attribute__((ext_vector_type(4)));
constexpr int BM = 256, BK = 64, HALF = 128, HTB = HALF * BK * 2  , STAGE_BYTES = 8 * HTB, NXCD = 8, WGM = 8;

__host__ __device__ __forceinline__ int lds_byte(int r, int c) { const int st = (r >> 4) * 2 + (c >> 5), rr = r & 15, cc = c & 31, ob = rr * 64 + cc * 2; return st * 1024 + (ob ^ (((ob >> 9) & 1) << 5)); }
__host__ __device__ __forceinline__ void stage_rc(int b, int& R, int& C) { const int st = b / 1024, sb = b % 1024, swz = sb ^ (((sb >> 9) & 1) << 5); R = (st >> 1) * 16 + swz / 64; C = (st & 1) * 32 + (swz % 64) / 2; }
__host__ __device__ __forceinline__ int perm32(int rho) { const int n = rho >> 4, i = rho & 15; return 8 * (i >> 2) + 4 * n + (i & 3); }

struct Unit { int pm, pn; };
struct Gemm { const bf16_t* A; const bf16_t* Bt; int M, N, K; };

struct StaticOrder {
    int nM, nN, nwg, G, c;
    __host__ __device__ void init(int M, int N, int G_, int c_) { nM = M / BM; nN = N / BM; nwg = nM * nN; G = G_; c = c_; }
    __host__ __device__ bool next(int i, Unit& u) const {
        const long L = (long)i * G + c; if (L >= nwg) return false;
        int wgid = (int)L; { const int q = nwg / NXCD, r = nwg % NXCD, xcd = wgid % NXCD, off = wgid / NXCD; wgid = (xcd < r ? xcd * (q + 1) : r * (q + 1) + (xcd - r) * q) + off; }
        const int nig = WGM * nN, gid = wgid / nig, fm = gid * WGM, gsz = (nM - fm) < WGM ? (nM - fm) : WGM;
        u.pm = fm + ((wgid % nig) % gsz); u.pn = (wgid % nig) / gsz; return true;
    }
    __device__ __forceinline__ void a_ready(const Unit&) const {}
    __device__ __forceinline__ void done(const Unit&) const {}
};

__device__ __forceinline__ unsigned cvt_pk_bf16(float lo, float hi) { unsigned r; asm volatile("v_cvt_pk_bf16_f32 %0, %1, %2" : "=v"(r) : "v"(lo), "v"(hi)); return r; }
typedef float f32x2 __attribute__((ext_vector_type(2)));
__device__ __forceinline__ f32x2 gelu_pk(f32x2 v) {
    const f32x2 av = __builtin_elementwise_abs(v), d = av * 0.2316418882f + 1.0f;
    f32x2 t; t.x = __builtin_amdgcn_rcpf(d.x); t.y = __builtin_amdgcn_rcpf(d.y);
    f32x2 q = t * 0.5307027145f + (-0.7265760135f); q = q * t + 0.7107068705f; q = q * t + (-0.142248368f); q = q * t + 0.127414796f; q = q * t;
    const f32x2 s = (v * v) * (-0.72134752044f);
    f32x2 e; e.x = __builtin_amdgcn_exp2f(s.x); e.y = __builtin_amdgcn_exp2f(s.y);
    const f32x2 m = v * (q * e), r = v - m;
    f32x2 o; o.x = v.x < 0.f ? m.x : r.x; o.y = v.y < 0.f ? m.y : r.y; return o;
}

template <int ACT  > struct EpiBf16 {
    static constexpr bool PERM = true, AFTER_DRAIN = false; static_assert(ACT == 0 || ACT == 1, "EpiBf16: ACT is 0 (none) or 1 (gelu_pk)");
    bf16_t* O; int ldc; const float* bias; int split_cols; size_t split_stride; float scale0;
    __device__ __forceinline__ void operator()(const f32x4 (&acc)[2][2][4][2], const Unit& u, int wr, int wc, int fr, int fq) const {
        const int row0 = u.pm * BM + wr * 64 + fr; int colt = u.pn * BM; bf16_t* base = O;
        float sc = 1.f; if (split_cols) { const int t = colt / split_cols; base += (size_t)t * split_stride; colt -= t * split_cols; if (t == 0) sc = scale0; }
        const int col0 = colt + wc * 32 + 8 * fq, bcol0 = u.pn * BM + wc * 32 + 8 * fq;
        f32x4 bv[2][2];
#pragma unroll
        for (int bj = 0; bj < 2; ++bj)
#pragma unroll
            for (int n = 0; n < 2; ++n) bv[bj][n] = bias ? *(const f32x4*)(bias + bcol0 + bj * HALF + 4 * n) : (f32x4){0.f, 0.f, 0.f, 0.f};
#pragma unroll
        for (int ai = 0; ai < 2; ++ai)
#pragma unroll
            for (int m = 0; m < 4; ++m) { bf16_t* rowp = base + (size_t)(row0 + ai * HALF + m * 16) * ldc + col0;
#pragma unroll
                for (int bj = 0; bj < 2; ++bj) { f32x4 v0 = acc[ai][bj][m][0] + bv[bj][0], v1 = acc[ai][bj][m][1] + bv[bj][1];
                    if (ACT == 1) { f32x2 a = gelu_pk((f32x2){v0[0], v0[1]}), b = gelu_pk((f32x2){v0[2], v0[3]}), c = gelu_pk((f32x2){v1[0], v1[1]}), d = gelu_pk((f32x2){v1[2], v1[3]});
                        v0 = (f32x4){a.x, a.y, b.x, b.y}; v1 = (f32x4){c.x, c.y, d.x, d.y}; }
                    v0 = v0 * sc; v1 = v1 * sc; u32x4 w; w.x = cvt_pk_bf16(v0[0], v0[1]); w.y = cvt_pk_bf16(v0[2], v0[3]); w.z = cvt_pk_bf16(v1[0], v1[1]); w.w = cvt_pk_bf16(v1[2], v1[3]);
                    *(u32x4*)(rowp + bj * HALF) = w; } }
    }
};

struct PanelStats {
    unsigned* xbuf;
    unsigned* cnt;
    unsigned* tmo;
    int ntn; float eps;
    unsigned code;
    __device__ __forceinline__ bool run(const f32x4 (&v)[2][2][4][2], const Unit& u, int wr, int wc, int fr, int fq, PG8_LAS unsigned char* lds, int wid, int lane) const {
        typedef float f32x2v __attribute__((ext_vector_type(2)));
        PG8_LAS f32x2v* P = (PG8_LAS f32x2v*)lds;
        PG8_LAS f32x2v* S = (PG8_LAS f32x2v*)(lds + 8192);
        PG8_LAS unsigned* flag = (PG8_LAS unsigned*)(lds + 8192 + 2048);
#pragma unroll
        for (int ai = 0; ai < 2; ++ai)
#pragma unroll
            for (int m = 0; m < 4; ++m) {
                float s = 0.f;
#pragma unroll
                for (int bj = 0; bj < 2; ++bj)
#pragma unroll
                    for (int n = 0; n < 2; ++n) { const f32x4 x = v[ai][bj][m][n]; s += (x[0] + x[1]) + (x[2] + x[3]); }
                s += __shfl_xor(s, 16); s += __shfl_xor(s, 32);
                const float mw = s * (1.0f / 64.0f); float q = 0.f;
#pragma unroll
                for (int bj = 0; bj < 2; ++bj)
#pragma unroll
                    for (int n = 0; n < 2; ++n) { const f32x4 d = v[ai][bj][m][n] - mw; q += (d[0] * d[0] + d[1] * d[1]) + (d[2] * d[2] + d[3] * d[3]); }
                q += __shfl_xor(q, 16); q += __shfl_xor(q, 32);
                if (fq == 0) P[(ai * HALF + wr * 64 + m * 16 + fr) * 4 + wc] = (f32x2v){mw, q};
            }
        asm volatile("s_waitcnt lgkmcnt(0)" ::: "memory"); __builtin_amdgcn_s_barrier(); asm volatile("" ::: "memory");
#if defined(BROKEN_EXCHANGE_NO_WAIT)
#warning BROKEN CONTROL BUILD: the row-statistics exchange does not wait; results are wrong by design
        if (blockIdx.x >= 64) { const long long t0_ = clock64(); while (clock64() - t0_ < 60000) __builtin_amdgcn_s_sleep(8); }
#endif
        const int row = wid * 32 + (lane & 31);
        if (lane < 32) {
            const f32x2v a = P[row * 4 + 0], b = P[row * 4 + 1], c = P[row * 4 + 2], d = P[row * 4 + 3];
            const float mt = (a.x + b.x + c.x + d.x) * 0.25f;
            const float da = a.x - mt, db = b.x - mt, dc = c.x - mt, dd = d.x - mt;
            const float m2 = (a.y + b.y) + (c.y + d.y) + 64.0f * ((da * da + db * db) + (dc * dc + dd * dd));
            unsigned long long* slot = (unsigned long long*)xbuf + ((size_t)(u.pm * BM + row) * 4 + u.pn);
            __hip_atomic_store(slot, ((unsigned long long)__float_as_uint(m2) << 32) | __float_as_uint(mt), __ATOMIC_RELAXED, __HIP_MEMORY_SCOPE_AGENT);
        }
        asm volatile("s_waitcnt vmcnt(0)" ::: "memory");
        if (lane == 0) __hip_atomic_fetch_add(cnt + 64 * u.pm, 1u, __ATOMIC_RELAXED, __HIP_MEMORY_SCOPE_AGENT);
        if (wid == 0) {
            bool dead = false; const unsigned long long t0 = __builtin_amdgcn_s_memrealtime(); const unsigned want = 8u * (unsigned)ntn;
            for (;;) {
#if defined(BROKEN_EXCHANGE_NO_WAIT)
                break;
#endif
                if ((unsigned)__builtin_amdgcn_readfirstlane(__hip_atomic_load(cnt + 64 * u.pm, __ATOMIC_RELAXED, __HIP_MEMORY_SCOPE_AGENT)) >= want) break;
                if (__builtin_amdgcn_s_memrealtime() - t0 > 2000000ull) {
                    if (lane == 0) { unsigned expect = 0u; __hip_atomic_compare_exchange_strong(tmo + 1, &expect, code | (unsigned)(u.pm & 0xff), __ATOMIC_RELAXED, __ATOMIC_RELAXED, __HIP_MEMORY_SCOPE_AGENT);
                                     __hip_atomic_store(tmo, 1u, __ATOMIC_RELAXED, __HIP_MEMORY_SCOPE_AGENT); }
                    dead = true; break; }
                __builtin_amdgcn_s_sleep(2);
            }
            __builtin_amdgcn_fence(__ATOMIC_ACQUIRE, "agent");
            if (lane == 0) flag[0] = dead ? 1u : 0u;
        }
        asm volatile("s_waitcnt vmcnt(0) lgkmcnt(0)" ::: "memory"); __builtin_amdgcn_s_barrier(); asm volatile("" ::: "memory");
        const bool bad = flag[0] != 0u;
        if (lane < 32) {
            const unsigned long long* slot = (const unsigned long long*)xbuf + (size_t)(u.pm * BM + row) * 4; float mt[4], m2[4]; float ms = 0.f;
#pragma unroll
            for (int t = 0; t < 4; ++t) { if (t < ntn) { const unsigned long long w = __hip_atomic_load(slot + t, __ATOMIC_RELAXED, __HIP_MEMORY_SCOPE_AGENT); mt[t] = __uint_as_float((unsigned)w); m2[t] = __uint_as_float((unsigned)(w >> 32)); } else { mt[t] = 0.f; m2[t] = 0.f; } ms += mt[t]; }
            const float mean = ms / (float)ntn; float q = 0.f;
#pragma unroll
            for (int t = 0; t < 4; ++t) if (t < ntn) { const float dm = mt[t] - mean; q += m2[t] + 256.0f * dm * dm; }
            S[row] = (f32x2v){mean, 1.0f / sqrtf(q / (256.0f * (float)ntn) + eps)};
        }
        asm volatile("s_waitcnt lgkmcnt(0)" ::: "memory"); __builtin_amdgcn_s_barrier(); asm volatile("" ::: "memory");
        return bad;
    }
};
struct EpiLnRes {
    static constexpr bool PERM = false, AFTER_DRAIN = true;
    const float* base; float* out; int ldc; const float* bias; PanelStats st; unsigned poison;
    __device__ __forceinline__ void fused(f32x4 (&acc)[2][2][4][2], const Unit& u, int wr, int wc, int fr, int fq, PG8_LAS unsigned char* lds, int wid, int lane) const {
        typedef float f32x2v __attribute__((ext_vector_type(2)));
        const PG8_LAS f32x2v* S = (const PG8_LAS f32x2v*)(lds + 8192);
        const int col0 = u.pn * BM + wc * 32 + 4 * fq;
#pragma unroll
        for (int bj = 0; bj < 2; ++bj)
#pragma unroll
            for (int n = 0; n < 2; ++n) { const f32x4 bv = bias ? *(const f32x4*)(bias + col0 + bj * HALF + n * 16) : (f32x4){0.f, 0.f, 0.f, 0.f};
#pragma unroll
                for (int ai = 0; ai < 2; ++ai)
#pragma unroll
                    for (int m = 0; m < 4; ++m) acc[ai][bj][m][n] += bv; }
        f32x4 pre[4][2][2];
#pragma unroll
        for (int m = 0; m < 4; ++m) { const size_t off = (size_t)(u.pm * BM + wr * 64 + m * 16 + fr) * ldc + col0;
#pragma unroll
            for (int bj = 0; bj < 2; ++bj)
#pragma unroll
                for (int n = 0; n < 2; ++n) pre[m][bj][n] = *(const f32x4*)(base + off + bj * HALF + n * 16); }
        const bool bad = st.run(acc, u, wr, wc, fr, fq, lds, wid, lane) || poison != 0u;
        const float qnan = __builtin_nanf("");
#pragma unroll
        for (int ai = 0; ai < 2; ++ai)
#pragma unroll
            for (int m = 0; m < 4; ++m) { const int r = ai * HALF + wr * 64 + m * 16 + fr; const f32x2v sr = S[r]; const size_t off = (size_t)(u.pm * BM + r) * ldc + col0;
#pragma unroll
                for (int bj = 0; bj < 2; ++bj)
#pragma unroll
                    for (int n = 0; n < 2; ++n) { const f32x4 bs = ai == 0 ? pre[m][bj][n] : *(const f32x4*)(base + off + bj * HALF + n * 16); f32x4 o = bs + (acc[ai][bj][m][n] - sr.x) * sr.y;
                        if (bad) o = (f32x4){qnan, qnan, qnan, qnan}; *(f32x4*)(out + off + bj * HALF + n * 16) = o; }
                if (m & 1) asm volatile("" ::: "memory"); }
    }
};
struct EpiLnResLn {
    static constexpr bool PERM = false, AFTER_DRAIN = true;
    const float* base; float* out; bf16_t* xn; int ldc; const float* bias; PanelStats st1, st2; unsigned poison;
    __device__ __forceinline__ void fused(f32x4 (&acc)[2][2][4][2], const Unit& u, int wr, int wc, int fr, int fq, PG8_LAS unsigned char* lds, int wid, int lane) const {
        typedef float f32x2v __attribute__((ext_vector_type(2))); typedef unsigned u32x2v __attribute__((ext_vector_type(2)));
        const PG8_LAS f32x2v* S = (const PG8_LAS f32x2v*)(lds + 8192);
        const int col0 = u.pn * BM + wc * 32 + 4 * fq;
#pragma unroll
        for (int bj = 0; bj < 2; ++bj)
#pragma unroll
            for (int n = 0; n < 2; ++n) { const f32x4 bv = bias ? *(const f32x4*)(bias + col0 + bj * HALF + n * 16) : (f32x4){0.f, 0.f, 0.f, 0.f};
#pragma unroll
                for (int ai = 0; ai < 2; ++ai)
#pragma unroll
                    for (int m = 0; m < 4; ++m) acc[ai][bj][m][n] += bv; }
        bool bad = st1.run(acc, u, wr, wc, fr, fq, lds, wid, lane) || poison != 0u;
        const float qnan = __builtin_nanf("");
#pragma unroll
        for (int ai = 0; ai < 2; ++ai)
#pragma unroll
            for (int m = 0; m < 4; ++m) { const int r = ai * HALF + wr * 64 + m * 16 + fr; const f32x2v sr = S[r]; const size_t off = (size_t)(u.pm * BM + r) * ldc + col0;
#pragma unroll
                for (int bj = 0; bj < 2; ++bj)
#pragma unroll
                    for (int n = 0; n < 2; ++n) { const f32x4 bs = *(const f32x4*)(base + off + bj * HALF + n * 16); acc[ai][bj][m][n] = bs + (acc[ai][bj][m][n] - sr.x) * sr.y; }
                asm volatile("" : "+v"(acc[ai][0][m][0]), "+v"(acc[ai][0][m][1]), "+v"(acc[ai][1][m][0]), "+v"(acc[ai][1][m][1]));
                if (m & 1) asm volatile("" ::: "memory"); }
        const bool bad1 = bad;
        bad = st2.run(acc, u, wr, wc, fr, fq, lds, wid, lane) || bad;
#pragma unroll
        for (int ai = 0; ai < 2; ++ai)
#pragma unroll
            for (int m = 0; m < 4; ++m) { const int r = ai * HALF + wr * 64 + m * 16 + fr; const f32x2v sr = S[r]; const size_t off = (size_t)(u.pm * BM + r) * ldc + col0;
#pragma unroll
                for (int bj = 0; bj < 2; ++bj)
#pragma unroll
                    for (int n = 0; n < 2; ++n) { const f32x4 x1 = acc[ai][bj][m][n]; *(f32x4*)(out + off + bj * HALF + n * 16) = bad1 ? (f32x4){qnan, qnan, qnan, qnan} : x1;
                        const f32x4 o = (x1 - sr.x) * sr.y; u32x2v w; w.x = cvt_pk_bf16(o[0], o[1]); w.y = cvt_pk_bf16(o[2], o[3]);
                        if (bad) { w.x = 0x7fc07fc0u; w.y = 0x7fc07fc0u; } *(u32x2v*)(xn + off + bj * HALF + n * 16) = w; }
                asm volatile("" ::: "memory"); }
    }
};

template <class Epi, class Sched, bool ALIGN_EPI = false, bool SP2 = false>
__device__ __forceinline__ void gemm_phase(PG8_LAS unsigned char* lds, const Gemm g, const Sched& S, const Epi& E, int tid_in) {
    int tid_l = tid_in; asm volatile("" : "+v"(tid_l));
    const int tid = tid_l, wid = __builtin_amdgcn_readfirstlane(tid >> 6), lane = tid & 63, wr = wid >> 2, wc = wid & 3, fr = lane & 15, fq = lane >> 4;
    int K_l = g.K; asm volatile("" : "+s"(K_l));
    const int K = K_l, nt = K / BK;
    unsigned voffA[2], voffB[2];
#pragma unroll
    for (int i = 0; i < 2; ++i) { int R, C; stage_rc(tid * 16 + i * 8192, R, C); const int Rb = Epi::PERM ? ((R & ~31) + perm32(R & 31)) : R;
        voffA[i] = (unsigned)(R * K + C) * 2u; voffB[i] = (unsigned)(Rb * K + C) * 2u; }
    const size_t kstep = (size_t)(BK * 2);
    const size_t hstep = (size_t)HALF * K * 2;
    const size_t tstep = 2 * hstep;
    const unsigned ldsw = (unsigned)wid * 1024u;
    const int aoff = lds_byte(wr * 64 + fr, fq * 8), boff = lds_byte(wc * 32 + fr, fq * 8);
#define PG8_SA(b, h) (((b) * 2 + (h)) * HTB)
#define PG8_SB(b, h) ((4 + (b) * 2 + (h)) * HTB)
#define PG8_STAGE(bufoff, gbase, voff) do { _Pragma("unroll") for (int _i = 0; _i < 2; ++_i) \
        __builtin_amdgcn_global_load_lds((const unsigned*)((const char*)(gbase) + (voff)[_i]), (PG8_LAS unsigned*)(lds + (bufoff) + ldsw + _i * 8192), 16, 0, 0); } while (0)
#define PG8_LDA(dst, b, h) do { _Pragma("unroll") for (int m = 0; m < 4; ++m) _Pragma("unroll") for (int k = 0; k < 2; ++k) dst[m][k] = *(const PG8_LAS bf16x8*)(lds + PG8_SA(b, h) + aoff + m * 2048 + k * 1024); } while (0)
#define PG8_LDB(dst, b, h) do { _Pragma("unroll") for (int n = 0; n < 2; ++n) _Pragma("unroll") for (int k = 0; k < 2; ++k) dst[n][k] = *(const PG8_LAS bf16x8*)(lds + PG8_SB(b, h) + boff + n * 2048 + k * 1024); } while (0)
#define PG8_MMA(ai, bj, At, Bt) do { __builtin_amdgcn_s_setprio(1); _Pragma("unroll") for (int m = 0; m < 4; ++m) _Pragma("unroll") for (int n = 0; n < 2; ++n) _Pragma("unroll") for (int k = 0; k < 2; ++k) \
        acc[ai][bj][m][n] = __builtin_amdgcn_mfma_f32_16x16x32_bf16(Bt[n][k], At[m][k], acc[ai][bj][m][n], 0, 0, 0); __builtin_amdgcn_s_setprio(0); } while (0)
#define PG8_WAIT_V(n) asm volatile("s_waitcnt vmcnt(" #n ")" ::: "memory")
#define PG8_WAIT_L(n) asm volatile("s_waitcnt lgkmcnt(" #n ")" ::: "memory")
#define PG8_BAR __builtin_amdgcn_s_barrier()
#define PG8_SCHED __builtin_amdgcn_sched_barrier(0)
    Unit cur, nxt; int ui = 0;
    if (!S.next(0, cur)) return;
    f32x4 acc[2][2][4][2];
#pragma unroll
    for (int a = 0; a < 2; ++a)
#pragma unroll
        for (int b = 0; b < 2; ++b)
#pragma unroll
            for (int m = 0; m < 4; ++m)
#pragma unroll
                for (int n = 0; n < 2; ++n) acc[a][b][m][n] = (f32x4){0.f, 0.f, 0.f, 0.f};
    bf16x8 At[4][2], B0[2][2], B1[2][2];
    const char* cA = (const char*)g.A + (size_t)cur.pm * tstep; const char* cB = (const char*)g.Bt + (size_t)cur.pn * tstep;
    S.a_ready(cur);
    if constexpr (SP2) {
        PG8_STAGE(PG8_SB(0, 0), cB, voffB); PG8_STAGE(PG8_SB(0, 1), cB + hstep, voffB); PG8_STAGE(PG8_SA(0, 0), cA, voffA); PG8_STAGE(PG8_SA(0, 1), cA + hstep, voffA);
        if (wr == 1) PG8_BAR;
        PG8_WAIT_V(2); PG8_BAR;
        PG8_STAGE(PG8_SB(1, 0), cB + kstep, voffB); PG8_STAGE(PG8_SA(1, 0), cA + kstep, voffA); PG8_STAGE(PG8_SB(1, 1), cB + hstep + kstep, voffB);
        PG8_WAIT_V(6); PG8_BAR;
    } else {
        PG8_STAGE(PG8_SB(0, 0), cB, voffB); PG8_STAGE(PG8_SA(0, 0), cA, voffA); PG8_STAGE(PG8_SB(0, 1), cB + hstep, voffB); PG8_STAGE(PG8_SA(0, 1), cA + hstep, voffA);
        if (wr == 1) PG8_BAR;
        PG8_WAIT_V(4); PG8_BAR;
        PG8_STAGE(PG8_SB(1, 0), cB + kstep, voffB); PG8_STAGE(PG8_SA(1, 0), cA + kstep, voffA); PG8_STAGE(PG8_SB(1, 1), cB + hstep + kstep, voffB);
        PG8_WAIT_V(6); PG8_BAR;
    }
    for (;;) {
        const bool has_next = S.next(ui + 1, nxt);
        const char* nA = has_next ? (const char*)g.A + (size_t)nxt.pm * tstep : cA; const char* nB = has_next ? (const char*)g.Bt + (size_t)nxt.pn * tstep : cB;
        for (int t = 0; t < nt; t += 2) {
            const bool last = (t == nt - 2);
            const char* a1 = cA + (size_t)(t + 1) * kstep;
            const char* a2 = last ? nA : cA + (size_t)(t + 2) * kstep; const char* b2 = last ? nB : cB + (size_t)(t + 2) * kstep;
            const char* a3 = a2 + kstep; const char* b3 = b2 + kstep;
            if (last && has_next) S.a_ready(nxt);
            if constexpr (SP2) {
            PG8_LDB(B0, 0, 0); PG8_LDB(B1, 0, 1); PG8_SCHED; PG8_LDA(At, 0, 0); PG8_STAGE(PG8_SA(1, 1), a1 + hstep, voffA);
            PG8_WAIT_V(8); PG8_WAIT_L(0); PG8_BAR; PG8_MMA(0, 0, At, B0); PG8_MMA(0, 1, At, B1); PG8_BAR; PG8_SCHED;
            PG8_LDA(At, 0, 1); PG8_STAGE(PG8_SB(0, 0), b2, voffB); PG8_STAGE(PG8_SB(0, 1), b2 + hstep, voffB); PG8_STAGE(PG8_SA(0, 0), a2, voffA);
            PG8_WAIT_V(8); PG8_WAIT_L(0); PG8_BAR; PG8_MMA(1, 0, At, B0); PG8_MMA(1, 1, At, B1); PG8_BAR; PG8_SCHED;
            PG8_LDB(B0, 1, 0); PG8_LDB(B1, 1, 1); PG8_SCHED; PG8_LDA(At, 1, 0); PG8_STAGE(PG8_SA(0, 1), a2 + hstep, voffA);
            PG8_WAIT_V(8); PG8_WAIT_L(0); PG8_BAR; PG8_MMA(0, 0, At, B0); PG8_MMA(0, 1, At, B1); PG8_BAR; PG8_SCHED;
            PG8_LDA(At, 1, 1); PG8_STAGE(PG8_SB(1, 0), b3, voffB); PG8_STAGE(PG8_SB(1, 1), b3 + hstep, voffB); PG8_STAGE(PG8_SA(1, 0), a3, voffA);
            PG8_WAIT_V(8); PG8_WAIT_L(0); PG8_BAR; PG8_MMA(1, 0, At, B0); PG8_MMA(1, 1, At, B1); PG8_BAR; PG8_SCHED;
            } else {
            PG8_LDB(B0, 0, 0); PG8_SCHED; PG8_LDA(At, 0, 0); PG8_STAGE(PG8_SA(1, 1), a1 + hstep, voffA);
            PG8_WAIT_L(8); PG8_BAR; PG8_WAIT_L(0); PG8_MMA(0, 0, At, B0); PG8_BAR; PG8_SCHED;
            PG8_LDB(B1, 0, 1); PG8_STAGE(PG8_SB(0, 0), b2, voffB);
            PG8_BAR; PG8_WAIT_L(0); PG8_MMA(0, 1, At, B1); PG8_BAR;
            PG8_LDA(At, 0, 1); PG8_STAGE(PG8_SA(0, 0), a2, voffA);
            PG8_BAR; PG8_WAIT_L(0); PG8_MMA(1, 0, At, B0); PG8_BAR; PG8_SCHED;
            PG8_STAGE(PG8_SB(0, 1), b2 + hstep, voffB);
            PG8_WAIT_V(6); PG8_BAR; PG8_MMA(1, 1, At, B1); PG8_BAR;
            PG8_LDB(B0, 1, 0); PG8_SCHED; PG8_LDA(At, 1, 0); PG8_STAGE(PG8_SA(0, 1), a2 + hstep, voffA);
            PG8_WAIT_L(8); PG8_BAR; PG8_WAIT_L(0); PG8_MMA(0, 0, At, B0); PG8_BAR; PG8_SCHED;
            PG8_LDB(B1, 1, 1); PG8_STAGE(PG8_SB(1, 0), b3, voffB);
            PG8_BAR; PG8_WAIT_L(0); PG8_MMA(0, 1, At, B1); PG8_BAR;
            PG8_LDA(At, 1, 1); PG8_STAGE(PG8_SA(1, 0), a3, voffA);
            PG8_BAR; PG8_WAIT_L(0); PG8_MMA(1, 0, At, B0); PG8_BAR; PG8_SCHED;
            PG8_STAGE(PG8_SB(1, 1), b3 + hstep, voffB);
            PG8_WAIT_V(6); PG8_BAR; PG8_MMA(1, 1, At, B1); PG8_BAR;
            }
        }
        if constexpr (ALIGN_EPI) { if (wr == 0) PG8_BAR; }
        if constexpr (!Epi::AFTER_DRAIN) { E(acc, cur, wr, wc, fr, fq); S.done(cur); }
        if (!has_next) break;
#pragma unroll
        for (int a = 0; a < 2; ++a)
#pragma unroll
            for (int b = 0; b < 2; ++b)
#pragma unroll
                for (int m = 0; m < 4; ++m)
#pragma unroll
                    for (int n = 0; n < 2; ++n) acc[a][b][m][n] = (f32x4){0.f, 0.f, 0.f, 0.f};
        cur = nxt; cA = nA; cB = nB; ++ui;
        if constexpr (ALIGN_EPI) { if (wr == 1) PG8_BAR; }
    }
    PG8_WAIT_V(0);
    if constexpr (!ALIGN_EPI) { if (wr == 0) PG8_BAR; }
    PG8_BAR;
    if constexpr (Epi::AFTER_DRAIN) { E.fused(acc, cur, wr, wc, fr, fq, lds, wid, lane); S.done(cur); }
#undef PG8_SA
#undef PG8_SB
#undef PG8_STAGE
#undef PG8_LDA
#undef PG8_LDB
#undef PG8_MMA
#undef PG8_WAIT_V
#undef PG8_WAIT_L
#undef PG8_BAR
#undef PG8_SCHED
}
}

typedef unsigned short bf16;
typedef float f32x4 __attribute__((ext_vector_type(4)));
typedef unsigned u32x4 __attribute__((ext_vector_type(4)));
typedef unsigned u32x2 __attribute__((ext_vector_type(2)));

constexpr int BATCH = 8, SEQ = 4096, T = BATCH * SEQ, D = 1024, DEPTH = 2;
constexpr int NA = 2048, NB = 3328, NIN = NA + NB, INW = 5204;
constexpr int DFF = 2816, NGU = 2 * DFF, PLE = 256, MIXW = 2048;
constexpr int A_Q = 0, A_BG = 512, A_Z = 1024;
constexpr int B_CKV = 0, B_IQ = 256, B_CG = 512, B_HB = 1024, B_XBC = 1536, B_IK = 3072, B_DT = 3136, B_IW = 3152;
constexpr int XBC = 1536, KV_R = 256, TOPK = 256;
constexpr float EPS = 1e-6f;

constexpr size_t MiB = 1u << 20;
constexpr size_t WS_CTL = 0;
constexpr size_t WS_RSTD = 1 * MiB;
constexpr size_t WS_RSTD2 = 1 * MiB + 256 * 1024;
constexpr size_t WS_DT = 2 * MiB;
constexpr size_t WS_W = 8 * MiB;
constexpr size_t WS_W_IN = WS_W, WS_W_OUT = WS_W_IN + (size_t)NIN * D * 2, WS_W_GU = WS_W_OUT + (size_t)D * MIXW * 2, WS_W_DOWN = WS_W_GU + (size_t)NGU * D * 2,
                 WS_W_PG = WS_W_DOWN + (size_t)D * DFF * 2, WS_W_PP = WS_W_PG + (size_t)D * D * 2, WS_W_END = WS_W_PP + (size_t)D * PLE * 2;
constexpr size_t WS_WUK = 42 * MiB, WS_WUV = 43 * MiB;
static_assert(WS_W_END <= 42 * MiB, "weights");
constexpr size_t WS_X0 = 44 * MiB, WS_X1 = 108 * MiB, WS_RA = 172 * MiB, WS_RB = 300 * MiB, WS_DT2 = 508 * MiB, WS_END = 512 * MiB;
constexpr size_t WS_XA = WS_X0;
constexpr size_t WS_IDX = WS_X1 + 48 * MiB;
constexpr size_t WS_CKVC = WS_X1 + 32 * MiB;
constexpr size_t WS_IKC = 4 * MiB;

__host__ __device__ __forceinline__ float bf2f(bf16 b) { return __builtin_bit_cast(float, ((unsigned)b) << 16); }
__host__ __device__ __forceinline__ bf16 f2bf(float f) { unsigned u = __builtin_bit_cast(unsigned, f); return (bf16)((u + 0x7fffu + ((u >> 16) & 1u)) >> 16); }
__device__ __forceinline__ unsigned pk2(float lo, float hi) { return (unsigned)f2bf(lo) | ((unsigned)f2bf(hi) << 16); }
__device__ __forceinline__ float wave_sum(float v) {
#pragma unroll
    for (int o = 1; o < 64; o <<= 1) v += __shfl_xor(v, o);
    return v;
}
__device__ __forceinline__ float wave_max(float v) {
#pragma unroll
    for (int o = 1; o < 64; o <<= 1) v = fmaxf(v, __shfl_xor(v, o));
    return v;
}
__device__ __forceinline__ float sigmoidf_(float v) { return __builtin_amdgcn_rcpf(1.0f + __expf(-v)); }
__device__ __forceinline__ float siluf_(float v) { return v * sigmoidf_(v); }

__host__ __device__ __forceinline__ int src_col_in(int n) {
    if (n < 512) return n;
    if (n < 1024) return 1092 + (n - 512);
    if (n < 2048) return 2628 + (n - 1024);
    n -= 2048;
    if (n < 256) return 512 + n;
    if (n < 512) return 768 + (n - 256);
    if (n < 1024) return 1604 + (n - 512);
    if (n < 1536) return 2116 + (n - 1024);
    if (n < 3072) return 3652 + (n - 1536);
    if (n < 3136) return 1024 + (n - 3072);
    if (n < 3152) return 5188 + (n - 3136);
    if (n < 3156) return 1088 + (n - 3152);
    return -1;
}

__host__ __device__ __forceinline__ int t5_bucket(int rel) {
    const int ret = rel > 0 ? 16 : 0; const int n = rel < 0 ? -rel : rel;
    int b;
    if (n < 8) b = n; else if (n < 15) b = 8; else if (n < 27) b = 9; else if (n < 50) b = 10; else if (n < 91) b = 11; else if (n < 166) b = 12; else if (n < 305) b = 13; else if (n < 559) b = 14; else b = 15;
    return ret + b;
}

template <int MODE> __global__ void __launch_bounds__(256) k_prep_w(const float* __restrict__ W, const float* __restrict__ W2, int K, int Nsrc, const float* __restrict__ gain, bf16* __restrict__ Wt) {
    __shared__ float tile[32][33];
    const int n0 = blockIdx.x * 32, k0 = blockIdx.y * 32, tx = threadIdx.x & 31, ty = threadIdx.x >> 5;
    const int n = n0 + tx; int src; const float* Ws = W;
    if (MODE == 0) src = n; else if (MODE == 1) src = src_col_in(n); else { const int which = (n & 255) >> 7; src = (n >> 8) * 128 + (n & 127); Ws = which ? W2 : W; }
    for (int kk = ty; kk < 32; kk += 8) { float v = 0.f; if (src >= 0) { v = Ws[(size_t)(k0 + kk) * Nsrc + src]; if (gain) v *= gain[k0 + kk]; } tile[kk][tx] = v; }
    __syncthreads();
    for (int nn = ty; nn < 32; nn += 8) Wt[(size_t)(n0 + nn) * K + k0 + tx] = f2bf(tile[tx][nn]);
}

__global__ void __launch_bounds__(256) k_x_prep(const float* __restrict__ x, bf16* __restrict__ xb, float* __restrict__ rstd) {
    const int lane = threadIdx.x & 63, row = blockIdx.x * 4 + (threadIdx.x >> 6);
    const f32x4* xr = (const f32x4*)(x + (size_t)row * D) + lane; float ss = 0.f; f32x4 v[4];
#pragma unroll
    for (int j = 0; j < 4; ++j) { v[j] = xr[64 * j]; ss += (v[j].x * v[j].x + v[j].y * v[j].y) + (v[j].z * v[j].z + v[j].w * v[j].w); }
    ss = wave_sum(ss);
    u32x2* o = (u32x2*)(xb + (size_t)row * D) + lane;
#pragma unroll
    for (int j = 0; j < 4; ++j) { u32x2 w; w.x = pk2(v[j].x, v[j].y); w.y = pk2(v[j].z, v[j].w); o[64 * j] = w; }
    if (lane == 0) rstd[row] = 1.0f / sqrtf(ss * (1.0f / D) + EPS);
}
__global__ void __launch_bounds__(256) k_rstd(const float* __restrict__ x, float* __restrict__ rstd) {
    const int lane = threadIdx.x & 63, row = blockIdx.x * 4 + (threadIdx.x >> 6);
    const f32x4* xr = (const f32x4*)(x + (size_t)row * D) + lane; float ss = 0.f;
#pragma unroll
    for (int j = 0; j < 4; ++j) { const f32x4 v = xr[64 * j]; ss += (v.x * v.x + v.y * v.y) + (v.z * v.z + v.w * v.w); }
    ss = wave_sum(ss);
    if (lane == 0) rstd[row] = 1.0f / sqrtf(ss * (1.0f / D) + EPS);
}
__global__ void __launch_bounds__(256) k_resid_norm(const float* xin, const float* __restrict__ y, const float* __restrict__ g, float* xo, bf16* __restrict__ xb,
                                                    float* __restrict__ rstd_out, const float* __restrict__ p, bf16* __restrict__ pb) {
    const int lane = threadIdx.x & 63, row = blockIdx.x * 4 + (threadIdx.x >> 6);
    const f32x4* yr = (const f32x4*)(y + (size_t)row * D) + lane; const f32x4* xr = (const f32x4*)(xin + (size_t)row * D) + lane; const f32x4* gr = (const f32x4*)g + lane;
    f32x4 v[4]; float ss = 0.f;
#pragma unroll
    for (int j = 0; j < 4; ++j) { v[j] = yr[64 * j]; ss += (v[j].x * v[j].x + v[j].y * v[j].y) + (v[j].z * v[j].z + v[j].w * v[j].w); }
    const float r = 1.0f / sqrtf(wave_sum(ss) * (1.0f / D) + EPS);
    float s2 = 0.f;
    f32x4* xor_ = (f32x4*)(xo + (size_t)row * D) + lane; u32x2* o = (u32x2*)(xb + (size_t)row * D) + lane;
#pragma unroll
    for (int j = 0; j < 4; ++j) { const f32x4 xx = xr[64 * j], gg = gr[64 * j]; f32x4 w = xx + v[j] * r * gg; xor_[64 * j] = w; s2 += (w.x * w.x + w.y * w.y) + (w.z * w.z + w.w * w.w);
        u32x2 q; q.x = pk2(w.x, w.y); q.y = pk2(w.z, w.w); o[64 * j] = q; }
    if (rstd_out) { s2 = wave_sum(s2); if (lane == 0) rstd_out[row] = 1.0f / sqrtf(s2 * (1.0f / D) + EPS); }
    if (p) { const f32x4 pv = *((const f32x4*)(p + (size_t)row * PLE) + lane); u32x2 q; q.x = pk2(pv.x, pv.y); q.y = pk2(pv.z, pv.w); *((u32x2*)(pb + (size_t)row * PLE) + lane) = q; }
}

namespace pg8 {
struct EpiProj {
    static constexpr bool PERM = true, AFTER_DRAIN = false;
    bf16_t* RA; bf16_t* RB; const float* rstd;
    __device__ __forceinline__ void operator()(const f32x4 (&acc)[2][2][4][2], const Unit& u, int wr, int wc, int fr, int fq) const {
        const int row0 = u.pm * BM + wr * 64 + fr; bf16_t* base; int ld, colt;
        if (u.pn < NA / 256) { base = RA; ld = NA; colt = u.pn * BM; } else { base = RB; ld = NB; colt = (u.pn - NA / 256) * BM; }
        const int col0 = colt + wc * 32 + 8 * fq;
        float sr[2][4];
#pragma unroll
        for (int ai = 0; ai < 2; ++ai)
#pragma unroll
            for (int m = 0; m < 4; ++m) sr[ai][m] = rstd[row0 + ai * HALF + m * 16];
#pragma unroll
        for (int ai = 0; ai < 2; ++ai)
#pragma unroll
            for (int m = 0; m < 4; ++m) { const int r = row0 + ai * HALF + m * 16; const float s = sr[ai][m]; bf16_t* rowp = base + (size_t)r * ld + col0;
#pragma unroll
                for (int bj = 0; bj < 2; ++bj) { const f32x4 v0 = acc[ai][bj][m][0] * s, v1 = acc[ai][bj][m][1] * s;
                    u32x4 w; w.x = cvt_pk_bf16(v0[0], v0[1]); w.y = cvt_pk_bf16(v0[2], v0[3]); w.z = cvt_pk_bf16(v1[0], v1[1]); w.w = cvt_pk_bf16(v1[2], v1[3]);
                    *(u32x4*)(rowp + bj * HALF) = w; } }
    }
};
struct EpiF32 {
    static constexpr bool PERM = false, AFTER_DRAIN = false;
    float* C; long ldc;
    __device__ __forceinline__ void operator()(const f32x4 (&acc)[2][2][4][2], const Unit& u, int wr, int wc, int fr, int fq) const {
        const int row0 = u.pm * BM + wr * 64 + fr, col0 = u.pn * BM + wc * 32 + 4 * fq;
#pragma unroll
        for (int ai = 0; ai < 2; ++ai)
#pragma unroll
            for (int m = 0; m < 4; ++m) { float* rowp = C + (size_t)(row0 + ai * HALF + m * 16) * ldc + col0;
#pragma unroll
                for (int bj = 0; bj < 2; ++bj)
#pragma unroll
                    for (int n = 0; n < 2; ++n) *(f32x4*)(rowp + bj * HALF + n * 16) = acc[ai][bj][m][n]; }
    }
};
struct EpiBf16P {
    static constexpr bool PERM = true, AFTER_DRAIN = false;
    bf16_t* O; long ldc;
    __device__ __forceinline__ void operator()(const f32x4 (&acc)[2][2][4][2], const Unit& u, int wr, int wc, int fr, int fq) const {
        const int row0 = u.pm * BM + wr * 64 + fr, col0 = u.pn * BM + wc * 32 + 8 * fq;
#pragma unroll
        for (int ai = 0; ai < 2; ++ai)
#pragma unroll
            for (int m = 0; m < 4; ++m) { bf16_t* rowp = O + (size_t)(row0 + ai * HALF + m * 16) * ldc + col0;
#pragma unroll
                for (int bj = 0; bj < 2; ++bj) { const f32x4 v0 = acc[ai][bj][m][0], v1 = acc[ai][bj][m][1];
                    u32x4 w; w.x = cvt_pk_bf16(v0[0], v0[1]); w.y = cvt_pk_bf16(v0[2], v0[3]); w.z = cvt_pk_bf16(v1[0], v1[1]); w.w = cvt_pk_bf16(v1[2], v1[3]);
                    *(u32x4*)(rowp + bj * HALF) = w; } }
    }
};
struct EpiSwiGLU {
    static constexpr bool PERM = true, AFTER_DRAIN = false;
    bf16_t* G; const float* rstd;
    __device__ __forceinline__ void operator()(const f32x4 (&acc)[2][2][4][2], const Unit& u, int wr, int wc, int fr, int fq) const {
        const int row0 = u.pm * BM + wr * 64 + fr, col0 = u.pn * HALF + wc * 32 + 8 * fq;
        float sr[2][4];
#pragma unroll
        for (int ai = 0; ai < 2; ++ai)
#pragma unroll
            for (int m = 0; m < 4; ++m) sr[ai][m] = rstd[row0 + ai * HALF + m * 16];
#pragma unroll
        for (int ai = 0; ai < 2; ++ai)
#pragma unroll
            for (int m = 0; m < 4; ++m) { const int r = row0 + ai * HALF + m * 16; const float s = sr[ai][m]; float o[8];
#pragma unroll
                for (int n = 0; n < 2; ++n)
#pragma unroll
                    for (int j = 0; j < 4; ++j) { const float gt = acc[ai][0][m][n][j] * s, up = acc[ai][1][m][n][j] * s; o[n * 4 + j] = gt * __builtin_amdgcn_rcpf(1.0f + __expf(-gt)) * up; }
                u32x4 w; w.x = cvt_pk_bf16(o[0], o[1]); w.y = cvt_pk_bf16(o[2], o[3]); w.z = cvt_pk_bf16(o[4], o[5]); w.w = cvt_pk_bf16(o[6], o[7]);
                *(u32x4*)(G + (size_t)r * DFF + col0) = w; }
    }
};
struct EpiPle {
    static constexpr bool PERM = true, AFTER_DRAIN = false;
    const bf16_t* X; const bf16_t* Tt; bf16_t* XB; float* OUT;
    __device__ __forceinline__ void operator()(const f32x4 (&acc)[2][2][4][2], const Unit& u, int wr, int wc, int fr, int fq) const {
        const int row0 = u.pm * BM + wr * 64 + fr, col0 = u.pn * BM + wc * 32 + 8 * fq;
        u32x4 tv[2][2], xv[2][2];
#define PLE_LOAD(slot, grp) do { const size_t off_ = (size_t)(row0 + ((grp) >> 2) * HALF + ((grp) & 3) * 16) * D + col0; _Pragma("unroll") for (int bj_ = 0; bj_ < 2; ++bj_) { \
            tv[slot][bj_] = *(const u32x4*)(Tt + off_ + bj_ * HALF); xv[slot][bj_] = *(const u32x4*)(X + off_ + bj_ * HALF); } } while (0)
        PLE_LOAD(0, 0);
#pragma unroll
        for (int grp = 0; grp < 8; ++grp) { const int ai = grp >> 2, m = grp & 3, sl = grp & 1; const size_t off = (size_t)(row0 + ai * HALF + m * 16) * D + col0;
            if (grp + 1 < 8) PLE_LOAD((grp + 1) & 1, grp + 1);
#pragma unroll
            for (int bj = 0; bj < 2; ++bj) { const unsigned tw[4] = {tv[sl][bj].x, tv[sl][bj].y, tv[sl][bj].z, tv[sl][bj].w}, xw[4] = {xv[sl][bj].x, xv[sl][bj].y, xv[sl][bj].z, xv[sl][bj].w}; f32x4 x0, x1;
#pragma unroll
                for (int j = 0; j < 4; ++j) { const float t0 = __builtin_bit_cast(float, (j & 1) ? (tw[j >> 1] & 0xffff0000u) : (tw[j >> 1] << 16));
                    const float t1 = __builtin_bit_cast(float, (j & 1) ? (tw[2 + (j >> 1)] & 0xffff0000u) : (tw[2 + (j >> 1)] << 16));
                    const float a0 = __builtin_bit_cast(float, (j & 1) ? (xw[j >> 1] & 0xffff0000u) : (xw[j >> 1] << 16));
                    const float a1 = __builtin_bit_cast(float, (j & 1) ? (xw[2 + (j >> 1)] & 0xffff0000u) : (xw[2 + (j >> 1)] << 16));
                    x0[j] = a0 + __builtin_amdgcn_rcpf(1.0f + __expf(-acc[ai][bj][m][0][j])) * t0; x1[j] = a1 + __builtin_amdgcn_rcpf(1.0f + __expf(-acc[ai][bj][m][1][j])) * t1; }
                if (OUT) { *(f32x4*)(OUT + off + bj * HALF) = x0; *(f32x4*)(OUT + off + bj * HALF + 4) = x1; }
                else { u32x4 w; w.x = cvt_pk_bf16(x0[0], x0[1]); w.y = cvt_pk_bf16(x0[2], x0[3]); w.z = cvt_pk_bf16(x1[0], x1[1]); w.w = cvt_pk_bf16(x1[2], x1[3]);
                    *(u32x4*)(XB + off + bj * HALF) = w; } } }
#undef PLE_LOAD
    }
};
}

__device__ __forceinline__ unsigned ord_key(float f) { const unsigned u = __builtin_bit_cast(unsigned, f); return (u & 0x80000000u) ? ~u : (u | 0x80000000u); }
#define LAS __attribute__((address_space(3)))
#define XB_TMO      128
#define XB_XCNT(j)  (256  + 64 * (j))
#define XB_XSUB(j)  (1280 + 64 * (j))
#define XB_XGEN(j)  (2304 + 64 * (j))
#define XB_TOP      3328
#define XB_TOPGEN   3392
#define XCD_BAR_WORDS 3456
#define XB_SPIN_CAP (1u << 18)

__device__ __forceinline__ unsigned xb_ld(unsigned* p)              { return __hip_atomic_load(p, __ATOMIC_RELAXED, __HIP_MEMORY_SCOPE_AGENT); }
__device__ __forceinline__ unsigned xb_add(unsigned* p, unsigned v) { return __hip_atomic_fetch_add(p, v, __ATOMIC_RELAXED, __HIP_MEMORY_SCOPE_AGENT); }
__device__ __forceinline__ unsigned xb_xcc_id() { return (unsigned)__builtin_amdgcn_s_getreg((3 << 11) | 20) & 0xFu; }
#define XB_SPIN(cond, bar) do { unsigned _sp = 0; while (cond) { __builtin_amdgcn_s_sleep(1); \
    if ((++_sp & 255u) == 0u) { if (xb_ld(&(bar)[XB_TMO])) break; if (_sp > XB_SPIN_CAP) { atomicAdd(&(bar)[XB_TMO], 1u); break; } } } } while (0)

struct XcdBarrier {
    unsigned* bar; unsigned x;
    volatile LAS unsigned* st;
};

__device__ __forceinline__ XcdBarrier xcd_barrier_post(unsigned* bar, volatile LAS unsigned* st) {
    XcdBarrier b; b.bar = bar; b.x = xb_xcc_id(); b.st = st;
    if (threadIdx.x == 0) (void)xb_add(&bar[XB_XCNT(b.x)], 1u);
    return b;
}
__device__ __forceinline__ void xcd_barrier_complete(unsigned* bar, unsigned x, unsigned& nloc, unsigned& nx) {
    const unsigned G = gridDim.x * gridDim.y * gridDim.z;
    unsigned sum, cnt, mine, sp = 0u;
    for (;;) {
        sum = 0u; cnt = 0u; mine = 0u;
#pragma unroll
        for (unsigned j = 0; j < 16; ++j) { const unsigned c = xb_ld(&bar[XB_XCNT(j)]); sum += c; cnt += (c > 0u) ? 1u : 0u; mine = (j == x) ? c : mine; }
        if (sum == G) break;
        __builtin_amdgcn_s_sleep(1);
        if ((++sp & 255u) == 0u) { if (xb_ld(&bar[XB_TMO])) break; if (sp > XB_SPIN_CAP) { atomicAdd(&bar[XB_TMO], 1u); break; } }
    }
    nloc = mine > 0u ? mine : 1u; nx = cnt > 0u ? cnt : 1u;
}

__device__ __forceinline__ void xcd_barrier(const XcdBarrier& b, int tid_in) {
    asm volatile("s_waitcnt vmcnt(0)" ::: "memory");
    __syncthreads();
    if (tid_in == 0) {
        unsigned* bar = b.bar;
        __builtin_amdgcn_s_waitcnt(0);
        unsigned nloc = b.st[0], nx = b.st[1];
        if (nloc == 0u) { xcd_barrier_complete(bar, b.x, nloc, nx); b.st[0] = nloc; b.st[1] = nx; }
        const unsigned old = xb_add(&bar[XB_XSUB(b.x)], 1u);
        const unsigned gen = old / nloc;
        if (old + 1u == (gen + 1u) * nloc) {
            __builtin_amdgcn_fence(__ATOMIC_RELEASE, "agent");
            asm volatile("s_waitcnt vmcnt(0)" ::: "memory");
            const unsigned og = xb_add(&bar[XB_TOP], 1u);
            const unsigned tg = og / nx;
            if (og + 1u == (tg + 1u) * nx) xb_add(&bar[XB_TOPGEN], 1u);
            else XB_SPIN(xb_ld(&bar[XB_TOPGEN]) == tg, bar);
            __builtin_amdgcn_fence(__ATOMIC_ACQUIRE, "agent");
            xb_add(&bar[XB_XGEN(b.x)], 1u);
            asm volatile("s_waitcnt vmcnt(0)" ::: "memory");
        } else {
            XB_SPIN(xb_ld(&bar[XB_XGEN(b.x)]) == gen, bar);
            __builtin_amdgcn_fence(__ATOMIC_ACQUIRE, "agent");
            asm volatile("s_waitcnt vmcnt(0)" ::: "memory");
        }
    }
    __syncthreads();
}


constexpr int NTHR = 512, NWAVES = 8;
constexpr int RING_BYTES = 131072, LDS_BYTES = 147456, MISC_OFF = LDS_BYTES - 512;
constexpr int CW_BAR = 4096, CW_RANK = 8192;
constexpr size_t CTL_ZERO_BYTES = 1 * MiB;
constexpr int NPH = 14;

__device__ __forceinline__ int mk_tid(int wave_s) { int l_; asm volatile("v_mbcnt_lo_u32_b32 %0, -1, 0\n\tv_mbcnt_hi_u32_b32 %0, -1, %0" : "=v"(l_)); return wave_s * 64 + l_; }
struct Params { const float* in[26]; float* out; unsigned char* ws; int ph_lo, ph_hi, dbl_mask, pad; };
static_assert(sizeof(Params) == 26 * 8 + 8 + 8 + 16, "no padding");

#define LDSP __attribute__((address_space(3)))
#define LDS_WAIT() asm volatile("s_waitcnt lgkmcnt(0)" ::: "memory")
#ifndef NAIVE_SELECT
#define NAIVE_SELECT 0
#endif
#ifndef NAIVE_ATTN
#define NAIVE_ATTN 0
#endif
#ifndef NAIVE_SSM
#define NAIVE_SSM 0
#endif
#ifndef DBG_SSM
#define DBG_SSM 0
#endif
#ifndef TIMING
#define TIMING 0
#endif
#ifndef DBL_MASK
#define DBL_MASK 0
#endif
#ifndef GEMM_DRYK
#define GEMM_DRYK 0
#endif
#ifndef CLK_PROBE
#define CLK_PROBE 0
#endif
#ifndef ATT_FN
#define ATT_FN wg_attn16d
#endif
#ifndef XTRA_BAR
#define XTRA_BAR 0
#endif
#ifndef ATT_SUB_V
#define ATT_SUB_V 0
#endif
#ifndef TIMING_SHIFT
#define TIMING_SHIFT 0.0f
#endif
#ifndef TIMING_A
#define TIMING_A 2
#endif
#ifndef TIMING_B
#define TIMING_B 3
#endif

template <int MODE> __device__ __forceinline__ void ph_prep_w(LDSP float* scr, const float* __restrict__ W, const float* __restrict__ W2, int K, int Nsrc, const float* __restrict__ gain, bf16* __restrict__ Wt, int Ndst, int gw, int NGW, int lane) {
    const int ntn = Ndst / 32, nt = ntn * (K / 64), n4 = lane & 7, kr = lane >> 3;
    f32x4 v[8];
#define PW_LOAD(it_) { const int n0_ = ((it_) % ntn) * 32, k0_ = ((it_) / ntn) * 64, n_ = n0_ + 4 * n4; int src_; const float* Ws_ = W; \
        if (MODE == 0) src_ = n_; else if (MODE == 1) src_ = src_col_in(n_); else { const int which_ = (n_ & 255) >> 7; src_ = (n_ >> 8) * 128 + (n_ & 127); Ws_ = which_ ? W2 : W; } \
        _Pragma("unroll") for (int i = 0; i < 8; ++i) { const int kk = kr + 8 * i; f32x4 t_ = (f32x4){0.f, 0.f, 0.f, 0.f}; if (src_ >= 0) { t_ = *(const f32x4*)(Ws_ + (size_t)(k0_ + kk) * Nsrc + src_); if (gain) t_ = t_ * gain[k0_ + kk]; } v[i] = t_; } }
    if (gw < nt) PW_LOAD(gw)
    for (int it = gw; it < nt; it += NGW) {
        const int n0 = (it % ntn) * 32, k0 = (it / ntn) * 64;
#pragma unroll
        for (int i = 0; i < 8; ++i) { LDSP float* d = scr + (kr + 8 * i) * 33 + 4 * n4; d[0] = v[i].x; d[1] = v[i].y; d[2] = v[i].z; d[3] = v[i].w; }
        if (it + NGW < nt) PW_LOAD(it + NGW)
        LDS_WAIT(); asm volatile("" ::: "memory");
        const int cc = lane & 7;
#pragma unroll
        for (int j = 0; j < 4; ++j) { const int nn = (lane >> 3) + 8 * j; const LDSP float* s = scr + (8 * cc) * 33 + nn;
            u32x4 o; o.x = pk2(s[0 * 33], s[1 * 33]); o.y = pk2(s[2 * 33], s[3 * 33]); o.z = pk2(s[4 * 33], s[5 * 33]); o.w = pk2(s[6 * 33], s[7 * 33]);
            *(u32x4*)(Wt + (size_t)(n0 + nn) * K + k0 + 8 * cc) = o; }
        LDS_WAIT(); asm volatile("" ::: "memory");
    }
#undef PW_LOAD
}
__device__ __forceinline__ void row_x_prep(const float* __restrict__ x, bf16* __restrict__ xb, float* __restrict__ rstd, int row, int lane) {
    const f32x4* xr = (const f32x4*)(x + (size_t)row * D) + lane; float ss = 0.f; f32x4 v[4];
#pragma unroll
    for (int j = 0; j < 4; ++j) { v[j] = xr[64 * j]; ss += (v[j].x * v[j].x + v[j].y * v[j].y) + (v[j].z * v[j].z + v[j].w * v[j].w); }
    ss = wave_sum(ss);
    if (xb) { u32x2* o = (u32x2*)(xb + (size_t)row * D) + lane;
#pragma unroll
        for (int j = 0; j < 4; ++j) { u32x2 w; w.x = pk2(v[j].x, v[j].y); w.y = pk2(v[j].z, v[j].w); o[64 * j] = w; } }
    if (lane == 0) rstd[row] = 1.0f / sqrtf(ss * (1.0f / D) + EPS);
}
__device__ __forceinline__ void row_resid_norm(const float* xin, const float* __restrict__ y, const float* __restrict__ g, float* xo, bf16* __restrict__ xb, float* __restrict__ rstd_out, const float* __restrict__ p, bf16* __restrict__ pb, int row, int lane, bool dry = false) {
    const f32x4* yr = (const f32x4*)(y + (size_t)row * D) + lane; const f32x4* xr = (const f32x4*)(xin + (size_t)row * D) + lane; const f32x4* gr = (const f32x4*)g + lane;
    f32x4 v[4]; float ss = 0.f;
#pragma unroll
    for (int j = 0; j < 4; ++j) { v[j] = yr[64 * j]; ss += (v[j].x * v[j].x + v[j].y * v[j].y) + (v[j].z * v[j].z + v[j].w * v[j].w); }
    const float r = 1.0f / sqrtf(wave_sum(ss) * (1.0f / D) + EPS);
    float s2 = 0.f;
    f32x4* xor_ = (f32x4*)(xo + (size_t)row * D) + lane; u32x2* o = (u32x2*)(xb + (size_t)row * D) + lane;
#pragma unroll
    for (int j = 0; j < 4; ++j) { const f32x4 xx = xr[64 * j], gg = gr[64 * j]; f32x4 w = xx + v[j] * r * gg; if (!dry) xor_[64 * j] = w; s2 += (w.x * w.x + w.y * w.y) + (w.z * w.z + w.w * w.w);
        u32x2 q; q.x = pk2(w.x, w.y); q.y = pk2(w.z, w.w); o[64 * j] = q; }
    if (rstd_out) { s2 = wave_sum(s2); if (lane == 0) rstd_out[row] = 1.0f / sqrtf(s2 * (1.0f / D) + EPS); }
    if (p) { const f32x4 pv = *((const f32x4*)(p + (size_t)row * PLE) + lane); u32x2 q; q.x = pk2(pv.x, pv.y); q.y = pk2(pv.z, pv.w); *((u32x2*)(pb + (size_t)row * PLE) + lane) = q; }
}

__device__ __forceinline__ void row_resid_norm2(const bf16* xin, const bf16* __restrict__ y, const float* __restrict__ g, bf16* xo, float* __restrict__ rstd_out, const float* __restrict__ p, bf16* __restrict__ pb, int row0, int lane, bool dry = false) {
    f32x4 v[2][4], xx[2][4], pv[2]; const f32x4* gr = (const f32x4*)g + lane;
#pragma unroll
    for (int r = 0; r < 2; ++r) { const u32x2* yr = (const u32x2*)(y + (size_t)(row0 + r) * D) + lane; const u32x2* xr = (const u32x2*)(xin + (size_t)(row0 + r) * D) + lane;
#pragma unroll
        for (int j = 0; j < 4; ++j) { const u32x2 yw = yr[64 * j], xw = xr[64 * j];
            v[r][j] = (f32x4){__builtin_bit_cast(float, yw.x << 16), __builtin_bit_cast(float, yw.x & 0xffff0000u), __builtin_bit_cast(float, yw.y << 16), __builtin_bit_cast(float, yw.y & 0xffff0000u)};
            xx[r][j] = (f32x4){__builtin_bit_cast(float, xw.x << 16), __builtin_bit_cast(float, xw.x & 0xffff0000u), __builtin_bit_cast(float, xw.y << 16), __builtin_bit_cast(float, xw.y & 0xffff0000u)}; }
        if (p) pv[r] = *((const f32x4*)(p + (size_t)(row0 + r) * PLE) + lane); }
    f32x4 gg[4];
#pragma unroll
    for (int j = 0; j < 4; ++j) gg[j] = gr[64 * j];
#pragma unroll
    for (int r = 0; r < 2; ++r) { float ss = 0.f;
#pragma unroll
        for (int j = 0; j < 4; ++j) ss += (v[r][j].x * v[r][j].x + v[r][j].y * v[r][j].y) + (v[r][j].z * v[r][j].z + v[r][j].w * v[r][j].w);
        const float rr = 1.0f / sqrtf(wave_sum(ss) * (1.0f / D) + EPS); float s2 = 0.f;
        u32x2* o = (u32x2*)(xo + (size_t)(row0 + r) * D) + lane;
#pragma unroll
        for (int j = 0; j < 4; ++j) { const f32x4 w = xx[r][j] + v[r][j] * rr * gg[j]; u32x2 q; q.x = pk2(w.x, w.y); q.y = pk2(w.z, w.w); if (!dry) o[64 * j] = q;
            const float r0 = __builtin_bit_cast(float, q.x << 16), r1 = __builtin_bit_cast(float, q.x & 0xffff0000u), r2 = __builtin_bit_cast(float, q.y << 16), r3 = __builtin_bit_cast(float, q.y & 0xffff0000u);
            s2 += (r0 * r0 + r1 * r1) + (r2 * r2 + r3 * r3); }
        if (rstd_out) { s2 = wave_sum(s2); if (lane == 0) rstd_out[row0 + r] = 1.0f / sqrtf(s2 * (1.0f / D) + EPS); }
        if (p) { u32x2 q; q.x = pk2(pv[r].x, pv[r].y); q.y = pk2(pv[r].z, pv[r].w); *((u32x2*)(pb + (size_t)(row0 + r) * PLE) + lane) = q; } }
}
__device__ __forceinline__ void row_rstd_bf16(const bf16* __restrict__ xb, float* __restrict__ rstd, int row, int lane) {
    const u32x2* xr = (const u32x2*)(xb + (size_t)row * D) + lane; float ss = 0.f;
#pragma unroll
    for (int j = 0; j < 4; ++j) { const u32x2 w = xr[64 * j]; const float a = __builtin_bit_cast(float, w.x << 16), b = __builtin_bit_cast(float, w.x & 0xffff0000u), c2 = __builtin_bit_cast(float, w.y << 16), d = __builtin_bit_cast(float, w.y & 0xffff0000u); ss += (a * a + b * b) + (c2 * c2 + d * d); }
    ss = wave_sum(ss); if (lane == 0) rstd[row] = 1.0f / sqrtf(ss * (1.0f / D) + EPS);
}
__device__ __forceinline__ void row_x_prep2(const float* __restrict__ x, bf16* __restrict__ xb, float* __restrict__ rstd, int row0, int lane) {
    f32x4 v[2][4]; float ss[2];
#pragma unroll
    for (int r = 0; r < 2; ++r) { const f32x4* xr = (const f32x4*)(x + (size_t)(row0 + r) * D) + lane;
#pragma unroll
        for (int j = 0; j < 4; ++j) v[r][j] = xr[64 * j]; }
#pragma unroll
    for (int r = 0; r < 2; ++r) { float s_ = 0.f;
#pragma unroll
        for (int j = 0; j < 4; ++j) s_ += (v[r][j].x * v[r][j].x + v[r][j].y * v[r][j].y) + (v[r][j].z * v[r][j].z + v[r][j].w * v[r][j].w);
        ss[r] = wave_sum(s_); u32x2* o = (u32x2*)(xb + (size_t)(row0 + r) * D) + lane;
#pragma unroll
        for (int j = 0; j < 4; ++j) { u32x2 w; w.x = pk2(v[r][j].x, v[r][j].y); w.y = pk2(v[r][j].z, v[r][j].w); o[64 * j] = w; } }
    if (lane < 2) rstd[row0 + lane] = 1.0f / sqrtf((lane ? ss[1] : ss[0]) * (1.0f / D) + EPS);
}
__device__ __forceinline__ void row_rstd_bf16x4(const bf16* __restrict__ xb, float* __restrict__ rstd, int row0, int lane) {
    u32x2 w[4][4]; float ss[4];
#pragma unroll
    for (int r = 0; r < 4; ++r) { const u32x2* xr = (const u32x2*)(xb + (size_t)(row0 + r) * D) + lane;
#pragma unroll
        for (int j = 0; j < 4; ++j) w[r][j] = xr[64 * j]; }
#pragma unroll
    for (int r = 0; r < 4; ++r) { float s_ = 0.f;
#pragma unroll
        for (int j = 0; j < 4; ++j) { const float a = __builtin_bit_cast(float, w[r][j].x << 16), b = __builtin_bit_cast(float, w[r][j].x & 0xffff0000u), c2 = __builtin_bit_cast(float, w[r][j].y << 16), d = __builtin_bit_cast(float, w[r][j].y & 0xffff0000u); s_ += (a * a + b * b) + (c2 * c2 + d * d); }
        ss[r] = wave_sum(s_); }
    const float sel = lane == 0 ? ss[0] : lane == 1 ? ss[1] : lane == 2 ? ss[2] : ss[3];
    if (lane < 4) rstd[row0 + lane] = 1.0f / sqrtf(sel * (1.0f / D) + EPS);
}
__device__ __forceinline__ void wave_gnorm4(bf16* RA, const float* __restrict__ nw, int w0, int lane, bool dry = false) {
    u32x4 v[4]; float ss[4];
#pragma unroll
    for (int i = 0; i < 4; ++i) { const int w = w0 + i, t = w >> 1, g = w & 1; v[i] = *(const u32x4*)(RA + (size_t)t * NA + A_Z + g * 512 + lane * 8); }
    float f[4][8];
#pragma unroll
    for (int i = 0; i < 4; ++i) { const unsigned vw[4] = {v[i].x, v[i].y, v[i].z, v[i].w}; ss[i] = 0.f;
#pragma unroll
        for (int e = 0; e < 8; ++e) { f[i][e] = bf2f((bf16)((vw[e >> 1] >> ((e & 1) * 16)) & 0xffff)); ss[i] += f[i][e] * f[i][e]; } }
#pragma unroll
    for (int o = 1; o < 64; o <<= 1) {
#pragma unroll
        for (int i = 0; i < 4; ++i) ss[i] += __shfl_xor(ss[i], o); }
#pragma unroll
    for (int i = 0; i < 4; ++i) { const int w = w0 + i, t = w >> 1, g = w & 1; const float r = 1.0f / sqrtf(ss[i] * (1.0f / 512.0f) + EPS); const float* gw = nw + g * 512 + lane * 8;
        u32x4 o; o.x = pk2(f[i][0] * r * gw[0], f[i][1] * r * gw[1]); o.y = pk2(f[i][2] * r * gw[2], f[i][3] * r * gw[3]); o.z = pk2(f[i][4] * r * gw[4], f[i][5] * r * gw[5]); o.w = pk2(f[i][6] * r * gw[6], f[i][7] * r * gw[7]);
        if (!dry) *(u32x4*)(RA + (size_t)t * NA + A_Z + g * 512 + lane * 8) = o; }
}
__device__ __forceinline__ void tok_m1(bf16* __restrict__ RA, bf16* __restrict__ RB, bf16* __restrict__ CKVC, bf16* __restrict__ IKC, const float* __restrict__ kvn, const float* __restrict__ ikg, const float* __restrict__ ikb, const float* __restrict__ scw, int t, int lane) {
    const int s = t & (SEQ - 1); bf16* rb = RB + (size_t)t * NB;
    {   const u32x2 w = *((const u32x2*)(rb + B_CKV) + lane); float v[4] = {bf2f((bf16)(w.x & 0xffff)), bf2f((bf16)(w.x >> 16)), bf2f((bf16)(w.y & 0xffff)), bf2f((bf16)(w.y >> 16))};
        float ss = (v[0] * v[0] + v[1] * v[1]) + (v[2] * v[2] + v[3] * v[3]); ss = wave_sum(ss); const float r = 1.0f / sqrtf(ss * (1.0f / KV_R) + EPS);
        const f32x4 g = *((const f32x4*)kvn + lane); u32x2 o; o.x = pk2(v[0] * r * g.x, v[1] * r * g.y); o.y = pk2(v[2] * r * g.z, v[3] * r * g.w); *((u32x2*)(rb + B_CKV) + lane) = o; *((u32x2*)(CKVC + (size_t)t * KV_R) + lane) = o; }
    {   const float x = bf2f(rb[B_IK + lane]); const float mu = wave_sum(x) * (1.0f / 64.0f); const float d = x - mu; const float var = wave_sum(d * d) * (1.0f / 64.0f);
        const bf16 o = f2bf(d * (1.0f / sqrtf(var + EPS)) * ikg[lane] + ikb[lane]); rb[B_IK + lane] = o; IKC[(size_t)t * 64 + lane] = o; }
    {   const int c = lane * 8; float acc[8] = {0.f, 0.f, 0.f, 0.f, 0.f, 0.f, 0.f, 0.f};
        for (int j = 0; j < 3; ++j) { const int ss_ = s - 2 + j; if (ss_ < 0) continue; const bf16* rr = RB + (size_t)(t - 2 + j) * NB;
            const u32x4 cg = *(const u32x4*)(rr + B_CG + c), hb = *(const u32x4*)(rr + B_HB + c); const unsigned cw[4] = {cg.x, cg.y, cg.z, cg.w}, hw[4] = {hb.x, hb.y, hb.z, hb.w};
#pragma unroll
            for (int e = 0; e < 8; ++e) { const float a = bf2f((bf16)((cw[e >> 1] >> ((e & 1) * 16)) & 0xffff)), b = bf2f((bf16)((hw[e >> 1] >> ((e & 1) * 16)) & 0xffff)); acc[e] += scw[j * 512 + c + e] * (a * b); } }
        bf16* ra = RA + (size_t)t * NA + A_BG + c; const u32x4 bg = *(const u32x4*)ra; const unsigned bw[4] = {bg.x, bg.y, bg.z, bg.w}; float o[8];
#pragma unroll
        for (int e = 0; e < 8; ++e) o[e] = bf2f((bf16)((bw[e >> 1] >> ((e & 1) * 16)) & 0xffff)) * acc[e];
        u32x4 w; w.x = pk2(o[0], o[1]); w.y = pk2(o[2], o[3]); w.z = pk2(o[4], o[5]); w.w = pk2(o[6], o[7]); *(u32x4*)ra = w; }
}
__device__ __forceinline__ void tok_m4a(const bf16* __restrict__ RB, const float* __restrict__ cw, const float* __restrict__ cb, const float* __restrict__ dtb, bf16* __restrict__ XA, float* __restrict__ DT, int t, int lane) {
    const int s = t & (SEQ - 1);
    for (int c = lane; c < XBC; c += 64) { float a = cb[c];
#pragma unroll
        for (int j = 0; j < 4; ++j) { const int ss = s - 3 + j; if (ss >= 0) a += cw[j * XBC + c] * bf2f(RB[(size_t)(t - 3 + j) * NB + B_XBC + c]); }
        XA[(size_t)t * XBC + c] = f2bf(siluf_(a)); }
    if (lane < 16) { const float x = bf2f(RB[(size_t)t * NB + B_DT + lane]) + dtb[lane]; DT[(size_t)t * 16 + lane] = x > 15.f ? x : log1pf(__expf(x)); }
}
__device__ __forceinline__ void wg_m2_select(LDSP unsigned char* lds, const bf16* __restrict__ RB, unsigned short* __restrict__ idx, int t, int tid) {
    LDSP float* iq = (LDSP float*)lds; LDSP float* iwv = iq + 256; LDSP unsigned* red = (LDSP unsigned*)(iq + 272); LDSP unsigned* keys = (LDSP unsigned*)(iq + 288);
    const int s = t & (SEQ - 1), b = t >> 12, lane = tid & 63, wv = tid >> 6;
    const int nk = ((s >> 6) + 1) << 6;
    const bf16* rb = RB + (size_t)t * NB;
    if (tid < 256) iq[tid] = bf2f(rb[B_IQ + tid]); if (tid < 4) iwv[tid] = bf2f(rb[B_IW + tid]) * (0.125f * 0.5f);
    __syncthreads();
    for (int k = tid; k < nk; k += NTHR) {
        const bf16* kr = RB + (size_t)(b * SEQ + k) * NB + B_IK; float sc = 0.f;
        float d0 = 0.f, d1 = 0.f, d2 = 0.f, d3 = 0.f;
#pragma unroll 1
        for (int j = 0; j < 8; ++j) { const u32x4 w = *((const u32x4*)kr + j); const unsigned ww[4] = {w.x, w.y, w.z, w.w};
#pragma unroll
            for (int e = 0; e < 8; ++e) { const float kv = bf2f((bf16)((ww[e >> 1] >> ((e & 1) * 16)) & 0xffff)); const int c = j * 8 + e;
                d0 += iq[c] * kv; d1 += iq[64 + c] * kv; d2 += iq[128 + c] * kv; d3 += iq[192 + c] * kv; } }
        sc += fmaxf(d0, 0.f) * iwv[0]; sc += fmaxf(d1, 0.f) * iwv[1]; sc += fmaxf(d2, 0.f) * iwv[2]; sc += fmaxf(d3, 0.f) * iwv[3];
        keys[k] = ord_key(sc);
    }
    __syncthreads();
    unsigned Tt = 0u;
    if (nk > TOPK) {
        for (int bit = 31; bit >= 0; --bit) { const unsigned cand = Tt | (1u << bit); unsigned c = 0;
            for (int k = tid; k < nk; k += NTHR) c += (keys[k] >= cand) ? 1u : 0u;
#pragma unroll
            for (int o = 1; o < 64; o <<= 1) c += __shfl_xor(c, o);
            if (lane == 0) red[wv] = c;
            __syncthreads();
            unsigned tot = 0;
#pragma unroll
            for (int w = 0; w < 8; ++w) tot += red[w];
            if (tot >= (unsigned)TOPK) Tt = cand;
            __syncthreads(); }
    }
    { unsigned c = 0; for (int k = tid; k < nk; k += NTHR) c += (keys[k] > Tt) ? 1u : 0u;
#pragma unroll
      for (int o = 1; o < 64; o <<= 1) c += __shfl_xor(c, o);
      if (lane == 0) red[8 + wv] = c; }
    __syncthreads();
    if (wv == 0) {
        int ngt = 0;
#pragma unroll
        for (int w = 0; w < 8; ++w) ngt += (int)red[8 + w];
        const int need = TOPK - ngt; int pos = 0, eq_taken = 0; const unsigned long long lt = (1ull << lane) - 1ull;
        for (int base = 0; base < nk; base += 64) { const unsigned k = keys[base + lane]; const bool gt = k > Tt, eq = (k == Tt);
            const unsigned long long meq = __ballot(eq); const int rank_eq = __popcll(meq & lt); const bool take = gt || (eq && (eq_taken + rank_eq < need));
            const unsigned long long msel = __ballot(take);
            if (take) { const int o = pos + __popcll(msel & lt); if (o < TOPK) idx[(size_t)t * TOPK + o] = (unsigned short)(base + lane); }
            pos += __popcll(msel); eq_taken += __popcll(__ballot(eq && take)); }
    }
    __syncthreads();
}
__device__ __forceinline__ void wg_m3_attn(LDSP unsigned char* lds, bf16* RA, const bf16* __restrict__ RB, const unsigned short* __restrict__ idx, const float* __restrict__ w_uk, const float* __restrict__ w_uv, const float* __restrict__ rel_bias, int t, int tid) {
    LDSP float* q = (LDSP float*)lds; LDSP float* qlat = q + 512; LDSP float* pr = qlat + 2048; LDSP float* outl = pr + 2048; LDSP unsigned short* sel = (LDSP unsigned short*)(outl + 2048);
    const int s = t & (SEQ - 1), b = t >> 12, lane = tid & 63, wv = tid >> 6;
    const int nk = ((s >> 6) + 1) << 6, nsel = nk < TOPK ? nk : TOPK;
    q[tid] = bf2f(RA[(size_t)t * NA + A_Q + tid]); if (tid < 256) sel[tid] = tid < nsel ? idx[(size_t)t * TOPK + tid] : (unsigned short)0;
    __syncthreads();
    {   const int r = tid & 255, h0 = (tid >> 8) * 4;
        for (int h = h0; h < h0 + 4; ++h) { const float* w = w_uk + ((size_t)r * 8 + h) * 64; float a = 0.f;
#pragma unroll 16
            for (int d = 0; d < 64; ++d) a += q[h * 64 + d] * w[d];
            qlat[h * 256 + r] = a * 0.125f; } }
    __syncthreads();
    {   const int k = tid & 255, h0 = (tid >> 8) * 4;
        if (k < nsel) { const int key = sel[k]; const bf16* kr = RB + (size_t)(b * SEQ + key) * NB + B_CKV; float a[4] = {0.f, 0.f, 0.f, 0.f};
            for (int j = 0; j < 32; ++j) { const u32x4 w = *((const u32x4*)kr + j); const unsigned ww[4] = {w.x, w.y, w.z, w.w};
#pragma unroll
                for (int e = 0; e < 8; ++e) { const float v = bf2f((bf16)((ww[e >> 1] >> ((e & 1) * 16)) & 0xffff));
#pragma unroll
                    for (int hh = 0; hh < 4; ++hh) a[hh] += qlat[(h0 + hh) * 256 + j * 8 + e] * v; } }
            const int bk = t5_bucket(key - s);
#pragma unroll
            for (int hh = 0; hh < 4; ++hh) pr[(h0 + hh) * 256 + k] = a[hh] + rel_bias[bk * 8 + h0 + hh];
        } else {
#pragma unroll
            for (int hh = 0; hh < 4; ++hh) pr[(h0 + hh) * 256 + k] = -INFINITY; } }
    __syncthreads();
    {   float v[4]; float m = -INFINITY;
#pragma unroll
        for (int j = 0; j < 4; ++j) { v[j] = pr[wv * 256 + lane + 64 * j]; m = fmaxf(m, v[j]); }
        m = wave_max(m); float sum = 0.f;
#pragma unroll
        for (int j = 0; j < 4; ++j) { v[j] = __expf(v[j] - m); sum += v[j]; }
        sum = wave_sum(sum); const float inv = 1.0f / sum;
#pragma unroll
        for (int j = 0; j < 4; ++j) pr[wv * 256 + lane + 64 * j] = v[j] * inv; }
    __syncthreads();
    {   const int r = tid & 255, h0 = (tid >> 8) * 4; float a[4] = {0.f, 0.f, 0.f, 0.f};
        for (int k = 0; k < nsel; ++k) { const float v = bf2f(RB[(size_t)(b * SEQ + sel[k]) * NB + B_CKV + r]);
#pragma unroll
            for (int hh = 0; hh < 4; ++hh) a[hh] += pr[(h0 + hh) * 256 + k] * v; }
#pragma unroll
        for (int hh = 0; hh < 4; ++hh) outl[(h0 + hh) * 256 + r] = a[hh]; }
    __syncthreads();
    {   const int h = tid >> 6, d = tid & 63; float a = 0.f;
        for (int r = 0; r < 256; ++r) a += outl[h * 256 + r] * w_uv[((size_t)r * 8 + h) * 64 + d];
        RA[(size_t)t * NA + A_Q + tid] = f2bf(a); }
    __syncthreads();
}
__device__ __forceinline__ void half_m4b_scan(bf16* RA, const bf16* __restrict__ XA, const float* __restrict__ DT, const float* __restrict__ a_log, const float* __restrict__ dsk, int b, int h, int tid) {
    const int g = h >> 3, p = tid >> 2, nq = tid & 3;
    const float A = -__expf(a_log[h]), Dh = dsk[h];
    float hs[32];
#pragma unroll
    for (int n = 0; n < 32; ++n) hs[n] = 0.f;
    for (int s = 0; s < SEQ; ++s) { const size_t t = (size_t)b * SEQ + s; const float dt = DT[t * 16 + h]; const float dA = __expf(dt * A);
        const bf16* xr = XA + t * XBC; const float x = bf2f(xr[h * 64 + p]); const float dx = dt * x;
        const u32x4* Bp = (const u32x4*)(xr + 1024 + g * 128 + nq * 32); const u32x4* Cp = (const u32x4*)(xr + 1280 + g * 128 + nq * 32); float y = 0.f;
#pragma unroll
        for (int j = 0; j < 4; ++j) { const u32x4 bw = Bp[j], cw = Cp[j]; const unsigned bb[4] = {bw.x, bw.y, bw.z, bw.w}, cc[4] = {cw.x, cw.y, cw.z, cw.w};
#pragma unroll
            for (int e = 0; e < 8; ++e) { const float Bv = bf2f((bf16)((bb[e >> 1] >> ((e & 1) * 16)) & 0xffff)), Cv = bf2f((bf16)((cc[e >> 1] >> ((e & 1) * 16)) & 0xffff));
                hs[j * 8 + e] = hs[j * 8 + e] * dA + dx * Bv; y += Cv * hs[j * 8 + e]; } }
        y += __shfl_xor(y, 1); y += __shfl_xor(y, 2);
        if (nq == 0) { bf16* zp = RA + t * NA + A_Z + h * 64 + p; const float z = bf2f(*zp); *zp = f2bf((y + Dh * x) * siluf_(z)); }
    }
}
__device__ __forceinline__ void wave_m4c_gnorm(bf16* RA, const float* __restrict__ nw, int w, int lane, bool dry = false) {
    const int t = w >> 1, g = w & 1;
    bf16* p = RA + (size_t)t * NA + A_Z + g * 512 + lane * 8; const u32x4 v = *(const u32x4*)p; const unsigned vw[4] = {v.x, v.y, v.z, v.w}; float f[8]; float ss = 0.f;
#pragma unroll
    for (int e = 0; e < 8; ++e) { f[e] = bf2f((bf16)((vw[e >> 1] >> ((e & 1) * 16)) & 0xffff)); ss += f[e] * f[e]; }
    const float r = 1.0f / sqrtf(wave_sum(ss) * (1.0f / 512.0f) + EPS); const float* gw = nw + g * 512 + lane * 8;
    u32x4 o; o.x = pk2(f[0] * r * gw[0], f[1] * r * gw[1]); o.y = pk2(f[2] * r * gw[2], f[3] * r * gw[3]); o.z = pk2(f[4] * r * gw[4], f[5] * r * gw[5]); o.w = pk2(f[6] * r * gw[6], f[7] * r * gw[7]);
    if (!dry) *(u32x4*)p = o;
}

__device__ __forceinline__ void unpack8(const u32x4 w, float (&f)[8]) { const unsigned ww[4] = {w.x, w.y, w.z, w.w};
#pragma unroll
    for (int e = 0; e < 4; ++e) { f[2 * e] = __builtin_bit_cast(float, ww[e] << 16); f[2 * e + 1] = __builtin_bit_cast(float, ww[e] & 0xffff0000u); } }
__device__ __forceinline__ void prep_ckv4(const bf16* __restrict__ RB, bf16* __restrict__ CKVC, const float* __restrict__ kvn, int it, int lane) {
    const int t = it * 4 + (lane >> 4), c = lane & 15; const u32x4* src = (const u32x4*)(RB + (size_t)t * NB + B_CKV + c * 16); const u32x4 a = src[0], b = src[1];
    float v[16]; { float f[8]; unpack8(a, f);
#pragma unroll
        for (int e = 0; e < 8; ++e) v[e] = f[e]; unpack8(b, f);
#pragma unroll
        for (int e = 0; e < 8; ++e) v[8 + e] = f[e]; }
    float ss = 0.f;
#pragma unroll
    for (int e = 0; e < 16; ++e) ss += v[e] * v[e];
    ss += __shfl_xor(ss, 1); ss += __shfl_xor(ss, 2); ss += __shfl_xor(ss, 4); ss += __shfl_xor(ss, 8);
    const float r = 1.0f / sqrtf(ss * (1.0f / KV_R) + EPS); const f32x4* gp = (const f32x4*)(kvn + c * 16); float o[16];
#pragma unroll
    for (int q = 0; q < 4; ++q) { const f32x4 gg = gp[q]; o[4 * q] = v[4 * q] * r * gg.x; o[4 * q + 1] = v[4 * q + 1] * r * gg.y; o[4 * q + 2] = v[4 * q + 2] * r * gg.z; o[4 * q + 3] = v[4 * q + 3] * r * gg.w; }
    u32x4 w0, w1; w0.x = pk2(o[0], o[1]); w0.y = pk2(o[2], o[3]); w0.z = pk2(o[4], o[5]); w0.w = pk2(o[6], o[7]); w1.x = pk2(o[8], o[9]); w1.y = pk2(o[10], o[11]); w1.z = pk2(o[12], o[13]); w1.w = pk2(o[14], o[15]);
    u32x4* dst = (u32x4*)(CKVC + (size_t)t * KV_R + c * 16); dst[0] = w0; dst[1] = w1;
}
__device__ __forceinline__ void prep_ik16(const bf16* __restrict__ RB, bf16* __restrict__ IKC, const float* __restrict__ ikg, const float* __restrict__ ikb, int it, int lane) {
    const int t = it * 16 + (lane >> 2), c = lane & 3; const u32x4* src = (const u32x4*)(RB + (size_t)t * NB + B_IK + c * 16); const u32x4 a = src[0], b = src[1];
    float v[16]; { float f[8]; unpack8(a, f);
#pragma unroll
        for (int e = 0; e < 8; ++e) v[e] = f[e]; unpack8(b, f);
#pragma unroll
        for (int e = 0; e < 8; ++e) v[8 + e] = f[e]; }
    float s = 0.f;
#pragma unroll
    for (int e = 0; e < 16; ++e) s += v[e];
    s += __shfl_xor(s, 1); s += __shfl_xor(s, 2); const float mu = s * (1.0f / 64.0f); float q2 = 0.f;
#pragma unroll
    for (int e = 0; e < 16; ++e) { v[e] -= mu; q2 += v[e] * v[e]; }
    q2 += __shfl_xor(q2, 1); q2 += __shfl_xor(q2, 2); const float r = 1.0f / sqrtf(q2 * (1.0f / 64.0f) + EPS); float o[16];
#pragma unroll
    for (int e = 0; e < 16; ++e) o[e] = v[e] * r * ikg[c * 16 + e] + ikb[c * 16 + e];
    u32x4 w0, w1; w0.x = pk2(o[0], o[1]); w0.y = pk2(o[2], o[3]); w0.z = pk2(o[4], o[5]); w0.w = pk2(o[6], o[7]); w1.x = pk2(o[8], o[9]); w1.y = pk2(o[10], o[11]); w1.z = pk2(o[12], o[13]); w1.w = pk2(o[14], o[15]);
    u32x4* dst = (u32x4*)(IKC + (size_t)t * 64 + c * 16); dst[0] = w0; dst[1] = w1;
}
__device__ __forceinline__ void prep_bout(bf16* RA, const bf16* __restrict__ RB, const float* __restrict__ scw, int t, int lane, bool dry = false) {
    const int s = t & (SEQ - 1), c = lane * 8; float acc[8] = {0.f, 0.f, 0.f, 0.f, 0.f, 0.f, 0.f, 0.f};
    u32x4 cg[3], hb[3];
#pragma unroll
    for (int j = 0; j < 3; ++j) { const bool ok = (s - 2 + j) >= 0; const bf16* rr = RB + (size_t)(t - 2 + j) * NB; cg[j] = ok ? *(const u32x4*)(rr + B_CG + c) : (u32x4){0u, 0u, 0u, 0u}; hb[j] = ok ? *(const u32x4*)(rr + B_HB + c) : (u32x4){0u, 0u, 0u, 0u}; }
    bf16* ra = RA + (size_t)t * NA + A_BG + c; const u32x4 bg = *(const u32x4*)ra;
#pragma unroll
    for (int j = 0; j < 3; ++j) { float a[8], b[8]; unpack8(cg[j], a); unpack8(hb[j], b); const f32x4 w0 = *(const f32x4*)(scw + j * 512 + c), w1 = *(const f32x4*)(scw + j * 512 + c + 4);
        acc[0] += w0.x * (a[0] * b[0]); acc[1] += w0.y * (a[1] * b[1]); acc[2] += w0.z * (a[2] * b[2]); acc[3] += w0.w * (a[3] * b[3]);
        acc[4] += w1.x * (a[4] * b[4]); acc[5] += w1.y * (a[5] * b[5]); acc[6] += w1.z * (a[6] * b[6]); acc[7] += w1.w * (a[7] * b[7]); }
    float g8[8]; unpack8(bg, g8); u32x4 w; w.x = pk2(g8[0] * acc[0], g8[1] * acc[1]); w.y = pk2(g8[2] * acc[2], g8[3] * acc[3]); w.z = pk2(g8[4] * acc[4], g8[5] * acc[5]); w.w = pk2(g8[6] * acc[6], g8[7] * acc[7]);
    if (!dry) *(u32x4*)ra = w;
}
__device__ __forceinline__ void prep_conv(const bf16* __restrict__ RB, bf16* __restrict__ XA, const float* __restrict__ cw, const float* __restrict__ cb, int it, int lane) {
    const int rb = it / 12, cbk = it % 12, xcol = cbk * 128 + 2 * lane, t0 = rb * 16, s0 = t0 & (SEQ - 1);
    float w0[4], w1[4];
#pragma unroll
    for (int j = 0; j < 4; ++j) { w0[j] = cw[j * XBC + xcol]; w1[j] = cw[j * XBC + xcol + 1]; }
    const float cb0 = cb[xcol], cb1 = cb[xcol + 1];
    const bf16* src = RB + (size_t)(t0 - 3) * NB + B_XBC + xcol; unsigned raw[19];
#pragma unroll
    for (int i = 0; i < 19; ++i) raw[i] = (s0 - 3 + i >= 0) ? *(const unsigned*)(src + (size_t)i * NB) : 0u;
#pragma unroll
    for (int i = 0; i < 16; ++i) { float a0 = cb0, a1 = cb1;
#pragma unroll
        for (int j = 0; j < 4; ++j) { a0 += w0[j] * __builtin_bit_cast(float, raw[i + j] << 16); a1 += w1[j] * __builtin_bit_cast(float, raw[i + j] & 0xffff0000u); }
        *(unsigned*)(XA + (size_t)(t0 + i) * XBC + xcol) = pk2(siluf_(a0), siluf_(a1)); }
}

typedef short bf16x8_t __attribute__((ext_vector_type(8)));
#ifndef SEL_REP_SEARCH
#define SEL_REP_SEARCH 1
#endif
#ifndef SEL_REP_STAGE
#define SEL_REP_STAGE 1
#endif
#define CNT8_GE(cnt, v0, v1, v2, v3, v4, v5, v6, v7, cand) do { unsigned long long m0_, m1_, m2_, m3_, m4_, m5_, m6_, m7_; \
    asm("v_cmp_ge_u32_e64 %0, %8, %16\n\tv_cmp_ge_u32_e64 %1, %9, %16\n\tv_cmp_ge_u32_e64 %2, %10, %16\n\tv_cmp_ge_u32_e64 %3, %11, %16\n\t" \
        "v_cmp_ge_u32_e64 %4, %12, %16\n\tv_cmp_ge_u32_e64 %5, %13, %16\n\tv_cmp_ge_u32_e64 %6, %14, %16\n\tv_cmp_ge_u32_e64 %7, %15, %16" \
        : "=&s"(m0_), "=&s"(m1_), "=&s"(m2_), "=&s"(m3_), "=&s"(m4_), "=&s"(m5_), "=&s"(m6_), "=&s"(m7_) \
        : "v"(v0), "v"(v1), "v"(v2), "v"(v3), "v"(v4), "v"(v5), "v"(v6), "v"(v7), "s"(cand)); \
    cnt += (__popcll(m0_) + __popcll(m1_)) + (__popcll(m2_) + __popcll(m3_)) + (__popcll(m4_) + __popcll(m5_)) + (__popcll(m6_) + __popcll(m7_)); } while (0)
constexpr int SC_STRIDE = 516, SC_BUF = 16 * SC_STRIDE;
constexpr int IKW_OFF = 66560;
__device__ __forceinline__ void wg_select16(LDSP unsigned char* lds, const bf16* __restrict__ RB, const bf16* __restrict__ IKC, unsigned short* __restrict__ idx, int unit, int tid, bool dry = false, bool lds_out = false) {
    const int lane = tid & 63, wave = __builtin_amdgcn_readfirstlane(tid >> 6), g = lane >> 4, c = lane & 15;
    const int b = unit >> 8, qg = unit & 255, t0 = b * SEQ + qg * 16, nk = ((qg >> 2) + 1) << 6, nr = nk >> 6;
    LDSP unsigned* SC = (LDSP unsigned*)lds;
    bf16x8_t bq[4][2]; float iwq[4];
    { const bf16* qr = RB + (size_t)(t0 + c) * NB;
#pragma unroll
      for (int h = 0; h < 4; ++h) { bq[h][0] = *(const bf16x8_t*)(qr + B_IQ + h * 64 + g * 8); bq[h][1] = *(const bf16x8_t*)(qr + B_IQ + h * 64 + 32 + g * 8); iwq[h] = bf2f(qr[B_IW + h]) * 0.0625f; } }
    unsigned val[2][64];
#pragma unroll
    for (int r = 0; r < 64; ++r) { val[0][r] = 0u; val[1][r] = 0u; }
    const bf16* ikb = IKC + (size_t)b * SEQ * 64;
    LDSP unsigned char* ikw = lds + IKW_OFF + wave * 8192;
#define IK_DMA(stage) do { if ((stage) * 512 + wave * 64 < nk) { const bf16* src_ = ikb + (size_t)((stage) * 512 + wave * 64) * 64 + lane * 8; _Pragma("unroll") for (int pc_ = 0; pc_ < 8; ++pc_) \
        __builtin_amdgcn_global_load_lds((const unsigned*)(src_ + pc_ * 512), (LDSP unsigned*)(ikw + pc_ * 1024), 16, 0, 0); } } while (0)
    IK_DMA(0);
    for (int rep_st = 0; rep_st < SEL_REP_STAGE; ++rep_st) {
    if (rep_st > 0) { asm volatile("s_waitcnt vmcnt(0)" ::: "memory"); __builtin_amdgcn_s_barrier(); IK_DMA(0); }
#pragma unroll
    for (int s = 0; s < 8; ++s) {
        if (s * 512 < nk) {
            LDSP unsigned* buf = SC + (s & 1) * SC_BUF;
            asm volatile("s_waitcnt vmcnt(0)" ::: "memory");
            bf16x8_t af[4][2];
#pragma unroll
            for (int i = 0; i < 4; ++i) { af[i][0] = *(const LDSP bf16x8_t*)(ikw + (16 * i + c) * 128 + g * 16); af[i][1] = *(const LDSP bf16x8_t*)(ikw + (16 * i + c) * 128 + 64 + g * 16); }
            asm volatile("s_waitcnt lgkmcnt(0)" ::: "memory");
            if (s < 7) IK_DMA(s + 1);
#pragma unroll
            for (int i = 0; i < 4; ++i) { const int tl = wave * 4 + i, kb = s * 512 + tl * 16;
                if (kb < nk) {
                    const bf16x8_t a0 = af[i][0], a1 = af[i][1];
                    float sc[4] = {0.f, 0.f, 0.f, 0.f};
#pragma unroll
                    for (int h = 0; h < 4; ++h) { pg8::f32x4 acc = {0.f, 0.f, 0.f, 0.f};
                        acc = __builtin_amdgcn_mfma_f32_16x16x32_bf16(a0, bq[h][0], acc, 0, 0, 0); acc = __builtin_amdgcn_mfma_f32_16x16x32_bf16(a1, bq[h][1], acc, 0, 0, 0);
#pragma unroll
                        for (int e = 0; e < 4; ++e) sc[e] += fmaxf(acc[e], 0.f) * iwq[h]; }
                    u32x4 kv; kv.x = ord_key(sc[0]); kv.y = ord_key(sc[1]); kv.z = ord_key(sc[2]); kv.w = ord_key(sc[3]);
                    *(LDSP u32x4*)(buf + c * SC_STRIDE + tl * 16 + 4 * g) = kv; } }
            asm volatile("s_waitcnt lgkmcnt(0)" ::: "memory"); __builtin_amdgcn_s_barrier(); asm volatile("" ::: "memory");
#pragma unroll
            for (int j = 0; j < 8; ++j) if (s * 512 + j * 64 < nk) { val[0][s * 8 + j] = buf[(2 * wave) * SC_STRIDE + j * 64 + lane]; val[1][s * 8 + j] = buf[(2 * wave + 1) * SC_STRIDE + j * 64 + lane]; }
            asm volatile("s_waitcnt lgkmcnt(0)" ::: "memory");
        }
    }
    }
    const unsigned long long lt = (1ull << lane) - 1ull;
#pragma unroll
    for (int qq = 0; qq < 2; ++qq) {
        unsigned Tt = 0u;
        for (int rep_se = 0; rep_se < SEL_REP_SEARCH; ++rep_se) { Tt = 0u; asm volatile("" : "+v"(val[qq][0]));
        if (nk > TOPK) {
            for (int bit = 31; bit >= 0; --bit) { const unsigned cand = Tt | (1u << bit); int cnt = 0;
#pragma unroll
                for (int r8 = 0; r8 < 8; ++r8) if (r8 * 8 < nr) CNT8_GE(cnt, val[qq][r8 * 8], val[qq][r8 * 8 + 1], val[qq][r8 * 8 + 2], val[qq][r8 * 8 + 3], val[qq][r8 * 8 + 4], val[qq][r8 * 8 + 5], val[qq][r8 * 8 + 6], val[qq][r8 * 8 + 7], cand);
                if (cnt >= TOPK) Tt = cand; if (cnt == TOPK) break; }
        }
        }
        unsigned short* orow = idx + (size_t)(t0 + 2 * wave + qq) * TOPK;
        LDSP unsigned short* orow_l = (LDSP unsigned short*)(lds + 134 * 1024) + (2 * wave + qq) * TOPK;
        int pos = 0;
#define PUT_KEY(o_, key_) do { if ((o_) < TOPK && !dry) { if (lds_out) orow_l[o_] = (unsigned short)(key_); else orow[o_] = (unsigned short)(key_); } } while (0)
#pragma unroll
        for (int r8 = 0; r8 < 8; ++r8) if (r8 * 8 < nr) { unsigned long long k0, k1, k2, k3, k4, k5, k6, k7;
            asm("v_cmp_gt_u32_e64 %0, %8, %16\n\tv_cmp_gt_u32_e64 %1, %9, %16\n\tv_cmp_gt_u32_e64 %2, %10, %16\n\tv_cmp_gt_u32_e64 %3, %11, %16\n\t"
                "v_cmp_gt_u32_e64 %4, %12, %16\n\tv_cmp_gt_u32_e64 %5, %13, %16\n\tv_cmp_gt_u32_e64 %6, %14, %16\n\tv_cmp_gt_u32_e64 %7, %15, %16"
                : "=&s"(k0), "=&s"(k1), "=&s"(k2), "=&s"(k3), "=&s"(k4), "=&s"(k5), "=&s"(k6), "=&s"(k7)
                : "v"(val[qq][r8 * 8]), "v"(val[qq][r8 * 8 + 1]), "v"(val[qq][r8 * 8 + 2]), "v"(val[qq][r8 * 8 + 3]), "v"(val[qq][r8 * 8 + 4]), "v"(val[qq][r8 * 8 + 5]), "v"(val[qq][r8 * 8 + 6]), "v"(val[qq][r8 * 8 + 7]), "s"(Tt));
#define PUT_MASK(m_, i_) do { if ((m_) != 0ull) { if (((m_) >> lane) & 1ull) { const int o = pos + __popcll((m_) & lt); PUT_KEY(o, (r8 * 8 + (i_)) * 64 + lane); } pos += __popcll(m_); } } while (0)
            PUT_MASK(k0, 0); PUT_MASK(k1, 1); PUT_MASK(k2, 2); PUT_MASK(k3, 3); PUT_MASK(k4, 4); PUT_MASK(k5, 5); PUT_MASK(k6, 6); PUT_MASK(k7, 7);
#undef PUT_MASK
        }
        int need = TOPK - pos;
        if (need > 0) {
#pragma unroll
            for (int r = 0; r < 64; ++r) if (r < nr && need > 0) { const unsigned long long meq = __ballot(val[qq][r] == Tt);
                if (meq != 0ull) { const int rank = __popcll(meq & lt); if (((meq >> lane) & 1ull) && rank < need) { PUT_KEY(pos + rank, r * 64 + lane); } const int tk = __popcll(meq); const int tkn = tk < need ? tk : need; pos += tkn; need -= tkn; } }
        }
#undef PUT_KEY
    }
    asm volatile("s_waitcnt vmcnt(0) lgkmcnt(0)" ::: "memory"); __builtin_amdgcn_s_barrier();
#undef IK_DMA
}

typedef unsigned short u16x4_t __attribute__((ext_vector_type(4)));
#ifndef ATT_LOCAL_DRY
#define ATT_LOCAL_DRY 0
#endif
#ifndef ATT_STAGGER
#define ATT_STAGGER 0
#endif
#ifndef ATT_DRY_SKIP
#define ATT_DRY_SKIP 0
#endif
#define DSK(b) (ATT_DRY_SKIP & (b)) && dry
#ifndef ATT_SUB_EN
#define ATT_SUB_EN 0
#endif
constexpr int SELW_OFF = 134 * 1024, BT_OFF = 142 * 1024, KVP = 528, TILE_STRIDE = 32 * KVP;
constexpr int SELW_OFF_OLD = 132 * 1024, BT_OFF_OLD = 140 * 1024;
__device__ __forceinline__ int kv_off(int row, int ch) { const int hf = ch >> 4, c16 = ch & 15; return hf * 8192 + 256 * row + 16 * (c16 ^ (((row & 3) << 2) | ((row >> 2) & 3))); }
#define TR4I(d0, d1, d2, d3, base, o0, o1, o2, o3) asm volatile("ds_read_b64_tr_b16 %0, %4 offset:%5\n\tds_read_b64_tr_b16 %1, %4 offset:%6\n\tds_read_b64_tr_b16 %2, %4 offset:%7\n\tds_read_b64_tr_b16 %3, %4 offset:%8" \
    : "=&v"(d0), "=&v"(d1), "=&v"(d2), "=&v"(d3) : "v"(base), "i"(o0), "i"(o1), "i"(o2), "i"(o3) : "memory")
#define TR8N(d0, d1, d2, d3, d4, d5, d6, d7, base, o0, o1, o2, o3, o4, o5, o6, o7) asm volatile( \
    "ds_read_b64_tr_b16 %0, %8 offset:%9\n\tds_read_b64_tr_b16 %1, %8 offset:%10\n\tds_read_b64_tr_b16 %2, %8 offset:%11\n\tds_read_b64_tr_b16 %3, %8 offset:%12\n\t" \
    "ds_read_b64_tr_b16 %4, %8 offset:%13\n\tds_read_b64_tr_b16 %5, %8 offset:%14\n\tds_read_b64_tr_b16 %6, %8 offset:%15\n\tds_read_b64_tr_b16 %7, %8 offset:%16" \
    : "=&v"(d0), "=&v"(d1), "=&v"(d2), "=&v"(d3), "=&v"(d4), "=&v"(d5), "=&v"(d6), "=&v"(d7) : "v"(base), "i"(o0), "i"(o1), "i"(o2), "i"(o3), "i"(o4), "i"(o5), "i"(o6), "i"(o7) : "memory")
#define WAITPIN8(n, d0, d1, d2, d3, d4, d5, d6, d7) asm volatile("s_waitcnt lgkmcnt(" #n ")" : "+v"(d0), "+v"(d1), "+v"(d2), "+v"(d3), "+v"(d4), "+v"(d5), "+v"(d6), "+v"(d7) :: "memory")
#define WAITPIN4(n, d0, d1, d2, d3) asm volatile("s_waitcnt lgkmcnt(" #n ")" : "+v"(d0), "+v"(d1), "+v"(d2), "+v"(d3) :: "memory")
__device__ __forceinline__ bf16x8_t mk8a(u16x4_t a, u16x4_t b) { bf16x8_t r; r[0] = a[0]; r[1] = a[1]; r[2] = a[2]; r[3] = a[3]; r[4] = b[0]; r[5] = b[1]; r[6] = b[2]; r[7] = b[3]; return r; }
#define TR8I(d0, d1, d2, d3, d4, d5, d6, d7, base, o0, o1, o2, o3, o4, o5, o6, o7) asm volatile( \
    "ds_read_b64_tr_b16 %0, %8 offset:%9\n\tds_read_b64_tr_b16 %1, %8 offset:%10\n\tds_read_b64_tr_b16 %2, %8 offset:%11\n\tds_read_b64_tr_b16 %3, %8 offset:%12\n\t" \
    "ds_read_b64_tr_b16 %4, %8 offset:%13\n\tds_read_b64_tr_b16 %5, %8 offset:%14\n\tds_read_b64_tr_b16 %6, %8 offset:%15\n\tds_read_b64_tr_b16 %7, %8 offset:%16\n\ts_waitcnt lgkmcnt(0)" \
    : "=&v"(d0), "=&v"(d1), "=&v"(d2), "=&v"(d3), "=&v"(d4), "=&v"(d5), "=&v"(d6), "=&v"(d7) : "v"(base), "i"(o0), "i"(o1), "i"(o2), "i"(o3), "i"(o4), "i"(o5), "i"(o6), "i"(o7) : "memory")
#define TR8(d0, d1, d2, d3, d4, d5, d6, d7, a0, a1, a2, a3, a4, a5, a6, a7) asm volatile( \
    "ds_read_b64_tr_b16 %0, %8\n\tds_read_b64_tr_b16 %1, %9\n\tds_read_b64_tr_b16 %2, %10\n\tds_read_b64_tr_b16 %3, %11\n\t" \
    "ds_read_b64_tr_b16 %4, %12\n\tds_read_b64_tr_b16 %5, %13\n\tds_read_b64_tr_b16 %6, %14\n\tds_read_b64_tr_b16 %7, %15\n\ts_waitcnt lgkmcnt(0)" \
    : "=&v"(d0), "=&v"(d1), "=&v"(d2), "=&v"(d3), "=&v"(d4), "=&v"(d5), "=&v"(d6), "=&v"(d7) : "v"(a0), "v"(a1), "v"(a2), "v"(a3), "v"(a4), "v"(a5), "v"(a6), "v"(a7) : "memory")
__device__ __forceinline__ void wg_attn16(LDSP unsigned char* lds, bf16* RA, const bf16* __restrict__ CKVC, const unsigned short* __restrict__ idx, const bf16* __restrict__ WUK, const bf16* __restrict__ WUV,
                                          const float* __restrict__ rel_bias, int unit, int nxt_unit, int par, bool first, int tid, bool dry = false, int qmode = 0, bf16* qscr = nullptr) {
    const int lane = tid & 63, wave = __builtin_amdgcn_readfirstlane(tid >> 6), g = lane >> 4, c = lane & 15;
    const int b = unit >> 9, qg = unit & 511, t0 = b * SEQ + qg * 8, nk = ((qg >> 3) + 1) << 6, nsel = nk < TOPK ? nk : TOPK, ntile = nsel >> 5;
    LDSP unsigned char* QL = lds;
    LDSP unsigned char* tile = lds + wave * TILE_STRIDE;
    LDSP unsigned short* selw = (LDSP unsigned short*)(lds + SELW_OFF + (par * 8 + wave) * 512);
    LDSP unsigned short* selw_n = (LDSP unsigned short*)(lds + SELW_OFF + ((par ^ 1) * 8 + wave) * 512);
    if (first) { if (lane < 32) *((LDSP u32x4*)selw + lane) = *((const u32x4*)(idx + (size_t)(t0 + wave) * TOPK) + lane); }
    const bf16* kvb = CKVC + (size_t)b * SEQ * KV_R + g * 8;
    bf16x8_t kv0[8], kv1[8];
#define KV_LOAD(dst, key) do { const bf16* rp_ = kvb + (size_t)(key) * KV_R; _Pragma("unroll") for (int ks_ = 0; ks_ < 8; ++ks_) dst[ks_] = *(const bf16x8_t*)(rp_ + ks_ * 32); } while (0)
    int ka = (int)selw[c], kb = (int)selw[16 + c];
    KV_LOAD(kv0, ka); KV_LOAD(kv1, kb);
    bf16x8_t qf[8];
    if (qmode != 2) {
        const int h = wave; const bf16* qr = RA + (size_t)(t0 + (qmode == 1 ? c : (c & 7))) * NA + A_Q + h * 64 + g * 8;
        const bf16x8_t b0 = *(const bf16x8_t*)qr, b1 = *(const bf16x8_t*)(qr + 32);
        const bf16* wb = WUK + ((size_t)h * 256 + c) * 64 + g * 8;
#pragma unroll 4
        for (int rt = 0; rt < 16; ++rt) { const bf16x8_t a0 = *(const bf16x8_t*)(wb + rt * 16 * 64), a1 = *(const bf16x8_t*)(wb + rt * 16 * 64 + 32);
            pg8::f32x4 acc = {0.f, 0.f, 0.f, 0.f};
            acc = __builtin_amdgcn_mfma_f32_16x16x32_bf16(a0, b0, acc, 0, 0, 0); acc = __builtin_amdgcn_mfma_f32_16x16x32_bf16(a1, b1, acc, 0, 0, 0);
            u32x2 w; w.x = pk2(acc[0], acc[1]); w.y = pk2(acc[2], acc[3]);
            if (c < 8) *(LDSP u32x2*)(QL + (((c * 8 + h) * 256) + rt * 16 + 4 * g) * 2) = w;
            else if (qmode == 1) *(u32x2*)(qscr + ((((c - 8) * 8 + h) * 256) + rt * 16 + 4 * g)) = w; }
        asm volatile("s_waitcnt lgkmcnt(0)" ::: "memory"); __builtin_amdgcn_s_barrier(); asm volatile("" ::: "memory");
#pragma unroll
        for (int ks = 0; ks < 8; ++ks) qf[ks] = *(const LDSP bf16x8_t*)(QL + (((wave * 8 + (c & 7)) * 256) + ks * 32 + g * 8) * 2);
        asm volatile("s_waitcnt lgkmcnt(0)" ::: "memory"); __builtin_amdgcn_s_barrier(); asm volatile("" ::: "memory");
    } else {
        const unsigned long long* qs = (const unsigned long long*)(qscr + (((wave * 8 + (c & 7)) * 256) + g * 8));
#pragma unroll
        for (int ks = 0; ks < 8; ++ks) { const unsigned long long lo = __hip_atomic_load(qs + ks * 8, __ATOMIC_RELAXED, __HIP_MEMORY_SCOPE_AGENT), hi = __hip_atomic_load(qs + ks * 8 + 1, __ATOMIC_RELAXED, __HIP_MEMORY_SCOPE_AGENT);
            u32x4 w; w.x = (unsigned)lo; w.y = (unsigned)(lo >> 32); w.z = (unsigned)hi; w.w = (unsigned)(hi >> 32); qf[ks] = __builtin_bit_cast(bf16x8_t, w); }
    }
    const unsigned tile_a = (unsigned)(size_t)tile;
#if ATT_STAGGER
    if (wave >= 4) __builtin_amdgcn_s_sleep(ATT_STAGGER);
#endif
    bf16x8_t bbf; { float bv[8];
#pragma unroll
        for (int j = 0; j < 8; ++j) bv[j] = rel_bias[(8 * g + j) * 8 + (c & 7)];
        u32x4 w; w.x = pk2(bv[0], bv[1]); w.y = pk2(bv[2], bv[3]); w.z = pk2(bv[4], bv[5]); w.w = pk2(bv[6], bv[7]); bbf = __builtin_bit_cast(bf16x8_t, w); }
    {
        const int spos = (qg * 8 + wave);
        pg8::f32x4 acc[16];
#pragma unroll
        for (int nt = 0; nt < 16; ++nt) acc[nt] = (pg8::f32x4){0.f, 0.f, 0.f, 0.f};
        float m_run = -INFINITY, l_run = 0.f;
#define ONEHOT(dst, key) do { const int rel_ = (key) - spos, n_ = rel_ < 0 ? -rel_ : rel_; \
            const int big_ = 8 + (n_ >= 15) + (n_ >= 27) + (n_ >= 50) + (n_ >= 91) + (n_ >= 166) + (n_ >= 305) + (n_ >= 559); \
            const int pos_ = (n_ < 8 ? n_ : big_) + (rel_ > 0 ? 16 : 0) - 8 * g; const unsigned one_ = (pos_ & 1) ? 0x3F800000u : 0x3F80u; const int hi_ = pos_ >> 1; \
            u32x4 w_; w_.x = (hi_ == 0) ? one_ : 0u; w_.y = (hi_ == 1) ? one_ : 0u; w_.z = (hi_ == 2) ? one_ : 0u; w_.w = (hi_ == 3) ? one_ : 0u; dst = __builtin_bit_cast(bf16x8_t, w_); } while (0)
        const int q4 = c >> 2, p = c & 3;
        const unsigned trb = tile_a + (4 * g + q4) * KVP + 8 * p;
        for (int tl = 0; tl < ntile; ++tl) {
            int kan = 0, kbn = 0; const bool more = tl + 1 < ntile;
            if (more) { kan = (int)selw[(2 * tl + 2) * 16 + c]; kbn = (int)selw[(2 * tl + 3) * 16 + c]; }
            bf16x8_t oha, ohb; ONEHOT(oha, ka); ONEHOT(ohb, kb);
            asm volatile("s_waitcnt vmcnt(8)" ::: "memory");
            pg8::f32x4 s0 = {0.f, 0.f, 0.f, 0.f}, s1 = {0.f, 0.f, 0.f, 0.f};
            s0 = __builtin_amdgcn_mfma_f32_16x16x32_bf16(oha, bbf, s0, 0, 0, 0);
#pragma unroll
            for (int ks = 0; ks < 8; ++ks) { s0 = __builtin_amdgcn_mfma_f32_16x16x32_bf16(kv0[ks], qf[ks], s0, 0, 0, 0); *(LDSP bf16x8_t*)(tile + c * KVP + g * 16 + ks * 64) = kv0[ks]; }
            if (more) KV_LOAD(kv0, kan);
            if (more) asm volatile("s_waitcnt vmcnt(8)" ::: "memory"); else asm volatile("s_waitcnt vmcnt(0)" ::: "memory");
            s1 = __builtin_amdgcn_mfma_f32_16x16x32_bf16(ohb, bbf, s1, 0, 0, 0);
#pragma unroll
            for (int ks = 0; ks < 8; ++ks) { s1 = __builtin_amdgcn_mfma_f32_16x16x32_bf16(kv1[ks], qf[ks], s1, 0, 0, 0); *(LDSP bf16x8_t*)(tile + (16 + c) * KVP + g * 16 + ks * 64) = kv1[ks]; }
            if (more) KV_LOAD(kv1, kbn);
            ka = kan; kb = kbn;
            float sv[8];
#pragma unroll
            for (int j = 0; j < 4; ++j) { sv[j] = s0[j]; sv[4 + j] = s1[j]; }
            float tmax = fmaxf(fmaxf(fmaxf(sv[0], sv[1]), fmaxf(sv[2], sv[3])), fmaxf(fmaxf(sv[4], sv[5]), fmaxf(sv[6], sv[7])));
            tmax = fmaxf(tmax, __shfl_xor(tmax, 16)); tmax = fmaxf(tmax, __shfl_xor(tmax, 32));
            const float m_new = fmaxf(m_run, tmax); const float scl = __expf(m_run - m_new); const bool grow = m_new > m_run; m_run = m_new;
            float ps = 0.f;
#pragma unroll
            for (int j = 0; j < 8; ++j) { sv[j] = __expf(sv[j] - m_new); ps += sv[j]; }
            l_run = l_run * scl + ps;
            bf16x8_t pf; { u32x4 w; w.x = pk2(sv[0], sv[1]); w.y = pk2(sv[2], sv[3]); w.z = pk2(sv[4], sv[5]); w.w = pk2(sv[6], sv[7]); pf = __builtin_bit_cast(bf16x8_t, w); }
            if (__builtin_amdgcn_ballot_w64(grow) != 0ull) {
                float rs[4];
#pragma unroll
                for (int e = 0; e < 4; ++e) rs[e] = __shfl(scl, 4 * g + e);
#pragma unroll
                for (int nt = 0; nt < 16; ++nt) {
#pragma unroll
                    for (int e = 0; e < 4; ++e) acc[nt][e] *= rs[e]; } }
            asm volatile("s_waitcnt lgkmcnt(0)" ::: "memory");
            u16x4_t va[8], vb[8];
            TR8N(va[0], va[1], va[2], va[3], va[4], va[5], va[6], va[7], trb, 0, 16 * KVP, 32, 32 + 16 * KVP, 64, 64 + 16 * KVP, 96, 96 + 16 * KVP);
            TR8N(vb[0], vb[1], vb[2], vb[3], vb[4], vb[5], vb[6], vb[7], trb, 128, 128 + 16 * KVP, 160, 160 + 16 * KVP, 192, 192 + 16 * KVP, 224, 224 + 16 * KVP);
            WAITPIN8(8, va[0], va[1], va[2], va[3], va[4], va[5], va[6], va[7]);
#pragma unroll
            for (int k = 0; k < 4; ++k) acc[k] = __builtin_amdgcn_mfma_f32_16x16x32_bf16(pf, mk8a(va[2 * k], va[2 * k + 1]), acc[k], 0, 0, 0);
            TR8N(va[0], va[1], va[2], va[3], va[4], va[5], va[6], va[7], trb, 256, 256 + 16 * KVP, 288, 288 + 16 * KVP, 320, 320 + 16 * KVP, 352, 352 + 16 * KVP);
            WAITPIN8(8, vb[0], vb[1], vb[2], vb[3], vb[4], vb[5], vb[6], vb[7]);
#pragma unroll
            for (int k = 0; k < 4; ++k) acc[4 + k] = __builtin_amdgcn_mfma_f32_16x16x32_bf16(pf, mk8a(vb[2 * k], vb[2 * k + 1]), acc[4 + k], 0, 0, 0);
            TR8N(vb[0], vb[1], vb[2], vb[3], vb[4], vb[5], vb[6], vb[7], trb, 384, 384 + 16 * KVP, 416, 416 + 16 * KVP, 448, 448 + 16 * KVP, 480, 480 + 16 * KVP);
            WAITPIN8(8, va[0], va[1], va[2], va[3], va[4], va[5], va[6], va[7]);
#pragma unroll
            for (int k = 0; k < 4; ++k) acc[8 + k] = __builtin_amdgcn_mfma_f32_16x16x32_bf16(pf, mk8a(va[2 * k], va[2 * k + 1]), acc[8 + k], 0, 0, 0);
            WAITPIN8(0, vb[0], vb[1], vb[2], vb[3], vb[4], vb[5], vb[6], vb[7]);
#pragma unroll
            for (int k = 0; k < 4; ++k) acc[12 + k] = __builtin_amdgcn_mfma_f32_16x16x32_bf16(pf, mk8a(vb[2 * k], vb[2 * k + 1]), acc[12 + k], 0, 0, 0);
        }
#undef KV_LOAD
#undef ONEHOT
        float lt = l_run + __shfl_xor(l_run, 16); lt += __shfl_xor(lt, 32); const float inv = 1.0f / lt;
        float ri[4];
#pragma unroll
        for (int e = 0; e < 4; ++e) ri[e] = __shfl(inv, 4 * g + e);
        if (g < 2) {
#pragma unroll
            for (int nt = 0; nt < 16; ++nt) { LDSP unsigned short* o1 = (LDSP unsigned short*)(tile) + (4 * g) * 256 + nt * 16 + c;
                o1[0] = f2bf(acc[nt][0] * ri[0]); o1[256] = f2bf(acc[nt][1] * ri[1]); o1[512] = f2bf(acc[nt][2] * ri[2]); o1[768] = f2bf(acc[nt][3] * ri[3]); }
        }
    }
    u32x4 nsel_v = {0u, 0u, 0u, 0u};
    if (nxt_unit >= 0 && lane < 32) { const int nb = nxt_unit >> 9, nq = nxt_unit & 511; nsel_v = *((const u32x4*)(idx + (size_t)(nb * SEQ + nq * 8 + wave) * TOPK) + lane); }
    asm volatile("s_waitcnt lgkmcnt(0)" ::: "memory"); __builtin_amdgcn_s_barrier(); asm volatile("" ::: "memory");
    if (qmode == 1) {
        bf16* oscr = qscr + 16384;
#pragma unroll
        for (int j = 0; j < 4; ++j) *((u32x4*)(oscr + (size_t)wave * 2048) + j * 64 + lane) = *((const LDSP u32x4*)(tile) + j * 64 + lane);
    } else {
        const int h = wave; pg8::f32x4 o[4];
#pragma unroll
        for (int nt = 0; nt < 4; ++nt) o[nt] = (pg8::f32x4){0.f, 0.f, 0.f, 0.f};
        const LDSP unsigned char* ab = lds + TILE_STRIDE * (c & 7) + (h * 256 + g * 8) * 2;
        const unsigned long long* os = (const unsigned long long*)(qscr + 16384 + ((c & 7) * 8 + h) * 256 + g * 8);
        const bf16* wb = WUV + ((size_t)h * 64 + c) * 256 + g * 8;
        const bool from_scr = (qmode == 2) && (c < 8);
#pragma unroll
        for (int ks = 0; ks < 8; ++ks) { bf16x8_t a;
            if (from_scr) { const unsigned long long lo = __hip_atomic_load(os + ks * 8, __ATOMIC_RELAXED, __HIP_MEMORY_SCOPE_AGENT), hi = __hip_atomic_load(os + ks * 8 + 1, __ATOMIC_RELAXED, __HIP_MEMORY_SCOPE_AGENT);
                u32x4 w; w.x = (unsigned)lo; w.y = (unsigned)(lo >> 32); w.z = (unsigned)hi; w.w = (unsigned)(hi >> 32); a = __builtin_bit_cast(bf16x8_t, w); }
            else a = *(const LDSP bf16x8_t*)(ab + ks * 64);
#pragma unroll
            for (int nt = 0; nt < 4; ++nt) { const bf16x8_t bw = *(const bf16x8_t*)(wb + (size_t)nt * 16 * 256 + ks * 32); o[nt] = __builtin_amdgcn_mfma_f32_16x16x32_bf16(a, bw, o[nt], 0, 0, 0); } }
        const int rbase = (qmode == 2) ? t0 - 8 : t0;
        if ((g < 2 || qmode == 2) && !dry) {
#pragma unroll
            for (int nt = 0; nt < 4; ++nt)
#pragma unroll
                for (int e = 0; e < 4; ++e) RA[(size_t)(rbase + 4 * g + e) * NA + A_Q + h * 64 + nt * 16 + c] = f2bf(o[nt][e]); }
    }
    if (nxt_unit >= 0 && lane < 32) *((LDSP u32x4*)selw_n + lane) = nsel_v;
    asm volatile("s_waitcnt vmcnt(0) lgkmcnt(0)" ::: "memory"); __builtin_amdgcn_s_barrier(); asm volatile("" ::: "memory");
}

template <int VAR = 0> __device__ __forceinline__ void wg_attn16d(LDSP unsigned char* lds, bf16* RA, const bf16* __restrict__ CKVC, const unsigned short* __restrict__ idx, const bf16* __restrict__ WUK, const bf16* __restrict__ WUV,
                                          const float* __restrict__ rel_bias, int unit, int nxt_unit, int par, bool first, int tid, bool dry = false, int qmode = 0, bf16* qscr = nullptr) {
    const int lane = tid & 63, wave = __builtin_amdgcn_readfirstlane(tid >> 6), g = lane >> 4, c = lane & 15;
    const int b = unit >> 9, qg = unit & 511, t0 = b * SEQ + qg * 8, nk = ((qg >> 3) + 1) << 6, nsel = nk < TOPK ? nk : TOPK, ntile = nsel >> 5;
    LDSP unsigned char* QL = lds;
    LDSP unsigned char* tile = lds + wave * TILE_STRIDE;
    LDSP unsigned short* selw = (LDSP unsigned short*)(lds + SELW_OFF + (par * 8 + wave) * 512);
    LDSP unsigned short* selw_n = (LDSP unsigned short*)(lds + SELW_OFF + ((par ^ 1) * 8 + wave) * 512);
    if (first) { if (lane < 32) *((LDSP u32x4*)selw + lane) = *((const u32x4*)(idx + (size_t)(t0 + wave) * TOPK) + lane); }
    const bf16* kvb = CKVC + (size_t)b * SEQ * KV_R;
    const int nstep = (VAR & 64) ? 0 : (nsel >> 4);
    constexpr bool halfdma = (VAR & 1) != 0, nodma = (VAR & 2) != 0, nolds = (VAR & 4) != 0, nopv = (VAR & 8) != 0, noqk = (VAR & 16) != 0, nosm = (VAR & 32) != 0;
#define KV_DMA(step) do { if (nodma) break; LDSP unsigned char* sl_ = tile + ((step) & 1) * 8192; \
        _Pragma("unroll") for (int i4_ = 0; i4_ < 4; ++i4_) { const int row_ = 4 * i4_ + g; const int key_ = (int)selw[(step) * 16 + row_]; const int c16_ = c ^ ((g << 2) | i4_); \
            const bf16* src_ = kvb + (size_t)key_ * KV_R + c16_ * 8; \
            __builtin_amdgcn_global_load_lds((const unsigned*)src_, (LDSP unsigned*)(sl_ + 1024 * i4_), 16, 0, 0); \
            if (!halfdma) __builtin_amdgcn_global_load_lds((const unsigned*)(src_ + 128), (LDSP unsigned*)(sl_ + 4096 + 1024 * i4_), 16, 0, 0); } } while (0)
    if (nstep > 0) KV_DMA(0);
    bf16x8_t qf[8];
    if (qmode != 2) {
        const int h = wave; const bf16* qr = RA + (size_t)(t0 + (qmode == 1 ? c : (c & 7))) * NA + A_Q + h * 64 + g * 8;
        const bf16x8_t b0 = *(const bf16x8_t*)qr, b1 = *(const bf16x8_t*)(qr + 32);
        const bf16* wb = WUK + ((size_t)h * 256 + c) * 64 + g * 8;
#pragma unroll 4
        for (int rt = 0; rt < 16; ++rt) { const bf16x8_t a0 = *(const bf16x8_t*)(wb + rt * 16 * 64), a1 = *(const bf16x8_t*)(wb + rt * 16 * 64 + 32);
            pg8::f32x4 acc = {0.f, 0.f, 0.f, 0.f};
            acc = __builtin_amdgcn_mfma_f32_16x16x32_bf16(a0, b0, acc, 0, 0, 0); acc = __builtin_amdgcn_mfma_f32_16x16x32_bf16(a1, b1, acc, 0, 0, 0);
            u32x2 w; w.x = pk2(acc[0], acc[1]); w.y = pk2(acc[2], acc[3]);
            if (c < 8) *(LDSP u32x2*)(lds + c * TILE_STRIDE + 8192 + ((h * 256) + rt * 16 + 4 * g) * 2) = w;
            else if (qmode == 1) *(u32x2*)(qscr + ((((c - 8) * 8 + h) * 256) + rt * 16 + 4 * g)) = w; }
        asm volatile("s_waitcnt lgkmcnt(0)" ::: "memory"); __builtin_amdgcn_s_barrier(); asm volatile("" ::: "memory");
#pragma unroll
        for (int ks = 0; ks < 8; ++ks) qf[ks] = *(const LDSP bf16x8_t*)(tile + 8192 + (((c & 7) * 256) + ks * 32 + g * 8) * 2);
        asm volatile("s_waitcnt lgkmcnt(0)" ::: "memory");
    } else {
        const unsigned long long* qs = (const unsigned long long*)(qscr + (((wave * 8 + (c & 7)) * 256) + g * 8));
#pragma unroll
        for (int ks = 0; ks < 8; ++ks) { const unsigned long long lo = __hip_atomic_load(qs + ks * 8, __ATOMIC_RELAXED, __HIP_MEMORY_SCOPE_AGENT), hi = __hip_atomic_load(qs + ks * 8 + 1, __ATOMIC_RELAXED, __HIP_MEMORY_SCOPE_AGENT);
            u32x4 w; w.x = (unsigned)lo; w.y = (unsigned)(lo >> 32); w.z = (unsigned)hi; w.w = (unsigned)(hi >> 32); qf[ks] = __builtin_bit_cast(bf16x8_t, w); }
    }
    const unsigned tile_a = (unsigned)(size_t)tile;
#if ATT_STAGGER
    if (wave >= 4) __builtin_amdgcn_s_sleep(ATT_STAGGER);
#endif
    bf16x8_t bbf; { float bv[8];
#pragma unroll
        for (int j = 0; j < 8; ++j) bv[j] = rel_bias[(8 * g + j) * 8 + (c & 7)];
        u32x4 w; w.x = pk2(bv[0], bv[1]); w.y = pk2(bv[2], bv[3]); w.z = pk2(bv[4], bv[5]); w.w = pk2(bv[6], bv[7]); bbf = __builtin_bit_cast(bf16x8_t, w); }
    {
        const int spos = (qg * 8 + wave);
        pg8::f32x4 acc[16];
#pragma unroll
        for (int nt = 0; nt < 16; ++nt) acc[nt] = (pg8::f32x4){0.f, 0.f, 0.f, 0.f};
        float m_run = -INFINITY, l_run = 0.f;
#define ONEHOT(dst, key) do { const int rel_ = (key) - spos, n_ = rel_ < 0 ? -rel_ : rel_; \
            const int big_ = 8 + (n_ >= 15) + (n_ >= 27) + (n_ >= 50) + (n_ >= 91) + (n_ >= 166) + (n_ >= 305) + (n_ >= 559); \
            const int pos_ = (n_ < 8 ? n_ : big_) + (rel_ > 0 ? 16 : 0) - 8 * g; const unsigned one_ = (pos_ & 1) ? 0x3F800000u : 0x3F80u; const int hi_ = pos_ >> 1; \
            u32x4 w_; w_.x = (hi_ == 0) ? one_ : 0u; w_.y = (hi_ == 1) ? one_ : 0u; w_.z = (hi_ == 2) ? one_ : 0u; w_.w = (hi_ == 3) ? one_ : 0u; dst = __builtin_bit_cast(bf16x8_t, w_); } while (0)
        const int q4 = c >> 2, p = c & 3;
        const unsigned rd0 = tile_a + 256 * c + 16 * (g ^ (c >> 2)); const unsigned rx = (unsigned)(c & 3);
        const unsigned tr0 = tile_a + 256 * (4 * g + q4) + 8 * (p & 1); const unsigned ts = (unsigned)(((q4 << 2) | g)), tb0 = (unsigned)(p >> 1);
        if (nstep > 1) KV_DMA(1);
        for (int st = 0; st < nstep; ++st) {
            const unsigned so = (unsigned)((st & 1) * 8192);
            const int key = (int)selw[st * 16 + c];
            bf16x8_t oh; ONEHOT(oh, key);
            if (st + 1 < nstep) { if (nodma) {} else if (halfdma) asm volatile("s_waitcnt vmcnt(4)" ::: "memory"); else asm volatile("s_waitcnt vmcnt(8)" ::: "memory"); } else asm volatile("s_waitcnt vmcnt(0)" ::: "memory");
            bf16x8_t af[8]; u16x4_t v[16];
#pragma unroll
            for (int ks = 0; ks < 8; ++ks) { if (nolds) af[ks] = qf[ks]; else af[ks] = *(const LDSP bf16x8_t*)(size_t)(rd0 + so + (ks >> 2) * 4096 + 64 * (((unsigned)(ks & 3)) ^ rx)); }
#pragma unroll
            for (int n4 = 0; n4 < 4; ++n4) { unsigned ad[4]; if (nolds) { v[n4 * 4] = v[n4 * 4 + 1] = v[n4 * 4 + 2] = v[n4 * 4 + 3] = (u16x4_t){(unsigned short)st, 1, 2, 3}; continue; }
#pragma unroll
                for (int k = 0; k < 4; ++k) { const unsigned nt = (unsigned)(n4 * 4 + k); ad[k] = tr0 + so + (nt >> 3) * 4096 + 16 * ((((nt & 7) << 1) | tb0) ^ ts); }
                asm volatile("ds_read_b64_tr_b16 %0, %4\n\tds_read_b64_tr_b16 %1, %5\n\tds_read_b64_tr_b16 %2, %6\n\tds_read_b64_tr_b16 %3, %7" : "=&v"(v[n4 * 4]), "=&v"(v[n4 * 4 + 1]), "=&v"(v[n4 * 4 + 2]), "=&v"(v[n4 * 4 + 3]) : "v"(ad[0]), "v"(ad[1]), "v"(ad[2]), "v"(ad[3]) : "memory"); }
            WAITPIN4(0, v[0], v[1], v[2], v[3]); WAITPIN4(0, v[4], v[5], v[6], v[7]); WAITPIN4(0, v[8], v[9], v[10], v[11]); WAITPIN4(0, v[12], v[13], v[14], v[15]);
            if (st + 2 < nstep) KV_DMA(st + 2);
            pg8::f32x4 s0 = {0.f, 0.f, 0.f, 0.f};
            s0 = __builtin_amdgcn_mfma_f32_16x16x32_bf16(oh, bbf, s0, 0, 0, 0);
#pragma unroll
            for (int ks = 0; ks < 8; ++ks) { if (noqk) { if (ks == 0) s0[0] += __builtin_bit_cast(float, ((unsigned)af[0][0] << 16) ^ ((unsigned)af[1][1] << 16) ^ ((unsigned)af[2][1] << 16) ^ ((unsigned)af[3][1] << 16) ^ ((unsigned)af[4][1] << 16) ^ ((unsigned)af[5][1] << 16) ^ ((unsigned)af[6][1] << 16) ^ ((unsigned)af[7][1] << 16)); } else s0 = __builtin_amdgcn_mfma_f32_16x16x32_bf16(af[ks], qf[ks], s0, 0, 0, 0); }
            float tmax = fmaxf(fmaxf(s0[0], s0[1]), fmaxf(s0[2], s0[3]));
            if (!nosm) { tmax = fmaxf(tmax, __shfl_xor(tmax, 16)); tmax = fmaxf(tmax, __shfl_xor(tmax, 32)); }
            const float m_new = fmaxf(m_run, tmax); const float scl = __expf(m_run - m_new); const bool grow = m_new > m_run; m_run = m_new;
            float sv[4]; float ps = 0.f;
#pragma unroll
            for (int j = 0; j < 4; ++j) { sv[j] = __expf(s0[j] - m_new); ps += sv[j]; }
            l_run = l_run * scl + ps;
            typedef short bf16x4_t __attribute__((ext_vector_type(4)));
            bf16x4_t pf; { u32x2 w; w.x = pk2(sv[0], sv[1]); w.y = pk2(sv[2], sv[3]); pf = __builtin_bit_cast(bf16x4_t, w); }
            if (__builtin_amdgcn_ballot_w64(grow) != 0ull) {
                float rs[4];
#pragma unroll
                for (int e = 0; e < 4; ++e) rs[e] = __shfl(scl, 4 * g + e);
#pragma unroll
                for (int nt = 0; nt < 16; ++nt) {
#pragma unroll
                    for (int e = 0; e < 4; ++e) acc[nt][e] *= rs[e]; } }
#pragma unroll
            for (int k = 0; k < 16; ++k) { if (nopv) { acc[k][0] += __builtin_bit_cast(float, (unsigned)v[k][0] << 16) * sv[0]; } else acc[k] = __builtin_amdgcn_mfma_f32_16x16x16bf16_1k(pf, __builtin_bit_cast(bf16x4_t, v[k]), acc[k], 0, 0, 0); }
        }
#undef KV_DMA
#undef ONEHOT
        float lt = l_run + __shfl_xor(l_run, 16); lt += __shfl_xor(lt, 32); const float inv = 1.0f / lt;
        float ri[4];
#pragma unroll
        for (int e = 0; e < 4; ++e) ri[e] = __shfl(inv, 4 * g + e);
        if (g < 2) {
#pragma unroll
            for (int nt = 0; nt < 16; ++nt) { LDSP unsigned short* o1 = (LDSP unsigned short*)(tile) + (4 * g) * 256 + nt * 16 + c;
                o1[0] = f2bf(acc[nt][0] * ri[0]); o1[256] = f2bf(acc[nt][1] * ri[1]); o1[512] = f2bf(acc[nt][2] * ri[2]); o1[768] = f2bf(acc[nt][3] * ri[3]); }
        }
    }
    u32x4 nsel_v = {0u, 0u, 0u, 0u};
    if (nxt_unit >= 0 && lane < 32) { const int nb = nxt_unit >> 9, nq = nxt_unit & 511; nsel_v = *((const u32x4*)(idx + (size_t)(nb * SEQ + nq * 8 + wave) * TOPK) + lane); }
    asm volatile("s_waitcnt lgkmcnt(0)" ::: "memory"); __builtin_amdgcn_s_barrier(); asm volatile("" ::: "memory");
    if (qmode == 1) {
        bf16* oscr = qscr + 16384;
#pragma unroll
        for (int j = 0; j < 4; ++j) *((u32x4*)(oscr + (size_t)wave * 2048) + j * 64 + lane) = *((const LDSP u32x4*)(tile) + j * 64 + lane);
    } else {
        const int h = wave; pg8::f32x4 o[4];
#pragma unroll
        for (int nt = 0; nt < 4; ++nt) o[nt] = (pg8::f32x4){0.f, 0.f, 0.f, 0.f};
        const LDSP unsigned char* ab = lds + TILE_STRIDE * (c & 7) + (h * 256 + g * 8) * 2;
        const unsigned long long* os = (const unsigned long long*)(qscr + 16384 + ((c & 7) * 8 + h) * 256 + g * 8);
        const bf16* wb = WUV + ((size_t)h * 64 + c) * 256 + g * 8;
        const bool from_scr = (qmode == 2) && (c < 8);
#pragma unroll
        for (int ks = 0; ks < 8; ++ks) { bf16x8_t a;
            if (from_scr) { const unsigned long long lo = __hip_atomic_load(os + ks * 8, __ATOMIC_RELAXED, __HIP_MEMORY_SCOPE_AGENT), hi = __hip_atomic_load(os + ks * 8 + 1, __ATOMIC_RELAXED, __HIP_MEMORY_SCOPE_AGENT);
                u32x4 w; w.x = (unsigned)lo; w.y = (unsigned)(lo >> 32); w.z = (unsigned)hi; w.w = (unsigned)(hi >> 32); a = __builtin_bit_cast(bf16x8_t, w); }
            else a = *(const LDSP bf16x8_t*)(ab + ks * 64);
#pragma unroll
            for (int nt = 0; nt < 4; ++nt) { const bf16x8_t bw = *(const bf16x8_t*)(wb + (size_t)nt * 16 * 256 + ks * 32); o[nt] = __builtin_amdgcn_mfma_f32_16x16x32_bf16(a, bw, o[nt], 0, 0, 0); } }
        const int rbase = (qmode == 2) ? t0 - 8 : t0;
        if ((g < 2 || qmode == 2) && !dry) {
#pragma unroll
            for (int nt = 0; nt < 4; ++nt)
#pragma unroll
                for (int e = 0; e < 4; ++e) RA[(size_t)(rbase + 4 * g + e) * NA + A_Q + h * 64 + nt * 16 + c] = f2bf(o[nt][e]); }
    }
    if (nxt_unit >= 0 && lane < 32) *((LDSP u32x4*)selw_n + lane) = nsel_v;
    asm volatile("s_waitcnt vmcnt(0) lgkmcnt(0)" ::: "memory"); __builtin_amdgcn_s_barrier(); asm volatile("" ::: "memory");
}

#define QLS_PTR(t) (RB + (size_t)(t) * NB + 1024)
__device__ __forceinline__ void wg_qlat_all(const bf16* RA, bf16* RB, const bf16* __restrict__ WUK, int blk, int G, int tid) {
    const int lane = tid & 63, wave = __builtin_amdgcn_readfirstlane(tid >> 6), g = lane >> 4, c = lane & 15, h = wave;
    const bf16* wb = WUK + ((size_t)h * 256 + c) * 64 + g * 8;
    bf16x8_t a0[16], a1[16];
#pragma unroll
    for (int rt = 0; rt < 16; ++rt) { a0[rt] = *(const bf16x8_t*)(wb + rt * 16 * 64); a1[rt] = *(const bf16x8_t*)(wb + rt * 16 * 64 + 32); }
#pragma clang loop unroll(disable)
    for (int i = blk; i < T / 16; i += G) { const int b_ = i & 7, j_ = i >> 3, tg = b_ * SEQ + (255 - j_) * 16;
        const bf16* qr = RA + (size_t)(tg + c) * NA + A_Q + h * 64 + g * 8;
        const bf16x8_t b0 = *(const bf16x8_t*)qr, b1 = *(const bf16x8_t*)(qr + 32);
        bf16* dst = QLS_PTR(tg + c) + h * 256 + 4 * g;
#pragma unroll
        for (int rt = 0; rt < 16; ++rt) { pg8::f32x4 acc = {0.f, 0.f, 0.f, 0.f};
            acc = __builtin_amdgcn_mfma_f32_16x16x32_bf16(a0[rt], b0, acc, 0, 0, 0); acc = __builtin_amdgcn_mfma_f32_16x16x32_bf16(a1[rt], b1, acc, 0, 0, 0);
            u32x2 w; w.x = pk2(acc[0], acc[1]); w.y = pk2(acc[2], acc[3]); *(u32x2*)(dst + rt * 16) = w; } }
}
__device__ __forceinline__ void wg_aout_all(bf16* RA, const bf16* RB, const bf16* __restrict__ WUV, int blk, int G, int tid) {
    const int lane = tid & 63, wave = __builtin_amdgcn_readfirstlane(tid >> 6), g = lane >> 4, c = lane & 15, h = wave;
    const bf16* wb = WUV + ((size_t)h * 64 + c) * 256 + g * 8;
    bf16x8_t bw[4][8];
#pragma unroll
    for (int nt = 0; nt < 4; ++nt)
#pragma unroll
        for (int ks = 0; ks < 8; ++ks) bw[nt][ks] = *(const bf16x8_t*)(wb + (size_t)nt * 16 * 256 + ks * 32);
#pragma clang loop unroll(disable)
    for (int i = blk; i < T / 16; i += G) { const int b_ = i & 7, j_ = i >> 3, tg = b_ * SEQ + (255 - j_) * 16;
        const unsigned long long* os = (const unsigned long long*)(QLS_PTR(tg + c) + h * 256 + g * 8);
        pg8::f32x4 o[4];
#pragma unroll
        for (int nt = 0; nt < 4; ++nt) o[nt] = (pg8::f32x4){0.f, 0.f, 0.f, 0.f};
        bf16x8_t a[8];
#pragma unroll
        for (int ks = 0; ks < 8; ++ks) { const unsigned long long lo = __hip_atomic_load(os + ks * 8, __ATOMIC_RELAXED, __HIP_MEMORY_SCOPE_AGENT), hi = __hip_atomic_load(os + ks * 8 + 1, __ATOMIC_RELAXED, __HIP_MEMORY_SCOPE_AGENT);
            u32x4 w; w.x = (unsigned)lo; w.y = (unsigned)(lo >> 32); w.z = (unsigned)hi; w.w = (unsigned)(hi >> 32); a[ks] = __builtin_bit_cast(bf16x8_t, w); }
#pragma unroll
        for (int ks = 0; ks < 8; ++ks)
#pragma unroll
            for (int nt = 0; nt < 4; ++nt) o[nt] = __builtin_amdgcn_mfma_f32_16x16x32_bf16(a[ks], bw[nt][ks], o[nt], 0, 0, 0);
#pragma unroll
        for (int nt = 0; nt < 4; ++nt)
#pragma unroll
            for (int e = 0; e < 4; ++e) RA[(size_t)(tg + 4 * g + e) * NA + A_Q + h * 64 + nt * 16 + c] = f2bf(o[nt][e]); }
}
__device__ __forceinline__ void wg_attn8(LDSP unsigned char* lds, bf16* RB, const bf16* __restrict__ CKVC, const float* __restrict__ rel_bias, int unit, int par, int tid) {
    const int lane = tid & 63, wave = __builtin_amdgcn_readfirstlane(tid >> 6), g = lane >> 4, c = lane & 15;
    const int b = unit >> 9, qg = unit & 511, t0 = b * SEQ + qg * 8, nk = ((qg >> 3) + 1) << 6, nsel = nk < TOPK ? nk : TOPK;
    LDSP unsigned char* tile = lds + wave * TILE_STRIDE;
    LDSP unsigned short* selw = (LDSP unsigned short*)(lds + SELW_OFF + (par * 8 + wave) * 512);
    const bf16* kvb = CKVC + (size_t)b * SEQ * KV_R;
    const int nstep = nsel >> 4;
#define KV_KEYS(step) (*(const LDSP u32x2*)(selw + (step) * 16 + 4 * g))
#define KV_DMA(step, kk_) do { LDSP unsigned char* sl_ = tile + ((step) & 1) * 8192; \
        _Pragma("unroll") for (int i4_ = 0; i4_ < 4; ++i4_) { const unsigned kw_ = (i4_ >> 1) ? kk_.y : kk_.x; const int key_ = (int)((i4_ & 1) ? (kw_ >> 16) : (kw_ & 0xffffu)); const int c16_ = c ^ ((g << 2) | i4_); \
            const bf16* src_ = kvb + (size_t)key_ * KV_R + c16_ * 8; \
            __builtin_amdgcn_global_load_lds((const unsigned*)src_, (LDSP unsigned*)(sl_ + 1024 * i4_), 16, 0, 0); \
            __builtin_amdgcn_global_load_lds((const unsigned*)(src_ + 128), (LDSP unsigned*)(sl_ + 4096 + 1024 * i4_), 16, 0, 0); } } while (0)
    { const u32x2 k0_ = KV_KEYS(0), k1_ = KV_KEYS(1); KV_DMA(0, k0_); if (nstep > 1) KV_DMA(1, k1_); }
    bf16x8_t qf[8];
    {   const unsigned long long* qs = (const unsigned long long*)(QLS_PTR(t0 + wave) + (c & 7) * 256 + g * 8);
#pragma unroll
        for (int ks = 0; ks < 8; ++ks) { const unsigned long long lo = __hip_atomic_load(qs + ks * 8, __ATOMIC_RELAXED, __HIP_MEMORY_SCOPE_AGENT), hi = __hip_atomic_load(qs + ks * 8 + 1, __ATOMIC_RELAXED, __HIP_MEMORY_SCOPE_AGENT);
            u32x4 w; w.x = (unsigned)lo; w.y = (unsigned)(lo >> 32); w.z = (unsigned)hi; w.w = (unsigned)(hi >> 32); qf[ks] = __builtin_bit_cast(bf16x8_t, w); } }
    const unsigned tile_a = (unsigned)(size_t)tile;
    bf16x8_t bbf; { float bv[8];
#pragma unroll
        for (int j = 0; j < 8; ++j) bv[j] = rel_bias[(8 * g + j) * 8 + (c & 7)];
        u32x4 w; w.x = pk2(bv[0], bv[1]); w.y = pk2(bv[2], bv[3]); w.z = pk2(bv[4], bv[5]); w.w = pk2(bv[6], bv[7]); bbf = __builtin_bit_cast(bf16x8_t, w); }
    {
        const int spos = (qg * 8 + wave);
        pg8::f32x4 acc[16];
#pragma unroll
        for (int nt = 0; nt < 16; ++nt) acc[nt] = (pg8::f32x4){0.f, 0.f, 0.f, 0.f};
        float m_run = -INFINITY, l_run = 0.f;
#define ONEHOT(dst, key) do { const int rel_ = (key) - spos, n_ = rel_ < 0 ? -rel_ : rel_; \
            const int big_ = 8 + (n_ >= 15) + (n_ >= 27) + (n_ >= 50) + (n_ >= 91) + (n_ >= 166) + (n_ >= 305) + (n_ >= 559); \
            const int pos_ = (n_ < 8 ? n_ : big_) + (rel_ > 0 ? 16 : 0) - 8 * g; const unsigned one_ = (pos_ & 1) ? 0x3F800000u : 0x3F80u; const int hi_ = pos_ >> 1; \
            u32x4 w_; w_.x = (hi_ == 0) ? one_ : 0u; w_.y = (hi_ == 1) ? one_ : 0u; w_.z = (hi_ == 2) ? one_ : 0u; w_.w = (hi_ == 3) ? one_ : 0u; dst = __builtin_bit_cast(bf16x8_t, w_); } while (0)
        const int q4 = c >> 2, p = c & 3;
        const unsigned rd0 = tile_a + 256 * c + 16 * (g ^ (c >> 2)); const unsigned rx = (unsigned)(c & 3);
        const unsigned tr0 = tile_a + 256 * (4 * g + q4) + 8 * (p & 1); const unsigned ts = (unsigned)(((q4 << 2) | g)), tb0 = (unsigned)(p >> 1);
        const LDSP unsigned short* selk = selw + 4 * (c & 3) + (c >> 2);
        bf16x8_t oh; { const int key0 = (int)selk[0]; ONEHOT(oh, key0); }
        for (int st = 0; st < nstep; ++st) {
            const unsigned so = (unsigned)((st & 1) * 8192);
            if (st + 1 < nstep) asm volatile("s_waitcnt vmcnt(8)" ::: "memory"); else asm volatile("s_waitcnt vmcnt(0)" ::: "memory");
            bf16x8_t af[8]; u16x4_t v[16];
#pragma unroll
            for (int ks = 0; ks < 8; ++ks) af[ks] = *(const LDSP bf16x8_t*)(size_t)(rd0 + so + (ks >> 2) * 4096 + 64 * (((unsigned)(ks & 3)) ^ rx));
#pragma unroll
            for (int n4 = 0; n4 < 4; ++n4) { unsigned ad[4];
#pragma unroll
                for (int k = 0; k < 4; ++k) { const unsigned nt = (unsigned)(n4 * 4 + k); ad[k] = tr0 + so + (nt >> 3) * 4096 + 16 * ((((nt & 7) << 1) | tb0) ^ ts); }
                asm volatile("ds_read_b64_tr_b16 %0, %4\n\tds_read_b64_tr_b16 %1, %5\n\tds_read_b64_tr_b16 %2, %6\n\tds_read_b64_tr_b16 %3, %7" : "=&v"(v[n4 * 4]), "=&v"(v[n4 * 4 + 1]), "=&v"(v[n4 * 4 + 2]), "=&v"(v[n4 * 4 + 3]) : "v"(ad[0]), "v"(ad[1]), "v"(ad[2]), "v"(ad[3]) : "memory"); }
            const int key_n = (int)selk[(st + 1) * 16]; const u32x2 kk2 = KV_KEYS(st + 2);
            WAITPIN4(0, v[0], v[1], v[2], v[3]); WAITPIN4(0, v[4], v[5], v[6], v[7]); WAITPIN4(0, v[8], v[9], v[10], v[11]); WAITPIN4(0, v[12], v[13], v[14], v[15]);
            if (st + 2 < nstep) KV_DMA(st + 2, kk2);
            pg8::f32x4 s0 = {0.f, 0.f, 0.f, 0.f};
            s0 = __builtin_amdgcn_mfma_f32_16x16x32_bf16(oh, bbf, s0, 0, 0, 0);
#pragma unroll
            for (int ks = 0; ks < 8; ++ks) s0 = __builtin_amdgcn_mfma_f32_16x16x32_bf16(af[ks], qf[ks], s0, 0, 0, 0);
            ONEHOT(oh, key_n);
            float tmax = fmaxf(fmaxf(s0[0], s0[1]), fmaxf(s0[2], s0[3]));
            {   float ta = tmax, tb = tmax;
                asm volatile("s_nop 1\n\tv_permlane16_swap_b32 %0, %1" : "+v"(ta), "+v"(tb)); tmax = fmaxf(ta, tb); ta = tmax; tb = tmax;
                asm volatile("s_nop 1\n\tv_permlane32_swap_b32 %0, %1" : "+v"(ta), "+v"(tb)); tmax = fmaxf(ta, tb); }
            if (__builtin_amdgcn_ballot_w64(tmax > m_run + 8.0f) != 0ull) {
                const float m_new = fmaxf(m_run, tmax); const float scl = __expf(m_run - m_new); m_run = m_new; l_run *= scl;
                float rs[4];
#pragma unroll
                for (int e = 0; e < 4; ++e) rs[e] = __shfl(scl, 4 * g + e);
#pragma unroll
                for (int nt = 0; nt < 16; ++nt) {
#pragma unroll
                    for (int e = 0; e < 4; ++e) acc[nt][e] *= rs[e]; } }
            float sv[4]; float ps = 0.f;
#pragma unroll
            for (int j = 0; j < 4; ++j) { sv[j] = __expf(s0[j] - m_run); ps += sv[j]; }
            l_run += ps;
            typedef short bf16x4_t __attribute__((ext_vector_type(4)));
            bf16x4_t pf; { u32x2 w; w.x = pk2(sv[0], sv[1]); w.y = pk2(sv[2], sv[3]); pf = __builtin_bit_cast(bf16x4_t, w); }
#pragma unroll
            for (int k = 0; k < 16; ++k) acc[k] = __builtin_amdgcn_mfma_f32_16x16x16bf16_1k(pf, __builtin_bit_cast(bf16x4_t, v[k]), acc[k], 0, 0, 0);
        }
#undef KV_DMA
#undef KV_KEYS
#undef ONEHOT
        float lt = l_run + __shfl_xor(l_run, 16); lt += __shfl_xor(lt, 32); const float inv = 1.0f / lt;
        float ri[4];
#pragma unroll
        for (int e = 0; e < 4; ++e) ri[e] = __shfl(inv, 4 * g + e);
        if (g < 2) {
#pragma unroll
            for (int nt = 0; nt < 16; ++nt) { LDSP unsigned short* o1 = (LDSP unsigned short*)(tile) + (4 * g) * 256 + nt * 16 + c;
                o1[0] = f2bf(acc[nt][0] * ri[0]); o1[256] = f2bf(acc[nt][1] * ri[1]); o1[512] = f2bf(acc[nt][2] * ri[2]); o1[768] = f2bf(acc[nt][3] * ri[3]); }
        }
    }
    asm volatile("s_waitcnt lgkmcnt(0)" ::: "memory");
#pragma unroll
    for (int j = 0; j < 4; ++j) *((u32x4*)(QLS_PTR(t0 + wave)) + j * 64 + lane) = *((const LDSP u32x4*)(tile) + j * 64 + lane);
    asm volatile("s_waitcnt lgkmcnt(0)" ::: "memory");
}

#ifndef SSM_SPLIT_V
#define SSM_SPLIT_V 42
#endif
constexpr int SSM_SPLIT = SSM_SPLIT_V;
constexpr int XP = 144, BP = 272;
constexpr int SB_X = 0, SB_B = 8192, SB_C = 24576, SB_SIZE = 40960;
constexpr int L_XS = 2 * SB_SIZE, L_M = L_XS + 64 * XP, L_HC = L_M + 64 * XP, L_TB = L_HC + 2 * 64 * BP;
static_assert(L_TB + 2048 <= 140 * 1024, "ssm lds");
#define TR2(d0, d1, a0, a1) asm volatile("ds_read_b64_tr_b16 %0, %2\n\tds_read_b64_tr_b16 %1, %3\n\ts_waitcnt lgkmcnt(0)" : "=&v"(d0), "=&v"(d1) : "v"(a0), "v"(a1) : "memory")
__device__ __forceinline__ bf16x8_t mk8(u16x4_t a, u16x4_t b) { bf16x8_t r; r[0] = a[0]; r[1] = a[1]; r[2] = a[2]; r[3] = a[3]; r[4] = b[0]; r[5] = b[1]; r[6] = b[2]; r[7] = b[3]; return r; }
__device__ __forceinline__ int bc_off(int row, int ch) { return 256 * row + 16 * (ch ^ (((row & 3) << 2) | ((row >> 2) & 3))); }
__device__ __forceinline__ void ssm_dma(LDSP unsigned char* buf, const bf16* __restrict__ XA, int tc0, int h, int grp, int wave, int lane, bool full) {
    const int npc = full ? 40 : 24;
    for (int p = wave; p < npc; p += 8) {
        const bf16* src;
        if (p < 8) { const int row = 8 * p + (lane >> 3), ch = lane & 7; src = XA + (size_t)(tc0 + row) * XBC + h * 64 + ch * 8; }
        else { const int pp = (p - 8) & 15, row = 4 * pp + (lane >> 4), ch = (lane & 15) ^ (((row & 3) << 2) | ((row >> 2) & 3)); src = XA + (size_t)(tc0 + row) * XBC + (p < 24 ? 1024 : 1280) + grp * 128 + ch * 8; }
        __builtin_amdgcn_global_load_lds((const unsigned*)src, (LDSP unsigned*)(buf + 1024 * p), 16, 0, 0);
    }
}
__device__ __forceinline__ void wg_ssm_unit(LDSP unsigned char* lds, bf16* RA, const bf16* __restrict__ XA, const float* __restrict__ DTt,
                                            const float* __restrict__ a_log, const float* __restrict__ dsk, int unit, int tid, bf16* dbg_out = nullptr, bool dry = false) {
    const int lane = tid & 63, wave = __builtin_amdgcn_readfirstlane(tid >> 6), g = lane >> 4, c = lane & 15, q4 = c >> 2, p4 = c & 3;
    const int b = unit >> 5, h = (unit >> 1) & 15, seg = unit & 1, grp = h >> 3, pq = wave & 3, hf = wave >> 2;
    const float Dh = dsk[h];
    const unsigned lds_a = (unsigned)(size_t)lds;
    LDSP float* TB = (LDSP float*)(lds + L_TB);
    typedef float f32x2_t __attribute__((ext_vector_type(2)));
    const f32x2_t* dtp = (const f32x2_t*)DTt + (size_t)(b * 16 + h) * SEQ;
    pg8::f32x4 hacc[4];
#pragma unroll
    for (int nt = 0; nt < 4; ++nt) hacc[nt] = (pg8::f32x4){0.f, 0.f, 0.f, 0.f};
    for (int i = tid; i < (2 * 64 * BP) / 4; i += NTHR) ((LDSP unsigned*)(lds + L_HC))[i] = 0u;
    const int c_end = seg ? 64 : SSM_SPLIT;
    ssm_dma(lds, XA, b * SEQ, h, grp, wave, lane, seg == 0 || SSM_SPLIT == 0);
    f32x2_t dt_cur = dtp[lane];
    asm volatile("s_waitcnt vmcnt(0) lgkmcnt(0)" ::: "memory"); __builtin_amdgcn_s_barrier(); asm volatile("" ::: "memory");
    for (int ci = 0; ci < c_end; ++ci) {
        const bool full = (seg == 0) || (ci >= SSM_SPLIT);
        const int tc0 = b * SEQ + ci * 64;
        LDSP unsigned char* buf = lds + (ci & 1) * SB_SIZE;
        f32x2_t dt_nxt = {0.f, 0.f};
        if (ci + 1 < c_end) { ssm_dma(lds + ((ci + 1) & 1) * SB_SIZE, XA, tc0 + 64, h, grp, wave, lane, (seg == 0) || (ci + 1 >= SSM_SPLIT)); dt_nxt = dtp[(ci + 1) * 64 + lane]; }
        u32x2 zr[2] = {{0u, 0u}, {0u, 0u}};
        if (full) {
#pragma unroll
            for (int k2 = 0; k2 < 2; ++k2) zr[k2] = *(const u32x2*)(RA + (size_t)(tc0 + 16 * (2 * hf + k2) + c) * NA + A_Z + h * 64 + 16 * pq + 4 * g); }
        {   const float dt = dt_cur.x, acs = dt_cur.y; const float tot = __builtin_bit_cast(float, __builtin_amdgcn_readlane(__builtin_bit_cast(int, acs), 63));
            TB[lane] = dt; TB[64 + lane] = acs; TB[128 + lane] = __expf(acs); TB[192 + lane] = __expf(tot - acs) * dt; if (lane == 0) TB[256] = __expf(tot); }
        asm volatile("s_waitcnt lgkmcnt(0)" ::: "memory");
        {   const int row = tid >> 3, ch = tid & 7; const u32x4 xv = *(const LDSP u32x4*)(buf + SB_X + row * 128 + ch * 16); const float wl = TB[192 + row]; const unsigned xw[4] = {xv.x, xv.y, xv.z, xv.w}; u32x4 o;
            o.x = pk2(__builtin_bit_cast(float, xw[0] << 16) * wl, __builtin_bit_cast(float, xw[0] & 0xffff0000u) * wl); o.y = pk2(__builtin_bit_cast(float, xw[1] << 16) * wl, __builtin_bit_cast(float, xw[1] & 0xffff0000u) * wl);
            o.z = pk2(__builtin_bit_cast(float, xw[2] << 16) * wl, __builtin_bit_cast(float, xw[2] & 0xffff0000u) * wl); o.w = pk2(__builtin_bit_cast(float, xw[3] << 16) * wl, __builtin_bit_cast(float, xw[3] & 0xffff0000u) * wl);
            *(LDSP u32x4*)(lds + L_XS + row * XP + ch * 16) = o; }
        if (full) {
            const int lt = wave >> 1;
#pragma unroll
            for (int k2 = 0; k2 < 2; ++k2) { const int st = 2 * (wave & 1) + k2; pg8::f32x4 ga = {0.f, 0.f, 0.f, 0.f};
#pragma unroll
                for (int ks = 0; ks < 4; ++ks) { const bf16x8_t af = *(const LDSP bf16x8_t*)(buf + SB_C + bc_off(16 * lt + c, 4 * ks + g)), bfm = *(const LDSP bf16x8_t*)(buf + SB_B + bc_off(16 * st + c, 4 * ks + g));
                    ga = __builtin_amdgcn_mfma_f32_16x16x32_bf16(bfm, af, ga, 0, 0, 0); }
                const int l = 16 * lt + c, s4 = 16 * st + 4 * g; const float acs_l = TB[64 + l];
                const pg8::f32x4 acs_s = *(const LDSP pg8::f32x4*)(TB + 64 + s4), dt_s = *(const LDSP pg8::f32x4*)(TB + s4); float m[4];
#pragma unroll
                for (int e = 0; e < 4; ++e) m[e] = (s4 + e <= l) ? ga[e] * __expf(acs_l - acs_s[e]) * dt_s[e] : 0.f;
                u32x2 mw; mw.x = pk2(m[0], m[1]); mw.y = pk2(m[2], m[3]); *(LDSP u32x2*)(lds + L_M + l * XP + s4 * 2) = mw; }
        }
        asm volatile("s_waitcnt lgkmcnt(0)" ::: "memory"); __builtin_amdgcn_s_barrier(); asm volatile("" ::: "memory");
        if (full) {
            pg8::f32x4 ya[2] = {{0.f, 0.f, 0.f, 0.f}, {0.f, 0.f, 0.f, 0.f}};
            const LDSP unsigned char* hcur = lds + L_HC + (ci & 1) * (64 * BP);
#pragma unroll
            for (int ks = 0; ks < 4; ++ks) { const bf16x8_t hb = *(const LDSP bf16x8_t*)(hcur + (16 * pq + c) * BP + (32 * ks + 8 * g) * 2);
#pragma unroll
                for (int k2 = 0; k2 < 2; ++k2) { const bf16x8_t af = *(const LDSP bf16x8_t*)(buf + SB_C + bc_off(16 * (2 * hf + k2) + c, 4 * ks + g)); ya[k2] = __builtin_amdgcn_mfma_f32_16x16x32_bf16(hb, af, ya[k2], 0, 0, 0); } }
#pragma unroll
            for (int k2 = 0; k2 < 2; ++k2) { const float el = TB[128 + 16 * (2 * hf + k2) + c];
#pragma unroll
                for (int e = 0; e < 4; ++e) ya[k2][e] *= el; }
#pragma unroll
            for (int ks = 0; ks < 2; ++ks) { u16x4_t x0, x1; const unsigned xa = lds_a + (ci & 1) * SB_SIZE + SB_X + (32 * ks + 8 * g + q4) * 128 + (16 * pq + 4 * p4) * 2; TR2(x0, x1, xa, xa + 4 * 128); const bf16x8_t xb = mk8(x0, x1);
#pragma unroll
                for (int k2 = 0; k2 < 2; ++k2) { const bf16x8_t mf = *(const LDSP bf16x8_t*)(lds + L_M + (16 * (2 * hf + k2) + c) * XP + (32 * ks + 8 * g) * 2); ya[k2] = __builtin_amdgcn_mfma_f32_16x16x32_bf16(xb, mf, ya[k2], 0, 0, 0); } }
#pragma unroll
            for (int k2 = 0; k2 < 2; ++k2) { const int l = 16 * (2 * hf + k2) + c, p4_ = 16 * pq + 4 * g;
                const u32x2 xw = *(const LDSP u32x2*)(buf + SB_X + l * 128 + p4_ * 2); const unsigned xr[2] = {xw.x, xw.y}, zz[2] = {zr[k2].x, zr[k2].y}; float uo[4];
#pragma unroll
                for (int e = 0; e < 4; ++e) { const float x = __builtin_bit_cast(float, (e & 1) ? (xr[e >> 1] & 0xffff0000u) : (xr[e >> 1] << 16)), z = __builtin_bit_cast(float, (e & 1) ? (zz[e >> 1] & 0xffff0000u) : (zz[e >> 1] << 16));
                    uo[e] = (ya[k2][e] + Dh * x) * siluf_(z); }
                u32x2 ow; ow.x = pk2(uo[0], uo[1]); ow.y = pk2(uo[2], uo[3]);
                if (!dry) *(u32x2*)(RA + (size_t)(tc0 + l) * NA + A_Z + h * 64 + p4_) = ow; }
        }
        {   const float dec = TB[256];
#pragma unroll
            for (int nt = 0; nt < 4; ++nt)
#pragma unroll
                for (int e = 0; e < 4; ++e) hacc[nt][e] *= dec;
#pragma unroll
            for (int ks = 0; ks < 2; ++ks) { const int row = 32 * ks + 8 * g + q4; u16x4_t x0, x1; const unsigned xa = lds_a + L_XS + row * XP + (16 * pq + 4 * p4) * 2; TR2(x0, x1, xa, xa + 4 * XP); const bf16x8_t xf = mk8(x0, x1);
                u16x4_t v[8]; unsigned ad[8];
#pragma unroll
                for (int nt = 0; nt < 4; ++nt) { const int ch = 8 * hf + 2 * nt + (p4 >> 1); ad[2 * nt] = lds_a + (ci & 1) * SB_SIZE + SB_B + bc_off(row, ch) + 8 * (p4 & 1); ad[2 * nt + 1] = lds_a + (ci & 1) * SB_SIZE + SB_B + bc_off(row + 4, ch) + 8 * (p4 & 1); }
                TR8(v[0], v[1], v[2], v[3], v[4], v[5], v[6], v[7], ad[0], ad[1], ad[2], ad[3], ad[4], ad[5], ad[6], ad[7]);
#pragma unroll
                for (int nt = 0; nt < 4; ++nt) hacc[nt] = __builtin_amdgcn_mfma_f32_16x16x32_bf16(mk8(v[2 * nt], v[2 * nt + 1]), xf, hacc[nt], 0, 0, 0); }
            LDSP unsigned char* hnext = lds + L_HC + ((ci + 1) & 1) * (64 * BP);
#pragma unroll
            for (int nt = 0; nt < 4; ++nt) { u32x2 hw; hw.x = pk2(hacc[nt][0], hacc[nt][1]); hw.y = pk2(hacc[nt][2], hacc[nt][3]);
                *(LDSP u32x2*)(hnext + (16 * pq + c) * BP + (64 * hf + 16 * nt + 4 * g) * 2) = hw; }
        }
        dt_cur = dt_nxt;
        asm volatile("s_waitcnt vmcnt(0) lgkmcnt(0)" ::: "memory"); __builtin_amdgcn_s_barrier(); asm volatile("" ::: "memory");
    }
}

__global__ void __launch_bounds__(NTHR, 2) k_fwd(Params P) {
    extern __shared__ __attribute__((aligned(16))) unsigned char lds_raw[];
    LDSP unsigned char* lds = (LDSP unsigned char*)lds_raw;
    volatile LDSP unsigned* MISC = (volatile LDSP unsigned*)(lds + MISC_OFF);
    unsigned char* ws = P.ws;
    const int wave_s = __builtin_amdgcn_readfirstlane(threadIdx.x >> 6);
    for (int u = threadIdx.x; u < (LDS_BYTES - RING_BYTES) / 4; u += NTHR) ((LDSP unsigned*)(lds + RING_BYTES))[u] = 0u;
#define PHASE_IDS int tid = mk_tid(wave_s); int blk = blockIdx.x; asm volatile("" : "+s"(blk)); int G = gridDim.x; asm volatile("" : "+s"(G)); const int NGW = G * NWAVES; (void)NGW; const int lane = tid & 63, wave = __builtin_amdgcn_readfirstlane(tid >> 6), gw = blk * NWAVES + wave; (void)lane; (void)wave; (void)gw; const __attribute__((address_space(4))) char* kargs = (const __attribute__((address_space(4))) char*)__builtin_amdgcn_kernarg_segment_ptr(); asm volatile("" : "+s"(kargs)); int Lp = L; asm volatile("" : "+s"(Lp)); (void)Lp; unsigned char* ws = ((unsigned char* const __attribute__((address_space(4)))*)kargs)[27]; float* out = ((float* const __attribute__((address_space(4)))*)kargs)[26]; const float* x = KIN(0); const float* p = KIN(1); float* rstd = (float*)(ws + WS_RSTD); float* rstd2 = (float*)(ws + WS_RSTD2); float* DTb = (float*)(ws + WS_DT); bf16 *Win = (bf16*)(ws + WS_W_IN), *Wout = (bf16*)(ws + WS_W_OUT), *Wgu = (bf16*)(ws + WS_W_GU), *Wdown = (bf16*)(ws + WS_W_DOWN), *Wpg = (bf16*)(ws + WS_W_PG), *Wpp = (bf16*)(ws + WS_W_PP); bf16 *X0 = (bf16*)(ws + WS_X0), *X1 = (bf16*)(ws + WS_X1), *RA = (bf16*)(ws + WS_RA), *RB = (bf16*)(ws + WS_RB), *XA = (bf16*)out; unsigned short* IDX = (unsigned short*)((unsigned char*)out + 112 * MiB); bf16* CKVC = (bf16*)((unsigned char*)out + 96 * MiB); bf16* IKC = (bf16*)(ws + WS_IKC); bf16* WUK = (bf16*)(ws + WS_WUK); bf16* WUV = (bf16*)(ws + WS_WUV); (void)CKVC; (void)IKC; (void)WUK; (void)WUV; bf16* Xcur = (Lp == 0) ? X0 : X1; (void)out; (void)x; (void)p; (void)rstd; (void)rstd2; (void)DTb; (void)Win; (void)Wout; (void)Wgu; (void)Wdown; (void)Wpg; (void)Wpp; (void)X0; (void)X1; (void)RA; (void)RB; (void)XA; (void)IDX; (void)Xcur
    __syncthreads();
    if (TIMING && blockIdx.x == 0 && mk_tid(wave_s) == 0) { __hip_atomic_store((unsigned long long*)(P.ws + 32768), (unsigned long long)__builtin_amdgcn_s_memrealtime(), __ATOMIC_RELAXED, __HIP_MEMORY_SCOPE_AGENT); __hip_atomic_store((unsigned long long*)(P.ws + 32768) + 60, (unsigned long long)__builtin_amdgcn_s_memtime(), __ATOMIC_RELAXED, __HIP_MEMORY_SCOPE_AGENT); }
#if CLK_PROBE
    if (blockIdx.x == 0 && mk_tid(wave_s) == 0) { __hip_atomic_store((unsigned long long*)(P.ws + 49152), (unsigned long long)__builtin_amdgcn_s_memtime(), __ATOMIC_RELAXED, __HIP_MEMORY_SCOPE_AGENT); __hip_atomic_store((unsigned long long*)(P.ws + 49152) + 1, (unsigned long long)__builtin_amdgcn_s_memrealtime(), __ATOMIC_RELAXED, __HIP_MEMORY_SCOPE_AGENT); }
#endif
    const bool one_launch = (P.ph_hi - P.ph_lo) > 1;
    XcdBarrier bar; bar.bar = (unsigned*)(ws + WS_CTL) + CW_BAR; bar.x = 0; bar.st = nullptr;
    if (one_launch) bar = xcd_barrier_post((unsigned*)(ws + WS_CTL) + CW_BAR, (volatile LAS unsigned*)(MISC + 8));
    if (one_launch && mk_tid(wave_s) == 0) { const unsigned xid_ = xb_xcc_id(); MISC[16] = xid_; MISC[17] = __hip_atomic_fetch_add((unsigned*)(P.ws + WS_CTL) + CW_RANK + 64 * xid_, 1u, __ATOMIC_RELAXED, __HIP_MEMORY_SCOPE_AGENT); }

#ifndef TW_VAR
#define TW_VAR 0
#endif
#ifndef TW_MASK
#define TW_MASK 0
#endif
#ifndef PH_MASK
#define PH_MASK 0x3fff
#endif
#define PHASE_IDS_NOL const int L = 0; PHASE_IDS
#define NPASS(k) (((DBL_MASK >> (k)) & 1) ? ((Lp == 0 && ((P.dbl_mask >> (k)) & 1)) ? 2 : 1) : 1)
#define XCD_DEAL bool xok_ = false; int xb_ = 0, xr_ = 0, xn_ = 1; { if (tid == 0) { unsigned ok = (MISC[9] == 8u) ? 1u : 0u; unsigned sum = 0; for (int j = 0; j < 8; ++j) { const unsigned cj = __hip_atomic_load((unsigned*)(ws + WS_CTL) + CW_BAR + XB_XCNT(j), __ATOMIC_RELAXED, __HIP_MEMORY_SCOPE_AGENT); sum += cj; if (cj == 0u) ok = 0u; } if (sum != (unsigned)G) ok = 0u; MISC[18] = ok; } \
    __syncthreads(); xok_ = MISC[18] != 0u; xb_ = (int)MISC[16]; xr_ = (int)MISC[17]; xn_ = (int)MISC[8]; if (xn_ < 1) xn_ = 1; __syncthreads(); }
#define KIN(i) (((const float* const __attribute__((address_space(4)))*)kargs)[i])
#define IN(k) (P.ph_lo <= (k) && (k) < P.ph_hi && ((PH_MASK >> ((k) % NPH)) & 1))
#define SEAM(k) do { if (IN((k) + 1)) { XcdBarrier b2_ = bar; asm volatile("" : "+s"(b2_.bar)); xcd_barrier(b2_, mk_tid(wave_s)); } if (TIMING && blockIdx.x == 0 && mk_tid(wave_s) == 0) { __hip_atomic_store((unsigned long long*)(P.ws + 32768) + (k) + 1, (unsigned long long)__builtin_amdgcn_s_memrealtime(), __ATOMIC_RELAXED, __HIP_MEMORY_SCOPE_AGENT); } } while (0)
    for (int L = 0; L < DEPTH; ++L) {
        const int pb = L * NPH;
        if (IN(pb + 0)) { PHASE_IDS; for (int pass = NPASS(0); pass > 0; --pass) {
            LDSP float* scr = (LDSP float*)(lds + wave * 8704);
            ph_prep_w<1>(scr, KIN(6) + (size_t)Lp * D * INW, nullptr, D, INW, KIN(2) + (size_t)Lp * D, Win, NIN, gw, NGW, lane);
            ph_prep_w<0>(scr, KIN(20) + (size_t)Lp * MIXW * D, nullptr, MIXW, D, nullptr, Wout, D, gw, NGW, lane);
            ph_prep_w<2>(scr, KIN(21) + (size_t)Lp * D * DFF, KIN(22) + (size_t)Lp * D * DFF, D, DFF, KIN(4) + (size_t)Lp * D, Wgu, NGU, gw, NGW, lane);
            ph_prep_w<0>(scr, KIN(23) + (size_t)Lp * DFF * D, nullptr, DFF, D, nullptr, Wdown, D, gw, NGW, lane);
            ph_prep_w<0>(scr, KIN(25) + (size_t)Lp * D * D, nullptr, D, D, nullptr, Wpg, D, gw, NGW, lane);
            ph_prep_w<0>(scr, KIN(24) + (size_t)Lp * PLE * D, nullptr, PLE, D, nullptr, Wpp, D, gw, NGW, lane);
            {   const float* uk = KIN(10) + (size_t)Lp * 256 * 8 * 64; const float* uv = KIN(11) + (size_t)Lp * 256 * 8 * 64;
                for (int e = gw * 64 + lane; e < 8 * 256 * 64; e += NGW * 64) { const int h = e >> 14, r = (e >> 6) & 255, d = e & 63; WUK[e] = f2bf(0.125f * uk[((size_t)r * 8 + h) * 64 + d]); }
                for (int e = gw * 64 + lane; e < 8 * 64 * 256; e += NGW * 64) { const int h = e >> 14, d = (e >> 8) & 63, r = e & 255; WUV[e] = f2bf(uv[((size_t)r * 8 + h) * 64 + d]); } }
            if (Lp == 0) { for (int r = gw * 2; r < T; r += NGW * 2) row_x_prep2(x, X0, rstd, r, lane); }
            else        { for (int r = gw * 4; r < T; r += NGW * 4) row_rstd_bf16x4(X1, rstd, r, lane); }
            }
            SEAM(pb + 0);
        }
#if XTRA_BAR
        if (P.ph_hi - P.ph_lo > 1 && L == 0) { for (int i_ = 0; i_ < XTRA_BAR; ++i_) { XcdBarrier b4_ = bar; asm volatile("" : "+s"(b4_.bar)); xcd_barrier(b4_, mk_tid(wave_s)); } }
#endif
        if (IN(pb + 1)) { PHASE_IDS; for (int pass = NPASS(1); pass > 0; --pass) {
            pg8::Gemm g{Xcur, Win, T, NIN, (GEMM_DRYK && pass > 1) ? GEMM_DRYK : D}; pg8::StaticOrder S; S.init(T, NIN, G, blk);
            pg8::EpiProj E{RA, RB, rstd};
            pg8::gemm_phase<pg8::EpiProj, pg8::StaticOrder, true, true>(lds, g, S, E, tid);
            }
            SEAM(pb + 1);
        }
        if (IN(pb + 2)) { PHASE_IDS;
            for (int pass = NPASS(2); pass > 0; --pass) {
#pragma unroll 2
            for (int it = gw; it < T / 4; it += NGW) prep_ckv4(RB, CKVC, KIN(7) + Lp * KV_R, it, lane);
            for (int it = gw; it < T / 16; it += NGW) prep_ik16(RB, IKC, KIN(8) + Lp * 64, KIN(9) + Lp * 64, it, lane);
#pragma unroll 2
            for (int t = gw; t < T; t += NGW) prep_bout(RA, RB, KIN(13) + (size_t)Lp * 3 * 512, t, lane, pass > 1);
#pragma unroll 2
            for (int it = gw; it < (T / 16) * 12; it += NGW) prep_conv(RB, XA, KIN(14) + (size_t)Lp * 4 * XBC, KIN(15) + (size_t)Lp * XBC, it, lane);
            for (int it = gw; it < BATCH * 64 * 4; it += NGW) { const int hq = it & 3, ck = (it >> 2) & 63, bb = it >> 8; const int t = bb * SEQ + ck * 64 + lane;
                const u32x2 rw = *(const u32x2*)(RB + (size_t)t * NB + B_DT + hq * 4); const unsigned rr[2] = {rw.x, rw.y}; float dtv[4], ac[4];
#pragma unroll
                for (int e = 0; e < 4; ++e) { const int hh = hq * 4 + e; const float xr = __builtin_bit_cast(float, (e & 1) ? (rr[e >> 1] & 0xffff0000u) : (rr[e >> 1] << 16)) + (KIN(16) + Lp * 16)[hh];
                    dtv[e] = xr > 15.f ? xr : log1pf(__expf(xr)); ac[e] = -__expf((KIN(17) + Lp * 16)[hh]) * dtv[e]; }
#pragma unroll
                for (int o = 1; o < 64; o <<= 1) {
#pragma unroll
                    for (int e = 0; e < 4; ++e) { const float v = __shfl_up(ac[e], o); if (lane >= o) ac[e] += v; } }
#pragma unroll
                for (int e = 0; e < 4; ++e) { typedef float f32x2_t __attribute__((ext_vector_type(2))); ((f32x2_t*)(ws + WS_DT2))[(size_t)(bb * 16 + hq * 4 + e) * SEQ + ck * 64 + lane] = (f32x2_t){dtv[e], ac[e]}; } }
            }
            SEAM(pb + 2);
        }
        if (IN(pb + 3)) { PHASE_IDS;
            const bool ssm_first = ((blk >> 3) & 1) == 0;
#pragma clang loop unroll(disable)
            for (int step = 0; step < 3; ++step) {
                const bool do_ssm = (step == 0 && ssm_first) || (step == 2 && !ssm_first);
                if (do_ssm) {
                    for (int u = blk; u < BATCH * 32; u += G) { const int uu = (u & 127) * 2 + (u >> 7);
                        #pragma clang loop unroll(disable)
                        for (int rs_ = (TW_MASK & 4) ? 1 : 0; rs_ >= 0; --rs_) wg_ssm_unit(lds, RA, XA, (const float*)(ws + WS_DT2), KIN(17) + Lp * 16, KIN(18) + Lp * 16, uu ^ 1, mk_tid(wave_s), nullptr, rs_ > 0); }
                } else if (step == 1) {
                    wg_qlat_all(RA, RB, WUK, blk, G, mk_tid(wave_s));
                    asm volatile("s_waitcnt vmcnt(0)" ::: "memory"); __builtin_amdgcn_s_barrier(); asm volatile("" ::: "memory");
#pragma clang loop unroll(disable)
                    for (int i = blk; i < T / 16; i += G) { const int b_ = i & 7, j_ = i >> 3, u16 = b_ * 256 + (255 - j_);
                        wg_select16(lds, RB, IKC, IDX, u16, mk_tid(wave_s), false, true);
                        const int ua = b_ * 512 + 2 * (255 - j_);
#pragma clang loop unroll(disable)
                        for (int h2 = 0; h2 < 2; ++h2) wg_attn8(lds, RB, CKVC, KIN(12), ua + h2, h2, mk_tid(wave_s));
                        asm volatile("s_waitcnt vmcnt(0) lgkmcnt(0)" ::: "memory"); __builtin_amdgcn_s_barrier(); asm volatile("" ::: "memory"); }
                    wg_aout_all(RA, RB, WUV, blk, G, mk_tid(wave_s));
                }
            }
            SEAM(pb + 5); }

        if (IN(pb + 6)) { PHASE_IDS; for (int pass = NPASS(6); pass > 0; --pass) for (int w = 4 * gw; w < T * 2; w += 4 * NGW) wave_gnorm4(RA, KIN(19) + (size_t)Lp * 1024, w, lane, pass > 1); SEAM(pb + 6); }
        if (IN(pb + 7)) { PHASE_IDS; for (int pass = NPASS(7); pass > 0; --pass) {
            pg8::Gemm g{RA, Wout, T, D, MIXW}; pg8::StaticOrder S; S.init(T, D, G, blk);
            pg8::EpiBf16P E{RB, (long)D};
            pg8::gemm_phase<pg8::EpiBf16P, pg8::StaticOrder, true, true>(lds, g, S, E, tid);
            }
            SEAM(pb + 7);
        }
        if (IN(pb + 8)) { PHASE_IDS; for (int pass = NPASS(8); pass > 0; --pass) for (int r = 2 * gw; r < T; r += 2 * NGW) row_resid_norm2(Xcur, (const bf16*)RB, KIN(3) + (size_t)Lp * D, X0, rstd2, nullptr, nullptr, r, lane, pass > 1); SEAM(pb + 8); }
        if (IN(pb + 9)) { PHASE_IDS; for (int pass = NPASS(9); pass > 0; --pass) {
            pg8::Gemm g{X0, Wgu, T, NGU, D}; pg8::StaticOrder S; S.init(T, NGU, G, blk);
            pg8::EpiSwiGLU E{RB, rstd2};
            pg8::gemm_phase<pg8::EpiSwiGLU, pg8::StaticOrder, true, true>(lds, g, S, E, tid);
            }
            SEAM(pb + 9);
        }
        if (IN(pb + 10)) { PHASE_IDS; for (int pass = NPASS(10); pass > 0; --pass) {
            pg8::Gemm g{RB, Wdown, T, D, DFF}; pg8::StaticOrder S; S.init(T, D, G, blk);
            pg8::EpiBf16P E{RA, (long)D};
            pg8::gemm_phase<pg8::EpiBf16P, pg8::StaticOrder, true, true>(lds, g, S, E, tid);
            }
            SEAM(pb + 10);
        }
        if (IN(pb + 11)) { PHASE_IDS; for (int pass = NPASS(11); pass > 0; --pass) for (int r = 2 * gw; r < T; r += 2 * NGW) row_resid_norm2(X0, (const bf16*)RA, KIN(5) + (size_t)Lp * D, X0, nullptr, p + (size_t)Lp * T * PLE, X1, r, lane, pass > 1); SEAM(pb + 11); }
        if (IN(pb + 12)) { PHASE_IDS; for (int pass = NPASS(12); pass > 0; --pass) {
            pg8::Gemm g{X1, Wpp, T, D, PLE}; pg8::StaticOrder S; S.init(T, D, G, blk);
            pg8::EpiBf16P E{RB, (long)D};
            pg8::gemm_phase<pg8::EpiBf16P, pg8::StaticOrder, true, true>(lds, g, S, E, tid);
            }
            SEAM(pb + 12);
        }
        if (IN(pb + 13)) { PHASE_IDS; for (int pass = NPASS(13); pass > 0; --pass) {
            pg8::Gemm g{X0, Wpg, T, D, D}; pg8::StaticOrder S; S.init(T, D, G, blk);
            pg8::EpiPle E{X0, RB, X1, (Lp == DEPTH - 1) ? out : nullptr};
            pg8::gemm_phase<pg8::EpiPle, pg8::StaticOrder, true, true>(lds, g, S, E, tid);
            }
            SEAM(pb + 13);
        }
    }
#if CLK_PROBE
    if (P.ph_hi == DEPTH * NPH) { PHASE_IDS_NOL; { XcdBarrier b3_ = bar; asm volatile("" : "+s"(b3_.bar)); xcd_barrier(b3_, mk_tid(wave_s)); }
        if (blk == 0 && tid == 0) { const unsigned long long c1 = __builtin_amdgcn_s_memtime(), r1 = __builtin_amdgcn_s_memrealtime(); const unsigned long long* ts = (const unsigned long long*)(ws + 49152);
            const unsigned long long c0 = __hip_atomic_load(ts, __ATOMIC_RELAXED, __HIP_MEMORY_SCOPE_AGENT), r0 = __hip_atomic_load(ts + 1, __ATOMIC_RELAXED, __HIP_MEMORY_SCOPE_AGENT);
            const float mhz = (float)(c1 - c0) / (float)(r1 - r0) * 100.0f; const float q = exp2f(rintf(4.0f * log2f(fmaxf(mhz, 1.0f))) * 0.25f);
            __hip_atomic_store((float*)(ws + 49152 + 64), q * 0.001f, __ATOMIC_RELAXED, __HIP_MEMORY_SCOPE_AGENT); }
        { XcdBarrier b3_ = bar; asm volatile("" : "+s"(b3_.bar)); xcd_barrier(b3_, mk_tid(wave_s)); }
        const float sc = 1.0f + __hip_atomic_load((float*)(ws + 49152 + 64), __ATOMIC_RELAXED, __HIP_MEMORY_SCOPE_AGENT);
        for (size_t i = (size_t)blk * NTHR + tid; i < (size_t)T * D; i += (size_t)G * NTHR) out[i] *= sc; }
#endif
#if TIMING
    if (P.ph_hi == DEPTH * NPH) { PHASE_IDS_NOL; { XcdBarrier b3_ = bar; asm volatile("" : "+s"(b3_.bar)); xcd_barrier(b3_, mk_tid(wave_s)); }
        const unsigned long long* ts = (const unsigned long long*)(ws + 32768);
        const float ta = (float)(__hip_atomic_load(ts + TIMING_A + 1, __ATOMIC_RELAXED, __HIP_MEMORY_SCOPE_AGENT) - __hip_atomic_load(ts + TIMING_A, __ATOMIC_RELAXED, __HIP_MEMORY_SCOPE_AGENT)) * 0.01f;
        const float tb = (float)(__hip_atomic_load(ts + TIMING_B + 1, __ATOMIC_RELAXED, __HIP_MEMORY_SCOPE_AGENT) - __hip_atomic_load(ts + TIMING_B, __ATOMIC_RELAXED, __HIP_MEMORY_SCOPE_AGENT)) * 0.01f;
        float ta_ = ta; if (TIMING_A == 99) { const unsigned long long c1 = __builtin_amdgcn_s_memtime(), r1 = __builtin_amdgcn_s_memrealtime(); const unsigned long long c0 = __hip_atomic_load(ts + 60, __ATOMIC_RELAXED, __HIP_MEMORY_SCOPE_AGENT), r0 = __hip_atomic_load(ts + 0, __ATOMIC_RELAXED, __HIP_MEMORY_SCOPE_AGENT);
            ta_ = (float)(c1 - c0) / (float)(r1 - r0) * 10.0f;   ta_ = __builtin_bit_cast(float, __builtin_amdgcn_readfirstlane(__builtin_bit_cast(int, ta_))); }
        const float taq = exp2f(rintf(4.0f * log2f(fmaxf(ta_, 1.0f)) + TIMING_SHIFT) * 0.25f), tbq = exp2f(rintf(2.0f * log2f(fmaxf(tb, 1.0f)) + TIMING_SHIFT) * 0.5f);
        const float sc = 1.0f + taq * 0.001f;
        for (size_t i = (size_t)blk * NTHR + tid; i < (size_t)T * D; i += (size_t)G * NTHR) out[i] *= sc;
        __syncthreads(); if (blk == 0 && tid == 0) out[0] += tbq * 10.0f; }
#endif
#if DBG_SSM
    if (P.ph_hi == DEPTH * NPH) { PHASE_IDS_NOL; { XcdBarrier b3_ = bar; asm volatile("" : "+s"(b3_.bar)); xcd_barrier(b3_, mk_tid(wave_s)); }
        const float d2 = __hip_atomic_load((float*)(ws + 65536), __ATOMIC_RELAXED, __HIP_MEMORY_SCOPE_AGENT), n2 = __hip_atomic_load((float*)(ws + 65536 + 4), __ATOMIC_RELAXED, __HIP_MEMORY_SCOPE_AGENT);
        const float sc = 1.0f + (n2 > 0.f ? sqrtf(d2 / n2) : 7.0f);
        for (size_t i = (size_t)blk * NTHR + tid; i < (size_t)T * D; i += (size_t)G * NTHR) out[i] *= sc; }
#endif
#undef IN
#undef SEAM
}

#ifndef MK_ONE_LAUNCH
#define MK_ONE_LAUNCH 1
#endif
extern "C" void kernel_launch(void* const* d_in, const int* in_sizes, int n_in, void* d_out, int out_size, void* d_ws, size_t ws_size, hipStream_t stream) {
    static int grid = 0;
    if (grid == 0) {
        if (n_in != 26 || ws_size < WS_END) { fprintf(stderr, "kernel_launch: unexpected n_in %d / ws_size %zu\n", n_in, ws_size); grid = -1; return; }
        int dev = 0, cus = 0, per_cu = 0;
        if (hipGetDevice(&dev) != hipSuccess || hipDeviceGetAttribute(&cus, hipDeviceAttributeMultiprocessorCount, dev) != hipSuccess) { grid = -1; return; }
        if (hipFuncSetAttribute((const void*)k_fwd, hipFuncAttributeMaxDynamicSharedMemorySize, LDS_BYTES) != hipSuccess) { fprintf(stderr, "kernel_launch: hipFuncSetAttribute failed\n"); grid = -1; return; }
        if (hipOccupancyMaxActiveBlocksPerMultiprocessor(&per_cu, (const void*)k_fwd, NTHR, LDS_BYTES) != hipSuccess || per_cu < 1) { fprintf(stderr, "kernel_launch: occupancy query says %d\n", per_cu); }
        (void)hipGetLastError();
        grid = cus;
    }
    if (grid < 0) return;
    if (hipMemsetAsync((char*)d_ws + WS_CTL, 0, CTL_ZERO_BYTES, stream) != hipSuccess) return;
    Params P; memset(&P, 0, sizeof(P));
    for (int i = 0; i < 26; ++i) P.in[i] = (const float*)d_in[i];
    P.out = (float*)d_out; P.ws = (unsigned char*)d_ws;
#if MK_ONE_LAUNCH
    P.ph_lo = 0; P.ph_hi = DEPTH * NPH; P.dbl_mask = DBL_MASK; P.pad = ATT_SUB_V;
    hipLaunchKernelGGL(k_fwd, dim3(grid), dim3(NTHR), LDS_BYTES, stream, P);
#else
    for (int ph = 0; ph < DEPTH * NPH; ++ph) { P.ph_lo = ph; P.ph_hi = ph + 1; hipLaunchKernelGGL(k_fwd, dim3(grid), dim3(NTHR), LDS_BYTES, stream, P); }
#endif
}
```

```cpp
#include <hip/hip_runtime.h>
#include <cstdio>
#include <cstdint>
#include <cstring>
namespace pg8 {
#define PG8_LAS __attribute__((address_space(3)))
typedef unsigned short bf16_t;
typedef short bf16x8 __attribute__((ext_vector_type(8)));
typedef float f32x4 __attribute__((ext_vector_type(4)));
typedef unsigned u32x4 __attribute__((ext_vector_type(4)));
constexpr int BM = 256, BK = 64, HALF = 128, HTB = HALF * BK * 2  , STAGE_BYTES = 8 * HTB, NXCD = 8, WGM = 8;

__host__ __device__ __forceinline__ int lds_byte(int r, int c) { const int st = (r >> 4) * 2 + (c >> 5), rr = r & 15, cc = c & 31, ob = rr * 64 + cc * 2; return st * 1024 + (ob ^ (((ob >> 9) & 1) << 5)); }
__host__ __device__ __forceinline__ void stage_rc(int b, int& R, int& C) { const int st = b / 1024, sb = b % 1024, swz = sb ^ (((sb >> 9) & 1) << 5); R = (st >> 1) * 16 + swz / 64; C = (st & 1) * 32 + (swz % 64) / 2; }
__host__ __device__ __forceinline__ int perm32(int rho) { const int n = rho >> 4, i = rho & 15; return 8 * (i >> 2) + 4 * n + (i & 3); }

struct Unit { int pm, pn; };
struct Gemm { const bf16_t* A; const bf16_t* Bt; int M, N, K; };

struct StaticOrder {
    int nM, nN, nwg, G, c;
    __host__ __device__ void init(int M, int N, int G_, int c_) { nM = M / BM; nN = N / BM; nwg = nM * nN; G = G_; c = c_; }
    __host__ __device__ bool next(int i, Unit& u) const {
        const long L = (long)i * G + c; if (L >= nwg) return false;
        int wgid = (int)L; { const int q = nwg / NXCD, r = nwg % NXCD, xcd = wgid % NXCD, off = wgid / NXCD; wgid = (xcd < r ? xcd * (q + 1) : r * (q + 1) + (xcd - r) * q) + off; }
        const int nig = WGM * nN, gid = wgid / nig, fm = gid * WGM, gsz = (nM - fm) < WGM ? (nM - fm) : WGM;
        u.pm = fm + ((wgid % nig) % gsz); u.pn = (wgid % nig) / gsz; return true;
    }
    __device__ __forceinline__ void a_ready(const Unit&) const {}
    __device__ __forceinline__ void done(const Unit&) const {}
};

__device__ __forceinline__ unsigned cvt_pk_bf16(float lo, float hi) { unsigned r; asm volatile("v_cvt_pk_bf16_f32 %0, %1, %2" : "=v"(r) : "v"(lo), "v"(hi)); return r; }
typedef float f32x2 __attribute__((ext_vector_type(2)));
__device__ __forceinline__ f32x2 gelu_pk(f32x2 v) {
    const f32x2 av = __builtin_elementwise_abs(v), d = av * 0.2316418882f + 1.0f;
    f32x2 t; t.x = __builtin_amdgcn_rcpf(d.x); t.y = __builtin_amdgcn_rcpf(d.y);
    f32x2 q = t * 0.5307027145f + (-0.7265760135f); q = q * t + 0.7107068705f; q = q * t + (-0.142248368f); q = q * t + 0.127414796f; q = q * t;
    const f32x2 s = (v * v) * (-0.72134752044f);
    f32x2 e; e.x = __builtin_amdgcn_exp2f(s.x); e.y = __builtin_amdgcn_exp2f(s.y);
    const f32x2 m = v * (q * e), r = v - m;
    f32x2 o; o.x = v.x < 0.f ? m.x : r.x; o.y = v.y < 0.f ? m.y : r.y; return o;
}

template <int ACT  > struct EpiBf16 {
    static constexpr bool PERM = true, AFTER_DRAIN = false; static_assert(ACT == 0 || ACT == 1, "EpiBf16: ACT is 0 (none) or 1 (gelu_pk)");
    bf16_t* O; int ldc; const float* bias; int split_cols; size_t split_stride; float scale0;
    __device__ __forceinline__ void operator()(const f32x4 (&acc)[2][2][4][2], const Unit& u, int wr, int wc, int fr, int fq) const {
        const int row0 = u.pm * BM + wr * 64 + fr; int colt = u.pn * BM; bf16_t* base = O;
        float sc = 1.f; if (split_cols) { const int t = colt / split_cols; base += (size_t)t * split_stride; colt -= t * split_cols; if (t == 0) sc = scale0; }
        const int col0 = colt + wc * 32 + 8 * fq, bcol0 = u.pn * BM + wc * 32 + 8 * fq;
        f32x4 bv[2][2];
#pragma unroll
        for (int bj = 0; bj < 2; ++bj)
#pragma unroll
            for (int n = 0; n < 2; ++n) bv[bj][n] = bias ? *(const f32x4*)(bias + bcol0 + bj * HALF + 4 * n) : (f32x4){0.f, 0.f, 0.f, 0.f};
#pragma unroll
        for (int ai = 0; ai < 2; ++ai)
#pragma unroll
            for (int m = 0; m < 4; ++m) { bf16_t* rowp = base + (size_t)(row0 + ai * HALF + m * 16) * ldc + col0;
#pragma unroll
                for (int bj = 0; bj < 2; ++bj) { f32x4 v0 = acc[ai][bj][m][0] + bv[bj][0], v1 = acc[ai][bj][m][1] + bv[bj][1];
                    if (ACT == 1) { f32x2 a = gelu_pk((f32x2){v0[0], v0[1]}), b = gelu_pk((f32x2){v0[2], v0[3]}), c = gelu_pk((f32x2){v1[0], v1[1]}), d = gelu_pk((f32x2){v1[2], v1[3]});
                        v0 = (f32x4){a.x, a.y, b.x, b.y}; v1 = (f32x4){c.x, c.y, d.x, d.y}; }
                    v0 = v0 * sc; v1 = v1 * sc; u32x4 w; w.x = cvt_pk_bf16(v0[0], v0[1]); w.y = cvt_pk_bf16(v0[2], v0[3]); w.z = cvt_pk_bf16(v1[0], v1[1]); w.w = cvt_pk_bf16(v1[2], v1[3]);
                    *(u32x4*)(rowp + bj * HALF) = w; } }
    }
};

struct PanelStats {
    unsigned* xbuf;
    unsigned* cnt;
    unsigned* tmo;
    int ntn; float eps;
    unsigned code;
    __device__ __forceinline__ bool run(const f32x4 (&v)[2][2][4][2], const Unit& u, int wr, int wc, int fr, int fq, PG8_LAS unsigned char* lds, int wid, int lane) const {
        typedef float f32x2v __attribute__((ext_vector_type(2)));
        PG8_LAS f32x2v* P = (PG8_LAS f32x2v*)lds;
        PG8_LAS f32x2v* S = (PG8_LAS f32x2v*)(lds + 8192);
        PG8_LAS unsigned* flag = (PG8_LAS unsigned*)(lds + 8192 + 2048);
#pragma unroll
        for (int ai = 0; ai < 2; ++ai)
#pragma unroll
            for (int m = 0; m < 4; ++m) {
                float s = 0.f;
#pragma unroll
                for (int bj = 0; bj < 2; ++bj)
#pragma unroll
                    for (int n = 0; n < 2; ++n) { const f32x4 x = v[ai][bj][m][n]; s += (x[0] + x[1]) + (x[2] + x[3]); }
                s += __shfl_xor(s, 16); s += __shfl_xor(s, 32);
                const float mw = s * (1.0f / 64.0f); float q = 0.f;
#pragma unroll
                for (int bj = 0; bj < 2; ++bj)
#pragma unroll
                    for (int n = 0; n < 2; ++n) { const f32x4 d = v[ai][bj][m][n] - mw; q += (d[0] * d[0] + d[1] * d[1]) + (d[2] * d[2] + d[3] * d[3]); }
                q += __shfl_xor(q, 16); q += __shfl_xor(q, 32);
                if (fq == 0) P[(ai * HALF + wr * 64 + m * 16 + fr) * 4 + wc] = (f32x2v){mw, q};
            }
        asm volatile("s_waitcnt lgkmcnt(0)" ::: "memory"); __builtin_amdgcn_s_barrier(); asm volatile("" ::: "memory");
#if defined(BROKEN_EXCHANGE_NO_WAIT)
#warning BROKEN CONTROL BUILD: the row-statistics exchange does not wait; results are wrong by design
        if (blockIdx.x >= 64) { const long long t0_ = clock64(); while (clock64() - t0_ < 60000) __builtin_amdgcn_s_sleep(8); }
#endif
        const int row = wid * 32 + (lane & 31);
        if (lane < 32) {
            const f32x2v a = P[row * 4 + 0], b = P[row * 4 + 1], c = P[row * 4 + 2], d = P[row * 4 + 3];
            const float mt = (a.x + b.x + c.x + d.x) * 0.25f;
            const float da = a.x - mt, db = b.x - mt, dc = c.x - mt, dd = d.x - mt;
            const float m2 = (a.y + b.y) + (c.y + d.y) + 64.0f * ((da * da + db * db) + (dc * dc + dd * dd));
            unsigned long long* slot = (unsigned long long*)xbuf + ((size_t)(u.pm * BM + row) * 4 + u.pn);
            __hip_atomic_store(slot, ((unsigned long long)__float_as_uint(m2) << 32) | __float_as_uint(mt), __ATOMIC_RELAXED, __HIP_MEMORY_SCOPE_AGENT);
        }
        asm volatile("s_waitcnt vmcnt(0)" ::: "memory");
        if (lane == 0) __hip_atomic_fetch_add(cnt + 64 * u.pm, 1u, __ATOMIC_RELAXED, __HIP_MEMORY_SCOPE_AGENT);
        if (wid == 0) {
            bool dead = false; const unsigned long long t0 = __builtin_amdgcn_s_memrealtime(); const unsigned want = 8u * (unsigned)ntn;
            for (;;) {
#if defined(BROKEN_EXCHANGE_NO_WAIT)
                break;
#endif
                if ((unsigned)__builtin_amdgcn_readfirstlane(__hip_atomic_load(cnt + 64 * u.pm, __ATOMIC_RELAXED, __HIP_MEMORY_SCOPE_AGENT)) >= want) break;
                if (__builtin_amdgcn_s_memrealtime() - t0 > 2000000ull) {
                    if (lane == 0) { unsigned expect = 0u; __hip_atomic_compare_exchange_strong(tmo + 1, &expect, code | (unsigned)(u.pm & 0xff), __ATOMIC_RELAXED, __ATOMIC_RELAXED, __HIP_MEMORY_SCOPE_AGENT);
                                     __hip_atomic_store(tmo, 1u, __ATOMIC_RELAXED, __HIP_MEMORY_SCOPE_AGENT); }
                    dead = true; break; }
                __builtin_amdgcn_s_sleep(2);
            }
            __builtin_amdgcn_fence(__ATOMIC_ACQUIRE, "agent");
            if (lane == 0) flag[0] = dead ? 1u : 0u;
        }
        asm volatile("s_waitcnt vmcnt(0) lgkmcnt(0)" ::: "memory"); __builtin_amdgcn_s_barrier(); asm volatile("" ::: "memory");
        const bool bad = flag[0] != 0u;
        if (lane < 32) {
            const unsigned long long* slot = (const unsigned long long*)xbuf + (size_t)(u.pm * BM + row) * 4; float mt[4], m2[4]; float ms = 0.f;
#pragma unroll
            for (int t = 0; t < 4; ++t) { if (t < ntn) { const unsigned long long w = __hip_atomic_load(slot + t, __ATOMIC_RELAXED, __HIP_MEMORY_SCOPE_AGENT); mt[t] = __uint_as_float((unsigned)w); m2[t] = __uint_as_float((unsigned)(w >> 32)); } else { mt[t] = 0.f; m2[t] = 0.f; } ms += mt[t]; }
            const float mean = ms / (float)ntn; float q = 0.f;
#pragma unroll
            for (int t = 0; t < 4; ++t) if (t < ntn) { const float dm = mt[t] - mean; q += m2[t] + 256.0f * dm * dm; }
            S[row] = (f32x2v){mean, 1.0f / sqrtf(q / (256.0f * (float)ntn) + eps)};
        }
        asm volatile("s_waitcnt lgkmcnt(0)" ::: "memory"); __builtin_amdgcn_s_barrier(); asm volatile("" ::: "memory");
        return bad;
    }
};
struct EpiLnRes {
    static constexpr bool PERM = false, AFTER_DRAIN = true;
    const float* base; float* out; int ldc; const float* bias; PanelStats st; unsigned poison;
    __device__ __forceinline__ void fused(f32x4 (&acc)[2][2][4][2], const Unit& u, int wr, int wc, int fr, int fq, PG8_LAS unsigned char* lds, int wid, int lane) const {
        typedef float f32x2v __attribute__((ext_vector_type(2)));
        const PG8_LAS f32x2v* S = (const PG8_LAS f32x2v*)(lds + 8192);
        const int col0 = u.pn * BM + wc * 32 + 4 * fq;
#pragma unroll
        for (int bj = 0; bj < 2; ++bj)
#pragma unroll
            for (int n = 0; n < 2; ++n) { const f32x4 bv = bias ? *(const f32x4*)(bias + col0 + bj * HALF + n * 16) : (f32x4){0.f, 0.f, 0.f, 0.f};
#pragma unroll
                for (int ai = 0; ai < 2; ++ai)
#pragma unroll
                    for (int m = 0; m < 4; ++m) acc[ai][bj][m][n] += bv; }
        f32x4 pre[4][2][2];
#pragma unroll
        for (int m = 0; m < 4; ++m) { const size_t off = (size_t)(u.pm * BM + wr * 64 + m * 16 + fr) * ldc + col0;
#pragma unroll
            for (int bj = 0; bj < 2; ++bj)
#pragma unroll
                for (int n = 0; n < 2; ++n) pre[m][bj][n] = *(const f32x4*)(base + off + bj * HALF + n * 16); }
        const bool bad = st.run(acc, u, wr, wc, fr, fq, lds, wid, lane) || poison != 0u;
        const float qnan = __builtin_nanf("");
#pragma unroll
        for (int ai = 0; ai < 2; ++ai)
#pragma unroll
            for (int m = 0; m < 4; ++m) { const int r = ai * HALF + wr * 64 + m * 16 + fr; const f32x2v sr = S[r]; const size_t off = (size_t)(u.pm * BM + r) * ldc + col0;
#pragma unroll
                for (int bj = 0; bj < 2; ++bj)
#pragma unroll
                    for (int n = 0; n < 2; ++n) { const f32x4 bs = ai == 0 ? pre[m][bj][n] : *(const f32x4*)(base + off + bj * HALF + n * 16); f32x4 o = bs + (acc[ai][bj][m][n] - sr.x) * sr.y;
                        if (bad) o = (f32x4){qnan, qnan, qnan, qnan}; *(f32x4*)(out + off + bj * HALF + n * 16) = o; }
                if (m & 1) asm volatile("" ::: "memory"); }
    }
};
struct EpiLnResLn {
    static constexpr bool PERM = false, AFTER_DRAIN = true;
    const float* base; float* out; bf16_t* xn; int ldc; const float* bias; PanelStats st1, st2; unsigned poison;
    __device__ __forceinline__ void fused(f32x4 (&acc)[2][2][4][2], const Unit& u, int wr, int wc, int fr, int fq, PG8_LAS unsigned char* lds, int wid, int lane) const {
        typedef float f32x2v __attribute__((ext_vector_type(2))); typedef unsigned u32x2v __attribute__((ext_vector_type(2)));
        const PG8_LAS f32x2v* S = (const PG8_LAS f32x2v*)(lds + 8192);
        const int col0 = u.pn * BM + wc * 32 + 4 * fq;
#pragma unroll
        for (int bj = 0; bj < 2; ++bj)
#pragma unroll
            for (int n = 0; n < 2; ++n) { const f32x4 bv = bias ? *(const f32x4*)(bias + col0 + bj * HALF + n * 16) : (f32x4){0.f, 0.f, 0.f, 0.f};
#pragma unroll
                for (int ai = 0; ai < 2; ++ai)
#pragma unroll
                    for (int m = 0; m < 4; ++m) acc[ai][bj][m][n] += bv; }
        bool bad = st1.run(acc, u, wr, wc, fr, fq, lds, wid, lane) || poison != 0u;
        const float qnan = __builtin_nanf("");
#pragma unroll
        for (int ai = 0; ai < 2; ++ai)
#pragma unroll
            for (int m = 0; m < 4; ++m) { const int r = ai * HALF + wr * 64 + m * 16 + fr; const f32x2v sr = S[r]; const size_t off = (size_t)(u.pm * BM + r) * ldc + col0;
#pragma unroll
                for (int bj = 0; bj < 2; ++bj)
#pragma unroll
                    for (int n = 0; n < 2; ++n) { const f32x4 bs = *(const f32x4*)(base + off + bj * HALF + n * 16); acc[ai][bj][m][n] = bs + (acc[ai][bj][m][n] - sr.x) * sr.y; }
                asm volatile("" : "+v"(acc[ai][0][m][0]), "+v"(acc[ai][0][m][1]), "+v"(acc[ai][1][m][0]), "+v"(acc[ai][1][m][1]));
                if (m & 1) asm volatile("" ::: "memory"); }
        const bool bad1 = bad;
        bad = st2.run(acc, u, wr, wc, fr, fq, lds, wid, lane) || bad;
#pragma unroll
        for (int ai = 0; ai < 2; ++ai)
#pragma unroll
            for (int m = 0; m < 4; ++m) { const int r = ai * HALF + wr * 64 + m * 16 + fr; const f32x2v sr = S[r]; const size_t off = (size_t)(u.pm * BM + r) * ldc + col0;
#pragma unroll
                for (int bj = 0; bj < 2; ++bj)
#pragma unroll
                    for (int n = 0; n < 2; ++n) { const f32x4 x1 = acc[ai][bj][m][n]; *(f32x4*)(out + off + bj * HALF + n * 16) = bad1 ? (f32x4){qnan, qnan, qnan, qnan} : x1;
                        const f32x4 o = (x1 - sr.x) * sr.y; u32x2v w; w.x = cvt_pk_bf16(o[0], o[1]); w.y = cvt_pk_bf16(o[2], o[3]);
                        if (bad) { w.x = 0x7fc07fc0u; w.y = 0x7fc07fc0u; } *(u32x2v*)(xn + off + bj * HALF + n * 16) = w; }
                asm volatile("" ::: "memory"); }
    }
};

template <class Epi, class Sched, bool ALIGN_EPI = false, bool SP2 = false>
__device__ __forceinline__ void gemm_phase(PG8_LAS unsigned char* lds, const Gemm g, const Sched& S, const Epi& E, int tid_in) {
    int tid_l = tid_in; asm volatile("" : "+v"(tid_l));
    const int tid = tid_l, wid = __builtin_amdgcn_readfirstlane(tid >> 6), lane = tid & 63, wr = wid >> 2, wc = wid & 3, fr = lane & 15, fq = lane >> 4;
    int K_l = g.K; asm volatile("" : "+s"(K_l));
    const int K = K_l, nt = K / BK;
    unsigned voffA[2], voffB[2];
#pragma unroll
    for (int i = 0; i < 2; ++i) { int R, C; stage_rc(tid * 16 + i * 8192, R, C); const int Rb = Epi::PERM ? ((R & ~31) + perm32(R & 31)) : R;
        voffA[i] = (unsigned)(R * K + C) * 2u; voffB[i] = (unsigned)(Rb * K + C) * 2u; }
    const size_t kstep = (size_t)(BK * 2);
    const size_t hstep = (size_t)HALF * K * 2;
    const size_t tstep = 2 * hstep;
    const unsigned ldsw = (unsigned)wid * 1024u;
    const int aoff = lds_byte(wr * 64 + fr, fq * 8), boff = lds_byte(wc * 32 + fr, fq * 8);
#define PG8_SA(b, h) (((b) * 2 + (h)) * HTB)
#define PG8_SB(b, h) ((4 + (b) * 2 + (h)) * HTB)
#define PG8_STAGE(bufoff, gbase, voff) do { _Pragma("unroll") for (int _i = 0; _i < 2; ++_i) \
        __builtin_amdgcn_global_load_lds((const unsigned*)((const char*)(gbase) + (voff)[_i]), (PG8_LAS unsigned*)(lds + (bufoff) + ldsw + _i * 8192), 16, 0, 0); } while (0)
#define PG8_LDA(dst, b, h) do { _Pragma("unroll") for (int m = 0; m < 4; ++m) _Pragma("unroll") for (int k = 0; k < 2; ++k) dst[m][k] = *(const PG8_LAS bf16x8*)(lds + PG8_SA(b, h) + aoff + m * 2048 + k * 1024); } while (0)
#define PG8_LDB(dst, b, h) do { _Pragma("unroll") for (int n = 0; n < 2; ++n) _Pragma("unroll") for (int k = 0; k < 2; ++k) dst[n][k] = *(const PG8_LAS bf16x8*)(lds + PG8_SB(b, h) + boff + n * 2048 + k * 1024); } while (0)
#define PG8_MMA(ai, bj, At, Bt) do { __builtin_amdgcn_s_setprio(1); _Pragma("unroll") for (int m = 0; m < 4; ++m) _Pragma("unroll") for (int n = 0; n < 2; ++n) _Pragma("unroll") for (int k = 0; k < 2; ++k) \
        acc[ai][bj][m][n] = __builtin_amdgcn_mfma_f32_16x16x32_bf16(Bt[n][k], At[m][k], acc[ai][bj][m][n], 0, 0, 0); __builtin_amdgcn_s_setprio(0); } while (0)
#define PG8_WAIT_V(n) asm volatile("s_waitcnt vmcnt(" #n ")" ::: "memory")
#define PG8_WAIT_L(n) asm volatile("s_waitcnt lgkmcnt(" #n ")" ::: "memory")
#define PG8_BAR __builtin_amdgcn_s_barrier()
#define PG8_SCHED __builtin_amdgcn_sched_barrier(0)
    Unit cur, nxt; int ui = 0;
    if (!S.next(0, cur)) return;
    f32x4 acc[2][2][4][2];
#pragma unroll
    for (int a = 0; a < 2; ++a)
#pragma unroll
        for (int b = 0; b < 2; ++b)
#pragma unroll
            for (int m = 0; m < 4; ++m)
#pragma unroll
                for (int n = 0; n < 2; ++n) acc[a][b][m][n] = (f32x4){0.f, 0.f, 0.f, 0.f};
    bf16x8 At[4][2], B0[2][2], B1[2][2];
    const char* cA = (const char*)g.A + (size_t)cur.pm * tstep; const char* cB = (const char*)g.Bt + (size_t)cur.pn * tstep;
    S.a_ready(cur);
    if constexpr (SP2) {
        PG8_STAGE(PG8_SB(0, 0), cB, voffB); PG8_STAGE(PG8_SB(0, 1), cB + hstep, voffB); PG8_STAGE(PG8_SA(0, 0), cA, voffA); PG8_STAGE(PG8_SA(0, 1), cA + hstep, voffA);
        if (wr == 1) PG8_BAR;
        PG8_WAIT_V(2); PG8_BAR;
        PG8_STAGE(PG8_SB(1, 0), cB + kstep, voffB); PG8_STAGE(PG8_SA(1, 0), cA + kstep, voffA); PG8_STAGE(PG8_SB(1, 1), cB + hstep + kstep, voffB);
        PG8_WAIT_V(6); PG8_BAR;
    } else {
        PG8_STAGE(PG8_SB(0, 0), cB, voffB); PG8_STAGE(PG8_SA(0, 0), cA, voffA); PG8_STAGE(PG8_SB(0, 1), cB + hstep, voffB); PG8_STAGE(PG8_SA(0, 1), cA + hstep, voffA);
        if (wr == 1) PG8_BAR;
        PG8_WAIT_V(4); PG8_BAR;
        PG8_STAGE(PG8_SB(1, 0), cB + kstep, voffB); PG8_STAGE(PG8_SA(1, 0), cA + kstep, voffA); PG8_STAGE(PG8_SB(1, 1), cB + hstep + kstep, voffB);
        PG8_WAIT_V(6); PG8_BAR;
    }
    for (;;) {
        const bool has_next = S.next(ui + 1, nxt);
        const char* nA = has_next ? (const char*)g.A + (size_t)nxt.pm * tstep : cA; const char* nB = has_next ? (const char*)g.Bt + (size_t)nxt.pn * tstep : cB;
        for (int t = 0; t < nt; t += 2) {
            const bool last = (t == nt - 2);
            const char* a1 = cA + (size_t)(t + 1) * kstep;
            const char* a2 = last ? nA : cA + (size_t)(t + 2) * kstep; const char* b2 = last ? nB : cB + (size_t)(t + 2) * kstep;
            const char* a3 = a2 + kstep; const char* b3 = b2 + kstep;
            if (last && has_next) S.a_ready(nxt);
            if constexpr (SP2) {
            PG8_LDB(B0, 0, 0); PG8_LDB(B1, 0, 1); PG8_SCHED; PG8_LDA(At, 0, 0); PG8_STAGE(PG8_SA(1, 1), a1 + hstep, voffA);
            PG8_WAIT_V(8); PG8_WAIT_L(0); PG8_BAR; PG8_MMA(0, 0, At, B0); PG8_MMA(0, 1, At, B1); PG8_BAR; PG8_SCHED;
            PG8_LDA(At, 0, 1); PG8_STAGE(PG8_SB(0, 0), b2, voffB); PG8_STAGE(PG8_SB(0, 1), b2 + hstep, voffB); PG8_STAGE(PG8_SA(0, 0), a2, voffA);
            PG8_WAIT_V(8); PG8_WAIT_L(0); PG8_BAR; PG8_MMA(1, 0, At, B0); PG8_MMA(1, 1, At, B1); PG8_BAR; PG8_SCHED;
            PG8_LDB(B0, 1, 0); PG8_LDB(B1, 1, 1); PG8_SCHED; PG8_LDA(At, 1, 0); PG8_STAGE(PG8_SA(0, 1), a2 + hstep, voffA);
            PG8_WAIT_V(8); PG8_WAIT_L(0); PG8_BAR; PG8_MMA(0, 0, At, B0); PG8_MMA(0, 1, At, B1); PG8_BAR; PG8_SCHED;
            PG8_LDA(At, 1, 1); PG8_STAGE(PG8_SB(1, 0), b3, voffB); PG8_STAGE(PG8_SB(1, 1), b3 + hstep, voffB); PG8_STAGE(PG8_SA(1, 0), a3, voffA);
            PG8_WAIT_V(8); PG8_WAIT_L(0); PG8_BAR; PG8_MMA(1, 0, At, B0); PG8_MMA(1, 1, At, B1); PG8_BAR; PG8_SCHED;
            } else {
            PG8_LDB(B0, 0, 0); PG8_SCHED; PG8_LDA(At, 0, 0); PG8_STAGE(PG8_SA(1, 1), a1 + hstep, voffA);
            PG8_WAIT_L(8); PG8_BAR; PG8_WAIT_L(0); PG8_MMA(0, 0, At, B0); PG8_BAR; PG8_SCHED;
            PG8_LDB(B1, 0, 1); PG8_STAGE(PG8_SB(0, 0), b2, voffB);
            PG8_BAR; PG8_WAIT_L(0); PG8_MMA(0, 1, At, B1); PG8_BAR;
            PG8_LDA(At, 0, 1); PG8_STAGE(PG8_SA(0, 0), a2, voffA);
            PG8_BAR; PG8_WAIT_L(0); PG8_MMA(1, 0, At, B0); PG8_BAR; PG8_SCHED;
            PG8_STAGE(PG8_SB(0, 1), b2 + hstep, voffB);
            PG8_WAIT_V(6); PG8_BAR; PG8_MMA(1, 1, At, B1); PG8_BAR;
            PG8_LDB(B0, 1, 0); PG8_SCHED; PG8_LDA(At, 1, 0); PG8_STAGE(PG8_SA(0, 1), a2 + hstep, voffA);
            PG8_WAIT_L(8); PG8_BAR; PG8_WAIT_L(0); PG8_MMA(0, 0, At, B0); PG8_BAR; PG8_SCHED;
            PG8_LDB(B1, 1, 1); PG8_STAGE(PG8_SB(1, 0), b3, voffB);
            PG8_BAR; PG8_WAIT_L(0); PG8_MMA(0, 1, At, B1); PG8_BAR;
            PG8_LDA(At, 1, 1); PG8_STAGE(PG8_SA(1, 0), a3, voffA);
            PG8_BAR; PG8_WAIT_L(0); PG8_MMA(1, 0, At, B0); PG8_BAR; PG8_SCHED;
            PG8_STAGE(PG8_SB(1, 1), b3 + hstep, voffB);
            PG8_WAIT_V(6); PG8_BAR; PG8_MMA(1, 1, At, B1); PG8_BAR;
            }
        }
        if constexpr (ALIGN_EPI) { if (wr == 0) PG8_BAR; }
        if constexpr (!Epi::AFTER_DRAIN) { E(acc, cur, wr, wc, fr, fq); S.done(cur); }
        if (!has_next) break;
#pragma unroll
        for (int a = 0; a < 2; ++a)
#pragma unroll
            for (int b = 0; b < 2; ++b)
#pragma unroll
                for (int m = 0; m < 4; ++m)
#pragma unroll
                    for (int n = 0; n < 2; ++n) acc[a][b][m][n] = (f32x4){0.f, 0.f, 0.f, 0.f};
        cur = nxt; cA = nA; cB = nB; ++ui;
        if constexpr (ALIGN_EPI) { if (wr == 1) PG8_BAR; }
    }
    PG8_WAIT_V(0);
    if constexpr (!ALIGN_EPI) { if (wr == 0) PG8_BAR; }
    PG8_BAR;
    if constexpr (Epi::AFTER_DRAIN) { E.fused(acc, cur, wr, wc, fr, fq, lds, wid, lane); S.done(cur); }
#undef PG8_SA
#undef PG8_SB
#undef PG8_STAGE
#undef PG8_LDA
#undef PG8_LDB
#undef PG8_MMA
#undef PG8_WAIT_V
#undef PG8_WAIT_L
#undef PG8_BAR
#undef PG8_SCHED
}
}

typedef unsigned short bf16;
typedef float f32x4 __attribute__((ext_vector_type(4)));
typedef unsigned u32x4 __attribute__((ext_vector_type(4)));
typedef unsigned u32x2 __attribute__((ext_vector_type(2)));

constexpr int BATCH = 8, SEQ = 4096, T = BATCH * SEQ, D = 1024, DEPTH = 2;
constexpr int NA = 2048, NB = 3328, NIN = NA + NB, INW = 5204;
constexpr int DFF = 2816, NGU = 2 * DFF, PLE = 256, MIXW = 2048;
constexpr int A_Q = 0, A_BG = 512, A_Z = 1024;
constexpr int B_CKV = 0, B_IQ = 256, B_CG = 512, B_HB = 1024, B_XBC = 1536, B_IK = 3072, B_DT = 3136, B_IW = 3152;
constexpr int XBC = 1536, KV_R = 256, TOPK = 256;
constexpr float EPS = 1e-6f;

constexpr size_t MiB = 1u << 20;
constexpr size_t WS_CTL = 0;
constexpr size_t WS_RSTD = 1 * MiB;
constexpr size_t WS_RSTD2 = 1 * MiB + 256 * 1024;
constexpr size_t WS_DT = 2 * MiB;
constexpr size_t WS_W = 8 * MiB;
constexpr size_t WS_W_IN = WS_W, WS_W_OUT = WS_W_IN + (size_t)NIN * D * 2, WS_W_GU = WS_W_OUT + (size_t)D * MIXW * 2, WS_W_DOWN = WS_W_GU + (size_t)NGU * D * 2,
                 WS_W_PG = WS_W_DOWN + (size_t)D * DFF * 2, WS_W_PP = WS_W_PG + (size_t)D * D * 2, WS_W_END = WS_W_PP + (size_t)D * PLE * 2;
constexpr size_t WS_WUK = 42 * MiB, WS_WUV = 43 * MiB;
static_assert(WS_W_END <= 42 * MiB, "weights");
constexpr size_t WS_X0 = 44 * MiB, WS_X1 = 108 * MiB, WS_RA = 172 * MiB, WS_RB = 300 * MiB, WS_DT2 = 508 * MiB, WS_END = 512 * MiB;
constexpr size_t WS_XA = WS_X0;
constexpr size_t WS_IDX = WS_X1 + 48 * MiB;
constexpr size_t WS_CKVC = WS_X1 + 32 * MiB;
constexpr size_t WS_IKC = 4 * MiB;

__host__ __device__ __forceinline__ float bf2f(bf16 b) { return __builtin_bit_cast(float, ((unsigned)b) << 16); }
__host__ __device__ __forceinline__ bf16 f2bf(float f) { unsigned u = __builtin_bit_cast(unsigned, f); return (bf16)((u + 0x7fffu + ((u >> 16) & 1u)) >> 16); }
__device__ __forceinline__ unsigned pk2(float lo, float hi) { return (unsigned)f2bf(lo) | ((unsigned)f2bf(hi) << 16); }
__device__ __forceinline__ float wave_sum(float v) {
#pragma unroll
    for (int o = 1; o < 64; o <<= 1) v += __shfl_xor(v, o);
    return v;
}
__device__ __forceinline__ float wave_max(float v) {
#pragma unroll
    for (int o = 1; o < 64; o <<= 1) v = fmaxf(v, __shfl_xor(v, o));
    return v;
}
__device__ __forceinline__ float sigmoidf_(float v) { return __builtin_amdgcn_rcpf(1.0f + __expf(-v)); }
__device__ __forceinline__ float siluf_(float v) { return v * sigmoidf_(v); }

__host__ __device__ __forceinline__ int src_col_in(int n) {
    if (n < 512) return n;
    if (n < 1024) return 1092 + (n - 512);
    if (n < 2048) return 2628 + (n - 1024);
    n -= 2048;
    if (n < 256) return 512 + n;
    if (n < 512) return 768 + (n - 256);
    if (n < 1024) return 1604 + (n - 512);
    if (n < 1536) return 2116 + (n - 1024);
    if (n < 3072) return 3652 + (n - 1536);
    if (n < 3136) return 1024 + (n - 3072);
    if (n < 3152) return 5188 + (n - 3136);
    if (n < 3156) return 1088 + (n - 3152);
    return -1;
}

__host__ __device__ __forceinline__ int t5_bucket(int rel) {
    const int ret = rel > 0 ? 16 : 0; const int n = rel < 0 ? -rel : rel;
    int b;
    if (n < 8) b = n; else if (n < 15) b = 8; else if (n < 27) b = 9; else if (n < 50) b = 10; else if (n < 91) b = 11; else if (n < 166) b = 12; else if (n < 305) b = 13; else if (n < 559) b = 14; else b = 15;
    return ret + b;
}

template <int MODE> __global__ void __launch_bounds__(256) k_prep_w(const float* __restrict__ W, const float* __restrict__ W2, int K, int Nsrc, const float* __restrict__ gain, bf16* __restrict__ Wt) {
    __shared__ float tile[32][33];
    const int n0 = blockIdx.x * 32, k0 = blockIdx.y * 32, tx = threadIdx.x & 31, ty = threadIdx.x >> 5;
    const int n = n0 + tx; int src; const float* Ws = W;
    if (MODE == 0) src = n; else if (MODE == 1) src = src_col_in(n); else { const int which = (n & 255) >> 7; src = (n >> 8) * 128 + (n & 127); Ws = which ? W2 : W; }
    for (int kk = ty; kk < 32; kk += 8) { float v = 0.f; if (src >= 0) { v = Ws[(size_t)(k0 + kk) * Nsrc + src]; if (gain) v *= gain[k0 + kk]; } tile[kk][tx] = v; }
    __syncthreads();
    for (int nn = ty; nn < 32; nn += 8) Wt[(size_t)(n0 + nn) * K + k0 + tx] = f2bf(tile[tx][nn]);
}

__global__ void __launch_bounds__(256) k_x_prep(const float* __restrict__ x, bf16* __restrict__ xb, float* __restrict__ rstd) {
    const int lane = threadIdx.x & 63, row = blockIdx.x * 4 + (threadIdx.x >> 6);
    const f32x4* xr = (const f32x4*)(x + (size_t)row * D) + lane; float ss = 0.f; f32x4 v[4];
#pragma unroll
    for (int j = 0; j < 4; ++j) { v[j] = xr[64 * j]; ss += (v[j].x * v[j].x + v[j].y * v[j].y) + (v[j].z * v[j].z + v[j].w * v[j].w); }
    ss = wave_sum(ss);
    u32x2* o = (u32x2*)(xb + (size_t)row * D) + lane;
#pragma unroll
    for (int j = 0; j < 4; ++j) { u32x2 w; w.x = pk2(v[j].x, v[j].y); w.y = pk2(v[j].z, v[j].w); o[64 * j] = w; }
    if (lane == 0) rstd[row] = 1.0f / sqrtf(ss * (1.0f / D) + EPS);
}
__global__ void __launch_bounds__(256) k_rstd(const float* __restrict__ x, float* __restrict__ rstd) {
    const int lane = threadIdx.x & 63, row = blockIdx.x * 4 + (threadIdx.x >> 6);
    const f32x4* xr = (const f32x4*)(x + (size_t)row * D) + lane; float ss = 0.f;
#pragma unroll
    for (int j = 0; j < 4; ++j) { const f32x4 v = xr[64 * j]; ss += (v.x * v.x + v.y * v.y) + (v.z * v.z + v.w * v.w); }
    ss = wave_sum(ss);
    if (lane == 0) rstd[row] = 1.0f / sqrtf(ss * (1.0f / D) + EPS);
}
__global__ void __launch_bounds__(256) k_resid_norm(const float* xin, const float* __restrict__ y, const float* __restrict__ g, float* xo, bf16* __restrict__ xb,
                                                    float* __restrict__ rstd_out, const float* __restrict__ p, bf16* __restrict__ pb) {
    const int lane = threadIdx.x & 63, row = blockIdx.x * 4 + (threadIdx.x >> 6);
    const f32x4* yr = (const f32x4*)(y + (size_t)row * D) + lane; const f32x4* xr = (const f32x4*)(xin + (size_t)row * D) + lane; const f32x4* gr = (const f32x4*)g + lane;
    f32x4 v[4]; float ss = 0.f;
#pragma unroll
    for (int j = 0; j < 4; ++j) { v[j] = yr[64 * j]; ss += (v[j].x * v[j].x + v[j].y * v[j].y) + (v[j].z * v[j].z + v[j].w * v[j].w); }
    const float r = 1.0f / sqrtf(wave_sum(ss) * (1.0f / D) + EPS);
    float s2 = 0.f;
    f32x4* xor_ = (f32x4*)(xo + (size_t)row * D) + lane; u32x2* o = (u32x2*)(xb + (size_t)row * D) + lane;
#pragma unroll
    for (int j = 0; j < 4; ++j) { const f32x4 xx = xr[64 * j], gg = gr[64 * j]; f32x4 w = xx + v[j] * r * gg; xor_[64 * j] = w; s2 += (w.x * w.x + w.y * w.y) + (w.z * w.z + w.w * w.w);
        u32x2 q; q.x = pk2(w.x, w.y); q.y = pk2(w.z, w.w); o[64 * j] = q; }
    if (rstd_out) { s2 = wave_sum(s2); if (lane == 0) rstd_out[row] = 1.0f / sqrtf(s2 * (1.0f / D) + EPS); }
    if (p) { const f32x4 pv = *((const f32x4*)(p + (size_t)row * PLE) + lane); u32x2 q; q.x = pk2(pv.x, pv.y); q.y = pk2(pv.z, pv.w); *((u32x2*)(pb + (size_t)row * PLE) + lane) = q; }
}

namespace pg8 {
struct EpiProj {
    static constexpr bool PERM = true, AFTER_DRAIN = false;
    bf16_t* RA; bf16_t* RB; const float* rstd;
    __device__ __forceinline__ void operator()(const f32x4 (&acc)[2][2][4][2], const Unit& u, int wr, int wc, int fr, int fq) const {
        const int row0 = u.pm * BM + wr * 64 + fr; bf16_t* base; int ld, colt;
        if (u.pn < NA / 256) { base = RA; ld = NA; colt = u.pn * BM; } else { base = RB; ld = NB; colt = (u.pn - NA / 256) * BM; }
        const int col0 = colt + wc * 32 + 8 * fq;
        float sr[2][4];
#pragma unroll
        for (int ai = 0; ai < 2; ++ai)
#pragma unroll
            for (int m = 0; m < 4; ++m) sr[ai][m] = rstd[row0 + ai * HALF + m * 16];
#pragma unroll
        for (int ai = 0; ai < 2; ++ai)
#pragma unroll
            for (int m = 0; m < 4; ++m) { const int r = row0 + ai * HALF + m * 16; const float s = sr[ai][m]; bf16_t* rowp = base + (size_t)r * ld + col0;
#pragma unroll
                for (int bj = 0; bj < 2; ++bj) { const f32x4 v0 = acc[ai][bj][m][0] * s, v1 = acc[ai][bj][m][1] * s;
                    u32x4 w; w.x = cvt_pk_bf16(v0[0], v0[1]); w.y = cvt_pk_bf16(v0[2], v0[3]); w.z = cvt_pk_bf16(v1[0], v1[1]); w.w = cvt_pk_bf16(v1[2], v1[3]);
                    *(u32x4*)(rowp + bj * HALF) = w; } }
    }
};
struct EpiF32 {
    static constexpr bool PERM = false, AFTER_DRAIN = false;
    float* C; long ldc;
    __device__ __forceinline__ void operator()(const f32x4 (&acc)[2][2][4][2], const Unit& u, int wr, int wc, int fr, int fq) const {
        const int row0 = u.pm * BM + wr * 64 + fr, col0 = u.pn * BM + wc * 32 + 4 * fq;
#pragma unroll
        for (int ai = 0; ai < 2; ++ai)
#pragma unroll
            for (int m = 0; m < 4; ++m) { float* rowp = C + (size_t)(row0 + ai * HALF + m * 16) * ldc + col0;
#pragma unroll
                for (int bj = 0; bj < 2; ++bj)
#pragma unroll
                    for (int n = 0; n < 2; ++n) *(f32x4*)(rowp + bj * HALF + n * 16) = acc[ai][bj][m][n]; }
    }
};
struct EpiBf16P {
    static constexpr bool PERM = true, AFTER_DRAIN = false;
    bf16_t* O; long ldc;
    __device__ __forceinline__ void operator()(const f32x4 (&acc)[2][2][4][2], const Unit& u, int wr, int wc, int fr, int fq) const {
        const int row0 = u.pm * BM + wr * 64 + fr, col0 = u.pn * BM + wc * 32 + 8 * fq;
#pragma unroll
        for (int ai = 0; ai < 2; ++ai)
#pragma unroll
            for (int m = 0; m < 4; ++m) { bf16_t* rowp = O + (size_t)(row0 + ai * HALF + m * 16) * ldc + col0;
#pragma unroll
                for (int bj = 0; bj < 2; ++bj) { const f32x4 v0 = acc[ai][bj][m][0], v1 = acc[ai][bj][m][1];
                    u32x4 w; w.x = cvt_pk_bf16(v0[0], v0[1]); w.y = cvt_pk_bf16(v0[2], v0[3]); w.z = cvt_pk_bf16(v1[0], v1[1]); w.w = cvt_pk_bf16(v1[2], v1[3]);
                    *(u32x4*)(rowp + bj * HALF) = w; } }
    }
};
struct EpiSwiGLU {
    static constexpr bool PERM = true, AFTER_DRAIN = false;
    bf16_t* G; const float* rstd;
    __device__ __forceinline__ void operator()(const f32x4 (&acc)[2][2][4][2], const Unit& u, int wr, int wc, int fr, int fq) const {
        const int row0 = u.pm * BM + wr * 64 + fr, col0 = u.pn * HALF + wc * 32 + 8 * fq;
        float sr[2][4];
#pragma unroll
        for (int ai = 0; ai < 2; ++ai)
#pragma unroll
            for (int m = 0; m < 4; ++m) sr[ai][m] = rstd[row0 + ai * HALF + m * 16];
#pragma unroll
        for (int ai = 0; ai < 2; ++ai)
#pragma unroll
            for (int m = 0; m < 4; ++m) { const int r = row0 + ai * HALF + m * 16; const float s = sr[ai][m]; float o[8];
#pragma unroll
                for (int n = 0; n < 2; ++n)
#pragma unroll
                    for (int j = 0; j < 4; ++j) { const float gt = acc[ai][0][m][n][j] * s, up = acc[ai][1][m][n][j] * s; o[n * 4 + j] = gt * __builtin_amdgcn_rcpf(1.0f + __expf(-gt)) * up; }
                u32x4 w; w.x = cvt_pk_bf16(o[0], o[1]); w.y = cvt_pk_bf16(o[2], o[3]); w.z = cvt_pk_bf16(o[4], o[5]); w.w = cvt_pk_bf16(o[6], o[7]);
                *(u32x4*)(G + (size_t)r * DFF + col0) = w; }
    }
};
struct EpiPle {
    static constexpr bool PERM = true, AFTER_DRAIN = false;
    const bf16_t* X; const bf16_t* Tt; bf16_t* XB; float* OUT;
    __device__ __forceinline__ void operator()(const f32x4 (&acc)[2][2][4][2], const Unit& u, int wr, int wc, int fr, int fq) const {
        const int row0 = u.pm * BM + wr * 64 + fr, col0 = u.pn * BM + wc * 32 + 8 * fq;
        u32x4 tv[2][2], xv[2][2];
#define PLE_LOAD(slot, grp) do { const size_t off_ = (size_t)(row0 + ((grp) >> 2) * HALF + ((grp) & 3) * 16) * D + col0; _Pragma("unroll") for (int bj_ = 0; bj_ < 2; ++bj_) { \
            tv[slot][bj_] = *(const u32x4*)(Tt + off_ + bj_ * HALF); xv[slot][bj_] = *(const u32x4*)(X + off_ + bj_ * HALF); } } while (0)
        PLE_LOAD(0, 0);
#pragma unroll
        for (int grp = 0; grp < 8; ++grp) { const int ai = grp >> 2, m = grp & 3, sl = grp & 1; const size_t off = (size_t)(row0 + ai * HALF + m * 16) * D + col0;
            if (grp + 1 < 8) PLE_LOAD((grp + 1) & 1, grp + 1);
#pragma unroll
            for (int bj = 0; bj < 2; ++bj) { const unsigned tw[4] = {tv[sl][bj].x, tv[sl][bj].y, tv[sl][bj].z, tv[sl][bj].w}, xw[4] = {xv[sl][bj].x, xv[sl][bj].y, xv[sl][bj].z, xv[sl][bj].w}; f32x4 x0, x1;
#pragma unroll
                for (int j = 0; j < 4; ++j) { const float t0 = __builtin_bit_cast(float, (j & 1) ? (tw[j >> 1] & 0xffff0000u) : (tw[j >> 1] << 16));
                    const float t1 = __builtin_bit_cast(float, (j & 1) ? (tw[2 + (j >> 1)] & 0xffff0000u) : (tw[2 + (j >> 1)] << 16));
                    const float a0 = __builtin_bit_cast(float, (j & 1) ? (xw[j >> 1] & 0xffff0000u) : (xw[j >> 1] << 16));
                    const float a1 = __builtin_bit_cast(float, (j & 1) ? (xw[2 + (j >> 1)] & 0xffff0000u) : (xw[2 + (j >> 1)] << 16));
                    x0[j] = a0 + __builtin_amdgcn_rcpf(1.0f + __expf(-acc[ai][bj][m][0][j])) * t0; x1[j] = a1 + __builtin_amdgcn_rcpf(1.0f + __expf(-acc[ai][bj][m][1][j])) * t1; }
                if (OUT) { *(f32x4*)(OUT + off + bj * HALF) = x0; *(f32x4*)(OUT + off + bj * HALF + 4) = x1; }
                else { u32x4 w; w.x = cvt_pk_bf16(x0[0], x0[1]); w.y = cvt_pk_bf16(x0[2], x0[3]); w.z = cvt_pk_bf16(x1[0], x1[1]); w.w = cvt_pk_bf16(x1[2], x1[3]);
                    *(u32x4*)(XB + off + bj * HALF) = w; } } }
#undef PLE_LOAD
    }
};
}

__device__ __forceinline__ unsigned ord_key(float f) { const unsigned u = __builtin_bit_cast(unsigned, f); return (u & 0x80000000u) ? ~u : (u | 0x80000000u); }
#define LAS __attribute__((address_space(3)))
#define XB_TMO      128
#define XB_XCNT(j)  (256  + 64 * (j))
#define XB_XSUB(j)  (1280 + 64 * (j))
#define XB_XGEN(j)  (2304 + 64 * (j))
#define XB_TOP      3328
#define XB_TOPGEN   3392
#define XCD_BAR_WORDS 3456
#define XB_SPIN_CAP (1u << 18)

__device__ __forceinline__ unsigned xb_ld(unsigned* p)              { return __hip_atomic_load(p, __ATOMIC_RELAXED, __HIP_MEMORY_SCOPE_AGENT); }
__device__ __forceinline__ unsigned xb_add(unsigned* p, unsigned v) { return __hip_atomic_fetch_add(p, v, __ATOMIC_RELAXED, __HIP_MEMORY_SCOPE_AGENT); }
__device__ __forceinline__ unsigned xb_xcc_id() { return (unsigned)__builtin_amdgcn_s_getreg((3 << 11) | 20) & 0xFu; }
#define XB_SPIN(cond, bar) do { unsigned _sp = 0; while (cond) { __builtin_amdgcn_s_sleep(1); \
    if ((++_sp & 255u) == 0u) { if (xb_ld(&(bar)[XB_TMO])) break; if (_sp > XB_SPIN_CAP) { atomicAdd(&(bar)[XB_TMO], 1u); break; } } } } while (0)

struct XcdBarrier {
    unsigned* bar; unsigned x;
    volatile LAS unsigned* st;
};

__device__ __forceinline__ XcdBarrier xcd_barrier_post(unsigned* bar, volatile LAS unsigned* st) {
    XcdBarrier b; b.bar = bar; b.x = xb_xcc_id(); b.st = st;
    if (threadIdx.x == 0) (void)xb_add(&bar[XB_XCNT(b.x)], 1u);
    return b;
}
__device__ __forceinline__ void xcd_barrier_complete(unsigned* bar, unsigned x, unsigned& nloc, unsigned& nx) {
    const unsigned G = gridDim.x * gridDim.y * gridDim.z;
    unsigned sum, cnt, mine, sp = 0u;
    for (;;) {
        sum = 0u; cnt = 0u; mine = 0u;
#pragma unroll
        for (unsigned j = 0; j < 16; ++j) { const unsigned c = xb_ld(&bar[XB_XCNT(j)]); sum += c; cnt += (c > 0u) ? 1u : 0u; mine = (j == x) ? c : mine; }
        if (sum == G) break;
        __builtin_amdgcn_s_sleep(1);
        if ((++sp & 255u) == 0u) { if (xb_ld(&bar[XB_TMO])) break; if (sp > XB_SPIN_CAP) { atomicAdd(&bar[XB_TMO], 1u); break; } }
    }
    nloc = mine > 0u ? mine : 1u; nx = cnt > 0u ? cnt : 1u;
}

__device__ __forceinline__ void xcd_barrier(const XcdBarrier& b, int tid_in) {
    asm volatile("s_waitcnt vmcnt(0)" ::: "memory");
    __syncthreads();
    if (tid_in == 0) {
        unsigned* bar = b.bar;
        __builtin_amdgcn_s_waitcnt(0);
        unsigned nloc = b.st[0], nx = b.st[1];
        if (nloc == 0u) { xcd_barrier_complete(bar, b.x, nloc, nx); b.st[0] = nloc; b.st[1] = nx; }
        const unsigned old = xb_add(&bar[XB_XSUB(b.x)], 1u);
        const unsigned gen = old / nloc;
        if (old + 1u == (gen + 1u) * nloc) {
            __builtin_amdgcn_fence(__ATOMIC_RELEASE, "agent");
            asm volatile("s_waitcnt vmcnt(0)" ::: "memory");
            const unsigned og = xb_add(&bar[XB_TOP], 1u);
            const unsigned tg = og / nx;
            if (og + 1u == (tg + 1u) * nx) xb_add(&bar[XB_TOPGEN], 1u);
            else XB_SPIN(xb_ld(&bar[XB_TOPGEN]) == tg, bar);
            __builtin_amdgcn_fence(__ATOMIC_ACQUIRE, "agent");
            xb_add(&bar[XB_XGEN(b.x)], 1u);
            asm volatile("s_waitcnt vmcnt(0)" ::: "memory");
        } else {
            XB_SPIN(xb_ld(&bar[XB_XGEN(b.x)]) == gen, bar);
            __builtin_amdgcn_fence(__ATOMIC_ACQUIRE, "agent");
            asm volatile("s_waitcnt vmcnt(0)" ::: "memory");
        }
    }
    __syncthreads();
}


constexpr int NTHR = 512, NWAVES = 8;
constexpr int RING_BYTES = 131072, LDS_BYTES = 147456, MISC_OFF = LDS_BYTES - 512;
constexpr int CW_BAR = 4096, CW_RANK = 8192;
constexpr size_t CTL_ZERO_BYTES = 1 * MiB;
constexpr int NPH = 14;

__device__ __forceinline__ int mk_tid(int wave_s) { int l_; asm volatile("v_mbcnt_lo_u32_b32 %0, -1, 0\n\tv_mbcnt_hi_u32_b32 %0, -1, %0" : "=v"(l_)); return wave_s * 64 + l_; }
struct Params { const float* in[26]; float* out; unsigned char* ws; int ph_lo, ph_hi, dbl_mask, pad; };
static_assert(sizeof(Params) == 26 * 8 + 8 + 8 + 16, "no padding");

#define LDSP __attribute__((address_space(3)))
#define LDS_WAIT() asm volatile("s_waitcnt lgkmcnt(0)" ::: "memory")
#ifndef NAIVE_SELECT
#define NAIVE_SELECT 0
#endif
#ifndef NAIVE_ATTN
#define NAIVE_ATTN 0
#endif
#ifndef NAIVE_SSM
#define NAIVE_SSM 0
#endif
#ifndef DBG_SSM
#define DBG_SSM 0
#endif
#ifndef TIMING
#define TIMING 0
#endif
#ifndef DBL_MASK
#define DBL_MASK 0
#endif
#ifndef GEMM_DRYK
#define GEMM_DRYK 0
#endif
#ifndef CLK_PROBE
#define CLK_PROBE 0
#endif
#ifndef ATT_FN
#define ATT_FN wg_attn16d
#endif
#ifndef XTRA_BAR
#define XTRA_BAR 0
#endif
#ifndef ATT_SUB_V
#define ATT_SUB_V 0
#endif
#ifndef TIMING_SHIFT
#define TIMING_SHIFT 0.0f
#endif
#ifndef TIMING_A
#define TIMING_A 2
#endif
#ifndef TIMING_B
#define TIMING_B 3
#endif

template <int MODE> __device__ __forceinline__ void ph_prep_w(LDSP float* scr, const float* __restrict__ W, const float* __restrict__ W2, int K, int Nsrc, const float* __restrict__ gain, bf16* __restrict__ Wt, int Ndst, int gw, int NGW, int lane) {
    const int ntn = Ndst / 32, nt = ntn * (K / 64), n4 = lane & 7, kr = lane >> 3;
    f32x4 v[8];
#define PW_LOAD(it_) { const int n0_ = ((it_) % ntn) * 32, k0_ = ((it_) / ntn) * 64, n_ = n0_ + 4 * n4; int src_; const float* Ws_ = W; \
        if (MODE == 0) src_ = n_; else if (MODE == 1) src_ = src_col_in(n_); else { const int which_ = (n_ & 255) >> 7; src_ = (n_ >> 8) * 128 + (n_ & 127); Ws_ = which_ ? W2 : W; } \
        _Pragma("unroll") for (int i = 0; i < 8; ++i) { const int kk = kr + 8 * i; f32x4 t_ = (f32x4){0.f, 0.f, 0.f, 0.f}; if (src_ >= 0) { t_ = *(const f32x4*)(Ws_ + (size_t)(k0_ + kk) * Nsrc + src_); if (gain) t_ = t_ * gain[k0_ + kk]; } v[i] = t_; } }
    if (gw < nt) PW_LOAD(gw)
    for (int it = gw; it < nt; it += NGW) {
        const int n0 = (it % ntn) * 32, k0 = (it / ntn) * 64;
#pragma unroll
        for (int i = 0; i < 8; ++i) { LDSP float* d = scr + (kr + 8 * i) * 33 + 4 * n4; d[0] = v[i].x; d[1] = v[i].y; d[2] = v[i].z; d[3] = v[i].w; }
        if (it + NGW < nt) PW_LOAD(it + NGW)
        LDS_WAIT(); asm volatile("" ::: "memory");
        const int cc = lane & 7;
#pragma unroll
        for (int j = 0; j < 4; ++j) { const int nn = (lane >> 3) + 8 * j; const LDSP float* s = scr + (8 * cc) * 33 + nn;
            u32x4 o; o.x = pk2(s[0 * 33], s[1 * 33]); o.y = pk2(s[2 * 33], s[3 * 33]); o.z = pk2(s[4 * 33], s[5 * 33]); o.w = pk2(s[6 * 33], s[7 * 33]);
            *(u32x4*)(Wt + (size_t)(n0 + nn) * K + k0 + 8 * cc) = o; }
        LDS_WAIT(); asm volatile("" ::: "memory");
    }
#undef PW_LOAD
}
__device__ __forceinline__ void row_x_prep(const float* __restrict__ x, bf16* __restrict__ xb, float* __restrict__ rstd, int row, int lane) {
    const f32x4* xr = (const f32x4*)(x + (size_t)row * D) + lane; float ss = 0.f; f32x4 v[4];
#pragma unroll
    for (int j = 0; j < 4; ++j) { v[j] = xr[64 * j]; ss += (v[j].x * v[j].x + v[j].y * v[j].y) + (v[j].z * v[j].z + v[j].w * v[j].w); }
    ss = wave_sum(ss);
    if (xb) { u32x2* o = (u32x2*)(xb + (size_t)row * D) + lane;
#pragma unroll
        for (int j = 0; j < 4; ++j) { u32x2 w; w.x = pk2(v[j].x, v[j].y); w.y = pk2(v[j].z, v[j].w); o[64 * j] = w; } }
    if (lane == 0) rstd[row] = 1.0f / sqrtf(ss * (1.0f / D) + EPS);
}
__device__ __forceinline__ void row_resid_norm(const float* xin, const float* __restrict__ y, const float* __restrict__ g, float* xo, bf16* __restrict__ xb, float* __restrict__ rstd_out, const float* __restrict__ p, bf16* __restrict__ pb, int row, int lane, bool dry = false) {
    const f32x4* yr = (const f32x4*)(y + (size_t)row * D) + lane; const f32x4* xr = (const f32x4*)(xin + (size_t)row * D) + lane; const f32x4* gr = (const f32x4*)g + lane;
    f32x4 v[4]; float ss = 0.f;
#pragma unroll
    for (int j = 0; j < 4; ++j) { v[j] = yr[64 * j]; ss += (v[j].x * v[j].x + v[j].y * v[j].y) + (v[j].z * v[j].z + v[j].w * v[j].w); }
    const float r = 1.0f / sqrtf(wave_sum(ss) * (1.0f / D) + EPS);
    float s2 = 0.f;
    f32x4* xor_ = (f32x4*)(xo + (size_t)row * D) + lane; u32x2* o = (u32x2*)(xb + (size_t)row * D) + lane;
#pragma unroll
    for (int j = 0; j < 4; ++j) { const f32x4 xx = xr[64 * j], gg = gr[64 * j]; f32x4 w = xx + v[j] * r * gg; if (!dry) xor_[64 * j] = w; s2 += (w.x * w.x + w.y * w.y) + (w.z * w.z + w.w * w.w);
        u32x2 q; q.x = pk2(w.x, w.y); q.y = pk2(w.z, w.w); o[64 * j] = q; }
    if (rstd_out) { s2 = wave_sum(s2); if (lane == 0) rstd_out[row] = 1.0f / sqrtf(s2 * (1.0f / D) + EPS); }
    if (p) { const f32x4 pv = *((const f32x4*)(p + (size_t)row * PLE) + lane); u32x2 q; q.x = pk2(pv.x, pv.y); q.y = pk2(pv.z, pv.w); *((u32x2*)(pb + (size_t)row * PLE) + lane) = q; }
}

__device__ __forceinline__ void row_resid_norm2(const bf16* xin, const bf16* __restrict__ y, const float* __restrict__ g, bf16* xo, float* __restrict__ rstd_out, const float* __restrict__ p, bf16* __restrict__ pb, int row0, int lane, bool dry = false) {
    f32x4 v[2][4], xx[2][4], pv[2]; const f32x4* gr = (const f32x4*)g + lane;
#pragma unroll
    for (int r = 0; r < 2; ++r) { const u32x2* yr = (const u32x2*)(y + (size_t)(row0 + r) * D) + lane; const u32x2* xr = (const u32x2*)(xin + (size_t)(row0 + r) * D) + lane;
#pragma unroll
        for (int j = 0; j < 4; ++j) { const u32x2 yw = yr[64 * j], xw = xr[64 * j];
            v[r][j] = (f32x4){__builtin_bit_cast(float, yw.x << 16), __builtin_bit_cast(float, yw.x & 0xffff0000u), __builtin_bit_cast(float, yw.y << 16), __builtin_bit_cast(float, yw.y & 0xffff0000u)};
            xx[r][j] = (f32x4){__builtin_bit_cast(float, xw.x << 16), __builtin_bit_cast(float, xw.x & 0xffff0000u), __builtin_bit_cast(float, xw.y << 16), __builtin_bit_cast(float, xw.y & 0xffff0000u)}; }
        if (p) pv[r] = *((const f32x4*)(p + (size_t)(row0 + r) * PLE) + lane); }
    f32x4 gg[4];
#pragma unroll
    for (int j = 0; j < 4; ++j) gg[j] = gr[64 * j];
#pragma unroll
    for (int r = 0; r < 2; ++r) { float ss = 0.f;
#pragma unroll
        for (int j = 0; j < 4; ++j) ss += (v[r][j].x * v[r][j].x + v[r][j].y * v[r][j].y) + (v[r][j].z * v[r][j].z + v[r][j].w * v[r][j].w);
        const float rr = 1.0f / sqrtf(wave_sum(ss) * (1.0f / D) + EPS); float s2 = 0.f;
        u32x2* o = (u32x2*)(xo + (size_t)(row0 + r) * D) + lane;
#pragma unroll
        for (int j = 0; j < 4; ++j) { const f32x4 w = xx[r][j] + v[r][j] * rr * gg[j]; u32x2 q; q.x = pk2(w.x, w.y); q.y = pk2(w.z, w.w); if (!dry) o[64 * j] = q;
            const float r0 = __builtin_bit_cast(float, q.x << 16), r1 = __builtin_bit_cast(float, q.x & 0xffff0000u), r2 = __builtin_bit_cast(float, q.y << 16), r3 = __builtin_bit_cast(float, q.y & 0xffff0000u);
            s2 += (r0 * r0 + r1 * r1) + (r2 * r2 + r3 * r3); }
        if (rstd_out) { s2 = wave_sum(s2); if (lane == 0) rstd_out[row0 + r] = 1.0f / sqrtf(s2 * (1.0f / D) + EPS); }
        if (p) { u32x2 q; q.x = pk2(pv[r].x, pv[r].y); q.y = pk2(pv[r].z, pv[r].w); *((u32x2*)(pb + (size_t)(row0 + r) * PLE) + lane) = q; } }
}
__device__ __forceinline__ void row_rstd_bf16(const bf16* __restrict__ xb, float* __restrict__ rstd, int row, int lane) {
    const u32x2* xr = (const u32x2*)(xb + (size_t)row * D) + lane; float ss = 0.f;
#pragma unroll
    for (int j = 0; j < 4; ++j) { const u32x2 w = xr[64 * j]; const float a = __builtin_bit_cast(float, w.x << 16), b = __builtin_bit_cast(float, w.x & 0xffff0000u), c2 = __builtin_bit_cast(float, w.y << 16), d = __builtin_bit_cast(float, w.y & 0xffff0000u); ss += (a * a + b * b) + (c2 * c2 + d * d); }
    ss = wave_sum(ss); if (lane == 0) rstd[row] = 1.0f / sqrtf(ss * (1.0f / D) + EPS);
}
__device__ __forceinline__ void row_x_prep2(const float* __restrict__ x, bf16* __restrict__ xb, float* __restrict__ rstd, int row0, int lane) {
    f32x4 v[2][4]; float ss[2];
#pragma unroll
    for (int r = 0; r < 2; ++r) { const f32x4* xr = (const f32x4*)(x + (size_t)(row0 + r) * D) + lane;
#pragma unroll
        for (int j = 0; j < 4; ++j) v[r][j] = xr[64 * j]; }
#pragma unroll
    for (int r = 0; r < 2; ++r) { float s_ = 0.f;
#pragma unroll
        for (int j = 0; j < 4; ++j) s_ += (v[r][j].x * v[r][j].x + v[r][j].y * v[r][j].y) + (v[r][j].z * v[r][j].z + v[r][j].w * v[r][j].w);
        ss[r] = wave_sum(s_); u32x2* o = (u32x2*)(xb + (size_t)(row0 + r) * D) + lane;
#pragma unroll
        for (int j = 0; j < 4; ++j) { u32x2 w; w.x = pk2(v[r][j].x, v[r][j].y); w.y = pk2(v[r][j].z, v[r][j].w); o[64 * j] = w; } }
    if (lane < 2) rstd[row0 + lane] = 1.0f / sqrtf((lane ? ss[1] : ss[0]) * (1.0f / D) + EPS);
}
__device__ __forceinline__ void row_rstd_bf16x4(const bf16* __restrict__ xb, float* __restrict__ rstd, int row0, int lane) {
    u32x2 w[4][4]; float ss[4];
#pragma unroll
    for (int r = 0; r < 4; ++r) { const u32x2* xr = (const u32x2*)(xb + (size_t)(row0 + r) * D) + lane;
#pragma unroll
        for (int j = 0; j < 4; ++j) w[r][j] = xr[64 * j]; }
#pragma unroll
    for (int r = 0; r < 4; ++r) { float s_ = 0.f;
#pragma unroll
        for (int j = 0; j < 4; ++j) { const float a = __builtin_bit_cast(float, w[r][j].x << 16), b = __builtin_bit_cast(float, w[r][j].x & 0xffff0000u), c2 = __builtin_bit_cast(float, w[r][j].y << 16), d = __builtin_bit_cast(float, w[r][j].y & 0xffff0000u); s_ += (a * a + b * b) + (c2 * c2 + d * d); }
        ss[r] = wave_sum(s_); }
    const float sel = lane == 0 ? ss[0] : lane == 1 ? ss[1] : lane == 2 ? ss[2] : ss[3];
    if (lane < 4) rstd[row0 + lane] = 1.0f / sqrtf(sel * (1.0f / D) + EPS);
}
__device__ __forceinline__ void wave_gnorm4(bf16* RA, const float* __restrict__ nw, int w0, int lane, bool dry = false) {
    u32x4 v[4]; float ss[4];
#pragma unroll
    for (int i = 0; i < 4; ++i) { const int w = w0 + i, t = w >> 1, g = w & 1; v[i] = *(const u32x4*)(RA + (size_t)t * NA + A_Z + g * 512 + lane * 8); }
    float f[4][8];
#pragma unroll
    for (int i = 0; i < 4; ++i) { const unsigned vw[4] = {v[i].x, v[i].y, v[i].z, v[i].w}; ss[i] = 0.f;
#pragma unroll
        for (int e = 0; e < 8; ++e) { f[i][e] = bf2f((bf16)((vw[e >> 1] >> ((e & 1) * 16)) & 0xffff)); ss[i] += f[i][e] * f[i][e]; } }
#pragma unroll
    for (int o = 1; o < 64; o <<= 1) {
#pragma unroll
        for (int i = 0; i < 4; ++i) ss[i] += __shfl_xor(ss[i], o); }
#pragma unroll
    for (int i = 0; i < 4; ++i) { const int w = w0 + i, t = w >> 1, g = w & 1; const float r = 1.0f / sqrtf(ss[i] * (1.0f / 512.0f) + EPS); const float* gw = nw + g * 512 + lane * 8;
        u32x4 o; o.x = pk2(f[i][0] * r * gw[0], f[i][1] * r * gw[1]); o.y = pk2(f[i][2] * r * gw[2], f[i][3] * r * gw[3]); o.z = pk2(f[i][4] * r * gw[4], f[i][5] * r * gw[5]); o.w = pk2(f[i][6] * r * gw[6], f[i][7] * r * gw[7]);
        if (!dry) *(u32x4*)(RA + (size_t)t * NA + A_Z + g * 512 + lane * 8) = o; }
}
__device__ __forceinline__ void tok_m1(bf16* __restrict__ RA, bf16* __restrict__ RB, bf16* __restrict__ CKVC, bf16* __restrict__ IKC, const float* __restrict__ kvn, const float* __restrict__ ikg, const float* __restrict__ ikb, const float* __restrict__ scw, int t, int lane) {
    const int s = t & (SEQ - 1); bf16* rb = RB + (size_t)t * NB;
    {   const u32x2 w = *((const u32x2*)(rb + B_CKV) + lane); float v[4] = {bf2f((bf16)(w.x & 0xffff)), bf2f((bf16)(w.x >> 16)), bf2f((bf16)(w.y & 0xffff)), bf2f((bf16)(w.y >> 16))};
        float ss = (v[0] * v[0] + v[1] * v[1]) + (v[2] * v[2] + v[3] * v[3]); ss = wave_sum(ss); const float r = 1.0f / sqrtf(ss * (1.0f / KV_R) + EPS);
        const f32x4 g = *((const f32x4*)kvn + lane); u32x2 o; o.x = pk2(v[0] * r * g.x, v[1] * r * g.y); o.y = pk2(v[2] * r * g.z, v[3] * r * g.w); *((u32x2*)(rb + B_CKV) + lane) = o; *((u32x2*)(CKVC + (size_t)t * KV_R) + lane) = o; }
    {   const float x = bf2f(rb[B_IK + lane]); const float mu = wave_sum(x) * (1.0f / 64.0f); const float d = x - mu; const float var = wave_sum(d * d) * (1.0f / 64.0f);
        const bf16 o = f2bf(d * (1.0f / sqrtf(var + EPS)) * ikg[lane] + ikb[lane]); rb[B_IK + lane] = o; IKC[(size_t)t * 64 + lane] = o; }
    {   const int c = lane * 8; float acc[8] = {0.f, 0.f, 0.f, 0.f, 0.f, 0.f, 0.f, 0.f};
        for (int j = 0; j < 3; ++j) { const int ss_ = s - 2 + j; if (ss_ < 0) continue; const bf16* rr = RB + (size_t)(t - 2 + j) * NB;
            const u32x4 cg = *(const u32x4*)(rr + B_CG + c), hb = *(const u32x4*)(rr + B_HB + c); const unsigned cw[4] = {cg.x, cg.y, cg.z, cg.w}, hw[4] = {hb.x, hb.y, hb.z, hb.w};
#pragma unroll
            for (int e = 0; e < 8; ++e) { const float a = bf2f((bf16)((cw[e >> 1] >> ((e & 1) * 16)) & 0xffff)), b = bf2f((bf16)((hw[e >> 1] >> ((e & 1) * 16)) & 0xffff)); acc[e] += scw[j * 512 + c + e] * (a * b); } }
        bf16* ra = RA + (size_t)t * NA + A_BG + c; const u32x4 bg = *(const u32x4*)ra; const unsigned bw[4] = {bg.x, bg.y, bg.z, bg.w}; float o[8];
#pragma unroll
        for (int e = 0; e < 8; ++e) o[e] = bf2f((bf16)((bw[e >> 1] >> ((e & 1) * 16)) & 0xffff)) * acc[e];
        u32x4 w; w.x = pk2(o[0], o[1]); w.y = pk2(o[2], o[3]); w.z = pk2(o[4], o[5]); w.w = pk2(o[6], o[7]); *(u32x4*)ra = w; }
}
__device__ __forceinline__ void tok_m4a(const bf16* __restrict__ RB, const float* __restrict__ cw, const float* __restrict__ cb, const float* __restrict__ dtb, bf16* __restrict__ XA, float* __restrict__ DT, int t, int lane) {
    const int s = t & (SEQ - 1);
    for (int c = lane; c < XBC; c += 64) { float a = cb[c];
#pragma unroll
        for (int j = 0; j < 4; ++j) { const int ss = s - 3 + j; if (ss >= 0) a += cw[j * XBC + c] * bf2f(RB[(size_t)(t - 3 + j) * NB + B_XBC + c]); }
        XA[(size_t)t * XBC + c] = f2bf(siluf_(a)); }
    if (lane < 16) { const float x = bf2f(RB[(size_t)t * NB + B_DT + lane]) + dtb[lane]; DT[(size_t)t * 16 + lane] = x > 15.f ? x : log1pf(__expf(x)); }
}
__device__ __forceinline__ void wg_m2_select(LDSP unsigned char* lds, const bf16* __restrict__ RB, unsigned short* __restrict__ idx, int t, int tid) {
    LDSP float* iq = (LDSP float*)lds; LDSP float* iwv = iq + 256; LDSP unsigned* red = (LDSP unsigned*)(iq + 272); LDSP unsigned* keys = (LDSP unsigned*)(iq + 288);
    const int s = t & (SEQ - 1), b = t >> 12, lane = tid & 63, wv = tid >> 6;
    const int nk = ((s >> 6) + 1) << 6;
    const bf16* rb = RB + (size_t)t * NB;
    if (tid < 256) iq[tid] = bf2f(rb[B_IQ + tid]); if (tid < 4) iwv[tid] = bf2f(rb[B_IW + tid]) * (0.125f * 0.5f);
    __syncthreads();
    for (int k = tid; k < nk; k += NTHR) {
        const bf16* kr = RB + (size_t)(b * SEQ + k) * NB + B_IK; float sc = 0.f;
        float d0 = 0.f, d1 = 0.f, d2 = 0.f, d3 = 0.f;
#pragma unroll 1
        for (int j = 0; j < 8; ++j) { const u32x4 w = *((const u32x4*)kr + j); const unsigned ww[4] = {w.x, w.y, w.z, w.w};
#pragma unroll
            for (int e = 0; e < 8; ++e) { const float kv = bf2f((bf16)((ww[e >> 1] >> ((e & 1) * 16)) & 0xffff)); const int c = j * 8 + e;
                d0 += iq[c] * kv; d1 += iq[64 + c] * kv; d2 += iq[128 + c] * kv; d3 += iq[192 + c] * kv; } }
        sc += fmaxf(d0, 0.f) * iwv[0]; sc += fmaxf(d1, 0.f) * iwv[1]; sc += fmaxf(d2, 0.f) * iwv[2]; sc += fmaxf(d3, 0.f) * iwv[3];
        keys[k] = ord_key(sc);
    }
    __syncthreads();
    unsigned Tt = 0u;
    if (nk > TOPK) {
        for (int bit = 31; bit >= 0; --bit) { const unsigned cand = Tt | (1u << bit); unsigned c = 0;
            for (int k = tid; k < nk; k += NTHR) c += (keys[k] >= cand) ? 1u : 0u;
#pragma unroll
            for (int o = 1; o < 64; o <<= 1) c += __shfl_xor(c, o);
            if (lane == 0) red[wv] = c;
            __syncthreads();
            unsigned tot = 0;
#pragma unroll
            for (int w = 0; w < 8; ++w) tot += red[w];
            if (tot >= (unsigned)TOPK) Tt = cand;
            __syncthreads(); }
    }
    { unsigned c = 0; for (int k = tid; k < nk; k += NTHR) c += (keys[k] > Tt) ? 1u : 0u;
#pragma unroll
      for (int o = 1; o < 64; o <<= 1) c += __shfl_xor(c, o);
      if (lane == 0) red[8 + wv] = c; }
    __syncthreads();
    if (wv == 0) {
        int ngt = 0;
#pragma unroll
        for (int w = 0; w < 8; ++w) ngt += (int)red[8 + w];
        const int need = TOPK - ngt; int pos = 0, eq_taken = 0; const unsigned long long lt = (1ull << lane) - 1ull;
        for (int base = 0; base < nk; base += 64) { const unsigned k = keys[base + lane]; const bool gt = k > Tt, eq = (k == Tt);
            const unsigned long long meq = __ballot(eq); const int rank_eq = __popcll(meq & lt); const bool take = gt || (eq && (eq_taken + rank_eq < need));
            const unsigned long long msel = __ballot(take);
            if (take) { const int o = pos + __popcll(msel & lt); if (o < TOPK) idx[(size_t)t * TOPK + o] = (unsigned short)(base + lane); }
            pos += __popcll(msel); eq_taken += __popcll(__ballot(eq && take)); }
    }
    __syncthreads();
}
__device__ __forceinline__ void wg_m3_attn(LDSP unsigned char* lds, bf16* RA, const bf16* __restrict__ RB, const unsigned short* __restrict__ idx, const float* __restrict__ w_uk, const float* __restrict__ w_uv, const float* __restrict__ rel_bias, int t, int tid) {
    LDSP float* q = (LDSP float*)lds; LDSP float* qlat = q + 512; LDSP float* pr = qlat + 2048; LDSP float* outl = pr + 2048; LDSP unsigned short* sel = (LDSP unsigned short*)(outl + 2048);
    const int s = t & (SEQ - 1), b = t >> 12, lane = tid & 63, wv = tid >> 6;
    const int nk = ((s >> 6) + 1) << 6, nsel = nk < TOPK ? nk : TOPK;
    q[tid] = bf2f(RA[(size_t)t * NA + A_Q + tid]); if (tid < 256) sel[tid] = tid < nsel ? idx[(size_t)t * TOPK + tid] : (unsigned short)0;
    __syncthreads();
    {   const int r = tid & 255, h0 = (tid >> 8) * 4;
        for (int h = h0; h < h0 + 4; ++h) { const float* w = w_uk + ((size_t)r * 8 + h) * 64; float a = 0.f;
#pragma unroll 16
            for (int d = 0; d < 64; ++d) a += q[h * 64 + d] * w[d];
            qlat[h * 256 + r] = a * 0.125f; } }
    __syncthreads();
    {   const int k = tid & 255, h0 = (tid >> 8) * 4;
        if (k < nsel) { const int key = sel[k]; const bf16* kr = RB + (size_t)(b * SEQ + key) * NB + B_CKV; float a[4] = {0.f, 0.f, 0.f, 0.f};
            for (int j = 0; j < 32; ++j) { const u32x4 w = *((const u32x4*)kr + j); const unsigned ww[4] = {w.x, w.y, w.z, w.w};
#pragma unroll
                for (int e = 0; e < 8; ++e) { const float v = bf2f((bf16)((ww[e >> 1] >> ((e & 1) * 16)) & 0xffff));
#pragma unroll
                    for (int hh = 0; hh < 4; ++hh) a[hh] += qlat[(h0 + hh) * 256 + j * 8 + e] * v; } }
            const int bk = t5_bucket(key - s);
#pragma unroll
            for (int hh = 0; hh < 4; ++hh) pr[(h0 + hh) * 256 + k] = a[hh] + rel_bias[bk * 8 + h0 + hh];
        } else {
#pragma unroll
            for (int hh = 0; hh < 4; ++hh) pr[(h0 + hh) * 256 + k] = -INFINITY; } }
    __syncthreads();
    {   float v[4]; float m = -INFINITY;
#pragma unroll
        for (int j = 0; j < 4; ++j) { v[j] = pr[wv * 256 + lane + 64 * j]; m = fmaxf(m, v[j]); }
        m = wave_max(m); float sum = 0.f;
#pragma unroll
        for (int j = 0; j < 4; ++j) { v[j] = __expf(v[j] - m); sum += v[j]; }
        sum = wave_sum(sum); const float inv = 1.0f / sum;
#pragma unroll
        for (int j = 0; j < 4; ++j) pr[wv * 256 + lane + 64 * j] = v[j] * inv; }
    __syncthreads();
    {   const int r = tid & 255, h0 = (tid >> 8) * 4; float a[4] = {0.f, 0.f, 0.f, 0.f};
        for (int k = 0; k < nsel; ++k) { const float v = bf2f(RB[(size_t)(b * SEQ + sel[k]) * NB + B_CKV + r]);
#pragma unroll
            for (int hh = 0; hh < 4; ++hh) a[hh] += pr[(h0 + hh) * 256 + k] * v; }
#pragma unroll
        for (int hh = 0; hh < 4; ++hh) outl[(h0 + hh) * 256 + r] = a[hh]; }
    __syncthreads();
    {   const int h = tid >> 6, d = tid & 63; float a = 0.f;
        for (int r = 0; r < 256; ++r) a += outl[h * 256 + r] * w_uv[((size_t)r * 8 + h) * 64 + d];
        RA[(size_t)t * NA + A_Q + tid] = f2bf(a); }
    __syncthreads();
}
__device__ __forceinline__ void half_m4b_scan(bf16* RA, const bf16* __restrict__ XA, const float* __restrict__ DT, const float* __restrict__ a_log, const float* __restrict__ dsk, int b, int h, int tid) {
    const int g = h >> 3, p = tid >> 2, nq = tid & 3;
    const float A = -__expf(a_log[h]), Dh = dsk[h];
    float hs[32];
#pragma unroll
    for (int n = 0; n < 32; ++n) hs[n] = 0.f;
    for (int s = 0; s < SEQ; ++s) { const size_t t = (size_t)b * SEQ + s; const float dt = DT[t * 16 + h]; const float dA = __expf(dt * A);
        const bf16* xr = XA + t * XBC; const float x = bf2f(xr[h * 64 + p]); const float dx = dt * x;
        const u32x4* Bp = (const u32x4*)(xr + 1024 + g * 128 + nq * 32); const u32x4* Cp = (const u32x4*)(xr + 1280 + g * 128 + nq * 32); float y = 0.f;
#pragma unroll
        for (int j = 0; j < 4; ++j) { const u32x4 bw = Bp[j], cw = Cp[j]; const unsigned bb[4] = {bw.x, bw.y, bw.z, bw.w}, cc[4] = {cw.x, cw.y, cw.z, cw.w};
#pragma unroll
            for (int e = 0; e < 8; ++e) { const float Bv = bf2f((bf16)((bb[e >> 1] >> ((e & 1) * 16)) & 0xffff)), Cv = bf2f((bf16)((cc[e >> 1] >> ((e & 1) * 16)) & 0xffff));
                hs[j * 8 + e] = hs[j * 8 + e] * dA + dx * Bv; y += Cv * hs[j * 8 + e]; } }
        y += __shfl_xor(y, 1); y += __shfl_xor(y, 2);
        if (nq == 0) { bf16* zp = RA + t * NA + A_Z + h * 64 + p; const float z = bf2f(*zp); *zp = f2bf((y + Dh * x) * siluf_(z)); }
    }
}
__device__ __forceinline__ void wave_m4c_gnorm(bf16* RA, const float* __restrict__ nw, int w, int lane, bool dry = false) {
    const int t = w >> 1, g = w & 1;
    bf16* p = RA + (size_t)t * NA + A_Z + g * 512 + lane * 8; const u32x4 v = *(const u32x4*)p; const unsigned vw[4] = {v.x, v.y, v.z, v.w}; float f[8]; float ss = 0.f;
#pragma unroll
    for (int e = 0; e < 8; ++e) { f[e] = bf2f((bf16)((vw[e >> 1] >> ((e & 1) * 16)) & 0xffff)); ss += f[e] * f[e]; }
    const float r = 1.0f / sqrtf(wave_sum(ss) * (1.0f / 512.0f) + EPS); const float* gw = nw + g * 512 + lane * 8;
    u32x4 o; o.x = pk2(f[0] * r * gw[0], f[1] * r * gw[1]); o.y = pk2(f[2] * r * gw[2], f[3] * r * gw[3]); o.z = pk2(f[4] * r * gw[4], f[5] * r * gw[5]); o.w = pk2(f[6] * r * gw[6], f[7] * r * gw[7]);
    if (!dry) *(u32x4*)p = o;
}

__device__ __forceinline__ void unpack8(const u32x4 w, float (&f)[8]) { const unsigned ww[4] = {w.x, w.y, w.z, w.w};
#pragma unroll
    for (int e = 0; e < 4; ++e) { f[2 * e] = __builtin_bit_cast(float, ww[e] << 16); f[2 * e + 1] = __builtin_bit_cast(float, ww[e] & 0xffff0000u); } }
__device__ __forceinline__ void prep_ckv4(const bf16* __restrict__ RB, bf16* __restrict__ CKVC, const float* __restrict__ kvn, int it, int lane) {
    const int t = it * 4 + (lane >> 4), c = lane & 15; const u32x4* src = (const u32x4*)(RB + (size_t)t * NB + B_CKV + c * 16); const u32x4 a = src[0], b = src[1];
    float v[16]; { float f[8]; unpack8(a, f);
#pragma unroll
        for (int e = 0; e < 8; ++e) v[e] = f[e]; unpack8(b, f);
#pragma unroll
        for (int e = 0; e < 8; ++e) v[8 + e] = f[e]; }
    float ss = 0.f;
#pragma unroll
    for (int e = 0; e < 16; ++e) ss += v[e] * v[e];
    ss += __shfl_xor(ss, 1); ss += __shfl_xor(ss, 2); ss += __shfl_xor(ss, 4); ss += __shfl_xor(ss, 8);
    const float r = 1.0f / sqrtf(ss * (1.0f / KV_R) + EPS); const f32x4* gp = (const f32x4*)(kvn + c * 16); float o[16];
#pragma unroll
    for (int q = 0; q < 4; ++q) { const f32x4 gg = gp[q]; o[4 * q] = v[4 * q] * r * gg.x; o[4 * q + 1] = v[4 * q + 1] * r * gg.y; o[4 * q + 2] = v[4 * q + 2] * r * gg.z; o[4 * q + 3] = v[4 * q + 3] * r * gg.w; }
    u32x4 w0, w1; w0.x = pk2(o[0], o[1]); w0.y = pk2(o[2], o[3]); w0.z = pk2(o[4], o[5]); w0.w = pk2(o[6], o[7]); w1.x = pk2(o[8], o[9]); w1.y = pk2(o[10], o[11]); w1.z = pk2(o[12], o[13]); w1.w = pk2(o[14], o[15]);
    u32x4* dst = (u32x4*)(CKVC + (size_t)t * KV_R + c * 16); dst[0] = w0; dst[1] = w1;
}
__device__ __forceinline__ void prep_ik16(const bf16* __restrict__ RB, bf16* __restrict__ IKC, const float* __restrict__ ikg, const float* __restrict__ ikb, int it, int lane) {
    const int t = it * 16 + (lane >> 2), c = lane & 3; const u32x4* src = (const u32x4*)(RB + (size_t)t * NB + B_IK + c * 16); const u32x4 a = src[0], b = src[1];
    float v[16]; { float f[8]; unpack8(a, f);
#pragma unroll
        for (int e = 0; e < 8; ++e) v[e] = f[e]; unpack8(b, f);
#pragma unroll
        for (int e = 0; e < 8; ++e) v[8 + e] = f[e]; }
    float s = 0.f;
#pragma unroll
    for (int e = 0; e < 16; ++e) s += v[e];
    s += __shfl_xor(s, 1); s += __shfl_xor(s, 2); const float mu = s * (1.0f / 64.0f); float q2 = 0.f;
#pragma unroll
    for (int e = 0; e < 16; ++e) { v[e] -= mu; q2 += v[e] * v[e]; }
    q2 += __shfl_xor(q2, 1); q2 += __shfl_xor(q2, 2); const float r = 1.0f / sqrtf(q2 * (1.0f / 64.0f) + EPS); float o[16];
#pragma unroll
    for (int e = 0; e < 16; ++e) o[e] = v[e] * r * ikg[c * 16 + e] + ikb[c * 16 + e];
    u32x4 w0, w1; w0.x = pk2(o[0], o[1]); w0.y = pk2(o[2], o[3]); w0.z = pk2(o[4], o[5]); w0.w = pk2(o[6], o[7]); w1.x = pk2(o[8], o[9]); w1.y = pk2(o[10], o[11]); w1.z = pk2(o[12], o[13]); w1.w = pk2(o[14], o[15]);
    u32x4* dst = (u32x4*)(IKC + (size_t)t * 64 + c * 16); dst[0] = w0; dst[1] = w1;
}
__device__ __forceinline__ void prep_bout(bf16* RA, const bf16* __restrict__ RB, const float* __restrict__ scw, int t, int lane, bool dry = false) {
    const int s = t & (SEQ - 1), c = lane * 8; float acc[8] = {0.f, 0.f, 0.f, 0.f, 0.f, 0.f, 0.f, 0.f};
    u32x4 cg[3], hb[3];
#pragma unroll
    for (int j = 0; j < 3; ++j) { const bool ok = (s - 2 + j) >= 0; const bf16* rr = RB + (size_t)(t - 2 + j) * NB; cg[j] = ok ? *(const u32x4*)(rr + B_CG + c) : (u32x4){0u, 0u, 0u, 0u}; hb[j] = ok ? *(const u32x4*)(rr + B_HB + c) : (u32x4){0u, 0u, 0u, 0u}; }
    bf16* ra = RA + (size_t)t * NA + A_BG + c; const u32x4 bg = *(const u32x4*)ra;
#pragma unroll
    for (int j = 0; j < 3; ++j) { float a[8], b[8]; unpack8(cg[j], a); unpack8(hb[j], b); const f32x4 w0 = *(const f32x4*)(scw + j * 512 + c), w1 = *(const f32x4*)(scw + j * 512 + c + 4);
        acc[0] += w0.x * (a[0] * b[0]); acc[1] += w0.y * (a[1] * b[1]); acc[2] += w0.z * (a[2] * b[2]); acc[3] += w0.w * (a[3] * b[3]);
        acc[4] += w1.x * (a[4] * b[4]); acc[5] += w1.y * (a[5] * b[5]); acc[6] += w1.z * (a[6] * b[6]); acc[7] += w1.w * (a[7] * b[7]); }
    float g8[8]; unpack8(bg, g8); u32x4 w; w.x = pk2(g8[0] * acc[0], g8[1] * acc[1]); w.y = pk2(g8[2] * acc[2], g8[3] * acc[3]); w.z = pk2(g8[4] * acc[4], g8[5] * acc[5]); w.w = pk2(g8[6] * acc[6], g8[7] * acc[7]);
    if (!dry) *(u32x4*)ra = w;
}
__device__ __forceinline__ void prep_conv(const bf16* __restrict__ RB, bf16* __restrict__ XA, const float* __restrict__ cw, const float* __restrict__ cb, int it, int lane) {
    const int rb = it / 12, cbk = it % 12, xcol = cbk * 128 + 2 * lane, t0 = rb * 16, s0 = t0 & (SEQ - 1);
    float w0[4], w1[4];
#pragma unroll
    for (int j = 0; j < 4; ++j) { w0[j] = cw[j * XBC + xcol]; w1[j] = cw[j * XBC + xcol + 1]; }
    const float cb0 = cb[xcol], cb1 = cb[xcol + 1];
    const bf16* src = RB + (size_t)(t0 - 3) * NB + B_XBC + xcol; unsigned raw[19];
#pragma unroll
    for (int i = 0; i < 19; ++i) raw[i] = (s0 - 3 + i >= 0) ? *(const unsigned*)(src + (size_t)i * NB) : 0u;
#pragma unroll
    for (int i = 0; i < 16; ++i) { float a0 = cb0, a1 = cb1;
#pragma unroll
        for (int j = 0; j < 4; ++j) { a0 += w0[j] * __builtin_bit_cast(float, raw[i + j] << 16); a1 += w1[j] * __builtin_bit_cast(float, raw[i + j] & 0xffff0000u); }
        *(unsigned*)(XA + (size_t)(t0 + i) * XBC + xcol) = pk2(siluf_(a0), siluf_(a1)); }
}

typedef short bf16x8_t __attribute__((ext_vector_type(8)));
#ifndef SEL_REP_SEARCH
#define SEL_REP_SEARCH 1
#endif
#ifndef SEL_REP_STAGE
#define SEL_REP_STAGE 1
#endif
#define CNT8_GE(cnt, v0, v1, v2, v3, v4, v5, v6, v7, cand) do { unsigned long long m0_, m1_, m2_, m3_, m4_, m5_, m6_, m7_; \
    asm("v_cmp_ge_u32_e64 %0, %8, %16\n\tv_cmp_ge_u32_e64 %1, %9, %16\n\tv_cmp_ge_u32_e64 %2, %10, %16\n\tv_cmp_ge_u32_e64 %3, %11, %16\n\t" \
        "v_cmp_ge_u32_e64 %4, %12, %16\n\tv_cmp_ge_u32_e64 %5, %13, %16\n\tv_cmp_ge_u32_e64 %6, %14, %16\n\tv_cmp_ge_u32_e64 %7, %15, %16" \
        : "=&s"(m0_), "=&s"(m1_), "=&s"(m2_), "=&s"(m3_), "=&s"(m4_), "=&s"(m5_), "=&s"(m6_), "=&s"(m7_) \
        : "v"(v0), "v"(v1), "v"(v2), "v"(v3), "v"(v4), "v"(v5), "v"(v6), "v"(v7), "s"(cand)); \
    cnt += (__popcll(m0_) + __popcll(m1_)) + (__popcll(m2_) + __popcll(m3_)) + (__popcll(m4_) + __popcll(m5_)) + (__popcll(m6_) + __popcll(m7_)); } while (0)
constexpr int SC_STRIDE = 516, SC_BUF = 16 * SC_STRIDE;
constexpr int IKW_OFF = 66560;
__device__ __forceinline__ void wg_select16(LDSP unsigned char* lds, const bf16* __restrict__ RB, const bf16* __restrict__ IKC, unsigned short* __restrict__ idx, int unit, int tid, bool dry = false, bool lds_out = false) {
    const int lane = tid & 63, wave = __builtin_amdgcn_readfirstlane(tid >> 6), g = lane >> 4, c = lane & 15;
    const int b = unit >> 8, qg = unit & 255, t0 = b * SEQ + qg * 16, nk = ((qg >> 2) + 1) << 6, nr = nk >> 6;
    LDSP unsigned* SC = (LDSP unsigned*)lds;
    bf16x8_t bq[4][2]; float iwq[4];
    { const bf16* qr = RB + (size_t)(t0 + c) * NB;
#pragma unroll
      for (int h = 0; h < 4; ++h) { bq[h][0] = *(const bf16x8_t*)(qr + B_IQ + h * 64 + g * 8); bq[h][1] = *(const bf16x8_t*)(qr + B_IQ + h * 64 + 32 + g * 8); iwq[h] = bf2f(qr[B_IW + h]) * 0.0625f; } }
    unsigned val[2][64];
#pragma unroll
    for (int r = 0; r < 64; ++r) { val[0][r] = 0u; val[1][r] = 0u; }
    const bf16* ikb = IKC + (size_t)b * SEQ * 64;
    LDSP unsigned char* ikw = lds + IKW_OFF + wave * 8192;
#define IK_DMA(stage) do { if ((stage) * 512 + wave * 64 < nk) { const bf16* src_ = ikb + (size_t)((stage) * 512 + wave * 64) * 64 + lane * 8; _Pragma("unroll") for (int pc_ = 0; pc_ < 8; ++pc_) \
        __builtin_amdgcn_global_load_lds((const unsigned*)(src_ + pc_ * 512), (LDSP unsigned*)(ikw + pc_ * 1024), 16, 0, 0); } } while (0)
    IK_DMA(0);
    for (int rep_st = 0; rep_st < SEL_REP_STAGE; ++rep_st) {
    if (rep_st > 0) { asm volatile("s_waitcnt vmcnt(0)" ::: "memory"); __builtin_amdgcn_s_barrier(); IK_DMA(0); }
#pragma unroll
    for (int s = 0; s < 8; ++s) {
        if (s * 512 < nk) {
            LDSP unsigned* buf = SC + (s & 1) * SC_BUF;
            asm volatile("s_waitcnt vmcnt(0)" ::: "memory");
            bf16x8_t af[4][2];
#pragma unroll
            for (int i = 0; i < 4; ++i) { af[i][0] = *(const LDSP bf16x8_t*)(ikw + (16 * i + c) * 128 + g * 16); af[i][1] = *(const LDSP bf16x8_t*)(ikw + (16 * i + c) * 128 + 64 + g * 16); }
            asm volatile("s_waitcnt lgkmcnt(0)" ::: "memory");
            if (s < 7) IK_DMA(s + 1);
#pragma unroll
            for (int i = 0; i < 4; ++i) { const int tl = wave * 4 + i, kb = s * 512 + tl * 16;
                if (kb < nk) {
                    const bf16x8_t a0 = af[i][0], a1 = af[i][1];
                    float sc[4] = {0.f, 0.f, 0.f, 0.f};
#pragma unroll
                    for (int h = 0; h < 4; ++h) { pg8::f32x4 acc = {0.f, 0.f, 0.f, 0.f};
                        acc = __builtin_amdgcn_mfma_f32_16x16x32_bf16(a0, bq[h][0], acc, 0, 0, 0); acc = __builtin_amdgcn_mfma_f32_16x16x32_bf16(a1, bq[h][1], acc, 0, 0, 0);
#pragma unroll
                        for (int e = 0; e < 4; ++e) sc[e] += fmaxf(acc[e], 0.f) * iwq[h]; }
                    u32x4 kv; kv.x = ord_key(sc[0]); kv.y = ord_key(sc[1]); kv.z = ord_key(sc[2]); kv.w = ord_key(sc[3]);
                    *(LDSP u32x4*)(buf + c * SC_STRIDE + tl * 16 + 4 * g) = kv; } }
            asm volatile("s_waitcnt lgkmcnt(0)" ::: "memory"); __builtin_amdgcn_s_barrier(); asm volatile("" ::: "memory");
#pragma unroll
            for (int j = 0; j < 8; ++j) if (s * 512 + j * 64 < nk) { val[0][s * 8 + j] = buf[(2 * wave) * SC_STRIDE + j * 64 + lane]; val[1][s * 8 + j] = buf[(2 * wave + 1) * SC_STRIDE + j * 64 + lane]; }
            asm volatile("s_waitcnt lgkmcnt(0)" ::: "memory");
        }
    }
    }
    const unsigned long long lt = (1ull << lane) - 1ull;
#pragma unroll
    for (int qq = 0; qq < 2; ++qq) {
        unsigned Tt = 0u;
        for (int rep_se = 0; rep_se < SEL_REP_SEARCH; ++rep_se) { Tt = 0u; asm volatile("" : "+v"(val[qq][0]));
        if (nk > TOPK) {
            for (int bit = 31; bit >= 0; --bit) { const unsigned cand = Tt | (1u << bit); int cnt = 0;
#pragma unroll
                for (int r8 = 0; r8 < 8; ++r8) if (r8 * 8 < nr) CNT8_GE(cnt, val[qq][r8 * 8], val[qq][r8 * 8 + 1], val[qq][r8 * 8 + 2], val[qq][r8 * 8 + 3], val[qq][r8 * 8 + 4], val[qq][r8 * 8 + 5], val[qq][r8 * 8 + 6], val[qq][r8 * 8 + 7], cand);
                if (cnt >= TOPK) Tt = cand; if (cnt == TOPK) break; }
        }
        }
        unsigned short* orow = idx + (size_t)(t0 + 2 * wave + qq) * TOPK;
        LDSP unsigned short* orow_l = (LDSP unsigned short*)(lds + 134 * 1024) + (2 * wave + qq) * TOPK;
        int pos = 0;
#define PUT_KEY(o_, key_) do { if ((o_) < TOPK && !dry) { if (lds_out) orow_l[o_] = (unsigned short)(key_); else orow[o_] = (unsigned short)(key_); } } while (0)
#pragma unroll
        for (int r8 = 0; r8 < 8; ++r8) if (r8 * 8 < nr) { unsigned long long k0, k1, k2, k3, k4, k5, k6, k7;
            asm("v_cmp_gt_u32_e64 %0, %8, %16\n\tv_cmp_gt_u32_e64 %1, %9, %16\n\tv_cmp_gt_u32_e64 %2, %10, %16\n\tv_cmp_gt_u32_e64 %3, %11, %16\n\t"
                "v_cmp_gt_u32_e64 %4, %12, %16\n\tv_cmp_gt_u32_e64 %5, %13, %16\n\tv_cmp_gt_u32_e64 %6, %14, %16\n\tv_cmp_gt_u32_e64 %7, %15, %16"
                : "=&s"(k0), "=&s"(k1), "=&s"(k2), "=&s"(k3), "=&s"(k4), "=&s"(k5), "=&s"(k6), "=&s"(k7)
                : "v"(val[qq][r8 * 8]), "v"(val[qq][r8 * 8 + 1]), "v"(val[qq][r8 * 8 + 2]), "v"(val[qq][r8 * 8 + 3]), "v"(val[qq][r8 * 8 + 4]), "v"(val[qq][r8 * 8 + 5]), "v"(val[qq][r8 * 8 + 6]), "v"(val[qq][r8 * 8 + 7]), "s"(Tt));
#define PUT_MASK(m_, i_) do { if ((m_) != 0ull) { if (((m_) >> lane) & 1ull) { const int o = pos + __popcll((m_) & lt); PUT_KEY(o, (r8 * 8 + (i_)) * 64 + lane); } pos += __popcll(m_); } } while (0)
            PUT_MASK(k0, 0); PUT_MASK(k1, 1); PUT_MASK(k2, 2); PUT_MASK(k3, 3); PUT_MASK(k4, 4); PUT_MASK(k5, 5); PUT_MASK(k6, 6); PUT_MASK(k7, 7);
#undef PUT_MASK
        }
        int need = TOPK - pos;
        if (need > 0) {
#pragma unroll
            for (int r = 0; r < 64; ++r) if (r < nr && need > 0) { const unsigned long long meq = __ballot(val[qq][r] == Tt);
                if (meq != 0ull) { const int rank = __popcll(meq & lt); if (((meq >> lane) & 1ull) && rank < need) { PUT_KEY(pos + rank, r * 64 + lane); } const int tk = __popcll(meq); const int tkn = tk < need ? tk : need; pos += tkn; need -= tkn; } }
        }
#undef PUT_KEY
    }
    asm volatile("s_waitcnt vmcnt(0) lgkmcnt(0)" ::: "memory"); __builtin_amdgcn_s_barrier();
#undef IK_DMA
}

typedef unsigned short u16x4_t __attribute__((ext_vector_type(4)));
#ifndef ATT_LOCAL_DRY
#define ATT_LOCAL_DRY 0
#endif
#ifndef ATT_STAGGER
#define ATT_STAGGER 0
#endif
#ifndef ATT_DRY_SKIP
#define ATT_DRY_SKIP 0
#endif
#define DSK(b) (ATT_DRY_SKIP & (b)) && dry
#ifndef ATT_SUB_EN
#define ATT_SUB_EN 0
#endif
constexpr int SELW_OFF = 134 * 1024, BT_OFF = 142 * 1024, KVP = 528, TILE_STRIDE = 32 * KVP;
constexpr int SELW_OFF_OLD = 132 * 1024, BT_OFF_OLD = 140 * 1024;
__device__ __forceinline__ int kv_off(int row, int ch) { const int hf = ch >> 4, c16 = ch & 15; return hf * 8192 + 256 * row + 16 * (c16 ^ (((row & 3) << 2) | ((row >> 2) & 3))); }
#define TR4I(d0, d1, d2, d3, base, o0, o1, o2, o3) asm volatile("ds_read_b64_tr_b16 %0, %4 offset:%5\n\tds_read_b64_tr_b16 %1, %4 offset:%6\n\tds_read_b64_tr_b16 %2, %4 offset:%7\n\tds_read_b64_tr_b16 %3, %4 offset:%8" \
    : "=&v"(d0), "=&v"(d1), "=&v"(d2), "=&v"(d3) : "v"(base), "i"(o0), "i"(o1), "i"(o2), "i"(o3) : "memory")
#define TR8N(d0, d1, d2, d3, d4, d5, d6, d7, base, o0, o1, o2, o3, o4, o5, o6, o7) asm volatile( \
    "ds_read_b64_tr_b16 %0, %8 offset:%9\n\tds_read_b64_tr_b16 %1, %8 offset:%10\n\tds_read_b64_tr_b16 %2, %8 offset:%11\n\tds_read_b64_tr_b16 %3, %8 offset:%12\n\t" \
    "ds_read_b64_tr_b16 %4, %8 offset:%13\n\tds_read_b64_tr_b16 %5, %8 offset:%14\n\tds_read_b64_tr_b16 %6, %8 offset:%15\n\tds_read_b64_tr_b16 %7, %8 offset:%16" \
    : "=&v"(d0), "=&v"(d1), "=&v"(d2), "=&v"(d3), "=&v"(d4), "=&v"(d5), "=&v"(d6), "=&v"(d7) : "v"(base), "i"(o0), "i"(o1), "i"(o2), "i"(o3), "i"(o4), "i"(o5), "i"(o6), "i"(o7) : "memory")
#define WAITPIN8(n, d0, d1, d2, d3, d4, d5, d6, d7) asm volatile("s_waitcnt lgkmcnt(" #n ")" : "+v"(d0), "+v"(d1), "+v"(d2), "+v"(d3), "+v"(d4), "+v"(d5), "+v"(d6), "+v"(d7) :: "memory")
#define WAITPIN4(n, d0, d1, d2, d3) asm volatile("s_waitcnt lgkmcnt(" #n ")" : "+v"(d0), "+v"(d1), "+v"(d2), "+v"(d3) :: "memory")
__device__ __forceinline__ bf16x8_t mk8a(u16x4_t a, u16x4_t b) { bf16x8_t r; r[0] = a[0]; r[1] = a[1]; r[2] = a[2]; r[3] = a[3]; r[4] = b[0]; r[5] = b[1]; r[6] = b[2]; r[7] = b[3]; return r; }
#define TR8I(d0, d1, d2, d3, d4, d5, d6, d7, base, o0, o1, o2, o3, o4, o5, o6, o7) asm volatile( \
    "ds_read_b64_tr_b16 %0, %8 offset:%9\n\tds_read_b64_tr_b16 %1, %8 offset:%10\n\tds_read_b64_tr_b16 %2, %8 offset:%11\n\tds_read_b64_tr_b16 %3, %8 offset:%12\n\t" \
    "ds_read_b64_tr_b16 %4, %8 offset:%13\n\tds_read_b64_tr_b16 %5, %8 offset:%14\n\tds_read_b64_tr_b16 %6, %8 offset:%15\n\tds_read_b64_tr_b16 %7, %8 offset:%16\n\ts_waitcnt lgkmcnt(0)" \
    : "=&v"(d0), "=&v"(d1), "=&v"(d2), "=&v"(d3), "=&v"(d4), "=&v"(d5), "=&v"(d6), "=&v"(d7) : "v"(base), "i"(o0), "i"(o1), "i"(o2), "i"(o3), "i"(o4), "i"(o5), "i"(o6), "i"(o7) : "memory")
#define TR8(d0, d1, d2, d3, d4, d5, d6, d7, a0, a1, a2, a3, a4, a5, a6, a7) asm volatile( \
    "ds_read_b64_tr_b16 %0, %8\n\tds_read_b64_tr_b16 %1, %9\n\tds_read_b64_tr_b16 %2, %10\n\tds_read_b64_tr_b16 %3, %11\n\t" \
    "ds_read_b64_tr_b16 %4, %12\n\tds_read_b64_tr_b16 %5, %13\n\tds_read_b64_tr_b16 %6, %14\n\tds_read_b64_tr_b16 %7, %15\n\ts_waitcnt lgkmcnt(0)" \
    : "=&v"(d0), "=&v"(d1), "=&v"(d2), "=&v"(d3), "=&v"(d4), "=&v"(d5), "=&v"(d6), "=&v"(d7) : "v"(a0), "v"(a1), "v"(a2), "v"(a3), "v"(a4), "v"(a5), "v"(a6), "v"(a7) : "memory")
__device__ __forceinline__ void wg_attn16(LDSP unsigned char* lds, bf16* RA, const bf16* __restrict__ CKVC, const unsigned short* __restrict__ idx, const bf16* __restrict__ WUK, const bf16* __restrict__ WUV,
                                          const float* __restrict__ rel_bias, int unit, int nxt_unit, int par, bool first, int tid, bool dry = false, int qmode = 0, bf16* qscr = nullptr) {
    const int lane = tid & 63, wave = __builtin_amdgcn_readfirstlane(tid >> 6), g = lane >> 4, c = lane & 15;
    const int b = unit >> 9, qg = unit & 511, t0 = b * SEQ + qg * 8, nk = ((qg >> 3) + 1) << 6, nsel = nk < TOPK ? nk : TOPK, ntile = nsel >> 5;
    LDSP unsigned char* QL = lds;
    LDSP unsigned char* tile = lds + wave * TILE_STRIDE;
    LDSP unsigned short* selw = (LDSP unsigned short*)(lds + SELW_OFF + (par * 8 + wave) * 512);
    LDSP unsigned short* selw_n = (LDSP unsigned short*)(lds + SELW_OFF + ((par ^ 1) * 8 + wave) * 512);
    if (first) { if (lane < 32) *((LDSP u32x4*)selw + lane) = *((const u32x4*)(idx + (size_t)(t0 + wave) * TOPK) + lane); }
    const bf16* kvb = CKVC + (size_t)b * SEQ * KV_R + g * 8;
    bf16x8_t kv0[8], kv1[8];
#define KV_LOAD(dst, key) do { const bf16* rp_ = kvb + (size_t)(key) * KV_R; _Pragma("unroll") for (int ks_ = 0; ks_ < 8; ++ks_) dst[ks_] = *(const bf16x8_t*)(rp_ + ks_ * 32); } while (0)
    int ka = (int)selw[c], kb = (int)selw[16 + c];
    KV_LOAD(kv0, ka); KV_LOAD(kv1, kb);
    bf16x8_t qf[8];
    if (qmode != 2) {
        const int h = wave; const bf16* qr = RA + (size_t)(t0 + (qmode == 1 ? c : (c & 7))) * NA + A_Q + h * 64 + g * 8;
        const bf16x8_t b0 = *(const bf16x8_t*)qr, b1 = *(const bf16x8_t*)(qr + 32);
        const bf16* wb = WUK + ((size_t)h * 256 + c) * 64 + g * 8;
#pragma unroll 4
        for (int rt = 0; rt < 16; ++rt) { const bf16x8_t a0 = *(const bf16x8_t*)(wb + rt * 16 * 64), a1 = *(const bf16x8_t*)(wb + rt * 16 * 64 + 32);
            pg8::f32x4 acc = {0.f, 0.f, 0.f, 0.f};
            acc = __builtin_amdgcn_mfma_f32_16x16x32_bf16(a0, b0, acc, 0, 0, 0); acc = __builtin_amdgcn_mfma_f32_16x16x32_bf16(a1, b1, acc, 0, 0, 0);
            u32x2 w; w.x = pk2(acc[0], acc[1]); w.y = pk2(acc[2], acc[3]);
            if (c < 8) *(LDSP u32x2*)(QL + (((c * 8 + h) * 256) + rt * 16 + 4 * g) * 2) = w;
            else if (qmode == 1) *(u32x2*)(qscr + ((((c - 8) * 8 + h) * 256) + rt * 16 + 4 * g)) = w; }
        asm volatile("s_waitcnt lgkmcnt(0)" ::: "memory"); __builtin_amdgcn_s_barrier(); asm volatile("" ::: "memory");
#pragma unroll
        for (int ks = 0; ks < 8; ++ks) qf[ks] = *(const LDSP bf16x8_t*)(QL + (((wave * 8 + (c & 7)) * 256) + ks * 32 + g * 8) * 2);
        asm volatile("s_waitcnt lgkmcnt(0)" ::: "memory"); __builtin_amdgcn_s_barrier(); asm volatile("" ::: "memory");
    } else {
        const unsigned long long* qs = (const unsigned long long*)(qscr + (((wave * 8 + (c & 7)) * 256) + g * 8));
#pragma unroll
        for (int ks = 0; ks < 8; ++ks) { const unsigned long long lo = __hip_atomic_load(qs + ks * 8, __ATOMIC_RELAXED, __HIP_MEMORY_SCOPE_AGENT), hi = __hip_atomic_load(qs + ks * 8 + 1, __ATOMIC_RELAXED, __HIP_MEMORY_SCOPE_AGENT);
            u32x4 w; w.x = (unsigned)lo; w.y = (unsigned)(lo >> 32); w.z = (unsigned)hi; w.w = (unsigned)(hi >> 32); qf[ks] = __builtin_bit_cast(bf16x8_t, w); }
    }
    const unsigned tile_a = (unsigned)(size_t)tile;
#if ATT_STAGGER
    if (wave >= 4) __builtin_amdgcn_s_sleep(ATT_STAGGER);
#endif
    bf16x8_t bbf; { float bv[8];
#pragma unroll
        for (int j = 0; j < 8; ++j) bv[j] = rel_bias[(8 * g + j) * 8 + (c & 7)];
        u32x4 w; w.x = pk2(bv[0], bv[1]); w.y = pk2(bv[2], bv[3]); w.z = pk2(bv[4], bv[5]); w.w = pk2(bv[6], bv[7]); bbf = __builtin_bit_cast(bf16x8_t, w); }
    {
        const int spos = (qg * 8 + wave);
        pg8::f32x4 acc[16];
#pragma unroll
        for (int nt = 0; nt < 16; ++nt) acc[nt] = (pg8::f32x4){0.f, 0.f, 0.f, 0.f};
        float m_run = -INFINITY, l_run = 0.f;
#define ONEHOT(dst, key) do { const int rel_ = (key) - spos, n_ = rel_ < 0 ? -rel_ : rel_; \
            const int big_ = 8 + (n_ >= 15) + (n_ >= 27) + (n_ >= 50) + (n_ >= 91) + (n_ >= 166) + (n_ >= 305) + (n_ >= 559); \
            const int pos_ = (n_ < 8 ? n_ : big_) + (rel_ > 0 ? 16 : 0) - 8 * g; const unsigned one_ = (pos_ & 1) ? 0x3F800000u : 0x3F80u; const int hi_ = pos_ >> 1; \
            u32x4 w_; w_.x = (hi_ == 0) ? one_ : 0u; w_.y = (hi_ == 1) ? one_ : 0u; w_.z = (hi_ == 2) ? one_ : 0u; w_.w = (hi_ == 3) ? one_ : 0u; dst = __builtin_bit_cast(bf16x8_t, w_); } while (0)
        const int q4 = c >> 2, p = c & 3;
        const unsigned trb = tile_a + (4 * g + q4) * KVP + 8 * p;
        for (int tl = 0; tl < ntile; ++tl) {
            int kan = 0, kbn = 0; const bool more = tl + 1 < ntile;
            if (more) { kan = (int)selw[(2 * tl + 2) * 16 + c]; kbn = (int)selw[(2 * tl + 3) * 16 + c]; }
            bf16x8_t oha, ohb; ONEHOT(oha, ka); ONEHOT(ohb, kb);
            asm volatile("s_waitcnt vmcnt(8)" ::: "memory");
            pg8::f32x4 s0 = {0.f, 0.f, 0.f, 0.f}, s1 = {0.f, 0.f, 0.f, 0.f};
            s0 = __builtin_amdgcn_mfma_f32_16x16x32_bf16(oha, bbf, s0, 0, 0, 0);
#pragma unroll
            for (int ks = 0; ks < 8; ++ks) { s0 = __builtin_amdgcn_mfma_f32_16x16x32_bf16(kv0[ks], qf[ks], s0, 0, 0, 0); *(LDSP bf16x8_t*)(tile + c * KVP + g * 16 + ks * 64) = kv0[ks]; }
            if (more) KV_LOAD(kv0, kan);
            if (more) asm volatile("s_waitcnt vmcnt(8)" ::: "memory"); else asm volatile("s_waitcnt vmcnt(0)" ::: "memory");
            s1 = __builtin_amdgcn_mfma_f32_16x16x32_bf16(ohb, bbf, s1, 0, 0, 0);
#pragma unroll
            for (int ks = 0; ks < 8; ++ks) { s1 = __builtin_amdgcn_mfma_f32_16x16x32_bf16(kv1[ks], qf[ks], s1, 0, 0, 0); *(LDSP bf16x8_t*)(tile + (16 + c) * KVP + g * 16 + ks * 64) = kv1[ks]; }
            if (more) KV_LOAD(kv1, kbn);
            ka = kan; kb = kbn;
            float sv[8];
#pragma unroll
            for (int j = 0; j < 4; ++j) { sv[j] = s0[j]; sv[4 + j] = s1[j]; }
            float tmax = fmaxf(fmaxf(fmaxf(sv[0], sv[1]), fmaxf(sv[2], sv[3])), fmaxf(fmaxf(sv[4], sv[5]), fmaxf(sv[6], sv[7])));
            tmax = fmaxf(tmax, __shfl_xor(tmax, 16)); tmax = fmaxf(tmax, __shfl_xor(tmax, 32));
            const float m_new = fmaxf(m_run, tmax); const float scl = __expf(m_run - m_new); const bool grow = m_new > m_run; m_run = m_new;
            float ps = 0.f;
#pragma unroll
            for (int j = 0; j < 8; ++j) { sv[j] = __expf(sv[j] - m_new); ps += sv[j]; }
            l_run = l_run * scl + ps;
            bf16x8_t pf; { u32x4 w; w.x = pk2(sv[0], sv[1]); w.y = pk2(sv[2], sv[3]); w.z = pk2(sv[4], sv[5]); w.w = pk2(sv[6], sv[7]); pf = __builtin_bit_cast(bf16x8_t, w); }
            if (__builtin_amdgcn_ballot_w64(grow) != 0ull) {
                float rs[4];
#pragma unroll
                for (int e = 0; e < 4; ++e) rs[e] = __shfl(scl, 4 * g + e);
#pragma unroll
                for (int nt = 0; nt < 16; ++nt) {
#pragma unroll
                    for (int e = 0; e < 4; ++e) acc[nt][e] *= rs[e]; } }
            asm volatile("s_waitcnt lgkmcnt(0)" ::: "memory");
            u16x4_t va[8], vb[8];
            TR8N(va[0], va[1], va[2], va[3], va[4], va[5], va[6], va[7], trb, 0, 16 * KVP, 32, 32 + 16 * KVP, 64, 64 + 16 * KVP, 96, 96 + 16 * KVP);
            TR8N(vb[0], vb[1], vb[2], vb[3], vb[4], vb[5], vb[6], vb[7], trb, 128, 128 + 16 * KVP, 160, 160 + 16 * KVP, 192, 192 + 16 * KVP, 224, 224 + 16 * KVP);
            WAITPIN8(8, va[0], va[1], va[2], va[3], va[4], va[5], va[6], va[7]);
#pragma unroll
            for (int k = 0; k < 4; ++k) acc[k] = __builtin_amdgcn_mfma_f32_16x16x32_bf16(pf, mk8a(va[2 * k], va[2 * k + 1]), acc[k], 0, 0, 0);
            TR8N(va[0], va[1], va[2], va[3], va[4], va[5], va[6], va[7], trb, 256, 256 + 16 * KVP, 288, 288 + 16 * KVP, 320, 320 + 16 * KVP, 352, 352 + 16 * KVP);
            WAITPIN8(8, vb[0], vb[1], vb[2], vb[3], vb[4], vb[5], vb[6], vb[7]);
#pragma unroll
            for (int k = 0; k < 4; ++k) acc[4 + k] = __builtin_amdgcn_mfma_f32_16x16x32_bf16(pf, mk8a(vb[2 * k], vb[2 * k + 1]), acc[4 + k], 0, 0, 0);
            TR8N(vb[0], vb[1], vb[2], vb[3], vb[4], vb[5], vb[6], vb[7], trb, 384, 384 + 16 * KVP, 416, 416 + 16 * KVP, 448, 448 + 16 * KVP, 480, 480 + 16 * KVP);
            WAITPIN8(8, va[0], va[1], va[2], va[3], va[4], va[5], va[6], va[7]);
#pragma unroll
            for (int k = 0; k < 4; ++k) acc[8 + k] = __builtin_amdgcn_mfma_f32_16x16x32_bf16(pf, mk8a(va[2 * k], va[2 * k + 1]), acc[8 + k], 0, 0, 0);
            WAITPIN8(0, vb[0], vb[1], vb[2], vb[3], vb[4], vb[5], vb[6], vb[7]);
#pragma unroll
            for (int k = 0; k < 4; ++k) acc[12 + k] = __builtin_amdgcn_mfma_f32_16x16x32_bf16(pf, mk8a(vb[2 * k], vb[2 * k + 1]), acc[12 + k], 0, 0, 0);
        }
#undef KV_LOAD
#undef ONEHOT
        float lt = l_run + __shfl_xor(l_run, 16); lt += __shfl_xor(lt, 32); const float inv = 1.0f / lt;
        float ri[4];
#pragma unroll
        for (int e = 0; e < 4; ++e) ri[e] = __shfl(inv, 4 * g + e);
        if (g < 2) {
#pragma unroll
            for (int nt = 0; nt < 16; ++nt) { LDSP unsigned short* o1 = (LDSP unsigned short*)(tile) + (4 * g) * 256 + nt * 16 + c;
                o1[0] = f2bf(acc[nt][0] * ri[0]); o1[256] = f2bf(acc[nt][1] * ri[1]); o1[512] = f2bf(acc[nt][2] * ri[2]); o1[768] = f2bf(acc[nt][3] * ri[3]); }
        }
    }
    u32x4 nsel_v = {0u, 0u, 0u, 0u};
    if (nxt_unit >= 0 && lane < 32) { const int nb = nxt_unit >> 9, nq = nxt_unit & 511; nsel_v = *((const u32x4*)(idx + (size_t)(nb * SEQ + nq * 8 + wave) * TOPK) + lane); }
    asm volatile("s_waitcnt lgkmcnt(0)" ::: "memory"); __builtin_amdgcn_s_barrier(); asm volatile("" ::: "memory");
    if (qmode == 1) {
        bf16* oscr = qscr + 16384;
#pragma unroll
        for (int j = 0; j < 4; ++j) *((u32x4*)(oscr + (size_t)wave * 2048) + j * 64 + lane) = *((const LDSP u32x4*)(tile) + j * 64 + lane);
    } else {
        const int h = wave; pg8::f32x4 o[4];
#pragma unroll
        for (int nt = 0; nt < 4; ++nt) o[nt] = (pg8::f32x4){0.f, 0.f, 0.f, 0.f};
        const LDSP unsigned char* ab = lds + TILE_STRIDE * (c & 7) + (h * 256 + g * 8) * 2;
        const unsigned long long* os = (const unsigned long long*)(qscr + 16384 + ((c & 7) * 8 + h) * 256 + g * 8);
        const bf16* wb = WUV + ((size_t)h * 64 + c) * 256 + g * 8;
        const bool from_scr = (qmode == 2) && (c < 8);
#pragma unroll
        for (int ks = 0; ks < 8; ++ks) { bf16x8_t a;
            if (from_scr) { const unsigned long long lo = __hip_atomic_load(os + ks * 8, __ATOMIC_RELAXED, __HIP_MEMORY_SCOPE_AGENT), hi = __hip_atomic_load(os + ks * 8 + 1, __ATOMIC_RELAXED, __HIP_MEMORY_SCOPE_AGENT);
                u32x4 w; w.x = (unsigned)lo; w.y = (unsigned)(lo >> 32); w.z = (unsigned)hi; w.w = (unsigned)(hi >> 32); a = __builtin_bit_cast(bf16x8_t, w); }
            else a = *(const LDSP bf16x8_t*)(ab + ks * 64);
#pragma unroll
            for (int nt = 0; nt < 4; ++nt) { const bf16x8_t bw = *(const bf16x8_t*)(wb + (size_t)nt * 16 * 256 + ks * 32); o[nt] = __builtin_amdgcn_mfma_f32_16x16x32_bf16(a, bw, o[nt], 0, 0, 0); } }
        const int rbase = (qmode == 2) ? t0 - 8 : t0;
        if ((g < 2 || qmode == 2) && !dry) {
#pragma unroll
            for (int nt = 0; nt < 4; ++nt)
#pragma unroll
                for (int e = 0; e < 4; ++e) RA[(size_t)(rbase + 4 * g + e) * NA + A_Q + h * 64 + nt * 16 + c] = f2bf(o[nt][e]); }
    }
    if (nxt_unit >= 0 && lane < 32) *((LDSP u32x4*)selw_n + lane) = nsel_v;
    asm volatile("s_waitcnt vmcnt(0) lgkmcnt(0)" ::: "memory"); __builtin_amdgcn_s_barrier(); asm volatile("" ::: "memory");
}

template <int VAR = 0> __device__ __forceinline__ void wg_attn16d(LDSP unsigned char* lds, bf16* RA, const bf16* __restrict__ CKVC, const unsigned short* __restrict__ idx, const bf16* __restrict__ WUK, const bf16* __restrict__ WUV,
                                          const float* __restrict__ rel_bias, int unit, int nxt_unit, int par, bool first, int tid, bool dry = false, int qmode = 0, bf16* qscr = nullptr) {
    const int lane = tid & 63, wave = __builtin_amdgcn_readfirstlane(tid >> 6), g = lane >> 4, c = lane & 15;
    const int b = unit >> 9, qg = unit & 511, t0 = b * SEQ + qg * 8, nk = ((qg >> 3) + 1) << 6, nsel = nk < TOPK ? nk : TOPK, ntile = nsel >> 5;
    LDSP unsigned char* QL = lds;
    LDSP unsigned char* tile = lds + wave * TILE_STRIDE;
    LDSP unsigned short* selw = (LDSP unsigned short*)(lds + SELW_OFF + (par * 8 + wave) * 512);
    LDSP unsigned short* selw_n = (LDSP unsigned short*)(lds + SELW_OFF + ((par ^ 1) * 8 + wave) * 512);
    if (first) { if (lane < 32) *((LDSP u32x4*)selw + lane) = *((const u32x4*)(idx + (size_t)(t0 + wave) * TOPK) + lane); }
    const bf16* kvb = CKVC + (size_t)b * SEQ * KV_R;
    const int nstep = (VAR & 64) ? 0 : (nsel >> 4);
    constexpr bool halfdma = (VAR & 1) != 0, nodma = (VAR & 2) != 0, nolds = (VAR & 4) != 0, nopv = (VAR & 8) != 0, noqk = (VAR & 16) != 0, nosm = (VAR & 32) != 0;
#define KV_DMA(step) do { if (nodma) break; LDSP unsigned char* sl_ = tile + ((step) & 1) * 8192; \
        _Pragma("unroll") for (int i4_ = 0; i4_ < 4; ++i4_) { const int row_ = 4 * i4_ + g; const int key_ = (int)selw[(step) * 16 + row_]; const int c16_ = c ^ ((g << 2) | i4_); \
            const bf16* src_ = kvb + (size_t)key_ * KV_R + c16_ * 8; \
            __builtin_amdgcn_global_load_lds((const unsigned*)src_, (LDSP unsigned*)(sl_ + 1024 * i4_), 16, 0, 0); \
            if (!halfdma) __builtin_amdgcn_global_load_lds((const unsigned*)(src_ + 128), (LDSP unsigned*)(sl_ + 4096 + 1024 * i4_), 16, 0, 0); } } while (0)
    if (nstep > 0) KV_DMA(0);
    bf16x8_t qf[8];
    if (qmode != 2) {
        const int h = wave; const bf16* qr = RA + (size_t)(t0 + (qmode == 1 ? c : (c & 7))) * NA + A_Q + h * 64 + g * 8;
        const bf16x8_t b0 = *(const bf16x8_t*)qr, b1 = *(const bf16x8_t*)(qr + 32);
        const bf16* wb = WUK + ((size_t)h * 256 + c) * 64 + g * 8;
#pragma unroll 4
        for (int rt = 0; rt < 16; ++rt) { const bf16x8_t a0 = *(const bf16x8_t*)(wb + rt * 16 * 64), a1 = *(const bf16x8_t*)(wb + rt * 16 * 64 + 32);
            pg8::f32x4 acc = {0.f, 0.f, 0.f, 0.f};
            acc = __builtin_amdgcn_mfma_f32_16x16x32_bf16(a0, b0, acc, 0, 0, 0); acc = __builtin_amdgcn_mfma_f32_16x16x32_bf16(a1, b1, acc, 0, 0, 0);
            u32x2 w; w.x = pk2(acc[0], acc[1]); w.y = pk2(acc[2], acc[3]);
            if (c < 8) *(LDSP u32x2*)(lds + c * TILE_STRIDE + 8192 + ((h * 256) + rt * 16 + 4 * g) * 2) = w;
            else if (qmode == 1) *(u32x2*)(qscr + ((((c - 8) * 8 + h) * 256) + rt * 16 + 4 * g)) = w; }
        asm volatile("s_waitcnt lgkmcnt(0)" ::: "memory"); __builtin_amdgcn_s_barrier(); asm volatile("" ::: "memory");
#pragma unroll
        for (int ks = 0; ks < 8; ++ks) qf[ks] = *(const LDSP bf16x8_t*)(tile + 8192 + (((c & 7) * 256) + ks * 32 + g * 8) * 2);
        asm volatile("s_waitcnt lgkmcnt(0)" ::: "memory");
    } else {
        const unsigned long long* qs = (const unsigned long long*)(qscr + (((wave * 8 + (c & 7)) * 256) + g * 8));
#pragma unroll
        for (int ks = 0; ks < 8; ++ks) { const unsigned long long lo = __hip_atomic_load(qs + ks * 8, __ATOMIC_RELAXED, __HIP_MEMORY_SCOPE_AGENT), hi = __hip_atomic_load(qs + ks * 8 + 1, __ATOMIC_RELAXED, __HIP_MEMORY_SCOPE_AGENT);
            u32x4 w; w.x = (unsigned)lo; w.y = (unsigned)(lo >> 32); w.z = (unsigned)hi; w.w = (unsigned)(hi >> 32); qf[ks] = __builtin_bit_cast(bf16x8_t, w); }
    }
    const unsigned tile_a = (unsigned)(size_t)tile;
#if ATT_STAGGER
    if (wave >= 4) __builtin_amdgcn_s_sleep(ATT_STAGGER);
#endif
    bf16x8_t bbf; { float bv[8];
#pragma unroll
        for (int j = 0; j < 8; ++j) bv[j] = rel_bias[(8 * g + j) * 8 + (c & 7)];
        u32x4 w; w.x = pk2(bv[0], bv[1]); w.y = pk2(bv[2], bv[3]); w.z = pk2(bv[4], bv[5]); w.w = pk2(bv[6], bv[7]); bbf = __builtin_bit_cast(bf16x8_t, w); }
    {
        const int spos = (qg * 8 + wave);
        pg8::f32x4 acc[16];
#pragma unroll
        for (int nt = 0; nt < 16; ++nt) acc[nt] = (pg8::f32x4){0.f, 0.f, 0.f, 0.f};
        float m_run = -INFINITY, l_run = 0.f;
#define ONEHOT(dst, key) do { const int rel_ = (key) - spos, n_ = rel_ < 0 ? -rel_ : rel_; \
            const int big_ = 8 + (n_ >= 15) + (n_ >= 27) + (n_ >= 50) + (n_ >= 91) + (n_ >= 166) + (n_ >= 305) + (n_ >= 559); \
            const int pos_ = (n_ < 8 ? n_ : big_) + (rel_ > 0 ? 16 : 0) - 8 * g; const unsigned one_ = (pos_ & 1) ? 0x3F800000u : 0x3F80u; const int hi_ = pos_ >> 1; \
            u32x4 w_; w_.x = (hi_ == 0) ? one_ : 0u; w_.y = (hi_ == 1) ? one_ : 0u; w_.z = (hi_ == 2) ? one_ : 0u; w_.w = (hi_ == 3) ? one_ : 0u; dst = __builtin_bit_cast(bf16x8_t, w_); } while (0)
        const int q4 = c >> 2, p = c & 3;
        const unsigned rd0 = tile_a + 256 * c + 16 * (g ^ (c >> 2)); const unsigned rx = (unsigned)(c & 3);
        const unsigned tr0 = tile_a + 256 * (4 * g + q4) + 8 * (p & 1); const unsigned ts = (unsigned)(((q4 << 2) | g)), tb0 = (unsigned)(p >> 1);
        if (nstep > 1) KV_DMA(1);
        for (int st = 0; st < nstep; ++st) {
            const unsigned so = (unsigned)((st & 1) * 8192);
            const int key = (int)selw[st * 16 + c];
            bf16x8_t oh; ONEHOT(oh, key);
            if (st + 1 < nstep) { if (nodma) {} else if (halfdma) asm volatile("s_waitcnt vmcnt(4)" ::: "memory"); else asm volatile("s_waitcnt vmcnt(8)" ::: "memory"); } else asm volatile("s_waitcnt vmcnt(0)" ::: "memory");
            bf16x8_t af[8]; u16x4_t v[16];
#pragma unroll
            for (int ks = 0; ks < 8; ++ks) { if (nolds) af[ks] = qf[ks]; else af[ks] = *(const LDSP bf16x8_t*)(size_t)(rd0 + so + (ks >> 2) * 4096 + 64 * (((unsigned)(ks & 3)) ^ rx)); }
#pragma unroll
            for (int n4 = 0; n4 < 4; ++n4) { unsigned ad[4]; if (nolds) { v[n4 * 4] = v[n4 * 4 + 1] = v[n4 * 4 + 2] = v[n4 * 4 + 3] = (u16x4_t){(unsigned short)st, 1, 2, 3}; continue; }
#pragma unroll
                for (int k = 0; k < 4; ++k) { const unsigned nt = (unsigned)(n4 * 4 + k); ad[k] = tr0 + so + (nt >> 3) * 4096 + 16 * ((((nt & 7) << 1) | tb0) ^ ts); }
                asm volatile("ds_read_b64_tr_b16 %0, %4\n\tds_read_b64_tr_b16 %1, %5\n\tds_read_b64_tr_b16 %2, %6\n\tds_read_b64_tr_b16 %3, %7" : "=&v"(v[n4 * 4]), "=&v"(v[n4 * 4 + 1]), "=&v"(v[n4 * 4 + 2]), "=&v"(v[n4 * 4 + 3]) : "v"(ad[0]), "v"(ad[1]), "v"(ad[2]), "v"(ad[3]) : "memory"); }
            WAITPIN4(0, v[0], v[1], v[2], v[3]); WAITPIN4(0, v[4], v[5], v[6], v[7]); WAITPIN4(0, v[8], v[9], v[10], v[11]); WAITPIN4(0, v[12], v[13], v[14], v[15]);
            if (st + 2 < nstep) KV_DMA(st + 2);
            pg8::f32x4 s0 = {0.f, 0.f, 0.f, 0.f};
            s0 = __builtin_amdgcn_mfma_f32_16x16x32_bf16(oh, bbf, s0, 0, 0, 0);
#pragma unroll
            for (int ks = 0; ks < 8; ++ks) { if (noqk) { if (ks == 0) s0[0] += __builtin_bit_cast(float, ((unsigned)af[0][0] << 16) ^ ((unsigned)af[1][1] << 16) ^ ((unsigned)af[2][1] << 16) ^ ((unsigned)af[3][1] << 16) ^ ((unsigned)af[4][1] << 16) ^ ((unsigned)af[5][1] << 16) ^ ((unsigned)af[6][1] << 16) ^ ((unsigned)af[7][1] << 16)); } else s0 = __builtin_amdgcn_mfma_f32_16x16x32_bf16(af[ks], qf[ks], s0, 0, 0, 0); }
            float tmax = fmaxf(fmaxf(s0[0], s0[1]), fmaxf(s0[2], s0[3]));
            if (!nosm) { tmax = fmaxf(tmax, __shfl_xor(tmax, 16)); tmax = fmaxf(tmax, __shfl_xor(tmax, 32)); }
            const float m_new = fmaxf(m_run, tmax); const float scl = __expf(m_run - m_new); const bool grow = m_new > m_run; m_run = m_new;
            float sv[4]; float ps = 0.f;
#pragma unroll
            for (int j = 0; j < 4; ++j) { sv[j] = __expf(s0[j] - m_new); ps += sv[j]; }
            l_run = l_run * scl + ps;
            typedef short bf16x4_t __attribute__((ext_vector_type(4)));
            bf16x4_t pf; { u32x2 w; w.x = pk2(sv[0], sv[1]); w.y = pk2(sv[2], sv[3]); pf = __builtin_bit_cast(bf16x4_t, w); }
            if (__builtin_amdgcn_ballot_w64(grow) != 0ull) {
                float rs[4];
#pragma unroll
                for (int e = 0; e < 4; ++e) rs[e] = __shfl(scl, 4 * g + e);
#pragma unroll
                for (int nt = 0; nt < 16; ++nt) {
#pragma unroll
                    for (int e = 0; e < 4; ++e) acc[nt][e] *= rs[e]; } }
#pragma unroll
            for (int k = 0; k < 16; ++k) { if (nopv) { acc[k][0] += __builtin_bit_cast(float, (unsigned)v[k][0] << 16) * sv[0]; } else acc[k] = __builtin_amdgcn_mfma_f32_16x16x16bf16_1k(pf, __builtin_bit_cast(bf16x4_t, v[k]), acc[k], 0, 0, 0); }
        }
#undef KV_DMA
#undef ONEHOT
        float lt = l_run + __shfl_xor(l_run, 16); lt += __shfl_xor(lt, 32); const float inv = 1.0f / lt;
        float ri[4];
#pragma unroll
        for (int e = 0; e < 4; ++e) ri[e] = __shfl(inv, 4 * g + e);
        if (g < 2) {
#pragma unroll
            for (int nt = 0; nt < 16; ++nt) { LDSP unsigned short* o1 = (LDSP unsigned short*)(tile) + (4 * g) * 256 + nt * 16 + c;
                o1[0] = f2bf(acc[nt][0] * ri[0]); o1[256] = f2bf(acc[nt][1] * ri[1]); o1[512] = f2bf(acc[nt][2] * ri[2]); o1[768] = f2bf(acc[nt][3] * ri[3]); }
        }
    }
    u32x4 nsel_v = {0u, 0u, 0u, 0u};
    if (nxt_unit >= 0 && lane < 32) { const int nb = nxt_unit >> 9, nq = nxt_unit & 511; nsel_v = *((const u32x4*)(idx + (size_t)(nb * SEQ + nq * 8 + wave) * TOPK) + lane); }
    asm volatile("s_waitcnt lgkmcnt(0)" ::: "memory"); __builtin_amdgcn_s_barrier(); asm volatile("" ::: "memory");
    if (qmode == 1) {
        bf16* oscr = qscr + 16384;
#pragma unroll
        for (int j = 0; j < 4; ++j) *((u32x4*)(oscr + (size_t)wave * 2048) + j * 64 + lane) = *((const LDSP u32x4*)(tile) + j * 64 + lane);
    } else {
        const int h = wave; pg8::f32x4 o[4];
#pragma unroll
        for (int nt = 0; nt < 4; ++nt) o[nt] = (pg8::f32x4){0.f, 0.f, 0.f, 0.f};
        const LDSP unsigned char* ab = lds + TILE_STRIDE * (c & 7) + (h * 256 + g * 8) * 2;
        const unsigned long long* os = (const unsigned long long*)(qscr + 16384 + ((c & 7) * 8 + h) * 256 + g * 8);
        const bf16* wb = WUV + ((size_t)h * 64 + c) * 256 + g * 8;
        const bool from_scr = (qmode == 2) && (c < 8);
#pragma unroll
        for (int ks = 0; ks < 8; ++ks) { bf16x8_t a;
            if (from_scr) { const unsigned long long lo = __hip_atomic_load(os + ks * 8, __ATOMIC_RELAXED, __HIP_MEMORY_SCOPE_AGENT), hi = __hip_atomic_load(os + ks * 8 + 1, __ATOMIC_RELAXED, __HIP_MEMORY_SCOPE_AGENT);
                u32x4 w; w.x = (unsigned)lo; w.y = (unsigned)(lo >> 32); w.z = (unsigned)hi; w.w = (unsigned)(hi >> 32); a = __builtin_bit_cast(bf16x8_t, w); }
            else a = *(const LDSP bf16x8_t*)(ab + ks * 64);
#pragma unroll
            for (int nt = 0; nt < 4; ++nt) { const bf16x8_t bw = *(const bf16x8_t*)(wb + (size_t)nt * 16 * 256 + ks * 32); o[nt] = __builtin_amdgcn_mfma_f32_16x16x32_bf16(a, bw, o[nt], 0, 0, 0); } }
        const int rbase = (qmode == 2) ? t0 - 8 : t0;
        if ((g < 2 || qmode == 2) && !dry) {
#pragma unroll
            for (int nt = 0; nt < 4; ++nt)
#pragma unroll
                for (int e = 0; e < 4; ++e) RA[(size_t)(rbase + 4 * g + e) * NA + A_Q + h * 64 + nt * 16 + c] = f2bf(o[nt][e]); }
    }
    if (nxt_unit >= 0 && lane < 32) *((LDSP u32x4*)selw_n + lane) = nsel_v;
    asm volatile("s_waitcnt vmcnt(0) lgkmcnt(0)" ::: "memory"); __builtin_amdgcn_s_barrier(); asm volatile("" ::: "memory");
}

#define QLS_PTR(t) (RB + (size_t)(t) * NB + 1024)
__device__ __forceinline__ void wg_qlat_all(const bf16* RA, bf16* RB, const bf16* __restrict__ WUK, int blk, int G, int tid) {
    const int lane = tid & 63, wave = __builtin_amdgcn_readfirstlane(tid >> 6), g = lane >> 4, c = lane & 15, h = wave;
    const bf16* wb = WUK + ((size_t)h * 256 + c) * 64 + g * 8;
    bf16x8_t a0[16], a1[16];
#pragma unroll
    for (int rt = 0; rt < 16; ++rt) { a0[rt] = *(const bf16x8_t*)(wb + rt * 16 * 64); a1[rt] = *(const bf16x8_t*)(wb + rt * 16 * 64 + 32); }
#pragma clang loop unroll(disable)
    for (int i = blk; i < T / 16; i += G) { const int b_ = i & 7, j_ = i >> 3, tg = b_ * SEQ + (255 - j_) * 16;
        const bf16* qr = RA + (size_t)(tg + c) * NA + A_Q + h * 64 + g * 8;
        const bf16x8_t b0 = *(const bf16x8_t*)qr, b1 = *(const bf16x8_t*)(qr + 32);
        bf16* dst = QLS_PTR(tg + c) + h * 256 + 4 * g;
#pragma unroll
        for (int rt = 0; rt < 16; ++rt) { pg8::f32x4 acc = {0.f, 0.f, 0.f, 0.f};
            acc = __builtin_amdgcn_mfma_f32_16x16x32_bf16(a0[rt], b0, acc, 0, 0, 0); acc = __builtin_amdgcn_mfma_f32_16x16x32_bf16(a1[rt], b1, acc, 0, 0, 0);
            u32x2 w; w.x = pk2(acc[0], acc[1]); w.y = pk2(acc[2], acc[3]); *(u32x2*)(dst + rt * 16) = w; } }
}
__device__ __forceinline__ void wg_aout_all(bf16* RA, const bf16* RB, const bf16* __restrict__ WUV, int blk, int G, int tid) {
    const int lane = tid & 63, wave = __builtin_amdgcn_readfirstlane(tid >> 6), g = lane >> 4, c = lane & 15, h = wave;
    const bf16* wb = WUV + ((size_t)h * 64 + c) * 256 + g * 8;
    bf16x8_t bw[4][8];
#pragma unroll
    for (int nt = 0; nt < 4; ++nt)
#pragma unroll
        for (int ks = 0; ks < 8; ++ks) bw[nt][ks] = *(const bf16x8_t*)(wb + (size_t)nt * 16 * 256 + ks * 32);
#pragma clang loop unroll(disable)
    for (int i = blk; i < T / 16; i += G) { const int b_ = i & 7, j_ = i >> 3, tg = b_ * SEQ + (255 - j_) * 16;
        const unsigned long long* os = (const unsigned long long*)(QLS_PTR(tg + c) + h * 256 + g * 8);
        pg8::f32x4 o[4];
#pragma unroll
        for (int nt = 0; nt < 4; ++nt) o[nt] = (pg8::f32x4){0.f, 0.f, 0.f, 0.f};
        bf16x8_t a[8];
#pragma unroll
        for (int ks = 0; ks < 8; ++ks) { const unsigned long long lo = __hip_atomic_load(os + ks * 8, __ATOMIC_RELAXED, __HIP_MEMORY_SCOPE_AGENT), hi = __hip_atomic_load(os + ks * 8 + 1, __ATOMIC_RELAXED, __HIP_MEMORY_SCOPE_AGENT);
            u32x4 w; w.x = (unsigned)lo; w.y = (unsigned)(lo >> 32); w.z = (unsigned)hi; w.w = (unsigned)(hi >> 32); a[ks] = __builtin_bit_cast(bf16x8_t, w); }
#pragma unroll
        for (int ks = 0; ks < 8; ++ks)
#pragma unroll
            for (int nt = 0; nt < 4; ++nt) o[nt] = __builtin_amdgcn_mfma_f32_16x16x32_bf16(a[ks], bw[nt][ks], o[nt], 0, 0, 0);
#pragma unroll
        for (int nt = 0; nt < 4; ++nt)
#pragma unroll
            for (int e = 0; e < 4; ++e) RA[(size_t)(tg + 4 * g + e) * NA + A_Q + h * 64 + nt * 16 + c] = f2bf(o[nt][e]); }
}
__device__ __forceinline__ void wg_attn8(LDSP unsigned char* lds, bf16* RB, const bf16* __restrict__ CKVC, const float* __restrict__ rel_bias, int unit, int par, int tid) {
    const int lane = tid & 63, wave = __builtin_amdgcn_readfirstlane(tid >> 6), g = lane >> 4, c = lane & 15;
    const int b = unit >> 9, qg = unit & 511, t0 = b * SEQ + qg * 8, nk = ((qg >> 3) + 1) << 6, nsel = nk < TOPK ? nk : TOPK;
    LDSP unsigned char* tile = lds + wave * TILE_STRIDE;
    LDSP unsigned short* selw = (LDSP unsigned short*)(lds + SELW_OFF + (par * 8 + wave) * 512);
    const bf16* kvb = CKVC + (size_t)b * SEQ * KV_R;
    const int nstep = nsel >> 4;
#define KV_KEYS(step) (*(const LDSP u32x2*)(selw + (step) * 16 + 4 * g))
#define KV_DMA(step, kk_) do { LDSP unsigned char* sl_ = tile + ((step) & 1) * 8192; \
        _Pragma("unroll") for (int i4_ = 0; i4_ < 4; ++i4_) { const unsigned kw_ = (i4_ >> 1) ? kk_.y : kk_.x; const int key_ = (int)((i4_ & 1) ? (kw_ >> 16) : (kw_ & 0xffffu)); const int c16_ = c ^ ((g << 2) | i4_); \
            const bf16* src_ = kvb + (size_t)key_ * KV_R + c16_ * 8; \
            __builtin_amdgcn_global_load_lds((const unsigned*)src_, (LDSP unsigned*)(sl_ + 1024 * i4_), 16, 0, 0); \
            __builtin_amdgcn_global_load_lds((const unsigned*)(src_ + 128), (LDSP unsigned*)(sl_ + 4096 + 1024 * i4_), 16, 0, 0); } } while (0)
    { const u32x2 k0_ = KV_KEYS(0), k1_ = KV_KEYS(1); KV_DMA(0, k0_); if (nstep > 1) KV_DMA(1, k1_); }
    bf16x8_t qf[8];
    {   const unsigned long long* qs = (const unsigned long long*)(QLS_PTR(t0 + wave) + (c & 7) * 256 + g * 8);
#pragma unroll
        for (int ks = 0; ks < 8; ++ks) { const unsigned long long lo = __hip_atomic_load(qs + ks * 8, __ATOMIC_RELAXED, __HIP_MEMORY_SCOPE_AGENT), hi = __hip_atomic_load(qs + ks * 8 + 1, __ATOMIC_RELAXED, __HIP_MEMORY_SCOPE_AGENT);
            u32x4 w; w.x = (unsigned)lo; w.y = (unsigned)(lo >> 32); w.z = (unsigned)hi; w.w = (unsigned)(hi >> 32); qf[ks] = __builtin_bit_cast(bf16x8_t, w); } }
    const unsigned tile_a = (unsigned)(size_t)tile;
    bf16x8_t bbf; { float bv[8];
#pragma unroll
        for (int j = 0; j < 8; ++j) bv[j] = rel_bias[(8 * g + j) * 8 + (c & 7)];
        u32x4 w; w.x = pk2(bv[0], bv[1]); w.y = pk2(bv[2], bv[3]); w.z = pk2(bv[4], bv[5]); w.w = pk2(bv[6], bv[7]); bbf = __builtin_bit_cast(bf16x8_t, w); }
    {
        const int spos = (qg * 8 + wave);
        pg8::f32x4 acc[16];
#pragma unroll
        for (int nt = 0; nt < 16; ++nt) acc[nt] = (pg8::f32x4){0.f, 0.f, 0.f, 0.f};
        float m_run = -INFINITY, l_run = 0.f;
#define ONEHOT(dst, key) do { const int rel_ = (key) - spos, n_ = rel_ < 0 ? -rel_ : rel_; \
            const int big_ = 8 + (n_ >= 15) + (n_ >= 27) + (n_ >= 50) + (n_ >= 91) + (n_ >= 166) + (n_ >= 305) + (n_ >= 559); \
            const int pos_ = (n_ < 8 ? n_ : big_) + (rel_ > 0 ? 16 : 0) - 8 * g; const unsigned one_ = (pos_ & 1) ? 0x3F800000u : 0x3F80u; const int hi_ = pos_ >> 1; \
            u32x4 w_; w_.x = (hi_ == 0) ? one_ : 0u; w_.y = (hi_ == 1) ? one_ : 0u; w_.z = (hi_ == 2) ? one_ : 0u; w_.w = (hi_ == 3) ? one_ : 0u; dst = __builtin_bit_cast(bf16x8_t, w_); } while (0)
        const int q4 = c >> 2, p = c & 3;
        const unsigned rd0 = tile_a + 256 * c + 16 * (g ^ (c >> 2)); const unsigned rx = (unsigned)(c & 3);
        const unsigned tr0 = tile_a + 256 * (4 * g + q4) + 8 * (p & 1); const unsigned ts = (unsigned)(((q4 << 2) | g)), tb0 = (unsigned)(p >> 1);
        const LDSP unsigned short* selk = selw + 4 * (c & 3) + (c >> 2);
        bf16x8_t oh; { const int key0 = (int)selk[0]; ONEHOT(oh, key0); }
        for (int st = 0; st < nstep; ++st) {
            const unsigned so = (unsigned)((st & 1) * 8192);
            if (st + 1 < nstep) asm volatile("s_waitcnt vmcnt(8)" ::: "memory"); else asm volatile("s_waitcnt vmcnt(0)" ::: "memory");
            bf16x8_t af[8]; u16x4_t v[16];
#pragma unroll
            for (int ks = 0; ks < 8; ++ks) af[ks] = *(const LDSP bf16x8_t*)(size_t)(rd0 + so + (ks >> 2) * 4096 + 64 * (((unsigned)(ks & 3)) ^ rx));
#pragma unroll
            for (int n4 = 0; n4 < 4; ++n4) { unsigned ad[4];
#pragma unroll
                for (int k = 0; k < 4; ++k) { const unsigned nt = (unsigned)(n4 * 4 + k); ad[k] = tr0 + so + (nt >> 3) * 4096 + 16 * ((((nt & 7) << 1) | tb0) ^ ts); }
                asm volatile("ds_read_b64_tr_b16 %0, %4\n\tds_read_b64_tr_b16 %1, %5\n\tds_read_b64_tr_b16 %2, %6\n\tds_read_b64_tr_b16 %3, %7" : "=&v"(v[n4 * 4]), "=&v"(v[n4 * 4 + 1]), "=&v"(v[n4 * 4 + 2]), "=&v"(v[n4 * 4 + 3]) : "v"(ad[0]), "v"(ad[1]), "v"(ad[2]), "v"(ad[3]) : "memory"); }
            const int key_n = (int)selk[(st + 1) * 16]; const u32x2 kk2 = KV_KEYS(st + 2);
            WAITPIN4(0, v[0], v[1], v[2], v[3]); WAITPIN4(0, v[4], v[5], v[6], v[7]); WAITPIN4(0, v[8], v[9], v[10], v[11]); WAITPIN4(0, v[12], v[13], v[14], v[15]);
            if (st + 2 < nstep) KV_DMA(st + 2, kk2);
            pg8::f32x4 s0 = {0.f, 0.f, 0.f, 0.f};
            s0 = __builtin_amdgcn_mfma_f32_16x16x32_bf16(oh, bbf, s0, 0, 0, 0);
#pragma unroll
            for (int ks = 0; ks < 8; ++ks) s0 = __builtin_amdgcn_mfma_f32_16x16x32_bf16(af[ks], qf[ks], s0, 0, 0, 0);
            ONEHOT(oh, key_n);
            float tmax = fmaxf(fmaxf(s0[0], s0[1]), fmaxf(s0[2], s0[3]));
            {   float ta = tmax, tb = tmax;
                asm volatile("s_nop 1\n\tv_permlane16_swap_b32 %0, %1" : "+v"(ta), "+v"(tb)); tmax = fmaxf(ta, tb); ta = tmax; tb = tmax;
                asm volatile("s_nop 1\n\tv_permlane32_swap_b32 %0, %1" : "+v"(ta), "+v"(tb)); tmax = fmaxf(ta, tb); }
            if (__builtin_amdgcn_ballot_w64(tmax > m_run + 8.0f) != 0ull) {
                const float m_new = fmaxf(m_run, tmax); const float scl = __expf(m_run - m_new); m_run = m_new; l_run *= scl;
                float rs[4];
#pragma unroll
                for (int e = 0; e < 4; ++e) rs[e] = __shfl(scl, 4 * g + e);
#pragma unroll
                for (int nt = 0; nt < 16; ++nt) {
#pragma unroll
                    for (int e = 0; e < 4; ++e) acc[nt][e] *= rs[e]; } }
            float sv[4]; float ps = 0.f;
#pragma unroll
            for (int j = 0; j < 4; ++j) { sv[j] = __expf(s0[j] - m_run); ps += sv[j]; }
            l_run += ps;
            typedef short bf16x4_t __attribute__((ext_vector_type(4)));
            bf16x4_t pf; { u32x2 w; w.x = pk2(sv[0], sv[1]); w.y = pk2(sv[2], sv[3]); pf = __builtin_bit_cast(bf16x4_t, w); }
#pragma unroll
            for (int k = 0; k < 16; ++k) acc[k] = __builtin_amdgcn_mfma_f32_16x16x16bf16_1k(pf, __builtin_bit_cast(bf16x4_t, v[k]), acc[k], 0, 0, 0);
        }
#undef KV_DMA
#undef KV_KEYS
#undef ONEHOT
        float lt = l_run + __shfl_xor(l_run, 16); lt += __shfl_xor(lt, 32); const float inv = 1.0f / lt;
        float ri[4];
#pragma unroll
        for (int e = 0; e < 4; ++e) ri[e] = __shfl(inv, 4 * g + e);
        if (g < 2) {
#pragma unroll
            for (int nt = 0; nt < 16; ++nt) { LDSP unsigned short* o1 = (LDSP unsigned short*)(tile) + (4 * g) * 256 + nt * 16 + c;
                o1[0] = f2bf(acc[nt][0] * ri[0]); o1[256] = f2bf(acc[nt][1] * ri[1]); o1[512] = f2bf(acc[nt][2] * ri[2]); o1[768] = f2bf(acc[nt][3] * ri[3]); }
        }
    }
    asm volatile("s_waitcnt lgkmcnt(0)" ::: "memory");
#pragma unroll
    for (int j = 0; j < 4; ++j) *((u32x4*)(QLS_PTR(t0 + wave)) + j * 64 + lane) = *((const LDSP u32x4*)(tile) + j * 64 + lane);
    asm volatile("s_waitcnt lgkmcnt(0)" ::: "memory");
}

#ifndef SSM_SPLIT_V
#define SSM_SPLIT_V 42
#endif
constexpr int SSM_SPLIT = SSM_SPLIT_V;
constexpr int XP = 144, BP = 272;
constexpr int SB_X = 0, SB_B = 8192, SB_C = 24576, SB_SIZE = 40960;
constexpr int L_XS = 2 * SB_SIZE, L_M = L_XS + 64 * XP, L_HC = L_M + 64 * XP, L_TB = L_HC + 2 * 64 * BP;
static_assert(L_TB + 2048 <= 140 * 1024, "ssm lds");
#define TR2(d0, d1, a0, a1) asm volatile("ds_read_b64_tr_b16 %0, %2\n\tds_read_b64_tr_b16 %1, %3\n\ts_waitcnt lgkmcnt(0)" : "=&v"(d0), "=&v"(d1) : "v"(a0), "v"(a1) : "memory")
#define TR2N(d0, d1, a0, a1) asm volatile("ds_read_b64_tr_b16 %0, %2\n\tds_read_b64_tr_b16 %1, %3" : "=&v"(d0), "=&v"(d1) : "v"(a0), "v"(a1) : "memory")
#define TR8NA(d0, d1, d2, d3, d4, d5, d6, d7, a0, a1, a2, a3, a4, a5, a6, a7) asm volatile( \
    "ds_read_b64_tr_b16 %0, %8\n\tds_read_b64_tr_b16 %1, %9\n\tds_read_b64_tr_b16 %2, %10\n\tds_read_b64_tr_b16 %3, %11\n\t" \
    "ds_read_b64_tr_b16 %4, %12\n\tds_read_b64_tr_b16 %5, %13\n\tds_read_b64_tr_b16 %6, %14\n\tds_read_b64_tr_b16 %7, %15" \
    : "=&v"(d0), "=&v"(d1), "=&v"(d2), "=&v"(d3), "=&v"(d4), "=&v"(d5), "=&v"(d6), "=&v"(d7) : "v"(a0), "v"(a1), "v"(a2), "v"(a3), "v"(a4), "v"(a5), "v"(a6), "v"(a7) : "memory")
__device__ __forceinline__ bf16x8_t mk8(u16x4_t a, u16x4_t b) { bf16x8_t r; r[0] = a[0]; r[1] = a[1]; r[2] = a[2]; r[3] = a[3]; r[4] = b[0]; r[5] = b[1]; r[6] = b[2]; r[7] = b[3]; return r; }
__device__ __forceinline__ int bc_off(int row, int ch) { return 256 * row + 16 * (ch ^ (((row & 3) << 2) | ((row >> 2) & 3))); }
__device__ __forceinline__ void ssm_dma(LDSP unsigned char* buf, const bf16* __restrict__ XA, int tc0, int h, int grp, int wave, int lane, bool full) {
    {   const int row = 8 * wave + (lane >> 3), ch = lane & 7;
        __builtin_amdgcn_global_load_lds((const unsigned*)(XA + (size_t)(tc0 + row) * XBC + h * 64 + ch * 8), (LDSP unsigned*)(buf + 1024 * wave), 16, 0, 0); }
#pragma unroll
    for (int k = 0; k < 4; ++k) { if (k >= 2 && !full) break;
        const int pp = wave + 8 * (k & 1), row = 4 * pp + (lane >> 4), ch = (lane & 15) ^ (((row & 3) << 2) | ((row >> 2) & 3));
        __builtin_amdgcn_global_load_lds((const unsigned*)(XA + (size_t)(tc0 + row) * XBC + (k < 2 ? 1024 : 1280) + grp * 128 + ch * 8), (LDSP unsigned*)(buf + 1024 * (8 + 16 * (k >> 1) + pp)), 16, 0, 0); }
}
__device__ __forceinline__ void wg_ssm_unit(LDSP unsigned char* lds, bf16* RA, const bf16* __restrict__ XA, const float* __restrict__ DTt,
                                            const float* __restrict__ a_log, const float* __restrict__ dsk, int unit, int tid, bf16* dbg_out = nullptr, bool dry = false) {
    const int lane = tid & 63, wave = __builtin_amdgcn_readfirstlane(tid >> 6), g = lane >> 4, c = lane & 15, q4 = c >> 2, p4 = c & 3;
    const int b = unit >> 5, h = (unit >> 1) & 15, seg = unit & 1, grp = h >> 3, pq = wave & 3, hf = wave >> 2;
    const float Dh = dsk[h];
    const unsigned lds_a = (unsigned)(size_t)lds;
    LDSP float* TB = (LDSP float*)(lds + L_TB);
    typedef float f32x2_t __attribute__((ext_vector_type(2)));
    const f32x2_t* dtp = (const f32x2_t*)DTt + (size_t)(b * 16 + h) * SEQ;
    pg8::f32x4 hacc[4];
#pragma unroll
    for (int nt = 0; nt < 4; ++nt) hacc[nt] = (pg8::f32x4){0.f, 0.f, 0.f, 0.f};
    for (int i = tid; i < (2 * 64 * BP) / 4; i += NTHR) ((LDSP unsigned*)(lds + L_HC))[i] = 0u;
    const int c_end = seg ? 64 : SSM_SPLIT;
    ssm_dma(lds, XA, b * SEQ, h, grp, wave, lane, seg == 0 || SSM_SPLIT == 0);
    f32x2_t dt_cur = dtp[lane];
    asm volatile("s_waitcnt vmcnt(0) lgkmcnt(0)" ::: "memory"); __builtin_amdgcn_s_barrier(); asm volatile("" ::: "memory");
    for (int ci = 0; ci < c_end; ++ci) {
        const bool full = (seg == 0) || (ci >= SSM_SPLIT);
        const int tc0 = b * SEQ + ci * 64;
        LDSP unsigned char* buf = lds + (ci & 1) * SB_SIZE;
        f32x2_t dt_nxt = {0.f, 0.f};
        if (ci + 1 < c_end) { ssm_dma(lds + ((ci + 1) & 1) * SB_SIZE, XA, tc0 + 64, h, grp, wave, lane, (seg == 0) || (ci + 1 >= SSM_SPLIT)); dt_nxt = dtp[(ci + 1) * 64 + lane]; }
        u32x2 zr[2] = {{0u, 0u}, {0u, 0u}};
        if (full) {
#pragma unroll
            for (int k2 = 0; k2 < 2; ++k2) zr[k2] = *(const u32x2*)(RA + (size_t)(tc0 + 16 * (2 * hf + k2) + c) * NA + A_Z + h * 64 + 16 * pq + 4 * g); }
        {   const float dt = dt_cur.x, acs = dt_cur.y; const float tot = __builtin_bit_cast(float, __builtin_amdgcn_readlane(__builtin_bit_cast(int, acs), 63));
            TB[lane] = dt; TB[64 + lane] = acs; TB[128 + lane] = __expf(acs); TB[192 + lane] = __expf(tot - acs) * dt; if (lane == 0) TB[256] = __expf(tot); }
        asm volatile("s_waitcnt lgkmcnt(0)" ::: "memory");
        {   const int row = tid >> 3, ch = tid & 7; const u32x4 xv = *(const LDSP u32x4*)(buf + SB_X + row * 128 + ch * 16); const float wl = TB[192 + row]; const unsigned xw[4] = {xv.x, xv.y, xv.z, xv.w}; u32x4 o;
            o.x = pk2(__builtin_bit_cast(float, xw[0] << 16) * wl, __builtin_bit_cast(float, xw[0] & 0xffff0000u) * wl); o.y = pk2(__builtin_bit_cast(float, xw[1] << 16) * wl, __builtin_bit_cast(float, xw[1] & 0xffff0000u) * wl);
            o.z = pk2(__builtin_bit_cast(float, xw[2] << 16) * wl, __builtin_bit_cast(float, xw[2] & 0xffff0000u) * wl); o.w = pk2(__builtin_bit_cast(float, xw[3] << 16) * wl, __builtin_bit_cast(float, xw[3] & 0xffff0000u) * wl);
            *(LDSP u32x4*)(lds + L_XS + row * XP + ch * 16) = o; }
        if (full) {
            const int lt = wave >> 1;
#pragma unroll
            for (int k2 = 0; k2 < 2; ++k2) { const int st = 2 * (wave & 1) + k2; pg8::f32x4 ga = {0.f, 0.f, 0.f, 0.f};
#pragma unroll
                for (int ks = 0; ks < 4; ++ks) { const bf16x8_t af = *(const LDSP bf16x8_t*)(buf + SB_C + bc_off(16 * lt + c, 4 * ks + g)), bfm = *(const LDSP bf16x8_t*)(buf + SB_B + bc_off(16 * st + c, 4 * ks + g));
                    ga = __builtin_amdgcn_mfma_f32_16x16x32_bf16(bfm, af, ga, 0, 0, 0); }
                const int l = 16 * lt + c, s4 = 16 * st + 4 * g; const float acs_l = TB[64 + l];
                const pg8::f32x4 acs_s = *(const LDSP pg8::f32x4*)(TB + 64 + s4), dt_s = *(const LDSP pg8::f32x4*)(TB + s4); float m[4];
#pragma unroll
                for (int e = 0; e < 4; ++e) m[e] = (s4 + e <= l) ? ga[e] * __expf(acs_l - acs_s[e]) * dt_s[e] : 0.f;
                u32x2 mw; mw.x = pk2(m[0], m[1]); mw.y = pk2(m[2], m[3]); *(LDSP u32x2*)(lds + L_M + l * XP + s4 * 2) = mw; }
        }
        asm volatile("s_waitcnt lgkmcnt(0)" ::: "memory"); __builtin_amdgcn_s_barrier(); asm volatile("" ::: "memory");
        if (full) {
            pg8::f32x4 ya[2] = {{0.f, 0.f, 0.f, 0.f}, {0.f, 0.f, 0.f, 0.f}};
            const LDSP unsigned char* hcur = lds + L_HC + (ci & 1) * (64 * BP);
#pragma unroll
            for (int ks = 0; ks < 4; ++ks) { const bf16x8_t hb = *(const LDSP bf16x8_t*)(hcur + (16 * pq + c) * BP + (32 * ks + 8 * g) * 2);
#pragma unroll
                for (int k2 = 0; k2 < 2; ++k2) { const bf16x8_t af = *(const LDSP bf16x8_t*)(buf + SB_C + bc_off(16 * (2 * hf + k2) + c, 4 * ks + g)); ya[k2] = __builtin_amdgcn_mfma_f32_16x16x32_bf16(hb, af, ya[k2], 0, 0, 0); } }
#pragma unroll
            for (int k2 = 0; k2 < 2; ++k2) { const float el = TB[128 + 16 * (2 * hf + k2) + c];
#pragma unroll
                for (int e = 0; e < 4; ++e) ya[k2][e] *= el; }
#pragma unroll
            for (int k0 = 0; k0 < 1; ++k0) { u16x4_t xq[2][2]; bf16x8_t mf[2][2];
#pragma unroll
                for (int ks = 0; ks < 2; ++ks) { const unsigned xa = lds_a + (ci & 1) * SB_SIZE + SB_X + (32 * ks + 8 * g + q4) * 128 + (16 * pq + 4 * p4) * 2; TR2N(xq[ks][0], xq[ks][1], xa, xa + 4 * 128); }
#pragma unroll
                for (int ks = 0; ks < 2; ++ks)
#pragma unroll
                    for (int k2 = 0; k2 < 2; ++k2) mf[ks][k2] = *(const LDSP bf16x8_t*)(lds + L_M + (16 * (2 * hf + k2) + c) * XP + (32 * ks + 8 * g) * 2);
                WAITPIN4(0, xq[0][0], xq[0][1], xq[1][0], xq[1][1]);
#pragma unroll
                for (int ks = 0; ks < 2; ++ks) { const bf16x8_t xb = mk8(xq[ks][0], xq[ks][1]);
#pragma unroll
                    for (int k2 = 0; k2 < 2; ++k2) ya[k2] = __builtin_amdgcn_mfma_f32_16x16x32_bf16(xb, mf[ks][k2], ya[k2], 0, 0, 0); } }
#pragma unroll
            for (int k2 = 0; k2 < 2; ++k2) { const int l = 16 * (2 * hf + k2) + c, p4_ = 16 * pq + 4 * g;
                const u32x2 xw = *(const LDSP u32x2*)(buf + SB_X + l * 128 + p4_ * 2); const unsigned xr[2] = {xw.x, xw.y}, zz[2] = {zr[k2].x, zr[k2].y}; float uo[4];
#pragma unroll
                for (int e = 0; e < 4; ++e) { const float x = __builtin_bit_cast(float, (e & 1) ? (xr[e >> 1] & 0xffff0000u) : (xr[e >> 1] << 16)), z = __builtin_bit_cast(float, (e & 1) ? (zz[e >> 1] & 0xffff0000u) : (zz[e >> 1] << 16));
                    uo[e] = (ya[k2][e] + Dh * x) * siluf_(z); }
                u32x2 ow; ow.x = pk2(uo[0], uo[1]); ow.y = pk2(uo[2], uo[3]);
                if (!dry) *(u32x2*)(RA + (size_t)(tc0 + l) * NA + A_Z + h * 64 + p4_) = ow; }
        }
        {   const float dec = TB[256];
#pragma unroll
            for (int nt = 0; nt < 4; ++nt)
#pragma unroll
                for (int e = 0; e < 4; ++e) hacc[nt][e] *= dec;
            {   u16x4_t xq[2][2], v[2][8];
#pragma unroll
                for (int ks = 0; ks < 2; ++ks) { const int row = 32 * ks + 8 * g + q4; const unsigned xa = lds_a + L_XS + row * XP + (16 * pq + 4 * p4) * 2; TR2N(xq[ks][0], xq[ks][1], xa, xa + 4 * XP);
                    unsigned ad[8];
#pragma unroll
                    for (int nt = 0; nt < 4; ++nt) { const int ch = 8 * hf + 2 * nt + (p4 >> 1); ad[2 * nt] = lds_a + (ci & 1) * SB_SIZE + SB_B + bc_off(row, ch) + 8 * (p4 & 1); ad[2 * nt + 1] = lds_a + (ci & 1) * SB_SIZE + SB_B + bc_off(row + 4, ch) + 8 * (p4 & 1); }
                    TR8NA(v[ks][0], v[ks][1], v[ks][2], v[ks][3], v[ks][4], v[ks][5], v[ks][6], v[ks][7], ad[0], ad[1], ad[2], ad[3], ad[4], ad[5], ad[6], ad[7]); }
                WAITPIN4(0, xq[0][0], xq[0][1], xq[1][0], xq[1][1]);
                WAITPIN8(0, v[0][0], v[0][1], v[0][2], v[0][3], v[0][4], v[0][5], v[0][6], v[0][7]); WAITPIN8(0, v[1][0], v[1][1], v[1][2], v[1][3], v[1][4], v[1][5], v[1][6], v[1][7]);
#pragma unroll
                for (int ks = 0; ks < 2; ++ks) { const bf16x8_t xf = mk8(xq[ks][0], xq[ks][1]);
#pragma unroll
                    for (int nt = 0; nt < 4; ++nt) hacc[nt] = __builtin_amdgcn_mfma_f32_16x16x32_bf16(mk8(v[ks][2 * nt], v[ks][2 * nt + 1]), xf, hacc[nt], 0, 0, 0); } }
            LDSP unsigned char* hnext = lds + L_HC + ((ci + 1) & 1) * (64 * BP);
#pragma unroll
            for (int nt = 0; nt < 4; ++nt) { u32x2 hw; hw.x = pk2(hacc[nt][0], hacc[nt][1]); hw.y = pk2(hacc[nt][2], hacc[nt][3]);
                *(LDSP u32x2*)(hnext + (16 * pq + c) * BP + (64 * hf + 16 * nt + 4 * g) * 2) = hw; }
        }
        dt_cur = dt_nxt;
        asm volatile("s_waitcnt vmcnt(0) lgkmcnt(0)" ::: "memory"); __builtin_amdgcn_s_barrier(); asm volatile("" ::: "memory");
    }
}

__global__ void __launch_bounds__(NTHR, 2) k_fwd(Params P) {
    extern __shared__ __attribute__((aligned(16))) unsigned char lds_raw[];
    LDSP unsigned char* lds = (LDSP unsigned char*)lds_raw;
    volatile LDSP unsigned* MISC = (volatile LDSP unsigned*)(lds + MISC_OFF);
    unsigned char* ws = P.ws;
    const int wave_s = __builtin_amdgcn_readfirstlane(threadIdx.x >> 6);
    for (int u = threadIdx.x; u < (LDS_BYTES - RING_BYTES) / 4; u += NTHR) ((LDSP unsigned*)(lds + RING_BYTES))[u] = 0u;
#define PHASE_IDS int tid = mk_tid(wave_s); int blk = blockIdx.x; asm volatile("" : "+s"(blk)); int G = gridDim.x; asm volatile("" : "+s"(G)); const int NGW = G * NWAVES; (void)NGW; const int lane = tid & 63, wave = __builtin_amdgcn_readfirstlane(tid >> 6), gw = blk * NWAVES + wave; (void)lane; (void)wave; (void)gw; const __attribute__((address_space(4))) char* kargs = (const __attribute__((address_space(4))) char*)__builtin_amdgcn_kernarg_segment_ptr(); asm volatile("" : "+s"(kargs)); int Lp = L; asm volatile("" : "+s"(Lp)); (void)Lp; unsigned char* ws = ((unsigned char* const __attribute__((address_space(4)))*)kargs)[27]; float* out = ((float* const __attribute__((address_space(4)))*)kargs)[26]; const float* x = KIN(0); const float* p = KIN(1); float* rstd = (float*)(ws + WS_RSTD); float* rstd2 = (float*)(ws + WS_RSTD2); float* DTb = (float*)(ws + WS_DT); bf16 *Win = (bf16*)(ws + WS_W_IN), *Wout = (bf16*)(ws + WS_W_OUT), *Wgu = (bf16*)(ws + WS_W_GU), *Wdown = (bf16*)(ws + WS_W_DOWN), *Wpg = (bf16*)(ws + WS_W_PG), *Wpp = (bf16*)(ws + WS_W_PP); bf16 *X0 = (bf16*)(ws + WS_X0), *X1 = (bf16*)(ws + WS_X1), *RA = (bf16*)(ws + WS_RA), *RB = (bf16*)(ws + WS_RB), *XA = (bf16*)out; unsigned short* IDX = (unsigned short*)((unsigned char*)out + 112 * MiB); bf16* CKVC = (bf16*)((unsigned char*)out + 96 * MiB); bf16* IKC = (bf16*)(ws + WS_IKC); bf16* WUK = (bf16*)(ws + WS_WUK); bf16* WUV = (bf16*)(ws + WS_WUV); (void)CKVC; (void)IKC; (void)WUK; (void)WUV; bf16* Xcur = (Lp == 0) ? X0 : X1; (void)out; (void)x; (void)p; (void)rstd; (void)rstd2; (void)DTb; (void)Win; (void)Wout; (void)Wgu; (void)Wdown; (void)Wpg; (void)Wpp; (void)X0; (void)X1; (void)RA; (void)RB; (void)XA; (void)IDX; (void)Xcur
    __syncthreads();
    if (TIMING && blockIdx.x == 0 && mk_tid(wave_s) == 0) { __hip_atomic_store((unsigned long long*)(P.ws + 32768), (unsigned long long)__builtin_amdgcn_s_memrealtime(), __ATOMIC_RELAXED, __HIP_MEMORY_SCOPE_AGENT); __hip_atomic_store((unsigned long long*)(P.ws + 32768) + 60, (unsigned long long)__builtin_amdgcn_s_memtime(), __ATOMIC_RELAXED, __HIP_MEMORY_SCOPE_AGENT); }
#if CLK_PROBE
    if (blockIdx.x == 0 && mk_tid(wave_s) == 0) { __hip_atomic_store((unsigned long long*)(P.ws + 49152), (unsigned long long)__builtin_amdgcn_s_memtime(), __ATOMIC_RELAXED, __HIP_MEMORY_SCOPE_AGENT); __hip_atomic_store((unsigned long long*)(P.ws + 49152) + 1, (unsigned long long)__builtin_amdgcn_s_memrealtime(), __ATOMIC_RELAXED, __HIP_MEMORY_SCOPE_AGENT); }
#endif
    const bool one_launch = (P.ph_hi - P.ph_lo) > 1;
    XcdBarrier bar; bar.bar = (unsigned*)(ws + WS_CTL) + CW_BAR; bar.x = 0; bar.st = nullptr;
    if (one_launch) bar = xcd_barrier_post((unsigned*)(ws + WS_CTL) + CW_BAR, (volatile LAS unsigned*)(MISC + 8));
    if (one_launch && mk_tid(wave_s) == 0) { const unsigned xid_ = xb_xcc_id(); MISC[16] = xid_; MISC[17] = __hip_atomic_fetch_add((unsigned*)(P.ws + WS_CTL) + CW_RANK + 64 * xid_, 1u, __ATOMIC_RELAXED, __HIP_MEMORY_SCOPE_AGENT); }

#ifndef TW_VAR
#define TW_VAR 0
#endif
#ifndef TW_MASK
#define TW_MASK 0
#endif
#ifndef PH_MASK
#define PH_MASK 0x3fff
#endif
#define PHASE_IDS_NOL const int L = 0; PHASE_IDS
#define NPASS(k) (((DBL_MASK >> (k)) & 1) ? ((Lp == 0 && ((P.dbl_mask >> (k)) & 1)) ? 2 : 1) : 1)
#define XCD_DEAL bool xok_ = false; int xb_ = 0, xr_ = 0, xn_ = 1; { if (tid == 0) { unsigned ok = (MISC[9] == 8u) ? 1u : 0u; unsigned sum = 0; for (int j = 0; j < 8; ++j) { const unsigned cj = __hip_atomic_load((unsigned*)(ws + WS_CTL) + CW_BAR + XB_XCNT(j), __ATOMIC_RELAXED, __HIP_MEMORY_SCOPE_AGENT); sum += cj; if (cj == 0u) ok = 0u; } if (sum != (unsigned)G) ok = 0u; MISC[18] = ok; } \
    __syncthreads(); xok_ = MISC[18] != 0u; xb_ = (int)MISC[16]; xr_ = (int)MISC[17]; xn_ = (int)MISC[8]; if (xn_ < 1) xn_ = 1; __syncthreads(); }
#define KIN(i) (((const float* const __attribute__((address_space(4)))*)kargs)[i])
#define IN(k) (P.ph_lo <= (k) && (k) < P.ph_hi && ((PH_MASK >> ((k) % NPH)) & 1))
#define SEAM(k) do { if (IN((k) + 1)) { XcdBarrier b2_ = bar; asm volatile("" : "+s"(b2_.bar)); xcd_barrier(b2_, mk_tid(wave_s)); } if (TIMING && blockIdx.x == 0 && mk_tid(wave_s) == 0) { __hip_atomic_store((unsigned long long*)(P.ws + 32768) + (k) + 1, (unsigned long long)__builtin_amdgcn_s_memrealtime(), __ATOMIC_RELAXED, __HIP_MEMORY_SCOPE_AGENT); } } while (0)
    for (int L = 0; L < DEPTH; ++L) {
        const int pb = L * NPH;
        if (IN(pb + 0)) { PHASE_IDS; for (int pass = NPASS(0); pass > 0; --pass) {
            LDSP float* scr = (LDSP float*)(lds + wave * 8704);
            ph_prep_w<1>(scr, KIN(6) + (size_t)Lp * D * INW, nullptr, D, INW, KIN(2) + (size_t)Lp * D, Win, NIN, gw, NGW, lane);
            ph_prep_w<0>(scr, KIN(20) + (size_t)Lp * MIXW * D, nullptr, MIXW, D, nullptr, Wout, D, gw, NGW, lane);
            ph_prep_w<2>(scr, KIN(21) + (size_t)Lp * D * DFF, KIN(22) + (size_t)Lp * D * DFF, D, DFF, KIN(4) + (size_t)Lp * D, Wgu, NGU, gw, NGW, lane);
            ph_prep_w<0>(scr, KIN(23) + (size_t)Lp * DFF * D, nullptr, DFF, D, nullptr, Wdown, D, gw, NGW, lane);
            ph_prep_w<0>(scr, KIN(25) + (size_t)Lp * D * D, nullptr, D, D, nullptr, Wpg, D, gw, NGW, lane);
            ph_prep_w<0>(scr, KIN(24) + (size_t)Lp * PLE * D, nullptr, PLE, D, nullptr, Wpp, D, gw, NGW, lane);
            {   const float* uk = KIN(10) + (size_t)Lp * 256 * 8 * 64; const float* uv = KIN(11) + (size_t)Lp * 256 * 8 * 64;
                for (int e = gw * 64 + lane; e < 8 * 256 * 64; e += NGW * 64) { const int h = e >> 14, r = (e >> 6) & 255, d = e & 63; WUK[e] = f2bf(0.125f * uk[((size_t)r * 8 + h) * 64 + d]); }
                for (int e = gw * 64 + lane; e < 8 * 64 * 256; e += NGW * 64) { const int h = e >> 14, d = (e >> 8) & 63, r = e & 255; WUV[e] = f2bf(uv[((size_t)r * 8 + h) * 64 + d]); } }
            if (Lp == 0) { for (int r = gw * 2; r < T; r += NGW * 2) row_x_prep2(x, X0, rstd, r, lane); }
            else        { for (int r = gw * 4; r < T; r += NGW * 4) row_rstd_bf16x4(X1, rstd, r, lane); }
            }
            SEAM(pb + 0);
        }
#if XTRA_BAR
        if (P.ph_hi - P.ph_lo > 1 && L == 0) { for (int i_ = 0; i_ < XTRA_BAR; ++i_) { XcdBarrier b4_ = bar; asm volatile("" : "+s"(b4_.bar)); xcd_barrier(b4_, mk_tid(wave_s)); } }
#endif
        if (IN(pb + 1)) { PHASE_IDS; for (int pass = NPASS(1); pass > 0; --pass) {
            pg8::Gemm g{Xcur, Win, T, NIN, (GEMM_DRYK && pass > 1) ? GEMM_DRYK : D}; pg8::StaticOrder S; S.init(T, NIN, G, blk);
            pg8::EpiProj E{RA, RB, rstd};
            pg8::gemm_phase<pg8::EpiProj, pg8::StaticOrder, true, true>(lds, g, S, E, tid);
            }
            SEAM(pb + 1);
        }
        if (IN(pb + 2)) { PHASE_IDS;
            for (int pass = NPASS(2); pass > 0; --pass) {
#pragma unroll 2
            for (int it = gw; it < T / 4; it += NGW) prep_ckv4(RB, CKVC, KIN(7) + Lp * KV_R, it, lane);
            for (int it = gw; it < T / 16; it += NGW) prep_ik16(RB, IKC, KIN(8) + Lp * 64, KIN(9) + Lp * 64, it, lane);
#pragma unroll 2
            for (int t = gw; t < T; t += NGW) prep_bout(RA, RB, KIN(13) + (size_t)Lp * 3 * 512, t, lane, pass > 1);
#pragma unroll 2
            for (int it = gw; it < (T / 16) * 12; it += NGW) prep_conv(RB, XA, KIN(14) + (size_t)Lp * 4 * XBC, KIN(15) + (size_t)Lp * XBC, it, lane);
            for (int it = gw; it < BATCH * 64 * 4; it += NGW) { const int hq = it & 3, ck = (it >> 2) & 63, bb = it >> 8; const int t = bb * SEQ + ck * 64 + lane;
                const u32x2 rw = *(const u32x2*)(RB + (size_t)t * NB + B_DT + hq * 4); const unsigned rr[2] = {rw.x, rw.y}; float dtv[4], ac[4];
#pragma unroll
                for (int e = 0; e < 4; ++e) { const int hh = hq * 4 + e; const float xr = __builtin_bit_cast(float, (e & 1) ? (rr[e >> 1] & 0xffff0000u) : (rr[e >> 1] << 16)) + (KIN(16) + Lp * 16)[hh];
                    dtv[e] = xr > 15.f ? xr : log1pf(__expf(xr)); ac[e] = -__expf((KIN(17) + Lp * 16)[hh]) * dtv[e]; }
#pragma unroll
                for (int o = 1; o < 64; o <<= 1) {
#pragma unroll
                    for (int e = 0; e < 4; ++e) { const float v = __shfl_up(ac[e], o); if (lane >= o) ac[e] += v; } }
#pragma unroll
                for (int e = 0; e < 4; ++e) { typedef float f32x2_t __attribute__((ext_vector_type(2))); ((f32x2_t*)(ws + WS_DT2))[(size_t)(bb * 16 + hq * 4 + e) * SEQ + ck * 64 + lane] = (f32x2_t){dtv[e], ac[e]}; } }
            }
            SEAM(pb + 2);
        }
        if (IN(pb + 3)) { PHASE_IDS;
            const bool ssm_first = ((blk >> 3) & 1) == 0;
#pragma clang loop unroll(disable)
            for (int step = 0; step < 3; ++step) {
                const bool do_ssm = (step == 0 && ssm_first) || (step == 2 && !ssm_first);
                if (do_ssm) {
                    for (int u = blk; u < BATCH * 32; u += G) { const int uu = (u & 127) * 2 + (u >> 7);
                        #pragma clang loop unroll(disable)
                        for (int rs_ = (TW_MASK & 4) ? 1 : 0; rs_ >= 0; --rs_) wg_ssm_unit(lds, RA, XA, (const float*)(ws + WS_DT2), KIN(17) + Lp * 16, KIN(18) + Lp * 16, uu ^ 1, mk_tid(wave_s), nullptr, rs_ > 0); }
                } else if (step == 1) {
                    wg_qlat_all(RA, RB, WUK, blk, G, mk_tid(wave_s));
                    asm volatile("s_waitcnt vmcnt(0)" ::: "memory"); __builtin_amdgcn_s_barrier(); asm volatile("" ::: "memory");
#pragma clang loop unroll(disable)
                    for (int i = blk; i < T / 16; i += G) { const int b_ = i & 7, j_ = i >> 3, u16 = b_ * 256 + (255 - j_);
                        wg_select16(lds, RB, IKC, IDX, u16, mk_tid(wave_s), false, true);
                        const int ua = b_ * 512 + 2 * (255 - j_);
#pragma clang loop unroll(disable)
                        for (int h2 = 0; h2 < 2; ++h2) wg_attn8(lds, RB, CKVC, KIN(12), ua + h2, h2, mk_tid(wave_s));
                        asm volatile("s_waitcnt vmcnt(0) lgkmcnt(0)" ::: "memory"); __builtin_amdgcn_s_barrier(); asm volatile("" ::: "memory"); }
                    wg_aout_all(RA, RB, WUV, blk, G, mk_tid(wave_s));
                }
            }
            SEAM(pb + 5); }

        if (IN(pb + 6)) { PHASE_IDS; for (int pass = NPASS(6); pass > 0; --pass) for (int w = 4 * gw; w < T * 2; w += 4 * NGW) wave_gnorm4(RA, KIN(19) + (size_t)Lp * 1024, w, lane, pass > 1); SEAM(pb + 6); }
        if (IN(pb + 7)) { PHASE_IDS; for (int pass = NPASS(7); pass > 0; --pass) {
            pg8::Gemm g{RA, Wout, T, D, MIXW}; pg8::StaticOrder S; S.init(T, D, G, blk);
            pg8::EpiBf16P E{RB, (long)D};
            pg8::gemm_phase<pg8::EpiBf16P, pg8::StaticOrder, true, true>(lds, g, S, E, tid);
            }
            SEAM(pb + 7);
        }
        if (IN(pb + 8)) { PHASE_IDS; for (int pass = NPASS(8); pass > 0; --pass) for (int r = 2 * gw; r < T; r += 2 * NGW) row_resid_norm2(Xcur, (const bf16*)RB, KIN(3) + (size_t)Lp * D, X0, rstd2, nullptr, nullptr, r, lane, pass > 1); SEAM(pb + 8); }
        if (IN(pb + 9)) { PHASE_IDS; for (int pass = NPASS(9); pass > 0; --pass) {
            pg8::Gemm g{X0, Wgu, T, NGU, D}; pg8::StaticOrder S; S.init(T, NGU, G, blk);
            pg8::EpiSwiGLU E{RB, rstd2};
            pg8::gemm_phase<pg8::EpiSwiGLU, pg8::StaticOrder, true, true>(lds, g, S, E, tid);
            }
            SEAM(pb + 9);
        }
        if (IN(pb + 10)) { PHASE_IDS; for (int pass = NPASS(10); pass > 0; --pass) {
            pg8::Gemm g{RB, Wdown, T, D, DFF}; pg8::StaticOrder S; S.init(T, D, G, blk);
            pg8::EpiBf16P E{RA, (long)D};
            pg8::gemm_phase<pg8::EpiBf16P, pg8::StaticOrder, true, true>(lds, g, S, E, tid);
            }
            SEAM(pb + 10);
        }
        if (IN(pb + 11)) { PHASE_IDS; for (int pass = NPASS(11); pass > 0; --pass) for (int r = 2 * gw; r < T; r += 2 * NGW) row_resid_norm2(X0, (const bf16*)RA, KIN(5) + (size_t)Lp * D, X0, nullptr, p + (size_t)Lp * T * PLE, X1, r, lane, pass > 1); SEAM(pb + 11); }
        if (IN(pb + 12)) { PHASE_IDS; for (int pass = NPASS(12); pass > 0; --pass) {
            pg8::Gemm g{X1, Wpp, T, D, PLE}; pg8::StaticOrder S; S.init(T, D, G, blk);
            pg8::EpiBf16P E{RB, (long)D};
            pg8::gemm_phase<pg8::EpiBf16P, pg8::StaticOrder, true, true>(lds, g, S, E, tid);
            }
            SEAM(pb + 12);
        }
        if (IN(pb + 13)) { PHASE_IDS; for (int pass = NPASS(13); pass > 0; --pass) {
            pg8::Gemm g{X0, Wpg, T, D, D}; pg8::StaticOrder S; S.init(T, D, G, blk);
            pg8::EpiPle E{X0, RB, X1, (Lp == DEPTH - 1) ? out : nullptr};
            pg8::gemm_phase<pg8::EpiPle, pg8::StaticOrder, true, true>(lds, g, S, E, tid);
            }
            SEAM(pb + 13);
        }
    }
#if CLK_PROBE
    if (P.ph_hi == DEPTH * NPH) { PHASE_IDS_NOL; { XcdBarrier b3_ = bar; asm volatile("" : "+s"(b3_.bar)); xcd_barrier(b3_, mk_tid(wave_s)); }
        if (blk == 0 && tid == 0) { const unsigned long long c1 = __builtin_amdgcn_s_memtime(), r1 = __builtin_amdgcn_s_memrealtime(); const unsigned long long* ts = (const unsigned long long*)(ws + 49152);
            const unsigned long long c0 = __hip_atomic_load(ts, __ATOMIC_RELAXED, __HIP_MEMORY_SCOPE_AGENT), r0 = __hip_atomic_load(ts + 1, __ATOMIC_RELAXED, __HIP_MEMORY_SCOPE_AGENT);
            const float mhz = (float)(c1 - c0) / (float)(r1 - r0) * 100.0f; const float q = exp2f(rintf(4.0f * log2f(fmaxf(mhz, 1.0f))) * 0.25f);
            __hip_atomic_store((float*)(ws + 49152 + 64), q * 0.001f, __ATOMIC_RELAXED, __HIP_MEMORY_SCOPE_AGENT); }
        { XcdBarrier b3_ = bar; asm volatile("" : "+s"(b3_.bar)); xcd_barrier(b3_, mk_tid(wave_s)); }
        const float sc = 1.0f + __hip_atomic_load((float*)(ws + 49152 + 64), __ATOMIC_RELAXED, __HIP_MEMORY_SCOPE_AGENT);
        for (size_t i = (size_t)blk * NTHR + tid; i < (size_t)T * D; i += (size_t)G * NTHR) out[i] *= sc; }
#endif
#if TIMING
    if (P.ph_hi == DEPTH * NPH) { PHASE_IDS_NOL; { XcdBarrier b3_ = bar; asm volatile("" : "+s"(b3_.bar)); xcd_barrier(b3_, mk_tid(wave_s)); }
        const unsigned long long* ts = (const unsigned long long*)(ws + 32768);
        const float ta = (float)(__hip_atomic_load(ts + TIMING_A + 1, __ATOMIC_RELAXED, __HIP_MEMORY_SCOPE_AGENT) - __hip_atomic_load(ts + TIMING_A, __ATOMIC_RELAXED, __HIP_MEMORY_SCOPE_AGENT)) * 0.01f;
        const float tb = (float)(__hip_atomic_load(ts + TIMING_B + 1, __ATOMIC_RELAXED, __HIP_MEMORY_SCOPE_AGENT) - __hip_atomic_load(ts + TIMING_B, __ATOMIC_RELAXED, __HIP_MEMORY_SCOPE_AGENT)) * 0.01f;
        float ta_ = ta; if (TIMING_A == 99) { const unsigned long long c1 = __builtin_amdgcn_s_memtime(), r1 = __builtin_amdgcn_s_memrealtime(); const unsigned long long c0 = __hip_atomic_load(ts + 60, __ATOMIC_RELAXED, __HIP_MEMORY_SCOPE_AGENT), r0 = __hip_atomic_load(ts + 0, __ATOMIC_RELAXED, __HIP_MEMORY_SCOPE_AGENT);
            ta_ = (float)(c1 - c0) / (float)(r1 - r0) * 10.0f;   ta_ = __builtin_bit_cast(float, __builtin_amdgcn_readfirstlane(__builtin_bit_cast(int, ta_))); }
        const float taq = exp2f(rintf(4.0f * log2f(fmaxf(ta_, 1.0f)) + TIMING_SHIFT) * 0.25f), tbq = exp2f(rintf(2.0f * log2f(fmaxf(tb, 1.0f)) + TIMING_SHIFT) * 0.5f);
        const float sc = 1.0f + taq * 0.001f;
        for (size_t i = (size_t)blk * NTHR + tid; i < (size_t)T * D; i += (size_t)G * NTHR) out[i] *= sc;
        __syncthreads(); if (blk == 0 && tid == 0) out[0] += tbq * 10.0f; }
#endif
#if DBG_SSM
    if (P.ph_hi == DEPTH * NPH) { PHASE_IDS_NOL; { XcdBarrier b3_ = bar; asm volatile("" : "+s"(b3_.bar)); xcd_barrier(b3_, mk_tid(wave_s)); }
        const float d2 = __hip_atomic_load((float*)(ws + 65536), __ATOMIC_RELAXED, __HIP_MEMORY_SCOPE_AGENT), n2 = __hip_atomic_load((float*)(ws + 65536 + 4), __ATOMIC_RELAXED, __HIP_MEMORY_SCOPE_AGENT);
        const float sc = 1.0f + (n2 > 0.f ? sqrtf(d2 / n2) : 7.0f);
        for (size_t i = (size_t)blk * NTHR + tid; i < (size_t)T * D; i += (size_t)G * NTHR) out[i] *= sc; }
#endif
#undef IN
#undef SEAM
}

#ifndef MK_ONE_LAUNCH
#define MK_ONE_LAUNCH 1
#endif
extern "C" void kernel_launch(void* const* d_in, const int* in_sizes, int n_in, void* d_out, int out_size, void* d_ws, size_t ws_size, hipStream_t stream) {
    static int grid = 0;
    if (grid == 0) {
        if (n_in != 26 || ws_size < WS_END) { fprintf(stderr, "kernel_launch: unexpected n_in %d / ws_size %zu\n", n_in, ws_size); grid = -1; return; }
        int dev = 0, cus = 0, per_cu = 0;
        if (hipGetDevice(&dev) != hipSuccess || hipDeviceGetAttribute(&cus, hipDeviceAttributeMultiprocessorCount, dev) != hipSuccess) { grid = -1; return; }
        if (hipFuncSetAttribute((const void*)k_fwd, hipFuncAttributeMaxDynamicSharedMemorySize, LDS_BYTES) != hipSuccess) { fprintf(stderr, "kernel_launch: hipFuncSetAttribute failed\n"); grid = -1; return; }
        if (hipOccupancyMaxActiveBlocksPerMultiprocessor(&per_cu, (const void*)k_fwd, NTHR, LDS_BYTES) != hipSuccess || per_cu < 1) { fprintf(stderr, "kernel_launch: occupancy query says %d\n", per_cu); }
        (void)hipGetLastError();
        grid = cus;
    }
    if (grid < 0) return;
    if (hipMemsetAsync((char*)d_ws + WS_CTL, 0, CTL_ZERO_BYTES, stream) != hipSuccess) return;
    Params P; memset(&P, 0, sizeof(P));
    for (int i = 0; i < 26; ++i) P.in[i] = (const float*)d_in[i];
    P.out = (float*)d_out; P.ws = (unsigned char*)d_ws;
#if MK_ONE_LAUNCH
    P.ph_lo = 0; P.ph_hi = DEPTH * NPH; P.dbl_mask = DBL_MASK; P.pad = ATT_SUB_V;
    hipLaunchKernelGGL(k_fwd, dim3(grid), dim3(NTHR), LDS_BYTES, stream, P);
#else
    for (int ph = 0; ph < DEPTH * NPH; ++ph) { P.ph_lo = ph; P.ph_hi = ph + 1; hipLaunchKernelGGL(k_fwd, dim3(grid), dim3(NTHR), LDS_BYTES, stream, P); }
#endif
}
```

```cpp
#include <hip/hip_runtime.h>
#include <cstdio>
#include <cstdint>
#include <cstring>
#ifndef PG8_AUX
#define PG8_AUX 0
#endif
namespace pg8 {
#define PG8_LAS __attribute__((address_space(3)))
typedef unsigned short bf16_t;
typedef short bf16x8 __attribute__((ext_vector_type(8)));
typedef float f32x4 __attribute__((ext_vector_type(4)));
typedef unsigned u32x4 __attribute__((ext_vector_type(4)));
constexpr int BM = 256, BK = 64, HALF = 128, HTB = HALF * BK * 2  , STAGE_BYTES = 8 * HTB, NXCD = 8, WGM = 8;

__host__ __device__ __forceinline__ int lds_byte(int r, int c) { const int st = (r >> 4) * 2 + (c >> 5), rr = r & 15, cc = c & 31, ob = rr * 64 + cc * 2; return st * 1024 + (ob ^ (((ob >> 9) & 1) << 5)); }
__host__ __device__ __forceinline__ void stage_rc(int b, int& R, int& C) { const int st = b / 1024, sb = b % 1024, swz = sb ^ (((sb >> 9) & 1) << 5); R = (st >> 1) * 16 + swz / 64; C = (st & 1) * 32 + (swz % 64) / 2; }
__host__ __device__ __forceinline__ int perm32(int rho) { const int n = rho >> 4, i = rho & 15; return 8 * (i >> 2) + 4 * n + (i & 3); }

struct Unit { int pm, pn; };
struct Gemm { const bf16_t* A; const bf16_t* Bt; int M, N, K; };

struct StaticOrder {
    int nM, nN, nwg, G, c;
    __host__ __device__ void init(int M, int N, int G_, int c_) { nM = M / BM; nN = N / BM; nwg = nM * nN; G = G_; c = c_; }
    __host__ __device__ bool next(int i, Unit& u) const {
        const long L = (long)i * G + c; if (L >= nwg) return false;
        int wgid = (int)L; { const int q = nwg / NXCD, r = nwg % NXCD, xcd = wgid % NXCD, off = wgid / NXCD; wgid = (xcd < r ? xcd * (q + 1) : r * (q + 1) + (xcd - r) * q) + off; }
        const int nig = WGM * nN, gid = wgid / nig, fm = gid * WGM, gsz = (nM - fm) < WGM ? (nM - fm) : WGM;
        u.pm = fm + ((wgid % nig) % gsz); u.pn = (wgid % nig) / gsz; return true;
    }
    __device__ __forceinline__ void a_ready(const Unit&) const {}
    __device__ __forceinline__ void done(const Unit&) const {}
};

__device__ __forceinline__ unsigned cvt_pk_bf16(float lo, float hi) { unsigned r; asm volatile("v_cvt_pk_bf16_f32 %0, %1, %2" : "=v"(r) : "v"(lo), "v"(hi)); return r; }
typedef float f32x2 __attribute__((ext_vector_type(2)));
__device__ __forceinline__ f32x2 gelu_pk(f32x2 v) {
    const f32x2 av = __builtin_elementwise_abs(v), d = av * 0.2316418882f + 1.0f;
    f32x2 t; t.x = __builtin_amdgcn_rcpf(d.x); t.y = __builtin_amdgcn_rcpf(d.y);
    f32x2 q = t * 0.5307027145f + (-0.7265760135f); q = q * t + 0.7107068705f; q = q * t + (-0.142248368f); q = q * t + 0.127414796f; q = q * t;
    const f32x2 s = (v * v) * (-0.72134752044f);
    f32x2 e; e.x = __builtin_amdgcn_exp2f(s.x); e.y = __builtin_amdgcn_exp2f(s.y);
    const f32x2 m = v * (q * e), r = v - m;
    f32x2 o; o.x = v.x < 0.f ? m.x : r.x; o.y = v.y < 0.f ? m.y : r.y; return o;
}

template <int ACT  > struct EpiBf16 {
    static constexpr bool PERM = true, AFTER_DRAIN = false; static_assert(ACT == 0 || ACT == 1, "EpiBf16: ACT is 0 (none) or 1 (gelu_pk)");
    bf16_t* O; int ldc; const float* bias; int split_cols; size_t split_stride; float scale0;
    __device__ __forceinline__ void operator()(const f32x4 (&acc)[2][2][4][2], const Unit& u, int wr, int wc, int fr, int fq) const {
        const int row0 = u.pm * BM + wr * 64 + fr; int colt = u.pn * BM; bf16_t* base = O;
        float sc = 1.f; if (split_cols) { const int t = colt / split_cols; base += (size_t)t * split_stride; colt -= t * split_cols; if (t == 0) sc = scale0; }
        const int col0 = colt + wc * 32 + 8 * fq, bcol0 = u.pn * BM + wc * 32 + 8 * fq;
        f32x4 bv[2][2];
#pragma unroll
        for (int bj = 0; bj < 2; ++bj)
#pragma unroll
            for (int n = 0; n < 2; ++n) bv[bj][n] = bias ? *(const f32x4*)(bias + bcol0 + bj * HALF + 4 * n) : (f32x4){0.f, 0.f, 0.f, 0.f};
#pragma unroll
        for (int ai = 0; ai < 2; ++ai)
#pragma unroll
            for (int m = 0; m < 4; ++m) { bf16_t* rowp = base + (size_t)(row0 + ai * HALF + m * 16) * ldc + col0;
#pragma unroll
                for (int bj = 0; bj < 2; ++bj) { f32x4 v0 = acc[ai][bj][m][0] + bv[bj][0], v1 = acc[ai][bj][m][1] + bv[bj][1];
                    if (ACT == 1) { f32x2 a = gelu_pk((f32x2){v0[0], v0[1]}), b = gelu_pk((f32x2){v0[2], v0[3]}), c = gelu_pk((f32x2){v1[0], v1[1]}), d = gelu_pk((f32x2){v1[2], v1[3]});
                        v0 = (f32x4){a.x, a.y, b.x, b.y}; v1 = (f32x4){c.x, c.y, d.x, d.y}; }
                    v0 = v0 * sc; v1 = v1 * sc; u32x4 w; w.x = cvt_pk_bf16(v0[0], v0[1]); w.y = cvt_pk_bf16(v0[2], v0[3]); w.z = cvt_pk_bf16(v1[0], v1[1]); w.w = cvt_pk_bf16(v1[2], v1[3]);
                    *(u32x4*)(rowp + bj * HALF) = w; } }
    }
};

struct PanelStats {
    unsigned* xbuf;
    unsigned* cnt;
    unsigned* tmo;
    int ntn; float eps;
    unsigned code;
    __device__ __forceinline__ bool run(const f32x4 (&v)[2][2][4][2], const Unit& u, int wr, int wc, int fr, int fq, PG8_LAS unsigned char* lds, int wid, int lane) const {
        typedef float f32x2v __attribute__((ext_vector_type(2)));
        PG8_LAS f32x2v* P = (PG8_LAS f32x2v*)lds;
        PG8_LAS f32x2v* S = (PG8_LAS f32x2v*)(lds + 8192);
        PG8_LAS unsigned* flag = (PG8_LAS unsigned*)(lds + 8192 + 2048);
#pragma unroll
        for (int ai = 0; ai < 2; ++ai)
#pragma unroll
            for (int m = 0; m < 4; ++m) {
                float s = 0.f;
#pragma unroll
                for (int bj = 0; bj < 2; ++bj)
#pragma unroll
                    for (int n = 0; n < 2; ++n) { const f32x4 x = v[ai][bj][m][n]; s += (x[0] + x[1]) + (x[2] + x[3]); }
                s += __shfl_xor(s, 16); s += __shfl_xor(s, 32);
                const float mw = s * (1.0f / 64.0f); float q = 0.f;
#pragma unroll
                for (int bj = 0; bj < 2; ++bj)
#pragma unroll
                    for (int n = 0; n < 2; ++n) { const f32x4 d = v[ai][bj][m][n] - mw; q += (d[0] * d[0] + d[1] * d[1]) + (d[2] * d[2] + d[3] * d[3]); }
                q += __shfl_xor(q, 16); q += __shfl_xor(q, 32);
                if (fq == 0) P[(ai * HALF + wr * 64 + m * 16 + fr) * 4 + wc] = (f32x2v){mw, q};
            }
        asm volatile("s_waitcnt lgkmcnt(0)" ::: "memory"); __builtin_amdgcn_s_barrier(); asm volatile("" ::: "memory");
#if defined(BROKEN_EXCHANGE_NO_WAIT)
#warning BROKEN CONTROL BUILD: the row-statistics exchange does not wait; results are wrong by design
        if (blockIdx.x >= 64) { const long long t0_ = clock64(); while (clock64() - t0_ < 60000) __builtin_amdgcn_s_sleep(8); }
#endif
        const int row = wid * 32 + (lane & 31);
        if (lane < 32) {
            const f32x2v a = P[row * 4 + 0], b = P[row * 4 + 1], c = P[row * 4 + 2], d = P[row * 4 + 3];
            const float mt = (a.x + b.x + c.x + d.x) * 0.25f;
            const float da = a.x - mt, db = b.x - mt, dc = c.x - mt, dd = d.x - mt;
            const float m2 = (a.y + b.y) + (c.y + d.y) + 64.0f * ((da * da + db * db) + (dc * dc + dd * dd));
            unsigned long long* slot = (unsigned long long*)xbuf + ((size_t)(u.pm * BM + row) * 4 + u.pn);
            __hip_atomic_store(slot, ((unsigned long long)__float_as_uint(m2) << 32) | __float_as_uint(mt), __ATOMIC_RELAXED, __HIP_MEMORY_SCOPE_AGENT);
        }
        asm volatile("s_waitcnt vmcnt(0)" ::: "memory");
        if (lane == 0) __hip_atomic_fetch_add(cnt + 64 * u.pm, 1u, __ATOMIC_RELAXED, __HIP_MEMORY_SCOPE_AGENT);
        if (wid == 0) {
            bool dead = false; const unsigned long long t0 = __builtin_amdgcn_s_memrealtime(); const unsigned want = 8u * (unsigned)ntn;
            for (;;) {
#if defined(BROKEN_EXCHANGE_NO_WAIT)
                break;
#endif
                if ((unsigned)__builtin_amdgcn_readfirstlane(__hip_atomic_load(cnt + 64 * u.pm, __ATOMIC_RELAXED, __HIP_MEMORY_SCOPE_AGENT)) >= want) break;
                if (__builtin_amdgcn_s_memrealtime() - t0 > 2000000ull) {
                    if (lane == 0) { unsigned expect = 0u; __hip_atomic_compare_exchange_strong(tmo + 1, &expect, code | (unsigned)(u.pm & 0xff), __ATOMIC_RELAXED, __ATOMIC_RELAXED, __HIP_MEMORY_SCOPE_AGENT);
                                     __hip_atomic_store(tmo, 1u, __ATOMIC_RELAXED, __HIP_MEMORY_SCOPE_AGENT); }
                    dead = true; break; }
                __builtin_amdgcn_s_sleep(2);
            }
            __builtin_amdgcn_fence(__ATOMIC_ACQUIRE, "agent");
            if (lane == 0) flag[0] = dead ? 1u : 0u;
        }
        asm volatile("s_waitcnt vmcnt(0) lgkmcnt(0)" ::: "memory"); __builtin_amdgcn_s_barrier(); asm volatile("" ::: "memory");
        const bool bad = flag[0] != 0u;
        if (lane < 32) {
            const unsigned long long* slot = (const unsigned long long*)xbuf + (size_t)(u.pm * BM + row) * 4; float mt[4], m2[4]; float ms = 0.f;
#pragma unroll
            for (int t = 0; t < 4; ++t) { if (t < ntn) { const unsigned long long w = __hip_atomic_load(slot + t, __ATOMIC_RELAXED, __HIP_MEMORY_SCOPE_AGENT); mt[t] = __uint_as_float((unsigned)w); m2[t] = __uint_as_float((unsigned)(w >> 32)); } else { mt[t] = 0.f; m2[t] = 0.f; } ms += mt[t]; }
            const float mean = ms / (float)ntn; float q = 0.f;
#pragma unroll
            for (int t = 0; t < 4; ++t) if (t < ntn) { const float dm = mt[t] - mean; q += m2[t] + 256.0f * dm * dm; }
            S[row] = (f32x2v){mean, 1.0f / sqrtf(q / (256.0f * (float)ntn) + eps)};
        }
        asm volatile("s_waitcnt lgkmcnt(0)" ::: "memory"); __builtin_amdgcn_s_barrier(); asm volatile("" ::: "memory");
        return bad;
    }
};
struct EpiLnRes {
    static constexpr bool PERM = false, AFTER_DRAIN = true;
    const float* base; float* out; int ldc; const float* bias; PanelStats st; unsigned poison;
    __device__ __forceinline__ void fused(f32x4 (&acc)[2][2][4][2], const Unit& u, int wr, int wc, int fr, int fq, PG8_LAS unsigned char* lds, int wid, int lane) const {
        typedef float f32x2v __attribute__((ext_vector_type(2)));
        const PG8_LAS f32x2v* S = (const PG8_LAS f32x2v*)(lds + 8192);
        const int col0 = u.pn * BM + wc * 32 + 4 * fq;
#pragma unroll
        for (int bj = 0; bj < 2; ++bj)
#pragma unroll
            for (int n = 0; n < 2; ++n) { const f32x4 bv = bias ? *(const f32x4*)(bias + col0 + bj * HALF + n * 16) : (f32x4){0.f, 0.f, 0.f, 0.f};
#pragma unroll
                for (int ai = 0; ai < 2; ++ai)
#pragma unroll
                    for (int m = 0; m < 4; ++m) acc[ai][bj][m][n] += bv; }
        f32x4 pre[4][2][2];
#pragma unroll
        for (int m = 0; m < 4; ++m) { const size_t off = (size_t)(u.pm * BM + wr * 64 + m * 16 + fr) * ldc + col0;
#pragma unroll
            for (int bj = 0; bj < 2; ++bj)
#pragma unroll
                for (int n = 0; n < 2; ++n) pre[m][bj][n] = *(const f32x4*)(base + off + bj * HALF + n * 16); }
        const bool bad = st.run(acc, u, wr, wc, fr, fq, lds, wid, lane) || poison != 0u;
        const float qnan = __builtin_nanf("");
#pragma unroll
        for (int ai = 0; ai < 2; ++ai)
#pragma unroll
            for (int m = 0; m < 4; ++m) { const int r = ai * HALF + wr * 64 + m * 16 + fr; const f32x2v sr = S[r]; const size_t off = (size_t)(u.pm * BM + r) * ldc + col0;
#pragma unroll
                for (int bj = 0; bj < 2; ++bj)
#pragma unroll
                    for (int n = 0; n < 2; ++n) { const f32x4 bs = ai == 0 ? pre[m][bj][n] : *(const f32x4*)(base + off + bj * HALF + n * 16); f32x4 o = bs + (acc[ai][bj][m][n] - sr.x) * sr.y;
                        if (bad) o = (f32x4){qnan, qnan, qnan, qnan}; *(f32x4*)(out + off + bj * HALF + n * 16) = o; }
                if (m & 1) asm volatile("" ::: "memory"); }
    }
};
struct EpiLnResLn {
    static constexpr bool PERM = false, AFTER_DRAIN = true;
    const float* base; float* out; bf16_t* xn; int ldc; const float* bias; PanelStats st1, st2; unsigned poison;
    __device__ __forceinline__ void fused(f32x4 (&acc)[2][2][4][2], const Unit& u, int wr, int wc, int fr, int fq, PG8_LAS unsigned char* lds, int wid, int lane) const {
        typedef float f32x2v __attribute__((ext_vector_type(2))); typedef unsigned u32x2v __attribute__((ext_vector_type(2)));
        const PG8_LAS f32x2v* S = (const PG8_LAS f32x2v*)(lds + 8192);
        const int col0 = u.pn * BM + wc * 32 + 4 * fq;
#pragma unroll
        for (int bj = 0; bj < 2; ++bj)
#pragma unroll
            for (int n = 0; n < 2; ++n) { const f32x4 bv = bias ? *(const f32x4*)(bias + col0 + bj * HALF + n * 16) : (f32x4){0.f, 0.f, 0.f, 0.f};
#pragma unroll
                for (int ai = 0; ai < 2; ++ai)
#pragma unroll
                    for (int m = 0; m < 4; ++m) acc[ai][bj][m][n] += bv; }
        bool bad = st1.run(acc, u, wr, wc, fr, fq, lds, wid, lane) || poison != 0u;
        const float qnan = __builtin_nanf("");
#pragma unroll
        for (int ai = 0; ai < 2; ++ai)
#pragma unroll
            for (int m = 0; m < 4; ++m) { const int r = ai * HALF + wr * 64 + m * 16 + fr; const f32x2v sr = S[r]; const size_t off = (size_t)(u.pm * BM + r) * ldc + col0;
#pragma unroll
                for (int bj = 0; bj < 2; ++bj)
#pragma unroll
                    for (int n = 0; n < 2; ++n) { const f32x4 bs = *(const f32x4*)(base + off + bj * HALF + n * 16); acc[ai][bj][m][n] = bs + (acc[ai][bj][m][n] - sr.x) * sr.y; }
                asm volatile("" : "+v"(acc[ai][0][m][0]), "+v"(acc[ai][0][m][1]), "+v"(acc[ai][1][m][0]), "+v"(acc[ai][1][m][1]));
                if (m & 1) asm volatile("" ::: "memory"); }
        const bool bad1 = bad;
        bad = st2.run(acc, u, wr, wc, fr, fq, lds, wid, lane) || bad;
#pragma unroll
        for (int ai = 0; ai < 2; ++ai)
#pragma unroll
            for (int m = 0; m < 4; ++m) { const int r = ai * HALF + wr * 64 + m * 16 + fr; const f32x2v sr = S[r]; const size_t off = (size_t)(u.pm * BM + r) * ldc + col0;
#pragma unroll
                for (int bj = 0; bj < 2; ++bj)
#pragma unroll
                    for (int n = 0; n < 2; ++n) { const f32x4 x1 = acc[ai][bj][m][n]; *(f32x4*)(out + off + bj * HALF + n * 16) = bad1 ? (f32x4){qnan, qnan, qnan, qnan} : x1;
                        const f32x4 o = (x1 - sr.x) * sr.y; u32x2v w; w.x = cvt_pk_bf16(o[0], o[1]); w.y = cvt_pk_bf16(o[2], o[3]);
                        if (bad) { w.x = 0x7fc07fc0u; w.y = 0x7fc07fc0u; } *(u32x2v*)(xn + off + bj * HALF + n * 16) = w; }
                asm volatile("" ::: "memory"); }
    }
};

template <class Epi, class Sched, bool ALIGN_EPI = false, bool SP2 = false>
__device__ __forceinline__ void gemm_phase(PG8_LAS unsigned char* lds, const Gemm g, const Sched& S, const Epi& E, int tid_in) {
    int tid_l = tid_in; asm volatile("" : "+v"(tid_l));
    const int tid = tid_l, wid = __builtin_amdgcn_readfirstlane(tid >> 6), lane = tid & 63, wr = wid >> 2, wc = wid & 3, fr = lane & 15, fq = lane >> 4;
    int K_l = g.K; asm volatile("" : "+s"(K_l));
    const int K = K_l, nt = K / BK;
    unsigned voffA[2], voffB[2];
#pragma unroll
    for (int i = 0; i < 2; ++i) { int R, C; stage_rc(tid * 16 + i * 8192, R, C); const int Rb = Epi::PERM ? ((R & ~31) + perm32(R & 31)) : R;
        voffA[i] = (unsigned)(R * K + C) * 2u; voffB[i] = (unsigned)(Rb * K + C) * 2u; }
    const size_t kstep = (size_t)(BK * 2);
    const size_t hstep = (size_t)HALF * K * 2;
    const size_t tstep = 2 * hstep;
    const unsigned ldsw = (unsigned)wid * 1024u;
    const int aoff = lds_byte(wr * 64 + fr, fq * 8), boff = lds_byte(wc * 32 + fr, fq * 8);
#define PG8_SA(b, h) (((b) * 2 + (h)) * HTB)
#define PG8_SB(b, h) ((4 + (b) * 2 + (h)) * HTB)
#define PG8_STAGE(bufoff, gbase, voff) do { _Pragma("unroll") for (int _i = 0; _i < 2; ++_i) \
        __builtin_amdgcn_global_load_lds((const unsigned*)((const char*)(gbase) + (voff)[_i]), (PG8_LAS unsigned*)(lds + (bufoff) + ldsw + _i * 8192), 16, 0, PG8_AUX); } while (0)
#define PG8_LDA(dst, b, h) do { _Pragma("unroll") for (int m = 0; m < 4; ++m) _Pragma("unroll") for (int k = 0; k < 2; ++k) dst[m][k] = *(const PG8_LAS bf16x8*)(lds + PG8_SA(b, h) + aoff + m * 2048 + k * 1024); } while (0)
#define PG8_LDB(dst, b, h) do { _Pragma("unroll") for (int n = 0; n < 2; ++n) _Pragma("unroll") for (int k = 0; k < 2; ++k) dst[n][k] = *(const PG8_LAS bf16x8*)(lds + PG8_SB(b, h) + boff + n * 2048 + k * 1024); } while (0)
#define PG8_MMA(ai, bj, At, Bt) do { __builtin_amdgcn_s_setprio(1); _Pragma("unroll") for (int m = 0; m < 4; ++m) _Pragma("unroll") for (int n = 0; n < 2; ++n) _Pragma("unroll") for (int k = 0; k < 2; ++k) \
        acc[ai][bj][m][n] = __builtin_amdgcn_mfma_f32_16x16x32_bf16(Bt[n][k], At[m][k], acc[ai][bj][m][n], 0, 0, 0); __builtin_amdgcn_s_setprio(0); } while (0)
#define PG8_WAIT_V(n) asm volatile("s_waitcnt vmcnt(" #n ")" ::: "memory")
#define PG8_WAIT_L(n) asm volatile("s_waitcnt lgkmcnt(" #n ")" ::: "memory")
#define PG8_BAR __builtin_amdgcn_s_barrier()
#define PG8_SCHED __builtin_amdgcn_sched_barrier(0)
    Unit cur, nxt; int ui = 0;
    if (!S.next(0, cur)) return;
    f32x4 acc[2][2][4][2];
#pragma unroll
    for (int a = 0; a < 2; ++a)
#pragma unroll
        for (int b = 0; b < 2; ++b)
#pragma unroll
            for (int m = 0; m < 4; ++m)
#pragma unroll
                for (int n = 0; n < 2; ++n) acc[a][b][m][n] = (f32x4){0.f, 0.f, 0.f, 0.f};
    bf16x8 At[4][2], B0[2][2], B1[2][2];
    const char* cA = (const char*)g.A + (size_t)cur.pm * tstep; const char* cB = (const char*)g.Bt + (size_t)cur.pn * tstep;
    S.a_ready(cur);
    if constexpr (SP2) {
        PG8_STAGE(PG8_SB(0, 0), cB, voffB); PG8_STAGE(PG8_SB(0, 1), cB + hstep, voffB); PG8_STAGE(PG8_SA(0, 0), cA, voffA); PG8_STAGE(PG8_SA(0, 1), cA + hstep, voffA);
        if (wr == 1) PG8_BAR;
        PG8_WAIT_V(2); PG8_BAR;
        PG8_STAGE(PG8_SB(1, 0), cB + kstep, voffB); PG8_STAGE(PG8_SA(1, 0), cA + kstep, voffA); PG8_STAGE(PG8_SB(1, 1), cB + hstep + kstep, voffB);
        PG8_WAIT_V(6); PG8_BAR;
    } else {
        PG8_STAGE(PG8_SB(0, 0), cB, voffB); PG8_STAGE(PG8_SA(0, 0), cA, voffA); PG8_STAGE(PG8_SB(0, 1), cB + hstep, voffB); PG8_STAGE(PG8_SA(0, 1), cA + hstep, voffA);
        if (wr == 1) PG8_BAR;
        PG8_WAIT_V(4); PG8_BAR;
        PG8_STAGE(PG8_SB(1, 0), cB + kstep, voffB); PG8_STAGE(PG8_SA(1, 0), cA + kstep, voffA); PG8_STAGE(PG8_SB(1, 1), cB + hstep + kstep, voffB);
        PG8_WAIT_V(6); PG8_BAR;
    }
    for (;;) {
        const bool has_next = S.next(ui + 1, nxt);
        const char* nA = has_next ? (const char*)g.A + (size_t)nxt.pm * tstep : cA; const char* nB = has_next ? (const char*)g.Bt + (size_t)nxt.pn * tstep : cB;
        for (int t = 0; t < nt; t += 2) {
            const bool last = (t == nt - 2);
            const char* a1 = cA + (size_t)(t + 1) * kstep;
            const char* a2 = last ? nA : cA + (size_t)(t + 2) * kstep; const char* b2 = last ? nB : cB + (size_t)(t + 2) * kstep;
            const char* a3 = a2 + kstep; const char* b3 = b2 + kstep;
            if (last && has_next) S.a_ready(nxt);
            if constexpr (SP2) {
            PG8_LDB(B0, 0, 0); PG8_LDB(B1, 0, 1); PG8_SCHED; PG8_LDA(At, 0, 0); PG8_STAGE(PG8_SA(1, 1), a1 + hstep, voffA);
            PG8_WAIT_V(8); PG8_WAIT_L(0); PG8_BAR; PG8_MMA(0, 0, At, B0); PG8_MMA(0, 1, At, B1); PG8_BAR; PG8_SCHED;
            PG8_LDA(At, 0, 1); PG8_STAGE(PG8_SB(0, 0), b2, voffB); PG8_STAGE(PG8_SB(0, 1), b2 + hstep, voffB); PG8_STAGE(PG8_SA(0, 0), a2, voffA);
            PG8_WAIT_V(8); PG8_WAIT_L(0); PG8_BAR; PG8_MMA(1, 0, At, B0); PG8_MMA(1, 1, At, B1); PG8_BAR; PG8_SCHED;
            PG8_LDB(B0, 1, 0); PG8_LDB(B1, 1, 1); PG8_SCHED; PG8_LDA(At, 1, 0); PG8_STAGE(PG8_SA(0, 1), a2 + hstep, voffA);
            PG8_WAIT_V(8); PG8_WAIT_L(0); PG8_BAR; PG8_MMA(0, 0, At, B0); PG8_MMA(0, 1, At, B1); PG8_BAR; PG8_SCHED;
            PG8_LDA(At, 1, 1); PG8_STAGE(PG8_SB(1, 0), b3, voffB); PG8_STAGE(PG8_SB(1, 1), b3 + hstep, voffB); PG8_STAGE(PG8_SA(1, 0), a3, voffA);
            PG8_WAIT_V(8); PG8_WAIT_L(0); PG8_BAR; PG8_MMA(1, 0, At, B0); PG8_MMA(1, 1, At, B1); PG8_BAR; PG8_SCHED;
            } else {
            PG8_LDB(B0, 0, 0); PG8_SCHED; PG8_LDA(At, 0, 0); PG8_STAGE(PG8_SA(1, 1), a1 + hstep, voffA);
            PG8_WAIT_L(8); PG8_BAR; PG8_WAIT_L(0); PG8_MMA(0, 0, At, B0); PG8_BAR; PG8_SCHED;
            PG8_LDB(B1, 0, 1); PG8_STAGE(PG8_SB(0, 0), b2, voffB);
            PG8_BAR; PG8_WAIT_L(0); PG8_MMA(0, 1, At, B1); PG8_BAR;
            PG8_LDA(At, 0, 1); PG8_STAGE(PG8_SA(0, 0), a2, voffA);
            PG8_BAR; PG8_WAIT_L(0); PG8_MMA(1, 0, At, B0); PG8_BAR; PG8_SCHED;
            PG8_STAGE(PG8_SB(0, 1), b2 + hstep, voffB);
            PG8_WAIT_V(6); PG8_BAR; PG8_MMA(1, 1, At, B1); PG8_BAR;
            PG8_LDB(B0, 1, 0); PG8_SCHED; PG8_LDA(At, 1, 0); PG8_STAGE(PG8_SA(0, 1), a2 + hstep, voffA);
            PG8_WAIT_L(8); PG8_BAR; PG8_WAIT_L(0); PG8_MMA(0, 0, At, B0); PG8_BAR; PG8_SCHED;
            PG8_LDB(B1, 1, 1); PG8_STAGE(PG8_SB(1, 0), b3, voffB);
            PG8_BAR; PG8_WAIT_L(0); PG8_MMA(0, 1, At, B1); PG8_BAR;
            PG8_LDA(At, 1, 1); PG8_STAGE(PG8_SA(1, 0), a3, voffA);
            PG8_BAR; PG8_WAIT_L(0); PG8_MMA(1, 0, At, B0); PG8_BAR; PG8_SCHED;
            PG8_STAGE(PG8_SB(1, 1), b3 + hstep, voffB);
            PG8_WAIT_V(6); PG8_BAR; PG8_MMA(1, 1, At, B1); PG8_BAR;
            }
        }
        if constexpr (ALIGN_EPI) { if (wr == 0) PG8_BAR; }
        if constexpr (!Epi::AFTER_DRAIN) { E(acc, cur, wr, wc, fr, fq); S.done(cur); }
        if (!has_next) break;
#pragma unroll
        for (int a = 0; a < 2; ++a)
#pragma unroll
            for (int b = 0; b < 2; ++b)
#pragma unroll
                for (int m = 0; m < 4; ++m)
#pragma unroll
                    for (int n = 0; n < 2; ++n) acc[a][b][m][n] = (f32x4){0.f, 0.f, 0.f, 0.f};
        cur = nxt; cA = nA; cB = nB; ++ui;
        if constexpr (ALIGN_EPI) { if (wr == 1) PG8_BAR; }
    }
    PG8_WAIT_V(0);
    if constexpr (!ALIGN_EPI) { if (wr == 0) PG8_BAR; }
    PG8_BAR;
    if constexpr (Epi::AFTER_DRAIN) { E.fused(acc, cur, wr, wc, fr, fq, lds, wid, lane); S.done(cur); }
#undef PG8_SA
#undef PG8_SB
#undef PG8_STAGE
#undef PG8_LDA
#undef PG8_LDB
#undef PG8_MMA
#undef PG8_WAIT_V
#undef PG8_WAIT_L
#undef PG8_BAR
#undef PG8_SCHED
}
}

typedef unsigned short bf16;
typedef float f32x4 __attribute__((ext_vector_type(4)));
typedef unsigned u32x4 __attribute__((ext_vector_type(4)));
typedef unsigned u32x2 __attribute__((ext_vector_type(2)));

constexpr int BATCH = 8, SEQ = 4096, T = BATCH * SEQ, D = 1024, DEPTH = 2;
constexpr int NA = 2048, NB = 3328, NIN = NA + NB, INW = 5204;
constexpr int DFF = 2816, NGU = 2 * DFF, PLE = 256, MIXW = 2048;
constexpr int A_Q = 0, A_BG = 512, A_Z = 1024;
constexpr int B_CKV = 0, B_IQ = 256, B_CG = 512, B_HB = 1024, B_XBC = 1536, B_IK = 3072, B_DT = 3136, B_IW = 3152;
constexpr int XBC = 1536, KV_R = 256, TOPK = 256;
constexpr float EPS = 1e-6f;

constexpr size_t MiB = 1u << 20;
constexpr size_t WS_CTL = 0;
constexpr size_t WS_RSTD = 1 * MiB;
constexpr size_t WS_RSTD2 = 1 * MiB + 256 * 1024;
constexpr size_t WS_DT = 2 * MiB;
constexpr size_t WS_W = 8 * MiB;
constexpr size_t WS_W_IN = WS_W, WS_W_OUT = WS_W_IN + (size_t)NIN * D * 2, WS_W_GU = WS_W_OUT + (size_t)D * MIXW * 2, WS_W_DOWN = WS_W_GU + (size_t)NGU * D * 2,
                 WS_W_PG = WS_W_DOWN + (size_t)D * DFF * 2, WS_W_PP = WS_W_PG + (size_t)D * D * 2, WS_W_END = WS_W_PP + (size_t)D * PLE * 2;
constexpr size_t WS_WUK = 42 * MiB, WS_WUV = 43 * MiB;
static_assert(WS_W_END <= 42 * MiB, "weights");
constexpr size_t WS_X0 = 44 * MiB, WS_X1 = 108 * MiB, WS_RA = 172 * MiB, WS_RB = 300 * MiB, WS_DT2 = 508 * MiB, WS_END = 512 * MiB;
constexpr size_t WS_XA = WS_X0;
constexpr size_t WS_IDX = WS_X1 + 48 * MiB;
constexpr size_t WS_CKVC = WS_X1 + 32 * MiB;
constexpr size_t WS_IKC = 4 * MiB;

__host__ __device__ __forceinline__ float bf2f(bf16 b) { return __builtin_bit_cast(float, ((unsigned)b) << 16); }
__host__ __device__ __forceinline__ bf16 f2bf(float f) { unsigned u = __builtin_bit_cast(unsigned, f); return (bf16)((u + 0x7fffu + ((u >> 16) & 1u)) >> 16); }
__device__ __forceinline__ unsigned pk2(float lo, float hi) { return (unsigned)f2bf(lo) | ((unsigned)f2bf(hi) << 16); }
__device__ __forceinline__ float wave_sum(float v) {
#pragma unroll
    for (int o = 1; o < 64; o <<= 1) v += __shfl_xor(v, o);
    return v;
}
__device__ __forceinline__ float wave_max(float v) {
#pragma unroll
    for (int o = 1; o < 64; o <<= 1) v = fmaxf(v, __shfl_xor(v, o));
    return v;
}
__device__ __forceinline__ float sigmoidf_(float v) { return __builtin_amdgcn_rcpf(1.0f + __expf(-v)); }
__device__ __forceinline__ float siluf_(float v) { return v * sigmoidf_(v); }

__host__ __device__ __forceinline__ int src_col_in(int n) {
    if (n < 512) return n;
    if (n < 1024) return 1092 + (n - 512);
    if (n < 2048) return 2628 + (n - 1024);
    n -= 2048;
    if (n < 256) return 512 + n;
    if (n < 512) return 768 + (n - 256);
    if (n < 1024) return 1604 + (n - 512);
    if (n < 1536) return 2116 + (n - 1024);
    if (n < 3072) return 3652 + (n - 1536);
    if (n < 3136) return 1024 + (n - 3072);
    if (n < 3152) return 5188 + (n - 3136);
    if (n < 3156) return 1088 + (n - 3152);
    return -1;
}

__host__ __device__ __forceinline__ int t5_bucket(int rel) {
    const int ret = rel > 0 ? 16 : 0; const int n = rel < 0 ? -rel : rel;
    int b;
    if (n < 8) b = n; else if (n < 15) b = 8; else if (n < 27) b = 9; else if (n < 50) b = 10; else if (n < 91) b = 11; else if (n < 166) b = 12; else if (n < 305) b = 13; else if (n < 559) b = 14; else b = 15;
    return ret + b;
}

template <int MODE> __global__ void __launch_bounds__(256) k_prep_w(const float* __restrict__ W, const float* __restrict__ W2, int K, int Nsrc, const float* __restrict__ gain, bf16* __restrict__ Wt) {
    __shared__ float tile[32][33];
    const int n0 = blockIdx.x * 32, k0 = blockIdx.y * 32, tx = threadIdx.x & 31, ty = threadIdx.x >> 5;
    const int n = n0 + tx; int src; const float* Ws = W;
    if (MODE == 0) src = n; else if (MODE == 1) src = src_col_in(n); else { const int which = (n & 255) >> 7; src = (n >> 8) * 128 + (n & 127); Ws = which ? W2 : W; }
    for (int kk = ty; kk < 32; kk += 8) { float v = 0.f; if (src >= 0) { v = Ws[(size_t)(k0 + kk) * Nsrc + src]; if (gain) v *= gain[k0 + kk]; } tile[kk][tx] = v; }
    __syncthreads();
    for (int nn = ty; nn < 32; nn += 8) Wt[(size_t)(n0 + nn) * K + k0 + tx] = f2bf(tile[tx][nn]);
}

__global__ void __launch_bounds__(256) k_x_prep(const float* __restrict__ x, bf16* __restrict__ xb, float* __restrict__ rstd) {
    const int lane = threadIdx.x & 63, row = blockIdx.x * 4 + (threadIdx.x >> 6);
    const f32x4* xr = (const f32x4*)(x + (size_t)row * D) + lane; float ss = 0.f; f32x4 v[4];
#pragma unroll
    for (int j = 0; j < 4; ++j) { v[j] = xr[64 * j]; ss += (v[j].x * v[j].x + v[j].y * v[j].y) + (v[j].z * v[j].z + v[j].w * v[j].w); }
    ss = wave_sum(ss);
    u32x2* o = (u32x2*)(xb + (size_t)row * D) + lane;
#pragma unroll
    for (int j = 0; j < 4; ++j) { u32x2 w; w.x = pk2(v[j].x, v[j].y); w.y = pk2(v[j].z, v[j].w); o[64 * j] = w; }
    if (lane == 0) rstd[row] = 1.0f / sqrtf(ss * (1.0f / D) + EPS);
}
__global__ void __launch_bounds__(256) k_rstd(const float* __restrict__ x, float* __restrict__ rstd) {
    const int lane = threadIdx.x & 63, row = blockIdx.x * 4 + (threadIdx.x >> 6);
    const f32x4* xr = (const f32x4*)(x + (size_t)row * D) + lane; float ss = 0.f;
#pragma unroll
    for (int j = 0; j < 4; ++j) { const f32x4 v = xr[64 * j]; ss += (v.x * v.x + v.y * v.y) + (v.z * v.z + v.w * v.w); }
    ss = wave_sum(ss);
    if (lane == 0) rstd[row] = 1.0f / sqrtf(ss * (1.0f / D) + EPS);
}
__global__ void __launch_bounds__(256) k_resid_norm(const float* xin, const float* __restrict__ y, const float* __restrict__ g, float* xo, bf16* __restrict__ xb,
                                                    float* __restrict__ rstd_out, const float* __restrict__ p, bf16* __restrict__ pb) {
    const int lane = threadIdx.x & 63, row = blockIdx.x * 4 + (threadIdx.x >> 6);
    const f32x4* yr = (const f32x4*)(y + (size_t)row * D) + lane; const f32x4* xr = (const f32x4*)(xin + (size_t)row * D) + lane; const f32x4* gr = (const f32x4*)g + lane;
    f32x4 v[4]; float ss = 0.f;
#pragma unroll
    for (int j = 0; j < 4; ++j) { v[j] = yr[64 * j]; ss += (v[j].x * v[j].x + v[j].y * v[j].y) + (v[j].z * v[j].z + v[j].w * v[j].w); }
    const float r = 1.0f / sqrtf(wave_sum(ss) * (1.0f / D) + EPS);
    float s2 = 0.f;
    f32x4* xor_ = (f32x4*)(xo + (size_t)row * D) + lane; u32x2* o = (u32x2*)(xb + (size_t)row * D) + lane;
#pragma unroll
    for (int j = 0; j < 4; ++j) { const f32x4 xx = xr[64 * j], gg = gr[64 * j]; f32x4 w = xx + v[j] * r * gg; xor_[64 * j] = w; s2 += (w.x * w.x + w.y * w.y) + (w.z * w.z + w.w * w.w);
        u32x2 q; q.x = pk2(w.x, w.y); q.y = pk2(w.z, w.w); o[64 * j] = q; }
    if (rstd_out) { s2 = wave_sum(s2); if (lane == 0) rstd_out[row] = 1.0f / sqrtf(s2 * (1.0f / D) + EPS); }
    if (p) { const f32x4 pv = *((const f32x4*)(p + (size_t)row * PLE) + lane); u32x2 q; q.x = pk2(pv.x, pv.y); q.y = pk2(pv.z, pv.w); *((u32x2*)(pb + (size_t)row * PLE) + lane) = q; }
}

namespace pg8 {
#ifndef PROJ_ST_MODE
#define PROJ_ST_MODE 0
#endif
struct EpiProj {
    static constexpr bool PERM = true, AFTER_DRAIN = false; static constexpr int NST = 16;
    bf16_t* RA; bf16_t* RB; const float* rstd;
    __device__ __forceinline__ void operator()(const f32x4 (&acc)[2][2][4][2], const Unit& u, int wr, int wc, int fr, int fq) const {
        const int row0 = u.pm * BM + wr * 64 + fr; bf16_t* base; int ld, colt;
        if (u.pn < NA / 256) { base = RA; ld = NA; colt = u.pn * BM; } else { base = RB; ld = NB; colt = (u.pn - NA / 256) * BM; }
        const int col0 = colt + wc * 32 + 8 * fq;
        float sr[2][4];
#pragma unroll
        for (int ai = 0; ai < 2; ++ai)
#pragma unroll
            for (int m = 0; m < 4; ++m) sr[ai][m] = rstd[row0 + ai * HALF + m * 16];
#pragma unroll
        for (int ai = 0; ai < 2; ++ai)
#pragma unroll
            for (int m = 0; m < 4; ++m) { const int r = row0 + ai * HALF + m * 16; const float s = sr[ai][m]; bf16_t* rowp = base + (size_t)r * ld + col0;
#pragma unroll
                for (int bj = 0; bj < 2; ++bj) { const f32x4 v0 = acc[ai][bj][m][0] * s, v1 = acc[ai][bj][m][1] * s;
                    u32x4 w; w.x = cvt_pk_bf16(v0[0], v0[1]); w.y = cvt_pk_bf16(v0[2], v0[3]); w.z = cvt_pk_bf16(v1[0], v1[1]); w.w = cvt_pk_bf16(v1[2], v1[3]);
                    { u32x4* sp_ = (u32x4*)(rowp + bj * HALF);
#if PROJ_ST_MODE == 1
                      asm volatile("global_store_dwordx4 %0, %1, off sc1\n\ts_nop 1" :: "v"(sp_), "v"(w) : "memory");
#elif PROJ_ST_MODE == 2
                      asm volatile("global_store_dwordx4 %0, %1, off sc0 sc1\n\ts_nop 1" :: "v"(sp_), "v"(w) : "memory");
#else
                      *sp_ = w;
#endif
                    } } }
    }
};
struct EpiF32 {
    static constexpr bool PERM = false, AFTER_DRAIN = false; static constexpr int NST = 0;
    float* C; long ldc;
    __device__ __forceinline__ void operator()(const f32x4 (&acc)[2][2][4][2], const Unit& u, int wr, int wc, int fr, int fq) const {
        const int row0 = u.pm * BM + wr * 64 + fr, col0 = u.pn * BM + wc * 32 + 4 * fq;
#pragma unroll
        for (int ai = 0; ai < 2; ++ai)
#pragma unroll
            for (int m = 0; m < 4; ++m) { float* rowp = C + (size_t)(row0 + ai * HALF + m * 16) * ldc + col0;
#pragma unroll
                for (int bj = 0; bj < 2; ++bj)
#pragma unroll
                    for (int n = 0; n < 2; ++n) *(f32x4*)(rowp + bj * HALF + n * 16) = acc[ai][bj][m][n]; }
    }
};
struct EpiBf16P {
    static constexpr bool PERM = true, AFTER_DRAIN = false; static constexpr int NST = 0;
    bf16_t* O; long ldc;
    __device__ __forceinline__ void operator()(const f32x4 (&acc)[2][2][4][2], const Unit& u, int wr, int wc, int fr, int fq) const {
        const int row0 = u.pm * BM + wr * 64 + fr, col0 = u.pn * BM + wc * 32 + 8 * fq;
#pragma unroll
        for (int ai = 0; ai < 2; ++ai)
#pragma unroll
            for (int m = 0; m < 4; ++m) { bf16_t* rowp = O + (size_t)(row0 + ai * HALF + m * 16) * ldc + col0;
#pragma unroll
                for (int bj = 0; bj < 2; ++bj) { const f32x4 v0 = acc[ai][bj][m][0], v1 = acc[ai][bj][m][1];
                    u32x4 w; w.x = cvt_pk_bf16(v0[0], v0[1]); w.y = cvt_pk_bf16(v0[2], v0[3]); w.z = cvt_pk_bf16(v1[0], v1[1]); w.w = cvt_pk_bf16(v1[2], v1[3]);
                    *(u32x4*)(rowp + bj * HALF) = w; } }
    }
};
struct EpiSwiGLU {
    static constexpr bool PERM = true, AFTER_DRAIN = false; static constexpr int NST = 0;
    bf16_t* G; const float* rstd;
    __device__ __forceinline__ void operator()(const f32x4 (&acc)[2][2][4][2], const Unit& u, int wr, int wc, int fr, int fq) const {
        const int row0 = u.pm * BM + wr * 64 + fr, col0 = u.pn * HALF + wc * 32 + 8 * fq;
        float sr[2][4];
#pragma unroll
        for (int ai = 0; ai < 2; ++ai)
#pragma unroll
            for (int m = 0; m < 4; ++m) sr[ai][m] = rstd[row0 + ai * HALF + m * 16];
#pragma unroll
        for (int ai = 0; ai < 2; ++ai)
#pragma unroll
            for (int m = 0; m < 4; ++m) { const int r = row0 + ai * HALF + m * 16; const float s = sr[ai][m]; float o[8];
#pragma unroll
                for (int n = 0; n < 2; ++n)
#pragma unroll
                    for (int j = 0; j < 4; ++j) { const float gt = acc[ai][0][m][n][j] * s, up = acc[ai][1][m][n][j] * s; o[n * 4 + j] = gt * __builtin_amdgcn_rcpf(1.0f + __expf(-gt)) * up; }
                u32x4 w; w.x = cvt_pk_bf16(o[0], o[1]); w.y = cvt_pk_bf16(o[2], o[3]); w.z = cvt_pk_bf16(o[4], o[5]); w.w = cvt_pk_bf16(o[6], o[7]);
                *(u32x4*)(G + (size_t)r * DFF + col0) = w; }
    }
};
struct EpiPle {
    static constexpr bool PERM = true, AFTER_DRAIN = false; static constexpr int NST = 0;
    const bf16_t* X; const bf16_t* Tt; bf16_t* XB; float* OUT;
    __device__ __forceinline__ void operator()(const f32x4 (&acc)[2][2][4][2], const Unit& u, int wr, int wc, int fr, int fq) const {
        const int row0 = u.pm * BM + wr * 64 + fr, col0 = u.pn * BM + wc * 32 + 8 * fq;
        u32x4 tv[2][2], xv[2][2];
#define PLE_LOAD(slot, grp) do { const size_t off_ = (size_t)(row0 + ((grp) >> 2) * HALF + ((grp) & 3) * 16) * D + col0; _Pragma("unroll") for (int bj_ = 0; bj_ < 2; ++bj_) { \
            tv[slot][bj_] = *(const u32x4*)(Tt + off_ + bj_ * HALF); xv[slot][bj_] = *(const u32x4*)(X + off_ + bj_ * HALF); } } while (0)
        PLE_LOAD(0, 0);
#pragma unroll
        for (int grp = 0; grp < 8; ++grp) { const int ai = grp >> 2, m = grp & 3, sl = grp & 1; const size_t off = (size_t)(row0 + ai * HALF + m * 16) * D + col0;
            if (grp + 1 < 8) PLE_LOAD((grp + 1) & 1, grp + 1);
#pragma unroll
            for (int bj = 0; bj < 2; ++bj) { const unsigned tw[4] = {tv[sl][bj].x, tv[sl][bj].y, tv[sl][bj].z, tv[sl][bj].w}, xw[4] = {xv[sl][bj].x, xv[sl][bj].y, xv[sl][bj].z, xv[sl][bj].w}; f32x4 x0, x1;
#pragma unroll
                for (int j = 0; j < 4; ++j) { const float t0 = __builtin_bit_cast(float, (j & 1) ? (tw[j >> 1] & 0xffff0000u) : (tw[j >> 1] << 16));
                    const float t1 = __builtin_bit_cast(float, (j & 1) ? (tw[2 + (j >> 1)] & 0xffff0000u) : (tw[2 + (j >> 1)] << 16));
                    const float a0 = __builtin_bit_cast(float, (j & 1) ? (xw[j >> 1] & 0xffff0000u) : (xw[j >> 1] << 16));
                    const float a1 = __builtin_bit_cast(float, (j & 1) ? (xw[2 + (j >> 1)] & 0xffff0000u) : (xw[2 + (j >> 1)] << 16));
                    x0[j] = a0 + __builtin_amdgcn_rcpf(1.0f + __expf(-acc[ai][bj][m][0][j])) * t0; x1[j] = a1 + __builtin_amdgcn_rcpf(1.0f + __expf(-acc[ai][bj][m][1][j])) * t1; }
                if (OUT) { *(f32x4*)(OUT + off + bj * HALF) = x0; *(f32x4*)(OUT + off + bj * HALF + 4) = x1; }
                else { u32x4 w; w.x = cvt_pk_bf16(x0[0], x0[1]); w.y = cvt_pk_bf16(x0[2], x0[3]); w.z = cvt_pk_bf16(x1[0], x1[1]); w.w = cvt_pk_bf16(x1[2], x1[3]);
                    *(u32x4*)(XB + off + bj * HALF) = w; } } }
#undef PLE_LOAD
    }
};
}

__device__ __forceinline__ unsigned ord_key(float f) { const unsigned u = __builtin_bit_cast(unsigned, f); return (u & 0x80000000u) ? ~u : (u | 0x80000000u); }
#ifndef XB_EARLY_WB
#define XB_EARLY_WB 0
#endif
#define LAS __attribute__((address_space(3)))
#define XB_TMO      128
#define XB_XCNT(j)  (256  + 64 * (j))
#define XB_XSUB(j)  (1280 + 64 * (j))
#define XB_XGEN(j)  (2304 + 64 * (j))
#define XB_TOP      3328
#define XB_TOPGEN   3392
#define XCD_BAR_WORDS 3456
#define XB_SPIN_CAP (1u << 18)

__device__ __forceinline__ unsigned xb_ld(unsigned* p)              { return __hip_atomic_load(p, __ATOMIC_RELAXED, __HIP_MEMORY_SCOPE_AGENT); }
__device__ __forceinline__ unsigned xb_add(unsigned* p, unsigned v) { return __hip_atomic_fetch_add(p, v, __ATOMIC_RELAXED, __HIP_MEMORY_SCOPE_AGENT); }
__device__ __forceinline__ unsigned xb_xcc_id() { return (unsigned)__builtin_amdgcn_s_getreg((3 << 11) | 20) & 0xFu; }
#define XB_SPIN(cond, bar) do { unsigned _sp = 0; while (cond) { __builtin_amdgcn_s_sleep(1); \
    if ((++_sp & 255u) == 0u) { if (xb_ld(&(bar)[XB_TMO])) break; if (_sp > XB_SPIN_CAP) { atomicAdd(&(bar)[XB_TMO], 1u); break; } } } } while (0)

struct XcdBarrier {
    unsigned* bar; unsigned x;
    volatile LAS unsigned* st;
};

__device__ __forceinline__ XcdBarrier xcd_barrier_post(unsigned* bar, volatile LAS unsigned* st) {
    XcdBarrier b; b.bar = bar; b.x = xb_xcc_id(); b.st = st;
    if (threadIdx.x == 0) (void)xb_add(&bar[XB_XCNT(b.x)], 1u);
    return b;
}
__device__ __forceinline__ void xcd_barrier_complete(unsigned* bar, unsigned x, unsigned& nloc, unsigned& nx) {
    const unsigned G = gridDim.x * gridDim.y * gridDim.z;
    unsigned sum, cnt, mine, sp = 0u;
    for (;;) {
        sum = 0u; cnt = 0u; mine = 0u;
#pragma unroll
        for (unsigned j = 0; j < 16; ++j) { const unsigned c = xb_ld(&bar[XB_XCNT(j)]); sum += c; cnt += (c > 0u) ? 1u : 0u; mine = (j == x) ? c : mine; }
        if (sum == G) break;
        __builtin_amdgcn_s_sleep(1);
        if ((++sp & 255u) == 0u) { if (xb_ld(&bar[XB_TMO])) break; if (sp > XB_SPIN_CAP) { atomicAdd(&bar[XB_TMO], 1u); break; } }
    }
    nloc = mine > 0u ? mine : 1u; nx = cnt > 0u ? cnt : 1u;
}

__device__ __forceinline__ void xcd_barrier(const XcdBarrier& b, int tid_in) {
    asm volatile("s_waitcnt vmcnt(0)" ::: "memory");
    __syncthreads();
    if (tid_in == 0) {
        unsigned* bar = b.bar;
        __builtin_amdgcn_s_waitcnt(0);
        unsigned nloc = b.st[0], nx = b.st[1];
        if (nloc == 0u) { xcd_barrier_complete(bar, b.x, nloc, nx); b.st[0] = nloc; b.st[1] = nx; }
#if XB_EARLY_WB
        __builtin_amdgcn_fence(__ATOMIC_RELEASE, "agent");
        asm volatile("s_waitcnt vmcnt(0)" ::: "memory");
#endif
        const unsigned old = xb_add(&bar[XB_XSUB(b.x)], 1u);
        const unsigned gen = old / nloc;
        if (old + 1u == (gen + 1u) * nloc) {
            __builtin_amdgcn_fence(__ATOMIC_RELEASE, "agent");
            asm volatile("s_waitcnt vmcnt(0)" ::: "memory");
            const unsigned og = xb_add(&bar[XB_TOP], 1u);
            const unsigned tg = og / nx;
            if (og + 1u == (tg + 1u) * nx) xb_add(&bar[XB_TOPGEN], 1u);
            else XB_SPIN(xb_ld(&bar[XB_TOPGEN]) == tg, bar);
            __builtin_amdgcn_fence(__ATOMIC_ACQUIRE, "agent");
            xb_add(&bar[XB_XGEN(b.x)], 1u);
            asm volatile("s_waitcnt vmcnt(0)" ::: "memory");
        } else {
            XB_SPIN(xb_ld(&bar[XB_XGEN(b.x)]) == gen, bar);
            __builtin_amdgcn_fence(__ATOMIC_ACQUIRE, "agent");
            asm volatile("s_waitcnt vmcnt(0)" ::: "memory");
        }
    }
    __syncthreads();
}


constexpr int NTHR = 512, NWAVES = 8;
constexpr int RING_BYTES = 131072, LDS_BYTES = 147456, MISC_OFF = LDS_BYTES - 512;
constexpr int CW_BAR = 4096, CW_RANK = 8192;
constexpr size_t CTL_ZERO_BYTES = 1 * MiB;
constexpr int NPH = 14;

__device__ __forceinline__ int mk_tid(int wave_s) { int l_; asm volatile("v_mbcnt_lo_u32_b32 %0, -1, 0\n\tv_mbcnt_hi_u32_b32 %0, -1, %0" : "=v"(l_)); return wave_s * 64 + l_; }
struct Params { const float* in[26]; float* out; unsigned char* ws; int ph_lo, ph_hi, dbl_mask, pad; };
static_assert(sizeof(Params) == 26 * 8 + 8 + 8 + 16, "no padding");

#define LDSP __attribute__((address_space(3)))
#define LDS_WAIT() asm volatile("s_waitcnt lgkmcnt(0)" ::: "memory")
#ifndef NAIVE_SELECT
#define NAIVE_SELECT 0
#endif
#ifndef NAIVE_ATTN
#define NAIVE_ATTN 0
#endif
#ifndef NAIVE_SSM
#define NAIVE_SSM 0
#endif
#ifndef DBG_SSM
#define DBG_SSM 0
#endif
#ifndef TIMING
#define TIMING 0
#endif
#ifndef DBL_MASK
#define DBL_MASK 0
#endif
#ifndef GEMM_DRYK
#define GEMM_DRYK 0
#endif
#ifndef CLK_PROBE
#define CLK_PROBE 0
#endif
#ifndef ATT_FN
#define ATT_FN wg_attn16d
#endif
#ifndef XTRA_BAR
#define XTRA_BAR 0
#endif
#ifndef ATT_SUB_V
#define ATT_SUB_V 0
#endif
#ifndef TIMING_SHIFT
#define TIMING_SHIFT 0.0f
#endif
#ifndef TIMING_A
#define TIMING_A 2
#endif
#ifndef TIMING_B
#define TIMING_B 3
#endif

template <int MODE> __device__ __forceinline__ void ph_prep_w(LDSP float* scr, const float* __restrict__ W, const float* __restrict__ W2, int K, int Nsrc, const float* __restrict__ gain, bf16* __restrict__ Wt, int Ndst, int gw, int NGW, int lane) {
    const int ntn = Ndst / 32, nt = ntn * (K / 64), n4 = lane & 7, kr = lane >> 3;
    f32x4 v[8];
#define PW_LOAD(it_) { const int n0_ = ((it_) % ntn) * 32, k0_ = ((it_) / ntn) * 64, n_ = n0_ + 4 * n4; int src_; const float* Ws_ = W; \
        if (MODE == 0) src_ = n_; else if (MODE == 1) src_ = src_col_in(n_); else { const int which_ = (n_ & 255) >> 7; src_ = (n_ >> 8) * 128 + (n_ & 127); Ws_ = which_ ? W2 : W; } \
        _Pragma("unroll") for (int i = 0; i < 8; ++i) { const int kk = kr + 8 * i; f32x4 t_ = (f32x4){0.f, 0.f, 0.f, 0.f}; if (src_ >= 0) { t_ = *(const f32x4*)(Ws_ + (size_t)(k0_ + kk) * Nsrc + src_); if (gain) t_ = t_ * gain[k0_ + kk]; } v[i] = t_; } }
    if (gw < nt) PW_LOAD(gw)
    for (int it = gw; it < nt; it += NGW) {
        const int n0 = (it % ntn) * 32, k0 = (it / ntn) * 64;
#pragma unroll
        for (int i = 0; i < 8; ++i) { LDSP float* d = scr + (kr + 8 * i) * 33 + 4 * n4; d[0] = v[i].x; d[1] = v[i].y; d[2] = v[i].z; d[3] = v[i].w; }
        if (it + NGW < nt) PW_LOAD(it + NGW)
        LDS_WAIT(); asm volatile("" ::: "memory");
        const int cc = lane & 7;
#pragma unroll
        for (int j = 0; j < 4; ++j) { const int nn = (lane >> 3) + 8 * j; const LDSP float* s = scr + (8 * cc) * 33 + nn;
            u32x4 o; o.x = pk2(s[0 * 33], s[1 * 33]); o.y = pk2(s[2 * 33], s[3 * 33]); o.z = pk2(s[4 * 33], s[5 * 33]); o.w = pk2(s[6 * 33], s[7 * 33]);
            *(u32x4*)(Wt + (size_t)(n0 + nn) * K + k0 + 8 * cc) = o; }
        LDS_WAIT(); asm volatile("" ::: "memory");
    }
#undef PW_LOAD
}
__device__ __forceinline__ void row_x_prep(const float* __restrict__ x, bf16* __restrict__ xb, float* __restrict__ rstd, int row, int lane) {
    const f32x4* xr = (const f32x4*)(x + (size_t)row * D) + lane; float ss = 0.f; f32x4 v[4];
#pragma unroll
    for (int j = 0; j < 4; ++j) { v[j] = xr[64 * j]; ss += (v[j].x * v[j].x + v[j].y * v[j].y) + (v[j].z * v[j].z + v[j].w * v[j].w); }
    ss = wave_sum(ss);
    if (xb) { u32x2* o = (u32x2*)(xb + (size_t)row * D) + lane;
#pragma unroll
        for (int j = 0; j < 4; ++j) { u32x2 w; w.x = pk2(v[j].x, v[j].y); w.y = pk2(v[j].z, v[j].w); o[64 * j] = w; } }
    if (lane == 0) rstd[row] = 1.0f / sqrtf(ss * (1.0f / D) + EPS);
}
__device__ __forceinline__ void row_resid_norm(const float* xin, const float* __restrict__ y, const float* __restrict__ g, float* xo, bf16* __restrict__ xb, float* __restrict__ rstd_out, const float* __restrict__ p, bf16* __restrict__ pb, int row, int lane, bool dry = false) {
    const f32x4* yr = (const f32x4*)(y + (size_t)row * D) + lane; const f32x4* xr = (const f32x4*)(xin + (size_t)row * D) + lane; const f32x4* gr = (const f32x4*)g + lane;
    f32x4 v[4]; float ss = 0.f;
#pragma unroll
    for (int j = 0; j < 4; ++j) { v[j] = yr[64 * j]; ss += (v[j].x * v[j].x + v[j].y * v[j].y) + (v[j].z * v[j].z + v[j].w * v[j].w); }
    const float r = 1.0f / sqrtf(wave_sum(ss) * (1.0f / D) + EPS);
    float s2 = 0.f;
    f32x4* xor_ = (f32x4*)(xo + (size_t)row * D) + lane; u32x2* o = (u32x2*)(xb + (size_t)row * D) + lane;
#pragma unroll
    for (int j = 0; j < 4; ++j) { const f32x4 xx = xr[64 * j], gg = gr[64 * j]; f32x4 w = xx + v[j] * r * gg; if (!dry) xor_[64 * j] = w; s2 += (w.x * w.x + w.y * w.y) + (w.z * w.z + w.w * w.w);
        u32x2 q; q.x = pk2(w.x, w.y); q.y = pk2(w.z, w.w); o[64 * j] = q; }
    if (rstd_out) { s2 = wave_sum(s2); if (lane == 0) rstd_out[row] = 1.0f / sqrtf(s2 * (1.0f / D) + EPS); }
    if (p) { const f32x4 pv = *((const f32x4*)(p + (size_t)row * PLE) + lane); u32x2 q; q.x = pk2(pv.x, pv.y); q.y = pk2(pv.z, pv.w); *((u32x2*)(pb + (size_t)row * PLE) + lane) = q; }
}

__device__ __forceinline__ void row_resid_norm2(const bf16* xin, const bf16* __restrict__ y, const float* __restrict__ g, bf16* xo, float* __restrict__ rstd_out, const float* __restrict__ p, bf16* __restrict__ pb, int row0, int lane, bool dry = false) {
    f32x4 v[2][4], xx[2][4], pv[2]; const f32x4* gr = (const f32x4*)g + lane;
#pragma unroll
    for (int r = 0; r < 2; ++r) { const u32x2* yr = (const u32x2*)(y + (size_t)(row0 + r) * D) + lane; const u32x2* xr = (const u32x2*)(xin + (size_t)(row0 + r) * D) + lane;
#pragma unroll
        for (int j = 0; j < 4; ++j) { const u32x2 yw = yr[64 * j], xw = xr[64 * j];
            v[r][j] = (f32x4){__builtin_bit_cast(float, yw.x << 16), __builtin_bit_cast(float, yw.x & 0xffff0000u), __builtin_bit_cast(float, yw.y << 16), __builtin_bit_cast(float, yw.y & 0xffff0000u)};
            xx[r][j] = (f32x4){__builtin_bit_cast(float, xw.x << 16), __builtin_bit_cast(float, xw.x & 0xffff0000u), __builtin_bit_cast(float, xw.y << 16), __builtin_bit_cast(float, xw.y & 0xffff0000u)}; }
        if (p) pv[r] = *((const f32x4*)(p + (size_t)(row0 + r) * PLE) + lane); }
    f32x4 gg[4];
#pragma unroll
    for (int j = 0; j < 4; ++j) gg[j] = gr[64 * j];
#pragma unroll
    for (int r = 0; r < 2; ++r) { float ss = 0.f;
#pragma unroll
        for (int j = 0; j < 4; ++j) ss += (v[r][j].x * v[r][j].x + v[r][j].y * v[r][j].y) + (v[r][j].z * v[r][j].z + v[r][j].w * v[r][j].w);
        const float rr = 1.0f / sqrtf(wave_sum(ss) * (1.0f / D) + EPS); float s2 = 0.f;
        u32x2* o = (u32x2*)(xo + (size_t)(row0 + r) * D) + lane;
#pragma unroll
        for (int j = 0; j < 4; ++j) { const f32x4 w = xx[r][j] + v[r][j] * rr * gg[j]; u32x2 q; q.x = pk2(w.x, w.y); q.y = pk2(w.z, w.w); if (!dry) o[64 * j] = q;
            const float r0 = __builtin_bit_cast(float, q.x << 16), r1 = __builtin_bit_cast(float, q.x & 0xffff0000u), r2 = __builtin_bit_cast(float, q.y << 16), r3 = __builtin_bit_cast(float, q.y & 0xffff0000u);
            s2 += (r0 * r0 + r1 * r1) + (r2 * r2 + r3 * r3); }
        if (rstd_out) { s2 = wave_sum(s2); if (lane == 0) rstd_out[row0 + r] = 1.0f / sqrtf(s2 * (1.0f / D) + EPS); }
        if (p) { u32x2 q; q.x = pk2(pv[r].x, pv[r].y); q.y = pk2(pv[r].z, pv[r].w); *((u32x2*)(pb + (size_t)(row0 + r) * PLE) + lane) = q; } }
}
__device__ __forceinline__ void row_rstd_bf16(const bf16* __restrict__ xb, float* __restrict__ rstd, int row, int lane) {
    const u32x2* xr = (const u32x2*)(xb + (size_t)row * D) + lane; float ss = 0.f;
#pragma unroll
    for (int j = 0; j < 4; ++j) { const u32x2 w = xr[64 * j]; const float a = __builtin_bit_cast(float, w.x << 16), b = __builtin_bit_cast(float, w.x & 0xffff0000u), c2 = __builtin_bit_cast(float, w.y << 16), d = __builtin_bit_cast(float, w.y & 0xffff0000u); ss += (a * a + b * b) + (c2 * c2 + d * d); }
    ss = wave_sum(ss); if (lane == 0) rstd[row] = 1.0f / sqrtf(ss * (1.0f / D) + EPS);
}
__device__ __forceinline__ void row_x_prep2(const float* __restrict__ x, bf16* __restrict__ xb, float* __restrict__ rstd, int row0, int lane) {
    f32x4 v[2][4]; float ss[2];
#pragma unroll
    for (int r = 0; r < 2; ++r) { const f32x4* xr = (const f32x4*)(x + (size_t)(row0 + r) * D) + lane;
#pragma unroll
        for (int j = 0; j < 4; ++j) v[r][j] = xr[64 * j]; }
#pragma unroll
    for (int r = 0; r < 2; ++r) { float s_ = 0.f;
#pragma unroll
        for (int j = 0; j < 4; ++j) s_ += (v[r][j].x * v[r][j].x + v[r][j].y * v[r][j].y) + (v[r][j].z * v[r][j].z + v[r][j].w * v[r][j].w);
        ss[r] = wave_sum(s_); u32x2* o = (u32x2*)(xb + (size_t)(row0 + r) * D) + lane;
#pragma unroll
        for (int j = 0; j < 4; ++j) { u32x2 w; w.x = pk2(v[r][j].x, v[r][j].y); w.y = pk2(v[r][j].z, v[r][j].w); o[64 * j] = w; } }
    if (lane < 2) rstd[row0 + lane] = 1.0f / sqrtf((lane ? ss[1] : ss[0]) * (1.0f / D) + EPS);
}
__device__ __forceinline__ void row_rstd_bf16x4(const bf16* __restrict__ xb, float* __restrict__ rstd, int row0, int lane) {
    u32x2 w[4][4]; float ss[4];
#pragma unroll
    for (int r = 0; r < 4; ++r) { const u32x2* xr = (const u32x2*)(xb + (size_t)(row0 + r) * D) + lane;
#pragma unroll
        for (int j = 0; j < 4; ++j) w[r][j] = xr[64 * j]; }
#pragma unroll
    for (int r = 0; r < 4; ++r) { float s_ = 0.f;
#pragma unroll
        for (int j = 0; j < 4; ++j) { const float a = __builtin_bit_cast(float, w[r][j].x << 16), b = __builtin_bit_cast(float, w[r][j].x & 0xffff0000u), c2 = __builtin_bit_cast(float, w[r][j].y << 16), d = __builtin_bit_cast(float, w[r][j].y & 0xffff0000u); s_ += (a * a + b * b) + (c2 * c2 + d * d); }
        ss[r] = wave_sum(s_); }
    const float sel = lane == 0 ? ss[0] : lane == 1 ? ss[1] : lane == 2 ? ss[2] : ss[3];
    if (lane < 4) rstd[row0 + lane] = 1.0f / sqrtf(sel * (1.0f / D) + EPS);
}
__device__ __forceinline__ void wave_gnorm4(bf16* RA, const float* __restrict__ nw, int w0, int lane, bool dry = false) {
    u32x4 v[4]; float ss[4];
#pragma unroll
    for (int i = 0; i < 4; ++i) { const int w = w0 + i, t = w >> 1, g = w & 1; v[i] = *(const u32x4*)(RA + (size_t)t * NA + A_Z + g * 512 + lane * 8); }
    float f[4][8];
#pragma unroll
    for (int i = 0; i < 4; ++i) { const unsigned vw[4] = {v[i].x, v[i].y, v[i].z, v[i].w}; ss[i] = 0.f;
#pragma unroll
        for (int e = 0; e < 8; ++e) { f[i][e] = bf2f((bf16)((vw[e >> 1] >> ((e & 1) * 16)) & 0xffff)); ss[i] += f[i][e] * f[i][e]; } }
#pragma unroll
    for (int o = 1; o < 64; o <<= 1) {
#pragma unroll
        for (int i = 0; i < 4; ++i) ss[i] += __shfl_xor(ss[i], o); }
#pragma unroll
    for (int i = 0; i < 4; ++i) { const int w = w0 + i, t = w >> 1, g = w & 1; const float r = 1.0f / sqrtf(ss[i] * (1.0f / 512.0f) + EPS); const float* gw = nw + g * 512 + lane * 8;
        u32x4 o; o.x = pk2(f[i][0] * r * gw[0], f[i][1] * r * gw[1]); o.y = pk2(f[i][2] * r * gw[2], f[i][3] * r * gw[3]); o.z = pk2(f[i][4] * r * gw[4], f[i][5] * r * gw[5]); o.w = pk2(f[i][6] * r * gw[6], f[i][7] * r * gw[7]);
        if (!dry) *(u32x4*)(RA + (size_t)t * NA + A_Z + g * 512 + lane * 8) = o; }
}
__device__ __forceinline__ void tok_m1(bf16* __restrict__ RA, bf16* __restrict__ RB, bf16* __restrict__ CKVC, bf16* __restrict__ IKC, const float* __restrict__ kvn, const float* __restrict__ ikg, const float* __restrict__ ikb, const float* __restrict__ scw, int t, int lane) {
    const int s = t & (SEQ - 1); bf16* rb = RB + (size_t)t * NB;
    {   const u32x2 w = *((const u32x2*)(rb + B_CKV) + lane); float v[4] = {bf2f((bf16)(w.x & 0xffff)), bf2f((bf16)(w.x >> 16)), bf2f((bf16)(w.y & 0xffff)), bf2f((bf16)(w.y >> 16))};
        float ss = (v[0] * v[0] + v[1] * v[1]) + (v[2] * v[2] + v[3] * v[3]); ss = wave_sum(ss); const float r = 1.0f / sqrtf(ss * (1.0f / KV_R) + EPS);
        const f32x4 g = *((const f32x4*)kvn + lane); u32x2 o; o.x = pk2(v[0] * r * g.x, v[1] * r * g.y); o.y = pk2(v[2] * r * g.z, v[3] * r * g.w); *((u32x2*)(rb + B_CKV) + lane) = o; *((u32x2*)(CKVC + (size_t)t * KV_R) + lane) = o; }
    {   const float x = bf2f(rb[B_IK + lane]); const float mu = wave_sum(x) * (1.0f / 64.0f); const float d = x - mu; const float var = wave_sum(d * d) * (1.0f / 64.0f);
        const bf16 o = f2bf(d * (1.0f / sqrtf(var + EPS)) * ikg[lane] + ikb[lane]); rb[B_IK + lane] = o; IKC[(size_t)t * 64 + lane] = o; }
    {   const int c = lane * 8; float acc[8] = {0.f, 0.f, 0.f, 0.f, 0.f, 0.f, 0.f, 0.f};
        for (int j = 0; j < 3; ++j) { const int ss_ = s - 2 + j; if (ss_ < 0) continue; const bf16* rr = RB + (size_t)(t - 2 + j) * NB;
            const u32x4 cg = *(const u32x4*)(rr + B_CG + c), hb = *(const u32x4*)(rr + B_HB + c); const unsigned cw[4] = {cg.x, cg.y, cg.z, cg.w}, hw[4] = {hb.x, hb.y, hb.z, hb.w};
#pragma unroll
            for (int e = 0; e < 8; ++e) { const float a = bf2f((bf16)((cw[e >> 1] >> ((e & 1) * 16)) & 0xffff)), b = bf2f((bf16)((hw[e >> 1] >> ((e & 1) * 16)) & 0xffff)); acc[e] += scw[j * 512 + c + e] * (a * b); } }
        bf16* ra = RA + (size_t)t * NA + A_BG + c; const u32x4 bg = *(const u32x4*)ra; const unsigned bw[4] = {bg.x, bg.y, bg.z, bg.w}; float o[8];
#pragma unroll
        for (int e = 0; e < 8; ++e) o[e] = bf2f((bf16)((bw[e >> 1] >> ((e & 1) * 16)) & 0xffff)) * acc[e];
        u32x4 w; w.x = pk2(o[0], o[1]); w.y = pk2(o[2], o[3]); w.z = pk2(o[4], o[5]); w.w = pk2(o[6], o[7]); *(u32x4*)ra = w; }
}
__device__ __forceinline__ void tok_m4a(const bf16* __restrict__ RB, const float* __restrict__ cw, const float* __restrict__ cb, const float* __restrict__ dtb, bf16* __restrict__ XA, float* __restrict__ DT, int t, int lane) {
    const int s = t & (SEQ - 1);
    for (int c = lane; c < XBC; c += 64) { float a = cb[c];
#pragma unroll
        for (int j = 0; j < 4; ++j) { const int ss = s - 3 + j; if (ss >= 0) a += cw[j * XBC + c] * bf2f(RB[(size_t)(t - 3 + j) * NB + B_XBC + c]); }
        XA[(size_t)t * XBC + c] = f2bf(siluf_(a)); }
    if (lane < 16) { const float x = bf2f(RB[(size_t)t * NB + B_DT + lane]) + dtb[lane]; DT[(size_t)t * 16 + lane] = x > 15.f ? x : log1pf(__expf(x)); }
}
__device__ __forceinline__ void wg_m2_select(LDSP unsigned char* lds, const bf16* __restrict__ RB, unsigned short* __restrict__ idx, int t, int tid) {
    LDSP float* iq = (LDSP float*)lds; LDSP float* iwv = iq + 256; LDSP unsigned* red = (LDSP unsigned*)(iq + 272); LDSP unsigned* keys = (LDSP unsigned*)(iq + 288);
    const int s = t & (SEQ - 1), b = t >> 12, lane = tid & 63, wv = tid >> 6;
    const int nk = ((s >> 6) + 1) << 6;
    const bf16* rb = RB + (size_t)t * NB;
    if (tid < 256) iq[tid] = bf2f(rb[B_IQ + tid]); if (tid < 4) iwv[tid] = bf2f(rb[B_IW + tid]) * (0.125f * 0.5f);
    __syncthreads();
    for (int k = tid; k < nk; k += NTHR) {
        const bf16* kr = RB + (size_t)(b * SEQ + k) * NB + B_IK; float sc = 0.f;
        float d0 = 0.f, d1 = 0.f, d2 = 0.f, d3 = 0.f;
#pragma unroll 2
        for (int j = 0; j < 8; ++j) { const u32x4 w = *((const u32x4*)kr + j); const unsigned ww[4] = {w.x, w.y, w.z, w.w};
#pragma unroll
            for (int e = 0; e < 8; ++e) { const float kv = bf2f((bf16)((ww[e >> 1] >> ((e & 1) * 16)) & 0xffff)); const int c = j * 8 + e;
                d0 += iq[c] * kv; d1 += iq[64 + c] * kv; d2 += iq[128 + c] * kv; d3 += iq[192 + c] * kv; } }
        sc += fmaxf(d0, 0.f) * iwv[0]; sc += fmaxf(d1, 0.f) * iwv[1]; sc += fmaxf(d2, 0.f) * iwv[2]; sc += fmaxf(d3, 0.f) * iwv[3];
        keys[k] = ord_key(sc);
    }
    __syncthreads();
    unsigned Tt = 0u;
    if (nk > TOPK) {
        for (int bit = 31; bit >= 0; --bit) { const unsigned cand = Tt | (1u << bit); unsigned c = 0;
            for (int k = tid; k < nk; k += NTHR) c += (keys[k] >= cand) ? 1u : 0u;
#pragma unroll
            for (int o = 1; o < 64; o <<= 1) c += __shfl_xor(c, o);
            if (lane == 0) red[wv] = c;
            __syncthreads();
            unsigned tot = 0;
#pragma unroll
            for (int w = 0; w < 8; ++w) tot += red[w];
            if (tot >= (unsigned)TOPK) Tt = cand;
            __syncthreads(); }
    }
    { unsigned c = 0; for (int k = tid; k < nk; k += NTHR) c += (keys[k] > Tt) ? 1u : 0u;
#pragma unroll
      for (int o = 1; o < 64; o <<= 1) c += __shfl_xor(c, o);
      if (lane == 0) red[8 + wv] = c; }
    __syncthreads();
    if (wv == 0) {
        int ngt = 0;
#pragma unroll
        for (int w = 0; w < 8; ++w) ngt += (int)red[8 + w];
        const int need = TOPK - ngt; int pos = 0, eq_taken = 0; const unsigned long long lt = (1ull << lane) - 1ull;
        for (int base = 0; base < nk; base += 64) { const unsigned k = keys[base + lane]; const bool gt = k > Tt, eq = (k == Tt);
            const unsigned long long meq = __ballot(eq); const int rank_eq = __popcll(meq & lt); const bool take = gt || (eq && (eq_taken + rank_eq < need));
            const unsigned long long msel = __ballot(take);
            if (take) { const int o = pos + __popcll(msel & lt); if (o < TOPK) idx[(size_t)t * TOPK + o] = (unsigned short)(base + lane); }
            pos += __popcll(msel); eq_taken += __popcll(__ballot(eq && take)); }
    }
    __syncthreads();
}
__device__ __forceinline__ void wg_m3_attn(LDSP unsigned char* lds, bf16* RA, const bf16* __restrict__ RB, const unsigned short* __restrict__ idx, const float* __restrict__ w_uk, const float* __restrict__ w_uv, const float* __restrict__ rel_bias, int t, int tid) {
    LDSP float* q = (LDSP float*)lds; LDSP float* qlat = q + 512; LDSP float* pr = qlat + 2048; LDSP float* outl = pr + 2048; LDSP unsigned short* sel = (LDSP unsigned short*)(outl + 2048);
    const int s = t & (SEQ - 1), b = t >> 12, lane = tid & 63, wv = tid >> 6;
    const int nk = ((s >> 6) + 1) << 6, nsel = nk < TOPK ? nk : TOPK;
    q[tid] = bf2f(RA[(size_t)t * NA + A_Q + tid]); if (tid < 256) sel[tid] = tid < nsel ? idx[(size_t)t * TOPK + tid] : (unsigned short)0;
    __syncthreads();
    {   const int r = tid & 255, h0 = (tid >> 8) * 4;
        for (int h = h0; h < h0 + 4; ++h) { const float* w = w_uk + ((size_t)r * 8 + h) * 64; float a = 0.f;
#pragma unroll 16
            for (int d = 0; d < 64; ++d) a += q[h * 64 + d] * w[d];
            qlat[h * 256 + r] = a * 0.125f; } }
    __syncthreads();
    {   const int k = tid & 255, h0 = (tid >> 8) * 4;
        if (k < nsel) { const int key = sel[k]; const bf16* kr = RB + (size_t)(b * SEQ + key) * NB + B_CKV; float a[4] = {0.f, 0.f, 0.f, 0.f};
            for (int j = 0; j < 32; ++j) { const u32x4 w = *((const u32x4*)kr + j); const unsigned ww[4] = {w.x, w.y, w.z, w.w};
#pragma unroll
                for (int e = 0; e < 8; ++e) { const float v = bf2f((bf16)((ww[e >> 1] >> ((e & 1) * 16)) & 0xffff));
#pragma unroll
                    for (int hh = 0; hh < 4; ++hh) a[hh] += qlat[(h0 + hh) * 256 + j * 8 + e] * v; } }
            const int bk = t5_bucket(key - s);
#pragma unroll
            for (int hh = 0; hh < 4; ++hh) pr[(h0 + hh) * 256 + k] = a[hh] + rel_bias[bk * 8 + h0 + hh];
        } else {
#pragma unroll
            for (int hh = 0; hh < 4; ++hh) pr[(h0 + hh) * 256 + k] = -INFINITY; } }
    __syncthreads();
    {   float v[4]; float m = -INFINITY;
#pragma unroll
        for (int j = 0; j < 4; ++j) { v[j] = pr[wv * 256 + lane + 64 * j]; m = fmaxf(m, v[j]); }
        m = wave_max(m); float sum = 0.f;
#pragma unroll
        for (int j = 0; j < 4; ++j) { v[j] = __expf(v[j] - m); sum += v[j]; }
        sum = wave_sum(sum); const float inv = 1.0f / sum;
#pragma unroll
        for (int j = 0; j < 4; ++j) pr[wv * 256 + lane + 64 * j] = v[j] * inv; }
    __syncthreads();
    {   const int r = tid & 255, h0 = (tid >> 8) * 4; float a[4] = {0.f, 0.f, 0.f, 0.f};
        for (int k = 0; k < nsel; ++k) { const float v = bf2f(RB[(size_t)(b * SEQ + sel[k]) * NB + B_CKV + r]);
#pragma unroll
            for (int hh = 0; hh < 4; ++hh) a[hh] += pr[(h0 + hh) * 256 + k] * v; }
#pragma unroll
        for (int hh = 0; hh < 4; ++hh) outl[(h0 + hh) * 256 + r] = a[hh]; }
    __syncthreads();
    {   const int h = tid >> 6, d = tid & 63; float a = 0.f;
        for (int r = 0; r < 256; ++r) a += outl[h * 256 + r] * w_uv[((size_t)r * 8 + h) * 64 + d];
        RA[(size_t)t * NA + A_Q + tid] = f2bf(a); }
    __syncthreads();
}
__device__ __forceinline__ void half_m4b_scan(bf16* RA, const bf16* __restrict__ XA, const float* __restrict__ DT, const float* __restrict__ a_log, const float* __restrict__ dsk, int b, int h, int tid) {
    const int g = h >> 3, p = tid >> 2, nq = tid & 3;
    const float A = -__expf(a_log[h]), Dh = dsk[h];
    float hs[32];
#pragma unroll
    for (int n = 0; n < 32; ++n) hs[n] = 0.f;
    for (int s = 0; s < SEQ; ++s) { const size_t t = (size_t)b * SEQ + s; const float dt = DT[t * 16 + h]; const float dA = __expf(dt * A);
        const bf16* xr = XA + t * XBC; const float x = bf2f(xr[h * 64 + p]); const float dx = dt * x;
        const u32x4* Bp = (const u32x4*)(xr + 1024 + g * 128 + nq * 32); const u32x4* Cp = (const u32x4*)(xr + 1280 + g * 128 + nq * 32); float y = 0.f;
#pragma unroll
        for (int j = 0; j < 4; ++j) { const u32x4 bw = Bp[j], cw = Cp[j]; const unsigned bb[4] = {bw.x, bw.y, bw.z, bw.w}, cc[4] = {cw.x, cw.y, cw.z, cw.w};
#pragma unroll
            for (int e = 0; e < 8; ++e) { const float Bv = bf2f((bf16)((bb[e >> 1] >> ((e & 1) * 16)) & 0xffff)), Cv = bf2f((bf16)((cc[e >> 1] >> ((e & 1) * 16)) & 0xffff));
                hs[j * 8 + e] = hs[j * 8 + e] * dA + dx * Bv; y += Cv * hs[j * 8 + e]; } }
        y += __shfl_xor(y, 1); y += __shfl_xor(y, 2);
        if (nq == 0) { bf16* zp = RA + t * NA + A_Z + h * 64 + p; const float z = bf2f(*zp); *zp = f2bf((y + Dh * x) * siluf_(z)); }
    }
}
__device__ __forceinline__ void wave_m4c_gnorm(bf16* RA, const float* __restrict__ nw, int w, int lane, bool dry = false) {
    const int t = w >> 1, g = w & 1;
    bf16* p = RA + (size_t)t * NA + A_Z + g * 512 + lane * 8; const u32x4 v = *(const u32x4*)p; const unsigned vw[4] = {v.x, v.y, v.z, v.w}; float f[8]; float ss = 0.f;
#pragma unroll
    for (int e = 0; e < 8; ++e) { f[e] = bf2f((bf16)((vw[e >> 1] >> ((e & 1) * 16)) & 0xffff)); ss += f[e] * f[e]; }
    const float r = 1.0f / sqrtf(wave_sum(ss) * (1.0f / 512.0f) + EPS); const float* gw = nw + g * 512 + lane * 8;
    u32x4 o; o.x = pk2(f[0] * r * gw[0], f[1] * r * gw[1]); o.y = pk2(f[2] * r * gw[2], f[3] * r * gw[3]); o.z = pk2(f[4] * r * gw[4], f[5] * r * gw[5]); o.w = pk2(f[6] * r * gw[6], f[7] * r * gw[7]);
    if (!dry) *(u32x4*)p = o;
}

__device__ __forceinline__ void unpack8(const u32x4 w, float (&f)[8]) { const unsigned ww[4] = {w.x, w.y, w.z, w.w};
#pragma unroll
    for (int e = 0; e < 4; ++e) { f[2 * e] = __builtin_bit_cast(float, ww[e] << 16); f[2 * e + 1] = __builtin_bit_cast(float, ww[e] & 0xffff0000u); } }
__device__ __forceinline__ void prep_ckv4(const bf16* __restrict__ RB, bf16* __restrict__ CKVC, const float* __restrict__ kvn, int it, int lane) {
    const int t = it * 4 + (lane >> 4), c = lane & 15; const u32x4* src = (const u32x4*)(RB + (size_t)t * NB + B_CKV + c * 16); const u32x4 a = src[0], b = src[1];
    float v[16]; { float f[8]; unpack8(a, f);
#pragma unroll
        for (int e = 0; e < 8; ++e) v[e] = f[e]; unpack8(b, f);
#pragma unroll
        for (int e = 0; e < 8; ++e) v[8 + e] = f[e]; }
    float ss = 0.f;
#pragma unroll
    for (int e = 0; e < 16; ++e) ss += v[e] * v[e];
    ss += __shfl_xor(ss, 1); ss += __shfl_xor(ss, 2); ss += __shfl_xor(ss, 4); ss += __shfl_xor(ss, 8);
    const float r = 1.0f / sqrtf(ss * (1.0f / KV_R) + EPS); const f32x4* gp = (const f32x4*)(kvn + c * 16); float o[16];
#pragma unroll
    for (int q = 0; q < 4; ++q) { const f32x4 gg = gp[q]; o[4 * q] = v[4 * q] * r * gg.x; o[4 * q + 1] = v[4 * q + 1] * r * gg.y; o[4 * q + 2] = v[4 * q + 2] * r * gg.z; o[4 * q + 3] = v[4 * q + 3] * r * gg.w; }
    u32x4 w0, w1; w0.x = pk2(o[0], o[1]); w0.y = pk2(o[2], o[3]); w0.z = pk2(o[4], o[5]); w0.w = pk2(o[6], o[7]); w1.x = pk2(o[8], o[9]); w1.y = pk2(o[10], o[11]); w1.z = pk2(o[12], o[13]); w1.w = pk2(o[14], o[15]);
    u32x4* dst = (u32x4*)(CKVC + (size_t)t * KV_R + c * 16); dst[0] = w0; dst[1] = w1;
}
__device__ __forceinline__ void prep_ik16(const bf16* __restrict__ RB, bf16* __restrict__ IKC, const float* __restrict__ ikg, const float* __restrict__ ikb, int it, int lane) {
    const int t = it * 16 + (lane >> 2), c = lane & 3; const u32x4* src = (const u32x4*)(RB + (size_t)t * NB + B_IK + c * 16); const u32x4 a = src[0], b = src[1];
    float v[16]; { float f[8]; unpack8(a, f);
#pragma unroll
        for (int e = 0; e < 8; ++e) v[e] = f[e]; unpack8(b, f);
#pragma unroll
        for (int e = 0; e < 8; ++e) v[8 + e] = f[e]; }
    float s = 0.f;
#pragma unroll
    for (int e = 0; e < 16; ++e) s += v[e];
    s += __shfl_xor(s, 1); s += __shfl_xor(s, 2); const float mu = s * (1.0f / 64.0f); float q2 = 0.f;
#pragma unroll
    for (int e = 0; e < 16; ++e) { v[e] -= mu; q2 += v[e] * v[e]; }
    q2 += __shfl_xor(q2, 1); q2 += __shfl_xor(q2, 2); const float r = 1.0f / sqrtf(q2 * (1.0f / 64.0f) + EPS); float o[16];
#pragma unroll
    for (int e = 0; e < 16; ++e) o[e] = v[e] * r * ikg[c * 16 + e] + ikb[c * 16 + e];
    u32x4 w0, w1; w0.x = pk2(o[0], o[1]); w0.y = pk2(o[2], o[3]); w0.z = pk2(o[4], o[5]); w0.w = pk2(o[6], o[7]); w1.x = pk2(o[8], o[9]); w1.y = pk2(o[10], o[11]); w1.z = pk2(o[12], o[13]); w1.w = pk2(o[14], o[15]);
    u32x4* dst = (u32x4*)(IKC + (size_t)t * 64 + c * 16); dst[0] = w0; dst[1] = w1;
}
__device__ __forceinline__ void prep_bout(bf16* RA, const bf16* __restrict__ RB, const float* __restrict__ scw, int t, int lane, bool dry = false) {
    const int s = t & (SEQ - 1), c = lane * 8; float acc[8] = {0.f, 0.f, 0.f, 0.f, 0.f, 0.f, 0.f, 0.f};
    u32x4 cg[3], hb[3];
#pragma unroll
    for (int j = 0; j < 3; ++j) { const bool ok = (s - 2 + j) >= 0; const bf16* rr = RB + (size_t)(t - 2 + j) * NB; cg[j] = ok ? *(const u32x4*)(rr + B_CG + c) : (u32x4){0u, 0u, 0u, 0u}; hb[j] = ok ? *(const u32x4*)(rr + B_HB + c) : (u32x4){0u, 0u, 0u, 0u}; }
    bf16* ra = RA + (size_t)t * NA + A_BG + c; const u32x4 bg = *(const u32x4*)ra;
#pragma unroll
    for (int j = 0; j < 3; ++j) { float a[8], b[8]; unpack8(cg[j], a); unpack8(hb[j], b); const f32x4 w0 = *(const f32x4*)(scw + j * 512 + c), w1 = *(const f32x4*)(scw + j * 512 + c + 4);
        acc[0] += w0.x * (a[0] * b[0]); acc[1] += w0.y * (a[1] * b[1]); acc[2] += w0.z * (a[2] * b[2]); acc[3] += w0.w * (a[3] * b[3]);
        acc[4] += w1.x * (a[4] * b[4]); acc[5] += w1.y * (a[5] * b[5]); acc[6] += w1.z * (a[6] * b[6]); acc[7] += w1.w * (a[7] * b[7]); }
    float g8[8]; unpack8(bg, g8); u32x4 w; w.x = pk2(g8[0] * acc[0], g8[1] * acc[1]); w.y = pk2(g8[2] * acc[2], g8[3] * acc[3]); w.z = pk2(g8[4] * acc[4], g8[5] * acc[5]); w.w = pk2(g8[6] * acc[6], g8[7] * acc[7]);
    if (!dry) *(u32x4*)ra = w;
}
__device__ __forceinline__ void prep_conv(const bf16* __restrict__ RB, bf16* __restrict__ XA, const float* __restrict__ cw, const float* __restrict__ cb, int it, int lane) {
    const int rb = it / 12, cbk = it % 12, xcol = cbk * 128 + 2 * lane, t0 = rb * 16, s0 = t0 & (SEQ - 1);
    float w0[4], w1[4];
#pragma unroll
    for (int j = 0; j < 4; ++j) { w0[j] = cw[j * XBC + xcol]; w1[j] = cw[j * XBC + xcol + 1]; }
    const float cb0 = cb[xcol], cb1 = cb[xcol + 1];
    const bf16* src = RB + (size_t)(t0 - 3) * NB + B_XBC + xcol; unsigned raw[19];
#pragma unroll
    for (int i = 0; i < 19; ++i) raw[i] = (s0 - 3 + i >= 0) ? *(const unsigned*)(src + (size_t)i * NB) : 0u;
#pragma unroll
    for (int i = 0; i < 16; ++i) { float a0 = cb0, a1 = cb1;
#pragma unroll
        for (int j = 0; j < 4; ++j) { a0 += w0[j] * __builtin_bit_cast(float, raw[i + j] << 16); a1 += w1[j] * __builtin_bit_cast(float, raw[i + j] & 0xffff0000u); }
        *(unsigned*)(XA + (size_t)(t0 + i) * XBC + xcol) = pk2(siluf_(a0), siluf_(a1)); }
}

typedef short bf16x8_t __attribute__((ext_vector_type(8)));
#ifndef SEL_SLEEP
#define SEL_SLEEP 0
#endif
#ifndef SEL_REP_SEARCH
#define SEL_REP_SEARCH 1
#endif
#ifndef SEL_REP_STAGE
#define SEL_REP_STAGE 1
#endif
#define CNT8_GE(cnt, v0, v1, v2, v3, v4, v5, v6, v7, cand) do { unsigned long long m0_, m1_, m2_, m3_, m4_, m5_, m6_, m7_; \
    asm("v_cmp_ge_u32_e64 %0, %8, %16\n\tv_cmp_ge_u32_e64 %1, %9, %16\n\tv_cmp_ge_u32_e64 %2, %10, %16\n\tv_cmp_ge_u32_e64 %3, %11, %16\n\t" \
        "v_cmp_ge_u32_e64 %4, %12, %16\n\tv_cmp_ge_u32_e64 %5, %13, %16\n\tv_cmp_ge_u32_e64 %6, %14, %16\n\tv_cmp_ge_u32_e64 %7, %15, %16" \
        : "=&s"(m0_), "=&s"(m1_), "=&s"(m2_), "=&s"(m3_), "=&s"(m4_), "=&s"(m5_), "=&s"(m6_), "=&s"(m7_) \
        : "v"(v0), "v"(v1), "v"(v2), "v"(v3), "v"(v4), "v"(v5), "v"(v6), "v"(v7), "s"(cand)); \
    cnt += (__popcll(m0_) + __popcll(m1_)) + (__popcll(m2_) + __popcll(m3_)) + (__popcll(m4_) + __popcll(m5_)) + (__popcll(m6_) + __popcll(m7_)); } while (0)
#define PK8_GE(acc, p0, p1, p2, p3, p4, p5, p6, p7, c2, ones) do { unsigned t0_, t1_; \
    asm("v_pk_sub_u16 %1, %3, %11 clamp\n\tv_pk_sub_u16 %2, %4, %11 clamp\n\tv_pk_min_u16 %1, %1, %12\n\tv_pk_min_u16 %2, %2, %12\n\tv_pk_add_u16 %0, %0, %1\n\tv_pk_add_u16 %0, %0, %2\n\t" \
        "v_pk_sub_u16 %1, %5, %11 clamp\n\tv_pk_sub_u16 %2, %6, %11 clamp\n\tv_pk_min_u16 %1, %1, %12\n\tv_pk_min_u16 %2, %2, %12\n\tv_pk_add_u16 %0, %0, %1\n\tv_pk_add_u16 %0, %0, %2\n\t" \
        "v_pk_sub_u16 %1, %7, %11 clamp\n\tv_pk_sub_u16 %2, %8, %11 clamp\n\tv_pk_min_u16 %1, %1, %12\n\tv_pk_min_u16 %2, %2, %12\n\tv_pk_add_u16 %0, %0, %1\n\tv_pk_add_u16 %0, %0, %2\n\t" \
        "v_pk_sub_u16 %1, %9, %11 clamp\n\tv_pk_sub_u16 %2, %10, %11 clamp\n\tv_pk_min_u16 %1, %1, %12\n\tv_pk_min_u16 %2, %2, %12\n\tv_pk_add_u16 %0, %0, %1\n\tv_pk_add_u16 %0, %0, %2" \
        : "+v"(acc), "=&v"(t0_), "=&v"(t1_) : "v"(p0), "v"(p1), "v"(p2), "v"(p3), "v"(p4), "v"(p5), "v"(p6), "v"(p7), "s"(c2), "s"(ones)); } while (0)
__device__ __forceinline__ int wave_sum_i(int x) {
    int a = x, b = x;
    asm volatile("s_nop 1\n\tv_permlane32_swap_b32 %0, %1" : "+v"(a), "+v"(b)); x = a + b; a = x; b = x;
    asm volatile("s_nop 1\n\tv_permlane16_swap_b32 %0, %1" : "+v"(a), "+v"(b)); x = a + b;
    x += __builtin_amdgcn_update_dpp(0, x, 0x128, 0xf, 0xf, false);
    x += __builtin_amdgcn_update_dpp(0, x, 0x124, 0xf, 0xf, false);
    x += __builtin_amdgcn_update_dpp(0, x, 0x122, 0xf, 0xf, false);
    x += __builtin_amdgcn_update_dpp(0, x, 0x121, 0xf, 0xf, false);
    return __builtin_amdgcn_readfirstlane(x);
}
constexpr int SC_STRIDE = 516, SC_BUF = 16 * SC_STRIDE;
constexpr int IKW_OFF = 66560;
__device__ __forceinline__ void wg_select16(LDSP unsigned char* lds, const bf16* __restrict__ RB, const bf16* __restrict__ IKC, unsigned short* __restrict__ idx, int unit, int tid, bool dry = false, bool lds_out = false) {
    const int lane = tid & 63, wave = __builtin_amdgcn_readfirstlane(tid >> 6), g = lane >> 4, c = lane & 15;
    const int b = unit >> 8, qg = unit & 255, t0 = b * SEQ + qg * 16, nk = ((qg >> 2) + 1) << 6, nr = nk >> 6;
    LDSP unsigned* SC = (LDSP unsigned*)lds;
    bf16x8_t bq[4][2]; float iwq[4];
    { const bf16* qr = RB + (size_t)(t0 + c) * NB;
#pragma unroll
      for (int h = 0; h < 4; ++h) { bq[h][0] = *(const bf16x8_t*)(qr + B_IQ + h * 64 + g * 8); bq[h][1] = *(const bf16x8_t*)(qr + B_IQ + h * 64 + 32 + g * 8); iwq[h] = bf2f(qr[B_IW + h]) * 0.0625f; } }
    unsigned val[2][64];
#pragma unroll
    for (int r = 0; r < 64; ++r) { val[0][r] = 0u; val[1][r] = 0u; }
    const bf16* ikb = IKC + (size_t)b * SEQ * 64;
    LDSP unsigned char* ikw = lds + IKW_OFF + wave * 8192;
#define IK_DMA(stage) do { if ((stage) * 512 + wave * 64 < nk) { const bf16* src_ = ikb + (size_t)((stage) * 512 + wave * 64) * 64 + lane * 8; _Pragma("unroll") for (int pc_ = 0; pc_ < 8; ++pc_) \
        __builtin_amdgcn_global_load_lds((const unsigned*)(src_ + pc_ * 512), (LDSP unsigned*)(ikw + pc_ * 1024), 16, 0, 0); } } while (0)
    IK_DMA(0);
    for (int rep_st = 0; rep_st < SEL_REP_STAGE; ++rep_st) {
    if (rep_st > 0) { asm volatile("s_waitcnt vmcnt(0)" ::: "memory"); __builtin_amdgcn_s_barrier(); IK_DMA(0); }
#pragma unroll
    for (int s = 0; s < 8; ++s) {
        if (s * 512 < nk) {
            LDSP unsigned* buf = SC + (s & 1) * SC_BUF;
            asm volatile("s_waitcnt vmcnt(0)" ::: "memory");
            bf16x8_t af[4][2];
#pragma unroll
            for (int i = 0; i < 4; ++i) { af[i][0] = *(const LDSP bf16x8_t*)(ikw + (16 * i + c) * 128 + g * 16); af[i][1] = *(const LDSP bf16x8_t*)(ikw + (16 * i + c) * 128 + 64 + g * 16); }
            asm volatile("s_waitcnt lgkmcnt(0)" ::: "memory");
            if (s < 7) IK_DMA(s + 1);
#if SEL_SLEEP
            __builtin_amdgcn_s_sleep(SEL_SLEEP);
#endif
#pragma unroll
            for (int i = 0; i < 4; ++i) { const int tl = wave * 4 + i, kb = s * 512 + tl * 16;
                if (kb < nk) {
                    const bf16x8_t a0 = af[i][0], a1 = af[i][1];
                    float sc[4] = {0.f, 0.f, 0.f, 0.f};
#pragma unroll
                    for (int h = 0; h < 4; ++h) { pg8::f32x4 acc = {0.f, 0.f, 0.f, 0.f};
                        acc = __builtin_amdgcn_mfma_f32_16x16x32_bf16(a0, bq[h][0], acc, 0, 0, 0); acc = __builtin_amdgcn_mfma_f32_16x16x32_bf16(a1, bq[h][1], acc, 0, 0, 0);
#pragma unroll
                        for (int e = 0; e < 4; ++e) sc[e] += fmaxf(acc[e], 0.f) * iwq[h]; }
                    u32x4 kv; kv.x = ord_key(sc[0]); kv.y = ord_key(sc[1]); kv.z = ord_key(sc[2]); kv.w = ord_key(sc[3]);
                    *(LDSP u32x4*)(buf + c * SC_STRIDE + tl * 16 + 4 * g) = kv; } }
            asm volatile("s_waitcnt lgkmcnt(0)" ::: "memory"); __builtin_amdgcn_s_barrier(); asm volatile("" ::: "memory");
#pragma unroll
            for (int j = 0; j < 8; ++j) if (s * 512 + j * 64 < nk) { val[0][s * 8 + j] = buf[(2 * wave) * SC_STRIDE + j * 64 + lane]; val[1][s * 8 + j] = buf[(2 * wave + 1) * SC_STRIDE + j * 64 + lane]; }
            asm volatile("s_waitcnt lgkmcnt(0)" ::: "memory");
        }
    }
    }
    const unsigned long long lt = (1ull << lane) - 1ull;
#pragma unroll
    for (int qq = 0; qq < 2; ++qq) {
        unsigned Tt = 0u;
        for (int rep_se = 0; rep_se < SEL_REP_SEARCH; ++rep_se) { Tt = 0u; asm volatile("" : "+v"(val[qq][0]));
        if (nk > TOPK) {
            unsigned ph[32];
#pragma unroll
            for (int j = 0; j < 32; ++j) ph[j] = __builtin_amdgcn_perm(val[qq][2 * j + 1], val[qq][2 * j], 0x07060302u);
            unsigned T16 = 0u; bool done16 = false; const unsigned ones = (unsigned)__builtin_amdgcn_readfirstlane(0x00010001);
#pragma clang loop unroll(disable)
            for (int bit = 15; bit >= 0; --bit) { const unsigned cand = T16 | (1u << bit), cm1 = cand - 1u, c2 = (unsigned)__builtin_amdgcn_readfirstlane((int)(cm1 | (cm1 << 16))); unsigned acc = 0u;
#pragma unroll
                for (int p8 = 0; p8 < 4; ++p8) if (p8 * 16 < nr) PK8_GE(acc, ph[p8 * 8], ph[p8 * 8 + 1], ph[p8 * 8 + 2], ph[p8 * 8 + 3], ph[p8 * 8 + 4], ph[p8 * 8 + 5], ph[p8 * 8 + 6], ph[p8 * 8 + 7], c2, ones);
                const int cnt = wave_sum_i((int)((acc & 0xffffu) + (acc >> 16)));
                if (cnt >= TOPK) T16 = cand; if (cnt == TOPK) { done16 = true; break; } }
            Tt = T16 << 16;
            if (!done16)
            for (int bit = 15; bit >= 0; --bit) { const unsigned cand = Tt | (1u << bit); int cnt = 0;
#pragma unroll
                for (int r8 = 0; r8 < 8; ++r8) if (r8 * 8 < nr) CNT8_GE(cnt, val[qq][r8 * 8], val[qq][r8 * 8 + 1], val[qq][r8 * 8 + 2], val[qq][r8 * 8 + 3], val[qq][r8 * 8 + 4], val[qq][r8 * 8 + 5], val[qq][r8 * 8 + 6], val[qq][r8 * 8 + 7], cand);
                if (cnt >= TOPK) Tt = cand; if (cnt == TOPK) break; }
        }
        }
        unsigned short* orow = idx + (size_t)(t0 + 2 * wave + qq) * TOPK;
        LDSP unsigned short* orow_l = (LDSP unsigned short*)(lds + 134 * 1024) + (2 * wave + qq) * TOPK;
        int pos = 0;
#define PUT_KEY(o_, key_) do { if ((o_) < TOPK && !dry) { if (lds_out) orow_l[o_] = (unsigned short)(key_); else orow[o_] = (unsigned short)(key_); } } while (0)
#pragma unroll
        for (int r8 = 0; r8 < 8; ++r8) if (r8 * 8 < nr) { unsigned long long k0, k1, k2, k3, k4, k5, k6, k7;
            asm("v_cmp_gt_u32_e64 %0, %8, %16\n\tv_cmp_gt_u32_e64 %1, %9, %16\n\tv_cmp_gt_u32_e64 %2, %10, %16\n\tv_cmp_gt_u32_e64 %3, %11, %16\n\t"
                "v_cmp_gt_u32_e64 %4, %12, %16\n\tv_cmp_gt_u32_e64 %5, %13, %16\n\tv_cmp_gt_u32_e64 %6, %14, %16\n\tv_cmp_gt_u32_e64 %7, %15, %16"
                : "=&s"(k0), "=&s"(k1), "=&s"(k2), "=&s"(k3), "=&s"(k4), "=&s"(k5), "=&s"(k6), "=&s"(k7)
                : "v"(val[qq][r8 * 8]), "v"(val[qq][r8 * 8 + 1]), "v"(val[qq][r8 * 8 + 2]), "v"(val[qq][r8 * 8 + 3]), "v"(val[qq][r8 * 8 + 4]), "v"(val[qq][r8 * 8 + 5]), "v"(val[qq][r8 * 8 + 6]), "v"(val[qq][r8 * 8 + 7]), "s"(Tt));
#define PUT_MASK(m_, i_) do { if ((m_) != 0ull) { if (((m_) >> lane) & 1ull) { const int o = pos + __popcll((m_) & lt); PUT_KEY(o, (r8 * 8 + (i_)) * 64 + lane); } pos += __popcll(m_); } } while (0)
            PUT_MASK(k0, 0); PUT_MASK(k1, 1); PUT_MASK(k2, 2); PUT_MASK(k3, 3); PUT_MASK(k4, 4); PUT_MASK(k5, 5); PUT_MASK(k6, 6); PUT_MASK(k7, 7);
#undef PUT_MASK
        }
        int need = TOPK - pos;
        if (need > 0) {
#pragma unroll
            for (int r = 0; r < 64; ++r) if (r < nr && need > 0) { const unsigned long long meq = __ballot(val[qq][r] == Tt);
                if (meq != 0ull) { const int rank = __popcll(meq & lt); if (((meq >> lane) & 1ull) && rank < need) { PUT_KEY(pos + rank, r * 64 + lane); } const int tk = __popcll(meq); const int tkn = tk < need ? tk : need; pos += tkn; need -= tkn; } }
        }
#undef PUT_KEY
    }
    asm volatile("s_waitcnt vmcnt(0) lgkmcnt(0)" ::: "memory"); __builtin_amdgcn_s_barrier();
#undef IK_DMA
}

typedef unsigned short u16x4_t __attribute__((ext_vector_type(4)));
#ifndef ATT_LOCAL_DRY
#define ATT_LOCAL_DRY 0
#endif
#ifndef ATT_STAGGER
#define ATT_STAGGER 0
#endif
#ifndef ATT_DRY_SKIP
#define ATT_DRY_SKIP 0
#endif
#define DSK(b) (ATT_DRY_SKIP & (b)) && dry
#ifndef ATT_SUB_EN
#define ATT_SUB_EN 0
#endif
constexpr int SELW_OFF = 134 * 1024, BT_OFF = 142 * 1024, KVP = 528, TILE_STRIDE = 32 * KVP;
constexpr int SELW_OFF_OLD = 132 * 1024, BT_OFF_OLD = 140 * 1024;
__device__ __forceinline__ int kv_off(int row, int ch) { const int hf = ch >> 4, c16 = ch & 15; return hf * 8192 + 256 * row + 16 * (c16 ^ (((row & 3) << 2) | ((row >> 2) & 3))); }
#define TR4I(d0, d1, d2, d3, base, o0, o1, o2, o3) asm volatile("ds_read_b64_tr_b16 %0, %4 offset:%5\n\tds_read_b64_tr_b16 %1, %4 offset:%6\n\tds_read_b64_tr_b16 %2, %4 offset:%7\n\tds_read_b64_tr_b16 %3, %4 offset:%8" \
    : "=&v"(d0), "=&v"(d1), "=&v"(d2), "=&v"(d3) : "v"(base), "i"(o0), "i"(o1), "i"(o2), "i"(o3) : "memory")
#define TR8N(d0, d1, d2, d3, d4, d5, d6, d7, base, o0, o1, o2, o3, o4, o5, o6, o7) asm volatile( \
    "ds_read_b64_tr_b16 %0, %8 offset:%9\n\tds_read_b64_tr_b16 %1, %8 offset:%10\n\tds_read_b64_tr_b16 %2, %8 offset:%11\n\tds_read_b64_tr_b16 %3, %8 offset:%12\n\t" \
    "ds_read_b64_tr_b16 %4, %8 offset:%13\n\tds_read_b64_tr_b16 %5, %8 offset:%14\n\tds_read_b64_tr_b16 %6, %8 offset:%15\n\tds_read_b64_tr_b16 %7, %8 offset:%16" \
    : "=&v"(d0), "=&v"(d1), "=&v"(d2), "=&v"(d3), "=&v"(d4), "=&v"(d5), "=&v"(d6), "=&v"(d7) : "v"(base), "i"(o0), "i"(o1), "i"(o2), "i"(o3), "i"(o4), "i"(o5), "i"(o6), "i"(o7) : "memory")
#define WAITPIN8(n, d0, d1, d2, d3, d4, d5, d6, d7) asm volatile("s_waitcnt lgkmcnt(" #n ")" : "+v"(d0), "+v"(d1), "+v"(d2), "+v"(d3), "+v"(d4), "+v"(d5), "+v"(d6), "+v"(d7) :: "memory")
#define WAITPIN4(n, d0, d1, d2, d3) asm volatile("s_waitcnt lgkmcnt(" #n ")" : "+v"(d0), "+v"(d1), "+v"(d2), "+v"(d3) :: "memory")
__device__ __forceinline__ bf16x8_t mk8a(u16x4_t a, u16x4_t b) { bf16x8_t r; r[0] = a[0]; r[1] = a[1]; r[2] = a[2]; r[3] = a[3]; r[4] = b[0]; r[5] = b[1]; r[6] = b[2]; r[7] = b[3]; return r; }
#define TR8I(d0, d1, d2, d3, d4, d5, d6, d7, base, o0, o1, o2, o3, o4, o5, o6, o7) asm volatile( \
    "ds_read_b64_tr_b16 %0, %8 offset:%9\n\tds_read_b64_tr_b16 %1, %8 offset:%10\n\tds_read_b64_tr_b16 %2, %8 offset:%11\n\tds_read_b64_tr_b16 %3, %8 offset:%12\n\t" \
    "ds_read_b64_tr_b16 %4, %8 offset:%13\n\tds_read_b64_tr_b16 %5, %8 offset:%14\n\tds_read_b64_tr_b16 %6, %8 offset:%15\n\tds_read_b64_tr_b16 %7, %8 offset:%16\n\ts_waitcnt lgkmcnt(0)" \
    : "=&v"(d0), "=&v"(d1), "=&v"(d2), "=&v"(d3), "=&v"(d4), "=&v"(d5), "=&v"(d6), "=&v"(d7) : "v"(base), "i"(o0), "i"(o1), "i"(o2), "i"(o3), "i"(o4), "i"(o5), "i"(o6), "i"(o7) : "memory")
#define TR8(d0, d1, d2, d3, d4, d5, d6, d7, a0, a1, a2, a3, a4, a5, a6, a7) asm volatile( \
    "ds_read_b64_tr_b16 %0, %8\n\tds_read_b64_tr_b16 %1, %9\n\tds_read_b64_tr_b16 %2, %10\n\tds_read_b64_tr_b16 %3, %11\n\t" \
    "ds_read_b64_tr_b16 %4, %12\n\tds_read_b64_tr_b16 %5, %13\n\tds_read_b64_tr_b16 %6, %14\n\tds_read_b64_tr_b16 %7, %15\n\ts_waitcnt lgkmcnt(0)" \
    : "=&v"(d0), "=&v"(d1), "=&v"(d2), "=&v"(d3), "=&v"(d4), "=&v"(d5), "=&v"(d6), "=&v"(d7) : "v"(a0), "v"(a1), "v"(a2), "v"(a3), "v"(a4), "v"(a5), "v"(a6), "v"(a7) : "memory")
__device__ __forceinline__ void wg_attn16(LDSP unsigned char* lds, bf16* RA, const bf16* __restrict__ CKVC, const unsigned short* __restrict__ idx, const bf16* __restrict__ WUK, const bf16* __restrict__ WUV,
                                          const float* __restrict__ rel_bias, int unit, int nxt_unit, int par, bool first, int tid, bool dry = false, int qmode = 0, bf16* qscr = nullptr) {
    const int lane = tid & 63, wave = __builtin_amdgcn_readfirstlane(tid >> 6), g = lane >> 4, c = lane & 15;
    const int b = unit >> 9, qg = unit & 511, t0 = b * SEQ + qg * 8, nk = ((qg >> 3) + 1) << 6, nsel = nk < TOPK ? nk : TOPK, ntile = nsel >> 5;
    LDSP unsigned char* QL = lds;
    LDSP unsigned char* tile = lds + wave * TILE_STRIDE;
    LDSP unsigned short* selw = (LDSP unsigned short*)(lds + SELW_OFF + (par * 8 + wave) * 512);
    LDSP unsigned short* selw_n = (LDSP unsigned short*)(lds + SELW_OFF + ((par ^ 1) * 8 + wave) * 512);
    if (first) { if (lane < 32) *((LDSP u32x4*)selw + lane) = *((const u32x4*)(idx + (size_t)(t0 + wave) * TOPK) + lane); }
    const bf16* kvb = CKVC + (size_t)b * SEQ * KV_R + g * 8;
    bf16x8_t kv0[8], kv1[8];
#define KV_LOAD(dst, key) do { const bf16* rp_ = kvb + (size_t)(key) * KV_R; _Pragma("unroll") for (int ks_ = 0; ks_ < 8; ++ks_) dst[ks_] = *(const bf16x8_t*)(rp_ + ks_ * 32); } while (0)
    int ka = (int)selw[c], kb = (int)selw[16 + c];
    KV_LOAD(kv0, ka); KV_LOAD(kv1, kb);
    bf16x8_t qf[8];
    if (qmode != 2) {
        const int h = wave; const bf16* qr = RA + (size_t)(t0 + (qmode == 1 ? c : (c & 7))) * NA + A_Q + h * 64 + g * 8;
        const bf16x8_t b0 = *(const bf16x8_t*)qr, b1 = *(const bf16x8_t*)(qr + 32);
        const bf16* wb = WUK + ((size_t)h * 256 + c) * 64 + g * 8;
#pragma unroll 4
        for (int rt = 0; rt < 16; ++rt) { const bf16x8_t a0 = *(const bf16x8_t*)(wb + rt * 16 * 64), a1 = *(const bf16x8_t*)(wb + rt * 16 * 64 + 32);
            pg8::f32x4 acc = {0.f, 0.f, 0.f, 0.f};
            acc = __builtin_amdgcn_mfma_f32_16x16x32_bf16(a0, b0, acc, 0, 0, 0); acc = __builtin_amdgcn_mfma_f32_16x16x32_bf16(a1, b1, acc, 0, 0, 0);
            u32x2 w; w.x = pk2(acc[0], acc[1]); w.y = pk2(acc[2], acc[3]);
            if (c < 8) *(LDSP u32x2*)(QL + (((c * 8 + h) * 256) + rt * 16 + 4 * g) * 2) = w;
            else if (qmode == 1) *(u32x2*)(qscr + ((((c - 8) * 8 + h) * 256) + rt * 16 + 4 * g)) = w; }
        asm volatile("s_waitcnt lgkmcnt(0)" ::: "memory"); __builtin_amdgcn_s_barrier(); asm volatile("" ::: "memory");
#pragma unroll
        for (int ks = 0; ks < 8; ++ks) qf[ks] = *(const LDSP bf16x8_t*)(QL + (((wave * 8 + (c & 7)) * 256) + ks * 32 + g * 8) * 2);
        asm volatile("s_waitcnt lgkmcnt(0)" ::: "memory"); __builtin_amdgcn_s_barrier(); asm volatile("" ::: "memory");
    } else {
        const unsigned long long* qs = (const unsigned long long*)(qscr + (((wave * 8 + (c & 7)) * 256) + g * 8));
#pragma unroll
        for (int ks = 0; ks < 8; ++ks) { const unsigned long long lo = __hip_atomic_load(qs + ks * 8, __ATOMIC_RELAXED, __HIP_MEMORY_SCOPE_AGENT), hi = __hip_atomic_load(qs + ks * 8 + 1, __ATOMIC_RELAXED, __HIP_MEMORY_SCOPE_AGENT);
            u32x4 w; w.x = (unsigned)lo; w.y = (unsigned)(lo >> 32); w.z = (unsigned)hi; w.w = (unsigned)(hi >> 32); qf[ks] = __builtin_bit_cast(bf16x8_t, w); }
    }
    const unsigned tile_a = (unsigned)(size_t)tile;
#if ATT_STAGGER
    if (wave >= 4) __builtin_amdgcn_s_sleep(ATT_STAGGER);
#endif
    bf16x8_t bbf; { float bv[8];
#pragma unroll
        for (int j = 0; j < 8; ++j) bv[j] = rel_bias[(8 * g + j) * 8 + (c & 7)];
        u32x4 w; w.x = pk2(bv[0], bv[1]); w.y = pk2(bv[2], bv[3]); w.z = pk2(bv[4], bv[5]); w.w = pk2(bv[6], bv[7]); bbf = __builtin_bit_cast(bf16x8_t, w); }
    {
        const int spos = (qg * 8 + wave);
        pg8::f32x4 acc[16];
#pragma unroll
        for (int nt = 0; nt < 16; ++nt) acc[nt] = (pg8::f32x4){0.f, 0.f, 0.f, 0.f};
        float m_run = -INFINITY, l_run = 0.f;
#define ONEHOT(dst, key) do { const int rel_ = (key) - spos, n_ = rel_ < 0 ? -rel_ : rel_; \
            const int big_ = 8 + (n_ >= 15) + (n_ >= 27) + (n_ >= 50) + (n_ >= 91) + (n_ >= 166) + (n_ >= 305) + (n_ >= 559); \
            const int pos_ = (n_ < 8 ? n_ : big_) + (rel_ > 0 ? 16 : 0) - 8 * g; const unsigned one_ = (pos_ & 1) ? 0x3F800000u : 0x3F80u; const int hi_ = pos_ >> 1; \
            u32x4 w_; w_.x = (hi_ == 0) ? one_ : 0u; w_.y = (hi_ == 1) ? one_ : 0u; w_.z = (hi_ == 2) ? one_ : 0u; w_.w = (hi_ == 3) ? one_ : 0u; dst = __builtin_bit_cast(bf16x8_t, w_); } while (0)
        const int q4 = c >> 2, p = c & 3;
        const unsigned trb = tile_a + (4 * g + q4) * KVP + 8 * p;
        for (int tl = 0; tl < ntile; ++tl) {
            int kan = 0, kbn = 0; const bool more = tl + 1 < ntile;
            if (more) { kan = (int)selw[(2 * tl + 2) * 16 + c]; kbn = (int)selw[(2 * tl + 3) * 16 + c]; }
            bf16x8_t oha, ohb; ONEHOT(oha, ka); ONEHOT(ohb, kb);
            asm volatile("s_waitcnt vmcnt(8)" ::: "memory");
            pg8::f32x4 s0 = {0.f, 0.f, 0.f, 0.f}, s1 = {0.f, 0.f, 0.f, 0.f};
            s0 = __builtin_amdgcn_mfma_f32_16x16x32_bf16(oha, bbf, s0, 0, 0, 0);
#pragma unroll
            for (int ks = 0; ks < 8; ++ks) { s0 = __builtin_amdgcn_mfma_f32_16x16x32_bf16(kv0[ks], qf[ks], s0, 0, 0, 0); *(LDSP bf16x8_t*)(tile + c * KVP + g * 16 + ks * 64) = kv0[ks]; }
            if (more) KV_LOAD(kv0, kan);
            if (more) asm volatile("s_waitcnt vmcnt(8)" ::: "memory"); else asm volatile("s_waitcnt vmcnt(0)" ::: "memory");
            s1 = __builtin_amdgcn_mfma_f32_16x16x32_bf16(ohb, bbf, s1, 0, 0, 0);
#pragma unroll
            for (int ks = 0; ks < 8; ++ks) { s1 = __builtin_amdgcn_mfma_f32_16x16x32_bf16(kv1[ks], qf[ks], s1, 0, 0, 0); *(LDSP bf16x8_t*)(tile + (16 + c) * KVP + g * 16 + ks * 64) = kv1[ks]; }
            if (more) KV_LOAD(kv1, kbn);
            ka = kan; kb = kbn;
            float sv[8];
#pragma unroll
            for (int j = 0; j < 4; ++j) { sv[j] = s0[j]; sv[4 + j] = s1[j]; }
            float tmax = fmaxf(fmaxf(fmaxf(sv[0], sv[1]), fmaxf(sv[2], sv[3])), fmaxf(fmaxf(sv[4], sv[5]), fmaxf(sv[6], sv[7])));
            tmax = fmaxf(tmax, __shfl_xor(tmax, 16)); tmax = fmaxf(tmax, __shfl_xor(tmax, 32));
            const float m_new = fmaxf(m_run, tmax); const float scl = __expf(m_run - m_new); const bool grow = m_new > m_run; m_run = m_new;
            float ps = 0.f;
#pragma unroll
            for (int j = 0; j < 8; ++j) { sv[j] = __expf(sv[j] - m_new); ps += sv[j]; }
            l_run = l_run * scl + ps;
            bf16x8_t pf; { u32x4 w; w.x = pk2(sv[0], sv[1]); w.y = pk2(sv[2], sv[3]); w.z = pk2(sv[4], sv[5]); w.w = pk2(sv[6], sv[7]); pf = __builtin_bit_cast(bf16x8_t, w); }
            if (__builtin_amdgcn_ballot_w64(grow) != 0ull) {
                float rs[4];
#pragma unroll
                for (int e = 0; e < 4; ++e) rs[e] = __shfl(scl, 4 * g + e);
#pragma unroll
                for (int nt = 0; nt < 16; ++nt) {
#pragma unroll
                    for (int e = 0; e < 4; ++e) acc[nt][e] *= rs[e]; } }
            asm volatile("s_waitcnt lgkmcnt(0)" ::: "memory");
            u16x4_t va[8], vb[8];
            TR8N(va[0], va[1], va[2], va[3], va[4], va[5], va[6], va[7], trb, 0, 16 * KVP, 32, 32 + 16 * KVP, 64, 64 + 16 * KVP, 96, 96 + 16 * KVP);
            TR8N(vb[0], vb[1], vb[2], vb[3], vb[4], vb[5], vb[6], vb[7], trb, 128, 128 + 16 * KVP, 160, 160 + 16 * KVP, 192, 192 + 16 * KVP, 224, 224 + 16 * KVP);
            WAITPIN8(8, va[0], va[1], va[2], va[3], va[4], va[5], va[6], va[7]);
#pragma unroll
            for (int k = 0; k < 4; ++k) acc[k] = __builtin_amdgcn_mfma_f32_16x16x32_bf16(pf, mk8a(va[2 * k], va[2 * k + 1]), acc[k], 0, 0, 0);
            TR8N(va[0], va[1], va[2], va[3], va[4], va[5], va[6], va[7], trb, 256, 256 + 16 * KVP, 288, 288 + 16 * KVP, 320, 320 + 16 * KVP, 352, 352 + 16 * KVP);
            WAITPIN8(8, vb[0], vb[1], vb[2], vb[3], vb[4], vb[5], vb[6], vb[7]);
#pragma unroll
            for (int k = 0; k < 4; ++k) acc[4 + k] = __builtin_amdgcn_mfma_f32_16x16x32_bf16(pf, mk8a(vb[2 * k], vb[2 * k + 1]), acc[4 + k], 0, 0, 0);
            TR8N(vb[0], vb[1], vb[2], vb[3], vb[4], vb[5], vb[6], vb[7], trb, 384, 384 + 16 * KVP, 416, 416 + 16 * KVP, 448, 448 + 16 * KVP, 480, 480 + 16 * KVP);
            WAITPIN8(8, va[0], va[1], va[2], va[3], va[4], va[5], va[6], va[7]);
#pragma unroll
            for (int k = 0; k < 4; ++k) acc[8 + k] = __builtin_amdgcn_mfma_f32_16x16x32_bf16(pf, mk8a(va[2 * k], va[2 * k + 1]), acc[8 + k], 0, 0, 0);
            WAITPIN8(0, vb[0], vb[1], vb[2], vb[3], vb[4], vb[5], vb[6], vb[7]);
#pragma unroll
            for (int k = 0; k < 4; ++k) acc[12 + k] = __builtin_amdgcn_mfma_f32_16x16x32_bf16(pf, mk8a(vb[2 * k], vb[2 * k + 1]), acc[12 + k], 0, 0, 0);
        }
#undef KV_LOAD
#undef ONEHOT
        float lt = l_run + __shfl_xor(l_run, 16); lt += __shfl_xor(lt, 32); const float inv = 1.0f / lt;
        float ri[4];
#pragma unroll
        for (int e = 0; e < 4; ++e) ri[e] = __shfl(inv, 4 * g + e);
        if (g < 2) {
#pragma unroll
            for (int nt = 0; nt < 16; ++nt) { LDSP unsigned short* o1 = (LDSP unsigned short*)(tile) + (4 * g) * 256 + nt * 16 + c;
                o1[0] = f2bf(acc[nt][0] * ri[0]); o1[256] = f2bf(acc[nt][1] * ri[1]); o1[512] = f2bf(acc[nt][2] * ri[2]); o1[768] = f2bf(acc[nt][3] * ri[3]); }
        }
    }
    u32x4 nsel_v = {0u, 0u, 0u, 0u};
    if (nxt_unit >= 0 && lane < 32) { const int nb = nxt_unit >> 9, nq = nxt_unit & 511; nsel_v = *((const u32x4*)(idx + (size_t)(nb * SEQ + nq * 8 + wave) * TOPK) + lane); }
    asm volatile("s_waitcnt lgkmcnt(0)" ::: "memory"); __builtin_amdgcn_s_barrier(); asm volatile("" ::: "memory");
    if (qmode == 1) {
        bf16* oscr = qscr + 16384;
#pragma unroll
        for (int j = 0; j < 4; ++j) *((u32x4*)(oscr + (size_t)wave * 2048) + j * 64 + lane) = *((const LDSP u32x4*)(tile) + j * 64 + lane);
    } else {
        const int h = wave; pg8::f32x4 o[4];
#pragma unroll
        for (int nt = 0; nt < 4; ++nt) o[nt] = (pg8::f32x4){0.f, 0.f, 0.f, 0.f};
        const LDSP unsigned char* ab = lds + TILE_STRIDE * (c & 7) + (h * 256 + g * 8) * 2;
        const unsigned long long* os = (const unsigned long long*)(qscr + 16384 + ((c & 7) * 8 + h) * 256 + g * 8);
        const bf16* wb = WUV + ((size_t)h * 64 + c) * 256 + g * 8;
        const bool from_scr = (qmode == 2) && (c < 8);
#pragma unroll
        for (int ks = 0; ks < 8; ++ks) { bf16x8_t a;
            if (from_scr) { const unsigned long long lo = __hip_atomic_load(os + ks * 8, __ATOMIC_RELAXED, __HIP_MEMORY_SCOPE_AGENT), hi = __hip_atomic_load(os + ks * 8 + 1, __ATOMIC_RELAXED, __HIP_MEMORY_SCOPE_AGENT);
                u32x4 w; w.x = (unsigned)lo; w.y = (unsigned)(lo >> 32); w.z = (unsigned)hi; w.w = (unsigned)(hi >> 32); a = __builtin_bit_cast(bf16x8_t, w); }
            else a = *(const LDSP bf16x8_t*)(ab + ks * 64);
#pragma unroll
            for (int nt = 0; nt < 4; ++nt) { const bf16x8_t bw = *(const bf16x8_t*)(wb + (size_t)nt * 16 * 256 + ks * 32); o[nt] = __builtin_amdgcn_mfma_f32_16x16x32_bf16(a, bw, o[nt], 0, 0, 0); } }
        const int rbase = (qmode == 2) ? t0 - 8 : t0;
        if ((g < 2 || qmode == 2) && !dry) {
#pragma unroll
            for (int nt = 0; nt < 4; ++nt)
#pragma unroll
                for (int e = 0; e < 4; ++e) RA[(size_t)(rbase + 4 * g + e) * NA + A_Q + h * 64 + nt * 16 + c] = f2bf(o[nt][e]); }
    }
    if (nxt_unit >= 0 && lane < 32) *((LDSP u32x4*)selw_n + lane) = nsel_v;
    asm volatile("s_waitcnt vmcnt(0) lgkmcnt(0)" ::: "memory"); __builtin_amdgcn_s_barrier(); asm volatile("" ::: "memory");
}

template <int VAR = 0> __device__ __forceinline__ void wg_attn16d(LDSP unsigned char* lds, bf16* RA, const bf16* __restrict__ CKVC, const unsigned short* __restrict__ idx, const bf16* __restrict__ WUK, const bf16* __restrict__ WUV,
                                          const float* __restrict__ rel_bias, int unit, int nxt_unit, int par, bool first, int tid, bool dry = false, int qmode = 0, bf16* qscr = nullptr) {
    const int lane = tid & 63, wave = __builtin_amdgcn_readfirstlane(tid >> 6), g = lane >> 4, c = lane & 15;
    const int b = unit >> 9, qg = unit & 511, t0 = b * SEQ + qg * 8, nk = ((qg >> 3) + 1) << 6, nsel = nk < TOPK ? nk : TOPK, ntile = nsel >> 5;
    LDSP unsigned char* QL = lds;
    LDSP unsigned char* tile = lds + wave * TILE_STRIDE;
    LDSP unsigned short* selw = (LDSP unsigned short*)(lds + SELW_OFF + (par * 8 + wave) * 512);
    LDSP unsigned short* selw_n = (LDSP unsigned short*)(lds + SELW_OFF + ((par ^ 1) * 8 + wave) * 512);
    if (first) { if (lane < 32) *((LDSP u32x4*)selw + lane) = *((const u32x4*)(idx + (size_t)(t0 + wave) * TOPK) + lane); }
    const bf16* kvb = CKVC + (size_t)b * SEQ * KV_R;
    const int nstep = (VAR & 64) ? 0 : (nsel >> 4);
    constexpr bool halfdma = (VAR & 1) != 0, nodma = (VAR & 2) != 0, nolds = (VAR & 4) != 0, nopv = (VAR & 8) != 0, noqk = (VAR & 16) != 0, nosm = (VAR & 32) != 0;
#define KV_DMA(step) do { if (nodma) break; LDSP unsigned char* sl_ = tile + ((step) & 1) * 8192; \
        _Pragma("unroll") for (int i4_ = 0; i4_ < 4; ++i4_) { const int row_ = 4 * i4_ + g; const int key_ = (int)selw[(step) * 16 + row_]; const int c16_ = c ^ ((g << 2) | i4_); \
            const bf16* src_ = kvb + (size_t)key_ * KV_R + c16_ * 8; \
            __builtin_amdgcn_global_load_lds((const unsigned*)src_, (LDSP unsigned*)(sl_ + 1024 * i4_), 16, 0, 0); \
            if (!halfdma) __builtin_amdgcn_global_load_lds((const unsigned*)(src_ + 128), (LDSP unsigned*)(sl_ + 4096 + 1024 * i4_), 16, 0, 0); } } while (0)
    if (nstep > 0) KV_DMA(0);
    bf16x8_t qf[8];
    if (qmode != 2) {
        const int h = wave; const bf16* qr = RA + (size_t)(t0 + (qmode == 1 ? c : (c & 7))) * NA + A_Q + h * 64 + g * 8;
        const bf16x8_t b0 = *(const bf16x8_t*)qr, b1 = *(const bf16x8_t*)(qr + 32);
        const bf16* wb = WUK + ((size_t)h * 256 + c) * 64 + g * 8;
#pragma unroll 4
        for (int rt = 0; rt < 16; ++rt) { const bf16x8_t a0 = *(const bf16x8_t*)(wb + rt * 16 * 64), a1 = *(const bf16x8_t*)(wb + rt * 16 * 64 + 32);
            pg8::f32x4 acc = {0.f, 0.f, 0.f, 0.f};
            acc = __builtin_amdgcn_mfma_f32_16x16x32_bf16(a0, b0, acc, 0, 0, 0); acc = __builtin_amdgcn_mfma_f32_16x16x32_bf16(a1, b1, acc, 0, 0, 0);
            u32x2 w; w.x = pk2(acc[0], acc[1]); w.y = pk2(acc[2], acc[3]);
            if (c < 8) *(LDSP u32x2*)(lds + c * TILE_STRIDE + 8192 + ((h * 256) + rt * 16 + 4 * g) * 2) = w;
            else if (qmode == 1) *(u32x2*)(qscr + ((((c - 8) * 8 + h) * 256) + rt * 16 + 4 * g)) = w; }
        asm volatile("s_waitcnt lgkmcnt(0)" ::: "memory"); __builtin_amdgcn_s_barrier(); asm volatile("" ::: "memory");
#pragma unroll
        for (int ks = 0; ks < 8; ++ks) qf[ks] = *(const LDSP bf16x8_t*)(tile + 8192 + (((c & 7) * 256) + ks * 32 + g * 8) * 2);
        asm volatile("s_waitcnt lgkmcnt(0)" ::: "memory");
    } else {
        const unsigned long long* qs = (const unsigned long long*)(qscr + (((wave * 8 + (c & 7)) * 256) + g * 8));
#pragma unroll
        for (int ks = 0; ks < 8; ++ks) { const unsigned long long lo = __hip_atomic_load(qs + ks * 8, __ATOMIC_RELAXED, __HIP_MEMORY_SCOPE_AGENT), hi = __hip_atomic_load(qs + ks * 8 + 1, __ATOMIC_RELAXED, __HIP_MEMORY_SCOPE_AGENT);
            u32x4 w; w.x = (unsigned)lo; w.y = (unsigned)(lo >> 32); w.z = (unsigned)hi; w.w = (unsigned)(hi >> 32); qf[ks] = __builtin_bit_cast(bf16x8_t, w); }
    }
    const unsigned tile_a = (unsigned)(size_t)tile;
#if ATT_STAGGER
    if (wave >= 4) __builtin_amdgcn_s_sleep(ATT_STAGGER);
#endif
    bf16x8_t bbf; { float bv[8];
#pragma unroll
        for (int j = 0; j < 8; ++j) bv[j] = rel_bias[(8 * g + j) * 8 + (c & 7)];
        u32x4 w; w.x = pk2(bv[0], bv[1]); w.y = pk2(bv[2], bv[3]); w.z = pk2(bv[4], bv[5]); w.w = pk2(bv[6], bv[7]); bbf = __builtin_bit_cast(bf16x8_t, w); }
    {
        const int spos = (qg * 8 + wave);
        pg8::f32x4 acc[16];
#pragma unroll
        for (int nt = 0; nt < 16; ++nt) acc[nt] = (pg8::f32x4){0.f, 0.f, 0.f, 0.f};
        float m_run = -INFINITY, l_run = 0.f;
#define ONEHOT(dst, key) do { const int rel_ = (key) - spos, n_ = rel_ < 0 ? -rel_ : rel_; \
            const int big_ = 8 + (n_ >= 15) + (n_ >= 27) + (n_ >= 50) + (n_ >= 91) + (n_ >= 166) + (n_ >= 305) + (n_ >= 559); \
            const int pos_ = (n_ < 8 ? n_ : big_) + (rel_ > 0 ? 16 : 0) - 8 * g; const unsigned one_ = (pos_ & 1) ? 0x3F800000u : 0x3F80u; const int hi_ = pos_ >> 1; \
            u32x4 w_; w_.x = (hi_ == 0) ? one_ : 0u; w_.y = (hi_ == 1) ? one_ : 0u; w_.z = (hi_ == 2) ? one_ : 0u; w_.w = (hi_ == 3) ? one_ : 0u; dst = __builtin_bit_cast(bf16x8_t, w_); } while (0)
        const int q4 = c >> 2, p = c & 3;
        const unsigned rd0 = tile_a + 256 * c + 16 * (g ^ (c >> 2)); const unsigned rx = (unsigned)(c & 3);
        const unsigned tr0 = tile_a + 256 * (4 * g + q4) + 8 * (p & 1); const unsigned ts = (unsigned)(((q4 << 2) | g)), tb0 = (unsigned)(p >> 1);
        if (nstep > 1) KV_DMA(1);
        for (int st = 0; st < nstep; ++st) {
            const unsigned so = (unsigned)((st & 1) * 8192);
            const int key = (int)selw[st * 16 + c];
            bf16x8_t oh; ONEHOT(oh, key);
            if (st + 1 < nstep) { if (nodma) {} else if (halfdma) asm volatile("s_waitcnt vmcnt(4)" ::: "memory"); else asm volatile("s_waitcnt vmcnt(8)" ::: "memory"); } else asm volatile("s_waitcnt vmcnt(0)" ::: "memory");
            bf16x8_t af[8]; u16x4_t v[16];
#pragma unroll
            for (int ks = 0; ks < 8; ++ks) { if (nolds) af[ks] = qf[ks]; else af[ks] = *(const LDSP bf16x8_t*)(size_t)(rd0 + so + (ks >> 2) * 4096 + 64 * (((unsigned)(ks & 3)) ^ rx)); }
#pragma unroll
            for (int n4 = 0; n4 < 4; ++n4) { unsigned ad[4]; if (nolds) { v[n4 * 4] = v[n4 * 4 + 1] = v[n4 * 4 + 2] = v[n4 * 4 + 3] = (u16x4_t){(unsigned short)st, 1, 2, 3}; continue; }
#pragma unroll
                for (int k = 0; k < 4; ++k) { const unsigned nt = (unsigned)(n4 * 4 + k); ad[k] = tr0 + so + (nt >> 3) * 4096 + 16 * ((((nt & 7) << 1) | tb0) ^ ts); }
                asm volatile("ds_read_b64_tr_b16 %0, %4\n\tds_read_b64_tr_b16 %1, %5\n\tds_read_b64_tr_b16 %2, %6\n\tds_read_b64_tr_b16 %3, %7" : "=&v"(v[n4 * 4]), "=&v"(v[n4 * 4 + 1]), "=&v"(v[n4 * 4 + 2]), "=&v"(v[n4 * 4 + 3]) : "v"(ad[0]), "v"(ad[1]), "v"(ad[2]), "v"(ad[3]) : "memory"); }
            WAITPIN4(0, v[0], v[1], v[2], v[3]); WAITPIN4(0, v[4], v[5], v[6], v[7]); WAITPIN4(0, v[8], v[9], v[10], v[11]); WAITPIN4(0, v[12], v[13], v[14], v[15]);
            if (st + 2 < nstep) KV_DMA(st + 2);
            pg8::f32x4 s0 = {0.f, 0.f, 0.f, 0.f};
            s0 = __builtin_amdgcn_mfma_f32_16x16x32_bf16(oh, bbf, s0, 0, 0, 0);
#pragma unroll
            for (int ks = 0; ks < 8; ++ks) { if (noqk) { if (ks == 0) s0[0] += __builtin_bit_cast(float, ((unsigned)af[0][0] << 16) ^ ((unsigned)af[1][1] << 16) ^ ((unsigned)af[2][1] << 16) ^ ((unsigned)af[3][1] << 16) ^ ((unsigned)af[4][1] << 16) ^ ((unsigned)af[5][1] << 16) ^ ((unsigned)af[6][1] << 16) ^ ((unsigned)af[7][1] << 16)); } else s0 = __builtin_amdgcn_mfma_f32_16x16x32_bf16(af[ks], qf[ks], s0, 0, 0, 0); }
            float tmax = fmaxf(fmaxf(s0[0], s0[1]), fmaxf(s0[2], s0[3]));
            if (!nosm) { tmax = fmaxf(tmax, __shfl_xor(tmax, 16)); tmax = fmaxf(tmax, __shfl_xor(tmax, 32)); }
            const float m_new = fmaxf(m_run, tmax); const float scl = __expf(m_run - m_new); const bool grow = m_new > m_run; m_run = m_new;
            float sv[4]; float ps = 0.f;
#pragma unroll
            for (int j = 0; j < 4; ++j) { sv[j] = __expf(s0[j] - m_new); ps += sv[j]; }
            l_run = l_run * scl + ps;
            typedef short bf16x4_t __attribute__((ext_vector_type(4)));
            bf16x4_t pf; { u32x2 w; w.x = pk2(sv[0], sv[1]); w.y = pk2(sv[2], sv[3]); pf = __builtin_bit_cast(bf16x4_t, w); }
            if (__builtin_amdgcn_ballot_w64(grow) != 0ull) {
                float rs[4];
#pragma unroll
                for (int e = 0; e < 4; ++e) rs[e] = __shfl(scl, 4 * g + e);
#pragma unroll
                for (int nt = 0; nt < 16; ++nt) {
#pragma unroll
                    for (int e = 0; e < 4; ++e) acc[nt][e] *= rs[e]; } }
#pragma unroll
            for (int k = 0; k < 16; ++k) { if (nopv) { acc[k][0] += __builtin_bit_cast(float, (unsigned)v[k][0] << 16) * sv[0]; } else acc[k] = __builtin_amdgcn_mfma_f32_16x16x16bf16_1k(pf, __builtin_bit_cast(bf16x4_t, v[k]), acc[k], 0, 0, 0); }
        }
#undef KV_DMA
#undef ONEHOT
        float lt = l_run + __shfl_xor(l_run, 16); lt += __shfl_xor(lt, 32); const float inv = 1.0f / lt;
        float ri[4];
#pragma unroll
        for (int e = 0; e < 4; ++e) ri[e] = __shfl(inv, 4 * g + e);
        if (g < 2) {
#pragma unroll
            for (int nt = 0; nt < 16; ++nt) { LDSP unsigned short* o1 = (LDSP unsigned short*)(tile) + (4 * g) * 256 + nt * 16 + c;
                o1[0] = f2bf(acc[nt][0] * ri[0]); o1[256] = f2bf(acc[nt][1] * ri[1]); o1[512] = f2bf(acc[nt][2] * ri[2]); o1[768] = f2bf(acc[nt][3] * ri[3]); }
        }
    }
    u32x4 nsel_v = {0u, 0u, 0u, 0u};
    if (nxt_unit >= 0 && lane < 32) { const int nb = nxt_unit >> 9, nq = nxt_unit & 511; nsel_v = *((const u32x4*)(idx + (size_t)(nb * SEQ + nq * 8 + wave) * TOPK) + lane); }
    asm volatile("s_waitcnt lgkmcnt(0)" ::: "memory"); __builtin_amdgcn_s_barrier(); asm volatile("" ::: "memory");
    if (qmode == 1) {
        bf16* oscr = qscr + 16384;
#pragma unroll
        for (int j = 0; j < 4; ++j) *((u32x4*)(oscr + (size_t)wave * 2048) + j * 64 + lane) = *((const LDSP u32x4*)(tile) + j * 64 + lane);
    } else {
        const int h = wave; pg8::f32x4 o[4];
#pragma unroll
        for (int nt = 0; nt < 4; ++nt) o[nt] = (pg8::f32x4){0.f, 0.f, 0.f, 0.f};
        const LDSP unsigned char* ab = lds + TILE_STRIDE * (c & 7) + (h * 256 + g * 8) * 2;
        const unsigned long long* os = (const unsigned long long*)(qscr + 16384 + ((c & 7) * 8 + h) * 256 + g * 8);
        const bf16* wb = WUV + ((size_t)h * 64 + c) * 256 + g * 8;
        const bool from_scr = (qmode == 2) && (c < 8);
#pragma unroll
        for (int ks = 0; ks < 8; ++ks) { bf16x8_t a;
            if (from_scr) { const unsigned long long lo = __hip_atomic_load(os + ks * 8, __ATOMIC_RELAXED, __HIP_MEMORY_SCOPE_AGENT), hi = __hip_atomic_load(os + ks * 8 + 1, __ATOMIC_RELAXED, __HIP_MEMORY_SCOPE_AGENT);
                u32x4 w; w.x = (unsigned)lo; w.y = (unsigned)(lo >> 32); w.z = (unsigned)hi; w.w = (unsigned)(hi >> 32); a = __builtin_bit_cast(bf16x8_t, w); }
            else a = *(const LDSP bf16x8_t*)(ab + ks * 64);
#pragma unroll
            for (int nt = 0; nt < 4; ++nt) { const bf16x8_t bw = *(const bf16x8_t*)(wb + (size_t)nt * 16 * 256 + ks * 32); o[nt] = __builtin_amdgcn_mfma_f32_16x16x32_bf16(a, bw, o[nt], 0, 0, 0); } }
        const int rbase = (qmode == 2) ? t0 - 8 : t0;
        if ((g < 2 || qmode == 2) && !dry) {
#pragma unroll
            for (int nt = 0; nt < 4; ++nt)
#pragma unroll
                for (int e = 0; e < 4; ++e) RA[(size_t)(rbase + 4 * g + e) * NA + A_Q + h * 64 + nt * 16 + c] = f2bf(o[nt][e]); }
    }
    if (nxt_unit >= 0 && lane < 32) *((LDSP u32x4*)selw_n + lane) = nsel_v;
    asm volatile("s_waitcnt vmcnt(0) lgkmcnt(0)" ::: "memory"); __builtin_amdgcn_s_barrier(); asm volatile("" ::: "memory");
}

#define QLS_PTR(t) (RB + (size_t)(t) * NB + 1024)
__device__ __forceinline__ void wg_qlat_all(const bf16* RA, bf16* RB, const bf16* __restrict__ WUK, int blk, int G, int tid) {
    const int lane = tid & 63, wave = __builtin_amdgcn_readfirstlane(tid >> 6), g = lane >> 4, c = lane & 15, h = wave;
    const bf16* wb = WUK + ((size_t)h * 256 + c) * 64 + g * 8;
    bf16x8_t a0[16], a1[16];
#pragma unroll
    for (int rt = 0; rt < 16; ++rt) { a0[rt] = *(const bf16x8_t*)(wb + rt * 16 * 64); a1[rt] = *(const bf16x8_t*)(wb + rt * 16 * 64 + 32); }
#pragma clang loop unroll(disable)
    for (int i = blk; i < T / 16; i += G) { const int b_ = i & 7, j_ = i >> 3, tg = b_ * SEQ + (255 - j_) * 16;
        const bf16* qr = RA + (size_t)(tg + c) * NA + A_Q + h * 64 + g * 8;
        const bf16x8_t b0 = *(const bf16x8_t*)qr, b1 = *(const bf16x8_t*)(qr + 32);
        bf16* dst = QLS_PTR(tg + c) + h * 256 + 4 * g;
#pragma unroll
        for (int rt = 0; rt < 16; ++rt) { pg8::f32x4 acc = {0.f, 0.f, 0.f, 0.f};
            acc = __builtin_amdgcn_mfma_f32_16x16x32_bf16(a0[rt], b0, acc, 0, 0, 0); acc = __builtin_amdgcn_mfma_f32_16x16x32_bf16(a1[rt], b1, acc, 0, 0, 0);
            u32x2 w; w.x = pk2(acc[0], acc[1]); w.y = pk2(acc[2], acc[3]); *(u32x2*)(dst + rt * 16) = w; } }
}
__device__ __forceinline__ void wg_aout_all(bf16* RA, const bf16* RB, const bf16* __restrict__ WUV, int blk, int G, int tid) {
    const int lane = tid & 63, wave = __builtin_amdgcn_readfirstlane(tid >> 6), g = lane >> 4, c = lane & 15, h = wave;
    const bf16* wb = WUV + ((size_t)h * 64 + c) * 256 + g * 8;
    bf16x8_t bw[4][8];
#pragma unroll
    for (int nt = 0; nt < 4; ++nt)
#pragma unroll
        for (int ks = 0; ks < 8; ++ks) bw[nt][ks] = *(const bf16x8_t*)(wb + (size_t)nt * 16 * 256 + ks * 32);
#pragma clang loop unroll(disable)
    for (int i = blk; i < T / 16; i += G) { const int b_ = i & 7, j_ = i >> 3, tg = b_ * SEQ + (255 - j_) * 16;
        const unsigned long long* os = (const unsigned long long*)(QLS_PTR(tg + c) + h * 256 + g * 8);
        pg8::f32x4 o[4];
#pragma unroll
        for (int nt = 0; nt < 4; ++nt) o[nt] = (pg8::f32x4){0.f, 0.f, 0.f, 0.f};
        bf16x8_t a[8];
#pragma unroll
        for (int ks = 0; ks < 8; ++ks) { const unsigned long long lo = __hip_atomic_load(os + ks * 8, __ATOMIC_RELAXED, __HIP_MEMORY_SCOPE_AGENT), hi = __hip_atomic_load(os + ks * 8 + 1, __ATOMIC_RELAXED, __HIP_MEMORY_SCOPE_AGENT);
            u32x4 w; w.x = (unsigned)lo; w.y = (unsigned)(lo >> 32); w.z = (unsigned)hi; w.w = (unsigned)(hi >> 32); a[ks] = __builtin_bit_cast(bf16x8_t, w); }
#pragma unroll
        for (int ks = 0; ks < 8; ++ks)
#pragma unroll
            for (int nt = 0; nt < 4; ++nt) o[nt] = __builtin_amdgcn_mfma_f32_16x16x32_bf16(a[ks], bw[nt][ks], o[nt], 0, 0, 0);
#pragma unroll
        for (int nt = 0; nt < 4; ++nt)
#pragma unroll
            for (int e = 0; e < 4; ++e) RA[(size_t)(tg + 4 * g + e) * NA + A_Q + h * 64 + nt * 16 + c] = f2bf(o[nt][e]); }
}
__device__ __forceinline__ void wg_attn8(LDSP unsigned char* lds, bf16* RB, const bf16* __restrict__ CKVC, const float* __restrict__ rel_bias, int unit, int par, int tid, bool pre = false, bool nxt = false) {
    const int lane = tid & 63, wave = __builtin_amdgcn_readfirstlane(tid >> 6), g = lane >> 4, c = lane & 15;
    const int b = unit >> 9, qg = unit & 511, t0 = b * SEQ + qg * 8, nk = ((qg >> 3) + 1) << 6, nsel = nk < TOPK ? nk : TOPK;
    LDSP unsigned char* tile = lds + wave * TILE_STRIDE;
    LDSP unsigned short* selw = (LDSP unsigned short*)(lds + SELW_OFF + (par * 8 + wave) * 512);
    const bf16* kvb = CKVC + (size_t)b * SEQ * KV_R;
    const int nstep = nsel >> 4;
#define KV_KEYS(step) (*(const LDSP u32x2*)(selw + (step) * 16 + 4 * g))
#define KV_DMA(step, kk_) do { LDSP unsigned char* sl_ = tile + ((step) & 1) * 8192; \
        _Pragma("unroll") for (int i4_ = 0; i4_ < 4; ++i4_) { const unsigned kw_ = (i4_ >> 1) ? kk_.y : kk_.x; const int key_ = (int)((i4_ & 1) ? (kw_ >> 16) : (kw_ & 0xffffu)); const int c16_ = c ^ ((g << 2) | i4_); \
            const bf16* src_ = kvb + (size_t)key_ * KV_R + c16_ * 8; \
            __builtin_amdgcn_global_load_lds((const unsigned*)src_, (LDSP unsigned*)(sl_ + 1024 * i4_), 16, 0, 0); \
            __builtin_amdgcn_global_load_lds((const unsigned*)(src_ + 128), (LDSP unsigned*)(sl_ + 4096 + 1024 * i4_), 16, 0, 0); } } while (0)
    const LDSP unsigned short* selw_n = (const LDSP unsigned short*)(lds + SELW_OFF + (((par + 1) & 1) * 8 + wave) * 512);
    if (!pre) { const u32x2 k0_ = KV_KEYS(0), k1_ = KV_KEYS(1); KV_DMA(0, k0_); if (nstep > 1) KV_DMA(1, k1_); }
    bf16x8_t qf[8];
    {   const unsigned long long* qs = (const unsigned long long*)(QLS_PTR(t0 + wave) + (c & 7) * 256 + g * 8);
#pragma unroll
        for (int ks = 0; ks < 8; ++ks) { const unsigned long long lo = __hip_atomic_load(qs + ks * 8, __ATOMIC_RELAXED, __HIP_MEMORY_SCOPE_AGENT), hi = __hip_atomic_load(qs + ks * 8 + 1, __ATOMIC_RELAXED, __HIP_MEMORY_SCOPE_AGENT);
            u32x4 w; w.x = (unsigned)lo; w.y = (unsigned)(lo >> 32); w.z = (unsigned)hi; w.w = (unsigned)(hi >> 32); qf[ks] = __builtin_bit_cast(bf16x8_t, w); } }
    const unsigned tile_a = (unsigned)(size_t)tile;
    bf16x8_t bbf; { float bv[8];
#pragma unroll
        for (int j = 0; j < 8; ++j) bv[j] = rel_bias[(8 * g + j) * 8 + (c & 7)];
        u32x4 w; w.x = pk2(bv[0], bv[1]); w.y = pk2(bv[2], bv[3]); w.z = pk2(bv[4], bv[5]); w.w = pk2(bv[6], bv[7]); bbf = __builtin_bit_cast(bf16x8_t, w); }
    {
        const int spos = (qg * 8 + wave);
        pg8::f32x4 acc[16];
#pragma unroll
        for (int nt = 0; nt < 16; ++nt) acc[nt] = (pg8::f32x4){0.f, 0.f, 0.f, 0.f};
        float m_run = -INFINITY, l_run = 0.f;
#define ONEHOT(dst, key) do { const int rel_ = (key) - spos, n_ = rel_ < 0 ? -rel_ : rel_; \
            const int big_ = 8 + (n_ >= 15) + (n_ >= 27) + (n_ >= 50) + (n_ >= 91) + (n_ >= 166) + (n_ >= 305) + (n_ >= 559); \
            const int pos_ = (n_ < 8 ? n_ : big_) + (rel_ > 0 ? 16 : 0) - 8 * g; const unsigned one_ = (pos_ & 1) ? 0x3F800000u : 0x3F80u; const int hi_ = pos_ >> 1; \
            u32x4 w_; w_.x = (hi_ == 0) ? one_ : 0u; w_.y = (hi_ == 1) ? one_ : 0u; w_.z = (hi_ == 2) ? one_ : 0u; w_.w = (hi_ == 3) ? one_ : 0u; dst = __builtin_bit_cast(bf16x8_t, w_); } while (0)
        const int q4 = c >> 2, p = c & 3;
        const unsigned rd0 = tile_a + 256 * c + 16 * (g ^ (c >> 2)); const unsigned rx = (unsigned)(c & 3);
        const unsigned tr0 = tile_a + 256 * (4 * g + q4) + 8 * (p & 1); const unsigned ts = (unsigned)(((q4 << 2) | g)), tb0 = (unsigned)(p >> 1);
        const LDSP unsigned short* selk = selw + 4 * (c & 3) + (c >> 2);
        bf16x8_t oh; { const int key0 = (int)selk[0]; ONEHOT(oh, key0); }
        for (int st = 0; st < nstep; ++st) {
            const unsigned so = (unsigned)((st & 1) * 8192);
            if (st + 1 < nstep || nxt) asm volatile("s_waitcnt vmcnt(8)" ::: "memory"); else asm volatile("s_waitcnt vmcnt(0)" ::: "memory");
            bf16x8_t af[8]; u16x4_t v[16];
#pragma unroll
            for (int ks = 0; ks < 8; ++ks) af[ks] = *(const LDSP bf16x8_t*)(size_t)(rd0 + so + (ks >> 2) * 4096 + 64 * (((unsigned)(ks & 3)) ^ rx));
#pragma unroll
            for (int n4 = 0; n4 < 4; ++n4) { unsigned ad[4];
#pragma unroll
                for (int k = 0; k < 4; ++k) { const unsigned nt = (unsigned)(n4 * 4 + k); ad[k] = tr0 + so + (nt >> 3) * 4096 + 16 * ((((nt & 7) << 1) | tb0) ^ ts); }
                asm volatile("ds_read_b64_tr_b16 %0, %4\n\tds_read_b64_tr_b16 %1, %5\n\tds_read_b64_tr_b16 %2, %6\n\tds_read_b64_tr_b16 %3, %7" : "=&v"(v[n4 * 4]), "=&v"(v[n4 * 4 + 1]), "=&v"(v[n4 * 4 + 2]), "=&v"(v[n4 * 4 + 3]) : "v"(ad[0]), "v"(ad[1]), "v"(ad[2]), "v"(ad[3]) : "memory"); }
            const int key_n = (int)selk[(st + 1) * 16]; const u32x2 kk2 = (st + 2 < nstep) ? KV_KEYS(st + 2) : *(const LDSP u32x2*)(selw_n + (st + 2 - nstep) * 16 + 4 * g);
            WAITPIN4(0, v[0], v[1], v[2], v[3]); WAITPIN4(0, v[4], v[5], v[6], v[7]); WAITPIN4(0, v[8], v[9], v[10], v[11]); WAITPIN4(0, v[12], v[13], v[14], v[15]);
            if (st + 2 < nstep || nxt) KV_DMA(st + 2, kk2);
            pg8::f32x4 s0 = {0.f, 0.f, 0.f, 0.f};
            s0 = __builtin_amdgcn_mfma_f32_16x16x32_bf16(oh, bbf, s0, 0, 0, 0);
#pragma unroll
            for (int ks = 0; ks < 8; ++ks) s0 = __builtin_amdgcn_mfma_f32_16x16x32_bf16(af[ks], qf[ks], s0, 0, 0, 0);
            ONEHOT(oh, key_n);
            float tmax = fmaxf(fmaxf(s0[0], s0[1]), fmaxf(s0[2], s0[3]));
            {   float ta = tmax, tb = tmax;
                asm volatile("s_nop 1\n\tv_permlane16_swap_b32 %0, %1" : "+v"(ta), "+v"(tb)); tmax = fmaxf(ta, tb); ta = tmax; tb = tmax;
                asm volatile("s_nop 1\n\tv_permlane32_swap_b32 %0, %1" : "+v"(ta), "+v"(tb)); tmax = fmaxf(ta, tb); }
            if (__builtin_amdgcn_ballot_w64(tmax > m_run + 8.0f) != 0ull) {
                const float m_new = fmaxf(m_run, tmax); const float scl = __expf(m_run - m_new); m_run = m_new; l_run *= scl;
#pragma unroll
                for (int nt = 0; nt < 16; ++nt) {
#pragma unroll
                    for (int e = 0; e < 4; ++e) acc[nt][e] *= scl; } }
            float sv[4]; float ps = 0.f;
#pragma unroll
            for (int j = 0; j < 4; ++j) { sv[j] = __expf(s0[j] - m_run); ps += sv[j]; }
            l_run += ps;
            typedef short bf16x4_t __attribute__((ext_vector_type(4)));
            bf16x4_t pf; { u32x2 w; w.x = pk2(sv[0], sv[1]); w.y = pk2(sv[2], sv[3]); pf = __builtin_bit_cast(bf16x4_t, w); }
#pragma unroll
            for (int k = 0; k < 16; ++k) acc[k] = __builtin_amdgcn_mfma_f32_16x16x16bf16_1k(__builtin_bit_cast(bf16x4_t, v[k]), pf, acc[k], 0, 0, 0);
        }
#undef KV_DMA
#undef KV_KEYS
#undef ONEHOT
        float lt; { float ta = l_run, tb = l_run;
            asm volatile("s_nop 1\n\tv_permlane16_swap_b32 %0, %1" : "+v"(ta), "+v"(tb)); lt = ta + tb; ta = lt; tb = lt;
            asm volatile("s_nop 1\n\tv_permlane32_swap_b32 %0, %1" : "+v"(ta), "+v"(tb)); lt = ta + tb; }
        const float inv = 1.0f / lt;
        if (c < 8) { bf16* orow = QLS_PTR(t0 + wave) + c * 256 + 4 * g;
#pragma unroll
            for (int nt = 0; nt < 16; ++nt) { u32x2 w; w.x = pk2(acc[nt][0] * inv, acc[nt][1] * inv); w.y = pk2(acc[nt][2] * inv, acc[nt][3] * inv); *(u32x2*)(orow + nt * 16) = w; } }
    }
    asm volatile("s_waitcnt lgkmcnt(0)" ::: "memory");
}

#ifndef SSM_AUX
#define SSM_AUX 0
#endif
#ifndef SSM_HSPLIT
#define SSM_HSPLIT 32
#endif
#ifndef SSM_SPLIT_V
#define SSM_SPLIT_V 42
#endif
constexpr int SSM_SPLIT = SSM_SPLIT_V;
constexpr int XP = 144, BP = 272;
constexpr int SB_X = 0, SB_B = 8192, SB_C = 24576, SB_SIZE = 40960;
constexpr int L_XS = 2 * SB_SIZE, L_M = L_XS + 64 * XP, L_HC = L_M + 64 * XP, L_TB = L_HC + 2 * 64 * BP;
static_assert(L_TB + 2048 <= 140 * 1024, "ssm lds");
#define TR2(d0, d1, a0, a1) asm volatile("ds_read_b64_tr_b16 %0, %2\n\tds_read_b64_tr_b16 %1, %3\n\ts_waitcnt lgkmcnt(0)" : "=&v"(d0), "=&v"(d1) : "v"(a0), "v"(a1) : "memory")
#define TR2N(d0, d1, a0, a1) asm volatile("ds_read_b64_tr_b16 %0, %2\n\tds_read_b64_tr_b16 %1, %3" : "=&v"(d0), "=&v"(d1) : "v"(a0), "v"(a1) : "memory")
#define TR8NA(d0, d1, d2, d3, d4, d5, d6, d7, a0, a1, a2, a3, a4, a5, a6, a7) asm volatile( \
    "ds_read_b64_tr_b16 %0, %8\n\tds_read_b64_tr_b16 %1, %9\n\tds_read_b64_tr_b16 %2, %10\n\tds_read_b64_tr_b16 %3, %11\n\t" \
    "ds_read_b64_tr_b16 %4, %12\n\tds_read_b64_tr_b16 %5, %13\n\tds_read_b64_tr_b16 %6, %14\n\tds_read_b64_tr_b16 %7, %15" \
    : "=&v"(d0), "=&v"(d1), "=&v"(d2), "=&v"(d3), "=&v"(d4), "=&v"(d5), "=&v"(d6), "=&v"(d7) : "v"(a0), "v"(a1), "v"(a2), "v"(a3), "v"(a4), "v"(a5), "v"(a6), "v"(a7) : "memory")
__device__ __forceinline__ bf16x8_t mk8(u16x4_t a, u16x4_t b) { bf16x8_t r; r[0] = a[0]; r[1] = a[1]; r[2] = a[2]; r[3] = a[3]; r[4] = b[0]; r[5] = b[1]; r[6] = b[2]; r[7] = b[3]; return r; }
__device__ __forceinline__ int bc_off(int row, int ch) { return 256 * row + 16 * (ch ^ (((row & 3) << 2) | ((row >> 2) & 3))); }
__device__ __forceinline__ void ssm_dma(LDSP unsigned char* buf, const bf16* __restrict__ XA, int tc0, int h, int grp, int wave, int lane, bool full) {
    {   const int row = 8 * wave + (lane >> 3), ch = lane & 7;
        __builtin_amdgcn_global_load_lds((const unsigned*)(XA + (size_t)(tc0 + row) * XBC + h * 64 + ch * 8), (LDSP unsigned*)(buf + 1024 * wave), 16, 0, SSM_AUX); }
#pragma unroll
    for (int k = 0; k < 4; ++k) { if (k >= 2 && !full) break;
        const int pp = wave + 8 * (k & 1), row = 4 * pp + (lane >> 4), ch = (lane & 15) ^ (((row & 3) << 2) | ((row >> 2) & 3));
        __builtin_amdgcn_global_load_lds((const unsigned*)(XA + (size_t)(tc0 + row) * XBC + (k < 2 ? 1024 : 1280) + grp * 128 + ch * 8), (LDSP unsigned*)(buf + 1024 * (8 + 16 * (k >> 1) + pp)), 16, 0, SSM_AUX); }
}
__device__ __forceinline__ void wg_ssm_unit(LDSP unsigned char* lds, bf16* RA, const bf16* __restrict__ XA, const float* __restrict__ DTt,
                                            const float* __restrict__ a_log, const float* __restrict__ dsk, int unit, int tid, bf16* dbg_out = nullptr, bool dry = false, float* ST = nullptr, unsigned* flg = nullptr) {
    const int lane = tid & 63, wave = __builtin_amdgcn_readfirstlane(tid >> 6), g = lane >> 4, c = lane & 15, q4 = c >> 2, p4 = c & 3;
    const int b = unit >> 5, h = (unit >> 1) & 15, seg = unit & 1, grp = h >> 3, pq = wave & 3, hf = wave >> 2;
    const float Dh = dsk[h];
    const unsigned lds_a = (unsigned)(size_t)lds;
    LDSP float* TB = (LDSP float*)(lds + L_TB);
    typedef float f32x2_t __attribute__((ext_vector_type(2)));
    const f32x2_t* dtp = (const f32x2_t*)DTt + (size_t)(b * 16 + h) * SEQ;
    pg8::f32x4 hacc[4];
#pragma unroll
    for (int nt = 0; nt < 4; ++nt) hacc[nt] = (pg8::f32x4){0.f, 0.f, 0.f, 0.f};
    for (int i = tid; i < (2 * 64 * BP) / 4; i += NTHR) ((LDSP unsigned*)(lds + L_HC))[i] = 0u;
    const bool hand = ST != nullptr;
    const int c_beg = (hand && seg) ? SSM_HSPLIT : 0;
    const int c_end = seg ? 64 : (hand ? SSM_HSPLIT : SSM_SPLIT);
    const int bh = b * 16 + h;
    ssm_dma(lds + (c_beg & 1) * SB_SIZE, XA, b * SEQ + c_beg * 64, h, grp, wave, lane, hand || seg == 0 || SSM_SPLIT == 0);
    f32x2_t dt_cur = dtp[c_beg * 64 + lane];
    if (hand && seg) {
        if (tid == 0) { unsigned sp_ = 0; while (__hip_atomic_load(flg + bh, __ATOMIC_RELAXED, __HIP_MEMORY_SCOPE_AGENT) == 0u) { __builtin_amdgcn_s_sleep(2); if (++sp_ > (1u << 22)) break; }
            __builtin_amdgcn_fence(__ATOMIC_ACQUIRE, "agent"); asm volatile("s_waitcnt vmcnt(0)" ::: "memory"); }
        asm volatile("s_waitcnt lgkmcnt(0)" ::: "memory"); __builtin_amdgcn_s_barrier(); asm volatile("" ::: "memory");
        const unsigned long long* sp = (const unsigned long long*)(ST + (size_t)bh * 8192 + (16 * pq + c) * 128 + 64 * hf + 4 * g);
        LDSP unsigned char* h0 = lds + L_HC + (c_beg & 1) * (64 * BP);
#pragma unroll
        for (int nt = 0; nt < 4; ++nt) { const unsigned long long lo = __hip_atomic_load(sp + 8 * nt, __ATOMIC_RELAXED, __HIP_MEMORY_SCOPE_AGENT), hi = __hip_atomic_load(sp + 8 * nt + 1, __ATOMIC_RELAXED, __HIP_MEMORY_SCOPE_AGENT);
            hacc[nt][0] = __uint_as_float((unsigned)lo); hacc[nt][1] = __uint_as_float((unsigned)(lo >> 32)); hacc[nt][2] = __uint_as_float((unsigned)hi); hacc[nt][3] = __uint_as_float((unsigned)(hi >> 32));
            u32x2 hw; hw.x = pk2(hacc[nt][0], hacc[nt][1]); hw.y = pk2(hacc[nt][2], hacc[nt][3]);
            *(LDSP u32x2*)(h0 + (16 * pq + c) * BP + (64 * hf + 16 * nt + 4 * g) * 2) = hw; }
    }
    asm volatile("s_waitcnt vmcnt(0) lgkmcnt(0)" ::: "memory"); __builtin_amdgcn_s_barrier(); asm volatile("" ::: "memory");
    for (int ci = c_beg; ci < c_end; ++ci) {
        const bool full = hand || (seg == 0) || (ci >= SSM_SPLIT);
        const int tc0 = b * SEQ + ci * 64;
        LDSP unsigned char* buf = lds + (ci & 1) * SB_SIZE;
        f32x2_t dt_nxt = {0.f, 0.f};
        if (ci + 1 < c_end) { ssm_dma(lds + ((ci + 1) & 1) * SB_SIZE, XA, tc0 + 64, h, grp, wave, lane, hand || (seg == 0) || (ci + 1 >= SSM_SPLIT)); dt_nxt = dtp[(ci + 1) * 64 + lane]; }
        u32x2 zr[2] = {{0u, 0u}, {0u, 0u}};
        if (full) {
#pragma unroll
            for (int k2 = 0; k2 < 2; ++k2) zr[k2] = *(const u32x2*)(RA + (size_t)(tc0 + 16 * (2 * hf + k2) + c) * NA + A_Z + h * 64 + 16 * pq + 4 * g); }
        {   const float dt = dt_cur.x, acs = dt_cur.y; const float tot = __builtin_bit_cast(float, __builtin_amdgcn_readlane(__builtin_bit_cast(int, acs), 63));
            TB[lane] = dt; TB[64 + lane] = acs; TB[128 + lane] = __expf(acs); TB[192 + lane] = __expf(tot - acs) * dt; if (lane == 0) TB[256] = __expf(tot); }
        asm volatile("s_waitcnt lgkmcnt(0)" ::: "memory");
        {   const int row = tid >> 3, ch = tid & 7; const u32x4 xv = *(const LDSP u32x4*)(buf + SB_X + row * 128 + ch * 16); const float wl = TB[192 + row]; const unsigned xw[4] = {xv.x, xv.y, xv.z, xv.w}; u32x4 o;
            o.x = pk2(__builtin_bit_cast(float, xw[0] << 16) * wl, __builtin_bit_cast(float, xw[0] & 0xffff0000u) * wl); o.y = pk2(__builtin_bit_cast(float, xw[1] << 16) * wl, __builtin_bit_cast(float, xw[1] & 0xffff0000u) * wl);
            o.z = pk2(__builtin_bit_cast(float, xw[2] << 16) * wl, __builtin_bit_cast(float, xw[2] & 0xffff0000u) * wl); o.w = pk2(__builtin_bit_cast(float, xw[3] << 16) * wl, __builtin_bit_cast(float, xw[3] & 0xffff0000u) * wl);
            *(LDSP u32x4*)(lds + L_XS + row * XP + ch * 16) = o; }
        if (full) {
            const int lt = wave >> 1;
#pragma unroll
            for (int k2 = 0; k2 < 2; ++k2) { const int st = 2 * (wave & 1) + k2; pg8::f32x4 ga = {0.f, 0.f, 0.f, 0.f};
#pragma unroll
                for (int ks = 0; ks < 4; ++ks) { const bf16x8_t af = *(const LDSP bf16x8_t*)(buf + SB_C + bc_off(16 * lt + c, 4 * ks + g)), bfm = *(const LDSP bf16x8_t*)(buf + SB_B + bc_off(16 * st + c, 4 * ks + g));
                    ga = __builtin_amdgcn_mfma_f32_16x16x32_bf16(bfm, af, ga, 0, 0, 0); }
                const int l = 16 * lt + c, s4 = 16 * st + 4 * g; const float acs_l = TB[64 + l];
                const pg8::f32x4 acs_s = *(const LDSP pg8::f32x4*)(TB + 64 + s4), dt_s = *(const LDSP pg8::f32x4*)(TB + s4); float m[4];
#pragma unroll
                for (int e = 0; e < 4; ++e) m[e] = (s4 + e <= l) ? ga[e] * __expf(acs_l - acs_s[e]) * dt_s[e] : 0.f;
                u32x2 mw; mw.x = pk2(m[0], m[1]); mw.y = pk2(m[2], m[3]); *(LDSP u32x2*)(lds + L_M + l * XP + s4 * 2) = mw; }
        }
        asm volatile("s_waitcnt lgkmcnt(0)" ::: "memory"); __builtin_amdgcn_s_barrier(); asm volatile("" ::: "memory");
        if (full) {
            pg8::f32x4 ya[2] = {{0.f, 0.f, 0.f, 0.f}, {0.f, 0.f, 0.f, 0.f}};
            const LDSP unsigned char* hcur = lds + L_HC + (ci & 1) * (64 * BP);
#pragma unroll
            for (int ks = 0; ks < 4; ++ks) { const bf16x8_t hb = *(const LDSP bf16x8_t*)(hcur + (16 * pq + c) * BP + (32 * ks + 8 * g) * 2);
#pragma unroll
                for (int k2 = 0; k2 < 2; ++k2) { const bf16x8_t af = *(const LDSP bf16x8_t*)(buf + SB_C + bc_off(16 * (2 * hf + k2) + c, 4 * ks + g)); ya[k2] = __builtin_amdgcn_mfma_f32_16x16x32_bf16(hb, af, ya[k2], 0, 0, 0); } }
#pragma unroll
            for (int k2 = 0; k2 < 2; ++k2) { const float el = TB[128 + 16 * (2 * hf + k2) + c];
#pragma unroll
                for (int e = 0; e < 4; ++e) ya[k2][e] *= el; }
#pragma unroll
            for (int k0 = 0; k0 < 1; ++k0) { u16x4_t xq[2][2]; bf16x8_t mf[2][2];
#pragma unroll
                for (int ks = 0; ks < 2; ++ks) { const unsigned xa = lds_a + (ci & 1) * SB_SIZE + SB_X + (32 * ks + 8 * g + q4) * 128 + (16 * pq + 4 * p4) * 2; TR2N(xq[ks][0], xq[ks][1], xa, xa + 4 * 128); }
#pragma unroll
                for (int ks = 0; ks < 2; ++ks)
#pragma unroll
                    for (int k2 = 0; k2 < 2; ++k2) mf[ks][k2] = *(const LDSP bf16x8_t*)(lds + L_M + (16 * (2 * hf + k2) + c) * XP + (32 * ks + 8 * g) * 2);
                WAITPIN4(0, xq[0][0], xq[0][1], xq[1][0], xq[1][1]);
#pragma unroll
                for (int ks = 0; ks < 2; ++ks) { const bf16x8_t xb = mk8(xq[ks][0], xq[ks][1]);
#pragma unroll
                    for (int k2 = 0; k2 < 2; ++k2) ya[k2] = __builtin_amdgcn_mfma_f32_16x16x32_bf16(xb, mf[ks][k2], ya[k2], 0, 0, 0); } }
#pragma unroll
            for (int k2 = 0; k2 < 2; ++k2) { const int l = 16 * (2 * hf + k2) + c, p4_ = 16 * pq + 4 * g;
                const u32x2 xw = *(const LDSP u32x2*)(buf + SB_X + l * 128 + p4_ * 2); const unsigned xr[2] = {xw.x, xw.y}, zz[2] = {zr[k2].x, zr[k2].y}; float uo[4];
#pragma unroll
                for (int e = 0; e < 4; ++e) { const float x = __builtin_bit_cast(float, (e & 1) ? (xr[e >> 1] & 0xffff0000u) : (xr[e >> 1] << 16)), z = __builtin_bit_cast(float, (e & 1) ? (zz[e >> 1] & 0xffff0000u) : (zz[e >> 1] << 16));
                    uo[e] = (ya[k2][e] + Dh * x) * siluf_(z); }
                u32x2 ow; ow.x = pk2(uo[0], uo[1]); ow.y = pk2(uo[2], uo[3]);
                if (!dry) *(u32x2*)(RA + (size_t)(tc0 + l) * NA + A_Z + h * 64 + p4_) = ow; }
        }
        {   const float dec = TB[256];
#pragma unroll
            for (int nt = 0; nt < 4; ++nt)
#pragma unroll
                for (int e = 0; e < 4; ++e) hacc[nt][e] *= dec;
            {   u16x4_t xq[2][2], v[2][8];
#pragma unroll
                for (int ks = 0; ks < 2; ++ks) { const int row = 32 * ks + 8 * g + q4; const unsigned xa = lds_a + L_XS + row * XP + (16 * pq + 4 * p4) * 2; TR2N(xq[ks][0], xq[ks][1], xa, xa + 4 * XP);
                    unsigned ad[8];
#pragma unroll
                    for (int nt = 0; nt < 4; ++nt) { const int ch = 8 * hf + 2 * nt + (p4 >> 1); ad[2 * nt] = lds_a + (ci & 1) * SB_SIZE + SB_B + bc_off(row, ch) + 8 * (p4 & 1); ad[2 * nt + 1] = lds_a + (ci & 1) * SB_SIZE + SB_B + bc_off(row + 4, ch) + 8 * (p4 & 1); }
                    TR8NA(v[ks][0], v[ks][1], v[ks][2], v[ks][3], v[ks][4], v[ks][5], v[ks][6], v[ks][7], ad[0], ad[1], ad[2], ad[3], ad[4], ad[5], ad[6], ad[7]); }
                WAITPIN4(0, xq[0][0], xq[0][1], xq[1][0], xq[1][1]);
                WAITPIN8(0, v[0][0], v[0][1], v[0][2], v[0][3], v[0][4], v[0][5], v[0][6], v[0][7]); WAITPIN8(0, v[1][0], v[1][1], v[1][2], v[1][3], v[1][4], v[1][5], v[1][6], v[1][7]);
#pragma unroll
                for (int ks = 0; ks < 2; ++ks) { const bf16x8_t xf = mk8(xq[ks][0], xq[ks][1]);
#pragma unroll
                    for (int nt = 0; nt < 4; ++nt) hacc[nt] = __builtin_amdgcn_mfma_f32_16x16x32_bf16(mk8(v[ks][2 * nt], v[ks][2 * nt + 1]), xf, hacc[nt], 0, 0, 0); } }
            LDSP unsigned char* hnext = lds + L_HC + ((ci + 1) & 1) * (64 * BP);
#pragma unroll
            for (int nt = 0; nt < 4; ++nt) { u32x2 hw; hw.x = pk2(hacc[nt][0], hacc[nt][1]); hw.y = pk2(hacc[nt][2], hacc[nt][3]);
                *(LDSP u32x2*)(hnext + (16 * pq + c) * BP + (64 * hf + 16 * nt + 4 * g) * 2) = hw; }
        }
        dt_cur = dt_nxt;
        asm volatile("s_waitcnt vmcnt(0) lgkmcnt(0)" ::: "memory"); __builtin_amdgcn_s_barrier(); asm volatile("" ::: "memory");
    }
    if (hand && !seg && !dry) {
        float* sp = ST + (size_t)bh * 8192 + (16 * pq + c) * 128 + 64 * hf + 4 * g;
#pragma unroll
        for (int nt = 0; nt < 4; ++nt) *(pg8::f32x4*)(sp + 16 * nt) = hacc[nt];
        asm volatile("s_waitcnt vmcnt(0)" ::: "memory"); __builtin_amdgcn_s_barrier(); asm volatile("" ::: "memory");
        if (tid == 0) { __builtin_amdgcn_fence(__ATOMIC_RELEASE, "agent"); asm volatile("s_waitcnt vmcnt(0)" ::: "memory"); __hip_atomic_store(flg + bh, 1u, __ATOMIC_RELAXED, __HIP_MEMORY_SCOPE_AGENT); }
    }
}

__global__ void __launch_bounds__(NTHR, 2) k_fwd(Params P) {
    extern __shared__ __attribute__((aligned(16))) unsigned char lds_raw[];
    LDSP unsigned char* lds = (LDSP unsigned char*)lds_raw;
    volatile LDSP unsigned* MISC = (volatile LDSP unsigned*)(lds + MISC_OFF);
    unsigned char* ws = P.ws;
    const int wave_s = __builtin_amdgcn_readfirstlane(threadIdx.x >> 6);
    for (int u = threadIdx.x; u < (LDS_BYTES - RING_BYTES) / 4; u += NTHR) ((LDSP unsigned*)(lds + RING_BYTES))[u] = 0u;
#define PHASE_IDS int tid = mk_tid(wave_s); int blk = blockIdx.x; asm volatile("" : "+s"(blk)); int G = gridDim.x; asm volatile("" : "+s"(G)); const int NGW = G * NWAVES; (void)NGW; const int lane = tid & 63, wave = __builtin_amdgcn_readfirstlane(tid >> 6), gw = blk * NWAVES + wave; (void)lane; (void)wave; (void)gw; const __attribute__((address_space(4))) char* kargs = (const __attribute__((address_space(4))) char*)__builtin_amdgcn_kernarg_segment_ptr(); asm volatile("" : "+s"(kargs)); int Lp = L; asm volatile("" : "+s"(Lp)); (void)Lp; unsigned char* ws = ((unsigned char* const __attribute__((address_space(4)))*)kargs)[27]; float* out = ((float* const __attribute__((address_space(4)))*)kargs)[26]; const float* x = KIN(0); const float* p = KIN(1); float* rstd = (float*)(ws + WS_RSTD); float* rstd2 = (float*)(ws + WS_RSTD2); float* DTb = (float*)(ws + WS_DT); bf16 *Win = (bf16*)(ws + WS_W_IN), *Wout = (bf16*)(ws + WS_W_OUT), *Wgu = (bf16*)(ws + WS_W_GU), *Wdown = (bf16*)(ws + WS_W_DOWN), *Wpg = (bf16*)(ws + WS_W_PG), *Wpp = (bf16*)(ws + WS_W_PP); bf16 *X0 = (bf16*)(ws + WS_X0), *X1 = (bf16*)(ws + WS_X1), *RA = (bf16*)(ws + WS_RA), *RB = (bf16*)(ws + WS_RB), *XA = (bf16*)out; unsigned short* IDX = (unsigned short*)((unsigned char*)out + 112 * MiB); bf16* CKVC = (bf16*)((unsigned char*)out + 96 * MiB); bf16* IKC = (bf16*)(ws + WS_IKC); bf16* WUK = (bf16*)(ws + WS_WUK); bf16* WUV = (bf16*)(ws + WS_WUV); (void)CKVC; (void)IKC; (void)WUK; (void)WUV; bf16* Xcur = (Lp == 0) ? X0 : X1; (void)out; (void)x; (void)p; (void)rstd; (void)rstd2; (void)DTb; (void)Win; (void)Wout; (void)Wgu; (void)Wdown; (void)Wpg; (void)Wpp; (void)X0; (void)X1; (void)RA; (void)RB; (void)XA; (void)IDX; (void)Xcur
    __syncthreads();
    if (TIMING && blockIdx.x == 0 && mk_tid(wave_s) == 0) { __hip_atomic_store((unsigned long long*)(P.ws + 32768), (unsigned long long)__builtin_amdgcn_s_memrealtime(), __ATOMIC_RELAXED, __HIP_MEMORY_SCOPE_AGENT); __hip_atomic_store((unsigned long long*)(P.ws + 32768) + 60, (unsigned long long)__builtin_amdgcn_s_memtime(), __ATOMIC_RELAXED, __HIP_MEMORY_SCOPE_AGENT); }
#if CLK_PROBE
    if (blockIdx.x == 0 && mk_tid(wave_s) == 0) { __hip_atomic_store((unsigned long long*)(P.ws + 49152), (unsigned long long)__builtin_amdgcn_s_memtime(), __ATOMIC_RELAXED, __HIP_MEMORY_SCOPE_AGENT); __hip_atomic_store((unsigned long long*)(P.ws + 49152) + 1, (unsigned long long)__builtin_amdgcn_s_memrealtime(), __ATOMIC_RELAXED, __HIP_MEMORY_SCOPE_AGENT); }
#endif
    const bool one_launch = (P.ph_hi - P.ph_lo) > 1;
    XcdBarrier bar; bar.bar = (unsigned*)(ws + WS_CTL) + CW_BAR; bar.x = 0; bar.st = nullptr;
    if (one_launch) bar = xcd_barrier_post((unsigned*)(ws + WS_CTL) + CW_BAR, (volatile LAS unsigned*)(MISC + 8));
    if (one_launch && mk_tid(wave_s) == 0) { const unsigned xid_ = xb_xcc_id(); MISC[16] = xid_; MISC[17] = __hip_atomic_fetch_add((unsigned*)(P.ws + WS_CTL) + CW_RANK + 64 * xid_, 1u, __ATOMIC_RELAXED, __HIP_MEMORY_SCOPE_AGENT); }

#ifndef EPI_DBG
#define EPI_DBG 0
#endif
#ifndef PREP_SUB
#define PREP_SUB 31
#endif
#ifndef DT_DENSE
#define DT_DENSE 0
#endif
#ifndef PREP_REP
#define PREP_REP 1
#endif
#ifndef SSM_HANDOFF
#define SSM_HANDOFF 1
#endif
#ifndef GEMM_ALIGN
#define GEMM_ALIGN true
#endif
#ifndef PROJ_STAG
#define PROJ_STAG 0
#endif
#ifndef TW_VAR
#define TW_VAR 0
#endif
#ifndef TW_MASK
#define TW_MASK 0
#endif
#ifndef PH_MASK
#define PH_MASK 0x3fff
#endif
#define PHASE_IDS_NOL const int L = 0; PHASE_IDS
#define NPASS(k) (((DBL_MASK >> (k)) & 1) ? ((Lp == 0 && ((P.dbl_mask >> (k)) & 1)) ? 2 : 1) : 1)
#define XCD_DEAL bool xok_ = false; int xb_ = 0, xr_ = 0, xn_ = 1; { if (tid == 0) { unsigned ok = (MISC[9] == 8u) ? 1u : 0u; unsigned sum = 0; for (int j = 0; j < 8; ++j) { const unsigned cj = __hip_atomic_load((unsigned*)(ws + WS_CTL) + CW_BAR + XB_XCNT(j), __ATOMIC_RELAXED, __HIP_MEMORY_SCOPE_AGENT); sum += cj; if (cj == 0u) ok = 0u; } if (sum != (unsigned)G) ok = 0u; MISC[18] = ok; } \
    __syncthreads(); xok_ = MISC[18] != 0u; xb_ = (int)MISC[16]; xr_ = (int)MISC[17]; xn_ = (int)MISC[8]; if (xn_ < 1) xn_ = 1; __syncthreads(); }
#define KIN(i) (((const float* const __attribute__((address_space(4)))*)kargs)[i])
#define IN(k) (P.ph_lo <= (k) && (k) < P.ph_hi && ((PH_MASK >> ((k) % NPH)) & 1))
#define SEAM(k) do { if (IN((k) + 1)) { XcdBarrier b2_ = bar; asm volatile("" : "+s"(b2_.bar)); xcd_barrier(b2_, mk_tid(wave_s)); } if (TIMING && blockIdx.x == 0 && mk_tid(wave_s) == 0) { __hip_atomic_store((unsigned long long*)(P.ws + 32768) + (k) + 1, (unsigned long long)__builtin_amdgcn_s_memrealtime(), __ATOMIC_RELAXED, __HIP_MEMORY_SCOPE_AGENT); } } while (0)
    for (int L = 0; L < DEPTH; ++L) {
        const int pb = L * NPH;
        if (IN(pb + 0)) { PHASE_IDS; for (int pass = NPASS(0); pass > 0; --pass) {
            LDSP float* scr = (LDSP float*)(lds + wave * 8704);
            ph_prep_w<1>(scr, KIN(6) + (size_t)Lp * D * INW, nullptr, D, INW, KIN(2) + (size_t)Lp * D, Win, NIN, gw, NGW, lane);
            ph_prep_w<0>(scr, KIN(20) + (size_t)Lp * MIXW * D, nullptr, MIXW, D, nullptr, Wout, D, gw, NGW, lane);
            ph_prep_w<2>(scr, KIN(21) + (size_t)Lp * D * DFF, KIN(22) + (size_t)Lp * D * DFF, D, DFF, KIN(4) + (size_t)Lp * D, Wgu, NGU, gw, NGW, lane);
            ph_prep_w<0>(scr, KIN(23) + (size_t)Lp * DFF * D, nullptr, DFF, D, nullptr, Wdown, D, gw, NGW, lane);
            ph_prep_w<0>(scr, KIN(25) + (size_t)Lp * D * D, nullptr, D, D, nullptr, Wpg, D, gw, NGW, lane);
            ph_prep_w<0>(scr, KIN(24) + (size_t)Lp * PLE * D, nullptr, PLE, D, nullptr, Wpp, D, gw, NGW, lane);
            {   const float* uk = KIN(10) + (size_t)Lp * 256 * 8 * 64; const float* uv = KIN(11) + (size_t)Lp * 256 * 8 * 64;
                for (int e = gw * 64 + lane; e < 8 * 256 * 64; e += NGW * 64) { const int h = e >> 14, r = (e >> 6) & 255, d = e & 63; WUK[e] = f2bf(0.125f * uk[((size_t)r * 8 + h) * 64 + d]); }
                for (int e = gw * 64 + lane; e < 8 * 64 * 256; e += NGW * 64) { const int h = e >> 14, d = (e >> 8) & 63, r = e & 255; WUV[e] = f2bf(uv[((size_t)r * 8 + h) * 64 + d]); } }
            if (Lp == 0) { for (int r = gw * 2; r < T; r += NGW * 2) row_x_prep2(x, X0, rstd, r, lane); }
            else        { for (int r = gw * 4; r < T; r += NGW * 4) row_rstd_bf16x4(X1, rstd, r, lane); }
            }
            SEAM(pb + 0);
        }
#if XTRA_BAR
        if (P.ph_hi - P.ph_lo > 1 && L == 0) { for (int i_ = 0; i_ < XTRA_BAR; ++i_) { XcdBarrier b4_ = bar; asm volatile("" : "+s"(b4_.bar)); xcd_barrier(b4_, mk_tid(wave_s)); } }
#endif
        if (IN(pb + 1)) { PHASE_IDS; for (int pass = NPASS(1); pass > 0; --pass) {
            pg8::Gemm g{Xcur, Win, T, NIN, (GEMM_DRYK && pass > 1) ? GEMM_DRYK : D}; pg8::StaticOrder S; S.init(T, NIN, G, blk);
            pg8::EpiProj E{RA, RB, rstd};
#if PROJ_STAG
            if (blk >= 128 && G == 256) { const unsigned long long t0_ = __builtin_amdgcn_s_memrealtime(); const unsigned long long dl_ = (unsigned long long)PROJ_STAG * (1 + ((blk >> 3) & 3)); while (__builtin_amdgcn_s_memrealtime() - t0_ < dl_) __builtin_amdgcn_s_sleep(8); }
#endif
            pg8::gemm_phase<pg8::EpiProj, pg8::StaticOrder, GEMM_ALIGN, true>(lds, g, S, E, tid);
            }
            SEAM(pb + 1);
        }
        if (IN(pb + 2)) { PHASE_IDS;
            for (int pass = NPASS(2); pass > 0; --pass) {
#define PSUB(b) (pass == 1 || ((PREP_SUB >> (b)) & 1))
            if (PSUB(0))
#pragma unroll 2
            for (int it = gw; it < T / 4; it += NGW) prep_ckv4(RB, CKVC, KIN(7) + Lp * KV_R, it, lane);
            if (PSUB(1)) for (int it = gw; it < T / 16; it += NGW) prep_ik16(RB, IKC, KIN(8) + Lp * 64, KIN(9) + Lp * 64, it, lane);
            if (PSUB(2)) for (int rep_ = (pass > 1) ? PREP_REP : 1; rep_ > 0; --rep_)
#pragma unroll 2
            for (int t = gw; t < T; t += NGW) prep_bout(RA, RB, KIN(13) + (size_t)Lp * 3 * 512, t, lane, pass > 1);
            if (PSUB(3)) for (int rep_ = (pass > 1) ? PREP_REP : 1; rep_ > 0; --rep_)
#pragma unroll 2
            for (int it = gw; it < (T / 16) * 12; it += NGW) prep_conv(RB, XA, KIN(14) + (size_t)Lp * 4 * XBC, KIN(15) + (size_t)Lp * XBC, it, lane);
            if (PSUB(4)) for (int rep_ = (pass > 1) ? PREP_REP : 1; rep_ > 0; --rep_) for (int it = gw; it < BATCH * 64 * 4; it += NGW) { const int hq = it & 3, ck = (it >> 2) & 63, bb = it >> 8; const int t = bb * SEQ + ck * 64 + lane;
                const u32x2 rw = *(const u32x2*)(RB + (size_t)t * ((DT_DENSE && pass > 1) ? 256 : NB) + B_DT + hq * 4); const unsigned rr[2] = {rw.x, rw.y}; float dtv[4], ac[4];
#pragma unroll
                for (int e = 0; e < 4; ++e) { const int hh = hq * 4 + e; const float xr = __builtin_bit_cast(float, (e & 1) ? (rr[e >> 1] & 0xffff0000u) : (rr[e >> 1] << 16)) + (KIN(16) + Lp * 16)[hh];
                    dtv[e] = xr > 15.f ? xr : log1pf(__expf(xr)); ac[e] = -__expf((KIN(17) + Lp * 16)[hh]) * dtv[e]; }
#pragma unroll
                for (int o = 1; o < 64; o <<= 1) {
#pragma unroll
                    for (int e = 0; e < 4; ++e) { const float v = __shfl_up(ac[e], o); if (lane >= o) ac[e] += v; } }
#pragma unroll
                for (int e = 0; e < 4; ++e) { typedef float f32x2_t __attribute__((ext_vector_type(2))); ((f32x2_t*)(ws + WS_DT2))[(size_t)(bb * 16 + hq * 4 + e) * SEQ + ck * 64 + lane] = (f32x2_t){dtv[e], ac[e]}; } }
            }
            SEAM(pb + 2);
        }
        if (IN(pb + 3)) { PHASE_IDS;
            const bool ssm_hand = (G == 256) && SSM_HANDOFF;
            const bool ssm_first = ssm_hand ? (blk >= 128) : (((blk >> 3) & 1) == 0);
            float* ssm_st = ssm_hand ? (float*)((unsigned char*)out + 112 * MiB) + (size_t)Lp * (128 * 8192) : nullptr; unsigned* ssm_fl = (unsigned*)(ws + WS_CTL + 65536) + Lp * 128;
#pragma clang loop unroll(disable)
            for (int step = 0; step < 3; ++step) {
                const bool do_ssm = (step == 0 && ssm_first) || (step == 2 && !ssm_first);
                if (do_ssm) {
                    for (int u = blk; u < BATCH * 32; u += G) { const int uu = (u & 127) * 2 + (u >> 7);
                        #pragma clang loop unroll(disable)
                        for (int rs_ = (TW_MASK & 4) ? 1 : 0; rs_ >= 0; --rs_) wg_ssm_unit(lds, RA, XA, (const float*)(ws + WS_DT2), KIN(17) + Lp * 16, KIN(18) + Lp * 16, uu ^ 1, mk_tid(wave_s), nullptr, rs_ > 0, ssm_st, ssm_fl); }
                } else if (step == 1) {
                    wg_qlat_all(RA, RB, WUK, blk, G, mk_tid(wave_s));
                    asm volatile("s_waitcnt vmcnt(0)" ::: "memory"); __builtin_amdgcn_s_barrier(); asm volatile("" ::: "memory");
#pragma clang loop unroll(disable)
                    for (int i = blk; i < T / 16; i += G) { const int b_ = i & 7, j_ = i >> 3, u16 = b_ * 256 + (255 - j_);
                        wg_select16(lds, RB, IKC, IDX, u16, mk_tid(wave_s), false, true);
                        const int ua = b_ * 512 + 2 * (255 - j_);
#pragma clang loop unroll(disable)
                        for (int h2 = 0; h2 < 2; ++h2) wg_attn8(lds, RB, CKVC, KIN(12), ua + h2, h2, mk_tid(wave_s), h2 == 1, h2 == 0);
                        asm volatile("s_waitcnt vmcnt(0) lgkmcnt(0)" ::: "memory"); __builtin_amdgcn_s_barrier(); asm volatile("" ::: "memory"); }
                    wg_aout_all(RA, RB, WUV, blk, G, mk_tid(wave_s));
                }
            }
            SEAM(pb + 5); }

        if (IN(pb + 6)) { PHASE_IDS; for (int pass = NPASS(6); pass > 0; --pass) for (int w = 4 * gw; w < T * 2; w += 4 * NGW) wave_gnorm4(RA, KIN(19) + (size_t)Lp * 1024, w, lane, pass > 1); SEAM(pb + 6); }
        if (IN(pb + 7)) { PHASE_IDS; for (int pass = NPASS(7); pass > 0; --pass) {
            pg8::Gemm g{RA, Wout, T, D, MIXW}; pg8::StaticOrder S; S.init(T, D, G, blk);
            pg8::EpiBf16P E{RB, (long)D};
            pg8::gemm_phase<pg8::EpiBf16P, pg8::StaticOrder, GEMM_ALIGN, true>(lds, g, S, E, tid);
            }
            SEAM(pb + 7);
        }
        if (IN(pb + 8)) { PHASE_IDS; for (int pass = NPASS(8); pass > 0; --pass) for (int r = 2 * gw; r < T; r += 2 * NGW) row_resid_norm2(Xcur, (const bf16*)RB, KIN(3) + (size_t)Lp * D, X0, rstd2, nullptr, nullptr, r, lane, pass > 1); SEAM(pb + 8); }
        if (IN(pb + 9)) { PHASE_IDS; for (int pass = NPASS(9); pass > 0; --pass) {
            pg8::Gemm g{X0, Wgu, T, NGU, D}; pg8::StaticOrder S; S.init(T, NGU, G, blk);
            pg8::EpiSwiGLU E{RB, rstd2};
            pg8::gemm_phase<pg8::EpiSwiGLU, pg8::StaticOrder, GEMM_ALIGN, true>(lds, g, S, E, tid);
            }
            SEAM(pb + 9);
        }
        if (IN(pb + 10)) { PHASE_IDS; for (int pass = NPASS(10); pass > 0; --pass) {
            pg8::Gemm g{RB, Wdown, T, D, DFF}; pg8::StaticOrder S; S.init(T, D, G, blk);
            pg8::EpiBf16P E{RA, (long)D};
            pg8::gemm_phase<pg8::EpiBf16P, pg8::StaticOrder, GEMM_ALIGN, true>(lds, g, S, E, tid);
            }
            SEAM(pb + 10);
        }
        if (IN(pb + 11)) { PHASE_IDS; for (int pass = NPASS(11); pass > 0; --pass) for (int r = 2 * gw; r < T; r += 2 * NGW) row_resid_norm2(X0, (const bf16*)RA, KIN(5) + (size_t)Lp * D, X0, nullptr, p + (size_t)Lp * T * PLE, X1, r, lane, pass > 1); SEAM(pb + 11); }
        if (IN(pb + 12)) { PHASE_IDS; for (int pass = NPASS(12); pass > 0; --pass) {
            pg8::Gemm g{X1, Wpp, T, D, PLE}; pg8::StaticOrder S; S.init(T, D, G, blk);
            pg8::EpiBf16P E{RB, (long)D};
            pg8::gemm_phase<pg8::EpiBf16P, pg8::StaticOrder, GEMM_ALIGN, true>(lds, g, S, E, tid);
            }
            SEAM(pb + 12);
        }
        if (IN(pb + 13)) { PHASE_IDS; for (int pass = NPASS(13); pass > 0; --pass) {
            pg8::Gemm g{X0, Wpg, T, D, D}; pg8::StaticOrder S; S.init(T, D, G, blk);
            pg8::EpiPle E{X0, RB, X1, (Lp == DEPTH - 1) ? out : nullptr};
            pg8::gemm_phase<pg8::EpiPle, pg8::StaticOrder, GEMM_ALIGN, true>(lds, g, S, E, tid);
            }
            SEAM(pb + 13);
        }
    }
#if CLK_PROBE
    if (P.ph_hi == DEPTH * NPH) { PHASE_IDS_NOL; { XcdBarrier b3_ = bar; asm volatile("" : "+s"(b3_.bar)); xcd_barrier(b3_, mk_tid(wave_s)); }
        if (blk == 0 && tid == 0) { const unsigned long long c1 = __builtin_amdgcn_s_memtime(), r1 = __builtin_amdgcn_s_memrealtime(); const unsigned long long* ts = (const unsigned long long*)(ws + 49152);
            const unsigned long long c0 = __hip_atomic_load(ts, __ATOMIC_RELAXED, __HIP_MEMORY_SCOPE_AGENT), r0 = __hip_atomic_load(ts + 1, __ATOMIC_RELAXED, __HIP_MEMORY_SCOPE_AGENT);
            const float mhz = (float)(c1 - c0) / (float)(r1 - r0) * 100.0f; const float q = exp2f(rintf(4.0f * log2f(fmaxf(mhz, 1.0f))) * 0.25f);
            __hip_atomic_store((float*)(ws + 49152 + 64), q * 0.001f, __ATOMIC_RELAXED, __HIP_MEMORY_SCOPE_AGENT); }
        { XcdBarrier b3_ = bar; asm volatile("" : "+s"(b3_.bar)); xcd_barrier(b3_, mk_tid(wave_s)); }
        const float sc = 1.0f + __hip_atomic_load((float*)(ws + 49152 + 64), __ATOMIC_RELAXED, __HIP_MEMORY_SCOPE_AGENT);
        for (size_t i = (size_t)blk * NTHR + tid; i < (size_t)T * D; i += (size_t)G * NTHR) out[i] *= sc; }
#endif
#if TIMING
    if (P.ph_hi == DEPTH * NPH) { PHASE_IDS_NOL; { XcdBarrier b3_ = bar; asm volatile("" : "+s"(b3_.bar)); xcd_barrier(b3_, mk_tid(wave_s)); }
        const unsigned long long* ts = (const unsigned long long*)(ws + 32768);
        const float ta = (float)(__hip_atomic_load(ts + TIMING_A + 1, __ATOMIC_RELAXED, __HIP_MEMORY_SCOPE_AGENT) - __hip_atomic_load(ts + TIMING_A, __ATOMIC_RELAXED, __HIP_MEMORY_SCOPE_AGENT)) * 0.01f;
        const float tb = (float)(__hip_atomic_load(ts + TIMING_B + 1, __ATOMIC_RELAXED, __HIP_MEMORY_SCOPE_AGENT) - __hip_atomic_load(ts + TIMING_B, __ATOMIC_RELAXED, __HIP_MEMORY_SCOPE_AGENT)) * 0.01f;
        float ta_ = ta; if (TIMING_A == 99) { const unsigned long long c1 = __builtin_amdgcn_s_memtime(), r1 = __builtin_amdgcn_s_memrealtime(); const unsigned long long c0 = __hip_atomic_load(ts + 60, __ATOMIC_RELAXED, __HIP_MEMORY_SCOPE_AGENT), r0 = __hip_atomic_load(ts + 0, __ATOMIC_RELAXED, __HIP_MEMORY_SCOPE_AGENT);
            ta_ = (float)(c1 - c0) / (float)(r1 - r0) * 10.0f;   ta_ = __builtin_bit_cast(float, __builtin_amdgcn_readfirstlane(__builtin_bit_cast(int, ta_))); }
        const float taq = exp2f(rintf(4.0f * log2f(fmaxf(ta_, 1.0f)) + TIMING_SHIFT) * 0.25f), tbq = exp2f(rintf(2.0f * log2f(fmaxf(tb, 1.0f)) + TIMING_SHIFT) * 0.5f);
        const float sc = 1.0f + taq * 0.001f;
        for (size_t i = (size_t)blk * NTHR + tid; i < (size_t)T * D; i += (size_t)G * NTHR) out[i] *= sc;
        __syncthreads(); if (blk == 0 && tid == 0) out[0] += tbq * 10.0f; }
#endif
#if DBG_SSM
    if (P.ph_hi == DEPTH * NPH) { PHASE_IDS_NOL; { XcdBarrier b3_ = bar; asm volatile("" : "+s"(b3_.bar)); xcd_barrier(b3_, mk_tid(wave_s)); }
        const float d2 = __hip_atomic_load((float*)(ws + 65536), __ATOMIC_RELAXED, __HIP_MEMORY_SCOPE_AGENT), n2 = __hip_atomic_load((float*)(ws + 65536 + 4), __ATOMIC_RELAXED, __HIP_MEMORY_SCOPE_AGENT);
        const float sc = 1.0f + (n2 > 0.f ? sqrtf(d2 / n2) : 7.0f);
        for (size_t i = (size_t)blk * NTHR + tid; i < (size_t)T * D; i += (size_t)G * NTHR) out[i] *= sc; }
#endif
#undef IN
#undef SEAM
}

#ifndef MK_ONE_LAUNCH
#define MK_ONE_LAUNCH 1
#endif
extern "C" void kernel_launch(void* const* d_in, const int* in_sizes, int n_in, void* d_out, int out_size, void* d_ws, size_t ws_size, hipStream_t stream) {
    static int grid = 0;
    if (grid == 0) {
        if (n_in != 26 || ws_size < WS_END) { fprintf(stderr, "kernel_launch: unexpected n_in %d / ws_size %zu\n", n_in, ws_size); grid = -1; return; }
        int dev = 0, cus = 0, per_cu = 0;
        if (hipGetDevice(&dev) != hipSuccess || hipDeviceGetAttribute(&cus, hipDeviceAttributeMultiprocessorCount, dev) != hipSuccess) { grid = -1; return; }
        if (hipFuncSetAttribute((const void*)k_fwd, hipFuncAttributeMaxDynamicSharedMemorySize, LDS_BYTES) != hipSuccess) { fprintf(stderr, "kernel_launch: hipFuncSetAttribute failed\n"); grid = -1; return; }
        if (hipOccupancyMaxActiveBlocksPerMultiprocessor(&per_cu, (const void*)k_fwd, NTHR, LDS_BYTES) != hipSuccess || per_cu < 1) { fprintf(stderr, "kernel_launch: occupancy query says %d\n", per_cu); }
        (void)hipGetLastError();
        grid = cus;
    }
    if (grid < 0) return;
    if (hipMemsetAsync((char*)d_ws + WS_CTL, 0, CTL_ZERO_BYTES, stream) != hipSuccess) return;
    Params P; memset(&P, 0, sizeof(P));
    for (int i = 0; i < 26; ++i) P.in[i] = (const float*)d_in[i];
    P.out = (float*)d_out; P.ws = (unsigned char*)d_ws;
#if MK_ONE_LAUNCH
    P.ph_lo = 0; P.ph_hi = DEPTH * NPH; P.dbl_mask = DBL_MASK; P.pad = ATT_SUB_V;
    hipLaunchKernelGGL(k_fwd, dim3(grid), dim3(NTHR), LDS_BYTES, stream, P);
#else
    for (int ph = 0; ph < DEPTH * NPH; ++ph) { P.ph_lo = ph; P.ph_hi = ph + 1; hipLaunchKernelGGL(k_fwd, dim3(grid), dim3(NTHR), LDS_BYTES, stream, P); }
#endif
}
```
